# Optimizing an MI355X kernel written in HIP

```python
import jax, jax.numpy as jnp
from jax import lax
import numpy as np

D_MODEL = 2048
BATCH = 1
SEQ = 16384
DEPTH = 1

HA_HEADS = 8
HA_DK = 128
HA_DV = 128
HA_KW = HA_HEADS * HA_DK
HA_VW = HA_HEADS * HA_DV
GB_HEADS = 8
GB_DK = 128
GB_DV = 128
GB_KW = GB_HEADS * GB_DK
GB_VW = GB_HEADS * GB_DV
GB_CONV = 5
GB_CONV_CH = 2 * GB_KW + GB_VW
CHUNK = 64
PEER_HEADS = 8
PEER_NKEYS = 128
PEER_EXPERTS = PEER_NKEYS * PEER_NKEYS
PEER_DQ = 256
PEER_TOPK = 16
PEER_TOKEN_BLOCK = 128
EPS = 1e-6

IN_SPLITS = (HA_KW, HA_KW, HA_KW, HA_VW, HA_VW,
             GB_KW, GB_KW, GB_VW, GB_VW, 2 * GB_HEADS, 2 * GB_HEADS,
             D_MODEL, D_MODEL)
IN_WIDTH = sum(IN_SPLITS)

kernel_name = "hybrid_hgrn2_gdn_peer_encoder"


def rms_norm(x, w):
    xf = x.astype(jnp.float32)
    y = xf * lax.rsqrt(jnp.mean(xf * xf, axis=-1, keepdims=True) + EPS)
    return (y * w.astype(jnp.float32)).astype(x.dtype)


def l2_norm(x):
    return x * lax.rsqrt(jnp.sum(x * x, axis=-1, keepdims=True) + EPS)


def _to_chunks(t):
    b, s, g, d = t.shape
    return t.reshape(b, s // CHUNK, CHUNK, g, d).transpose(1, 0, 3, 2, 4)


def _from_chunks(t):
    nc, b, g, c, d = t.shape
    return t.transpose(1, 0, 3, 2, 4).reshape(b, nc * c, g, d)


def _bidir_stack(fwd, bwd):
    return jnp.concatenate([fwd, jnp.flip(bwd, axis=1)], axis=2)


def _bidir_merge(o, h):
    return o[:, :, :h] + jnp.flip(o[:, :, h:], axis=1)


def hgrn2_mixer(q_in, f_fwd, f_bwd, i_in, og, lb_fwd, lb_bwd, norm_w):
    b, s, _ = q_in.shape
    f32 = jnp.float32
    heads = lambda t, d: t.reshape(b, s, -1, d)
    q = heads(jax.nn.silu(q_in.astype(f32)), HA_DK)
    v = heads(i_in.astype(f32), HA_DV)

    def forget(f, lb):
        fg = lb + (1.0 - lb) * jax.nn.sigmoid(f.astype(f32))
        return heads(1.0 - fg, HA_DK), heads(jnp.log(fg), HA_DK)

    k_f, lf_f = forget(f_fwd, lb_fwd)
    k_b, lf_b = forget(f_bwd, lb_bwd)
    qc = _to_chunks(_bidir_stack(q, q))
    kc = _to_chunks(_bidir_stack(k_f, k_b))
    vc = _to_chunks(_bidir_stack(v, v))
    bc = jnp.cumsum(_to_chunks(_bidir_stack(lf_f, lf_b)), axis=3)
    mask = jnp.tril(jnp.ones((CHUNK, CHUNK), dtype=bool))[:, :, None]

    def step(state, inp):
        qt, kt, vt, bt = inp
        o_inter = jnp.einsum('bgtk,bgkv->bgtv', qt * jnp.exp(bt), state)
        diff = bt[:, :, :, None, :] - bt[:, :, None, :, :]
        dec = jnp.exp(jnp.where(mask, diff, -jnp.inf))
        att = jnp.einsum('bgtk,bgtsk,bgsk->bgts', qt, dec, kt)
        o = o_inter + jnp.einsum('bgts,bgsv->bgtv', att, vt)
        blast = bt[:, :, -1]
        state = state * jnp.exp(blast)[..., None] + jnp.einsum(
            'bgsk,bgsv->bgkv', kt * jnp.exp(blast[:, :, None, :] - bt), vt)
        return state, o

    state0 = jnp.zeros((b, 2 * HA_HEADS, HA_DK, HA_DV), f32)
    _, o = lax.scan(step, state0, (qc, kc, vc, bc))
    o = _bidir_merge(_from_chunks(o), HA_HEADS)
    o = rms_norm(o, norm_w) * jax.nn.silu(heads(og.astype(f32), HA_DV))
    return o.reshape(b, s, HA_VW).astype(q_in.dtype)


def gated_deltanet_mixer(q_in, k_in, v_in, z, a, beta_in, conv_w, a_log, dt_bias, norm_w):
    b, s, _ = q_in.shape
    f32 = jnp.float32
    qkv = jnp.concatenate([q_in, k_in, v_in], axis=-1)
    qkv = lax.conv_general_dilated(
        qkv, conv_w[:, None, :].astype(qkv.dtype), window_strides=(1,),
        padding=((GB_CONV // 2, GB_CONV // 2),), dimension_numbers=('NWC', 'WIO', 'NWC'),
        feature_group_count=GB_CONV_CH)
    qkv = jax.nn.silu(qkv.astype(f32))
    q, k, v = jnp.split(qkv, [GB_KW, 2 * GB_KW], axis=-1)
    q = l2_norm(q.reshape(b, s, GB_HEADS, GB_DK)) * (GB_DK ** -0.5)
    k = l2_norm(k.reshape(b, s, GB_HEADS, GB_DK))
    v = v.reshape(b, s, GB_HEADS, GB_DV)
    a = a.astype(f32).reshape(b, s, 2, GB_HEADS)
    g = -jnp.exp(a_log.astype(f32)) * jax.nn.softplus(a + dt_bias.astype(f32))
    beta = jax.nn.sigmoid(beta_in.astype(f32).reshape(b, s, 2, GB_HEADS))
    gs = _bidir_stack(g[:, :, 0, :, None], g[:, :, 1, :, None])
    bs = _bidir_stack(beta[:, :, 0, :, None], beta[:, :, 1, :, None])
    qc = _to_chunks(_bidir_stack(q, q))
    kc = _to_chunks(_bidir_stack(k, k))
    vc = _to_chunks(_bidir_stack(v, v))
    decay = jnp.cumsum(_to_chunks(gs)[..., 0], axis=-1)
    betac = _to_chunks(bs)

    incl = jnp.tril(jnp.ones((CHUNK, CHUNK), dtype=bool))
    strict = jnp.tril(jnp.ones((CHUNK, CHUNK), dtype=bool), k=-1)
    diff = decay[..., :, None] - decay[..., None, :]
    lmask = jnp.exp(jnp.where(incl, diff, -jnp.inf))
    kbeta = kc * betac
    akk = jnp.where(strict, jnp.einsum('nbgtk,nbgsk->nbgts', kbeta, kc) * lmask, 0.0)
    eye = jnp.eye(CHUNK, dtype=f32)
    tmat = lax.linalg.triangular_solve(eye + akk, jnp.broadcast_to(eye, akk.shape),
                                       left_side=True, lower=True, unit_diagonal=True)
    u = jnp.einsum('nbgts,nbgsv->nbgtv', tmat, vc * betac)
    w = jnp.einsum('nbgts,nbgsk->nbgtk', tmat, kbeta * jnp.exp(decay)[..., None])
    aqk = jnp.einsum('nbgtk,nbgsk->nbgts', qc, kc) * lmask
    qd = qc * jnp.exp(decay)[..., None]
    kd = kc * jnp.exp(decay[..., -1:] - decay)[..., None]
    glast = jnp.exp(decay[..., -1])

    def step(state, inp):
        qdt, aqkt, ut, wt, kdt, glt = inp
        v_new = ut - jnp.einsum('bgtk,bgkv->bgtv', wt, state)
        o = jnp.einsum('bgtk,bgkv->bgtv', qdt, state) + jnp.einsum('bgts,bgsv->bgtv', aqkt, v_new)
        state = state * glt[..., None, None] + jnp.einsum('bgsk,bgsv->bgkv', kdt, v_new)
        return state, o

    state0 = jnp.zeros((b, 2 * GB_HEADS, GB_DK, GB_DV), f32)
    _, o = lax.scan(step, state0, (qd, aqk, u, w, kd, glast))
    o = _bidir_merge(_from_chunks(o), GB_HEADS)
    o = rms_norm(o, norm_w) * jax.nn.silu(z.astype(f32).reshape(b, s, GB_HEADS, GB_DV))
    return o.reshape(b, s, GB_VW).astype(q_in.dtype)


def peer_ffn(x, w_q, sub_k1, sub_k2, u_tab, v_tab):
    b, s, d = x.shape
    t = b * s
    xt = x.reshape(t, d)
    q = (xt @ w_q).reshape(t, PEER_HEADS, PEER_DQ)
    q1, q2 = jnp.split(q, 2, axis=-1)
    s1 = jnp.einsum('thd,nd->thn', q1, sub_k1).astype(jnp.float32)
    s2 = jnp.einsum('thd,nd->thn', q2, sub_k2).astype(jnp.float32)
    v1, i1 = lax.top_k(s1, PEER_TOPK)
    v2, i2 = lax.top_k(s2, PEER_TOPK)
    cand = (v1[..., :, None] + v2[..., None, :]).reshape(t, PEER_HEADS, PEER_TOPK * PEER_TOPK)
    cand_id = (i1[..., :, None] * PEER_NKEYS + i2[..., None, :]).reshape(t, PEER_HEADS, PEER_TOPK * PEER_TOPK)
    top_s, top_pos = lax.top_k(cand, PEER_TOPK)
    eid = jnp.take_along_axis(cand_id, top_pos, axis=-1)
    gate = jax.nn.softmax(top_s, axis=-1).astype(x.dtype)
    nb = t // PEER_TOKEN_BLOCK
    hk = PEER_HEADS * PEER_TOPK
    xb = xt.reshape(nb, PEER_TOKEN_BLOCK, d)
    eb = eid.reshape(nb, PEER_TOKEN_BLOCK, hk)
    gb = gate.reshape(nb, PEER_TOKEN_BLOCK, hk)

    def block(args):
        xk, ek, gk = args
        ue = jnp.take(u_tab, ek, axis=0)
        act = jax.nn.gelu(jnp.einsum('tkd,td->tk', ue, xk), approximate=False) * gk
        ve = jnp.take(v_tab, ek, axis=0)
        return jnp.einsum('tk,tkd->td', act, ve)

    y = lax.map(block, (xb, eb, gb))
    return y.reshape(b, s, d)


def setup_inputs(seed: int = 0) -> dict:
    key = jax.random.key(seed)
    ks = jax.random.split(key, 20)
    f32 = jnp.float32
    nrm = lambda k, shp, sc: jax.random.normal(k, shp, f32) * sc
    gain = lambda k, shp: 1.0 + 0.01 * jax.random.normal(k, shp, f32)
    dt = jnp.exp(jax.random.uniform(ks[6], (DEPTH, 2, GB_HEADS), f32) * (np.log(0.1) - np.log(0.001)) + np.log(0.001))
    return {
        "x": nrm(ks[0], (BATCH, SEQ, D_MODEL), 1.0),
        "norm1_w": gain(ks[1], (DEPTH, D_MODEL)),
        "w_in": nrm(ks[2], (DEPTH, D_MODEL, IN_WIDTH), D_MODEL ** -0.5),
        "lb_logits": nrm(ks[3], (2, DEPTH + 1, HA_KW), 0.1),
        "hgrn_norm_w": gain(ks[4], (DEPTH, HA_DV)),
        "conv_w": nrm(ks[5], (DEPTH, GB_CONV, GB_CONV_CH), GB_CONV ** -0.5),
        "a_log": jnp.log(jax.random.uniform(ks[7], (DEPTH, 2, GB_HEADS), f32, 1.0, 16.0)),
        "dt_bias": dt + jnp.log(-jnp.expm1(-dt)),
        "gdn_norm_w": gain(ks[8], (DEPTH, GB_DV)),
        "w_proj_a": nrm(ks[9], (DEPTH, HA_VW, D_MODEL), HA_VW ** -0.5),
        "w_proj_b": nrm(ks[10], (DEPTH, GB_VW, D_MODEL), GB_VW ** -0.5),
        "w_out": nrm(ks[11], (DEPTH, D_MODEL, D_MODEL), D_MODEL ** -0.5),
        "norm2_w": gain(ks[12], (DEPTH, D_MODEL)),
        "peer_w_q": nrm(ks[13], (DEPTH, D_MODEL, PEER_HEADS * PEER_DQ), D_MODEL ** -0.5),
        "peer_sub_k1": nrm(ks[14], (DEPTH, PEER_NKEYS, PEER_DQ // 2), (PEER_DQ // 2) ** -0.5),
        "peer_sub_k2": nrm(ks[15], (DEPTH, PEER_NKEYS, PEER_DQ // 2), (PEER_DQ // 2) ** -0.5),
        "peer_u": nrm(ks[16], (DEPTH, PEER_EXPERTS, D_MODEL), D_MODEL ** -0.5),
        "peer_v": nrm(ks[17], (DEPTH, PEER_EXPERTS, D_MODEL), PEER_HEADS ** -0.5),
        "final_norm_w": gain(ks[18], (D_MODEL,)),
    }


def reference(x, norm1_w, w_in, lb_logits, hgrn_norm_w, conv_w, a_log, dt_bias, gdn_norm_w,
              w_proj_a, w_proj_b, w_out, norm2_w, peer_w_q, peer_sub_k1, peer_sub_k2,
              peer_u, peer_v, final_norm_w):
    lb_all = jnp.cumsum(jax.nn.softmax(lb_logits.astype(jnp.float32), axis=1), axis=1)
    split_idx = np.cumsum(IN_SPLITS)[:-1].tolist()
    for l in range(DEPTH):
        xn = rms_norm(x, norm1_w[l])
        proj = xn @ w_in[l]
        (a_q, a_ff, a_fb, a_i, a_og, b_q, b_k, b_v, b_z, b_a, b_b,
         gate_a, gate_b) = jnp.split(proj, split_idx, axis=-1)
        ya = hgrn2_mixer(a_q, a_ff, a_fb, a_i, a_og, lb_all[0, l], lb_all[1, l], hgrn_norm_w[l])
        yb = gated_deltanet_mixer(b_q, b_k, b_v, b_z, b_a, b_b, conv_w[l], a_log[l], dt_bias[l], gdn_norm_w[l])
        merged = jax.nn.sigmoid(gate_a) * (ya @ w_proj_a[l]) + jax.nn.sigmoid(gate_b) * (yb @ w_proj_b[l])
        x = x + merged @ w_out[l]
        x = x + peer_ffn(rms_norm(x, norm2_w[l]), peer_w_q[l], peer_sub_k1[l], peer_sub_k2[l],
                         peer_u[l], peer_v[l])
    return rms_norm(x, final_norm_w)
```

```cpp
#include <hip/hip_runtime.h>
#include <cstdio>
#include <cstdint>
#define GAS __attribute__((address_space(1)))
#define LAS __attribute__((address_space(3)))
#define MK_N_LAUNCHES 1
namespace pg8 {
#define PG8_LAS __attribute__((address_space(3)))
typedef unsigned short bf16_t;
typedef short bf16x8 __attribute__((ext_vector_type(8)));
typedef float f32x4 __attribute__((ext_vector_type(4)));
typedef unsigned u32x4 __attribute__((ext_vector_type(4)));
constexpr int BM = 256, BK = 64, HALF = 128, HTB = HALF * BK * 2  , STAGE_BYTES = 8 * HTB, NXCD = 8, WGM = 8;

__host__ __device__ __forceinline__ int lds_byte(int r, int c) { const int st = (r >> 4) * 2 + (c >> 5), rr = r & 15, cc = c & 31, ob = rr * 64 + cc * 2; return st * 1024 + (ob ^ (((ob >> 9) & 1) << 5)); }
__host__ __device__ __forceinline__ void stage_rc(int b, int& R, int& C) { const int st = b / 1024, sb = b % 1024, swz = sb ^ (((sb >> 9) & 1) << 5); R = (st >> 1) * 16 + swz / 64; C = (st & 1) * 32 + (swz % 64) / 2; }
__host__ __device__ __forceinline__ int perm32(int rho) { const int n = rho >> 4, i = rho & 15; return 8 * (i >> 2) + 4 * n + (i & 3); }

struct Unit { int pm, pn; };
struct Gemm { const bf16_t* A; const bf16_t* Bt; int M, N, K; };

struct StaticOrder {
    int nM, nN, nwg, G, c;
    __host__ __device__ void init(int M, int N, int G_, int c_) { nM = M / BM; nN = N / BM; nwg = nM * nN; G = G_; c = c_; }
    __host__ __device__ bool next(int i, Unit& u) const {
        const long L = (long)i * G + c; if (L >= nwg) return false;
        int wgid = (int)L; { const int q = nwg / NXCD, r = nwg % NXCD, xcd = wgid % NXCD, off = wgid / NXCD; wgid = (xcd < r ? xcd * (q + 1) : r * (q + 1) + (xcd - r) * q) + off; }
        const int nig = WGM * nN, gid = wgid / nig, fm = gid * WGM, gsz = (nM - fm) < WGM ? (nM - fm) : WGM;
        u.pm = fm + ((wgid % nig) % gsz); u.pn = (wgid % nig) / gsz; return true;
    }
    __device__ __forceinline__ void a_ready(const Unit&) const {}
    __device__ __forceinline__ void done(const Unit&) const {}
};

__device__ __forceinline__ unsigned cvt_pk_bf16(float lo, float hi) { unsigned r; asm volatile("v_cvt_pk_bf16_f32 %0, %1, %2" : "=v"(r) : "v"(lo), "v"(hi)); return r; }
typedef float f32x2 __attribute__((ext_vector_type(2)));
__device__ __forceinline__ f32x2 gelu_pk(f32x2 v) {
    const f32x2 av = __builtin_elementwise_abs(v), d = av * 0.2316418882f + 1.0f;
    f32x2 t; t.x = __builtin_amdgcn_rcpf(d.x); t.y = __builtin_amdgcn_rcpf(d.y);
    f32x2 q = t * 0.5307027145f + (-0.7265760135f); q = q * t + 0.7107068705f; q = q * t + (-0.142248368f); q = q * t + 0.127414796f; q = q * t;
    const f32x2 s = (v * v) * (-0.72134752044f);
    f32x2 e; e.x = __builtin_amdgcn_exp2f(s.x); e.y = __builtin_amdgcn_exp2f(s.y);
    const f32x2 m = v * (q * e), r = v - m;
    f32x2 o; o.x = v.x < 0.f ? m.x : r.x; o.y = v.y < 0.f ? m.y : r.y; return o;
}

template <class Epi, class Sched, bool ALIGN_EPI = false, bool SP2 = false>
__device__ __forceinline__ void gemm_phase(PG8_LAS unsigned char* lds, const Gemm g, const Sched& S, const Epi& E) {
    const int tid = threadIdx.x, wid = __builtin_amdgcn_readfirstlane(tid >> 6), lane = tid & 63, wr = wid >> 2, wc = wid & 3, fr = lane & 15, fq = lane >> 4;
    const int K = g.K, nt = K / BK;
    unsigned voffA[2], voffB[2];
#pragma unroll
    for (int i = 0; i < 2; ++i) { int R, C; stage_rc(tid * 16 + i * 8192, R, C); const int Rb = Epi::PERM ? ((R & ~31) + perm32(R & 31)) : R;
        voffA[i] = (unsigned)(R * K + C) * 2u; voffB[i] = (unsigned)(Rb * K + C) * 2u; }
    const size_t kstep = (size_t)(BK * 2);
    const size_t hstep = (size_t)HALF * K * 2;
    const size_t tstep = 2 * hstep;
    const unsigned ldsw = (unsigned)wid * 1024u;
    const int aoff = lds_byte(wr * 64 + fr, fq * 8), boff = lds_byte(wc * 32 + fr, fq * 8);
#define PG8_SA(b, h) (((b) * 2 + (h)) * HTB)
#define PG8_SB(b, h) ((4 + (b) * 2 + (h)) * HTB)
#define PG8_STAGE(bufoff, gbase, voff) do { _Pragma("unroll") for (int _i = 0; _i < 2; ++_i) \
        __builtin_amdgcn_global_load_lds((const unsigned*)((const char*)(gbase) + (voff)[_i]), (PG8_LAS unsigned*)(lds + (bufoff) + ldsw + _i * 8192), 16, 0, 0); } while (0)
#define PG8_LDA(dst, b, h) do { _Pragma("unroll") for (int m = 0; m < 4; ++m) _Pragma("unroll") for (int k = 0; k < 2; ++k) dst[m][k] = *(const PG8_LAS bf16x8*)(lds + PG8_SA(b, h) + aoff + m * 2048 + k * 1024); } while (0)
#define PG8_LDB(dst, b, h) do { _Pragma("unroll") for (int n = 0; n < 2; ++n) _Pragma("unroll") for (int k = 0; k < 2; ++k) dst[n][k] = *(const PG8_LAS bf16x8*)(lds + PG8_SB(b, h) + boff + n * 2048 + k * 1024); } while (0)
#define PG8_MMA(ai, bj, At, Bt) do { __builtin_amdgcn_s_setprio(1); _Pragma("unroll") for (int m = 0; m < 4; ++m) _Pragma("unroll") for (int n = 0; n < 2; ++n) _Pragma("unroll") for (int k = 0; k < 2; ++k) \
        acc[ai][bj][m][n] = __builtin_amdgcn_mfma_f32_16x16x32_bf16(Bt[n][k], At[m][k], acc[ai][bj][m][n], 0, 0, 0); __builtin_amdgcn_s_setprio(0); } while (0)
#define PG8_WAIT_V(n) asm volatile("s_waitcnt vmcnt(" #n ")" ::: "memory")
#define PG8_WAIT_L(n) asm volatile("s_waitcnt lgkmcnt(" #n ")" ::: "memory")
#define PG8_BAR __builtin_amdgcn_s_barrier()
#define PG8_SCHED __builtin_amdgcn_sched_barrier(0)
    Unit cur, nxt; int ui = 0;
    if (!S.next(0, cur)) return;
    f32x4 acc[2][2][4][2];
#pragma unroll
    for (int a = 0; a < 2; ++a)
#pragma unroll
        for (int b = 0; b < 2; ++b)
#pragma unroll
            for (int m = 0; m < 4; ++m)
#pragma unroll
                for (int n = 0; n < 2; ++n) acc[a][b][m][n] = (f32x4){0.f, 0.f, 0.f, 0.f};
    bf16x8 At[4][2], B0[2][2], B1[2][2];
    const char* cA = (const char*)g.A + (size_t)cur.pm * tstep; const char* cB = (const char*)g.Bt + (size_t)cur.pn * tstep;
    S.a_ready(cur);
    if constexpr (SP2) {
        PG8_STAGE(PG8_SB(0, 0), cB, voffB); PG8_STAGE(PG8_SB(0, 1), cB + hstep, voffB); PG8_STAGE(PG8_SA(0, 0), cA, voffA); PG8_STAGE(PG8_SA(0, 1), cA + hstep, voffA);
        if (wr == 1) PG8_BAR;
        PG8_WAIT_V(2); PG8_BAR;
        PG8_STAGE(PG8_SB(1, 0), cB + kstep, voffB); PG8_STAGE(PG8_SA(1, 0), cA + kstep, voffA); PG8_STAGE(PG8_SB(1, 1), cB + hstep + kstep, voffB);
        PG8_WAIT_V(6); PG8_BAR;
    } else {
        PG8_STAGE(PG8_SB(0, 0), cB, voffB); PG8_STAGE(PG8_SA(0, 0), cA, voffA); PG8_STAGE(PG8_SB(0, 1), cB + hstep, voffB); PG8_STAGE(PG8_SA(0, 1), cA + hstep, voffA);
        if (wr == 1) PG8_BAR;
        PG8_WAIT_V(4); PG8_BAR;
        PG8_STAGE(PG8_SB(1, 0), cB + kstep, voffB); PG8_STAGE(PG8_SA(1, 0), cA + kstep, voffA); PG8_STAGE(PG8_SB(1, 1), cB + hstep + kstep, voffB);
        PG8_WAIT_V(6); PG8_BAR;
    }
    for (;;) {
        const bool has_next = S.next(ui + 1, nxt);
        const char* nA = has_next ? (const char*)g.A + (size_t)nxt.pm * tstep : cA; const char* nB = has_next ? (const char*)g.Bt + (size_t)nxt.pn * tstep : cB;
        for (int t = 0; t < nt; t += 2) {
            const bool last = (t == nt - 2);
            const char* a1 = cA + (size_t)(t + 1) * kstep;
            const char* a2 = last ? nA : cA + (size_t)(t + 2) * kstep; const char* b2 = last ? nB : cB + (size_t)(t + 2) * kstep;
            const char* a3 = a2 + kstep; const char* b3 = b2 + kstep;
            if (last && has_next) S.a_ready(nxt);
            if constexpr (SP2) {
            PG8_LDB(B0, 0, 0); PG8_LDB(B1, 0, 1); PG8_SCHED; PG8_LDA(At, 0, 0); PG8_STAGE(PG8_SA(1, 1), a1 + hstep, voffA);
            PG8_WAIT_V(8); PG8_WAIT_L(0); PG8_BAR; PG8_MMA(0, 0, At, B0); PG8_MMA(0, 1, At, B1); PG8_BAR; PG8_SCHED;
            PG8_LDA(At, 0, 1); PG8_STAGE(PG8_SB(0, 0), b2, voffB); PG8_STAGE(PG8_SB(0, 1), b2 + hstep, voffB); PG8_STAGE(PG8_SA(0, 0), a2, voffA);
            PG8_WAIT_V(8); PG8_WAIT_L(0); PG8_BAR; PG8_MMA(1, 0, At, B0); PG8_MMA(1, 1, At, B1); PG8_BAR; PG8_SCHED;
            PG8_LDB(B0, 1, 0); PG8_LDB(B1, 1, 1); PG8_SCHED; PG8_LDA(At, 1, 0); PG8_STAGE(PG8_SA(0, 1), a2 + hstep, voffA);
            PG8_WAIT_V(8); PG8_WAIT_L(0); PG8_BAR; PG8_MMA(0, 0, At, B0); PG8_MMA(0, 1, At, B1); PG8_BAR; PG8_SCHED;
            PG8_LDA(At, 1, 1); PG8_STAGE(PG8_SB(1, 0), b3, voffB); PG8_STAGE(PG8_SB(1, 1), b3 + hstep, voffB); PG8_STAGE(PG8_SA(1, 0), a3, voffA);
            PG8_WAIT_V(8); PG8_WAIT_L(0); PG8_BAR; PG8_MMA(1, 0, At, B0); PG8_MMA(1, 1, At, B1); PG8_BAR; PG8_SCHED;
            } else {
            PG8_LDB(B0, 0, 0); PG8_SCHED; PG8_LDA(At, 0, 0); PG8_STAGE(PG8_SA(1, 1), a1 + hstep, voffA);
            PG8_WAIT_L(8); PG8_BAR; PG8_WAIT_L(0); PG8_MMA(0, 0, At, B0); PG8_BAR; PG8_SCHED;
            PG8_LDB(B1, 0, 1); PG8_STAGE(PG8_SB(0, 0), b2, voffB);
            PG8_BAR; PG8_WAIT_L(0); PG8_MMA(0, 1, At, B1); PG8_BAR;
            PG8_LDA(At, 0, 1); PG8_STAGE(PG8_SA(0, 0), a2, voffA);
            PG8_BAR; PG8_WAIT_L(0); PG8_MMA(1, 0, At, B0); PG8_BAR; PG8_SCHED;
            PG8_STAGE(PG8_SB(0, 1), b2 + hstep, voffB);
            PG8_WAIT_V(6); PG8_BAR; PG8_MMA(1, 1, At, B1); PG8_BAR;
            PG8_LDB(B0, 1, 0); PG8_SCHED; PG8_LDA(At, 1, 0); PG8_STAGE(PG8_SA(0, 1), a2 + hstep, voffA);
            PG8_WAIT_L(8); PG8_BAR; PG8_WAIT_L(0); PG8_MMA(0, 0, At, B0); PG8_BAR; PG8_SCHED;
            PG8_LDB(B1, 1, 1); PG8_STAGE(PG8_SB(1, 0), b3, voffB);
            PG8_BAR; PG8_WAIT_L(0); PG8_MMA(0, 1, At, B1); PG8_BAR;
            PG8_LDA(At, 1, 1); PG8_STAGE(PG8_SA(1, 0), a3, voffA);
            PG8_BAR; PG8_WAIT_L(0); PG8_MMA(1, 0, At, B0); PG8_BAR; PG8_SCHED;
            PG8_STAGE(PG8_SB(1, 1), b3 + hstep, voffB);
            PG8_WAIT_V(6); PG8_BAR; PG8_MMA(1, 1, At, B1); PG8_BAR;
            }
        }
        if constexpr (ALIGN_EPI) { if (wr == 0) PG8_BAR; }
        if constexpr (!Epi::AFTER_DRAIN) { E(acc, cur, wr, wc, fr, fq); S.done(cur); }
        if (!has_next) break;
#pragma unroll
        for (int a = 0; a < 2; ++a)
#pragma unroll
            for (int b = 0; b < 2; ++b)
#pragma unroll
                for (int m = 0; m < 4; ++m)
#pragma unroll
                    for (int n = 0; n < 2; ++n) acc[a][b][m][n] = (f32x4){0.f, 0.f, 0.f, 0.f};
        cur = nxt; cA = nA; cB = nB; ++ui;
        if constexpr (ALIGN_EPI) { if (wr == 1) PG8_BAR; }
    }
    PG8_WAIT_V(0);
    if constexpr (!ALIGN_EPI) { if (wr == 0) PG8_BAR; }
    PG8_BAR;
    if constexpr (Epi::AFTER_DRAIN) { E.fused(acc, cur, wr, wc, fr, fq, lds, wid, lane); S.done(cur); }
#undef PG8_SA
#undef PG8_SB
#undef PG8_STAGE
#undef PG8_LDA
#undef PG8_LDB
#undef PG8_MMA
#undef PG8_WAIT_V
#undef PG8_WAIT_L
#undef PG8_BAR
#undef PG8_SCHED
}
}
typedef unsigned short bf16;
typedef unsigned v4u __attribute__((ext_vector_type(4)));
typedef unsigned v2u __attribute__((ext_vector_type(2)));
typedef float f32x4 __attribute__((ext_vector_type(4)));
typedef float f32x2 __attribute__((ext_vector_type(2)));
typedef short bf16x8 __attribute__((ext_vector_type(8)));
typedef GAS unsigned gu32;
#define RLX_AGENT __ATOMIC_RELAXED, __HIP_MEMORY_SCOPE_AGENT
#define LDS_WAIT() asm volatile("s_waitcnt lgkmcnt(0)" ::: "memory")
#define VM_WAIT() asm volatile("s_waitcnt vmcnt(0)" ::: "memory")
typedef __bf16 bf16x2_hw __attribute__((ext_vector_type(2)));
__device__ __forceinline__ unsigned pk2(float lo, float hi) { const f32x2 v = {lo, hi}; const bf16x2_hw b = __builtin_convertvector(v, bf16x2_hw); return __builtin_bit_cast(unsigned, b); }
__device__ __forceinline__ unsigned f2bf(float f) { return pk2(f, 0.f) & 0xffffu; }
__device__ __forceinline__ float bflo(unsigned w) { return __builtin_bit_cast(float, w << 16); }
__device__ __forceinline__ float bfhi(unsigned w) { return __builtin_bit_cast(float, w & 0xffff0000u); }
__device__ __forceinline__ float bf1(bf16 b) { return __builtin_bit_cast(float, ((unsigned)b) << 16); }
__device__ __forceinline__ float fast_exp(float x) { return __builtin_amdgcn_exp2f(x * 1.4426950408889634f); }
__device__ __forceinline__ float fast_rcp(float x) { return __builtin_amdgcn_rcpf(x); }
__device__ __forceinline__ float sigmoidf_(float x) { return fast_rcp(1.0f + fast_exp(-x)); }
__device__ __forceinline__ float siluf_(float x) { return x * sigmoidf_(x); }
template <int CTRL> __device__ __forceinline__ float dppf(float v) { return __builtin_bit_cast(float, __builtin_amdgcn_mov_dpp(__builtin_bit_cast(int, v), CTRL, 0xF, 0xF, true)); }
template <int CTRL> __device__ __forceinline__ int dppi(int v) { return __builtin_amdgcn_mov_dpp(v, CTRL, 0xF, 0xF, true); }
__device__ __forceinline__ float rdl(float v, int l) { return __builtin_bit_cast(float, __builtin_amdgcn_readlane(__builtin_bit_cast(int, v), l)); }
__device__ __forceinline__ float wave_sum(float v) {
    v += dppf<0xB1>(v); v += dppf<0x4E>(v); v += dppf<0x141>(v); v += dppf<0x140>(v);
    return (rdl(v, 0) + rdl(v, 16)) + (rdl(v, 32) + rdl(v, 48));
}
__device__ __forceinline__ float wave_max(float v) {
    v = fmaxf(v, dppf<0xB1>(v)); v = fmaxf(v, dppf<0x4E>(v)); v = fmaxf(v, dppf<0x141>(v)); v = fmaxf(v, dppf<0x140>(v));
    return fmaxf(fmaxf(rdl(v, 0), rdl(v, 16)), fmaxf(rdl(v, 32), rdl(v, 48)));
}
__device__ __forceinline__ int wave_sum_i(int v) {
    v += dppi<0xB1>(v); v += dppi<0x4E>(v); v += dppi<0x141>(v); v += dppi<0x140>(v);
    return (__builtin_amdgcn_readlane(v, 0) + __builtin_amdgcn_readlane(v, 16)) + (__builtin_amdgcn_readlane(v, 32) + __builtin_amdgcn_readlane(v, 48));
}

constexpr int NWAVES = 8, NTHR = 512;
constexpr int SEQ = 16384, DM = 2048, NH = 8, HD = 128, HW = 1024;
constexpr int CK = 64, NCHUNK = SEQ / CK, NSEG = 16, CPS = NCHUNK / NSEG;
constexpr int INW = 13344;
constexpr int N1 = 9216;
constexpr float EPS = 1e-6f;
constexpr int PEER_K = 16;

constexpr size_t MiB = (size_t)1 << 20;
constexpr size_t WS_CTL = 0, CTL_ZERO_BYTES = 1 * MiB;
constexpr size_t WS_WG = 2 * MiB, WS_WPA = 18 * MiB, WS_WPB = 22 * MiB, WS_WOUT = 26 * MiB, WS_WS = 34 * MiB, WS_W1 = 42 * MiB;
constexpr size_t WS_XN = 80 * MiB;
constexpr size_t WS_H = 144 * MiB;
constexpr size_t WS_GAB = 432 * MiB;
constexpr size_t WS_HL = 434 * MiB;
constexpr size_t WS_HDS = 450 * MiB;
constexpr size_t WS_OHF = 452 * MiB, WS_OHB = 484 * MiB;
constexpr size_t WS_GSC = 516 * MiB;
constexpr size_t WS_UTF = 144 * MiB, WS_UTB = 176 * MiB, WS_WF = 208 * MiB, WS_WB = 240 * MiB;
constexpr size_t DO_AQKF = 0, DO_AQKB = 16 * MiB, DO_QN = 32 * MiB, DO_KNT = 64 * MiB;
constexpr size_t WS_GL = 42 * MiB, WS_GP = 58 * MiB;
constexpr size_t WS_OGF = 304 * MiB, WS_OGB = 336 * MiB;
constexpr size_t WS_YA = 42 * MiB, WS_YB = 368 * MiB;
constexpr size_t WS_TU = 144 * MiB, WS_TV = 176 * MiB;
constexpr size_t WS_PSC = 520 * MiB;
constexpr size_t WS_GT = 272 * MiB, WS_GT2 = 400 * MiB;
constexpr size_t WS_X1B = 80 * MiB;
constexpr size_t WS_SC = 272 * MiB;
constexpr size_t WS_END = 536 * MiB;
constexpr int CW_BAR = 4096;

constexpr int LDS_BYTES = 163840;
constexpr int MISC_OFF = 163840 - 256;
constexpr int LDS_USABLE = MISC_OFF;

__device__ __forceinline__ bf16x8 ldfrag(const LAS bf16* T, int pitch, int row, int k) { return *(const LAS bf16x8*)(T + row * pitch + k); }
__device__ __forceinline__ f32x4 mfma16(bf16x8 x, bf16x8 y, f32x4 c) { return __builtin_amdgcn_mfma_f32_16x16x32_bf16(x, y, c, 0, 0, 0); }
__device__ __forceinline__ v2u pack4(f32x4 v) { v2u r; r.x = pk2(v[0], v[1]); r.y = pk2(v[2], v[3]); return r; }
#define XB_TMO      128
#define XB_XCNT(j)  (256  + 64 * (j))
#define XB_XSUB(j)  (1280 + 64 * (j))
#define XB_XGEN(j)  (2304 + 64 * (j))
#define XB_TOP      3328
#define XB_TOPGEN   3392
#define XCD_BAR_WORDS 3456
#define XB_SPIN_CAP (1u << 18)

__device__ __forceinline__ unsigned xb_ld(unsigned* p)              { return __hip_atomic_load(p, __ATOMIC_RELAXED, __HIP_MEMORY_SCOPE_AGENT); }
__device__ __forceinline__ unsigned xb_add(unsigned* p, unsigned v) { return __hip_atomic_fetch_add(p, v, __ATOMIC_RELAXED, __HIP_MEMORY_SCOPE_AGENT); }
__device__ __forceinline__ unsigned xb_xcc_id() { return (unsigned)__builtin_amdgcn_s_getreg((3 << 11) | 20) & 0xFu; }
#define XB_SPIN(cond, bar) do { unsigned _sp = 0; while (cond) { __builtin_amdgcn_s_sleep(1); \
    if ((++_sp & 255u) == 0u) { if (xb_ld(&(bar)[XB_TMO])) break; if (_sp > XB_SPIN_CAP) { atomicAdd(&(bar)[XB_TMO], 1u); break; } } } } while (0)

struct XcdBarrier {
    unsigned* bar; unsigned x;
    volatile LAS unsigned* st;
};

__device__ __forceinline__ XcdBarrier xcd_barrier_post(unsigned* bar, volatile LAS unsigned* st) {
    XcdBarrier b; b.bar = bar; b.x = xb_xcc_id(); b.st = st;
    if (threadIdx.x == 0) (void)xb_add(&bar[XB_XCNT(b.x)], 1u);
    return b;
}
__device__ __forceinline__ void xcd_barrier_complete(unsigned* bar, unsigned x, unsigned& nloc, unsigned& nx) {
    const unsigned G = gridDim.x * gridDim.y * gridDim.z;
    unsigned sum, cnt, mine, sp = 0u;
    for (;;) {
        sum = 0u; cnt = 0u; mine = 0u;
#pragma unroll
        for (unsigned j = 0; j < 16; ++j) { const unsigned c = xb_ld(&bar[XB_XCNT(j)]); sum += c; cnt += (c > 0u) ? 1u : 0u; mine = (j == x) ? c : mine; }
        if (sum == G) break;
        __builtin_amdgcn_s_sleep(1);
        if ((++sp & 255u) == 0u) { if (xb_ld(&bar[XB_TMO])) break; if (sp > XB_SPIN_CAP) { atomicAdd(&bar[XB_TMO], 1u); break; } }
    }
    nloc = mine > 0u ? mine : 1u; nx = cnt > 0u ? cnt : 1u;
}

__device__ __forceinline__ void xcd_barrier(const XcdBarrier& b) {
    asm volatile("s_waitcnt vmcnt(0)" ::: "memory");
    __syncthreads();
    if (threadIdx.x == 0) {
        unsigned* bar = b.bar;
        __builtin_amdgcn_s_waitcnt(0);
        unsigned nloc = b.st[0], nx = b.st[1];
        if (nloc == 0u) { xcd_barrier_complete(bar, b.x, nloc, nx); b.st[0] = nloc; b.st[1] = nx; }
        const unsigned old = xb_add(&bar[XB_XSUB(b.x)], 1u);
        const unsigned gen = old / nloc;
        if (old + 1u == (gen + 1u) * nloc) {
            __builtin_amdgcn_fence(__ATOMIC_RELEASE, "agent");
            asm volatile("s_waitcnt vmcnt(0)" ::: "memory");
            const unsigned og = xb_add(&bar[XB_TOP], 1u);
            const unsigned tg = og / nx;
            if (og + 1u == (tg + 1u) * nx) xb_add(&bar[XB_TOPGEN], 1u);
            else XB_SPIN(xb_ld(&bar[XB_TOPGEN]) == tg, bar);
            __builtin_amdgcn_fence(__ATOMIC_ACQUIRE, "agent");
            xb_add(&bar[XB_XGEN(b.x)], 1u);
            asm volatile("s_waitcnt vmcnt(0)" ::: "memory");
        } else {
            XB_SPIN(xb_ld(&bar[XB_XGEN(b.x)]) == gen, bar);
            __builtin_amdgcn_fence(__ATOMIC_ACQUIRE, "agent");
            asm volatile("s_waitcnt vmcnt(0)" ::: "memory");
        }
    }
    __syncthreads();
}

struct Frame {
    LAS unsigned char* lds;
    volatile LAS unsigned* MISC;
    gu32* ctl;
    int tid, lane, wave, vcu, G;
    const float* in[19]; float* out; unsigned char* ws;
};
enum { I_X = 0, I_N1W, I_WIN, I_LB, I_HNW, I_CONVW, I_ALOG, I_DTB, I_GNW, I_WPA, I_WPB, I_WOUT, I_N2W, I_WQ, I_K1, I_K2, I_PU, I_PV, I_FNW };

__device__ __forceinline__ void p0_transpose_item(const float* W, int ldw, int c0, int K, int ncols, bf16* WT, int row_off, LAS float* scr, int item, int lane) {
    const int nblk = ncols / 32, kb = item / nblk, nb = item % nblk, k0 = 64 * kb, n0 = 32 * nb;
#pragma unroll 8
    for (int i = 0; i < 32; ++i) { const int kk = 2 * i + (lane >> 5); scr[kk * 33 + (lane & 31)] = W[(size_t)(k0 + kk) * ldw + c0 + n0 + (lane & 31)]; }
    LDS_WAIT(); asm volatile("" ::: "memory");
    const int c = lane & 7;
#pragma unroll
    for (int j = 0; j < 4; ++j) { const int n = (lane >> 3) + 8 * j; const LAS float* s = scr + (8 * c) * 33 + n;
        v4u o; o.x = pk2(s[0 * 33], s[1 * 33]); o.y = pk2(s[2 * 33], s[3 * 33]); o.z = pk2(s[4 * 33], s[5 * 33]); o.w = pk2(s[6 * 33], s[7 * 33]);
        *(GAS v4u*)(WT + (size_t)(row_off + n0 + n) * K + k0 + 8 * c) = o; }
    LDS_WAIT(); asm volatile("" ::: "memory");
}
__device__ __forceinline__ void rms_row_to_bf16(int lane, const float* xrow, const float* w, bf16* orow) {
    const GAS f32x4* xr = (const GAS f32x4*)xrow + lane; const GAS f32x4* wr = (const GAS f32x4*)w + lane;
    f32x4 v[8]; float s = 0.f;
#pragma unroll
    for (int j = 0; j < 8; ++j) { v[j] = xr[64 * j]; s += (v[j].x * v[j].x + v[j].y * v[j].y) + (v[j].z * v[j].z + v[j].w * v[j].w); }
    const float r = 1.0f / sqrtf(wave_sum(s) * (1.f / DM) + EPS);
    GAS v2u* o8 = (GAS v2u*)orow + lane;
#pragma unroll
    for (int j = 0; j < 8; ++j) { const f32x4 ww = wr[64 * j]; v2u o; o.x = pk2(v[j].x * r * ww.x, v[j].y * r * ww.y); o.y = pk2(v[j].z * r * ww.z, v[j].w * r * ww.w); o8[64 * j] = o; }
}
__device__ __forceinline__ void p0_ws_item(Frame& F, int it) {
    const int h = it >> 6, half = (it >> 5) & 1, j0 = (it & 31) * 64, hc = h * 256 + half * 128;
    const float* Wq = F.in[I_WQ]; const float* Ks = half ? F.in[I_K2] : F.in[I_K1]; const float* n2 = F.in[I_N2W];
    LAS bf16* Xs = (LAS bf16*)F.lds; LAS bf16* Ys = Xs + 64 * 136;
    { const int row = F.tid >> 3, c0 = (F.tid & 7) * 16; const GAS f32x4* src = (const GAS f32x4*)(Wq + (size_t)(j0 + row) * DM + hc + c0);
      const f32x4 a = src[0], b = src[1], c = src[2], d = src[3];
      v4u o0, o1; o0.x = pk2(a.x, a.y); o0.y = pk2(a.z, a.w); o0.z = pk2(b.x, b.y); o0.w = pk2(b.z, b.w); o1.x = pk2(c.x, c.y); o1.y = pk2(c.z, c.w); o1.z = pk2(d.x, d.y); o1.w = pk2(d.z, d.w);
      *(LAS v4u*)(Xs + row * 136 + c0) = o0; *(LAS v4u*)(Xs + row * 136 + c0 + 8) = o1; }
    { const int row = F.tid >> 2, c0 = (F.tid & 3) * 32; const GAS f32x4* src = (const GAS f32x4*)(Ks + (size_t)row * 128 + c0);
#pragma unroll
      for (int q = 0; q < 4; ++q) { const f32x4 a = src[2 * q], b = src[2 * q + 1]; v4u o; o.x = pk2(a.x, a.y); o.y = pk2(a.z, a.w); o.z = pk2(b.x, b.y); o.w = pk2(b.z, b.w); *(LAS v4u*)(Ys + row * 136 + c0 + 8 * q) = o; } }
    __syncthreads();
    const int fr = F.lane & 15, fq = F.lane >> 4, w = F.wave;
    bf16* WSt = (bf16*)(F.ws + WS_WS);
#pragma unroll
    for (int jt = 0; jt < 4; ++jt) {
        f32x4 acc = {0.f, 0.f, 0.f, 0.f};
#pragma unroll
        for (int k0 = 0; k0 < 4; ++k0) acc = mfma16(ldfrag(Xs, 136, 16 * jt + fr, 32 * k0 + 8 * fq), ldfrag(Ys, 136, 16 * w + fr, 32 * k0 + 8 * fq), acc);
        const int jj = j0 + 16 * jt + 4 * fq; const f32x4 nw = *(const GAS f32x4*)(n2 + jj);
        *(GAS v2u*)(WSt + (size_t)(hc + 16 * w + fr) * DM + jj) = pack4(acc * nw);
    }
    __syncthreads();
}
__device__ __forceinline__ void p0_prologue(Frame& F) {
    LAS float* scr = (LAS float*)(F.lds + F.wave * 16384);
    const int gw = F.vcu * NWAVES + F.wave, NGW = F.G * NWAVES;
    constexpr int I_1 = (DM / 64) * (9248 / 32), I_G = (DM / 64) * (4096 / 32), I_PA = (HW / 64) * (DM / 32), I_O = (DM / 64) * (DM / 32);
    constexpr int NITEMS = I_1 + I_G + 2 * I_PA + I_O;
    bf16* W1t = (bf16*)(F.ws + WS_W1);
    for (int it = gw; it < NITEMS; it += NGW) {
        int r = it;
        if (r < I_1) { p0_transpose_item(F.in[I_WIN], INW, 0, DM, 9248, W1t, 0, scr, r, F.lane); continue; } r -= I_1;
        if (r < I_G) { p0_transpose_item(F.in[I_WIN], INW, 9248, DM, 4096, (bf16*)(F.ws + WS_WG), 0, scr, r, F.lane); continue; } r -= I_G;
        if (r < I_PA) { p0_transpose_item(F.in[I_WPA], DM, 0, HW, DM, (bf16*)(F.ws + WS_WPA), 0, scr, r, F.lane); continue; } r -= I_PA;
        if (r < I_PA) { p0_transpose_item(F.in[I_WPB], DM, 0, HW, DM, (bf16*)(F.ws + WS_WPB), 0, scr, r, F.lane); continue; } r -= I_PA;
        p0_transpose_item(F.in[I_WOUT], DM, 0, DM, DM, (bf16*)(F.ws + WS_WOUT), 0, scr, r, F.lane);
    }
    bf16* XN = (bf16*)(F.ws + WS_XN);
    for (int m = gw; m < SEQ; m += NGW) rms_row_to_bf16(F.lane, F.in[I_X] + (size_t)m * DM, F.in[I_N1W], XN + (size_t)m * DM);
    __syncthreads();
    for (int it = blockIdx.x; it < 512; it += F.G) p0_ws_item(F, it);
}
typedef unsigned u32x4 __attribute__((ext_vector_type(4)));
__device__ __forceinline__ u32x4 pack8(f32x4 a, f32x4 b) { u32x4 w; w.x = pk2(a[0], a[1]); w.y = pk2(a[2], a[3]); w.z = pk2(b[0], b[1]); w.w = pk2(b[2], b[3]); return w; }
__device__ __forceinline__ void unpack8(u32x4 w, f32x4& a, f32x4& b) { a = (f32x4){bflo(w.x), bfhi(w.x), bflo(w.y), bfhi(w.y)}; b = (f32x4){bflo(w.z), bfhi(w.z), bflo(w.w), bfhi(w.w)}; }
__device__ __forceinline__ f32x4 silu4(f32x4 v) { return (f32x4){siluf_(v[0]), siluf_(v[1]), siluf_(v[2]), siluf_(v[3])}; }
__device__ __forceinline__ f32x4 sigm4(f32x4 v) { return (f32x4){sigmoidf_(v[0]), sigmoidf_(v[1]), sigmoidf_(v[2]), sigmoidf_(v[3])}; }

struct EpiG1 {
    static constexpr bool PERM = true, AFTER_DRAIN = false;
    unsigned char* ws; const float* lbl;
    __device__ __forceinline__ void operator()(const f32x4 (&acc)[2][2][4][2], const pg8::Unit& u, int wr, int wc, int fr, int fq) const {
        const int pn = u.pn, row0 = u.pm * 256 + wr * 64 + fr;
        {
            const int grp = pn >> 2; const bool act = (grp == 0) | (grp == 4) | (grp == 8);
            bf16* base = (bf16*)(ws + WS_H + (size_t)grp * 32 * MiB); const int col0 = (pn & 3) * 256 + wc * 32 + 8 * fq;
            const bool fgate = (grp == 1) | (grp == 2); f32x4 lbv[2][2];
            if (fgate) { const float* l0 = lbl + (grp - 1) * 2048 + col0;
#pragma unroll
                for (int bj = 0; bj < 2; ++bj)
#pragma unroll
                    for (int n = 0; n < 2; ++n) { const f32x4 a0 = *(const f32x4*)(l0 + bj * 128 + 4 * n), a1 = *(const f32x4*)(l0 + 1024 + bj * 128 + 4 * n);
                        lbv[bj][n] = (f32x4){fast_rcp(1.0f + fast_exp(a1[0] - a0[0])), fast_rcp(1.0f + fast_exp(a1[1] - a0[1])), fast_rcp(1.0f + fast_exp(a1[2] - a0[2])), fast_rcp(1.0f + fast_exp(a1[3] - a0[3]))}; } }
#pragma unroll
            for (int ai = 0; ai < 2; ++ai)
#pragma unroll
                for (int m = 0; m < 4; ++m) { bf16* rowp = base + (size_t)(row0 + ai * 128 + m * 16) * HW + col0;
#pragma unroll
                    for (int bj = 0; bj < 2; ++bj) { f32x4 v0 = acc[ai][bj][m][0], v1 = acc[ai][bj][m][1];
                        if (act) { v0 = silu4(v0); v1 = silu4(v1); }
                        if (fgate) { v0 = lbv[bj][0] + (1.0f - lbv[bj][0]) * sigm4(v0); v1 = lbv[bj][1] + (1.0f - lbv[bj][1]) * sigm4(v1); }
                        *(u32x4*)(rowp + bj * 128) = pack8(v0, v1); } }
        }
    }
};
struct EpiGate {
    static constexpr bool PERM = true, AFTER_DRAIN = false;
    bf16* O;
    __device__ __forceinline__ void operator()(const f32x4 (&acc)[2][2][4][2], const pg8::Unit& u, int wr, int wc, int fr, int fq) const {
        const int row0 = u.pm * 256 + wr * 64 + fr, col0 = u.pn * 256 + wc * 32 + 8 * fq;
#pragma unroll
        for (int ai = 0; ai < 2; ++ai)
#pragma unroll
            for (int m = 0; m < 4; ++m) { bf16* rowp = O + (size_t)(row0 + ai * 128 + m * 16) * DM + col0;
#pragma unroll
                for (int bj = 0; bj < 2; ++bj) *(u32x4*)(rowp + bj * 128) = pack8(sigm4(acc[ai][bj][m][0]), sigm4(acc[ai][bj][m][1])); }
    }
};
template <int MODE> struct EpiMix {
    static constexpr bool PERM = true, AFTER_DRAIN = false;
    bf16* O; const bf16* G;
    __device__ __forceinline__ void operator()(const f32x4 (&acc)[2][2][4][2], const pg8::Unit& u, int wr, int wc, int fr, int fq) const {
        const int row0 = u.pm * 256 + wr * 64 + fr, col0 = u.pn * 256 + wc * 32 + 8 * fq;
#pragma unroll
        for (int ai = 0; ai < 2; ++ai)
#pragma unroll
            for (int m = 0; m < 4; ++m) { const size_t off = (size_t)(row0 + ai * 128 + m * 16) * DM + col0;
#pragma unroll
                for (int bj = 0; bj < 2; ++bj) { f32x4 o0, o1; unpack8(*(const u32x4*)(O + off + bj * 128), o0, o1);
                    if (MODE == 0) { o0 = o0 * acc[ai][bj][m][0]; o1 = o1 * acc[ai][bj][m][1]; }
                    else { f32x4 g0, g1; unpack8(*(const u32x4*)(G + off + bj * 128), g0, g1); o0 = o0 + g0 * acc[ai][bj][m][0]; o1 = o1 + g1 * acc[ai][bj][m][1]; }
                    *(u32x4*)(O + off + bj * 128) = pack8(o0, o1); } }
    }
};
struct EpiX1 {
    static constexpr bool PERM = false, AFTER_DRAIN = false;
    const float* x; float* out; bf16* xb;
    __device__ __forceinline__ void operator()(const f32x4 (&acc)[2][2][4][2], const pg8::Unit& u, int wr, int wc, int fr, int fq) const {
        const int row0 = u.pm * 256 + wr * 64 + fr, col0 = u.pn * 256 + wc * 32 + 4 * fq;
#pragma unroll
        for (int ai = 0; ai < 2; ++ai)
#pragma unroll
            for (int m = 0; m < 4; ++m) { const size_t off = (size_t)(row0 + ai * 128 + m * 16) * DM + col0;
#pragma unroll
                for (int bj = 0; bj < 2; ++bj)
#pragma unroll
                    for (int n = 0; n < 2; ++n) { const size_t o = off + bj * 128 + n * 16; const f32x4 v = *(const f32x4*)(x + o) + acc[ai][bj][m][n];
                        *(f32x4*)(out + o) = v; *(v2u*)(xb + o) = pack4(v); } }
    }
};
struct EpiF32 {
    static constexpr bool PERM = false, AFTER_DRAIN = false;
    float* C;
    __device__ __forceinline__ void operator()(const f32x4 (&acc)[2][2][4][2], const pg8::Unit& u, int wr, int wc, int fr, int fq) const {
        const int row0 = u.pm * 256 + wr * 64 + fr, col0 = u.pn * 256 + wc * 32 + 4 * fq;
#pragma unroll
        for (int ai = 0; ai < 2; ++ai)
#pragma unroll
            for (int m = 0; m < 4; ++m) { float* rowp = C + (size_t)(row0 + ai * 128 + m * 16) * DM + col0;
#pragma unroll
                for (int bj = 0; bj < 2; ++bj)
#pragma unroll
                    for (int n = 0; n < 2; ++n) *(f32x4*)(rowp + bj * 128 + n * 16) = acc[ai][bj][m][n]; }
    }
};

__device__ __forceinline__ void p1_ab(Frame& F) {
    const bf16* XN = (const bf16*)(F.ws + WS_XN); const bf16* Wab = (const bf16*)(F.ws + WS_W1) + (size_t)9216 * DM; float* Gab = (float*)(F.ws + WS_GAB);
    const int fr = F.lane & 15, fq = F.lane >> 4, rt = F.wave >> 1, ct = F.wave & 1;
    for (int blk = F.vcu; blk < SEQ / 64; blk += F.G) {
        const bf16* ap = XN + (size_t)(blk * 64 + rt * 16 + fr) * DM + 8 * fq; const bf16* bp = Wab + (size_t)(ct * 16 + fr) * DM + 8 * fq;
        f32x4 acc = {0.f, 0.f, 0.f, 0.f};
#pragma unroll 8
        for (int k0 = 0; k0 < DM; k0 += 32) acc = mfma16(*(const GAS bf16x8*)(bp + k0), *(const GAS bf16x8*)(ap + k0), acc);
        *(GAS f32x4*)(Gab + (size_t)(blk * 64 + rt * 16 + fr) * 32 + ct * 16 + 4 * fq) = acc;
    }
}
template <bool PASS3, int SKIP = 0>
__device__ __forceinline__ void hgrn_pass(Frame& F) {
    LAS bf16*  ST  = (LAS bf16*)(F.lds + 0);
    LAS float* LF  = (LAS float*)(F.lds + 0);
    LAS bf16*  QT  = (LAS bf16*)(F.lds + 34816);
    LAS bf16*  KT  = (LAS bf16*)(F.lds + 52224);
    LAS bf16*  KHT = (LAS bf16*)(F.lds + 69632);
    LAS bf16*  VT  = (LAS bf16*)(F.lds + 88064);
    LAS bf16*  ATT = (LAS bf16*)(F.lds + 106496);
    LAS float* PT  = (LAS float*)(F.lds + 115712);
    LAS float* BL  = (LAS float*)(F.lds + 117760);
    LAS float* DKK = (LAS float*)(F.lds + 118272);
    LAS float* LBV = (LAS float*)(F.lds + 118784);
    LAS bf16*  VR  = (LAS bf16*)(F.lds + 119296);
    const int tid = F.tid, lane = F.lane, w = F.wave, fr = lane & 15, fq = lane >> 4;
    const int row = tid >> 3, c0 = (tid & 7) * 16;
    float* HL = (float*)(F.ws + WS_HL); float* HDS = (float*)(F.ws + WS_HDS);
    for (int it = blockIdx.x; it < 256; it += F.G) {
        const int hd = it >> 4, sg = it & 15, dir = hd >> 3, h = hd & 7;
        const bf16* Hq = (const bf16*)(F.ws + WS_H); const bf16* Hf = (const bf16*)(F.ws + WS_H + (size_t)(1 + dir) * 32 * MiB); const bf16* Hi = (const bf16*)(F.ws + WS_H + (size_t)3 * 32 * MiB);
        bf16* Oh = (bf16*)(F.ws + (dir ? WS_OHB : WS_OHF));
        __syncthreads();
        f32x4 Sacc[8];
#pragma unroll
        for (int kt = 0; kt < 8; ++kt) Sacc[kt] = (f32x4){0.f, 0.f, 0.f, 0.f};
        if (PASS3) {
            for (int p = 0; p < sg; ++p) { const int ip = hd * 16 + p;
#pragma unroll
                for (int kt = 0; kt < 8; ++kt) { const f32x4 dsv = *(const GAS f32x4*)(HDS + ip * 128 + 16 * kt + 4 * fq);
                    const f32x4 l = *(const GAS f32x4*)(HL + ((size_t)((ip * 8 + w) * 8 + kt) * 64 + lane) * 4); Sacc[kt] = Sacc[kt] * dsv + l; } }
        }
        float sumbl = 1.f;
        v4u rq[2], rf[2], rv[2];
        { const int oc = dir ? 255 - sg * 16 : sg * 16; const size_t off = (size_t)(64 * oc + row) * HW + h * 128 + c0;
          rq[0] = *(const GAS v4u*)(Hq + off); rq[1] = *(const GAS v4u*)(Hq + off + 8); rf[0] = *(const GAS v4u*)(Hf + off); rf[1] = *(const GAS v4u*)(Hf + off + 8); rv[0] = *(const GAS v4u*)(Hi + off); rv[1] = *(const GAS v4u*)(Hi + off + 8); }
        __syncthreads();
        for (int ci = 0; ci < ((SKIP & 4) ? 1 : CPS); ++ci) {
            const int sc = sg * 16 + ci, oc = dir ? 255 - sc : sc, tok0 = 64 * oc;
            float kk[16], qq[16];
            { const unsigned fw[8] = {rf[0].x, rf[0].y, rf[0].z, rf[0].w, rf[1].x, rf[1].y, rf[1].z, rf[1].w};
              const unsigned qw[8] = {rq[0].x, rq[0].y, rq[0].z, rq[0].w, rq[1].x, rq[1].y, rq[1].z, rq[1].w};
              float fgv[16];
#pragma unroll
              for (int e = 0; e < 16; ++e) { fgv[e] = (e & 1) ? bfhi(fw[e >> 1]) : bflo(fw[e >> 1]); qq[e] = (e & 1) ? bfhi(qw[e >> 1]) : bflo(qw[e >> 1]); kk[e] = 1.0f - fgv[e]; }
#pragma unroll
              for (int q4 = 0; q4 < 4; ++q4) *(LAS f32x4*)(LF + row * 132 + c0 + 4 * q4) = (f32x4){fgv[4 * q4], fgv[4 * q4 + 1], fgv[4 * q4 + 2], fgv[4 * q4 + 3]};
              *(LAS v4u*)(VR + row * 136 + c0) = rv[0]; *(LAS v4u*)(VR + row * 136 + c0 + 8) = rv[1]; }
            if (ci + 1 < CPS && !(SKIP & 2)) { const int oc2 = dir ? oc - 1 : oc + 1; const size_t off = (size_t)(64 * oc2 + row) * HW + h * 128 + c0;
              rq[0] = *(const GAS v4u*)(Hq + off); rq[1] = *(const GAS v4u*)(Hq + off + 8); rf[0] = *(const GAS v4u*)(Hf + off); rf[1] = *(const GAS v4u*)(Hf + off + 8); rv[0] = *(const GAS v4u*)(Hi + off); rv[1] = *(const GAS v4u*)(Hi + off + 8); }
            if (!(SKIP & 8)) __syncthreads();
            { const int c = tid & 127, part = tid >> 7, r0 = part * 16; float b[16], fv[16]; float run = 1.f;
#pragma unroll
              for (int i = 0; i < 16; ++i) fv[i] = LF[(r0 + i) * 132 + c];
              if (!dir) {
#pragma unroll
                  for (int i = 0; i < 16; ++i) { run *= fv[i]; b[i] = run; }
              } else {
#pragma unroll
                  for (int i = 15; i >= 0; --i) { run *= fv[i]; b[i] = run; }
              }
              PT[part * 128 + c] = run;
              unsigned short vcol[16];
#pragma unroll
              for (int i = 0; i < 16; ++i) vcol[i] = VR[(r0 + i) * 136 + c];
              if (!(SKIP & 8)) __syncthreads();
              const float p0 = PT[c], p1 = PT[128 + c], p2 = PT[256 + c], p3 = PT[384 + c];
              float offs;
              if (!dir) offs = (part > 0 ? p0 : 1.f) * (part > 1 ? p1 : 1.f) * (part > 2 ? p2 : 1.f);
              else      offs = (part < 3 ? p3 : 1.f) * (part < 2 ? p2 : 1.f) * (part < 1 ? p1 : 1.f);
              const float tot = (p0 * p1) * (p2 * p3);
              unsigned kh[8], vw[8];
#pragma unroll
              for (int i = 0; i < 8; ++i) { const float P0 = b[2 * i] * offs, P1 = b[2 * i + 1] * offs;
                  if (PASS3) { LF[(r0 + 2 * i) * 132 + c] = P0; LF[(r0 + 2 * i + 1) * 132 + c] = P1; }
                  kh[i] = pk2((1.0f - fv[2 * i]) * tot * fast_rcp(P0), (1.0f - fv[2 * i + 1]) * tot * fast_rcp(P1)); vw[i] = (unsigned)vcol[2 * i] | ((unsigned)vcol[2 * i + 1] << 16); }
              *(LAS v4u*)(KHT + c * 72 + r0) = (v4u){kh[0], kh[1], kh[2], kh[3]}; *(LAS v4u*)(KHT + c * 72 + r0 + 8) = (v4u){kh[4], kh[5], kh[6], kh[7]};
              *(LAS v4u*)(VT + c * 72 + r0) = (v4u){vw[0], vw[1], vw[2], vw[3]}; *(LAS v4u*)(VT + c * 72 + r0 + 8) = (v4u){vw[4], vw[5], vw[6], vw[7]};
              if (part == 0) { DKK[c] = tot; sumbl *= tot; }
            }
            if (!(SKIP & 8)) __syncthreads();
            if (PASS3 && !(SKIP & 1)) { float bb[16];
#pragma unroll
              for (int q4 = 0; q4 < 4; ++q4) { const f32x4 t4 = *(const LAS f32x4*)(LF + row * 132 + c0 + 4 * q4); bb[4 * q4] = t4[0]; bb[4 * q4 + 1] = t4[1]; bb[4 * q4 + 2] = t4[2]; bb[4 * q4 + 3] = t4[3]; }
              unsigned qo[8], ko[8];
#pragma unroll
              for (int e = 0; e < 8; ++e) { qo[e] = pk2(qq[2 * e] * bb[2 * e], qq[2 * e + 1] * bb[2 * e + 1]); ko[e] = pk2(kk[2 * e] * fast_rcp(bb[2 * e]), kk[2 * e + 1] * fast_rcp(bb[2 * e + 1])); }
              *(LAS v4u*)(QT + row * 136 + c0) = (v4u){qo[0], qo[1], qo[2], qo[3]}; *(LAS v4u*)(QT + row * 136 + c0 + 8) = (v4u){qo[4], qo[5], qo[6], qo[7]};
              *(LAS v4u*)(KT + row * 136 + c0) = (v4u){ko[0], ko[1], ko[2], ko[3]}; *(LAS v4u*)(KT + row * 136 + c0 + 8) = (v4u){ko[4], ko[5], ko[6], ko[7]};
            }
            if (PASS3) if (!(SKIP & 8)) __syncthreads();
            if (PASS3 && !(SKIP & 1)) {
                { bf16x8 kf[2][4], qf[2][4]; f32x4 acc[2];
#pragma unroll
                  for (int q2 = 0; q2 < 2; ++q2) { const int tl = 2 * w + q2, ti = tl >> 2, tj = tl & 3; acc[q2] = (f32x4){0.f, 0.f, 0.f, 0.f};
#pragma unroll
                      for (int k0 = 0; k0 < 4; ++k0) { kf[q2][k0] = ldfrag(KT, 136, 16 * ti + fr, 32 * k0 + 8 * fq); qf[q2][k0] = ldfrag(QT, 136, 16 * tj + fr, 32 * k0 + 8 * fq); } }
                  __builtin_amdgcn_sched_barrier(0);
#pragma unroll
                  for (int k0 = 0; k0 < 4; ++k0)
#pragma unroll
                      for (int q2 = 0; q2 < 2; ++q2) acc[q2] = mfma16(kf[q2][k0], qf[q2][k0], acc[q2]);
                  __builtin_amdgcn_sched_barrier(0);
#pragma unroll
                  for (int q2 = 0; q2 < 2; ++q2) { const int tl = 2 * w + q2, ti = tl >> 2, tj = tl & 3; const int t = 16 * tj + fr, s0 = 16 * ti + 4 * fq;
#pragma unroll
                      for (int r = 0; r < 4; ++r) { const bool keep = dir ? (s0 + r >= t) : (s0 + r <= t); acc[q2][r] = keep ? acc[q2][r] : 0.f; }
                      *(LAS v2u*)(ATT + t * 72 + s0) = pack4(acc[q2]); } }
#pragma unroll
                for (int kt = 0; kt < 8; ++kt) *(LAS v2u*)(ST + (16 * w + fr) * 136 + 16 * kt + 4 * fq) = pack4(Sacc[kt]);
                if (!(SKIP & 8)) __syncthreads();
            }
            bf16x8 xv[2];
#pragma unroll
            for (int s0 = 0; s0 < 2; ++s0) xv[s0] = ldfrag(VT, 72, 16 * w + fr, 32 * s0 + 8 * fq);
            if (PASS3 && !(SKIP & 1)) {
                bf16x8 xs[4];
#pragma unroll
                for (int k0 = 0; k0 < 4; ++k0) xs[k0] = ldfrag(ST, 136, 16 * w + fr, 32 * k0 + 8 * fq);
#pragma unroll
                for (int th = 0; th < 2; ++th) { bf16x8 qf[2][4], af[2][2]; f32x4 acc[2];
#pragma unroll
                    for (int tq = 0; tq < 2; ++tq) { const int tt = 2 * th + tq; acc[tq] = (f32x4){0.f, 0.f, 0.f, 0.f};
#pragma unroll
                        for (int k0 = 0; k0 < 4; ++k0) qf[tq][k0] = ldfrag(QT, 136, 16 * tt + fr, 32 * k0 + 8 * fq);
#pragma unroll
                        for (int s0 = 0; s0 < 2; ++s0) af[tq][s0] = ldfrag(ATT, 72, 16 * tt + fr, 32 * s0 + 8 * fq); }
                    __builtin_amdgcn_sched_barrier(0);
#pragma unroll
                    for (int k0 = 0; k0 < 4; ++k0)
#pragma unroll
                        for (int tq = 0; tq < 2; ++tq) acc[tq] = mfma16(xs[k0], qf[tq][k0], acc[tq]);
#pragma unroll
                    for (int s0 = 0; s0 < 2; ++s0)
#pragma unroll
                        for (int tq = 0; tq < 2; ++tq) acc[tq] = mfma16(xv[s0], af[tq][s0], acc[tq]);
                    __builtin_amdgcn_sched_barrier(0);
#pragma unroll
                    for (int tq = 0; tq < 2; ++tq) *(GAS v2u*)(Oh + (size_t)(tok0 + 16 * (2 * th + tq) + fr) * HW + h * 128 + 16 * w + 4 * fq) = pack4(acc[tq]); }
            }
#pragma unroll
            for (int kh = 0; kh < ((SKIP & 1) ? 0 : 2); ++kh) { bf16x8 kf[4][2];
#pragma unroll
                for (int kq = 0; kq < 4; ++kq) { const int kt = 4 * kh + kq; const f32x4 d4 = *(const LAS f32x4*)(DKK + 16 * kt + 4 * fq); Sacc[kt] = Sacc[kt] * d4;
#pragma unroll
                    for (int s0 = 0; s0 < 2; ++s0) kf[kq][s0] = ldfrag(KHT, 72, 16 * kt + fr, 32 * s0 + 8 * fq); }
                __builtin_amdgcn_sched_barrier(0);
#pragma unroll
                for (int s0 = 0; s0 < 2; ++s0)
#pragma unroll
                    for (int kq = 0; kq < 4; ++kq) Sacc[4 * kh + kq] = mfma16(kf[kq][s0], xv[s0], Sacc[4 * kh + kq]);
                __builtin_amdgcn_sched_barrier(0); }
            if (!(SKIP & 8)) __syncthreads();
        }
        if (!PASS3) {
#pragma unroll
            for (int kt = 0; kt < 8; ++kt) *(GAS f32x4*)(HL + ((size_t)((it * 8 + w) * 8 + kt) * 64 + lane) * 4) = Sacc[kt];
            if (tid < 128) HDS[it * 128 + tid] = sumbl;
        }
    }
}
template <int SKIP>
__device__ __forceinline__ void gdn_prep(Frame& F) {
    LAS bf16*  QN  = (LAS bf16*)(F.lds + 0);
    LAS bf16*  KN  = (LAS bf16*)(F.lds + 17408);
    LAS bf16*  VT  = (LAS bf16*)(F.lds + 34816);
    LAS bf16*  KNT = (LAS bf16*)(F.lds + 53248);
    LAS float* AM  = (LAS float*)(F.lds + 71680);
    LAS bf16*  TB  = (LAS bf16*)(F.lds + 104448);
    LAS bf16*  VR  = (LAS bf16*)(F.lds + 104448);
    LAS float* CWL = (LAS float*)(F.lds + 142848);
    LAS float* DEC = (LAS float*)(F.lds + 141312);
    LAS float* BET = DEC + 128;
    LAS float* EXD = DEC + 256;
    const int tid = F.tid, lane = F.lane, w = F.wave, fr = lane & 15, fq = lane >> 4;
    const int row = tid >> 3, c0 = (tid & 7) * 16;
    const bf16* Gq = (const bf16*)(F.ws + WS_H + (size_t)5 * 32 * MiB); const bf16* Gk = (const bf16*)(F.ws + WS_H + (size_t)6 * 32 * MiB); const bf16* Gv = (const bf16*)(F.ws + WS_H + (size_t)7 * 32 * MiB);
    const float* Gab = (const float*)(F.ws + WS_GAB); const float* cw = F.in[I_CONVW];
    unsigned char* dob = (unsigned char*)F.out;
    bf16* QNg = (bf16*)(dob + DO_QN); bf16* KNTg = (bf16*)(dob + DO_KNT); float* GSC = (float*)(F.ws + WS_GSC);
    int hload = -1;
    for (int it = blockIdx.x; it < 2048; it += F.G) {
        const int h = it & 7, oc = it >> 3, tok0 = 64 * oc;
        __syncthreads();
        if (h != hload) { hload = h;
            for (int i = tid; i < 5 * 384; i += NTHR) { const int j = i / 384, r = i % 384; CWL[i] = cw[j * 3072 + (r >> 7) * 1024 + h * 128 + (r & 127)]; }
            __syncthreads(); }
        if (it + F.G < 2048 && tid < 408) { const int it2 = it + F.G, h2 = it2 & 7, oc2 = it2 >> 3; const int tz = tid / 136, rl = tid % 136, r = rl >> 1, half = rl & 1; const int tr = 64 * oc2 - 2 + r;
            if (tr >= 0 && tr < SEQ) { const bf16* src = (tz == 0 ? Gq : tz == 1 ? Gk : Gv) + (size_t)tr * HW + h2 * 128 + half * 64; unsigned tmp = *(const GAS unsigned*)src; asm volatile("" :: "v"(tmp)); } }
        if (tid < 128) { const int dir = tid >> 6, l = tid & 63, pos = dir ? 63 - l : l;
            const float a = Gab[(size_t)(tok0 + pos) * 32 + dir * 8 + h], b = Gab[(size_t)(tok0 + pos) * 32 + 16 + dir * 8 + h];
            const float x = a + F.in[I_DTB][dir * 8 + h]; const float sp = x > 20.f ? x : log1pf(__expf(x));
            float d = -__expf(F.in[I_ALOG][dir * 8 + h]) * sp;
#pragma unroll
            for (int o = 1; o < 64; o <<= 1) { const float t = __shfl_up(d, o); if (l >= o) d += t; }
            DEC[dir * 64 + pos] = d; BET[dir * 64 + pos] = sigmoidf_(b); EXD[dir * 64 + pos] = __expf(d); }
        if (!(SKIP & 64)) { float q[16], k[16], v[16];
#pragma unroll
          for (int e = 0; e < 16; ++e) { q[e] = 0.f; k[e] = 0.f; v[e] = 0.f; }
          const int ch = h * 128 + c0;
#pragma unroll
          for (int j = 0; j < ((SKIP & 1) ? 0 : 5); ++j) { const int tr = tok0 + row + j - 2;
              if (tr >= 0 && tr < SEQ) { const size_t off = (size_t)tr * HW + ch;
                  const v4u xq0 = *(const GAS v4u*)(Gq + off), xq1 = *(const GAS v4u*)(Gq + off + 8), xk0 = *(const GAS v4u*)(Gk + off), xk1 = *(const GAS v4u*)(Gk + off + 8), xv0 = *(const GAS v4u*)(Gv + off), xv1 = *(const GAS v4u*)(Gv + off + 8);
                  const unsigned wq[8] = {xq0.x, xq0.y, xq0.z, xq0.w, xq1.x, xq1.y, xq1.z, xq1.w}, wk[8] = {xk0.x, xk0.y, xk0.z, xk0.w, xk1.x, xk1.y, xk1.z, xk1.w}, wv[8] = {xv0.x, xv0.y, xv0.z, xv0.w, xv1.x, xv1.y, xv1.z, xv1.w};
                  const LAS float* cq = CWL + j * 384 + c0;
#pragma unroll
                  for (int e = 0; e < 16; ++e) { const float fq_ = (e & 1) ? bfhi(wq[e >> 1]) : bflo(wq[e >> 1]), fk_ = (e & 1) ? bfhi(wk[e >> 1]) : bflo(wk[e >> 1]), fv_ = (e & 1) ? bfhi(wv[e >> 1]) : bflo(wv[e >> 1]);
                      q[e] += cq[e] * fq_; k[e] += cq[128 + e] * fk_; v[e] += cq[256 + e] * fv_; } } }
          float sq = 0.f, sk = 0.f;
#pragma unroll
          for (int e = 0; e < 16; ++e) { q[e] = siluf_(q[e]); k[e] = siluf_(k[e]); v[e] = siluf_(v[e]); sq += q[e] * q[e]; sk += k[e] * k[e]; }
          sq += __shfl_xor(sq, 1); sq += __shfl_xor(sq, 2); sq += __shfl_xor(sq, 4); sk += __shfl_xor(sk, 1); sk += __shfl_xor(sk, 2); sk += __shfl_xor(sk, 4);
          const float rq = 0.08838834764831845f / sqrtf(sq + EPS), rk = 1.0f / sqrtf(sk + EPS);
          unsigned qo[8], ko[8];
#pragma unroll
          for (int e = 0; e < 8; ++e) { qo[e] = pk2(q[2 * e] * rq, q[2 * e + 1] * rq); ko[e] = pk2(k[2 * e] * rk, k[2 * e + 1] * rk); }
          const v4u q0 = {qo[0], qo[1], qo[2], qo[3]}, q1 = {qo[4], qo[5], qo[6], qo[7]}, k0_ = {ko[0], ko[1], ko[2], ko[3]}, k1_ = {ko[4], ko[5], ko[6], ko[7]};
          *(LAS v4u*)(QN + row * 136 + c0) = q0; *(LAS v4u*)(QN + row * 136 + c0 + 8) = q1; *(LAS v4u*)(KN + row * 136 + c0) = k0_; *(LAS v4u*)(KN + row * 136 + c0 + 8) = k1_;
          if (!(SKIP & 16)) { *(GAS v4u*)(QNg + (size_t)(tok0 + row) * HW + ch) = q0; *(GAS v4u*)(QNg + (size_t)(tok0 + row) * HW + ch + 8) = q1; }
          unsigned vo[8];
#pragma unroll
          for (int e = 0; e < 8; ++e) vo[e] = pk2(v[2 * e], v[2 * e + 1]);
          *(LAS v4u*)(VR + row * 136 + c0) = (v4u){vo[0], vo[1], vo[2], vo[3]}; *(LAS v4u*)(VR + row * 136 + c0 + 8) = (v4u){vo[4], vo[5], vo[6], vo[7]};
        }
        __syncthreads();
        { const int c = tid & 127, r0 = (tid >> 7) * 16; unsigned vw[8], kw[8];
#pragma unroll
          for (int i = 0; i < 8; ++i) { vw[i] = (unsigned)VR[(r0 + 2 * i) * 136 + c] | ((unsigned)VR[(r0 + 2 * i + 1) * 136 + c] << 16); kw[i] = (unsigned)KN[(r0 + 2 * i) * 136 + c] | ((unsigned)KN[(r0 + 2 * i + 1) * 136 + c] << 16); }
          *(LAS v4u*)(VT + c * 72 + r0) = (v4u){vw[0], vw[1], vw[2], vw[3]}; *(LAS v4u*)(VT + c * 72 + r0 + 8) = (v4u){vw[4], vw[5], vw[6], vw[7]};
          *(LAS v4u*)(KNT + c * 72 + r0) = (v4u){kw[0], kw[1], kw[2], kw[3]}; *(LAS v4u*)(KNT + c * 72 + r0 + 8) = (v4u){kw[4], kw[5], kw[6], kw[7]}; }
#pragma unroll
        for (int q2 = 0; q2 < ((SKIP & 8) ? 0 : 2); ++q2) { const int tl = 2 * w + q2, ti = tl >> 2, tj = tl & 3; f32x4 kkv = {0.f, 0.f, 0.f, 0.f}, qkv = {0.f, 0.f, 0.f, 0.f};
#pragma unroll
            for (int k0 = 0; k0 < 4; ++k0) { const bf16x8 xs = ldfrag(KN, 136, 16 * ti + fr, 32 * k0 + 8 * fq);
                kkv = mfma16(xs, ldfrag(KN, 136, 16 * tj + fr, 32 * k0 + 8 * fq), kkv); qkv = mfma16(xs, ldfrag(QN, 136, 16 * tj + fr, 32 * k0 + 8 * fq), qkv); }
            const int t = 16 * tj + fr, s0 = 16 * ti + 4 * fq;
#pragma unroll
            for (int dir = 0; dir < 2; ++dir) { const float dt = DEC[dir * 64 + t], bt = BET[dir * 64 + t]; f32x4 aq;
#pragma unroll
                for (int r = 0; r < 4; ++r) { const int s = s0 + r; const bool before = dir ? (s > t) : (s < t), beq = before || (s == t);
                    const float e = beq ? __expf(dt - DEC[dir * 64 + s]) : 0.f;
                    AM[dir * 4096 + (dir ? (63 - s) * 64 + (63 - t) : s * 64 + t)] = before ? bt * kkv[r] * e : 0.f;   aq[r] = qkv[r] * e; }
                bf16* AQg = (bf16*)(dob + (dir ? DO_AQKB : DO_AQKF));
                if (!(SKIP & 16)) *(GAS v2u*)(AQg + ((size_t)(h * 256 + oc) * 64 + t) * 64 + s0) = pack4(aq); } }
        __syncthreads();
        if (SKIP & 32) {} else if (w < 2) { const int dir = w; int c = lane; asm volatile("" : "+v"(c)); const LAS float* A = AM + dir * 4096;
            float t[64];
#pragma unroll
            for (int bi = 0; bi < 4; ++bi) { float r[16];
#pragma unroll
                for (int ii = 0; ii < 16; ++ii) r[ii] = (16 * bi + ii == c) ? 1.f : 0.f;
                if (!(SKIP & 2)) {
#pragma unroll
                for (int j0 = 0; j0 < 16 * bi; j0 += 4) { f32x4 av[4][4];
#pragma unroll
                    for (int jq = 0; jq < 4; ++jq)
#pragma unroll
                        for (int q4 = 0; q4 < 4; ++q4) av[jq][q4] = *(const LAS f32x4*)(A + (j0 + jq) * 64 + 16 * bi + 4 * q4);
                    __builtin_amdgcn_sched_barrier(0);
#pragma unroll
                    for (int jq = 0; jq < 4; ++jq)
#pragma unroll
                        for (int q4 = 0; q4 < 4; ++q4) { r[4 * q4] -= av[jq][q4][0] * t[j0 + jq]; r[4 * q4 + 1] -= av[jq][q4][1] * t[j0 + jq]; r[4 * q4 + 2] -= av[jq][q4][2] * t[j0 + jq]; r[4 * q4 + 3] -= av[jq][q4][3] * t[j0 + jq]; }
                    __builtin_amdgcn_sched_barrier(0); }
#pragma unroll
                for (int jg = 0; jg < 4; ++jg) { f32x4 av[4][4];
#pragma unroll
                    for (int jq = 0; jq < 4; ++jq)
#pragma unroll
                        for (int q4 = jg; q4 < 4; ++q4) av[jq][q4] = *(const LAS f32x4*)(A + (16 * bi + 4 * jg + jq) * 64 + 16 * bi + 4 * q4);
                    __builtin_amdgcn_sched_barrier(0);
#pragma unroll
                    for (int jq = 0; jq < 4; ++jq) { const int jj = 4 * jg + jq; t[16 * bi + jj] = r[jj];
#pragma unroll
                        for (int q4 = jg; q4 < 4; ++q4)
#pragma unroll
                            for (int e = 0; e < 4; ++e) if (4 * q4 + e > jj) r[4 * q4 + e] -= av[jq][q4][e] * r[jj]; }
                    __builtin_amdgcn_sched_barrier(0); }
                } else {
#pragma unroll
                for (int jj = 0; jj < 16; ++jj) t[16 * bi + jj] = r[jj]; }
            }
            const int tc = dir ? 63 - c : c; const float bc = BET[dir * 64 + tc], bd = bc * EXD[dir * 64 + tc];
            LAS bf16* T0 = TB + (dir * 2 + 0) * 64 * 72 + tc + (dir ? 63 * 72 : 0); const int tstep = dir ? -72 : 72;
#pragma unroll
            for (int i = 0; i < 64; ++i) { T0[i * tstep] = (bf16)f2bf(t[i] * bc); T0[64 * 72 + i * tstep] = (bf16)f2bf(t[i] * bd); }
        } else {
            for (int idx = tid - 128; idx < ((SKIP & 16) ? 0 : 1024); idx += 384) { const int r = idx >> 3, c8 = idx & 7; *(GAS v4u*)(KNTg + ((size_t)(h * 256 + oc) * 128 + r) * 64 + c8 * 8) = *(const LAS v4u*)(KNT + r * 72 + c8 * 8); }
            if (tid >= 128 && tid < 256) { const int dir = (tid - 128) >> 6, t = tid & 63; const float dl = dir ? DEC[64] : DEC[63];
                float* g = GSC + (size_t)((dir * 8 + h) * 256 + oc) * 192; g[t] = EXD[dir * 64 + t]; g[64 + t] = __expf(dl - DEC[dir * 64 + t]); if (t == 0) g[128] = __expf(dl); }
        }
        __syncthreads();
#pragma unroll 1
        for (int n = 0; n < ((SKIP & 4) ? 0 : 16); ++n) { const int qi = w * 16 + n, dir = qi >> 6, kind = (qi >> 5) & 1, idx = qi & 31; f32x4 acc = {0.f, 0.f, 0.f, 0.f};
            const LAS bf16* Tm = TB + (dir * 2 + kind) * 64 * 72; const size_t cb = (size_t)(h * 256 + oc) * 8192;
            if (kind == 0) { const int ti = idx >> 3, vj = idx & 7;
#pragma unroll
                for (int s0 = 0; s0 < 2; ++s0) acc = mfma16(ldfrag(Tm, 72, 16 * ti + fr, 32 * s0 + 8 * fq), ldfrag(VT, 72, 16 * vj + fr, 32 * s0 + 8 * fq), acc);
                bf16* U = (bf16*)(F.ws + (dir ? WS_UTB : WS_UTF)); if (!(SKIP & 16)) *(GAS v2u*)(U + cb + (16 * vj + fr) * 64 + 16 * ti + 4 * fq) = pack4(acc);
            } else { const int ki = idx >> 2, tj = idx & 3;
#pragma unroll
                for (int s0 = 0; s0 < 2; ++s0) acc = mfma16(ldfrag(KNT, 72, 16 * ki + fr, 32 * s0 + 8 * fq), ldfrag(Tm, 72, 16 * tj + fr, 32 * s0 + 8 * fq), acc);
                bf16* W = (bf16*)(F.ws + (dir ? WS_WB : WS_WF)); if (!(SKIP & 16)) *(GAS v2u*)(W + cb + (16 * tj + fr) * 128 + 16 * ki + 4 * fq) = pack4(acc); }
        }
    }
}
__device__ __forceinline__ void gdn_load_tiles(const unsigned char* ws, const unsigned char* dob, int tid, int dir, int hd, int h, int oc, bool pass3, v4u (&rw)[2], v4u (&rq)[2], v4u (&ru)[2], v4u (&rk)[2], v4u& ra, float& rs) {
    const size_t cb = (size_t)(h * 256 + oc);
    const int row = tid >> 3, c0 = (tid & 7) * 16, vrow = tid >> 2, t0 = (tid & 3) * 16;
    const bf16* W = (const bf16*)(ws + (dir ? WS_WB : WS_WF)) + cb * 8192 + row * 128 + c0; rw[0] = *(const GAS v4u*)W; rw[1] = *(const GAS v4u*)(W + 8);
    const bf16* U = (const bf16*)(ws + (dir ? WS_UTB : WS_UTF)) + cb * 8192 + vrow * 64 + t0; ru[0] = *(const GAS v4u*)U; ru[1] = *(const GAS v4u*)(U + 8);
    const bf16* Kt = (const bf16*)(dob + DO_KNT) + (size_t)(h * 256 + oc) * 8192 + vrow * 64 + t0; rk[0] = *(const GAS v4u*)Kt; rk[1] = *(const GAS v4u*)(Kt + 8);
    if (pass3) {
        const bf16* Q = (const bf16*)(dob + DO_QN) + (size_t)(64 * oc + row) * HW + h * 128 + c0; rq[0] = *(const GAS v4u*)Q; rq[1] = *(const GAS v4u*)(Q + 8);
        const bf16* A = (const bf16*)(dob + (dir ? DO_AQKB : DO_AQKF)) + cb * 4096 + row * 64 + (tid & 7) * 8; ra = *(const GAS v4u*)A;
    }
    rs = (tid < 192) ? ((const float*)(ws + WS_GSC))[(size_t)(hd * 256 + oc) * 192 + tid] : 0.f;
}
#define SCHED_FENCE() __builtin_amdgcn_sched_barrier(0)
template <bool PASS3, bool UREAL>
__device__ __forceinline__ void gdn_tile(f32x4 (&A)[8], const LAS bf16* WTL, const LAS bf16* QNL, const LAS bf16* UTL, const LAS bf16* KTL, const LAS bf16* AQL, const LAS float* SCL,
                                         LAS bf16* ST, LAS bf16* VN, LAS bf16* VNS, int w, int fr, int fq, float gl, bf16* Ogc) {
#pragma unroll
    for (int kt = 0; kt < 8; ++kt) *(LAS v2u*)(ST + fr * 136 + 16 * kt + 4 * fq) = pack4(A[kt]);
    asm volatile("" ::: "memory");
    bf16x8 xs[4];
#pragma unroll
    for (int k0 = 0; k0 < 4; ++k0) xs[k0] = ldfrag(ST, 136, fr, 32 * k0 + 8 * fq);
#pragma unroll
    for (int th = 0; th < 2; ++th) { bf16x8 wf[2][4]; f32x4 acc[2]; v2u uw[2]; f32x4 es[2];
#pragma unroll
      for (int tq = 0; tq < 2; ++tq) { const int tt = 2 * th + tq;
#pragma unroll
          for (int k0 = 0; k0 < 4; ++k0) wf[tq][k0] = ldfrag(WTL, 136, 16 * tt + fr, 32 * k0 + 8 * fq);
          if (UREAL) uw[tq] = *(const LAS v2u*)(UTL + (16 * w + fr) * 72 + 16 * tt + 4 * fq);
          es[tq] = *(const LAS f32x4*)(SCL + 64 + 16 * tt + 4 * fq); acc[tq] = (f32x4){0.f, 0.f, 0.f, 0.f}; }
      SCHED_FENCE();
#pragma unroll
      for (int k0 = 0; k0 < 4; ++k0)
#pragma unroll
          for (int tq = 0; tq < 2; ++tq) acc[tq] = mfma16(wf[tq][k0], xs[k0], acc[tq]);
      SCHED_FENCE();
#pragma unroll
      for (int tq = 0; tq < 2; ++tq) { const int tt = 2 * th + tq; f32x4 u4 = {0.f, 0.f, 0.f, 0.f};
          if (UREAL) u4 = (f32x4){bflo(uw[tq].x), bfhi(uw[tq].x), bflo(uw[tq].y), bfhi(uw[tq].y)};
          const f32x4 vn = u4 - acc[tq];
          if (PASS3) *(LAS v2u*)(VN + fr * 72 + 16 * tt + 4 * fq) = pack4(vn);
          *(LAS v2u*)(VNS + fr * 72 + 16 * tt + 4 * fq) = pack4(vn * es[tq]); }
      SCHED_FENCE(); }
    asm volatile("" ::: "memory");
    if (PASS3) { bf16x8 yv[2];
#pragma unroll
        for (int s0 = 0; s0 < 2; ++s0) yv[s0] = ldfrag(VN, 72, fr, 32 * s0 + 8 * fq);
#pragma unroll
        for (int th = 0; th < 2; ++th) { bf16x8 qf[2][4], af[2][2]; f32x4 acc[2]; float ed[2];
#pragma unroll
            for (int tq = 0; tq < 2; ++tq) { const int tt = 2 * th + tq;
#pragma unroll
                for (int k0 = 0; k0 < 4; ++k0) qf[tq][k0] = ldfrag(QNL, 136, 16 * tt + fr, 32 * k0 + 8 * fq);
#pragma unroll
                for (int s0 = 0; s0 < 2; ++s0) af[tq][s0] = ldfrag(AQL, 72, 16 * tt + fr, 32 * s0 + 8 * fq);
                ed[tq] = SCL[16 * tt + fr]; acc[tq] = (f32x4){0.f, 0.f, 0.f, 0.f}; }
            SCHED_FENCE();
#pragma unroll
            for (int k0 = 0; k0 < 4; ++k0)
#pragma unroll
                for (int tq = 0; tq < 2; ++tq) acc[tq] = mfma16(xs[k0], qf[tq][k0], acc[tq]);
#pragma unroll
            for (int tq = 0; tq < 2; ++tq) acc[tq] = acc[tq] * ed[tq];
#pragma unroll
            for (int s0 = 0; s0 < 2; ++s0)
#pragma unroll
                for (int tq = 0; tq < 2; ++tq) acc[tq] = mfma16(yv[s0], af[tq][s0], acc[tq]);
            SCHED_FENCE();
#pragma unroll
            for (int tq = 0; tq < 2; ++tq) *(GAS v2u*)(Ogc + (size_t)(16 * (2 * th + tq) + fr) * HW + 16 * w + 4 * fq) = pack4(acc[tq]);
            SCHED_FENCE(); } }
    { bf16x8 ys[2];
#pragma unroll
      for (int s0 = 0; s0 < 2; ++s0) ys[s0] = ldfrag(VNS, 72, fr, 32 * s0 + 8 * fq);
#pragma unroll
      for (int kh = 0; kh < 2; ++kh) { bf16x8 kf[4][2];
#pragma unroll
          for (int kq = 0; kq < 4; ++kq)
#pragma unroll
              for (int s0 = 0; s0 < 2; ++s0) kf[kq][s0] = ldfrag(KTL, 72, 16 * (4 * kh + kq) + fr, 32 * s0 + 8 * fq);
#pragma unroll
          for (int kq = 0; kq < 4; ++kq) A[4 * kh + kq] = A[4 * kh + kq] * gl;
          SCHED_FENCE();
#pragma unroll
          for (int s0 = 0; s0 < 2; ++s0)
#pragma unroll
              for (int kq = 0; kq < 4; ++kq) A[4 * kh + kq] = mfma16(kf[kq][s0], ys[s0], A[4 * kh + kq]);
          SCHED_FENCE(); } }
}
template <bool PASS3, int SKIP = 0>
__device__ __forceinline__ void gdn_pass(Frame& F) {
    LAS bf16*  WTL = (LAS bf16*)(F.lds + 0);
    LAS bf16*  QNL = (LAS bf16*)(F.lds + 17408);
    LAS bf16*  UTL = (LAS bf16*)(F.lds + 34816);
    LAS bf16*  KTL = (LAS bf16*)(F.lds + 53248);
    LAS bf16*  AQL = (LAS bf16*)(F.lds + 71680);
    LAS float* SCL = (LAS float*)(F.lds + 80896);
    LAS bf16*  PX  = (LAS bf16*)(F.lds + 0);
    const int tid = F.tid, lane = F.lane, w = F.wave, fr = lane & 15, fq = lane >> 4;
    LAS bf16* ST  = (LAS bf16*)(F.lds + 81920 + w * 8960);
    LAS bf16* VN  = ST + 16 * 136;
    LAS bf16* VNS = VN + 16 * 72;
    const int row = tid >> 3, c0 = (tid & 7) * 16, vrow = tid >> 2, t0 = (tid & 3) * 16;
    const unsigned char* dob = (const unsigned char*)F.out;
    float* GL = (float*)(F.ws + WS_GL); bf16* GP = (bf16*)(F.ws + WS_GP);
    for (int it = blockIdx.x; it < 256; it += F.G) {
        const int hd = it >> 4, sg = it & 15, dir = hd >> 3, h = hd & 7;
        bf16* Og = (bf16*)(F.ws + (dir ? WS_OGB : WS_OGF));
        f32x4 Sacc[8], Pacc[8];
        int dgi = 16 * w + fr - 4 * fq; asm volatile("" : "+v"(dgi));
#pragma unroll
        for (int kt = 0; kt < 8; ++kt) { Sacc[kt] = (f32x4){0.f, 0.f, 0.f, 0.f};
#pragma unroll
            for (int r = 0; r < 4; ++r) Pacc[kt][r] = (!PASS3 && (16 * kt + r == dgi)) ? 1.f : 0.f; }
        __syncthreads();
        if (PASS3) {
            for (int p = 0; p < sg; ++p) { const int ip = hd * 16 + p;
                { const bf16* src = GP + (size_t)ip * 16384 + vrow * 128 + (tid & 3) * 32;
#pragma unroll
                  for (int q = 0; q < 4; ++q) *(LAS v4u*)(PX + vrow * 136 + (tid & 3) * 32 + 8 * q) = *(const GAS v4u*)(src + 8 * q); }
#pragma unroll
                for (int kt = 0; kt < 8; ++kt) *(LAS v2u*)(ST + fr * 136 + 16 * kt + 4 * fq) = pack4(Sacc[kt]);
                __syncthreads();
                bf16x8 xs[4];
#pragma unroll
                for (int k0 = 0; k0 < 4; ++k0) xs[k0] = ldfrag(ST, 136, fr, 32 * k0 + 8 * fq);
#pragma unroll
                for (int kh = 0; kh < 2; ++kh) { bf16x8 pf[4][4]; f32x4 acc[4];
#pragma unroll
                    for (int kq = 0; kq < 4; ++kq) { const int kt = 4 * kh + kq; acc[kq] = *(const GAS f32x4*)(GL + ((size_t)((ip * 8 + w) * 8 + kt) * 64 + lane) * 4);
#pragma unroll
                        for (int k0 = 0; k0 < 4; ++k0) pf[kq][k0] = ldfrag(PX, 136, 16 * kt + fr, 32 * k0 + 8 * fq); }
                    SCHED_FENCE();
#pragma unroll
                    for (int k0 = 0; k0 < 4; ++k0)
#pragma unroll
                        for (int kq = 0; kq < 4; ++kq) acc[kq] = mfma16(pf[kq][k0], xs[k0], acc[kq]);
                    SCHED_FENCE();
#pragma unroll
                    for (int kq = 0; kq < 4; ++kq) Sacc[4 * kh + kq] = acc[kq]; }
                __syncthreads();
            }
        }
        v4u rw[2], rq[2], ru[2], rk[2], ra; float rs;
        gdn_load_tiles(F.ws, dob, tid, dir, hd, h, dir ? 255 - sg * 16 : sg * 16, PASS3, rw, rq, ru, rk, ra, rs);
        for (int ci = 0; ci < CPS; ++ci) {
            const int sc = sg * 16 + ci, oc = dir ? 255 - sc : sc, tok0 = 64 * oc;
            *(LAS v4u*)(WTL + row * 136 + c0) = rw[0]; *(LAS v4u*)(WTL + row * 136 + c0 + 8) = rw[1];
            *(LAS v4u*)(UTL + vrow * 72 + t0) = ru[0]; *(LAS v4u*)(UTL + vrow * 72 + t0 + 8) = ru[1];
            *(LAS v4u*)(KTL + vrow * 72 + t0) = rk[0]; *(LAS v4u*)(KTL + vrow * 72 + t0 + 8) = rk[1];
            if (PASS3) { *(LAS v4u*)(QNL + row * 136 + c0) = rq[0]; *(LAS v4u*)(QNL + row * 136 + c0 + 8) = rq[1]; *(LAS v4u*)(AQL + row * 72 + (tid & 7) * 8) = ra; }
            if (tid < 192) SCL[tid] = rs;
            __syncthreads();
            if (ci + 1 < CPS && !(SKIP & 1)) gdn_load_tiles(F.ws, dob, tid, dir, hd, h, dir ? oc - 1 : oc + 1, PASS3, rw, rq, ru, rk, ra, rs);
            const float gl = SCL[128];
            gdn_tile<PASS3, true>(Sacc, WTL, QNL, UTL, KTL, AQL, SCL, ST, VN, VNS, w, fr, fq, gl, Og + (size_t)tok0 * HW + h * 128);
            if (!PASS3) gdn_tile<PASS3, false>(Pacc, WTL, QNL, UTL, KTL, AQL, SCL, ST, VN, VNS, w, fr, fq, gl, Og);
            __syncthreads();
        }
        if (!PASS3) {
            int pofs = (4 * fq) * 128 + 16 * w + fr; asm volatile("" : "+v"(pofs));
            bf16* gp = GP + (size_t)it * 16384 + pofs;
#pragma unroll
            for (int kt = 0; kt < 8; ++kt) { *(GAS f32x4*)(GL + ((size_t)((it * 8 + w) * 8 + kt) * 64 + lane) * 4) = Sacc[kt];
#pragma unroll
                for (int r = 0; r < 4; ++r) gp[(16 * kt + r) * 128] = (bf16)f2bf(Pacc[kt][r]); }
        }
    }
}
__device__ __forceinline__ void p7_mix(Frame& F) {
    const int gw = F.vcu * NWAVES + F.wave, NGW = F.G * NWAVES, lane = F.lane;
    const int e0 = (lane & 7) * 16, col = (lane >> 3) * 128 + e0;
    for (int m = gw; m < SEQ; m += NGW) {
#pragma unroll
        for (int mx = 0; mx < 2; ++mx) {
            const bf16* of = (const bf16*)(F.ws + (mx ? WS_OGF : WS_OHF)); const bf16* ob = (const bf16*)(F.ws + (mx ? WS_OGB : WS_OHB));
            const bf16* gt = (const bf16*)(F.ws + WS_H + (size_t)(mx ? 8 : 4) * 32 * MiB); const float* nw = F.in[mx ? I_GNW : I_HNW];
            bf16* yo = (bf16*)(F.ws + (mx ? WS_YB : WS_YA));
            const size_t off = (size_t)m * HW + col;
            const v4u a0 = *(const GAS v4u*)(of + off), a1 = *(const GAS v4u*)(of + off + 8), b0 = *(const GAS v4u*)(ob + off), b1 = *(const GAS v4u*)(ob + off + 8), g0 = *(const GAS v4u*)(gt + off), g1 = *(const GAS v4u*)(gt + off + 8);
            const unsigned aw[8] = {a0.x, a0.y, a0.z, a0.w, a1.x, a1.y, a1.z, a1.w}, bw[8] = {b0.x, b0.y, b0.z, b0.w, b1.x, b1.y, b1.z, b1.w}, gw_[8] = {g0.x, g0.y, g0.z, g0.w, g1.x, g1.y, g1.z, g1.w};
            float o[16]; float ss = 0.f;
#pragma unroll
            for (int e = 0; e < 8; ++e) { o[2 * e] = bflo(aw[e]) + bflo(bw[e]); o[2 * e + 1] = bfhi(aw[e]) + bfhi(bw[e]); ss += o[2 * e] * o[2 * e] + o[2 * e + 1] * o[2 * e + 1]; }
            ss += __shfl_xor(ss, 1); ss += __shfl_xor(ss, 2); ss += __shfl_xor(ss, 4);
            const float r = 1.0f / sqrtf(ss * (1.f / 128.f) + EPS);
            unsigned yw[8];
#pragma unroll
            for (int e = 0; e < 8; ++e) yw[e] = pk2(o[2 * e] * r * nw[e0 + 2 * e] * bflo(gw_[e]), o[2 * e + 1] * r * nw[e0 + 2 * e + 1] * bfhi(gw_[e]));
            *(GAS v4u*)(yo + off) = (v4u){yw[0], yw[1], yw[2], yw[3]}; *(GAS v4u*)(yo + off + 8) = (v4u){yw[4], yw[5], yw[6], yw[7]};
        }
    }
    for (int tb = 0; tb < 2; ++tb) { const float* src = F.in[tb ? I_PV : I_PU]; unsigned char* dst = F.ws + (tb ? WS_TV : WS_TU); float* scl = (float*)(F.ws + WS_PSC) + tb * 16384;
        for (int r = gw; r < 16384; r += NGW) { const float* row = src + (size_t)r * DM; f32x4 v[8]; float mx = 0.f;
#pragma unroll
            for (int q = 0; q < 8; ++q) { v[q] = *(const GAS f32x4*)(row + (tb ? (q >> 2) * 1024 + lane * 16 + 4 * (q & 3) : lane * 32 + 4 * q)); const f32x4 a = __builtin_elementwise_abs(v[q]); mx = fmaxf(mx, fmaxf(fmaxf(a.x, a.y), fmaxf(a.z, a.w))); }
            mx = wave_max(mx);
            const float sc = mx > 0.f ? mx * (1.0f / 127.0f) : 1.0f, inv = 1.0f / sc; const int bias = tb ? 128 : 0;
            unsigned w[8];
#pragma unroll
            for (int q = 0; q < 8; ++q) { const f32x4 x = v[q]; const int a = (int)rintf(x.x * inv) + bias, b = (int)rintf(x.y * inv) + bias, c = (int)rintf(x.z * inv) + bias, d = (int)rintf(x.w * inv) + bias;
                w[q] = (unsigned)(a & 255) | ((unsigned)(b & 255) << 8) | ((unsigned)(c & 255) << 16) | ((unsigned)(d & 255) << 24); }
            if (tb) { *(GAS v4u*)(dst + (size_t)r * DM + lane * 16) = (v4u){w[0], w[1], w[2], w[3]}; *(GAS v4u*)(dst + (size_t)r * DM + 1024 + lane * 16) = (v4u){w[4], w[5], w[6], w[7]}; }
            else { GAS v4u* o = (GAS v4u*)(dst + ((size_t)lane * 16384 + r) * 32); o[0] = (v4u){w[0], w[1], w[2], w[3]}; o[1] = (v4u){w[4], w[5], w[6], w[7]}; }
            if (lane == 0) scl[r] = sc; } }
}
constexpr size_t WS_XQ = 80 * MiB;
constexpr size_t WS_SXR = 112 * MiB;
constexpr size_t WS_EID = 113 * MiB, WS_GATE = 121 * MiB, WS_AV = 129 * MiB;
constexpr size_t WS_REC = 208 * MiB;
constexpr int NET = 32, ETSZ = 512, NBUCK = 16 * NET, REC_CAP = 16384, CW_CNT = 8192, CW_Q = 8192 + 16 * NBUCK;
__device__ __forceinline__ unsigned fkey(float f) { const unsigned u = __builtin_bit_cast(unsigned, f); return (u & 0x80000000u) ? ~u : (u | 0x80000000u); }
__device__ __forceinline__ float gelu_erf(float x) { return 0.5f * x * (1.0f + erff(x * 0.70710678118654752f)); }
__device__ __forceinline__ float cvt_ub0(unsigned w) { float f; asm("v_cvt_f32_ubyte0 %0, %1" : "=v"(f) : "v"(w)); return f; }
__device__ __forceinline__ float cvt_ub1(unsigned w) { float f; asm("v_cvt_f32_ubyte1 %0, %1" : "=v"(f) : "v"(w)); return f; }
__device__ __forceinline__ float cvt_ub2(unsigned w) { float f; asm("v_cvt_f32_ubyte2 %0, %1" : "=v"(f) : "v"(w)); return f; }
__device__ __forceinline__ float cvt_ub3(unsigned w) { float f; asm("v_cvt_f32_ubyte3 %0, %1" : "=v"(f) : "v"(w)); return f; }

__device__ __forceinline__ float key_val(unsigned k, unsigned mask) { unsigned u = k & ~mask; u = (u & 0x80000000u) ? (u & 0x7fffffffu) : ~u; return __builtin_bit_cast(float, u); }
template <int SKIP>
__device__ __forceinline__ void p11a_topk(Frame& F) {
    LAS float* SCR = (LAS float*)(F.lds + F.wave * 16384);
    LAS unsigned* SL = (LAS unsigned*)SCR;
    LAS int* EIDS = (LAS int*)(SCR + 1024);
    LAS int* OFFS = (LAS int*)(SCR + 2048);
    LAS float* RTS = SCR + 2304;
    LAS int* BC = (LAS int*)(F.lds + 8 * 16384);
    const float* SC = (const float*)(F.ws + WS_SC);
    unsigned char* XQ = F.ws + WS_XQ; float* SXR = (float*)(F.ws + WS_SXR); int* EIDg = (int*)(F.ws + WS_EID); float* GATEg = (float*)(F.ws + WS_GATE); unsigned* REC = (unsigned*)(F.ws + WS_REC);
    for (int blk = F.vcu; blk < SEQ / 64; blk += F.G) {
        __syncthreads();
        if (F.tid < NET) BC[F.tid] = 0;
        __syncthreads();
        const int m0 = blk * 64 + F.wave * 8;
#pragma unroll 2
        for (int ti = 0; ti < 8; ++ti) { const int m = m0 + ti;
            int lane = F.lane; asm volatile("" : "+v"(lane));
            float xh[32]; float ss = 0.f;
            const float* x1 = F.out + (size_t)m * DM + lane * 32; const float* n2 = F.in[I_N2W] + lane * 32;
#pragma unroll
            for (int q = 0; q < 8; ++q) { const f32x4 a = *(const GAS f32x4*)(x1 + 4 * q); xh[4 * q] = a.x; xh[4 * q + 1] = a.y; xh[4 * q + 2] = a.z; xh[4 * q + 3] = a.w; }
#pragma unroll
            for (int e = 0; e < 32; ++e) ss += xh[e] * xh[e];
            const float rt = 1.0f / sqrtf(wave_sum(ss) * (1.f / DM) + EPS);
            float amx = 0.f;
#pragma unroll
            for (int q = 0; q < 8; ++q) { const f32x4 a = *(const GAS f32x4*)(n2 + 4 * q); xh[4 * q] *= rt * a.x; xh[4 * q + 1] *= rt * a.y; xh[4 * q + 2] *= rt * a.z; xh[4 * q + 3] *= rt * a.w; }
#pragma unroll
            for (int e = 0; e < 32; ++e) amx = fmaxf(amx, fabsf(xh[e]));
            amx = wave_max(amx);
            const float sx = amx > 0.f ? amx * (1.0f / 127.0f) : 1.0f, isx = 1.0f / sx;
            unsigned xq[8];
#pragma unroll
            for (int d = 0; d < 8; ++d) { const int a = (int)rintf(xh[4 * d] * isx), b = (int)rintf(xh[4 * d + 1] * isx), c = (int)rintf(xh[4 * d + 2] * isx), e = (int)rintf(xh[4 * d + 3] * isx);
                xq[d] = (unsigned)(a & 255) | ((unsigned)(b & 255) << 8) | ((unsigned)(c & 255) << 16) | ((unsigned)(e & 255) << 24); }
            if (!(SKIP & 2)) { GAS v4u* o = (GAS v4u*)(XQ + ((size_t)lane * SEQ + m) * 32); o[0] = (v4u){xq[0], xq[1], xq[2], xq[3]}; o[1] = (v4u){xq[4], xq[5], xq[6], xq[7]}; }
            if (lane == 0) { SXR[2 * m] = sx; SXR[2 * m + 1] = rt; RTS[ti] = rt; }
        }
#pragma unroll 1
        for (int grp = 0; grp < 2; ++grp) {
            int lane = F.lane; asm volatile("" : "+v"(lane));
            if (!(SKIP & 1)) {
                { const float* src = SC + (size_t)(m0 + grp * 4 + (lane >> 4)) * DM + (lane & 15) * 128;
                  unsigned v[16];
#pragma unroll
                  for (int i = 0; i < 16; ++i) v[i] = 0u;
#pragma unroll 1
                  for (int s8 = 0; s8 < 4; ++s8) { f32x4 a8[8];
#pragma unroll
                      for (int u = 0; u < 8; ++u) a8[u] = *(const GAS f32x4*)(src + 32 * s8 + 4 * u);
#pragma unroll
                      for (int u = 0; u < 8; ++u) { const float av[4] = {a8[u].x, a8[u].y, a8[u].z, a8[u].w};
#pragma unroll
                          for (int e = 0; e < 4; ++e) { unsigned x = (fkey(av[e]) & ~127u) | (unsigned)(32 * s8 + 4 * u + e);
#pragma unroll
                              for (int i = 0; i < 16; ++i) { const unsigned hi = v[i] > x ? v[i] : x; x = v[i] > x ? x : v[i]; v[i] = hi; } } } }
#pragma unroll
                  for (int q = 0; q < 4; ++q) *(LAS v4u*)(SL + lane * 16 + 4 * q) = (v4u){v[4 * q], v[4 * q + 1], v[4 * q + 2], v[4 * q + 3]}; }
                asm volatile("" ::: "memory");
                if (lane < 32) { const int tk = lane >> 3, h = lane & 7, m = m0 + grp * 4 + tk;
                    const LAS unsigned* L1 = SL + (tk * 16 + 2 * h) * 16; const LAS unsigned* L2 = L1 + 16;
                    float f1[16], f2[16];
#pragma unroll
                    for (int q = 0; q < 4; ++q) { const v4u a = *(const LAS v4u*)(L1 + 4 * q), b = *(const LAS v4u*)(L2 + 4 * q);
                        f1[4 * q] = key_val(a.x, 127u); f1[4 * q + 1] = key_val(a.y, 127u); f1[4 * q + 2] = key_val(a.z, 127u); f1[4 * q + 3] = key_val(a.w, 127u);
                        f2[4 * q] = key_val(b.x, 127u); f2[4 * q + 1] = key_val(b.y, 127u); f2[4 * q + 2] = key_val(b.z, 127u); f2[4 * q + 3] = key_val(b.w, 127u); }
                    unsigned c[16];
#pragma unroll
                    for (int i = 0; i < 16; ++i) c[i] = 0u;
#pragma unroll
                    for (int i = 0; i < 16; ++i)
#pragma unroll
                        for (int j = 0; j < 16; ++j) if ((i + 1) * (j + 1) <= 16) { unsigned x = (fkey(f1[i] + f2[j]) & ~255u) | (unsigned)(i * 16 + j);
#pragma unroll
                            for (int r = 0; r < 16; ++r) { const unsigned hi = c[r] > x ? c[r] : x; x = c[r] > x ? x : c[r]; c[r] = hi; } }
                    const float rt = RTS[grp * 4 + tk];
                    float sc[16]; int ee[16]; float mx = -3.0e38f;
#pragma unroll
                    for (int r = 0; r < 16; ++r) { const unsigned ij = c[r] & 255u; const unsigned k1 = L1[ij >> 4], k2 = L2[ij & 15u];
                        sc[r] = key_val(k1, 127u) + key_val(k2, 127u); ee[r] = (int)((k1 & 127u) * 128u + (k2 & 127u)); mx = fmaxf(mx, sc[r]); }
                    float sum = 0.f;
#pragma unroll
                    for (int r = 0; r < 16; ++r) { sc[r] = __expf(rt * (sc[r] - mx)); sum += sc[r]; }
                    const float inv = 1.0f / sum;
#pragma unroll
                    for (int q = 0; q < 4; ++q) { *(LAS v4u*)(EIDS + (grp * 4 + tk) * 128 + h * 16 + 4 * q) = (v4u){(unsigned)ee[4 * q], (unsigned)ee[4 * q + 1], (unsigned)ee[4 * q + 2], (unsigned)ee[4 * q + 3]};
                        if (!(SKIP & 4)) { *(GAS v4u*)(EIDg + (size_t)m * 128 + h * 16 + 4 * q) = (v4u){(unsigned)ee[4 * q], (unsigned)ee[4 * q + 1], (unsigned)ee[4 * q + 2], (unsigned)ee[4 * q + 3]};
                            *(GAS f32x4*)(GATEg + (size_t)m * 128 + h * 16 + 4 * q) = (f32x4){sc[4 * q] * inv, sc[4 * q + 1] * inv, sc[4 * q + 2] * inv, sc[4 * q + 3] * inv}; } }
                }
                asm volatile("" ::: "memory");
            }
        }
#pragma unroll 1
        for (int ti = 0; ti < 8; ++ti) {
            int lane = F.lane; asm volatile("" : "+v"(lane));
            const int tA = (EIDS[ti * 128 + lane] >> 9) & 31, tB = (EIDS[ti * 128 + 64 + lane] >> 9) & 31; int mycnt = 0;
#pragma unroll
            for (int k = 0; k < NET; ++k) { const int c = __popcll(__ballot(tA == k)) + __popcll(__ballot(tB == k)); mycnt = (lane == k) ? c : mycnt; }
            if (lane < NET) OFFS[ti * NET + lane] = __hip_atomic_fetch_add((int*)(BC + lane), mycnt, __ATOMIC_RELAXED, __HIP_MEMORY_SCOPE_WORKGROUP);
        }
        __syncthreads();
        const int tt = blk >> 4;
        if (F.tid < NET) BC[NET + F.tid] = (int)__hip_atomic_fetch_add((unsigned*)(F.ctl + CW_CNT) + (tt * NET + F.tid) * 16, (unsigned)BC[F.tid], __ATOMIC_RELAXED, __HIP_MEMORY_SCOPE_AGENT);
        __syncthreads();
#pragma unroll 1
        for (int ti = 0; ti < 8; ++ti) { const int m = m0 + ti;
            int lane = F.lane; asm volatile("" : "+v"(lane));
            const unsigned long long lt_mask = (1ull << lane) - 1ull;
            const int eA = EIDS[ti * 128 + lane] & 16383, eB = EIDS[ti * 128 + 64 + lane] & 16383, tA = eA >> 9, tB = eB >> 9; int rankA = 0, rankB = 0;
#pragma unroll
            for (int k = 0; k < NET; ++k) { const unsigned long long mA = __ballot(tA == k), mB = __ballot(tB == k);
                rankA = (tA == k) ? __popcll(mA & lt_mask) : rankA; rankB = (tB == k) ? __popcll(mA) + __popcll(mB & lt_mask) : rankB; }
            const unsigned tl = (unsigned)(m & 1023) << 17;
            if (!(SKIP & 4)) { const int s = BC[NET + tA] + OFFS[ti * NET + tA] + rankA; if (s < REC_CAP) REC[(size_t)(tt * NET + tA) * REC_CAP + s] = tl | ((unsigned)(eA & 511) << 7) | (unsigned)lane; }
            if (!(SKIP & 4)) { const int s = BC[NET + tB] + OFFS[ti * NET + tB] + rankB; if (s < REC_CAP) REC[(size_t)(tt * NET + tB) * REC_CAP + s] = tl | ((unsigned)(eB & 511) << 7) | (unsigned)(lane + 64); }
        }
    }
}

constexpr int NSLOT = 12, UPITCH = 80;
__device__ __forceinline__ void p11b_udot(Frame& F) {
    LAS unsigned char* XS = (LAS unsigned char*)F.lds;
    LAS unsigned char* US = XS + 1024 * UPITCH;
    LAS int* QB = (LAS int*)(F.lds + 124 * 1024);
    const int tid = F.tid;
    const unsigned char* XQ = F.ws + WS_XQ; const unsigned char* TU = F.ws + WS_TU; const unsigned* REC = (const unsigned*)(F.ws + WS_REC);
    const float* SXR = (const float*)(F.ws + WS_SXR); const float* GATEg = (const float*)(F.ws + WS_GATE); float* AVg = (float*)(F.ws + WS_AV);
    const float* SU = (const float*)(F.ws + WS_PSC); const float* SV = SU + 16384;
    for (;;) {
        __syncthreads();
        if (tid == 0) QB[0] = (int)__hip_atomic_fetch_add((unsigned*)(F.ctl + CW_Q), 1u, __ATOMIC_RELAXED, __HIP_MEMORY_SCOPE_AGENT);
        __syncthreads();
        const int b = QB[0];
        if (b >= NBUCK) break;
        const int tt = b >> 5, et = b & 31;
        int n = (int)__hip_atomic_load((unsigned*)(F.ctl + CW_CNT) + b * 16, __ATOMIC_RELAXED, __HIP_MEMORY_SCOPE_AGENT); n = n < REC_CAP ? n : REC_CAP;
        for (int g0 = 0; g0 < n; g0 += NSLOT * NTHR) {
            const int npass = (n - g0) < NSLOT * NTHR ? (n - g0) : NSLOT * NTHR;
            unsigned rec[NSLOT]; int acc[NSLOT];
#pragma unroll
            for (int j = 0; j < NSLOT; ++j) { const int idx = g0 + j * NTHR + tid; const unsigned r = idx < n ? REC[(size_t)b * REC_CAP + idx] : 0xffffffffu; acc[j] = 0;
                rec[j] = ((r >> 17) & 1023u) | (((r >> 7) & 511u) << 16); }
            v4u st[12];
#define P11B_SRC(step, i) (((i) % 6) < 4 ? XQ + ((size_t)(2 * (step) + (i) / 6) * SEQ + tt * 1024) * 32 + (size_t)(tid + 512 * ((i) % 6)) * 16 : TU + ((size_t)(2 * (step) + (i) / 6) * 16384 + et * ETSZ) * 32 + (size_t)(tid + 512 * (((i) % 6) - 4)) * 16)
#pragma unroll
            for (int i = 0; i < 12; ++i) st[i] = *(const GAS v4u*)P11B_SRC(0, i);
#pragma unroll 1
            for (int c = 0; c < 32; ++c) {
                __syncthreads();
#pragma unroll
                for (int i = 0; i < 12; ++i) { const int q = i % 6, hc = i / 6, p = (q < 4) ? tid + 512 * q : tid + 512 * (q - 4); *(LAS v4u*)((q < 4 ? XS : US) + (p >> 1) * UPITCH + hc * 32 + (p & 1) * 16) = st[i]; }
                __syncthreads();
                if (c + 1 < 32) {
#pragma unroll
                    for (int i = 0; i < 12; ++i) st[i] = *(const GAS v4u*)P11B_SRC(c + 1, i);
                }
#pragma unroll
                for (int j0 = 0; j0 < NSLOT; j0 += 2) {
                    if (j0 * NTHR < npass) {
                        v4u xb[2][4], ub[2][4];
#pragma unroll
                        for (int q = 0; q < 2; ++q) { unsigned r = rec[j0 + q]; asm volatile("" : "+v"(r));
                            const unsigned xo = (r & 0xffffu) * UPITCH, uo = (r >> 16) * UPITCH;
#pragma unroll
                            for (int hh = 0; hh < 4; ++hh) { xb[q][hh] = *(const LAS v4u*)(XS + xo + 16 * hh); ub[q][hh] = *(const LAS v4u*)(US + uo + 16 * hh); } }
                        __builtin_amdgcn_sched_barrier(0);
#pragma unroll
                        for (int q = 0; q < 2; ++q) { int s = acc[j0 + q];
#pragma unroll
                            for (int hh = 0; hh < 4; ++hh) { const v4u u = ub[q][hh], x = xb[q][hh];
                                s = __builtin_amdgcn_sdot4((int)u.x, (int)x.x, s, false); s = __builtin_amdgcn_sdot4((int)u.y, (int)x.y, s, false); s = __builtin_amdgcn_sdot4((int)u.z, (int)x.z, s, false); s = __builtin_amdgcn_sdot4((int)u.w, (int)x.w, s, false); }
                            acc[j0 + q] = s; }
                        __builtin_amdgcn_sched_barrier(0);
                    }
                }
            }
#undef P11B_SRC
#pragma unroll
            for (int j = 0; j < NSLOT; ++j) { const int idx = g0 + j * NTHR + tid; const unsigned r = idx < n ? REC[(size_t)b * REC_CAP + idx] : 0xffffffffu;
                if (r != 0xffffffffu) { const int t = tt * 1024 + (int)((r >> 17) & 1023), e = et * ETSZ + (int)((r >> 7) & 511), j7 = (int)(r & 127);
                    const float hv = (float)acc[j] * SU[e] * SXR[2 * t]; AVg[(size_t)t * 128 + j7] = gelu_erf(hv) * GATEg[(size_t)t * 128 + j7] * SV[e]; } }
        }
    }
}

__device__ __forceinline__ void p11c_vsum(Frame& F) {
    const int gw = F.vcu * NWAVES + F.wave, NGW = F.G * NWAVES;
    LAS int* EID = (LAS int*)(F.lds + F.wave * 16384); LAS float* AV = (LAS float*)(EID + 128);
    const unsigned char* TV = F.ws + WS_TV; const int* EIDg = (const int*)(F.ws + WS_EID); const float* AVg = (const float*)(F.ws + WS_AV);
    for (int m = gw; m < SEQ; m += NGW) {
        int lane = F.lane; asm volatile("" : "+v"(lane));
        const int lo16 = lane * 16;
        EID[lane] = EIDg[(size_t)m * 128 + lane]; EID[lane + 64] = EIDg[(size_t)m * 128 + 64 + lane]; AV[lane] = AVg[(size_t)m * 128 + lane]; AV[lane + 64] = AVg[(size_t)m * 128 + 64 + lane];
        asm volatile("" ::: "memory");
        float y[32]; float sas = 0.f;
#pragma unroll
        for (int e = 0; e < 32; ++e) y[e] = 0.f;
        v4u rv[2][4][2]; float av[2][4];
#define P11C_LOAD(buf, g) do { _Pragma("unroll") for (int q = 0; q < 4; ++q) { const int e = __builtin_amdgcn_readfirstlane(EID[(g) + q]); av[buf][q] = AV[(g) + q]; const unsigned char* rp = TV + (size_t)e * DM + lo16; \
            rv[buf][q][0] = *(const GAS v4u*)(rp); rv[buf][q][1] = *(const GAS v4u*)(rp + 1024); } } while (0)
#define P11C_ACC(buf) do { _Pragma("unroll") for (int q = 0; q < 4; ++q) { const float a = av[buf][q]; sas += a; \
            _Pragma("unroll") for (int j = 0; j < 2; ++j) { const v4u r = rv[buf][q][j]; const unsigned wv[4] = {r.x, r.y, r.z, r.w}; \
                _Pragma("unroll") for (int dd = 0; dd < 4; ++dd) { y[16 * j + 4 * dd] += a * cvt_ub0(wv[dd]); y[16 * j + 4 * dd + 1] += a * cvt_ub1(wv[dd]); y[16 * j + 4 * dd + 2] += a * cvt_ub2(wv[dd]); y[16 * j + 4 * dd + 3] += a * cvt_ub3(wv[dd]); } } \
            __builtin_amdgcn_sched_barrier(0); } } while (0)
        P11C_LOAD(0, 0);
#pragma unroll 1
        for (int g = 0; g < 128; g += 8) {
            P11C_LOAD(1, g + 4);
            P11C_ACC(0);
            if (g + 8 < 128) P11C_LOAD(0, g + 8);
            P11C_ACC(1);
        }
#undef P11C_LOAD
#undef P11C_ACC
        const float* x1 = F.out + (size_t)m * DM;
        float s2 = 0.f; const float corr = 128.0f * sas;
#pragma unroll
        for (int j = 0; j < 2; ++j)
#pragma unroll
            for (int q = 0; q < 4; ++q) { const f32x4 a = *(const GAS f32x4*)(x1 + j * 1024 + lo16 + 4 * q);
                y[16 * j + 4 * q] += a.x - corr; y[16 * j + 4 * q + 1] += a.y - corr; y[16 * j + 4 * q + 2] += a.z - corr; y[16 * j + 4 * q + 3] += a.w - corr; }
#pragma unroll
        for (int e = 0; e < 32; ++e) s2 += y[e] * y[e];
        const float ro = 1.0f / sqrtf(wave_sum(s2) * (1.f / DM) + EPS);
        float* orow = F.out + (size_t)m * DM;
#pragma unroll
        for (int j = 0; j < 2; ++j)
#pragma unroll
            for (int q = 0; q < 4; ++q) { const f32x4 a = *(const GAS f32x4*)(F.in[I_FNW] + j * 1024 + lo16 + 4 * q);
                *(GAS f32x4*)(orow + j * 1024 + lo16 + 4 * q) = (f32x4){y[16 * j + 4 * q] * ro * a.x, y[16 * j + 4 * q + 1] * ro * a.y, y[16 * j + 4 * q + 2] * ro * a.z, y[16 * j + 4 * q + 3] * ro * a.w}; }
    }
}
#ifndef MK_N_LAUNCHES
#define MK_N_LAUNCHES 1
#endif
constexpr int N_PHASES = 14;
constexpr int N_LAUNCHES = MK_N_LAUNCHES;
static_assert(N_LAUNCHES == 1 || N_LAUNCHES == N_PHASES, "MK_N_LAUNCHES is 1 or N_PHASES");
#ifndef PG8_SP2
#define PG8_SP2 true
#endif
#ifndef PG8_ALIGN
#define PG8_ALIGN true
#endif
struct Args { const float* in[19]; float* out; unsigned char* ws; int ph_lo, ph_hi; };
__global__ void __launch_bounds__(NTHR, 2) fwd_kernel(Args args) {
    extern __shared__ __attribute__((aligned(16))) unsigned char lds[];
    Frame F;
    F.lds = (LAS unsigned char*)lds;
    F.MISC = (volatile LAS unsigned*)(F.lds + MISC_OFF);
    F.tid = threadIdx.x; F.lane = F.tid & 63; F.wave = __builtin_amdgcn_readfirstlane(F.tid >> 6);
    F.G = gridDim.x; { const int bx = blockIdx.x; F.vcu = (F.G % 8 == 0) ? (bx % 8) * (F.G / 8) + bx / 8 : bx; }
    F.ws = args.ws; F.out = args.out; F.ctl = (gu32*)(args.ws + WS_CTL);
#pragma unroll
    for (int i = 0; i < 19; ++i) F.in[i] = args.in[i];
    for (int u = F.tid; u < (LDS_BYTES - MISC_OFF) / 4; u += NTHR) ((LAS unsigned*)(F.lds + MISC_OFF))[u] = 0u;
    __syncthreads();
    XcdBarrier bar; bar.bar = (unsigned*)(F.ctl + CW_BAR); bar.x = 0; bar.st = nullptr;
    if (N_LAUNCHES == 1) bar = xcd_barrier_post((unsigned*)(F.ctl + CW_BAR), F.MISC + 8);
    const int lo = args.ph_lo, hi = args.ph_hi;
#ifdef ONLY_PHASE
#define IN(k) ((k) == ONLY_PHASE && lo <= (k) && (k) < hi)
#else
#define IN(k) (lo <= (k) && (k) < hi)
#endif
#define SEAM(k) do { if (IN(k) && IN((k) + 1)) xcd_barrier(bar); } while (0)
#ifndef REPEAT_MASK
#define REPEAT_MASK 0
#endif
#ifndef P11A_SKIP
#define P11A_SKIP 0
#endif
#define REPS(k) for (int rep_ = 0; rep_ < (((REPEAT_MASK) >> (k)) & 1) + 1; ++rep_)
#define RSEAM(k) do { if ((((REPEAT_MASK) >> (k)) & 1) && rep_ == 0) xcd_barrier(bar); } while (0)
    unsigned char* ws = args.ws;
    if (IN(0)) { REPS(0) { p0_prologue(F); RSEAM(0); } SEAM(0); }
    if (IN(1)) {
        pg8::Gemm g{(const bf16*)(ws + WS_XN), (const bf16*)(ws + WS_W1), SEQ, N1, DM}; pg8::StaticOrder S; S.init(SEQ, N1, F.G, (int)blockIdx.x);
        EpiG1 E{ws, F.in[I_LB]};
        if ((REPEAT_MASK >> 1) & 1) { pg8::gemm_phase<EpiG1, pg8::StaticOrder, PG8_ALIGN, PG8_SP2>(F.lds, g, S, E); xcd_barrier(bar); }
        pg8::gemm_phase<EpiG1, pg8::StaticOrder, PG8_ALIGN, PG8_SP2>(F.lds, g, S, E);
        p1_ab(F);
        SEAM(1);
    }
#ifdef EXTRA_BARRIERS
    for (int eb = 0; eb < EXTRA_BARRIERS; ++eb) xcd_barrier(bar);
#endif
    if (IN(2)) { REPS(2) { hgrn_pass<false>(F); RSEAM(2); } SEAM(2); }
    if (IN(3)) { if ((REPEAT_MASK >> 3) & 1) { hgrn_pass<true, P11A_SKIP>(F); xcd_barrier(bar); } hgrn_pass<true>(F); SEAM(3); }
    if (IN(4)) { if ((REPEAT_MASK >> 4) & 1) { gdn_prep<P11A_SKIP>(F); xcd_barrier(bar); } gdn_prep<0>(F); SEAM(4); }
    if (IN(5)) { if ((REPEAT_MASK >> 5) & 1) { gdn_pass<false, P11A_SKIP>(F); xcd_barrier(bar); } gdn_pass<false>(F); SEAM(5); }
    if (IN(6)) { if ((REPEAT_MASK >> 6) & 1) { gdn_pass<true, P11A_SKIP>(F); xcd_barrier(bar); } gdn_pass<true>(F); SEAM(6); }
    if (IN(7)) { REPS(7) { p7_mix(F); RSEAM(7); } SEAM(7); }
    if (IN(8)) {
        pg8::StaticOrder S; S.init(SEQ, DM, F.G, (int)blockIdx.x);
        bf16* GT = (bf16*)(ws + WS_GT); bf16* GT2 = (bf16*)(ws + WS_GT2);
#define P8_BODY \
        { pg8::Gemm g{(const bf16*)(ws + WS_XN), (const bf16*)(ws + WS_WG), SEQ, DM, DM}; EpiGate E{GT}; pg8::gemm_phase<EpiGate, pg8::StaticOrder, PG8_ALIGN, PG8_SP2>(F.lds, g, S, E); } \
        __builtin_amdgcn_fence(__ATOMIC_ACQUIRE, "agent"); VM_WAIT(); __syncthreads(); \
        { pg8::Gemm g{(const bf16*)(ws + WS_YA), (const bf16*)(ws + WS_WPA), SEQ, DM, HW}; EpiMix<0> E{GT, nullptr}; pg8::gemm_phase<EpiMix<0>, pg8::StaticOrder, PG8_ALIGN, PG8_SP2>(F.lds, g, S, E); } \
        { pg8::Gemm g{(const bf16*)(ws + WS_XN), (const bf16*)(ws + WS_WG) + (size_t)DM * DM, SEQ, DM, DM}; EpiGate E{GT2}; pg8::gemm_phase<EpiGate, pg8::StaticOrder, PG8_ALIGN, PG8_SP2>(F.lds, g, S, E); } \
        __builtin_amdgcn_fence(__ATOMIC_ACQUIRE, "agent"); VM_WAIT(); __syncthreads(); \
        { pg8::Gemm g{(const bf16*)(ws + WS_YB), (const bf16*)(ws + WS_WPB), SEQ, DM, HW}; EpiMix<1> E{GT, GT2}; pg8::gemm_phase<EpiMix<1>, pg8::StaticOrder, PG8_ALIGN, PG8_SP2>(F.lds, g, S, E); }
        if ((REPEAT_MASK >> 8) & 1) { P8_BODY xcd_barrier(bar); }
        P8_BODY
#undef P8_BODY
        SEAM(8);
    }
    if (IN(9)) {
        pg8::Gemm g{(const bf16*)(ws + WS_GT), (const bf16*)(ws + WS_WOUT), SEQ, DM, DM}; pg8::StaticOrder S; S.init(SEQ, DM, F.G, (int)blockIdx.x);
        EpiX1 E{F.in[I_X], F.out, (bf16*)(ws + WS_X1B)};
        if ((REPEAT_MASK >> 9) & 1) { pg8::gemm_phase<EpiX1, pg8::StaticOrder, PG8_ALIGN, PG8_SP2>(F.lds, g, S, E); xcd_barrier(bar); }
        pg8::gemm_phase<EpiX1, pg8::StaticOrder, PG8_ALIGN, PG8_SP2>(F.lds, g, S, E);
        SEAM(9);
    }
    if (IN(10)) {
        pg8::Gemm g{(const bf16*)(ws + WS_X1B), (const bf16*)(ws + WS_WS), SEQ, DM, DM}; pg8::StaticOrder S; S.init(SEQ, DM, F.G, (int)blockIdx.x);
        EpiF32 E{(float*)(ws + WS_SC)};
        if ((REPEAT_MASK >> 10) & 1) { pg8::gemm_phase<EpiF32, pg8::StaticOrder, PG8_ALIGN, PG8_SP2>(F.lds, g, S, E); xcd_barrier(bar); }
        pg8::gemm_phase<EpiF32, pg8::StaticOrder, PG8_ALIGN, PG8_SP2>(F.lds, g, S, E);
        SEAM(10);
    }
    if (IN(11)) {
        if ((REPEAT_MASK >> 11) & 1) { p11a_topk<P11A_SKIP>(F); xcd_barrier(bar); if (blockIdx.x == 0) for (int i = F.tid; i < NBUCK + 1; i += NTHR) __hip_atomic_store((unsigned*)(F.ctl + CW_CNT) + i * 16, 0u, __ATOMIC_RELAXED, __HIP_MEMORY_SCOPE_AGENT); xcd_barrier(bar); }
        p11a_topk<0>(F); SEAM(11); }
    if (IN(12)) { if ((REPEAT_MASK >> 12) & 1) { p11b_udot(F); xcd_barrier(bar); if (blockIdx.x == 0 && F.tid == 0) __hip_atomic_store((unsigned*)(F.ctl + CW_Q), 0u, __ATOMIC_RELAXED, __HIP_MEMORY_SCOPE_AGENT); xcd_barrier(bar); } p11b_udot(F); SEAM(12); }
    if (IN(13)) { p11c_vsum(F); }
#undef IN
#undef SEAM
}


#ifdef PROBE
__global__ void digest_kernel(const unsigned* ws, float* out) {
    const size_t n = (size_t)SEQ * DM;
    for (size_t i = (size_t)blockIdx.x * blockDim.x + threadIdx.x; i < n; i += (size_t)gridDim.x * blockDim.x) {
        unsigned acc = (PROBE >= 9) ? __builtin_bit_cast(unsigned, out[i]) : 0u;
        const size_t offs[5] = {0, 128 * MiB / 4, 256 * MiB / 4, 384 * MiB / 4, 408 * MiB / 4};
#pragma unroll
        for (int r = 0; r < 5; ++r) acc = acc * 1664525u + ws[offs[r] + i];
        out[i] = (float)(acc >> 8) * (1.0f / 16777216.0f);
    }
}
#endif
extern "C" void kernel_launch(void* const* d_in, const int* in_sizes, int n_in, void* d_out, int out_size, void* d_ws, size_t ws_size, hipStream_t stream) {
    static int grid = 0;
    if (grid == 0) {
        if (n_in != 19 || in_sizes[0] != SEQ * DM || out_size != SEQ * DM || ws_size < WS_END) { fprintf(stderr, "kernel_launch: unexpected shapes (n_in %d, in0 %d, out %d, ws %zu; need ws >= %zu)\n", n_in, n_in > 0 ? in_sizes[0] : -1, out_size, ws_size, (size_t)WS_END); grid = -1; return; }
        int dev = 0, cus = 0, per_cu = 0;
        if (hipGetDevice(&dev) != hipSuccess || hipDeviceGetAttribute(&cus, hipDeviceAttributeMultiprocessorCount, dev) != hipSuccess) { grid = -1; return; }
        if (hipFuncSetAttribute((const void*)fwd_kernel, hipFuncAttributeMaxDynamicSharedMemorySize, LDS_BYTES) != hipSuccess) { fprintf(stderr, "kernel_launch: hipFuncSetAttribute failed\n"); grid = -1; return; }
        if (hipOccupancyMaxActiveBlocksPerMultiprocessor(&per_cu, (const void*)fwd_kernel, NTHR, LDS_BYTES) != hipSuccess || per_cu < 1) fprintf(stderr, "kernel_launch: occupancy query reports %d\n", per_cu);
        (void)hipGetLastError();
        grid = cus;
    }
    if (grid < 0) return;
    (void)hipMemsetAsync((char*)d_ws + WS_CTL, 0, CTL_ZERO_BYTES, stream);
    Args a{};
    for (int i = 0; i < 19; ++i) a.in[i] = (const float*)d_in[i];
    a.out = (float*)d_out; a.ws = (unsigned char*)d_ws;
    for (int li = 0; li < N_LAUNCHES; ++li) {
        a.ph_lo = (N_LAUNCHES == 1) ? 0 : li; a.ph_hi = (N_LAUNCHES == 1) ? N_PHASES : li + 1;
#ifdef PROBE
        if (li > PROBE) break;
#endif
        hipLaunchKernelGGL(fwd_kernel, dim3(grid), dim3(NTHR), LDS_BYTES, stream, a);
    }
#ifdef PROBE
    hipLaunchKernelGGL(digest_kernel, dim3(2048), dim3(256), 0, stream, (const unsigned*)d_ws, (float*)d_out);
#endif
}
```

```cpp
#include <hip/hip_runtime.h>
#include <cstdio>
#include <cstdint>
#define GAS __attribute__((address_space(1)))
#define LAS __attribute__((address_space(3)))
#define MK_N_LAUNCHES 1
namespace pg8 {
#define PG8_LAS __attribute__((address_space(3)))
typedef unsigned short bf16_t;
typedef short bf16x8 __attribute__((ext_vector_type(8)));
typedef float f32x4 __attribute__((ext_vector_type(4)));
typedef unsigned u32x4 __attribute__((ext_vector_type(4)));
constexpr int BM = 256, BK = 64, HALF = 128, HTB = HALF * BK * 2  , STAGE_BYTES = 8 * HTB, NXCD = 8, WGM = 8;

__host__ __device__ __forceinline__ int lds_byte(int r, int c) { const int st = (r >> 4) * 2 + (c >> 5), rr = r & 15, cc = c & 31, ob = rr * 64 + cc * 2; return st * 1024 + (ob ^ (((ob >> 9) & 1) << 5)); }
__host__ __device__ __forceinline__ void stage_rc(int b, int& R, int& C) { const int st = b / 1024, sb = b % 1024, swz = sb ^ (((sb >> 9) & 1) << 5); R = (st >> 1) * 16 + swz / 64; C = (st & 1) * 32 + (swz % 64) / 2; }
__host__ __device__ __forceinline__ int perm32(int rho) { const int n = rho >> 4, i = rho & 15; return 8 * (i >> 2) + 4 * n + (i & 3); }

struct Unit { int pm, pn; };
struct Gemm { const bf16_t* A; const bf16_t* Bt; int M, N, K; };

struct StaticOrder {
    int nM, nN, nwg, G, c;
    __host__ __device__ void init(int M, int N, int G_, int c_) { nM = M / BM; nN = N / BM; nwg = nM * nN; G = G_; c = c_; }
    __host__ __device__ bool next(int i, Unit& u) const {
        const long L = (long)i * G + c; if (L >= nwg) return false;
        int wgid = (int)L; { const int q = nwg / NXCD, r = nwg % NXCD, xcd = wgid % NXCD, off = wgid / NXCD; wgid = (xcd < r ? xcd * (q + 1) : r * (q + 1) + (xcd - r) * q) + off; }
        const int nig = WGM * nN, gid = wgid / nig, fm = gid * WGM, gsz = (nM - fm) < WGM ? (nM - fm) : WGM;
        u.pm = fm + ((wgid % nig) % gsz); u.pn = (wgid % nig) / gsz; return true;
    }
    __device__ __forceinline__ void a_ready(const Unit&) const {}
    __device__ __forceinline__ void done(const Unit&) const {}
};

__device__ __forceinline__ unsigned cvt_pk_bf16(float lo, float hi) { unsigned r; asm volatile("v_cvt_pk_bf16_f32 %0, %1, %2" : "=v"(r) : "v"(lo), "v"(hi)); return r; }
typedef float f32x2 __attribute__((ext_vector_type(2)));
__device__ __forceinline__ f32x2 gelu_pk(f32x2 v) {
    const f32x2 av = __builtin_elementwise_abs(v), d = av * 0.2316418882f + 1.0f;
    f32x2 t; t.x = __builtin_amdgcn_rcpf(d.x); t.y = __builtin_amdgcn_rcpf(d.y);
    f32x2 q = t * 0.5307027145f + (-0.7265760135f); q = q * t + 0.7107068705f; q = q * t + (-0.142248368f); q = q * t + 0.127414796f; q = q * t;
    const f32x2 s = (v * v) * (-0.72134752044f);
    f32x2 e; e.x = __builtin_amdgcn_exp2f(s.x); e.y = __builtin_amdgcn_exp2f(s.y);
    const f32x2 m = v * (q * e), r = v - m;
    f32x2 o; o.x = v.x < 0.f ? m.x : r.x; o.y = v.y < 0.f ? m.y : r.y; return o;
}

template <class Epi, class Sched, bool ALIGN_EPI = false, bool SP2 = false>
__device__ __forceinline__ void gemm_phase(PG8_LAS unsigned char* lds, const Gemm g, const Sched& S, const Epi& E) {
    const int tid = threadIdx.x, wid = __builtin_amdgcn_readfirstlane(tid >> 6), lane = tid & 63, wr = wid >> 2, wc = wid & 3, fr = lane & 15, fq = lane >> 4;
    const int K = g.K, nt = K / BK;
    unsigned voffA[2], voffB[2];
#pragma unroll
    for (int i = 0; i < 2; ++i) { int R, C; stage_rc(tid * 16 + i * 8192, R, C); const int Rb = Epi::PERM ? ((R & ~31) + perm32(R & 31)) : R;
        voffA[i] = (unsigned)(R * K + C) * 2u; voffB[i] = (unsigned)(Rb * K + C) * 2u; }
    const size_t kstep = (size_t)(BK * 2);
    const size_t hstep = (size_t)HALF * K * 2;
    const size_t tstep = 2 * hstep;
    const unsigned ldsw = (unsigned)wid * 1024u;
    const int aoff = lds_byte(wr * 64 + fr, fq * 8), boff = lds_byte(wc * 32 + fr, fq * 8);
#define PG8_SA(b, h) (((b) * 2 + (h)) * HTB)
#define PG8_SB(b, h) ((4 + (b) * 2 + (h)) * HTB)
#define PG8_STAGE(bufoff, gbase, voff) do { _Pragma("unroll") for (int _i = 0; _i < 2; ++_i) \
        __builtin_amdgcn_global_load_lds((const unsigned*)((const char*)(gbase) + (voff)[_i]), (PG8_LAS unsigned*)(lds + (bufoff) + ldsw + _i * 8192), 16, 0, 0); } while (0)
#define PG8_LDA(dst, b, h) do { _Pragma("unroll") for (int m = 0; m < 4; ++m) _Pragma("unroll") for (int k = 0; k < 2; ++k) dst[m][k] = *(const PG8_LAS bf16x8*)(lds + PG8_SA(b, h) + aoff + m * 2048 + k * 1024); } while (0)
#define PG8_LDB(dst, b, h) do { _Pragma("unroll") for (int n = 0; n < 2; ++n) _Pragma("unroll") for (int k = 0; k < 2; ++k) dst[n][k] = *(const PG8_LAS bf16x8*)(lds + PG8_SB(b, h) + boff + n * 2048 + k * 1024); } while (0)
#define PG8_MMA(ai, bj, At, Bt) do { __builtin_amdgcn_s_setprio(1); _Pragma("unroll") for (int m = 0; m < 4; ++m) _Pragma("unroll") for (int n = 0; n < 2; ++n) _Pragma("unroll") for (int k = 0; k < 2; ++k) \
        acc[ai][bj][m][n] = __builtin_amdgcn_mfma_f32_16x16x32_bf16(Bt[n][k], At[m][k], acc[ai][bj][m][n], 0, 0, 0); __builtin_amdgcn_s_setprio(0); } while (0)
#define PG8_WAIT_V(n) asm volatile("s_waitcnt vmcnt(" #n ")" ::: "memory")
#define PG8_WAIT_L(n) asm volatile("s_waitcnt lgkmcnt(" #n ")" ::: "memory")
#define PG8_BAR __builtin_amdgcn_s_barrier()
#define PG8_SCHED __builtin_amdgcn_sched_barrier(0)
    Unit cur, nxt; int ui = 0;
    if (!S.next(0, cur)) return;
    f32x4 acc[2][2][4][2];
#pragma unroll
    for (int a = 0; a < 2; ++a)
#pragma unroll
        for (int b = 0; b < 2; ++b)
#pragma unroll
            for (int m = 0; m < 4; ++m)
#pragma unroll
                for (int n = 0; n < 2; ++n) acc[a][b][m][n] = (f32x4){0.f, 0.f, 0.f, 0.f};
    bf16x8 At[4][2], B0[2][2], B1[2][2];
    const char* cA = (const char*)g.A + (size_t)cur.pm * tstep; const char* cB = (const char*)g.Bt + (size_t)cur.pn * tstep;
    S.a_ready(cur);
    if constexpr (SP2) {
        PG8_STAGE(PG8_SB(0, 0), cB, voffB); PG8_STAGE(PG8_SB(0, 1), cB + hstep, voffB); PG8_STAGE(PG8_SA(0, 0), cA, voffA); PG8_STAGE(PG8_SA(0, 1), cA + hstep, voffA);
        if (wr == 1) PG8_BAR;
        PG8_WAIT_V(2); PG8_BAR;
        PG8_STAGE(PG8_SB(1, 0), cB + kstep, voffB); PG8_STAGE(PG8_SA(1, 0), cA + kstep, voffA); PG8_STAGE(PG8_SB(1, 1), cB + hstep + kstep, voffB);
        PG8_WAIT_V(6); PG8_BAR;
    } else {
        PG8_STAGE(PG8_SB(0, 0), cB, voffB); PG8_STAGE(PG8_SA(0, 0), cA, voffA); PG8_STAGE(PG8_SB(0, 1), cB + hstep, voffB); PG8_STAGE(PG8_SA(0, 1), cA + hstep, voffA);
        if (wr == 1) PG8_BAR;
        PG8_WAIT_V(4); PG8_BAR;
        PG8_STAGE(PG8_SB(1, 0), cB + kstep, voffB); PG8_STAGE(PG8_SA(1, 0), cA + kstep, voffA); PG8_STAGE(PG8_SB(1, 1), cB + hstep + kstep, voffB);
        PG8_WAIT_V(6); PG8_BAR;
    }
    for (;;) {
        const bool has_next = S.next(ui + 1, nxt);
        const char* nA = has_next ? (const char*)g.A + (size_t)nxt.pm * tstep : cA; const char* nB = has_next ? (const char*)g.Bt + (size_t)nxt.pn * tstep : cB;
        for (int t = 0; t < nt; t += 2) {
            const bool last = (t == nt - 2);
            const char* a1 = cA + (size_t)(t + 1) * kstep;
            const char* a2 = last ? nA : cA + (size_t)(t + 2) * kstep; const char* b2 = last ? nB : cB + (size_t)(t + 2) * kstep;
            const char* a3 = a2 + kstep; const char* b3 = b2 + kstep;
            if (last && has_next) S.a_ready(nxt);
            if constexpr (SP2) {
            PG8_LDB(B0, 0, 0); PG8_LDB(B1, 0, 1); PG8_SCHED; PG8_LDA(At, 0, 0); PG8_STAGE(PG8_SA(1, 1), a1 + hstep, voffA);
            PG8_WAIT_V(8); PG8_WAIT_L(0); PG8_BAR; PG8_MMA(0, 0, At, B0); PG8_MMA(0, 1, At, B1); PG8_BAR; PG8_SCHED;
            PG8_LDA(At, 0, 1); PG8_STAGE(PG8_SB(0, 0), b2, voffB); PG8_STAGE(PG8_SB(0, 1), b2 + hstep, voffB); PG8_STAGE(PG8_SA(0, 0), a2, voffA);
            PG8_WAIT_V(8); PG8_WAIT_L(0); PG8_BAR; PG8_MMA(1, 0, At, B0); PG8_MMA(1, 1, At, B1); PG8_BAR; PG8_SCHED;
            PG8_LDB(B0, 1, 0); PG8_LDB(B1, 1, 1); PG8_SCHED; PG8_LDA(At, 1, 0); PG8_STAGE(PG8_SA(0, 1), a2 + hstep, voffA);
            PG8_WAIT_V(8); PG8_WAIT_L(0); PG8_BAR; PG8_MMA(0, 0, At, B0); PG8_MMA(0, 1, At, B1); PG8_BAR; PG8_SCHED;
            PG8_LDA(At, 1, 1); PG8_STAGE(PG8_SB(1, 0), b3, voffB); PG8_STAGE(PG8_SB(1, 1), b3 + hstep, voffB); PG8_STAGE(PG8_SA(1, 0), a3, voffA);
            PG8_WAIT_V(8); PG8_WAIT_L(0); PG8_BAR; PG8_MMA(1, 0, At, B0); PG8_MMA(1, 1, At, B1); PG8_BAR; PG8_SCHED;
            } else {
            PG8_LDB(B0, 0, 0); PG8_SCHED; PG8_LDA(At, 0, 0); PG8_STAGE(PG8_SA(1, 1), a1 + hstep, voffA);
            PG8_WAIT_L(8); PG8_BAR; PG8_WAIT_L(0); PG8_MMA(0, 0, At, B0); PG8_BAR; PG8_SCHED;
            PG8_LDB(B1, 0, 1); PG8_STAGE(PG8_SB(0, 0), b2, voffB);
            PG8_BAR; PG8_WAIT_L(0); PG8_MMA(0, 1, At, B1); PG8_BAR;
            PG8_LDA(At, 0, 1); PG8_STAGE(PG8_SA(0, 0), a2, voffA);
            PG8_BAR; PG8_WAIT_L(0); PG8_MMA(1, 0, At, B0); PG8_BAR; PG8_SCHED;
            PG8_STAGE(PG8_SB(0, 1), b2 + hstep, voffB);
            PG8_WAIT_V(6); PG8_BAR; PG8_MMA(1, 1, At, B1); PG8_BAR;
            PG8_LDB(B0, 1, 0); PG8_SCHED; PG8_LDA(At, 1, 0); PG8_STAGE(PG8_SA(0, 1), a2 + hstep, voffA);
            PG8_WAIT_L(8); PG8_BAR; PG8_WAIT_L(0); PG8_MMA(0, 0, At, B0); PG8_BAR; PG8_SCHED;
            PG8_LDB(B1, 1, 1); PG8_STAGE(PG8_SB(1, 0), b3, voffB);
            PG8_BAR; PG8_WAIT_L(0); PG8_MMA(0, 1, At, B1); PG8_BAR;
            PG8_LDA(At, 1, 1); PG8_STAGE(PG8_SA(1, 0), a3, voffA);
            PG8_BAR; PG8_WAIT_L(0); PG8_MMA(1, 0, At, B0); PG8_BAR; PG8_SCHED;
            PG8_STAGE(PG8_SB(1, 1), b3 + hstep, voffB);
            PG8_WAIT_V(6); PG8_BAR; PG8_MMA(1, 1, At, B1); PG8_BAR;
            }
        }
        if constexpr (ALIGN_EPI) { if (wr == 0) PG8_BAR; }
        if constexpr (!Epi::AFTER_DRAIN) { E(acc, cur, wr, wc, fr, fq); S.done(cur); }
        if (!has_next) break;
#pragma unroll
        for (int a = 0; a < 2; ++a)
#pragma unroll
            for (int b = 0; b < 2; ++b)
#pragma unroll
                for (int m = 0; m < 4; ++m)
#pragma unroll
                    for (int n = 0; n < 2; ++n) acc[a][b][m][n] = (f32x4){0.f, 0.f, 0.f, 0.f};
        cur = nxt; cA = nA; cB = nB; ++ui;
        if constexpr (ALIGN_EPI) { if (wr == 1) PG8_BAR; }
    }
    PG8_WAIT_V(0);
    if constexpr (!ALIGN_EPI) { if (wr == 0) PG8_BAR; }
    PG8_BAR;
    if constexpr (Epi::AFTER_DRAIN) { E.fused(acc, cur, wr, wc, fr, fq, lds, wid, lane); S.done(cur); }
#undef PG8_SA
#undef PG8_SB
#undef PG8_STAGE
#undef PG8_LDA
#undef PG8_LDB
#undef PG8_MMA
#undef PG8_WAIT_V
#undef PG8_WAIT_L
#undef PG8_BAR
#undef PG8_SCHED
}
}
typedef unsigned short bf16;
typedef unsigned v4u __attribute__((ext_vector_type(4)));
typedef unsigned v2u __attribute__((ext_vector_type(2)));
typedef float f32x4 __attribute__((ext_vector_type(4)));
typedef float f32x2 __attribute__((ext_vector_type(2)));
typedef short bf16x8 __attribute__((ext_vector_type(8)));
typedef GAS unsigned gu32;
#define RLX_AGENT __ATOMIC_RELAXED, __HIP_MEMORY_SCOPE_AGENT
#define LDS_WAIT() asm volatile("s_waitcnt lgkmcnt(0)" ::: "memory")
#define VM_WAIT() asm volatile("s_waitcnt vmcnt(0)" ::: "memory")
typedef __bf16 bf16x2_hw __attribute__((ext_vector_type(2)));
__device__ __forceinline__ unsigned pk2(float lo, float hi) { const f32x2 v = {lo, hi}; const bf16x2_hw b = __builtin_convertvector(v, bf16x2_hw); return __builtin_bit_cast(unsigned, b); }
__device__ __forceinline__ unsigned f2bf(float f) { return pk2(f, 0.f) & 0xffffu; }
__device__ __forceinline__ float bflo(unsigned w) { return __builtin_bit_cast(float, w << 16); }
__device__ __forceinline__ float bfhi(unsigned w) { return __builtin_bit_cast(float, w & 0xffff0000u); }
__device__ __forceinline__ float bf1(bf16 b) { return __builtin_bit_cast(float, ((unsigned)b) << 16); }
__device__ __forceinline__ float fast_exp(float x) { return __builtin_amdgcn_exp2f(x * 1.4426950408889634f); }
__device__ __forceinline__ float fast_rcp(float x) { return __builtin_amdgcn_rcpf(x); }
__device__ __forceinline__ float sigmoidf_(float x) { return fast_rcp(1.0f + fast_exp(-x)); }
__device__ __forceinline__ float siluf_(float x) { return x * sigmoidf_(x); }
template <int CTRL> __device__ __forceinline__ float dppf(float v) { return __builtin_bit_cast(float, __builtin_amdgcn_mov_dpp(__builtin_bit_cast(int, v), CTRL, 0xF, 0xF, true)); }
template <int CTRL> __device__ __forceinline__ int dppi(int v) { return __builtin_amdgcn_mov_dpp(v, CTRL, 0xF, 0xF, true); }
__device__ __forceinline__ float rdl(float v, int l) { return __builtin_bit_cast(float, __builtin_amdgcn_readlane(__builtin_bit_cast(int, v), l)); }
__device__ __forceinline__ float wave_sum(float v) {
    v += dppf<0xB1>(v); v += dppf<0x4E>(v); v += dppf<0x141>(v); v += dppf<0x140>(v);
    return (rdl(v, 0) + rdl(v, 16)) + (rdl(v, 32) + rdl(v, 48));
}
__device__ __forceinline__ float wave_max(float v) {
    v = fmaxf(v, dppf<0xB1>(v)); v = fmaxf(v, dppf<0x4E>(v)); v = fmaxf(v, dppf<0x141>(v)); v = fmaxf(v, dppf<0x140>(v));
    return fmaxf(fmaxf(rdl(v, 0), rdl(v, 16)), fmaxf(rdl(v, 32), rdl(v, 48)));
}
__device__ __forceinline__ int wave_sum_i(int v) {
    v += dppi<0xB1>(v); v += dppi<0x4E>(v); v += dppi<0x141>(v); v += dppi<0x140>(v);
    return (__builtin_amdgcn_readlane(v, 0) + __builtin_amdgcn_readlane(v, 16)) + (__builtin_amdgcn_readlane(v, 32) + __builtin_amdgcn_readlane(v, 48));
}

constexpr int NWAVES = 8, NTHR = 512;
constexpr int SEQ = 16384, DM = 2048, NH = 8, HD = 128, HW = 1024;
constexpr int CK = 64, NCHUNK = SEQ / CK, NSEG = 16, CPS = NCHUNK / NSEG;
constexpr int INW = 13344;
constexpr int N1 = 9216;
constexpr float EPS = 1e-6f;
constexpr int PEER_K = 16;

constexpr size_t MiB = (size_t)1 << 20;
constexpr size_t WS_CTL = 0, CTL_ZERO_BYTES = 1 * MiB;
constexpr size_t WS_WG = 2 * MiB, WS_WPA = 18 * MiB, WS_WPB = 22 * MiB, WS_WOUT = 26 * MiB, WS_WS = 34 * MiB, WS_W1 = 42 * MiB;
constexpr size_t WS_XN = 80 * MiB;
constexpr size_t WS_H = 144 * MiB;
constexpr size_t WS_GAB = 432 * MiB;
constexpr size_t WS_HL = 434 * MiB;
constexpr size_t WS_HDS = 450 * MiB;
constexpr size_t WS_OHF = 452 * MiB, WS_OHB = 484 * MiB;
constexpr size_t WS_GSC = 516 * MiB;
constexpr size_t WS_UTF = 144 * MiB, WS_UTB = 176 * MiB, WS_WF = 208 * MiB, WS_WB = 240 * MiB;
constexpr size_t DO_AQKF = 0, DO_AQKB = 16 * MiB, DO_QN = 32 * MiB, DO_KNT = 64 * MiB;
constexpr size_t WS_GL = 42 * MiB, WS_GP = 58 * MiB;
constexpr size_t WS_OGF = 304 * MiB, WS_OGB = 336 * MiB;
constexpr size_t WS_YA = 42 * MiB, WS_YB = 368 * MiB;
constexpr size_t WS_TU = 144 * MiB, WS_TV = 176 * MiB;
constexpr size_t WS_PSC = 520 * MiB;
constexpr size_t WS_GT = 272 * MiB, WS_GT2 = 400 * MiB;
constexpr size_t WS_X1B = 80 * MiB;
constexpr size_t WS_SC = 272 * MiB;
constexpr size_t WS_END = 536 * MiB;
constexpr int CW_BAR = 4096;

constexpr int LDS_BYTES = 163840;
constexpr int MISC_OFF = 163840 - 256;
constexpr int LDS_USABLE = MISC_OFF;

__device__ __forceinline__ bf16x8 ldfrag(const LAS bf16* T, int pitch, int row, int k) { return *(const LAS bf16x8*)(T + row * pitch + k); }
__device__ __forceinline__ f32x4 mfma16(bf16x8 x, bf16x8 y, f32x4 c) { return __builtin_amdgcn_mfma_f32_16x16x32_bf16(x, y, c, 0, 0, 0); }
__device__ __forceinline__ v2u pack4(f32x4 v) { v2u r; r.x = pk2(v[0], v[1]); r.y = pk2(v[2], v[3]); return r; }
#define XB_TMO      128
#define XB_XCNT(j)  (256  + 64 * (j))
#define XB_XSUB(j)  (1280 + 64 * (j))
#define XB_XGEN(j)  (2304 + 64 * (j))
#define XB_TOP      3328
#define XB_TOPGEN   3392
#define XCD_BAR_WORDS 3456
#define XB_SPIN_CAP (1u << 18)

__device__ __forceinline__ unsigned xb_ld(unsigned* p)              { return __hip_atomic_load(p, __ATOMIC_RELAXED, __HIP_MEMORY_SCOPE_AGENT); }
__device__ __forceinline__ unsigned xb_add(unsigned* p, unsigned v) { return __hip_atomic_fetch_add(p, v, __ATOMIC_RELAXED, __HIP_MEMORY_SCOPE_AGENT); }
__device__ __forceinline__ unsigned xb_xcc_id() { return (unsigned)__builtin_amdgcn_s_getreg((3 << 11) | 20) & 0xFu; }
#define XB_SPIN(cond, bar) do { unsigned _sp = 0; while (cond) { __builtin_amdgcn_s_sleep(1); \
    if ((++_sp & 255u) == 0u) { if (xb_ld(&(bar)[XB_TMO])) break; if (_sp > XB_SPIN_CAP) { atomicAdd(&(bar)[XB_TMO], 1u); break; } } } } while (0)

struct XcdBarrier {
    unsigned* bar; unsigned x;
    volatile LAS unsigned* st;
};

__device__ __forceinline__ XcdBarrier xcd_barrier_post(unsigned* bar, volatile LAS unsigned* st) {
    XcdBarrier b; b.bar = bar; b.x = xb_xcc_id(); b.st = st;
    if (threadIdx.x == 0) (void)xb_add(&bar[XB_XCNT(b.x)], 1u);
    return b;
}
__device__ __forceinline__ void xcd_barrier_complete(unsigned* bar, unsigned x, unsigned& nloc, unsigned& nx) {
    const unsigned G = gridDim.x * gridDim.y * gridDim.z;
    unsigned sum, cnt, mine, sp = 0u;
    for (;;) {
        sum = 0u; cnt = 0u; mine = 0u;
#pragma unroll
        for (unsigned j = 0; j < 16; ++j) { const unsigned c = xb_ld(&bar[XB_XCNT(j)]); sum += c; cnt += (c > 0u) ? 1u : 0u; mine = (j == x) ? c : mine; }
        if (sum == G) break;
        __builtin_amdgcn_s_sleep(1);
        if ((++sp & 255u) == 0u) { if (xb_ld(&bar[XB_TMO])) break; if (sp > XB_SPIN_CAP) { atomicAdd(&bar[XB_TMO], 1u); break; } }
    }
    nloc = mine > 0u ? mine : 1u; nx = cnt > 0u ? cnt : 1u;
}

__device__ __forceinline__ void xcd_barrier(const XcdBarrier& b) {
    asm volatile("s_waitcnt vmcnt(0)" ::: "memory");
    __syncthreads();
    if (threadIdx.x == 0) {
        unsigned* bar = b.bar;
        __builtin_amdgcn_s_waitcnt(0);
        unsigned nloc = b.st[0], nx = b.st[1];
        if (nloc == 0u) { xcd_barrier_complete(bar, b.x, nloc, nx); b.st[0] = nloc; b.st[1] = nx; }
        const unsigned old = xb_add(&bar[XB_XSUB(b.x)], 1u);
        const unsigned gen = old / nloc;
        if (old + 1u == (gen + 1u) * nloc) {
            __builtin_amdgcn_fence(__ATOMIC_RELEASE, "agent");
            asm volatile("s_waitcnt vmcnt(0)" ::: "memory");
            const unsigned og = xb_add(&bar[XB_TOP], 1u);
            const unsigned tg = og / nx;
            if (og + 1u == (tg + 1u) * nx) xb_add(&bar[XB_TOPGEN], 1u);
            else XB_SPIN(xb_ld(&bar[XB_TOPGEN]) == tg, bar);
            __builtin_amdgcn_fence(__ATOMIC_ACQUIRE, "agent");
            xb_add(&bar[XB_XGEN(b.x)], 1u);
            asm volatile("s_waitcnt vmcnt(0)" ::: "memory");
        } else {
            XB_SPIN(xb_ld(&bar[XB_XGEN(b.x)]) == gen, bar);
            __builtin_amdgcn_fence(__ATOMIC_ACQUIRE, "agent");
            asm volatile("s_waitcnt vmcnt(0)" ::: "memory");
        }
    }
    __syncthreads();
}

struct Frame {
    LAS unsigned char* lds;
    volatile LAS unsigned* MISC;
    gu32* ctl;
    int tid, lane, wave, vcu, G;
    const float* in[19]; float* out; unsigned char* ws;
};
enum { I_X = 0, I_N1W, I_WIN, I_LB, I_HNW, I_CONVW, I_ALOG, I_DTB, I_GNW, I_WPA, I_WPB, I_WOUT, I_N2W, I_WQ, I_K1, I_K2, I_PU, I_PV, I_FNW };

__device__ __forceinline__ void p0_transpose_item(const float* W, int ldw, int c0, int K, int ncols, bf16* WT, int row_off, LAS float* scr, int item, int lane) {
    const int nblk = ncols / 32, kb = item / nblk, nb = item % nblk, k0 = 64 * kb, n0 = 32 * nb;
#pragma unroll 8
    for (int i = 0; i < 32; ++i) { const int kk = 2 * i + (lane >> 5); scr[kk * 33 + (lane & 31)] = W[(size_t)(k0 + kk) * ldw + c0 + n0 + (lane & 31)]; }
    LDS_WAIT(); asm volatile("" ::: "memory");
    const int c = lane & 7;
#pragma unroll
    for (int j = 0; j < 4; ++j) { const int n = (lane >> 3) + 8 * j; const LAS float* s = scr + (8 * c) * 33 + n;
        v4u o; o.x = pk2(s[0 * 33], s[1 * 33]); o.y = pk2(s[2 * 33], s[3 * 33]); o.z = pk2(s[4 * 33], s[5 * 33]); o.w = pk2(s[6 * 33], s[7 * 33]);
        *(GAS v4u*)(WT + (size_t)(row_off + n0 + n) * K + k0 + 8 * c) = o; }
    LDS_WAIT(); asm volatile("" ::: "memory");
}
__device__ __forceinline__ void rms_row_to_bf16(int lane, const float* xrow, const float* w, bf16* orow) {
    const GAS f32x4* xr = (const GAS f32x4*)xrow + lane; const GAS f32x4* wr = (const GAS f32x4*)w + lane;
    f32x4 v[8]; float s = 0.f;
#pragma unroll
    for (int j = 0; j < 8; ++j) { v[j] = xr[64 * j]; s += (v[j].x * v[j].x + v[j].y * v[j].y) + (v[j].z * v[j].z + v[j].w * v[j].w); }
    const float r = 1.0f / sqrtf(wave_sum(s) * (1.f / DM) + EPS);
    GAS v2u* o8 = (GAS v2u*)orow + lane;
#pragma unroll
    for (int j = 0; j < 8; ++j) { const f32x4 ww = wr[64 * j]; v2u o; o.x = pk2(v[j].x * r * ww.x, v[j].y * r * ww.y); o.y = pk2(v[j].z * r * ww.z, v[j].w * r * ww.w); o8[64 * j] = o; }
}
__device__ __forceinline__ void p0_ws_item(Frame& F, int it) {
    const int h = it >> 6, half = (it >> 5) & 1, j0 = (it & 31) * 64, hc = h * 256 + half * 128;
    const float* Wq = F.in[I_WQ]; const float* Ks = half ? F.in[I_K2] : F.in[I_K1]; const float* n2 = F.in[I_N2W];
    LAS bf16* Xs = (LAS bf16*)F.lds; LAS bf16* Ys = Xs + 64 * 136;
    { const int row = F.tid >> 3, c0 = (F.tid & 7) * 16; const GAS f32x4* src = (const GAS f32x4*)(Wq + (size_t)(j0 + row) * DM + hc + c0);
      const f32x4 a = src[0], b = src[1], c = src[2], d = src[3];
      v4u o0, o1; o0.x = pk2(a.x, a.y); o0.y = pk2(a.z, a.w); o0.z = pk2(b.x, b.y); o0.w = pk2(b.z, b.w); o1.x = pk2(c.x, c.y); o1.y = pk2(c.z, c.w); o1.z = pk2(d.x, d.y); o1.w = pk2(d.z, d.w);
      *(LAS v4u*)(Xs + row * 136 + c0) = o0; *(LAS v4u*)(Xs + row * 136 + c0 + 8) = o1; }
    { const int row = F.tid >> 2, c0 = (F.tid & 3) * 32; const GAS f32x4* src = (const GAS f32x4*)(Ks + (size_t)row * 128 + c0);
#pragma unroll
      for (int q = 0; q < 4; ++q) { const f32x4 a = src[2 * q], b = src[2 * q + 1]; v4u o; o.x = pk2(a.x, a.y); o.y = pk2(a.z, a.w); o.z = pk2(b.x, b.y); o.w = pk2(b.z, b.w); *(LAS v4u*)(Ys + row * 136 + c0 + 8 * q) = o; } }
    __syncthreads();
    const int fr = F.lane & 15, fq = F.lane >> 4, w = F.wave;
    bf16* WSt = (bf16*)(F.ws + WS_WS);
#pragma unroll
    for (int jt = 0; jt < 4; ++jt) {
        f32x4 acc = {0.f, 0.f, 0.f, 0.f};
#pragma unroll
        for (int k0 = 0; k0 < 4; ++k0) acc = mfma16(ldfrag(Xs, 136, 16 * jt + fr, 32 * k0 + 8 * fq), ldfrag(Ys, 136, 16 * w + fr, 32 * k0 + 8 * fq), acc);
        const int jj = j0 + 16 * jt + 4 * fq; const f32x4 nw = *(const GAS f32x4*)(n2 + jj);
        *(GAS v2u*)(WSt + (size_t)(hc + 16 * w + fr) * DM + jj) = pack4(acc * nw);
    }
    __syncthreads();
}
__device__ __forceinline__ void p0_prologue(Frame& F) {
    LAS float* scr = (LAS float*)(F.lds + F.wave * 16384);
    const int gw = F.vcu * NWAVES + F.wave, NGW = F.G * NWAVES;
    constexpr int I_1 = (DM / 64) * (9248 / 32), I_G = (DM / 64) * (4096 / 32), I_PA = (HW / 64) * (DM / 32), I_O = (DM / 64) * (DM / 32);
    constexpr int NITEMS = I_1 + I_G + 2 * I_PA + I_O;
    bf16* W1t = (bf16*)(F.ws + WS_W1);
    for (int it = gw; it < NITEMS; it += NGW) {
        int r = it;
        if (r < I_1) { p0_transpose_item(F.in[I_WIN], INW, 0, DM, 9248, W1t, 0, scr, r, F.lane); continue; } r -= I_1;
        if (r < I_G) { p0_transpose_item(F.in[I_WIN], INW, 9248, DM, 4096, (bf16*)(F.ws + WS_WG), 0, scr, r, F.lane); continue; } r -= I_G;
        if (r < I_PA) { p0_transpose_item(F.in[I_WPA], DM, 0, HW, DM, (bf16*)(F.ws + WS_WPA), 0, scr, r, F.lane); continue; } r -= I_PA;
        if (r < I_PA) { p0_transpose_item(F.in[I_WPB], DM, 0, HW, DM, (bf16*)(F.ws + WS_WPB), 0, scr, r, F.lane); continue; } r -= I_PA;
        p0_transpose_item(F.in[I_WOUT], DM, 0, DM, DM, (bf16*)(F.ws + WS_WOUT), 0, scr, r, F.lane);
    }
    bf16* XN = (bf16*)(F.ws + WS_XN);
    for (int m = gw; m < SEQ; m += NGW) rms_row_to_bf16(F.lane, F.in[I_X] + (size_t)m * DM, F.in[I_N1W], XN + (size_t)m * DM);
    __syncthreads();
    for (int it = blockIdx.x; it < 512; it += F.G) p0_ws_item(F, it);
}
typedef unsigned u32x4 __attribute__((ext_vector_type(4)));
__device__ __forceinline__ u32x4 pack8(f32x4 a, f32x4 b) { u32x4 w; w.x = pk2(a[0], a[1]); w.y = pk2(a[2], a[3]); w.z = pk2(b[0], b[1]); w.w = pk2(b[2], b[3]); return w; }
__device__ __forceinline__ void unpack8(u32x4 w, f32x4& a, f32x4& b) { a = (f32x4){bflo(w.x), bfhi(w.x), bflo(w.y), bfhi(w.y)}; b = (f32x4){bflo(w.z), bfhi(w.z), bflo(w.w), bfhi(w.w)}; }
__device__ __forceinline__ f32x4 silu4(f32x4 v) { return (f32x4){siluf_(v[0]), siluf_(v[1]), siluf_(v[2]), siluf_(v[3])}; }
__device__ __forceinline__ f32x4 sigm4(f32x4 v) { return (f32x4){sigmoidf_(v[0]), sigmoidf_(v[1]), sigmoidf_(v[2]), sigmoidf_(v[3])}; }

struct EpiG1 {
    static constexpr bool PERM = true, AFTER_DRAIN = false;
    unsigned char* ws; const float* lbl;
    __device__ __forceinline__ void operator()(const f32x4 (&acc)[2][2][4][2], const pg8::Unit& u, int wr, int wc, int fr, int fq) const {
        const int pn = u.pn, row0 = u.pm * 256 + wr * 64 + fr;
        {
            const int grp = pn >> 2; const bool act = (grp == 0) | (grp == 4) | (grp == 8);
            bf16* base = (bf16*)(ws + WS_H + (size_t)grp * 32 * MiB); const int col0 = (pn & 3) * 256 + wc * 32 + 8 * fq;
            const bool fgate = (grp == 1) | (grp == 2); f32x4 lbv[2][2];
            if (fgate) { const float* l0 = lbl + (grp - 1) * 2048 + col0;
#pragma unroll
                for (int bj = 0; bj < 2; ++bj)
#pragma unroll
                    for (int n = 0; n < 2; ++n) { const f32x4 a0 = *(const f32x4*)(l0 + bj * 128 + 4 * n), a1 = *(const f32x4*)(l0 + 1024 + bj * 128 + 4 * n);
                        lbv[bj][n] = (f32x4){fast_rcp(1.0f + fast_exp(a1[0] - a0[0])), fast_rcp(1.0f + fast_exp(a1[1] - a0[1])), fast_rcp(1.0f + fast_exp(a1[2] - a0[2])), fast_rcp(1.0f + fast_exp(a1[3] - a0[3]))}; } }
#pragma unroll
            for (int ai = 0; ai < 2; ++ai)
#pragma unroll
                for (int m = 0; m < 4; ++m) { bf16* rowp = base + (size_t)(row0 + ai * 128 + m * 16) * HW + col0;
#pragma unroll
                    for (int bj = 0; bj < 2; ++bj) { f32x4 v0 = acc[ai][bj][m][0], v1 = acc[ai][bj][m][1];
                        if (act) { v0 = silu4(v0); v1 = silu4(v1); }
                        if (fgate) { v0 = lbv[bj][0] + (1.0f - lbv[bj][0]) * sigm4(v0); v1 = lbv[bj][1] + (1.0f - lbv[bj][1]) * sigm4(v1); }
                        *(u32x4*)(rowp + bj * 128) = pack8(v0, v1); } }
        }
    }
};
struct EpiGate {
    static constexpr bool PERM = true, AFTER_DRAIN = false;
    bf16* O;
    __device__ __forceinline__ void operator()(const f32x4 (&acc)[2][2][4][2], const pg8::Unit& u, int wr, int wc, int fr, int fq) const {
        const int row0 = u.pm * 256 + wr * 64 + fr, col0 = u.pn * 256 + wc * 32 + 8 * fq;
#pragma unroll
        for (int ai = 0; ai < 2; ++ai)
#pragma unroll
            for (int m = 0; m < 4; ++m) { bf16* rowp = O + (size_t)(row0 + ai * 128 + m * 16) * DM + col0;
#pragma unroll
                for (int bj = 0; bj < 2; ++bj) *(u32x4*)(rowp + bj * 128) = pack8(sigm4(acc[ai][bj][m][0]), sigm4(acc[ai][bj][m][1])); }
    }
};
template <int MODE> struct EpiMix {
    static constexpr bool PERM = true, AFTER_DRAIN = false;
    bf16* O; const bf16* G;
    __device__ __forceinline__ void operator()(const f32x4 (&acc)[2][2][4][2], const pg8::Unit& u, int wr, int wc, int fr, int fq) const {
        const int row0 = u.pm * 256 + wr * 64 + fr, col0 = u.pn * 256 + wc * 32 + 8 * fq;
#pragma unroll
        for (int ai = 0; ai < 2; ++ai)
#pragma unroll
            for (int m = 0; m < 4; ++m) { const size_t off = (size_t)(row0 + ai * 128 + m * 16) * DM + col0;
#pragma unroll
                for (int bj = 0; bj < 2; ++bj) { f32x4 o0, o1; unpack8(*(const u32x4*)(O + off + bj * 128), o0, o1);
                    if (MODE == 0) { o0 = o0 * acc[ai][bj][m][0]; o1 = o1 * acc[ai][bj][m][1]; }
                    else { f32x4 g0, g1; unpack8(*(const u32x4*)(G + off + bj * 128), g0, g1); o0 = o0 + g0 * acc[ai][bj][m][0]; o1 = o1 + g1 * acc[ai][bj][m][1]; }
                    *(u32x4*)(O + off + bj * 128) = pack8(o0, o1); } }
    }
};
struct EpiX1 {
    static constexpr bool PERM = false, AFTER_DRAIN = false;
    const float* x; float* out; bf16* xb;
    __device__ __forceinline__ void operator()(const f32x4 (&acc)[2][2][4][2], const pg8::Unit& u, int wr, int wc, int fr, int fq) const {
        const int row0 = u.pm * 256 + wr * 64 + fr, col0 = u.pn * 256 + wc * 32 + 4 * fq;
#pragma unroll
        for (int ai = 0; ai < 2; ++ai)
#pragma unroll
            for (int m = 0; m < 4; ++m) { const size_t off = (size_t)(row0 + ai * 128 + m * 16) * DM + col0;
#pragma unroll
                for (int bj = 0; bj < 2; ++bj)
#pragma unroll
                    for (int n = 0; n < 2; ++n) { const size_t o = off + bj * 128 + n * 16; const f32x4 v = *(const f32x4*)(x + o) + acc[ai][bj][m][n];
                        *(f32x4*)(out + o) = v; *(v2u*)(xb + o) = pack4(v); } }
    }
};
struct EpiBf {
    static constexpr bool PERM = true, AFTER_DRAIN = false;
    bf16* O;
    __device__ __forceinline__ void operator()(const f32x4 (&acc)[2][2][4][2], const pg8::Unit& u, int wr, int wc, int fr, int fq) const {
        const int row0 = u.pm * 256 + wr * 64 + fr, col0 = u.pn * 256 + wc * 32 + 8 * fq;
#pragma unroll
        for (int ai = 0; ai < 2; ++ai)
#pragma unroll
            for (int m = 0; m < 4; ++m) { bf16* rowp = O + (size_t)(row0 + ai * 128 + m * 16) * DM + col0;
#pragma unroll
                for (int bj = 0; bj < 2; ++bj) *(u32x4*)(rowp + bj * 128) = pack8(acc[ai][bj][m][0], acc[ai][bj][m][1]); }
    }
};
struct EpiF32 {
    static constexpr bool PERM = false, AFTER_DRAIN = false;
    float* C;
    __device__ __forceinline__ void operator()(const f32x4 (&acc)[2][2][4][2], const pg8::Unit& u, int wr, int wc, int fr, int fq) const {
        const int row0 = u.pm * 256 + wr * 64 + fr, col0 = u.pn * 256 + wc * 32 + 4 * fq;
#pragma unroll
        for (int ai = 0; ai < 2; ++ai)
#pragma unroll
            for (int m = 0; m < 4; ++m) { float* rowp = C + (size_t)(row0 + ai * 128 + m * 16) * DM + col0;
#pragma unroll
                for (int bj = 0; bj < 2; ++bj)
#pragma unroll
                    for (int n = 0; n < 2; ++n) *(f32x4*)(rowp + bj * 128 + n * 16) = acc[ai][bj][m][n]; }
    }
};

__device__ __forceinline__ void p1_ab(Frame& F) {
    const bf16* XN = (const bf16*)(F.ws + WS_XN); const bf16* Wab = (const bf16*)(F.ws + WS_W1) + (size_t)9216 * DM; float* Gab = (float*)(F.ws + WS_GAB);
    const int fr = F.lane & 15, fq = F.lane >> 4, rt = F.wave >> 1, ct = F.wave & 1;
    for (int blk = F.vcu; blk < SEQ / 64; blk += F.G) {
        const bf16* ap = XN + (size_t)(blk * 64 + rt * 16 + fr) * DM + 8 * fq; const bf16* bp = Wab + (size_t)(ct * 16 + fr) * DM + 8 * fq;
        f32x4 acc = {0.f, 0.f, 0.f, 0.f};
#pragma unroll 8
        for (int k0 = 0; k0 < DM; k0 += 32) acc = mfma16(*(const GAS bf16x8*)(bp + k0), *(const GAS bf16x8*)(ap + k0), acc);
        *(GAS f32x4*)(Gab + (size_t)(blk * 64 + rt * 16 + fr) * 32 + ct * 16 + 4 * fq) = acc;
    }
}
template <bool PASS3, int SKIP = 0>
__device__ __forceinline__ void hgrn_pass(Frame& F) {
    LAS bf16*  ST  = (LAS bf16*)(F.lds + 0);
    LAS float* LF  = (LAS float*)(F.lds + 0);
    LAS bf16*  QT  = (LAS bf16*)(F.lds + 34816);
    LAS bf16*  KT  = (LAS bf16*)(F.lds + 52224);
    LAS bf16*  KHT = (LAS bf16*)(F.lds + 69632);
    LAS bf16*  VT  = (LAS bf16*)(F.lds + 88064);
    LAS bf16*  ATT = (LAS bf16*)(F.lds + 106496);
    LAS float* PT  = (LAS float*)(F.lds + 115712);
    LAS float* BL  = (LAS float*)(F.lds + 117760);
    LAS float* DKK = (LAS float*)(F.lds + 118272);
    LAS float* LBV = (LAS float*)(F.lds + 118784);
    LAS bf16*  VR  = (LAS bf16*)(F.lds + 119296);
    const int tid = F.tid, lane = F.lane, w = F.wave, fr = lane & 15, fq = lane >> 4;
    const int row = tid >> 3, c0 = (tid & 7) * 16;
    float* HL = (float*)(F.ws + WS_HL); float* HDS = (float*)(F.ws + WS_HDS);
    for (int it = blockIdx.x; it < 256; it += F.G) {
        const int hd = it >> 4, sg = it & 15, dir = hd >> 3, h = hd & 7;
        const bf16* Hq = (const bf16*)(F.ws + WS_H); const bf16* Hf = (const bf16*)(F.ws + WS_H + (size_t)(1 + dir) * 32 * MiB); const bf16* Hi = (const bf16*)(F.ws + WS_H + (size_t)3 * 32 * MiB);
        bf16* Oh = (bf16*)(F.ws + (dir ? WS_OHB : WS_OHF));
        __syncthreads();
        f32x4 Sacc[8];
#pragma unroll
        for (int kt = 0; kt < 8; ++kt) Sacc[kt] = (f32x4){0.f, 0.f, 0.f, 0.f};
        if (PASS3) {
            for (int p = 0; p < sg; ++p) { const int ip = hd * 16 + p;
#pragma unroll
                for (int kt = 0; kt < 8; ++kt) { const f32x4 dsv = *(const GAS f32x4*)(HDS + ip * 128 + 16 * kt + 4 * fq);
                    const f32x4 l = *(const GAS f32x4*)(HL + ((size_t)((ip * 8 + w) * 8 + kt) * 64 + lane) * 4); Sacc[kt] = Sacc[kt] * dsv + l; } }
        }
        float sumbl = 1.f;
        v4u rq[2], rf[2], rv[2];
        { const int oc = dir ? 255 - sg * 16 : sg * 16; const size_t off = (size_t)(64 * oc + row) * HW + h * 128 + c0;
          rq[0] = *(const GAS v4u*)(Hq + off); rq[1] = *(const GAS v4u*)(Hq + off + 8); rf[0] = *(const GAS v4u*)(Hf + off); rf[1] = *(const GAS v4u*)(Hf + off + 8); rv[0] = *(const GAS v4u*)(Hi + off); rv[1] = *(const GAS v4u*)(Hi + off + 8); }
        __syncthreads();
        for (int ci = 0; ci < ((SKIP & 4) ? 1 : CPS); ++ci) {
            const int sc = sg * 16 + ci, oc = dir ? 255 - sc : sc, tok0 = 64 * oc;
            float kk[16], qq[16];
            { const unsigned fw[8] = {rf[0].x, rf[0].y, rf[0].z, rf[0].w, rf[1].x, rf[1].y, rf[1].z, rf[1].w};
              const unsigned qw[8] = {rq[0].x, rq[0].y, rq[0].z, rq[0].w, rq[1].x, rq[1].y, rq[1].z, rq[1].w};
              float fgv[16];
#pragma unroll
              for (int e = 0; e < 16; ++e) { fgv[e] = (e & 1) ? bfhi(fw[e >> 1]) : bflo(fw[e >> 1]); qq[e] = (e & 1) ? bfhi(qw[e >> 1]) : bflo(qw[e >> 1]); kk[e] = 1.0f - fgv[e]; }
#pragma unroll
              for (int q4 = 0; q4 < 4; ++q4) *(LAS f32x4*)(LF + row * 132 + c0 + 4 * q4) = (f32x4){fgv[4 * q4], fgv[4 * q4 + 1], fgv[4 * q4 + 2], fgv[4 * q4 + 3]};
              *(LAS v4u*)(VR + row * 136 + c0) = rv[0]; *(LAS v4u*)(VR + row * 136 + c0 + 8) = rv[1]; }
            if (ci + 1 < CPS && !(SKIP & 2)) { const int oc2 = dir ? oc - 1 : oc + 1; const size_t off = (size_t)(64 * oc2 + row) * HW + h * 128 + c0;
              rq[0] = *(const GAS v4u*)(Hq + off); rq[1] = *(const GAS v4u*)(Hq + off + 8); rf[0] = *(const GAS v4u*)(Hf + off); rf[1] = *(const GAS v4u*)(Hf + off + 8); rv[0] = *(const GAS v4u*)(Hi + off); rv[1] = *(const GAS v4u*)(Hi + off + 8); }
            if (!(SKIP & 8)) __syncthreads();
            { const int c = tid & 127, part = tid >> 7, r0 = part * 16; float b[16], fv[16]; float run = 1.f;
#pragma unroll
              for (int i = 0; i < 16; ++i) fv[i] = LF[(r0 + i) * 132 + c];
              if (!dir) {
#pragma unroll
                  for (int i = 0; i < 16; ++i) { run *= fv[i]; b[i] = run; }
              } else {
#pragma unroll
                  for (int i = 15; i >= 0; --i) { run *= fv[i]; b[i] = run; }
              }
              PT[part * 128 + c] = run;
              unsigned short vcol[16];
#pragma unroll
              for (int i = 0; i < 16; ++i) vcol[i] = VR[(r0 + i) * 136 + c];
              if (!(SKIP & 8)) __syncthreads();
              const float p0 = PT[c], p1 = PT[128 + c], p2 = PT[256 + c], p3 = PT[384 + c];
              float offs;
              if (!dir) offs = (part > 0 ? p0 : 1.f) * (part > 1 ? p1 : 1.f) * (part > 2 ? p2 : 1.f);
              else      offs = (part < 3 ? p3 : 1.f) * (part < 2 ? p2 : 1.f) * (part < 1 ? p1 : 1.f);
              const float tot = (p0 * p1) * (p2 * p3);
              unsigned kh[8], vw[8];
#pragma unroll
              for (int i = 0; i < 8; ++i) { const float P0 = b[2 * i] * offs, P1 = b[2 * i + 1] * offs;
                  if (PASS3) { LF[(r0 + 2 * i) * 132 + c] = P0; LF[(r0 + 2 * i + 1) * 132 + c] = P1; }
                  kh[i] = pk2((1.0f - fv[2 * i]) * tot * fast_rcp(P0), (1.0f - fv[2 * i + 1]) * tot * fast_rcp(P1)); vw[i] = (unsigned)vcol[2 * i] | ((unsigned)vcol[2 * i + 1] << 16); }
              *(LAS v4u*)(KHT + c * 72 + r0) = (v4u){kh[0], kh[1], kh[2], kh[3]}; *(LAS v4u*)(KHT + c * 72 + r0 + 8) = (v4u){kh[4], kh[5], kh[6], kh[7]};
              *(LAS v4u*)(VT + c * 72 + r0) = (v4u){vw[0], vw[1], vw[2], vw[3]}; *(LAS v4u*)(VT + c * 72 + r0 + 8) = (v4u){vw[4], vw[5], vw[6], vw[7]};
              if (part == 0) { DKK[c] = tot; sumbl *= tot; }
            }
            if (!(SKIP & 8)) __syncthreads();
            if (PASS3 && !(SKIP & 1)) { float bb[16];
#pragma unroll
              for (int q4 = 0; q4 < 4; ++q4) { const f32x4 t4 = *(const LAS f32x4*)(LF + row * 132 + c0 + 4 * q4); bb[4 * q4] = t4[0]; bb[4 * q4 + 1] = t4[1]; bb[4 * q4 + 2] = t4[2]; bb[4 * q4 + 3] = t4[3]; }
              unsigned qo[8], ko[8];
#pragma unroll
              for (int e = 0; e < 8; ++e) { qo[e] = pk2(qq[2 * e] * bb[2 * e], qq[2 * e + 1] * bb[2 * e + 1]); ko[e] = pk2(kk[2 * e] * fast_rcp(bb[2 * e]), kk[2 * e + 1] * fast_rcp(bb[2 * e + 1])); }
              *(LAS v4u*)(QT + row * 136 + c0) = (v4u){qo[0], qo[1], qo[2], qo[3]}; *(LAS v4u*)(QT + row * 136 + c0 + 8) = (v4u){qo[4], qo[5], qo[6], qo[7]};
              *(LAS v4u*)(KT + row * 136 + c0) = (v4u){ko[0], ko[1], ko[2], ko[3]}; *(LAS v4u*)(KT + row * 136 + c0 + 8) = (v4u){ko[4], ko[5], ko[6], ko[7]};
            }
            if (PASS3) if (!(SKIP & 8)) __syncthreads();
            if (PASS3 && !(SKIP & 1)) {
                { bf16x8 kf[2][4], qf[2][4]; f32x4 acc[2];
#pragma unroll
                  for (int q2 = 0; q2 < 2; ++q2) { const int tl = 2 * w + q2, ti = tl >> 2, tj = tl & 3; acc[q2] = (f32x4){0.f, 0.f, 0.f, 0.f};
#pragma unroll
                      for (int k0 = 0; k0 < 4; ++k0) { kf[q2][k0] = ldfrag(KT, 136, 16 * ti + fr, 32 * k0 + 8 * fq); qf[q2][k0] = ldfrag(QT, 136, 16 * tj + fr, 32 * k0 + 8 * fq); } }
                  __builtin_amdgcn_sched_barrier(0);
#pragma unroll
                  for (int k0 = 0; k0 < 4; ++k0)
#pragma unroll
                      for (int q2 = 0; q2 < 2; ++q2) acc[q2] = mfma16(kf[q2][k0], qf[q2][k0], acc[q2]);
                  __builtin_amdgcn_sched_barrier(0);
#pragma unroll
                  for (int q2 = 0; q2 < 2; ++q2) { const int tl = 2 * w + q2, ti = tl >> 2, tj = tl & 3; const int t = 16 * tj + fr, s0 = 16 * ti + 4 * fq;
#pragma unroll
                      for (int r = 0; r < 4; ++r) { const bool keep = dir ? (s0 + r >= t) : (s0 + r <= t); acc[q2][r] = keep ? acc[q2][r] : 0.f; }
                      *(LAS v2u*)(ATT + t * 72 + s0) = pack4(acc[q2]); } }
#pragma unroll
                for (int kt = 0; kt < 8; ++kt) *(LAS v2u*)(ST + (16 * w + fr) * 136 + 16 * kt + 4 * fq) = pack4(Sacc[kt]);
                if (!(SKIP & 8)) __syncthreads();
            }
            bf16x8 xv[2];
#pragma unroll
            for (int s0 = 0; s0 < 2; ++s0) xv[s0] = ldfrag(VT, 72, 16 * w + fr, 32 * s0 + 8 * fq);
            if (PASS3 && !(SKIP & 1)) {
                bf16x8 xs[4];
#pragma unroll
                for (int k0 = 0; k0 < 4; ++k0) xs[k0] = ldfrag(ST, 136, 16 * w + fr, 32 * k0 + 8 * fq);
#pragma unroll
                for (int th = 0; th < 2; ++th) { bf16x8 qf[2][4], af[2][2]; f32x4 acc[2];
#pragma unroll
                    for (int tq = 0; tq < 2; ++tq) { const int tt = 2 * th + tq; acc[tq] = (f32x4){0.f, 0.f, 0.f, 0.f};
#pragma unroll
                        for (int k0 = 0; k0 < 4; ++k0) qf[tq][k0] = ldfrag(QT, 136, 16 * tt + fr, 32 * k0 + 8 * fq);
#pragma unroll
                        for (int s0 = 0; s0 < 2; ++s0) af[tq][s0] = ldfrag(ATT, 72, 16 * tt + fr, 32 * s0 + 8 * fq); }
                    __builtin_amdgcn_sched_barrier(0);
#pragma unroll
                    for (int k0 = 0; k0 < 4; ++k0)
#pragma unroll
                        for (int tq = 0; tq < 2; ++tq) acc[tq] = mfma16(xs[k0], qf[tq][k0], acc[tq]);
#pragma unroll
                    for (int s0 = 0; s0 < 2; ++s0)
#pragma unroll
                        for (int tq = 0; tq < 2; ++tq) acc[tq] = mfma16(xv[s0], af[tq][s0], acc[tq]);
                    __builtin_amdgcn_sched_barrier(0);
#pragma unroll
                    for (int tq = 0; tq < 2; ++tq) *(GAS v2u*)(Oh + (size_t)(tok0 + 16 * (2 * th + tq) + fr) * HW + h * 128 + 16 * w + 4 * fq) = pack4(acc[tq]); }
            }
#pragma unroll
            for (int kh = 0; kh < ((SKIP & 1) ? 0 : 2); ++kh) { bf16x8 kf[4][2];
#pragma unroll
                for (int kq = 0; kq < 4; ++kq) { const int kt = 4 * kh + kq; const f32x4 d4 = *(const LAS f32x4*)(DKK + 16 * kt + 4 * fq); Sacc[kt] = Sacc[kt] * d4;
#pragma unroll
                    for (int s0 = 0; s0 < 2; ++s0) kf[kq][s0] = ldfrag(KHT, 72, 16 * kt + fr, 32 * s0 + 8 * fq); }
                __builtin_amdgcn_sched_barrier(0);
#pragma unroll
                for (int s0 = 0; s0 < 2; ++s0)
#pragma unroll
                    for (int kq = 0; kq < 4; ++kq) Sacc[4 * kh + kq] = mfma16(kf[kq][s0], xv[s0], Sacc[4 * kh + kq]);
                __builtin_amdgcn_sched_barrier(0); }
            if (!(SKIP & 8)) __syncthreads();
        }
        if (!PASS3) {
#pragma unroll
            for (int kt = 0; kt < 8; ++kt) *(GAS f32x4*)(HL + ((size_t)((it * 8 + w) * 8 + kt) * 64 + lane) * 4) = Sacc[kt];
            if (tid < 128) HDS[it * 128 + tid] = sumbl;
        }
    }
}
template <int SKIP>
__device__ __forceinline__ void gdn_prep(Frame& F) {
    LAS bf16*  QN  = (LAS bf16*)(F.lds + 0);
    LAS bf16*  KN  = (LAS bf16*)(F.lds + 17408);
    LAS bf16*  VT  = (LAS bf16*)(F.lds + 34816);
    LAS bf16*  KNT = (LAS bf16*)(F.lds + 53248);
    LAS float* AM  = (LAS float*)(F.lds + 71680);
    LAS bf16*  TB  = (LAS bf16*)(F.lds + 104448);
    LAS bf16*  VR  = (LAS bf16*)(F.lds + 104448);
    LAS float* CWL = (LAS float*)(F.lds + 142848);
    LAS float* DEC = (LAS float*)(F.lds + 141312);
    LAS float* BET = DEC + 128;
    LAS float* EXD = DEC + 256;
    const int tid = F.tid, lane = F.lane, w = F.wave, fr = lane & 15, fq = lane >> 4;
    const int row = tid >> 3, c0 = (tid & 7) * 16;
    const bf16* Gq = (const bf16*)(F.ws + WS_H + (size_t)5 * 32 * MiB); const bf16* Gk = (const bf16*)(F.ws + WS_H + (size_t)6 * 32 * MiB); const bf16* Gv = (const bf16*)(F.ws + WS_H + (size_t)7 * 32 * MiB);
    const float* Gab = (const float*)(F.ws + WS_GAB); const float* cw = F.in[I_CONVW];
    unsigned char* dob = (unsigned char*)F.out;
    bf16* QNg = (bf16*)(dob + DO_QN); bf16* KNTg = (bf16*)(dob + DO_KNT); float* GSC = (float*)(F.ws + WS_GSC);
    int hload = -1;
    for (int it = blockIdx.x; it < 2048; it += F.G) {
        const int h = it & 7, oc = it >> 3, tok0 = 64 * oc;
        __syncthreads();
        if (h != hload) { hload = h;
            for (int i = tid; i < 5 * 384; i += NTHR) { const int j = i / 384, r = i % 384; CWL[i] = cw[j * 3072 + (r >> 7) * 1024 + h * 128 + (r & 127)]; }
            __syncthreads(); }
        if (it + F.G < 2048 && tid < 408) { const int it2 = it + F.G, h2 = it2 & 7, oc2 = it2 >> 3; const int tz = tid / 136, rl = tid % 136, r = rl >> 1, half = rl & 1; const int tr = 64 * oc2 - 2 + r;
            if (tr >= 0 && tr < SEQ) { const bf16* src = (tz == 0 ? Gq : tz == 1 ? Gk : Gv) + (size_t)tr * HW + h2 * 128 + half * 64; unsigned tmp = *(const GAS unsigned*)src; asm volatile("" :: "v"(tmp)); } }
        if (tid < 128) { const int dir = tid >> 6, l = tid & 63, pos = dir ? 63 - l : l;
            const float a = Gab[(size_t)(tok0 + pos) * 32 + dir * 8 + h], b = Gab[(size_t)(tok0 + pos) * 32 + 16 + dir * 8 + h];
            const float x = a + F.in[I_DTB][dir * 8 + h]; const float sp = x > 20.f ? x : log1pf(__expf(x));
            float d = -__expf(F.in[I_ALOG][dir * 8 + h]) * sp;
#pragma unroll
            for (int o = 1; o < 64; o <<= 1) { const float t = __shfl_up(d, o); if (l >= o) d += t; }
            DEC[dir * 64 + pos] = d; BET[dir * 64 + pos] = sigmoidf_(b); EXD[dir * 64 + pos] = __expf(d); }
        if (!(SKIP & 64)) { float q[16], k[16], v[16];
#pragma unroll
          for (int e = 0; e < 16; ++e) { q[e] = 0.f; k[e] = 0.f; v[e] = 0.f; }
          const int ch = h * 128 + c0;
#pragma unroll
          for (int j = 0; j < ((SKIP & 1) ? 0 : 5); ++j) { const int tr = tok0 + row + j - 2;
              if (tr >= 0 && tr < SEQ) { const size_t off = (size_t)tr * HW + ch;
                  const v4u xq0 = *(const GAS v4u*)(Gq + off), xq1 = *(const GAS v4u*)(Gq + off + 8), xk0 = *(const GAS v4u*)(Gk + off), xk1 = *(const GAS v4u*)(Gk + off + 8), xv0 = *(const GAS v4u*)(Gv + off), xv1 = *(const GAS v4u*)(Gv + off + 8);
                  const unsigned wq[8] = {xq0.x, xq0.y, xq0.z, xq0.w, xq1.x, xq1.y, xq1.z, xq1.w}, wk[8] = {xk0.x, xk0.y, xk0.z, xk0.w, xk1.x, xk1.y, xk1.z, xk1.w}, wv[8] = {xv0.x, xv0.y, xv0.z, xv0.w, xv1.x, xv1.y, xv1.z, xv1.w};
                  const LAS float* cq = CWL + j * 384 + c0;
#pragma unroll
                  for (int e = 0; e < 16; ++e) { const float fq_ = (e & 1) ? bfhi(wq[e >> 1]) : bflo(wq[e >> 1]), fk_ = (e & 1) ? bfhi(wk[e >> 1]) : bflo(wk[e >> 1]), fv_ = (e & 1) ? bfhi(wv[e >> 1]) : bflo(wv[e >> 1]);
                      q[e] += cq[e] * fq_; k[e] += cq[128 + e] * fk_; v[e] += cq[256 + e] * fv_; } } }
          float sq = 0.f, sk = 0.f;
#pragma unroll
          for (int e = 0; e < 16; ++e) { q[e] = siluf_(q[e]); k[e] = siluf_(k[e]); v[e] = siluf_(v[e]); sq += q[e] * q[e]; sk += k[e] * k[e]; }
          sq += __shfl_xor(sq, 1); sq += __shfl_xor(sq, 2); sq += __shfl_xor(sq, 4); sk += __shfl_xor(sk, 1); sk += __shfl_xor(sk, 2); sk += __shfl_xor(sk, 4);
          const float rq = 0.08838834764831845f / sqrtf(sq + EPS), rk = 1.0f / sqrtf(sk + EPS);
          unsigned qo[8], ko[8];
#pragma unroll
          for (int e = 0; e < 8; ++e) { qo[e] = pk2(q[2 * e] * rq, q[2 * e + 1] * rq); ko[e] = pk2(k[2 * e] * rk, k[2 * e + 1] * rk); }
          const v4u q0 = {qo[0], qo[1], qo[2], qo[3]}, q1 = {qo[4], qo[5], qo[6], qo[7]}, k0_ = {ko[0], ko[1], ko[2], ko[3]}, k1_ = {ko[4], ko[5], ko[6], ko[7]};
          *(LAS v4u*)(QN + row * 136 + c0) = q0; *(LAS v4u*)(QN + row * 136 + c0 + 8) = q1; *(LAS v4u*)(KN + row * 136 + c0) = k0_; *(LAS v4u*)(KN + row * 136 + c0 + 8) = k1_;
          if (!(SKIP & 16)) { *(GAS v4u*)(QNg + (size_t)(tok0 + row) * HW + ch) = q0; *(GAS v4u*)(QNg + (size_t)(tok0 + row) * HW + ch + 8) = q1; }
          unsigned vo[8];
#pragma unroll
          for (int e = 0; e < 8; ++e) vo[e] = pk2(v[2 * e], v[2 * e + 1]);
          *(LAS v4u*)(VR + row * 136 + c0) = (v4u){vo[0], vo[1], vo[2], vo[3]}; *(LAS v4u*)(VR + row * 136 + c0 + 8) = (v4u){vo[4], vo[5], vo[6], vo[7]};
        }
        __syncthreads();
        { const int c = tid & 127, r0 = (tid >> 7) * 16; unsigned vw[8], kw[8];
#pragma unroll
          for (int i = 0; i < 8; ++i) { vw[i] = (unsigned)VR[(r0 + 2 * i) * 136 + c] | ((unsigned)VR[(r0 + 2 * i + 1) * 136 + c] << 16); kw[i] = (unsigned)KN[(r0 + 2 * i) * 136 + c] | ((unsigned)KN[(r0 + 2 * i + 1) * 136 + c] << 16); }
          *(LAS v4u*)(VT + c * 72 + r0) = (v4u){vw[0], vw[1], vw[2], vw[3]}; *(LAS v4u*)(VT + c * 72 + r0 + 8) = (v4u){vw[4], vw[5], vw[6], vw[7]};
          *(LAS v4u*)(KNT + c * 72 + r0) = (v4u){kw[0], kw[1], kw[2], kw[3]}; *(LAS v4u*)(KNT + c * 72 + r0 + 8) = (v4u){kw[4], kw[5], kw[6], kw[7]}; }
#pragma unroll
        for (int q2 = 0; q2 < ((SKIP & 8) ? 0 : 2); ++q2) { const int tl = 2 * w + q2, ti = tl >> 2, tj = tl & 3; f32x4 kkv = {0.f, 0.f, 0.f, 0.f}, qkv = {0.f, 0.f, 0.f, 0.f};
#pragma unroll
            for (int k0 = 0; k0 < 4; ++k0) { const bf16x8 xs = ldfrag(KN, 136, 16 * ti + fr, 32 * k0 + 8 * fq);
                kkv = mfma16(xs, ldfrag(KN, 136, 16 * tj + fr, 32 * k0 + 8 * fq), kkv); qkv = mfma16(xs, ldfrag(QN, 136, 16 * tj + fr, 32 * k0 + 8 * fq), qkv); }
            const int t = 16 * tj + fr, s0 = 16 * ti + 4 * fq;
#pragma unroll
            for (int dir = 0; dir < 2; ++dir) { const float dt = DEC[dir * 64 + t], bt = BET[dir * 64 + t]; f32x4 aq;
#pragma unroll
                for (int r = 0; r < 4; ++r) { const int s = s0 + r; const bool before = dir ? (s > t) : (s < t), beq = before || (s == t);
                    const float e = beq ? __expf(dt - DEC[dir * 64 + s]) : 0.f;
                    AM[dir * 4096 + (dir ? (63 - s) * 64 + (63 - t) : s * 64 + t)] = before ? bt * kkv[r] * e : 0.f;   aq[r] = qkv[r] * e; }
                bf16* AQg = (bf16*)(dob + (dir ? DO_AQKB : DO_AQKF));
                if (!(SKIP & 16)) *(GAS v2u*)(AQg + ((size_t)(h * 256 + oc) * 64 + t) * 64 + s0) = pack4(aq); } }
        __syncthreads();
        if (SKIP & 32) {} else if (w < 2) { const int dir = w; int c = lane; asm volatile("" : "+v"(c)); const LAS float* A = AM + dir * 4096;
            float t[64];
#pragma unroll
            for (int bi = 0; bi < 4; ++bi) { float r[16];
#pragma unroll
                for (int ii = 0; ii < 16; ++ii) r[ii] = (16 * bi + ii == c) ? 1.f : 0.f;
                if (!(SKIP & 2)) {
#pragma unroll
                for (int j0 = 0; j0 < 16 * bi; j0 += 4) { f32x4 av[4][4];
#pragma unroll
                    for (int jq = 0; jq < 4; ++jq)
#pragma unroll
                        for (int q4 = 0; q4 < 4; ++q4) av[jq][q4] = *(const LAS f32x4*)(A + (j0 + jq) * 64 + 16 * bi + 4 * q4);
                    __builtin_amdgcn_sched_barrier(0);
#pragma unroll
                    for (int jq = 0; jq < 4; ++jq)
#pragma unroll
                        for (int q4 = 0; q4 < 4; ++q4) { r[4 * q4] -= av[jq][q4][0] * t[j0 + jq]; r[4 * q4 + 1] -= av[jq][q4][1] * t[j0 + jq]; r[4 * q4 + 2] -= av[jq][q4][2] * t[j0 + jq]; r[4 * q4 + 3] -= av[jq][q4][3] * t[j0 + jq]; }
                    __builtin_amdgcn_sched_barrier(0); }
#pragma unroll
                for (int jg = 0; jg < 4; ++jg) { f32x4 av[4][4];
#pragma unroll
                    for (int jq = 0; jq < 4; ++jq)
#pragma unroll
                        for (int q4 = jg; q4 < 4; ++q4) av[jq][q4] = *(const LAS f32x4*)(A + (16 * bi + 4 * jg + jq) * 64 + 16 * bi + 4 * q4);
                    __builtin_amdgcn_sched_barrier(0);
#pragma unroll
                    for (int jq = 0; jq < 4; ++jq) { const int jj = 4 * jg + jq; t[16 * bi + jj] = r[jj];
#pragma unroll
                        for (int q4 = jg; q4 < 4; ++q4)
#pragma unroll
                            for (int e = 0; e < 4; ++e) if (4 * q4 + e > jj) r[4 * q4 + e] -= av[jq][q4][e] * r[jj]; }
                    __builtin_amdgcn_sched_barrier(0); }
                } else {
#pragma unroll
                for (int jj = 0; jj < 16; ++jj) t[16 * bi + jj] = r[jj]; }
            }
            const int tc = dir ? 63 - c : c; const float bc = BET[dir * 64 + tc], bd = bc * EXD[dir * 64 + tc];
            LAS bf16* T0 = TB + (dir * 2 + 0) * 64 * 72 + tc + (dir ? 63 * 72 : 0); const int tstep = dir ? -72 : 72;
#pragma unroll
            for (int i = 0; i < 64; ++i) { T0[i * tstep] = (bf16)f2bf(t[i] * bc); T0[64 * 72 + i * tstep] = (bf16)f2bf(t[i] * bd); }
        } else {
            for (int idx = tid - 128; idx < ((SKIP & 16) ? 0 : 1024); idx += 384) { const int r = idx >> 3, c8 = idx & 7; *(GAS v4u*)(KNTg + ((size_t)(h * 256 + oc) * 128 + r) * 64 + c8 * 8) = *(const LAS v4u*)(KNT + r * 72 + c8 * 8); }
            if (tid >= 128 && tid < 256) { const int dir = (tid - 128) >> 6, t = tid & 63; const float dl = dir ? DEC[64] : DEC[63];
                float* g = GSC + (size_t)((dir * 8 + h) * 256 + oc) * 192; g[t] = EXD[dir * 64 + t]; g[64 + t] = __expf(dl - DEC[dir * 64 + t]); if (t == 0) g[128] = __expf(dl); }
        }
        __syncthreads();
#pragma unroll 1
        for (int n = 0; n < ((SKIP & 4) ? 0 : 16); ++n) { const int qi = w * 16 + n, dir = qi >> 6, kind = (qi >> 5) & 1, idx = qi & 31; f32x4 acc = {0.f, 0.f, 0.f, 0.f};
            const LAS bf16* Tm = TB + (dir * 2 + kind) * 64 * 72; const size_t cb = (size_t)(h * 256 + oc) * 8192;
            if (kind == 0) { const int ti = idx >> 3, vj = idx & 7;
#pragma unroll
                for (int s0 = 0; s0 < 2; ++s0) acc = mfma16(ldfrag(Tm, 72, 16 * ti + fr, 32 * s0 + 8 * fq), ldfrag(VT, 72, 16 * vj + fr, 32 * s0 + 8 * fq), acc);
                bf16* U = (bf16*)(F.ws + (dir ? WS_UTB : WS_UTF)); if (!(SKIP & 16)) *(GAS v2u*)(U + cb + (16 * vj + fr) * 64 + 16 * ti + 4 * fq) = pack4(acc);
            } else { const int ki = idx >> 2, tj = idx & 3;
#pragma unroll
                for (int s0 = 0; s0 < 2; ++s0) acc = mfma16(ldfrag(KNT, 72, 16 * ki + fr, 32 * s0 + 8 * fq), ldfrag(Tm, 72, 16 * tj + fr, 32 * s0 + 8 * fq), acc);
                bf16* W = (bf16*)(F.ws + (dir ? WS_WB : WS_WF)); if (!(SKIP & 16)) *(GAS v2u*)(W + cb + (16 * tj + fr) * 128 + 16 * ki + 4 * fq) = pack4(acc); }
        }
    }
}
__device__ __forceinline__ void gdn_load_tiles(const unsigned char* ws, const unsigned char* dob, int tid, int dir, int hd, int h, int oc, bool pass3, v4u (&rw)[2], v4u (&rq)[2], v4u (&ru)[2], v4u (&rk)[2], v4u& ra, float& rs) {
    const size_t cb = (size_t)(h * 256 + oc);
    const int row = tid >> 3, c0 = (tid & 7) * 16, vrow = tid >> 2, t0 = (tid & 3) * 16;
    const bf16* W = (const bf16*)(ws + (dir ? WS_WB : WS_WF)) + cb * 8192 + row * 128 + c0; rw[0] = *(const GAS v4u*)W; rw[1] = *(const GAS v4u*)(W + 8);
    const bf16* U = (const bf16*)(ws + (dir ? WS_UTB : WS_UTF)) + cb * 8192 + vrow * 64 + t0; ru[0] = *(const GAS v4u*)U; ru[1] = *(const GAS v4u*)(U + 8);
    const bf16* Kt = (const bf16*)(dob + DO_KNT) + (size_t)(h * 256 + oc) * 8192 + vrow * 64 + t0; rk[0] = *(const GAS v4u*)Kt; rk[1] = *(const GAS v4u*)(Kt + 8);
    if (pass3) {
        const bf16* Q = (const bf16*)(dob + DO_QN) + (size_t)(64 * oc + row) * HW + h * 128 + c0; rq[0] = *(const GAS v4u*)Q; rq[1] = *(const GAS v4u*)(Q + 8);
        const bf16* A = (const bf16*)(dob + (dir ? DO_AQKB : DO_AQKF)) + cb * 4096 + row * 64 + (tid & 7) * 8; ra = *(const GAS v4u*)A;
    }
    rs = (tid < 192) ? ((const float*)(ws + WS_GSC))[(size_t)(hd * 256 + oc) * 192 + tid] : 0.f;
}
#define SCHED_FENCE() __builtin_amdgcn_sched_barrier(0)
template <bool PASS3, bool UREAL>
__device__ __forceinline__ void gdn_tile(f32x4 (&A)[8], const LAS bf16* WTL, const LAS bf16* QNL, const LAS bf16* UTL, const LAS bf16* KTL, const LAS bf16* AQL, const LAS float* SCL,
                                         LAS bf16* ST, LAS bf16* VN, LAS bf16* VNS, int w, int fr, int fq, float gl, bf16* Ogc) {
#pragma unroll
    for (int kt = 0; kt < 8; ++kt) *(LAS v2u*)(ST + fr * 136 + 16 * kt + 4 * fq) = pack4(A[kt]);
    asm volatile("" ::: "memory");
    bf16x8 xs[4];
#pragma unroll
    for (int k0 = 0; k0 < 4; ++k0) xs[k0] = ldfrag(ST, 136, fr, 32 * k0 + 8 * fq);
#pragma unroll
    for (int th = 0; th < 2; ++th) { bf16x8 wf[2][4]; f32x4 acc[2]; v2u uw[2]; f32x4 es[2];
#pragma unroll
      for (int tq = 0; tq < 2; ++tq) { const int tt = 2 * th + tq;
#pragma unroll
          for (int k0 = 0; k0 < 4; ++k0) wf[tq][k0] = ldfrag(WTL, 136, 16 * tt + fr, 32 * k0 + 8 * fq);
          if (UREAL) uw[tq] = *(const LAS v2u*)(UTL + (16 * w + fr) * 72 + 16 * tt + 4 * fq);
          es[tq] = *(const LAS f32x4*)(SCL + 64 + 16 * tt + 4 * fq); acc[tq] = (f32x4){0.f, 0.f, 0.f, 0.f}; }
      SCHED_FENCE();
#pragma unroll
      for (int k0 = 0; k0 < 4; ++k0)
#pragma unroll
          for (int tq = 0; tq < 2; ++tq) acc[tq] = mfma16(wf[tq][k0], xs[k0], acc[tq]);
      SCHED_FENCE();
#pragma unroll
      for (int tq = 0; tq < 2; ++tq) { const int tt = 2 * th + tq; f32x4 u4 = {0.f, 0.f, 0.f, 0.f};
          if (UREAL) u4 = (f32x4){bflo(uw[tq].x), bfhi(uw[tq].x), bflo(uw[tq].y), bfhi(uw[tq].y)};
          const f32x4 vn = u4 - acc[tq];
          if (PASS3) *(LAS v2u*)(VN + fr * 72 + 16 * tt + 4 * fq) = pack4(vn);
          *(LAS v2u*)(VNS + fr * 72 + 16 * tt + 4 * fq) = pack4(vn * es[tq]); }
      SCHED_FENCE(); }
    asm volatile("" ::: "memory");
    if (PASS3) { bf16x8 yv[2];
#pragma unroll
        for (int s0 = 0; s0 < 2; ++s0) yv[s0] = ldfrag(VN, 72, fr, 32 * s0 + 8 * fq);
#pragma unroll
        for (int th = 0; th < 2; ++th) { bf16x8 qf[2][4], af[2][2]; f32x4 acc[2]; float ed[2];
#pragma unroll
            for (int tq = 0; tq < 2; ++tq) { const int tt = 2 * th + tq;
#pragma unroll
                for (int k0 = 0; k0 < 4; ++k0) qf[tq][k0] = ldfrag(QNL, 136, 16 * tt + fr, 32 * k0 + 8 * fq);
#pragma unroll
                for (int s0 = 0; s0 < 2; ++s0) af[tq][s0] = ldfrag(AQL, 72, 16 * tt + fr, 32 * s0 + 8 * fq);
                ed[tq] = SCL[16 * tt + fr]; acc[tq] = (f32x4){0.f, 0.f, 0.f, 0.f}; }
            SCHED_FENCE();
#pragma unroll
            for (int k0 = 0; k0 < 4; ++k0)
#pragma unroll
                for (int tq = 0; tq < 2; ++tq) acc[tq] = mfma16(xs[k0], qf[tq][k0], acc[tq]);
#pragma unroll
            for (int tq = 0; tq < 2; ++tq) acc[tq] = acc[tq] * ed[tq];
#pragma unroll
            for (int s0 = 0; s0 < 2; ++s0)
#pragma unroll
                for (int tq = 0; tq < 2; ++tq) acc[tq] = mfma16(yv[s0], af[tq][s0], acc[tq]);
            SCHED_FENCE();
#pragma unroll
            for (int tq = 0; tq < 2; ++tq) *(GAS v2u*)(Ogc + (size_t)(16 * (2 * th + tq) + fr) * HW + 16 * w + 4 * fq) = pack4(acc[tq]);
            SCHED_FENCE(); } }
    { bf16x8 ys[2];
#pragma unroll
      for (int s0 = 0; s0 < 2; ++s0) ys[s0] = ldfrag(VNS, 72, fr, 32 * s0 + 8 * fq);
#pragma unroll
      for (int kh = 0; kh < 2; ++kh) { bf16x8 kf[4][2];
#pragma unroll
          for (int kq = 0; kq < 4; ++kq)
#pragma unroll
              for (int s0 = 0; s0 < 2; ++s0) kf[kq][s0] = ldfrag(KTL, 72, 16 * (4 * kh + kq) + fr, 32 * s0 + 8 * fq);
#pragma unroll
          for (int kq = 0; kq < 4; ++kq) A[4 * kh + kq] = A[4 * kh + kq] * gl;
          SCHED_FENCE();
#pragma unroll
          for (int s0 = 0; s0 < 2; ++s0)
#pragma unroll
              for (int kq = 0; kq < 4; ++kq) A[4 * kh + kq] = mfma16(kf[kq][s0], ys[s0], A[4 * kh + kq]);
          SCHED_FENCE(); } }
}
template <bool PASS3, int SKIP = 0>
__device__ __forceinline__ void gdn_pass(Frame& F) {
    LAS bf16*  WTL = (LAS bf16*)(F.lds + 0);
    LAS bf16*  QNL = (LAS bf16*)(F.lds + 17408);
    LAS bf16*  UTL = (LAS bf16*)(F.lds + 34816);
    LAS bf16*  KTL = (LAS bf16*)(F.lds + 53248);
    LAS bf16*  AQL = (LAS bf16*)(F.lds + 71680);
    LAS float* SCL = (LAS float*)(F.lds + 80896);
    LAS bf16*  PX  = (LAS bf16*)(F.lds + 0);
    const int tid = F.tid, lane = F.lane, w = F.wave, fr = lane & 15, fq = lane >> 4;
    LAS bf16* ST  = (LAS bf16*)(F.lds + 81920 + w * 8960);
    LAS bf16* VN  = ST + 16 * 136;
    LAS bf16* VNS = VN + 16 * 72;
    const int row = tid >> 3, c0 = (tid & 7) * 16, vrow = tid >> 2, t0 = (tid & 3) * 16;
    const unsigned char* dob = (const unsigned char*)F.out;
    float* GL = (float*)(F.ws + WS_GL); bf16* GP = (bf16*)(F.ws + WS_GP);
    for (int it = blockIdx.x; it < 256; it += F.G) {
        const int hd = it >> 4, sg = it & 15, dir = hd >> 3, h = hd & 7;
        bf16* Og = (bf16*)(F.ws + (dir ? WS_OGB : WS_OGF));
        f32x4 Sacc[8], Pacc[8];
        int dgi = 16 * w + fr - 4 * fq; asm volatile("" : "+v"(dgi));
#pragma unroll
        for (int kt = 0; kt < 8; ++kt) { Sacc[kt] = (f32x4){0.f, 0.f, 0.f, 0.f};
#pragma unroll
            for (int r = 0; r < 4; ++r) Pacc[kt][r] = (!PASS3 && (16 * kt + r == dgi)) ? 1.f : 0.f; }
        __syncthreads();
        if (PASS3) {
            for (int p = 0; p < sg; ++p) { const int ip = hd * 16 + p;
                { const bf16* src = GP + (size_t)ip * 16384 + vrow * 128 + (tid & 3) * 32;
#pragma unroll
                  for (int q = 0; q < 4; ++q) *(LAS v4u*)(PX + vrow * 136 + (tid & 3) * 32 + 8 * q) = *(const GAS v4u*)(src + 8 * q); }
#pragma unroll
                for (int kt = 0; kt < 8; ++kt) *(LAS v2u*)(ST + fr * 136 + 16 * kt + 4 * fq) = pack4(Sacc[kt]);
                __syncthreads();
                bf16x8 xs[4];
#pragma unroll
                for (int k0 = 0; k0 < 4; ++k0) xs[k0] = ldfrag(ST, 136, fr, 32 * k0 + 8 * fq);
#pragma unroll
                for (int kh = 0; kh < 2; ++kh) { bf16x8 pf[4][4]; f32x4 acc[4];
#pragma unroll
                    for (int kq = 0; kq < 4; ++kq) { const int kt = 4 * kh + kq; acc[kq] = *(const GAS f32x4*)(GL + ((size_t)((ip * 8 + w) * 8 + kt) * 64 + lane) * 4);
#pragma unroll
                        for (int k0 = 0; k0 < 4; ++k0) pf[kq][k0] = ldfrag(PX, 136, 16 * kt + fr, 32 * k0 + 8 * fq); }
                    SCHED_FENCE();
#pragma unroll
                    for (int k0 = 0; k0 < 4; ++k0)
#pragma unroll
                        for (int kq = 0; kq < 4; ++kq) acc[kq] = mfma16(pf[kq][k0], xs[k0], acc[kq]);
                    SCHED_FENCE();
#pragma unroll
                    for (int kq = 0; kq < 4; ++kq) Sacc[4 * kh + kq] = acc[kq]; }
                __syncthreads();
            }
        }
        v4u rw[2], rq[2], ru[2], rk[2], ra; float rs;
        gdn_load_tiles(F.ws, dob, tid, dir, hd, h, dir ? 255 - sg * 16 : sg * 16, PASS3, rw, rq, ru, rk, ra, rs);
        for (int ci = 0; ci < CPS; ++ci) {
            const int sc = sg * 16 + ci, oc = dir ? 255 - sc : sc, tok0 = 64 * oc;
            *(LAS v4u*)(WTL + row * 136 + c0) = rw[0]; *(LAS v4u*)(WTL + row * 136 + c0 + 8) = rw[1];
            *(LAS v4u*)(UTL + vrow * 72 + t0) = ru[0]; *(LAS v4u*)(UTL + vrow * 72 + t0 + 8) = ru[1];
            *(LAS v4u*)(KTL + vrow * 72 + t0) = rk[0]; *(LAS v4u*)(KTL + vrow * 72 + t0 + 8) = rk[1];
            if (PASS3) { *(LAS v4u*)(QNL + row * 136 + c0) = rq[0]; *(LAS v4u*)(QNL + row * 136 + c0 + 8) = rq[1]; *(LAS v4u*)(AQL + row * 72 + (tid & 7) * 8) = ra; }
            if (tid < 192) SCL[tid] = rs;
            __syncthreads();
            if (ci + 1 < CPS && !(SKIP & 1)) gdn_load_tiles(F.ws, dob, tid, dir, hd, h, dir ? oc - 1 : oc + 1, PASS3, rw, rq, ru, rk, ra, rs);
            const float gl = SCL[128];
            gdn_tile<PASS3, true>(Sacc, WTL, QNL, UTL, KTL, AQL, SCL, ST, VN, VNS, w, fr, fq, gl, Og + (size_t)tok0 * HW + h * 128);
            if (!PASS3) gdn_tile<PASS3, false>(Pacc, WTL, QNL, UTL, KTL, AQL, SCL, ST, VN, VNS, w, fr, fq, gl, Og);
            __syncthreads();
        }
        if (!PASS3) {
            int pofs = (4 * fq) * 128 + 16 * w + fr; asm volatile("" : "+v"(pofs));
            bf16* gp = GP + (size_t)it * 16384 + pofs;
#pragma unroll
            for (int kt = 0; kt < 8; ++kt) { *(GAS f32x4*)(GL + ((size_t)((it * 8 + w) * 8 + kt) * 64 + lane) * 4) = Sacc[kt];
#pragma unroll
                for (int r = 0; r < 4; ++r) gp[(16 * kt + r) * 128] = (bf16)f2bf(Pacc[kt][r]); }
        }
    }
}
__device__ __forceinline__ void p7_mix(Frame& F) {
    const int gw = F.vcu * NWAVES + F.wave, NGW = F.G * NWAVES, lane = F.lane;
    const int e0 = (lane & 7) * 16, col = (lane >> 3) * 128 + e0;
    for (int m = gw; m < SEQ; m += NGW) {
#pragma unroll
        for (int mx = 0; mx < 2; ++mx) {
            const bf16* of = (const bf16*)(F.ws + (mx ? WS_OGF : WS_OHF)); const bf16* ob = (const bf16*)(F.ws + (mx ? WS_OGB : WS_OHB));
            const bf16* gt = (const bf16*)(F.ws + WS_H + (size_t)(mx ? 8 : 4) * 32 * MiB); const float* nw = F.in[mx ? I_GNW : I_HNW];
            bf16* yo = (bf16*)(F.ws + (mx ? WS_YB : WS_YA));
            const size_t off = (size_t)m * HW + col;
            const v4u a0 = *(const GAS v4u*)(of + off), a1 = *(const GAS v4u*)(of + off + 8), b0 = *(const GAS v4u*)(ob + off), b1 = *(const GAS v4u*)(ob + off + 8), g0 = *(const GAS v4u*)(gt + off), g1 = *(const GAS v4u*)(gt + off + 8);
            const unsigned aw[8] = {a0.x, a0.y, a0.z, a0.w, a1.x, a1.y, a1.z, a1.w}, bw[8] = {b0.x, b0.y, b0.z, b0.w, b1.x, b1.y, b1.z, b1.w}, gw_[8] = {g0.x, g0.y, g0.z, g0.w, g1.x, g1.y, g1.z, g1.w};
            float o[16]; float ss = 0.f;
#pragma unroll
            for (int e = 0; e < 8; ++e) { o[2 * e] = bflo(aw[e]) + bflo(bw[e]); o[2 * e + 1] = bfhi(aw[e]) + bfhi(bw[e]); ss += o[2 * e] * o[2 * e] + o[2 * e + 1] * o[2 * e + 1]; }
            ss += __shfl_xor(ss, 1); ss += __shfl_xor(ss, 2); ss += __shfl_xor(ss, 4);
            const float r = 1.0f / sqrtf(ss * (1.f / 128.f) + EPS);
            unsigned yw[8];
#pragma unroll
            for (int e = 0; e < 8; ++e) yw[e] = pk2(o[2 * e] * r * nw[e0 + 2 * e] * bflo(gw_[e]), o[2 * e + 1] * r * nw[e0 + 2 * e + 1] * bfhi(gw_[e]));
            *(GAS v4u*)(yo + off) = (v4u){yw[0], yw[1], yw[2], yw[3]}; *(GAS v4u*)(yo + off + 8) = (v4u){yw[4], yw[5], yw[6], yw[7]};
        }
    }
    for (int tb = 0; tb < 2; ++tb) { const float* src = F.in[tb ? I_PV : I_PU]; unsigned char* dst = F.ws + (tb ? WS_TV : WS_TU); float* scl = (float*)(F.ws + WS_PSC) + tb * 16384;
        for (int r = gw; r < 16384; r += NGW) { const float* row = src + (size_t)r * DM; f32x4 v[8]; float mx = 0.f;
#pragma unroll
            for (int q = 0; q < 8; ++q) { v[q] = *(const GAS f32x4*)(row + (tb ? (q >> 2) * 1024 + lane * 16 + 4 * (q & 3) : lane * 32 + 4 * q)); const f32x4 a = __builtin_elementwise_abs(v[q]); mx = fmaxf(mx, fmaxf(fmaxf(a.x, a.y), fmaxf(a.z, a.w))); }
            mx = wave_max(mx);
            const float sc = mx > 0.f ? mx * (1.0f / 127.0f) : 1.0f, inv = 1.0f / sc; const int bias = tb ? 128 : 0;
            unsigned w[8];
#pragma unroll
            for (int q = 0; q < 8; ++q) { const f32x4 x = v[q]; const int a = (int)rintf(x.x * inv) + bias, b = (int)rintf(x.y * inv) + bias, c = (int)rintf(x.z * inv) + bias, d = (int)rintf(x.w * inv) + bias;
                w[q] = (unsigned)(a & 255) | ((unsigned)(b & 255) << 8) | ((unsigned)(c & 255) << 16) | ((unsigned)(d & 255) << 24); }
            if (tb) { *(GAS v4u*)(dst + (size_t)r * DM + lane * 16) = (v4u){w[0], w[1], w[2], w[3]}; *(GAS v4u*)(dst + (size_t)r * DM + 1024 + lane * 16) = (v4u){w[4], w[5], w[6], w[7]}; }
            else { GAS v4u* o = (GAS v4u*)(dst + ((size_t)lane * 16384 + r) * 32); o[0] = (v4u){w[0], w[1], w[2], w[3]}; o[1] = (v4u){w[4], w[5], w[6], w[7]}; }
            if (lane == 0) scl[r] = sc; } }
}
constexpr size_t WS_XQ = 80 * MiB;
constexpr size_t WS_SXR = 112 * MiB;
constexpr size_t WS_EID = 113 * MiB, WS_GATE = 121 * MiB, WS_AV = 129 * MiB;
constexpr size_t WS_REC = 208 * MiB;
constexpr int NET = 32, ETSZ = 512, NBUCK = 16 * NET, REC_CAP = 16384, CW_CNT = 8192, CW_Q = 8192 + 16 * NBUCK;
__device__ __forceinline__ unsigned fkey(float f) { const unsigned u = __builtin_bit_cast(unsigned, f); return (u & 0x80000000u) ? ~u : (u | 0x80000000u); }
__device__ __forceinline__ float gelu_erf(float x) { return 0.5f * x * (1.0f + erff(x * 0.70710678118654752f)); }
__device__ __forceinline__ float cvt_ub0(unsigned w) { float f; asm("v_cvt_f32_ubyte0 %0, %1" : "=v"(f) : "v"(w)); return f; }
__device__ __forceinline__ float cvt_ub1(unsigned w) { float f; asm("v_cvt_f32_ubyte1 %0, %1" : "=v"(f) : "v"(w)); return f; }
__device__ __forceinline__ float cvt_ub2(unsigned w) { float f; asm("v_cvt_f32_ubyte2 %0, %1" : "=v"(f) : "v"(w)); return f; }
__device__ __forceinline__ float cvt_ub3(unsigned w) { float f; asm("v_cvt_f32_ubyte3 %0, %1" : "=v"(f) : "v"(w)); return f; }

__device__ __forceinline__ float key_val(unsigned k, unsigned mask) { unsigned u = k & ~mask; u = (u & 0x80000000u) ? (u & 0x7fffffffu) : ~u; return __builtin_bit_cast(float, u); }
template <int SKIP>
__device__ __forceinline__ void p11a_topk(Frame& F) {
    LAS float* SCR = (LAS float*)(F.lds + F.wave * 16384);
    LAS unsigned* SL = (LAS unsigned*)SCR;
    LAS int* EIDS = (LAS int*)(SCR + 1024);
    LAS int* OFFS = (LAS int*)(SCR + 2048);
    LAS float* RTS = SCR + 2304;
    LAS int* BC = (LAS int*)(F.lds + 8 * 16384);
    const bf16* SC = (const bf16*)(F.ws + WS_SC);
    unsigned char* XQ = F.ws + WS_XQ; float* SXR = (float*)(F.ws + WS_SXR); int* EIDg = (int*)(F.ws + WS_EID); float* GATEg = (float*)(F.ws + WS_GATE); unsigned* REC = (unsigned*)(F.ws + WS_REC);
    for (int blk = F.vcu; blk < SEQ / 64; blk += F.G) {
        __syncthreads();
        if (F.tid < NET) BC[F.tid] = 0;
        __syncthreads();
        const int m0 = blk * 64 + F.wave * 8;
#pragma unroll 2
        for (int ti = 0; ti < 8; ++ti) { const int m = m0 + ti;
            int lane = F.lane; asm volatile("" : "+v"(lane));
            float xh[32]; float ss = 0.f;
            const float* x1 = F.out + (size_t)m * DM + lane * 32; const float* n2 = F.in[I_N2W] + lane * 32;
#pragma unroll
            for (int q = 0; q < 8; ++q) { const f32x4 a = *(const GAS f32x4*)(x1 + 4 * q); xh[4 * q] = a.x; xh[4 * q + 1] = a.y; xh[4 * q + 2] = a.z; xh[4 * q + 3] = a.w; }
#pragma unroll
            for (int e = 0; e < 32; ++e) ss += xh[e] * xh[e];
            const float rt = 1.0f / sqrtf(wave_sum(ss) * (1.f / DM) + EPS);
            float amx = 0.f;
#pragma unroll
            for (int q = 0; q < 8; ++q) { const f32x4 a = *(const GAS f32x4*)(n2 + 4 * q); xh[4 * q] *= rt * a.x; xh[4 * q + 1] *= rt * a.y; xh[4 * q + 2] *= rt * a.z; xh[4 * q + 3] *= rt * a.w; }
#pragma unroll
            for (int e = 0; e < 32; ++e) amx = fmaxf(amx, fabsf(xh[e]));
            amx = wave_max(amx);
            const float sx = amx > 0.f ? amx * (1.0f / 127.0f) : 1.0f, isx = 1.0f / sx;
            unsigned xq[8];
#pragma unroll
            for (int d = 0; d < 8; ++d) { const int a = (int)rintf(xh[4 * d] * isx), b = (int)rintf(xh[4 * d + 1] * isx), c = (int)rintf(xh[4 * d + 2] * isx), e = (int)rintf(xh[4 * d + 3] * isx);
                xq[d] = (unsigned)(a & 255) | ((unsigned)(b & 255) << 8) | ((unsigned)(c & 255) << 16) | ((unsigned)(e & 255) << 24); }
            if (!(SKIP & 2)) { GAS v4u* o = (GAS v4u*)(XQ + ((size_t)lane * SEQ + m) * 32); o[0] = (v4u){xq[0], xq[1], xq[2], xq[3]}; o[1] = (v4u){xq[4], xq[5], xq[6], xq[7]}; }
            if (lane == 0) { SXR[2 * m] = sx; SXR[2 * m + 1] = rt; RTS[ti] = rt; }
        }
#pragma unroll 1
        for (int grp = 0; grp < 2; ++grp) {
            int lane = F.lane; asm volatile("" : "+v"(lane));
            if (!(SKIP & 1)) {
                { const bf16* src = SC + (size_t)(m0 + grp * 4 + (lane >> 4)) * DM + (lane & 15) * 128;
                  unsigned v[16];
#pragma unroll
                  for (int i = 0; i < 16; ++i) v[i] = 0u;
#pragma unroll 1
                  for (int s8 = 0; s8 < 2; ++s8) { v4u a8[8];
#pragma unroll
                      for (int u = 0; u < 8; ++u) a8[u] = *(const GAS v4u*)(src + 64 * s8 + 8 * u);
#pragma unroll
                      for (int u = 0; u < 8; ++u) { const unsigned wv[4] = {a8[u].x, a8[u].y, a8[u].z, a8[u].w};
#pragma unroll
                          for (int e = 0; e < 8; ++e) { const float sv = (e & 1) ? bfhi(wv[e >> 1]) : bflo(wv[e >> 1]); unsigned x = (fkey(sv) & ~127u) | (unsigned)(64 * s8 + 8 * u + e);
#pragma unroll
                              for (int i = 0; i < 16; ++i) { const unsigned hi = v[i] > x ? v[i] : x; x = v[i] > x ? x : v[i]; v[i] = hi; } } } }
#pragma unroll
                  for (int q = 0; q < 4; ++q) *(LAS v4u*)(SL + lane * 16 + 4 * q) = (v4u){v[4 * q], v[4 * q + 1], v[4 * q + 2], v[4 * q + 3]}; }
                asm volatile("" ::: "memory");
                if (lane < 32) { const int tk = lane >> 3, h = lane & 7, m = m0 + grp * 4 + tk;
                    const LAS unsigned* L1 = SL + (tk * 16 + 2 * h) * 16; const LAS unsigned* L2 = L1 + 16;
                    float f1[16], f2[16];
#pragma unroll
                    for (int q = 0; q < 4; ++q) { const v4u a = *(const LAS v4u*)(L1 + 4 * q), b = *(const LAS v4u*)(L2 + 4 * q);
                        f1[4 * q] = key_val(a.x, 127u); f1[4 * q + 1] = key_val(a.y, 127u); f1[4 * q + 2] = key_val(a.z, 127u); f1[4 * q + 3] = key_val(a.w, 127u);
                        f2[4 * q] = key_val(b.x, 127u); f2[4 * q + 1] = key_val(b.y, 127u); f2[4 * q + 2] = key_val(b.z, 127u); f2[4 * q + 3] = key_val(b.w, 127u); }
                    unsigned c[16];
#pragma unroll
                    for (int i = 0; i < 16; ++i) c[i] = 0u;
#pragma unroll
                    for (int i = 0; i < 16; ++i)
#pragma unroll
                        for (int j = 0; j < 16; ++j) if ((i + 1) * (j + 1) <= 16) { unsigned x = (fkey(f1[i] + f2[j]) & ~255u) | (unsigned)(i * 16 + j);
#pragma unroll
                            for (int r = 0; r < 16; ++r) { const unsigned hi = c[r] > x ? c[r] : x; x = c[r] > x ? x : c[r]; c[r] = hi; } }
                    const float rt = RTS[grp * 4 + tk];
                    float sc[16]; int ee[16]; float mx = -3.0e38f;
#pragma unroll
                    for (int r = 0; r < 16; ++r) { const unsigned ij = c[r] & 255u; const unsigned k1 = L1[ij >> 4], k2 = L2[ij & 15u];
                        sc[r] = key_val(k1, 127u) + key_val(k2, 127u); ee[r] = (int)((k1 & 127u) * 128u + (k2 & 127u)); mx = fmaxf(mx, sc[r]); }
                    float sum = 0.f;
#pragma unroll
                    for (int r = 0; r < 16; ++r) { sc[r] = __expf(rt * (sc[r] - mx)); sum += sc[r]; }
                    const float inv = 1.0f / sum;
#pragma unroll
                    for (int q = 0; q < 4; ++q) { *(LAS v4u*)(EIDS + (grp * 4 + tk) * 128 + h * 16 + 4 * q) = (v4u){(unsigned)ee[4 * q], (unsigned)ee[4 * q + 1], (unsigned)ee[4 * q + 2], (unsigned)ee[4 * q + 3]};
                        if (!(SKIP & 4)) { *(GAS v4u*)(EIDg + (size_t)m * 128 + h * 16 + 4 * q) = (v4u){(unsigned)ee[4 * q], (unsigned)ee[4 * q + 1], (unsigned)ee[4 * q + 2], (unsigned)ee[4 * q + 3]};
                            *(GAS f32x4*)(GATEg + (size_t)m * 128 + h * 16 + 4 * q) = (f32x4){sc[4 * q] * inv, sc[4 * q + 1] * inv, sc[4 * q + 2] * inv, sc[4 * q + 3] * inv}; } }
                }
                asm volatile("" ::: "memory");
            }
        }
#pragma unroll 1
        for (int ti = 0; ti < 8; ++ti) {
            int lane = F.lane; asm volatile("" : "+v"(lane));
            const int tA = (EIDS[ti * 128 + lane] >> 9) & 31, tB = (EIDS[ti * 128 + 64 + lane] >> 9) & 31; int mycnt = 0;
#pragma unroll
            for (int k = 0; k < NET; ++k) { const int c = __popcll(__ballot(tA == k)) + __popcll(__ballot(tB == k)); mycnt = (lane == k) ? c : mycnt; }
            if (lane < NET) OFFS[ti * NET + lane] = __hip_atomic_fetch_add((int*)(BC + lane), mycnt, __ATOMIC_RELAXED, __HIP_MEMORY_SCOPE_WORKGROUP);
        }
        __syncthreads();
        const int tt = blk >> 4;
        if (F.tid < NET) BC[NET + F.tid] = (int)__hip_atomic_fetch_add((unsigned*)(F.ctl + CW_CNT) + (tt * NET + F.tid) * 16, (unsigned)BC[F.tid], __ATOMIC_RELAXED, __HIP_MEMORY_SCOPE_AGENT);
        __syncthreads();
#pragma unroll 1
        for (int ti = 0; ti < 8; ++ti) { const int m = m0 + ti;
            int lane = F.lane; asm volatile("" : "+v"(lane));
            const unsigned long long lt_mask = (1ull << lane) - 1ull;
            const int eA = EIDS[ti * 128 + lane] & 16383, eB = EIDS[ti * 128 + 64 + lane] & 16383, tA = eA >> 9, tB = eB >> 9; int rankA = 0, rankB = 0;
#pragma unroll
            for (int k = 0; k < NET; ++k) { const unsigned long long mA = __ballot(tA == k), mB = __ballot(tB == k);
                rankA = (tA == k) ? __popcll(mA & lt_mask) : rankA; rankB = (tB == k) ? __popcll(mA) + __popcll(mB & lt_mask) : rankB; }
            const unsigned tl = (unsigned)(m & 1023) << 17;
            if (!(SKIP & 4)) { const int s = BC[NET + tA] + OFFS[ti * NET + tA] + rankA; if (s < REC_CAP) REC[(size_t)(tt * NET + tA) * REC_CAP + s] = tl | ((unsigned)(eA & 511) << 7) | (unsigned)lane; }
            if (!(SKIP & 4)) { const int s = BC[NET + tB] + OFFS[ti * NET + tB] + rankB; if (s < REC_CAP) REC[(size_t)(tt * NET + tB) * REC_CAP + s] = tl | ((unsigned)(eB & 511) << 7) | (unsigned)(lane + 64); }
        }
    }
}

constexpr int NSLOT = 12, UPITCH = 80;
__device__ __forceinline__ void p11b_udot(Frame& F) {
    LAS unsigned char* XS = (LAS unsigned char*)F.lds;
    LAS unsigned char* US = XS + 1024 * UPITCH;
    LAS int* QB = (LAS int*)(F.lds + 124 * 1024);
    const int tid = F.tid;
    const unsigned char* XQ = F.ws + WS_XQ; const unsigned char* TU = F.ws + WS_TU; const unsigned* REC = (const unsigned*)(F.ws + WS_REC);
    const float* SXR = (const float*)(F.ws + WS_SXR); const float* GATEg = (const float*)(F.ws + WS_GATE); float* AVg = (float*)(F.ws + WS_AV);
    const float* SU = (const float*)(F.ws + WS_PSC); const float* SV = SU + 16384;
    for (;;) {
        __syncthreads();
        if (tid == 0) QB[0] = (int)__hip_atomic_fetch_add((unsigned*)(F.ctl + CW_Q), 1u, __ATOMIC_RELAXED, __HIP_MEMORY_SCOPE_AGENT);
        __syncthreads();
        const int b = QB[0];
        if (b >= NBUCK) break;
        const int tt = b >> 5, et = b & 31;
        int n = (int)__hip_atomic_load((unsigned*)(F.ctl + CW_CNT) + b * 16, __ATOMIC_RELAXED, __HIP_MEMORY_SCOPE_AGENT); n = n < REC_CAP ? n : REC_CAP;
        for (int g0 = 0; g0 < n; g0 += NSLOT * NTHR) {
            const int npass = (n - g0) < NSLOT * NTHR ? (n - g0) : NSLOT * NTHR;
            unsigned rec[NSLOT]; int acc[NSLOT];
#pragma unroll
            for (int j = 0; j < NSLOT; ++j) { const int idx = g0 + j * NTHR + tid; const unsigned r = idx < n ? REC[(size_t)b * REC_CAP + idx] : 0xffffffffu; acc[j] = 0;
                rec[j] = ((r >> 17) & 1023u) | (((r >> 7) & 511u) << 16); }
            v4u st[12];
#define P11B_SRC(step, i) (((i) % 6) < 4 ? XQ + ((size_t)(2 * (step) + (i) / 6) * SEQ + tt * 1024) * 32 + (size_t)(tid + 512 * ((i) % 6)) * 16 : TU + ((size_t)(2 * (step) + (i) / 6) * 16384 + et * ETSZ) * 32 + (size_t)(tid + 512 * (((i) % 6) - 4)) * 16)
#pragma unroll
            for (int i = 0; i < 12; ++i) st[i] = *(const GAS v4u*)P11B_SRC(0, i);
#pragma unroll 1
            for (int c = 0; c < 32; ++c) {
                __syncthreads();
#pragma unroll
                for (int i = 0; i < 12; ++i) { const int q = i % 6, hc = i / 6, p = (q < 4) ? tid + 512 * q : tid + 512 * (q - 4); *(LAS v4u*)((q < 4 ? XS : US) + (p >> 1) * UPITCH + hc * 32 + (p & 1) * 16) = st[i]; }
                __syncthreads();
                if (c + 1 < 32) {
#pragma unroll
                    for (int i = 0; i < 12; ++i) st[i] = *(const GAS v4u*)P11B_SRC(c + 1, i);
                }
#pragma unroll
                for (int j0 = 0; j0 < NSLOT; j0 += 2) {
                    if (j0 * NTHR < npass) {
                        v4u xb[2][4], ub[2][4];
#pragma unroll
                        for (int q = 0; q < 2; ++q) { unsigned r = rec[j0 + q]; asm volatile("" : "+v"(r));
                            const unsigned xo = (r & 0xffffu) * UPITCH, uo = (r >> 16) * UPITCH;
#pragma unroll
                            for (int hh = 0; hh < 4; ++hh) { xb[q][hh] = *(const LAS v4u*)(XS + xo + 16 * hh); ub[q][hh] = *(const LAS v4u*)(US + uo + 16 * hh); } }
                        __builtin_amdgcn_sched_barrier(0);
#pragma unroll
                        for (int q = 0; q < 2; ++q) { int s = acc[j0 + q];
#pragma unroll
                            for (int hh = 0; hh < 4; ++hh) { const v4u u = ub[q][hh], x = xb[q][hh];
                                s = __builtin_amdgcn_sdot4((int)u.x, (int)x.x, s, false); s = __builtin_amdgcn_sdot4((int)u.y, (int)x.y, s, false); s = __builtin_amdgcn_sdot4((int)u.z, (int)x.z, s, false); s = __builtin_amdgcn_sdot4((int)u.w, (int)x.w, s, false); }
                            acc[j0 + q] = s; }
                        __builtin_amdgcn_sched_barrier(0);
                    }
                }
            }
#undef P11B_SRC
#pragma unroll
            for (int j = 0; j < NSLOT; ++j) { const int idx = g0 + j * NTHR + tid; const unsigned r = idx < n ? REC[(size_t)b * REC_CAP + idx] : 0xffffffffu;
                if (r != 0xffffffffu) { const int t = tt * 1024 + (int)((r >> 17) & 1023), e = et * ETSZ + (int)((r >> 7) & 511), j7 = (int)(r & 127);
                    const float hv = (float)acc[j] * SU[e] * SXR[2 * t]; AVg[(size_t)t * 128 + j7] = gelu_erf(hv) * GATEg[(size_t)t * 128 + j7] * SV[e]; } }
        }
    }
}

__device__ __forceinline__ void p11c_vsum(Frame& F) {
    const int gw = F.vcu * NWAVES + F.wave, NGW = F.G * NWAVES;
    LAS int* EID = (LAS int*)(F.lds + F.wave * 16384); LAS float* AV = (LAS float*)(EID + 128);
    const unsigned char* TV = F.ws + WS_TV; const int* EIDg = (const int*)(F.ws + WS_EID); const float* AVg = (const float*)(F.ws + WS_AV);
    for (int m = gw; m < SEQ; m += NGW) {
        int lane = F.lane; asm volatile("" : "+v"(lane));
        const int lo16 = lane * 16;
        EID[lane] = EIDg[(size_t)m * 128 + lane]; EID[lane + 64] = EIDg[(size_t)m * 128 + 64 + lane]; AV[lane] = AVg[(size_t)m * 128 + lane]; AV[lane + 64] = AVg[(size_t)m * 128 + 64 + lane];
        asm volatile("" ::: "memory");
        float y[32]; float sas = 0.f;
#pragma unroll
        for (int e = 0; e < 32; ++e) y[e] = 0.f;
        v4u rv[2][4][2]; float av[2][4];
#define P11C_LOAD(buf, g) do { _Pragma("unroll") for (int q = 0; q < 4; ++q) { const int e = __builtin_amdgcn_readfirstlane(EID[(g) + q]); av[buf][q] = AV[(g) + q]; const unsigned char* rp = TV + (size_t)e * DM + lo16; \
            rv[buf][q][0] = *(const GAS v4u*)(rp); rv[buf][q][1] = *(const GAS v4u*)(rp + 1024); } } while (0)
#define P11C_ACC(buf) do { _Pragma("unroll") for (int q = 0; q < 4; ++q) { const float a = av[buf][q]; sas += a; \
            _Pragma("unroll") for (int j = 0; j < 2; ++j) { const v4u r = rv[buf][q][j]; const unsigned wv[4] = {r.x, r.y, r.z, r.w}; \
                _Pragma("unroll") for (int dd = 0; dd < 4; ++dd) { y[16 * j + 4 * dd] += a * cvt_ub0(wv[dd]); y[16 * j + 4 * dd + 1] += a * cvt_ub1(wv[dd]); y[16 * j + 4 * dd + 2] += a * cvt_ub2(wv[dd]); y[16 * j + 4 * dd + 3] += a * cvt_ub3(wv[dd]); } } \
            __builtin_amdgcn_sched_barrier(0); } } while (0)
        P11C_LOAD(0, 0);
#pragma unroll 1
        for (int g = 0; g < 128; g += 8) {
            P11C_LOAD(1, g + 4);
            P11C_ACC(0);
            if (g + 8 < 128) P11C_LOAD(0, g + 8);
            P11C_ACC(1);
        }
#undef P11C_LOAD
#undef P11C_ACC
        const float* x1 = F.out + (size_t)m * DM;
        float s2 = 0.f; const float corr = 128.0f * sas;
#pragma unroll
        for (int j = 0; j < 2; ++j)
#pragma unroll
            for (int q = 0; q < 4; ++q) { const f32x4 a = *(const GAS f32x4*)(x1 + j * 1024 + lo16 + 4 * q);
                y[16 * j + 4 * q] += a.x - corr; y[16 * j + 4 * q + 1] += a.y - corr; y[16 * j + 4 * q + 2] += a.z - corr; y[16 * j + 4 * q + 3] += a.w - corr; }
#pragma unroll
        for (int e = 0; e < 32; ++e) s2 += y[e] * y[e];
        const float ro = 1.0f / sqrtf(wave_sum(s2) * (1.f / DM) + EPS);
        float* orow = F.out + (size_t)m * DM;
#pragma unroll
        for (int j = 0; j < 2; ++j)
#pragma unroll
            for (int q = 0; q < 4; ++q) { const f32x4 a = *(const GAS f32x4*)(F.in[I_FNW] + j * 1024 + lo16 + 4 * q);
                *(GAS f32x4*)(orow + j * 1024 + lo16 + 4 * q) = (f32x4){y[16 * j + 4 * q] * ro * a.x, y[16 * j + 4 * q + 1] * ro * a.y, y[16 * j + 4 * q + 2] * ro * a.z, y[16 * j + 4 * q + 3] * ro * a.w}; }
    }
}
#ifndef MK_N_LAUNCHES
#define MK_N_LAUNCHES 1
#endif
constexpr int N_PHASES = 14;
constexpr int N_LAUNCHES = MK_N_LAUNCHES;
static_assert(N_LAUNCHES == 1 || N_LAUNCHES == N_PHASES, "MK_N_LAUNCHES is 1 or N_PHASES");
#ifndef PG8_SP2
#define PG8_SP2 true
#endif
#ifndef PG8_ALIGN
#define PG8_ALIGN true
#endif
struct Args { const float* in[19]; float* out; unsigned char* ws; int ph_lo, ph_hi; };
__global__ void __launch_bounds__(NTHR, 2) fwd_kernel(Args args) {
    extern __shared__ __attribute__((aligned(16))) unsigned char lds[];
    Frame F;
    F.lds = (LAS unsigned char*)lds;
    F.MISC = (volatile LAS unsigned*)(F.lds + MISC_OFF);
    F.tid = threadIdx.x; F.lane = F.tid & 63; F.wave = __builtin_amdgcn_readfirstlane(F.tid >> 6);
    F.G = gridDim.x; { const int bx = blockIdx.x; F.vcu = (F.G % 8 == 0) ? (bx % 8) * (F.G / 8) + bx / 8 : bx; }
    F.ws = args.ws; F.out = args.out; F.ctl = (gu32*)(args.ws + WS_CTL);
#pragma unroll
    for (int i = 0; i < 19; ++i) F.in[i] = args.in[i];
    for (int u = F.tid; u < (LDS_BYTES - MISC_OFF) / 4; u += NTHR) ((LAS unsigned*)(F.lds + MISC_OFF))[u] = 0u;
    __syncthreads();
    XcdBarrier bar; bar.bar = (unsigned*)(F.ctl + CW_BAR); bar.x = 0; bar.st = nullptr;
    if (N_LAUNCHES == 1) bar = xcd_barrier_post((unsigned*)(F.ctl + CW_BAR), F.MISC + 8);
    const int lo = args.ph_lo, hi = args.ph_hi;
#ifdef ONLY_PHASE
#define IN(k) ((k) == ONLY_PHASE && lo <= (k) && (k) < hi)
#else
#define IN(k) (lo <= (k) && (k) < hi)
#endif
#define SEAM(k) do { if (IN(k) && IN((k) + 1)) xcd_barrier(bar); } while (0)
#ifndef REPEAT_MASK
#define REPEAT_MASK 0
#endif
#ifndef P11A_SKIP
#define P11A_SKIP 0
#endif
#define REPS(k) for (int rep_ = 0; rep_ < (((REPEAT_MASK) >> (k)) & 1) + 1; ++rep_)
#define RSEAM(k) do { if ((((REPEAT_MASK) >> (k)) & 1) && rep_ == 0) xcd_barrier(bar); } while (0)
    unsigned char* ws = args.ws;
    if (IN(0)) { REPS(0) { p0_prologue(F); RSEAM(0); } SEAM(0); }
    if (IN(1)) {
        pg8::Gemm g{(const bf16*)(ws + WS_XN), (const bf16*)(ws + WS_W1), SEQ, N1, DM}; pg8::StaticOrder S; S.init(SEQ, N1, F.G, (int)blockIdx.x);
        EpiG1 E{ws, F.in[I_LB]};
        if ((REPEAT_MASK >> 1) & 1) { pg8::gemm_phase<EpiG1, pg8::StaticOrder, PG8_ALIGN, PG8_SP2>(F.lds, g, S, E); xcd_barrier(bar); }
        pg8::gemm_phase<EpiG1, pg8::StaticOrder, PG8_ALIGN, PG8_SP2>(F.lds, g, S, E);
        p1_ab(F);
        SEAM(1);
    }
#ifdef EXTRA_BARRIERS
    for (int eb = 0; eb < EXTRA_BARRIERS; ++eb) xcd_barrier(bar);
#endif
    if (IN(2)) { REPS(2) { hgrn_pass<false>(F); RSEAM(2); } SEAM(2); }
    if (IN(3)) { if ((REPEAT_MASK >> 3) & 1) { hgrn_pass<true, P11A_SKIP>(F); xcd_barrier(bar); } hgrn_pass<true>(F); SEAM(3); }
    if (IN(4)) { if ((REPEAT_MASK >> 4) & 1) { gdn_prep<P11A_SKIP>(F); xcd_barrier(bar); } gdn_prep<0>(F); SEAM(4); }
    if (IN(5)) { if ((REPEAT_MASK >> 5) & 1) { gdn_pass<false, P11A_SKIP>(F); xcd_barrier(bar); } gdn_pass<false>(F); SEAM(5); }
    if (IN(6)) { if ((REPEAT_MASK >> 6) & 1) { gdn_pass<true, P11A_SKIP>(F); xcd_barrier(bar); } gdn_pass<true>(F); SEAM(6); }
    if (IN(7)) { REPS(7) { p7_mix(F); RSEAM(7); } SEAM(7); }
    if (IN(8)) {
        pg8::StaticOrder S; S.init(SEQ, DM, F.G, (int)blockIdx.x);
        bf16* GT = (bf16*)(ws + WS_GT); bf16* GT2 = (bf16*)(ws + WS_GT2);
#define P8_BODY \
        { pg8::Gemm g{(const bf16*)(ws + WS_XN), (const bf16*)(ws + WS_WG), SEQ, DM, DM}; EpiGate E{GT}; pg8::gemm_phase<EpiGate, pg8::StaticOrder, PG8_ALIGN, PG8_SP2>(F.lds, g, S, E); } \
        __builtin_amdgcn_fence(__ATOMIC_ACQUIRE, "agent"); VM_WAIT(); __syncthreads(); \
        { pg8::Gemm g{(const bf16*)(ws + WS_YA), (const bf16*)(ws + WS_WPA), SEQ, DM, HW}; EpiMix<0> E{GT, nullptr}; pg8::gemm_phase<EpiMix<0>, pg8::StaticOrder, PG8_ALIGN, PG8_SP2>(F.lds, g, S, E); } \
        { pg8::Gemm g{(const bf16*)(ws + WS_XN), (const bf16*)(ws + WS_WG) + (size_t)DM * DM, SEQ, DM, DM}; EpiGate E{GT2}; pg8::gemm_phase<EpiGate, pg8::StaticOrder, PG8_ALIGN, PG8_SP2>(F.lds, g, S, E); } \
        __builtin_amdgcn_fence(__ATOMIC_ACQUIRE, "agent"); VM_WAIT(); __syncthreads(); \
        { pg8::Gemm g{(const bf16*)(ws + WS_YB), (const bf16*)(ws + WS_WPB), SEQ, DM, HW}; EpiMix<1> E{GT, GT2}; pg8::gemm_phase<EpiMix<1>, pg8::StaticOrder, PG8_ALIGN, PG8_SP2>(F.lds, g, S, E); }
        if ((REPEAT_MASK >> 8) & 1) { P8_BODY xcd_barrier(bar); }
        P8_BODY
#undef P8_BODY
        SEAM(8);
    }
    if (IN(9)) {
        pg8::Gemm g{(const bf16*)(ws + WS_GT), (const bf16*)(ws + WS_WOUT), SEQ, DM, DM}; pg8::StaticOrder S; S.init(SEQ, DM, F.G, (int)blockIdx.x);
        EpiX1 E{F.in[I_X], F.out, (bf16*)(ws + WS_X1B)};
        if ((REPEAT_MASK >> 9) & 1) { pg8::gemm_phase<EpiX1, pg8::StaticOrder, PG8_ALIGN, PG8_SP2>(F.lds, g, S, E); xcd_barrier(bar); }
        pg8::gemm_phase<EpiX1, pg8::StaticOrder, PG8_ALIGN, PG8_SP2>(F.lds, g, S, E);
        SEAM(9);
    }
    if (IN(10)) {
        pg8::Gemm g{(const bf16*)(ws + WS_X1B), (const bf16*)(ws + WS_WS), SEQ, DM, DM}; pg8::StaticOrder S; S.init(SEQ, DM, F.G, (int)blockIdx.x);
        EpiBf E{(bf16*)(ws + WS_SC)};
        if ((REPEAT_MASK >> 10) & 1) { pg8::gemm_phase<EpiBf, pg8::StaticOrder, PG8_ALIGN, PG8_SP2>(F.lds, g, S, E); xcd_barrier(bar); }
        pg8::gemm_phase<EpiBf, pg8::StaticOrder, PG8_ALIGN, PG8_SP2>(F.lds, g, S, E);
        SEAM(10);
    }
    if (IN(11)) {
        if ((REPEAT_MASK >> 11) & 1) { p11a_topk<P11A_SKIP>(F); xcd_barrier(bar); if (blockIdx.x == 0) for (int i = F.tid; i < NBUCK + 1; i += NTHR) __hip_atomic_store((unsigned*)(F.ctl + CW_CNT) + i * 16, 0u, __ATOMIC_RELAXED, __HIP_MEMORY_SCOPE_AGENT); xcd_barrier(bar); }
        p11a_topk<0>(F); SEAM(11); }
    if (IN(12)) { if ((REPEAT_MASK >> 12) & 1) { p11b_udot(F); xcd_barrier(bar); if (blockIdx.x == 0 && F.tid == 0) __hip_atomic_store((unsigned*)(F.ctl + CW_Q), 0u, __ATOMIC_RELAXED, __HIP_MEMORY_SCOPE_AGENT); xcd_barrier(bar); } p11b_udot(F); SEAM(12); }
    if (IN(13)) { p11c_vsum(F); }
#undef IN
#undef SEAM
}


#ifdef PROBE
__global__ void digest_kernel(const unsigned* ws, float* out) {
    const size_t n = (size_t)SEQ * DM;
    for (size_t i = (size_t)blockIdx.x * blockDim.x + threadIdx.x; i < n; i += (size_t)gridDim.x * blockDim.x) {
        unsigned acc = (PROBE >= 9) ? __builtin_bit_cast(unsigned, out[i]) : 0u;
        const size_t offs[5] = {0, 128 * MiB / 4, 256 * MiB / 4, 384 * MiB / 4, 408 * MiB / 4};
#pragma unroll
        for (int r = 0; r < 5; ++r) acc = acc * 1664525u + ws[offs[r] + i];
        out[i] = (float)(acc >> 8) * (1.0f / 16777216.0f);
    }
}
#endif
extern "C" void kernel_launch(void* const* d_in, const int* in_sizes, int n_in, void* d_out, int out_size, void* d_ws, size_t ws_size, hipStream_t stream) {
    static int grid = 0;
    if (grid == 0) {
        if (n_in != 19 || in_sizes[0] != SEQ * DM || out_size != SEQ * DM || ws_size < WS_END) { fprintf(stderr, "kernel_launch: unexpected shapes (n_in %d, in0 %d, out %d, ws %zu; need ws >= %zu)\n", n_in, n_in > 0 ? in_sizes[0] : -1, out_size, ws_size, (size_t)WS_END); grid = -1; return; }
        int dev = 0, cus = 0, per_cu = 0;
        if (hipGetDevice(&dev) != hipSuccess || hipDeviceGetAttribute(&cus, hipDeviceAttributeMultiprocessorCount, dev) != hipSuccess) { grid = -1; return; }
        if (hipFuncSetAttribute((const void*)fwd_kernel, hipFuncAttributeMaxDynamicSharedMemorySize, LDS_BYTES) != hipSuccess) { fprintf(stderr, "kernel_launch: hipFuncSetAttribute failed\n"); grid = -1; return; }
        if (hipOccupancyMaxActiveBlocksPerMultiprocessor(&per_cu, (const void*)fwd_kernel, NTHR, LDS_BYTES) != hipSuccess || per_cu < 1) fprintf(stderr, "kernel_launch: occupancy query reports %d\n", per_cu);
        (void)hipGetLastError();
        grid = cus;
    }
    if (grid < 0) return;
    (void)hipMemsetAsync((char*)d_ws + WS_CTL, 0, CTL_ZERO_BYTES, stream);
    Args a{};
    for (int i = 0; i < 19; ++i) a.in[i] = (const float*)d_in[i];
    a.out = (float*)d_out; a.ws = (unsigned char*)d_ws;
    for (int li = 0; li < N_LAUNCHES; ++li) {
        a.ph_lo = (N_LAUNCHES == 1) ? 0 : li; a.ph_hi = (N_LAUNCHES == 1) ? N_PHASES : li + 1;
#ifdef PROBE
        if (li > PROBE) break;
#endif
        hipLaunchKernelGGL(fwd_kernel, dim3(grid), dim3(NTHR), LDS_BYTES, stream, a);
    }
#ifdef PROBE
    hipLaunchKernelGGL(digest_kernel, dim3(2048), dim3(256), 0, stream, (const unsigned*)d_ws, (float*)d_out);
#endif
}
```

```cpp
#include <hip/hip_runtime.h>
#include <cstdio>
#include <cstdint>
#define GAS __attribute__((address_space(1)))
#define LAS __attribute__((address_space(3)))
#define MK_N_LAUNCHES 1
namespace pg8 {
#define PG8_LAS __attribute__((address_space(3)))
typedef unsigned short bf16_t;
typedef short bf16x8 __attribute__((ext_vector_type(8)));
typedef float f32x4 __attribute__((ext_vector_type(4)));
typedef unsigned u32x4 __attribute__((ext_vector_type(4)));
constexpr int BM = 256, BK = 64, HALF = 128, HTB = HALF * BK * 2  , STAGE_BYTES = 8 * HTB, NXCD = 8, WGM = 8;

__host__ __device__ __forceinline__ int lds_byte(int r, int c) { const int st = (r >> 4) * 2 + (c >> 5), rr = r & 15, cc = c & 31, ob = rr * 64 + cc * 2; return st * 1024 + (ob ^ (((ob >> 9) & 1) << 5)); }
__host__ __device__ __forceinline__ void stage_rc(int b, int& R, int& C) { const int st = b / 1024, sb = b % 1024, swz = sb ^ (((sb >> 9) & 1) << 5); R = (st >> 1) * 16 + swz / 64; C = (st & 1) * 32 + (swz % 64) / 2; }
__host__ __device__ __forceinline__ int perm32(int rho) { const int n = rho >> 4, i = rho & 15; return 8 * (i >> 2) + 4 * n + (i & 3); }

struct Unit { int pm, pn; };
struct Gemm { const bf16_t* A; const bf16_t* Bt; int M, N, K; };

struct StaticOrder {
    int nM, nN, nwg, G, c;
    __host__ __device__ void init(int M, int N, int G_, int c_) { nM = M / BM; nN = N / BM; nwg = nM * nN; G = G_; c = c_; }
    __host__ __device__ bool next(int i, Unit& u) const {
        const long L = (long)i * G + c; if (L >= nwg) return false;
        int wgid = (int)L; { const int q = nwg / NXCD, r = nwg % NXCD, xcd = wgid % NXCD, off = wgid / NXCD; wgid = (xcd < r ? xcd * (q + 1) : r * (q + 1) + (xcd - r) * q) + off; }
        const int nig = WGM * nN, gid = wgid / nig, fm = gid * WGM, gsz = (nM - fm) < WGM ? (nM - fm) : WGM;
        u.pm = fm + ((wgid % nig) % gsz); u.pn = (wgid % nig) / gsz; return true;
    }
    __device__ __forceinline__ void a_ready(const Unit&) const {}
    __device__ __forceinline__ void done(const Unit&) const {}
};

__device__ __forceinline__ unsigned cvt_pk_bf16(float lo, float hi) { unsigned r; asm volatile("v_cvt_pk_bf16_f32 %0, %1, %2" : "=v"(r) : "v"(lo), "v"(hi)); return r; }
typedef float f32x2 __attribute__((ext_vector_type(2)));
__device__ __forceinline__ f32x2 gelu_pk(f32x2 v) {
    const f32x2 av = __builtin_elementwise_abs(v), d = av * 0.2316418882f + 1.0f;
    f32x2 t; t.x = __builtin_amdgcn_rcpf(d.x); t.y = __builtin_amdgcn_rcpf(d.y);
    f32x2 q = t * 0.5307027145f + (-0.7265760135f); q = q * t + 0.7107068705f; q = q * t + (-0.142248368f); q = q * t + 0.127414796f; q = q * t;
    const f32x2 s = (v * v) * (-0.72134752044f);
    f32x2 e; e.x = __builtin_amdgcn_exp2f(s.x); e.y = __builtin_amdgcn_exp2f(s.y);
    const f32x2 m = v * (q * e), r = v - m;
    f32x2 o; o.x = v.x < 0.f ? m.x : r.x; o.y = v.y < 0.f ? m.y : r.y; return o;
}

template <class Epi, class Sched, bool ALIGN_EPI = false, bool SP2 = false>
__device__ __forceinline__ void gemm_phase(PG8_LAS unsigned char* lds, const Gemm g, const Sched& S, const Epi& E) {
    const int tid = threadIdx.x, wid = __builtin_amdgcn_readfirstlane(tid >> 6), lane = tid & 63, wr = wid >> 2, wc = wid & 3, fr = lane & 15, fq = lane >> 4;
    const int K = g.K, nt = K / BK;
    unsigned voffA[2], voffB[2];
#pragma unroll
    for (int i = 0; i < 2; ++i) { int R, C; stage_rc(tid * 16 + i * 8192, R, C); const int Rb = Epi::PERM ? ((R & ~31) + perm32(R & 31)) : R;
        voffA[i] = (unsigned)(R * K + C) * 2u; voffB[i] = (unsigned)(Rb * K + C) * 2u; }
    const size_t kstep = (size_t)(BK * 2);
    const size_t hstep = (size_t)HALF * K * 2;
    const size_t tstep = 2 * hstep;
    const unsigned ldsw = (unsigned)wid * 1024u;
    const int aoff = lds_byte(wr * 64 + fr, fq * 8), boff = lds_byte(wc * 32 + fr, fq * 8);
#define PG8_SA(b, h) (((b) * 2 + (h)) * HTB)
#define PG8_SB(b, h) ((4 + (b) * 2 + (h)) * HTB)
#define PG8_STAGE(bufoff, gbase, voff) do { _Pragma("unroll") for (int _i = 0; _i < 2; ++_i) \
        __builtin_amdgcn_global_load_lds((const unsigned*)((const char*)(gbase) + (voff)[_i]), (PG8_LAS unsigned*)(lds + (bufoff) + ldsw + _i * 8192), 16, 0, 0); } while (0)
#define PG8_LDA(dst, b, h) do { _Pragma("unroll") for (int m = 0; m < 4; ++m) _Pragma("unroll") for (int k = 0; k < 2; ++k) dst[m][k] = *(const PG8_LAS bf16x8*)(lds + PG8_SA(b, h) + aoff + m * 2048 + k * 1024); } while (0)
#define PG8_LDB(dst, b, h) do { _Pragma("unroll") for (int n = 0; n < 2; ++n) _Pragma("unroll") for (int k = 0; k < 2; ++k) dst[n][k] = *(const PG8_LAS bf16x8*)(lds + PG8_SB(b, h) + boff + n * 2048 + k * 1024); } while (0)
#define PG8_MMA(ai, bj, At, Bt) do { __builtin_amdgcn_s_setprio(1); _Pragma("unroll") for (int m = 0; m < 4; ++m) _Pragma("unroll") for (int n = 0; n < 2; ++n) _Pragma("unroll") for (int k = 0; k < 2; ++k) \
        acc[ai][bj][m][n] = __builtin_amdgcn_mfma_f32_16x16x32_bf16(Bt[n][k], At[m][k], acc[ai][bj][m][n], 0, 0, 0); __builtin_amdgcn_s_setprio(0); } while (0)
#define PG8_WAIT_V(n) asm volatile("s_waitcnt vmcnt(" #n ")" ::: "memory")
#define PG8_WAIT_L(n) asm volatile("s_waitcnt lgkmcnt(" #n ")" ::: "memory")
#define PG8_BAR __builtin_amdgcn_s_barrier()
#define PG8_SCHED __builtin_amdgcn_sched_barrier(0)
    Unit cur, nxt; int ui = 0;
    if (!S.next(0, cur)) return;
    f32x4 acc[2][2][4][2];
#pragma unroll
    for (int a = 0; a < 2; ++a)
#pragma unroll
        for (int b = 0; b < 2; ++b)
#pragma unroll
            for (int m = 0; m < 4; ++m)
#pragma unroll
                for (int n = 0; n < 2; ++n) acc[a][b][m][n] = (f32x4){0.f, 0.f, 0.f, 0.f};
    bf16x8 At[4][2], B0[2][2], B1[2][2];
    const char* cA = (const char*)g.A + (size_t)cur.pm * tstep; const char* cB = (const char*)g.Bt + (size_t)cur.pn * tstep;
    S.a_ready(cur);
    if constexpr (SP2) {
        PG8_STAGE(PG8_SB(0, 0), cB, voffB); PG8_STAGE(PG8_SB(0, 1), cB + hstep, voffB); PG8_STAGE(PG8_SA(0, 0), cA, voffA); PG8_STAGE(PG8_SA(0, 1), cA + hstep, voffA);
        if (wr == 1) PG8_BAR;
        PG8_WAIT_V(2); PG8_BAR;
        PG8_STAGE(PG8_SB(1, 0), cB + kstep, voffB); PG8_STAGE(PG8_SA(1, 0), cA + kstep, voffA); PG8_STAGE(PG8_SB(1, 1), cB + hstep + kstep, voffB);
        PG8_WAIT_V(6); PG8_BAR;
    } else {
        PG8_STAGE(PG8_SB(0, 0), cB, voffB); PG8_STAGE(PG8_SA(0, 0), cA, voffA); PG8_STAGE(PG8_SB(0, 1), cB + hstep, voffB); PG8_STAGE(PG8_SA(0, 1), cA + hstep, voffA);
        if (wr == 1) PG8_BAR;
        PG8_WAIT_V(4); PG8_BAR;
        PG8_STAGE(PG8_SB(1, 0), cB + kstep, voffB); PG8_STAGE(PG8_SA(1, 0), cA + kstep, voffA); PG8_STAGE(PG8_SB(1, 1), cB + hstep + kstep, voffB);
        PG8_WAIT_V(6); PG8_BAR;
    }
    for (;;) {
        const bool has_next = S.next(ui + 1, nxt);
        const char* nA = has_next ? (const char*)g.A + (size_t)nxt.pm * tstep : cA; const char* nB = has_next ? (const char*)g.Bt + (size_t)nxt.pn * tstep : cB;
        for (int t = 0; t < nt; t += 2) {
            const bool last = (t == nt - 2);
            const char* a1 = cA + (size_t)(t + 1) * kstep;
            const char* a2 = last ? nA : cA + (size_t)(t + 2) * kstep; const char* b2 = last ? nB : cB + (size_t)(t + 2) * kstep;
            const char* a3 = a2 + kstep; const char* b3 = b2 + kstep;
            if (last && has_next) S.a_ready(nxt);
            if constexpr (SP2) {
            PG8_LDB(B0, 0, 0); PG8_LDB(B1, 0, 1); PG8_SCHED; PG8_LDA(At, 0, 0); PG8_STAGE(PG8_SA(1, 1), a1 + hstep, voffA);
            PG8_WAIT_V(8); PG8_WAIT_L(0); PG8_BAR; PG8_MMA(0, 0, At, B0); PG8_MMA(0, 1, At, B1); PG8_BAR; PG8_SCHED;
            PG8_LDA(At, 0, 1); PG8_STAGE(PG8_SB(0, 0), b2, voffB); PG8_STAGE(PG8_SB(0, 1), b2 + hstep, voffB); PG8_STAGE(PG8_SA(0, 0), a2, voffA);
            PG8_WAIT_V(8); PG8_WAIT_L(0); PG8_BAR; PG8_MMA(1, 0, At, B0); PG8_MMA(1, 1, At, B1); PG8_BAR; PG8_SCHED;
            PG8_LDB(B0, 1, 0); PG8_LDB(B1, 1, 1); PG8_SCHED; PG8_LDA(At, 1, 0); PG8_STAGE(PG8_SA(0, 1), a2 + hstep, voffA);
            PG8_WAIT_V(8); PG8_WAIT_L(0); PG8_BAR; PG8_MMA(0, 0, At, B0); PG8_MMA(0, 1, At, B1); PG8_BAR; PG8_SCHED;
            PG8_LDA(At, 1, 1); PG8_STAGE(PG8_SB(1, 0), b3, voffB); PG8_STAGE(PG8_SB(1, 1), b3 + hstep, voffB); PG8_STAGE(PG8_SA(1, 0), a3, voffA);
            PG8_WAIT_V(8); PG8_WAIT_L(0); PG8_BAR; PG8_MMA(1, 0, At, B0); PG8_MMA(1, 1, At, B1); PG8_BAR; PG8_SCHED;
            } else {
            PG8_LDB(B0, 0, 0); PG8_SCHED; PG8_LDA(At, 0, 0); PG8_STAGE(PG8_SA(1, 1), a1 + hstep, voffA);
            PG8_WAIT_L(8); PG8_BAR; PG8_WAIT_L(0); PG8_MMA(0, 0, At, B0); PG8_BAR; PG8_SCHED;
            PG8_LDB(B1, 0, 1); PG8_STAGE(PG8_SB(0, 0), b2, voffB);
            PG8_BAR; PG8_WAIT_L(0); PG8_MMA(0, 1, At, B1); PG8_BAR;
            PG8_LDA(At, 0, 1); PG8_STAGE(PG8_SA(0, 0), a2, voffA);
            PG8_BAR; PG8_WAIT_L(0); PG8_MMA(1, 0, At, B0); PG8_BAR; PG8_SCHED;
            PG8_STAGE(PG8_SB(0, 1), b2 + hstep, voffB);
            PG8_WAIT_V(6); PG8_BAR; PG8_MMA(1, 1, At, B1); PG8_BAR;
            PG8_LDB(B0, 1, 0); PG8_SCHED; PG8_LDA(At, 1, 0); PG8_STAGE(PG8_SA(0, 1), a2 + hstep, voffA);
            PG8_WAIT_L(8); PG8_BAR; PG8_WAIT_L(0); PG8_MMA(0, 0, At, B0); PG8_BAR; PG8_SCHED;
            PG8_LDB(B1, 1, 1); PG8_STAGE(PG8_SB(1, 0), b3, voffB);
            PG8_BAR; PG8_WAIT_L(0); PG8_MMA(0, 1, At, B1); PG8_BAR;
            PG8_LDA(At, 1, 1); PG8_STAGE(PG8_SA(1, 0), a3, voffA);
            PG8_BAR; PG8_WAIT_L(0); PG8_MMA(1, 0, At, B0); PG8_BAR; PG8_SCHED;
            PG8_STAGE(PG8_SB(1, 1), b3 + hstep, voffB);
            PG8_WAIT_V(6); PG8_BAR; PG8_MMA(1, 1, At, B1); PG8_BAR;
            }
        }
        if constexpr (ALIGN_EPI) { if (wr == 0) PG8_BAR; }
        if constexpr (!Epi::AFTER_DRAIN) { E(acc, cur, wr, wc, fr, fq); S.done(cur); }
        if (!has_next) break;
#pragma unroll
        for (int a = 0; a < 2; ++a)
#pragma unroll
            for (int b = 0; b < 2; ++b)
#pragma unroll
                for (int m = 0; m < 4; ++m)
#pragma unroll
                    for (int n = 0; n < 2; ++n) acc[a][b][m][n] = (f32x4){0.f, 0.f, 0.f, 0.f};
        cur = nxt; cA = nA; cB = nB; ++ui;
        if constexpr (ALIGN_EPI) { if (wr == 1) PG8_BAR; }
    }
    PG8_WAIT_V(0);
    if constexpr (!ALIGN_EPI) { if (wr == 0) PG8_BAR; }
    PG8_BAR;
    if constexpr (Epi::AFTER_DRAIN) { E.fused(acc, cur, wr, wc, fr, fq, lds, wid, lane); S.done(cur); }
#undef PG8_SA
#undef PG8_SB
#undef PG8_STAGE
#undef PG8_LDA
#undef PG8_LDB
#undef PG8_MMA
#undef PG8_WAIT_V
#undef PG8_WAIT_L
#undef PG8_BAR
#undef PG8_SCHED
}
}
typedef unsigned short bf16;
typedef unsigned v4u __attribute__((ext_vector_type(4)));
typedef unsigned v2u __attribute__((ext_vector_type(2)));
typedef float f32x4 __attribute__((ext_vector_type(4)));
typedef float f32x2 __attribute__((ext_vector_type(2)));
typedef short bf16x8 __attribute__((ext_vector_type(8)));
typedef GAS unsigned gu32;
#define RLX_AGENT __ATOMIC_RELAXED, __HIP_MEMORY_SCOPE_AGENT
#define LDS_WAIT() asm volatile("s_waitcnt lgkmcnt(0)" ::: "memory")
#define VM_WAIT() asm volatile("s_waitcnt vmcnt(0)" ::: "memory")
typedef __bf16 bf16x2_hw __attribute__((ext_vector_type(2)));
__device__ __forceinline__ unsigned pk2(float lo, float hi) { const f32x2 v = {lo, hi}; const bf16x2_hw b = __builtin_convertvector(v, bf16x2_hw); return __builtin_bit_cast(unsigned, b); }
__device__ __forceinline__ unsigned f2bf(float f) { return pk2(f, 0.f) & 0xffffu; }
__device__ __forceinline__ float bflo(unsigned w) { return __builtin_bit_cast(float, w << 16); }
__device__ __forceinline__ float bfhi(unsigned w) { return __builtin_bit_cast(float, w & 0xffff0000u); }
__device__ __forceinline__ float bf1(bf16 b) { return __builtin_bit_cast(float, ((unsigned)b) << 16); }
__device__ __forceinline__ float fast_exp(float x) { return __builtin_amdgcn_exp2f(x * 1.4426950408889634f); }
__device__ __forceinline__ float fast_rcp(float x) { return __builtin_amdgcn_rcpf(x); }
__device__ __forceinline__ float sigmoidf_(float x) { return fast_rcp(1.0f + fast_exp(-x)); }
__device__ __forceinline__ float siluf_(float x) { return x * sigmoidf_(x); }
template <int CTRL> __device__ __forceinline__ float dppf(float v) { return __builtin_bit_cast(float, __builtin_amdgcn_mov_dpp(__builtin_bit_cast(int, v), CTRL, 0xF, 0xF, true)); }
template <int CTRL> __device__ __forceinline__ int dppi(int v) { return __builtin_amdgcn_mov_dpp(v, CTRL, 0xF, 0xF, true); }
__device__ __forceinline__ float rdl(float v, int l) { return __builtin_bit_cast(float, __builtin_amdgcn_readlane(__builtin_bit_cast(int, v), l)); }
__device__ __forceinline__ float wave_sum(float v) {
    v += dppf<0xB1>(v); v += dppf<0x4E>(v); v += dppf<0x141>(v); v += dppf<0x140>(v);
    return (rdl(v, 0) + rdl(v, 16)) + (rdl(v, 32) + rdl(v, 48));
}
__device__ __forceinline__ float wave_max(float v) {
    v = fmaxf(v, dppf<0xB1>(v)); v = fmaxf(v, dppf<0x4E>(v)); v = fmaxf(v, dppf<0x141>(v)); v = fmaxf(v, dppf<0x140>(v));
    return fmaxf(fmaxf(rdl(v, 0), rdl(v, 16)), fmaxf(rdl(v, 32), rdl(v, 48)));
}
__device__ __forceinline__ int wave_sum_i(int v) {
    v += dppi<0xB1>(v); v += dppi<0x4E>(v); v += dppi<0x141>(v); v += dppi<0x140>(v);
    return (__builtin_amdgcn_readlane(v, 0) + __builtin_amdgcn_readlane(v, 16)) + (__builtin_amdgcn_readlane(v, 32) + __builtin_amdgcn_readlane(v, 48));
}

constexpr int NWAVES = 8, NTHR = 512;
constexpr int SEQ = 16384, DM = 2048, NH = 8, HD = 128, HW = 1024;
constexpr int CK = 64, NCHUNK = SEQ / CK, NSEG = 16, CPS = NCHUNK / NSEG;
constexpr int INW = 13344;
constexpr int N1 = 9216;
constexpr float EPS = 1e-6f;
constexpr int PEER_K = 16;

constexpr size_t MiB = (size_t)1 << 20;
constexpr size_t WS_CTL = 0, CTL_ZERO_BYTES = 1 * MiB;
constexpr size_t WS_WG = 2 * MiB, WS_WPA = 18 * MiB, WS_WPB = 22 * MiB, WS_WOUT = 26 * MiB, WS_WS = 34 * MiB, WS_W1 = 42 * MiB;
constexpr size_t WS_XN = 80 * MiB;
constexpr size_t WS_H = 144 * MiB;
constexpr size_t WS_GAB = 432 * MiB;
constexpr size_t WS_HL = 434 * MiB;
constexpr size_t WS_HDS = 450 * MiB;
constexpr size_t WS_OHF = 452 * MiB, WS_OHB = 484 * MiB;
constexpr size_t WS_GSC = 516 * MiB;
constexpr size_t WS_UTF = 144 * MiB, WS_UTB = 176 * MiB, WS_WF = 208 * MiB, WS_WB = 240 * MiB;
constexpr size_t DO_AQKF = 0, DO_AQKB = 16 * MiB, DO_QN = 32 * MiB, DO_KNT = 64 * MiB;
constexpr size_t WS_GL = 42 * MiB, WS_GP = 58 * MiB;
constexpr size_t WS_OGF = 304 * MiB, WS_OGB = 336 * MiB;
constexpr size_t WS_YA = 42 * MiB, WS_YB = 368 * MiB;
constexpr size_t WS_TU = 144 * MiB, WS_TV = 176 * MiB;
constexpr size_t WS_PSC = 520 * MiB;
constexpr size_t WS_GT = 272 * MiB, WS_GT2 = 400 * MiB;
constexpr size_t WS_X1B = 80 * MiB;
constexpr size_t WS_SC = 272 * MiB;
constexpr size_t WS_END = 536 * MiB;
constexpr int CW_BAR = 4096;

constexpr int LDS_BYTES = 163840;
constexpr int MISC_OFF = 163840 - 256;
constexpr int LDS_USABLE = MISC_OFF;

__device__ __forceinline__ bf16x8 ldfrag(const LAS bf16* T, int pitch, int row, int k) { return *(const LAS bf16x8*)(T + row * pitch + k); }
__device__ __forceinline__ f32x4 mfma16(bf16x8 x, bf16x8 y, f32x4 c) { return __builtin_amdgcn_mfma_f32_16x16x32_bf16(x, y, c, 0, 0, 0); }
__device__ __forceinline__ v2u pack4(f32x4 v) { v2u r; r.x = pk2(v[0], v[1]); r.y = pk2(v[2], v[3]); return r; }
#define XB_TMO      128
#define XB_XCNT(j)  (256  + 64 * (j))
#define XB_XSUB(j)  (1280 + 64 * (j))
#define XB_XGEN(j)  (2304 + 64 * (j))
#define XB_TOP      3328
#define XB_TOPGEN   3392
#define XCD_BAR_WORDS 3456
#define XB_SPIN_CAP (1u << 18)

__device__ __forceinline__ unsigned xb_ld(unsigned* p)              { return __hip_atomic_load(p, __ATOMIC_RELAXED, __HIP_MEMORY_SCOPE_AGENT); }
__device__ __forceinline__ unsigned xb_add(unsigned* p, unsigned v) { return __hip_atomic_fetch_add(p, v, __ATOMIC_RELAXED, __HIP_MEMORY_SCOPE_AGENT); }
__device__ __forceinline__ unsigned xb_xcc_id() { return (unsigned)__builtin_amdgcn_s_getreg((3 << 11) | 20) & 0xFu; }
#define XB_SPIN(cond, bar) do { unsigned _sp = 0; while (cond) { __builtin_amdgcn_s_sleep(1); \
    if ((++_sp & 255u) == 0u) { if (xb_ld(&(bar)[XB_TMO])) break; if (_sp > XB_SPIN_CAP) { atomicAdd(&(bar)[XB_TMO], 1u); break; } } } } while (0)

struct XcdBarrier {
    unsigned* bar; unsigned x;
    volatile LAS unsigned* st;
};

__device__ __forceinline__ XcdBarrier xcd_barrier_post(unsigned* bar, volatile LAS unsigned* st) {
    XcdBarrier b; b.bar = bar; b.x = xb_xcc_id(); b.st = st;
    if (threadIdx.x == 0) (void)xb_add(&bar[XB_XCNT(b.x)], 1u);
    return b;
}
__device__ __forceinline__ void xcd_barrier_complete(unsigned* bar, unsigned x, unsigned& nloc, unsigned& nx) {
    const unsigned G = gridDim.x * gridDim.y * gridDim.z;
    unsigned sum, cnt, mine, sp = 0u;
    for (;;) {
        sum = 0u; cnt = 0u; mine = 0u;
#pragma unroll
        for (unsigned j = 0; j < 16; ++j) { const unsigned c = xb_ld(&bar[XB_XCNT(j)]); sum += c; cnt += (c > 0u) ? 1u : 0u; mine = (j == x) ? c : mine; }
        if (sum == G) break;
        __builtin_amdgcn_s_sleep(1);
        if ((++sp & 255u) == 0u) { if (xb_ld(&bar[XB_TMO])) break; if (sp > XB_SPIN_CAP) { atomicAdd(&bar[XB_TMO], 1u); break; } }
    }
    nloc = mine > 0u ? mine : 1u; nx = cnt > 0u ? cnt : 1u;
}

__device__ __forceinline__ void xcd_barrier(const XcdBarrier& b) {
    asm volatile("s_waitcnt vmcnt(0)" ::: "memory");
    __syncthreads();
    if (threadIdx.x == 0) {
        unsigned* bar = b.bar;
        __builtin_amdgcn_s_waitcnt(0);
        unsigned nloc = b.st[0], nx = b.st[1];
        if (nloc == 0u) { xcd_barrier_complete(bar, b.x, nloc, nx); b.st[0] = nloc; b.st[1] = nx; }
        const unsigned old = xb_add(&bar[XB_XSUB(b.x)], 1u);
        const unsigned gen = old / nloc;
        if (old + 1u == (gen + 1u) * nloc) {
            __builtin_amdgcn_fence(__ATOMIC_RELEASE, "agent");
            asm volatile("s_waitcnt vmcnt(0)" ::: "memory");
            const unsigned og = xb_add(&bar[XB_TOP], 1u);
            const unsigned tg = og / nx;
            if (og + 1u == (tg + 1u) * nx) xb_add(&bar[XB_TOPGEN], 1u);
            else XB_SPIN(xb_ld(&bar[XB_TOPGEN]) == tg, bar);
            __builtin_amdgcn_fence(__ATOMIC_ACQUIRE, "agent");
            xb_add(&bar[XB_XGEN(b.x)], 1u);
            asm volatile("s_waitcnt vmcnt(0)" ::: "memory");
        } else {
            XB_SPIN(xb_ld(&bar[XB_XGEN(b.x)]) == gen, bar);
            __builtin_amdgcn_fence(__ATOMIC_ACQUIRE, "agent");
            asm volatile("s_waitcnt vmcnt(0)" ::: "memory");
        }
    }
    __syncthreads();
}

struct Frame {
    LAS unsigned char* lds;
    volatile LAS unsigned* MISC;
    gu32* ctl;
    int tid, lane, wave, vcu, G;
    const float* in[19]; float* out; unsigned char* ws;
};
enum { I_X = 0, I_N1W, I_WIN, I_LB, I_HNW, I_CONVW, I_ALOG, I_DTB, I_GNW, I_WPA, I_WPB, I_WOUT, I_N2W, I_WQ, I_K1, I_K2, I_PU, I_PV, I_FNW };

__device__ __forceinline__ void p0_transpose_item(const float* W, int ldw, int c0, int K, int ncols, bf16* WT, int row_off, LAS float* scr, int item, int lane) {
    const int nblk = ncols / 32, kb = item / nblk, nb = item % nblk, k0 = 64 * kb, n0 = 32 * nb;
#pragma unroll 8
    for (int i = 0; i < 32; ++i) { const int kk = 2 * i + (lane >> 5); scr[kk * 33 + (lane & 31)] = W[(size_t)(k0 + kk) * ldw + c0 + n0 + (lane & 31)]; }
    LDS_WAIT(); asm volatile("" ::: "memory");
    const int c = lane & 7;
#pragma unroll
    for (int j = 0; j < 4; ++j) { const int n = (lane >> 3) + 8 * j; const LAS float* s = scr + (8 * c) * 33 + n;
        v4u o; o.x = pk2(s[0 * 33], s[1 * 33]); o.y = pk2(s[2 * 33], s[3 * 33]); o.z = pk2(s[4 * 33], s[5 * 33]); o.w = pk2(s[6 * 33], s[7 * 33]);
        *(GAS v4u*)(WT + (size_t)(row_off + n0 + n) * K + k0 + 8 * c) = o; }
    LDS_WAIT(); asm volatile("" ::: "memory");
}
__device__ __forceinline__ void rms_row_to_bf16(int lane, const float* xrow, const float* w, bf16* orow) {
    const GAS f32x4* xr = (const GAS f32x4*)xrow + lane; const GAS f32x4* wr = (const GAS f32x4*)w + lane;
    f32x4 v[8]; float s = 0.f;
#pragma unroll
    for (int j = 0; j < 8; ++j) { v[j] = xr[64 * j]; s += (v[j].x * v[j].x + v[j].y * v[j].y) + (v[j].z * v[j].z + v[j].w * v[j].w); }
    const float r = 1.0f / sqrtf(wave_sum(s) * (1.f / DM) + EPS);
    GAS v2u* o8 = (GAS v2u*)orow + lane;
#pragma unroll
    for (int j = 0; j < 8; ++j) { const f32x4 ww = wr[64 * j]; v2u o; o.x = pk2(v[j].x * r * ww.x, v[j].y * r * ww.y); o.y = pk2(v[j].z * r * ww.z, v[j].w * r * ww.w); o8[64 * j] = o; }
}
__device__ __forceinline__ void p0_ws_item(Frame& F, int it) {
    const int h = it >> 6, half = (it >> 5) & 1, j0 = (it & 31) * 64, hc = h * 256 + half * 128;
    const float* Wq = F.in[I_WQ]; const float* Ks = half ? F.in[I_K2] : F.in[I_K1]; const float* n2 = F.in[I_N2W];
    LAS bf16* Xs = (LAS bf16*)F.lds; LAS bf16* Ys = Xs + 64 * 136;
    { const int row = F.tid >> 3, c0 = (F.tid & 7) * 16; const GAS f32x4* src = (const GAS f32x4*)(Wq + (size_t)(j0 + row) * DM + hc + c0);
      const f32x4 a = src[0], b = src[1], c = src[2], d = src[3];
      v4u o0, o1; o0.x = pk2(a.x, a.y); o0.y = pk2(a.z, a.w); o0.z = pk2(b.x, b.y); o0.w = pk2(b.z, b.w); o1.x = pk2(c.x, c.y); o1.y = pk2(c.z, c.w); o1.z = pk2(d.x, d.y); o1.w = pk2(d.z, d.w);
      *(LAS v4u*)(Xs + row * 136 + c0) = o0; *(LAS v4u*)(Xs + row * 136 + c0 + 8) = o1; }
    { const int row = F.tid >> 2, c0 = (F.tid & 3) * 32; const GAS f32x4* src = (const GAS f32x4*)(Ks + (size_t)row * 128 + c0);
#pragma unroll
      for (int q = 0; q < 4; ++q) { const f32x4 a = src[2 * q], b = src[2 * q + 1]; v4u o; o.x = pk2(a.x, a.y); o.y = pk2(a.z, a.w); o.z = pk2(b.x, b.y); o.w = pk2(b.z, b.w); *(LAS v4u*)(Ys + row * 136 + c0 + 8 * q) = o; } }
    __syncthreads();
    const int fr = F.lane & 15, fq = F.lane >> 4, w = F.wave;
    bf16* WSt = (bf16*)(F.ws + WS_WS);
#pragma unroll
    for (int jt = 0; jt < 4; ++jt) {
        f32x4 acc = {0.f, 0.f, 0.f, 0.f};
#pragma unroll
        for (int k0 = 0; k0 < 4; ++k0) acc = mfma16(ldfrag(Xs, 136, 16 * jt + fr, 32 * k0 + 8 * fq), ldfrag(Ys, 136, 16 * w + fr, 32 * k0 + 8 * fq), acc);
        const int jj = j0 + 16 * jt + 4 * fq; const f32x4 nw = *(const GAS f32x4*)(n2 + jj);
        *(GAS v2u*)(WSt + (size_t)(hc + 16 * w + fr) * DM + jj) = pack4(acc * nw);
    }
    __syncthreads();
}
__device__ __forceinline__ void p0_prologue(Frame& F) {
    LAS float* scr = (LAS float*)(F.lds + F.wave * 16384);
    const int gw = F.vcu * NWAVES + F.wave, NGW = F.G * NWAVES;
    constexpr int I_1 = (DM / 64) * (9248 / 32), I_G = (DM / 64) * (4096 / 32), I_PA = (HW / 64) * (DM / 32), I_O = (DM / 64) * (DM / 32);
    constexpr int NITEMS = I_1 + I_G + 2 * I_PA + I_O;
    bf16* W1t = (bf16*)(F.ws + WS_W1);
    for (int it = gw; it < NITEMS; it += NGW) {
        int r = it;
        if (r < I_1) { p0_transpose_item(F.in[I_WIN], INW, 0, DM, 9248, W1t, 0, scr, r, F.lane); continue; } r -= I_1;
        if (r < I_G) { p0_transpose_item(F.in[I_WIN], INW, 9248, DM, 4096, (bf16*)(F.ws + WS_WG), 0, scr, r, F.lane); continue; } r -= I_G;
        if (r < I_PA) { p0_transpose_item(F.in[I_WPA], DM, 0, HW, DM, (bf16*)(F.ws + WS_WPA), 0, scr, r, F.lane); continue; } r -= I_PA;
        if (r < I_PA) { p0_transpose_item(F.in[I_WPB], DM, 0, HW, DM, (bf16*)(F.ws + WS_WPB), 0, scr, r, F.lane); continue; } r -= I_PA;
        p0_transpose_item(F.in[I_WOUT], DM, 0, DM, DM, (bf16*)(F.ws + WS_WOUT), 0, scr, r, F.lane);
    }
    bf16* XN = (bf16*)(F.ws + WS_XN);
    for (int m = gw; m < SEQ; m += NGW) rms_row_to_bf16(F.lane, F.in[I_X] + (size_t)m * DM, F.in[I_N1W], XN + (size_t)m * DM);
    __syncthreads();
    for (int it = blockIdx.x; it < 512; it += F.G) p0_ws_item(F, it);
}
typedef unsigned u32x4 __attribute__((ext_vector_type(4)));
__device__ __forceinline__ u32x4 pack8(f32x4 a, f32x4 b) { u32x4 w; w.x = pk2(a[0], a[1]); w.y = pk2(a[2], a[3]); w.z = pk2(b[0], b[1]); w.w = pk2(b[2], b[3]); return w; }
__device__ __forceinline__ void unpack8(u32x4 w, f32x4& a, f32x4& b) { a = (f32x4){bflo(w.x), bfhi(w.x), bflo(w.y), bfhi(w.y)}; b = (f32x4){bflo(w.z), bfhi(w.z), bflo(w.w), bfhi(w.w)}; }
__device__ __forceinline__ f32x4 silu4(f32x4 v) { return (f32x4){siluf_(v[0]), siluf_(v[1]), siluf_(v[2]), siluf_(v[3])}; }
__device__ __forceinline__ f32x4 sigm4(f32x4 v) { return (f32x4){sigmoidf_(v[0]), sigmoidf_(v[1]), sigmoidf_(v[2]), sigmoidf_(v[3])}; }

struct EpiG1 {
    static constexpr bool PERM = true, AFTER_DRAIN = false;
    unsigned char* ws; const float* lbl;
    __device__ __forceinline__ void operator()(const f32x4 (&acc)[2][2][4][2], const pg8::Unit& u, int wr, int wc, int fr, int fq) const {
        const int pn = u.pn, row0 = u.pm * 256 + wr * 64 + fr;
        {
            const int grp = pn >> 2; const bool act = (grp == 0) | (grp == 4) | (grp == 8);
            bf16* base = (bf16*)(ws + WS_H + (size_t)grp * 32 * MiB); const int col0 = (pn & 3) * 256 + wc * 32 + 8 * fq;
            const bool fgate = (grp == 1) | (grp == 2); f32x4 lbv[2][2];
            if (fgate) { const float* l0 = lbl + (grp - 1) * 2048 + col0;
#pragma unroll
                for (int bj = 0; bj < 2; ++bj)
#pragma unroll
                    for (int n = 0; n < 2; ++n) { const f32x4 a0 = *(const f32x4*)(l0 + bj * 128 + 4 * n), a1 = *(const f32x4*)(l0 + 1024 + bj * 128 + 4 * n);
                        lbv[bj][n] = (f32x4){fast_rcp(1.0f + fast_exp(a1[0] - a0[0])), fast_rcp(1.0f + fast_exp(a1[1] - a0[1])), fast_rcp(1.0f + fast_exp(a1[2] - a0[2])), fast_rcp(1.0f + fast_exp(a1[3] - a0[3]))}; } }
#pragma unroll
            for (int ai = 0; ai < 2; ++ai)
#pragma unroll
                for (int m = 0; m < 4; ++m) { bf16* rowp = base + (size_t)(row0 + ai * 128 + m * 16) * HW + col0;
#pragma unroll
                    for (int bj = 0; bj < 2; ++bj) { f32x4 v0 = acc[ai][bj][m][0], v1 = acc[ai][bj][m][1];
                        if (act) { v0 = silu4(v0); v1 = silu4(v1); }
                        if (fgate) { v0 = lbv[bj][0] + (1.0f - lbv[bj][0]) * sigm4(v0); v1 = lbv[bj][1] + (1.0f - lbv[bj][1]) * sigm4(v1); }
                        *(u32x4*)(rowp + bj * 128) = pack8(v0, v1); } }
        }
    }
};
struct EpiGate {
    static constexpr bool PERM = true, AFTER_DRAIN = false;
    bf16* O;
    __device__ __forceinline__ void operator()(const f32x4 (&acc)[2][2][4][2], const pg8::Unit& u, int wr, int wc, int fr, int fq) const {
        const int row0 = u.pm * 256 + wr * 64 + fr, col0 = u.pn * 256 + wc * 32 + 8 * fq;
#pragma unroll
        for (int ai = 0; ai < 2; ++ai)
#pragma unroll
            for (int m = 0; m < 4; ++m) { bf16* rowp = O + (size_t)(row0 + ai * 128 + m * 16) * DM + col0;
#pragma unroll
                for (int bj = 0; bj < 2; ++bj) *(u32x4*)(rowp + bj * 128) = pack8(sigm4(acc[ai][bj][m][0]), sigm4(acc[ai][bj][m][1])); }
    }
};
template <int MODE> struct EpiMix {
    static constexpr bool PERM = true, AFTER_DRAIN = false;
    bf16* O; const bf16* G;
    __device__ __forceinline__ void operator()(const f32x4 (&acc)[2][2][4][2], const pg8::Unit& u, int wr, int wc, int fr, int fq) const {
        const int row0 = u.pm * 256 + wr * 64 + fr, col0 = u.pn * 256 + wc * 32 + 8 * fq;
#pragma unroll
        for (int ai = 0; ai < 2; ++ai)
#pragma unroll
            for (int m = 0; m < 4; ++m) { const size_t off = (size_t)(row0 + ai * 128 + m * 16) * DM + col0;
#pragma unroll
                for (int bj = 0; bj < 2; ++bj) { f32x4 o0, o1; unpack8(*(const u32x4*)(O + off + bj * 128), o0, o1);
                    if (MODE == 0) { o0 = o0 * acc[ai][bj][m][0]; o1 = o1 * acc[ai][bj][m][1]; }
                    else { f32x4 g0, g1; unpack8(*(const u32x4*)(G + off + bj * 128), g0, g1); o0 = o0 + g0 * acc[ai][bj][m][0]; o1 = o1 + g1 * acc[ai][bj][m][1]; }
                    *(u32x4*)(O + off + bj * 128) = pack8(o0, o1); } }
    }
};
struct EpiX1 {
    static constexpr bool PERM = false, AFTER_DRAIN = false;
    const float* x; float* out; bf16* xb;
    __device__ __forceinline__ void operator()(const f32x4 (&acc)[2][2][4][2], const pg8::Unit& u, int wr, int wc, int fr, int fq) const {
        const int row0 = u.pm * 256 + wr * 64 + fr, col0 = u.pn * 256 + wc * 32 + 4 * fq;
#pragma unroll
        for (int ai = 0; ai < 2; ++ai)
#pragma unroll
            for (int m = 0; m < 4; ++m) { const size_t off = (size_t)(row0 + ai * 128 + m * 16) * DM + col0;
#pragma unroll
                for (int bj = 0; bj < 2; ++bj)
#pragma unroll
                    for (int n = 0; n < 2; ++n) { const size_t o = off + bj * 128 + n * 16; const f32x4 v = *(const f32x4*)(x + o) + acc[ai][bj][m][n];
                        *(f32x4*)(out + o) = v; *(v2u*)(xb + o) = pack4(v); } }
    }
};
struct EpiBf {
    static constexpr bool PERM = true, AFTER_DRAIN = false;
    bf16* O;
    __device__ __forceinline__ void operator()(const f32x4 (&acc)[2][2][4][2], const pg8::Unit& u, int wr, int wc, int fr, int fq) const {
        const int row0 = u.pm * 256 + wr * 64 + fr, col0 = u.pn * 256 + wc * 32 + 8 * fq;
#pragma unroll
        for (int ai = 0; ai < 2; ++ai)
#pragma unroll
            for (int m = 0; m < 4; ++m) { bf16* rowp = O + (size_t)(row0 + ai * 128 + m * 16) * DM + col0;
#pragma unroll
                for (int bj = 0; bj < 2; ++bj) *(u32x4*)(rowp + bj * 128) = pack8(acc[ai][bj][m][0], acc[ai][bj][m][1]); }
    }
};
struct EpiF32 {
    static constexpr bool PERM = false, AFTER_DRAIN = false;
    float* C;
    __device__ __forceinline__ void operator()(const f32x4 (&acc)[2][2][4][2], const pg8::Unit& u, int wr, int wc, int fr, int fq) const {
        const int row0 = u.pm * 256 + wr * 64 + fr, col0 = u.pn * 256 + wc * 32 + 4 * fq;
#pragma unroll
        for (int ai = 0; ai < 2; ++ai)
#pragma unroll
            for (int m = 0; m < 4; ++m) { float* rowp = C + (size_t)(row0 + ai * 128 + m * 16) * DM + col0;
#pragma unroll
                for (int bj = 0; bj < 2; ++bj)
#pragma unroll
                    for (int n = 0; n < 2; ++n) *(f32x4*)(rowp + bj * 128 + n * 16) = acc[ai][bj][m][n]; }
    }
};

__device__ __forceinline__ void p1_ab(Frame& F) {
    const bf16* XN = (const bf16*)(F.ws + WS_XN); const bf16* Wab = (const bf16*)(F.ws + WS_W1) + (size_t)9216 * DM; float* Gab = (float*)(F.ws + WS_GAB);
    const int fr = F.lane & 15, fq = F.lane >> 4, rt = F.wave >> 1, ct = F.wave & 1;
    for (int blk = F.vcu; blk < SEQ / 64; blk += F.G) {
        const bf16* ap = XN + (size_t)(blk * 64 + rt * 16 + fr) * DM + 8 * fq; const bf16* bp = Wab + (size_t)(ct * 16 + fr) * DM + 8 * fq;
        f32x4 acc = {0.f, 0.f, 0.f, 0.f};
#pragma unroll 1
        for (int kb = 0; kb < DM; kb += 512) { bf16x8 af[16], bfr[16];
#pragma unroll
            for (int u = 0; u < 16; ++u) { af[u] = *(const GAS bf16x8*)(ap + kb + 32 * u); bfr[u] = *(const GAS bf16x8*)(bp + kb + 32 * u); }
            __builtin_amdgcn_sched_barrier(0);
#pragma unroll
            for (int u = 0; u < 16; ++u) acc = mfma16(bfr[u], af[u], acc);
            __builtin_amdgcn_sched_barrier(0); }
        *(GAS f32x4*)(Gab + (size_t)(blk * 64 + rt * 16 + fr) * 32 + ct * 16 + 4 * fq) = acc;
    }
}
template <bool PASS3, int SKIP = 0>
__device__ __forceinline__ void hgrn_pass(Frame& F) {
    LAS bf16*  ST  = (LAS bf16*)(F.lds + 0);
    LAS float* LF  = (LAS float*)(F.lds + 0);
    LAS bf16*  QT  = (LAS bf16*)(F.lds + 34816);
    LAS bf16*  KT  = (LAS bf16*)(F.lds + 52224);
    LAS bf16*  KHT = (LAS bf16*)(F.lds + 69632);
    LAS bf16*  VT  = (LAS bf16*)(F.lds + 88064);
    LAS bf16*  ATT = (LAS bf16*)(F.lds + 106496);
    LAS float* PT  = (LAS float*)(F.lds + 115712);
    LAS float* BL  = (LAS float*)(F.lds + 117760);
    LAS float* DKK = (LAS float*)(F.lds + 118272);
    LAS float* LBV = (LAS float*)(F.lds + 118784);
    LAS bf16*  VR  = (LAS bf16*)(F.lds + 119296);
    const int tid = F.tid, lane = F.lane, w = F.wave, fr = lane & 15, fq = lane >> 4;
    const int row = tid >> 3, c0 = (tid & 7) * 16;
    float* HL = (float*)(F.ws + WS_HL); float* HDS = (float*)(F.ws + WS_HDS);
    for (int it = blockIdx.x; it < 256; it += F.G) {
        const int hd = it >> 4, sg = it & 15, dir = hd >> 3, h = hd & 7;
        const bf16* Hq = (const bf16*)(F.ws + WS_H); const bf16* Hf = (const bf16*)(F.ws + WS_H + (size_t)(1 + dir) * 32 * MiB); const bf16* Hi = (const bf16*)(F.ws + WS_H + (size_t)3 * 32 * MiB);
        bf16* Oh = (bf16*)(F.ws + (dir ? WS_OHB : WS_OHF));
        __syncthreads();
        f32x4 Sacc[8];
#pragma unroll
        for (int kt = 0; kt < 8; ++kt) Sacc[kt] = (f32x4){0.f, 0.f, 0.f, 0.f};
        if (PASS3) {
            for (int p = 0; p < sg; ++p) { const int ip = hd * 16 + p; f32x4 dsv[8], lv[8];
#pragma unroll
                for (int kt = 0; kt < 8; ++kt) { dsv[kt] = *(const GAS f32x4*)(HDS + ip * 128 + 16 * kt + 4 * fq); lv[kt] = *(const GAS f32x4*)(HL + ((size_t)((ip * 8 + w) * 8 + kt) * 64 + lane) * 4); }
                __builtin_amdgcn_sched_barrier(0);
#pragma unroll
                for (int kt = 0; kt < 8; ++kt) Sacc[kt] = Sacc[kt] * dsv[kt] + lv[kt];
                __builtin_amdgcn_sched_barrier(0); }
        }
        float sumbl = 1.f;
        v4u rq[2], rf[2], rv[2];
        { const int oc = dir ? 255 - sg * 16 : sg * 16; const size_t off = (size_t)(64 * oc + row) * HW + h * 128 + c0;
          rq[0] = *(const GAS v4u*)(Hq + off); rq[1] = *(const GAS v4u*)(Hq + off + 8); rf[0] = *(const GAS v4u*)(Hf + off); rf[1] = *(const GAS v4u*)(Hf + off + 8); rv[0] = *(const GAS v4u*)(Hi + off); rv[1] = *(const GAS v4u*)(Hi + off + 8); }
        __syncthreads();
        for (int ci = 0; ci < ((SKIP & 4) ? 1 : CPS); ++ci) {
            const int sc = sg * 16 + ci, oc = dir ? 255 - sc : sc, tok0 = 64 * oc;
            float kk[16], qq[16];
            { const unsigned fw[8] = {rf[0].x, rf[0].y, rf[0].z, rf[0].w, rf[1].x, rf[1].y, rf[1].z, rf[1].w};
              const unsigned qw[8] = {rq[0].x, rq[0].y, rq[0].z, rq[0].w, rq[1].x, rq[1].y, rq[1].z, rq[1].w};
              float fgv[16];
#pragma unroll
              for (int e = 0; e < 16; ++e) { fgv[e] = (e & 1) ? bfhi(fw[e >> 1]) : bflo(fw[e >> 1]); qq[e] = (e & 1) ? bfhi(qw[e >> 1]) : bflo(qw[e >> 1]); kk[e] = 1.0f - fgv[e]; }
#pragma unroll
              for (int q4 = 0; q4 < 4; ++q4) *(LAS f32x4*)(LF + row * 132 + c0 + 4 * q4) = (f32x4){fgv[4 * q4], fgv[4 * q4 + 1], fgv[4 * q4 + 2], fgv[4 * q4 + 3]};
              *(LAS v4u*)(VR + row * 136 + c0) = rv[0]; *(LAS v4u*)(VR + row * 136 + c0 + 8) = rv[1]; }
            if (ci + 1 < CPS && !(SKIP & 2)) { const int oc2 = dir ? oc - 1 : oc + 1; const size_t off = (size_t)(64 * oc2 + row) * HW + h * 128 + c0;
              rq[0] = *(const GAS v4u*)(Hq + off); rq[1] = *(const GAS v4u*)(Hq + off + 8); rf[0] = *(const GAS v4u*)(Hf + off); rf[1] = *(const GAS v4u*)(Hf + off + 8); rv[0] = *(const GAS v4u*)(Hi + off); rv[1] = *(const GAS v4u*)(Hi + off + 8); }
            if (!(SKIP & 8)) __syncthreads();
            { const int c = tid & 127, part = tid >> 7, r0 = part * 16; float b[16], fv[16]; float run = 1.f;
#pragma unroll
              for (int i = 0; i < 16; ++i) fv[i] = LF[(r0 + i) * 132 + c];
              if (!dir) {
#pragma unroll
                  for (int i = 0; i < 16; ++i) { run *= fv[i]; b[i] = run; }
              } else {
#pragma unroll
                  for (int i = 15; i >= 0; --i) { run *= fv[i]; b[i] = run; }
              }
              PT[part * 128 + c] = run;
              unsigned short vcol[16];
#pragma unroll
              for (int i = 0; i < 16; ++i) vcol[i] = VR[(r0 + i) * 136 + c];
              if (!(SKIP & 8)) __syncthreads();
              const float p0 = PT[c], p1 = PT[128 + c], p2 = PT[256 + c], p3 = PT[384 + c];
              float offs;
              if (!dir) offs = (part > 0 ? p0 : 1.f) * (part > 1 ? p1 : 1.f) * (part > 2 ? p2 : 1.f);
              else      offs = (part < 3 ? p3 : 1.f) * (part < 2 ? p2 : 1.f) * (part < 1 ? p1 : 1.f);
              const float tot = (p0 * p1) * (p2 * p3);
              unsigned kh[8], vw[8];
#pragma unroll
              for (int i = 0; i < 8; ++i) { const float P0 = b[2 * i] * offs, P1 = b[2 * i + 1] * offs;
                  if (PASS3) { LF[(r0 + 2 * i) * 132 + c] = P0; LF[(r0 + 2 * i + 1) * 132 + c] = P1; }
                  kh[i] = pk2((1.0f - fv[2 * i]) * tot * fast_rcp(P0), (1.0f - fv[2 * i + 1]) * tot * fast_rcp(P1)); vw[i] = (unsigned)vcol[2 * i] | ((unsigned)vcol[2 * i + 1] << 16); }
              *(LAS v4u*)(KHT + c * 72 + r0) = (v4u){kh[0], kh[1], kh[2], kh[3]}; *(LAS v4u*)(KHT + c * 72 + r0 + 8) = (v4u){kh[4], kh[5], kh[6], kh[7]};
              *(LAS v4u*)(VT + c * 72 + r0) = (v4u){vw[0], vw[1], vw[2], vw[3]}; *(LAS v4u*)(VT + c * 72 + r0 + 8) = (v4u){vw[4], vw[5], vw[6], vw[7]};
              if (part == 0) { DKK[c] = tot; sumbl *= tot; }
            }
            if (!(SKIP & 8)) __syncthreads();
            if (PASS3 && !(SKIP & 1)) { float bb[16];
#pragma unroll
              for (int q4 = 0; q4 < 4; ++q4) { const f32x4 t4 = *(const LAS f32x4*)(LF + row * 132 + c0 + 4 * q4); bb[4 * q4] = t4[0]; bb[4 * q4 + 1] = t4[1]; bb[4 * q4 + 2] = t4[2]; bb[4 * q4 + 3] = t4[3]; }
              unsigned qo[8], ko[8];
#pragma unroll
              for (int e = 0; e < 8; ++e) { qo[e] = pk2(qq[2 * e] * bb[2 * e], qq[2 * e + 1] * bb[2 * e + 1]); ko[e] = pk2(kk[2 * e] * fast_rcp(bb[2 * e]), kk[2 * e + 1] * fast_rcp(bb[2 * e + 1])); }
              *(LAS v4u*)(QT + row * 136 + c0) = (v4u){qo[0], qo[1], qo[2], qo[3]}; *(LAS v4u*)(QT + row * 136 + c0 + 8) = (v4u){qo[4], qo[5], qo[6], qo[7]};
              *(LAS v4u*)(KT + row * 136 + c0) = (v4u){ko[0], ko[1], ko[2], ko[3]}; *(LAS v4u*)(KT + row * 136 + c0 + 8) = (v4u){ko[4], ko[5], ko[6], ko[7]};
            }
            if (PASS3) if (!(SKIP & 8)) __syncthreads();
            if (PASS3 && !(SKIP & 1)) {
                { bf16x8 kf[2][4], qf[2][4]; f32x4 acc[2];
#pragma unroll
                  for (int q2 = 0; q2 < 2; ++q2) { const int tl = 2 * w + q2, ti = tl >> 2, tj = tl & 3; acc[q2] = (f32x4){0.f, 0.f, 0.f, 0.f};
#pragma unroll
                      for (int k0 = 0; k0 < 4; ++k0) { kf[q2][k0] = ldfrag(KT, 136, 16 * ti + fr, 32 * k0 + 8 * fq); qf[q2][k0] = ldfrag(QT, 136, 16 * tj + fr, 32 * k0 + 8 * fq); } }
                  __builtin_amdgcn_sched_barrier(0);
#pragma unroll
                  for (int k0 = 0; k0 < 4; ++k0)
#pragma unroll
                      for (int q2 = 0; q2 < 2; ++q2) acc[q2] = mfma16(kf[q2][k0], qf[q2][k0], acc[q2]);
                  __builtin_amdgcn_sched_barrier(0);
#pragma unroll
                  for (int q2 = 0; q2 < 2; ++q2) { const int tl = 2 * w + q2, ti = tl >> 2, tj = tl & 3; const int t = 16 * tj + fr, s0 = 16 * ti + 4 * fq;
#pragma unroll
                      for (int r = 0; r < 4; ++r) { const bool keep = dir ? (s0 + r >= t) : (s0 + r <= t); acc[q2][r] = keep ? acc[q2][r] : 0.f; }
                      *(LAS v2u*)(ATT + t * 72 + s0) = pack4(acc[q2]); } }
#pragma unroll
                for (int kt = 0; kt < 8; ++kt) *(LAS v2u*)(ST + (16 * w + fr) * 136 + 16 * kt + 4 * fq) = pack4(Sacc[kt]);
                if (!(SKIP & 8)) __syncthreads();
            }
            bf16x8 xv[2];
#pragma unroll
            for (int s0 = 0; s0 < 2; ++s0) xv[s0] = ldfrag(VT, 72, 16 * w + fr, 32 * s0 + 8 * fq);
            if (PASS3 && !(SKIP & 1)) {
                bf16x8 xs[4];
#pragma unroll
                for (int k0 = 0; k0 < 4; ++k0) xs[k0] = ldfrag(ST, 136, 16 * w + fr, 32 * k0 + 8 * fq);
#pragma unroll
                for (int th = 0; th < 2; ++th) { bf16x8 qf[2][4], af[2][2]; f32x4 acc[2];
#pragma unroll
                    for (int tq = 0; tq < 2; ++tq) { const int tt = 2 * th + tq; acc[tq] = (f32x4){0.f, 0.f, 0.f, 0.f};
#pragma unroll
                        for (int k0 = 0; k0 < 4; ++k0) qf[tq][k0] = ldfrag(QT, 136, 16 * tt + fr, 32 * k0 + 8 * fq);
#pragma unroll
                        for (int s0 = 0; s0 < 2; ++s0) af[tq][s0] = ldfrag(ATT, 72, 16 * tt + fr, 32 * s0 + 8 * fq); }
                    __builtin_amdgcn_sched_barrier(0);
#pragma unroll
                    for (int k0 = 0; k0 < 4; ++k0)
#pragma unroll
                        for (int tq = 0; tq < 2; ++tq) acc[tq] = mfma16(xs[k0], qf[tq][k0], acc[tq]);
#pragma unroll
                    for (int s0 = 0; s0 < 2; ++s0)
#pragma unroll
                        for (int tq = 0; tq < 2; ++tq) acc[tq] = mfma16(xv[s0], af[tq][s0], acc[tq]);
                    __builtin_amdgcn_sched_barrier(0);
#pragma unroll
                    for (int tq = 0; tq < 2; ++tq) *(GAS v2u*)(Oh + (size_t)(tok0 + 16 * (2 * th + tq) + fr) * HW + h * 128 + 16 * w + 4 * fq) = pack4(acc[tq]); }
            }
#pragma unroll
            for (int kh = 0; kh < ((SKIP & 1) ? 0 : 2); ++kh) { bf16x8 kf[4][2];
#pragma unroll
                for (int kq = 0; kq < 4; ++kq) { const int kt = 4 * kh + kq; const f32x4 d4 = *(const LAS f32x4*)(DKK + 16 * kt + 4 * fq); Sacc[kt] = Sacc[kt] * d4;
#pragma unroll
                    for (int s0 = 0; s0 < 2; ++s0) kf[kq][s0] = ldfrag(KHT, 72, 16 * kt + fr, 32 * s0 + 8 * fq); }
                __builtin_amdgcn_sched_barrier(0);
#pragma unroll
                for (int s0 = 0; s0 < 2; ++s0)
#pragma unroll
                    for (int kq = 0; kq < 4; ++kq) Sacc[4 * kh + kq] = mfma16(kf[kq][s0], xv[s0], Sacc[4 * kh + kq]);
                __builtin_amdgcn_sched_barrier(0); }
            if (!(SKIP & 8)) __syncthreads();
        }
        if (!PASS3) {
#pragma unroll
            for (int kt = 0; kt < 8; ++kt) *(GAS f32x4*)(HL + ((size_t)((it * 8 + w) * 8 + kt) * 64 + lane) * 4) = Sacc[kt];
            if (tid < 128) HDS[it * 128 + tid] = sumbl;
        }
    }
}
template <int SKIP>
__device__ __forceinline__ void gdn_prep(Frame& F) {
    LAS bf16*  QN  = (LAS bf16*)(F.lds + 0);
    LAS bf16*  KN  = (LAS bf16*)(F.lds + 17408);
    LAS bf16*  VT  = (LAS bf16*)(F.lds + 34816);
    LAS bf16*  KNT = (LAS bf16*)(F.lds + 53248);
    LAS float* AM  = (LAS float*)(F.lds + 71680);
    LAS bf16*  TB  = (LAS bf16*)(F.lds + 104448);
    LAS bf16*  VR  = (LAS bf16*)(F.lds + 104448);
    LAS float* CWL = (LAS float*)(F.lds + 142848);
    LAS float* DEC = (LAS float*)(F.lds + 141312);
    LAS float* BET = DEC + 128;
    LAS float* EXD = DEC + 256;
    const int tid = F.tid, lane = F.lane, w = F.wave, fr = lane & 15, fq = lane >> 4;
    const int row = tid >> 3, c0 = (tid & 7) * 16;
    const bf16* Gq = (const bf16*)(F.ws + WS_H + (size_t)5 * 32 * MiB); const bf16* Gk = (const bf16*)(F.ws + WS_H + (size_t)6 * 32 * MiB); const bf16* Gv = (const bf16*)(F.ws + WS_H + (size_t)7 * 32 * MiB);
    const float* Gab = (const float*)(F.ws + WS_GAB); const float* cw = F.in[I_CONVW];
    unsigned char* dob = (unsigned char*)F.out;
    bf16* QNg = (bf16*)(dob + DO_QN); bf16* KNTg = (bf16*)(dob + DO_KNT); float* GSC = (float*)(F.ws + WS_GSC);
    int hload = -1;
    for (int it = blockIdx.x; it < 2048; it += F.G) {
        const int h = it & 7, oc = it >> 3, tok0 = 64 * oc;
        __syncthreads();
        if (h != hload) { hload = h;
            for (int i = tid; i < 5 * 384; i += NTHR) { const int j = i / 384, r = i % 384; CWL[i] = cw[j * 3072 + (r >> 7) * 1024 + h * 128 + (r & 127)]; }
            __syncthreads(); }
        if (it + F.G < 2048 && tid < 408) { const int it2 = it + F.G, h2 = it2 & 7, oc2 = it2 >> 3; const int tz = tid / 136, rl = tid % 136, r = rl >> 1, half = rl & 1; const int tr = 64 * oc2 - 2 + r;
            if (tr >= 0 && tr < SEQ) { const bf16* src = (tz == 0 ? Gq : tz == 1 ? Gk : Gv) + (size_t)tr * HW + h2 * 128 + half * 64; unsigned tmp = *(const GAS unsigned*)src; asm volatile("" :: "v"(tmp)); } }
        if (tid < 128) { const int dir = tid >> 6, l = tid & 63, pos = dir ? 63 - l : l;
            const float a = Gab[(size_t)(tok0 + pos) * 32 + dir * 8 + h], b = Gab[(size_t)(tok0 + pos) * 32 + 16 + dir * 8 + h];
            const float x = a + F.in[I_DTB][dir * 8 + h]; const float sp = x > 20.f ? x : log1pf(__expf(x));
            float d = -__expf(F.in[I_ALOG][dir * 8 + h]) * sp;
#pragma unroll
            for (int o = 1; o < 64; o <<= 1) { const float t = __shfl_up(d, o); if (l >= o) d += t; }
            DEC[dir * 64 + pos] = d; BET[dir * 64 + pos] = sigmoidf_(b); EXD[dir * 64 + pos] = __expf(d); }
        if (!(SKIP & 64)) { float q[16], k[16], v[16];
#pragma unroll
          for (int e = 0; e < 16; ++e) { q[e] = 0.f; k[e] = 0.f; v[e] = 0.f; }
          const int ch = h * 128 + c0;
#pragma unroll
          for (int j = 0; j < ((SKIP & 1) ? 0 : 5); ++j) { const int tr = tok0 + row + j - 2;
              if (tr >= 0 && tr < SEQ) { const size_t off = (size_t)tr * HW + ch;
                  const v4u xq0 = *(const GAS v4u*)(Gq + off), xq1 = *(const GAS v4u*)(Gq + off + 8), xk0 = *(const GAS v4u*)(Gk + off), xk1 = *(const GAS v4u*)(Gk + off + 8), xv0 = *(const GAS v4u*)(Gv + off), xv1 = *(const GAS v4u*)(Gv + off + 8);
                  const unsigned wq[8] = {xq0.x, xq0.y, xq0.z, xq0.w, xq1.x, xq1.y, xq1.z, xq1.w}, wk[8] = {xk0.x, xk0.y, xk0.z, xk0.w, xk1.x, xk1.y, xk1.z, xk1.w}, wv[8] = {xv0.x, xv0.y, xv0.z, xv0.w, xv1.x, xv1.y, xv1.z, xv1.w};
                  const LAS float* cq = CWL + j * 384 + c0;
#pragma unroll
                  for (int e = 0; e < 16; ++e) { const float fq_ = (e & 1) ? bfhi(wq[e >> 1]) : bflo(wq[e >> 1]), fk_ = (e & 1) ? bfhi(wk[e >> 1]) : bflo(wk[e >> 1]), fv_ = (e & 1) ? bfhi(wv[e >> 1]) : bflo(wv[e >> 1]);
                      q[e] += cq[e] * fq_; k[e] += cq[128 + e] * fk_; v[e] += cq[256 + e] * fv_; } } }
          float sq = 0.f, sk = 0.f;
#pragma unroll
          for (int e = 0; e < 16; ++e) { q[e] = siluf_(q[e]); k[e] = siluf_(k[e]); v[e] = siluf_(v[e]); sq += q[e] * q[e]; sk += k[e] * k[e]; }
          sq += __shfl_xor(sq, 1); sq += __shfl_xor(sq, 2); sq += __shfl_xor(sq, 4); sk += __shfl_xor(sk, 1); sk += __shfl_xor(sk, 2); sk += __shfl_xor(sk, 4);
          const float rq = 0.08838834764831845f / sqrtf(sq + EPS), rk = 1.0f / sqrtf(sk + EPS);
          unsigned qo[8], ko[8];
#pragma unroll
          for (int e = 0; e < 8; ++e) { qo[e] = pk2(q[2 * e] * rq, q[2 * e + 1] * rq); ko[e] = pk2(k[2 * e] * rk, k[2 * e + 1] * rk); }
          const v4u q0 = {qo[0], qo[1], qo[2], qo[3]}, q1 = {qo[4], qo[5], qo[6], qo[7]}, k0_ = {ko[0], ko[1], ko[2], ko[3]}, k1_ = {ko[4], ko[5], ko[6], ko[7]};
          *(LAS v4u*)(QN + row * 136 + c0) = q0; *(LAS v4u*)(QN + row * 136 + c0 + 8) = q1; *(LAS v4u*)(KN + row * 136 + c0) = k0_; *(LAS v4u*)(KN + row * 136 + c0 + 8) = k1_;
          if (!(SKIP & 16)) { *(GAS v4u*)(QNg + (size_t)(tok0 + row) * HW + ch) = q0; *(GAS v4u*)(QNg + (size_t)(tok0 + row) * HW + ch + 8) = q1; }
          unsigned vo[8];
#pragma unroll
          for (int e = 0; e < 8; ++e) vo[e] = pk2(v[2 * e], v[2 * e + 1]);
          *(LAS v4u*)(VR + row * 136 + c0) = (v4u){vo[0], vo[1], vo[2], vo[3]}; *(LAS v4u*)(VR + row * 136 + c0 + 8) = (v4u){vo[4], vo[5], vo[6], vo[7]};
        }
        __syncthreads();
        { const int c = tid & 127, r0 = (tid >> 7) * 16; unsigned vw[8], kw[8];
#pragma unroll
          for (int i = 0; i < 8; ++i) { vw[i] = (unsigned)VR[(r0 + 2 * i) * 136 + c] | ((unsigned)VR[(r0 + 2 * i + 1) * 136 + c] << 16); kw[i] = (unsigned)KN[(r0 + 2 * i) * 136 + c] | ((unsigned)KN[(r0 + 2 * i + 1) * 136 + c] << 16); }
          *(LAS v4u*)(VT + c * 72 + r0) = (v4u){vw[0], vw[1], vw[2], vw[3]}; *(LAS v4u*)(VT + c * 72 + r0 + 8) = (v4u){vw[4], vw[5], vw[6], vw[7]};
          *(LAS v4u*)(KNT + c * 72 + r0) = (v4u){kw[0], kw[1], kw[2], kw[3]}; *(LAS v4u*)(KNT + c * 72 + r0 + 8) = (v4u){kw[4], kw[5], kw[6], kw[7]}; }
#pragma unroll
        for (int q2 = 0; q2 < ((SKIP & 8) ? 0 : 2); ++q2) { const int tl = 2 * w + q2, ti = tl >> 2, tj = tl & 3; f32x4 kkv = {0.f, 0.f, 0.f, 0.f}, qkv = {0.f, 0.f, 0.f, 0.f};
#pragma unroll
            for (int k0 = 0; k0 < 4; ++k0) { const bf16x8 xs = ldfrag(KN, 136, 16 * ti + fr, 32 * k0 + 8 * fq);
                kkv = mfma16(xs, ldfrag(KN, 136, 16 * tj + fr, 32 * k0 + 8 * fq), kkv); qkv = mfma16(xs, ldfrag(QN, 136, 16 * tj + fr, 32 * k0 + 8 * fq), qkv); }
            const int t = 16 * tj + fr, s0 = 16 * ti + 4 * fq;
#pragma unroll
            for (int dir = 0; dir < 2; ++dir) { const float dt = DEC[dir * 64 + t], bt = BET[dir * 64 + t]; f32x4 aq;
#pragma unroll
                for (int r = 0; r < 4; ++r) { const int s = s0 + r; const bool before = dir ? (s > t) : (s < t), beq = before || (s == t);
                    const float e = beq ? __expf(dt - DEC[dir * 64 + s]) : 0.f;
                    AM[dir * 4096 + (dir ? (63 - s) * 64 + (63 - t) : s * 64 + t)] = before ? bt * kkv[r] * e : 0.f;   aq[r] = qkv[r] * e; }
                bf16* AQg = (bf16*)(dob + (dir ? DO_AQKB : DO_AQKF));
                if (!(SKIP & 16)) *(GAS v2u*)(AQg + ((size_t)(h * 256 + oc) * 64 + t) * 64 + s0) = pack4(aq); } }
        __syncthreads();
        if (SKIP & 32) {} else if (w < 2) { const int dir = w; int c = lane; asm volatile("" : "+v"(c)); const LAS float* A = AM + dir * 4096;
            float t[64];
#pragma unroll
            for (int bi = 0; bi < 4; ++bi) { float r[16];
#pragma unroll
                for (int ii = 0; ii < 16; ++ii) r[ii] = (16 * bi + ii == c) ? 1.f : 0.f;
                if (!(SKIP & 2)) {
#pragma unroll
                for (int j0 = 0; j0 < 16 * bi; j0 += 4) { f32x4 av[4][4];
#pragma unroll
                    for (int jq = 0; jq < 4; ++jq)
#pragma unroll
                        for (int q4 = 0; q4 < 4; ++q4) av[jq][q4] = *(const LAS f32x4*)(A + (j0 + jq) * 64 + 16 * bi + 4 * q4);
                    __builtin_amdgcn_sched_barrier(0);
#pragma unroll
                    for (int jq = 0; jq < 4; ++jq)
#pragma unroll
                        for (int q4 = 0; q4 < 4; ++q4) { r[4 * q4] -= av[jq][q4][0] * t[j0 + jq]; r[4 * q4 + 1] -= av[jq][q4][1] * t[j0 + jq]; r[4 * q4 + 2] -= av[jq][q4][2] * t[j0 + jq]; r[4 * q4 + 3] -= av[jq][q4][3] * t[j0 + jq]; }
                    __builtin_amdgcn_sched_barrier(0); }
#pragma unroll
                for (int jg = 0; jg < 4; ++jg) { f32x4 av[4][4];
#pragma unroll
                    for (int jq = 0; jq < 4; ++jq)
#pragma unroll
                        for (int q4 = jg; q4 < 4; ++q4) av[jq][q4] = *(const LAS f32x4*)(A + (16 * bi + 4 * jg + jq) * 64 + 16 * bi + 4 * q4);
                    __builtin_amdgcn_sched_barrier(0);
#pragma unroll
                    for (int jq = 0; jq < 4; ++jq) { const int jj = 4 * jg + jq; t[16 * bi + jj] = r[jj];
#pragma unroll
                        for (int q4 = jg; q4 < 4; ++q4)
#pragma unroll
                            for (int e = 0; e < 4; ++e) if (4 * q4 + e > jj) r[4 * q4 + e] -= av[jq][q4][e] * r[jj]; }
                    __builtin_amdgcn_sched_barrier(0); }
                } else {
#pragma unroll
                for (int jj = 0; jj < 16; ++jj) t[16 * bi + jj] = r[jj]; }
            }
            const int tc = dir ? 63 - c : c; const float bc = BET[dir * 64 + tc], bd = bc * EXD[dir * 64 + tc];
            LAS bf16* T0 = TB + (dir * 2 + 0) * 64 * 72 + tc + (dir ? 63 * 72 : 0); const int tstep = dir ? -72 : 72;
#pragma unroll
            for (int i = 0; i < 64; ++i) { T0[i * tstep] = (bf16)f2bf(t[i] * bc); T0[64 * 72 + i * tstep] = (bf16)f2bf(t[i] * bd); }
        } else {
            for (int idx = tid - 128; idx < ((SKIP & 16) ? 0 : 1024); idx += 384) { const int r = idx >> 3, c8 = idx & 7; *(GAS v4u*)(KNTg + ((size_t)(h * 256 + oc) * 128 + r) * 64 + c8 * 8) = *(const LAS v4u*)(KNT + r * 72 + c8 * 8); }
            if (tid >= 128 && tid < 256) { const int dir = (tid - 128) >> 6, t = tid & 63; const float dl = dir ? DEC[64] : DEC[63];
                float* g = GSC + (size_t)((dir * 8 + h) * 256 + oc) * 192; g[t] = EXD[dir * 64 + t]; g[64 + t] = __expf(dl - DEC[dir * 64 + t]); if (t == 0) g[128] = __expf(dl); }
        }
        __syncthreads();
#pragma unroll 1
        for (int n = 0; n < ((SKIP & 4) ? 0 : 16); ++n) { const int qi = w * 16 + n, dir = qi >> 6, kind = (qi >> 5) & 1, idx = qi & 31; f32x4 acc = {0.f, 0.f, 0.f, 0.f};
            const LAS bf16* Tm = TB + (dir * 2 + kind) * 64 * 72; const size_t cb = (size_t)(h * 256 + oc) * 8192;
            if (kind == 0) { const int ti = idx >> 3, vj = idx & 7;
#pragma unroll
                for (int s0 = 0; s0 < 2; ++s0) acc = mfma16(ldfrag(Tm, 72, 16 * ti + fr, 32 * s0 + 8 * fq), ldfrag(VT, 72, 16 * vj + fr, 32 * s0 + 8 * fq), acc);
                bf16* U = (bf16*)(F.ws + (dir ? WS_UTB : WS_UTF)); if (!(SKIP & 16)) *(GAS v2u*)(U + cb + (16 * vj + fr) * 64 + 16 * ti + 4 * fq) = pack4(acc);
            } else { const int ki = idx >> 2, tj = idx & 3;
#pragma unroll
                for (int s0 = 0; s0 < 2; ++s0) acc = mfma16(ldfrag(KNT, 72, 16 * ki + fr, 32 * s0 + 8 * fq), ldfrag(Tm, 72, 16 * tj + fr, 32 * s0 + 8 * fq), acc);
                bf16* W = (bf16*)(F.ws + (dir ? WS_WB : WS_WF)); if (!(SKIP & 16)) *(GAS v2u*)(W + cb + (16 * tj + fr) * 128 + 16 * ki + 4 * fq) = pack4(acc); }
        }
    }
}
__device__ __forceinline__ void gdn_load_tiles(const unsigned char* ws, const unsigned char* dob, int tid, int dir, int hd, int h, int oc, bool pass3, v4u (&rw)[2], v4u (&rq)[2], v4u (&ru)[2], v4u (&rk)[2], v4u& ra, float& rs) {
    const size_t cb = (size_t)(h * 256 + oc);
    const int row = tid >> 3, c0 = (tid & 7) * 16, vrow = tid >> 2, t0 = (tid & 3) * 16;
    const bf16* W = (const bf16*)(ws + (dir ? WS_WB : WS_WF)) + cb * 8192 + row * 128 + c0; rw[0] = *(const GAS v4u*)W; rw[1] = *(const GAS v4u*)(W + 8);
    const bf16* U = (const bf16*)(ws + (dir ? WS_UTB : WS_UTF)) + cb * 8192 + vrow * 64 + t0; ru[0] = *(const GAS v4u*)U; ru[1] = *(const GAS v4u*)(U + 8);
    const bf16* Kt = (const bf16*)(dob + DO_KNT) + (size_t)(h * 256 + oc) * 8192 + vrow * 64 + t0; rk[0] = *(const GAS v4u*)Kt; rk[1] = *(const GAS v4u*)(Kt + 8);
    if (pass3) {
        const bf16* Q = (const bf16*)(dob + DO_QN) + (size_t)(64 * oc + row) * HW + h * 128 + c0; rq[0] = *(const GAS v4u*)Q; rq[1] = *(const GAS v4u*)(Q + 8);
        const bf16* A = (const bf16*)(dob + (dir ? DO_AQKB : DO_AQKF)) + cb * 4096 + row * 64 + (tid & 7) * 8; ra = *(const GAS v4u*)A;
    }
    rs = (tid < 192) ? ((const float*)(ws + WS_GSC))[(size_t)(hd * 256 + oc) * 192 + tid] : 0.f;
}
#define SCHED_FENCE() __builtin_amdgcn_sched_barrier(0)
template <bool PASS3, bool UREAL>
__device__ __forceinline__ void gdn_tile(f32x4 (&A)[8], const LAS bf16* WTL, const LAS bf16* QNL, const LAS bf16* UTL, const LAS bf16* KTL, const LAS bf16* AQL, const LAS float* SCL,
                                         LAS bf16* ST, LAS bf16* VN, LAS bf16* VNS, int w, int fr, int fq, float gl, bf16* Ogc) {
#pragma unroll
    for (int kt = 0; kt < 8; ++kt) *(LAS v2u*)(ST + fr * 136 + 16 * kt + 4 * fq) = pack4(A[kt]);
    asm volatile("" ::: "memory");
    bf16x8 xs[4];
#pragma unroll
    for (int k0 = 0; k0 < 4; ++k0) xs[k0] = ldfrag(ST, 136, fr, 32 * k0 + 8 * fq);
#pragma unroll
    for (int th = 0; th < 2; ++th) { bf16x8 wf[2][4]; f32x4 acc[2]; v2u uw[2]; f32x4 es[2];
#pragma unroll
      for (int tq = 0; tq < 2; ++tq) { const int tt = 2 * th + tq;
#pragma unroll
          for (int k0 = 0; k0 < 4; ++k0) wf[tq][k0] = ldfrag(WTL, 136, 16 * tt + fr, 32 * k0 + 8 * fq);
          if (UREAL) uw[tq] = *(const LAS v2u*)(UTL + (16 * w + fr) * 72 + 16 * tt + 4 * fq);
          es[tq] = *(const LAS f32x4*)(SCL + 64 + 16 * tt + 4 * fq); acc[tq] = (f32x4){0.f, 0.f, 0.f, 0.f}; }
      SCHED_FENCE();
#pragma unroll
      for (int k0 = 0; k0 < 4; ++k0)
#pragma unroll
          for (int tq = 0; tq < 2; ++tq) acc[tq] = mfma16(wf[tq][k0], xs[k0], acc[tq]);
      SCHED_FENCE();
#pragma unroll
      for (int tq = 0; tq < 2; ++tq) { const int tt = 2 * th + tq; f32x4 u4 = {0.f, 0.f, 0.f, 0.f};
          if (UREAL) u4 = (f32x4){bflo(uw[tq].x), bfhi(uw[tq].x), bflo(uw[tq].y), bfhi(uw[tq].y)};
          const f32x4 vn = u4 - acc[tq];
          if (PASS3) *(LAS v2u*)(VN + fr * 72 + 16 * tt + 4 * fq) = pack4(vn);
          *(LAS v2u*)(VNS + fr * 72 + 16 * tt + 4 * fq) = pack4(vn * es[tq]); }
      SCHED_FENCE(); }
    asm volatile("" ::: "memory");
    if (PASS3) { bf16x8 yv[2];
#pragma unroll
        for (int s0 = 0; s0 < 2; ++s0) yv[s0] = ldfrag(VN, 72, fr, 32 * s0 + 8 * fq);
#pragma unroll
        for (int th = 0; th < 2; ++th) { bf16x8 qf[2][4], af[2][2]; f32x4 acc[2]; float ed[2];
#pragma unroll
            for (int tq = 0; tq < 2; ++tq) { const int tt = 2 * th + tq;
#pragma unroll
                for (int k0 = 0; k0 < 4; ++k0) qf[tq][k0] = ldfrag(QNL, 136, 16 * tt + fr, 32 * k0 + 8 * fq);
#pragma unroll
                for (int s0 = 0; s0 < 2; ++s0) af[tq][s0] = ldfrag(AQL, 72, 16 * tt + fr, 32 * s0 + 8 * fq);
                ed[tq] = SCL[16 * tt + fr]; acc[tq] = (f32x4){0.f, 0.f, 0.f, 0.f}; }
            SCHED_FENCE();
#pragma unroll
            for (int k0 = 0; k0 < 4; ++k0)
#pragma unroll
                for (int tq = 0; tq < 2; ++tq) acc[tq] = mfma16(xs[k0], qf[tq][k0], acc[tq]);
#pragma unroll
            for (int tq = 0; tq < 2; ++tq) acc[tq] = acc[tq] * ed[tq];
#pragma unroll
            for (int s0 = 0; s0 < 2; ++s0)
#pragma unroll
                for (int tq = 0; tq < 2; ++tq) acc[tq] = mfma16(yv[s0], af[tq][s0], acc[tq]);
            SCHED_FENCE();
#pragma unroll
            for (int tq = 0; tq < 2; ++tq) *(GAS v2u*)(Ogc + (size_t)(16 * (2 * th + tq) + fr) * HW + 16 * w + 4 * fq) = pack4(acc[tq]);
            SCHED_FENCE(); } }
    { bf16x8 ys[2];
#pragma unroll
      for (int s0 = 0; s0 < 2; ++s0) ys[s0] = ldfrag(VNS, 72, fr, 32 * s0 + 8 * fq);
#pragma unroll
      for (int kh = 0; kh < 2; ++kh) { bf16x8 kf[4][2];
#pragma unroll
          for (int kq = 0; kq < 4; ++kq)
#pragma unroll
              for (int s0 = 0; s0 < 2; ++s0) kf[kq][s0] = ldfrag(KTL, 72, 16 * (4 * kh + kq) + fr, 32 * s0 + 8 * fq);
#pragma unroll
          for (int kq = 0; kq < 4; ++kq) A[4 * kh + kq] = A[4 * kh + kq] * gl;
          SCHED_FENCE();
#pragma unroll
          for (int s0 = 0; s0 < 2; ++s0)
#pragma unroll
              for (int kq = 0; kq < 4; ++kq) A[4 * kh + kq] = mfma16(kf[kq][s0], ys[s0], A[4 * kh + kq]);
          SCHED_FENCE(); } }
}
template <bool PASS3, int SKIP = 0>
__device__ __forceinline__ void gdn_pass(Frame& F) {
    LAS bf16*  WTL = (LAS bf16*)(F.lds + 0);
    LAS bf16*  QNL = (LAS bf16*)(F.lds + 17408);
    LAS bf16*  UTL = (LAS bf16*)(F.lds + 34816);
    LAS bf16*  KTL = (LAS bf16*)(F.lds + 53248);
    LAS bf16*  AQL = (LAS bf16*)(F.lds + 71680);
    LAS float* SCL = (LAS float*)(F.lds + 80896);
    LAS bf16*  PX  = (LAS bf16*)(F.lds + 0);
    const int tid = F.tid, lane = F.lane, w = F.wave, fr = lane & 15, fq = lane >> 4;
    LAS bf16* ST  = (LAS bf16*)(F.lds + 81920 + w * 8960);
    LAS bf16* VN  = ST + 16 * 136;
    LAS bf16* VNS = VN + 16 * 72;
    const int row = tid >> 3, c0 = (tid & 7) * 16, vrow = tid >> 2, t0 = (tid & 3) * 16;
    const unsigned char* dob = (const unsigned char*)F.out;
    float* GL = (float*)(F.ws + WS_GL); bf16* GP = (bf16*)(F.ws + WS_GP);
    for (int it = blockIdx.x; it < 256; it += F.G) {
        const int hd = it >> 4, sg = it & 15, dir = hd >> 3, h = hd & 7;
        bf16* Og = (bf16*)(F.ws + (dir ? WS_OGB : WS_OGF));
        f32x4 Sacc[8], Pacc[8];
        int dgi = 16 * w + fr - 4 * fq; asm volatile("" : "+v"(dgi));
#pragma unroll
        for (int kt = 0; kt < 8; ++kt) { Sacc[kt] = (f32x4){0.f, 0.f, 0.f, 0.f};
#pragma unroll
            for (int r = 0; r < 4; ++r) Pacc[kt][r] = (!PASS3 && (16 * kt + r == dgi)) ? 1.f : 0.f; }
        __syncthreads();
        if (PASS3) {
            for (int p = 0; p < sg; ++p) { const int ip = hd * 16 + p;
                { const bf16* src = GP + (size_t)ip * 16384 + vrow * 128 + (tid & 3) * 32;
#pragma unroll
                  for (int q = 0; q < 4; ++q) *(LAS v4u*)(PX + vrow * 136 + (tid & 3) * 32 + 8 * q) = *(const GAS v4u*)(src + 8 * q); }
#pragma unroll
                for (int kt = 0; kt < 8; ++kt) *(LAS v2u*)(ST + fr * 136 + 16 * kt + 4 * fq) = pack4(Sacc[kt]);
                __syncthreads();
                bf16x8 xs[4];
#pragma unroll
                for (int k0 = 0; k0 < 4; ++k0) xs[k0] = ldfrag(ST, 136, fr, 32 * k0 + 8 * fq);
#pragma unroll
                for (int kh = 0; kh < 2; ++kh) { bf16x8 pf[4][4]; f32x4 acc[4];
#pragma unroll
                    for (int kq = 0; kq < 4; ++kq) { const int kt = 4 * kh + kq; acc[kq] = *(const GAS f32x4*)(GL + ((size_t)((ip * 8 + w) * 8 + kt) * 64 + lane) * 4);
#pragma unroll
                        for (int k0 = 0; k0 < 4; ++k0) pf[kq][k0] = ldfrag(PX, 136, 16 * kt + fr, 32 * k0 + 8 * fq); }
                    SCHED_FENCE();
#pragma unroll
                    for (int k0 = 0; k0 < 4; ++k0)
#pragma unroll
                        for (int kq = 0; kq < 4; ++kq) acc[kq] = mfma16(pf[kq][k0], xs[k0], acc[kq]);
                    SCHED_FENCE();
#pragma unroll
                    for (int kq = 0; kq < 4; ++kq) Sacc[4 * kh + kq] = acc[kq]; }
                __syncthreads();
            }
        }
        v4u rw[2], rq[2], ru[2], rk[2], ra; float rs;
        gdn_load_tiles(F.ws, dob, tid, dir, hd, h, dir ? 255 - sg * 16 : sg * 16, PASS3, rw, rq, ru, rk, ra, rs);
        for (int ci = 0; ci < CPS; ++ci) {
            const int sc = sg * 16 + ci, oc = dir ? 255 - sc : sc, tok0 = 64 * oc;
            *(LAS v4u*)(WTL + row * 136 + c0) = rw[0]; *(LAS v4u*)(WTL + row * 136 + c0 + 8) = rw[1];
            *(LAS v4u*)(UTL + vrow * 72 + t0) = ru[0]; *(LAS v4u*)(UTL + vrow * 72 + t0 + 8) = ru[1];
            *(LAS v4u*)(KTL + vrow * 72 + t0) = rk[0]; *(LAS v4u*)(KTL + vrow * 72 + t0 + 8) = rk[1];
            if (PASS3) { *(LAS v4u*)(QNL + row * 136 + c0) = rq[0]; *(LAS v4u*)(QNL + row * 136 + c0 + 8) = rq[1]; *(LAS v4u*)(AQL + row * 72 + (tid & 7) * 8) = ra; }
            if (tid < 192) SCL[tid] = rs;
            __syncthreads();
            if (ci + 1 < CPS && !(SKIP & 1)) gdn_load_tiles(F.ws, dob, tid, dir, hd, h, dir ? oc - 1 : oc + 1, PASS3, rw, rq, ru, rk, ra, rs);
            const float gl = SCL[128];
            gdn_tile<PASS3, true>(Sacc, WTL, QNL, UTL, KTL, AQL, SCL, ST, VN, VNS, w, fr, fq, gl, Og + (size_t)tok0 * HW + h * 128);
            if (!PASS3) gdn_tile<PASS3, false>(Pacc, WTL, QNL, UTL, KTL, AQL, SCL, ST, VN, VNS, w, fr, fq, gl, Og);
            __syncthreads();
        }
        if (!PASS3) {
            int pofs = (4 * fq) * 128 + 16 * w + fr; asm volatile("" : "+v"(pofs));
            bf16* gp = GP + (size_t)it * 16384 + pofs;
#pragma unroll
            for (int kt = 0; kt < 8; ++kt) { *(GAS f32x4*)(GL + ((size_t)((it * 8 + w) * 8 + kt) * 64 + lane) * 4) = Sacc[kt];
#pragma unroll
                for (int r = 0; r < 4; ++r) gp[(16 * kt + r) * 128] = (bf16)f2bf(Pacc[kt][r]); }
        }
    }
}
__device__ __forceinline__ void p7_mix(Frame& F) {
    const int gw = F.vcu * NWAVES + F.wave, NGW = F.G * NWAVES, lane = F.lane;
    const int e0 = (lane & 7) * 16, col = (lane >> 3) * 128 + e0;
    for (int m = gw; m < SEQ; m += NGW) {
#pragma unroll
        for (int mx = 0; mx < 2; ++mx) {
            const bf16* of = (const bf16*)(F.ws + (mx ? WS_OGF : WS_OHF)); const bf16* ob = (const bf16*)(F.ws + (mx ? WS_OGB : WS_OHB));
            const bf16* gt = (const bf16*)(F.ws + WS_H + (size_t)(mx ? 8 : 4) * 32 * MiB); const float* nw = F.in[mx ? I_GNW : I_HNW];
            bf16* yo = (bf16*)(F.ws + (mx ? WS_YB : WS_YA));
            const size_t off = (size_t)m * HW + col;
            const v4u a0 = *(const GAS v4u*)(of + off), a1 = *(const GAS v4u*)(of + off + 8), b0 = *(const GAS v4u*)(ob + off), b1 = *(const GAS v4u*)(ob + off + 8), g0 = *(const GAS v4u*)(gt + off), g1 = *(const GAS v4u*)(gt + off + 8);
            const unsigned aw[8] = {a0.x, a0.y, a0.z, a0.w, a1.x, a1.y, a1.z, a1.w}, bw[8] = {b0.x, b0.y, b0.z, b0.w, b1.x, b1.y, b1.z, b1.w}, gw_[8] = {g0.x, g0.y, g0.z, g0.w, g1.x, g1.y, g1.z, g1.w};
            float o[16]; float ss = 0.f;
#pragma unroll
            for (int e = 0; e < 8; ++e) { o[2 * e] = bflo(aw[e]) + bflo(bw[e]); o[2 * e + 1] = bfhi(aw[e]) + bfhi(bw[e]); ss += o[2 * e] * o[2 * e] + o[2 * e + 1] * o[2 * e + 1]; }
            ss += __shfl_xor(ss, 1); ss += __shfl_xor(ss, 2); ss += __shfl_xor(ss, 4);
            const float r = 1.0f / sqrtf(ss * (1.f / 128.f) + EPS);
            unsigned yw[8];
#pragma unroll
            for (int e = 0; e < 8; ++e) yw[e] = pk2(o[2 * e] * r * nw[e0 + 2 * e] * bflo(gw_[e]), o[2 * e + 1] * r * nw[e0 + 2 * e + 1] * bfhi(gw_[e]));
            *(GAS v4u*)(yo + off) = (v4u){yw[0], yw[1], yw[2], yw[3]}; *(GAS v4u*)(yo + off + 8) = (v4u){yw[4], yw[5], yw[6], yw[7]};
        }
    }
    for (int tb = 0; tb < 2; ++tb) { const float* src = F.in[tb ? I_PV : I_PU]; unsigned char* dst = F.ws + (tb ? WS_TV : WS_TU); float* scl = (float*)(F.ws + WS_PSC) + tb * 16384;
        for (int r = gw; r < 16384; r += NGW) { const float* row = src + (size_t)r * DM; f32x4 v[8]; float mx = 0.f;
#pragma unroll
            for (int q = 0; q < 8; ++q) { v[q] = *(const GAS f32x4*)(row + (tb ? (q >> 2) * 1024 + lane * 16 + 4 * (q & 3) : lane * 32 + 4 * q)); const f32x4 a = __builtin_elementwise_abs(v[q]); mx = fmaxf(mx, fmaxf(fmaxf(a.x, a.y), fmaxf(a.z, a.w))); }
            mx = wave_max(mx);
            const float sc = mx > 0.f ? mx * (1.0f / 127.0f) : 1.0f, inv = 1.0f / sc; const int bias = tb ? 128 : 0;
            unsigned w[8];
#pragma unroll
            for (int q = 0; q < 8; ++q) { const f32x4 x = v[q]; const int a = (int)rintf(x.x * inv) + bias, b = (int)rintf(x.y * inv) + bias, c = (int)rintf(x.z * inv) + bias, d = (int)rintf(x.w * inv) + bias;
                w[q] = (unsigned)(a & 255) | ((unsigned)(b & 255) << 8) | ((unsigned)(c & 255) << 16) | ((unsigned)(d & 255) << 24); }
            if (tb) { *(GAS v4u*)(dst + (size_t)r * DM + lane * 16) = (v4u){w[0], w[1], w[2], w[3]}; *(GAS v4u*)(dst + (size_t)r * DM + 1024 + lane * 16) = (v4u){w[4], w[5], w[6], w[7]}; }
            else { GAS v4u* o = (GAS v4u*)(dst + ((size_t)lane * 16384 + r) * 32); o[0] = (v4u){w[0], w[1], w[2], w[3]}; o[1] = (v4u){w[4], w[5], w[6], w[7]}; }
            if (lane == 0) scl[r] = sc; } }
}
constexpr size_t WS_XQ = 80 * MiB;
constexpr size_t WS_SXR = 112 * MiB;
constexpr size_t WS_EID = 113 * MiB, WS_GATE = 121 * MiB, WS_AV = 129 * MiB;
constexpr size_t WS_REC = 208 * MiB;
constexpr int NET = 32, ETSZ = 512, NBUCK = 16 * NET, REC_CAP = 16384, CW_CNT = 8192, CW_Q = 8192 + 16 * NBUCK;
__device__ __forceinline__ unsigned fkey(float f) { const unsigned u = __builtin_bit_cast(unsigned, f); return (u & 0x80000000u) ? ~u : (u | 0x80000000u); }
__device__ __forceinline__ float gelu_erf(float x) { return 0.5f * x * (1.0f + erff(x * 0.70710678118654752f)); }
__device__ __forceinline__ float cvt_ub0(unsigned w) { float f; asm("v_cvt_f32_ubyte0 %0, %1" : "=v"(f) : "v"(w)); return f; }
__device__ __forceinline__ float cvt_ub1(unsigned w) { float f; asm("v_cvt_f32_ubyte1 %0, %1" : "=v"(f) : "v"(w)); return f; }
__device__ __forceinline__ float cvt_ub2(unsigned w) { float f; asm("v_cvt_f32_ubyte2 %0, %1" : "=v"(f) : "v"(w)); return f; }
__device__ __forceinline__ float cvt_ub3(unsigned w) { float f; asm("v_cvt_f32_ubyte3 %0, %1" : "=v"(f) : "v"(w)); return f; }

__device__ __forceinline__ float key_val(unsigned k, unsigned mask) { unsigned u = k & ~mask; u = (u & 0x80000000u) ? (u & 0x7fffffffu) : ~u; return __builtin_bit_cast(float, u); }
template <int SKIP>
__device__ __forceinline__ void p11a_topk(Frame& F) {
    LAS float* SCR = (LAS float*)(F.lds + F.wave * 16384);
    LAS unsigned* SL = (LAS unsigned*)SCR;
    LAS int* EIDS = (LAS int*)(SCR + 1024);
    LAS int* OFFS = (LAS int*)(SCR + 2048);
    LAS float* RTS = SCR + 2304;
    LAS int* BC = (LAS int*)(F.lds + 8 * 16384);
    const bf16* SC = (const bf16*)(F.ws + WS_SC);
    unsigned char* XQ = F.ws + WS_XQ; float* SXR = (float*)(F.ws + WS_SXR); int* EIDg = (int*)(F.ws + WS_EID); float* GATEg = (float*)(F.ws + WS_GATE); unsigned* REC = (unsigned*)(F.ws + WS_REC);
    for (int blk = F.vcu; blk < SEQ / 64; blk += F.G) {
        __syncthreads();
        if (F.tid < NET) BC[F.tid] = 0;
        __syncthreads();
        const int m0 = blk * 64 + F.wave * 8;
#pragma unroll 2
        for (int ti = 0; ti < 8; ++ti) { const int m = m0 + ti;
            int lane = F.lane; asm volatile("" : "+v"(lane));
            float xh[32]; float ss = 0.f;
            const float* x1 = F.out + (size_t)m * DM + lane * 32; const float* n2 = F.in[I_N2W] + lane * 32;
            f32x4 nwv[8];
#pragma unroll
            for (int q = 0; q < 8; ++q) { const f32x4 a = *(const GAS f32x4*)(x1 + 4 * q); nwv[q] = *(const GAS f32x4*)(n2 + 4 * q); xh[4 * q] = a.x; xh[4 * q + 1] = a.y; xh[4 * q + 2] = a.z; xh[4 * q + 3] = a.w; }
#pragma unroll
            for (int e = 0; e < 32; ++e) ss += xh[e] * xh[e];
            const float rt = 1.0f / sqrtf(wave_sum(ss) * (1.f / DM) + EPS);
            float amx = 0.f;
#pragma unroll
            for (int q = 0; q < 8; ++q) { const f32x4 a = nwv[q]; xh[4 * q] *= rt * a.x; xh[4 * q + 1] *= rt * a.y; xh[4 * q + 2] *= rt * a.z; xh[4 * q + 3] *= rt * a.w; }
#pragma unroll
            for (int e = 0; e < 32; ++e) amx = fmaxf(amx, fabsf(xh[e]));
            amx = wave_max(amx);
            const float sx = amx > 0.f ? amx * (1.0f / 127.0f) : 1.0f, isx = 1.0f / sx;
            unsigned xq[8];
#pragma unroll
            for (int d = 0; d < 8; ++d) { const int a = (int)rintf(xh[4 * d] * isx), b = (int)rintf(xh[4 * d + 1] * isx), c = (int)rintf(xh[4 * d + 2] * isx), e = (int)rintf(xh[4 * d + 3] * isx);
                xq[d] = (unsigned)(a & 255) | ((unsigned)(b & 255) << 8) | ((unsigned)(c & 255) << 16) | ((unsigned)(e & 255) << 24); }
            if (!(SKIP & 2)) { GAS v4u* o = (GAS v4u*)(XQ + ((size_t)lane * SEQ + m) * 32); o[0] = (v4u){xq[0], xq[1], xq[2], xq[3]}; o[1] = (v4u){xq[4], xq[5], xq[6], xq[7]}; }
            if (lane == 0) { SXR[2 * m] = sx; SXR[2 * m + 1] = rt; RTS[ti] = rt; }
        }
#pragma unroll 1
        for (int grp = 0; grp < 2; ++grp) {
            int lane = F.lane; asm volatile("" : "+v"(lane));
            if (!(SKIP & 1)) {
                { const bf16* src = SC + (size_t)(m0 + grp * 4 + (lane >> 4)) * DM + (lane & 15) * 128;
                  unsigned v[16];
#pragma unroll
                  for (int i = 0; i < 16; ++i) v[i] = 0u;
#pragma unroll 1
                  for (int s8 = 0; s8 < 2; ++s8) { v4u a8[8];
#pragma unroll
                      for (int u = 0; u < 8; ++u) a8[u] = *(const GAS v4u*)(src + 64 * s8 + 8 * u);
#pragma unroll
                      for (int u = 0; u < 8; ++u) { const unsigned wv[4] = {a8[u].x, a8[u].y, a8[u].z, a8[u].w};
#pragma unroll
                          for (int e = 0; e < 8; ++e) { const float sv = (e & 1) ? bfhi(wv[e >> 1]) : bflo(wv[e >> 1]); unsigned x = (fkey(sv) & ~127u) | (unsigned)(64 * s8 + 8 * u + e);
#pragma unroll
                              for (int i = 0; i < 16; ++i) { const unsigned hi = v[i] > x ? v[i] : x; x = v[i] > x ? x : v[i]; v[i] = hi; } } } }
#pragma unroll
                  for (int q = 0; q < 4; ++q) *(LAS v4u*)(SL + lane * 16 + 4 * q) = (v4u){v[4 * q], v[4 * q + 1], v[4 * q + 2], v[4 * q + 3]}; }
                asm volatile("" ::: "memory");
                if (lane < 32) { const int tk = lane >> 3, h = lane & 7, m = m0 + grp * 4 + tk;
                    const LAS unsigned* L1 = SL + (tk * 16 + 2 * h) * 16; const LAS unsigned* L2 = L1 + 16;
                    float f1[16], f2[16];
#pragma unroll
                    for (int q = 0; q < 4; ++q) { const v4u a = *(const LAS v4u*)(L1 + 4 * q), b = *(const LAS v4u*)(L2 + 4 * q);
                        f1[4 * q] = key_val(a.x, 127u); f1[4 * q + 1] = key_val(a.y, 127u); f1[4 * q + 2] = key_val(a.z, 127u); f1[4 * q + 3] = key_val(a.w, 127u);
                        f2[4 * q] = key_val(b.x, 127u); f2[4 * q + 1] = key_val(b.y, 127u); f2[4 * q + 2] = key_val(b.z, 127u); f2[4 * q + 3] = key_val(b.w, 127u); }
                    unsigned c[16];
#pragma unroll
                    for (int i = 0; i < 16; ++i) c[i] = 0u;
#pragma unroll
                    for (int i = 0; i < 16; ++i)
#pragma unroll
                        for (int j = 0; j < 16; ++j) if ((i + 1) * (j + 1) <= 16) { unsigned x = (fkey(f1[i] + f2[j]) & ~255u) | (unsigned)(i * 16 + j);
#pragma unroll
                            for (int r = 0; r < 16; ++r) { const unsigned hi = c[r] > x ? c[r] : x; x = c[r] > x ? x : c[r]; c[r] = hi; } }
                    const float rt = RTS[grp * 4 + tk];
                    float sc[16]; int ee[16]; float mx = -3.0e38f;
#pragma unroll
                    for (int r = 0; r < 16; ++r) { const unsigned ij = c[r] & 255u; const unsigned k1 = L1[ij >> 4], k2 = L2[ij & 15u];
                        sc[r] = key_val(k1, 127u) + key_val(k2, 127u); ee[r] = (int)((k1 & 127u) * 128u + (k2 & 127u)); mx = fmaxf(mx, sc[r]); }
                    float sum = 0.f;
#pragma unroll
                    for (int r = 0; r < 16; ++r) { sc[r] = __expf(rt * (sc[r] - mx)); sum += sc[r]; }
                    const float inv = 1.0f / sum;
#pragma unroll
                    for (int q = 0; q < 4; ++q) { *(LAS v4u*)(EIDS + (grp * 4 + tk) * 128 + h * 16 + 4 * q) = (v4u){(unsigned)ee[4 * q], (unsigned)ee[4 * q + 1], (unsigned)ee[4 * q + 2], (unsigned)ee[4 * q + 3]};
                        if (!(SKIP & 4)) { *(GAS v4u*)(EIDg + (size_t)m * 128 + h * 16 + 4 * q) = (v4u){(unsigned)ee[4 * q], (unsigned)ee[4 * q + 1], (unsigned)ee[4 * q + 2], (unsigned)ee[4 * q + 3]};
                            *(GAS f32x4*)(GATEg + (size_t)m * 128 + h * 16 + 4 * q) = (f32x4){sc[4 * q] * inv, sc[4 * q + 1] * inv, sc[4 * q + 2] * inv, sc[4 * q + 3] * inv}; } }
                }
                asm volatile("" ::: "memory");
            }
        }
#pragma unroll 1
        for (int ti = 0; ti < 8; ++ti) {
            int lane = F.lane; asm volatile("" : "+v"(lane));
            const int tA = (EIDS[ti * 128 + lane] >> 9) & 31, tB = (EIDS[ti * 128 + 64 + lane] >> 9) & 31; int mycnt = 0;
#pragma unroll
            for (int k = 0; k < NET; ++k) { const int c = __popcll(__ballot(tA == k)) + __popcll(__ballot(tB == k)); mycnt = (lane == k) ? c : mycnt; }
            if (lane < NET) OFFS[ti * NET + lane] = __hip_atomic_fetch_add((int*)(BC + lane), mycnt, __ATOMIC_RELAXED, __HIP_MEMORY_SCOPE_WORKGROUP);
        }
        __syncthreads();
        const int tt = blk >> 4;
        if (F.tid < NET) BC[NET + F.tid] = (int)__hip_atomic_fetch_add((unsigned*)(F.ctl + CW_CNT) + (tt * NET + F.tid) * 16, (unsigned)BC[F.tid], __ATOMIC_RELAXED, __HIP_MEMORY_SCOPE_AGENT);
        __syncthreads();
#pragma unroll 1
        for (int ti = 0; ti < 8; ++ti) { const int m = m0 + ti;
            int lane = F.lane; asm volatile("" : "+v"(lane));
            const unsigned long long lt_mask = (1ull << lane) - 1ull;
            const int eA = EIDS[ti * 128 + lane] & 16383, eB = EIDS[ti * 128 + 64 + lane] & 16383, tA = eA >> 9, tB = eB >> 9; int rankA = 0, rankB = 0;
#pragma unroll
            for (int k = 0; k < NET; ++k) { const unsigned long long mA = __ballot(tA == k), mB = __ballot(tB == k);
                rankA = (tA == k) ? __popcll(mA & lt_mask) : rankA; rankB = (tB == k) ? __popcll(mA) + __popcll(mB & lt_mask) : rankB; }
            const unsigned tl = (unsigned)(m & 1023) << 17;
            if (!(SKIP & 4)) { const int s = BC[NET + tA] + OFFS[ti * NET + tA] + rankA; if (s < REC_CAP) REC[(size_t)(tt * NET + tA) * REC_CAP + s] = tl | ((unsigned)(eA & 511) << 7) | (unsigned)lane; }
            if (!(SKIP & 4)) { const int s = BC[NET + tB] + OFFS[ti * NET + tB] + rankB; if (s < REC_CAP) REC[(size_t)(tt * NET + tB) * REC_CAP + s] = tl | ((unsigned)(eB & 511) << 7) | (unsigned)(lane + 64); }
        }
    }
}

constexpr int NSLOT = 12, UPITCH = 80;
__device__ __forceinline__ void p11b_udot(Frame& F) {
    LAS unsigned char* XS = (LAS unsigned char*)F.lds;
    LAS unsigned char* US = XS + 1024 * UPITCH;
    LAS int* QB = (LAS int*)(F.lds + 124 * 1024);
    const int tid = F.tid;
    const unsigned char* XQ = F.ws + WS_XQ; const unsigned char* TU = F.ws + WS_TU; const unsigned* REC = (const unsigned*)(F.ws + WS_REC);
    const float* SXR = (const float*)(F.ws + WS_SXR); const float* GATEg = (const float*)(F.ws + WS_GATE); float* AVg = (float*)(F.ws + WS_AV);
    const float* SU = (const float*)(F.ws + WS_PSC); const float* SV = SU + 16384;
    for (;;) {
        __syncthreads();
        if (tid == 0) QB[0] = (int)__hip_atomic_fetch_add((unsigned*)(F.ctl + CW_Q), 1u, __ATOMIC_RELAXED, __HIP_MEMORY_SCOPE_AGENT);
        __syncthreads();
        const int b = QB[0];
        if (b >= NBUCK) break;
        const int tt = b >> 5, et = b & 31;
        int n = (int)__hip_atomic_load((unsigned*)(F.ctl + CW_CNT) + b * 16, __ATOMIC_RELAXED, __HIP_MEMORY_SCOPE_AGENT); n = n < REC_CAP ? n : REC_CAP;
        for (int g0 = 0; g0 < n; g0 += NSLOT * NTHR) {
            const int npass = (n - g0) < NSLOT * NTHR ? (n - g0) : NSLOT * NTHR;
            unsigned rec[NSLOT]; int acc[NSLOT];
#pragma unroll
            for (int j = 0; j < NSLOT; ++j) { const int idx = g0 + j * NTHR + tid; const unsigned r = idx < n ? REC[(size_t)b * REC_CAP + idx] : 0xffffffffu; acc[j] = 0;
                rec[j] = ((r >> 17) & 1023u) | (((r >> 7) & 511u) << 16); }
            v4u st[12];
#define P11B_SRC(step, i) (((i) % 6) < 4 ? XQ + ((size_t)(2 * (step) + (i) / 6) * SEQ + tt * 1024) * 32 + (size_t)(tid + 512 * ((i) % 6)) * 16 : TU + ((size_t)(2 * (step) + (i) / 6) * 16384 + et * ETSZ) * 32 + (size_t)(tid + 512 * (((i) % 6) - 4)) * 16)
#pragma unroll
            for (int i = 0; i < 12; ++i) st[i] = *(const GAS v4u*)P11B_SRC(0, i);
#pragma unroll 1
            for (int c = 0; c < 32; ++c) {
                __syncthreads();
#pragma unroll
                for (int i = 0; i < 12; ++i) { const int q = i % 6, hc = i / 6, p = (q < 4) ? tid + 512 * q : tid + 512 * (q - 4); *(LAS v4u*)((q < 4 ? XS : US) + (p >> 1) * UPITCH + hc * 32 + (p & 1) * 16) = st[i]; }
                __syncthreads();
                if (c + 1 < 32) {
#pragma unroll
                    for (int i = 0; i < 12; ++i) st[i] = *(const GAS v4u*)P11B_SRC(c + 1, i);
                }
#pragma unroll
                for (int j0 = 0; j0 < NSLOT; j0 += 2) {
                    if (j0 * NTHR < npass) {
                        v4u xb[2][4], ub[2][4];
#pragma unroll
                        for (int q = 0; q < 2; ++q) { unsigned r = rec[j0 + q]; asm volatile("" : "+v"(r));
                            const unsigned xo = (r & 0xffffu) * UPITCH, uo = (r >> 16) * UPITCH;
#pragma unroll
                            for (int hh = 0; hh < 4; ++hh) { xb[q][hh] = *(const LAS v4u*)(XS + xo + 16 * hh); ub[q][hh] = *(const LAS v4u*)(US + uo + 16 * hh); } }
                        __builtin_amdgcn_sched_barrier(0);
#pragma unroll
                        for (int q = 0; q < 2; ++q) { int s = acc[j0 + q];
#pragma unroll
                            for (int hh = 0; hh < 4; ++hh) { const v4u u = ub[q][hh], x = xb[q][hh];
                                s = __builtin_amdgcn_sdot4((int)u.x, (int)x.x, s, false); s = __builtin_amdgcn_sdot4((int)u.y, (int)x.y, s, false); s = __builtin_amdgcn_sdot4((int)u.z, (int)x.z, s, false); s = __builtin_amdgcn_sdot4((int)u.w, (int)x.w, s, false); }
                            acc[j0 + q] = s; }
                        __builtin_amdgcn_sched_barrier(0);
                    }
                }
            }
#undef P11B_SRC
#pragma unroll
            for (int j = 0; j < NSLOT; ++j) { const int idx = g0 + j * NTHR + tid; const unsigned r = idx < n ? REC[(size_t)b * REC_CAP + idx] : 0xffffffffu;
                if (r != 0xffffffffu) { const int t = tt * 1024 + (int)((r >> 17) & 1023), e = et * ETSZ + (int)((r >> 7) & 511), j7 = (int)(r & 127);
                    const float hv = (float)acc[j] * SU[e] * SXR[2 * t]; AVg[(size_t)t * 128 + j7] = gelu_erf(hv) * GATEg[(size_t)t * 128 + j7] * SV[e]; } }
        }
    }
}

__device__ __forceinline__ void p11c_vsum(Frame& F) {
    const int gw = F.vcu * NWAVES + F.wave, NGW = F.G * NWAVES;
    LAS int* EID = (LAS int*)(F.lds + F.wave * 16384); LAS float* AV = (LAS float*)(EID + 128);
    const unsigned char* TV = F.ws + WS_TV; const int* EIDg = (const int*)(F.ws + WS_EID); const float* AVg = (const float*)(F.ws + WS_AV);
    for (int m = gw; m < SEQ; m += NGW) {
        int lane = F.lane; asm volatile("" : "+v"(lane));
        const int lo16 = lane * 16;
        EID[lane] = EIDg[(size_t)m * 128 + lane]; EID[lane + 64] = EIDg[(size_t)m * 128 + 64 + lane]; AV[lane] = AVg[(size_t)m * 128 + lane]; AV[lane + 64] = AVg[(size_t)m * 128 + 64 + lane];
        asm volatile("" ::: "memory");
        float y[32]; float sas = 0.f;
#pragma unroll
        for (int e = 0; e < 32; ++e) y[e] = 0.f;
        v4u rv[2][4][2]; float av[2][4];
#define P11C_LOAD(buf, g) do { _Pragma("unroll") for (int q = 0; q < 4; ++q) { const int e = __builtin_amdgcn_readfirstlane(EID[(g) + q]); av[buf][q] = AV[(g) + q]; const unsigned char* rp = TV + (size_t)e * DM + lo16; \
            rv[buf][q][0] = *(const GAS v4u*)(rp); rv[buf][q][1] = *(const GAS v4u*)(rp + 1024); } } while (0)
#define P11C_ACC(buf) do { _Pragma("unroll") for (int q = 0; q < 4; ++q) { const float a = av[buf][q]; sas += a; \
            _Pragma("unroll") for (int j = 0; j < 2; ++j) { const v4u r = rv[buf][q][j]; const unsigned wv[4] = {r.x, r.y, r.z, r.w}; \
                _Pragma("unroll") for (int dd = 0; dd < 4; ++dd) { y[16 * j + 4 * dd] += a * cvt_ub0(wv[dd]); y[16 * j + 4 * dd + 1] += a * cvt_ub1(wv[dd]); y[16 * j + 4 * dd + 2] += a * cvt_ub2(wv[dd]); y[16 * j + 4 * dd + 3] += a * cvt_ub3(wv[dd]); } } \
            __builtin_amdgcn_sched_barrier(0); } } while (0)
        P11C_LOAD(0, 0);
#pragma unroll 1
        for (int g = 0; g < 128; g += 8) {
            P11C_LOAD(1, g + 4);
            P11C_ACC(0);
            if (g + 8 < 128) P11C_LOAD(0, g + 8);
            P11C_ACC(1);
        }
#undef P11C_LOAD
#undef P11C_ACC
        const float* x1 = F.out + (size_t)m * DM;
        float s2 = 0.f; const float corr = 128.0f * sas;
#pragma unroll
        for (int j = 0; j < 2; ++j)
#pragma unroll
            for (int q = 0; q < 4; ++q) { const f32x4 a = *(const GAS f32x4*)(x1 + j * 1024 + lo16 + 4 * q);
                y[16 * j + 4 * q] += a.x - corr; y[16 * j + 4 * q + 1] += a.y - corr; y[16 * j + 4 * q + 2] += a.z - corr; y[16 * j + 4 * q + 3] += a.w - corr; }
#pragma unroll
        for (int e = 0; e < 32; ++e) s2 += y[e] * y[e];
        const float ro = 1.0f / sqrtf(wave_sum(s2) * (1.f / DM) + EPS);
        float* orow = F.out + (size_t)m * DM;
#pragma unroll
        for (int j = 0; j < 2; ++j)
#pragma unroll
            for (int q = 0; q < 4; ++q) { const f32x4 a = *(const GAS f32x4*)(F.in[I_FNW] + j * 1024 + lo16 + 4 * q);
                *(GAS f32x4*)(orow + j * 1024 + lo16 + 4 * q) = (f32x4){y[16 * j + 4 * q] * ro * a.x, y[16 * j + 4 * q + 1] * ro * a.y, y[16 * j + 4 * q + 2] * ro * a.z, y[16 * j + 4 * q + 3] * ro * a.w}; }
    }
}
#ifndef MK_N_LAUNCHES
#define MK_N_LAUNCHES 1
#endif
constexpr int N_PHASES = 14;
constexpr int N_LAUNCHES = MK_N_LAUNCHES;
static_assert(N_LAUNCHES == 1 || N_LAUNCHES == N_PHASES, "MK_N_LAUNCHES is 1 or N_PHASES");
#ifndef PG8_SP2
#define PG8_SP2 true
#endif
#ifndef PG8_ALIGN
#define PG8_ALIGN true
#endif
struct Args { const float* in[19]; float* out; unsigned char* ws; int ph_lo, ph_hi; };
__global__ void __launch_bounds__(NTHR, 2) fwd_kernel(Args args) {
    extern __shared__ __attribute__((aligned(16))) unsigned char lds[];
    Frame F;
    F.lds = (LAS unsigned char*)lds;
    F.MISC = (volatile LAS unsigned*)(F.lds + MISC_OFF);
    F.tid = threadIdx.x; F.lane = F.tid & 63; F.wave = __builtin_amdgcn_readfirstlane(F.tid >> 6);
    F.G = gridDim.x; { const int bx = blockIdx.x; F.vcu = (F.G % 8 == 0) ? (bx % 8) * (F.G / 8) + bx / 8 : bx; }
    F.ws = args.ws; F.out = args.out; F.ctl = (gu32*)(args.ws + WS_CTL);
#pragma unroll
    for (int i = 0; i < 19; ++i) F.in[i] = args.in[i];
    for (int u = F.tid; u < (LDS_BYTES - MISC_OFF) / 4; u += NTHR) ((LAS unsigned*)(F.lds + MISC_OFF))[u] = 0u;
    __syncthreads();
    XcdBarrier bar; bar.bar = (unsigned*)(F.ctl + CW_BAR); bar.x = 0; bar.st = nullptr;
    if (N_LAUNCHES == 1) bar = xcd_barrier_post((unsigned*)(F.ctl + CW_BAR), F.MISC + 8);
    const int lo = args.ph_lo, hi = args.ph_hi;
#ifdef ONLY_PHASE
#define IN(k) ((k) == ONLY_PHASE && lo <= (k) && (k) < hi)
#else
#define IN(k) (lo <= (k) && (k) < hi)
#endif
#define SEAM(k) do { if (IN(k) && IN((k) + 1)) xcd_barrier(bar); } while (0)
#ifndef REPEAT_MASK
#define REPEAT_MASK 0
#endif
#ifndef P11A_SKIP
#define P11A_SKIP 0
#endif
#define REPS(k) for (int rep_ = 0; rep_ < (((REPEAT_MASK) >> (k)) & 1) + 1; ++rep_)
#define RSEAM(k) do { if ((((REPEAT_MASK) >> (k)) & 1) && rep_ == 0) xcd_barrier(bar); } while (0)
    unsigned char* ws = args.ws;
    if (IN(0)) { REPS(0) { p0_prologue(F); RSEAM(0); } SEAM(0); }
    if (IN(1)) {
        pg8::Gemm g{(const bf16*)(ws + WS_XN), (const bf16*)(ws + WS_W1), SEQ, N1, DM}; pg8::StaticOrder S; S.init(SEQ, N1, F.G, (int)blockIdx.x);
        EpiG1 E{ws, F.in[I_LB]};
        if ((REPEAT_MASK >> 1) & 1) { pg8::gemm_phase<EpiG1, pg8::StaticOrder, PG8_ALIGN, PG8_SP2>(F.lds, g, S, E); xcd_barrier(bar); }
        pg8::gemm_phase<EpiG1, pg8::StaticOrder, PG8_ALIGN, PG8_SP2>(F.lds, g, S, E);
        p1_ab(F);
        SEAM(1);
    }
#ifdef EXTRA_BARRIERS
    for (int eb = 0; eb < EXTRA_BARRIERS; ++eb) xcd_barrier(bar);
#endif
    if (IN(2)) { REPS(2) { hgrn_pass<false>(F); RSEAM(2); } SEAM(2); }
    if (IN(3)) { if ((REPEAT_MASK >> 3) & 1) { hgrn_pass<true, P11A_SKIP>(F); xcd_barrier(bar); } hgrn_pass<true>(F); SEAM(3); }
    if (IN(4)) { if ((REPEAT_MASK >> 4) & 1) { gdn_prep<P11A_SKIP>(F); xcd_barrier(bar); } gdn_prep<0>(F); SEAM(4); }
    if (IN(5)) { if ((REPEAT_MASK >> 5) & 1) { gdn_pass<false, P11A_SKIP>(F); xcd_barrier(bar); } gdn_pass<false>(F); SEAM(5); }
    if (IN(6)) { if ((REPEAT_MASK >> 6) & 1) { gdn_pass<true, P11A_SKIP>(F); xcd_barrier(bar); } gdn_pass<true>(F); SEAM(6); }
    if (IN(7)) { REPS(7) { p7_mix(F); RSEAM(7); } SEAM(7); }
    if (IN(8)) {
        pg8::StaticOrder S; S.init(SEQ, DM, F.G, (int)blockIdx.x);
        bf16* GT = (bf16*)(ws + WS_GT); bf16* GT2 = (bf16*)(ws + WS_GT2);
#define P8_BODY \
        { pg8::Gemm g{(const bf16*)(ws + WS_XN), (const bf16*)(ws + WS_WG), SEQ, DM, DM}; EpiGate E{GT}; pg8::gemm_phase<EpiGate, pg8::StaticOrder, PG8_ALIGN, PG8_SP2>(F.lds, g, S, E); } \
        __builtin_amdgcn_fence(__ATOMIC_ACQUIRE, "agent"); VM_WAIT(); __syncthreads(); \
        { pg8::Gemm g{(const bf16*)(ws + WS_YA), (const bf16*)(ws + WS_WPA), SEQ, DM, HW}; EpiMix<0> E{GT, nullptr}; pg8::gemm_phase<EpiMix<0>, pg8::StaticOrder, PG8_ALIGN, PG8_SP2>(F.lds, g, S, E); } \
        { pg8::Gemm g{(const bf16*)(ws + WS_XN), (const bf16*)(ws + WS_WG) + (size_t)DM * DM, SEQ, DM, DM}; EpiGate E{GT2}; pg8::gemm_phase<EpiGate, pg8::StaticOrder, PG8_ALIGN, PG8_SP2>(F.lds, g, S, E); } \
        __builtin_amdgcn_fence(__ATOMIC_ACQUIRE, "agent"); VM_WAIT(); __syncthreads(); \
        { pg8::Gemm g{(const bf16*)(ws + WS_YB), (const bf16*)(ws + WS_WPB), SEQ, DM, HW}; EpiMix<1> E{GT, GT2}; pg8::gemm_phase<EpiMix<1>, pg8::StaticOrder, PG8_ALIGN, PG8_SP2>(F.lds, g, S, E); }
        if ((REPEAT_MASK >> 8) & 1) { P8_BODY xcd_barrier(bar); }
        P8_BODY
#undef P8_BODY
        SEAM(8);
    }
    if (IN(9)) {
        pg8::Gemm g{(const bf16*)(ws + WS_GT), (const bf16*)(ws + WS_WOUT), SEQ, DM, DM}; pg8::StaticOrder S; S.init(SEQ, DM, F.G, (int)blockIdx.x);
        EpiX1 E{F.in[I_X], F.out, (bf16*)(ws + WS_X1B)};
        if ((REPEAT_MASK >> 9) & 1) { pg8::gemm_phase<EpiX1, pg8::StaticOrder, PG8_ALIGN, PG8_SP2>(F.lds, g, S, E); xcd_barrier(bar); }
        pg8::gemm_phase<EpiX1, pg8::StaticOrder, PG8_ALIGN, PG8_SP2>(F.lds, g, S, E);
        SEAM(9);
    }
    if (IN(10)) {
        pg8::Gemm g{(const bf16*)(ws + WS_X1B), (const bf16*)(ws + WS_WS), SEQ, DM, DM}; pg8::StaticOrder S; S.init(SEQ, DM, F.G, (int)blockIdx.x);
        EpiBf E{(bf16*)(ws + WS_SC)};
        if ((REPEAT_MASK >> 10) & 1) { pg8::gemm_phase<EpiBf, pg8::StaticOrder, PG8_ALIGN, PG8_SP2>(F.lds, g, S, E); xcd_barrier(bar); }
        pg8::gemm_phase<EpiBf, pg8::StaticOrder, PG8_ALIGN, PG8_SP2>(F.lds, g, S, E);
        SEAM(10);
    }
    if (IN(11)) {
        if ((REPEAT_MASK >> 11) & 1) { p11a_topk<P11A_SKIP>(F); xcd_barrier(bar); if (blockIdx.x == 0) for (int i = F.tid; i < NBUCK + 1; i += NTHR) __hip_atomic_store((unsigned*)(F.ctl + CW_CNT) + i * 16, 0u, __ATOMIC_RELAXED, __HIP_MEMORY_SCOPE_AGENT); xcd_barrier(bar); }
        p11a_topk<0>(F); SEAM(11); }
    if (IN(12)) { if ((REPEAT_MASK >> 12) & 1) { p11b_udot(F); xcd_barrier(bar); if (blockIdx.x == 0 && F.tid == 0) __hip_atomic_store((unsigned*)(F.ctl + CW_Q), 0u, __ATOMIC_RELAXED, __HIP_MEMORY_SCOPE_AGENT); xcd_barrier(bar); } p11b_udot(F); SEAM(12); }
    if (IN(13)) { p11c_vsum(F); }
#undef IN
#undef SEAM
}


#ifdef PROBE
__global__ void digest_kernel(const unsigned* ws, float* out) {
    const size_t n = (size_t)SEQ * DM;
    for (size_t i = (size_t)blockIdx.x * blockDim.x + threadIdx.x; i < n; i += (size_t)gridDim.x * blockDim.x) {
        unsigned acc = (PROBE >= 9) ? __builtin_bit_cast(unsigned, out[i]) : 0u;
        const size_t offs[5] = {0, 128 * MiB / 4, 256 * MiB / 4, 384 * MiB / 4, 408 * MiB / 4};
#pragma unroll
        for (int r = 0; r < 5; ++r) acc = acc * 1664525u + ws[offs[r] + i];
        out[i] = (float)(acc >> 8) * (1.0f / 16777216.0f);
    }
}
#endif
extern "C" void kernel_launch(void* const* d_in, const int* in_sizes, int n_in, void* d_out, int out_size, void* d_ws, size_t ws_size, hipStream_t stream) {
    static int grid = 0;
    if (grid == 0) {
        if (n_in != 19 || in_sizes[0] != SEQ * DM || out_size != SEQ * DM || ws_size < WS_END) { fprintf(stderr, "kernel_launch: unexpected shapes (n_in %d, in0 %d, out %d, ws %zu; need ws >= %zu)\n", n_in, n_in > 0 ? in_sizes[0] : -1, out_size, ws_size, (size_t)WS_END); grid = -1; return; }
        int dev = 0, cus = 0, per_cu = 0;
        if (hipGetDevice(&dev) != hipSuccess || hipDeviceGetAttribute(&cus, hipDeviceAttributeMultiprocessorCount, dev) != hipSuccess) { grid = -1; return; }
        if (hipFuncSetAttribute((const void*)fwd_kernel, hipFuncAttributeMaxDynamicSharedMemorySize, LDS_BYTES) != hipSuccess) { fprintf(stderr, "kernel_launch: hipFuncSetAttribute failed\n"); grid = -1; return; }
        if (hipOccupancyMaxActiveBlocksPerMultiprocessor(&per_cu, (const void*)fwd_kernel, NTHR, LDS_BYTES) != hipSuccess || per_cu < 1) fprintf(stderr, "kernel_launch: occupancy query reports %d\n", per_cu);
        (void)hipGetLastError();
        grid = cus;
    }
    if (grid < 0) return;
    (void)hipMemsetAsync((char*)d_ws + WS_CTL, 0, CTL_ZERO_BYTES, stream);
    Args a{};
    for (int i = 0; i < 19; ++i) a.in[i] = (const float*)d_in[i];
    a.out = (float*)d_out; a.ws = (unsigned char*)d_ws;
    for (int li = 0; li < N_LAUNCHES; ++li) {
        a.ph_lo = (N_LAUNCHES == 1) ? 0 : li; a.ph_hi = (N_LAUNCHES == 1) ? N_PHASES : li + 1;
#ifdef PROBE
        if (li > PROBE) break;
#endif
        hipLaunchKernelGGL(fwd_kernel, dim3(grid), dim3(NTHR), LDS_BYTES, stream, a);
    }
#ifdef PROBE
    hipLaunchKernelGGL(digest_kernel, dim3(2048), dim3(256), 0, stream, (const unsigned*)d_ws, (float*)d_out);
#endif
}
```

```cpp
#include <hip/hip_runtime.h>
#include <cstdio>
#include <cstdint>
#define GAS __attribute__((address_space(1)))
#define LAS __attribute__((address_space(3)))
#define MK_N_LAUNCHES 1
namespace pg8 {
#define PG8_LAS __attribute__((address_space(3)))
typedef unsigned short bf16_t;
typedef short bf16x8 __attribute__((ext_vector_type(8)));
typedef float f32x4 __attribute__((ext_vector_type(4)));
typedef unsigned u32x4 __attribute__((ext_vector_type(4)));
constexpr int BM = 256, BK = 64, HALF = 128, HTB = HALF * BK * 2  , STAGE_BYTES = 8 * HTB, NXCD = 8, WGM = 8;

__host__ __device__ __forceinline__ int lds_byte(int r, int c) { const int st = (r >> 4) * 2 + (c >> 5), rr = r & 15, cc = c & 31, ob = rr * 64 + cc * 2; return st * 1024 + (ob ^ (((ob >> 9) & 1) << 5)); }
__host__ __device__ __forceinline__ void stage_rc(int b, int& R, int& C) { const int st = b / 1024, sb = b % 1024, swz = sb ^ (((sb >> 9) & 1) << 5); R = (st >> 1) * 16 + swz / 64; C = (st & 1) * 32 + (swz % 64) / 2; }
__host__ __device__ __forceinline__ int perm32(int rho) { const int n = rho >> 4, i = rho & 15; return 8 * (i >> 2) + 4 * n + (i & 3); }

struct Unit { int pm, pn; };
struct Gemm { const bf16_t* A; const bf16_t* Bt; int M, N, K; };

struct StaticOrder {
    int nM, nN, nwg, G, c;
    __host__ __device__ void init(int M, int N, int G_, int c_) { nM = M / BM; nN = N / BM; nwg = nM * nN; G = G_; c = c_; }
    __host__ __device__ bool next(int i, Unit& u) const {
        const long L = (long)i * G + c; if (L >= nwg) return false;
        int wgid = (int)L; { const int q = nwg / NXCD, r = nwg % NXCD, xcd = wgid % NXCD, off = wgid / NXCD; wgid = (xcd < r ? xcd * (q + 1) : r * (q + 1) + (xcd - r) * q) + off; }
        const int nig = WGM * nN, gid = wgid / nig, fm = gid * WGM, gsz = (nM - fm) < WGM ? (nM - fm) : WGM;
        u.pm = fm + ((wgid % nig) % gsz); u.pn = (wgid % nig) / gsz; return true;
    }
    __device__ __forceinline__ void a_ready(const Unit&) const {}
    __device__ __forceinline__ void done(const Unit&) const {}
};

__device__ __forceinline__ unsigned cvt_pk_bf16(float lo, float hi) { unsigned r; asm volatile("v_cvt_pk_bf16_f32 %0, %1, %2" : "=v"(r) : "v"(lo), "v"(hi)); return r; }
typedef float f32x2 __attribute__((ext_vector_type(2)));
__device__ __forceinline__ f32x2 gelu_pk(f32x2 v) {
    const f32x2 av = __builtin_elementwise_abs(v), d = av * 0.2316418882f + 1.0f;
    f32x2 t; t.x = __builtin_amdgcn_rcpf(d.x); t.y = __builtin_amdgcn_rcpf(d.y);
    f32x2 q = t * 0.5307027145f + (-0.7265760135f); q = q * t + 0.7107068705f; q = q * t + (-0.142248368f); q = q * t + 0.127414796f; q = q * t;
    const f32x2 s = (v * v) * (-0.72134752044f);
    f32x2 e; e.x = __builtin_amdgcn_exp2f(s.x); e.y = __builtin_amdgcn_exp2f(s.y);
    const f32x2 m = v * (q * e), r = v - m;
    f32x2 o; o.x = v.x < 0.f ? m.x : r.x; o.y = v.y < 0.f ? m.y : r.y; return o;
}

typedef int i32x4v __attribute__((ext_vector_type(4)));
typedef int i32x8v __attribute__((ext_vector_type(8)));
__device__ __forceinline__ i32x8v cat8(bf16x8 lo, bf16x8 hi) { return __builtin_shufflevector(__builtin_bit_cast(i32x4v, lo), __builtin_bit_cast(i32x4v, hi), 0, 1, 2, 3, 4, 5, 6, 7); }
template <class Epi, class Sched, bool ALIGN_EPI = false, bool SP2 = false, int QM = 0>
__device__ __forceinline__ void gemm_phase(PG8_LAS unsigned char* lds, const Gemm g, const Sched& S, const Epi& E) {
    const int tid = threadIdx.x, wid = __builtin_amdgcn_readfirstlane(tid >> 6), lane = tid & 63, wr = wid >> 2, wc = wid & 3, fr = lane & 15, fq = lane >> 4;
    constexpr bool F8 = QM == 1, I8 = QM == 2;
    const int K = g.K, KB = QM ? K : 2 * K  , nt = KB / (BK * 2);
    unsigned voffA[2], voffB[2];
#pragma unroll
    for (int i = 0; i < 2; ++i) { int R, C; stage_rc(tid * 16 + i * 8192, R, C); const int Rb = Epi::PERM ? ((R & ~31) + perm32(R & 31)) : R;
        voffA[i] = (unsigned)(R * KB + C * 2); voffB[i] = (unsigned)(Rb * KB + C * 2); }
    const size_t kstep = (size_t)(BK * 2);
    const size_t hstep = (size_t)HALF * KB;
    const size_t tstep = 2 * hstep;
    const unsigned ldsw = (unsigned)wid * 1024u;
    const int aoff = lds_byte(wr * 64 + fr, fq * 8), boff = lds_byte(wc * 32 + fr, fq * 8);
#define PG8_SA(b, h) (((b) * 2 + (h)) * HTB)
#define PG8_SB(b, h) ((4 + (b) * 2 + (h)) * HTB)
#define PG8_STAGE(bufoff, gbase, voff) do { _Pragma("unroll") for (int _i = 0; _i < 2; ++_i) \
        __builtin_amdgcn_global_load_lds((const unsigned*)((const char*)(gbase) + (voff)[_i]), (PG8_LAS unsigned*)(lds + (bufoff) + ldsw + _i * 8192), 16, 0, 0); } while (0)
#define PG8_LD16(off) (*(const PG8_LAS bf16x8*)(lds + (off)))
#define PG8_LDA(dst, b, h) do { _Pragma("unroll") for (int m = 0; m < 4; ++m) { if constexpr (F8) dst##8[m] = cat8(PG8_LD16(PG8_SA(b, h) + aoff + m * 2048), PG8_LD16(PG8_SA(b, h) + aoff + m * 2048 + 1024)); \
        else { _Pragma("unroll") for (int k = 0; k < 2; ++k) dst[m][k] = PG8_LD16(PG8_SA(b, h) + aoff + m * 2048 + k * 1024); } } } while (0)
#define PG8_LDB(dst, b, h) do { _Pragma("unroll") for (int n = 0; n < 2; ++n) { if constexpr (F8) dst##8[n] = cat8(PG8_LD16(PG8_SB(b, h) + boff + n * 2048), PG8_LD16(PG8_SB(b, h) + boff + n * 2048 + 1024)); \
        else { _Pragma("unroll") for (int k = 0; k < 2; ++k) dst[n][k] = PG8_LD16(PG8_SB(b, h) + boff + n * 2048 + k * 1024); } } } while (0)
#define PG8_MMA(ai, bj, At, Bt) do { __builtin_amdgcn_s_setprio(1); _Pragma("unroll") for (int m = 0; m < 4; ++m) _Pragma("unroll") for (int n = 0; n < 2; ++n) { \
        if constexpr (F8) asm volatile("v_mfma_f32_16x16x128_f8f6f4 %0, %1, %2, %0" : "+v"(acc[ai][bj][m][n]) : "v"(Bt##8[n]), "v"(At##8[m])); \
        else if constexpr (I8) { _Pragma("unroll") for (int k = 0; k < 2; ++k) acc[ai][bj][m][n] = __builtin_bit_cast(f32x4, __builtin_amdgcn_mfma_i32_16x16x64_i8(__builtin_bit_cast(i32x4v, Bt[n][k]), __builtin_bit_cast(i32x4v, At[m][k]), __builtin_bit_cast(i32x4v, acc[ai][bj][m][n]), 0, 0, 0)); } \
        else { _Pragma("unroll") for (int k = 0; k < 2; ++k) acc[ai][bj][m][n] = __builtin_amdgcn_mfma_f32_16x16x32_bf16(Bt[n][k], At[m][k], acc[ai][bj][m][n], 0, 0, 0); } } \
        __builtin_amdgcn_s_setprio(0); } while (0)
#define PG8_WAIT_V(n) asm volatile("s_waitcnt vmcnt(" #n ")" ::: "memory")
#define PG8_WAIT_L(n) asm volatile("s_waitcnt lgkmcnt(" #n ")" ::: "memory")
#define PG8_BAR __builtin_amdgcn_s_barrier()
#define PG8_SCHED __builtin_amdgcn_sched_barrier(0)
    Unit cur, nxt; int ui = 0;
    if (!S.next(0, cur)) return;
    f32x4 acc[2][2][4][2];
#pragma unroll
    for (int a = 0; a < 2; ++a)
#pragma unroll
        for (int b = 0; b < 2; ++b)
#pragma unroll
            for (int m = 0; m < 4; ++m)
#pragma unroll
                for (int n = 0; n < 2; ++n) acc[a][b][m][n] = (f32x4){0.f, 0.f, 0.f, 0.f};
    bf16x8 At[4][2], B0[2][2], B1[2][2]; i32x8v At8[4], B08[2], B18[2];
    const char* cA = (const char*)g.A + (size_t)cur.pm * tstep; const char* cB = (const char*)g.Bt + (size_t)cur.pn * tstep;
    S.a_ready(cur);
    if constexpr (SP2) {
        PG8_STAGE(PG8_SB(0, 0), cB, voffB); PG8_STAGE(PG8_SB(0, 1), cB + hstep, voffB); PG8_STAGE(PG8_SA(0, 0), cA, voffA); PG8_STAGE(PG8_SA(0, 1), cA + hstep, voffA);
        if (wr == 1) PG8_BAR;
        PG8_WAIT_V(2); PG8_BAR;
        PG8_STAGE(PG8_SB(1, 0), cB + kstep, voffB); PG8_STAGE(PG8_SA(1, 0), cA + kstep, voffA); PG8_STAGE(PG8_SB(1, 1), cB + hstep + kstep, voffB);
        PG8_WAIT_V(6); PG8_BAR;
    } else {
        PG8_STAGE(PG8_SB(0, 0), cB, voffB); PG8_STAGE(PG8_SA(0, 0), cA, voffA); PG8_STAGE(PG8_SB(0, 1), cB + hstep, voffB); PG8_STAGE(PG8_SA(0, 1), cA + hstep, voffA);
        if (wr == 1) PG8_BAR;
        PG8_WAIT_V(4); PG8_BAR;
        PG8_STAGE(PG8_SB(1, 0), cB + kstep, voffB); PG8_STAGE(PG8_SA(1, 0), cA + kstep, voffA); PG8_STAGE(PG8_SB(1, 1), cB + hstep + kstep, voffB);
        PG8_WAIT_V(6); PG8_BAR;
    }
    for (;;) {
        const bool has_next = S.next(ui + 1, nxt);
        const char* nA = has_next ? (const char*)g.A + (size_t)nxt.pm * tstep : cA; const char* nB = has_next ? (const char*)g.Bt + (size_t)nxt.pn * tstep : cB;
        for (int t = 0; t < nt; t += 2) {
            const bool last = (t == nt - 2);
            const char* a1 = cA + (size_t)(t + 1) * kstep;
            const char* a2 = last ? nA : cA + (size_t)(t + 2) * kstep; const char* b2 = last ? nB : cB + (size_t)(t + 2) * kstep;
            const char* a3 = a2 + kstep; const char* b3 = b2 + kstep;
            if (last && has_next) S.a_ready(nxt);
            if constexpr (SP2) {
            PG8_LDB(B0, 0, 0); PG8_LDB(B1, 0, 1); PG8_SCHED; PG8_LDA(At, 0, 0); PG8_STAGE(PG8_SA(1, 1), a1 + hstep, voffA);
            PG8_WAIT_V(8); PG8_WAIT_L(0); PG8_BAR; PG8_MMA(0, 0, At, B0); PG8_MMA(0, 1, At, B1); PG8_BAR; PG8_SCHED;
            PG8_LDA(At, 0, 1); PG8_STAGE(PG8_SB(0, 0), b2, voffB); PG8_STAGE(PG8_SB(0, 1), b2 + hstep, voffB); PG8_STAGE(PG8_SA(0, 0), a2, voffA);
            PG8_WAIT_V(8); PG8_WAIT_L(0); PG8_BAR; PG8_MMA(1, 0, At, B0); PG8_MMA(1, 1, At, B1); PG8_BAR; PG8_SCHED;
            PG8_LDB(B0, 1, 0); PG8_LDB(B1, 1, 1); PG8_SCHED; PG8_LDA(At, 1, 0); PG8_STAGE(PG8_SA(0, 1), a2 + hstep, voffA);
            PG8_WAIT_V(8); PG8_WAIT_L(0); PG8_BAR; PG8_MMA(0, 0, At, B0); PG8_MMA(0, 1, At, B1); PG8_BAR; PG8_SCHED;
            PG8_LDA(At, 1, 1); PG8_STAGE(PG8_SB(1, 0), b3, voffB); PG8_STAGE(PG8_SB(1, 1), b3 + hstep, voffB); PG8_STAGE(PG8_SA(1, 0), a3, voffA);
            PG8_WAIT_V(8); PG8_WAIT_L(0); PG8_BAR; PG8_MMA(1, 0, At, B0); PG8_MMA(1, 1, At, B1); PG8_BAR; PG8_SCHED;
            } else {
            PG8_LDB(B0, 0, 0); PG8_SCHED; PG8_LDA(At, 0, 0); PG8_STAGE(PG8_SA(1, 1), a1 + hstep, voffA);
            PG8_WAIT_L(8); PG8_BAR; PG8_WAIT_L(0); PG8_MMA(0, 0, At, B0); PG8_BAR; PG8_SCHED;
            PG8_LDB(B1, 0, 1); PG8_STAGE(PG8_SB(0, 0), b2, voffB);
            PG8_BAR; PG8_WAIT_L(0); PG8_MMA(0, 1, At, B1); PG8_BAR;
            PG8_LDA(At, 0, 1); PG8_STAGE(PG8_SA(0, 0), a2, voffA);
            PG8_BAR; PG8_WAIT_L(0); PG8_MMA(1, 0, At, B0); PG8_BAR; PG8_SCHED;
            PG8_STAGE(PG8_SB(0, 1), b2 + hstep, voffB);
            PG8_WAIT_V(6); PG8_BAR; PG8_MMA(1, 1, At, B1); PG8_BAR;
            PG8_LDB(B0, 1, 0); PG8_SCHED; PG8_LDA(At, 1, 0); PG8_STAGE(PG8_SA(0, 1), a2 + hstep, voffA);
            PG8_WAIT_L(8); PG8_BAR; PG8_WAIT_L(0); PG8_MMA(0, 0, At, B0); PG8_BAR; PG8_SCHED;
            PG8_LDB(B1, 1, 1); PG8_STAGE(PG8_SB(1, 0), b3, voffB);
            PG8_BAR; PG8_WAIT_L(0); PG8_MMA(0, 1, At, B1); PG8_BAR;
            PG8_LDA(At, 1, 1); PG8_STAGE(PG8_SA(1, 0), a3, voffA);
            PG8_BAR; PG8_WAIT_L(0); PG8_MMA(1, 0, At, B0); PG8_BAR; PG8_SCHED;
            PG8_STAGE(PG8_SB(1, 1), b3 + hstep, voffB);
            PG8_WAIT_V(6); PG8_BAR; PG8_MMA(1, 1, At, B1); PG8_BAR;
            }
        }
        if constexpr (ALIGN_EPI) { if (wr == 0) PG8_BAR; }
        if constexpr (F8) asm volatile("s_nop 15\n\ts_nop 15" ::: "memory");
        if constexpr (!Epi::AFTER_DRAIN) { E(acc, cur, wr, wc, fr, fq); S.done(cur); }
        if (!has_next) break;
#pragma unroll
        for (int a = 0; a < 2; ++a)
#pragma unroll
            for (int b = 0; b < 2; ++b)
#pragma unroll
                for (int m = 0; m < 4; ++m)
#pragma unroll
                    for (int n = 0; n < 2; ++n) acc[a][b][m][n] = (f32x4){0.f, 0.f, 0.f, 0.f};
        cur = nxt; cA = nA; cB = nB; ++ui;
        if constexpr (ALIGN_EPI) { if (wr == 1) PG8_BAR; }
    }
    PG8_WAIT_V(0);
    if constexpr (!ALIGN_EPI) { if (wr == 0) PG8_BAR; }
    PG8_BAR;
    if constexpr (Epi::AFTER_DRAIN) { E.fused(acc, cur, wr, wc, fr, fq, lds, wid, lane); S.done(cur); }
#undef PG8_SA
#undef PG8_SB
#undef PG8_STAGE
#undef PG8_LD16
#undef PG8_LDA
#undef PG8_LDB
#undef PG8_MMA
#undef PG8_WAIT_V
#undef PG8_WAIT_L
#undef PG8_BAR
#undef PG8_SCHED
}
}
typedef unsigned short bf16;
typedef unsigned v4u __attribute__((ext_vector_type(4)));
typedef unsigned v2u __attribute__((ext_vector_type(2)));
typedef float f32x4 __attribute__((ext_vector_type(4)));
typedef float f32x2 __attribute__((ext_vector_type(2)));
typedef short bf16x8 __attribute__((ext_vector_type(8)));
typedef GAS unsigned gu32;
#define RLX_AGENT __ATOMIC_RELAXED, __HIP_MEMORY_SCOPE_AGENT
#define LDS_WAIT() asm volatile("s_waitcnt lgkmcnt(0)" ::: "memory")
#define VM_WAIT() asm volatile("s_waitcnt vmcnt(0)" ::: "memory")
typedef __bf16 bf16x2_hw __attribute__((ext_vector_type(2)));
__device__ __forceinline__ unsigned pk2(float lo, float hi) { const f32x2 v = {lo, hi}; const bf16x2_hw b = __builtin_convertvector(v, bf16x2_hw); return __builtin_bit_cast(unsigned, b); }
__device__ __forceinline__ unsigned pk4f8(float a, float b, float c, float d) { int w = 0; w = __builtin_amdgcn_cvt_pk_fp8_f32(a, b, w, false); w = __builtin_amdgcn_cvt_pk_fp8_f32(c, d, w, true); return (unsigned)w; }
__device__ __forceinline__ unsigned f2bf(float f) { return pk2(f, 0.f) & 0xffffu; }
__device__ __forceinline__ float bflo(unsigned w) { return __builtin_bit_cast(float, w << 16); }
__device__ __forceinline__ float bfhi(unsigned w) { return __builtin_bit_cast(float, w & 0xffff0000u); }
__device__ __forceinline__ float bf1(bf16 b) { return __builtin_bit_cast(float, ((unsigned)b) << 16); }
__device__ __forceinline__ float fast_exp(float x) { return __builtin_amdgcn_exp2f(x * 1.4426950408889634f); }
__device__ __forceinline__ float fast_rcp(float x) { return __builtin_amdgcn_rcpf(x); }
__device__ __forceinline__ float sigmoidf_(float x) { return fast_rcp(1.0f + fast_exp(-x)); }
__device__ __forceinline__ float siluf_(float x) { return x * sigmoidf_(x); }
template <int CTRL> __device__ __forceinline__ float dppf(float v) { return __builtin_bit_cast(float, __builtin_amdgcn_mov_dpp(__builtin_bit_cast(int, v), CTRL, 0xF, 0xF, true)); }
template <int CTRL> __device__ __forceinline__ int dppi(int v) { return __builtin_amdgcn_mov_dpp(v, CTRL, 0xF, 0xF, true); }
__device__ __forceinline__ float rdl(float v, int l) { return __builtin_bit_cast(float, __builtin_amdgcn_readlane(__builtin_bit_cast(int, v), l)); }
__device__ __forceinline__ float wave_sum(float v) {
    v += dppf<0xB1>(v); v += dppf<0x4E>(v); v += dppf<0x141>(v); v += dppf<0x140>(v);
    return (rdl(v, 0) + rdl(v, 16)) + (rdl(v, 32) + rdl(v, 48));
}
__device__ __forceinline__ float wave_max(float v) {
    v = fmaxf(v, dppf<0xB1>(v)); v = fmaxf(v, dppf<0x4E>(v)); v = fmaxf(v, dppf<0x141>(v)); v = fmaxf(v, dppf<0x140>(v));
    return fmaxf(fmaxf(rdl(v, 0), rdl(v, 16)), fmaxf(rdl(v, 32), rdl(v, 48)));
}
__device__ __forceinline__ int wave_sum_i(int v) {
    v += dppi<0xB1>(v); v += dppi<0x4E>(v); v += dppi<0x141>(v); v += dppi<0x140>(v);
    return (__builtin_amdgcn_readlane(v, 0) + __builtin_amdgcn_readlane(v, 16)) + (__builtin_amdgcn_readlane(v, 32) + __builtin_amdgcn_readlane(v, 48));
}

constexpr int NWAVES = 8, NTHR = 512;
constexpr int SEQ = 16384, DM = 2048, NH = 8, HD = 128, HW = 1024;
constexpr int CK = 64, NCHUNK = SEQ / CK, NSEG = 16, CPS = NCHUNK / NSEG;
constexpr int INW = 13344;
constexpr int N1 = 9216;
constexpr float EPS = 1e-6f;
constexpr int PEER_K = 16;

constexpr size_t MiB = (size_t)1 << 20;
constexpr size_t WS_CTL = 0, CTL_ZERO_BYTES = 1 * MiB;
constexpr size_t WS_WG = 2 * MiB, WS_WPA = 18 * MiB, WS_WPB = 22 * MiB, WS_WOUT = 26 * MiB, WS_WS = 34 * MiB, WS_W1 = 42 * MiB;
constexpr size_t WS_XN = 80 * MiB;
constexpr size_t WS_H = 144 * MiB;
constexpr size_t WS_GAB = 432 * MiB;
constexpr size_t WS_HL = 434 * MiB;
constexpr size_t WS_HDS = 450 * MiB;
constexpr size_t WS_OHF = 452 * MiB, WS_OHB = 484 * MiB;
constexpr size_t WS_GSC = 516 * MiB;
constexpr size_t WS_UTF = 144 * MiB, WS_UTB = 176 * MiB, WS_WF = 208 * MiB, WS_WB = 240 * MiB;
constexpr size_t DO_AQKF = 0, DO_AQKB = 16 * MiB, DO_QN = 32 * MiB, DO_KNT = 64 * MiB;
constexpr size_t WS_GL = 42 * MiB, WS_GP = 58 * MiB;
constexpr size_t WS_OGF = 304 * MiB, WS_OGB = 336 * MiB;
constexpr size_t WS_YA = 42 * MiB, WS_YB = 368 * MiB;
constexpr size_t WS_TU = 144 * MiB, WS_TV = 176 * MiB;
constexpr size_t WS_PSC = 520 * MiB;
constexpr size_t WS_GT = 272 * MiB, WS_GT2 = 400 * MiB;
constexpr size_t WS_X1B = 80 * MiB;
constexpr size_t WS_SC = 272 * MiB;
constexpr size_t WS_END = 536 * MiB;
#ifndef QM_G1_
#define QM_G1_ 2
#endif
#ifndef QM_GATE_
#define QM_GATE_ 2
#endif
#ifndef QM_MIX_
#define QM_MIX_ 2
#endif
#ifndef QM_OUT_
#define QM_OUT_ 0
#endif
constexpr int QM_G1 = QM_G1_, QM_GATE = QM_GATE_, QM_MIX = QM_MIX_, QM_OUT = QM_OUT_;
constexpr int QM_XN = QM_G1 ? QM_G1 : QM_GATE;
static_assert(QM_G1 == 0 || QM_GATE == 0 || QM_G1 == QM_GATE, "xn has one 8-bit copy");
static_assert(QM_OUT != 2, "merged has no row scale");
constexpr float F8_WSCALE = 128.0f;
constexpr size_t WS_WAB = 78 * MiB;
constexpr size_t DO_XN8 = 96 * MiB;
constexpr size_t WS_GT8 = 336 * MiB;
constexpr size_t WS_QW = 521 * MiB;
constexpr int QW_W1 = 0, QW_WG = 9216, QW_WPA = 13312, QW_WPB = 15360, QW_WOUT = 17408;
constexpr size_t WS_QX = 522 * MiB;
constexpr int CW_BAR = 4096;

constexpr int LDS_BYTES = 163840;
constexpr int MISC_OFF = 163840 - 256;
constexpr int LDS_USABLE = MISC_OFF;

__device__ __forceinline__ bf16x8 ldfrag(const LAS bf16* T, int pitch, int row, int k) { return *(const LAS bf16x8*)(T + row * pitch + k); }
__device__ __forceinline__ f32x4 mfma16(bf16x8 x, bf16x8 y, f32x4 c) { return __builtin_amdgcn_mfma_f32_16x16x32_bf16(x, y, c, 0, 0, 0); }
__device__ __forceinline__ v2u pack4(f32x4 v) { v2u r; r.x = pk2(v[0], v[1]); r.y = pk2(v[2], v[3]); return r; }
#define XB_TMO      128
#define XB_XCNT(j)  (256  + 64 * (j))
#define XB_XSUB(j)  (1280 + 64 * (j))
#define XB_XGEN(j)  (2304 + 64 * (j))
#define XB_TOP      3328
#define XB_TOPGEN   3392
#define XCD_BAR_WORDS 3456
#define XB_SPIN_CAP (1u << 18)

__device__ __forceinline__ unsigned xb_ld(unsigned* p)              { return __hip_atomic_load(p, __ATOMIC_RELAXED, __HIP_MEMORY_SCOPE_AGENT); }
__device__ __forceinline__ unsigned xb_add(unsigned* p, unsigned v) { return __hip_atomic_fetch_add(p, v, __ATOMIC_RELAXED, __HIP_MEMORY_SCOPE_AGENT); }
__device__ __forceinline__ unsigned xb_xcc_id() { return (unsigned)__builtin_amdgcn_s_getreg((3 << 11) | 20) & 0xFu; }
#define XB_SPIN(cond, bar) do { unsigned _sp = 0; while (cond) { __builtin_amdgcn_s_sleep(1); \
    if ((++_sp & 255u) == 0u) { if (xb_ld(&(bar)[XB_TMO])) break; if (_sp > XB_SPIN_CAP) { atomicAdd(&(bar)[XB_TMO], 1u); break; } } } } while (0)

struct XcdBarrier {
    unsigned* bar; unsigned x;
    volatile LAS unsigned* st;
};

__device__ __forceinline__ XcdBarrier xcd_barrier_post(unsigned* bar, volatile LAS unsigned* st) {
    XcdBarrier b; b.bar = bar; b.x = xb_xcc_id(); b.st = st;
    if (threadIdx.x == 0) (void)xb_add(&bar[XB_XCNT(b.x)], 1u);
    return b;
}
__device__ __forceinline__ void xcd_barrier_complete(unsigned* bar, unsigned x, unsigned& nloc, unsigned& nx) {
    const unsigned G = gridDim.x * gridDim.y * gridDim.z;
    unsigned sum, cnt, mine, sp = 0u;
    for (;;) {
        sum = 0u; cnt = 0u; mine = 0u;
#pragma unroll
        for (unsigned j = 0; j < 16; ++j) { const unsigned c = xb_ld(&bar[XB_XCNT(j)]); sum += c; cnt += (c > 0u) ? 1u : 0u; mine = (j == x) ? c : mine; }
        if (sum == G) break;
        __builtin_amdgcn_s_sleep(1);
        if ((++sp & 255u) == 0u) { if (xb_ld(&bar[XB_TMO])) break; if (sp > XB_SPIN_CAP) { atomicAdd(&bar[XB_TMO], 1u); break; } }
    }
    nloc = mine > 0u ? mine : 1u; nx = cnt > 0u ? cnt : 1u;
}

__device__ __forceinline__ void xcd_barrier(const XcdBarrier& b) {
    asm volatile("s_waitcnt vmcnt(0)" ::: "memory");
    __syncthreads();
    if (threadIdx.x == 0) {
        unsigned* bar = b.bar;
        __builtin_amdgcn_s_waitcnt(0);
        unsigned nloc = b.st[0], nx = b.st[1];
        if (nloc == 0u) { xcd_barrier_complete(bar, b.x, nloc, nx); b.st[0] = nloc; b.st[1] = nx; }
        const unsigned old = xb_add(&bar[XB_XSUB(b.x)], 1u);
        const unsigned gen = old / nloc;
        if (old + 1u == (gen + 1u) * nloc) {
            __builtin_amdgcn_fence(__ATOMIC_RELEASE, "agent");
            asm volatile("s_waitcnt vmcnt(0)" ::: "memory");
            const unsigned og = xb_add(&bar[XB_TOP], 1u);
            const unsigned tg = og / nx;
            if (og + 1u == (tg + 1u) * nx) xb_add(&bar[XB_TOPGEN], 1u);
            else XB_SPIN(xb_ld(&bar[XB_TOPGEN]) == tg, bar);
            __builtin_amdgcn_fence(__ATOMIC_ACQUIRE, "agent");
            xb_add(&bar[XB_XGEN(b.x)], 1u);
            asm volatile("s_waitcnt vmcnt(0)" ::: "memory");
        } else {
            XB_SPIN(xb_ld(&bar[XB_XGEN(b.x)]) == gen, bar);
            __builtin_amdgcn_fence(__ATOMIC_ACQUIRE, "agent");
            asm volatile("s_waitcnt vmcnt(0)" ::: "memory");
        }
    }
    __syncthreads();
}

struct Frame {
    LAS unsigned char* lds;
    volatile LAS unsigned* MISC;
    gu32* ctl;
    int tid, lane, wave, vcu, G;
    const float* in[19]; float* out; unsigned char* ws;
};
enum { I_X = 0, I_N1W, I_WIN, I_LB, I_HNW, I_CONVW, I_ALOG, I_DTB, I_GNW, I_WPA, I_WPB, I_WOUT, I_N2W, I_WQ, I_K1, I_K2, I_PU, I_PV, I_FNW };

template <bool F8>
__device__ __forceinline__ void p0_transpose_item(const float* W, int ldw, int c0, int K, int ncols, void* WTv, int row_off, LAS float* scr, int item, int lane) {
    const int nblk = ncols / 32, kb = item / nblk, nb = item % nblk, k0 = 64 * kb, n0 = 32 * nb;
#pragma unroll 8
    for (int i = 0; i < 32; ++i) { const int kk = 2 * i + (lane >> 5); scr[kk * 33 + (lane & 31)] = W[(size_t)(k0 + kk) * ldw + c0 + n0 + (lane & 31)]; }
    LDS_WAIT(); asm volatile("" ::: "memory");
    const int c = lane & 7;
#pragma unroll
    for (int j = 0; j < 4; ++j) { const int n = (lane >> 3) + 8 * j; const LAS float* s = scr + (8 * c) * 33 + n;
        if (F8) { v2u o; o.x = pk4f8(s[0 * 33] * F8_WSCALE, s[1 * 33] * F8_WSCALE, s[2 * 33] * F8_WSCALE, s[3 * 33] * F8_WSCALE); o.y = pk4f8(s[4 * 33] * F8_WSCALE, s[5 * 33] * F8_WSCALE, s[6 * 33] * F8_WSCALE, s[7 * 33] * F8_WSCALE);
            *(GAS v2u*)((unsigned char*)WTv + (size_t)(row_off + n0 + n) * K + k0 + 8 * c) = o; }
        else { v4u o; o.x = pk2(s[0 * 33], s[1 * 33]); o.y = pk2(s[2 * 33], s[3 * 33]); o.z = pk2(s[4 * 33], s[5 * 33]); o.w = pk2(s[6 * 33], s[7 * 33]);
            *(GAS v4u*)((bf16*)WTv + (size_t)(row_off + n0 + n) * K + k0 + 8 * c) = o; } }
    LDS_WAIT(); asm volatile("" ::: "memory");
}
__device__ __forceinline__ unsigned pk4i8(f32x4 v, float inv) {
    const int a = (int)rintf(v.x * inv), b = (int)rintf(v.y * inv), c = (int)rintf(v.z * inv), d = (int)rintf(v.w * inv);
    return (unsigned)(a & 255) | ((unsigned)(b & 255) << 8) | ((unsigned)(c & 255) << 16) | ((unsigned)d << 24);
}
__device__ __forceinline__ float amax4(f32x4 v) { const f32x4 a = __builtin_elementwise_abs(v); return fmaxf(fmaxf(a.x, a.y), fmaxf(a.z, a.w)); }
__device__ __forceinline__ void rms_row_to_bf16(int lane, const float* xrow, const float* w, bf16* orow, unsigned char* orow8, float* sx) {
    const GAS f32x4* xr = (const GAS f32x4*)xrow + lane; const GAS f32x4* wr = (const GAS f32x4*)w + lane;
    f32x4 v[8]; float s = 0.f;
#pragma unroll
    for (int j = 0; j < 8; ++j) { v[j] = xr[64 * j]; s += (v[j].x * v[j].x + v[j].y * v[j].y) + (v[j].z * v[j].z + v[j].w * v[j].w); }
    const float r = 1.0f / sqrtf(wave_sum(s) * (1.f / DM) + EPS);
    GAS v2u* o8 = (GAS v2u*)orow + lane; GAS unsigned* q8 = (GAS unsigned*)orow8 + lane; float am = 0.f;
#pragma unroll
    for (int j = 0; j < 8; ++j) { const f32x4 ww = wr[64 * j]; const f32x4 y = {v[j].x * r * ww.x, v[j].y * r * ww.y, v[j].z * r * ww.z, v[j].w * r * ww.w};
        v2u o; o.x = pk2(y.x, y.y); o.y = pk2(y.z, y.w); o8[64 * j] = o;
        if (QM_XN == 1) q8[64 * j] = pk4f8(y.x, y.y, y.z, y.w);
        if (QM_XN == 2) { v[j] = y; am = fmaxf(am, amax4(y)); } }
    if (QM_XN == 2) { am = wave_max(am); const float inv = am > 0.f ? 127.0f / am : 0.f;
#pragma unroll
        for (int j = 0; j < 8; ++j) q8[64 * j] = pk4i8(v[j], inv);
        if (lane == 0) *sx = am > 0.f ? am * (1.0f / 127.0f) : 1.0f; }
}
template <int KT>
__device__ __forceinline__ void p0_quant_item(Frame& F, const float* W, int ldw, int c0, signed char* Wq, float* scl, int n0) {
    constexpr int KW = KT / 8, NB = KW / 64;
    const int col = F.lane & 31, kh = F.lane >> 5;
    const GAS float* src = (const GAS float*)W + (size_t)(F.wave * KW + 32 * kh) * ldw + c0 + n0 + col;
    float v[NB][32]; float mx = 0.f;
#pragma unroll
    for (int b = 0; b < NB; ++b)
#pragma unroll
        for (int i = 0; i < 32; ++i) v[b][i] = src[(size_t)(64 * b + i) * ldw];
#pragma unroll
    for (int b = 0; b < NB; ++b)
#pragma unroll
        for (int i = 0; i < 32; ++i) mx = fmaxf(mx, fabsf(v[b][i]));
    mx = fmaxf(mx, __shfl_xor(mx, 32));
    LAS float* part = (LAS float*)F.lds;
    if (kh == 0) part[F.wave * 32 + col] = mx;
    __syncthreads();
    float cm = part[col];
#pragma unroll
    for (int w = 1; w < 8; ++w) cm = fmaxf(cm, part[w * 32 + col]);
    const float inv = cm > 0.f ? 127.0f / cm : 0.f;
    if (F.wave == 0 && kh == 0) scl[n0 + col] = cm > 0.f ? cm * (1.0f / 127.0f) : 1.0f;
    GAS v4u* dst = (GAS v4u*)(Wq + (size_t)(n0 + col) * KT + F.wave * KW + 32 * kh);
#pragma unroll
    for (int b = 0; b < NB; ++b) { unsigned w[8];
#pragma unroll
        for (int q = 0; q < 8; ++q) w[q] = pk4i8((f32x4){v[b][4 * q], v[b][4 * q + 1], v[b][4 * q + 2], v[b][4 * q + 3]}, inv);
        dst[4 * b] = (v4u){w[0], w[1], w[2], w[3]}; dst[4 * b + 1] = (v4u){w[4], w[5], w[6], w[7]}; }
    __syncthreads();
}
__device__ __forceinline__ void p0_ws_item(Frame& F, int it) {
    const int h = it >> 6, half = (it >> 5) & 1, j0 = (it & 31) * 64, hc = h * 256 + half * 128;
    const float* Wq = F.in[I_WQ]; const float* Ks = half ? F.in[I_K2] : F.in[I_K1]; const float* n2 = F.in[I_N2W];
    LAS bf16* Xs = (LAS bf16*)F.lds; LAS bf16* Ys = Xs + 64 * 136;
    { const int row = F.tid >> 3, c0 = (F.tid & 7) * 16; const GAS f32x4* src = (const GAS f32x4*)(Wq + (size_t)(j0 + row) * DM + hc + c0);
      const f32x4 a = src[0], b = src[1], c = src[2], d = src[3];
      v4u o0, o1; o0.x = pk2(a.x, a.y); o0.y = pk2(a.z, a.w); o0.z = pk2(b.x, b.y); o0.w = pk2(b.z, b.w); o1.x = pk2(c.x, c.y); o1.y = pk2(c.z, c.w); o1.z = pk2(d.x, d.y); o1.w = pk2(d.z, d.w);
      *(LAS v4u*)(Xs + row * 136 + c0) = o0; *(LAS v4u*)(Xs + row * 136 + c0 + 8) = o1; }
    { const int row = F.tid >> 2, c0 = (F.tid & 3) * 32; const GAS f32x4* src = (const GAS f32x4*)(Ks + (size_t)row * 128 + c0);
#pragma unroll
      for (int q = 0; q < 4; ++q) { const f32x4 a = src[2 * q], b = src[2 * q + 1]; v4u o; o.x = pk2(a.x, a.y); o.y = pk2(a.z, a.w); o.z = pk2(b.x, b.y); o.w = pk2(b.z, b.w); *(LAS v4u*)(Ys + row * 136 + c0 + 8 * q) = o; } }
    __syncthreads();
    const int fr = F.lane & 15, fq = F.lane >> 4, w = F.wave;
    bf16* WSt = (bf16*)(F.ws + WS_WS);
#pragma unroll
    for (int jt = 0; jt < 4; ++jt) {
        f32x4 acc = {0.f, 0.f, 0.f, 0.f};
#pragma unroll
        for (int k0 = 0; k0 < 4; ++k0) acc = mfma16(ldfrag(Xs, 136, 16 * jt + fr, 32 * k0 + 8 * fq), ldfrag(Ys, 136, 16 * w + fr, 32 * k0 + 8 * fq), acc);
        const int jj = j0 + 16 * jt + 4 * fq; const f32x4 nw = *(const GAS f32x4*)(n2 + jj);
        *(GAS v2u*)(WSt + (size_t)(hc + 16 * w + fr) * DM + jj) = pack4(acc * nw);
    }
    __syncthreads();
}
__device__ __forceinline__ void p0_prologue(Frame& F) {
    LAS float* scr = (LAS float*)(F.lds + F.wave * 16384);
    const int gw = F.vcu * NWAVES + F.wave, NGW = F.G * NWAVES;
    constexpr int I_1 = QM_G1 == 2 ? 0 : (DM / 64) * (N1 / 32), I_AB = (DM / 64), I_G = QM_GATE == 2 ? 0 : (DM / 64) * (4096 / 32), I_PA = QM_MIX == 2 ? 0 : (HW / 64) * (DM / 32), I_O = QM_OUT == 2 ? 0 : (DM / 64) * (DM / 32);
    constexpr int NITEMS = I_1 + I_AB + I_G + 2 * I_PA + I_O;
    for (int it = gw; it < NITEMS; it += NGW) {
        int r = it;
        if (r < I_1) { p0_transpose_item<QM_G1 == 1>(F.in[I_WIN], INW, 0, DM, N1, F.ws + WS_W1, 0, scr, r, F.lane); continue; } r -= I_1;
        if (r < I_AB) { p0_transpose_item<false>(F.in[I_WIN], INW, N1, DM, 32, F.ws + WS_WAB, 0, scr, r, F.lane); continue; } r -= I_AB;
        if (r < I_G) { p0_transpose_item<QM_GATE == 1>(F.in[I_WIN], INW, 9248, DM, 4096, F.ws + WS_WG, 0, scr, r, F.lane); continue; } r -= I_G;
        if (r < I_PA) { p0_transpose_item<QM_MIX == 1>(F.in[I_WPA], DM, 0, HW, DM, F.ws + WS_WPA, 0, scr, r, F.lane); continue; } r -= I_PA;
        if (r < I_PA) { p0_transpose_item<QM_MIX == 1>(F.in[I_WPB], DM, 0, HW, DM, F.ws + WS_WPB, 0, scr, r, F.lane); continue; } r -= I_PA;
        p0_transpose_item<QM_OUT == 1>(F.in[I_WOUT], DM, 0, DM, DM, F.ws + WS_WOUT, 0, scr, r, F.lane);
    }
    bf16* XN = (bf16*)(F.ws + WS_XN); float* QX = (float*)(F.ws + WS_QX);
    for (int m = gw; m < SEQ; m += NGW) rms_row_to_bf16(F.lane, F.in[I_X] + (size_t)m * DM, F.in[I_N1W], XN + (size_t)m * DM, (unsigned char*)F.out + DO_XN8 + (size_t)m * DM, QX + m);
    __syncthreads();
    { constexpr int J_1 = QM_G1 == 2 ? N1 / 32 : 0, J_G = QM_GATE == 2 ? 4096 / 32 : 0, J_O = QM_OUT == 2 ? DM / 32 : 0, J_P = QM_MIX == 2 ? DM / 32 : 0;
      float* QW = (float*)(F.ws + WS_QW);
      for (int it = F.vcu; it < J_1 + J_G + J_O + 2 * J_P; it += F.G) {
          int r = it;
          if (r < J_1) { p0_quant_item<DM>(F, F.in[I_WIN], INW, 0, (signed char*)(F.ws + WS_W1), QW + QW_W1, 32 * r); continue; } r -= J_1;
          if (r < J_G) { p0_quant_item<DM>(F, F.in[I_WIN], INW, 9248, (signed char*)(F.ws + WS_WG), QW + QW_WG, 32 * r); continue; } r -= J_G;
          if (r < J_O) { p0_quant_item<DM>(F, F.in[I_WOUT], DM, 0, (signed char*)(F.ws + WS_WOUT), QW + QW_WOUT, 32 * r); continue; } r -= J_O;
          if (r < J_P) { p0_quant_item<HW>(F, F.in[I_WPA], DM, 0, (signed char*)(F.ws + WS_WPA), QW + QW_WPA, 32 * r); continue; } r -= J_P;
          p0_quant_item<HW>(F, F.in[I_WPB], DM, 0, (signed char*)(F.ws + WS_WPB), QW + QW_WPB, 32 * r);
      } }
    __syncthreads();
    for (int it = blockIdx.x; it < 512; it += F.G) p0_ws_item(F, it);
}
typedef unsigned u32x4 __attribute__((ext_vector_type(4)));
__device__ __forceinline__ u32x4 pack8(f32x4 a, f32x4 b) { u32x4 w; w.x = pk2(a[0], a[1]); w.y = pk2(a[2], a[3]); w.z = pk2(b[0], b[1]); w.w = pk2(b[2], b[3]); return w; }
__device__ __forceinline__ void unpack8(u32x4 w, f32x4& a, f32x4& b) { a = (f32x4){bflo(w.x), bfhi(w.x), bflo(w.y), bfhi(w.y)}; b = (f32x4){bflo(w.z), bfhi(w.z), bflo(w.w), bfhi(w.w)}; }
__device__ __forceinline__ f32x4 silu4(f32x4 v) { return (f32x4){siluf_(v[0]), siluf_(v[1]), siluf_(v[2]), siluf_(v[3])}; }
__device__ __forceinline__ f32x4 sigm4(f32x4 v) { return (f32x4){sigmoidf_(v[0]), sigmoidf_(v[1]), sigmoidf_(v[2]), sigmoidf_(v[3])}; }

typedef int i32x4 __attribute__((ext_vector_type(4)));
template <int QM> __device__ __forceinline__ f32x4 deq(f32x4 a, float sr, f32x4 sc) {
    if (QM == 2) { const i32x4 q = __builtin_bit_cast(i32x4, a); return (f32x4){(float)q[0], (float)q[1], (float)q[2], (float)q[3]} * (sc * sr); }
    if (QM == 1) return a * (1.0f / F8_WSCALE);
    return a;
}
template <int QM, bool PERM> __device__ __forceinline__ void ld_colscale(f32x4 (&scv)[2][2], const float* sb, int cb) {
#pragma unroll
    for (int bj = 0; bj < 2; ++bj)
#pragma unroll
        for (int n = 0; n < 2; ++n) scv[bj][n] = (QM == 2) ? *(const f32x4*)(sb + cb + bj * 128 + (PERM ? 4 : 16) * n) : (f32x4){1.f, 1.f, 1.f, 1.f};
}
struct EpiG1 {
    static constexpr bool PERM = true, AFTER_DRAIN = false;
    unsigned char* ws; const float* lbl;
    const float* sa; const float* sb;
    __device__ __forceinline__ void operator()(const f32x4 (&acc)[2][2][4][2], const pg8::Unit& u, int wr, int wc, int fr, int fq) const {
        const int pn = u.pn, row0 = u.pm * 256 + wr * 64 + fr;
        {
            const int grp = pn >> 2; const bool act = (grp == 0) | (grp == 4) | (grp == 8);
            bf16* base = (bf16*)(ws + WS_H + (size_t)grp * 32 * MiB); const int col0 = (pn & 3) * 256 + wc * 32 + 8 * fq;
            f32x4 scv[2][2]; ld_colscale<QM_G1, true>(scv, sb, pn * 256 + wc * 32 + 8 * fq);
            const bool fgate = (grp == 1) | (grp == 2); f32x4 lbv[2][2];
            if (fgate) { const float* l0 = lbl + (grp - 1) * 2048 + col0;
#pragma unroll
                for (int bj = 0; bj < 2; ++bj)
#pragma unroll
                    for (int n = 0; n < 2; ++n) { const f32x4 a0 = *(const f32x4*)(l0 + bj * 128 + 4 * n), a1 = *(const f32x4*)(l0 + 1024 + bj * 128 + 4 * n);
                        lbv[bj][n] = (f32x4){fast_rcp(1.0f + fast_exp(a1[0] - a0[0])), fast_rcp(1.0f + fast_exp(a1[1] - a0[1])), fast_rcp(1.0f + fast_exp(a1[2] - a0[2])), fast_rcp(1.0f + fast_exp(a1[3] - a0[3]))}; } }
#pragma unroll
            for (int ai = 0; ai < 2; ++ai)
#pragma unroll
                for (int m = 0; m < 4; ++m) { bf16* rowp = base + (size_t)(row0 + ai * 128 + m * 16) * HW + col0; const float sr = (QM_G1 == 2) ? sa[row0 + ai * 128 + m * 16] : 1.f;
#pragma unroll
                    for (int bj = 0; bj < 2; ++bj) { f32x4 v0 = deq<QM_G1>(acc[ai][bj][m][0], sr, scv[bj][0]), v1 = deq<QM_G1>(acc[ai][bj][m][1], sr, scv[bj][1]);
                        if (act) { v0 = silu4(v0); v1 = silu4(v1); }
                        if (fgate) { v0 = lbv[bj][0] + (1.0f - lbv[bj][0]) * sigm4(v0); v1 = lbv[bj][1] + (1.0f - lbv[bj][1]) * sigm4(v1); }
                        *(u32x4*)(rowp + bj * 128) = pack8(v0, v1); } }
        }
    }
};
struct EpiGate {
    static constexpr bool PERM = true, AFTER_DRAIN = false;
    bf16* O; const float* sa; const float* sb;
    __device__ __forceinline__ void operator()(const f32x4 (&acc)[2][2][4][2], const pg8::Unit& u, int wr, int wc, int fr, int fq) const {
        const int row0 = u.pm * 256 + wr * 64 + fr, col0 = u.pn * 256 + wc * 32 + 8 * fq;
        f32x4 scv[2][2]; ld_colscale<QM_GATE, true>(scv, sb, col0);
#pragma unroll
        for (int ai = 0; ai < 2; ++ai)
#pragma unroll
            for (int m = 0; m < 4; ++m) { bf16* rowp = O + (size_t)(row0 + ai * 128 + m * 16) * DM + col0; const float sr = (QM_GATE == 2) ? sa[row0 + ai * 128 + m * 16] : 1.f;
#pragma unroll
                for (int bj = 0; bj < 2; ++bj) *(u32x4*)(rowp + bj * 128) = pack8(sigm4(deq<QM_GATE>(acc[ai][bj][m][0], sr, scv[bj][0])), sigm4(deq<QM_GATE>(acc[ai][bj][m][1], sr, scv[bj][1]))); }
    }
};
template <int MODE> struct EpiMix {
    static constexpr bool PERM = true, AFTER_DRAIN = false;
    bf16* O; const bf16* G; unsigned char* O8;
    const float* sa; const float* sb;
    __device__ __forceinline__ void operator()(const f32x4 (&acc)[2][2][4][2], const pg8::Unit& u, int wr, int wc, int fr, int fq) const {
        const int row0 = u.pm * 256 + wr * 64 + fr, col0 = u.pn * 256 + wc * 32 + 8 * fq;
        f32x4 scv[2][2]; ld_colscale<QM_MIX, true>(scv, sb, col0);
#pragma unroll
        for (int ai = 0; ai < 2; ++ai)
#pragma unroll
            for (int m = 0; m < 4; ++m) { const size_t off = (size_t)(row0 + ai * 128 + m * 16) * DM + col0; const float sr = (QM_MIX == 2) ? sa[row0 + ai * 128 + m * 16] : 1.f;
#pragma unroll
                for (int bj = 0; bj < 2; ++bj) { f32x4 o0, o1; unpack8(*(const u32x4*)(O + off + bj * 128), o0, o1);
                    const f32x4 c0 = deq<QM_MIX>(acc[ai][bj][m][0], sr, scv[bj][0]), c1 = deq<QM_MIX>(acc[ai][bj][m][1], sr, scv[bj][1]);
                    if (MODE == 0) { o0 = o0 * c0; o1 = o1 * c1; }
                    else { f32x4 g0, g1; unpack8(*(const u32x4*)(G + off + bj * 128), g0, g1); o0 = o0 + g0 * c0; o1 = o1 + g1 * c1; }
                    if (MODE == 1 && QM_OUT == 1) { v2u w; w.x = pk4f8(o0[0], o0[1], o0[2], o0[3]); w.y = pk4f8(o1[0], o1[1], o1[2], o1[3]); *(v2u*)(O8 + off + bj * 128) = w; }
                    else *(u32x4*)(O + off + bj * 128) = pack8(o0, o1); } }
    }
};
struct EpiX1 {
    static constexpr bool PERM = false, AFTER_DRAIN = false;
    const float* x; float* out; bf16* xb;
    __device__ __forceinline__ void operator()(const f32x4 (&acc)[2][2][4][2], const pg8::Unit& u, int wr, int wc, int fr, int fq) const {
        const int row0 = u.pm * 256 + wr * 64 + fr, col0 = u.pn * 256 + wc * 32 + 4 * fq;
#pragma unroll
        for (int ai = 0; ai < 2; ++ai)
#pragma unroll
            for (int m = 0; m < 4; ++m) { const size_t off = (size_t)(row0 + ai * 128 + m * 16) * DM + col0;
#pragma unroll
                for (int bj = 0; bj < 2; ++bj)
#pragma unroll
                    for (int n = 0; n < 2; ++n) { const size_t o = off + bj * 128 + n * 16; const f32x4 v = *(const f32x4*)(x + o) + deq<QM_OUT>(acc[ai][bj][m][n], 1.f, (f32x4){1.f, 1.f, 1.f, 1.f});
                        *(f32x4*)(out + o) = v; *(v2u*)(xb + o) = pack4(v); } }
    }
};
struct EpiBf {
    static constexpr bool PERM = true, AFTER_DRAIN = false;
    bf16* O;
    __device__ __forceinline__ void operator()(const f32x4 (&acc)[2][2][4][2], const pg8::Unit& u, int wr, int wc, int fr, int fq) const {
        const int row0 = u.pm * 256 + wr * 64 + fr, col0 = u.pn * 256 + wc * 32 + 8 * fq;
#pragma unroll
        for (int ai = 0; ai < 2; ++ai)
#pragma unroll
            for (int m = 0; m < 4; ++m) { bf16* rowp = O + (size_t)(row0 + ai * 128 + m * 16) * DM + col0;
#pragma unroll
                for (int bj = 0; bj < 2; ++bj) *(u32x4*)(rowp + bj * 128) = pack8(acc[ai][bj][m][0], acc[ai][bj][m][1]); }
    }
};
struct EpiF32 {
    static constexpr bool PERM = false, AFTER_DRAIN = false;
    float* C;
    __device__ __forceinline__ void operator()(const f32x4 (&acc)[2][2][4][2], const pg8::Unit& u, int wr, int wc, int fr, int fq) const {
        const int row0 = u.pm * 256 + wr * 64 + fr, col0 = u.pn * 256 + wc * 32 + 4 * fq;
#pragma unroll
        for (int ai = 0; ai < 2; ++ai)
#pragma unroll
            for (int m = 0; m < 4; ++m) { float* rowp = C + (size_t)(row0 + ai * 128 + m * 16) * DM + col0;
#pragma unroll
                for (int bj = 0; bj < 2; ++bj)
#pragma unroll
                    for (int n = 0; n < 2; ++n) *(f32x4*)(rowp + bj * 128 + n * 16) = acc[ai][bj][m][n]; }
    }
};

__device__ __forceinline__ void p1_ab(Frame& F) {
    const bf16* XN = (const bf16*)(F.ws + WS_XN); const bf16* Wab = (const bf16*)(F.ws + WS_WAB); float* Gab = (float*)(F.ws + WS_GAB);
    const int fr = F.lane & 15, fq = F.lane >> 4, rt = F.wave >> 1, ct = F.wave & 1;
    for (int blk = F.vcu; blk < SEQ / 64; blk += F.G) {
        const bf16* ap = XN + (size_t)(blk * 64 + rt * 16 + fr) * DM + 8 * fq; const bf16* bp = Wab + (size_t)(ct * 16 + fr) * DM + 8 * fq;
        f32x4 acc = {0.f, 0.f, 0.f, 0.f};
#pragma unroll 1
        for (int kb = 0; kb < DM; kb += 512) { bf16x8 af[16], bfr[16];
#pragma unroll
            for (int u = 0; u < 16; ++u) { af[u] = *(const GAS bf16x8*)(ap + kb + 32 * u); bfr[u] = *(const GAS bf16x8*)(bp + kb + 32 * u); }
            __builtin_amdgcn_sched_barrier(0);
#pragma unroll
            for (int u = 0; u < 16; ++u) acc = mfma16(bfr[u], af[u], acc);
            __builtin_amdgcn_sched_barrier(0); }
        *(GAS f32x4*)(Gab + (size_t)(blk * 64 + rt * 16 + fr) * 32 + ct * 16 + 4 * fq) = acc;
    }
}
template <bool PASS3, int SKIP = 0>
__device__ __forceinline__ void hgrn_pass(Frame& F) {
    LAS bf16*  ST  = (LAS bf16*)(F.lds + 0);
    LAS float* LF  = (LAS float*)(F.lds + 0);
    LAS bf16*  QT  = (LAS bf16*)(F.lds + 34816);
    LAS bf16*  KT  = (LAS bf16*)(F.lds + 52224);
    LAS bf16*  KHT = (LAS bf16*)(F.lds + 69632);
    LAS bf16*  VT  = (LAS bf16*)(F.lds + 88064);
    LAS bf16*  ATT = (LAS bf16*)(F.lds + 106496);
    LAS float* PT  = (LAS float*)(F.lds + 115712);
    LAS float* BL  = (LAS float*)(F.lds + 117760);
    LAS float* DKK = (LAS float*)(F.lds + 118272);
    LAS float* LBV = (LAS float*)(F.lds + 118784);
    LAS bf16*  VR  = (LAS bf16*)(F.lds + 119296);
    const int tid = F.tid, lane = F.lane, w = F.wave, fr = lane & 15, fq = lane >> 4;
    const int row = tid >> 3, c0 = (tid & 7) * 16;
    float* HL = (float*)(F.ws + WS_HL); float* HDS = (float*)(F.ws + WS_HDS);
    for (int it = blockIdx.x; it < 256; it += F.G) {
        const int hd = it >> 4, sg = it & 15, dir = hd >> 3, h = hd & 7;
        const bf16* Hq = (const bf16*)(F.ws + WS_H); const bf16* Hf = (const bf16*)(F.ws + WS_H + (size_t)(1 + dir) * 32 * MiB); const bf16* Hi = (const bf16*)(F.ws + WS_H + (size_t)3 * 32 * MiB);
        bf16* Oh = (bf16*)(F.ws + (dir ? WS_OHB : WS_OHF));
        __syncthreads();
        f32x4 Sacc[8];
#pragma unroll
        for (int kt = 0; kt < 8; ++kt) Sacc[kt] = (f32x4){0.f, 0.f, 0.f, 0.f};
        if (PASS3) {
            for (int p = 0; p < sg; ++p) { const int ip = hd * 16 + p; f32x4 dsv[8], lv[8];
#pragma unroll
                for (int kt = 0; kt < 8; ++kt) { dsv[kt] = *(const GAS f32x4*)(HDS + ip * 128 + 16 * kt + 4 * fq); lv[kt] = *(const GAS f32x4*)(HL + ((size_t)((ip * 8 + w) * 8 + kt) * 64 + lane) * 4); }
                __builtin_amdgcn_sched_barrier(0);
#pragma unroll
                for (int kt = 0; kt < 8; ++kt) Sacc[kt] = Sacc[kt] * dsv[kt] + lv[kt];
                __builtin_amdgcn_sched_barrier(0); }
        }
        float sumbl = 1.f;
        v4u rq[2], rf[2], rv[2];
        { const int oc = dir ? 255 - sg * 16 : sg * 16; const size_t off = (size_t)(64 * oc + row) * HW + h * 128 + c0;
          rq[0] = *(const GAS v4u*)(Hq + off); rq[1] = *(const GAS v4u*)(Hq + off + 8); rf[0] = *(const GAS v4u*)(Hf + off); rf[1] = *(const GAS v4u*)(Hf + off + 8); rv[0] = *(const GAS v4u*)(Hi + off); rv[1] = *(const GAS v4u*)(Hi + off + 8); }
        __syncthreads();
        for (int ci = 0; ci < ((SKIP & 4) ? 1 : CPS); ++ci) {
            const int sc = sg * 16 + ci, oc = dir ? 255 - sc : sc, tok0 = 64 * oc;
            float kk[16], qq[16];
            { const unsigned fw[8] = {rf[0].x, rf[0].y, rf[0].z, rf[0].w, rf[1].x, rf[1].y, rf[1].z, rf[1].w};
              const unsigned qw[8] = {rq[0].x, rq[0].y, rq[0].z, rq[0].w, rq[1].x, rq[1].y, rq[1].z, rq[1].w};
              float fgv[16];
#pragma unroll
              for (int e = 0; e < 16; ++e) { fgv[e] = (e & 1) ? bfhi(fw[e >> 1]) : bflo(fw[e >> 1]); qq[e] = (e & 1) ? bfhi(qw[e >> 1]) : bflo(qw[e >> 1]); kk[e] = 1.0f - fgv[e]; }
#pragma unroll
              for (int q4 = 0; q4 < 4; ++q4) *(LAS f32x4*)(LF + row * 132 + c0 + 4 * q4) = (f32x4){fgv[4 * q4], fgv[4 * q4 + 1], fgv[4 * q4 + 2], fgv[4 * q4 + 3]};
              *(LAS v4u*)(VR + row * 136 + c0) = rv[0]; *(LAS v4u*)(VR + row * 136 + c0 + 8) = rv[1]; }
            if (ci + 1 < CPS && !(SKIP & 2)) { const int oc2 = dir ? oc - 1 : oc + 1; const size_t off = (size_t)(64 * oc2 + row) * HW + h * 128 + c0;
              rq[0] = *(const GAS v4u*)(Hq + off); rq[1] = *(const GAS v4u*)(Hq + off + 8); rf[0] = *(const GAS v4u*)(Hf + off); rf[1] = *(const GAS v4u*)(Hf + off + 8); rv[0] = *(const GAS v4u*)(Hi + off); rv[1] = *(const GAS v4u*)(Hi + off + 8); }
            if (!(SKIP & 8)) __syncthreads();
            { const int c = tid & 127, part = tid >> 7, r0 = part * 16; float b[16], fv[16]; float run = 1.f;
#pragma unroll
              for (int i = 0; i < 16; ++i) fv[i] = LF[(r0 + i) * 132 + c];
              if (!dir) {
#pragma unroll
                  for (int i = 0; i < 16; ++i) { run *= fv[i]; b[i] = run; }
              } else {
#pragma unroll
                  for (int i = 15; i >= 0; --i) { run *= fv[i]; b[i] = run; }
              }
              PT[part * 128 + c] = run;
              unsigned short vcol[16];
#pragma unroll
              for (int i = 0; i < 16; ++i) vcol[i] = VR[(r0 + i) * 136 + c];
              if (!(SKIP & 8)) __syncthreads();
              const float p0 = PT[c], p1 = PT[128 + c], p2 = PT[256 + c], p3 = PT[384 + c];
              float offs;
              if (!dir) offs = (part > 0 ? p0 : 1.f) * (part > 1 ? p1 : 1.f) * (part > 2 ? p2 : 1.f);
              else      offs = (part < 3 ? p3 : 1.f) * (part < 2 ? p2 : 1.f) * (part < 1 ? p1 : 1.f);
              const float tot = (p0 * p1) * (p2 * p3);
              unsigned kh[8], vw[8];
#pragma unroll
              for (int i = 0; i < 8; ++i) { const float P0 = b[2 * i] * offs, P1 = b[2 * i + 1] * offs;
                  if (PASS3) { LF[(r0 + 2 * i) * 132 + c] = P0; LF[(r0 + 2 * i + 1) * 132 + c] = P1; }
                  kh[i] = pk2((1.0f - fv[2 * i]) * tot * fast_rcp(P0), (1.0f - fv[2 * i + 1]) * tot * fast_rcp(P1)); vw[i] = (unsigned)vcol[2 * i] | ((unsigned)vcol[2 * i + 1] << 16); }
              *(LAS v4u*)(KHT + c * 72 + r0) = (v4u){kh[0], kh[1], kh[2], kh[3]}; *(LAS v4u*)(KHT + c * 72 + r0 + 8) = (v4u){kh[4], kh[5], kh[6], kh[7]};
              *(LAS v4u*)(VT + c * 72 + r0) = (v4u){vw[0], vw[1], vw[2], vw[3]}; *(LAS v4u*)(VT + c * 72 + r0 + 8) = (v4u){vw[4], vw[5], vw[6], vw[7]};
              if (part == 0) { DKK[c] = tot; sumbl *= tot; }
            }
            if (!(SKIP & 8)) __syncthreads();
            if (PASS3 && !(SKIP & 1)) { float bb[16];
#pragma unroll
              for (int q4 = 0; q4 < 4; ++q4) { const f32x4 t4 = *(const LAS f32x4*)(LF + row * 132 + c0 + 4 * q4); bb[4 * q4] = t4[0]; bb[4 * q4 + 1] = t4[1]; bb[4 * q4 + 2] = t4[2]; bb[4 * q4 + 3] = t4[3]; }
              unsigned qo[8], ko[8];
#pragma unroll
              for (int e = 0; e < 8; ++e) { qo[e] = pk2(qq[2 * e] * bb[2 * e], qq[2 * e + 1] * bb[2 * e + 1]); ko[e] = pk2(kk[2 * e] * fast_rcp(bb[2 * e]), kk[2 * e + 1] * fast_rcp(bb[2 * e + 1])); }
              *(LAS v4u*)(QT + row * 136 + c0) = (v4u){qo[0], qo[1], qo[2], qo[3]}; *(LAS v4u*)(QT + row * 136 + c0 + 8) = (v4u){qo[4], qo[5], qo[6], qo[7]};
              *(LAS v4u*)(KT + row * 136 + c0) = (v4u){ko[0], ko[1], ko[2], ko[3]}; *(LAS v4u*)(KT + row * 136 + c0 + 8) = (v4u){ko[4], ko[5], ko[6], ko[7]};
            }
            if (PASS3) if (!(SKIP & 8)) __syncthreads();
            if (PASS3 && !(SKIP & 1)) {
                { bf16x8 kf[2][4], qf[2][4]; f32x4 acc[2];
#pragma unroll
                  for (int q2 = 0; q2 < 2; ++q2) { const int tl = 2 * w + q2, ti = tl >> 2, tj = tl & 3; acc[q2] = (f32x4){0.f, 0.f, 0.f, 0.f};
#pragma unroll
                      for (int k0 = 0; k0 < 4; ++k0) { kf[q2][k0] = ldfrag(KT, 136, 16 * ti + fr, 32 * k0 + 8 * fq); qf[q2][k0] = ldfrag(QT, 136, 16 * tj + fr, 32 * k0 + 8 * fq); } }
                  __builtin_amdgcn_sched_barrier(0);
#pragma unroll
                  for (int k0 = 0; k0 < 4; ++k0)
#pragma unroll
                      for (int q2 = 0; q2 < 2; ++q2) acc[q2] = mfma16(kf[q2][k0], qf[q2][k0], acc[q2]);
                  __builtin_amdgcn_sched_barrier(0);
#pragma unroll
                  for (int q2 = 0; q2 < 2; ++q2) { const int tl = 2 * w + q2, ti = tl >> 2, tj = tl & 3; const int t = 16 * tj + fr, s0 = 16 * ti + 4 * fq;
#pragma unroll
                      for (int r = 0; r < 4; ++r) { const bool keep = dir ? (s0 + r >= t) : (s0 + r <= t); acc[q2][r] = keep ? acc[q2][r] : 0.f; }
                      *(LAS v2u*)(ATT + t * 72 + s0) = pack4(acc[q2]); } }
#pragma unroll
                for (int kt = 0; kt < 8; ++kt) *(LAS v2u*)(ST + (16 * w + fr) * 136 + 16 * kt + 4 * fq) = pack4(Sacc[kt]);
                if (!(SKIP & 8)) __syncthreads();
            }
            bf16x8 xv[2];
#pragma unroll
            for (int s0 = 0; s0 < 2; ++s0) xv[s0] = ldfrag(VT, 72, 16 * w + fr, 32 * s0 + 8 * fq);
            if (PASS3 && !(SKIP & 1)) {
                bf16x8 xs[4];
#pragma unroll
                for (int k0 = 0; k0 < 4; ++k0) xs[k0] = ldfrag(ST, 136, 16 * w + fr, 32 * k0 + 8 * fq);
#pragma unroll
                for (int th = 0; th < 2; ++th) { bf16x8 qf[2][4], af[2][2]; f32x4 acc[2];
#pragma unroll
                    for (int tq = 0; tq < 2; ++tq) { const int tt = 2 * th + tq; acc[tq] = (f32x4){0.f, 0.f, 0.f, 0.f};
#pragma unroll
                        for (int k0 = 0; k0 < 4; ++k0) qf[tq][k0] = ldfrag(QT, 136, 16 * tt + fr, 32 * k0 + 8 * fq);
#pragma unroll
                        for (int s0 = 0; s0 < 2; ++s0) af[tq][s0] = ldfrag(ATT, 72, 16 * tt + fr, 32 * s0 + 8 * fq); }
                    __builtin_amdgcn_sched_barrier(0);
#pragma unroll
                    for (int k0 = 0; k0 < 4; ++k0)
#pragma unroll
                        for (int tq = 0; tq < 2; ++tq) acc[tq] = mfma16(xs[k0], qf[tq][k0], acc[tq]);
#pragma unroll
                    for (int s0 = 0; s0 < 2; ++s0)
#pragma unroll
                        for (int tq = 0; tq < 2; ++tq) acc[tq] = mfma16(xv[s0], af[tq][s0], acc[tq]);
                    __builtin_amdgcn_sched_barrier(0);
#pragma unroll
                    for (int tq = 0; tq < 2; ++tq) *(GAS v2u*)(Oh + (size_t)(tok0 + 16 * (2 * th + tq) + fr) * HW + h * 128 + 16 * w + 4 * fq) = pack4(acc[tq]); }
            }
#pragma unroll
            for (int kh = 0; kh < ((SKIP & 1) ? 0 : 2); ++kh) { bf16x8 kf[4][2];
#pragma unroll
                for (int kq = 0; kq < 4; ++kq) { const int kt = 4 * kh + kq; const f32x4 d4 = *(const LAS f32x4*)(DKK + 16 * kt + 4 * fq); Sacc[kt] = Sacc[kt] * d4;
#pragma unroll
                    for (int s0 = 0; s0 < 2; ++s0) kf[kq][s0] = ldfrag(KHT, 72, 16 * kt + fr, 32 * s0 + 8 * fq); }
                __builtin_amdgcn_sched_barrier(0);
#pragma unroll
                for (int s0 = 0; s0 < 2; ++s0)
#pragma unroll
                    for (int kq = 0; kq < 4; ++kq) Sacc[4 * kh + kq] = mfma16(kf[kq][s0], xv[s0], Sacc[4 * kh + kq]);
                __builtin_amdgcn_sched_barrier(0); }
            if (!(SKIP & 8)) __syncthreads();
        }
        if (!PASS3) {
#pragma unroll
            for (int kt = 0; kt < 8; ++kt) *(GAS f32x4*)(HL + ((size_t)((it * 8 + w) * 8 + kt) * 64 + lane) * 4) = Sacc[kt];
            if (tid < 128) HDS[it * 128 + tid] = sumbl;
        }
    }
}
template <int SKIP>
__device__ __forceinline__ void gdn_prep(Frame& F) {
    LAS bf16*  QN  = (LAS bf16*)(F.lds + 0);
    LAS bf16*  KN  = (LAS bf16*)(F.lds + 17408);
    LAS bf16*  VT  = (LAS bf16*)(F.lds + 34816);
    LAS bf16*  KNT = (LAS bf16*)(F.lds + 53248);
    LAS float* AM  = (LAS float*)(F.lds + 71680);
    LAS bf16*  TB  = (LAS bf16*)(F.lds + 104448);
    LAS bf16*  VR  = (LAS bf16*)(F.lds + 104448);
    LAS float* CWL = (LAS float*)(F.lds + 142848);
    LAS float* DEC = (LAS float*)(F.lds + 141312);
    LAS float* BET = DEC + 128;
    LAS float* EXD = DEC + 256;
    const int tid = F.tid, lane = F.lane, w = F.wave, fr = lane & 15, fq = lane >> 4;
    const int row = tid >> 3, c0 = (tid & 7) * 16;
    const bf16* Gq = (const bf16*)(F.ws + WS_H + (size_t)5 * 32 * MiB); const bf16* Gk = (const bf16*)(F.ws + WS_H + (size_t)6 * 32 * MiB); const bf16* Gv = (const bf16*)(F.ws + WS_H + (size_t)7 * 32 * MiB);
    const float* Gab = (const float*)(F.ws + WS_GAB); const float* cw = F.in[I_CONVW];
    unsigned char* dob = (unsigned char*)F.out;
    bf16* QNg = (bf16*)(dob + DO_QN); bf16* KNTg = (bf16*)(dob + DO_KNT); float* GSC = (float*)(F.ws + WS_GSC);
    int hload = -1;
    for (int it = blockIdx.x; it < 2048; it += F.G) {
        const int h = it & 7, oc = it >> 3, tok0 = 64 * oc;
        __syncthreads();
        if (h != hload) { hload = h;
            for (int i = tid; i < 5 * 384; i += NTHR) { const int j = i / 384, r = i % 384; CWL[i] = cw[j * 3072 + (r >> 7) * 1024 + h * 128 + (r & 127)]; }
            __syncthreads(); }
        if (it + F.G < 2048 && tid < 408) { const int it2 = it + F.G, h2 = it2 & 7, oc2 = it2 >> 3; const int tz = tid / 136, rl = tid % 136, r = rl >> 1, half = rl & 1; const int tr = 64 * oc2 - 2 + r;
            if (tr >= 0 && tr < SEQ) { const bf16* src = (tz == 0 ? Gq : tz == 1 ? Gk : Gv) + (size_t)tr * HW + h2 * 128 + half * 64; unsigned tmp = *(const GAS unsigned*)src; asm volatile("" :: "v"(tmp)); } }
        if (tid < 128) { const int dir = tid >> 6, l = tid & 63, pos = dir ? 63 - l : l;
            const float a = Gab[(size_t)(tok0 + pos) * 32 + dir * 8 + h], b = Gab[(size_t)(tok0 + pos) * 32 + 16 + dir * 8 + h];
            const float x = a + F.in[I_DTB][dir * 8 + h]; const float sp = x > 20.f ? x : log1pf(__expf(x));
            float d = -__expf(F.in[I_ALOG][dir * 8 + h]) * sp;
#pragma unroll
            for (int o = 1; o < 64; o <<= 1) { const float t = __shfl_up(d, o); if (l >= o) d += t; }
            DEC[dir * 64 + pos] = d; BET[dir * 64 + pos] = sigmoidf_(b); EXD[dir * 64 + pos] = __expf(d); }
        if (!(SKIP & 64)) { float q[16], k[16], v[16];
#pragma unroll
          for (int e = 0; e < 16; ++e) { q[e] = 0.f; k[e] = 0.f; v[e] = 0.f; }
          const int ch = h * 128 + c0;
#pragma unroll
          for (int j = 0; j < ((SKIP & 1) ? 0 : 5); ++j) { const int tr = tok0 + row + j - 2;
              if (tr >= 0 && tr < SEQ) { const size_t off = (size_t)tr * HW + ch;
                  const v4u xq0 = *(const GAS v4u*)(Gq + off), xq1 = *(const GAS v4u*)(Gq + off + 8), xk0 = *(const GAS v4u*)(Gk + off), xk1 = *(const GAS v4u*)(Gk + off + 8), xv0 = *(const GAS v4u*)(Gv + off), xv1 = *(const GAS v4u*)(Gv + off + 8);
                  const unsigned wq[8] = {xq0.x, xq0.y, xq0.z, xq0.w, xq1.x, xq1.y, xq1.z, xq1.w}, wk[8] = {xk0.x, xk0.y, xk0.z, xk0.w, xk1.x, xk1.y, xk1.z, xk1.w}, wv[8] = {xv0.x, xv0.y, xv0.z, xv0.w, xv1.x, xv1.y, xv1.z, xv1.w};
                  const LAS float* cq = CWL + j * 384 + c0;
#pragma unroll
                  for (int e = 0; e < 16; ++e) { const float fq_ = (e & 1) ? bfhi(wq[e >> 1]) : bflo(wq[e >> 1]), fk_ = (e & 1) ? bfhi(wk[e >> 1]) : bflo(wk[e >> 1]), fv_ = (e & 1) ? bfhi(wv[e >> 1]) : bflo(wv[e >> 1]);
                      q[e] += cq[e] * fq_; k[e] += cq[128 + e] * fk_; v[e] += cq[256 + e] * fv_; } } }
          float sq = 0.f, sk = 0.f;
#pragma unroll
          for (int e = 0; e < 16; ++e) { q[e] = siluf_(q[e]); k[e] = siluf_(k[e]); v[e] = siluf_(v[e]); sq += q[e] * q[e]; sk += k[e] * k[e]; }
          sq += __shfl_xor(sq, 1); sq += __shfl_xor(sq, 2); sq += __shfl_xor(sq, 4); sk += __shfl_xor(sk, 1); sk += __shfl_xor(sk, 2); sk += __shfl_xor(sk, 4);
          const float rq = 0.08838834764831845f / sqrtf(sq + EPS), rk = 1.0f / sqrtf(sk + EPS);
          unsigned qo[8], ko[8];
#pragma unroll
          for (int e = 0; e < 8; ++e) { qo[e] = pk2(q[2 * e] * rq, q[2 * e + 1] * rq); ko[e] = pk2(k[2 * e] * rk, k[2 * e + 1] * rk); }
          const v4u q0 = {qo[0], qo[1], qo[2], qo[3]}, q1 = {qo[4], qo[5], qo[6], qo[7]}, k0_ = {ko[0], ko[1], ko[2], ko[3]}, k1_ = {ko[4], ko[5], ko[6], ko[7]};
          *(LAS v4u*)(QN + row * 136 + c0) = q0; *(LAS v4u*)(QN + row * 136 + c0 + 8) = q1; *(LAS v4u*)(KN + row * 136 + c0) = k0_; *(LAS v4u*)(KN + row * 136 + c0 + 8) = k1_;
          if (!(SKIP & 16)) { *(GAS v4u*)(QNg + (size_t)(tok0 + row) * HW + ch) = q0; *(GAS v4u*)(QNg + (size_t)(tok0 + row) * HW + ch + 8) = q1; }
          unsigned vo[8];
#pragma unroll
          for (int e = 0; e < 8; ++e) vo[e] = pk2(v[2 * e], v[2 * e + 1]);
          *(LAS v4u*)(VR + row * 136 + c0) = (v4u){vo[0], vo[1], vo[2], vo[3]}; *(LAS v4u*)(VR + row * 136 + c0 + 8) = (v4u){vo[4], vo[5], vo[6], vo[7]};
        }
        __syncthreads();
        { const int c = tid & 127, r0 = (tid >> 7) * 16; unsigned vw[8], kw[8];
#pragma unroll
          for (int i = 0; i < 8; ++i) { vw[i] = (unsigned)VR[(r0 + 2 * i) * 136 + c] | ((unsigned)VR[(r0 + 2 * i + 1) * 136 + c] << 16); kw[i] = (unsigned)KN[(r0 + 2 * i) * 136 + c] | ((unsigned)KN[(r0 + 2 * i + 1) * 136 + c] << 16); }
          *(LAS v4u*)(VT + c * 72 + r0) = (v4u){vw[0], vw[1], vw[2], vw[3]}; *(LAS v4u*)(VT + c * 72 + r0 + 8) = (v4u){vw[4], vw[5], vw[6], vw[7]};
          *(LAS v4u*)(KNT + c * 72 + r0) = (v4u){kw[0], kw[1], kw[2], kw[3]}; *(LAS v4u*)(KNT + c * 72 + r0 + 8) = (v4u){kw[4], kw[5], kw[6], kw[7]}; }
#pragma unroll
        for (int q2 = 0; q2 < ((SKIP & 8) ? 0 : 2); ++q2) { const int tl = 2 * w + q2, ti = tl >> 2, tj = tl & 3; f32x4 kkv = {0.f, 0.f, 0.f, 0.f}, qkv = {0.f, 0.f, 0.f, 0.f};
#pragma unroll
            for (int k0 = 0; k0 < 4; ++k0) { const bf16x8 xs = ldfrag(KN, 136, 16 * ti + fr, 32 * k0 + 8 * fq);
                kkv = mfma16(xs, ldfrag(KN, 136, 16 * tj + fr, 32 * k0 + 8 * fq), kkv); qkv = mfma16(xs, ldfrag(QN, 136, 16 * tj + fr, 32 * k0 + 8 * fq), qkv); }
            const int t = 16 * tj + fr, s0 = 16 * ti + 4 * fq;
#pragma unroll
            for (int dir = 0; dir < 2; ++dir) { const float dt = DEC[dir * 64 + t], bt = BET[dir * 64 + t]; f32x4 aq;
#pragma unroll
                for (int r = 0; r < 4; ++r) { const int s = s0 + r; const bool before = dir ? (s > t) : (s < t), beq = before || (s == t);
                    const float e = beq ? __expf(dt - DEC[dir * 64 + s]) : 0.f;
                    AM[dir * 4096 + (dir ? (63 - s) * 64 + (63 - t) : s * 64 + t)] = before ? bt * kkv[r] * e : 0.f;   aq[r] = qkv[r] * e; }
                bf16* AQg = (bf16*)(dob + (dir ? DO_AQKB : DO_AQKF));
                if (!(SKIP & 16)) *(GAS v2u*)(AQg + ((size_t)(h * 256 + oc) * 64 + t) * 64 + s0) = pack4(aq); } }
        __syncthreads();
        if (SKIP & 32) {} else if (w < 2) { const int dir = w; int c = lane; asm volatile("" : "+v"(c)); const LAS float* A = AM + dir * 4096;
            float t[64];
#pragma unroll
            for (int bi = 0; bi < 4; ++bi) { float r[16];
#pragma unroll
                for (int ii = 0; ii < 16; ++ii) r[ii] = (16 * bi + ii == c) ? 1.f : 0.f;
                if (!(SKIP & 2)) {
#pragma unroll
                for (int j0 = 0; j0 < 16 * bi; j0 += 4) { f32x4 av[4][4];
#pragma unroll
                    for (int jq = 0; jq < 4; ++jq)
#pragma unroll
                        for (int q4 = 0; q4 < 4; ++q4) av[jq][q4] = *(const LAS f32x4*)(A + (j0 + jq) * 64 + 16 * bi + 4 * q4);
                    __builtin_amdgcn_sched_barrier(0);
#pragma unroll
                    for (int jq = 0; jq < 4; ++jq)
#pragma unroll
                        for (int q4 = 0; q4 < 4; ++q4) { r[4 * q4] -= av[jq][q4][0] * t[j0 + jq]; r[4 * q4 + 1] -= av[jq][q4][1] * t[j0 + jq]; r[4 * q4 + 2] -= av[jq][q4][2] * t[j0 + jq]; r[4 * q4 + 3] -= av[jq][q4][3] * t[j0 + jq]; }
                    __builtin_amdgcn_sched_barrier(0); }
#pragma unroll
                for (int jg = 0; jg < 4; ++jg) { f32x4 av[4][4];
#pragma unroll
                    for (int jq = 0; jq < 4; ++jq)
#pragma unroll
                        for (int q4 = jg; q4 < 4; ++q4) av[jq][q4] = *(const LAS f32x4*)(A + (16 * bi + 4 * jg + jq) * 64 + 16 * bi + 4 * q4);
                    __builtin_amdgcn_sched_barrier(0);
#pragma unroll
                    for (int jq = 0; jq < 4; ++jq) { const int jj = 4 * jg + jq; t[16 * bi + jj] = r[jj];
#pragma unroll
                        for (int q4 = jg; q4 < 4; ++q4)
#pragma unroll
                            for (int e = 0; e < 4; ++e) if (4 * q4 + e > jj) r[4 * q4 + e] -= av[jq][q4][e] * r[jj]; }
                    __builtin_amdgcn_sched_barrier(0); }
                } else {
#pragma unroll
                for (int jj = 0; jj < 16; ++jj) t[16 * bi + jj] = r[jj]; }
            }
            const int tc = dir ? 63 - c : c; const float bc = BET[dir * 64 + tc], bd = bc * EXD[dir * 64 + tc];
            LAS bf16* T0 = TB + (dir * 2 + 0) * 64 * 72 + tc + (dir ? 63 * 72 : 0); const int tstep = dir ? -72 : 72;
#pragma unroll
            for (int i = 0; i < 64; ++i) { T0[i * tstep] = (bf16)f2bf(t[i] * bc); T0[64 * 72 + i * tstep] = (bf16)f2bf(t[i] * bd); }
        } else {
            for (int idx = tid - 128; idx < ((SKIP & 16) ? 0 : 1024); idx += 384) { const int r = idx >> 3, c8 = idx & 7; *(GAS v4u*)(KNTg + ((size_t)(h * 256 + oc) * 128 + r) * 64 + c8 * 8) = *(const LAS v4u*)(KNT + r * 72 + c8 * 8); }
            if (tid >= 128 && tid < 256) { const int dir = (tid - 128) >> 6, t = tid & 63; const float dl = dir ? DEC[64] : DEC[63];
                float* g = GSC + (size_t)((dir * 8 + h) * 256 + oc) * 192; g[t] = EXD[dir * 64 + t]; g[64 + t] = __expf(dl - DEC[dir * 64 + t]); if (t == 0) g[128] = __expf(dl); }
        }
        __syncthreads();
#pragma unroll 1
        for (int n = 0; n < ((SKIP & 4) ? 0 : 16); ++n) { const int qi = w * 16 + n, dir = qi >> 6, kind = (qi >> 5) & 1, idx = qi & 31; f32x4 acc = {0.f, 0.f, 0.f, 0.f};
            const LAS bf16* Tm = TB + (dir * 2 + kind) * 64 * 72; const size_t cb = (size_t)(h * 256 + oc) * 8192;
            if (kind == 0) { const int ti = idx >> 3, vj = idx & 7;
#pragma unroll
                for (int s0 = 0; s0 < 2; ++s0) acc = mfma16(ldfrag(Tm, 72, 16 * ti + fr, 32 * s0 + 8 * fq), ldfrag(VT, 72, 16 * vj + fr, 32 * s0 + 8 * fq), acc);
                bf16* U = (bf16*)(F.ws + (dir ? WS_UTB : WS_UTF)); if (!(SKIP & 16)) *(GAS v2u*)(U + cb + (16 * vj + fr) * 64 + 16 * ti + 4 * fq) = pack4(acc);
            } else { const int ki = idx >> 2, tj = idx & 3;
#pragma unroll
                for (int s0 = 0; s0 < 2; ++s0) acc = mfma16(ldfrag(KNT, 72, 16 * ki + fr, 32 * s0 + 8 * fq), ldfrag(Tm, 72, 16 * tj + fr, 32 * s0 + 8 * fq), acc);
                bf16* W = (bf16*)(F.ws + (dir ? WS_WB : WS_WF)); if (!(SKIP & 16)) *(GAS v2u*)(W + cb + (16 * tj + fr) * 128 + 16 * ki + 4 * fq) = pack4(acc); }
        }
    }
}
__device__ __forceinline__ void gdn_load_tiles(const unsigned char* ws, const unsigned char* dob, int tid, int dir, int hd, int h, int oc, bool pass3, v4u (&rw)[2], v4u (&rq)[2], v4u (&ru)[2], v4u (&rk)[2], v4u& ra, float& rs) {
    const size_t cb = (size_t)(h * 256 + oc);
    const int row = tid >> 3, c0 = (tid & 7) * 16, vrow = tid >> 2, t0 = (tid & 3) * 16;
    const bf16* W = (const bf16*)(ws + (dir ? WS_WB : WS_WF)) + cb * 8192 + row * 128 + c0; rw[0] = *(const GAS v4u*)W; rw[1] = *(const GAS v4u*)(W + 8);
    const bf16* U = (const bf16*)(ws + (dir ? WS_UTB : WS_UTF)) + cb * 8192 + vrow * 64 + t0; ru[0] = *(const GAS v4u*)U; ru[1] = *(const GAS v4u*)(U + 8);
    const bf16* Kt = (const bf16*)(dob + DO_KNT) + (size_t)(h * 256 + oc) * 8192 + vrow * 64 + t0; rk[0] = *(const GAS v4u*)Kt; rk[1] = *(const GAS v4u*)(Kt + 8);
    if (pass3) {
        const bf16* Q = (const bf16*)(dob + DO_QN) + (size_t)(64 * oc + row) * HW + h * 128 + c0; rq[0] = *(const GAS v4u*)Q; rq[1] = *(const GAS v4u*)(Q + 8);
        const bf16* A = (const bf16*)(dob + (dir ? DO_AQKB : DO_AQKF)) + cb * 4096 + row * 64 + (tid & 7) * 8; ra = *(const GAS v4u*)A;
    }
    rs = (tid < 192) ? ((const float*)(ws + WS_GSC))[(size_t)(hd * 256 + oc) * 192 + tid] : 0.f;
}
#define SCHED_FENCE() __builtin_amdgcn_sched_barrier(0)
template <bool PASS3, bool UREAL>
__device__ __forceinline__ void gdn_tile(f32x4 (&A)[8], const LAS bf16* WTL, const LAS bf16* QNL, const LAS bf16* UTL, const LAS bf16* KTL, const LAS bf16* AQL, const LAS float* SCL,
                                         LAS bf16* ST, LAS bf16* VN, LAS bf16* VNS, int w, int fr, int fq, float gl, bf16* Ogc) {
#pragma unroll
    for (int kt = 0; kt < 8; ++kt) *(LAS v2u*)(ST + fr * 136 + 16 * kt + 4 * fq) = pack4(A[kt]);
    asm volatile("" ::: "memory");
    bf16x8 xs[4];
#pragma unroll
    for (int k0 = 0; k0 < 4; ++k0) xs[k0] = ldfrag(ST, 136, fr, 32 * k0 + 8 * fq);
#pragma unroll
    for (int th = 0; th < 2; ++th) { bf16x8 wf[2][4]; f32x4 acc[2]; v2u uw[2]; f32x4 es[2];
#pragma unroll
      for (int tq = 0; tq < 2; ++tq) { const int tt = 2 * th + tq;
#pragma unroll
          for (int k0 = 0; k0 < 4; ++k0) wf[tq][k0] = ldfrag(WTL, 136, 16 * tt + fr, 32 * k0 + 8 * fq);
          if (UREAL) uw[tq] = *(const LAS v2u*)(UTL + (16 * w + fr) * 72 + 16 * tt + 4 * fq);
          es[tq] = *(const LAS f32x4*)(SCL + 64 + 16 * tt + 4 * fq); acc[tq] = (f32x4){0.f, 0.f, 0.f, 0.f}; }
      SCHED_FENCE();
#pragma unroll
      for (int k0 = 0; k0 < 4; ++k0)
#pragma unroll
          for (int tq = 0; tq < 2; ++tq) acc[tq] = mfma16(wf[tq][k0], xs[k0], acc[tq]);
      SCHED_FENCE();
#pragma unroll
      for (int tq = 0; tq < 2; ++tq) { const int tt = 2 * th + tq; f32x4 u4 = {0.f, 0.f, 0.f, 0.f};
          if (UREAL) u4 = (f32x4){bflo(uw[tq].x), bfhi(uw[tq].x), bflo(uw[tq].y), bfhi(uw[tq].y)};
          const f32x4 vn = u4 - acc[tq];
          if (PASS3) *(LAS v2u*)(VN + fr * 72 + 16 * tt + 4 * fq) = pack4(vn);
          *(LAS v2u*)(VNS + fr * 72 + 16 * tt + 4 * fq) = pack4(vn * es[tq]); }
      SCHED_FENCE(); }
    asm volatile("" ::: "memory");
    if (PASS3) { bf16x8 yv[2];
#pragma unroll
        for (int s0 = 0; s0 < 2; ++s0) yv[s0] = ldfrag(VN, 72, fr, 32 * s0 + 8 * fq);
#pragma unroll
        for (int th = 0; th < 2; ++th) { bf16x8 qf[2][4], af[2][2]; f32x4 acc[2]; float ed[2];
#pragma unroll
            for (int tq = 0; tq < 2; ++tq) { const int tt = 2 * th + tq;
#pragma unroll
                for (int k0 = 0; k0 < 4; ++k0) qf[tq][k0] = ldfrag(QNL, 136, 16 * tt + fr, 32 * k0 + 8 * fq);
#pragma unroll
                for (int s0 = 0; s0 < 2; ++s0) af[tq][s0] = ldfrag(AQL, 72, 16 * tt + fr, 32 * s0 + 8 * fq);
                ed[tq] = SCL[16 * tt + fr]; acc[tq] = (f32x4){0.f, 0.f, 0.f, 0.f}; }
            SCHED_FENCE();
#pragma unroll
            for (int k0 = 0; k0 < 4; ++k0)
#pragma unroll
                for (int tq = 0; tq < 2; ++tq) acc[tq] = mfma16(xs[k0], qf[tq][k0], acc[tq]);
#pragma unroll
            for (int tq = 0; tq < 2; ++tq) acc[tq] = acc[tq] * ed[tq];
#pragma unroll
            for (int s0 = 0; s0 < 2; ++s0)
#pragma unroll
                for (int tq = 0; tq < 2; ++tq) acc[tq] = mfma16(yv[s0], af[tq][s0], acc[tq]);
            SCHED_FENCE();
#pragma unroll
            for (int tq = 0; tq < 2; ++tq) *(GAS v2u*)(Ogc + (size_t)(16 * (2 * th + tq) + fr) * HW + 16 * w + 4 * fq) = pack4(acc[tq]);
            SCHED_FENCE(); } }
    { bf16x8 ys[2];
#pragma unroll
      for (int s0 = 0; s0 < 2; ++s0) ys[s0] = ldfrag(VNS, 72, fr, 32 * s0 + 8 * fq);
#pragma unroll
      for (int kh = 0; kh < 2; ++kh) { bf16x8 kf[4][2];
#pragma unroll
          for (int kq = 0; kq < 4; ++kq)
#pragma unroll
              for (int s0 = 0; s0 < 2; ++s0) kf[kq][s0] = ldfrag(KTL, 72, 16 * (4 * kh + kq) + fr, 32 * s0 + 8 * fq);
#pragma unroll
          for (int kq = 0; kq < 4; ++kq) A[4 * kh + kq] = A[4 * kh + kq] * gl;
          SCHED_FENCE();
#pragma unroll
          for (int s0 = 0; s0 < 2; ++s0)
#pragma unroll
              for (int kq = 0; kq < 4; ++kq) A[4 * kh + kq] = mfma16(kf[kq][s0], ys[s0], A[4 * kh + kq]);
          SCHED_FENCE(); } }
}
template <bool PASS3, int SKIP = 0>
__device__ __forceinline__ void gdn_pass(Frame& F) {
    LAS bf16*  WTL = (LAS bf16*)(F.lds + 0);
    LAS bf16*  QNL = (LAS bf16*)(F.lds + 17408);
    LAS bf16*  UTL = (LAS bf16*)(F.lds + 34816);
    LAS bf16*  KTL = (LAS bf16*)(F.lds + 53248);
    LAS bf16*  AQL = (LAS bf16*)(F.lds + 71680);
    LAS float* SCL = (LAS float*)(F.lds + 80896);
    LAS bf16*  PX  = (LAS bf16*)(F.lds + 0);
    const int tid = F.tid, lane = F.lane, w = F.wave, fr = lane & 15, fq = lane >> 4;
    LAS bf16* ST  = (LAS bf16*)(F.lds + 81920 + w * 8960);
    LAS bf16* VN  = ST + 16 * 136;
    LAS bf16* VNS = VN + 16 * 72;
    const int row = tid >> 3, c0 = (tid & 7) * 16, vrow = tid >> 2, t0 = (tid & 3) * 16;
    const unsigned char* dob = (const unsigned char*)F.out;
    float* GL = (float*)(F.ws + WS_GL); bf16* GP = (bf16*)(F.ws + WS_GP);
    for (int it = blockIdx.x; it < 256; it += F.G) {
        const int hd = it >> 4, sg = it & 15, dir = hd >> 3, h = hd & 7;
        bf16* Og = (bf16*)(F.ws + (dir ? WS_OGB : WS_OGF));
        f32x4 Sacc[8], Pacc[8];
        int dgi = 16 * w + fr - 4 * fq; asm volatile("" : "+v"(dgi));
#pragma unroll
        for (int kt = 0; kt < 8; ++kt) { Sacc[kt] = (f32x4){0.f, 0.f, 0.f, 0.f};
#pragma unroll
            for (int r = 0; r < 4; ++r) Pacc[kt][r] = (!PASS3 && (16 * kt + r == dgi)) ? 1.f : 0.f; }
        __syncthreads();
        if (PASS3) {
            for (int p = 0; p < sg; ++p) { const int ip = hd * 16 + p;
                { const bf16* src = GP + (size_t)ip * 16384 + vrow * 128 + (tid & 3) * 32;
#pragma unroll
                  for (int q = 0; q < 4; ++q) *(LAS v4u*)(PX + vrow * 136 + (tid & 3) * 32 + 8 * q) = *(const GAS v4u*)(src + 8 * q); }
#pragma unroll
                for (int kt = 0; kt < 8; ++kt) *(LAS v2u*)(ST + fr * 136 + 16 * kt + 4 * fq) = pack4(Sacc[kt]);
                __syncthreads();
                bf16x8 xs[4];
#pragma unroll
                for (int k0 = 0; k0 < 4; ++k0) xs[k0] = ldfrag(ST, 136, fr, 32 * k0 + 8 * fq);
#pragma unroll
                for (int kh = 0; kh < 2; ++kh) { bf16x8 pf[4][4]; f32x4 acc[4];
#pragma unroll
                    for (int kq = 0; kq < 4; ++kq) { const int kt = 4 * kh + kq; acc[kq] = *(const GAS f32x4*)(GL + ((size_t)((ip * 8 + w) * 8 + kt) * 64 + lane) * 4);
#pragma unroll
                        for (int k0 = 0; k0 < 4; ++k0) pf[kq][k0] = ldfrag(PX, 136, 16 * kt + fr, 32 * k0 + 8 * fq); }
                    SCHED_FENCE();
#pragma unroll
                    for (int k0 = 0; k0 < 4; ++k0)
#pragma unroll
                        for (int kq = 0; kq < 4; ++kq) acc[kq] = mfma16(pf[kq][k0], xs[k0], acc[kq]);
                    SCHED_FENCE();
#pragma unroll
                    for (int kq = 0; kq < 4; ++kq) Sacc[4 * kh + kq] = acc[kq]; }
                __syncthreads();
            }
        }
        v4u rw[2], rq[2], ru[2], rk[2], ra; float rs;
        gdn_load_tiles(F.ws, dob, tid, dir, hd, h, dir ? 255 - sg * 16 : sg * 16, PASS3, rw, rq, ru, rk, ra, rs);
        for (int ci = 0; ci < CPS; ++ci) {
            const int sc = sg * 16 + ci, oc = dir ? 255 - sc : sc, tok0 = 64 * oc;
            *(LAS v4u*)(WTL + row * 136 + c0) = rw[0]; *(LAS v4u*)(WTL + row * 136 + c0 + 8) = rw[1];
            *(LAS v4u*)(UTL + vrow * 72 + t0) = ru[0]; *(LAS v4u*)(UTL + vrow * 72 + t0 + 8) = ru[1];
            *(LAS v4u*)(KTL + vrow * 72 + t0) = rk[0]; *(LAS v4u*)(KTL + vrow * 72 + t0 + 8) = rk[1];
            if (PASS3) { *(LAS v4u*)(QNL + row * 136 + c0) = rq[0]; *(LAS v4u*)(QNL + row * 136 + c0 + 8) = rq[1]; *(LAS v4u*)(AQL + row * 72 + (tid & 7) * 8) = ra; }
            if (tid < 192) SCL[tid] = rs;
            __syncthreads();
            if (ci + 1 < CPS && !(SKIP & 1)) gdn_load_tiles(F.ws, dob, tid, dir, hd, h, dir ? oc - 1 : oc + 1, PASS3, rw, rq, ru, rk, ra, rs);
            const float gl = SCL[128];
            gdn_tile<PASS3, true>(Sacc, WTL, QNL, UTL, KTL, AQL, SCL, ST, VN, VNS, w, fr, fq, gl, Og + (size_t)tok0 * HW + h * 128);
            if (!PASS3) gdn_tile<PASS3, false>(Pacc, WTL, QNL, UTL, KTL, AQL, SCL, ST, VN, VNS, w, fr, fq, gl, Og);
            __syncthreads();
        }
        if (!PASS3) {
            int pofs = (4 * fq) * 128 + 16 * w + fr; asm volatile("" : "+v"(pofs));
            bf16* gp = GP + (size_t)it * 16384 + pofs;
#pragma unroll
            for (int kt = 0; kt < 8; ++kt) { *(GAS f32x4*)(GL + ((size_t)((it * 8 + w) * 8 + kt) * 64 + lane) * 4) = Sacc[kt];
#pragma unroll
                for (int r = 0; r < 4; ++r) gp[(16 * kt + r) * 128] = (bf16)f2bf(Pacc[kt][r]); }
        }
    }
}
__device__ __forceinline__ void p7_mix(Frame& F) {
    const int gw = F.vcu * NWAVES + F.wave, NGW = F.G * NWAVES, lane = F.lane;
    const int e0 = (lane & 7) * 16, col = (lane >> 3) * 128 + e0;
    for (int m = gw; m < SEQ; m += NGW) {
#pragma unroll
        for (int mx = 0; mx < 2; ++mx) {
            const bf16* of = (const bf16*)(F.ws + (mx ? WS_OGF : WS_OHF)); const bf16* ob = (const bf16*)(F.ws + (mx ? WS_OGB : WS_OHB));
            const bf16* gt = (const bf16*)(F.ws + WS_H + (size_t)(mx ? 8 : 4) * 32 * MiB); const float* nw = F.in[mx ? I_GNW : I_HNW];
            bf16* yo = (bf16*)(F.ws + (mx ? WS_YB : WS_YA));
            const size_t off = (size_t)m * HW + col;
            const v4u a0 = *(const GAS v4u*)(of + off), a1 = *(const GAS v4u*)(of + off + 8), b0 = *(const GAS v4u*)(ob + off), b1 = *(const GAS v4u*)(ob + off + 8), g0 = *(const GAS v4u*)(gt + off), g1 = *(const GAS v4u*)(gt + off + 8);
            const unsigned aw[8] = {a0.x, a0.y, a0.z, a0.w, a1.x, a1.y, a1.z, a1.w}, bw[8] = {b0.x, b0.y, b0.z, b0.w, b1.x, b1.y, b1.z, b1.w}, gw_[8] = {g0.x, g0.y, g0.z, g0.w, g1.x, g1.y, g1.z, g1.w};
            float o[16]; float ss = 0.f;
#pragma unroll
            for (int e = 0; e < 8; ++e) { o[2 * e] = bflo(aw[e]) + bflo(bw[e]); o[2 * e + 1] = bfhi(aw[e]) + bfhi(bw[e]); ss += o[2 * e] * o[2 * e] + o[2 * e + 1] * o[2 * e + 1]; }
            ss += __shfl_xor(ss, 1); ss += __shfl_xor(ss, 2); ss += __shfl_xor(ss, 4);
            const float r = 1.0f / sqrtf(ss * (1.f / 128.f) + EPS);
            if (QM_MIX == 2) { float yv[16]; float am = 0.f;
#pragma unroll
                for (int e = 0; e < 8; ++e) { yv[2 * e] = o[2 * e] * r * nw[e0 + 2 * e] * bflo(gw_[e]); yv[2 * e + 1] = o[2 * e + 1] * r * nw[e0 + 2 * e + 1] * bfhi(gw_[e]); am = fmaxf(am, fmaxf(fabsf(yv[2 * e]), fabsf(yv[2 * e + 1]))); }
                am = wave_max(am); const float inv = am > 0.f ? 127.0f / am : 0.f;
                *(GAS v4u*)((unsigned char*)yo + off) = (v4u){pk4i8((f32x4){yv[0], yv[1], yv[2], yv[3]}, inv), pk4i8((f32x4){yv[4], yv[5], yv[6], yv[7]}, inv), pk4i8((f32x4){yv[8], yv[9], yv[10], yv[11]}, inv), pk4i8((f32x4){yv[12], yv[13], yv[14], yv[15]}, inv)};
                if (lane == 0) ((float*)(F.ws + WS_QX))[(1 + mx) * SEQ + m] = am > 0.f ? am * (1.0f / 127.0f) : 1.0f; }
            else if (QM_MIX == 1) { unsigned yq[4];
#pragma unroll
                for (int e = 0; e < 4; ++e) yq[e] = pk4f8(o[4 * e] * r * nw[e0 + 4 * e] * bflo(gw_[2 * e]), o[4 * e + 1] * r * nw[e0 + 4 * e + 1] * bfhi(gw_[2 * e]), o[4 * e + 2] * r * nw[e0 + 4 * e + 2] * bflo(gw_[2 * e + 1]), o[4 * e + 3] * r * nw[e0 + 4 * e + 3] * bfhi(gw_[2 * e + 1]));
                *(GAS v4u*)((unsigned char*)yo + off) = (v4u){yq[0], yq[1], yq[2], yq[3]}; }
            else { unsigned yw[8];
#pragma unroll
            for (int e = 0; e < 8; ++e) yw[e] = pk2(o[2 * e] * r * nw[e0 + 2 * e] * bflo(gw_[e]), o[2 * e + 1] * r * nw[e0 + 2 * e + 1] * bfhi(gw_[e]));
            *(GAS v4u*)(yo + off) = (v4u){yw[0], yw[1], yw[2], yw[3]}; *(GAS v4u*)(yo + off + 8) = (v4u){yw[4], yw[5], yw[6], yw[7]}; }
        }
    }
    for (int tb = 0; tb < 2; ++tb) { const float* src = F.in[tb ? I_PV : I_PU]; unsigned char* dst = F.ws + (tb ? WS_TV : WS_TU); float* scl = (float*)(F.ws + WS_PSC) + tb * 16384;
        for (int r = gw; r < 16384; r += NGW) { const float* row = src + (size_t)r * DM; f32x4 v[8]; float mx = 0.f;
#pragma unroll
            for (int q = 0; q < 8; ++q) { v[q] = *(const GAS f32x4*)(row + (tb ? (q >> 2) * 1024 + lane * 16 + 4 * (q & 3) : lane * 32 + 4 * q)); const f32x4 a = __builtin_elementwise_abs(v[q]); mx = fmaxf(mx, fmaxf(fmaxf(a.x, a.y), fmaxf(a.z, a.w))); }
            mx = wave_max(mx);
            const float sc = mx > 0.f ? mx * (1.0f / 127.0f) : 1.0f, inv = 1.0f / sc; const int bias = tb ? 128 : 0;
            unsigned w[8];
#pragma unroll
            for (int q = 0; q < 8; ++q) { const f32x4 x = v[q]; const int a = (int)rintf(x.x * inv) + bias, b = (int)rintf(x.y * inv) + bias, c = (int)rintf(x.z * inv) + bias, d = (int)rintf(x.w * inv) + bias;
                w[q] = (unsigned)(a & 255) | ((unsigned)(b & 255) << 8) | ((unsigned)(c & 255) << 16) | ((unsigned)(d & 255) << 24); }
            if (tb) { *(GAS v4u*)(dst + (size_t)r * DM + lane * 16) = (v4u){w[0], w[1], w[2], w[3]}; *(GAS v4u*)(dst + (size_t)r * DM + 1024 + lane * 16) = (v4u){w[4], w[5], w[6], w[7]}; }
            else { GAS v4u* o = (GAS v4u*)(dst + ((size_t)lane * 16384 + r) * 32); o[0] = (v4u){w[0], w[1], w[2], w[3]}; o[1] = (v4u){w[4], w[5], w[6], w[7]}; }
            if (lane == 0) scl[r] = sc; } }
}
constexpr size_t WS_XQ = 80 * MiB;
constexpr size_t WS_SXR = 112 * MiB;
constexpr size_t WS_EID = 113 * MiB, WS_GATE = 121 * MiB, WS_AV = 129 * MiB;
constexpr size_t WS_REC = 208 * MiB;
constexpr int NET = 32, ETSZ = 512, NBUCK = 16 * NET, REC_CAP = 16384, CW_CNT = 8192, CW_Q = 8192 + 16 * NBUCK;
__device__ __forceinline__ unsigned fkey(float f) { const unsigned u = __builtin_bit_cast(unsigned, f); return (u & 0x80000000u) ? ~u : (u | 0x80000000u); }
__device__ __forceinline__ float gelu_erf(float x) { return 0.5f * x * (1.0f + erff(x * 0.70710678118654752f)); }
__device__ __forceinline__ float cvt_ub0(unsigned w) { float f; asm("v_cvt_f32_ubyte0 %0, %1" : "=v"(f) : "v"(w)); return f; }
__device__ __forceinline__ float cvt_ub1(unsigned w) { float f; asm("v_cvt_f32_ubyte1 %0, %1" : "=v"(f) : "v"(w)); return f; }
__device__ __forceinline__ float cvt_ub2(unsigned w) { float f; asm("v_cvt_f32_ubyte2 %0, %1" : "=v"(f) : "v"(w)); return f; }
__device__ __forceinline__ float cvt_ub3(unsigned w) { float f; asm("v_cvt_f32_ubyte3 %0, %1" : "=v"(f) : "v"(w)); return f; }

__device__ __forceinline__ float key_val(unsigned k, unsigned mask) { unsigned u = k & ~mask; u = (u & 0x80000000u) ? (u & 0x7fffffffu) : ~u; return __builtin_bit_cast(float, u); }
template <int SKIP>
__device__ __forceinline__ void p11a_topk(Frame& F) {
    LAS float* SCR = (LAS float*)(F.lds + F.wave * 16384);
    LAS unsigned* SL = (LAS unsigned*)SCR;
    LAS int* EIDS = (LAS int*)(SCR + 1024);
    LAS int* OFFS = (LAS int*)(SCR + 2048);
    LAS float* RTS = SCR + 2304;
    LAS int* BC = (LAS int*)(F.lds + 8 * 16384);
    const bf16* SC = (const bf16*)(F.ws + WS_SC);
    unsigned char* XQ = F.ws + WS_XQ; float* SXR = (float*)(F.ws + WS_SXR); int* EIDg = (int*)(F.ws + WS_EID); float* GATEg = (float*)(F.ws + WS_GATE); unsigned* REC = (unsigned*)(F.ws + WS_REC);
    for (int blk = F.vcu; blk < SEQ / 64; blk += F.G) {
        __syncthreads();
        if (F.tid < NET) BC[F.tid] = 0;
        __syncthreads();
        const int m0 = blk * 64 + F.wave * 8;
#pragma unroll 2
        for (int ti = 0; ti < 8; ++ti) { const int m = m0 + ti;
            int lane = F.lane; asm volatile("" : "+v"(lane));
            float xh[32]; float ss = 0.f;
            const float* x1 = F.out + (size_t)m * DM + lane * 32; const float* n2 = F.in[I_N2W] + lane * 32;
            f32x4 nwv[8];
#pragma unroll
            for (int q = 0; q < 8; ++q) { const f32x4 a = *(const GAS f32x4*)(x1 + 4 * q); nwv[q] = *(const GAS f32x4*)(n2 + 4 * q); xh[4 * q] = a.x; xh[4 * q + 1] = a.y; xh[4 * q + 2] = a.z; xh[4 * q + 3] = a.w; }
#pragma unroll
            for (int e = 0; e < 32; ++e) ss += xh[e] * xh[e];
            const float rt = 1.0f / sqrtf(wave_sum(ss) * (1.f / DM) + EPS);
            float amx = 0.f;
#pragma unroll
            for (int q = 0; q < 8; ++q) { const f32x4 a = nwv[q]; xh[4 * q] *= rt * a.x; xh[4 * q + 1] *= rt * a.y; xh[4 * q + 2] *= rt * a.z; xh[4 * q + 3] *= rt * a.w; }
#pragma unroll
            for (int e = 0; e < 32; ++e) amx = fmaxf(amx, fabsf(xh[e]));
            amx = wave_max(amx);
            const float sx = amx > 0.f ? amx * (1.0f / 127.0f) : 1.0f, isx = 1.0f / sx;
            unsigned xq[8];
#pragma unroll
            for (int d = 0; d < 8; ++d) { const int a = (int)rintf(xh[4 * d] * isx), b = (int)rintf(xh[4 * d + 1] * isx), c = (int)rintf(xh[4 * d + 2] * isx), e = (int)rintf(xh[4 * d + 3] * isx);
                xq[d] = (unsigned)(a & 255) | ((unsigned)(b & 255) << 8) | ((unsigned)(c & 255) << 16) | ((unsigned)(e & 255) << 24); }
            if (!(SKIP & 2)) { GAS v4u* o = (GAS v4u*)(XQ + ((size_t)lane * SEQ + m) * 32); o[0] = (v4u){xq[0], xq[1], xq[2], xq[3]}; o[1] = (v4u){xq[4], xq[5], xq[6], xq[7]}; }
            if (lane == 0) { SXR[2 * m] = sx; SXR[2 * m + 1] = rt; RTS[ti] = rt; }
        }
#pragma unroll 1
        for (int grp = 0; grp < 2; ++grp) {
            int lane = F.lane; asm volatile("" : "+v"(lane));
            if (!(SKIP & 1)) {
                { const bf16* src = SC + (size_t)(m0 + grp * 4 + (lane >> 4)) * DM + (lane & 15) * 128;
                  unsigned v[16];
#pragma unroll
                  for (int i = 0; i < 16; ++i) v[i] = 0u;
#pragma unroll 1
                  for (int s8 = 0; s8 < 2; ++s8) { v4u a8[8];
#pragma unroll
                      for (int u = 0; u < 8; ++u) a8[u] = *(const GAS v4u*)(src + 64 * s8 + 8 * u);
#pragma unroll
                      for (int u = 0; u < 8; ++u) { const unsigned wv[4] = {a8[u].x, a8[u].y, a8[u].z, a8[u].w};
#pragma unroll
                          for (int e = 0; e < 8; ++e) { const float sv = (e & 1) ? bfhi(wv[e >> 1]) : bflo(wv[e >> 1]); unsigned x = (fkey(sv) & ~127u) | (unsigned)(64 * s8 + 8 * u + e);
#pragma unroll
                              for (int i = 0; i < 16; ++i) { const unsigned hi = v[i] > x ? v[i] : x; x = v[i] > x ? x : v[i]; v[i] = hi; } } } }
#pragma unroll
                  for (int q = 0; q < 4; ++q) *(LAS v4u*)(SL + lane * 16 + 4 * q) = (v4u){v[4 * q], v[4 * q + 1], v[4 * q + 2], v[4 * q + 3]}; }
                asm volatile("" ::: "memory");
                if (lane < 32) { const int tk = lane >> 3, h = lane & 7, m = m0 + grp * 4 + tk;
                    const LAS unsigned* L1 = SL + (tk * 16 + 2 * h) * 16; const LAS unsigned* L2 = L1 + 16;
                    float f1[16], f2[16];
#pragma unroll
                    for (int q = 0; q < 4; ++q) { const v4u a = *(const LAS v4u*)(L1 + 4 * q), b = *(const LAS v4u*)(L2 + 4 * q);
                        f1[4 * q] = key_val(a.x, 127u); f1[4 * q + 1] = key_val(a.y, 127u); f1[4 * q + 2] = key_val(a.z, 127u); f1[4 * q + 3] = key_val(a.w, 127u);
                        f2[4 * q] = key_val(b.x, 127u); f2[4 * q + 1] = key_val(b.y, 127u); f2[4 * q + 2] = key_val(b.z, 127u); f2[4 * q + 3] = key_val(b.w, 127u); }
                    unsigned c[16];
#pragma unroll
                    for (int i = 0; i < 16; ++i) c[i] = 0u;
#pragma unroll
                    for (int i = 0; i < 16; ++i)
#pragma unroll
                        for (int j = 0; j < 16; ++j) if ((i + 1) * (j + 1) <= 16) { unsigned x = (fkey(f1[i] + f2[j]) & ~255u) | (unsigned)(i * 16 + j);
#pragma unroll
                            for (int r = 0; r < 16; ++r) { const unsigned hi = c[r] > x ? c[r] : x; x = c[r] > x ? x : c[r]; c[r] = hi; } }
                    const float rt = RTS[grp * 4 + tk];
                    float sc[16]; int ee[16]; float mx = -3.0e38f;
#pragma unroll
                    for (int r = 0; r < 16; ++r) { const unsigned ij = c[r] & 255u; const unsigned k1 = L1[ij >> 4], k2 = L2[ij & 15u];
                        sc[r] = key_val(k1, 127u) + key_val(k2, 127u); ee[r] = (int)((k1 & 127u) * 128u + (k2 & 127u)); mx = fmaxf(mx, sc[r]); }
                    float sum = 0.f;
#pragma unroll
                    for (int r = 0; r < 16; ++r) { sc[r] = __expf(rt * (sc[r] - mx)); sum += sc[r]; }
                    const float inv = 1.0f / sum;
#pragma unroll
                    for (int q = 0; q < 4; ++q) { *(LAS v4u*)(EIDS + (grp * 4 + tk) * 128 + h * 16 + 4 * q) = (v4u){(unsigned)ee[4 * q], (unsigned)ee[4 * q + 1], (unsigned)ee[4 * q + 2], (unsigned)ee[4 * q + 3]};
                        if (!(SKIP & 4)) { *(GAS v4u*)(EIDg + (size_t)m * 128 + h * 16 + 4 * q) = (v4u){(unsigned)ee[4 * q], (unsigned)ee[4 * q + 1], (unsigned)ee[4 * q + 2], (unsigned)ee[4 * q + 3]};
                            *(GAS f32x4*)(GATEg + (size_t)m * 128 + h * 16 + 4 * q) = (f32x4){sc[4 * q] * inv, sc[4 * q + 1] * inv, sc[4 * q + 2] * inv, sc[4 * q + 3] * inv}; } }
                }
                asm volatile("" ::: "memory");
            }
        }
#pragma unroll 1
        for (int ti = 0; ti < 8; ++ti) {
            int lane = F.lane; asm volatile("" : "+v"(lane));
            const int tA = (EIDS[ti * 128 + lane] >> 9) & 31, tB = (EIDS[ti * 128 + 64 + lane] >> 9) & 31; int mycnt = 0;
#pragma unroll
            for (int k = 0; k < NET; ++k) { const int c = __popcll(__ballot(tA == k)) + __popcll(__ballot(tB == k)); mycnt = (lane == k) ? c : mycnt; }
            if (lane < NET) OFFS[ti * NET + lane] = __hip_atomic_fetch_add((int*)(BC + lane), mycnt, __ATOMIC_RELAXED, __HIP_MEMORY_SCOPE_WORKGROUP);
        }
        __syncthreads();
        const int tt = blk >> 4;
        if (F.tid < NET) BC[NET + F.tid] = (int)__hip_atomic_fetch_add((unsigned*)(F.ctl + CW_CNT) + (tt * NET + F.tid) * 16, (unsigned)BC[F.tid], __ATOMIC_RELAXED, __HIP_MEMORY_SCOPE_AGENT);
        __syncthreads();
#pragma unroll 1
        for (int ti = 0; ti < 8; ++ti) { const int m = m0 + ti;
            int lane = F.lane; asm volatile("" : "+v"(lane));
            const unsigned long long lt_mask = (1ull << lane) - 1ull;
            const int eA = EIDS[ti * 128 + lane] & 16383, eB = EIDS[ti * 128 + 64 + lane] & 16383, tA = eA >> 9, tB = eB >> 9; int rankA = 0, rankB = 0;
#pragma unroll
            for (int k = 0; k < NET; ++k) { const unsigned long long mA = __ballot(tA == k), mB = __ballot(tB == k);
                rankA = (tA == k) ? __popcll(mA & lt_mask) : rankA; rankB = (tB == k) ? __popcll(mA) + __popcll(mB & lt_mask) : rankB; }
            const unsigned tl = (unsigned)(m & 1023) << 17;
            if (!(SKIP & 4)) { const int s = BC[NET + tA] + OFFS[ti * NET + tA] + rankA; if (s < REC_CAP) REC[(size_t)(tt * NET + tA) * REC_CAP + s] = tl | ((unsigned)(eA & 511) << 7) | (unsigned)lane; }
            if (!(SKIP & 4)) { const int s = BC[NET + tB] + OFFS[ti * NET + tB] + rankB; if (s < REC_CAP) REC[(size_t)(tt * NET + tB) * REC_CAP + s] = tl | ((unsigned)(eB & 511) << 7) | (unsigned)(lane + 64); }
        }
    }
}

constexpr int NSLOT = 12, UPITCH = 80;
__device__ __forceinline__ void p11b_udot(Frame& F) {
    LAS unsigned char* XS = (LAS unsigned char*)F.lds;
    LAS unsigned char* US = XS + 1024 * UPITCH;
    LAS int* QB = (LAS int*)(F.lds + 124 * 1024);
    const int tid = F.tid;
    const unsigned char* XQ = F.ws + WS_XQ; const unsigned char* TU = F.ws + WS_TU; const unsigned* REC = (const unsigned*)(F.ws + WS_REC);
    const float* SXR = (const float*)(F.ws + WS_SXR); const float* GATEg = (const float*)(F.ws + WS_GATE); float* AVg = (float*)(F.ws + WS_AV);
    const float* SU = (const float*)(F.ws + WS_PSC); const float* SV = SU + 16384;
    for (;;) {
        __syncthreads();
        if (tid == 0) QB[0] = (int)__hip_atomic_fetch_add((unsigned*)(F.ctl + CW_Q), 1u, __ATOMIC_RELAXED, __HIP_MEMORY_SCOPE_AGENT);
        __syncthreads();
        const int b = QB[0];
        if (b >= NBUCK) break;
        const int tt = b >> 5, et = b & 31;
        int n = (int)__hip_atomic_load((unsigned*)(F.ctl + CW_CNT) + b * 16, __ATOMIC_RELAXED, __HIP_MEMORY_SCOPE_AGENT); n = n < REC_CAP ? n : REC_CAP;
        for (int g0 = 0; g0 < n; g0 += NSLOT * NTHR) {
            const int npass = (n - g0) < NSLOT * NTHR ? (n - g0) : NSLOT * NTHR;
            unsigned rec[NSLOT]; int acc[NSLOT];
#pragma unroll
            for (int j = 0; j < NSLOT; ++j) { const int idx = g0 + j * NTHR + tid; const unsigned r = idx < n ? REC[(size_t)b * REC_CAP + idx] : 0xffffffffu; acc[j] = 0;
                rec[j] = ((r >> 17) & 1023u) | (((r >> 7) & 511u) << 16); }
            v4u st[12];
#define P11B_SRC(step, i) (((i) % 6) < 4 ? XQ + ((size_t)(2 * (step) + (i) / 6) * SEQ + tt * 1024) * 32 + (size_t)(tid + 512 * ((i) % 6)) * 16 : TU + ((size_t)(2 * (step) + (i) / 6) * 16384 + et * ETSZ) * 32 + (size_t)(tid + 512 * (((i) % 6) - 4)) * 16)
#pragma unroll
            for (int i = 0; i < 12; ++i) st[i] = *(const GAS v4u*)P11B_SRC(0, i);
#pragma unroll 1
            for (int c = 0; c < 32; ++c) {
                __syncthreads();
#pragma unroll
                for (int i = 0; i < 12; ++i) { const int q = i % 6, hc = i / 6, p = (q < 4) ? tid + 512 * q : tid + 512 * (q - 4); *(LAS v4u*)((q < 4 ? XS : US) + (p >> 1) * UPITCH + hc * 32 + (p & 1) * 16) = st[i]; }
                __syncthreads();
                if (c + 1 < 32) {
#pragma unroll
                    for (int i = 0; i < 12; ++i) st[i] = *(const GAS v4u*)P11B_SRC(c + 1, i);
                }
#pragma unroll
                for (int j0 = 0; j0 < NSLOT; j0 += 2) {
                    if (j0 * NTHR < npass) {
                        v4u xb[2][4], ub[2][4];
#pragma unroll
                        for (int q = 0; q < 2; ++q) { unsigned r = rec[j0 + q]; asm volatile("" : "+v"(r));
                            const unsigned xo = (r & 0xffffu) * UPITCH, uo = (r >> 16) * UPITCH;
#pragma unroll
                            for (int hh = 0; hh < 4; ++hh) { xb[q][hh] = *(const LAS v4u*)(XS + xo + 16 * hh); ub[q][hh] = *(const LAS v4u*)(US + uo + 16 * hh); } }
                        __builtin_amdgcn_sched_barrier(0);
#pragma unroll
                        for (int q = 0; q < 2; ++q) { int s = acc[j0 + q];
#pragma unroll
                            for (int hh = 0; hh < 4; ++hh) { const v4u u = ub[q][hh], x = xb[q][hh];
                                s = __builtin_amdgcn_sdot4((int)u.x, (int)x.x, s, false); s = __builtin_amdgcn_sdot4((int)u.y, (int)x.y, s, false); s = __builtin_amdgcn_sdot4((int)u.z, (int)x.z, s, false); s = __builtin_amdgcn_sdot4((int)u.w, (int)x.w, s, false); }
                            acc[j0 + q] = s; }
                        __builtin_amdgcn_sched_barrier(0);
                    }
                }
            }
#undef P11B_SRC
#pragma unroll
            for (int j = 0; j < NSLOT; ++j) { const int idx = g0 + j * NTHR + tid; const unsigned r = idx < n ? REC[(size_t)b * REC_CAP + idx] : 0xffffffffu;
                if (r != 0xffffffffu) { const int t = tt * 1024 + (int)((r >> 17) & 1023), e = et * ETSZ + (int)((r >> 7) & 511), j7 = (int)(r & 127);
                    const float hv = (float)acc[j] * SU[e] * SXR[2 * t]; AVg[(size_t)t * 128 + j7] = gelu_erf(hv) * GATEg[(size_t)t * 128 + j7] * SV[e]; } }
        }
    }
}

__device__ __forceinline__ void p11c_vsum(Frame& F) {
    const int gw = F.vcu * NWAVES + F.wave, NGW = F.G * NWAVES;
    LAS int* EID = (LAS int*)(F.lds + F.wave * 16384); LAS float* AV = (LAS float*)(EID + 128);
    const unsigned char* TV = F.ws + WS_TV; const int* EIDg = (const int*)(F.ws + WS_EID); const float* AVg = (const float*)(F.ws + WS_AV);
    for (int m = gw; m < SEQ; m += NGW) {
        int lane = F.lane; asm volatile("" : "+v"(lane));
        const int lo16 = lane * 16;
        EID[lane] = EIDg[(size_t)m * 128 + lane]; EID[lane + 64] = EIDg[(size_t)m * 128 + 64 + lane]; AV[lane] = AVg[(size_t)m * 128 + lane]; AV[lane + 64] = AVg[(size_t)m * 128 + 64 + lane];
        asm volatile("" ::: "memory");
        float y[32]; float sas = 0.f;
#pragma unroll
        for (int e = 0; e < 32; ++e) y[e] = 0.f;
        v4u rv[2][4][2]; float av[2][4];
#define P11C_LOAD(buf, g) do { _Pragma("unroll") for (int q = 0; q < 4; ++q) { const int e = __builtin_amdgcn_readfirstlane(EID[(g) + q]); av[buf][q] = AV[(g) + q]; const unsigned char* rp = TV + (size_t)e * DM + lo16; \
            rv[buf][q][0] = *(const GAS v4u*)(rp); rv[buf][q][1] = *(const GAS v4u*)(rp + 1024); } } while (0)
#define P11C_ACC(buf) do { _Pragma("unroll") for (int q = 0; q < 4; ++q) { const float a = av[buf][q]; sas += a; \
            _Pragma("unroll") for (int j = 0; j < 2; ++j) { const v4u r = rv[buf][q][j]; const unsigned wv[4] = {r.x, r.y, r.z, r.w}; \
                _Pragma("unroll") for (int dd = 0; dd < 4; ++dd) { y[16 * j + 4 * dd] += a * cvt_ub0(wv[dd]); y[16 * j + 4 * dd + 1] += a * cvt_ub1(wv[dd]); y[16 * j + 4 * dd + 2] += a * cvt_ub2(wv[dd]); y[16 * j + 4 * dd + 3] += a * cvt_ub3(wv[dd]); } } \
            __builtin_amdgcn_sched_barrier(0); } } while (0)
        P11C_LOAD(0, 0);
#pragma unroll 1
        for (int g = 0; g < 128; g += 8) {
            P11C_LOAD(1, g + 4);
            P11C_ACC(0);
            if (g + 8 < 128) P11C_LOAD(0, g + 8);
            P11C_ACC(1);
        }
#undef P11C_LOAD
#undef P11C_ACC
        const float* x1 = F.out + (size_t)m * DM;
        float s2 = 0.f; const float corr = 128.0f * sas;
#pragma unroll
        for (int j = 0; j < 2; ++j)
#pragma unroll
            for (int q = 0; q < 4; ++q) { const f32x4 a = *(const GAS f32x4*)(x1 + j * 1024 + lo16 + 4 * q);
                y[16 * j + 4 * q] += a.x - corr; y[16 * j + 4 * q + 1] += a.y - corr; y[16 * j + 4 * q + 2] += a.z - corr; y[16 * j + 4 * q + 3] += a.w - corr; }
#pragma unroll
        for (int e = 0; e < 32; ++e) s2 += y[e] * y[e];
        const float ro = 1.0f / sqrtf(wave_sum(s2) * (1.f / DM) + EPS);
        float* orow = F.out + (size_t)m * DM;
#pragma unroll
        for (int j = 0; j < 2; ++j)
#pragma unroll
            for (int q = 0; q < 4; ++q) { const f32x4 a = *(const GAS f32x4*)(F.in[I_FNW] + j * 1024 + lo16 + 4 * q);
                *(GAS f32x4*)(orow + j * 1024 + lo16 + 4 * q) = (f32x4){y[16 * j + 4 * q] * ro * a.x, y[16 * j + 4 * q + 1] * ro * a.y, y[16 * j + 4 * q + 2] * ro * a.z, y[16 * j + 4 * q + 3] * ro * a.w}; }
    }
}
#ifndef MK_N_LAUNCHES
#define MK_N_LAUNCHES 1
#endif
constexpr int N_PHASES = 14;
constexpr int N_LAUNCHES = MK_N_LAUNCHES;
static_assert(N_LAUNCHES == 1 || N_LAUNCHES == N_PHASES, "MK_N_LAUNCHES is 1 or N_PHASES");
#ifndef PG8_SP2
#define PG8_SP2 true
#endif
#ifndef PG8_ALIGN
#define PG8_ALIGN true
#endif
struct Args { const float* in[19]; float* out; unsigned char* ws; int ph_lo, ph_hi; };
__global__ void __launch_bounds__(NTHR, 2) fwd_kernel(Args args) {
    extern __shared__ __attribute__((aligned(16))) unsigned char lds[];
    Frame F;
    F.lds = (LAS unsigned char*)lds;
    F.MISC = (volatile LAS unsigned*)(F.lds + MISC_OFF);
    F.tid = threadIdx.x; F.lane = F.tid & 63; F.wave = __builtin_amdgcn_readfirstlane(F.tid >> 6);
    F.G = gridDim.x; { const int bx = blockIdx.x; F.vcu = (F.G % 8 == 0) ? (bx % 8) * (F.G / 8) + bx / 8 : bx; }
    F.ws = args.ws; F.out = args.out; F.ctl = (gu32*)(args.ws + WS_CTL);
#pragma unroll
    for (int i = 0; i < 19; ++i) F.in[i] = args.in[i];
    for (int u = F.tid; u < (LDS_BYTES - MISC_OFF) / 4; u += NTHR) ((LAS unsigned*)(F.lds + MISC_OFF))[u] = 0u;
    __syncthreads();
    XcdBarrier bar; bar.bar = (unsigned*)(F.ctl + CW_BAR); bar.x = 0; bar.st = nullptr;
    if (N_LAUNCHES == 1) bar = xcd_barrier_post((unsigned*)(F.ctl + CW_BAR), F.MISC + 8);
    const int lo = args.ph_lo, hi = args.ph_hi;
#ifdef ONLY_PHASE
#define IN(k) ((k) == ONLY_PHASE && lo <= (k) && (k) < hi)
#else
#define IN(k) (lo <= (k) && (k) < hi)
#endif
#define SEAM(k) do { if (IN(k) && IN((k) + 1)) xcd_barrier(bar); } while (0)
#ifndef REPEAT_MASK
#define REPEAT_MASK 0
#endif
#ifndef P11A_SKIP
#define P11A_SKIP 0
#endif
#define REPS(k) for (int rep_ = 0; rep_ < (((REPEAT_MASK) >> (k)) & 1) + 1; ++rep_)
#define RSEAM(k) do { if ((((REPEAT_MASK) >> (k)) & 1) && rep_ == 0) xcd_barrier(bar); } while (0)
    unsigned char* ws = args.ws;
    if (IN(0)) { REPS(0) { p0_prologue(F); RSEAM(0); } SEAM(0); }
    if (IN(1)) {
        pg8::Gemm g{(const bf16*)(ws + WS_XN), (const bf16*)(ws + WS_W1), SEQ, N1, DM}; pg8::StaticOrder S; S.init(SEQ, N1, F.G, (int)blockIdx.x);
        EpiG1 E{ws, F.in[I_LB], (const float*)(ws + WS_QX), (const float*)(ws + WS_QW) + QW_W1};
        if (QM_G1) g.A = (const bf16*)((const unsigned char*)F.out + DO_XN8);
        if ((REPEAT_MASK >> 1) & 1) { pg8::gemm_phase<EpiG1, pg8::StaticOrder, PG8_ALIGN, PG8_SP2, QM_G1>(F.lds, g, S, E); xcd_barrier(bar); }
        pg8::gemm_phase<EpiG1, pg8::StaticOrder, PG8_ALIGN, PG8_SP2, QM_G1>(F.lds, g, S, E);
        p1_ab(F);
        SEAM(1);
    }
#ifdef EXTRA_BARRIERS
    for (int eb = 0; eb < EXTRA_BARRIERS; ++eb) xcd_barrier(bar);
#endif
    if (IN(2)) { REPS(2) { hgrn_pass<false>(F); RSEAM(2); } SEAM(2); }
    if (IN(3)) { if ((REPEAT_MASK >> 3) & 1) { hgrn_pass<true, P11A_SKIP>(F); xcd_barrier(bar); } hgrn_pass<true>(F); SEAM(3); }
    if (IN(4)) { if ((REPEAT_MASK >> 4) & 1) { gdn_prep<P11A_SKIP>(F); xcd_barrier(bar); } gdn_prep<0>(F); SEAM(4); }
    if (IN(5)) { if ((REPEAT_MASK >> 5) & 1) { gdn_pass<false, P11A_SKIP>(F); xcd_barrier(bar); } gdn_pass<false>(F); SEAM(5); }
    if (IN(6)) { if ((REPEAT_MASK >> 6) & 1) { gdn_pass<true, P11A_SKIP>(F); xcd_barrier(bar); } gdn_pass<true>(F); SEAM(6); }
    if (IN(7)) { REPS(7) { p7_mix(F); RSEAM(7); } SEAM(7); }
    if (IN(8)) {
        pg8::StaticOrder S; S.init(SEQ, DM, F.G, (int)blockIdx.x);
        bf16* GT = (bf16*)(ws + WS_GT); bf16* GT2 = (bf16*)(ws + WS_GT2);
        const bf16* XNg = QM_GATE ? (const bf16*)((const unsigned char*)F.out + DO_XN8) : (const bf16*)(ws + WS_XN);
        const bf16* WG2 = QM_GATE ? (const bf16*)(ws + WS_WG + (size_t)DM * DM) : (const bf16*)(ws + WS_WG) + (size_t)DM * DM;
        const float* QX = (const float*)(ws + WS_QX); const float* QW = (const float*)(ws + WS_QW);
#define P8_BODY \
        { pg8::Gemm g{XNg, (const bf16*)(ws + WS_WG), SEQ, DM, DM}; EpiGate E{GT, QX, QW + QW_WG}; pg8::gemm_phase<EpiGate, pg8::StaticOrder, PG8_ALIGN, PG8_SP2, QM_GATE>(F.lds, g, S, E); } \
        __builtin_amdgcn_fence(__ATOMIC_ACQUIRE, "agent"); VM_WAIT(); __syncthreads(); \
        { pg8::Gemm g{(const bf16*)(ws + WS_YA), (const bf16*)(ws + WS_WPA), SEQ, DM, HW}; EpiMix<0> E{GT, nullptr, nullptr, QX + SEQ, QW + QW_WPA}; pg8::gemm_phase<EpiMix<0>, pg8::StaticOrder, PG8_ALIGN, PG8_SP2, QM_MIX>(F.lds, g, S, E); } \
        { pg8::Gemm g{XNg, WG2, SEQ, DM, DM}; EpiGate E{GT2, QX, QW + QW_WG + DM}; pg8::gemm_phase<EpiGate, pg8::StaticOrder, PG8_ALIGN, PG8_SP2, QM_GATE>(F.lds, g, S, E); } \
        __builtin_amdgcn_fence(__ATOMIC_ACQUIRE, "agent"); VM_WAIT(); __syncthreads(); \
        { pg8::Gemm g{(const bf16*)(ws + WS_YB), (const bf16*)(ws + WS_WPB), SEQ, DM, HW}; EpiMix<1> E{GT, GT2, ws + WS_GT8, QX + 2 * SEQ, QW + QW_WPB}; pg8::gemm_phase<EpiMix<1>, pg8::StaticOrder, PG8_ALIGN, PG8_SP2, QM_MIX>(F.lds, g, S, E); }
        if ((REPEAT_MASK >> 8) & 1) { P8_BODY xcd_barrier(bar); }
        P8_BODY
#undef P8_BODY
        SEAM(8);
    }
    if (IN(9)) {
        pg8::Gemm g{(const bf16*)(ws + (QM_OUT ? WS_GT8 : WS_GT)), (const bf16*)(ws + WS_WOUT), SEQ, DM, DM}; pg8::StaticOrder S; S.init(SEQ, DM, F.G, (int)blockIdx.x);
        EpiX1 E{F.in[I_X], F.out, (bf16*)(ws + WS_X1B)};
        if ((REPEAT_MASK >> 9) & 1) { pg8::gemm_phase<EpiX1, pg8::StaticOrder, PG8_ALIGN, PG8_SP2, QM_OUT>(F.lds, g, S, E); xcd_barrier(bar); }
        pg8::gemm_phase<EpiX1, pg8::StaticOrder, PG8_ALIGN, PG8_SP2, QM_OUT>(F.lds, g, S, E);
        SEAM(9);
    }
    if (IN(10)) {
        pg8::Gemm g{(const bf16*)(ws + WS_X1B), (const bf16*)(ws + WS_WS), SEQ, DM, DM}; pg8::StaticOrder S; S.init(SEQ, DM, F.G, (int)blockIdx.x);
        EpiBf E{(bf16*)(ws + WS_SC)};
        if ((REPEAT_MASK >> 10) & 1) { pg8::gemm_phase<EpiBf, pg8::StaticOrder, PG8_ALIGN, PG8_SP2>(F.lds, g, S, E); xcd_barrier(bar); }
        pg8::gemm_phase<EpiBf, pg8::StaticOrder, PG8_ALIGN, PG8_SP2>(F.lds, g, S, E);
        SEAM(10);
    }
    if (IN(11)) {
        if ((REPEAT_MASK >> 11) & 1) { p11a_topk<P11A_SKIP>(F); xcd_barrier(bar); if (blockIdx.x == 0) for (int i = F.tid; i < NBUCK + 1; i += NTHR) __hip_atomic_store((unsigned*)(F.ctl + CW_CNT) + i * 16, 0u, __ATOMIC_RELAXED, __HIP_MEMORY_SCOPE_AGENT); xcd_barrier(bar); }
        p11a_topk<0>(F); SEAM(11); }
    if (IN(12)) { if ((REPEAT_MASK >> 12) & 1) { p11b_udot(F); xcd_barrier(bar); if (blockIdx.x == 0 && F.tid == 0) __hip_atomic_store((unsigned*)(F.ctl + CW_Q), 0u, __ATOMIC_RELAXED, __HIP_MEMORY_SCOPE_AGENT); xcd_barrier(bar); } p11b_udot(F); SEAM(12); }
    if (IN(13)) { p11c_vsum(F); }
#undef IN
#undef SEAM
}


#ifdef PROBE
__global__ void digest_kernel(const unsigned* ws, float* out) {
    const size_t n = (size_t)SEQ * DM;
    for (size_t i = (size_t)blockIdx.x * blockDim.x + threadIdx.x; i < n; i += (size_t)gridDim.x * blockDim.x) {
        unsigned acc = (PROBE >= 9) ? __builtin_bit_cast(unsigned, out[i]) : 0u;
        const size_t offs[5] = {0, 128 * MiB / 4, 256 * MiB / 4, 384 * MiB / 4, 408 * MiB / 4};
#pragma unroll
        for (int r = 0; r < 5; ++r) acc = acc * 1664525u + ws[offs[r] + i];
        out[i] = (float)(acc >> 8) * (1.0f / 16777216.0f);
    }
}
#endif
extern "C" void kernel_launch(void* const* d_in, const int* in_sizes, int n_in, void* d_out, int out_size, void* d_ws, size_t ws_size, hipStream_t stream) {
    static int grid = 0;
    if (grid == 0) {
        if (n_in != 19 || in_sizes[0] != SEQ * DM || out_size != SEQ * DM || ws_size < WS_END) { fprintf(stderr, "kernel_launch: unexpected shapes (n_in %d, in0 %d, out %d, ws %zu; need ws >= %zu)\n", n_in, n_in > 0 ? in_sizes[0] : -1, out_size, ws_size, (size_t)WS_END); grid = -1; return; }
        int dev = 0, cus = 0, per_cu = 0;
        if (hipGetDevice(&dev) != hipSuccess || hipDeviceGetAttribute(&cus, hipDeviceAttributeMultiprocessorCount, dev) != hipSuccess) { grid = -1; return; }
        if (hipFuncSetAttribute((const void*)fwd_kernel, hipFuncAttributeMaxDynamicSharedMemorySize, LDS_BYTES) != hipSuccess) { fprintf(stderr, "kernel_launch: hipFuncSetAttribute failed\n"); grid = -1; return; }
        if (hipOccupancyMaxActiveBlocksPerMultiprocessor(&per_cu, (const void*)fwd_kernel, NTHR, LDS_BYTES) != hipSuccess || per_cu < 1) fprintf(stderr, "kernel_launch: occupancy query reports %d\n", per_cu);
        (void)hipGetLastError();
        grid = cus;
    }
    if (grid < 0) return;
    (void)hipMemsetAsync((char*)d_ws + WS_CTL, 0, CTL_ZERO_BYTES, stream);
    Args a{};
    for (int i = 0; i < 19; ++i) a.in[i] = (const float*)d_in[i];
    a.out = (float*)d_out; a.ws = (unsigned char*)d_ws;
    for (int li = 0; li < N_LAUNCHES; ++li) {
        a.ph_lo = (N_LAUNCHES == 1) ? 0 : li; a.ph_hi = (N_LAUNCHES == 1) ? N_PHASES : li + 1;
#ifdef PROBE
        if (li > PROBE) break;
#endif
        hipLaunchKernelGGL(fwd_kernel, dim3(grid), dim3(NTHR), LDS_BYTES, stream, a);
    }
#ifdef PROBE
    hipLaunchKernelGGL(digest_kernel, dim3(2048), dim3(256), 0, stream, (const unsigned*)d_ws, (float*)d_out);
#endif
}
```

```cpp
#include <hip/hip_runtime.h>
#include <cstdio>
#include <cstdint>
#define GAS __attribute__((address_space(1)))
#define LAS __attribute__((address_space(3)))
#define MK_N_LAUNCHES 1
namespace pg8 {
#define PG8_LAS __attribute__((address_space(3)))
typedef unsigned short bf16_t;
typedef short bf16x8 __attribute__((ext_vector_type(8)));
typedef float f32x4 __attribute__((ext_vector_type(4)));
typedef unsigned u32x4 __attribute__((ext_vector_type(4)));
constexpr int BM = 256, BK = 64, HALF = 128, HTB = HALF * BK * 2  , STAGE_BYTES = 8 * HTB, NXCD = 8, WGM = 8;

__host__ __device__ __forceinline__ int lds_byte(int r, int c) { const int st = (r >> 4) * 2 + (c >> 5), rr = r & 15, cc = c & 31, ob = rr * 64 + cc * 2; return st * 1024 + (ob ^ (((ob >> 9) & 1) << 5)); }
__host__ __device__ __forceinline__ void stage_rc(int b, int& R, int& C) { const int st = b / 1024, sb = b % 1024, swz = sb ^ (((sb >> 9) & 1) << 5); R = (st >> 1) * 16 + swz / 64; C = (st & 1) * 32 + (swz % 64) / 2; }
__host__ __device__ __forceinline__ int perm32(int rho) { const int n = rho >> 4, i = rho & 15; return 8 * (i >> 2) + 4 * n + (i & 3); }

struct Unit { int pm, pn; };
struct Gemm { const bf16_t* A; const bf16_t* Bt; int M, N, K; };

struct StaticOrder {
    int nM, nN, nwg, G, c;
    __host__ __device__ void init(int M, int N, int G_, int c_) { nM = M / BM; nN = N / BM; nwg = nM * nN; G = G_; c = c_; }
    __host__ __device__ bool next(int i, Unit& u) const {
        const long L = (long)i * G + c; if (L >= nwg) return false;
        int wgid = (int)L; { const int q = nwg / NXCD, r = nwg % NXCD, xcd = wgid % NXCD, off = wgid / NXCD; wgid = (xcd < r ? xcd * (q + 1) : r * (q + 1) + (xcd - r) * q) + off; }
        const int nig = WGM * nN, gid = wgid / nig, fm = gid * WGM, gsz = (nM - fm) < WGM ? (nM - fm) : WGM;
        u.pm = fm + ((wgid % nig) % gsz); u.pn = (wgid % nig) / gsz; return true;
    }
    __device__ __forceinline__ void a_ready(const Unit&) const {}
    __device__ __forceinline__ void done(const Unit&) const {}
};

__device__ __forceinline__ unsigned cvt_pk_bf16(float lo, float hi) { unsigned r; asm volatile("v_cvt_pk_bf16_f32 %0, %1, %2" : "=v"(r) : "v"(lo), "v"(hi)); return r; }
typedef float f32x2 __attribute__((ext_vector_type(2)));
__device__ __forceinline__ f32x2 gelu_pk(f32x2 v) {
    const f32x2 av = __builtin_elementwise_abs(v), d = av * 0.2316418882f + 1.0f;
    f32x2 t; t.x = __builtin_amdgcn_rcpf(d.x); t.y = __builtin_amdgcn_rcpf(d.y);
    f32x2 q = t * 0.5307027145f + (-0.7265760135f); q = q * t + 0.7107068705f; q = q * t + (-0.142248368f); q = q * t + 0.127414796f; q = q * t;
    const f32x2 s = (v * v) * (-0.72134752044f);
    f32x2 e; e.x = __builtin_amdgcn_exp2f(s.x); e.y = __builtin_amdgcn_exp2f(s.y);
    const f32x2 m = v * (q * e), r = v - m;
    f32x2 o; o.x = v.x < 0.f ? m.x : r.x; o.y = v.y < 0.f ? m.y : r.y; return o;
}

typedef int i32x4v __attribute__((ext_vector_type(4)));
typedef int i32x8v __attribute__((ext_vector_type(8)));
__device__ __forceinline__ i32x8v cat8(bf16x8 lo, bf16x8 hi) { return __builtin_shufflevector(__builtin_bit_cast(i32x4v, lo), __builtin_bit_cast(i32x4v, hi), 0, 1, 2, 3, 4, 5, 6, 7); }
template <class Epi, class Sched, bool ALIGN_EPI = false, bool SP2 = false, int QM = 0>
__device__ __forceinline__ void gemm_phase(PG8_LAS unsigned char* lds, const Gemm g, const Sched& S, const Epi& E) {
    const int tid = threadIdx.x, wid = __builtin_amdgcn_readfirstlane(tid >> 6), lane = tid & 63, wr = wid >> 2, wc = wid & 3, fr = lane & 15, fq = lane >> 4;
    constexpr bool F8 = QM == 1, I8 = QM == 2;
    const int K = g.K, KB = QM ? K : 2 * K  , nt = KB / (BK * 2);
    unsigned voffA[2], voffB[2];
#pragma unroll
    for (int i = 0; i < 2; ++i) { int R, C; stage_rc(tid * 16 + i * 8192, R, C); const int Rb = Epi::PERM ? ((R & ~31) + perm32(R & 31)) : R;
        voffA[i] = (unsigned)(R * KB + C * 2); voffB[i] = (unsigned)(Rb * KB + C * 2); }
    const size_t kstep = (size_t)(BK * 2);
    const size_t hstep = (size_t)HALF * KB;
    const size_t tstep = 2 * hstep;
    const unsigned ldsw = (unsigned)wid * 1024u;
    const int aoff = lds_byte(wr * 64 + fr, fq * 8), boff = lds_byte(wc * 32 + fr, fq * 8);
#define PG8_SA(b, h) (((b) * 2 + (h)) * HTB)
#define PG8_SB(b, h) ((4 + (b) * 2 + (h)) * HTB)
#define PG8_STAGE(bufoff, gbase, voff) do { _Pragma("unroll") for (int _i = 0; _i < 2; ++_i) \
        __builtin_amdgcn_global_load_lds((const unsigned*)((const char*)(gbase) + (voff)[_i]), (PG8_LAS unsigned*)(lds + (bufoff) + ldsw + _i * 8192), 16, 0, 0); } while (0)
#define PG8_LD16(off) (*(const PG8_LAS bf16x8*)(lds + (off)))
#define PG8_LDA(dst, b, h) do { _Pragma("unroll") for (int m = 0; m < 4; ++m) { if constexpr (F8) dst##8[m] = cat8(PG8_LD16(PG8_SA(b, h) + aoff + m * 2048), PG8_LD16(PG8_SA(b, h) + aoff + m * 2048 + 1024)); \
        else { _Pragma("unroll") for (int k = 0; k < 2; ++k) dst[m][k] = PG8_LD16(PG8_SA(b, h) + aoff + m * 2048 + k * 1024); } } } while (0)
#define PG8_LDB(dst, b, h) do { _Pragma("unroll") for (int n = 0; n < 2; ++n) { if constexpr (F8) dst##8[n] = cat8(PG8_LD16(PG8_SB(b, h) + boff + n * 2048), PG8_LD16(PG8_SB(b, h) + boff + n * 2048 + 1024)); \
        else { _Pragma("unroll") for (int k = 0; k < 2; ++k) dst[n][k] = PG8_LD16(PG8_SB(b, h) + boff + n * 2048 + k * 1024); } } } while (0)
#define PG8_MMA(ai, bj, At, Bt) do { __builtin_amdgcn_s_setprio(1); _Pragma("unroll") for (int m = 0; m < 4; ++m) _Pragma("unroll") for (int n = 0; n < 2; ++n) { \
        if constexpr (F8) asm volatile("v_mfma_f32_16x16x128_f8f6f4 %0, %1, %2, %0" : "+v"(acc[ai][bj][m][n]) : "v"(Bt##8[n]), "v"(At##8[m])); \
        else if constexpr (I8) { _Pragma("unroll") for (int k = 0; k < 2; ++k) acc[ai][bj][m][n] = __builtin_bit_cast(f32x4, __builtin_amdgcn_mfma_i32_16x16x64_i8(__builtin_bit_cast(i32x4v, Bt[n][k]), __builtin_bit_cast(i32x4v, At[m][k]), __builtin_bit_cast(i32x4v, acc[ai][bj][m][n]), 0, 0, 0)); } \
        else { _Pragma("unroll") for (int k = 0; k < 2; ++k) acc[ai][bj][m][n] = __builtin_amdgcn_mfma_f32_16x16x32_bf16(Bt[n][k], At[m][k], acc[ai][bj][m][n], 0, 0, 0); } } \
        __builtin_amdgcn_s_setprio(0); } while (0)
#define PG8_WAIT_V(n) asm volatile("s_waitcnt vmcnt(" #n ")" ::: "memory")
#define PG8_WAIT_L(n) asm volatile("s_waitcnt lgkmcnt(" #n ")" ::: "memory")
#define PG8_BAR __builtin_amdgcn_s_barrier()
#define PG8_SCHED __builtin_amdgcn_sched_barrier(0)
    Unit cur, nxt; int ui = 0;
    if (!S.next(0, cur)) return;
    f32x4 acc[2][2][4][2];
#pragma unroll
    for (int a = 0; a < 2; ++a)
#pragma unroll
        for (int b = 0; b < 2; ++b)
#pragma unroll
            for (int m = 0; m < 4; ++m)
#pragma unroll
                for (int n = 0; n < 2; ++n) acc[a][b][m][n] = (f32x4){0.f, 0.f, 0.f, 0.f};
    bf16x8 At[4][2], B0[2][2], B1[2][2]; i32x8v At8[4], B08[2], B18[2];
    const char* cA = (const char*)g.A + (size_t)cur.pm * tstep; const char* cB = (const char*)g.Bt + (size_t)cur.pn * tstep;
    S.a_ready(cur);
    if constexpr (SP2) {
        PG8_STAGE(PG8_SB(0, 0), cB, voffB); PG8_STAGE(PG8_SB(0, 1), cB + hstep, voffB); PG8_STAGE(PG8_SA(0, 0), cA, voffA); PG8_STAGE(PG8_SA(0, 1), cA + hstep, voffA);
        if (wr == 1) PG8_BAR;
        PG8_WAIT_V(2); PG8_BAR;
        PG8_STAGE(PG8_SB(1, 0), cB + kstep, voffB); PG8_STAGE(PG8_SA(1, 0), cA + kstep, voffA); PG8_STAGE(PG8_SB(1, 1), cB + hstep + kstep, voffB);
        PG8_WAIT_V(6); PG8_BAR;
    } else {
        PG8_STAGE(PG8_SB(0, 0), cB, voffB); PG8_STAGE(PG8_SA(0, 0), cA, voffA); PG8_STAGE(PG8_SB(0, 1), cB + hstep, voffB); PG8_STAGE(PG8_SA(0, 1), cA + hstep, voffA);
        if (wr == 1) PG8_BAR;
        PG8_WAIT_V(4); PG8_BAR;
        PG8_STAGE(PG8_SB(1, 0), cB + kstep, voffB); PG8_STAGE(PG8_SA(1, 0), cA + kstep, voffA); PG8_STAGE(PG8_SB(1, 1), cB + hstep + kstep, voffB);
        PG8_WAIT_V(6); PG8_BAR;
    }
    for (;;) {
        const bool has_next = S.next(ui + 1, nxt);
        const char* nA = has_next ? (const char*)g.A + (size_t)nxt.pm * tstep : cA; const char* nB = has_next ? (const char*)g.Bt + (size_t)nxt.pn * tstep : cB;
        for (int t = 0; t < nt; t += 2) {
            const bool last = (t == nt - 2);
            const char* a1 = cA + (size_t)(t + 1) * kstep;
            const char* a2 = last ? nA : cA + (size_t)(t + 2) * kstep; const char* b2 = last ? nB : cB + (size_t)(t + 2) * kstep;
            const char* a3 = a2 + kstep; const char* b3 = b2 + kstep;
            if (last && has_next) S.a_ready(nxt);
            if constexpr (SP2) {
            PG8_LDB(B0, 0, 0); PG8_LDB(B1, 0, 1); PG8_SCHED; PG8_LDA(At, 0, 0); PG8_STAGE(PG8_SA(1, 1), a1 + hstep, voffA);
            PG8_WAIT_V(8); PG8_WAIT_L(0); PG8_BAR; PG8_MMA(0, 0, At, B0); PG8_MMA(0, 1, At, B1); PG8_BAR; PG8_SCHED;
            PG8_LDA(At, 0, 1); PG8_STAGE(PG8_SB(0, 0), b2, voffB); PG8_STAGE(PG8_SB(0, 1), b2 + hstep, voffB); PG8_STAGE(PG8_SA(0, 0), a2, voffA);
            PG8_WAIT_V(8); PG8_WAIT_L(0); PG8_BAR; PG8_MMA(1, 0, At, B0); PG8_MMA(1, 1, At, B1); PG8_BAR; PG8_SCHED;
            PG8_LDB(B0, 1, 0); PG8_LDB(B1, 1, 1); PG8_SCHED; PG8_LDA(At, 1, 0); PG8_STAGE(PG8_SA(0, 1), a2 + hstep, voffA);
            PG8_WAIT_V(8); PG8_WAIT_L(0); PG8_BAR; PG8_MMA(0, 0, At, B0); PG8_MMA(0, 1, At, B1); PG8_BAR; PG8_SCHED;
            PG8_LDA(At, 1, 1); PG8_STAGE(PG8_SB(1, 0), b3, voffB); PG8_STAGE(PG8_SB(1, 1), b3 + hstep, voffB); PG8_STAGE(PG8_SA(1, 0), a3, voffA);
            PG8_WAIT_V(8); PG8_WAIT_L(0); PG8_BAR; PG8_MMA(1, 0, At, B0); PG8_MMA(1, 1, At, B1); PG8_BAR; PG8_SCHED;
            } else {
            PG8_LDB(B0, 0, 0); PG8_SCHED; PG8_LDA(At, 0, 0); PG8_STAGE(PG8_SA(1, 1), a1 + hstep, voffA);
            PG8_WAIT_L(8); PG8_BAR; PG8_WAIT_L(0); PG8_MMA(0, 0, At, B0); PG8_BAR; PG8_SCHED;
            PG8_LDB(B1, 0, 1); PG8_STAGE(PG8_SB(0, 0), b2, voffB);
            PG8_BAR; PG8_WAIT_L(0); PG8_MMA(0, 1, At, B1); PG8_BAR;
            PG8_LDA(At, 0, 1); PG8_STAGE(PG8_SA(0, 0), a2, voffA);
            PG8_BAR; PG8_WAIT_L(0); PG8_MMA(1, 0, At, B0); PG8_BAR; PG8_SCHED;
            PG8_STAGE(PG8_SB(0, 1), b2 + hstep, voffB);
            PG8_WAIT_V(6); PG8_BAR; PG8_MMA(1, 1, At, B1); PG8_BAR;
            PG8_LDB(B0, 1, 0); PG8_SCHED; PG8_LDA(At, 1, 0); PG8_STAGE(PG8_SA(0, 1), a2 + hstep, voffA);
            PG8_WAIT_L(8); PG8_BAR; PG8_WAIT_L(0); PG8_MMA(0, 0, At, B0); PG8_BAR; PG8_SCHED;
            PG8_LDB(B1, 1, 1); PG8_STAGE(PG8_SB(1, 0), b3, voffB);
            PG8_BAR; PG8_WAIT_L(0); PG8_MMA(0, 1, At, B1); PG8_BAR;
            PG8_LDA(At, 1, 1); PG8_STAGE(PG8_SA(1, 0), a3, voffA);
            PG8_BAR; PG8_WAIT_L(0); PG8_MMA(1, 0, At, B0); PG8_BAR; PG8_SCHED;
            PG8_STAGE(PG8_SB(1, 1), b3 + hstep, voffB);
            PG8_WAIT_V(6); PG8_BAR; PG8_MMA(1, 1, At, B1); PG8_BAR;
            }
        }
        if constexpr (ALIGN_EPI) { if (wr == 0) PG8_BAR; }
        if constexpr (F8) asm volatile("s_nop 15\n\ts_nop 15" ::: "memory");
        if constexpr (!Epi::AFTER_DRAIN) { E(acc, cur, wr, wc, fr, fq); S.done(cur); }
        if (!has_next) break;
#pragma unroll
        for (int a = 0; a < 2; ++a)
#pragma unroll
            for (int b = 0; b < 2; ++b)
#pragma unroll
                for (int m = 0; m < 4; ++m)
#pragma unroll
                    for (int n = 0; n < 2; ++n) acc[a][b][m][n] = (f32x4){0.f, 0.f, 0.f, 0.f};
        cur = nxt; cA = nA; cB = nB; ++ui;
        if constexpr (ALIGN_EPI) { if (wr == 1) PG8_BAR; }
    }
    PG8_WAIT_V(0);
    if constexpr (!ALIGN_EPI) { if (wr == 0) PG8_BAR; }
    PG8_BAR;
    if constexpr (Epi::AFTER_DRAIN) { E.fused(acc, cur, wr, wc, fr, fq, lds, wid, lane); S.done(cur); }
#undef PG8_SA
#undef PG8_SB
#undef PG8_STAGE
#undef PG8_LD16
#undef PG8_LDA
#undef PG8_LDB
#undef PG8_MMA
#undef PG8_WAIT_V
#undef PG8_WAIT_L
#undef PG8_BAR
#undef PG8_SCHED
}
}
typedef unsigned short bf16;
typedef unsigned v4u __attribute__((ext_vector_type(4)));
typedef unsigned v2u __attribute__((ext_vector_type(2)));
typedef float f32x4 __attribute__((ext_vector_type(4)));
typedef float f32x2 __attribute__((ext_vector_type(2)));
typedef short bf16x8 __attribute__((ext_vector_type(8)));
typedef GAS unsigned gu32;
#define RLX_AGENT __ATOMIC_RELAXED, __HIP_MEMORY_SCOPE_AGENT
#define LDS_WAIT() asm volatile("s_waitcnt lgkmcnt(0)" ::: "memory")
#define VM_WAIT() asm volatile("s_waitcnt vmcnt(0)" ::: "memory")
typedef __bf16 bf16x2_hw __attribute__((ext_vector_type(2)));
__device__ __forceinline__ unsigned pk2(float lo, float hi) { const f32x2 v = {lo, hi}; const bf16x2_hw b = __builtin_convertvector(v, bf16x2_hw); return __builtin_bit_cast(unsigned, b); }
__device__ __forceinline__ unsigned pk4f8(float a, float b, float c, float d) { int w = 0; w = __builtin_amdgcn_cvt_pk_fp8_f32(a, b, w, false); w = __builtin_amdgcn_cvt_pk_fp8_f32(c, d, w, true); return (unsigned)w; }
__device__ __forceinline__ float cvt_ub0(unsigned w) { float f; asm("v_cvt_f32_ubyte0 %0, %1" : "=v"(f) : "v"(w)); return f; }
__device__ __forceinline__ float cvt_ub1(unsigned w) { float f; asm("v_cvt_f32_ubyte1 %0, %1" : "=v"(f) : "v"(w)); return f; }
__device__ __forceinline__ float cvt_ub2(unsigned w) { float f; asm("v_cvt_f32_ubyte2 %0, %1" : "=v"(f) : "v"(w)); return f; }
__device__ __forceinline__ float cvt_ub3(unsigned w) { float f; asm("v_cvt_f32_ubyte3 %0, %1" : "=v"(f) : "v"(w)); return f; }
__device__ __forceinline__ unsigned f2bf(float f) { return pk2(f, 0.f) & 0xffffu; }
__device__ __forceinline__ float bflo(unsigned w) { return __builtin_bit_cast(float, w << 16); }
__device__ __forceinline__ float bfhi(unsigned w) { return __builtin_bit_cast(float, w & 0xffff0000u); }
__device__ __forceinline__ float bf1(bf16 b) { return __builtin_bit_cast(float, ((unsigned)b) << 16); }
__device__ __forceinline__ float fast_exp(float x) { return __builtin_amdgcn_exp2f(x * 1.4426950408889634f); }
__device__ __forceinline__ float fast_rcp(float x) { return __builtin_amdgcn_rcpf(x); }
__device__ __forceinline__ float sigmoidf_(float x) { return fast_rcp(1.0f + fast_exp(-x)); }
__device__ __forceinline__ float siluf_(float x) { return x * sigmoidf_(x); }
template <int CTRL> __device__ __forceinline__ float dppf(float v) { return __builtin_bit_cast(float, __builtin_amdgcn_mov_dpp(__builtin_bit_cast(int, v), CTRL, 0xF, 0xF, true)); }
template <int CTRL> __device__ __forceinline__ int dppi(int v) { return __builtin_amdgcn_mov_dpp(v, CTRL, 0xF, 0xF, true); }
__device__ __forceinline__ float rdl(float v, int l) { return __builtin_bit_cast(float, __builtin_amdgcn_readlane(__builtin_bit_cast(int, v), l)); }
__device__ __forceinline__ float wave_sum(float v) {
    v += dppf<0xB1>(v); v += dppf<0x4E>(v); v += dppf<0x141>(v); v += dppf<0x140>(v);
    return (rdl(v, 0) + rdl(v, 16)) + (rdl(v, 32) + rdl(v, 48));
}
__device__ __forceinline__ float wave_max(float v) {
    v = fmaxf(v, dppf<0xB1>(v)); v = fmaxf(v, dppf<0x4E>(v)); v = fmaxf(v, dppf<0x141>(v)); v = fmaxf(v, dppf<0x140>(v));
    return fmaxf(fmaxf(rdl(v, 0), rdl(v, 16)), fmaxf(rdl(v, 32), rdl(v, 48)));
}
__device__ __forceinline__ int wave_sum_i(int v) {
    v += dppi<0xB1>(v); v += dppi<0x4E>(v); v += dppi<0x141>(v); v += dppi<0x140>(v);
    return (__builtin_amdgcn_readlane(v, 0) + __builtin_amdgcn_readlane(v, 16)) + (__builtin_amdgcn_readlane(v, 32) + __builtin_amdgcn_readlane(v, 48));
}

constexpr int NWAVES = 8, NTHR = 512;
constexpr int SEQ = 16384, DM = 2048, NH = 8, HD = 128, HW = 1024;
constexpr int CK = 64, NCHUNK = SEQ / CK, NSEG = 16, CPS = NCHUNK / NSEG;
constexpr int INW = 13344;
constexpr int N1 = 9216;
constexpr float EPS = 1e-6f;
constexpr int PEER_K = 16;

constexpr size_t MiB = (size_t)1 << 20;
constexpr size_t WS_CTL = 0, CTL_ZERO_BYTES = 1 * MiB;
constexpr size_t WS_WG = 2 * MiB, WS_WPA = 18 * MiB, WS_WPB = 22 * MiB, WS_WOUT = 26 * MiB, WS_WS = 34 * MiB, WS_W1 = 42 * MiB;
constexpr size_t WS_XN = 80 * MiB;
constexpr size_t WS_H = 144 * MiB;
constexpr size_t WS_GAB = 432 * MiB;
constexpr size_t WS_HL = 434 * MiB;
constexpr size_t WS_HDS = 450 * MiB;
constexpr size_t WS_OHF = 452 * MiB, WS_OHB = 484 * MiB;
constexpr size_t WS_GSC = 516 * MiB;
constexpr size_t WS_UTF = 144 * MiB, WS_UTB = 176 * MiB, WS_WF = 208 * MiB, WS_WB = 240 * MiB;
constexpr size_t DO_AQKF = 0, DO_AQKB = 16 * MiB, DO_QN = 32 * MiB, DO_KNT = 64 * MiB;
constexpr size_t WS_GL = 42 * MiB, WS_GP = 58 * MiB;
constexpr size_t WS_OGF = 304 * MiB, WS_OGB = 336 * MiB;
constexpr size_t WS_YA = 42 * MiB, WS_YB = 368 * MiB;
constexpr size_t WS_TU = 144 * MiB, WS_TV = 176 * MiB;
constexpr size_t WS_PSC = 520 * MiB;
constexpr size_t WS_GT = 272 * MiB, WS_GT2 = 400 * MiB;
constexpr size_t WS_X1B = 400 * MiB;
constexpr size_t WS_SC = 272 * MiB;
constexpr size_t WS_END = 536 * MiB;
#ifndef QM_G1_
#define QM_G1_ 2
#endif
#ifndef QM_GATE_
#define QM_GATE_ 2
#endif
#ifndef QM_MIX_
#define QM_MIX_ 2
#endif
#ifndef QM_OUT_
#define QM_OUT_ 0
#endif
constexpr int QM_G1 = QM_G1_, QM_GATE = QM_GATE_, QM_MIX = QM_MIX_, QM_OUT = QM_OUT_;
constexpr int QM_XN = QM_G1 ? QM_G1 : QM_GATE;
static_assert(QM_G1 == 0 || QM_GATE == 0 || QM_G1 == QM_GATE, "xn has one 8-bit copy");
static_assert(QM_OUT != 2, "merged has no row scale");
constexpr float F8_WSCALE = 128.0f;
constexpr size_t WS_WAB = 78 * MiB;
constexpr size_t DO_XN8 = 96 * MiB;
constexpr size_t WS_GT8 = 336 * MiB;
constexpr size_t WS_QW = 521 * MiB;
constexpr int QW_W1 = 0, QW_WG = 9216, QW_WPA = 13312, QW_WPB = 15360, QW_WOUT = 17408, QW_WAB = 19456;
constexpr bool AB_I8 = QM_XN == 2;
constexpr bool XN_BF16 = QM_G1 == 0 || QM_GATE == 0 || !AB_I8;
constexpr size_t WS_QX = 522 * MiB;
constexpr int CW_BAR = 4096;

constexpr int LDS_BYTES = 163840;
constexpr int MISC_OFF = 163840 - 256;
constexpr int LDS_USABLE = MISC_OFF;

__device__ __forceinline__ bf16x8 ldfrag(const LAS bf16* T, int pitch, int row, int k) { return *(const LAS bf16x8*)(T + row * pitch + k); }
__device__ __forceinline__ f32x4 mfma16(bf16x8 x, bf16x8 y, f32x4 c) { return __builtin_amdgcn_mfma_f32_16x16x32_bf16(x, y, c, 0, 0, 0); }
__device__ __forceinline__ v2u pack4(f32x4 v) { v2u r; r.x = pk2(v[0], v[1]); r.y = pk2(v[2], v[3]); return r; }
#define XB_TMO      128
#define XB_XCNT(j)  (256  + 64 * (j))
#define XB_XSUB(j)  (1280 + 64 * (j))
#define XB_XGEN(j)  (2304 + 64 * (j))
#define XB_TOP      3328
#define XB_TOPGEN   3392
#define XCD_BAR_WORDS 3456
#define XB_SPIN_CAP (1u << 18)

__device__ __forceinline__ unsigned xb_ld(unsigned* p)              { return __hip_atomic_load(p, __ATOMIC_RELAXED, __HIP_MEMORY_SCOPE_AGENT); }
__device__ __forceinline__ unsigned xb_add(unsigned* p, unsigned v) { return __hip_atomic_fetch_add(p, v, __ATOMIC_RELAXED, __HIP_MEMORY_SCOPE_AGENT); }
__device__ __forceinline__ unsigned xb_xcc_id() { return (unsigned)__builtin_amdgcn_s_getreg((3 << 11) | 20) & 0xFu; }
#define XB_SPIN(cond, bar) do { unsigned _sp = 0; while (cond) { __builtin_amdgcn_s_sleep(1); \
    if ((++_sp & 255u) == 0u) { if (xb_ld(&(bar)[XB_TMO])) break; if (_sp > XB_SPIN_CAP) { atomicAdd(&(bar)[XB_TMO], 1u); break; } } } } while (0)

struct XcdBarrier {
    unsigned* bar; unsigned x;
    volatile LAS unsigned* st;
};

__device__ __forceinline__ XcdBarrier xcd_barrier_post(unsigned* bar, volatile LAS unsigned* st) {
    XcdBarrier b; b.bar = bar; b.x = xb_xcc_id(); b.st = st;
    if (threadIdx.x == 0) (void)xb_add(&bar[XB_XCNT(b.x)], 1u);
    return b;
}
__device__ __forceinline__ void xcd_barrier_complete(unsigned* bar, unsigned x, unsigned& nloc, unsigned& nx) {
    const unsigned G = gridDim.x * gridDim.y * gridDim.z;
    unsigned sum, cnt, mine, sp = 0u;
    for (;;) {
        sum = 0u; cnt = 0u; mine = 0u;
#pragma unroll
        for (unsigned j = 0; j < 16; ++j) { const unsigned c = xb_ld(&bar[XB_XCNT(j)]); sum += c; cnt += (c > 0u) ? 1u : 0u; mine = (j == x) ? c : mine; }
        if (sum == G) break;
        __builtin_amdgcn_s_sleep(1);
        if ((++sp & 255u) == 0u) { if (xb_ld(&bar[XB_TMO])) break; if (sp > XB_SPIN_CAP) { atomicAdd(&bar[XB_TMO], 1u); break; } }
    }
    nloc = mine > 0u ? mine : 1u; nx = cnt > 0u ? cnt : 1u;
}

__device__ __forceinline__ void xcd_barrier(const XcdBarrier& b) {
    asm volatile("s_waitcnt vmcnt(0)" ::: "memory");
    __syncthreads();
    if (threadIdx.x == 0) {
        unsigned* bar = b.bar;
        __builtin_amdgcn_s_waitcnt(0);
        unsigned nloc = b.st[0], nx = b.st[1];
        if (nloc == 0u) { xcd_barrier_complete(bar, b.x, nloc, nx); b.st[0] = nloc; b.st[1] = nx; }
        const unsigned old = xb_add(&bar[XB_XSUB(b.x)], 1u);
        const unsigned gen = old / nloc;
        if (old + 1u == (gen + 1u) * nloc) {
            __builtin_amdgcn_fence(__ATOMIC_RELEASE, "agent");
            asm volatile("s_waitcnt vmcnt(0)" ::: "memory");
            const unsigned og = xb_add(&bar[XB_TOP], 1u);
            const unsigned tg = og / nx;
            if (og + 1u == (tg + 1u) * nx) xb_add(&bar[XB_TOPGEN], 1u);
            else XB_SPIN(xb_ld(&bar[XB_TOPGEN]) == tg, bar);
            __builtin_amdgcn_fence(__ATOMIC_ACQUIRE, "agent");
            xb_add(&bar[XB_XGEN(b.x)], 1u);
            asm volatile("s_waitcnt vmcnt(0)" ::: "memory");
        } else {
            XB_SPIN(xb_ld(&bar[XB_XGEN(b.x)]) == gen, bar);
            __builtin_amdgcn_fence(__ATOMIC_ACQUIRE, "agent");
            asm volatile("s_waitcnt vmcnt(0)" ::: "memory");
        }
    }
    __syncthreads();
}

struct Frame {
    LAS unsigned char* lds;
    volatile LAS unsigned* MISC;
    gu32* ctl;
    int tid, lane, wave, vcu, G;
    const float* in[19]; float* out; unsigned char* ws;
};
enum { I_X = 0, I_N1W, I_WIN, I_LB, I_HNW, I_CONVW, I_ALOG, I_DTB, I_GNW, I_WPA, I_WPB, I_WOUT, I_N2W, I_WQ, I_K1, I_K2, I_PU, I_PV, I_FNW };

template <bool F8>
__device__ __forceinline__ void p0_transpose_item(const float* W, int ldw, int c0, int K, int ncols, void* WTv, int row_off, LAS float* scr, int item, int lane) {
    const int nblk = ncols / 32, kb = item / nblk, nb = item % nblk, k0 = 64 * kb, n0 = 32 * nb;
#pragma unroll 8
    for (int i = 0; i < 32; ++i) { const int kk = 2 * i + (lane >> 5); scr[kk * 33 + (lane & 31)] = W[(size_t)(k0 + kk) * ldw + c0 + n0 + (lane & 31)]; }
    LDS_WAIT(); asm volatile("" ::: "memory");
    const int c = lane & 7;
#pragma unroll
    for (int j = 0; j < 4; ++j) { const int n = (lane >> 3) + 8 * j; const LAS float* s = scr + (8 * c) * 33 + n;
        if (F8) { v2u o; o.x = pk4f8(s[0 * 33] * F8_WSCALE, s[1 * 33] * F8_WSCALE, s[2 * 33] * F8_WSCALE, s[3 * 33] * F8_WSCALE); o.y = pk4f8(s[4 * 33] * F8_WSCALE, s[5 * 33] * F8_WSCALE, s[6 * 33] * F8_WSCALE, s[7 * 33] * F8_WSCALE);
            *(GAS v2u*)((unsigned char*)WTv + (size_t)(row_off + n0 + n) * K + k0 + 8 * c) = o; }
        else { v4u o; o.x = pk2(s[0 * 33], s[1 * 33]); o.y = pk2(s[2 * 33], s[3 * 33]); o.z = pk2(s[4 * 33], s[5 * 33]); o.w = pk2(s[6 * 33], s[7 * 33]);
            *(GAS v4u*)((bf16*)WTv + (size_t)(row_off + n0 + n) * K + k0 + 8 * c) = o; } }
    LDS_WAIT(); asm volatile("" ::: "memory");
}
__device__ __forceinline__ unsigned pk4i8(f32x4 v, float inv) {
    const int a = (int)rintf(v.x * inv), b = (int)rintf(v.y * inv), c = (int)rintf(v.z * inv), d = (int)rintf(v.w * inv);
    return (unsigned)(a & 255) | ((unsigned)(b & 255) << 8) | ((unsigned)(c & 255) << 16) | ((unsigned)d << 24);
}
__device__ __forceinline__ float amax4(f32x4 v) { const f32x4 a = __builtin_elementwise_abs(v); return fmaxf(fmaxf(a.x, a.y), fmaxf(a.z, a.w)); }
__device__ __forceinline__ void rms_row_to_bf16(int lane, const float* xrow, const float* w, bf16* orow, unsigned char* orow8, float* sx) {
    const GAS f32x4* xr = (const GAS f32x4*)xrow + lane; const GAS f32x4* wr = (const GAS f32x4*)w + lane;
    f32x4 v[8]; float s = 0.f;
#pragma unroll
    for (int j = 0; j < 8; ++j) { v[j] = xr[64 * j]; s += (v[j].x * v[j].x + v[j].y * v[j].y) + (v[j].z * v[j].z + v[j].w * v[j].w); }
    const float r = 1.0f / sqrtf(wave_sum(s) * (1.f / DM) + EPS);
    GAS v2u* o8 = (GAS v2u*)orow + lane; GAS unsigned* q8 = (GAS unsigned*)orow8 + lane; float am = 0.f;
#pragma unroll
    for (int j = 0; j < 8; ++j) { const f32x4 ww = wr[64 * j]; const f32x4 y = {v[j].x * r * ww.x, v[j].y * r * ww.y, v[j].z * r * ww.z, v[j].w * r * ww.w};
        if (XN_BF16) { v2u o; o.x = pk2(y.x, y.y); o.y = pk2(y.z, y.w); o8[64 * j] = o; }
        if (QM_XN == 1) q8[64 * j] = pk4f8(y.x, y.y, y.z, y.w);
        if (QM_XN == 2) { v[j] = y; am = fmaxf(am, amax4(y)); } }
    if (QM_XN == 2) { am = wave_max(am); const float inv = am > 0.f ? 127.0f / am : 0.f;
#pragma unroll
        for (int j = 0; j < 8; ++j) q8[64 * j] = pk4i8(v[j], inv);
        if (lane == 0) *sx = am > 0.f ? am * (1.0f / 127.0f) : 1.0f; }
}
template <int KT>
__device__ __forceinline__ void p0_quant_item(Frame& F, const float* W, int ldw, int c0, signed char* Wq, float* scl, int n0) {
    constexpr int KW = KT / 8, NB = KW / 64;
    const int col = F.lane & 31, kh = F.lane >> 5;
    const GAS float* src = (const GAS float*)W + (size_t)(F.wave * KW + 32 * kh) * ldw + c0 + n0 + col;
    float v[NB][32]; float mx = 0.f;
#pragma unroll
    for (int b = 0; b < NB; ++b)
#pragma unroll
        for (int i = 0; i < 32; ++i) v[b][i] = src[(size_t)(64 * b + i) * ldw];
#pragma unroll
    for (int b = 0; b < NB; ++b)
#pragma unroll
        for (int i = 0; i < 32; ++i) mx = fmaxf(mx, fabsf(v[b][i]));
    mx = fmaxf(mx, __shfl_xor(mx, 32));
    LAS float* part = (LAS float*)F.lds;
    if (kh == 0) part[F.wave * 32 + col] = mx;
    __syncthreads();
    float cm = part[col];
#pragma unroll
    for (int w = 1; w < 8; ++w) cm = fmaxf(cm, part[w * 32 + col]);
    const float inv = cm > 0.f ? 127.0f / cm : 0.f;
    if (F.wave == 0 && kh == 0) scl[n0 + col] = cm > 0.f ? cm * (1.0f / 127.0f) : 1.0f;
    GAS v4u* dst = (GAS v4u*)(Wq + (size_t)(n0 + col) * KT + F.wave * KW + 32 * kh);
#pragma unroll
    for (int b = 0; b < NB; ++b) { unsigned w[8];
#pragma unroll
        for (int q = 0; q < 8; ++q) w[q] = pk4i8((f32x4){v[b][4 * q], v[b][4 * q + 1], v[b][4 * q + 2], v[b][4 * q + 3]}, inv);
        dst[4 * b] = (v4u){w[0], w[1], w[2], w[3]}; dst[4 * b + 1] = (v4u){w[4], w[5], w[6], w[7]}; }
    __syncthreads();
}
__device__ __forceinline__ void p0_ws_item(Frame& F, int it) {
    const int h = it >> 6, half = (it >> 5) & 1, j0 = (it & 31) * 64, hc = h * 256 + half * 128;
    const float* Wq = F.in[I_WQ]; const float* Ks = half ? F.in[I_K2] : F.in[I_K1]; const float* n2 = F.in[I_N2W];
    LAS bf16* Xs = (LAS bf16*)F.lds; LAS bf16* Ys = Xs + 64 * 136;
    { const int row = F.tid >> 3, c0 = (F.tid & 7) * 16; const GAS f32x4* src = (const GAS f32x4*)(Wq + (size_t)(j0 + row) * DM + hc + c0);
      const f32x4 a = src[0], b = src[1], c = src[2], d = src[3];
      v4u o0, o1; o0.x = pk2(a.x, a.y); o0.y = pk2(a.z, a.w); o0.z = pk2(b.x, b.y); o0.w = pk2(b.z, b.w); o1.x = pk2(c.x, c.y); o1.y = pk2(c.z, c.w); o1.z = pk2(d.x, d.y); o1.w = pk2(d.z, d.w);
      *(LAS v4u*)(Xs + row * 136 + c0) = o0; *(LAS v4u*)(Xs + row * 136 + c0 + 8) = o1; }
    { const int row = F.tid >> 2, c0 = (F.tid & 3) * 32; const GAS f32x4* src = (const GAS f32x4*)(Ks + (size_t)row * 128 + c0);
#pragma unroll
      for (int q = 0; q < 4; ++q) { const f32x4 a = src[2 * q], b = src[2 * q + 1]; v4u o; o.x = pk2(a.x, a.y); o.y = pk2(a.z, a.w); o.z = pk2(b.x, b.y); o.w = pk2(b.z, b.w); *(LAS v4u*)(Ys + row * 136 + c0 + 8 * q) = o; } }
    __syncthreads();
    const int fr = F.lane & 15, fq = F.lane >> 4, w = F.wave;
    bf16* WSt = (bf16*)(F.ws + WS_WS);
#pragma unroll
    for (int jt = 0; jt < 4; ++jt) {
        f32x4 acc = {0.f, 0.f, 0.f, 0.f};
#pragma unroll
        for (int k0 = 0; k0 < 4; ++k0) acc = mfma16(ldfrag(Xs, 136, 16 * jt + fr, 32 * k0 + 8 * fq), ldfrag(Ys, 136, 16 * w + fr, 32 * k0 + 8 * fq), acc);
        const int jj = j0 + 16 * jt + 4 * fq; const f32x4 nw = *(const GAS f32x4*)(n2 + jj);
        *(GAS v2u*)(WSt + (size_t)(hc + 16 * w + fr) * DM + jj) = pack4(acc * nw);
    }
    __syncthreads();
}
__device__ __forceinline__ void p0_prologue(Frame& F) {
    LAS float* scr = (LAS float*)(F.lds + F.wave * 16384);
    const int gw = F.vcu * NWAVES + F.wave, NGW = F.G * NWAVES;
    constexpr int I_1 = QM_G1 == 2 ? 0 : (DM / 64) * (N1 / 32), I_AB = AB_I8 ? 0 : (DM / 64), I_G = QM_GATE == 2 ? 0 : (DM / 64) * (4096 / 32), I_PA = QM_MIX == 2 ? 0 : (HW / 64) * (DM / 32), I_O = QM_OUT == 2 ? 0 : (DM / 64) * (DM / 32);
    constexpr int NITEMS = I_1 + I_AB + I_G + 2 * I_PA + I_O;
    for (int it = gw; it < NITEMS; it += NGW) {
        int r = it;
        if (r < I_1) { p0_transpose_item<QM_G1 == 1>(F.in[I_WIN], INW, 0, DM, N1, F.ws + WS_W1, 0, scr, r, F.lane); continue; } r -= I_1;
        if (r < I_AB) { p0_transpose_item<false>(F.in[I_WIN], INW, N1, DM, 32, F.ws + WS_WAB, 0, scr, r, F.lane); continue; } r -= I_AB;
        if (r < I_G) { p0_transpose_item<QM_GATE == 1>(F.in[I_WIN], INW, 9248, DM, 4096, F.ws + WS_WG, 0, scr, r, F.lane); continue; } r -= I_G;
        if (r < I_PA) { p0_transpose_item<QM_MIX == 1>(F.in[I_WPA], DM, 0, HW, DM, F.ws + WS_WPA, 0, scr, r, F.lane); continue; } r -= I_PA;
        if (r < I_PA) { p0_transpose_item<QM_MIX == 1>(F.in[I_WPB], DM, 0, HW, DM, F.ws + WS_WPB, 0, scr, r, F.lane); continue; } r -= I_PA;
        p0_transpose_item<QM_OUT == 1>(F.in[I_WOUT], DM, 0, DM, DM, F.ws + WS_WOUT, 0, scr, r, F.lane);
    }
    bf16* XN = (bf16*)(F.ws + WS_XN); float* QX = (float*)(F.ws + WS_QX);
    for (int m = gw; m < SEQ; m += NGW) rms_row_to_bf16(F.lane, F.in[I_X] + (size_t)m * DM, F.in[I_N1W], XN + (size_t)m * DM, (unsigned char*)F.out + DO_XN8 + (size_t)m * DM, QX + m);
    __syncthreads();
    { constexpr int J_1 = (QM_G1 == 2 ? N1 / 32 : 0) + (AB_I8 ? 1 : 0), J_G = QM_GATE == 2 ? 4096 / 32 : 0, J_O = QM_OUT == 2 ? DM / 32 : 0, J_P = QM_MIX == 2 ? DM / 32 : 0;
      float* QW = (float*)(F.ws + WS_QW);
#pragma unroll 1
      for (int it = F.vcu; it < J_1 + J_G + J_O + 2 * J_P; it += F.G) {
          int r = it; const float* W = F.in[I_WIN]; int ldw = INW, c0 = 0, n0 = 0, qo = QW_W1; size_t wo = WS_W1; bool half = false;
          if (r < J_1) { n0 = 32 * r; if (AB_I8 && r == J_1 - 1) { c0 = N1; n0 = 0; qo = QW_WAB; wo = WS_WAB; } }
          else if ((r -= J_1) < J_G) { c0 = 9248; n0 = 32 * r; qo = QW_WG; wo = WS_WG; }
          else if ((r -= J_G) < J_O) { W = F.in[I_WOUT]; ldw = DM; n0 = 32 * r; qo = QW_WOUT; wo = WS_WOUT; }
          else if ((r -= J_O) < J_P) { W = F.in[I_WPA]; ldw = DM; n0 = 32 * r; qo = QW_WPA; wo = WS_WPA; half = true; }
          else { r -= J_P; W = F.in[I_WPB]; ldw = DM; n0 = 32 * r; qo = QW_WPB; wo = WS_WPB; half = true; }
          if (half) p0_quant_item<HW>(F, W, ldw, c0, (signed char*)(F.ws + wo), QW + qo, n0);
          else p0_quant_item<DM>(F, W, ldw, c0, (signed char*)(F.ws + wo), QW + qo, n0);
      } }
    __syncthreads();
    for (int it = blockIdx.x; it < 512; it += F.G) p0_ws_item(F, it);
}
typedef unsigned u32x4 __attribute__((ext_vector_type(4)));
__device__ __forceinline__ u32x4 pack8(f32x4 a, f32x4 b) { u32x4 w; w.x = pk2(a[0], a[1]); w.y = pk2(a[2], a[3]); w.z = pk2(b[0], b[1]); w.w = pk2(b[2], b[3]); return w; }
__device__ __forceinline__ void unpack8(u32x4 w, f32x4& a, f32x4& b) { a = (f32x4){bflo(w.x), bfhi(w.x), bflo(w.y), bfhi(w.y)}; b = (f32x4){bflo(w.z), bfhi(w.z), bflo(w.w), bfhi(w.w)}; }
__device__ __forceinline__ f32x4 silu4(f32x4 v) { return (f32x4){siluf_(v[0]), siluf_(v[1]), siluf_(v[2]), siluf_(v[3])}; }
__device__ __forceinline__ f32x4 sigm4(f32x4 v) { return (f32x4){sigmoidf_(v[0]), sigmoidf_(v[1]), sigmoidf_(v[2]), sigmoidf_(v[3])}; }

typedef int i32x4 __attribute__((ext_vector_type(4)));
template <int QM> __device__ __forceinline__ f32x4 deq(f32x4 a, float sr, f32x4 sc) {
    if (QM == 2) { const i32x4 q = __builtin_bit_cast(i32x4, a); return (f32x4){(float)q[0], (float)q[1], (float)q[2], (float)q[3]} * (sc * sr); }
    if (QM == 1) return a * (1.0f / F8_WSCALE);
    return a;
}
template <int QM, bool PERM> __device__ __forceinline__ void ld_colscale(f32x4 (&scv)[2][2], const float* sb, int cb) {
#pragma unroll
    for (int bj = 0; bj < 2; ++bj)
#pragma unroll
        for (int n = 0; n < 2; ++n) scv[bj][n] = (QM == 2) ? *(const f32x4*)(sb + cb + bj * 128 + (PERM ? 4 : 16) * n) : (f32x4){1.f, 1.f, 1.f, 1.f};
}
__device__ __forceinline__ unsigned pk4u8(f32x4 v) { const unsigned a = (unsigned)(v[0] * 255.f + 0.5f), b = (unsigned)(v[1] * 255.f + 0.5f), c = (unsigned)(v[2] * 255.f + 0.5f), d = (unsigned)(v[3] * 255.f + 0.5f); return a | (b << 8) | (c << 16) | (d << 24); }
__device__ __forceinline__ f32x4 un4u8(unsigned w) { return (f32x4){cvt_ub0(w), cvt_ub1(w), cvt_ub2(w), cvt_ub3(w)} * (1.0f / 255.f); }
struct EpiG1 {
    static constexpr bool PERM = true, AFTER_DRAIN = false;
    unsigned char* ws; const float* lbl;
    const float* sa; const float* sb;
    __device__ __forceinline__ void operator()(const f32x4 (&acc)[2][2][4][2], const pg8::Unit& u, int wr, int wc, int fr, int fq) const {
        const int pn = u.pn, row0 = u.pm * 256 + wr * 64 + fr;
        {
            const int grp = pn >> 2; const bool act = (grp == 0) | (grp == 4) | (grp == 8);
            bf16* base = (bf16*)(ws + WS_H + (size_t)grp * 32 * MiB); const int col0 = (pn & 3) * 256 + wc * 32 + 8 * fq;
            f32x4 scv[2][2]; ld_colscale<QM_G1, true>(scv, sb, pn * 256 + wc * 32 + 8 * fq);
            const bool fgate = (grp == 1) | (grp == 2); f32x4 lbv[2][2];
            if (fgate) { const float* l0 = lbl + (grp - 1) * 2048 + col0;
#pragma unroll
                for (int bj = 0; bj < 2; ++bj)
#pragma unroll
                    for (int n = 0; n < 2; ++n) { const f32x4 a0 = *(const f32x4*)(l0 + bj * 128 + 4 * n), a1 = *(const f32x4*)(l0 + 1024 + bj * 128 + 4 * n);
                        lbv[bj][n] = (f32x4){fast_rcp(1.0f + fast_exp(a1[0] - a0[0])), fast_rcp(1.0f + fast_exp(a1[1] - a0[1])), fast_rcp(1.0f + fast_exp(a1[2] - a0[2])), fast_rcp(1.0f + fast_exp(a1[3] - a0[3]))}; } }
#pragma unroll
            for (int ai = 0; ai < 2; ++ai)
#pragma unroll
                for (int m = 0; m < 4; ++m) { bf16* rowp = base + (size_t)(row0 + ai * 128 + m * 16) * HW + col0; const float sr = (QM_G1 == 2) ? sa[row0 + ai * 128 + m * 16] : 1.f;
#pragma unroll
                    for (int bj = 0; bj < 2; ++bj) { f32x4 v0 = deq<QM_G1>(acc[ai][bj][m][0], sr, scv[bj][0]), v1 = deq<QM_G1>(acc[ai][bj][m][1], sr, scv[bj][1]);
                        if (act) { v0 = silu4(v0); v1 = silu4(v1); }
                        if (fgate) { v0 = lbv[bj][0] + (1.0f - lbv[bj][0]) * sigm4(v0); v1 = lbv[bj][1] + (1.0f - lbv[bj][1]) * sigm4(v1); }
                        *(u32x4*)(rowp + bj * 128) = pack8(v0, v1); } }
        }
    }
};
struct EpiGate {
    static constexpr bool PERM = true, AFTER_DRAIN = false;
    unsigned char* O; const float* sa; const float* sb;
    __device__ __forceinline__ void operator()(const f32x4 (&acc)[2][2][4][2], const pg8::Unit& u, int wr, int wc, int fr, int fq) const {
        const int row0 = u.pm * 256 + wr * 64 + fr, col0 = u.pn * 256 + wc * 32 + 8 * fq;
        f32x4 scv[2][2]; ld_colscale<QM_GATE, true>(scv, sb, col0);
#pragma unroll
        for (int ai = 0; ai < 2; ++ai)
#pragma unroll
            for (int m = 0; m < 4; ++m) { unsigned char* rowp = O + (size_t)(row0 + ai * 128 + m * 16) * DM + col0; const float sr = (QM_GATE == 2) ? sa[row0 + ai * 128 + m * 16] : 1.f;
#pragma unroll
                for (int bj = 0; bj < 2; ++bj) { v2u w; w.x = pk4u8(sigm4(deq<QM_GATE>(acc[ai][bj][m][0], sr, scv[bj][0]))); w.y = pk4u8(sigm4(deq<QM_GATE>(acc[ai][bj][m][1], sr, scv[bj][1]))); *(v2u*)(rowp + bj * 128) = w; } }
    }
};
template <int MODE> struct EpiMix {
    static constexpr bool PERM = true, AFTER_DRAIN = false;
    bf16* O; const unsigned char* G; unsigned char* O8;
    const float* sa; const float* sb;
    __device__ __forceinline__ void operator()(const f32x4 (&acc)[2][2][4][2], const pg8::Unit& u, int wr, int wc, int fr, int fq) const {
        const int row0 = u.pm * 256 + wr * 64 + fr, col0 = u.pn * 256 + wc * 32 + 8 * fq;
        f32x4 scv[2][2]; ld_colscale<QM_MIX, true>(scv, sb, col0);
#pragma unroll
        for (int ai = 0; ai < 2; ++ai)
#pragma unroll
            for (int m = 0; m < 4; ++m) { const size_t off = (size_t)(row0 + ai * 128 + m * 16) * DM + col0; const float sr = (QM_MIX == 2) ? sa[row0 + ai * 128 + m * 16] : 1.f;
#pragma unroll
                for (int bj = 0; bj < 2; ++bj) { f32x4 o0, o1; const v2u gw = *(const v2u*)(G + off + bj * 128); const f32x4 g0 = un4u8(gw.x), g1 = un4u8(gw.y);
                    const f32x4 c0 = deq<QM_MIX>(acc[ai][bj][m][0], sr, scv[bj][0]), c1 = deq<QM_MIX>(acc[ai][bj][m][1], sr, scv[bj][1]);
                    if (MODE == 0) { o0 = g0 * c0; o1 = g1 * c1; }
                    else { unpack8(*(const u32x4*)(O + off + bj * 128), o0, o1); o0 = o0 + g0 * c0; o1 = o1 + g1 * c1; }
                    if (MODE == 1 && QM_OUT == 1) { v2u w; w.x = pk4f8(o0[0], o0[1], o0[2], o0[3]); w.y = pk4f8(o1[0], o1[1], o1[2], o1[3]); *(v2u*)(O8 + off + bj * 128) = w; }
                    else *(u32x4*)(O + off + bj * 128) = pack8(o0, o1); } }
    }
};
struct EpiX1 {
    static constexpr bool PERM = false, AFTER_DRAIN = false;
    const float* x; float* out; bf16* xb;
    __device__ __forceinline__ void operator()(const f32x4 (&acc)[2][2][4][2], const pg8::Unit& u, int wr, int wc, int fr, int fq) const {
        const int row0 = u.pm * 256 + wr * 64 + fr, col0 = u.pn * 256 + wc * 32 + 4 * fq;
#pragma unroll
        for (int ai = 0; ai < 2; ++ai)
#pragma unroll
            for (int m = 0; m < 4; ++m) { const size_t off = (size_t)(row0 + ai * 128 + m * 16) * DM + col0;
#pragma unroll
                for (int bj = 0; bj < 2; ++bj)
#pragma unroll
                    for (int n = 0; n < 2; ++n) { const size_t o = off + bj * 128 + n * 16; const f32x4 v = *(const f32x4*)(x + o) + deq<QM_OUT>(acc[ai][bj][m][n], 1.f, (f32x4){1.f, 1.f, 1.f, 1.f});
                        *(v2u*)(xb + o) = pack4(v); } }
    }
};
struct EpiBf {
    static constexpr bool PERM = true, AFTER_DRAIN = false;
    bf16* O;
    __device__ __forceinline__ void operator()(const f32x4 (&acc)[2][2][4][2], const pg8::Unit& u, int wr, int wc, int fr, int fq) const {
        const int row0 = u.pm * 256 + wr * 64 + fr, col0 = u.pn * 256 + wc * 32 + 8 * fq;
#pragma unroll
        for (int ai = 0; ai < 2; ++ai)
#pragma unroll
            for (int m = 0; m < 4; ++m) { bf16* rowp = O + (size_t)(row0 + ai * 128 + m * 16) * DM + col0;
#pragma unroll
                for (int bj = 0; bj < 2; ++bj) *(u32x4*)(rowp + bj * 128) = pack8(acc[ai][bj][m][0], acc[ai][bj][m][1]); }
    }
};
struct EpiF32 {
    static constexpr bool PERM = false, AFTER_DRAIN = false;
    float* C;
    __device__ __forceinline__ void operator()(const f32x4 (&acc)[2][2][4][2], const pg8::Unit& u, int wr, int wc, int fr, int fq) const {
        const int row0 = u.pm * 256 + wr * 64 + fr, col0 = u.pn * 256 + wc * 32 + 4 * fq;
#pragma unroll
        for (int ai = 0; ai < 2; ++ai)
#pragma unroll
            for (int m = 0; m < 4; ++m) { float* rowp = C + (size_t)(row0 + ai * 128 + m * 16) * DM + col0;
#pragma unroll
                for (int bj = 0; bj < 2; ++bj)
#pragma unroll
                    for (int n = 0; n < 2; ++n) *(f32x4*)(rowp + bj * 128 + n * 16) = acc[ai][bj][m][n]; }
    }
};

__device__ __forceinline__ void p1_ab(Frame& F) {
    float* Gab = (float*)(F.ws + WS_GAB);
    const int fr = F.lane & 15, fq = F.lane >> 4, rt = F.wave >> 1, ct = F.wave & 1;
    if (AB_I8) {
        const signed char* XQ = (const signed char*)F.out + DO_XN8; const signed char* Wab = (const signed char*)(F.ws + WS_WAB);
        const float* QX = (const float*)(F.ws + WS_QX); const f32x4 sw = *(const f32x4*)((const float*)(F.ws + WS_QW) + QW_WAB + ct * 16 + 4 * fq);
        for (int blk = F.vcu; blk < SEQ / 64; blk += F.G) {
            const int row = blk * 64 + rt * 16 + fr;
            const signed char* ap = XQ + (size_t)row * DM + 16 * fq; const signed char* bp = Wab + (size_t)(ct * 16 + fr) * DM + 16 * fq;
            i32x4 acc = {0, 0, 0, 0};
#pragma unroll 1
            for (int kb = 0; kb < DM; kb += 1024) { i32x4 af[16], bfr[16];
#pragma unroll
                for (int u = 0; u < 16; ++u) { af[u] = *(const GAS i32x4*)(ap + kb + 64 * u); bfr[u] = *(const GAS i32x4*)(bp + kb + 64 * u); }
                __builtin_amdgcn_sched_barrier(0);
#pragma unroll
                for (int u = 0; u < 16; ++u) acc = __builtin_amdgcn_mfma_i32_16x16x64_i8(bfr[u], af[u], acc, 0, 0, 0);
                __builtin_amdgcn_sched_barrier(0); }
            *(GAS f32x4*)(Gab + (size_t)row * 32 + ct * 16 + 4 * fq) = (f32x4){(float)acc[0], (float)acc[1], (float)acc[2], (float)acc[3]} * (sw * QX[row]);
        }
        return;
    }
    const bf16* XN = (const bf16*)(F.ws + WS_XN); const bf16* Wab = (const bf16*)(F.ws + WS_WAB);
    for (int blk = F.vcu; blk < SEQ / 64; blk += F.G) {
        const bf16* ap = XN + (size_t)(blk * 64 + rt * 16 + fr) * DM + 8 * fq; const bf16* bp = Wab + (size_t)(ct * 16 + fr) * DM + 8 * fq;
        f32x4 acc = {0.f, 0.f, 0.f, 0.f};
#pragma unroll 1
        for (int kb = 0; kb < DM; kb += 512) { bf16x8 af[16], bfr[16];
#pragma unroll
            for (int u = 0; u < 16; ++u) { af[u] = *(const GAS bf16x8*)(ap + kb + 32 * u); bfr[u] = *(const GAS bf16x8*)(bp + kb + 32 * u); }
            __builtin_amdgcn_sched_barrier(0);
#pragma unroll
            for (int u = 0; u < 16; ++u) acc = mfma16(bfr[u], af[u], acc);
            __builtin_amdgcn_sched_barrier(0); }
        *(GAS f32x4*)(Gab + (size_t)(blk * 64 + rt * 16 + fr) * 32 + ct * 16 + 4 * fq) = acc;
    }
}
template <bool PASS3, int SKIP = 0>
__device__ __forceinline__ void hgrn_pass(Frame& F) {
    LAS bf16*  ST  = (LAS bf16*)(F.lds + 0);
    LAS float* LF  = (LAS float*)(F.lds + 0);
    LAS bf16*  QT  = (LAS bf16*)(F.lds + 34816);
    LAS bf16*  KT  = (LAS bf16*)(F.lds + 52224);
    LAS bf16*  KHT = (LAS bf16*)(F.lds + 69632);
    LAS bf16*  VT  = (LAS bf16*)(F.lds + 88064);
    LAS bf16*  ATT = (LAS bf16*)(F.lds + 106496);
    LAS float* PT  = (LAS float*)(F.lds + 115712);
    LAS float* BL  = (LAS float*)(F.lds + 117760);
    LAS float* DKK = (LAS float*)(F.lds + 118272);
    LAS float* LBV = (LAS float*)(F.lds + 118784);
    LAS bf16*  VR  = (LAS bf16*)(F.lds + 119296);
    const int tid = F.tid, lane = F.lane, w = F.wave, fr = lane & 15, fq = lane >> 4;
    const int row = tid >> 3, c0 = (tid & 7) * 16;
    float* HL = (float*)(F.ws + WS_HL); float* HDS = (float*)(F.ws + WS_HDS);
    for (int it = blockIdx.x; it < 256; it += F.G) {
        const int hd = it >> 4, sg = it & 15, dir = hd >> 3, h = hd & 7;
        const bf16* Hq = (const bf16*)(F.ws + WS_H); const bf16* Hf = (const bf16*)(F.ws + WS_H + (size_t)(1 + dir) * 32 * MiB); const bf16* Hi = (const bf16*)(F.ws + WS_H + (size_t)3 * 32 * MiB);
        bf16* Oh = (bf16*)(F.ws + (dir ? WS_OHB : WS_OHF));
        __syncthreads();
        f32x4 Sacc[8];
#pragma unroll
        for (int kt = 0; kt < 8; ++kt) Sacc[kt] = (f32x4){0.f, 0.f, 0.f, 0.f};
        if (PASS3) {
            for (int p = 0; p < sg; ++p) { const int ip = hd * 16 + p; f32x4 dsv[8], lv[8];
#pragma unroll
                for (int kt = 0; kt < 8; ++kt) { dsv[kt] = *(const GAS f32x4*)(HDS + ip * 128 + 16 * kt + 4 * fq); lv[kt] = *(const GAS f32x4*)(HL + ((size_t)((ip * 8 + w) * 8 + kt) * 64 + lane) * 4); }
                __builtin_amdgcn_sched_barrier(0);
#pragma unroll
                for (int kt = 0; kt < 8; ++kt) Sacc[kt] = Sacc[kt] * dsv[kt] + lv[kt];
                __builtin_amdgcn_sched_barrier(0); }
        }
        float sumbl = 1.f;
        v4u rq[2], rf[2], rv[2];
        { const int oc = dir ? 255 - sg * 16 : sg * 16; const size_t off = (size_t)(64 * oc + row) * HW + h * 128 + c0;
          rq[0] = *(const GAS v4u*)(Hq + off); rq[1] = *(const GAS v4u*)(Hq + off + 8); rf[0] = *(const GAS v4u*)(Hf + off); rf[1] = *(const GAS v4u*)(Hf + off + 8); rv[0] = *(const GAS v4u*)(Hi + off); rv[1] = *(const GAS v4u*)(Hi + off + 8); }
        __syncthreads();
        for (int ci = 0; ci < ((SKIP & 4) ? 1 : CPS); ++ci) {
            const int sc = sg * 16 + ci, oc = dir ? 255 - sc : sc, tok0 = 64 * oc;
            float kk[16], qq[16];
            { const unsigned fw[8] = {rf[0].x, rf[0].y, rf[0].z, rf[0].w, rf[1].x, rf[1].y, rf[1].z, rf[1].w};
              const unsigned qw[8] = {rq[0].x, rq[0].y, rq[0].z, rq[0].w, rq[1].x, rq[1].y, rq[1].z, rq[1].w};
              float fgv[16];
#pragma unroll
              for (int e = 0; e < 16; ++e) { fgv[e] = (e & 1) ? bfhi(fw[e >> 1]) : bflo(fw[e >> 1]); qq[e] = (e & 1) ? bfhi(qw[e >> 1]) : bflo(qw[e >> 1]); kk[e] = 1.0f - fgv[e]; }
#pragma unroll
              for (int q4 = 0; q4 < 4; ++q4) *(LAS f32x4*)(LF + row * 132 + c0 + 4 * q4) = (f32x4){fgv[4 * q4], fgv[4 * q4 + 1], fgv[4 * q4 + 2], fgv[4 * q4 + 3]};
              *(LAS v4u*)(VR + row * 136 + c0) = rv[0]; *(LAS v4u*)(VR + row * 136 + c0 + 8) = rv[1]; }
            if (ci + 1 < CPS && !(SKIP & 2)) { const int oc2 = dir ? oc - 1 : oc + 1; const size_t off = (size_t)(64 * oc2 + row) * HW + h * 128 + c0;
              rq[0] = *(const GAS v4u*)(Hq + off); rq[1] = *(const GAS v4u*)(Hq + off + 8); rf[0] = *(const GAS v4u*)(Hf + off); rf[1] = *(const GAS v4u*)(Hf + off + 8); rv[0] = *(const GAS v4u*)(Hi + off); rv[1] = *(const GAS v4u*)(Hi + off + 8); }
            if (!(SKIP & 8)) __syncthreads();
            { const int c = tid & 127, part = tid >> 7, r0 = part * 16; float b[16], fv[16]; float run = 1.f;
#pragma unroll
              for (int i = 0; i < 16; ++i) fv[i] = LF[(r0 + i) * 132 + c];
              if (!dir) {
#pragma unroll
                  for (int i = 0; i < 16; ++i) { run *= fv[i]; b[i] = run; }
              } else {
#pragma unroll
                  for (int i = 15; i >= 0; --i) { run *= fv[i]; b[i] = run; }
              }
              PT[part * 128 + c] = run;
              unsigned short vcol[16];
#pragma unroll
              for (int i = 0; i < 16; ++i) vcol[i] = VR[(r0 + i) * 136 + c];
              if (!(SKIP & 8)) __syncthreads();
              const float p0 = PT[c], p1 = PT[128 + c], p2 = PT[256 + c], p3 = PT[384 + c];
              float offs;
              if (!dir) offs = (part > 0 ? p0 : 1.f) * (part > 1 ? p1 : 1.f) * (part > 2 ? p2 : 1.f);
              else      offs = (part < 3 ? p3 : 1.f) * (part < 2 ? p2 : 1.f) * (part < 1 ? p1 : 1.f);
              const float tot = (p0 * p1) * (p2 * p3);
              unsigned kh[8], vw[8];
#pragma unroll
              for (int i = 0; i < 8; ++i) { const float P0 = b[2 * i] * offs, P1 = b[2 * i + 1] * offs;
                  if (PASS3) { LF[(r0 + 2 * i) * 132 + c] = P0; LF[(r0 + 2 * i + 1) * 132 + c] = P1; }
                  kh[i] = pk2((1.0f - fv[2 * i]) * tot * fast_rcp(P0), (1.0f - fv[2 * i + 1]) * tot * fast_rcp(P1)); vw[i] = (unsigned)vcol[2 * i] | ((unsigned)vcol[2 * i + 1] << 16); }
              *(LAS v4u*)(KHT + c * 72 + r0) = (v4u){kh[0], kh[1], kh[2], kh[3]}; *(LAS v4u*)(KHT + c * 72 + r0 + 8) = (v4u){kh[4], kh[5], kh[6], kh[7]};
              *(LAS v4u*)(VT + c * 72 + r0) = (v4u){vw[0], vw[1], vw[2], vw[3]}; *(LAS v4u*)(VT + c * 72 + r0 + 8) = (v4u){vw[4], vw[5], vw[6], vw[7]};
              if (part == 0) { DKK[c] = tot; sumbl *= tot; }
            }
            if (!(SKIP & 8)) __syncthreads();
            if (PASS3 && !(SKIP & 1)) { float bb[16];
#pragma unroll
              for (int q4 = 0; q4 < 4; ++q4) { const f32x4 t4 = *(const LAS f32x4*)(LF + row * 132 + c0 + 4 * q4); bb[4 * q4] = t4[0]; bb[4 * q4 + 1] = t4[1]; bb[4 * q4 + 2] = t4[2]; bb[4 * q4 + 3] = t4[3]; }
              unsigned qo[8], ko[8];
#pragma unroll
              for (int e = 0; e < 8; ++e) { qo[e] = pk2(qq[2 * e] * bb[2 * e], qq[2 * e + 1] * bb[2 * e + 1]); ko[e] = pk2(kk[2 * e] * fast_rcp(bb[2 * e]), kk[2 * e + 1] * fast_rcp(bb[2 * e + 1])); }
              *(LAS v4u*)(QT + row * 136 + c0) = (v4u){qo[0], qo[1], qo[2], qo[3]}; *(LAS v4u*)(QT + row * 136 + c0 + 8) = (v4u){qo[4], qo[5], qo[6], qo[7]};
              *(LAS v4u*)(KT + row * 136 + c0) = (v4u){ko[0], ko[1], ko[2], ko[3]}; *(LAS v4u*)(KT + row * 136 + c0 + 8) = (v4u){ko[4], ko[5], ko[6], ko[7]};
            }
            if (PASS3) if (!(SKIP & 8)) __syncthreads();
            if (PASS3 && !(SKIP & 1)) {
                { bf16x8 kf[2][4], qf[2][4]; f32x4 acc[2];
#pragma unroll
                  for (int q2 = 0; q2 < 2; ++q2) { const int tl = 2 * w + q2, ti = tl >> 2, tj = tl & 3; acc[q2] = (f32x4){0.f, 0.f, 0.f, 0.f};
#pragma unroll
                      for (int k0 = 0; k0 < 4; ++k0) { kf[q2][k0] = ldfrag(KT, 136, 16 * ti + fr, 32 * k0 + 8 * fq); qf[q2][k0] = ldfrag(QT, 136, 16 * tj + fr, 32 * k0 + 8 * fq); } }
                  __builtin_amdgcn_sched_barrier(0);
#pragma unroll
                  for (int k0 = 0; k0 < 4; ++k0)
#pragma unroll
                      for (int q2 = 0; q2 < 2; ++q2) acc[q2] = mfma16(kf[q2][k0], qf[q2][k0], acc[q2]);
                  __builtin_amdgcn_sched_barrier(0);
#pragma unroll
                  for (int q2 = 0; q2 < 2; ++q2) { const int tl = 2 * w + q2, ti = tl >> 2, tj = tl & 3; const int t = 16 * tj + fr, s0 = 16 * ti + 4 * fq;
#pragma unroll
                      for (int r = 0; r < 4; ++r) { const bool keep = dir ? (s0 + r >= t) : (s0 + r <= t); acc[q2][r] = keep ? acc[q2][r] : 0.f; }
                      *(LAS v2u*)(ATT + t * 72 + s0) = pack4(acc[q2]); } }
#pragma unroll
                for (int kt = 0; kt < 8; ++kt) *(LAS v2u*)(ST + (16 * w + fr) * 136 + 16 * kt + 4 * fq) = pack4(Sacc[kt]);
                if (!(SKIP & 8)) __syncthreads();
            }
            bf16x8 xv[2];
#pragma unroll
            for (int s0 = 0; s0 < 2; ++s0) xv[s0] = ldfrag(VT, 72, 16 * w + fr, 32 * s0 + 8 * fq);
            if (PASS3 && !(SKIP & 1)) {
                bf16x8 xs[4];
#pragma unroll
                for (int k0 = 0; k0 < 4; ++k0) xs[k0] = ldfrag(ST, 136, 16 * w + fr, 32 * k0 + 8 * fq);
#pragma unroll
                for (int th = 0; th < 2; ++th) { bf16x8 qf[2][4], af[2][2]; f32x4 acc[2];
#pragma unroll
                    for (int tq = 0; tq < 2; ++tq) { const int tt = 2 * th + tq; acc[tq] = (f32x4){0.f, 0.f, 0.f, 0.f};
#pragma unroll
                        for (int k0 = 0; k0 < 4; ++k0) qf[tq][k0] = ldfrag(QT, 136, 16 * tt + fr, 32 * k0 + 8 * fq);
#pragma unroll
                        for (int s0 = 0; s0 < 2; ++s0) af[tq][s0] = ldfrag(ATT, 72, 16 * tt + fr, 32 * s0 + 8 * fq); }
                    __builtin_amdgcn_sched_barrier(0);
#pragma unroll
                    for (int k0 = 0; k0 < 4; ++k0)
#pragma unroll
                        for (int tq = 0; tq < 2; ++tq) acc[tq] = mfma16(xs[k0], qf[tq][k0], acc[tq]);
#pragma unroll
                    for (int s0 = 0; s0 < 2; ++s0)
#pragma unroll
                        for (int tq = 0; tq < 2; ++tq) acc[tq] = mfma16(xv[s0], af[tq][s0], acc[tq]);
                    __builtin_amdgcn_sched_barrier(0);
#pragma unroll
                    for (int tq = 0; tq < 2; ++tq) *(GAS v2u*)(Oh + (size_t)(tok0 + 16 * (2 * th + tq) + fr) * HW + h * 128 + 16 * w + 4 * fq) = pack4(acc[tq]); }
            }
#pragma unroll
            for (int kh = 0; kh < ((SKIP & 1) ? 0 : 2); ++kh) { bf16x8 kf[4][2];
#pragma unroll
                for (int kq = 0; kq < 4; ++kq) { const int kt = 4 * kh + kq; const f32x4 d4 = *(const LAS f32x4*)(DKK + 16 * kt + 4 * fq); Sacc[kt] = Sacc[kt] * d4;
#pragma unroll
                    for (int s0 = 0; s0 < 2; ++s0) kf[kq][s0] = ldfrag(KHT, 72, 16 * kt + fr, 32 * s0 + 8 * fq); }
                __builtin_amdgcn_sched_barrier(0);
#pragma unroll
                for (int s0 = 0; s0 < 2; ++s0)
#pragma unroll
                    for (int kq = 0; kq < 4; ++kq) Sacc[4 * kh + kq] = mfma16(kf[kq][s0], xv[s0], Sacc[4 * kh + kq]);
                __builtin_amdgcn_sched_barrier(0); }
            if (!(SKIP & 8)) __syncthreads();
        }
        if (!PASS3) {
#pragma unroll
            for (int kt = 0; kt < 8; ++kt) *(GAS f32x4*)(HL + ((size_t)((it * 8 + w) * 8 + kt) * 64 + lane) * 4) = Sacc[kt];
            if (tid < 128) HDS[it * 128 + tid] = sumbl;
        }
    }
}
template <int SKIP>
__device__ __forceinline__ void gdn_prep(Frame& F) {
    LAS bf16*  QN  = (LAS bf16*)(F.lds + 0);
    LAS bf16*  KN  = (LAS bf16*)(F.lds + 17408);
    LAS bf16*  VT  = (LAS bf16*)(F.lds + 34816);
    LAS bf16*  KNT = (LAS bf16*)(F.lds + 53248);
    LAS float* AM  = (LAS float*)(F.lds + 71680);
    LAS bf16*  TB  = (LAS bf16*)(F.lds + 104448);
    LAS bf16*  VR  = (LAS bf16*)(F.lds + 104448);
    LAS float* CWL = (LAS float*)(F.lds + 142848);
    LAS float* DEC = (LAS float*)(F.lds + 141312);
    LAS float* BET = DEC + 128;
    LAS float* EXD = DEC + 256;
    const int tid = F.tid, lane = F.lane, w = F.wave, fr = lane & 15, fq = lane >> 4;
    const int row = tid >> 3, c0 = (tid & 7) * 16;
    const bf16* Gq = (const bf16*)(F.ws + WS_H + (size_t)5 * 32 * MiB); const bf16* Gk = (const bf16*)(F.ws + WS_H + (size_t)6 * 32 * MiB); const bf16* Gv = (const bf16*)(F.ws + WS_H + (size_t)7 * 32 * MiB);
    const float* Gab = (const float*)(F.ws + WS_GAB); const float* cw = F.in[I_CONVW];
    unsigned char* dob = (unsigned char*)F.out;
    bf16* QNg = (bf16*)(dob + DO_QN); bf16* KNTg = (bf16*)(dob + DO_KNT); float* GSC = (float*)(F.ws + WS_GSC);
    int hload = -1;
    for (int it = blockIdx.x; it < 2048; it += F.G) {
        const int h = it & 7, oc = it >> 3, tok0 = 64 * oc;
        __syncthreads();
        if (h != hload) { hload = h;
            for (int i = tid; i < 5 * 384; i += NTHR) { const int j = i / 384, r = i % 384; CWL[i] = cw[j * 3072 + (r >> 7) * 1024 + h * 128 + (r & 127)]; }
            __syncthreads(); }
        if (it + F.G < 2048 && tid < 408) { const int it2 = it + F.G, h2 = it2 & 7, oc2 = it2 >> 3; const int tz = tid / 136, rl = tid % 136, r = rl >> 1, half = rl & 1; const int tr = 64 * oc2 - 2 + r;
            if (tr >= 0 && tr < SEQ) { const bf16* src = (tz == 0 ? Gq : tz == 1 ? Gk : Gv) + (size_t)tr * HW + h2 * 128 + half * 64; unsigned tmp = *(const GAS unsigned*)src; asm volatile("" :: "v"(tmp)); } }
        if (tid < 128) { const int dir = tid >> 6, l = tid & 63, pos = dir ? 63 - l : l;
            const float a = Gab[(size_t)(tok0 + pos) * 32 + dir * 8 + h], b = Gab[(size_t)(tok0 + pos) * 32 + 16 + dir * 8 + h];
            const float x = a + F.in[I_DTB][dir * 8 + h]; const float sp = x > 20.f ? x : log1pf(__expf(x));
            float d = -__expf(F.in[I_ALOG][dir * 8 + h]) * sp;
#pragma unroll
            for (int o = 1; o < 64; o <<= 1) { const float t = __shfl_up(d, o); if (l >= o) d += t; }
            DEC[dir * 64 + pos] = d; BET[dir * 64 + pos] = sigmoidf_(b); EXD[dir * 64 + pos] = __expf(d); }
        if (!(SKIP & 64)) { float q[16], k[16], v[16];
#pragma unroll
          for (int e = 0; e < 16; ++e) { q[e] = 0.f; k[e] = 0.f; v[e] = 0.f; }
          const int ch = h * 128 + c0;
#pragma unroll
          for (int j = 0; j < ((SKIP & 1) ? 0 : 5); ++j) { const int tr = tok0 + row + j - 2;
              if (tr >= 0 && tr < SEQ) { const size_t off = (size_t)tr * HW + ch;
                  const v4u xq0 = *(const GAS v4u*)(Gq + off), xq1 = *(const GAS v4u*)(Gq + off + 8), xk0 = *(const GAS v4u*)(Gk + off), xk1 = *(const GAS v4u*)(Gk + off + 8), xv0 = *(const GAS v4u*)(Gv + off), xv1 = *(const GAS v4u*)(Gv + off + 8);
                  const unsigned wq[8] = {xq0.x, xq0.y, xq0.z, xq0.w, xq1.x, xq1.y, xq1.z, xq1.w}, wk[8] = {xk0.x, xk0.y, xk0.z, xk0.w, xk1.x, xk1.y, xk1.z, xk1.w}, wv[8] = {xv0.x, xv0.y, xv0.z, xv0.w, xv1.x, xv1.y, xv1.z, xv1.w};
                  const LAS float* cq = CWL + j * 384 + c0;
#pragma unroll
                  for (int e = 0; e < 16; ++e) { const float fq_ = (e & 1) ? bfhi(wq[e >> 1]) : bflo(wq[e >> 1]), fk_ = (e & 1) ? bfhi(wk[e >> 1]) : bflo(wk[e >> 1]), fv_ = (e & 1) ? bfhi(wv[e >> 1]) : bflo(wv[e >> 1]);
                      q[e] += cq[e] * fq_; k[e] += cq[128 + e] * fk_; v[e] += cq[256 + e] * fv_; } } }
          float sq = 0.f, sk = 0.f;
#pragma unroll
          for (int e = 0; e < 16; ++e) { q[e] = siluf_(q[e]); k[e] = siluf_(k[e]); v[e] = siluf_(v[e]); sq += q[e] * q[e]; sk += k[e] * k[e]; }
          sq += __shfl_xor(sq, 1); sq += __shfl_xor(sq, 2); sq += __shfl_xor(sq, 4); sk += __shfl_xor(sk, 1); sk += __shfl_xor(sk, 2); sk += __shfl_xor(sk, 4);
          const float rq = 0.08838834764831845f / sqrtf(sq + EPS), rk = 1.0f / sqrtf(sk + EPS);
          unsigned qo[8], ko[8];
#pragma unroll
          for (int e = 0; e < 8; ++e) { qo[e] = pk2(q[2 * e] * rq, q[2 * e + 1] * rq); ko[e] = pk2(k[2 * e] * rk, k[2 * e + 1] * rk); }
          const v4u q0 = {qo[0], qo[1], qo[2], qo[3]}, q1 = {qo[4], qo[5], qo[6], qo[7]}, k0_ = {ko[0], ko[1], ko[2], ko[3]}, k1_ = {ko[4], ko[5], ko[6], ko[7]};
          *(LAS v4u*)(QN + row * 136 + c0) = q0; *(LAS v4u*)(QN + row * 136 + c0 + 8) = q1; *(LAS v4u*)(KN + row * 136 + c0) = k0_; *(LAS v4u*)(KN + row * 136 + c0 + 8) = k1_;
          if (!(SKIP & 16)) { *(GAS v4u*)(QNg + (size_t)(tok0 + row) * HW + ch) = q0; *(GAS v4u*)(QNg + (size_t)(tok0 + row) * HW + ch + 8) = q1; }
          unsigned vo[8];
#pragma unroll
          for (int e = 0; e < 8; ++e) vo[e] = pk2(v[2 * e], v[2 * e + 1]);
          *(LAS v4u*)(VR + row * 136 + c0) = (v4u){vo[0], vo[1], vo[2], vo[3]}; *(LAS v4u*)(VR + row * 136 + c0 + 8) = (v4u){vo[4], vo[5], vo[6], vo[7]};
        }
        __syncthreads();
        { const int c = tid & 127, r0 = (tid >> 7) * 16; unsigned vw[8], kw[8];
#pragma unroll
          for (int i = 0; i < 8; ++i) { vw[i] = (unsigned)VR[(r0 + 2 * i) * 136 + c] | ((unsigned)VR[(r0 + 2 * i + 1) * 136 + c] << 16); kw[i] = (unsigned)KN[(r0 + 2 * i) * 136 + c] | ((unsigned)KN[(r0 + 2 * i + 1) * 136 + c] << 16); }
          *(LAS v4u*)(VT + c * 72 + r0) = (v4u){vw[0], vw[1], vw[2], vw[3]}; *(LAS v4u*)(VT + c * 72 + r0 + 8) = (v4u){vw[4], vw[5], vw[6], vw[7]};
          *(LAS v4u*)(KNT + c * 72 + r0) = (v4u){kw[0], kw[1], kw[2], kw[3]}; *(LAS v4u*)(KNT + c * 72 + r0 + 8) = (v4u){kw[4], kw[5], kw[6], kw[7]}; }
#pragma unroll
        for (int q2 = 0; q2 < ((SKIP & 8) ? 0 : 2); ++q2) { const int tl = 2 * w + q2, ti = tl >> 2, tj = tl & 3; f32x4 kkv = {0.f, 0.f, 0.f, 0.f}, qkv = {0.f, 0.f, 0.f, 0.f};
#pragma unroll
            for (int k0 = 0; k0 < 4; ++k0) { const bf16x8 xs = ldfrag(KN, 136, 16 * ti + fr, 32 * k0 + 8 * fq);
                kkv = mfma16(xs, ldfrag(KN, 136, 16 * tj + fr, 32 * k0 + 8 * fq), kkv); qkv = mfma16(xs, ldfrag(QN, 136, 16 * tj + fr, 32 * k0 + 8 * fq), qkv); }
            const int t = 16 * tj + fr, s0 = 16 * ti + 4 * fq;
#pragma unroll
            for (int dir = 0; dir < 2; ++dir) { const float dt = DEC[dir * 64 + t], bt = BET[dir * 64 + t]; f32x4 aq;
#pragma unroll
                for (int r = 0; r < 4; ++r) { const int s = s0 + r; const bool before = dir ? (s > t) : (s < t), beq = before || (s == t);
                    const float e = beq ? __expf(dt - DEC[dir * 64 + s]) : 0.f;
                    AM[dir * 4096 + (dir ? (63 - s) * 64 + (63 - t) : s * 64 + t)] = before ? bt * kkv[r] * e : 0.f;   aq[r] = qkv[r] * e; }
                bf16* AQg = (bf16*)(dob + (dir ? DO_AQKB : DO_AQKF));
                if (!(SKIP & 16)) *(GAS v2u*)(AQg + ((size_t)(h * 256 + oc) * 64 + t) * 64 + s0) = pack4(aq); } }
        __syncthreads();
        if (SKIP & 32) {} else if (w < 2) { const int dir = w; int c = lane; asm volatile("" : "+v"(c)); const LAS float* A = AM + dir * 4096;
            float t[64];
#pragma unroll
            for (int bi = 0; bi < 4; ++bi) { float r[16];
#pragma unroll
                for (int ii = 0; ii < 16; ++ii) r[ii] = (16 * bi + ii == c) ? 1.f : 0.f;
                if (!(SKIP & 2)) {
#pragma unroll
                for (int j0 = 0; j0 < 16 * bi; j0 += 4) { f32x4 av[4][4];
#pragma unroll
                    for (int jq = 0; jq < 4; ++jq)
#pragma unroll
                        for (int q4 = 0; q4 < 4; ++q4) av[jq][q4] = *(const LAS f32x4*)(A + (j0 + jq) * 64 + 16 * bi + 4 * q4);
                    __builtin_amdgcn_sched_barrier(0);
#pragma unroll
                    for (int jq = 0; jq < 4; ++jq)
#pragma unroll
                        for (int q4 = 0; q4 < 4; ++q4) { r[4 * q4] -= av[jq][q4][0] * t[j0 + jq]; r[4 * q4 + 1] -= av[jq][q4][1] * t[j0 + jq]; r[4 * q4 + 2] -= av[jq][q4][2] * t[j0 + jq]; r[4 * q4 + 3] -= av[jq][q4][3] * t[j0 + jq]; }
                    __builtin_amdgcn_sched_barrier(0); }
#pragma unroll
                for (int jg = 0; jg < 4; ++jg) { f32x4 av[4][4];
#pragma unroll
                    for (int jq = 0; jq < 4; ++jq)
#pragma unroll
                        for (int q4 = jg; q4 < 4; ++q4) av[jq][q4] = *(const LAS f32x4*)(A + (16 * bi + 4 * jg + jq) * 64 + 16 * bi + 4 * q4);
                    __builtin_amdgcn_sched_barrier(0);
#pragma unroll
                    for (int jq = 0; jq < 4; ++jq) { const int jj = 4 * jg + jq; t[16 * bi + jj] = r[jj];
#pragma unroll
                        for (int q4 = jg; q4 < 4; ++q4)
#pragma unroll
                            for (int e = 0; e < 4; ++e) if (4 * q4 + e > jj) r[4 * q4 + e] -= av[jq][q4][e] * r[jj]; }
                    __builtin_amdgcn_sched_barrier(0); }
                } else {
#pragma unroll
                for (int jj = 0; jj < 16; ++jj) t[16 * bi + jj] = r[jj]; }
            }
            const int tc = dir ? 63 - c : c; const float bc = BET[dir * 64 + tc], bd = bc * EXD[dir * 64 + tc];
            LAS bf16* T0 = TB + (dir * 2 + 0) * 64 * 72 + tc + (dir ? 63 * 72 : 0); const int tstep = dir ? -72 : 72;
#pragma unroll
            for (int i = 0; i < 64; ++i) { T0[i * tstep] = (bf16)f2bf(t[i] * bc); T0[64 * 72 + i * tstep] = (bf16)f2bf(t[i] * bd); }
        } else {
            for (int idx = tid - 128; idx < ((SKIP & 16) ? 0 : 1024); idx += 384) { const int r = idx >> 3, c8 = idx & 7; *(GAS v4u*)(KNTg + ((size_t)(h * 256 + oc) * 128 + r) * 64 + c8 * 8) = *(const LAS v4u*)(KNT + r * 72 + c8 * 8); }
            if (tid >= 128 && tid < 256) { const int dir = (tid - 128) >> 6, t = tid & 63; const float dl = dir ? DEC[64] : DEC[63];
                float* g = GSC + (size_t)((dir * 8 + h) * 256 + oc) * 192; g[t] = EXD[dir * 64 + t]; g[64 + t] = __expf(dl - DEC[dir * 64 + t]); if (t == 0) g[128] = __expf(dl); }
        }
        __syncthreads();
#pragma unroll 1
        for (int n = 0; n < ((SKIP & 4) ? 0 : 16); ++n) { const int qi = w * 16 + n, dir = qi >> 6, kind = (qi >> 5) & 1, idx = qi & 31; f32x4 acc = {0.f, 0.f, 0.f, 0.f};
            const LAS bf16* Tm = TB + (dir * 2 + kind) * 64 * 72; const size_t cb = (size_t)(h * 256 + oc) * 8192;
            if (kind == 0) { const int ti = idx >> 3, vj = idx & 7;
#pragma unroll
                for (int s0 = 0; s0 < 2; ++s0) acc = mfma16(ldfrag(Tm, 72, 16 * ti + fr, 32 * s0 + 8 * fq), ldfrag(VT, 72, 16 * vj + fr, 32 * s0 + 8 * fq), acc);
                bf16* U = (bf16*)(F.ws + (dir ? WS_UTB : WS_UTF)); if (!(SKIP & 16)) *(GAS v2u*)(U + cb + (16 * vj + fr) * 64 + 16 * ti + 4 * fq) = pack4(acc);
            } else { const int ki = idx >> 2, tj = idx & 3;
#pragma unroll
                for (int s0 = 0; s0 < 2; ++s0) acc = mfma16(ldfrag(KNT, 72, 16 * ki + fr, 32 * s0 + 8 * fq), ldfrag(Tm, 72, 16 * tj + fr, 32 * s0 + 8 * fq), acc);
                bf16* W = (bf16*)(F.ws + (dir ? WS_WB : WS_WF)); if (!(SKIP & 16)) *(GAS v2u*)(W + cb + (16 * tj + fr) * 128 + 16 * ki + 4 * fq) = pack4(acc); }
        }
    }
}
__device__ __forceinline__ void gdn_load_tiles(const unsigned char* ws, const unsigned char* dob, int tid, int dir, int hd, int h, int oc, bool pass3, v4u (&rw)[2], v4u (&rq)[2], v4u (&ru)[2], v4u (&rk)[2], v4u& ra, float& rs) {
    const size_t cb = (size_t)(h * 256 + oc);
    const int row = tid >> 3, c0 = (tid & 7) * 16, vrow = tid >> 2, t0 = (tid & 3) * 16;
    const bf16* W = (const bf16*)(ws + (dir ? WS_WB : WS_WF)) + cb * 8192 + row * 128 + c0; rw[0] = *(const GAS v4u*)W; rw[1] = *(const GAS v4u*)(W + 8);
    const bf16* U = (const bf16*)(ws + (dir ? WS_UTB : WS_UTF)) + cb * 8192 + vrow * 64 + t0; ru[0] = *(const GAS v4u*)U; ru[1] = *(const GAS v4u*)(U + 8);
    const bf16* Kt = (const bf16*)(dob + DO_KNT) + (size_t)(h * 256 + oc) * 8192 + vrow * 64 + t0; rk[0] = *(const GAS v4u*)Kt; rk[1] = *(const GAS v4u*)(Kt + 8);
    if (pass3) {
        const bf16* Q = (const bf16*)(dob + DO_QN) + (size_t)(64 * oc + row) * HW + h * 128 + c0; rq[0] = *(const GAS v4u*)Q; rq[1] = *(const GAS v4u*)(Q + 8);
        const bf16* A = (const bf16*)(dob + (dir ? DO_AQKB : DO_AQKF)) + cb * 4096 + row * 64 + (tid & 7) * 8; ra = *(const GAS v4u*)A;
    }
    rs = (tid < 192) ? ((const float*)(ws + WS_GSC))[(size_t)(hd * 256 + oc) * 192 + tid] : 0.f;
}
#define SCHED_FENCE() __builtin_amdgcn_sched_barrier(0)
template <bool PASS3, bool UREAL>
__device__ __forceinline__ void gdn_tile(f32x4 (&A)[8], const LAS bf16* WTL, const LAS bf16* QNL, const LAS bf16* UTL, const LAS bf16* KTL, const LAS bf16* AQL, const LAS float* SCL,
                                         LAS bf16* ST, LAS bf16* VN, LAS bf16* VNS, int w, int fr, int fq, float gl, bf16* Ogc) {
#pragma unroll
    for (int kt = 0; kt < 8; ++kt) *(LAS v2u*)(ST + fr * 136 + 16 * kt + 4 * fq) = pack4(A[kt]);
    asm volatile("" ::: "memory");
    bf16x8 xs[4];
#pragma unroll
    for (int k0 = 0; k0 < 4; ++k0) xs[k0] = ldfrag(ST, 136, fr, 32 * k0 + 8 * fq);
#pragma unroll
    for (int th = 0; th < 2; ++th) { bf16x8 wf[2][4]; f32x4 acc[2]; v2u uw[2]; f32x4 es[2];
#pragma unroll
      for (int tq = 0; tq < 2; ++tq) { const int tt = 2 * th + tq;
#pragma unroll
          for (int k0 = 0; k0 < 4; ++k0) wf[tq][k0] = ldfrag(WTL, 136, 16 * tt + fr, 32 * k0 + 8 * fq);
          if (UREAL) uw[tq] = *(const LAS v2u*)(UTL + (16 * w + fr) * 72 + 16 * tt + 4 * fq);
          es[tq] = *(const LAS f32x4*)(SCL + 64 + 16 * tt + 4 * fq); acc[tq] = (f32x4){0.f, 0.f, 0.f, 0.f}; }
      SCHED_FENCE();
#pragma unroll
      for (int k0 = 0; k0 < 4; ++k0)
#pragma unroll
          for (int tq = 0; tq < 2; ++tq) acc[tq] = mfma16(wf[tq][k0], xs[k0], acc[tq]);
      SCHED_FENCE();
#pragma unroll
      for (int tq = 0; tq < 2; ++tq) { const int tt = 2 * th + tq; f32x4 u4 = {0.f, 0.f, 0.f, 0.f};
          if (UREAL) u4 = (f32x4){bflo(uw[tq].x), bfhi(uw[tq].x), bflo(uw[tq].y), bfhi(uw[tq].y)};
          const f32x4 vn = u4 - acc[tq];
          if (PASS3) *(LAS v2u*)(VN + fr * 72 + 16 * tt + 4 * fq) = pack4(vn);
          *(LAS v2u*)(VNS + fr * 72 + 16 * tt + 4 * fq) = pack4(vn * es[tq]); }
      SCHED_FENCE(); }
    asm volatile("" ::: "memory");
    if (PASS3) { bf16x8 yv[2];
#pragma unroll
        for (int s0 = 0; s0 < 2; ++s0) yv[s0] = ldfrag(VN, 72, fr, 32 * s0 + 8 * fq);
#pragma unroll
        for (int th = 0; th < 2; ++th) { bf16x8 qf[2][4], af[2][2]; f32x4 acc[2]; float ed[2];
#pragma unroll
            for (int tq = 0; tq < 2; ++tq) { const int tt = 2 * th + tq;
#pragma unroll
                for (int k0 = 0; k0 < 4; ++k0) qf[tq][k0] = ldfrag(QNL, 136, 16 * tt + fr, 32 * k0 + 8 * fq);
#pragma unroll
                for (int s0 = 0; s0 < 2; ++s0) af[tq][s0] = ldfrag(AQL, 72, 16 * tt + fr, 32 * s0 + 8 * fq);
                ed[tq] = SCL[16 * tt + fr]; acc[tq] = (f32x4){0.f, 0.f, 0.f, 0.f}; }
            SCHED_FENCE();
#pragma unroll
            for (int k0 = 0; k0 < 4; ++k0)
#pragma unroll
                for (int tq = 0; tq < 2; ++tq) acc[tq] = mfma16(xs[k0], qf[tq][k0], acc[tq]);
#pragma unroll
            for (int tq = 0; tq < 2; ++tq) acc[tq] = acc[tq] * ed[tq];
#pragma unroll
            for (int s0 = 0; s0 < 2; ++s0)
#pragma unroll
                for (int tq = 0; tq < 2; ++tq) acc[tq] = mfma16(yv[s0], af[tq][s0], acc[tq]);
            SCHED_FENCE();
#pragma unroll
            for (int tq = 0; tq < 2; ++tq) *(GAS v2u*)(Ogc + (size_t)(16 * (2 * th + tq) + fr) * HW + 16 * w + 4 * fq) = pack4(acc[tq]);
            SCHED_FENCE(); } }
    { bf16x8 ys[2];
#pragma unroll
      for (int s0 = 0; s0 < 2; ++s0) ys[s0] = ldfrag(VNS, 72, fr, 32 * s0 + 8 * fq);
#pragma unroll
      for (int kh = 0; kh < 2; ++kh) { bf16x8 kf[4][2];
#pragma unroll
          for (int kq = 0; kq < 4; ++kq)
#pragma unroll
              for (int s0 = 0; s0 < 2; ++s0) kf[kq][s0] = ldfrag(KTL, 72, 16 * (4 * kh + kq) + fr, 32 * s0 + 8 * fq);
#pragma unroll
          for (int kq = 0; kq < 4; ++kq) A[4 * kh + kq] = A[4 * kh + kq] * gl;
          SCHED_FENCE();
#pragma unroll
          for (int s0 = 0; s0 < 2; ++s0)
#pragma unroll
              for (int kq = 0; kq < 4; ++kq) A[4 * kh + kq] = mfma16(kf[kq][s0], ys[s0], A[4 * kh + kq]);
          SCHED_FENCE(); } }
}
template <bool PASS3, int SKIP = 0>
__device__ __forceinline__ void gdn_pass(Frame& F) {
    LAS bf16*  WTL = (LAS bf16*)(F.lds + 0);
    LAS bf16*  QNL = (LAS bf16*)(F.lds + 17408);
    LAS bf16*  UTL = (LAS bf16*)(F.lds + 34816);
    LAS bf16*  KTL = (LAS bf16*)(F.lds + 53248);
    LAS bf16*  AQL = (LAS bf16*)(F.lds + 71680);
    LAS float* SCL = (LAS float*)(F.lds + 80896);
    LAS bf16*  PX  = (LAS bf16*)(F.lds + 0);
    const int tid = F.tid, lane = F.lane, w = F.wave, fr = lane & 15, fq = lane >> 4;
    LAS bf16* ST  = (LAS bf16*)(F.lds + 81920 + w * 8960);
    LAS bf16* VN  = ST + 16 * 136;
    LAS bf16* VNS = VN + 16 * 72;
    const int row = tid >> 3, c0 = (tid & 7) * 16, vrow = tid >> 2, t0 = (tid & 3) * 16;
    const unsigned char* dob = (const unsigned char*)F.out;
    float* GL = (float*)(F.ws + WS_GL); bf16* GP = (bf16*)(F.ws + WS_GP);
    for (int it = blockIdx.x; it < 256; it += F.G) {
        const int hd = it >> 4, sg = it & 15, dir = hd >> 3, h = hd & 7;
        bf16* Og = (bf16*)(F.ws + (dir ? WS_OGB : WS_OGF));
        f32x4 Sacc[8], Pacc[8];
        int dgi = 16 * w + fr - 4 * fq; asm volatile("" : "+v"(dgi));
#pragma unroll
        for (int kt = 0; kt < 8; ++kt) { Sacc[kt] = (f32x4){0.f, 0.f, 0.f, 0.f};
#pragma unroll
            for (int r = 0; r < 4; ++r) Pacc[kt][r] = (!PASS3 && (16 * kt + r == dgi)) ? 1.f : 0.f; }
        __syncthreads();
        if (PASS3) {
            for (int p = 0; p < sg; ++p) { const int ip = hd * 16 + p;
                { const bf16* src = GP + (size_t)ip * 16384 + vrow * 128 + (tid & 3) * 32;
#pragma unroll
                  for (int q = 0; q < 4; ++q) *(LAS v4u*)(PX + vrow * 136 + (tid & 3) * 32 + 8 * q) = *(const GAS v4u*)(src + 8 * q); }
#pragma unroll
                for (int kt = 0; kt < 8; ++kt) *(LAS v2u*)(ST + fr * 136 + 16 * kt + 4 * fq) = pack4(Sacc[kt]);
                __syncthreads();
                bf16x8 xs[4];
#pragma unroll
                for (int k0 = 0; k0 < 4; ++k0) xs[k0] = ldfrag(ST, 136, fr, 32 * k0 + 8 * fq);
#pragma unroll
                for (int kh = 0; kh < 2; ++kh) { bf16x8 pf[4][4]; f32x4 acc[4];
#pragma unroll
                    for (int kq = 0; kq < 4; ++kq) { const int kt = 4 * kh + kq; acc[kq] = *(const GAS f32x4*)(GL + ((size_t)((ip * 8 + w) * 8 + kt) * 64 + lane) * 4);
#pragma unroll
                        for (int k0 = 0; k0 < 4; ++k0) pf[kq][k0] = ldfrag(PX, 136, 16 * kt + fr, 32 * k0 + 8 * fq); }
                    SCHED_FENCE();
#pragma unroll
                    for (int k0 = 0; k0 < 4; ++k0)
#pragma unroll
                        for (int kq = 0; kq < 4; ++kq) acc[kq] = mfma16(pf[kq][k0], xs[k0], acc[kq]);
                    SCHED_FENCE();
#pragma unroll
                    for (int kq = 0; kq < 4; ++kq) Sacc[4 * kh + kq] = acc[kq]; }
                __syncthreads();
            }
        }
        v4u rw[2], rq[2], ru[2], rk[2], ra; float rs;
        gdn_load_tiles(F.ws, dob, tid, dir, hd, h, dir ? 255 - sg * 16 : sg * 16, PASS3, rw, rq, ru, rk, ra, rs);
        for (int ci = 0; ci < CPS; ++ci) {
            const int sc = sg * 16 + ci, oc = dir ? 255 - sc : sc, tok0 = 64 * oc;
            *(LAS v4u*)(WTL + row * 136 + c0) = rw[0]; *(LAS v4u*)(WTL + row * 136 + c0 + 8) = rw[1];
            *(LAS v4u*)(UTL + vrow * 72 + t0) = ru[0]; *(LAS v4u*)(UTL + vrow * 72 + t0 + 8) = ru[1];
            *(LAS v4u*)(KTL + vrow * 72 + t0) = rk[0]; *(LAS v4u*)(KTL + vrow * 72 + t0 + 8) = rk[1];
            if (PASS3) { *(LAS v4u*)(QNL + row * 136 + c0) = rq[0]; *(LAS v4u*)(QNL + row * 136 + c0 + 8) = rq[1]; *(LAS v4u*)(AQL + row * 72 + (tid & 7) * 8) = ra; }
            if (tid < 192) SCL[tid] = rs;
            __syncthreads();
            if (ci + 1 < CPS && !(SKIP & 1)) gdn_load_tiles(F.ws, dob, tid, dir, hd, h, dir ? oc - 1 : oc + 1, PASS3, rw, rq, ru, rk, ra, rs);
            const float gl = SCL[128];
            gdn_tile<PASS3, true>(Sacc, WTL, QNL, UTL, KTL, AQL, SCL, ST, VN, VNS, w, fr, fq, gl, Og + (size_t)tok0 * HW + h * 128);
            if (!PASS3) gdn_tile<PASS3, false>(Pacc, WTL, QNL, UTL, KTL, AQL, SCL, ST, VN, VNS, w, fr, fq, gl, Og);
            __syncthreads();
        }
        if (!PASS3) {
            int pofs = (4 * fq) * 128 + 16 * w + fr; asm volatile("" : "+v"(pofs));
            bf16* gp = GP + (size_t)it * 16384 + pofs;
#pragma unroll
            for (int kt = 0; kt < 8; ++kt) { *(GAS f32x4*)(GL + ((size_t)((it * 8 + w) * 8 + kt) * 64 + lane) * 4) = Sacc[kt];
#pragma unroll
                for (int r = 0; r < 4; ++r) gp[(16 * kt + r) * 128] = (bf16)f2bf(Pacc[kt][r]); }
        }
    }
}
__device__ __forceinline__ void p7_mix(Frame& F) {
    const int gw = F.vcu * NWAVES + F.wave, NGW = F.G * NWAVES, lane = F.lane;
    const int e0 = (lane & 7) * 16, col = (lane >> 3) * 128 + e0;
    for (int m = gw; m < SEQ; m += NGW) {
#pragma unroll
        for (int mx = 0; mx < 2; ++mx) {
            const bf16* of = (const bf16*)(F.ws + (mx ? WS_OGF : WS_OHF)); const bf16* ob = (const bf16*)(F.ws + (mx ? WS_OGB : WS_OHB));
            const bf16* gt = (const bf16*)(F.ws + WS_H + (size_t)(mx ? 8 : 4) * 32 * MiB); const float* nw = F.in[mx ? I_GNW : I_HNW];
            bf16* yo = (bf16*)(F.ws + (mx ? WS_YB : WS_YA));
            const size_t off = (size_t)m * HW + col;
            const v4u a0 = *(const GAS v4u*)(of + off), a1 = *(const GAS v4u*)(of + off + 8), b0 = *(const GAS v4u*)(ob + off), b1 = *(const GAS v4u*)(ob + off + 8), g0 = *(const GAS v4u*)(gt + off), g1 = *(const GAS v4u*)(gt + off + 8);
            const unsigned aw[8] = {a0.x, a0.y, a0.z, a0.w, a1.x, a1.y, a1.z, a1.w}, bw[8] = {b0.x, b0.y, b0.z, b0.w, b1.x, b1.y, b1.z, b1.w}, gw_[8] = {g0.x, g0.y, g0.z, g0.w, g1.x, g1.y, g1.z, g1.w};
            float o[16]; float ss = 0.f;
#pragma unroll
            for (int e = 0; e < 8; ++e) { o[2 * e] = bflo(aw[e]) + bflo(bw[e]); o[2 * e + 1] = bfhi(aw[e]) + bfhi(bw[e]); ss += o[2 * e] * o[2 * e] + o[2 * e + 1] * o[2 * e + 1]; }
            ss += __shfl_xor(ss, 1); ss += __shfl_xor(ss, 2); ss += __shfl_xor(ss, 4);
            const float r = 1.0f / sqrtf(ss * (1.f / 128.f) + EPS);
            if (QM_MIX == 2) { float yv[16]; float am = 0.f;
#pragma unroll
                for (int e = 0; e < 8; ++e) { yv[2 * e] = o[2 * e] * r * nw[e0 + 2 * e] * bflo(gw_[e]); yv[2 * e + 1] = o[2 * e + 1] * r * nw[e0 + 2 * e + 1] * bfhi(gw_[e]); am = fmaxf(am, fmaxf(fabsf(yv[2 * e]), fabsf(yv[2 * e + 1]))); }
                am = wave_max(am); const float inv = am > 0.f ? 127.0f / am : 0.f;
                *(GAS v4u*)((unsigned char*)yo + off) = (v4u){pk4i8((f32x4){yv[0], yv[1], yv[2], yv[3]}, inv), pk4i8((f32x4){yv[4], yv[5], yv[6], yv[7]}, inv), pk4i8((f32x4){yv[8], yv[9], yv[10], yv[11]}, inv), pk4i8((f32x4){yv[12], yv[13], yv[14], yv[15]}, inv)};
                if (lane == 0) ((float*)(F.ws + WS_QX))[(1 + mx) * SEQ + m] = am > 0.f ? am * (1.0f / 127.0f) : 1.0f; }
            else if (QM_MIX == 1) { unsigned yq[4];
#pragma unroll
                for (int e = 0; e < 4; ++e) yq[e] = pk4f8(o[4 * e] * r * nw[e0 + 4 * e] * bflo(gw_[2 * e]), o[4 * e + 1] * r * nw[e0 + 4 * e + 1] * bfhi(gw_[2 * e]), o[4 * e + 2] * r * nw[e0 + 4 * e + 2] * bflo(gw_[2 * e + 1]), o[4 * e + 3] * r * nw[e0 + 4 * e + 3] * bfhi(gw_[2 * e + 1]));
                *(GAS v4u*)((unsigned char*)yo + off) = (v4u){yq[0], yq[1], yq[2], yq[3]}; }
            else { unsigned yw[8];
#pragma unroll
            for (int e = 0; e < 8; ++e) yw[e] = pk2(o[2 * e] * r * nw[e0 + 2 * e] * bflo(gw_[e]), o[2 * e + 1] * r * nw[e0 + 2 * e + 1] * bfhi(gw_[e]));
            *(GAS v4u*)(yo + off) = (v4u){yw[0], yw[1], yw[2], yw[3]}; *(GAS v4u*)(yo + off + 8) = (v4u){yw[4], yw[5], yw[6], yw[7]}; }
        }
    }
    for (int tb = 0; tb < 2; ++tb) { const float* src = F.in[tb ? I_PV : I_PU]; unsigned char* dst = F.ws + (tb ? WS_TV : WS_TU); float* scl = (float*)(F.ws + WS_PSC) + tb * 16384;
        for (int r = gw; r < 16384; r += NGW) { const float* row = src + (size_t)r * DM; f32x4 v[8]; float mx = 0.f;
#pragma unroll
            for (int q = 0; q < 8; ++q) { v[q] = *(const GAS f32x4*)(row + (tb ? (q >> 2) * 1024 + lane * 16 + 4 * (q & 3) : lane * 32 + 4 * q)); const f32x4 a = __builtin_elementwise_abs(v[q]); mx = fmaxf(mx, fmaxf(fmaxf(a.x, a.y), fmaxf(a.z, a.w))); }
            mx = wave_max(mx);
            const float sc = mx > 0.f ? mx * (tb ? 1.0f / 256.0f : 1.0f / 127.0f) : 1.0f, inv = 1.0f / sc;
            unsigned w[8];
#pragma unroll
            for (int q = 0; q < 8; ++q) { const f32x4 x = v[q];
                if (tb) w[q] = pk4f8(x.x * inv, x.y * inv, x.z * inv, x.w * inv);
                else { const int a = (int)rintf(x.x * inv), b = (int)rintf(x.y * inv), c = (int)rintf(x.z * inv), d = (int)rintf(x.w * inv);
                    w[q] = (unsigned)(a & 255) | ((unsigned)(b & 255) << 8) | ((unsigned)(c & 255) << 16) | ((unsigned)(d & 255) << 24); } }
            if (tb) { *(GAS v4u*)(dst + (size_t)r * DM + lane * 16) = (v4u){w[0], w[1], w[2], w[3]}; *(GAS v4u*)(dst + (size_t)r * DM + 1024 + lane * 16) = (v4u){w[4], w[5], w[6], w[7]}; }
            else { GAS v4u* o = (GAS v4u*)(dst + ((size_t)lane * 16384 + r) * 32); o[0] = (v4u){w[0], w[1], w[2], w[3]}; o[1] = (v4u){w[4], w[5], w[6], w[7]}; }
            if (lane == 0) scl[r] = sc; } }
}
constexpr size_t WS_XQ = 80 * MiB;
constexpr size_t WS_SXR = 112 * MiB;
constexpr size_t WS_EID = 113 * MiB, WS_GATE = 121 * MiB, WS_AV = 129 * MiB;
constexpr size_t WS_REC = 208 * MiB;
constexpr int NET = 32, ETSZ = 512, NBUCK = 16 * NET, REC_CAP = 16384, CW_CNT = 8192, CW_Q = 8192 + 16 * NBUCK;
__device__ __forceinline__ unsigned fkey(float f) { const unsigned u = __builtin_bit_cast(unsigned, f); return (u & 0x80000000u) ? ~u : (u | 0x80000000u); }
__device__ __forceinline__ float gelu_erf(float x) { return 0.5f * x * (1.0f + erff(x * 0.70710678118654752f)); }

__device__ __forceinline__ float key_val(unsigned k, unsigned mask) { unsigned u = k & ~mask; u = (u & 0x80000000u) ? (u & 0x7fffffffu) : ~u; return __builtin_bit_cast(float, u); }
template <int SKIP>
__device__ __forceinline__ void p11a_topk(Frame& F) {
    LAS float* SCR = (LAS float*)(F.lds + F.wave * 16384);
    LAS unsigned* SL = (LAS unsigned*)SCR;
    LAS int* EIDS = (LAS int*)(SCR + 1024);
    LAS int* OFFS = (LAS int*)(SCR + 2048);
    LAS float* RTS = SCR + 2304;
    LAS int* BC = (LAS int*)(F.lds + 8 * 16384);
    const bf16* SC = (const bf16*)(F.ws + WS_SC);
    unsigned char* XQ = F.ws + WS_XQ; float* SXR = (float*)(F.ws + WS_SXR); int* EIDg = (int*)(F.ws + WS_EID); float* GATEg = (float*)(F.ws + WS_GATE); unsigned* REC = (unsigned*)(F.ws + WS_REC);
    for (int blk = F.vcu; blk < SEQ / 64; blk += F.G) {
        __syncthreads();
        if (F.tid < NET) BC[F.tid] = 0;
        __syncthreads();
        const int m0 = blk * 64 + F.wave * 8;
#pragma unroll 2
        for (int ti = 0; ti < 8; ++ti) { const int m = m0 + ti;
            int lane = F.lane; asm volatile("" : "+v"(lane));
            float xh[32]; float ss = 0.f;
            const bf16* x1 = (const bf16*)(F.ws + WS_X1B) + (size_t)m * DM + lane * 32; const float* n2 = F.in[I_N2W] + lane * 32;
            f32x4 nwv[8];
#pragma unroll
            for (int q = 0; q < 8; ++q) { const v2u a = *(const GAS v2u*)(x1 + 4 * q); nwv[q] = *(const GAS f32x4*)(n2 + 4 * q); xh[4 * q] = bflo(a.x); xh[4 * q + 1] = bfhi(a.x); xh[4 * q + 2] = bflo(a.y); xh[4 * q + 3] = bfhi(a.y); }
#pragma unroll
            for (int e = 0; e < 32; ++e) ss += xh[e] * xh[e];
            const float rt = 1.0f / sqrtf(wave_sum(ss) * (1.f / DM) + EPS);
            float amx = 0.f;
#pragma unroll
            for (int q = 0; q < 8; ++q) { const f32x4 a = nwv[q]; xh[4 * q] *= rt * a.x; xh[4 * q + 1] *= rt * a.y; xh[4 * q + 2] *= rt * a.z; xh[4 * q + 3] *= rt * a.w; }
#pragma unroll
            for (int e = 0; e < 32; ++e) amx = fmaxf(amx, fabsf(xh[e]));
            amx = wave_max(amx);
            const float sx = amx > 0.f ? amx * (1.0f / 127.0f) : 1.0f, isx = 1.0f / sx;
            unsigned xq[8];
#pragma unroll
            for (int d = 0; d < 8; ++d) { const int a = (int)rintf(xh[4 * d] * isx), b = (int)rintf(xh[4 * d + 1] * isx), c = (int)rintf(xh[4 * d + 2] * isx), e = (int)rintf(xh[4 * d + 3] * isx);
                xq[d] = (unsigned)(a & 255) | ((unsigned)(b & 255) << 8) | ((unsigned)(c & 255) << 16) | ((unsigned)(e & 255) << 24); }
            if (!(SKIP & 2)) { GAS v4u* o = (GAS v4u*)(XQ + ((size_t)lane * SEQ + m) * 32); o[0] = (v4u){xq[0], xq[1], xq[2], xq[3]}; o[1] = (v4u){xq[4], xq[5], xq[6], xq[7]}; }
            if (lane == 0) { SXR[2 * m] = sx; SXR[2 * m + 1] = rt; RTS[ti] = rt; }
        }
#pragma unroll 1
        for (int grp = 0; grp < 2; ++grp) {
            int lane = F.lane; asm volatile("" : "+v"(lane));
            if (!(SKIP & 1)) {
                { const bf16* src = SC + (size_t)(m0 + grp * 4 + (lane >> 4)) * DM + (lane & 15) * 128;
                  unsigned v[16];
#pragma unroll
                  for (int i = 0; i < 16; ++i) v[i] = 0u;
#pragma unroll 1
                  for (int s8 = 0; s8 < 2; ++s8) { v4u a8[8];
#pragma unroll
                      for (int u = 0; u < 8; ++u) a8[u] = *(const GAS v4u*)(src + 64 * s8 + 8 * u);
#pragma unroll
                      for (int u = 0; u < 8; ++u) { const unsigned wv[4] = {a8[u].x, a8[u].y, a8[u].z, a8[u].w};
#pragma unroll
                          for (int e = 0; e < 8; ++e) { const float sv = (e & 1) ? bfhi(wv[e >> 1]) : bflo(wv[e >> 1]); unsigned x = (fkey(sv) & ~127u) | (unsigned)(64 * s8 + 8 * u + e);
#pragma unroll
                              for (int i = 0; i < 16; ++i) { const unsigned hi = v[i] > x ? v[i] : x; x = v[i] > x ? x : v[i]; v[i] = hi; } } } }
#pragma unroll
                  for (int q = 0; q < 4; ++q) *(LAS v4u*)(SL + lane * 16 + 4 * q) = (v4u){v[4 * q], v[4 * q + 1], v[4 * q + 2], v[4 * q + 3]}; }
                asm volatile("" ::: "memory");
                if (lane < 32) { const int tk = lane >> 3, h = lane & 7, m = m0 + grp * 4 + tk;
                    const LAS unsigned* L1 = SL + (tk * 16 + 2 * h) * 16; const LAS unsigned* L2 = L1 + 16;
                    float f1[16], f2[16];
#pragma unroll
                    for (int q = 0; q < 4; ++q) { const v4u a = *(const LAS v4u*)(L1 + 4 * q), b = *(const LAS v4u*)(L2 + 4 * q);
                        f1[4 * q] = key_val(a.x, 127u); f1[4 * q + 1] = key_val(a.y, 127u); f1[4 * q + 2] = key_val(a.z, 127u); f1[4 * q + 3] = key_val(a.w, 127u);
                        f2[4 * q] = key_val(b.x, 127u); f2[4 * q + 1] = key_val(b.y, 127u); f2[4 * q + 2] = key_val(b.z, 127u); f2[4 * q + 3] = key_val(b.w, 127u); }
                    unsigned c[16];
#pragma unroll
                    for (int i = 0; i < 16; ++i) c[i] = 0u;
#pragma unroll
                    for (int i = 0; i < 16; ++i)
#pragma unroll
                        for (int j = 0; j < 16; ++j) if ((i + 1) * (j + 1) <= 16) { unsigned x = (fkey(f1[i] + f2[j]) & ~255u) | (unsigned)(i * 16 + j);
#pragma unroll
                            for (int r = 0; r < 16; ++r) { const unsigned hi = c[r] > x ? c[r] : x; x = c[r] > x ? x : c[r]; c[r] = hi; } }
                    const float rt = RTS[grp * 4 + tk];
                    float sc[16]; int ee[16]; float mx = -3.0e38f;
#pragma unroll
                    for (int r = 0; r < 16; ++r) { const unsigned ij = c[r] & 255u; const unsigned k1 = L1[ij >> 4], k2 = L2[ij & 15u];
                        sc[r] = key_val(k1, 127u) + key_val(k2, 127u); ee[r] = (int)((k1 & 127u) * 128u + (k2 & 127u)); mx = fmaxf(mx, sc[r]); }
                    float sum = 0.f;
#pragma unroll
                    for (int r = 0; r < 16; ++r) { sc[r] = __expf(rt * (sc[r] - mx)); sum += sc[r]; }
                    const float inv = 1.0f / sum;
#pragma unroll
                    for (int q = 0; q < 4; ++q) { *(LAS v4u*)(EIDS + (grp * 4 + tk) * 128 + h * 16 + 4 * q) = (v4u){(unsigned)ee[4 * q], (unsigned)ee[4 * q + 1], (unsigned)ee[4 * q + 2], (unsigned)ee[4 * q + 3]};
                        if (!(SKIP & 4)) { *(GAS v4u*)(EIDg + (size_t)m * 128 + h * 16 + 4 * q) = (v4u){(unsigned)ee[4 * q], (unsigned)ee[4 * q + 1], (unsigned)ee[4 * q + 2], (unsigned)ee[4 * q + 3]};
                            *(GAS f32x4*)(GATEg + (size_t)m * 128 + h * 16 + 4 * q) = (f32x4){sc[4 * q] * inv, sc[4 * q + 1] * inv, sc[4 * q + 2] * inv, sc[4 * q + 3] * inv}; } }
                }
                asm volatile("" ::: "memory");
            }
        }
#pragma unroll 1
        for (int ti = 0; ti < 8; ++ti) {
            int lane = F.lane; asm volatile("" : "+v"(lane));
            const int tA = (EIDS[ti * 128 + lane] >> 9) & 31, tB = (EIDS[ti * 128 + 64 + lane] >> 9) & 31; int mycnt = 0;
#pragma unroll
            for (int k = 0; k < NET; ++k) { const int c = __popcll(__ballot(tA == k)) + __popcll(__ballot(tB == k)); mycnt = (lane == k) ? c : mycnt; }
            if (lane < NET) OFFS[ti * NET + lane] = __hip_atomic_fetch_add((int*)(BC + lane), mycnt, __ATOMIC_RELAXED, __HIP_MEMORY_SCOPE_WORKGROUP);
        }
        __syncthreads();
        const int tt = blk >> 4;
        if (F.tid < NET) BC[NET + F.tid] = (int)__hip_atomic_fetch_add((unsigned*)(F.ctl + CW_CNT) + (tt * NET + F.tid) * 16, (unsigned)BC[F.tid], __ATOMIC_RELAXED, __HIP_MEMORY_SCOPE_AGENT);
        __syncthreads();
#pragma unroll 1
        for (int ti = 0; ti < 8; ++ti) { const int m = m0 + ti;
            int lane = F.lane; asm volatile("" : "+v"(lane));
            const unsigned long long lt_mask = (1ull << lane) - 1ull;
            const int eA = EIDS[ti * 128 + lane] & 16383, eB = EIDS[ti * 128 + 64 + lane] & 16383, tA = eA >> 9, tB = eB >> 9; int rankA = 0, rankB = 0;
#pragma unroll
            for (int k = 0; k < NET; ++k) { const unsigned long long mA = __ballot(tA == k), mB = __ballot(tB == k);
                rankA = (tA == k) ? __popcll(mA & lt_mask) : rankA; rankB = (tB == k) ? __popcll(mA) + __popcll(mB & lt_mask) : rankB; }
            const unsigned tl = (unsigned)(m & 1023) << 17;
            if (!(SKIP & 4)) { const int s = BC[NET + tA] + OFFS[ti * NET + tA] + rankA; if (s < REC_CAP) REC[(size_t)(tt * NET + tA) * REC_CAP + s] = tl | ((unsigned)(eA & 511) << 7) | (unsigned)lane; }
            if (!(SKIP & 4)) { const int s = BC[NET + tB] + OFFS[ti * NET + tB] + rankB; if (s < REC_CAP) REC[(size_t)(tt * NET + tB) * REC_CAP + s] = tl | ((unsigned)(eB & 511) << 7) | (unsigned)(lane + 64); }
        }
    }
}

constexpr int NSLOT = 12, UPITCH = 80;
template <int SKIP>
__device__ __forceinline__ void p11b_udot(Frame& F) {
    LAS unsigned char* XS = (LAS unsigned char*)F.lds;
    LAS unsigned char* US = XS + 1024 * UPITCH;
    LAS int* QB = (LAS int*)(F.lds + 124 * 1024);
    const int tid = F.tid;
    const unsigned char* XQ = F.ws + WS_XQ; const unsigned char* TU = F.ws + WS_TU; const unsigned* REC = (const unsigned*)(F.ws + WS_REC);
    const float* SXR = (const float*)(F.ws + WS_SXR); const float* GATEg = (const float*)(F.ws + WS_GATE); float* AVg = (float*)(F.ws + WS_AV);
    const float* SU = (const float*)(F.ws + WS_PSC); const float* SV = SU + 16384;
    for (;;) {
        __syncthreads();
        if (tid == 0) QB[0] = (int)__hip_atomic_fetch_add((unsigned*)(F.ctl + CW_Q), 1u, __ATOMIC_RELAXED, __HIP_MEMORY_SCOPE_AGENT);
        __syncthreads();
        const int b = QB[0];
        if (b >= NBUCK) break;
        const int tt = b >> 5, et = b & 31;
        int n = (int)__hip_atomic_load((unsigned*)(F.ctl + CW_CNT) + b * 16, __ATOMIC_RELAXED, __HIP_MEMORY_SCOPE_AGENT); n = n < REC_CAP ? n : REC_CAP;
        for (int g0 = 0; g0 < n; g0 += NSLOT * NTHR) {
            const int npass = (n - g0) < NSLOT * NTHR ? (n - g0) : NSLOT * NTHR;
            unsigned rec[NSLOT]; int acc[NSLOT];
#pragma unroll
            for (int j = 0; j < NSLOT; ++j) { const int idx = g0 + j * NTHR + tid; const unsigned r = idx < n ? REC[(size_t)b * REC_CAP + idx] : 0xffffffffu; acc[j] = 0;
                rec[j] = ((r >> 17) & 1023u) | (((r >> 7) & 511u) << 16); }
            v4u st[12];
#define P11B_SRC(step, i) (((i) % 6) < 4 ? XQ + ((size_t)(2 * (step) + (i) / 6) * SEQ + tt * 1024) * 32 + (size_t)(tid + 512 * ((i) % 6)) * 16 : TU + ((size_t)(2 * (step) + (i) / 6) * 16384 + et * ETSZ) * 32 + (size_t)(tid + 512 * (((i) % 6) - 4)) * 16)
#pragma unroll
            for (int i = 0; i < 12; ++i) st[i] = *(const GAS v4u*)P11B_SRC(0, i);
#pragma unroll 1
            for (int c = 0; c < 32; ++c) {
                __syncthreads();
#pragma unroll
                for (int i = 0; i < 12; ++i) { const int q = i % 6, hc = i / 6, p = (q < 4) ? tid + 512 * q : tid + 512 * (q - 4); *(LAS v4u*)((q < 4 ? XS : US) + (p >> 1) * UPITCH + hc * 32 + (p & 1) * 16) = st[i]; }
                __syncthreads();
                if (c + 1 < 32 && !(SKIP & 1)) {
#pragma unroll
                    for (int i = 0; i < 12; ++i) st[i] = *(const GAS v4u*)P11B_SRC(c + 1, i);
                }
#pragma unroll
                for (int j0 = 0; j0 < NSLOT; j0 += 2) {
                    if (j0 * NTHR < npass && !(SKIP & 2)) {
                        v4u xb[2][4], ub[2][4];
#pragma unroll
                        for (int q = 0; q < 2; ++q) { unsigned r = rec[j0 + q]; asm volatile("" : "+v"(r));
                            const unsigned xo = (r & 0xffffu) * UPITCH, uo = (r >> 16) * UPITCH;
#pragma unroll
                            for (int hh = 0; hh < 4; ++hh) { xb[q][hh] = *(const LAS v4u*)(XS + xo + 16 * hh); ub[q][hh] = *(const LAS v4u*)(US + uo + 16 * hh); } }
                        __builtin_amdgcn_sched_barrier(0);
#pragma unroll
                        for (int q = 0; q < 2; ++q) { int s = acc[j0 + q];
#pragma unroll
                            for (int hh = 0; hh < 4; ++hh) { const v4u u = ub[q][hh], x = xb[q][hh];
                                s = __builtin_amdgcn_sdot4((int)u.x, (int)x.x, s, false); s = __builtin_amdgcn_sdot4((int)u.y, (int)x.y, s, false); s = __builtin_amdgcn_sdot4((int)u.z, (int)x.z, s, false); s = __builtin_amdgcn_sdot4((int)u.w, (int)x.w, s, false); }
                            acc[j0 + q] = s; }
                        __builtin_amdgcn_sched_barrier(0);
                    }
                }
            }
#undef P11B_SRC
#pragma unroll
            for (int j = 0; j < NSLOT; ++j) { const int idx = g0 + j * NTHR + tid; const unsigned r = idx < n ? REC[(size_t)b * REC_CAP + idx] : 0xffffffffu;
                if (r != 0xffffffffu) { const int t = tt * 1024 + (int)((r >> 17) & 1023), e = et * ETSZ + (int)((r >> 7) & 511), j7 = (int)(r & 127);
                    const float hv = (float)acc[j] * SU[e] * SXR[2 * t]; AVg[(size_t)t * 128 + j7] = gelu_erf(hv) * GATEg[(size_t)t * 128 + j7] * SV[e]; } }
        }
    }
}

__device__ __forceinline__ void p11c_vsum(Frame& F) {
    const int gw = F.vcu * NWAVES + F.wave, NGW = F.G * NWAVES;
    LAS int* EID = (LAS int*)(F.lds + F.wave * 16384); LAS float* AV = (LAS float*)(EID + 128);
    const unsigned char* TV = F.ws + WS_TV; const int* EIDg = (const int*)(F.ws + WS_EID); const float* AVg = (const float*)(F.ws + WS_AV);
    for (int m = gw; m < SEQ; m += NGW) {
        int lane = F.lane; asm volatile("" : "+v"(lane));
        const int lo16 = lane * 16;
        EID[lane] = EIDg[(size_t)m * 128 + lane]; EID[lane + 64] = EIDg[(size_t)m * 128 + 64 + lane]; AV[lane] = AVg[(size_t)m * 128 + lane]; AV[lane + 64] = AVg[(size_t)m * 128 + 64 + lane];
        asm volatile("" ::: "memory");
        f32x2 y2[16];
#pragma unroll
        for (int e = 0; e < 16; ++e) y2[e] = (f32x2){0.f, 0.f};
        v4u rv[2][4][2]; float av[2][4];
#define P11C_LOAD(buf, g) do { _Pragma("unroll") for (int q = 0; q < 4; ++q) { const int e = __builtin_amdgcn_readfirstlane(EID[(g) + q]); av[buf][q] = AV[(g) + q]; const unsigned char* rp = TV + (size_t)e * DM + lo16; \
            rv[buf][q][0] = *(const GAS v4u*)(rp); rv[buf][q][1] = *(const GAS v4u*)(rp + 1024); } } while (0)
#define P11C_ACC(buf) do { _Pragma("unroll") for (int q = 0; q < 4; ++q) { const float a = av[buf][q]; const f32x2 a2 = {a, a}; \
            _Pragma("unroll") for (int j = 0; j < 2; ++j) { const v4u r = rv[buf][q][j]; const unsigned wv[4] = {r.x, r.y, r.z, r.w}; \
                _Pragma("unroll") for (int dd = 0; dd < 4; ++dd) { y2[8 * j + 2 * dd] += a2 * __builtin_amdgcn_cvt_pk_f32_fp8((int)wv[dd], false); y2[8 * j + 2 * dd + 1] += a2 * __builtin_amdgcn_cvt_pk_f32_fp8((int)wv[dd], true); } } \
            __builtin_amdgcn_sched_barrier(0); } } while (0)
        P11C_LOAD(0, 0);
#pragma unroll 1
        for (int g = 0; g < 128; g += 8) {
            P11C_LOAD(1, g + 4);
            P11C_ACC(0);
            if (g + 8 < 128) P11C_LOAD(0, g + 8);
            P11C_ACC(1);
        }
#undef P11C_LOAD
#undef P11C_ACC
        float y[32];
#pragma unroll
        for (int e = 0; e < 16; ++e) { y[2 * e] = y2[e].x; y[2 * e + 1] = y2[e].y; }
        const bf16* x1 = (const bf16*)(F.ws + WS_X1B) + (size_t)m * DM;
        float s2 = 0.f;
#pragma unroll
        for (int j = 0; j < 2; ++j)
#pragma unroll
            for (int q = 0; q < 4; ++q) { const v2u a2 = *(const GAS v2u*)(x1 + j * 1024 + lo16 + 4 * q); const f32x4 a = {bflo(a2.x), bfhi(a2.x), bflo(a2.y), bfhi(a2.y)};
                y[16 * j + 4 * q] += a.x; y[16 * j + 4 * q + 1] += a.y; y[16 * j + 4 * q + 2] += a.z; y[16 * j + 4 * q + 3] += a.w; }
#pragma unroll
        for (int e = 0; e < 32; ++e) s2 += y[e] * y[e];
        const float ro = 1.0f / sqrtf(wave_sum(s2) * (1.f / DM) + EPS);
        float* orow = F.out + (size_t)m * DM;
#pragma unroll
        for (int j = 0; j < 2; ++j)
#pragma unroll
            for (int q = 0; q < 4; ++q) { const f32x4 a = *(const GAS f32x4*)(F.in[I_FNW] + j * 1024 + lo16 + 4 * q);
                *(GAS f32x4*)(orow + j * 1024 + lo16 + 4 * q) = (f32x4){y[16 * j + 4 * q] * ro * a.x, y[16 * j + 4 * q + 1] * ro * a.y, y[16 * j + 4 * q + 2] * ro * a.z, y[16 * j + 4 * q + 3] * ro * a.w}; }
    }
}
#ifndef MK_N_LAUNCHES
#define MK_N_LAUNCHES 1
#endif
constexpr int N_PHASES = 14;
constexpr int N_LAUNCHES = MK_N_LAUNCHES;
static_assert(N_LAUNCHES == 1 || N_LAUNCHES == N_PHASES, "MK_N_LAUNCHES is 1 or N_PHASES");
#ifndef PG8_SP2
#define PG8_SP2 true
#endif
#ifndef PG8_ALIGN
#define PG8_ALIGN true
#endif
struct Args { const float* in[19]; float* out; unsigned char* ws; int ph_lo, ph_hi; };
__global__ void __launch_bounds__(NTHR, 2) fwd_kernel(Args args) {
    extern __shared__ __attribute__((aligned(16))) unsigned char lds[];
    Frame F;
    F.lds = (LAS unsigned char*)lds;
    F.MISC = (volatile LAS unsigned*)(F.lds + MISC_OFF);
    F.tid = threadIdx.x; F.lane = F.tid & 63; F.wave = __builtin_amdgcn_readfirstlane(F.tid >> 6);
    F.G = gridDim.x; { const int bx = blockIdx.x; F.vcu = (F.G % 8 == 0) ? (bx % 8) * (F.G / 8) + bx / 8 : bx; }
    F.ws = args.ws; F.out = args.out; F.ctl = (gu32*)(args.ws + WS_CTL);
#pragma unroll
    for (int i = 0; i < 19; ++i) F.in[i] = args.in[i];
    for (int u = F.tid; u < (LDS_BYTES - MISC_OFF) / 4; u += NTHR) ((LAS unsigned*)(F.lds + MISC_OFF))[u] = 0u;
    __syncthreads();
    XcdBarrier bar; bar.bar = (unsigned*)(F.ctl + CW_BAR); bar.x = 0; bar.st = nullptr;
    if (N_LAUNCHES == 1) bar = xcd_barrier_post((unsigned*)(F.ctl + CW_BAR), F.MISC + 8);
    const int lo = args.ph_lo, hi = args.ph_hi;
#ifdef ONLY_PHASE
#define IN(k) ((k) == ONLY_PHASE && lo <= (k) && (k) < hi)
#else
#define IN(k) (lo <= (k) && (k) < hi)
#endif
#define SEAM(k) do { if (IN(k) && IN((k) + 1)) xcd_barrier(bar); } while (0)
#ifndef REPEAT_MASK
#define REPEAT_MASK 0
#endif
#ifndef P11A_SKIP
#define P11A_SKIP 0
#endif
#define REPS(k) for (int rep_ = 0; rep_ < (((REPEAT_MASK) >> (k)) & 1) + 1; ++rep_)
#define RSEAM(k) do { if ((((REPEAT_MASK) >> (k)) & 1) && rep_ == 0) xcd_barrier(bar); } while (0)
    unsigned char* ws = args.ws;
    if (IN(0)) { REPS(0) { p0_prologue(F); RSEAM(0); } SEAM(0); }
    if (IN(1)) {
        pg8::Gemm g{(const bf16*)(ws + WS_XN), (const bf16*)(ws + WS_W1), SEQ, N1, DM}; pg8::StaticOrder S; S.init(SEQ, N1, F.G, (int)blockIdx.x);
        EpiG1 E{ws, F.in[I_LB], (const float*)(ws + WS_QX), (const float*)(ws + WS_QW) + QW_W1};
        if (QM_G1) g.A = (const bf16*)((const unsigned char*)F.out + DO_XN8);
        if ((REPEAT_MASK >> 1) & 1) { pg8::gemm_phase<EpiG1, pg8::StaticOrder, PG8_ALIGN, PG8_SP2, QM_G1>(F.lds, g, S, E); xcd_barrier(bar); }
        pg8::gemm_phase<EpiG1, pg8::StaticOrder, PG8_ALIGN, PG8_SP2, QM_G1>(F.lds, g, S, E);
        p1_ab(F);
        SEAM(1);
    }
#ifdef EXTRA_BARRIERS
    for (int eb = 0; eb < EXTRA_BARRIERS; ++eb) xcd_barrier(bar);
#endif
    if (IN(2)) { REPS(2) { hgrn_pass<false>(F); RSEAM(2); } SEAM(2); }
    if (IN(3)) { if ((REPEAT_MASK >> 3) & 1) { hgrn_pass<true, P11A_SKIP>(F); xcd_barrier(bar); } hgrn_pass<true>(F); SEAM(3); }
    if (IN(4)) { if ((REPEAT_MASK >> 4) & 1) { gdn_prep<P11A_SKIP>(F); xcd_barrier(bar); } gdn_prep<0>(F); SEAM(4); }
    if (IN(5)) { if ((REPEAT_MASK >> 5) & 1) { gdn_pass<false, P11A_SKIP>(F); xcd_barrier(bar); } gdn_pass<false>(F); SEAM(5); }
    if (IN(6)) { if ((REPEAT_MASK >> 6) & 1) { gdn_pass<true, P11A_SKIP>(F); xcd_barrier(bar); } gdn_pass<true>(F); SEAM(6); }
    if (IN(7)) { REPS(7) { p7_mix(F); RSEAM(7); } SEAM(7); }
    if (IN(8)) {
        pg8::StaticOrder S; S.init(SEQ, DM, F.G, (int)blockIdx.x);
        bf16* GT = (bf16*)(ws + WS_GT); unsigned char* GA8 = ws + WS_GT2; unsigned char* GB8 = ws + WS_GT2 + 32 * MiB;
        const bf16* XNg = QM_GATE ? (const bf16*)((const unsigned char*)F.out + DO_XN8) : (const bf16*)(ws + WS_XN);
        const bf16* WG2 = QM_GATE ? (const bf16*)(ws + WS_WG + (size_t)DM * DM) : (const bf16*)(ws + WS_WG) + (size_t)DM * DM;
        const float* QX = (const float*)(ws + WS_QX); const float* QW = (const float*)(ws + WS_QW);
#define P8_BODY \
        { pg8::Gemm g{XNg, (const bf16*)(ws + WS_WG), SEQ, DM, DM}; EpiGate E{GA8, QX, QW + QW_WG}; pg8::gemm_phase<EpiGate, pg8::StaticOrder, PG8_ALIGN, PG8_SP2, QM_GATE>(F.lds, g, S, E); } \
        __builtin_amdgcn_fence(__ATOMIC_ACQUIRE, "agent"); VM_WAIT(); __syncthreads(); \
        { pg8::Gemm g{(const bf16*)(ws + WS_YA), (const bf16*)(ws + WS_WPA), SEQ, DM, HW}; EpiMix<0> E{GT, GA8, nullptr, QX + SEQ, QW + QW_WPA}; pg8::gemm_phase<EpiMix<0>, pg8::StaticOrder, PG8_ALIGN, PG8_SP2, QM_MIX>(F.lds, g, S, E); } \
        { pg8::Gemm g{XNg, WG2, SEQ, DM, DM}; EpiGate E{GB8, QX, QW + QW_WG + DM}; pg8::gemm_phase<EpiGate, pg8::StaticOrder, PG8_ALIGN, PG8_SP2, QM_GATE>(F.lds, g, S, E); } \
        __builtin_amdgcn_fence(__ATOMIC_ACQUIRE, "agent"); VM_WAIT(); __syncthreads(); \
        { pg8::Gemm g{(const bf16*)(ws + WS_YB), (const bf16*)(ws + WS_WPB), SEQ, DM, HW}; EpiMix<1> E{GT, GB8, ws + WS_GT8, QX + 2 * SEQ, QW + QW_WPB}; pg8::gemm_phase<EpiMix<1>, pg8::StaticOrder, PG8_ALIGN, PG8_SP2, QM_MIX>(F.lds, g, S, E); }
        if ((REPEAT_MASK >> 8) & 1) { P8_BODY xcd_barrier(bar); }
        P8_BODY
#undef P8_BODY
        SEAM(8);
    }
    if (IN(9)) {
        pg8::Gemm g{(const bf16*)(ws + (QM_OUT ? WS_GT8 : WS_GT)), (const bf16*)(ws + WS_WOUT), SEQ, DM, DM}; pg8::StaticOrder S; S.init(SEQ, DM, F.G, (int)blockIdx.x);
        EpiX1 E{F.in[I_X], F.out, (bf16*)(ws + WS_X1B)};
        if ((REPEAT_MASK >> 9) & 1) { pg8::gemm_phase<EpiX1, pg8::StaticOrder, PG8_ALIGN, PG8_SP2, QM_OUT>(F.lds, g, S, E); xcd_barrier(bar); }
        pg8::gemm_phase<EpiX1, pg8::StaticOrder, PG8_ALIGN, PG8_SP2, QM_OUT>(F.lds, g, S, E);
        SEAM(9);
    }
    if (IN(10)) {
        pg8::Gemm g{(const bf16*)(ws + WS_X1B), (const bf16*)(ws + WS_WS), SEQ, DM, DM}; pg8::StaticOrder S; S.init(SEQ, DM, F.G, (int)blockIdx.x);
        EpiBf E{(bf16*)(ws + WS_SC)};
        if ((REPEAT_MASK >> 10) & 1) { pg8::gemm_phase<EpiBf, pg8::StaticOrder, PG8_ALIGN, PG8_SP2>(F.lds, g, S, E); xcd_barrier(bar); }
        pg8::gemm_phase<EpiBf, pg8::StaticOrder, PG8_ALIGN, PG8_SP2>(F.lds, g, S, E);
        SEAM(10);
    }
    if (IN(11)) {
        if ((REPEAT_MASK >> 11) & 1) { p11a_topk<P11A_SKIP>(F); xcd_barrier(bar); if (blockIdx.x == 0) for (int i = F.tid; i < NBUCK + 1; i += NTHR) __hip_atomic_store((unsigned*)(F.ctl + CW_CNT) + i * 16, 0u, __ATOMIC_RELAXED, __HIP_MEMORY_SCOPE_AGENT); xcd_barrier(bar); }
        p11a_topk<0>(F); SEAM(11); }
    if (IN(12)) { if ((REPEAT_MASK >> 12) & 1) { p11b_udot<P11A_SKIP>(F); xcd_barrier(bar); if (blockIdx.x == 0 && F.tid == 0) __hip_atomic_store((unsigned*)(F.ctl + CW_Q), 0u, __ATOMIC_RELAXED, __HIP_MEMORY_SCOPE_AGENT); xcd_barrier(bar); } p11b_udot<0>(F); SEAM(12); }
    if (IN(13)) { p11c_vsum(F); }
#undef IN
#undef SEAM
}


#ifdef PROBE
__global__ void digest_kernel(const unsigned* ws, float* out) {
    const size_t n = (size_t)SEQ * DM;
    for (size_t i = (size_t)blockIdx.x * blockDim.x + threadIdx.x; i < n; i += (size_t)gridDim.x * blockDim.x) {
        unsigned acc = (PROBE >= 9) ? __builtin_bit_cast(unsigned, out[i]) : 0u;
        const size_t offs[5] = {0, 128 * MiB / 4, 256 * MiB / 4, 384 * MiB / 4, 408 * MiB / 4};
#pragma unroll
        for (int r = 0; r < 5; ++r) acc = acc * 1664525u + ws[offs[r] + i];
        out[i] = (float)(acc >> 8) * (1.0f / 16777216.0f);
    }
}
#endif
extern "C" void kernel_launch(void* const* d_in, const int* in_sizes, int n_in, void* d_out, int out_size, void* d_ws, size_t ws_size, hipStream_t stream) {
    static int grid = 0;
    if (grid == 0) {
        if (n_in != 19 || in_sizes[0] != SEQ * DM || out_size != SEQ * DM || ws_size < WS_END) { fprintf(stderr, "kernel_launch: unexpected shapes (n_in %d, in0 %d, out %d, ws %zu; need ws >= %zu)\n", n_in, n_in > 0 ? in_sizes[0] : -1, out_size, ws_size, (size_t)WS_END); grid = -1; return; }
        int dev = 0, cus = 0, per_cu = 0;
        if (hipGetDevice(&dev) != hipSuccess || hipDeviceGetAttribute(&cus, hipDeviceAttributeMultiprocessorCount, dev) != hipSuccess) { grid = -1; return; }
        if (hipFuncSetAttribute((const void*)fwd_kernel, hipFuncAttributeMaxDynamicSharedMemorySize, LDS_BYTES) != hipSuccess) { fprintf(stderr, "kernel_launch: hipFuncSetAttribute failed\n"); grid = -1; return; }
        if (hipOccupancyMaxActiveBlocksPerMultiprocessor(&per_cu, (const void*)fwd_kernel, NTHR, LDS_BYTES) != hipSuccess || per_cu < 1) fprintf(stderr, "kernel_launch: occupancy query reports %d\n", per_cu);
        (void)hipGetLastError();
        grid = cus;
    }
    if (grid < 0) return;
    (void)hipMemsetAsync((char*)d_ws + WS_CTL, 0, CTL_ZERO_BYTES, stream);
    Args a{};
    for (int i = 0; i < 19; ++i) a.in[i] = (const float*)d_in[i];
    a.out = (float*)d_out; a.ws = (unsigned char*)d_ws;
    for (int li = 0; li < N_LAUNCHES; ++li) {
        a.ph_lo = (N_LAUNCHES == 1) ? 0 : li; a.ph_hi = (N_LAUNCHES == 1) ? N_PHASES : li + 1;
#ifdef PROBE
        if (li > PROBE) break;
#endif
        hipLaunchKernelGGL(fwd_kernel, dim3(grid), dim3(NTHR), LDS_BYTES, stream, a);
    }
#ifdef PROBE
    hipLaunchKernelGGL(digest_kernel, dim3(2048), dim3(256), 0, stream, (const unsigned*)d_ws, (float*)d_out);
#endif
}
```

```cpp
#include <hip/hip_runtime.h>
#include <cstdio>
#include <cstdint>
#define GAS __attribute__((address_space(1)))
#define LAS __attribute__((address_space(3)))
#define MK_N_LAUNCHES 1
namespace pg8 {
#define PG8_LAS __attribute__((address_space(3)))
typedef unsigned short bf16_t;
typedef short bf16x8 __attribute__((ext_vector_type(8)));
typedef float f32x4 __attribute__((ext_vector_type(4)));
typedef unsigned u32x4 __attribute__((ext_vector_type(4)));
constexpr int BM = 256, BK = 64, HALF = 128, HTB = HALF * BK * 2  , STAGE_BYTES = 8 * HTB, NXCD = 8, WGM = 8;

__host__ __device__ __forceinline__ int lds_byte(int r, int c) { const int st = (r >> 4) * 2 + (c >> 5), rr = r & 15, cc = c & 31, ob = rr * 64 + cc * 2; return st * 1024 + (ob ^ (((ob >> 9) & 1) << 5)); }
__host__ __device__ __forceinline__ void stage_rc(int b, int& R, int& C) { const int st = b / 1024, sb = b % 1024, swz = sb ^ (((sb >> 9) & 1) << 5); R = (st >> 1) * 16 + swz / 64; C = (st & 1) * 32 + (swz % 64) / 2; }
__host__ __device__ __forceinline__ int perm32(int rho) { const int n = rho >> 4, i = rho & 15; return 8 * (i >> 2) + 4 * n + (i & 3); }

struct Unit { int pm, pn; };
struct Gemm { const bf16_t* A; const bf16_t* Bt; int M, N, K; };

struct StaticOrder {
    int nM, nN, nwg, G, c;
    __host__ __device__ void init(int M, int N, int G_, int c_) { nM = M / BM; nN = N / BM; nwg = nM * nN; G = G_; c = c_; }
    __host__ __device__ bool next(int i, Unit& u) const {
        const long L = (long)i * G + c; if (L >= nwg) return false;
        int wgid = (int)L; { const int q = nwg / NXCD, r = nwg % NXCD, xcd = wgid % NXCD, off = wgid / NXCD; wgid = (xcd < r ? xcd * (q + 1) : r * (q + 1) + (xcd - r) * q) + off; }
        const int nig = WGM * nN, gid = wgid / nig, fm = gid * WGM, gsz = (nM - fm) < WGM ? (nM - fm) : WGM;
        u.pm = fm + ((wgid % nig) % gsz); u.pn = (wgid % nig) / gsz; return true;
    }
    __device__ __forceinline__ void a_ready(const Unit&) const {}
    __device__ __forceinline__ void done(const Unit&) const {}
};

__device__ __forceinline__ unsigned cvt_pk_bf16(float lo, float hi) { unsigned r; asm volatile("v_cvt_pk_bf16_f32 %0, %1, %2" : "=v"(r) : "v"(lo), "v"(hi)); return r; }
typedef float f32x2 __attribute__((ext_vector_type(2)));
__device__ __forceinline__ f32x2 gelu_pk(f32x2 v) {
    const f32x2 av = __builtin_elementwise_abs(v), d = av * 0.2316418882f + 1.0f;
    f32x2 t; t.x = __builtin_amdgcn_rcpf(d.x); t.y = __builtin_amdgcn_rcpf(d.y);
    f32x2 q = t * 0.5307027145f + (-0.7265760135f); q = q * t + 0.7107068705f; q = q * t + (-0.142248368f); q = q * t + 0.127414796f; q = q * t;
    const f32x2 s = (v * v) * (-0.72134752044f);
    f32x2 e; e.x = __builtin_amdgcn_exp2f(s.x); e.y = __builtin_amdgcn_exp2f(s.y);
    const f32x2 m = v * (q * e), r = v - m;
    f32x2 o; o.x = v.x < 0.f ? m.x : r.x; o.y = v.y < 0.f ? m.y : r.y; return o;
}

typedef int i32x4v __attribute__((ext_vector_type(4)));
typedef int i32x8v __attribute__((ext_vector_type(8)));
__device__ __forceinline__ i32x8v cat8(bf16x8 lo, bf16x8 hi) { return __builtin_shufflevector(__builtin_bit_cast(i32x4v, lo), __builtin_bit_cast(i32x4v, hi), 0, 1, 2, 3, 4, 5, 6, 7); }
template <class Epi, class Sched, bool ALIGN_EPI = false, bool SP2 = false, int QM = 0>
__device__ __forceinline__ void gemm_phase(PG8_LAS unsigned char* lds, const Gemm g, const Sched& S, const Epi& E) {
    const int tid = threadIdx.x, wid = __builtin_amdgcn_readfirstlane(tid >> 6), lane = tid & 63, wr = wid >> 2, wc = wid & 3, fr = lane & 15, fq = lane >> 4;
    constexpr bool F8 = QM == 1, I8 = QM == 2;
    const int K = g.K, KB = QM ? K : 2 * K  , nt = KB / (BK * 2);
    unsigned voffA[2], voffB[2];
#pragma unroll
    for (int i = 0; i < 2; ++i) { int R, C; stage_rc(tid * 16 + i * 8192, R, C); const int Rb = Epi::PERM ? ((R & ~31) + perm32(R & 31)) : R;
        voffA[i] = (unsigned)(R * KB + C * 2); voffB[i] = (unsigned)(Rb * KB + C * 2); }
    const size_t kstep = (size_t)(BK * 2);
    const size_t hstep = (size_t)HALF * KB;
    const size_t tstep = 2 * hstep;
    const unsigned ldsw = (unsigned)wid * 1024u;
    const int aoff = lds_byte(wr * 64 + fr, fq * 8), boff = lds_byte(wc * 32 + fr, fq * 8);
#define PG8_SA(b, h) (((b) * 2 + (h)) * HTB)
#define PG8_SB(b, h) ((4 + (b) * 2 + (h)) * HTB)
#define PG8_STAGE(bufoff, gbase, voff) do { _Pragma("unroll") for (int _i = 0; _i < 2; ++_i) \
        __builtin_amdgcn_global_load_lds((const unsigned*)((const char*)(gbase) + (voff)[_i]), (PG8_LAS unsigned*)(lds + (bufoff) + ldsw + _i * 8192), 16, 0, 0); } while (0)
#define PG8_LD16(off) (*(const PG8_LAS bf16x8*)(lds + (off)))
#define PG8_LDA(dst, b, h) do { _Pragma("unroll") for (int m = 0; m < 4; ++m) { if constexpr (F8) dst##8[m] = cat8(PG8_LD16(PG8_SA(b, h) + aoff + m * 2048), PG8_LD16(PG8_SA(b, h) + aoff + m * 2048 + 1024)); \
        else { _Pragma("unroll") for (int k = 0; k < 2; ++k) dst[m][k] = PG8_LD16(PG8_SA(b, h) + aoff + m * 2048 + k * 1024); } } } while (0)
#define PG8_LDB(dst, b, h) do { _Pragma("unroll") for (int n = 0; n < 2; ++n) { if constexpr (F8) dst##8[n] = cat8(PG8_LD16(PG8_SB(b, h) + boff + n * 2048), PG8_LD16(PG8_SB(b, h) + boff + n * 2048 + 1024)); \
        else { _Pragma("unroll") for (int k = 0; k < 2; ++k) dst[n][k] = PG8_LD16(PG8_SB(b, h) + boff + n * 2048 + k * 1024); } } } while (0)
#define PG8_MMA(ai, bj, At, Bt) do { __builtin_amdgcn_s_setprio(1); _Pragma("unroll") for (int m = 0; m < 4; ++m) _Pragma("unroll") for (int n = 0; n < 2; ++n) { \
        if constexpr (F8) asm volatile("v_mfma_f32_16x16x128_f8f6f4 %0, %1, %2, %0" : "+v"(acc[ai][bj][m][n]) : "v"(Bt##8[n]), "v"(At##8[m])); \
        else if constexpr (I8) { _Pragma("unroll") for (int k = 0; k < 2; ++k) acc[ai][bj][m][n] = __builtin_bit_cast(f32x4, __builtin_amdgcn_mfma_i32_16x16x64_i8(__builtin_bit_cast(i32x4v, Bt[n][k]), __builtin_bit_cast(i32x4v, At[m][k]), __builtin_bit_cast(i32x4v, acc[ai][bj][m][n]), 0, 0, 0)); } \
        else { _Pragma("unroll") for (int k = 0; k < 2; ++k) acc[ai][bj][m][n] = __builtin_amdgcn_mfma_f32_16x16x32_bf16(Bt[n][k], At[m][k], acc[ai][bj][m][n], 0, 0, 0); } } \
        __builtin_amdgcn_s_setprio(0); } while (0)
#define PG8_WAIT_V(n) asm volatile("s_waitcnt vmcnt(" #n ")" ::: "memory")
#define PG8_WAIT_L(n) asm volatile("s_waitcnt lgkmcnt(" #n ")" ::: "memory")
#define PG8_BAR __builtin_amdgcn_s_barrier()
#define PG8_SCHED __builtin_amdgcn_sched_barrier(0)
    Unit cur, nxt; int ui = 0;
    if (!S.next(0, cur)) return;
    f32x4 acc[2][2][4][2];
#pragma unroll
    for (int a = 0; a < 2; ++a)
#pragma unroll
        for (int b = 0; b < 2; ++b)
#pragma unroll
            for (int m = 0; m < 4; ++m)
#pragma unroll
                for (int n = 0; n < 2; ++n) acc[a][b][m][n] = (f32x4){0.f, 0.f, 0.f, 0.f};
    bf16x8 At[4][2], B0[2][2], B1[2][2]; i32x8v At8[4], B08[2], B18[2];
    const char* cA = (const char*)g.A + (size_t)cur.pm * tstep; const char* cB = (const char*)g.Bt + (size_t)cur.pn * tstep;
    S.a_ready(cur);
    if constexpr (SP2) {
        PG8_STAGE(PG8_SB(0, 0), cB, voffB); PG8_STAGE(PG8_SB(0, 1), cB + hstep, voffB); PG8_STAGE(PG8_SA(0, 0), cA, voffA); PG8_STAGE(PG8_SA(0, 1), cA + hstep, voffA);
        if (wr == 1) PG8_BAR;
        PG8_WAIT_V(2); PG8_BAR;
        PG8_STAGE(PG8_SB(1, 0), cB + kstep, voffB); PG8_STAGE(PG8_SA(1, 0), cA + kstep, voffA); PG8_STAGE(PG8_SB(1, 1), cB + hstep + kstep, voffB);
        PG8_WAIT_V(6); PG8_BAR;
    } else {
        PG8_STAGE(PG8_SB(0, 0), cB, voffB); PG8_STAGE(PG8_SA(0, 0), cA, voffA); PG8_STAGE(PG8_SB(0, 1), cB + hstep, voffB); PG8_STAGE(PG8_SA(0, 1), cA + hstep, voffA);
        if (wr == 1) PG8_BAR;
        PG8_WAIT_V(4); PG8_BAR;
        PG8_STAGE(PG8_SB(1, 0), cB + kstep, voffB); PG8_STAGE(PG8_SA(1, 0), cA + kstep, voffA); PG8_STAGE(PG8_SB(1, 1), cB + hstep + kstep, voffB);
        PG8_WAIT_V(6); PG8_BAR;
    }
    for (;;) {
        const bool has_next = S.next(ui + 1, nxt);
        const char* nA = has_next ? (const char*)g.A + (size_t)nxt.pm * tstep : cA; const char* nB = has_next ? (const char*)g.Bt + (size_t)nxt.pn * tstep : cB;
        for (int t = 0; t < nt; t += 2) {
            const bool last = (t == nt - 2);
            const char* a1 = cA + (size_t)(t + 1) * kstep;
            const char* a2 = last ? nA : cA + (size_t)(t + 2) * kstep; const char* b2 = last ? nB : cB + (size_t)(t + 2) * kstep;
            const char* a3 = a2 + kstep; const char* b3 = b2 + kstep;
            if (last && has_next) S.a_ready(nxt);
            if constexpr (SP2) {
            PG8_LDB(B0, 0, 0); PG8_LDB(B1, 0, 1); PG8_SCHED; PG8_LDA(At, 0, 0); PG8_STAGE(PG8_SA(1, 1), a1 + hstep, voffA);
            PG8_WAIT_V(8); PG8_WAIT_L(0); PG8_BAR; PG8_MMA(0, 0, At, B0); PG8_MMA(0, 1, At, B1); PG8_BAR; PG8_SCHED;
            PG8_LDA(At, 0, 1); PG8_STAGE(PG8_SB(0, 0), b2, voffB); PG8_STAGE(PG8_SB(0, 1), b2 + hstep, voffB); PG8_STAGE(PG8_SA(0, 0), a2, voffA);
            PG8_WAIT_V(8); PG8_WAIT_L(0); PG8_BAR; PG8_MMA(1, 0, At, B0); PG8_MMA(1, 1, At, B1); PG8_BAR; PG8_SCHED;
            PG8_LDB(B0, 1, 0); PG8_LDB(B1, 1, 1); PG8_SCHED; PG8_LDA(At, 1, 0); PG8_STAGE(PG8_SA(0, 1), a2 + hstep, voffA);
            PG8_WAIT_V(8); PG8_WAIT_L(0); PG8_BAR; PG8_MMA(0, 0, At, B0); PG8_MMA(0, 1, At, B1); PG8_BAR; PG8_SCHED;
            PG8_LDA(At, 1, 1); PG8_STAGE(PG8_SB(1, 0), b3, voffB); PG8_STAGE(PG8_SB(1, 1), b3 + hstep, voffB); PG8_STAGE(PG8_SA(1, 0), a3, voffA);
            PG8_WAIT_V(8); PG8_WAIT_L(0); PG8_BAR; PG8_MMA(1, 0, At, B0); PG8_MMA(1, 1, At, B1); PG8_BAR; PG8_SCHED;
            } else {
            PG8_LDB(B0, 0, 0); PG8_SCHED; PG8_LDA(At, 0, 0); PG8_STAGE(PG8_SA(1, 1), a1 + hstep, voffA);
            PG8_WAIT_L(8); PG8_BAR; PG8_WAIT_L(0); PG8_MMA(0, 0, At, B0); PG8_BAR; PG8_SCHED;
            PG8_LDB(B1, 0, 1); PG8_STAGE(PG8_SB(0, 0), b2, voffB);
            PG8_BAR; PG8_WAIT_L(0); PG8_MMA(0, 1, At, B1); PG8_BAR;
            PG8_LDA(At, 0, 1); PG8_STAGE(PG8_SA(0, 0), a2, voffA);
            PG8_BAR; PG8_WAIT_L(0); PG8_MMA(1, 0, At, B0); PG8_BAR; PG8_SCHED;
            PG8_STAGE(PG8_SB(0, 1), b2 + hstep, voffB);
            PG8_WAIT_V(6); PG8_BAR; PG8_MMA(1, 1, At, B1); PG8_BAR;
            PG8_LDB(B0, 1, 0); PG8_SCHED; PG8_LDA(At, 1, 0); PG8_STAGE(PG8_SA(0, 1), a2 + hstep, voffA);
            PG8_WAIT_L(8); PG8_BAR; PG8_WAIT_L(0); PG8_MMA(0, 0, At, B0); PG8_BAR; PG8_SCHED;
            PG8_LDB(B1, 1, 1); PG8_STAGE(PG8_SB(1, 0), b3, voffB);
            PG8_BAR; PG8_WAIT_L(0); PG8_MMA(0, 1, At, B1); PG8_BAR;
            PG8_LDA(At, 1, 1); PG8_STAGE(PG8_SA(1, 0), a3, voffA);
            PG8_BAR; PG8_WAIT_L(0); PG8_MMA(1, 0, At, B0); PG8_BAR; PG8_SCHED;
            PG8_STAGE(PG8_SB(1, 1), b3 + hstep, voffB);
            PG8_WAIT_V(6); PG8_BAR; PG8_MMA(1, 1, At, B1); PG8_BAR;
            }
        }
        if constexpr (ALIGN_EPI) { if (wr == 0) PG8_BAR; }
        if constexpr (F8) asm volatile("s_nop 15\n\ts_nop 15" ::: "memory");
        if constexpr (!Epi::AFTER_DRAIN) { E(acc, cur, wr, wc, fr, fq); S.done(cur); }
        if (!has_next) break;
#pragma unroll
        for (int a = 0; a < 2; ++a)
#pragma unroll
            for (int b = 0; b < 2; ++b)
#pragma unroll
                for (int m = 0; m < 4; ++m)
#pragma unroll
                    for (int n = 0; n < 2; ++n) acc[a][b][m][n] = (f32x4){0.f, 0.f, 0.f, 0.f};
        cur = nxt; cA = nA; cB = nB; ++ui;
        if constexpr (ALIGN_EPI) { if (wr == 1) PG8_BAR; }
    }
    PG8_WAIT_V(0);
    if constexpr (!ALIGN_EPI) { if (wr == 0) PG8_BAR; }
    PG8_BAR;
    if constexpr (Epi::AFTER_DRAIN) { E.fused(acc, cur, wr, wc, fr, fq, lds, wid, lane); S.done(cur); }
#undef PG8_SA
#undef PG8_SB
#undef PG8_STAGE
#undef PG8_LD16
#undef PG8_LDA
#undef PG8_LDB
#undef PG8_MMA
#undef PG8_WAIT_V
#undef PG8_WAIT_L
#undef PG8_BAR
#undef PG8_SCHED
}
}
typedef unsigned short bf16;
typedef unsigned v4u __attribute__((ext_vector_type(4)));
typedef unsigned v2u __attribute__((ext_vector_type(2)));
typedef float f32x4 __attribute__((ext_vector_type(4)));
typedef float f32x2 __attribute__((ext_vector_type(2)));
typedef short bf16x8 __attribute__((ext_vector_type(8)));
typedef GAS unsigned gu32;
#define RLX_AGENT __ATOMIC_RELAXED, __HIP_MEMORY_SCOPE_AGENT
#define LDS_WAIT() asm volatile("s_waitcnt lgkmcnt(0)" ::: "memory")
#define VM_WAIT() asm volatile("s_waitcnt vmcnt(0)" ::: "memory")
typedef __bf16 bf16x2_hw __attribute__((ext_vector_type(2)));
__device__ __forceinline__ unsigned pk2(float lo, float hi) { const f32x2 v = {lo, hi}; const bf16x2_hw b = __builtin_convertvector(v, bf16x2_hw); return __builtin_bit_cast(unsigned, b); }
__device__ __forceinline__ unsigned pk4f8(float a, float b, float c, float d) { int w = 0; w = __builtin_amdgcn_cvt_pk_fp8_f32(a, b, w, false); w = __builtin_amdgcn_cvt_pk_fp8_f32(c, d, w, true); return (unsigned)w; }
__device__ __forceinline__ float cvt_ub0(unsigned w) { float f; asm("v_cvt_f32_ubyte0 %0, %1" : "=v"(f) : "v"(w)); return f; }
__device__ __forceinline__ float cvt_ub1(unsigned w) { float f; asm("v_cvt_f32_ubyte1 %0, %1" : "=v"(f) : "v"(w)); return f; }
__device__ __forceinline__ float cvt_ub2(unsigned w) { float f; asm("v_cvt_f32_ubyte2 %0, %1" : "=v"(f) : "v"(w)); return f; }
__device__ __forceinline__ float cvt_ub3(unsigned w) { float f; asm("v_cvt_f32_ubyte3 %0, %1" : "=v"(f) : "v"(w)); return f; }
__device__ __forceinline__ unsigned f2bf(float f) { return pk2(f, 0.f) & 0xffffu; }
__device__ __forceinline__ float bflo(unsigned w) { return __builtin_bit_cast(float, w << 16); }
__device__ __forceinline__ float bfhi(unsigned w) { return __builtin_bit_cast(float, w & 0xffff0000u); }
__device__ __forceinline__ float bf1(bf16 b) { return __builtin_bit_cast(float, ((unsigned)b) << 16); }
__device__ __forceinline__ float fast_exp(float x) { return __builtin_amdgcn_exp2f(x * 1.4426950408889634f); }
__device__ __forceinline__ float fast_rcp(float x) { return __builtin_amdgcn_rcpf(x); }
__device__ __forceinline__ float sigmoidf_(float x) { return fast_rcp(1.0f + fast_exp(-x)); }
__device__ __forceinline__ float siluf_(float x) { return x * sigmoidf_(x); }
template <int CTRL> __device__ __forceinline__ float dppf(float v) { return __builtin_bit_cast(float, __builtin_amdgcn_mov_dpp(__builtin_bit_cast(int, v), CTRL, 0xF, 0xF, true)); }
template <int CTRL> __device__ __forceinline__ int dppi(int v) { return __builtin_amdgcn_mov_dpp(v, CTRL, 0xF, 0xF, true); }
__device__ __forceinline__ float rdl(float v, int l) { return __builtin_bit_cast(float, __builtin_amdgcn_readlane(__builtin_bit_cast(int, v), l)); }
__device__ __forceinline__ float wave_sum(float v) {
    v += dppf<0xB1>(v); v += dppf<0x4E>(v); v += dppf<0x141>(v); v += dppf<0x140>(v);
    return (rdl(v, 0) + rdl(v, 16)) + (rdl(v, 32) + rdl(v, 48));
}
__device__ __forceinline__ float wave_max(float v) {
    v = fmaxf(v, dppf<0xB1>(v)); v = fmaxf(v, dppf<0x4E>(v)); v = fmaxf(v, dppf<0x141>(v)); v = fmaxf(v, dppf<0x140>(v));
    return fmaxf(fmaxf(rdl(v, 0), rdl(v, 16)), fmaxf(rdl(v, 32), rdl(v, 48)));
}
__device__ __forceinline__ int wave_sum_i(int v) {
    v += dppi<0xB1>(v); v += dppi<0x4E>(v); v += dppi<0x141>(v); v += dppi<0x140>(v);
    return (__builtin_amdgcn_readlane(v, 0) + __builtin_amdgcn_readlane(v, 16)) + (__builtin_amdgcn_readlane(v, 32) + __builtin_amdgcn_readlane(v, 48));
}

constexpr int NWAVES = 8, NTHR = 512;
constexpr int SEQ = 16384, DM = 2048, NH = 8, HD = 128, HW = 1024;
constexpr int CK = 64, NCHUNK = SEQ / CK, NSEG = 16, CPS = NCHUNK / NSEG;
constexpr int INW = 13344;
constexpr int N1 = 9216;
constexpr float EPS = 1e-6f;
constexpr int PEER_K = 16;

constexpr size_t MiB = (size_t)1 << 20;
constexpr size_t WS_CTL = 0, CTL_ZERO_BYTES = 1 * MiB;
constexpr size_t WS_WG = 2 * MiB, WS_WPA = 18 * MiB, WS_WPB = 22 * MiB, WS_WOUT = 26 * MiB, WS_WS = 34 * MiB, WS_W1 = 42 * MiB;
constexpr size_t WS_XN = 80 * MiB;
constexpr size_t WS_H = 144 * MiB;
constexpr size_t WS_GAB = 432 * MiB;
constexpr size_t WS_HL = 434 * MiB;
constexpr size_t WS_HDS = 450 * MiB;
constexpr size_t WS_OHF = 452 * MiB, WS_OHB = 484 * MiB;
constexpr size_t WS_GSC = 516 * MiB;
constexpr size_t WS_UTF = 144 * MiB, WS_UTB = 176 * MiB, WS_WF = 208 * MiB, WS_WB = 240 * MiB;
constexpr size_t DO_AQKF = 0, DO_AQKB = 16 * MiB, DO_QN = 32 * MiB, DO_KNT = 64 * MiB;
constexpr size_t WS_GL = 42 * MiB, WS_GP = 58 * MiB;
constexpr size_t WS_OGF = 304 * MiB, WS_OGB = 336 * MiB;
constexpr size_t WS_YA = 42 * MiB, WS_YB = 368 * MiB;
constexpr size_t WS_TU = 144 * MiB, WS_TV = 176 * MiB;
constexpr size_t WS_PSC = 520 * MiB;
constexpr size_t WS_GT = 272 * MiB, WS_GT2 = 400 * MiB;
constexpr size_t WS_X1B = 400 * MiB;
constexpr size_t WS_SC = 272 * MiB;
constexpr size_t WS_END = 536 * MiB;
#ifndef QM_G1_
#define QM_G1_ 2
#endif
#ifndef QM_GATE_
#define QM_GATE_ 2
#endif
#ifndef QM_MIX_
#define QM_MIX_ 2
#endif
#ifndef QM_OUT_
#define QM_OUT_ 0
#endif
constexpr int QM_G1 = QM_G1_, QM_GATE = QM_GATE_, QM_MIX = QM_MIX_, QM_OUT = QM_OUT_;
constexpr int QM_XN = QM_G1 ? QM_G1 : QM_GATE;
static_assert(QM_G1 == 0 || QM_GATE == 0 || QM_G1 == QM_GATE, "xn has one 8-bit copy");
static_assert(QM_OUT != 2, "merged has no row scale");
constexpr float F8_WSCALE = 128.0f;
constexpr size_t WS_WAB = 78 * MiB;
constexpr size_t DO_XN8 = 96 * MiB;
constexpr size_t WS_GT8 = 336 * MiB;
constexpr size_t WS_QW = 521 * MiB;
constexpr int QW_W1 = 0, QW_WG = 9216, QW_WPA = 13312, QW_WPB = 15360, QW_WOUT = 17408, QW_WAB = 19456;
constexpr bool AB_I8 = QM_XN == 2;
constexpr bool XN_BF16 = QM_G1 == 0 || QM_GATE == 0 || !AB_I8;
constexpr size_t WS_QX = 522 * MiB;
#ifndef VFMT
#define VFMT 6
#endif
#ifndef FP6_IL
#define FP6_IL 1
#endif
constexpr int TV_PITCH = VFMT == 6 ? 1536 : 2048;
typedef float v16f __attribute__((ext_vector_type(16)));
typedef float v32f __attribute__((ext_vector_type(32)));
typedef unsigned v6u __attribute__((ext_vector_type(6)));
constexpr int CW_BAR = 4096;

constexpr int LDS_BYTES = 163840;
constexpr int MISC_OFF = 163840 - 256;
constexpr int LDS_USABLE = MISC_OFF;

__device__ __forceinline__ bf16x8 ldfrag(const LAS bf16* T, int pitch, int row, int k) { return *(const LAS bf16x8*)(T + row * pitch + k); }
__device__ __forceinline__ f32x4 mfma16(bf16x8 x, bf16x8 y, f32x4 c) { return __builtin_amdgcn_mfma_f32_16x16x32_bf16(x, y, c, 0, 0, 0); }
__device__ __forceinline__ v2u pack4(f32x4 v) { v2u r; r.x = pk2(v[0], v[1]); r.y = pk2(v[2], v[3]); return r; }
#define XB_TMO      128
#define XB_XCNT(j)  (256  + 64 * (j))
#define XB_XSUB(j)  (1280 + 64 * (j))
#define XB_XGEN(j)  (2304 + 64 * (j))
#define XB_TOP      3328
#define XB_TOPGEN   3392
#define XCD_BAR_WORDS 3456
#define XB_SPIN_CAP (1u << 18)

__device__ __forceinline__ unsigned xb_ld(unsigned* p)              { return __hip_atomic_load(p, __ATOMIC_RELAXED, __HIP_MEMORY_SCOPE_AGENT); }
__device__ __forceinline__ unsigned xb_add(unsigned* p, unsigned v) { return __hip_atomic_fetch_add(p, v, __ATOMIC_RELAXED, __HIP_MEMORY_SCOPE_AGENT); }
__device__ __forceinline__ unsigned xb_xcc_id() { return (unsigned)__builtin_amdgcn_s_getreg((3 << 11) | 20) & 0xFu; }
#define XB_SPIN(cond, bar) do { unsigned _sp = 0; while (cond) { __builtin_amdgcn_s_sleep(1); \
    if ((++_sp & 255u) == 0u) { if (xb_ld(&(bar)[XB_TMO])) break; if (_sp > XB_SPIN_CAP) { atomicAdd(&(bar)[XB_TMO], 1u); break; } } } } while (0)

struct XcdBarrier {
    unsigned* bar; unsigned x;
    volatile LAS unsigned* st;
};

__device__ __forceinline__ XcdBarrier xcd_barrier_post(unsigned* bar, volatile LAS unsigned* st) {
    XcdBarrier b; b.bar = bar; b.x = xb_xcc_id(); b.st = st;
    if (threadIdx.x == 0) (void)xb_add(&bar[XB_XCNT(b.x)], 1u);
    return b;
}
__device__ __forceinline__ void xcd_barrier_complete(unsigned* bar, unsigned x, unsigned& nloc, unsigned& nx) {
    const unsigned G = gridDim.x * gridDim.y * gridDim.z;
    unsigned sum, cnt, mine, sp = 0u;
    for (;;) {
        sum = 0u; cnt = 0u; mine = 0u;
#pragma unroll
        for (unsigned j = 0; j < 16; ++j) { const unsigned c = xb_ld(&bar[XB_XCNT(j)]); sum += c; cnt += (c > 0u) ? 1u : 0u; mine = (j == x) ? c : mine; }
        if (sum == G) break;
        __builtin_amdgcn_s_sleep(1);
        if ((++sp & 255u) == 0u) { if (xb_ld(&bar[XB_TMO])) break; if (sp > XB_SPIN_CAP) { atomicAdd(&bar[XB_TMO], 1u); break; } }
    }
    nloc = mine > 0u ? mine : 1u; nx = cnt > 0u ? cnt : 1u;
}

__device__ __forceinline__ void xcd_barrier(const XcdBarrier& b) {
    asm volatile("s_waitcnt vmcnt(0)" ::: "memory");
    __syncthreads();
    if (threadIdx.x == 0) {
        unsigned* bar = b.bar;
        __builtin_amdgcn_s_waitcnt(0);
        unsigned nloc = b.st[0], nx = b.st[1];
        if (nloc == 0u) { xcd_barrier_complete(bar, b.x, nloc, nx); b.st[0] = nloc; b.st[1] = nx; }
        const unsigned old = xb_add(&bar[XB_XSUB(b.x)], 1u);
        const unsigned gen = old / nloc;
        if (old + 1u == (gen + 1u) * nloc) {
            __builtin_amdgcn_fence(__ATOMIC_RELEASE, "agent");
            asm volatile("s_waitcnt vmcnt(0)" ::: "memory");
            const unsigned og = xb_add(&bar[XB_TOP], 1u);
            const unsigned tg = og / nx;
            if (og + 1u == (tg + 1u) * nx) xb_add(&bar[XB_TOPGEN], 1u);
            else XB_SPIN(xb_ld(&bar[XB_TOPGEN]) == tg, bar);
            __builtin_amdgcn_fence(__ATOMIC_ACQUIRE, "agent");
            xb_add(&bar[XB_XGEN(b.x)], 1u);
            asm volatile("s_waitcnt vmcnt(0)" ::: "memory");
        } else {
            XB_SPIN(xb_ld(&bar[XB_XGEN(b.x)]) == gen, bar);
            __builtin_amdgcn_fence(__ATOMIC_ACQUIRE, "agent");
            asm volatile("s_waitcnt vmcnt(0)" ::: "memory");
        }
    }
    __syncthreads();
}

struct Frame {
    LAS unsigned char* lds;
    volatile LAS unsigned* MISC;
    gu32* ctl;
    int tid, lane, wave, vcu, G;
    const float* in[19]; float* out; unsigned char* ws;
};
enum { I_X = 0, I_N1W, I_WIN, I_LB, I_HNW, I_CONVW, I_ALOG, I_DTB, I_GNW, I_WPA, I_WPB, I_WOUT, I_N2W, I_WQ, I_K1, I_K2, I_PU, I_PV, I_FNW };

template <bool F8>
__device__ __forceinline__ void p0_transpose_item(const float* W, int ldw, int c0, int K, int ncols, void* WTv, int row_off, LAS float* scr, int item, int lane) {
    const int nblk = ncols / 32, kb = item / nblk, nb = item % nblk, k0 = 64 * kb, n0 = 32 * nb;
#pragma unroll 8
    for (int i = 0; i < 32; ++i) { const int kk = 2 * i + (lane >> 5); scr[kk * 33 + (lane & 31)] = W[(size_t)(k0 + kk) * ldw + c0 + n0 + (lane & 31)]; }
    LDS_WAIT(); asm volatile("" ::: "memory");
    const int c = lane & 7;
#pragma unroll
    for (int j = 0; j < 4; ++j) { const int n = (lane >> 3) + 8 * j; const LAS float* s = scr + (8 * c) * 33 + n;
        if (F8) { v2u o; o.x = pk4f8(s[0 * 33] * F8_WSCALE, s[1 * 33] * F8_WSCALE, s[2 * 33] * F8_WSCALE, s[3 * 33] * F8_WSCALE); o.y = pk4f8(s[4 * 33] * F8_WSCALE, s[5 * 33] * F8_WSCALE, s[6 * 33] * F8_WSCALE, s[7 * 33] * F8_WSCALE);
            *(GAS v2u*)((unsigned char*)WTv + (size_t)(row_off + n0 + n) * K + k0 + 8 * c) = o; }
        else { v4u o; o.x = pk2(s[0 * 33], s[1 * 33]); o.y = pk2(s[2 * 33], s[3 * 33]); o.z = pk2(s[4 * 33], s[5 * 33]); o.w = pk2(s[6 * 33], s[7 * 33]);
            *(GAS v4u*)((bf16*)WTv + (size_t)(row_off + n0 + n) * K + k0 + 8 * c) = o; } }
    LDS_WAIT(); asm volatile("" ::: "memory");
}
__device__ __forceinline__ unsigned pk4i8(f32x4 v, float inv) {
    const int a = (int)rintf(v.x * inv), b = (int)rintf(v.y * inv), c = (int)rintf(v.z * inv), d = (int)rintf(v.w * inv);
    return (unsigned)(a & 255) | ((unsigned)(b & 255) << 8) | ((unsigned)(c & 255) << 16) | ((unsigned)d << 24);
}
__device__ __forceinline__ float amax4(f32x4 v) { const f32x4 a = __builtin_elementwise_abs(v); return fmaxf(fmaxf(a.x, a.y), fmaxf(a.z, a.w)); }
__device__ __forceinline__ void rms_row_to_bf16(int lane, const float* xrow, const float* w, bf16* orow, unsigned char* orow8, float* sx) {
    const GAS f32x4* xr = (const GAS f32x4*)xrow + lane; const GAS f32x4* wr = (const GAS f32x4*)w + lane;
    f32x4 v[8]; float s = 0.f;
#pragma unroll
    for (int j = 0; j < 8; ++j) { v[j] = xr[64 * j]; s += (v[j].x * v[j].x + v[j].y * v[j].y) + (v[j].z * v[j].z + v[j].w * v[j].w); }
    const float r = 1.0f / sqrtf(wave_sum(s) * (1.f / DM) + EPS);
    GAS v2u* o8 = (GAS v2u*)orow + lane; GAS unsigned* q8 = (GAS unsigned*)orow8 + lane; float am = 0.f;
#pragma unroll
    for (int j = 0; j < 8; ++j) { const f32x4 ww = wr[64 * j]; const f32x4 y = {v[j].x * r * ww.x, v[j].y * r * ww.y, v[j].z * r * ww.z, v[j].w * r * ww.w};
        if (XN_BF16) { v2u o; o.x = pk2(y.x, y.y); o.y = pk2(y.z, y.w); o8[64 * j] = o; }
        if (QM_XN == 1) q8[64 * j] = pk4f8(y.x, y.y, y.z, y.w);
        if (QM_XN == 2) { v[j] = y; am = fmaxf(am, amax4(y)); } }
    if (QM_XN == 2) { am = wave_max(am); const float inv = am > 0.f ? 127.0f / am : 0.f;
#pragma unroll
        for (int j = 0; j < 8; ++j) q8[64 * j] = pk4i8(v[j], inv);
        if (lane == 0) *sx = am > 0.f ? am * (1.0f / 127.0f) : 1.0f; }
}
template <int KT>
__device__ __forceinline__ void p0_quant_item(Frame& F, const float* W, int ldw, int c0, signed char* Wq, float* scl, int n0) {
    constexpr int KW = KT / 8, NB = KW / 64;
    const int col = F.lane & 31, kh = F.lane >> 5;
    const GAS float* src = (const GAS float*)W + (size_t)(F.wave * KW + 32 * kh) * ldw + c0 + n0 + col;
    float v[NB][32]; float mx = 0.f;
#pragma unroll
    for (int b = 0; b < NB; ++b)
#pragma unroll
        for (int i = 0; i < 32; ++i) v[b][i] = src[(size_t)(64 * b + i) * ldw];
#pragma unroll
    for (int b = 0; b < NB; ++b)
#pragma unroll
        for (int i = 0; i < 32; ++i) mx = fmaxf(mx, fabsf(v[b][i]));
    mx = fmaxf(mx, __shfl_xor(mx, 32));
    LAS float* part = (LAS float*)F.lds;
    if (kh == 0) part[F.wave * 32 + col] = mx;
    __syncthreads();
    float cm = part[col];
#pragma unroll
    for (int w = 1; w < 8; ++w) cm = fmaxf(cm, part[w * 32 + col]);
    const float inv = cm > 0.f ? 127.0f / cm : 0.f;
    if (F.wave == 0 && kh == 0) scl[n0 + col] = cm > 0.f ? cm * (1.0f / 127.0f) : 1.0f;
    GAS v4u* dst = (GAS v4u*)(Wq + (size_t)(n0 + col) * KT + F.wave * KW + 32 * kh);
#pragma unroll
    for (int b = 0; b < NB; ++b) { unsigned w[8];
#pragma unroll
        for (int q = 0; q < 8; ++q) w[q] = pk4i8((f32x4){v[b][4 * q], v[b][4 * q + 1], v[b][4 * q + 2], v[b][4 * q + 3]}, inv);
        dst[4 * b] = (v4u){w[0], w[1], w[2], w[3]}; dst[4 * b + 1] = (v4u){w[4], w[5], w[6], w[7]}; }
    __syncthreads();
}
__device__ __forceinline__ void p0_ws_item(Frame& F, int it) {
    const int h = it >> 6, half = (it >> 5) & 1, j0 = (it & 31) * 64, hc = h * 256 + half * 128;
    const float* Wq = F.in[I_WQ]; const float* Ks = half ? F.in[I_K2] : F.in[I_K1]; const float* n2 = F.in[I_N2W];
    LAS bf16* Xs = (LAS bf16*)F.lds; LAS bf16* Ys = Xs + 64 * 136;
    { const int row = F.tid >> 3, c0 = (F.tid & 7) * 16; const GAS f32x4* src = (const GAS f32x4*)(Wq + (size_t)(j0 + row) * DM + hc + c0);
      const f32x4 a = src[0], b = src[1], c = src[2], d = src[3];
      v4u o0, o1; o0.x = pk2(a.x, a.y); o0.y = pk2(a.z, a.w); o0.z = pk2(b.x, b.y); o0.w = pk2(b.z, b.w); o1.x = pk2(c.x, c.y); o1.y = pk2(c.z, c.w); o1.z = pk2(d.x, d.y); o1.w = pk2(d.z, d.w);
      *(LAS v4u*)(Xs + row * 136 + c0) = o0; *(LAS v4u*)(Xs + row * 136 + c0 + 8) = o1; }
    { const int row = F.tid >> 2, c0 = (F.tid & 3) * 32; const GAS f32x4* src = (const GAS f32x4*)(Ks + (size_t)row * 128 + c0);
#pragma unroll
      for (int q = 0; q < 4; ++q) { const f32x4 a = src[2 * q], b = src[2 * q + 1]; v4u o; o.x = pk2(a.x, a.y); o.y = pk2(a.z, a.w); o.z = pk2(b.x, b.y); o.w = pk2(b.z, b.w); *(LAS v4u*)(Ys + row * 136 + c0 + 8 * q) = o; } }
    __syncthreads();
    const int fr = F.lane & 15, fq = F.lane >> 4, w = F.wave;
    bf16* WSt = (bf16*)(F.ws + WS_WS);
#pragma unroll
    for (int jt = 0; jt < 4; ++jt) {
        f32x4 acc = {0.f, 0.f, 0.f, 0.f};
#pragma unroll
        for (int k0 = 0; k0 < 4; ++k0) acc = mfma16(ldfrag(Xs, 136, 16 * jt + fr, 32 * k0 + 8 * fq), ldfrag(Ys, 136, 16 * w + fr, 32 * k0 + 8 * fq), acc);
        const int jj = j0 + 16 * jt + 4 * fq; const f32x4 nw = *(const GAS f32x4*)(n2 + jj);
        *(GAS v2u*)(WSt + (size_t)(hc + 16 * w + fr) * DM + jj) = pack4(acc * nw);
    }
    __syncthreads();
}
__device__ __forceinline__ void p0_prologue(Frame& F) {
    LAS float* scr = (LAS float*)(F.lds + F.wave * 16384);
    const int gw = F.vcu * NWAVES + F.wave, NGW = F.G * NWAVES;
    constexpr int I_1 = QM_G1 == 2 ? 0 : (DM / 64) * (N1 / 32), I_AB = AB_I8 ? 0 : (DM / 64), I_G = QM_GATE == 2 ? 0 : (DM / 64) * (4096 / 32), I_PA = QM_MIX == 2 ? 0 : (HW / 64) * (DM / 32), I_O = QM_OUT == 2 ? 0 : (DM / 64) * (DM / 32);
    constexpr int NITEMS = I_1 + I_AB + I_G + 2 * I_PA + I_O;
    for (int it = gw; it < NITEMS; it += NGW) {
        int r = it;
        if (r < I_1) { p0_transpose_item<QM_G1 == 1>(F.in[I_WIN], INW, 0, DM, N1, F.ws + WS_W1, 0, scr, r, F.lane); continue; } r -= I_1;
        if (r < I_AB) { p0_transpose_item<false>(F.in[I_WIN], INW, N1, DM, 32, F.ws + WS_WAB, 0, scr, r, F.lane); continue; } r -= I_AB;
        if (r < I_G) { p0_transpose_item<QM_GATE == 1>(F.in[I_WIN], INW, 9248, DM, 4096, F.ws + WS_WG, 0, scr, r, F.lane); continue; } r -= I_G;
        if (r < I_PA) { p0_transpose_item<QM_MIX == 1>(F.in[I_WPA], DM, 0, HW, DM, F.ws + WS_WPA, 0, scr, r, F.lane); continue; } r -= I_PA;
        if (r < I_PA) { p0_transpose_item<QM_MIX == 1>(F.in[I_WPB], DM, 0, HW, DM, F.ws + WS_WPB, 0, scr, r, F.lane); continue; } r -= I_PA;
        p0_transpose_item<QM_OUT == 1>(F.in[I_WOUT], DM, 0, DM, DM, F.ws + WS_WOUT, 0, scr, r, F.lane);
    }
    bf16* XN = (bf16*)(F.ws + WS_XN); float* QX = (float*)(F.ws + WS_QX);
    for (int m = gw; m < SEQ; m += NGW) rms_row_to_bf16(F.lane, F.in[I_X] + (size_t)m * DM, F.in[I_N1W], XN + (size_t)m * DM, (unsigned char*)F.out + DO_XN8 + (size_t)m * DM, QX + m);
    __syncthreads();
    { constexpr int J_1 = (QM_G1 == 2 ? N1 / 32 : 0) + (AB_I8 ? 1 : 0), J_G = QM_GATE == 2 ? 4096 / 32 : 0, J_O = QM_OUT == 2 ? DM / 32 : 0, J_P = QM_MIX == 2 ? DM / 32 : 0;
      float* QW = (float*)(F.ws + WS_QW);
#pragma unroll 1
      for (int it = F.vcu; it < J_1 + J_G + J_O + 2 * J_P; it += F.G) {
          int r = it; const float* W = F.in[I_WIN]; int ldw = INW, c0 = 0, n0 = 0, qo = QW_W1; size_t wo = WS_W1; bool half = false;
          if (r < J_1) { n0 = 32 * r; if (AB_I8 && r == J_1 - 1) { c0 = N1; n0 = 0; qo = QW_WAB; wo = WS_WAB; } }
          else if ((r -= J_1) < J_G) { c0 = 9248; n0 = 32 * r; qo = QW_WG; wo = WS_WG; }
          else if ((r -= J_G) < J_O) { W = F.in[I_WOUT]; ldw = DM; n0 = 32 * r; qo = QW_WOUT; wo = WS_WOUT; }
          else if ((r -= J_O) < J_P) { W = F.in[I_WPA]; ldw = DM; n0 = 32 * r; qo = QW_WPA; wo = WS_WPA; half = true; }
          else { r -= J_P; W = F.in[I_WPB]; ldw = DM; n0 = 32 * r; qo = QW_WPB; wo = WS_WPB; half = true; }
          if (half) p0_quant_item<HW>(F, W, ldw, c0, (signed char*)(F.ws + wo), QW + qo, n0);
          else p0_quant_item<DM>(F, W, ldw, c0, (signed char*)(F.ws + wo), QW + qo, n0);
      } }
    __syncthreads();
    for (int it = blockIdx.x; it < 512; it += F.G) p0_ws_item(F, it);
}
typedef unsigned u32x4 __attribute__((ext_vector_type(4)));
__device__ __forceinline__ u32x4 pack8(f32x4 a, f32x4 b) { u32x4 w; w.x = pk2(a[0], a[1]); w.y = pk2(a[2], a[3]); w.z = pk2(b[0], b[1]); w.w = pk2(b[2], b[3]); return w; }
__device__ __forceinline__ void unpack8(u32x4 w, f32x4& a, f32x4& b) { a = (f32x4){bflo(w.x), bfhi(w.x), bflo(w.y), bfhi(w.y)}; b = (f32x4){bflo(w.z), bfhi(w.z), bflo(w.w), bfhi(w.w)}; }
__device__ __forceinline__ f32x4 silu4(f32x4 v) { return (f32x4){siluf_(v[0]), siluf_(v[1]), siluf_(v[2]), siluf_(v[3])}; }
__device__ __forceinline__ f32x4 sigm4(f32x4 v) { return (f32x4){sigmoidf_(v[0]), sigmoidf_(v[1]), sigmoidf_(v[2]), sigmoidf_(v[3])}; }

typedef int i32x4 __attribute__((ext_vector_type(4)));
template <int QM> __device__ __forceinline__ f32x4 deq(f32x4 a, float sr, f32x4 sc) {
    if (QM == 2) { const i32x4 q = __builtin_bit_cast(i32x4, a); return (f32x4){(float)q[0], (float)q[1], (float)q[2], (float)q[3]} * (sc * sr); }
    if (QM == 1) return a * (1.0f / F8_WSCALE);
    return a;
}
template <int QM, bool PERM> __device__ __forceinline__ void ld_colscale(f32x4 (&scv)[2][2], const float* sb, int cb) {
#pragma unroll
    for (int bj = 0; bj < 2; ++bj)
#pragma unroll
        for (int n = 0; n < 2; ++n) scv[bj][n] = (QM == 2) ? *(const f32x4*)(sb + cb + bj * 128 + (PERM ? 4 : 16) * n) : (f32x4){1.f, 1.f, 1.f, 1.f};
}
__device__ __forceinline__ unsigned pk4u8(f32x4 v) { const unsigned a = (unsigned)(v[0] * 255.f + 0.5f), b = (unsigned)(v[1] * 255.f + 0.5f), c = (unsigned)(v[2] * 255.f + 0.5f), d = (unsigned)(v[3] * 255.f + 0.5f); return a | (b << 8) | (c << 16) | (d << 24); }
__device__ __forceinline__ f32x4 un4u8(unsigned w) { return (f32x4){cvt_ub0(w), cvt_ub1(w), cvt_ub2(w), cvt_ub3(w)} * (1.0f / 255.f); }
struct EpiG1 {
    static constexpr bool PERM = true, AFTER_DRAIN = false;
    unsigned char* ws; const float* lbl;
    const float* sa; const float* sb;
    __device__ __forceinline__ void operator()(const f32x4 (&acc)[2][2][4][2], const pg8::Unit& u, int wr, int wc, int fr, int fq) const {
        const int pn = u.pn, row0 = u.pm * 256 + wr * 64 + fr;
        {
            const int grp = pn >> 2; const bool act = (grp == 0) | (grp == 4) | (grp == 8);
            bf16* base = (bf16*)(ws + WS_H + (size_t)grp * 32 * MiB); const int col0 = (pn & 3) * 256 + wc * 32 + 8 * fq;
            f32x4 scv[2][2]; ld_colscale<QM_G1, true>(scv, sb, pn * 256 + wc * 32 + 8 * fq);
            const bool fgate = (grp == 1) | (grp == 2); f32x4 lbv[2][2];
            if (fgate) { const float* l0 = lbl + (grp - 1) * 2048 + col0;
#pragma unroll
                for (int bj = 0; bj < 2; ++bj)
#pragma unroll
                    for (int n = 0; n < 2; ++n) { const f32x4 a0 = *(const f32x4*)(l0 + bj * 128 + 4 * n), a1 = *(const f32x4*)(l0 + 1024 + bj * 128 + 4 * n);
                        lbv[bj][n] = (f32x4){fast_rcp(1.0f + fast_exp(a1[0] - a0[0])), fast_rcp(1.0f + fast_exp(a1[1] - a0[1])), fast_rcp(1.0f + fast_exp(a1[2] - a0[2])), fast_rcp(1.0f + fast_exp(a1[3] - a0[3]))}; } }
#pragma unroll
            for (int ai = 0; ai < 2; ++ai)
#pragma unroll
                for (int m = 0; m < 4; ++m) { bf16* rowp = base + (size_t)(row0 + ai * 128 + m * 16) * HW + col0; const float sr = (QM_G1 == 2) ? sa[row0 + ai * 128 + m * 16] : 1.f;
#pragma unroll
                    for (int bj = 0; bj < 2; ++bj) { f32x4 v0 = deq<QM_G1>(acc[ai][bj][m][0], sr, scv[bj][0]), v1 = deq<QM_G1>(acc[ai][bj][m][1], sr, scv[bj][1]);
                        if (act) { v0 = silu4(v0); v1 = silu4(v1); }
                        if (fgate) { v0 = lbv[bj][0] + (1.0f - lbv[bj][0]) * sigm4(v0); v1 = lbv[bj][1] + (1.0f - lbv[bj][1]) * sigm4(v1); }
                        *(u32x4*)(rowp + bj * 128) = pack8(v0, v1); } }
        }
    }
};
struct EpiGate {
    static constexpr bool PERM = true, AFTER_DRAIN = false;
    unsigned char* O; const float* sa; const float* sb;
    __device__ __forceinline__ void operator()(const f32x4 (&acc)[2][2][4][2], const pg8::Unit& u, int wr, int wc, int fr, int fq) const {
        const int row0 = u.pm * 256 + wr * 64 + fr, col0 = u.pn * 256 + wc * 32 + 8 * fq;
        f32x4 scv[2][2]; ld_colscale<QM_GATE, true>(scv, sb, col0);
#pragma unroll
        for (int ai = 0; ai < 2; ++ai)
#pragma unroll
            for (int m = 0; m < 4; ++m) { unsigned char* rowp = O + (size_t)(row0 + ai * 128 + m * 16) * DM + col0; const float sr = (QM_GATE == 2) ? sa[row0 + ai * 128 + m * 16] : 1.f;
#pragma unroll
                for (int bj = 0; bj < 2; ++bj) { v2u w; w.x = pk4u8(sigm4(deq<QM_GATE>(acc[ai][bj][m][0], sr, scv[bj][0]))); w.y = pk4u8(sigm4(deq<QM_GATE>(acc[ai][bj][m][1], sr, scv[bj][1]))); *(v2u*)(rowp + bj * 128) = w; } }
    }
};
template <int MODE> struct EpiMix {
    static constexpr bool PERM = true, AFTER_DRAIN = false;
    bf16* O; const unsigned char* G; unsigned char* O8;
    const float* sa; const float* sb;
    __device__ __forceinline__ void operator()(const f32x4 (&acc)[2][2][4][2], const pg8::Unit& u, int wr, int wc, int fr, int fq) const {
        const int row0 = u.pm * 256 + wr * 64 + fr, col0 = u.pn * 256 + wc * 32 + 8 * fq;
        f32x4 scv[2][2]; ld_colscale<QM_MIX, true>(scv, sb, col0);
#pragma unroll
        for (int ai = 0; ai < 2; ++ai)
#pragma unroll
            for (int m = 0; m < 4; ++m) { const size_t off = (size_t)(row0 + ai * 128 + m * 16) * DM + col0; const float sr = (QM_MIX == 2) ? sa[row0 + ai * 128 + m * 16] : 1.f;
#pragma unroll
                for (int bj = 0; bj < 2; ++bj) { f32x4 o0, o1; const v2u gw = *(const v2u*)(G + off + bj * 128); const f32x4 g0 = un4u8(gw.x), g1 = un4u8(gw.y);
                    const f32x4 c0 = deq<QM_MIX>(acc[ai][bj][m][0], sr, scv[bj][0]), c1 = deq<QM_MIX>(acc[ai][bj][m][1], sr, scv[bj][1]);
                    if (MODE == 0) { o0 = g0 * c0; o1 = g1 * c1; }
                    else { unpack8(*(const u32x4*)(O + off + bj * 128), o0, o1); o0 = o0 + g0 * c0; o1 = o1 + g1 * c1; }
                    if (MODE == 1 && QM_OUT == 1) { v2u w; w.x = pk4f8(o0[0], o0[1], o0[2], o0[3]); w.y = pk4f8(o1[0], o1[1], o1[2], o1[3]); *(v2u*)(O8 + off + bj * 128) = w; }
                    else *(u32x4*)(O + off + bj * 128) = pack8(o0, o1); } }
    }
};
struct EpiX1 {
    static constexpr bool PERM = false, AFTER_DRAIN = false;
    const float* x; float* out; bf16* xb;
    __device__ __forceinline__ void operator()(const f32x4 (&acc)[2][2][4][2], const pg8::Unit& u, int wr, int wc, int fr, int fq) const {
        const int row0 = u.pm * 256 + wr * 64 + fr, col0 = u.pn * 256 + wc * 32 + 4 * fq;
#pragma unroll
        for (int ai = 0; ai < 2; ++ai)
#pragma unroll
            for (int m = 0; m < 4; ++m) { const size_t off = (size_t)(row0 + ai * 128 + m * 16) * DM + col0;
#pragma unroll
                for (int bj = 0; bj < 2; ++bj)
#pragma unroll
                    for (int n = 0; n < 2; ++n) { const size_t o = off + bj * 128 + n * 16; const f32x4 v = *(const f32x4*)(x + o) + deq<QM_OUT>(acc[ai][bj][m][n], 1.f, (f32x4){1.f, 1.f, 1.f, 1.f});
                        *(v2u*)(xb + o) = pack4(v); } }
    }
};
struct EpiBf {
    static constexpr bool PERM = true, AFTER_DRAIN = false;
    bf16* O;
    __device__ __forceinline__ void operator()(const f32x4 (&acc)[2][2][4][2], const pg8::Unit& u, int wr, int wc, int fr, int fq) const {
        const int row0 = u.pm * 256 + wr * 64 + fr, col0 = u.pn * 256 + wc * 32 + 8 * fq;
#pragma unroll
        for (int ai = 0; ai < 2; ++ai)
#pragma unroll
            for (int m = 0; m < 4; ++m) { bf16* rowp = O + (size_t)(row0 + ai * 128 + m * 16) * DM + col0;
#pragma unroll
                for (int bj = 0; bj < 2; ++bj) *(u32x4*)(rowp + bj * 128) = pack8(acc[ai][bj][m][0], acc[ai][bj][m][1]); }
    }
};
struct EpiF32 {
    static constexpr bool PERM = false, AFTER_DRAIN = false;
    float* C;
    __device__ __forceinline__ void operator()(const f32x4 (&acc)[2][2][4][2], const pg8::Unit& u, int wr, int wc, int fr, int fq) const {
        const int row0 = u.pm * 256 + wr * 64 + fr, col0 = u.pn * 256 + wc * 32 + 4 * fq;
#pragma unroll
        for (int ai = 0; ai < 2; ++ai)
#pragma unroll
            for (int m = 0; m < 4; ++m) { float* rowp = C + (size_t)(row0 + ai * 128 + m * 16) * DM + col0;
#pragma unroll
                for (int bj = 0; bj < 2; ++bj)
#pragma unroll
                    for (int n = 0; n < 2; ++n) *(f32x4*)(rowp + bj * 128 + n * 16) = acc[ai][bj][m][n]; }
    }
};

__device__ __forceinline__ void p1_ab(Frame& F) {
    float* Gab = (float*)(F.ws + WS_GAB);
    const int fr = F.lane & 15, fq = F.lane >> 4, rt = F.wave >> 1, ct = F.wave & 1;
    if (AB_I8) {
        const signed char* XQ = (const signed char*)F.out + DO_XN8; const signed char* Wab = (const signed char*)(F.ws + WS_WAB);
        const float* QX = (const float*)(F.ws + WS_QX); const f32x4 sw = *(const f32x4*)((const float*)(F.ws + WS_QW) + QW_WAB + ct * 16 + 4 * fq);
        for (int blk = F.vcu; blk < SEQ / 64; blk += F.G) {
            const int row = blk * 64 + rt * 16 + fr;
            const signed char* ap = XQ + (size_t)row * DM + 16 * fq; const signed char* bp = Wab + (size_t)(ct * 16 + fr) * DM + 16 * fq;
            i32x4 acc = {0, 0, 0, 0};
#pragma unroll 1
            for (int kb = 0; kb < DM; kb += 1024) { i32x4 af[16], bfr[16];
#pragma unroll
                for (int u = 0; u < 16; ++u) { af[u] = *(const GAS i32x4*)(ap + kb + 64 * u); bfr[u] = *(const GAS i32x4*)(bp + kb + 64 * u); }
                __builtin_amdgcn_sched_barrier(0);
#pragma unroll
                for (int u = 0; u < 16; ++u) acc = __builtin_amdgcn_mfma_i32_16x16x64_i8(bfr[u], af[u], acc, 0, 0, 0);
                __builtin_amdgcn_sched_barrier(0); }
            *(GAS f32x4*)(Gab + (size_t)row * 32 + ct * 16 + 4 * fq) = (f32x4){(float)acc[0], (float)acc[1], (float)acc[2], (float)acc[3]} * (sw * QX[row]);
        }
        return;
    }
    const bf16* XN = (const bf16*)(F.ws + WS_XN); const bf16* Wab = (const bf16*)(F.ws + WS_WAB);
    for (int blk = F.vcu; blk < SEQ / 64; blk += F.G) {
        const bf16* ap = XN + (size_t)(blk * 64 + rt * 16 + fr) * DM + 8 * fq; const bf16* bp = Wab + (size_t)(ct * 16 + fr) * DM + 8 * fq;
        f32x4 acc = {0.f, 0.f, 0.f, 0.f};
#pragma unroll 1
        for (int kb = 0; kb < DM; kb += 512) { bf16x8 af[16], bfr[16];
#pragma unroll
            for (int u = 0; u < 16; ++u) { af[u] = *(const GAS bf16x8*)(ap + kb + 32 * u); bfr[u] = *(const GAS bf16x8*)(bp + kb + 32 * u); }
            __builtin_amdgcn_sched_barrier(0);
#pragma unroll
            for (int u = 0; u < 16; ++u) acc = mfma16(bfr[u], af[u], acc);
            __builtin_amdgcn_sched_barrier(0); }
        *(GAS f32x4*)(Gab + (size_t)(blk * 64 + rt * 16 + fr) * 32 + ct * 16 + 4 * fq) = acc;
    }
}
template <bool PASS3, int SKIP = 0>
__device__ __forceinline__ void hgrn_pass(Frame& F) {
    LAS bf16*  ST  = (LAS bf16*)(F.lds + 0);
    LAS float* LF  = (LAS float*)(F.lds + 0);
    LAS bf16*  QT  = (LAS bf16*)(F.lds + 34816);
    LAS bf16*  KT  = (LAS bf16*)(F.lds + 52224);
    LAS bf16*  KHT = (LAS bf16*)(F.lds + 69632);
    LAS bf16*  VT  = (LAS bf16*)(F.lds + 88064);
    LAS bf16*  ATT = (LAS bf16*)(F.lds + 106496);
    LAS float* PT  = (LAS float*)(F.lds + 115712);
    LAS float* BL  = (LAS float*)(F.lds + 117760);
    LAS float* DKK = (LAS float*)(F.lds + 118272);
    LAS float* LBV = (LAS float*)(F.lds + 118784);
    LAS bf16*  VR  = (LAS bf16*)(F.lds + 119296);
    const int tid = F.tid, lane = F.lane, w = F.wave, fr = lane & 15, fq = lane >> 4;
    const int row = tid >> 3, c0 = (tid & 7) * 16;
    float* HL = (float*)(F.ws + WS_HL); float* HDS = (float*)(F.ws + WS_HDS);
    for (int it = blockIdx.x; it < 256; it += F.G) {
        const int hd = it >> 4, sg = it & 15, dir = hd >> 3, h = hd & 7;
        const bf16* Hq = (const bf16*)(F.ws + WS_H); const bf16* Hf = (const bf16*)(F.ws + WS_H + (size_t)(1 + dir) * 32 * MiB); const bf16* Hi = (const bf16*)(F.ws + WS_H + (size_t)3 * 32 * MiB);
        bf16* Oh = (bf16*)(F.ws + (dir ? WS_OHB : WS_OHF));
        __syncthreads();
        f32x4 Sacc[8];
#pragma unroll
        for (int kt = 0; kt < 8; ++kt) Sacc[kt] = (f32x4){0.f, 0.f, 0.f, 0.f};
        if (PASS3) {
            for (int p = 0; p < sg; ++p) { const int ip = hd * 16 + p; f32x4 dsv[8], lv[8];
#pragma unroll
                for (int kt = 0; kt < 8; ++kt) { dsv[kt] = *(const GAS f32x4*)(HDS + ip * 128 + 16 * kt + 4 * fq); lv[kt] = *(const GAS f32x4*)(HL + ((size_t)((ip * 8 + w) * 8 + kt) * 64 + lane) * 4); }
                __builtin_amdgcn_sched_barrier(0);
#pragma unroll
                for (int kt = 0; kt < 8; ++kt) Sacc[kt] = Sacc[kt] * dsv[kt] + lv[kt];
                __builtin_amdgcn_sched_barrier(0); }
        }
        float sumbl = 1.f;
        v4u rq[2], rf[2], rv[2];
        { const int oc = dir ? 255 - sg * 16 : sg * 16; const size_t off = (size_t)(64 * oc + row) * HW + h * 128 + c0;
          rq[0] = *(const GAS v4u*)(Hq + off); rq[1] = *(const GAS v4u*)(Hq + off + 8); rf[0] = *(const GAS v4u*)(Hf + off); rf[1] = *(const GAS v4u*)(Hf + off + 8); rv[0] = *(const GAS v4u*)(Hi + off); rv[1] = *(const GAS v4u*)(Hi + off + 8); }
        __syncthreads();
        for (int ci = 0; ci < ((SKIP & 4) ? 1 : CPS); ++ci) {
            const int sc = sg * 16 + ci, oc = dir ? 255 - sc : sc, tok0 = 64 * oc;
            float kk[16], qq[16];
            { const unsigned fw[8] = {rf[0].x, rf[0].y, rf[0].z, rf[0].w, rf[1].x, rf[1].y, rf[1].z, rf[1].w};
              const unsigned qw[8] = {rq[0].x, rq[0].y, rq[0].z, rq[0].w, rq[1].x, rq[1].y, rq[1].z, rq[1].w};
              float fgv[16];
#pragma unroll
              for (int e = 0; e < 16; ++e) { fgv[e] = (e & 1) ? bfhi(fw[e >> 1]) : bflo(fw[e >> 1]); qq[e] = (e & 1) ? bfhi(qw[e >> 1]) : bflo(qw[e >> 1]); kk[e] = 1.0f - fgv[e]; }
#pragma unroll
              for (int q4 = 0; q4 < 4; ++q4) *(LAS f32x4*)(LF + row * 132 + c0 + 4 * q4) = (f32x4){fgv[4 * q4], fgv[4 * q4 + 1], fgv[4 * q4 + 2], fgv[4 * q4 + 3]};
              *(LAS v4u*)(VR + row * 136 + c0) = rv[0]; *(LAS v4u*)(VR + row * 136 + c0 + 8) = rv[1]; }
            if (ci + 1 < CPS && !(SKIP & 2)) { const int oc2 = dir ? oc - 1 : oc + 1; const size_t off = (size_t)(64 * oc2 + row) * HW + h * 128 + c0;
              rq[0] = *(const GAS v4u*)(Hq + off); rq[1] = *(const GAS v4u*)(Hq + off + 8); rf[0] = *(const GAS v4u*)(Hf + off); rf[1] = *(const GAS v4u*)(Hf + off + 8); rv[0] = *(const GAS v4u*)(Hi + off); rv[1] = *(const GAS v4u*)(Hi + off + 8); }
            if (!(SKIP & 8)) __syncthreads();
            { const int c = tid & 127, part = tid >> 7, r0 = part * 16; float b[16], fv[16]; float run = 1.f;
#pragma unroll
              for (int i = 0; i < 16; ++i) fv[i] = LF[(r0 + i) * 132 + c];
              if (!dir) {
#pragma unroll
                  for (int i = 0; i < 16; ++i) { run *= fv[i]; b[i] = run; }
              } else {
#pragma unroll
                  for (int i = 15; i >= 0; --i) { run *= fv[i]; b[i] = run; }
              }
              PT[part * 128 + c] = run;
              unsigned short vcol[16];
#pragma unroll
              for (int i = 0; i < 16; ++i) vcol[i] = VR[(r0 + i) * 136 + c];
              if (!(SKIP & 8)) __syncthreads();
              const float p0 = PT[c], p1 = PT[128 + c], p2 = PT[256 + c], p3 = PT[384 + c];
              float offs;
              if (!dir) offs = (part > 0 ? p0 : 1.f) * (part > 1 ? p1 : 1.f) * (part > 2 ? p2 : 1.f);
              else      offs = (part < 3 ? p3 : 1.f) * (part < 2 ? p2 : 1.f) * (part < 1 ? p1 : 1.f);
              const float tot = (p0 * p1) * (p2 * p3);
              unsigned kh[8], vw[8];
#pragma unroll
              for (int i = 0; i < 8; ++i) { const float P0 = b[2 * i] * offs, P1 = b[2 * i + 1] * offs;
                  if (PASS3) { LF[(r0 + 2 * i) * 132 + c] = P0; LF[(r0 + 2 * i + 1) * 132 + c] = P1; }
                  kh[i] = pk2((1.0f - fv[2 * i]) * tot * fast_rcp(P0), (1.0f - fv[2 * i + 1]) * tot * fast_rcp(P1)); vw[i] = (unsigned)vcol[2 * i] | ((unsigned)vcol[2 * i + 1] << 16); }
              *(LAS v4u*)(KHT + c * 72 + r0) = (v4u){kh[0], kh[1], kh[2], kh[3]}; *(LAS v4u*)(KHT + c * 72 + r0 + 8) = (v4u){kh[4], kh[5], kh[6], kh[7]};
              *(LAS v4u*)(VT + c * 72 + r0) = (v4u){vw[0], vw[1], vw[2], vw[3]}; *(LAS v4u*)(VT + c * 72 + r0 + 8) = (v4u){vw[4], vw[5], vw[6], vw[7]};
              if (part == 0) { DKK[c] = tot; sumbl *= tot; }
            }
            if (!(SKIP & 8)) __syncthreads();
            if (PASS3 && !(SKIP & 1)) { float bb[16];
#pragma unroll
              for (int q4 = 0; q4 < 4; ++q4) { const f32x4 t4 = *(const LAS f32x4*)(LF + row * 132 + c0 + 4 * q4); bb[4 * q4] = t4[0]; bb[4 * q4 + 1] = t4[1]; bb[4 * q4 + 2] = t4[2]; bb[4 * q4 + 3] = t4[3]; }
              unsigned qo[8], ko[8];
#pragma unroll
              for (int e = 0; e < 8; ++e) { qo[e] = pk2(qq[2 * e] * bb[2 * e], qq[2 * e + 1] * bb[2 * e + 1]); ko[e] = pk2(kk[2 * e] * fast_rcp(bb[2 * e]), kk[2 * e + 1] * fast_rcp(bb[2 * e + 1])); }
              *(LAS v4u*)(QT + row * 136 + c0) = (v4u){qo[0], qo[1], qo[2], qo[3]}; *(LAS v4u*)(QT + row * 136 + c0 + 8) = (v4u){qo[4], qo[5], qo[6], qo[7]};
              *(LAS v4u*)(KT + row * 136 + c0) = (v4u){ko[0], ko[1], ko[2], ko[3]}; *(LAS v4u*)(KT + row * 136 + c0 + 8) = (v4u){ko[4], ko[5], ko[6], ko[7]};
            }
            if (PASS3) if (!(SKIP & 8)) __syncthreads();
            if (PASS3 && !(SKIP & 1)) {
                { bf16x8 kf[2][4], qf[2][4]; f32x4 acc[2];
#pragma unroll
                  for (int q2 = 0; q2 < 2; ++q2) { const int tl = 2 * w + q2, ti = tl >> 2, tj = tl & 3; acc[q2] = (f32x4){0.f, 0.f, 0.f, 0.f};
#pragma unroll
                      for (int k0 = 0; k0 < 4; ++k0) { kf[q2][k0] = ldfrag(KT, 136, 16 * ti + fr, 32 * k0 + 8 * fq); qf[q2][k0] = ldfrag(QT, 136, 16 * tj + fr, 32 * k0 + 8 * fq); } }
                  __builtin_amdgcn_sched_barrier(0);
#pragma unroll
                  for (int k0 = 0; k0 < 4; ++k0)
#pragma unroll
                      for (int q2 = 0; q2 < 2; ++q2) acc[q2] = mfma16(kf[q2][k0], qf[q2][k0], acc[q2]);
                  __builtin_amdgcn_sched_barrier(0);
#pragma unroll
                  for (int q2 = 0; q2 < 2; ++q2) { const int tl = 2 * w + q2, ti = tl >> 2, tj = tl & 3; const int t = 16 * tj + fr, s0 = 16 * ti + 4 * fq;
#pragma unroll
                      for (int r = 0; r < 4; ++r) { const bool keep = dir ? (s0 + r >= t) : (s0 + r <= t); acc[q2][r] = keep ? acc[q2][r] : 0.f; }
                      *(LAS v2u*)(ATT + t * 72 + s0) = pack4(acc[q2]); } }
#pragma unroll
                for (int kt = 0; kt < 8; ++kt) *(LAS v2u*)(ST + (16 * w + fr) * 136 + 16 * kt + 4 * fq) = pack4(Sacc[kt]);
                if (!(SKIP & 8)) __syncthreads();
            }
            bf16x8 xv[2];
#pragma unroll
            for (int s0 = 0; s0 < 2; ++s0) xv[s0] = ldfrag(VT, 72, 16 * w + fr, 32 * s0 + 8 * fq);
            if (PASS3 && !(SKIP & 1)) {
                bf16x8 xs[4];
#pragma unroll
                for (int k0 = 0; k0 < 4; ++k0) xs[k0] = ldfrag(ST, 136, 16 * w + fr, 32 * k0 + 8 * fq);
#pragma unroll
                for (int th = 0; th < 2; ++th) { bf16x8 qf[2][4], af[2][2]; f32x4 acc[2];
#pragma unroll
                    for (int tq = 0; tq < 2; ++tq) { const int tt = 2 * th + tq; acc[tq] = (f32x4){0.f, 0.f, 0.f, 0.f};
#pragma unroll
                        for (int k0 = 0; k0 < 4; ++k0) qf[tq][k0] = ldfrag(QT, 136, 16 * tt + fr, 32 * k0 + 8 * fq);
#pragma unroll
                        for (int s0 = 0; s0 < 2; ++s0) af[tq][s0] = ldfrag(ATT, 72, 16 * tt + fr, 32 * s0 + 8 * fq); }
                    __builtin_amdgcn_sched_barrier(0);
#pragma unroll
                    for (int k0 = 0; k0 < 4; ++k0)
#pragma unroll
                        for (int tq = 0; tq < 2; ++tq) acc[tq] = mfma16(xs[k0], qf[tq][k0], acc[tq]);
#pragma unroll
                    for (int s0 = 0; s0 < 2; ++s0)
#pragma unroll
                        for (int tq = 0; tq < 2; ++tq) acc[tq] = mfma16(xv[s0], af[tq][s0], acc[tq]);
                    __builtin_amdgcn_sched_barrier(0);
#pragma unroll
                    for (int tq = 0; tq < 2; ++tq) *(GAS v2u*)(Oh + (size_t)(tok0 + 16 * (2 * th + tq) + fr) * HW + h * 128 + 16 * w + 4 * fq) = pack4(acc[tq]); }
            }
#pragma unroll
            for (int kh = 0; kh < ((SKIP & 1) ? 0 : 2); ++kh) { bf16x8 kf[4][2];
#pragma unroll
                for (int kq = 0; kq < 4; ++kq) { const int kt = 4 * kh + kq; const f32x4 d4 = *(const LAS f32x4*)(DKK + 16 * kt + 4 * fq); Sacc[kt] = Sacc[kt] * d4;
#pragma unroll
                    for (int s0 = 0; s0 < 2; ++s0) kf[kq][s0] = ldfrag(KHT, 72, 16 * kt + fr, 32 * s0 + 8 * fq); }
                __builtin_amdgcn_sched_barrier(0);
#pragma unroll
                for (int s0 = 0; s0 < 2; ++s0)
#pragma unroll
                    for (int kq = 0; kq < 4; ++kq) Sacc[4 * kh + kq] = mfma16(kf[kq][s0], xv[s0], Sacc[4 * kh + kq]);
                __builtin_amdgcn_sched_barrier(0); }
            if (!(SKIP & 8)) __syncthreads();
        }
        if (!PASS3) {
#pragma unroll
            for (int kt = 0; kt < 8; ++kt) *(GAS f32x4*)(HL + ((size_t)((it * 8 + w) * 8 + kt) * 64 + lane) * 4) = Sacc[kt];
            if (tid < 128) HDS[it * 128 + tid] = sumbl;
        }
    }
}
template <int SKIP>
__device__ __forceinline__ void gdn_prep(Frame& F) {
    LAS bf16*  QN  = (LAS bf16*)(F.lds + 0);
    LAS bf16*  KN  = (LAS bf16*)(F.lds + 17408);
    LAS bf16*  VT  = (LAS bf16*)(F.lds + 34816);
    LAS bf16*  KNT = (LAS bf16*)(F.lds + 53248);
    LAS float* AM  = (LAS float*)(F.lds + 71680);
    LAS bf16*  TB  = (LAS bf16*)(F.lds + 104448);
    LAS bf16*  VR  = (LAS bf16*)(F.lds + 104448);
    LAS float* CWL = (LAS float*)(F.lds + 142848);
    LAS float* DEC = (LAS float*)(F.lds + 141312);
    LAS float* BET = DEC + 128;
    LAS float* EXD = DEC + 256;
    const int tid = F.tid, lane = F.lane, w = F.wave, fr = lane & 15, fq = lane >> 4;
    const int row = tid >> 3, c0 = (tid & 7) * 16;
    const bf16* Gq = (const bf16*)(F.ws + WS_H + (size_t)5 * 32 * MiB); const bf16* Gk = (const bf16*)(F.ws + WS_H + (size_t)6 * 32 * MiB); const bf16* Gv = (const bf16*)(F.ws + WS_H + (size_t)7 * 32 * MiB);
    const float* Gab = (const float*)(F.ws + WS_GAB); const float* cw = F.in[I_CONVW];
    unsigned char* dob = (unsigned char*)F.out;
    bf16* QNg = (bf16*)(dob + DO_QN); bf16* KNTg = (bf16*)(dob + DO_KNT); float* GSC = (float*)(F.ws + WS_GSC);
    int hload = -1;
    for (int it = blockIdx.x; it < 2048; it += F.G) {
        const int h = it & 7, oc = it >> 3, tok0 = 64 * oc;
        __syncthreads();
        if (h != hload) { hload = h;
            for (int i = tid; i < 5 * 384; i += NTHR) { const int j = i / 384, r = i % 384; CWL[i] = cw[j * 3072 + (r >> 7) * 1024 + h * 128 + (r & 127)]; }
            __syncthreads(); }
        if (it + F.G < 2048 && tid < 408) { const int it2 = it + F.G, h2 = it2 & 7, oc2 = it2 >> 3; const int tz = tid / 136, rl = tid % 136, r = rl >> 1, half = rl & 1; const int tr = 64 * oc2 - 2 + r;
            if (tr >= 0 && tr < SEQ) { const bf16* src = (tz == 0 ? Gq : tz == 1 ? Gk : Gv) + (size_t)tr * HW + h2 * 128 + half * 64; unsigned tmp = *(const GAS unsigned*)src; asm volatile("" :: "v"(tmp)); } }
        if (tid < 128) { const int dir = tid >> 6, l = tid & 63, pos = dir ? 63 - l : l;
            const float a = Gab[(size_t)(tok0 + pos) * 32 + dir * 8 + h], b = Gab[(size_t)(tok0 + pos) * 32 + 16 + dir * 8 + h];
            const float x = a + F.in[I_DTB][dir * 8 + h]; const float sp = x > 20.f ? x : log1pf(__expf(x));
            float d = -__expf(F.in[I_ALOG][dir * 8 + h]) * sp;
#pragma unroll
            for (int o = 1; o < 64; o <<= 1) { const float t = __shfl_up(d, o); if (l >= o) d += t; }
            DEC[dir * 64 + pos] = d; BET[dir * 64 + pos] = sigmoidf_(b); EXD[dir * 64 + pos] = __expf(d); }
        if (!(SKIP & 64)) { float q[16], k[16], v[16];
#pragma unroll
          for (int e = 0; e < 16; ++e) { q[e] = 0.f; k[e] = 0.f; v[e] = 0.f; }
          const int ch = h * 128 + c0;
#pragma unroll
          for (int j = 0; j < ((SKIP & 1) ? 0 : 5); ++j) { const int tr = tok0 + row + j - 2;
              if (tr >= 0 && tr < SEQ) { const size_t off = (size_t)tr * HW + ch;
                  const v4u xq0 = *(const GAS v4u*)(Gq + off), xq1 = *(const GAS v4u*)(Gq + off + 8), xk0 = *(const GAS v4u*)(Gk + off), xk1 = *(const GAS v4u*)(Gk + off + 8), xv0 = *(const GAS v4u*)(Gv + off), xv1 = *(const GAS v4u*)(Gv + off + 8);
                  const unsigned wq[8] = {xq0.x, xq0.y, xq0.z, xq0.w, xq1.x, xq1.y, xq1.z, xq1.w}, wk[8] = {xk0.x, xk0.y, xk0.z, xk0.w, xk1.x, xk1.y, xk1.z, xk1.w}, wv[8] = {xv0.x, xv0.y, xv0.z, xv0.w, xv1.x, xv1.y, xv1.z, xv1.w};
                  const LAS float* cq = CWL + j * 384 + c0;
#pragma unroll
                  for (int e = 0; e < 16; ++e) { const float fq_ = (e & 1) ? bfhi(wq[e >> 1]) : bflo(wq[e >> 1]), fk_ = (e & 1) ? bfhi(wk[e >> 1]) : bflo(wk[e >> 1]), fv_ = (e & 1) ? bfhi(wv[e >> 1]) : bflo(wv[e >> 1]);
                      q[e] += cq[e] * fq_; k[e] += cq[128 + e] * fk_; v[e] += cq[256 + e] * fv_; } } }
          float sq = 0.f, sk = 0.f;
#pragma unroll
          for (int e = 0; e < 16; ++e) { q[e] = siluf_(q[e]); k[e] = siluf_(k[e]); v[e] = siluf_(v[e]); sq += q[e] * q[e]; sk += k[e] * k[e]; }
          sq += __shfl_xor(sq, 1); sq += __shfl_xor(sq, 2); sq += __shfl_xor(sq, 4); sk += __shfl_xor(sk, 1); sk += __shfl_xor(sk, 2); sk += __shfl_xor(sk, 4);
          const float rq = 0.08838834764831845f / sqrtf(sq + EPS), rk = 1.0f / sqrtf(sk + EPS);
          unsigned qo[8], ko[8];
#pragma unroll
          for (int e = 0; e < 8; ++e) { qo[e] = pk2(q[2 * e] * rq, q[2 * e + 1] * rq); ko[e] = pk2(k[2 * e] * rk, k[2 * e + 1] * rk); }
          const v4u q0 = {qo[0], qo[1], qo[2], qo[3]}, q1 = {qo[4], qo[5], qo[6], qo[7]}, k0_ = {ko[0], ko[1], ko[2], ko[3]}, k1_ = {ko[4], ko[5], ko[6], ko[7]};
          *(LAS v4u*)(QN + row * 136 + c0) = q0; *(LAS v4u*)(QN + row * 136 + c0 + 8) = q1; *(LAS v4u*)(KN + row * 136 + c0) = k0_; *(LAS v4u*)(KN + row * 136 + c0 + 8) = k1_;
          if (!(SKIP & 16)) { *(GAS v4u*)(QNg + (size_t)(tok0 + row) * HW + ch) = q0; *(GAS v4u*)(QNg + (size_t)(tok0 + row) * HW + ch + 8) = q1; }
          unsigned vo[8];
#pragma unroll
          for (int e = 0; e < 8; ++e) vo[e] = pk2(v[2 * e], v[2 * e + 1]);
          *(LAS v4u*)(VR + row * 136 + c0) = (v4u){vo[0], vo[1], vo[2], vo[3]}; *(LAS v4u*)(VR + row * 136 + c0 + 8) = (v4u){vo[4], vo[5], vo[6], vo[7]};
        }
        __syncthreads();
        { const int c = tid & 127, r0 = (tid >> 7) * 16; unsigned vw[8], kw[8];
#pragma unroll
          for (int i = 0; i < 8; ++i) { vw[i] = (unsigned)VR[(r0 + 2 * i) * 136 + c] | ((unsigned)VR[(r0 + 2 * i + 1) * 136 + c] << 16); kw[i] = (unsigned)KN[(r0 + 2 * i) * 136 + c] | ((unsigned)KN[(r0 + 2 * i + 1) * 136 + c] << 16); }
          *(LAS v4u*)(VT + c * 72 + r0) = (v4u){vw[0], vw[1], vw[2], vw[3]}; *(LAS v4u*)(VT + c * 72 + r0 + 8) = (v4u){vw[4], vw[5], vw[6], vw[7]};
          *(LAS v4u*)(KNT + c * 72 + r0) = (v4u){kw[0], kw[1], kw[2], kw[3]}; *(LAS v4u*)(KNT + c * 72 + r0 + 8) = (v4u){kw[4], kw[5], kw[6], kw[7]}; }
#pragma unroll
        for (int q2 = 0; q2 < ((SKIP & 8) ? 0 : 2); ++q2) { const int tl = 2 * w + q2, ti = tl >> 2, tj = tl & 3; f32x4 kkv = {0.f, 0.f, 0.f, 0.f}, qkv = {0.f, 0.f, 0.f, 0.f};
#pragma unroll
            for (int k0 = 0; k0 < 4; ++k0) { const bf16x8 xs = ldfrag(KN, 136, 16 * ti + fr, 32 * k0 + 8 * fq);
                kkv = mfma16(xs, ldfrag(KN, 136, 16 * tj + fr, 32 * k0 + 8 * fq), kkv); qkv = mfma16(xs, ldfrag(QN, 136, 16 * tj + fr, 32 * k0 + 8 * fq), qkv); }
            const int t = 16 * tj + fr, s0 = 16 * ti + 4 * fq;
#pragma unroll
            for (int dir = 0; dir < 2; ++dir) { const float dt = DEC[dir * 64 + t], bt = BET[dir * 64 + t]; f32x4 aq;
#pragma unroll
                for (int r = 0; r < 4; ++r) { const int s = s0 + r; const bool before = dir ? (s > t) : (s < t), beq = before || (s == t);
                    const float e = beq ? __expf(dt - DEC[dir * 64 + s]) : 0.f;
                    AM[dir * 4096 + (dir ? (63 - s) * 64 + (63 - t) : s * 64 + t)] = before ? bt * kkv[r] * e : 0.f;   aq[r] = qkv[r] * e; }
                bf16* AQg = (bf16*)(dob + (dir ? DO_AQKB : DO_AQKF));
                if (!(SKIP & 16)) *(GAS v2u*)(AQg + ((size_t)(h * 256 + oc) * 64 + t) * 64 + s0) = pack4(aq); } }
        __syncthreads();
        if (SKIP & 32) {} else if (w < 2) { const int dir = w; int c = lane; asm volatile("" : "+v"(c)); const LAS float* A = AM + dir * 4096;
            float t[64];
#pragma unroll
            for (int bi = 0; bi < 4; ++bi) { float r[16];
#pragma unroll
                for (int ii = 0; ii < 16; ++ii) r[ii] = (16 * bi + ii == c) ? 1.f : 0.f;
                if (!(SKIP & 2)) {
#pragma unroll
                for (int j0 = 0; j0 < 16 * bi; j0 += 4) { f32x4 av[4][4];
#pragma unroll
                    for (int jq = 0; jq < 4; ++jq)
#pragma unroll
                        for (int q4 = 0; q4 < 4; ++q4) av[jq][q4] = *(const LAS f32x4*)(A + (j0 + jq) * 64 + 16 * bi + 4 * q4);
                    __builtin_amdgcn_sched_barrier(0);
#pragma unroll
                    for (int jq = 0; jq < 4; ++jq)
#pragma unroll
                        for (int q4 = 0; q4 < 4; ++q4) { r[4 * q4] -= av[jq][q4][0] * t[j0 + jq]; r[4 * q4 + 1] -= av[jq][q4][1] * t[j0 + jq]; r[4 * q4 + 2] -= av[jq][q4][2] * t[j0 + jq]; r[4 * q4 + 3] -= av[jq][q4][3] * t[j0 + jq]; }
                    __builtin_amdgcn_sched_barrier(0); }
#pragma unroll
                for (int jg = 0; jg < 4; ++jg) { f32x4 av[4][4];
#pragma unroll
                    for (int jq = 0; jq < 4; ++jq)
#pragma unroll
                        for (int q4 = jg; q4 < 4; ++q4) av[jq][q4] = *(const LAS f32x4*)(A + (16 * bi + 4 * jg + jq) * 64 + 16 * bi + 4 * q4);
                    __builtin_amdgcn_sched_barrier(0);
#pragma unroll
                    for (int jq = 0; jq < 4; ++jq) { const int jj = 4 * jg + jq; t[16 * bi + jj] = r[jj];
#pragma unroll
                        for (int q4 = jg; q4 < 4; ++q4)
#pragma unroll
                            for (int e = 0; e < 4; ++e) if (4 * q4 + e > jj) r[4 * q4 + e] -= av[jq][q4][e] * r[jj]; }
                    __builtin_amdgcn_sched_barrier(0); }
                } else {
#pragma unroll
                for (int jj = 0; jj < 16; ++jj) t[16 * bi + jj] = r[jj]; }
            }
            const int tc = dir ? 63 - c : c; const float bc = BET[dir * 64 + tc], bd = bc * EXD[dir * 64 + tc];
            LAS bf16* T0 = TB + (dir * 2 + 0) * 64 * 72 + tc + (dir ? 63 * 72 : 0); const int tstep = dir ? -72 : 72;
#pragma unroll
            for (int i = 0; i < 64; ++i) { T0[i * tstep] = (bf16)f2bf(t[i] * bc); T0[64 * 72 + i * tstep] = (bf16)f2bf(t[i] * bd); }
        } else {
            for (int idx = tid - 128; idx < ((SKIP & 16) ? 0 : 1024); idx += 384) { const int r = idx >> 3, c8 = idx & 7; *(GAS v4u*)(KNTg + ((size_t)(h * 256 + oc) * 128 + r) * 64 + c8 * 8) = *(const LAS v4u*)(KNT + r * 72 + c8 * 8); }
            if (tid >= 128 && tid < 256) { const int dir = (tid - 128) >> 6, t = tid & 63; const float dl = dir ? DEC[64] : DEC[63];
                float* g = GSC + (size_t)((dir * 8 + h) * 256 + oc) * 192; g[t] = EXD[dir * 64 + t]; g[64 + t] = __expf(dl - DEC[dir * 64 + t]); if (t == 0) g[128] = __expf(dl); }
        }
        __syncthreads();
#pragma unroll 1
        for (int n = 0; n < ((SKIP & 4) ? 0 : 16); ++n) { const int qi = w * 16 + n, dir = qi >> 6, kind = (qi >> 5) & 1, idx = qi & 31; f32x4 acc = {0.f, 0.f, 0.f, 0.f};
            const LAS bf16* Tm = TB + (dir * 2 + kind) * 64 * 72; const size_t cb = (size_t)(h * 256 + oc) * 8192;
            if (kind == 0) { const int ti = idx >> 3, vj = idx & 7;
#pragma unroll
                for (int s0 = 0; s0 < 2; ++s0) acc = mfma16(ldfrag(Tm, 72, 16 * ti + fr, 32 * s0 + 8 * fq), ldfrag(VT, 72, 16 * vj + fr, 32 * s0 + 8 * fq), acc);
                bf16* U = (bf16*)(F.ws + (dir ? WS_UTB : WS_UTF)); if (!(SKIP & 16)) *(GAS v2u*)(U + cb + (16 * vj + fr) * 64 + 16 * ti + 4 * fq) = pack4(acc);
            } else { const int ki = idx >> 2, tj = idx & 3;
#pragma unroll
                for (int s0 = 0; s0 < 2; ++s0) acc = mfma16(ldfrag(KNT, 72, 16 * ki + fr, 32 * s0 + 8 * fq), ldfrag(Tm, 72, 16 * tj + fr, 32 * s0 + 8 * fq), acc);
                bf16* W = (bf16*)(F.ws + (dir ? WS_WB : WS_WF)); if (!(SKIP & 16)) *(GAS v2u*)(W + cb + (16 * tj + fr) * 128 + 16 * ki + 4 * fq) = pack4(acc); }
        }
    }
}
__device__ __forceinline__ void gdn_load_tiles(const unsigned char* ws, const unsigned char* dob, int tid, int dir, int hd, int h, int oc, bool pass3, v4u (&rw)[2], v4u (&rq)[2], v4u (&ru)[2], v4u (&rk)[2], v4u& ra, float& rs) {
    const size_t cb = (size_t)(h * 256 + oc);
    const int row = tid >> 3, c0 = (tid & 7) * 16, vrow = tid >> 2, t0 = (tid & 3) * 16;
    const bf16* W = (const bf16*)(ws + (dir ? WS_WB : WS_WF)) + cb * 8192 + row * 128 + c0; rw[0] = *(const GAS v4u*)W; rw[1] = *(const GAS v4u*)(W + 8);
    const bf16* U = (const bf16*)(ws + (dir ? WS_UTB : WS_UTF)) + cb * 8192 + vrow * 64 + t0; ru[0] = *(const GAS v4u*)U; ru[1] = *(const GAS v4u*)(U + 8);
    const bf16* Kt = (const bf16*)(dob + DO_KNT) + (size_t)(h * 256 + oc) * 8192 + vrow * 64 + t0; rk[0] = *(const GAS v4u*)Kt; rk[1] = *(const GAS v4u*)(Kt + 8);
    if (pass3) {
        const bf16* Q = (const bf16*)(dob + DO_QN) + (size_t)(64 * oc + row) * HW + h * 128 + c0; rq[0] = *(const GAS v4u*)Q; rq[1] = *(const GAS v4u*)(Q + 8);
        const bf16* A = (const bf16*)(dob + (dir ? DO_AQKB : DO_AQKF)) + cb * 4096 + row * 64 + (tid & 7) * 8; ra = *(const GAS v4u*)A;
    }
    rs = (tid < 192) ? ((const float*)(ws + WS_GSC))[(size_t)(hd * 256 + oc) * 192 + tid] : 0.f;
}
#define SCHED_FENCE() __builtin_amdgcn_sched_barrier(0)
template <bool PASS3, bool UREAL>
__device__ __forceinline__ void gdn_tile(f32x4 (&A)[8], const LAS bf16* WTL, const LAS bf16* QNL, const LAS bf16* UTL, const LAS bf16* KTL, const LAS bf16* AQL, const LAS float* SCL,
                                         LAS bf16* ST, LAS bf16* VN, LAS bf16* VNS, int w, int fr, int fq, float gl, bf16* Ogc) {
#pragma unroll
    for (int kt = 0; kt < 8; ++kt) *(LAS v2u*)(ST + fr * 136 + 16 * kt + 4 * fq) = pack4(A[kt]);
    asm volatile("" ::: "memory");
    bf16x8 xs[4];
#pragma unroll
    for (int k0 = 0; k0 < 4; ++k0) xs[k0] = ldfrag(ST, 136, fr, 32 * k0 + 8 * fq);
#pragma unroll
    for (int th = 0; th < 2; ++th) { bf16x8 wf[2][4]; f32x4 acc[2]; v2u uw[2]; f32x4 es[2];
#pragma unroll
      for (int tq = 0; tq < 2; ++tq) { const int tt = 2 * th + tq;
#pragma unroll
          for (int k0 = 0; k0 < 4; ++k0) wf[tq][k0] = ldfrag(WTL, 136, 16 * tt + fr, 32 * k0 + 8 * fq);
          if (UREAL) uw[tq] = *(const LAS v2u*)(UTL + (16 * w + fr) * 72 + 16 * tt + 4 * fq);
          es[tq] = *(const LAS f32x4*)(SCL + 64 + 16 * tt + 4 * fq); acc[tq] = (f32x4){0.f, 0.f, 0.f, 0.f}; }
      SCHED_FENCE();
#pragma unroll
      for (int k0 = 0; k0 < 4; ++k0)
#pragma unroll
          for (int tq = 0; tq < 2; ++tq) acc[tq] = mfma16(wf[tq][k0], xs[k0], acc[tq]);
      SCHED_FENCE();
#pragma unroll
      for (int tq = 0; tq < 2; ++tq) { const int tt = 2 * th + tq; f32x4 u4 = {0.f, 0.f, 0.f, 0.f};
          if (UREAL) u4 = (f32x4){bflo(uw[tq].x), bfhi(uw[tq].x), bflo(uw[tq].y), bfhi(uw[tq].y)};
          const f32x4 vn = u4 - acc[tq];
          if (PASS3) *(LAS v2u*)(VN + fr * 72 + 16 * tt + 4 * fq) = pack4(vn);
          *(LAS v2u*)(VNS + fr * 72 + 16 * tt + 4 * fq) = pack4(vn * es[tq]); }
      SCHED_FENCE(); }
    asm volatile("" ::: "memory");
    if (PASS3) { bf16x8 yv[2];
#pragma unroll
        for (int s0 = 0; s0 < 2; ++s0) yv[s0] = ldfrag(VN, 72, fr, 32 * s0 + 8 * fq);
#pragma unroll
        for (int th = 0; th < 2; ++th) { bf16x8 qf[2][4], af[2][2]; f32x4 acc[2]; float ed[2];
#pragma unroll
            for (int tq = 0; tq < 2; ++tq) { const int tt = 2 * th + tq;
#pragma unroll
                for (int k0 = 0; k0 < 4; ++k0) qf[tq][k0] = ldfrag(QNL, 136, 16 * tt + fr, 32 * k0 + 8 * fq);
#pragma unroll
                for (int s0 = 0; s0 < 2; ++s0) af[tq][s0] = ldfrag(AQL, 72, 16 * tt + fr, 32 * s0 + 8 * fq);
                ed[tq] = SCL[16 * tt + fr]; acc[tq] = (f32x4){0.f, 0.f, 0.f, 0.f}; }
            SCHED_FENCE();
#pragma unroll
            for (int k0 = 0; k0 < 4; ++k0)
#pragma unroll
                for (int tq = 0; tq < 2; ++tq) acc[tq] = mfma16(xs[k0], qf[tq][k0], acc[tq]);
#pragma unroll
            for (int tq = 0; tq < 2; ++tq) acc[tq] = acc[tq] * ed[tq];
#pragma unroll
            for (int s0 = 0; s0 < 2; ++s0)
#pragma unroll
                for (int tq = 0; tq < 2; ++tq) acc[tq] = mfma16(yv[s0], af[tq][s0], acc[tq]);
            SCHED_FENCE();
#pragma unroll
            for (int tq = 0; tq < 2; ++tq) *(GAS v2u*)(Ogc + (size_t)(16 * (2 * th + tq) + fr) * HW + 16 * w + 4 * fq) = pack4(acc[tq]);
            SCHED_FENCE(); } }
    { bf16x8 ys[2];
#pragma unroll
      for (int s0 = 0; s0 < 2; ++s0) ys[s0] = ldfrag(VNS, 72, fr, 32 * s0 + 8 * fq);
#pragma unroll
      for (int kh = 0; kh < 2; ++kh) { bf16x8 kf[4][2];
#pragma unroll
          for (int kq = 0; kq < 4; ++kq)
#pragma unroll
              for (int s0 = 0; s0 < 2; ++s0) kf[kq][s0] = ldfrag(KTL, 72, 16 * (4 * kh + kq) + fr, 32 * s0 + 8 * fq);
#pragma unroll
          for (int kq = 0; kq < 4; ++kq) A[4 * kh + kq] = A[4 * kh + kq] * gl;
          SCHED_FENCE();
#pragma unroll
          for (int s0 = 0; s0 < 2; ++s0)
#pragma unroll
              for (int kq = 0; kq < 4; ++kq) A[4 * kh + kq] = mfma16(kf[kq][s0], ys[s0], A[4 * kh + kq]);
          SCHED_FENCE(); } }
}
template <bool PASS3, int SKIP = 0>
__device__ __forceinline__ void gdn_pass(Frame& F) {
    LAS bf16*  WTL = (LAS bf16*)(F.lds + 0);
    LAS bf16*  QNL = (LAS bf16*)(F.lds + 17408);
    LAS bf16*  UTL = (LAS bf16*)(F.lds + 34816);
    LAS bf16*  KTL = (LAS bf16*)(F.lds + 53248);
    LAS bf16*  AQL = (LAS bf16*)(F.lds + 71680);
    LAS float* SCL = (LAS float*)(F.lds + 80896);
    LAS bf16*  PX  = (LAS bf16*)(F.lds + 0);
    const int tid = F.tid, lane = F.lane, w = F.wave, fr = lane & 15, fq = lane >> 4;
    LAS bf16* ST  = (LAS bf16*)(F.lds + 81920 + w * 8960);
    LAS bf16* VN  = ST + 16 * 136;
    LAS bf16* VNS = VN + 16 * 72;
    const int row = tid >> 3, c0 = (tid & 7) * 16, vrow = tid >> 2, t0 = (tid & 3) * 16;
    const unsigned char* dob = (const unsigned char*)F.out;
    float* GL = (float*)(F.ws + WS_GL); bf16* GP = (bf16*)(F.ws + WS_GP);
    for (int it = blockIdx.x; it < 256; it += F.G) {
        const int hd = it >> 4, sg = it & 15, dir = hd >> 3, h = hd & 7;
        bf16* Og = (bf16*)(F.ws + (dir ? WS_OGB : WS_OGF));
        f32x4 Sacc[8], Pacc[8];
        int dgi = 16 * w + fr - 4 * fq; asm volatile("" : "+v"(dgi));
#pragma unroll
        for (int kt = 0; kt < 8; ++kt) { Sacc[kt] = (f32x4){0.f, 0.f, 0.f, 0.f};
#pragma unroll
            for (int r = 0; r < 4; ++r) Pacc[kt][r] = (!PASS3 && (16 * kt + r == dgi)) ? 1.f : 0.f; }
        __syncthreads();
        if (PASS3) {
            for (int p = 0; p < sg; ++p) { const int ip = hd * 16 + p;
                { const bf16* src = GP + (size_t)ip * 16384 + vrow * 128 + (tid & 3) * 32;
#pragma unroll
                  for (int q = 0; q < 4; ++q) *(LAS v4u*)(PX + vrow * 136 + (tid & 3) * 32 + 8 * q) = *(const GAS v4u*)(src + 8 * q); }
#pragma unroll
                for (int kt = 0; kt < 8; ++kt) *(LAS v2u*)(ST + fr * 136 + 16 * kt + 4 * fq) = pack4(Sacc[kt]);
                __syncthreads();
                bf16x8 xs[4];
#pragma unroll
                for (int k0 = 0; k0 < 4; ++k0) xs[k0] = ldfrag(ST, 136, fr, 32 * k0 + 8 * fq);
#pragma unroll
                for (int kh = 0; kh < 2; ++kh) { bf16x8 pf[4][4]; f32x4 acc[4];
#pragma unroll
                    for (int kq = 0; kq < 4; ++kq) { const int kt = 4 * kh + kq; acc[kq] = *(const GAS f32x4*)(GL + ((size_t)((ip * 8 + w) * 8 + kt) * 64 + lane) * 4);
#pragma unroll
                        for (int k0 = 0; k0 < 4; ++k0) pf[kq][k0] = ldfrag(PX, 136, 16 * kt + fr, 32 * k0 + 8 * fq); }
                    SCHED_FENCE();
#pragma unroll
                    for (int k0 = 0; k0 < 4; ++k0)
#pragma unroll
                        for (int kq = 0; kq < 4; ++kq) acc[kq] = mfma16(pf[kq][k0], xs[k0], acc[kq]);
                    SCHED_FENCE();
#pragma unroll
                    for (int kq = 0; kq < 4; ++kq) Sacc[4 * kh + kq] = acc[kq]; }
                __syncthreads();
            }
        }
        v4u rw[2], rq[2], ru[2], rk[2], ra; float rs;
        gdn_load_tiles(F.ws, dob, tid, dir, hd, h, dir ? 255 - sg * 16 : sg * 16, PASS3, rw, rq, ru, rk, ra, rs);
        for (int ci = 0; ci < CPS; ++ci) {
            const int sc = sg * 16 + ci, oc = dir ? 255 - sc : sc, tok0 = 64 * oc;
            *(LAS v4u*)(WTL + row * 136 + c0) = rw[0]; *(LAS v4u*)(WTL + row * 136 + c0 + 8) = rw[1];
            *(LAS v4u*)(UTL + vrow * 72 + t0) = ru[0]; *(LAS v4u*)(UTL + vrow * 72 + t0 + 8) = ru[1];
            *(LAS v4u*)(KTL + vrow * 72 + t0) = rk[0]; *(LAS v4u*)(KTL + vrow * 72 + t0 + 8) = rk[1];
            if (PASS3) { *(LAS v4u*)(QNL + row * 136 + c0) = rq[0]; *(LAS v4u*)(QNL + row * 136 + c0 + 8) = rq[1]; *(LAS v4u*)(AQL + row * 72 + (tid & 7) * 8) = ra; }
            if (tid < 192) SCL[tid] = rs;
            __syncthreads();
            if (ci + 1 < CPS && !(SKIP & 1)) gdn_load_tiles(F.ws, dob, tid, dir, hd, h, dir ? oc - 1 : oc + 1, PASS3, rw, rq, ru, rk, ra, rs);
            const float gl = SCL[128];
            gdn_tile<PASS3, true>(Sacc, WTL, QNL, UTL, KTL, AQL, SCL, ST, VN, VNS, w, fr, fq, gl, Og + (size_t)tok0 * HW + h * 128);
            if (!PASS3) gdn_tile<PASS3, false>(Pacc, WTL, QNL, UTL, KTL, AQL, SCL, ST, VN, VNS, w, fr, fq, gl, Og);
            __syncthreads();
        }
        if (!PASS3) {
            int pofs = (4 * fq) * 128 + 16 * w + fr; asm volatile("" : "+v"(pofs));
            bf16* gp = GP + (size_t)it * 16384 + pofs;
#pragma unroll
            for (int kt = 0; kt < 8; ++kt) { *(GAS f32x4*)(GL + ((size_t)((it * 8 + w) * 8 + kt) * 64 + lane) * 4) = Sacc[kt];
#pragma unroll
                for (int r = 0; r < 4; ++r) gp[(16 * kt + r) * 128] = (bf16)f2bf(Pacc[kt][r]); }
        }
    }
}
__device__ __forceinline__ void p7_mix(Frame& F) {
    const int gw = F.vcu * NWAVES + F.wave, NGW = F.G * NWAVES, lane = F.lane;
    const int e0 = (lane & 7) * 16, col = (lane >> 3) * 128 + e0;
    for (int m = gw; m < SEQ; m += NGW) {
#pragma unroll
        for (int mx = 0; mx < 2; ++mx) {
            const bf16* of = (const bf16*)(F.ws + (mx ? WS_OGF : WS_OHF)); const bf16* ob = (const bf16*)(F.ws + (mx ? WS_OGB : WS_OHB));
            const bf16* gt = (const bf16*)(F.ws + WS_H + (size_t)(mx ? 8 : 4) * 32 * MiB); const float* nw = F.in[mx ? I_GNW : I_HNW];
            bf16* yo = (bf16*)(F.ws + (mx ? WS_YB : WS_YA));
            const size_t off = (size_t)m * HW + col;
            const v4u a0 = *(const GAS v4u*)(of + off), a1 = *(const GAS v4u*)(of + off + 8), b0 = *(const GAS v4u*)(ob + off), b1 = *(const GAS v4u*)(ob + off + 8), g0 = *(const GAS v4u*)(gt + off), g1 = *(const GAS v4u*)(gt + off + 8);
            const unsigned aw[8] = {a0.x, a0.y, a0.z, a0.w, a1.x, a1.y, a1.z, a1.w}, bw[8] = {b0.x, b0.y, b0.z, b0.w, b1.x, b1.y, b1.z, b1.w}, gw_[8] = {g0.x, g0.y, g0.z, g0.w, g1.x, g1.y, g1.z, g1.w};
            float o[16]; float ss = 0.f;
#pragma unroll
            for (int e = 0; e < 8; ++e) { o[2 * e] = bflo(aw[e]) + bflo(bw[e]); o[2 * e + 1] = bfhi(aw[e]) + bfhi(bw[e]); ss += o[2 * e] * o[2 * e] + o[2 * e + 1] * o[2 * e + 1]; }
            ss += __shfl_xor(ss, 1); ss += __shfl_xor(ss, 2); ss += __shfl_xor(ss, 4);
            const float r = 1.0f / sqrtf(ss * (1.f / 128.f) + EPS);
            if (QM_MIX == 2) { float yv[16]; float am = 0.f;
#pragma unroll
                for (int e = 0; e < 8; ++e) { yv[2 * e] = o[2 * e] * r * nw[e0 + 2 * e] * bflo(gw_[e]); yv[2 * e + 1] = o[2 * e + 1] * r * nw[e0 + 2 * e + 1] * bfhi(gw_[e]); am = fmaxf(am, fmaxf(fabsf(yv[2 * e]), fabsf(yv[2 * e + 1]))); }
                am = wave_max(am); const float inv = am > 0.f ? 127.0f / am : 0.f;
                *(GAS v4u*)((unsigned char*)yo + off) = (v4u){pk4i8((f32x4){yv[0], yv[1], yv[2], yv[3]}, inv), pk4i8((f32x4){yv[4], yv[5], yv[6], yv[7]}, inv), pk4i8((f32x4){yv[8], yv[9], yv[10], yv[11]}, inv), pk4i8((f32x4){yv[12], yv[13], yv[14], yv[15]}, inv)};
                if (lane == 0) ((float*)(F.ws + WS_QX))[(1 + mx) * SEQ + m] = am > 0.f ? am * (1.0f / 127.0f) : 1.0f; }
            else if (QM_MIX == 1) { unsigned yq[4];
#pragma unroll
                for (int e = 0; e < 4; ++e) yq[e] = pk4f8(o[4 * e] * r * nw[e0 + 4 * e] * bflo(gw_[2 * e]), o[4 * e + 1] * r * nw[e0 + 4 * e + 1] * bfhi(gw_[2 * e]), o[4 * e + 2] * r * nw[e0 + 4 * e + 2] * bflo(gw_[2 * e + 1]), o[4 * e + 3] * r * nw[e0 + 4 * e + 3] * bfhi(gw_[2 * e + 1]));
                *(GAS v4u*)((unsigned char*)yo + off) = (v4u){yq[0], yq[1], yq[2], yq[3]}; }
            else { unsigned yw[8];
#pragma unroll
            for (int e = 0; e < 8; ++e) yw[e] = pk2(o[2 * e] * r * nw[e0 + 2 * e] * bflo(gw_[e]), o[2 * e + 1] * r * nw[e0 + 2 * e + 1] * bfhi(gw_[e]));
            *(GAS v4u*)(yo + off) = (v4u){yw[0], yw[1], yw[2], yw[3]}; *(GAS v4u*)(yo + off + 8) = (v4u){yw[4], yw[5], yw[6], yw[7]}; }
        }
    }
    for (int tb = 0; tb < 2; ++tb) { const float* src = F.in[tb ? I_PV : I_PU]; unsigned char* dst = F.ws + (tb ? WS_TV : WS_TU); float* scl = (float*)(F.ws + WS_PSC) + tb * 16384;
        for (int r = gw; r < 16384; r += NGW) { const float* row = src + (size_t)r * DM; f32x4 v[8]; float mx = 0.f;
#pragma unroll
            for (int q = 0; q < 8; ++q) { v[q] = *(const GAS f32x4*)(row + (tb ? (q >> 2) * 1024 + lane * 16 + 4 * (q & 3) : lane * 32 + 4 * q)); const f32x4 a = __builtin_elementwise_abs(v[q]); mx = fmaxf(mx, fmaxf(fmaxf(a.x, a.y), fmaxf(a.z, a.w))); }
            mx = wave_max(mx);
            const float sc = mx > 0.f ? mx * (tb ? (VFMT == 6 ? 1.0f / 7.5f : 1.0f / 256.0f) : 1.0f / 127.0f) : 1.0f, inv = 1.0f / sc;
            if (tb && VFMT == 6) { v16f a16, b16;
#pragma unroll
                for (int q = 0; q < 4; ++q) { a16[4 * q] = v[q].x * inv; a16[4 * q + 1] = v[q].y * inv; a16[4 * q + 2] = v[q].z * inv; a16[4 * q + 3] = v[q].w * inv;
                    b16[4 * q] = v[4 + q].x * inv; b16[4 * q + 1] = v[4 + q].y * inv; b16[4 * q + 2] = v[4 + q].z * inv; b16[4 * q + 3] = v[4 + q].w * inv; }
                const v6u pk = __builtin_amdgcn_cvt_scalef32_2xpk16_fp6_f32(a16, b16, 1.0f);
                *(GAS v4u*)(dst + (size_t)r * TV_PITCH + lane * 16) = (v4u){pk[0], pk[1], pk[2], pk[3]}; *(GAS v2u*)(dst + (size_t)r * TV_PITCH + 1024 + lane * 8) = (v2u){pk[4], pk[5]};
                if (lane == 0) scl[r] = sc;
                continue; }
            unsigned w[8];
#pragma unroll
            for (int q = 0; q < 8; ++q) { const f32x4 x = v[q];
                if (tb) w[q] = pk4f8(x.x * inv, x.y * inv, x.z * inv, x.w * inv);
                else { const int a = (int)rintf(x.x * inv), b = (int)rintf(x.y * inv), c = (int)rintf(x.z * inv), d = (int)rintf(x.w * inv);
                    w[q] = (unsigned)(a & 255) | ((unsigned)(b & 255) << 8) | ((unsigned)(c & 255) << 16) | ((unsigned)(d & 255) << 24); } }
            if (tb) { *(GAS v4u*)(dst + (size_t)r * DM + lane * 16) = (v4u){w[0], w[1], w[2], w[3]}; *(GAS v4u*)(dst + (size_t)r * DM + 1024 + lane * 16) = (v4u){w[4], w[5], w[6], w[7]}; }
            else { GAS v4u* o = (GAS v4u*)(dst + ((size_t)lane * 16384 + r) * 32); o[0] = (v4u){w[0], w[1], w[2], w[3]}; o[1] = (v4u){w[4], w[5], w[6], w[7]}; }
            if (lane == 0) scl[r] = sc; } }
}
constexpr size_t WS_XQ = 80 * MiB;
constexpr size_t WS_SXR = 112 * MiB;
constexpr size_t WS_EID = 113 * MiB, WS_GATE = 121 * MiB, WS_AV = 129 * MiB;
constexpr size_t WS_REC = 208 * MiB;
constexpr int NET = 32, ETSZ = 512, NBUCK = 16 * NET, REC_CAP = 16384, CW_CNT = 8192, CW_Q = 8192 + 16 * NBUCK;
__device__ __forceinline__ unsigned fkey(float f) { const unsigned u = __builtin_bit_cast(unsigned, f); return (u & 0x80000000u) ? ~u : (u | 0x80000000u); }
__device__ __forceinline__ float gelu_erf(float x) { return 0.5f * x * (1.0f + erff(x * 0.70710678118654752f)); }

__device__ __forceinline__ float key_val(unsigned k, unsigned mask) { unsigned u = k & ~mask; u = (u & 0x80000000u) ? (u & 0x7fffffffu) : ~u; return __builtin_bit_cast(float, u); }
template <int SKIP>
__device__ __forceinline__ void p11a_topk(Frame& F) {
    LAS float* SCR = (LAS float*)(F.lds + F.wave * 16384);
    LAS unsigned* SL = (LAS unsigned*)SCR;
    LAS int* EIDS = (LAS int*)(SCR + 1024);
    LAS int* OFFS = (LAS int*)(SCR + 2048);
    LAS float* RTS = SCR + 2304;
    LAS int* BC = (LAS int*)(F.lds + 8 * 16384);
    const bf16* SC = (const bf16*)(F.ws + WS_SC);
    unsigned char* XQ = F.ws + WS_XQ; float* SXR = (float*)(F.ws + WS_SXR); int* EIDg = (int*)(F.ws + WS_EID); float* GATEg = (float*)(F.ws + WS_GATE); unsigned* REC = (unsigned*)(F.ws + WS_REC);
    for (int blk = F.vcu; blk < SEQ / 64; blk += F.G) {
        __syncthreads();
        if (F.tid < NET) BC[F.tid] = 0;
        __syncthreads();
        const int m0 = blk * 64 + F.wave * 8;
#pragma unroll 2
        for (int ti = 0; ti < 8; ++ti) { const int m = m0 + ti;
            int lane = F.lane; asm volatile("" : "+v"(lane));
            float xh[32]; float ss = 0.f;
            const bf16* x1 = (const bf16*)(F.ws + WS_X1B) + (size_t)m * DM + lane * 32; const float* n2 = F.in[I_N2W] + lane * 32;
            f32x4 nwv[8];
#pragma unroll
            for (int q = 0; q < 8; ++q) { const v2u a = *(const GAS v2u*)(x1 + 4 * q); nwv[q] = *(const GAS f32x4*)(n2 + 4 * q); xh[4 * q] = bflo(a.x); xh[4 * q + 1] = bfhi(a.x); xh[4 * q + 2] = bflo(a.y); xh[4 * q + 3] = bfhi(a.y); }
#pragma unroll
            for (int e = 0; e < 32; ++e) ss += xh[e] * xh[e];
            const float rt = 1.0f / sqrtf(wave_sum(ss) * (1.f / DM) + EPS);
            float amx = 0.f;
#pragma unroll
            for (int q = 0; q < 8; ++q) { const f32x4 a = nwv[q]; xh[4 * q] *= rt * a.x; xh[4 * q + 1] *= rt * a.y; xh[4 * q + 2] *= rt * a.z; xh[4 * q + 3] *= rt * a.w; }
#pragma unroll
            for (int e = 0; e < 32; ++e) amx = fmaxf(amx, fabsf(xh[e]));
            amx = wave_max(amx);
            const float sx = amx > 0.f ? amx * (1.0f / 127.0f) : 1.0f, isx = 1.0f / sx;
            unsigned xq[8];
#pragma unroll
            for (int d = 0; d < 8; ++d) { const int a = (int)rintf(xh[4 * d] * isx), b = (int)rintf(xh[4 * d + 1] * isx), c = (int)rintf(xh[4 * d + 2] * isx), e = (int)rintf(xh[4 * d + 3] * isx);
                xq[d] = (unsigned)(a & 255) | ((unsigned)(b & 255) << 8) | ((unsigned)(c & 255) << 16) | ((unsigned)(e & 255) << 24); }
            if (!(SKIP & 2)) { GAS v4u* o = (GAS v4u*)(XQ + ((size_t)lane * SEQ + m) * 32); o[0] = (v4u){xq[0], xq[1], xq[2], xq[3]}; o[1] = (v4u){xq[4], xq[5], xq[6], xq[7]}; }
            if (lane == 0) { SXR[2 * m] = sx; SXR[2 * m + 1] = rt; RTS[ti] = rt; }
        }
#pragma unroll 1
        for (int grp = 0; grp < 2; ++grp) {
            int lane = F.lane; asm volatile("" : "+v"(lane));
            if (!(SKIP & 1)) {
                { const bf16* src = SC + (size_t)(m0 + grp * 4 + (lane >> 4)) * DM + (lane & 15) * 128;
                  unsigned v[16];
#pragma unroll
                  for (int i = 0; i < 16; ++i) v[i] = 0u;
#pragma unroll 1
                  for (int s8 = 0; s8 < 2; ++s8) { v4u a8[8];
#pragma unroll
                      for (int u = 0; u < 8; ++u) a8[u] = *(const GAS v4u*)(src + 64 * s8 + 8 * u);
#pragma unroll
                      for (int u = 0; u < 8; ++u) { const unsigned wv[4] = {a8[u].x, a8[u].y, a8[u].z, a8[u].w};
#pragma unroll
                          for (int e = 0; e < 8; ++e) { const float sv = (e & 1) ? bfhi(wv[e >> 1]) : bflo(wv[e >> 1]); unsigned x = (fkey(sv) & ~127u) | (unsigned)(64 * s8 + 8 * u + e);
#pragma unroll
                              for (int i = 0; i < 16; ++i) { const unsigned hi = v[i] > x ? v[i] : x; x = v[i] > x ? x : v[i]; v[i] = hi; } } } }
#pragma unroll
                  for (int q = 0; q < 4; ++q) *(LAS v4u*)(SL + lane * 16 + 4 * q) = (v4u){v[4 * q], v[4 * q + 1], v[4 * q + 2], v[4 * q + 3]}; }
                asm volatile("" ::: "memory");
                if (lane < 32) { const int tk = lane >> 3, h = lane & 7, m = m0 + grp * 4 + tk;
                    const LAS unsigned* L1 = SL + (tk * 16 + 2 * h) * 16; const LAS unsigned* L2 = L1 + 16;
                    float f1[16], f2[16];
#pragma unroll
                    for (int q = 0; q < 4; ++q) { const v4u a = *(const LAS v4u*)(L1 + 4 * q), b = *(const LAS v4u*)(L2 + 4 * q);
                        f1[4 * q] = key_val(a.x, 127u); f1[4 * q + 1] = key_val(a.y, 127u); f1[4 * q + 2] = key_val(a.z, 127u); f1[4 * q + 3] = key_val(a.w, 127u);
                        f2[4 * q] = key_val(b.x, 127u); f2[4 * q + 1] = key_val(b.y, 127u); f2[4 * q + 2] = key_val(b.z, 127u); f2[4 * q + 3] = key_val(b.w, 127u); }
                    unsigned c[16];
#pragma unroll
                    for (int i = 0; i < 16; ++i) c[i] = 0u;
#pragma unroll
                    for (int i = 0; i < 16; ++i)
#pragma unroll
                        for (int j = 0; j < 16; ++j) if ((i + 1) * (j + 1) <= 16) { unsigned x = (fkey(f1[i] + f2[j]) & ~255u) | (unsigned)(i * 16 + j);
#pragma unroll
                            for (int r = 0; r < 16; ++r) { const unsigned hi = c[r] > x ? c[r] : x; x = c[r] > x ? x : c[r]; c[r] = hi; } }
                    const float rt = RTS[grp * 4 + tk];
                    float sc[16]; int ee[16]; float mx = -3.0e38f;
#pragma unroll
                    for (int r = 0; r < 16; ++r) { const unsigned ij = c[r] & 255u; const unsigned k1 = L1[ij >> 4], k2 = L2[ij & 15u];
                        sc[r] = key_val(k1, 127u) + key_val(k2, 127u); ee[r] = (int)((k1 & 127u) * 128u + (k2 & 127u)); mx = fmaxf(mx, sc[r]); }
                    float sum = 0.f;
#pragma unroll
                    for (int r = 0; r < 16; ++r) { sc[r] = __expf(rt * (sc[r] - mx)); sum += sc[r]; }
                    const float inv = 1.0f / sum;
#pragma unroll
                    for (int q = 0; q < 4; ++q) { *(LAS v4u*)(EIDS + (grp * 4 + tk) * 128 + h * 16 + 4 * q) = (v4u){(unsigned)ee[4 * q], (unsigned)ee[4 * q + 1], (unsigned)ee[4 * q + 2], (unsigned)ee[4 * q + 3]};
                        if (!(SKIP & 4)) { *(GAS v4u*)(EIDg + (size_t)m * 128 + h * 16 + 4 * q) = (v4u){(unsigned)ee[4 * q], (unsigned)ee[4 * q + 1], (unsigned)ee[4 * q + 2], (unsigned)ee[4 * q + 3]};
                            *(GAS f32x4*)(GATEg + (size_t)m * 128 + h * 16 + 4 * q) = (f32x4){sc[4 * q] * inv, sc[4 * q + 1] * inv, sc[4 * q + 2] * inv, sc[4 * q + 3] * inv}; } }
                }
                asm volatile("" ::: "memory");
            }
        }
#pragma unroll 1
        for (int ti = 0; ti < 8; ++ti) {
            int lane = F.lane; asm volatile("" : "+v"(lane));
            const int tA = (EIDS[ti * 128 + lane] >> 9) & 31, tB = (EIDS[ti * 128 + 64 + lane] >> 9) & 31; int mycnt = 0;
#pragma unroll
            for (int k = 0; k < NET; ++k) { const int c = __popcll(__ballot(tA == k)) + __popcll(__ballot(tB == k)); mycnt = (lane == k) ? c : mycnt; }
            if (lane < NET) OFFS[ti * NET + lane] = __hip_atomic_fetch_add((int*)(BC + lane), mycnt, __ATOMIC_RELAXED, __HIP_MEMORY_SCOPE_WORKGROUP);
        }
        __syncthreads();
        const int tt = blk >> 4;
        if (F.tid < NET) BC[NET + F.tid] = (int)__hip_atomic_fetch_add((unsigned*)(F.ctl + CW_CNT) + (tt * NET + F.tid) * 16, (unsigned)BC[F.tid], __ATOMIC_RELAXED, __HIP_MEMORY_SCOPE_AGENT);
        __syncthreads();
#pragma unroll 1
        for (int ti = 0; ti < 8; ++ti) { const int m = m0 + ti;
            int lane = F.lane; asm volatile("" : "+v"(lane));
            const unsigned long long lt_mask = (1ull << lane) - 1ull;
            const int eA = EIDS[ti * 128 + lane] & 16383, eB = EIDS[ti * 128 + 64 + lane] & 16383, tA = eA >> 9, tB = eB >> 9; int rankA = 0, rankB = 0;
#pragma unroll
            for (int k = 0; k < NET; ++k) { const unsigned long long mA = __ballot(tA == k), mB = __ballot(tB == k);
                rankA = (tA == k) ? __popcll(mA & lt_mask) : rankA; rankB = (tB == k) ? __popcll(mA) + __popcll(mB & lt_mask) : rankB; }
            const unsigned tl = (unsigned)(m & 1023) << 17;
            if (!(SKIP & 4)) { const int s = BC[NET + tA] + OFFS[ti * NET + tA] + rankA; if (s < REC_CAP) REC[(size_t)(tt * NET + tA) * REC_CAP + s] = tl | ((unsigned)(eA & 511) << 7) | (unsigned)lane; }
            if (!(SKIP & 4)) { const int s = BC[NET + tB] + OFFS[ti * NET + tB] + rankB; if (s < REC_CAP) REC[(size_t)(tt * NET + tB) * REC_CAP + s] = tl | ((unsigned)(eB & 511) << 7) | (unsigned)(lane + 64); }
        }
    }
}

constexpr int NSLOT = 12, UPITCH = 80;
template <int SKIP>
__device__ __forceinline__ void p11b_udot(Frame& F) {
    LAS unsigned char* XS = (LAS unsigned char*)F.lds;
    LAS unsigned char* US = XS + 1024 * UPITCH;
    LAS int* QB = (LAS int*)(F.lds + 124 * 1024);
    const int tid = F.tid;
    const unsigned char* XQ = F.ws + WS_XQ; const unsigned char* TU = F.ws + WS_TU; const unsigned* REC = (const unsigned*)(F.ws + WS_REC);
    const float* SXR = (const float*)(F.ws + WS_SXR); const float* GATEg = (const float*)(F.ws + WS_GATE); float* AVg = (float*)(F.ws + WS_AV);
    const float* SU = (const float*)(F.ws + WS_PSC); const float* SV = SU + 16384;
    for (;;) {
        __syncthreads();
        if (tid == 0) QB[0] = (int)__hip_atomic_fetch_add((unsigned*)(F.ctl + CW_Q), 1u, __ATOMIC_RELAXED, __HIP_MEMORY_SCOPE_AGENT);
        __syncthreads();
        const int b = QB[0];
        if (b >= NBUCK) break;
        const int tt = b >> 5, et = b & 31;
        int n = (int)__hip_atomic_load((unsigned*)(F.ctl + CW_CNT) + b * 16, __ATOMIC_RELAXED, __HIP_MEMORY_SCOPE_AGENT); n = n < REC_CAP ? n : REC_CAP;
        for (int g0 = 0; g0 < n; g0 += NSLOT * NTHR) {
            const int npass = (n - g0) < NSLOT * NTHR ? (n - g0) : NSLOT * NTHR;
            unsigned rec[NSLOT]; int acc[NSLOT];
#pragma unroll
            for (int j = 0; j < NSLOT; ++j) { const int idx = g0 + j * NTHR + tid; const unsigned r = idx < n ? REC[(size_t)b * REC_CAP + idx] : 0xffffffffu; acc[j] = 0;
                rec[j] = ((r >> 17) & 1023u) | (((r >> 7) & 511u) << 16); }
            v4u st[12];
#define P11B_SRC(step, i) (((i) % 6) < 4 ? XQ + ((size_t)(2 * (step) + (i) / 6) * SEQ + tt * 1024) * 32 + (size_t)(tid + 512 * ((i) % 6)) * 16 : TU + ((size_t)(2 * (step) + (i) / 6) * 16384 + et * ETSZ) * 32 + (size_t)(tid + 512 * (((i) % 6) - 4)) * 16)
#pragma unroll
            for (int i = 0; i < 12; ++i) st[i] = *(const GAS v4u*)P11B_SRC(0, i);
#pragma unroll 1
            for (int c = 0; c < 32; ++c) {
                __syncthreads();
#pragma unroll
                for (int i = 0; i < 12; ++i) { const int q = i % 6, hc = i / 6, p = (q < 4) ? tid + 512 * q : tid + 512 * (q - 4); *(LAS v4u*)((q < 4 ? XS : US) + (p >> 1) * UPITCH + hc * 32 + (p & 1) * 16) = st[i]; }
                __syncthreads();
                if (c + 1 < 32 && !(SKIP & 1)) {
#pragma unroll
                    for (int i = 0; i < 12; ++i) st[i] = *(const GAS v4u*)P11B_SRC(c + 1, i);
                }
#pragma unroll
                for (int j0 = 0; j0 < NSLOT; j0 += 2) {
                    if (j0 * NTHR < npass && !(SKIP & 2)) {
                        v4u xb[2][4], ub[2][4];
#pragma unroll
                        for (int q = 0; q < 2; ++q) { unsigned r = rec[j0 + q]; asm volatile("" : "+v"(r));
                            const unsigned xo = (r & 0xffffu) * UPITCH, uo = (r >> 16) * UPITCH;
#pragma unroll
                            for (int hh = 0; hh < 4; ++hh) { xb[q][hh] = *(const LAS v4u*)(XS + xo + 16 * hh); ub[q][hh] = *(const LAS v4u*)(US + uo + 16 * hh); } }
                        __builtin_amdgcn_sched_barrier(0);
#pragma unroll
                        for (int q = 0; q < 2; ++q) { int s = acc[j0 + q];
#pragma unroll
                            for (int hh = 0; hh < 4; ++hh) { const v4u u = ub[q][hh], x = xb[q][hh];
                                s = __builtin_amdgcn_sdot4((int)u.x, (int)x.x, s, false); s = __builtin_amdgcn_sdot4((int)u.y, (int)x.y, s, false); s = __builtin_amdgcn_sdot4((int)u.z, (int)x.z, s, false); s = __builtin_amdgcn_sdot4((int)u.w, (int)x.w, s, false); }
                            acc[j0 + q] = s; }
                        __builtin_amdgcn_sched_barrier(0);
                    }
                }
            }
#undef P11B_SRC
#pragma unroll
            for (int j = 0; j < NSLOT; ++j) { const int idx = g0 + j * NTHR + tid; const unsigned r = idx < n ? REC[(size_t)b * REC_CAP + idx] : 0xffffffffu;
                if (r != 0xffffffffu) { const int t = tt * 1024 + (int)((r >> 17) & 1023), e = et * ETSZ + (int)((r >> 7) & 511), j7 = (int)(r & 127);
                    const float hv = (float)acc[j] * SU[e] * SXR[2 * t]; AVg[(size_t)t * 128 + j7] = gelu_erf(hv) * GATEg[(size_t)t * 128 + j7] * SV[e]; } }
        }
    }
}

__device__ __forceinline__ void p11c_vsum(Frame& F) {
    const int gw = F.vcu * NWAVES + F.wave, NGW = F.G * NWAVES;
    LAS int* EID = (LAS int*)(F.lds + F.wave * 16384); LAS float* AV = (LAS float*)(EID + 128);
    const unsigned char* TV = F.ws + WS_TV; const int* EIDg = (const int*)(F.ws + WS_EID); const float* AVg = (const float*)(F.ws + WS_AV);
    for (int m = gw; m < SEQ; m += NGW) {
        int lane = F.lane; asm volatile("" : "+v"(lane));
        const int lo16 = lane * 16;
        EID[lane] = EIDg[(size_t)m * 128 + lane]; EID[lane + 64] = EIDg[(size_t)m * 128 + 64 + lane]; AV[lane] = AVg[(size_t)m * 128 + lane]; AV[lane + 64] = AVg[(size_t)m * 128 + 64 + lane];
        asm volatile("" ::: "memory");
        f32x2 y2[16];
#pragma unroll
        for (int e = 0; e < 16; ++e) y2[e] = (f32x2){0.f, 0.f};
        float av[2][4];
#if VFMT == 6
        v4u rv[2][4]; v2u rw[2][4];
#define P11C_LOAD(buf, g) do { _Pragma("unroll") for (int q = 0; q < 4; ++q) { const int e = __builtin_amdgcn_readfirstlane(EID[(g) + q]); av[buf][q] = AV[(g) + q]; const unsigned char* rp = TV + (size_t)e * TV_PITCH; \
            rv[buf][q] = *(const GAS v4u*)(rp + lo16); rw[buf][q] = *(const GAS v2u*)(rp + 1024 + lane * 8); } } while (0)
#define P11C_ACC(buf) do { _Pragma("unroll") for (int q = 0; q < 4; ++q) { const float a = av[buf][q]; const f32x2 a2 = {a, a}; \
            const v6u pk = {rv[buf][q].x, rv[buf][q].y, rv[buf][q].z, rv[buf][q].w, rw[buf][q].x, rw[buf][q].y}; const v32f f = __builtin_amdgcn_cvt_scalef32_pk32_f32_fp6(pk, 1.0f); \
            _Pragma("unroll") for (int k = 0; k < 16; ++k) y2[k] += a2 * (f32x2){f[2 * k], f[2 * k + 1]}; \
            __builtin_amdgcn_sched_barrier(0); } } while (0)
#else
        v4u rv[2][4][2];
#define P11C_LOAD(buf, g) do { _Pragma("unroll") for (int q = 0; q < 4; ++q) { const int e = __builtin_amdgcn_readfirstlane(EID[(g) + q]); av[buf][q] = AV[(g) + q]; const unsigned char* rp = TV + (size_t)e * DM + lo16; \
            rv[buf][q][0] = *(const GAS v4u*)(rp); rv[buf][q][1] = *(const GAS v4u*)(rp + 1024); } } while (0)
#define P11C_ACC(buf) do { _Pragma("unroll") for (int q = 0; q < 4; ++q) { const float a = av[buf][q]; const f32x2 a2 = {a, a}; \
            _Pragma("unroll") for (int j = 0; j < 2; ++j) { const v4u r = rv[buf][q][j]; const unsigned wv[4] = {r.x, r.y, r.z, r.w}; \
                _Pragma("unroll") for (int dd = 0; dd < 4; ++dd) { y2[8 * j + 2 * dd] += a2 * __builtin_amdgcn_cvt_pk_f32_fp8((int)wv[dd], false); y2[8 * j + 2 * dd + 1] += a2 * __builtin_amdgcn_cvt_pk_f32_fp8((int)wv[dd], true); } } \
            __builtin_amdgcn_sched_barrier(0); } } while (0)
#endif
        P11C_LOAD(0, 0);
#pragma unroll 1
        for (int g = 0; g < 128; g += 8) {
            P11C_LOAD(1, g + 4);
            P11C_ACC(0);
            if (g + 8 < 128) P11C_LOAD(0, g + 8);
            P11C_ACC(1);
        }
#undef P11C_LOAD
#undef P11C_ACC
        float y[32];
#pragma unroll
        for (int e = 0; e < 16; ++e) { if (VFMT == 6 && FP6_IL) { y[e] = y2[e].x; y[16 + e] = y2[e].y; } else { y[2 * e] = y2[e].x; y[2 * e + 1] = y2[e].y; } }
        const bf16* x1 = (const bf16*)(F.ws + WS_X1B) + (size_t)m * DM;
        float s2 = 0.f;
#pragma unroll
        for (int j = 0; j < 2; ++j)
#pragma unroll
            for (int q = 0; q < 4; ++q) { const v2u a2 = *(const GAS v2u*)(x1 + j * 1024 + lo16 + 4 * q); const f32x4 a = {bflo(a2.x), bfhi(a2.x), bflo(a2.y), bfhi(a2.y)};
                y[16 * j + 4 * q] += a.x; y[16 * j + 4 * q + 1] += a.y; y[16 * j + 4 * q + 2] += a.z; y[16 * j + 4 * q + 3] += a.w; }
#pragma unroll
        for (int e = 0; e < 32; ++e) s2 += y[e] * y[e];
        const float ro = 1.0f / sqrtf(wave_sum(s2) * (1.f / DM) + EPS);
        float* orow = F.out + (size_t)m * DM;
#pragma unroll
        for (int j = 0; j < 2; ++j)
#pragma unroll
            for (int q = 0; q < 4; ++q) { const f32x4 a = *(const GAS f32x4*)(F.in[I_FNW] + j * 1024 + lo16 + 4 * q);
                *(GAS f32x4*)(orow + j * 1024 + lo16 + 4 * q) = (f32x4){y[16 * j + 4 * q] * ro * a.x, y[16 * j + 4 * q + 1] * ro * a.y, y[16 * j + 4 * q + 2] * ro * a.z, y[16 * j + 4 * q + 3] * ro * a.w}; }
    }
}
#ifndef MK_N_LAUNCHES
#define MK_N_LAUNCHES 1
#endif
constexpr int N_PHASES = 14;
constexpr int N_LAUNCHES = MK_N_LAUNCHES;
static_assert(N_LAUNCHES == 1 || N_LAUNCHES == N_PHASES, "MK_N_LAUNCHES is 1 or N_PHASES");
#ifndef PG8_SP2
#define PG8_SP2 true
#endif
#ifndef PG8_ALIGN
#define PG8_ALIGN true
#endif
struct Args { const float* in[19]; float* out; unsigned char* ws; int ph_lo, ph_hi; };
__global__ void __launch_bounds__(NTHR, 2) fwd_kernel(Args args) {
    extern __shared__ __attribute__((aligned(16))) unsigned char lds[];
    Frame F;
    F.lds = (LAS unsigned char*)lds;
    F.MISC = (volatile LAS unsigned*)(F.lds + MISC_OFF);
    F.tid = threadIdx.x; F.lane = F.tid & 63; F.wave = __builtin_amdgcn_readfirstlane(F.tid >> 6);
    F.G = gridDim.x; { const int bx = blockIdx.x; F.vcu = (F.G % 8 == 0) ? (bx % 8) * (F.G / 8) + bx / 8 : bx; }
    F.ws = args.ws; F.out = args.out; F.ctl = (gu32*)(args.ws + WS_CTL);
#pragma unroll
    for (int i = 0; i < 19; ++i) F.in[i] = args.in[i];
    for (int u = F.tid; u < (LDS_BYTES - MISC_OFF) / 4; u += NTHR) ((LAS unsigned*)(F.lds + MISC_OFF))[u] = 0u;
    __syncthreads();
    XcdBarrier bar; bar.bar = (unsigned*)(F.ctl + CW_BAR); bar.x = 0; bar.st = nullptr;
    if (N_LAUNCHES == 1) bar = xcd_barrier_post((unsigned*)(F.ctl + CW_BAR), F.MISC + 8);
    const int lo = args.ph_lo, hi = args.ph_hi;
#ifdef ONLY_PHASE
#define IN(k) ((k) == ONLY_PHASE && lo <= (k) && (k) < hi)
#else
#define IN(k) (lo <= (k) && (k) < hi)
#endif
#define SEAM(k) do { if (IN(k) && IN((k) + 1)) xcd_barrier(bar); } while (0)
#ifndef REPEAT_MASK
#define REPEAT_MASK 0
#endif
#ifndef P11A_SKIP
#define P11A_SKIP 0
#endif
#define REPS(k) for (int rep_ = 0; rep_ < (((REPEAT_MASK) >> (k)) & 1) + 1; ++rep_)
#define RSEAM(k) do { if ((((REPEAT_MASK) >> (k)) & 1) && rep_ == 0) xcd_barrier(bar); } while (0)
    unsigned char* ws = args.ws;
    if (IN(0)) { REPS(0) { p0_prologue(F); RSEAM(0); } SEAM(0); }
    if (IN(1)) {
        pg8::Gemm g{(const bf16*)(ws + WS_XN), (const bf16*)(ws + WS_W1), SEQ, N1, DM}; pg8::StaticOrder S; S.init(SEQ, N1, F.G, (int)blockIdx.x);
        EpiG1 E{ws, F.in[I_LB], (const float*)(ws + WS_QX), (const float*)(ws + WS_QW) + QW_W1};
        if (QM_G1) g.A = (const bf16*)((const unsigned char*)F.out + DO_XN8);
        if ((REPEAT_MASK >> 1) & 1) { pg8::gemm_phase<EpiG1, pg8::StaticOrder, PG8_ALIGN, PG8_SP2, QM_G1>(F.lds, g, S, E); xcd_barrier(bar); }
        pg8::gemm_phase<EpiG1, pg8::StaticOrder, PG8_ALIGN, PG8_SP2, QM_G1>(F.lds, g, S, E);
        p1_ab(F);
        SEAM(1);
    }
#ifdef EXTRA_BARRIERS
    for (int eb = 0; eb < EXTRA_BARRIERS; ++eb) xcd_barrier(bar);
#endif
    if (IN(2)) { REPS(2) { hgrn_pass<false>(F); RSEAM(2); } SEAM(2); }
    if (IN(3)) { if ((REPEAT_MASK >> 3) & 1) { hgrn_pass<true, P11A_SKIP>(F); xcd_barrier(bar); } hgrn_pass<true>(F); SEAM(3); }
    if (IN(4)) { if ((REPEAT_MASK >> 4) & 1) { gdn_prep<P11A_SKIP>(F); xcd_barrier(bar); } gdn_prep<0>(F); SEAM(4); }
    if (IN(5)) { if ((REPEAT_MASK >> 5) & 1) { gdn_pass<false, P11A_SKIP>(F); xcd_barrier(bar); } gdn_pass<false>(F); SEAM(5); }
    if (IN(6)) { if ((REPEAT_MASK >> 6) & 1) { gdn_pass<true, P11A_SKIP>(F); xcd_barrier(bar); } gdn_pass<true>(F); SEAM(6); }
    if (IN(7)) { REPS(7) { p7_mix(F); RSEAM(7); } SEAM(7); }
    if (IN(8)) {
        pg8::StaticOrder S; S.init(SEQ, DM, F.G, (int)blockIdx.x);
        bf16* GT = (bf16*)(ws + WS_GT); unsigned char* GA8 = ws + WS_GT2; unsigned char* GB8 = ws + WS_GT2 + 32 * MiB;
        const bf16* XNg = QM_GATE ? (const bf16*)((const unsigned char*)F.out + DO_XN8) : (const bf16*)(ws + WS_XN);
        const bf16* WG2 = QM_GATE ? (const bf16*)(ws + WS_WG + (size_t)DM * DM) : (const bf16*)(ws + WS_WG) + (size_t)DM * DM;
        const float* QX = (const float*)(ws + WS_QX); const float* QW = (const float*)(ws + WS_QW);
#define P8_BODY \
        { pg8::Gemm g{XNg, (const bf16*)(ws + WS_WG), SEQ, DM, DM}; EpiGate E{GA8, QX, QW + QW_WG}; pg8::gemm_phase<EpiGate, pg8::StaticOrder, PG8_ALIGN, PG8_SP2, QM_GATE>(F.lds, g, S, E); } \
        __builtin_amdgcn_fence(__ATOMIC_ACQUIRE, "agent"); VM_WAIT(); __syncthreads(); \
        { pg8::Gemm g{(const bf16*)(ws + WS_YA), (const bf16*)(ws + WS_WPA), SEQ, DM, HW}; EpiMix<0> E{GT, GA8, nullptr, QX + SEQ, QW + QW_WPA}; pg8::gemm_phase<EpiMix<0>, pg8::StaticOrder, PG8_ALIGN, PG8_SP2, QM_MIX>(F.lds, g, S, E); } \
        { pg8::Gemm g{XNg, WG2, SEQ, DM, DM}; EpiGate E{GB8, QX, QW + QW_WG + DM}; pg8::gemm_phase<EpiGate, pg8::StaticOrder, PG8_ALIGN, PG8_SP2, QM_GATE>(F.lds, g, S, E); } \
        __builtin_amdgcn_fence(__ATOMIC_ACQUIRE, "agent"); VM_WAIT(); __syncthreads(); \
        { pg8::Gemm g{(const bf16*)(ws + WS_YB), (const bf16*)(ws + WS_WPB), SEQ, DM, HW}; EpiMix<1> E{GT, GB8, ws + WS_GT8, QX + 2 * SEQ, QW + QW_WPB}; pg8::gemm_phase<EpiMix<1>, pg8::StaticOrder, PG8_ALIGN, PG8_SP2, QM_MIX>(F.lds, g, S, E); }
        if ((REPEAT_MASK >> 8) & 1) { P8_BODY xcd_barrier(bar); }
        P8_BODY
#undef P8_BODY
        SEAM(8);
    }
    if (IN(9)) {
        pg8::Gemm g{(const bf16*)(ws + (QM_OUT ? WS_GT8 : WS_GT)), (const bf16*)(ws + WS_WOUT), SEQ, DM, DM}; pg8::StaticOrder S; S.init(SEQ, DM, F.G, (int)blockIdx.x);
        EpiX1 E{F.in[I_X], F.out, (bf16*)(ws + WS_X1B)};
        if ((REPEAT_MASK >> 9) & 1) { pg8::gemm_phase<EpiX1, pg8::StaticOrder, PG8_ALIGN, PG8_SP2, QM_OUT>(F.lds, g, S, E); xcd_barrier(bar); }
        pg8::gemm_phase<EpiX1, pg8::StaticOrder, PG8_ALIGN, PG8_SP2, QM_OUT>(F.lds, g, S, E);
        SEAM(9);
    }
    if (IN(10)) {
        pg8::Gemm g{(const bf16*)(ws + WS_X1B), (const bf16*)(ws + WS_WS), SEQ, DM, DM}; pg8::StaticOrder S; S.init(SEQ, DM, F.G, (int)blockIdx.x);
        EpiBf E{(bf16*)(ws + WS_SC)};
        if ((REPEAT_MASK >> 10) & 1) { pg8::gemm_phase<EpiBf, pg8::StaticOrder, PG8_ALIGN, PG8_SP2>(F.lds, g, S, E); xcd_barrier(bar); }
        pg8::gemm_phase<EpiBf, pg8::StaticOrder, PG8_ALIGN, PG8_SP2>(F.lds, g, S, E);
        SEAM(10);
    }
    if (IN(11)) {
        if ((REPEAT_MASK >> 11) & 1) { p11a_topk<P11A_SKIP>(F); xcd_barrier(bar); if (blockIdx.x == 0) for (int i = F.tid; i < NBUCK + 1; i += NTHR) __hip_atomic_store((unsigned*)(F.ctl + CW_CNT) + i * 16, 0u, __ATOMIC_RELAXED, __HIP_MEMORY_SCOPE_AGENT); xcd_barrier(bar); }
        p11a_topk<0>(F); SEAM(11); }
    if (IN(12)) { if ((REPEAT_MASK >> 12) & 1) { p11b_udot<P11A_SKIP>(F); xcd_barrier(bar); if (blockIdx.x == 0 && F.tid == 0) __hip_atomic_store((unsigned*)(F.ctl + CW_Q), 0u, __ATOMIC_RELAXED, __HIP_MEMORY_SCOPE_AGENT); xcd_barrier(bar); } p11b_udot<0>(F); SEAM(12); }
    if (IN(13)) { p11c_vsum(F); }
#undef IN
#undef SEAM
}


#ifdef PROBE
__global__ void digest_kernel(const unsigned* ws, float* out) {
    const size_t n = (size_t)SEQ * DM;
    for (size_t i = (size_t)blockIdx.x * blockDim.x + threadIdx.x; i < n; i += (size_t)gridDim.x * blockDim.x) {
        unsigned acc = (PROBE >= 9) ? __builtin_bit_cast(unsigned, out[i]) : 0u;
        const size_t offs[5] = {0, 128 * MiB / 4, 256 * MiB / 4, 384 * MiB / 4, 408 * MiB / 4};
#pragma unroll
        for (int r = 0; r < 5; ++r) acc = acc * 1664525u + ws[offs[r] + i];
        out[i] = (float)(acc >> 8) * (1.0f / 16777216.0f);
    }
}
#endif
extern "C" void kernel_launch(void* const* d_in, const int* in_sizes, int n_in, void* d_out, int out_size, void* d_ws, size_t ws_size, hipStream_t stream) {
    static int grid = 0;
    if (grid == 0) {
        if (n_in != 19 || in_sizes[0] != SEQ * DM || out_size != SEQ * DM || ws_size < WS_END) { fprintf(stderr, "kernel_launch: unexpected shapes (n_in %d, in0 %d, out %d, ws %zu; need ws >= %zu)\n", n_in, n_in > 0 ? in_sizes[0] : -1, out_size, ws_size, (size_t)WS_END); grid = -1; return; }
        int dev = 0, cus = 0, per_cu = 0;
        if (hipGetDevice(&dev) != hipSuccess || hipDeviceGetAttribute(&cus, hipDeviceAttributeMultiprocessorCount, dev) != hipSuccess) { grid = -1; return; }
        if (hipFuncSetAttribute((const void*)fwd_kernel, hipFuncAttributeMaxDynamicSharedMemorySize, LDS_BYTES) != hipSuccess) { fprintf(stderr, "kernel_launch: hipFuncSetAttribute failed\n"); grid = -1; return; }
        if (hipOccupancyMaxActiveBlocksPerMultiprocessor(&per_cu, (const void*)fwd_kernel, NTHR, LDS_BYTES) != hipSuccess || per_cu < 1) fprintf(stderr, "kernel_launch: occupancy query reports %d\n", per_cu);
        (void)hipGetLastError();
        grid = cus;
    }
    if (grid < 0) return;
    (void)hipMemsetAsync((char*)d_ws + WS_CTL, 0, CTL_ZERO_BYTES, stream);
    Args a{};
    for (int i = 0; i < 19; ++i) a.in[i] = (const float*)d_in[i];
    a.out = (float*)d_out; a.ws = (unsigned char*)d_ws;
    for (int li = 0; li < N_LAUNCHES; ++li) {
        a.ph_lo = (N_LAUNCHES == 1) ? 0 : li; a.ph_hi = (N_LAUNCHES == 1) ? N_PHASES : li + 1;
#ifdef PROBE
        if (li > PROBE) break;
#endif
        hipLaunchKernelGGL(fwd_kernel, dim3(grid), dim3(NTHR), LDS_BYTES, stream, a);
    }
#ifdef PROBE
    hipLaunchKernelGGL(digest_kernel, dim3(2048), dim3(256), 0, stream, (const unsigned*)d_ws, (float*)d_out);
#endif
}
```

```cpp
#include <hip/hip_runtime.h>
#include <cstdio>
#include <cstdint>
#define GAS __attribute__((address_space(1)))
#define LAS __attribute__((address_space(3)))
#define MK_N_LAUNCHES 1
namespace pg8 {
#define PG8_LAS __attribute__((address_space(3)))
typedef unsigned short bf16_t;
typedef short bf16x8 __attribute__((ext_vector_type(8)));
typedef float f32x4 __attribute__((ext_vector_type(4)));
typedef unsigned u32x4 __attribute__((ext_vector_type(4)));
constexpr int BM = 256, BK = 64, HALF = 128, HTB = HALF * BK * 2  , STAGE_BYTES = 8 * HTB, NXCD = 8, WGM = 8;

__host__ __device__ __forceinline__ int lds_byte(int r, int c) { const int st = (r >> 4) * 2 + (c >> 5), rr = r & 15, cc = c & 31, ob = rr * 64 + cc * 2; return st * 1024 + (ob ^ (((ob >> 9) & 1) << 5)); }
__host__ __device__ __forceinline__ void stage_rc(int b, int& R, int& C) { const int st = b / 1024, sb = b % 1024, swz = sb ^ (((sb >> 9) & 1) << 5); R = (st >> 1) * 16 + swz / 64; C = (st & 1) * 32 + (swz % 64) / 2; }
__host__ __device__ __forceinline__ int perm32(int rho) { const int n = rho >> 4, i = rho & 15; return 8 * (i >> 2) + 4 * n + (i & 3); }

struct Unit { int pm, pn; };
struct Gemm { const bf16_t* A; const bf16_t* Bt; int M, N, K; };

struct StaticOrder {
    int nM, nN, nwg, G, c;
    __host__ __device__ void init(int M, int N, int G_, int c_) { nM = M / BM; nN = N / BM; nwg = nM * nN; G = G_; c = c_; }
    __host__ __device__ bool next(int i, Unit& u) const {
        const long L = (long)i * G + c; if (L >= nwg) return false;
        int wgid = (int)L; { const int q = nwg / NXCD, r = nwg % NXCD, xcd = wgid % NXCD, off = wgid / NXCD; wgid = (xcd < r ? xcd * (q + 1) : r * (q + 1) + (xcd - r) * q) + off; }
        const int nig = WGM * nN, gid = wgid / nig, fm = gid * WGM, gsz = (nM - fm) < WGM ? (nM - fm) : WGM;
        u.pm = fm + ((wgid % nig) % gsz); u.pn = (wgid % nig) / gsz; return true;
    }
    __device__ __forceinline__ void a_ready(const Unit&) const {}
    __device__ __forceinline__ void done(const Unit&) const {}
};

__device__ __forceinline__ unsigned cvt_pk_bf16(float lo, float hi) { unsigned r; asm volatile("v_cvt_pk_bf16_f32 %0, %1, %2" : "=v"(r) : "v"(lo), "v"(hi)); return r; }
typedef float f32x2 __attribute__((ext_vector_type(2)));
__device__ __forceinline__ f32x2 gelu_pk(f32x2 v) {
    const f32x2 av = __builtin_elementwise_abs(v), d = av * 0.2316418882f + 1.0f;
    f32x2 t; t.x = __builtin_amdgcn_rcpf(d.x); t.y = __builtin_amdgcn_rcpf(d.y);
    f32x2 q = t * 0.5307027145f + (-0.7265760135f); q = q * t + 0.7107068705f; q = q * t + (-0.142248368f); q = q * t + 0.127414796f; q = q * t;
    const f32x2 s = (v * v) * (-0.72134752044f);
    f32x2 e; e.x = __builtin_amdgcn_exp2f(s.x); e.y = __builtin_amdgcn_exp2f(s.y);
    const f32x2 m = v * (q * e), r = v - m;
    f32x2 o; o.x = v.x < 0.f ? m.x : r.x; o.y = v.y < 0.f ? m.y : r.y; return o;
}

typedef int i32x4v __attribute__((ext_vector_type(4)));
typedef int i32x8v __attribute__((ext_vector_type(8)));
__device__ __forceinline__ i32x8v cat8(bf16x8 lo, bf16x8 hi) { return __builtin_shufflevector(__builtin_bit_cast(i32x4v, lo), __builtin_bit_cast(i32x4v, hi), 0, 1, 2, 3, 4, 5, 6, 7); }
template <class Epi, class Sched, bool ALIGN_EPI = false, bool SP2 = false, int QM = 0>
__device__ __forceinline__ void gemm_phase(PG8_LAS unsigned char* lds, const Gemm g, const Sched& S, const Epi& E) {
    const int tid = threadIdx.x, wid = __builtin_amdgcn_readfirstlane(tid >> 6), lane = tid & 63, wr = wid >> 2, wc = wid & 3, fr = lane & 15, fq = lane >> 4;
    constexpr bool F8 = QM == 1, I8 = QM == 2;
    const int K = g.K, KB = QM ? K : 2 * K  , nt = KB / (BK * 2);
    unsigned voffA[2], voffB[2];
#pragma unroll
    for (int i = 0; i < 2; ++i) { int R, C; stage_rc(tid * 16 + i * 8192, R, C); const int Rb = Epi::PERM ? ((R & ~31) + perm32(R & 31)) : R;
        voffA[i] = (unsigned)(R * KB + C * 2); voffB[i] = (unsigned)(Rb * KB + C * 2); }
    const size_t kstep = (size_t)(BK * 2);
    const size_t hstep = (size_t)HALF * KB;
    const size_t tstep = 2 * hstep;
    const unsigned ldsw = (unsigned)wid * 1024u;
    const int aoff = lds_byte(wr * 64 + fr, fq * 8), boff = lds_byte(wc * 32 + fr, fq * 8);
#define PG8_SA(b, h) (((b) * 2 + (h)) * HTB)
#define PG8_SB(b, h) ((4 + (b) * 2 + (h)) * HTB)
#define PG8_STAGE(bufoff, gbase, voff) do { _Pragma("unroll") for (int _i = 0; _i < 2; ++_i) \
        __builtin_amdgcn_global_load_lds((const unsigned*)((const char*)(gbase) + (voff)[_i]), (PG8_LAS unsigned*)(lds + (bufoff) + ldsw + _i * 8192), 16, 0, 0); } while (0)
#define PG8_LD16(off) (*(const PG8_LAS bf16x8*)(lds + (off)))
#define PG8_LDA(dst, b, h) do { _Pragma("unroll") for (int m = 0; m < 4; ++m) { if constexpr (F8) dst##8[m] = cat8(PG8_LD16(PG8_SA(b, h) + aoff + m * 2048), PG8_LD16(PG8_SA(b, h) + aoff + m * 2048 + 1024)); \
        else { _Pragma("unroll") for (int k = 0; k < 2; ++k) dst[m][k] = PG8_LD16(PG8_SA(b, h) + aoff + m * 2048 + k * 1024); } } } while (0)
#define PG8_LDB(dst, b, h) do { _Pragma("unroll") for (int n = 0; n < 2; ++n) { if constexpr (F8) dst##8[n] = cat8(PG8_LD16(PG8_SB(b, h) + boff + n * 2048), PG8_LD16(PG8_SB(b, h) + boff + n * 2048 + 1024)); \
        else { _Pragma("unroll") for (int k = 0; k < 2; ++k) dst[n][k] = PG8_LD16(PG8_SB(b, h) + boff + n * 2048 + k * 1024); } } } while (0)
#define PG8_MMA(ai, bj, At, Bt) do { __builtin_amdgcn_s_setprio(1); _Pragma("unroll") for (int m = 0; m < 4; ++m) _Pragma("unroll") for (int n = 0; n < 2; ++n) { \
        if constexpr (F8) asm volatile("v_mfma_f32_16x16x128_f8f6f4 %0, %1, %2, %0" : "+v"(acc[ai][bj][m][n]) : "v"(Bt##8[n]), "v"(At##8[m])); \
        else if constexpr (I8) { _Pragma("unroll") for (int k = 0; k < 2; ++k) acc[ai][bj][m][n] = __builtin_bit_cast(f32x4, __builtin_amdgcn_mfma_i32_16x16x64_i8(__builtin_bit_cast(i32x4v, Bt[n][k]), __builtin_bit_cast(i32x4v, At[m][k]), __builtin_bit_cast(i32x4v, acc[ai][bj][m][n]), 0, 0, 0)); } \
        else { _Pragma("unroll") for (int k = 0; k < 2; ++k) acc[ai][bj][m][n] = __builtin_amdgcn_mfma_f32_16x16x32_bf16(Bt[n][k], At[m][k], acc[ai][bj][m][n], 0, 0, 0); } } \
        __builtin_amdgcn_s_setprio(0); } while (0)
#define PG8_WAIT_V(n) asm volatile("s_waitcnt vmcnt(" #n ")" ::: "memory")
#define PG8_WAIT_L(n) asm volatile("s_waitcnt lgkmcnt(" #n ")" ::: "memory")
#define PG8_BAR __builtin_amdgcn_s_barrier()
#define PG8_SCHED __builtin_amdgcn_sched_barrier(0)
    Unit cur, nxt; int ui = 0;
    if (!S.next(0, cur)) return;
    f32x4 acc[2][2][4][2];
#pragma unroll
    for (int a = 0; a < 2; ++a)
#pragma unroll
        for (int b = 0; b < 2; ++b)
#pragma unroll
            for (int m = 0; m < 4; ++m)
#pragma unroll
                for (int n = 0; n < 2; ++n) acc[a][b][m][n] = (f32x4){0.f, 0.f, 0.f, 0.f};
    bf16x8 At[4][2], B0[2][2], B1[2][2]; i32x8v At8[4], B08[2], B18[2];
    const char* cA = (const char*)g.A + (size_t)cur.pm * tstep; const char* cB = (const char*)g.Bt + (size_t)cur.pn * tstep;
    S.a_ready(cur);
    if constexpr (SP2) {
        PG8_STAGE(PG8_SB(0, 0), cB, voffB); PG8_STAGE(PG8_SB(0, 1), cB + hstep, voffB); PG8_STAGE(PG8_SA(0, 0), cA, voffA); PG8_STAGE(PG8_SA(0, 1), cA + hstep, voffA);
        if (wr == 1) PG8_BAR;
        PG8_WAIT_V(2); PG8_BAR;
        PG8_STAGE(PG8_SB(1, 0), cB + kstep, voffB); PG8_STAGE(PG8_SA(1, 0), cA + kstep, voffA); PG8_STAGE(PG8_SB(1, 1), cB + hstep + kstep, voffB);
        PG8_WAIT_V(6); PG8_BAR;
    } else {
        PG8_STAGE(PG8_SB(0, 0), cB, voffB); PG8_STAGE(PG8_SA(0, 0), cA, voffA); PG8_STAGE(PG8_SB(0, 1), cB + hstep, voffB); PG8_STAGE(PG8_SA(0, 1), cA + hstep, voffA);
        if (wr == 1) PG8_BAR;
        PG8_WAIT_V(4); PG8_BAR;
        PG8_STAGE(PG8_SB(1, 0), cB + kstep, voffB); PG8_STAGE(PG8_SA(1, 0), cA + kstep, voffA); PG8_STAGE(PG8_SB(1, 1), cB + hstep + kstep, voffB);
        PG8_WAIT_V(6); PG8_BAR;
    }
    for (;;) {
        const bool has_next = S.next(ui + 1, nxt);
        const char* nA = has_next ? (const char*)g.A + (size_t)nxt.pm * tstep : cA; const char* nB = has_next ? (const char*)g.Bt + (size_t)nxt.pn * tstep : cB;
        for (int t = 0; t < nt; t += 2) {
            const bool last = (t == nt - 2);
            const char* a1 = cA + (size_t)(t + 1) * kstep;
            const char* a2 = last ? nA : cA + (size_t)(t + 2) * kstep; const char* b2 = last ? nB : cB + (size_t)(t + 2) * kstep;
            const char* a3 = a2 + kstep; const char* b3 = b2 + kstep;
            if (last && has_next) S.a_ready(nxt);
            if constexpr (SP2) {
            PG8_LDB(B0, 0, 0); PG8_LDB(B1, 0, 1); PG8_SCHED; PG8_LDA(At, 0, 0); PG8_STAGE(PG8_SA(1, 1), a1 + hstep, voffA);
            PG8_WAIT_V(8); PG8_WAIT_L(0); PG8_BAR; PG8_MMA(0, 0, At, B0); PG8_MMA(0, 1, At, B1); PG8_BAR; PG8_SCHED;
            PG8_LDA(At, 0, 1); PG8_STAGE(PG8_SB(0, 0), b2, voffB); PG8_STAGE(PG8_SB(0, 1), b2 + hstep, voffB); PG8_STAGE(PG8_SA(0, 0), a2, voffA);
            PG8_WAIT_V(8); PG8_WAIT_L(0); PG8_BAR; PG8_MMA(1, 0, At, B0); PG8_MMA(1, 1, At, B1); PG8_BAR; PG8_SCHED;
            PG8_LDB(B0, 1, 0); PG8_LDB(B1, 1, 1); PG8_SCHED; PG8_LDA(At, 1, 0); PG8_STAGE(PG8_SA(0, 1), a2 + hstep, voffA);
            PG8_WAIT_V(8); PG8_WAIT_L(0); PG8_BAR; PG8_MMA(0, 0, At, B0); PG8_MMA(0, 1, At, B1); PG8_BAR; PG8_SCHED;
            PG8_LDA(At, 1, 1); PG8_STAGE(PG8_SB(1, 0), b3, voffB); PG8_STAGE(PG8_SB(1, 1), b3 + hstep, voffB); PG8_STAGE(PG8_SA(1, 0), a3, voffA);
            PG8_WAIT_V(8); PG8_WAIT_L(0); PG8_BAR; PG8_MMA(1, 0, At, B0); PG8_MMA(1, 1, At, B1); PG8_BAR; PG8_SCHED;
            } else {
            PG8_LDB(B0, 0, 0); PG8_SCHED; PG8_LDA(At, 0, 0); PG8_STAGE(PG8_SA(1, 1), a1 + hstep, voffA);
            PG8_WAIT_L(8); PG8_BAR; PG8_WAIT_L(0); PG8_MMA(0, 0, At, B0); PG8_BAR; PG8_SCHED;
            PG8_LDB(B1, 0, 1); PG8_STAGE(PG8_SB(0, 0), b2, voffB);
            PG8_BAR; PG8_WAIT_L(0); PG8_MMA(0, 1, At, B1); PG8_BAR;
            PG8_LDA(At, 0, 1); PG8_STAGE(PG8_SA(0, 0), a2, voffA);
            PG8_BAR; PG8_WAIT_L(0); PG8_MMA(1, 0, At, B0); PG8_BAR; PG8_SCHED;
            PG8_STAGE(PG8_SB(0, 1), b2 + hstep, voffB);
            PG8_WAIT_V(6); PG8_BAR; PG8_MMA(1, 1, At, B1); PG8_BAR;
            PG8_LDB(B0, 1, 0); PG8_SCHED; PG8_LDA(At, 1, 0); PG8_STAGE(PG8_SA(0, 1), a2 + hstep, voffA);
            PG8_WAIT_L(8); PG8_BAR; PG8_WAIT_L(0); PG8_MMA(0, 0, At, B0); PG8_BAR; PG8_SCHED;
            PG8_LDB(B1, 1, 1); PG8_STAGE(PG8_SB(1, 0), b3, voffB);
            PG8_BAR; PG8_WAIT_L(0); PG8_MMA(0, 1, At, B1); PG8_BAR;
            PG8_LDA(At, 1, 1); PG8_STAGE(PG8_SA(1, 0), a3, voffA);
            PG8_BAR; PG8_WAIT_L(0); PG8_MMA(1, 0, At, B0); PG8_BAR; PG8_SCHED;
            PG8_STAGE(PG8_SB(1, 1), b3 + hstep, voffB);
            PG8_WAIT_V(6); PG8_BAR; PG8_MMA(1, 1, At, B1); PG8_BAR;
            }
        }
        if constexpr (ALIGN_EPI) { if (wr == 0) PG8_BAR; }
        if constexpr (F8) asm volatile("s_nop 15\n\ts_nop 15" ::: "memory");
        if constexpr (!Epi::AFTER_DRAIN) { E(acc, cur, wr, wc, fr, fq); S.done(cur); }
        if (!has_next) break;
#pragma unroll
        for (int a = 0; a < 2; ++a)
#pragma unroll
            for (int b = 0; b < 2; ++b)
#pragma unroll
                for (int m = 0; m < 4; ++m)
#pragma unroll
                    for (int n = 0; n < 2; ++n) acc[a][b][m][n] = (f32x4){0.f, 0.f, 0.f, 0.f};
        cur = nxt; cA = nA; cB = nB; ++ui;
        if constexpr (ALIGN_EPI) { if (wr == 1) PG8_BAR; }
    }
    PG8_WAIT_V(0);
    if constexpr (!ALIGN_EPI) { if (wr == 0) PG8_BAR; }
    PG8_BAR;
    if constexpr (Epi::AFTER_DRAIN) { E.fused(acc, cur, wr, wc, fr, fq, lds, wid, lane); S.done(cur); }
#undef PG8_SA
#undef PG8_SB
#undef PG8_STAGE
#undef PG8_LD16
#undef PG8_LDA
#undef PG8_LDB
#undef PG8_MMA
#undef PG8_WAIT_V
#undef PG8_WAIT_L
#undef PG8_BAR
#undef PG8_SCHED
}
}
typedef unsigned short bf16;
typedef unsigned v4u __attribute__((ext_vector_type(4)));
typedef unsigned v2u __attribute__((ext_vector_type(2)));
typedef float f32x4 __attribute__((ext_vector_type(4)));
typedef float f32x2 __attribute__((ext_vector_type(2)));
typedef short bf16x8 __attribute__((ext_vector_type(8)));
typedef GAS unsigned gu32;
#define RLX_AGENT __ATOMIC_RELAXED, __HIP_MEMORY_SCOPE_AGENT
#define LDS_WAIT() asm volatile("s_waitcnt lgkmcnt(0)" ::: "memory")
#define VM_WAIT() asm volatile("s_waitcnt vmcnt(0)" ::: "memory")
typedef __bf16 bf16x2_hw __attribute__((ext_vector_type(2)));
__device__ __forceinline__ unsigned pk2(float lo, float hi) { const f32x2 v = {lo, hi}; const bf16x2_hw b = __builtin_convertvector(v, bf16x2_hw); return __builtin_bit_cast(unsigned, b); }
__device__ __forceinline__ unsigned pk4f8(float a, float b, float c, float d) { int w = 0; w = __builtin_amdgcn_cvt_pk_fp8_f32(a, b, w, false); w = __builtin_amdgcn_cvt_pk_fp8_f32(c, d, w, true); return (unsigned)w; }
__device__ __forceinline__ float cvt_ub0(unsigned w) { float f; asm("v_cvt_f32_ubyte0 %0, %1" : "=v"(f) : "v"(w)); return f; }
__device__ __forceinline__ float cvt_ub1(unsigned w) { float f; asm("v_cvt_f32_ubyte1 %0, %1" : "=v"(f) : "v"(w)); return f; }
__device__ __forceinline__ float cvt_ub2(unsigned w) { float f; asm("v_cvt_f32_ubyte2 %0, %1" : "=v"(f) : "v"(w)); return f; }
__device__ __forceinline__ float cvt_ub3(unsigned w) { float f; asm("v_cvt_f32_ubyte3 %0, %1" : "=v"(f) : "v"(w)); return f; }
__device__ __forceinline__ unsigned f2bf(float f) { return pk2(f, 0.f) & 0xffffu; }
__device__ __forceinline__ float bflo(unsigned w) { return __builtin_bit_cast(float, w << 16); }
__device__ __forceinline__ float bfhi(unsigned w) { return __builtin_bit_cast(float, w & 0xffff0000u); }
__device__ __forceinline__ float bf1(bf16 b) { return __builtin_bit_cast(float, ((unsigned)b) << 16); }
__device__ __forceinline__ float fast_exp(float x) { return __builtin_amdgcn_exp2f(x * 1.4426950408889634f); }
__device__ __forceinline__ float fast_rcp(float x) { return __builtin_amdgcn_rcpf(x); }
__device__ __forceinline__ float sigmoidf_(float x) { return fast_rcp(1.0f + fast_exp(-x)); }
__device__ __forceinline__ float siluf_(float x) { return x * sigmoidf_(x); }
template <int CTRL> __device__ __forceinline__ float dppf(float v) { return __builtin_bit_cast(float, __builtin_amdgcn_mov_dpp(__builtin_bit_cast(int, v), CTRL, 0xF, 0xF, true)); }
template <int CTRL> __device__ __forceinline__ int dppi(int v) { return __builtin_amdgcn_mov_dpp(v, CTRL, 0xF, 0xF, true); }
__device__ __forceinline__ float rdl(float v, int l) { return __builtin_bit_cast(float, __builtin_amdgcn_readlane(__builtin_bit_cast(int, v), l)); }
__device__ __forceinline__ float wave_sum(float v) {
    v += dppf<0xB1>(v); v += dppf<0x4E>(v); v += dppf<0x141>(v); v += dppf<0x140>(v);
    return (rdl(v, 0) + rdl(v, 16)) + (rdl(v, 32) + rdl(v, 48));
}
__device__ __forceinline__ float wave_max(float v) {
    v = fmaxf(v, dppf<0xB1>(v)); v = fmaxf(v, dppf<0x4E>(v)); v = fmaxf(v, dppf<0x141>(v)); v = fmaxf(v, dppf<0x140>(v));
    return fmaxf(fmaxf(rdl(v, 0), rdl(v, 16)), fmaxf(rdl(v, 32), rdl(v, 48)));
}
__device__ __forceinline__ int wave_sum_i(int v) {
    v += dppi<0xB1>(v); v += dppi<0x4E>(v); v += dppi<0x141>(v); v += dppi<0x140>(v);
    return (__builtin_amdgcn_readlane(v, 0) + __builtin_amdgcn_readlane(v, 16)) + (__builtin_amdgcn_readlane(v, 32) + __builtin_amdgcn_readlane(v, 48));
}

constexpr int NWAVES = 8, NTHR = 512;
constexpr int SEQ = 16384, DM = 2048, NH = 8, HD = 128, HW = 1024;
constexpr int CK = 64, NCHUNK = SEQ / CK, NSEG = 16, CPS = NCHUNK / NSEG;
constexpr int INW = 13344;
constexpr int N1 = 9216;
constexpr float EPS = 1e-6f;
constexpr int PEER_K = 16;

constexpr size_t MiB = (size_t)1 << 20;
constexpr size_t WS_CTL = 0, CTL_ZERO_BYTES = 1 * MiB;
constexpr size_t WS_WG = 2 * MiB, WS_WPA = 18 * MiB, WS_WPB = 22 * MiB, WS_WOUT = 26 * MiB, WS_WS = 34 * MiB, WS_W1 = 42 * MiB;
constexpr size_t WS_XN = 80 * MiB;
constexpr size_t WS_H = 144 * MiB;
constexpr size_t WS_GAB = 432 * MiB;
constexpr size_t WS_HL = 434 * MiB;
constexpr size_t WS_HDS = 450 * MiB;
constexpr size_t WS_OHF = 452 * MiB, WS_OHB = 484 * MiB;
constexpr size_t WS_GSC = 516 * MiB;
constexpr size_t WS_UTF = 144 * MiB, WS_UTB = 176 * MiB, WS_WF = 208 * MiB, WS_WB = 240 * MiB;
constexpr size_t DO_AQKF = 0, DO_AQKB = 16 * MiB, DO_QN = 32 * MiB, DO_KNT = 64 * MiB;
constexpr size_t WS_GL = 42 * MiB, WS_GP = 58 * MiB;
constexpr size_t WS_OGF = 304 * MiB, WS_OGB = 336 * MiB;
constexpr size_t WS_YA = 42 * MiB, WS_YB = 368 * MiB;
constexpr size_t WS_TU = 144 * MiB, WS_TV = 176 * MiB;
constexpr size_t WS_PSC = 520 * MiB;
constexpr size_t WS_GT = 272 * MiB, WS_GT2 = 400 * MiB;
constexpr size_t WS_X1B = 400 * MiB;
constexpr size_t WS_SC = 272 * MiB;
constexpr size_t WS_END = 536 * MiB;
#ifndef QM_G1_
#define QM_G1_ 2
#endif
#ifndef QM_GATE_
#define QM_GATE_ 2
#endif
#ifndef QM_MIX_
#define QM_MIX_ 2
#endif
#ifndef QM_OUT_
#define QM_OUT_ 0
#endif
constexpr int QM_G1 = QM_G1_, QM_GATE = QM_GATE_, QM_MIX = QM_MIX_, QM_OUT = QM_OUT_;
constexpr int QM_XN = QM_G1 ? QM_G1 : QM_GATE;
static_assert(QM_G1 == 0 || QM_GATE == 0 || QM_G1 == QM_GATE, "xn has one 8-bit copy");
static_assert(QM_OUT != 2, "merged has no row scale");
constexpr float F8_WSCALE = 128.0f;
constexpr size_t WS_WAB = 78 * MiB;
constexpr size_t DO_XN8 = 96 * MiB;
constexpr size_t WS_GT8 = 336 * MiB;
constexpr size_t WS_QW = 521 * MiB;
constexpr int QW_W1 = 0, QW_WG = 9216, QW_WPA = 13312, QW_WPB = 15360, QW_WOUT = 17408, QW_WAB = 19456;
constexpr bool AB_I8 = QM_XN == 2;
constexpr bool XN_BF16 = QM_G1 == 0 || QM_GATE == 0 || !AB_I8;
constexpr size_t WS_QX = 522 * MiB;
#ifndef VFMT
#define VFMT 6
#endif
#ifndef FP6_IL
#define FP6_IL 1
#endif
constexpr int TV_PITCH = VFMT == 6 ? 1536 : 2048;
typedef float v16f __attribute__((ext_vector_type(16)));
typedef float v32f __attribute__((ext_vector_type(32)));
typedef unsigned v6u __attribute__((ext_vector_type(6)));
constexpr int CW_BAR = 4096;

constexpr int LDS_BYTES = 163840;
constexpr int MISC_OFF = 163840 - 256;
constexpr int LDS_USABLE = MISC_OFF;

__device__ __forceinline__ bf16x8 ldfrag(const LAS bf16* T, int pitch, int row, int k) { return *(const LAS bf16x8*)(T + row * pitch + k); }
__device__ __forceinline__ f32x4 mfma16(bf16x8 x, bf16x8 y, f32x4 c) { return __builtin_amdgcn_mfma_f32_16x16x32_bf16(x, y, c, 0, 0, 0); }
__device__ __forceinline__ v2u pack4(f32x4 v) { v2u r; r.x = pk2(v[0], v[1]); r.y = pk2(v[2], v[3]); return r; }
#define XB_TMO      128
#define XB_XCNT(j)  (256  + 64 * (j))
#define XB_XSUB(j)  (1280 + 64 * (j))
#define XB_XGEN(j)  (2304 + 64 * (j))
#define XB_TOP      3328
#define XB_TOPGEN   3392
#define XCD_BAR_WORDS 3456
#define XB_SPIN_CAP (1u << 18)

__device__ __forceinline__ unsigned xb_ld(unsigned* p)              { return __hip_atomic_load(p, __ATOMIC_RELAXED, __HIP_MEMORY_SCOPE_AGENT); }
__device__ __forceinline__ unsigned xb_add(unsigned* p, unsigned v) { return __hip_atomic_fetch_add(p, v, __ATOMIC_RELAXED, __HIP_MEMORY_SCOPE_AGENT); }
__device__ __forceinline__ unsigned xb_xcc_id() { return (unsigned)__builtin_amdgcn_s_getreg((3 << 11) | 20) & 0xFu; }
#define XB_SPIN(cond, bar) do { unsigned _sp = 0; while (cond) { __builtin_amdgcn_s_sleep(1); \
    if ((++_sp & 255u) == 0u) { if (xb_ld(&(bar)[XB_TMO])) break; if (_sp > XB_SPIN_CAP) { atomicAdd(&(bar)[XB_TMO], 1u); break; } } } } while (0)

struct XcdBarrier {
    unsigned* bar; unsigned x;
    volatile LAS unsigned* st;
};

__device__ __forceinline__ XcdBarrier xcd_barrier_post(unsigned* bar, volatile LAS unsigned* st) {
    XcdBarrier b; b.bar = bar; b.x = xb_xcc_id(); b.st = st;
    if (threadIdx.x == 0) (void)xb_add(&bar[XB_XCNT(b.x)], 1u);
    return b;
}
__device__ __forceinline__ void xcd_barrier_complete(unsigned* bar, unsigned x, unsigned& nloc, unsigned& nx) {
    const unsigned G = gridDim.x * gridDim.y * gridDim.z;
    unsigned sum, cnt, mine, sp = 0u;
    for (;;) {
        sum = 0u; cnt = 0u; mine = 0u;
#pragma unroll
        for (unsigned j = 0; j < 16; ++j) { const unsigned c = xb_ld(&bar[XB_XCNT(j)]); sum += c; cnt += (c > 0u) ? 1u : 0u; mine = (j == x) ? c : mine; }
        if (sum == G) break;
        __builtin_amdgcn_s_sleep(1);
        if ((++sp & 255u) == 0u) { if (xb_ld(&bar[XB_TMO])) break; if (sp > XB_SPIN_CAP) { atomicAdd(&bar[XB_TMO], 1u); break; } }
    }
    nloc = mine > 0u ? mine : 1u; nx = cnt > 0u ? cnt : 1u;
}

__device__ __forceinline__ void xcd_barrier(const XcdBarrier& b) {
    asm volatile("s_waitcnt vmcnt(0)" ::: "memory");
    __syncthreads();
    if (threadIdx.x == 0) {
        unsigned* bar = b.bar;
        __builtin_amdgcn_s_waitcnt(0);
        unsigned nloc = b.st[0], nx = b.st[1];
        if (nloc == 0u) { xcd_barrier_complete(bar, b.x, nloc, nx); b.st[0] = nloc; b.st[1] = nx; }
        const unsigned old = xb_add(&bar[XB_XSUB(b.x)], 1u);
        const unsigned gen = old / nloc;
        if (old + 1u == (gen + 1u) * nloc) {
            __builtin_amdgcn_fence(__ATOMIC_RELEASE, "agent");
            asm volatile("s_waitcnt vmcnt(0)" ::: "memory");
            const unsigned og = xb_add(&bar[XB_TOP], 1u);
            const unsigned tg = og / nx;
            if (og + 1u == (tg + 1u) * nx) xb_add(&bar[XB_TOPGEN], 1u);
            else XB_SPIN(xb_ld(&bar[XB_TOPGEN]) == tg, bar);
            __builtin_amdgcn_fence(__ATOMIC_ACQUIRE, "agent");
            xb_add(&bar[XB_XGEN(b.x)], 1u);
            asm volatile("s_waitcnt vmcnt(0)" ::: "memory");
        } else {
            XB_SPIN(xb_ld(&bar[XB_XGEN(b.x)]) == gen, bar);
            __builtin_amdgcn_fence(__ATOMIC_ACQUIRE, "agent");
            asm volatile("s_waitcnt vmcnt(0)" ::: "memory");
        }
    }
    __syncthreads();
}

struct Frame {
    LAS unsigned char* lds;
    volatile LAS unsigned* MISC;
    gu32* ctl;
    int tid, lane, wave, vcu, G;
    const float* in[19]; float* out; unsigned char* ws;
};
enum { I_X = 0, I_N1W, I_WIN, I_LB, I_HNW, I_CONVW, I_ALOG, I_DTB, I_GNW, I_WPA, I_WPB, I_WOUT, I_N2W, I_WQ, I_K1, I_K2, I_PU, I_PV, I_FNW };

template <bool F8>
__device__ __forceinline__ void p0_transpose_item(const float* W, int ldw, int c0, int K, int ncols, void* WTv, int row_off, LAS float* scr, int item, int lane) {
    const int nblk = ncols / 32, kb = item / nblk, nb = item % nblk, k0 = 64 * kb, n0 = 32 * nb;
#pragma unroll 8
    for (int i = 0; i < 32; ++i) { const int kk = 2 * i + (lane >> 5); scr[kk * 33 + (lane & 31)] = W[(size_t)(k0 + kk) * ldw + c0 + n0 + (lane & 31)]; }
    LDS_WAIT(); asm volatile("" ::: "memory");
    const int c = lane & 7;
#pragma unroll
    for (int j = 0; j < 4; ++j) { const int n = (lane >> 3) + 8 * j; const LAS float* s = scr + (8 * c) * 33 + n;
        if (F8) { v2u o; o.x = pk4f8(s[0 * 33] * F8_WSCALE, s[1 * 33] * F8_WSCALE, s[2 * 33] * F8_WSCALE, s[3 * 33] * F8_WSCALE); o.y = pk4f8(s[4 * 33] * F8_WSCALE, s[5 * 33] * F8_WSCALE, s[6 * 33] * F8_WSCALE, s[7 * 33] * F8_WSCALE);
            *(GAS v2u*)((unsigned char*)WTv + (size_t)(row_off + n0 + n) * K + k0 + 8 * c) = o; }
        else { v4u o; o.x = pk2(s[0 * 33], s[1 * 33]); o.y = pk2(s[2 * 33], s[3 * 33]); o.z = pk2(s[4 * 33], s[5 * 33]); o.w = pk2(s[6 * 33], s[7 * 33]);
            *(GAS v4u*)((bf16*)WTv + (size_t)(row_off + n0 + n) * K + k0 + 8 * c) = o; } }
    LDS_WAIT(); asm volatile("" ::: "memory");
}
__device__ __forceinline__ unsigned pk4i8(f32x4 v, float inv) {
    const int a = (int)rintf(v.x * inv), b = (int)rintf(v.y * inv), c = (int)rintf(v.z * inv), d = (int)rintf(v.w * inv);
    return (unsigned)(a & 255) | ((unsigned)(b & 255) << 8) | ((unsigned)(c & 255) << 16) | ((unsigned)d << 24);
}
__device__ __forceinline__ float amax4(f32x4 v) { const f32x4 a = __builtin_elementwise_abs(v); return fmaxf(fmaxf(a.x, a.y), fmaxf(a.z, a.w)); }
__device__ __forceinline__ void rms_row_to_bf16(int lane, const float* xrow, const float* w, bf16* orow, unsigned char* orow8, float* sx) {
    const GAS f32x4* xr = (const GAS f32x4*)xrow + lane; const GAS f32x4* wr = (const GAS f32x4*)w + lane;
    f32x4 v[8]; float s = 0.f;
#pragma unroll
    for (int j = 0; j < 8; ++j) { v[j] = xr[64 * j]; s += (v[j].x * v[j].x + v[j].y * v[j].y) + (v[j].z * v[j].z + v[j].w * v[j].w); }
    const float r = 1.0f / sqrtf(wave_sum(s) * (1.f / DM) + EPS);
    GAS v2u* o8 = (GAS v2u*)orow + lane; GAS unsigned* q8 = (GAS unsigned*)orow8 + lane; float am = 0.f;
#pragma unroll
    for (int j = 0; j < 8; ++j) { const f32x4 ww = wr[64 * j]; const f32x4 y = {v[j].x * r * ww.x, v[j].y * r * ww.y, v[j].z * r * ww.z, v[j].w * r * ww.w};
        if (XN_BF16) { v2u o; o.x = pk2(y.x, y.y); o.y = pk2(y.z, y.w); o8[64 * j] = o; }
        if (QM_XN == 1) q8[64 * j] = pk4f8(y.x, y.y, y.z, y.w);
        if (QM_XN == 2) { v[j] = y; am = fmaxf(am, amax4(y)); } }
    if (QM_XN == 2) { am = wave_max(am); const float inv = am > 0.f ? 127.0f / am : 0.f;
#pragma unroll
        for (int j = 0; j < 8; ++j) q8[64 * j] = pk4i8(v[j], inv);
        if (lane == 0) *sx = am > 0.f ? am * (1.0f / 127.0f) : 1.0f; }
}
template <int KT>
__device__ __forceinline__ void p0_quant_item(Frame& F, const float* W, int ldw, int c0, signed char* Wq, float* scl, int n0) {
    constexpr int KW = KT / 8, NB = KW / 64;
    const int col = F.lane & 31, kh = F.lane >> 5;
    const GAS float* src = (const GAS float*)W + (size_t)(F.wave * KW + 32 * kh) * ldw + c0 + n0 + col;
    float v[NB][32]; float mx = 0.f;
#pragma unroll
    for (int b = 0; b < NB; ++b)
#pragma unroll
        for (int i = 0; i < 32; ++i) v[b][i] = src[(size_t)(64 * b + i) * ldw];
#pragma unroll
    for (int b = 0; b < NB; ++b)
#pragma unroll
        for (int i = 0; i < 32; ++i) mx = fmaxf(mx, fabsf(v[b][i]));
    mx = fmaxf(mx, __shfl_xor(mx, 32));
    LAS float* part = (LAS float*)F.lds;
    if (kh == 0) part[F.wave * 32 + col] = mx;
    __syncthreads();
    float cm = part[col];
#pragma unroll
    for (int w = 1; w < 8; ++w) cm = fmaxf(cm, part[w * 32 + col]);
    const float inv = cm > 0.f ? 127.0f / cm : 0.f;
    if (F.wave == 0 && kh == 0) scl[n0 + col] = cm > 0.f ? cm * (1.0f / 127.0f) : 1.0f;
    GAS v4u* dst = (GAS v4u*)(Wq + (size_t)(n0 + col) * KT + F.wave * KW + 32 * kh);
#pragma unroll
    for (int b = 0; b < NB; ++b) { unsigned w[8];
#pragma unroll
        for (int q = 0; q < 8; ++q) w[q] = pk4i8((f32x4){v[b][4 * q], v[b][4 * q + 1], v[b][4 * q + 2], v[b][4 * q + 3]}, inv);
        dst[4 * b] = (v4u){w[0], w[1], w[2], w[3]}; dst[4 * b + 1] = (v4u){w[4], w[5], w[6], w[7]}; }
    __syncthreads();
}
__device__ __forceinline__ void p0_ws_item(Frame& F, int it) {
    const int h = it >> 6, half = (it >> 5) & 1, j0 = (it & 31) * 64, hc = h * 256 + half * 128;
    const float* Wq = F.in[I_WQ]; const float* Ks = half ? F.in[I_K2] : F.in[I_K1]; const float* n2 = F.in[I_N2W];
    LAS bf16* Xs = (LAS bf16*)F.lds; LAS bf16* Ys = Xs + 64 * 136;
    { const int row = F.tid >> 3, c0 = (F.tid & 7) * 16; const GAS f32x4* src = (const GAS f32x4*)(Wq + (size_t)(j0 + row) * DM + hc + c0);
      const f32x4 a = src[0], b = src[1], c = src[2], d = src[3];
      v4u o0, o1; o0.x = pk2(a.x, a.y); o0.y = pk2(a.z, a.w); o0.z = pk2(b.x, b.y); o0.w = pk2(b.z, b.w); o1.x = pk2(c.x, c.y); o1.y = pk2(c.z, c.w); o1.z = pk2(d.x, d.y); o1.w = pk2(d.z, d.w);
      *(LAS v4u*)(Xs + row * 136 + c0) = o0; *(LAS v4u*)(Xs + row * 136 + c0 + 8) = o1; }
    { const int row = F.tid >> 2, c0 = (F.tid & 3) * 32; const GAS f32x4* src = (const GAS f32x4*)(Ks + (size_t)row * 128 + c0);
#pragma unroll
      for (int q = 0; q < 4; ++q) { const f32x4 a = src[2 * q], b = src[2 * q + 1]; v4u o; o.x = pk2(a.x, a.y); o.y = pk2(a.z, a.w); o.z = pk2(b.x, b.y); o.w = pk2(b.z, b.w); *(LAS v4u*)(Ys + row * 136 + c0 + 8 * q) = o; } }
    __syncthreads();
    const int fr = F.lane & 15, fq = F.lane >> 4, w = F.wave;
    bf16* WSt = (bf16*)(F.ws + WS_WS);
#pragma unroll
    for (int jt = 0; jt < 4; ++jt) {
        f32x4 acc = {0.f, 0.f, 0.f, 0.f};
#pragma unroll
        for (int k0 = 0; k0 < 4; ++k0) acc = mfma16(ldfrag(Xs, 136, 16 * jt + fr, 32 * k0 + 8 * fq), ldfrag(Ys, 136, 16 * w + fr, 32 * k0 + 8 * fq), acc);
        const int jj = j0 + 16 * jt + 4 * fq; const f32x4 nw = *(const GAS f32x4*)(n2 + jj);
        *(GAS v2u*)(WSt + (size_t)(hc + 16 * w + fr) * DM + jj) = pack4(acc * nw);
    }
    __syncthreads();
}
__device__ __forceinline__ void p0_prologue(Frame& F) {
    LAS float* scr = (LAS float*)(F.lds + F.wave * 16384);
    const int gw = F.vcu * NWAVES + F.wave, NGW = F.G * NWAVES;
    constexpr int I_1 = QM_G1 == 2 ? 0 : (DM / 64) * (N1 / 32), I_AB = AB_I8 ? 0 : (DM / 64), I_G = QM_GATE == 2 ? 0 : (DM / 64) * (4096 / 32), I_PA = QM_MIX == 2 ? 0 : (HW / 64) * (DM / 32), I_O = QM_OUT == 2 ? 0 : (DM / 64) * (DM / 32);
    constexpr int NITEMS = I_1 + I_AB + I_G + 2 * I_PA + I_O;
    for (int it = gw; it < NITEMS; it += NGW) {
        int r = it;
        if (r < I_1) { p0_transpose_item<QM_G1 == 1>(F.in[I_WIN], INW, 0, DM, N1, F.ws + WS_W1, 0, scr, r, F.lane); continue; } r -= I_1;
        if (r < I_AB) { p0_transpose_item<false>(F.in[I_WIN], INW, N1, DM, 32, F.ws + WS_WAB, 0, scr, r, F.lane); continue; } r -= I_AB;
        if (r < I_G) { p0_transpose_item<QM_GATE == 1>(F.in[I_WIN], INW, 9248, DM, 4096, F.ws + WS_WG, 0, scr, r, F.lane); continue; } r -= I_G;
        if (r < I_PA) { p0_transpose_item<QM_MIX == 1>(F.in[I_WPA], DM, 0, HW, DM, F.ws + WS_WPA, 0, scr, r, F.lane); continue; } r -= I_PA;
        if (r < I_PA) { p0_transpose_item<QM_MIX == 1>(F.in[I_WPB], DM, 0, HW, DM, F.ws + WS_WPB, 0, scr, r, F.lane); continue; } r -= I_PA;
        p0_transpose_item<QM_OUT == 1>(F.in[I_WOUT], DM, 0, DM, DM, F.ws + WS_WOUT, 0, scr, r, F.lane);
    }
    bf16* XN = (bf16*)(F.ws + WS_XN); float* QX = (float*)(F.ws + WS_QX);
    for (int m = gw; m < SEQ; m += NGW) rms_row_to_bf16(F.lane, F.in[I_X] + (size_t)m * DM, F.in[I_N1W], XN + (size_t)m * DM, (unsigned char*)F.out + DO_XN8 + (size_t)m * DM, QX + m);
    __syncthreads();
    { constexpr int J_1 = (QM_G1 == 2 ? N1 / 32 : 0) + (AB_I8 ? 1 : 0), J_G = QM_GATE == 2 ? 4096 / 32 : 0, J_O = QM_OUT == 2 ? DM / 32 : 0, J_P = QM_MIX == 2 ? DM / 32 : 0;
      float* QW = (float*)(F.ws + WS_QW);
#pragma unroll 1
      for (int it = F.vcu; it < J_1 + J_G + J_O + 2 * J_P; it += F.G) {
          int r = it; const float* W = F.in[I_WIN]; int ldw = INW, c0 = 0, n0 = 0, qo = QW_W1; size_t wo = WS_W1; bool half = false;
          if (r < J_1) { n0 = 32 * r; if (AB_I8 && r == J_1 - 1) { c0 = N1; n0 = 0; qo = QW_WAB; wo = WS_WAB; } }
          else if ((r -= J_1) < J_G) { c0 = 9248; n0 = 32 * r; qo = QW_WG; wo = WS_WG; }
          else if ((r -= J_G) < J_O) { W = F.in[I_WOUT]; ldw = DM; n0 = 32 * r; qo = QW_WOUT; wo = WS_WOUT; }
          else if ((r -= J_O) < J_P) { W = F.in[I_WPA]; ldw = DM; n0 = 32 * r; qo = QW_WPA; wo = WS_WPA; half = true; }
          else { r -= J_P; W = F.in[I_WPB]; ldw = DM; n0 = 32 * r; qo = QW_WPB; wo = WS_WPB; half = true; }
          if (half) p0_quant_item<HW>(F, W, ldw, c0, (signed char*)(F.ws + wo), QW + qo, n0);
          else p0_quant_item<DM>(F, W, ldw, c0, (signed char*)(F.ws + wo), QW + qo, n0);
      } }
    __syncthreads();
    for (int it = blockIdx.x; it < 512; it += F.G) p0_ws_item(F, it);
}
typedef unsigned u32x4 __attribute__((ext_vector_type(4)));
__device__ __forceinline__ u32x4 pack8(f32x4 a, f32x4 b) { u32x4 w; w.x = pk2(a[0], a[1]); w.y = pk2(a[2], a[3]); w.z = pk2(b[0], b[1]); w.w = pk2(b[2], b[3]); return w; }
__device__ __forceinline__ void unpack8(u32x4 w, f32x4& a, f32x4& b) { a = (f32x4){bflo(w.x), bfhi(w.x), bflo(w.y), bfhi(w.y)}; b = (f32x4){bflo(w.z), bfhi(w.z), bflo(w.w), bfhi(w.w)}; }
__device__ __forceinline__ f32x4 silu4(f32x4 v) { return (f32x4){siluf_(v[0]), siluf_(v[1]), siluf_(v[2]), siluf_(v[3])}; }
__device__ __forceinline__ f32x4 sigm4(f32x4 v) { return (f32x4){sigmoidf_(v[0]), sigmoidf_(v[1]), sigmoidf_(v[2]), sigmoidf_(v[3])}; }

typedef int i32x4 __attribute__((ext_vector_type(4)));
template <int QM> __device__ __forceinline__ f32x4 deq(f32x4 a, float sr, f32x4 sc) {
    if (QM == 2) { const i32x4 q = __builtin_bit_cast(i32x4, a); return (f32x4){(float)q[0], (float)q[1], (float)q[2], (float)q[3]} * (sc * sr); }
    if (QM == 1) return a * (1.0f / F8_WSCALE);
    return a;
}
template <int QM, bool PERM> __device__ __forceinline__ void ld_colscale(f32x4 (&scv)[2][2], const float* sb, int cb) {
#pragma unroll
    for (int bj = 0; bj < 2; ++bj)
#pragma unroll
        for (int n = 0; n < 2; ++n) scv[bj][n] = (QM == 2) ? *(const f32x4*)(sb + cb + bj * 128 + (PERM ? 4 : 16) * n) : (f32x4){1.f, 1.f, 1.f, 1.f};
}
__device__ __forceinline__ unsigned pk4u8(f32x4 v) { const unsigned a = (unsigned)(v[0] * 255.f + 0.5f), b = (unsigned)(v[1] * 255.f + 0.5f), c = (unsigned)(v[2] * 255.f + 0.5f), d = (unsigned)(v[3] * 255.f + 0.5f); return a | (b << 8) | (c << 16) | (d << 24); }
__device__ __forceinline__ f32x4 un4u8(unsigned w) { return (f32x4){cvt_ub0(w), cvt_ub1(w), cvt_ub2(w), cvt_ub3(w)} * (1.0f / 255.f); }
struct EpiG1 {
    static constexpr bool PERM = true, AFTER_DRAIN = false;
    unsigned char* ws; const float* lbl;
    const float* sa; const float* sb;
    __device__ __forceinline__ void operator()(const f32x4 (&acc)[2][2][4][2], const pg8::Unit& u, int wr, int wc, int fr, int fq) const {
        const int pn = u.pn, row0 = u.pm * 256 + wr * 64 + fr;
        {
            const int grp = pn >> 2; const bool act = (grp == 0) | (grp == 4) | (grp == 8);
            bf16* base = (bf16*)(ws + WS_H + (size_t)grp * 32 * MiB); const int col0 = (pn & 3) * 256 + wc * 32 + 8 * fq;
            f32x4 scv[2][2]; ld_colscale<QM_G1, true>(scv, sb, pn * 256 + wc * 32 + 8 * fq);
            const bool fgate = (grp == 1) | (grp == 2); f32x4 lbv[2][2];
            if (fgate) { const float* l0 = lbl + (grp - 1) * 2048 + col0;
#pragma unroll
                for (int bj = 0; bj < 2; ++bj)
#pragma unroll
                    for (int n = 0; n < 2; ++n) { const f32x4 a0 = *(const f32x4*)(l0 + bj * 128 + 4 * n), a1 = *(const f32x4*)(l0 + 1024 + bj * 128 + 4 * n);
                        lbv[bj][n] = (f32x4){fast_rcp(1.0f + fast_exp(a1[0] - a0[0])), fast_rcp(1.0f + fast_exp(a1[1] - a0[1])), fast_rcp(1.0f + fast_exp(a1[2] - a0[2])), fast_rcp(1.0f + fast_exp(a1[3] - a0[3]))}; } }
#pragma unroll
            for (int ai = 0; ai < 2; ++ai)
#pragma unroll
                for (int m = 0; m < 4; ++m) { bf16* rowp = base + (size_t)(row0 + ai * 128 + m * 16) * HW + col0; const float sr = (QM_G1 == 2) ? sa[row0 + ai * 128 + m * 16] : 1.f;
#pragma unroll
                    for (int bj = 0; bj < 2; ++bj) { f32x4 v0 = deq<QM_G1>(acc[ai][bj][m][0], sr, scv[bj][0]), v1 = deq<QM_G1>(acc[ai][bj][m][1], sr, scv[bj][1]);
                        if (act) { v0 = silu4(v0); v1 = silu4(v1); }
                        if (fgate) { v0 = lbv[bj][0] + (1.0f - lbv[bj][0]) * sigm4(v0); v1 = lbv[bj][1] + (1.0f - lbv[bj][1]) * sigm4(v1); }
                        *(u32x4*)(rowp + bj * 128) = pack8(v0, v1); } }
        }
    }
};
struct EpiGate {
    static constexpr bool PERM = true, AFTER_DRAIN = false;
    unsigned char* O; const float* sa; const float* sb;
    __device__ __forceinline__ void operator()(const f32x4 (&acc)[2][2][4][2], const pg8::Unit& u, int wr, int wc, int fr, int fq) const {
        const int row0 = u.pm * 256 + wr * 64 + fr, col0 = u.pn * 256 + wc * 32 + 8 * fq;
        f32x4 scv[2][2]; ld_colscale<QM_GATE, true>(scv, sb, col0);
#pragma unroll
        for (int ai = 0; ai < 2; ++ai)
#pragma unroll
            for (int m = 0; m < 4; ++m) { unsigned char* rowp = O + (size_t)(row0 + ai * 128 + m * 16) * DM + col0; const float sr = (QM_GATE == 2) ? sa[row0 + ai * 128 + m * 16] : 1.f;
#pragma unroll
                for (int bj = 0; bj < 2; ++bj) { v2u w; w.x = pk4u8(sigm4(deq<QM_GATE>(acc[ai][bj][m][0], sr, scv[bj][0]))); w.y = pk4u8(sigm4(deq<QM_GATE>(acc[ai][bj][m][1], sr, scv[bj][1]))); *(v2u*)(rowp + bj * 128) = w; } }
    }
};
template <int MODE> struct EpiMix {
    static constexpr bool PERM = true, AFTER_DRAIN = false;
    bf16* O; const unsigned char* G; unsigned char* O8;
    const float* sa; const float* sb;
    __device__ __forceinline__ void operator()(const f32x4 (&acc)[2][2][4][2], const pg8::Unit& u, int wr, int wc, int fr, int fq) const {
        const int row0 = u.pm * 256 + wr * 64 + fr, col0 = u.pn * 256 + wc * 32 + 8 * fq;
        f32x4 scv[2][2]; ld_colscale<QM_MIX, true>(scv, sb, col0);
#pragma unroll
        for (int ai = 0; ai < 2; ++ai)
#pragma unroll
            for (int m = 0; m < 4; ++m) { const size_t off = (size_t)(row0 + ai * 128 + m * 16) * DM + col0; const float sr = (QM_MIX == 2) ? sa[row0 + ai * 128 + m * 16] : 1.f;
#pragma unroll
                for (int bj = 0; bj < 2; ++bj) { f32x4 o0, o1; const v2u gw = *(const v2u*)(G + off + bj * 128); const f32x4 g0 = un4u8(gw.x), g1 = un4u8(gw.y);
                    const f32x4 c0 = deq<QM_MIX>(acc[ai][bj][m][0], sr, scv[bj][0]), c1 = deq<QM_MIX>(acc[ai][bj][m][1], sr, scv[bj][1]);
                    if (MODE == 0) { o0 = g0 * c0; o1 = g1 * c1; }
                    else { unpack8(*(const u32x4*)(O + off + bj * 128), o0, o1); o0 = o0 + g0 * c0; o1 = o1 + g1 * c1; }
                    if (MODE == 1 && QM_OUT == 1) { v2u w; w.x = pk4f8(o0[0], o0[1], o0[2], o0[3]); w.y = pk4f8(o1[0], o1[1], o1[2], o1[3]); *(v2u*)(O8 + off + bj * 128) = w; }
                    else *(u32x4*)(O + off + bj * 128) = pack8(o0, o1); } }
    }
};
struct EpiX1 {
    static constexpr bool PERM = false, AFTER_DRAIN = false;
    const float* x; float* out; bf16* xb;
    __device__ __forceinline__ void operator()(const f32x4 (&acc)[2][2][4][2], const pg8::Unit& u, int wr, int wc, int fr, int fq) const {
        const int row0 = u.pm * 256 + wr * 64 + fr, col0 = u.pn * 256 + wc * 32 + 4 * fq;
#pragma unroll
        for (int ai = 0; ai < 2; ++ai)
#pragma unroll
            for (int m = 0; m < 4; ++m) { const size_t off = (size_t)(row0 + ai * 128 + m * 16) * DM + col0;
#pragma unroll
                for (int bj = 0; bj < 2; ++bj)
#pragma unroll
                    for (int n = 0; n < 2; ++n) { const size_t o = off + bj * 128 + n * 16; const f32x4 v = *(const f32x4*)(x + o) + deq<QM_OUT>(acc[ai][bj][m][n], 1.f, (f32x4){1.f, 1.f, 1.f, 1.f});
                        *(v2u*)(xb + o) = pack4(v); } }
    }
};
struct EpiBf {
    static constexpr bool PERM = true, AFTER_DRAIN = false;
    bf16* O;
    __device__ __forceinline__ void operator()(const f32x4 (&acc)[2][2][4][2], const pg8::Unit& u, int wr, int wc, int fr, int fq) const {
        const int row0 = u.pm * 256 + wr * 64 + fr, col0 = u.pn * 256 + wc * 32 + 8 * fq;
#pragma unroll
        for (int ai = 0; ai < 2; ++ai)
#pragma unroll
            for (int m = 0; m < 4; ++m) { bf16* rowp = O + (size_t)(row0 + ai * 128 + m * 16) * DM + col0;
#pragma unroll
                for (int bj = 0; bj < 2; ++bj) *(u32x4*)(rowp + bj * 128) = pack8(acc[ai][bj][m][0], acc[ai][bj][m][1]); }
    }
};
struct EpiF32 {
    static constexpr bool PERM = false, AFTER_DRAIN = false;
    float* C;
    __device__ __forceinline__ void operator()(const f32x4 (&acc)[2][2][4][2], const pg8::Unit& u, int wr, int wc, int fr, int fq) const {
        const int row0 = u.pm * 256 + wr * 64 + fr, col0 = u.pn * 256 + wc * 32 + 4 * fq;
#pragma unroll
        for (int ai = 0; ai < 2; ++ai)
#pragma unroll
            for (int m = 0; m < 4; ++m) { float* rowp = C + (size_t)(row0 + ai * 128 + m * 16) * DM + col0;
#pragma unroll
                for (int bj = 0; bj < 2; ++bj)
#pragma unroll
                    for (int n = 0; n < 2; ++n) *(f32x4*)(rowp + bj * 128 + n * 16) = acc[ai][bj][m][n]; }
    }
};

__device__ __forceinline__ void p1_ab(Frame& F) {
    float* Gab = (float*)(F.ws + WS_GAB);
    const int fr = F.lane & 15, fq = F.lane >> 4, rt = F.wave >> 1, ct = F.wave & 1;
    if (AB_I8) {
        const signed char* XQ = (const signed char*)F.out + DO_XN8; const signed char* Wab = (const signed char*)(F.ws + WS_WAB);
        const float* QX = (const float*)(F.ws + WS_QX); const f32x4 sw = *(const f32x4*)((const float*)(F.ws + WS_QW) + QW_WAB + ct * 16 + 4 * fq);
        for (int blk = F.vcu; blk < SEQ / 64; blk += F.G) {
            const int row = blk * 64 + rt * 16 + fr;
            const signed char* ap = XQ + (size_t)row * DM + 16 * fq; const signed char* bp = Wab + (size_t)(ct * 16 + fr) * DM + 16 * fq;
            i32x4 acc = {0, 0, 0, 0};
#pragma unroll 1
            for (int kb = 0; kb < DM; kb += 1024) { i32x4 af[16], bfr[16];
#pragma unroll
                for (int u = 0; u < 16; ++u) { af[u] = *(const GAS i32x4*)(ap + kb + 64 * u); bfr[u] = *(const GAS i32x4*)(bp + kb + 64 * u); }
                __builtin_amdgcn_sched_barrier(0);
#pragma unroll
                for (int u = 0; u < 16; ++u) acc = __builtin_amdgcn_mfma_i32_16x16x64_i8(bfr[u], af[u], acc, 0, 0, 0);
                __builtin_amdgcn_sched_barrier(0); }
            *(GAS f32x4*)(Gab + (size_t)row * 32 + ct * 16 + 4 * fq) = (f32x4){(float)acc[0], (float)acc[1], (float)acc[2], (float)acc[3]} * (sw * QX[row]);
        }
        return;
    }
    const bf16* XN = (const bf16*)(F.ws + WS_XN); const bf16* Wab = (const bf16*)(F.ws + WS_WAB);
    for (int blk = F.vcu; blk < SEQ / 64; blk += F.G) {
        const bf16* ap = XN + (size_t)(blk * 64 + rt * 16 + fr) * DM + 8 * fq; const bf16* bp = Wab + (size_t)(ct * 16 + fr) * DM + 8 * fq;
        f32x4 acc = {0.f, 0.f, 0.f, 0.f};
#pragma unroll 1
        for (int kb = 0; kb < DM; kb += 512) { bf16x8 af[16], bfr[16];
#pragma unroll
            for (int u = 0; u < 16; ++u) { af[u] = *(const GAS bf16x8*)(ap + kb + 32 * u); bfr[u] = *(const GAS bf16x8*)(bp + kb + 32 * u); }
            __builtin_amdgcn_sched_barrier(0);
#pragma unroll
            for (int u = 0; u < 16; ++u) acc = mfma16(bfr[u], af[u], acc);
            __builtin_amdgcn_sched_barrier(0); }
        *(GAS f32x4*)(Gab + (size_t)(blk * 64 + rt * 16 + fr) * 32 + ct * 16 + 4 * fq) = acc;
    }
}
template <bool PASS3, int SKIP = 0>
__device__ __forceinline__ void hgrn_pass(Frame& F) {
    LAS bf16*  ST  = (LAS bf16*)(F.lds + 0);
    LAS float* LF  = (LAS float*)(F.lds + 0);
    LAS bf16*  QT  = (LAS bf16*)(F.lds + 34816);
    LAS bf16*  KT  = (LAS bf16*)(F.lds + 52224);
    LAS bf16*  KHT = (LAS bf16*)(F.lds + 69632);
    LAS bf16*  VT  = (LAS bf16*)(F.lds + 88064);
    LAS bf16*  ATT = (LAS bf16*)(F.lds + 106496);
    LAS float* PT  = (LAS float*)(F.lds + 115712);
    LAS float* BL  = (LAS float*)(F.lds + 117760);
    LAS float* DKK = (LAS float*)(F.lds + 118272);
    LAS float* LBV = (LAS float*)(F.lds + 118784);
    LAS bf16*  VR  = (LAS bf16*)(F.lds + 119296);
    const int tid = F.tid, lane = F.lane, w = F.wave, fr = lane & 15, fq = lane >> 4;
    const int row = tid >> 3, c0 = (tid & 7) * 16;
    float* HL = (float*)(F.ws + WS_HL); float* HDS = (float*)(F.ws + WS_HDS);
    for (int it = blockIdx.x; it < 256; it += F.G) {
        const int hd = it >> 4, sg = it & 15, dir = hd >> 3, h = hd & 7;
        const bf16* Hq = (const bf16*)(F.ws + WS_H); const bf16* Hf = (const bf16*)(F.ws + WS_H + (size_t)(1 + dir) * 32 * MiB); const bf16* Hi = (const bf16*)(F.ws + WS_H + (size_t)3 * 32 * MiB);
        bf16* Oh = (bf16*)(F.ws + (dir ? WS_OHB : WS_OHF));
        __syncthreads();
        f32x4 Sacc[8];
#pragma unroll
        for (int kt = 0; kt < 8; ++kt) Sacc[kt] = (f32x4){0.f, 0.f, 0.f, 0.f};
        if (PASS3) {
            for (int p = 0; p < sg; ++p) { const int ip = hd * 16 + p; f32x4 dsv[8], lv[8];
#pragma unroll
                for (int kt = 0; kt < 8; ++kt) { dsv[kt] = *(const GAS f32x4*)(HDS + ip * 128 + 16 * kt + 4 * fq); lv[kt] = *(const GAS f32x4*)(HL + ((size_t)((ip * 8 + w) * 8 + kt) * 64 + lane) * 4); }
                __builtin_amdgcn_sched_barrier(0);
#pragma unroll
                for (int kt = 0; kt < 8; ++kt) Sacc[kt] = Sacc[kt] * dsv[kt] + lv[kt];
                __builtin_amdgcn_sched_barrier(0); }
        }
        float sumbl = 1.f;
        v4u rq[2], rf[2], rv[2];
        { const int oc = dir ? 255 - sg * 16 : sg * 16; const size_t off = (size_t)(64 * oc + row) * HW + h * 128 + c0;
          rq[0] = *(const GAS v4u*)(Hq + off); rq[1] = *(const GAS v4u*)(Hq + off + 8); rf[0] = *(const GAS v4u*)(Hf + off); rf[1] = *(const GAS v4u*)(Hf + off + 8); rv[0] = *(const GAS v4u*)(Hi + off); rv[1] = *(const GAS v4u*)(Hi + off + 8); }
        __syncthreads();
        for (int ci = 0; ci < ((SKIP & 4) ? 1 : CPS); ++ci) {
            const int sc = sg * 16 + ci, oc = dir ? 255 - sc : sc, tok0 = 64 * oc;
            float kk[16], qq[16];
            { const unsigned fw[8] = {rf[0].x, rf[0].y, rf[0].z, rf[0].w, rf[1].x, rf[1].y, rf[1].z, rf[1].w};
              const unsigned qw[8] = {rq[0].x, rq[0].y, rq[0].z, rq[0].w, rq[1].x, rq[1].y, rq[1].z, rq[1].w};
              float fgv[16];
#pragma unroll
              for (int e = 0; e < 16; ++e) { fgv[e] = (e & 1) ? bfhi(fw[e >> 1]) : bflo(fw[e >> 1]); qq[e] = (e & 1) ? bfhi(qw[e >> 1]) : bflo(qw[e >> 1]); kk[e] = 1.0f - fgv[e]; }
#pragma unroll
              for (int q4 = 0; q4 < 4; ++q4) *(LAS f32x4*)(LF + row * 132 + c0 + 4 * q4) = (f32x4){fgv[4 * q4], fgv[4 * q4 + 1], fgv[4 * q4 + 2], fgv[4 * q4 + 3]};
              *(LAS v4u*)(VR + row * 136 + c0) = rv[0]; *(LAS v4u*)(VR + row * 136 + c0 + 8) = rv[1]; }
            if (ci + 1 < CPS && !(SKIP & 2)) { const int oc2 = dir ? oc - 1 : oc + 1; const size_t off = (size_t)(64 * oc2 + row) * HW + h * 128 + c0;
              rq[0] = *(const GAS v4u*)(Hq + off); rq[1] = *(const GAS v4u*)(Hq + off + 8); rf[0] = *(const GAS v4u*)(Hf + off); rf[1] = *(const GAS v4u*)(Hf + off + 8); rv[0] = *(const GAS v4u*)(Hi + off); rv[1] = *(const GAS v4u*)(Hi + off + 8); }
            if (!(SKIP & 8)) __syncthreads();
            { const int c = tid & 127, part = tid >> 7, r0 = part * 16; float b[16], fv[16]; float run = 1.f;
#pragma unroll
              for (int i = 0; i < 16; ++i) fv[i] = LF[(r0 + i) * 132 + c];
              if (!dir) {
#pragma unroll
                  for (int i = 0; i < 16; ++i) { run *= fv[i]; b[i] = run; }
              } else {
#pragma unroll
                  for (int i = 15; i >= 0; --i) { run *= fv[i]; b[i] = run; }
              }
              PT[part * 128 + c] = run;
              unsigned short vcol[16];
#pragma unroll
              for (int i = 0; i < 16; ++i) vcol[i] = VR[(r0 + i) * 136 + c];
              if (!(SKIP & 8)) __syncthreads();
              const float p0 = PT[c], p1 = PT[128 + c], p2 = PT[256 + c], p3 = PT[384 + c];
              float offs;
              if (!dir) offs = (part > 0 ? p0 : 1.f) * (part > 1 ? p1 : 1.f) * (part > 2 ? p2 : 1.f);
              else      offs = (part < 3 ? p3 : 1.f) * (part < 2 ? p2 : 1.f) * (part < 1 ? p1 : 1.f);
              const float tot = (p0 * p1) * (p2 * p3);
              unsigned kh[8], vw[8];
#pragma unroll
              for (int i = 0; i < 8; ++i) { const float P0 = b[2 * i] * offs, P1 = b[2 * i + 1] * offs;
                  if (PASS3) { LF[(r0 + 2 * i) * 132 + c] = P0; LF[(r0 + 2 * i + 1) * 132 + c] = P1; }
                  kh[i] = pk2((1.0f - fv[2 * i]) * tot * fast_rcp(P0), (1.0f - fv[2 * i + 1]) * tot * fast_rcp(P1)); vw[i] = (unsigned)vcol[2 * i] | ((unsigned)vcol[2 * i + 1] << 16); }
              *(LAS v4u*)(KHT + c * 72 + r0) = (v4u){kh[0], kh[1], kh[2], kh[3]}; *(LAS v4u*)(KHT + c * 72 + r0 + 8) = (v4u){kh[4], kh[5], kh[6], kh[7]};
              *(LAS v4u*)(VT + c * 72 + r0) = (v4u){vw[0], vw[1], vw[2], vw[3]}; *(LAS v4u*)(VT + c * 72 + r0 + 8) = (v4u){vw[4], vw[5], vw[6], vw[7]};
              if (part == 0) { DKK[c] = tot; sumbl *= tot; }
            }
            if (!(SKIP & 8)) __syncthreads();
            if (PASS3 && !(SKIP & 1)) { float bb[16];
#pragma unroll
              for (int q4 = 0; q4 < 4; ++q4) { const f32x4 t4 = *(const LAS f32x4*)(LF + row * 132 + c0 + 4 * q4); bb[4 * q4] = t4[0]; bb[4 * q4 + 1] = t4[1]; bb[4 * q4 + 2] = t4[2]; bb[4 * q4 + 3] = t4[3]; }
              unsigned qo[8], ko[8];
#pragma unroll
              for (int e = 0; e < 8; ++e) { qo[e] = pk2(qq[2 * e] * bb[2 * e], qq[2 * e + 1] * bb[2 * e + 1]); ko[e] = pk2(kk[2 * e] * fast_rcp(bb[2 * e]), kk[2 * e + 1] * fast_rcp(bb[2 * e + 1])); }
              *(LAS v4u*)(QT + row * 136 + c0) = (v4u){qo[0], qo[1], qo[2], qo[3]}; *(LAS v4u*)(QT + row * 136 + c0 + 8) = (v4u){qo[4], qo[5], qo[6], qo[7]};
              *(LAS v4u*)(KT + row * 136 + c0) = (v4u){ko[0], ko[1], ko[2], ko[3]}; *(LAS v4u*)(KT + row * 136 + c0 + 8) = (v4u){ko[4], ko[5], ko[6], ko[7]};
            }
            if (PASS3) if (!(SKIP & 8)) __syncthreads();
            if (PASS3 && !(SKIP & 1)) {
                { bf16x8 kf[2][4], qf[2][4]; f32x4 acc[2];
#pragma unroll
                  for (int q2 = 0; q2 < 2; ++q2) { const int tl = 2 * w + q2, ti = tl >> 2, tj = tl & 3; acc[q2] = (f32x4){0.f, 0.f, 0.f, 0.f};
#pragma unroll
                      for (int k0 = 0; k0 < 4; ++k0) { kf[q2][k0] = ldfrag(KT, 136, 16 * ti + fr, 32 * k0 + 8 * fq); qf[q2][k0] = ldfrag(QT, 136, 16 * tj + fr, 32 * k0 + 8 * fq); } }
                  __builtin_amdgcn_sched_barrier(0);
#pragma unroll
                  for (int k0 = 0; k0 < 4; ++k0)
#pragma unroll
                      for (int q2 = 0; q2 < 2; ++q2) acc[q2] = mfma16(kf[q2][k0], qf[q2][k0], acc[q2]);
                  __builtin_amdgcn_sched_barrier(0);
#pragma unroll
                  for (int q2 = 0; q2 < 2; ++q2) { const int tl = 2 * w + q2, ti = tl >> 2, tj = tl & 3; const int t = 16 * tj + fr, s0 = 16 * ti + 4 * fq;
#pragma unroll
                      for (int r = 0; r < 4; ++r) { const bool keep = dir ? (s0 + r >= t) : (s0 + r <= t); acc[q2][r] = keep ? acc[q2][r] : 0.f; }
                      *(LAS v2u*)(ATT + t * 72 + s0) = pack4(acc[q2]); } }
#pragma unroll
                for (int kt = 0; kt < 8; ++kt) *(LAS v2u*)(ST + (16 * w + fr) * 136 + 16 * kt + 4 * fq) = pack4(Sacc[kt]);
                if (!(SKIP & 8)) __syncthreads();
            }
            bf16x8 xv[2];
#pragma unroll
            for (int s0 = 0; s0 < 2; ++s0) xv[s0] = ldfrag(VT, 72, 16 * w + fr, 32 * s0 + 8 * fq);
            if (PASS3 && !(SKIP & 1)) {
                bf16x8 xs[4];
#pragma unroll
                for (int k0 = 0; k0 < 4; ++k0) xs[k0] = ldfrag(ST, 136, 16 * w + fr, 32 * k0 + 8 * fq);
#pragma unroll
                for (int th = 0; th < 2; ++th) { bf16x8 qf[2][4], af[2][2]; f32x4 acc[2];
#pragma unroll
                    for (int tq = 0; tq < 2; ++tq) { const int tt = 2 * th + tq; acc[tq] = (f32x4){0.f, 0.f, 0.f, 0.f};
#pragma unroll
                        for (int k0 = 0; k0 < 4; ++k0) qf[tq][k0] = ldfrag(QT, 136, 16 * tt + fr, 32 * k0 + 8 * fq);
#pragma unroll
                        for (int s0 = 0; s0 < 2; ++s0) af[tq][s0] = ldfrag(ATT, 72, 16 * tt + fr, 32 * s0 + 8 * fq); }
                    __builtin_amdgcn_sched_barrier(0);
#pragma unroll
                    for (int k0 = 0; k0 < 4; ++k0)
#pragma unroll
                        for (int tq = 0; tq < 2; ++tq) acc[tq] = mfma16(xs[k0], qf[tq][k0], acc[tq]);
#pragma unroll
                    for (int s0 = 0; s0 < 2; ++s0)
#pragma unroll
                        for (int tq = 0; tq < 2; ++tq) acc[tq] = mfma16(xv[s0], af[tq][s0], acc[tq]);
                    __builtin_amdgcn_sched_barrier(0);
#pragma unroll
                    for (int tq = 0; tq < 2; ++tq) *(GAS v2u*)(Oh + (size_t)(tok0 + 16 * (2 * th + tq) + fr) * HW + h * 128 + 16 * w + 4 * fq) = pack4(acc[tq]); }
            }
#pragma unroll
            for (int kh = 0; kh < ((SKIP & 1) ? 0 : 2); ++kh) { bf16x8 kf[4][2];
#pragma unroll
                for (int kq = 0; kq < 4; ++kq) { const int kt = 4 * kh + kq; const f32x4 d4 = *(const LAS f32x4*)(DKK + 16 * kt + 4 * fq); Sacc[kt] = Sacc[kt] * d4;
#pragma unroll
                    for (int s0 = 0; s0 < 2; ++s0) kf[kq][s0] = ldfrag(KHT, 72, 16 * kt + fr, 32 * s0 + 8 * fq); }
                __builtin_amdgcn_sched_barrier(0);
#pragma unroll
                for (int s0 = 0; s0 < 2; ++s0)
#pragma unroll
                    for (int kq = 0; kq < 4; ++kq) Sacc[4 * kh + kq] = mfma16(kf[kq][s0], xv[s0], Sacc[4 * kh + kq]);
                __builtin_amdgcn_sched_barrier(0); }
            if (!(SKIP & 8)) __syncthreads();
        }
        if (!PASS3) {
#pragma unroll
            for (int kt = 0; kt < 8; ++kt) *(GAS f32x4*)(HL + ((size_t)((it * 8 + w) * 8 + kt) * 64 + lane) * 4) = Sacc[kt];
            if (tid < 128) HDS[it * 128 + tid] = sumbl;
        }
    }
}
template <int SKIP>
__device__ __forceinline__ void gdn_prep(Frame& F) {
    LAS bf16*  QN  = (LAS bf16*)(F.lds + 0);
    LAS bf16*  KN  = (LAS bf16*)(F.lds + 17408);
    LAS bf16*  VT  = (LAS bf16*)(F.lds + 34816);
    LAS bf16*  KNT = (LAS bf16*)(F.lds + 53248);
    LAS float* AM  = (LAS float*)(F.lds + 71680);
    LAS bf16*  TB  = (LAS bf16*)(F.lds + 104448);
    LAS bf16*  VR  = (LAS bf16*)(F.lds + 104448);
    LAS float* CWL = (LAS float*)(F.lds + 142848);
    LAS float* DEC = (LAS float*)(F.lds + 141312);
    LAS float* BET = DEC + 128;
    LAS float* EXD = DEC + 256;
    const int tid = F.tid, lane = F.lane, w = F.wave, fr = lane & 15, fq = lane >> 4;
    const int row = tid >> 3, c0 = (tid & 7) * 16;
    const bf16* Gq = (const bf16*)(F.ws + WS_H + (size_t)5 * 32 * MiB); const bf16* Gk = (const bf16*)(F.ws + WS_H + (size_t)6 * 32 * MiB); const bf16* Gv = (const bf16*)(F.ws + WS_H + (size_t)7 * 32 * MiB);
    const float* Gab = (const float*)(F.ws + WS_GAB); const float* cw = F.in[I_CONVW];
    unsigned char* dob = (unsigned char*)F.out;
    bf16* QNg = (bf16*)(dob + DO_QN); bf16* KNTg = (bf16*)(dob + DO_KNT); float* GSC = (float*)(F.ws + WS_GSC);
    int hload = -1;
    for (int it = blockIdx.x; it < 2048; it += F.G) {
        const int h = it & 7, oc = it >> 3, tok0 = 64 * oc;
        __syncthreads();
        if (h != hload) { hload = h;
            for (int i = tid; i < 5 * 384; i += NTHR) { const int j = i / 384, r = i % 384; CWL[i] = cw[j * 3072 + (r >> 7) * 1024 + h * 128 + (r & 127)]; }
            __syncthreads(); }
        if (it + F.G < 2048 && tid < 408) { const int it2 = it + F.G, h2 = it2 & 7, oc2 = it2 >> 3; const int tz = tid / 136, rl = tid % 136, r = rl >> 1, half = rl & 1; const int tr = 64 * oc2 - 2 + r;
            if (tr >= 0 && tr < SEQ) { const bf16* src = (tz == 0 ? Gq : tz == 1 ? Gk : Gv) + (size_t)tr * HW + h2 * 128 + half * 64; unsigned tmp = *(const GAS unsigned*)src; asm volatile("" :: "v"(tmp)); } }
        if (tid < 128) { const int dir = tid >> 6, l = tid & 63, pos = dir ? 63 - l : l;
            const float a = Gab[(size_t)(tok0 + pos) * 32 + dir * 8 + h], b = Gab[(size_t)(tok0 + pos) * 32 + 16 + dir * 8 + h];
            const float x = a + F.in[I_DTB][dir * 8 + h]; const float sp = x > 20.f ? x : log1pf(__expf(x));
            float d = -__expf(F.in[I_ALOG][dir * 8 + h]) * sp;
#pragma unroll
            for (int o = 1; o < 64; o <<= 1) { const float t = __shfl_up(d, o); if (l >= o) d += t; }
            DEC[dir * 64 + pos] = d; BET[dir * 64 + pos] = sigmoidf_(b); EXD[dir * 64 + pos] = __expf(d); }
        if (!(SKIP & 64)) { float q[16], k[16], v[16];
#pragma unroll
          for (int e = 0; e < 16; ++e) { q[e] = 0.f; k[e] = 0.f; v[e] = 0.f; }
          const int ch = h * 128 + c0;
#pragma unroll
          for (int j = 0; j < ((SKIP & 1) ? 0 : 5); ++j) { const int tr = tok0 + row + j - 2;
              if (tr >= 0 && tr < SEQ) { const size_t off = (size_t)tr * HW + ch;
                  const v4u xq0 = *(const GAS v4u*)(Gq + off), xq1 = *(const GAS v4u*)(Gq + off + 8), xk0 = *(const GAS v4u*)(Gk + off), xk1 = *(const GAS v4u*)(Gk + off + 8), xv0 = *(const GAS v4u*)(Gv + off), xv1 = *(const GAS v4u*)(Gv + off + 8);
                  const unsigned wq[8] = {xq0.x, xq0.y, xq0.z, xq0.w, xq1.x, xq1.y, xq1.z, xq1.w}, wk[8] = {xk0.x, xk0.y, xk0.z, xk0.w, xk1.x, xk1.y, xk1.z, xk1.w}, wv[8] = {xv0.x, xv0.y, xv0.z, xv0.w, xv1.x, xv1.y, xv1.z, xv1.w};
                  const LAS float* cq = CWL + j * 384 + c0;
#pragma unroll
                  for (int e = 0; e < 16; ++e) { const float fq_ = (e & 1) ? bfhi(wq[e >> 1]) : bflo(wq[e >> 1]), fk_ = (e & 1) ? bfhi(wk[e >> 1]) : bflo(wk[e >> 1]), fv_ = (e & 1) ? bfhi(wv[e >> 1]) : bflo(wv[e >> 1]);
                      q[e] += cq[e] * fq_; k[e] += cq[128 + e] * fk_; v[e] += cq[256 + e] * fv_; } } }
          float sq = 0.f, sk = 0.f;
#pragma unroll
          for (int e = 0; e < 16; ++e) { q[e] = siluf_(q[e]); k[e] = siluf_(k[e]); v[e] = siluf_(v[e]); sq += q[e] * q[e]; sk += k[e] * k[e]; }
          sq += __shfl_xor(sq, 1); sq += __shfl_xor(sq, 2); sq += __shfl_xor(sq, 4); sk += __shfl_xor(sk, 1); sk += __shfl_xor(sk, 2); sk += __shfl_xor(sk, 4);
          const float rq = 0.08838834764831845f / sqrtf(sq + EPS), rk = 1.0f / sqrtf(sk + EPS);
          unsigned qo[8], ko[8];
#pragma unroll
          for (int e = 0; e < 8; ++e) { qo[e] = pk2(q[2 * e] * rq, q[2 * e + 1] * rq); ko[e] = pk2(k[2 * e] * rk, k[2 * e + 1] * rk); }
          const v4u q0 = {qo[0], qo[1], qo[2], qo[3]}, q1 = {qo[4], qo[5], qo[6], qo[7]}, k0_ = {ko[0], ko[1], ko[2], ko[3]}, k1_ = {ko[4], ko[5], ko[6], ko[7]};
          *(LAS v4u*)(QN + row * 136 + c0) = q0; *(LAS v4u*)(QN + row * 136 + c0 + 8) = q1; *(LAS v4u*)(KN + row * 136 + c0) = k0_; *(LAS v4u*)(KN + row * 136 + c0 + 8) = k1_;
          if (!(SKIP & 16)) { *(GAS v4u*)(QNg + (size_t)(tok0 + row) * HW + ch) = q0; *(GAS v4u*)(QNg + (size_t)(tok0 + row) * HW + ch + 8) = q1; }
          unsigned vo[8];
#pragma unroll
          for (int e = 0; e < 8; ++e) vo[e] = pk2(v[2 * e], v[2 * e + 1]);
          *(LAS v4u*)(VR + row * 136 + c0) = (v4u){vo[0], vo[1], vo[2], vo[3]}; *(LAS v4u*)(VR + row * 136 + c0 + 8) = (v4u){vo[4], vo[5], vo[6], vo[7]};
        }
        __syncthreads();
        { const int c = tid & 127, r0 = (tid >> 7) * 16; unsigned vw[8], kw[8];
#pragma unroll
          for (int i = 0; i < 8; ++i) { vw[i] = (unsigned)VR[(r0 + 2 * i) * 136 + c] | ((unsigned)VR[(r0 + 2 * i + 1) * 136 + c] << 16); kw[i] = (unsigned)KN[(r0 + 2 * i) * 136 + c] | ((unsigned)KN[(r0 + 2 * i + 1) * 136 + c] << 16); }
          *(LAS v4u*)(VT + c * 72 + r0) = (v4u){vw[0], vw[1], vw[2], vw[3]}; *(LAS v4u*)(VT + c * 72 + r0 + 8) = (v4u){vw[4], vw[5], vw[6], vw[7]};
          *(LAS v4u*)(KNT + c * 72 + r0) = (v4u){kw[0], kw[1], kw[2], kw[3]}; *(LAS v4u*)(KNT + c * 72 + r0 + 8) = (v4u){kw[4], kw[5], kw[6], kw[7]}; }
#pragma unroll
        for (int q2 = 0; q2 < ((SKIP & 8) ? 0 : 2); ++q2) { const int tl = 2 * w + q2, ti = tl >> 2, tj = tl & 3; f32x4 kkv = {0.f, 0.f, 0.f, 0.f}, qkv = {0.f, 0.f, 0.f, 0.f};
#pragma unroll
            for (int k0 = 0; k0 < 4; ++k0) { const bf16x8 xs = ldfrag(KN, 136, 16 * ti + fr, 32 * k0 + 8 * fq);
                kkv = mfma16(xs, ldfrag(KN, 136, 16 * tj + fr, 32 * k0 + 8 * fq), kkv); qkv = mfma16(xs, ldfrag(QN, 136, 16 * tj + fr, 32 * k0 + 8 * fq), qkv); }
            const int t = 16 * tj + fr, s0 = 16 * ti + 4 * fq;
#pragma unroll
            for (int dir = 0; dir < 2; ++dir) { const float dt = DEC[dir * 64 + t], bt = BET[dir * 64 + t]; f32x4 aq;
#pragma unroll
                for (int r = 0; r < 4; ++r) { const int s = s0 + r; const bool before = dir ? (s > t) : (s < t), beq = before || (s == t);
                    const float e = beq ? __expf(dt - DEC[dir * 64 + s]) : 0.f;
                    AM[dir * 4096 + (dir ? (63 - s) * 64 + (63 - t) : s * 64 + t)] = before ? bt * kkv[r] * e : 0.f;   aq[r] = qkv[r] * e; }
                bf16* AQg = (bf16*)(dob + (dir ? DO_AQKB : DO_AQKF));
                if (!(SKIP & 16)) *(GAS v2u*)(AQg + ((size_t)(h * 256 + oc) * 64 + t) * 64 + s0) = pack4(aq); } }
        __syncthreads();
        if (SKIP & 32) {} else if (w < 2) { const int dir = w; int c = lane; asm volatile("" : "+v"(c)); const LAS float* A = AM + dir * 4096;
            float t[64];
#pragma unroll
            for (int bi = 0; bi < 4; ++bi) { float r[16];
#pragma unroll
                for (int ii = 0; ii < 16; ++ii) r[ii] = (16 * bi + ii == c) ? 1.f : 0.f;
                if (!(SKIP & 2)) {
#pragma unroll
                for (int j0 = 0; j0 < 16 * bi; j0 += 4) { f32x4 av[4][4];
#pragma unroll
                    for (int jq = 0; jq < 4; ++jq)
#pragma unroll
                        for (int q4 = 0; q4 < 4; ++q4) av[jq][q4] = *(const LAS f32x4*)(A + (j0 + jq) * 64 + 16 * bi + 4 * q4);
                    __builtin_amdgcn_sched_barrier(0);
#pragma unroll
                    for (int jq = 0; jq < 4; ++jq)
#pragma unroll
                        for (int q4 = 0; q4 < 4; ++q4) { r[4 * q4] -= av[jq][q4][0] * t[j0 + jq]; r[4 * q4 + 1] -= av[jq][q4][1] * t[j0 + jq]; r[4 * q4 + 2] -= av[jq][q4][2] * t[j0 + jq]; r[4 * q4 + 3] -= av[jq][q4][3] * t[j0 + jq]; }
                    __builtin_amdgcn_sched_barrier(0); }
#pragma unroll
                for (int jg = 0; jg < 4; ++jg) { f32x4 av[4][4];
#pragma unroll
                    for (int jq = 0; jq < 4; ++jq)
#pragma unroll
                        for (int q4 = jg; q4 < 4; ++q4) av[jq][q4] = *(const LAS f32x4*)(A + (16 * bi + 4 * jg + jq) * 64 + 16 * bi + 4 * q4);
                    __builtin_amdgcn_sched_barrier(0);
#pragma unroll
                    for (int jq = 0; jq < 4; ++jq) { const int jj = 4 * jg + jq; t[16 * bi + jj] = r[jj];
#pragma unroll
                        for (int q4 = jg; q4 < 4; ++q4)
#pragma unroll
                            for (int e = 0; e < 4; ++e) if (4 * q4 + e > jj) r[4 * q4 + e] -= av[jq][q4][e] * r[jj]; }
                    __builtin_amdgcn_sched_barrier(0); }
                } else {
#pragma unroll
                for (int jj = 0; jj < 16; ++jj) t[16 * bi + jj] = r[jj]; }
            }
            const int tc = dir ? 63 - c : c; const float bc = BET[dir * 64 + tc], bd = bc * EXD[dir * 64 + tc];
            LAS bf16* T0 = TB + (dir * 2 + 0) * 64 * 72 + tc + (dir ? 63 * 72 : 0); const int tstep = dir ? -72 : 72;
#pragma unroll
            for (int i = 0; i < 64; ++i) { T0[i * tstep] = (bf16)f2bf(t[i] * bc); T0[64 * 72 + i * tstep] = (bf16)f2bf(t[i] * bd); }
        } else {
            for (int idx = tid - 128; idx < ((SKIP & 16) ? 0 : 1024); idx += 384) { const int r = idx >> 3, c8 = idx & 7; *(GAS v4u*)(KNTg + ((size_t)(h * 256 + oc) * 128 + r) * 64 + c8 * 8) = *(const LAS v4u*)(KNT + r * 72 + c8 * 8); }
            if (tid >= 128 && tid < 256) { const int dir = (tid - 128) >> 6, t = tid & 63; const float dl = dir ? DEC[64] : DEC[63];
                float* g = GSC + (size_t)((dir * 8 + h) * 256 + oc) * 192; g[t] = EXD[dir * 64 + t]; g[64 + t] = __expf(dl - DEC[dir * 64 + t]); if (t == 0) g[128] = __expf(dl); }
        }
        __syncthreads();
#pragma unroll 1
        for (int n = 0; n < ((SKIP & 4) ? 0 : 16); ++n) { const int qi = w * 16 + n, dir = qi >> 6, kind = (qi >> 5) & 1, idx = qi & 31; f32x4 acc = {0.f, 0.f, 0.f, 0.f};
            const LAS bf16* Tm = TB + (dir * 2 + kind) * 64 * 72; const size_t cb = (size_t)(h * 256 + oc) * 8192;
            if (kind == 0) { const int ti = idx >> 3, vj = idx & 7;
#pragma unroll
                for (int s0 = 0; s0 < 2; ++s0) acc = mfma16(ldfrag(Tm, 72, 16 * ti + fr, 32 * s0 + 8 * fq), ldfrag(VT, 72, 16 * vj + fr, 32 * s0 + 8 * fq), acc);
                bf16* U = (bf16*)(F.ws + (dir ? WS_UTB : WS_UTF)); if (!(SKIP & 16)) *(GAS v2u*)(U + cb + (16 * vj + fr) * 64 + 16 * ti + 4 * fq) = pack4(acc);
            } else { const int ki = idx >> 2, tj = idx & 3;
#pragma unroll
                for (int s0 = 0; s0 < 2; ++s0) acc = mfma16(ldfrag(KNT, 72, 16 * ki + fr, 32 * s0 + 8 * fq), ldfrag(Tm, 72, 16 * tj + fr, 32 * s0 + 8 * fq), acc);
                bf16* W = (bf16*)(F.ws + (dir ? WS_WB : WS_WF)); if (!(SKIP & 16)) *(GAS v2u*)(W + cb + (16 * tj + fr) * 128 + 16 * ki + 4 * fq) = pack4(acc); }
        }
    }
}
__device__ __forceinline__ void gdn_load_tiles(const unsigned char* ws, const unsigned char* dob, int tid, int dir, int hd, int h, int oc, bool pass3, v4u (&rw)[2], v4u (&rq)[2], v4u (&ru)[2], v4u (&rk)[2], v4u& ra, float& rs) {
    const size_t cb = (size_t)(h * 256 + oc);
    const int row = tid >> 3, c0 = (tid & 7) * 16, vrow = tid >> 2, t0 = (tid & 3) * 16;
    const bf16* W = (const bf16*)(ws + (dir ? WS_WB : WS_WF)) + cb * 8192 + row * 128 + c0; rw[0] = *(const GAS v4u*)W; rw[1] = *(const GAS v4u*)(W + 8);
    const bf16* U = (const bf16*)(ws + (dir ? WS_UTB : WS_UTF)) + cb * 8192 + vrow * 64 + t0; ru[0] = *(const GAS v4u*)U; ru[1] = *(const GAS v4u*)(U + 8);
    const bf16* Kt = (const bf16*)(dob + DO_KNT) + (size_t)(h * 256 + oc) * 8192 + vrow * 64 + t0; rk[0] = *(const GAS v4u*)Kt; rk[1] = *(const GAS v4u*)(Kt + 8);
    if (pass3) {
        const bf16* Q = (const bf16*)(dob + DO_QN) + (size_t)(64 * oc + row) * HW + h * 128 + c0; rq[0] = *(const GAS v4u*)Q; rq[1] = *(const GAS v4u*)(Q + 8);
        const bf16* A = (const bf16*)(dob + (dir ? DO_AQKB : DO_AQKF)) + cb * 4096 + row * 64 + (tid & 7) * 8; ra = *(const GAS v4u*)A;
    }
    rs = (tid < 192) ? ((const float*)(ws + WS_GSC))[(size_t)(hd * 256 + oc) * 192 + tid] : 0.f;
}
#define SCHED_FENCE() __builtin_amdgcn_sched_barrier(0)
template <bool PASS3, bool UREAL>
__device__ __forceinline__ void gdn_tile(f32x4 (&A)[8], const LAS bf16* WTL, const LAS bf16* QNL, const LAS bf16* UTL, const LAS bf16* KTL, const LAS bf16* AQL, const LAS float* SCL,
                                         LAS bf16* ST, LAS bf16* VN, LAS bf16* VNS, int w, int fr, int fq, float gl, bf16* Ogc) {
#pragma unroll
    for (int kt = 0; kt < 8; ++kt) *(LAS v2u*)(ST + fr * 136 + 16 * kt + 4 * fq) = pack4(A[kt]);
    asm volatile("" ::: "memory");
    bf16x8 xs[4];
#pragma unroll
    for (int k0 = 0; k0 < 4; ++k0) xs[k0] = ldfrag(ST, 136, fr, 32 * k0 + 8 * fq);
#pragma unroll
    for (int th = 0; th < 2; ++th) { bf16x8 wf[2][4]; f32x4 acc[2]; v2u uw[2]; f32x4 es[2];
#pragma unroll
      for (int tq = 0; tq < 2; ++tq) { const int tt = 2 * th + tq;
#pragma unroll
          for (int k0 = 0; k0 < 4; ++k0) wf[tq][k0] = ldfrag(WTL, 136, 16 * tt + fr, 32 * k0 + 8 * fq);
          if (UREAL) uw[tq] = *(const LAS v2u*)(UTL + (16 * w + fr) * 72 + 16 * tt + 4 * fq);
          es[tq] = *(const LAS f32x4*)(SCL + 64 + 16 * tt + 4 * fq); acc[tq] = (f32x4){0.f, 0.f, 0.f, 0.f}; }
      SCHED_FENCE();
#pragma unroll
      for (int k0 = 0; k0 < 4; ++k0)
#pragma unroll
          for (int tq = 0; tq < 2; ++tq) acc[tq] = mfma16(wf[tq][k0], xs[k0], acc[tq]);
      SCHED_FENCE();
#pragma unroll
      for (int tq = 0; tq < 2; ++tq) { const int tt = 2 * th + tq; f32x4 u4 = {0.f, 0.f, 0.f, 0.f};
          if (UREAL) u4 = (f32x4){bflo(uw[tq].x), bfhi(uw[tq].x), bflo(uw[tq].y), bfhi(uw[tq].y)};
          const f32x4 vn = u4 - acc[tq];
          if (PASS3) *(LAS v2u*)(VN + fr * 72 + 16 * tt + 4 * fq) = pack4(vn);
          *(LAS v2u*)(VNS + fr * 72 + 16 * tt + 4 * fq) = pack4(vn * es[tq]); }
      SCHED_FENCE(); }
    asm volatile("" ::: "memory");
    if (PASS3) { bf16x8 yv[2];
#pragma unroll
        for (int s0 = 0; s0 < 2; ++s0) yv[s0] = ldfrag(VN, 72, fr, 32 * s0 + 8 * fq);
#pragma unroll
        for (int th = 0; th < 2; ++th) { bf16x8 qf[2][4], af[2][2]; f32x4 acc[2]; float ed[2];
#pragma unroll
            for (int tq = 0; tq < 2; ++tq) { const int tt = 2 * th + tq;
#pragma unroll
                for (int k0 = 0; k0 < 4; ++k0) qf[tq][k0] = ldfrag(QNL, 136, 16 * tt + fr, 32 * k0 + 8 * fq);
#pragma unroll
                for (int s0 = 0; s0 < 2; ++s0) af[tq][s0] = ldfrag(AQL, 72, 16 * tt + fr, 32 * s0 + 8 * fq);
                ed[tq] = SCL[16 * tt + fr]; acc[tq] = (f32x4){0.f, 0.f, 0.f, 0.f}; }
            SCHED_FENCE();
#pragma unroll
            for (int k0 = 0; k0 < 4; ++k0)
#pragma unroll
                for (int tq = 0; tq < 2; ++tq) acc[tq] = mfma16(xs[k0], qf[tq][k0], acc[tq]);
#pragma unroll
            for (int tq = 0; tq < 2; ++tq) acc[tq] = acc[tq] * ed[tq];
#pragma unroll
            for (int s0 = 0; s0 < 2; ++s0)
#pragma unroll
                for (int tq = 0; tq < 2; ++tq) acc[tq] = mfma16(yv[s0], af[tq][s0], acc[tq]);
            SCHED_FENCE();
#pragma unroll
            for (int tq = 0; tq < 2; ++tq) *(GAS v2u*)(Ogc + (size_t)(16 * (2 * th + tq) + fr) * HW + 16 * w + 4 * fq) = pack4(acc[tq]);
            SCHED_FENCE(); } }
    { bf16x8 ys[2];
#pragma unroll
      for (int s0 = 0; s0 < 2; ++s0) ys[s0] = ldfrag(VNS, 72, fr, 32 * s0 + 8 * fq);
#pragma unroll
      for (int kh = 0; kh < 2; ++kh) { bf16x8 kf[4][2];
#pragma unroll
          for (int kq = 0; kq < 4; ++kq)
#pragma unroll
              for (int s0 = 0; s0 < 2; ++s0) kf[kq][s0] = ldfrag(KTL, 72, 16 * (4 * kh + kq) + fr, 32 * s0 + 8 * fq);
#pragma unroll
          for (int kq = 0; kq < 4; ++kq) A[4 * kh + kq] = A[4 * kh + kq] * gl;
          SCHED_FENCE();
#pragma unroll
          for (int s0 = 0; s0 < 2; ++s0)
#pragma unroll
              for (int kq = 0; kq < 4; ++kq) A[4 * kh + kq] = mfma16(kf[kq][s0], ys[s0], A[4 * kh + kq]);
          SCHED_FENCE(); } }
}
template <bool PASS3, int SKIP = 0>
__device__ __forceinline__ void gdn_pass(Frame& F) {
    LAS bf16*  WTL = (LAS bf16*)(F.lds + 0);
    LAS bf16*  QNL = (LAS bf16*)(F.lds + 17408);
    LAS bf16*  UTL = (LAS bf16*)(F.lds + 34816);
    LAS bf16*  KTL = (LAS bf16*)(F.lds + 53248);
    LAS bf16*  AQL = (LAS bf16*)(F.lds + 71680);
    LAS float* SCL = (LAS float*)(F.lds + 80896);
    LAS bf16*  PX  = (LAS bf16*)(F.lds + 0);
    const int tid = F.tid, lane = F.lane, w = F.wave, fr = lane & 15, fq = lane >> 4;
    LAS bf16* ST  = (LAS bf16*)(F.lds + 81920 + w * 8960);
    LAS bf16* VN  = ST + 16 * 136;
    LAS bf16* VNS = VN + 16 * 72;
    const int row = tid >> 3, c0 = (tid & 7) * 16, vrow = tid >> 2, t0 = (tid & 3) * 16;
    const unsigned char* dob = (const unsigned char*)F.out;
    float* GL = (float*)(F.ws + WS_GL); bf16* GP = (bf16*)(F.ws + WS_GP);
    for (int it = blockIdx.x; it < 256; it += F.G) {
        const int hd = it >> 4, sg = it & 15, dir = hd >> 3, h = hd & 7;
        bf16* Og = (bf16*)(F.ws + (dir ? WS_OGB : WS_OGF));
        f32x4 Sacc[8], Pacc[8];
        int dgi = 16 * w + fr - 4 * fq; asm volatile("" : "+v"(dgi));
#pragma unroll
        for (int kt = 0; kt < 8; ++kt) { Sacc[kt] = (f32x4){0.f, 0.f, 0.f, 0.f};
#pragma unroll
            for (int r = 0; r < 4; ++r) Pacc[kt][r] = (!PASS3 && (16 * kt + r == dgi)) ? 1.f : 0.f; }
        __syncthreads();
        if (PASS3) {
            for (int p = 0; p < sg; ++p) { const int ip = hd * 16 + p;
                { const bf16* src = GP + (size_t)ip * 16384 + vrow * 128 + (tid & 3) * 32;
#pragma unroll
                  for (int q = 0; q < 4; ++q) *(LAS v4u*)(PX + vrow * 136 + (tid & 3) * 32 + 8 * q) = *(const GAS v4u*)(src + 8 * q); }
#pragma unroll
                for (int kt = 0; kt < 8; ++kt) *(LAS v2u*)(ST + fr * 136 + 16 * kt + 4 * fq) = pack4(Sacc[kt]);
                __syncthreads();
                bf16x8 xs[4];
#pragma unroll
                for (int k0 = 0; k0 < 4; ++k0) xs[k0] = ldfrag(ST, 136, fr, 32 * k0 + 8 * fq);
#pragma unroll
                for (int kh = 0; kh < 2; ++kh) { bf16x8 pf[4][4]; f32x4 acc[4];
#pragma unroll
                    for (int kq = 0; kq < 4; ++kq) { const int kt = 4 * kh + kq; acc[kq] = *(const GAS f32x4*)(GL + ((size_t)((ip * 8 + w) * 8 + kt) * 64 + lane) * 4);
#pragma unroll
                        for (int k0 = 0; k0 < 4; ++k0) pf[kq][k0] = ldfrag(PX, 136, 16 * kt + fr, 32 * k0 + 8 * fq); }
                    SCHED_FENCE();
#pragma unroll
                    for (int k0 = 0; k0 < 4; ++k0)
#pragma unroll
                        for (int kq = 0; kq < 4; ++kq) acc[kq] = mfma16(pf[kq][k0], xs[k0], acc[kq]);
                    SCHED_FENCE();
#pragma unroll
                    for (int kq = 0; kq < 4; ++kq) Sacc[4 * kh + kq] = acc[kq]; }
                __syncthreads();
            }
        }
        v4u rw[2], rq[2], ru[2], rk[2], ra; float rs;
        gdn_load_tiles(F.ws, dob, tid, dir, hd, h, dir ? 255 - sg * 16 : sg * 16, PASS3, rw, rq, ru, rk, ra, rs);
        for (int ci = 0; ci < CPS; ++ci) {
            const int sc = sg * 16 + ci, oc = dir ? 255 - sc : sc, tok0 = 64 * oc;
            *(LAS v4u*)(WTL + row * 136 + c0) = rw[0]; *(LAS v4u*)(WTL + row * 136 + c0 + 8) = rw[1];
            *(LAS v4u*)(UTL + vrow * 72 + t0) = ru[0]; *(LAS v4u*)(UTL + vrow * 72 + t0 + 8) = ru[1];
            *(LAS v4u*)(KTL + vrow * 72 + t0) = rk[0]; *(LAS v4u*)(KTL + vrow * 72 + t0 + 8) = rk[1];
            if (PASS3) { *(LAS v4u*)(QNL + row * 136 + c0) = rq[0]; *(LAS v4u*)(QNL + row * 136 + c0 + 8) = rq[1]; *(LAS v4u*)(AQL + row * 72 + (tid & 7) * 8) = ra; }
            if (tid < 192) SCL[tid] = rs;
            __syncthreads();
            if (ci + 1 < CPS && !(SKIP & 1)) gdn_load_tiles(F.ws, dob, tid, dir, hd, h, dir ? oc - 1 : oc + 1, PASS3, rw, rq, ru, rk, ra, rs);
            const float gl = SCL[128];
            gdn_tile<PASS3, true>(Sacc, WTL, QNL, UTL, KTL, AQL, SCL, ST, VN, VNS, w, fr, fq, gl, Og + (size_t)tok0 * HW + h * 128);
            if (!PASS3) gdn_tile<PASS3, false>(Pacc, WTL, QNL, UTL, KTL, AQL, SCL, ST, VN, VNS, w, fr, fq, gl, Og);
            __syncthreads();
        }
        if (!PASS3) {
            int pofs = (4 * fq) * 128 + 16 * w + fr; asm volatile("" : "+v"(pofs));
            bf16* gp = GP + (size_t)it * 16384 + pofs;
#pragma unroll
            for (int kt = 0; kt < 8; ++kt) { *(GAS f32x4*)(GL + ((size_t)((it * 8 + w) * 8 + kt) * 64 + lane) * 4) = Sacc[kt];
#pragma unroll
                for (int r = 0; r < 4; ++r) gp[(16 * kt + r) * 128] = (bf16)f2bf(Pacc[kt][r]); }
        }
    }
}
__device__ __forceinline__ void p7_mix(Frame& F) {
    const int gw = F.vcu * NWAVES + F.wave, NGW = F.G * NWAVES, lane = F.lane;
    const int e0 = (lane & 7) * 16, col = (lane >> 3) * 128 + e0;
    for (int m = gw; m < SEQ; m += NGW) {
#pragma unroll
        for (int mx = 0; mx < 2; ++mx) {
            const bf16* of = (const bf16*)(F.ws + (mx ? WS_OGF : WS_OHF)); const bf16* ob = (const bf16*)(F.ws + (mx ? WS_OGB : WS_OHB));
            const bf16* gt = (const bf16*)(F.ws + WS_H + (size_t)(mx ? 8 : 4) * 32 * MiB); const float* nw = F.in[mx ? I_GNW : I_HNW];
            bf16* yo = (bf16*)(F.ws + (mx ? WS_YB : WS_YA));
            const size_t off = (size_t)m * HW + col;
            const v4u a0 = *(const GAS v4u*)(of + off), a1 = *(const GAS v4u*)(of + off + 8), b0 = *(const GAS v4u*)(ob + off), b1 = *(const GAS v4u*)(ob + off + 8), g0 = *(const GAS v4u*)(gt + off), g1 = *(const GAS v4u*)(gt + off + 8);
            const unsigned aw[8] = {a0.x, a0.y, a0.z, a0.w, a1.x, a1.y, a1.z, a1.w}, bw[8] = {b0.x, b0.y, b0.z, b0.w, b1.x, b1.y, b1.z, b1.w}, gw_[8] = {g0.x, g0.y, g0.z, g0.w, g1.x, g1.y, g1.z, g1.w};
            float o[16]; float ss = 0.f;
#pragma unroll
            for (int e = 0; e < 8; ++e) { o[2 * e] = bflo(aw[e]) + bflo(bw[e]); o[2 * e + 1] = bfhi(aw[e]) + bfhi(bw[e]); ss += o[2 * e] * o[2 * e] + o[2 * e + 1] * o[2 * e + 1]; }
            ss += __shfl_xor(ss, 1); ss += __shfl_xor(ss, 2); ss += __shfl_xor(ss, 4);
            const float r = 1.0f / sqrtf(ss * (1.f / 128.f) + EPS);
            if (QM_MIX == 2) { float yv[16]; float am = 0.f;
#pragma unroll
                for (int e = 0; e < 8; ++e) { yv[2 * e] = o[2 * e] * r * nw[e0 + 2 * e] * bflo(gw_[e]); yv[2 * e + 1] = o[2 * e + 1] * r * nw[e0 + 2 * e + 1] * bfhi(gw_[e]); am = fmaxf(am, fmaxf(fabsf(yv[2 * e]), fabsf(yv[2 * e + 1]))); }
                am = wave_max(am); const float inv = am > 0.f ? 127.0f / am : 0.f;
                *(GAS v4u*)((unsigned char*)yo + off) = (v4u){pk4i8((f32x4){yv[0], yv[1], yv[2], yv[3]}, inv), pk4i8((f32x4){yv[4], yv[5], yv[6], yv[7]}, inv), pk4i8((f32x4){yv[8], yv[9], yv[10], yv[11]}, inv), pk4i8((f32x4){yv[12], yv[13], yv[14], yv[15]}, inv)};
                if (lane == 0) ((float*)(F.ws + WS_QX))[(1 + mx) * SEQ + m] = am > 0.f ? am * (1.0f / 127.0f) : 1.0f; }
            else if (QM_MIX == 1) { unsigned yq[4];
#pragma unroll
                for (int e = 0; e < 4; ++e) yq[e] = pk4f8(o[4 * e] * r * nw[e0 + 4 * e] * bflo(gw_[2 * e]), o[4 * e + 1] * r * nw[e0 + 4 * e + 1] * bfhi(gw_[2 * e]), o[4 * e + 2] * r * nw[e0 + 4 * e + 2] * bflo(gw_[2 * e + 1]), o[4 * e + 3] * r * nw[e0 + 4 * e + 3] * bfhi(gw_[2 * e + 1]));
                *(GAS v4u*)((unsigned char*)yo + off) = (v4u){yq[0], yq[1], yq[2], yq[3]}; }
            else { unsigned yw[8];
#pragma unroll
            for (int e = 0; e < 8; ++e) yw[e] = pk2(o[2 * e] * r * nw[e0 + 2 * e] * bflo(gw_[e]), o[2 * e + 1] * r * nw[e0 + 2 * e + 1] * bfhi(gw_[e]));
            *(GAS v4u*)(yo + off) = (v4u){yw[0], yw[1], yw[2], yw[3]}; *(GAS v4u*)(yo + off + 8) = (v4u){yw[4], yw[5], yw[6], yw[7]}; }
        }
    }
    for (int tb = 0; tb < 2; ++tb) { const float* src = F.in[tb ? I_PV : I_PU]; unsigned char* dst = F.ws + (tb ? WS_TV : WS_TU); float* scl = (float*)(F.ws + WS_PSC) + tb * 16384;
        for (int r = gw; r < 16384; r += NGW) { const float* row = src + (size_t)r * DM; f32x4 v[8]; float mx = 0.f;
#pragma unroll
            for (int q = 0; q < 8; ++q) { v[q] = *(const GAS f32x4*)(row + (tb ? (q >> 2) * 1024 + lane * 16 + 4 * (q & 3) : lane * 32 + 4 * q)); const f32x4 a = __builtin_elementwise_abs(v[q]); mx = fmaxf(mx, fmaxf(fmaxf(a.x, a.y), fmaxf(a.z, a.w))); }
            mx = wave_max(mx);
            const float sc = mx > 0.f ? mx * (tb ? (VFMT == 6 ? 1.0f / 7.5f : 1.0f / 256.0f) : 1.0f / 127.0f) : 1.0f, inv = 1.0f / sc;
            if (tb && VFMT == 6) { v16f a16, b16;
#pragma unroll
                for (int q = 0; q < 4; ++q) { a16[4 * q] = v[q].x * inv; a16[4 * q + 1] = v[q].y * inv; a16[4 * q + 2] = v[q].z * inv; a16[4 * q + 3] = v[q].w * inv;
                    b16[4 * q] = v[4 + q].x * inv; b16[4 * q + 1] = v[4 + q].y * inv; b16[4 * q + 2] = v[4 + q].z * inv; b16[4 * q + 3] = v[4 + q].w * inv; }
                const v6u pk = __builtin_amdgcn_cvt_scalef32_2xpk16_fp6_f32(a16, b16, 1.0f);
                *(GAS v4u*)(dst + (size_t)r * TV_PITCH + lane * 16) = (v4u){pk[0], pk[1], pk[2], pk[3]}; *(GAS v2u*)(dst + (size_t)r * TV_PITCH + 1024 + lane * 8) = (v2u){pk[4], pk[5]};
                if (lane == 0) scl[r] = sc;
                continue; }
            unsigned w[8];
#pragma unroll
            for (int q = 0; q < 8; ++q) { const f32x4 x = v[q];
                if (tb) w[q] = pk4f8(x.x * inv, x.y * inv, x.z * inv, x.w * inv);
                else { const int a = (int)rintf(x.x * inv), b = (int)rintf(x.y * inv), c = (int)rintf(x.z * inv), d = (int)rintf(x.w * inv);
                    w[q] = (unsigned)(a & 255) | ((unsigned)(b & 255) << 8) | ((unsigned)(c & 255) << 16) | ((unsigned)(d & 255) << 24); } }
            if (tb) { *(GAS v4u*)(dst + (size_t)r * DM + lane * 16) = (v4u){w[0], w[1], w[2], w[3]}; *(GAS v4u*)(dst + (size_t)r * DM + 1024 + lane * 16) = (v4u){w[4], w[5], w[6], w[7]}; }
            else { GAS v4u* o = (GAS v4u*)(dst + ((size_t)lane * 16384 + r) * 32); o[0] = (v4u){w[0], w[1], w[2], w[3]}; o[1] = (v4u){w[4], w[5], w[6], w[7]}; }
            if (lane == 0) scl[r] = sc; } }
}
constexpr size_t WS_XQ = 80 * MiB;
constexpr size_t WS_SXR = 112 * MiB;
constexpr size_t WS_EID = 113 * MiB, WS_GATE = 121 * MiB, WS_AV = 129 * MiB;
constexpr size_t WS_REC = 208 * MiB;
constexpr int NET = 32, ETSZ = 512, NBUCK = 16 * NET, REC_CAP = 16384, CW_CNT = 8192, CW_Q = 8192 + 16 * NBUCK;
__device__ __forceinline__ unsigned fkey(float f) { const unsigned u = __builtin_bit_cast(unsigned, f); return (u & 0x80000000u) ? ~u : (u | 0x80000000u); }
__device__ __forceinline__ float gelu_erf(float x) { return 0.5f * x * (1.0f + erff(x * 0.70710678118654752f)); }

__device__ __forceinline__ float key_val(unsigned k, unsigned mask) { unsigned u = k & ~mask; u = (u & 0x80000000u) ? (u & 0x7fffffffu) : ~u; return __builtin_bit_cast(float, u); }
#define SN_CE(x, y) do { const unsigned sn_h = (x) > (y) ? (x) : (y); (y) = (x) > (y) ? (y) : (x); (x) = sn_h; } while (0)
#define SN_SORT16(k) do { SN_CE(k[0], k[1]); SN_CE(k[2], k[3]); SN_CE(k[0], k[2]); SN_CE(k[1], k[3]); SN_CE(k[1], k[2]); SN_CE(k[4], k[5]); SN_CE(k[6], k[7]); SN_CE(k[4], k[6]); SN_CE(k[5], k[7]); SN_CE(k[5], k[6]); SN_CE(k[0], k[4]); SN_CE(k[2], k[6]); SN_CE(k[2], k[4]); SN_CE(k[1], k[5]); SN_CE(k[3], k[7]); SN_CE(k[3], k[5]); SN_CE(k[1], k[2]); SN_CE(k[3], k[4]); SN_CE(k[5], k[6]); SN_CE(k[8], k[9]); SN_CE(k[10], k[11]); SN_CE(k[8], k[10]); SN_CE(k[9], k[11]); SN_CE(k[9], k[10]); SN_CE(k[12], k[13]); SN_CE(k[14], k[15]); SN_CE(k[12], k[14]); SN_CE(k[13], k[15]); SN_CE(k[13], k[14]); SN_CE(k[8], k[12]); SN_CE(k[10], k[14]); SN_CE(k[10], k[12]); SN_CE(k[9], k[13]); SN_CE(k[11], k[15]); SN_CE(k[11], k[13]); SN_CE(k[9], k[10]); SN_CE(k[11], k[12]); SN_CE(k[13], k[14]); SN_CE(k[0], k[8]); SN_CE(k[4], k[12]); SN_CE(k[4], k[8]); SN_CE(k[2], k[10]); SN_CE(k[6], k[14]); SN_CE(k[6], k[10]); SN_CE(k[2], k[4]); SN_CE(k[6], k[8]); SN_CE(k[10], k[12]); SN_CE(k[1], k[9]); SN_CE(k[5], k[13]); SN_CE(k[5], k[9]); SN_CE(k[3], k[11]); SN_CE(k[7], k[15]); SN_CE(k[7], k[11]); SN_CE(k[3], k[5]); SN_CE(k[7], k[9]); SN_CE(k[11], k[13]); SN_CE(k[1], k[2]); SN_CE(k[3], k[4]); SN_CE(k[5], k[6]); SN_CE(k[7], k[8]); SN_CE(k[9], k[10]); SN_CE(k[11], k[12]); SN_CE(k[13], k[14]); } while (0)
#define SN_MERGE16(t, k) do { t[0] = t[0] > k[15] ? t[0] : k[15]; t[1] = t[1] > k[14] ? t[1] : k[14]; t[2] = t[2] > k[13] ? t[2] : k[13]; t[3] = t[3] > k[12] ? t[3] : k[12]; t[4] = t[4] > k[11] ? t[4] : k[11]; t[5] = t[5] > k[10] ? t[5] : k[10]; t[6] = t[6] > k[9] ? t[6] : k[9]; t[7] = t[7] > k[8] ? t[7] : k[8]; t[8] = t[8] > k[7] ? t[8] : k[7]; t[9] = t[9] > k[6] ? t[9] : k[6]; t[10] = t[10] > k[5] ? t[10] : k[5]; t[11] = t[11] > k[4] ? t[11] : k[4]; t[12] = t[12] > k[3] ? t[12] : k[3]; t[13] = t[13] > k[2] ? t[13] : k[2]; t[14] = t[14] > k[1] ? t[14] : k[1]; t[15] = t[15] > k[0] ? t[15] : k[0]; SN_CE(t[0], t[8]); SN_CE(t[1], t[9]); SN_CE(t[2], t[10]); SN_CE(t[3], t[11]); SN_CE(t[4], t[12]); SN_CE(t[5], t[13]); SN_CE(t[6], t[14]); SN_CE(t[7], t[15]); SN_CE(t[0], t[4]); SN_CE(t[1], t[5]); SN_CE(t[2], t[6]); SN_CE(t[3], t[7]); SN_CE(t[8], t[12]); SN_CE(t[9], t[13]); SN_CE(t[10], t[14]); SN_CE(t[11], t[15]); SN_CE(t[0], t[2]); SN_CE(t[1], t[3]); SN_CE(t[4], t[6]); SN_CE(t[5], t[7]); SN_CE(t[8], t[10]); SN_CE(t[9], t[11]); SN_CE(t[12], t[14]); SN_CE(t[13], t[15]); SN_CE(t[0], t[1]); SN_CE(t[2], t[3]); SN_CE(t[4], t[5]); SN_CE(t[6], t[7]); SN_CE(t[8], t[9]); SN_CE(t[10], t[11]); SN_CE(t[12], t[13]); SN_CE(t[14], t[15]); } while (0)
#define SN_CAND(i, j) ((fkey(f1[i] + f2[j]) & ~255u) | (unsigned)((i) * 16 + (j)))
#define SN_STAGE2(c, k) do { k[0] = SN_CAND(0, 0); k[1] = SN_CAND(0, 1); k[2] = SN_CAND(0, 2); k[3] = SN_CAND(0, 3); k[4] = SN_CAND(0, 4); k[5] = SN_CAND(0, 5); k[6] = SN_CAND(0, 6); k[7] = SN_CAND(0, 7); k[8] = SN_CAND(0, 8); k[9] = SN_CAND(0, 9); k[10] = SN_CAND(0, 10); k[11] = SN_CAND(0, 11); k[12] = SN_CAND(0, 12); k[13] = SN_CAND(0, 13); k[14] = SN_CAND(0, 14); k[15] = SN_CAND(0, 15); SN_SORT16(k); c[0] = k[0]; c[1] = k[1]; c[2] = k[2]; c[3] = k[3]; c[4] = k[4]; c[5] = k[5]; c[6] = k[6]; c[7] = k[7]; c[8] = k[8]; c[9] = k[9]; c[10] = k[10]; c[11] = k[11]; c[12] = k[12]; c[13] = k[13]; c[14] = k[14]; c[15] = k[15]; k[0] = SN_CAND(1, 0); k[1] = SN_CAND(1, 1); k[2] = SN_CAND(1, 2); k[3] = SN_CAND(1, 3); k[4] = SN_CAND(1, 4); k[5] = SN_CAND(1, 5); k[6] = SN_CAND(1, 6); k[7] = SN_CAND(1, 7); k[8] = SN_CAND(2, 0); k[9] = SN_CAND(2, 1); k[10] = SN_CAND(2, 2); k[11] = SN_CAND(2, 3); k[12] = SN_CAND(2, 4); k[13] = SN_CAND(3, 0); k[14] = SN_CAND(3, 1); k[15] = SN_CAND(3, 2); SN_SORT16(k); SN_MERGE16(c, k); k[0] = SN_CAND(3, 3); k[1] = SN_CAND(4, 0); k[2] = SN_CAND(4, 1); k[3] = SN_CAND(4, 2); k[4] = SN_CAND(5, 0); k[5] = SN_CAND(5, 1); k[6] = SN_CAND(6, 0); k[7] = SN_CAND(6, 1); k[8] = SN_CAND(7, 0); k[9] = SN_CAND(7, 1); k[10] = SN_CAND(8, 0); k[11] = SN_CAND(9, 0); k[12] = SN_CAND(10, 0); k[13] = SN_CAND(11, 0); k[14] = SN_CAND(12, 0); k[15] = SN_CAND(13, 0); SN_SORT16(k); SN_MERGE16(c, k); { unsigned x = SN_CAND(14, 0); _Pragma("unroll") for (int r = 0; r < 16; ++r) { const unsigned hi = c[r] > x ? c[r] : x; x = c[r] > x ? x : c[r]; c[r] = hi; } } { unsigned x = SN_CAND(15, 0); _Pragma("unroll") for (int r = 0; r < 16; ++r) { const unsigned hi = c[r] > x ? c[r] : x; x = c[r] > x ? x : c[r]; c[r] = hi; } } } while (0)
template <int SKIP>
__device__ __forceinline__ void p11a_topk(Frame& F) {
    LAS float* SCR = (LAS float*)(F.lds + F.wave * 16384);
    LAS unsigned* SL = (LAS unsigned*)SCR;
    LAS int* EIDS = (LAS int*)(SCR + 1024);
    LAS int* OFFS = (LAS int*)(SCR + 2048);
    LAS float* RTS = SCR + 2304;
    LAS int* BC = (LAS int*)(F.lds + 8 * 16384);
    const bf16* SC = (const bf16*)(F.ws + WS_SC);
    unsigned char* XQ = F.ws + WS_XQ; float* SXR = (float*)(F.ws + WS_SXR); int* EIDg = (int*)(F.ws + WS_EID); float* GATEg = (float*)(F.ws + WS_GATE); unsigned* REC = (unsigned*)(F.ws + WS_REC);
    for (int blk = F.vcu; blk < SEQ / 64; blk += F.G) {
        __syncthreads();
        if (F.tid < NET) BC[F.tid] = 0;
        __syncthreads();
        const int m0 = blk * 64 + F.wave * 8;
#pragma unroll 2
        for (int ti = 0; ti < 8; ++ti) { const int m = m0 + ti;
            int lane = F.lane; asm volatile("" : "+v"(lane));
            float xh[32]; float ss = 0.f;
            const bf16* x1 = (const bf16*)(F.ws + WS_X1B) + (size_t)m * DM + lane * 32; const float* n2 = F.in[I_N2W] + lane * 32;
            f32x4 nwv[8];
#pragma unroll
            for (int q = 0; q < 8; ++q) { const v2u a = *(const GAS v2u*)(x1 + 4 * q); nwv[q] = *(const GAS f32x4*)(n2 + 4 * q); xh[4 * q] = bflo(a.x); xh[4 * q + 1] = bfhi(a.x); xh[4 * q + 2] = bflo(a.y); xh[4 * q + 3] = bfhi(a.y); }
#pragma unroll
            for (int e = 0; e < 32; ++e) ss += xh[e] * xh[e];
            const float rt = 1.0f / sqrtf(wave_sum(ss) * (1.f / DM) + EPS);
            float amx = 0.f;
#pragma unroll
            for (int q = 0; q < 8; ++q) { const f32x4 a = nwv[q]; xh[4 * q] *= rt * a.x; xh[4 * q + 1] *= rt * a.y; xh[4 * q + 2] *= rt * a.z; xh[4 * q + 3] *= rt * a.w; }
#pragma unroll
            for (int e = 0; e < 32; ++e) amx = fmaxf(amx, fabsf(xh[e]));
            amx = wave_max(amx);
            const float sx = amx > 0.f ? amx * (1.0f / 127.0f) : 1.0f, isx = 1.0f / sx;
            unsigned xq[8];
#pragma unroll
            for (int d = 0; d < 8; ++d) { const int a = (int)rintf(xh[4 * d] * isx), b = (int)rintf(xh[4 * d + 1] * isx), c = (int)rintf(xh[4 * d + 2] * isx), e = (int)rintf(xh[4 * d + 3] * isx);
                xq[d] = (unsigned)(a & 255) | ((unsigned)(b & 255) << 8) | ((unsigned)(c & 255) << 16) | ((unsigned)(e & 255) << 24); }
            if (!(SKIP & 2)) { GAS v4u* o = (GAS v4u*)(XQ + ((size_t)lane * SEQ + m) * 32); o[0] = (v4u){xq[0], xq[1], xq[2], xq[3]}; o[1] = (v4u){xq[4], xq[5], xq[6], xq[7]}; }
            if (lane == 0) { SXR[2 * m] = sx; SXR[2 * m + 1] = rt; RTS[ti] = rt; }
        }
#pragma unroll 1
        for (int grp = 0; grp < 2; ++grp) {
            int lane = F.lane; asm volatile("" : "+v"(lane));
            if (!(SKIP & 1)) {
                { const bf16* src = SC + (size_t)(m0 + grp * 4 + (lane >> 4)) * DM + (lane & 15) * 128;
                  unsigned v[16];
#pragma unroll
                  for (int i = 0; i < 16; ++i) v[i] = 0u;
#pragma unroll 1
                  for (int s8 = 0; s8 < 2; ++s8) { v4u a8[8];
#pragma unroll
                      for (int u = 0; u < 8; ++u) a8[u] = *(const GAS v4u*)(src + 64 * s8 + 8 * u);
#pragma unroll
                      for (int u2 = 0; u2 < 4; ++u2) { unsigned k[16];
#pragma unroll
                          for (int h = 0; h < 2; ++h) { const unsigned wv[4] = {a8[2 * u2 + h].x, a8[2 * u2 + h].y, a8[2 * u2 + h].z, a8[2 * u2 + h].w};
#pragma unroll
                              for (int e = 0; e < 8; ++e) { const float sv = (e & 1) ? bfhi(wv[e >> 1]) : bflo(wv[e >> 1]); k[8 * h + e] = (fkey(sv) & ~127u) | (unsigned)(64 * s8 + 16 * u2 + 8 * h + e); } }
                          SN_SORT16(k); SN_MERGE16(v, k); } }
#pragma unroll
                  for (int q = 0; q < 4; ++q) *(LAS v4u*)(SL + lane * 16 + 4 * q) = (v4u){v[4 * q], v[4 * q + 1], v[4 * q + 2], v[4 * q + 3]}; }
                asm volatile("" ::: "memory");
                if (lane < 32) { const int tk = lane >> 3, h = lane & 7, m = m0 + grp * 4 + tk;
                    const LAS unsigned* L1 = SL + (tk * 16 + 2 * h) * 16; const LAS unsigned* L2 = L1 + 16;
                    float f1[16], f2[16];
#pragma unroll
                    for (int q = 0; q < 4; ++q) { const v4u a = *(const LAS v4u*)(L1 + 4 * q), b = *(const LAS v4u*)(L2 + 4 * q);
                        f1[4 * q] = key_val(a.x, 127u); f1[4 * q + 1] = key_val(a.y, 127u); f1[4 * q + 2] = key_val(a.z, 127u); f1[4 * q + 3] = key_val(a.w, 127u);
                        f2[4 * q] = key_val(b.x, 127u); f2[4 * q + 1] = key_val(b.y, 127u); f2[4 * q + 2] = key_val(b.z, 127u); f2[4 * q + 3] = key_val(b.w, 127u); }
                    unsigned c[16]; { unsigned k[16]; SN_STAGE2(c, k); }
                    const float rt = RTS[grp * 4 + tk];
                    float sc[16]; int ee[16]; float mx = -3.0e38f;
#pragma unroll
                    for (int r = 0; r < 16; ++r) { const unsigned ij = c[r] & 255u; const unsigned k1 = L1[ij >> 4], k2 = L2[ij & 15u];
                        sc[r] = key_val(k1, 127u) + key_val(k2, 127u); ee[r] = (int)((k1 & 127u) * 128u + (k2 & 127u)); mx = fmaxf(mx, sc[r]); }
                    float sum = 0.f;
#pragma unroll
                    for (int r = 0; r < 16; ++r) { sc[r] = __expf(rt * (sc[r] - mx)); sum += sc[r]; }
                    const float inv = 1.0f / sum;
#pragma unroll
                    for (int q = 0; q < 4; ++q) { *(LAS v4u*)(EIDS + (grp * 4 + tk) * 128 + h * 16 + 4 * q) = (v4u){(unsigned)ee[4 * q], (unsigned)ee[4 * q + 1], (unsigned)ee[4 * q + 2], (unsigned)ee[4 * q + 3]};
                        if (!(SKIP & 4)) { *(GAS v4u*)(EIDg + (size_t)m * 128 + h * 16 + 4 * q) = (v4u){(unsigned)ee[4 * q], (unsigned)ee[4 * q + 1], (unsigned)ee[4 * q + 2], (unsigned)ee[4 * q + 3]};
                            *(GAS f32x4*)(GATEg + (size_t)m * 128 + h * 16 + 4 * q) = (f32x4){sc[4 * q] * inv, sc[4 * q + 1] * inv, sc[4 * q + 2] * inv, sc[4 * q + 3] * inv}; } }
                }
                asm volatile("" ::: "memory");
            }
        }
#pragma unroll 1
        for (int ti = 0; ti < 8; ++ti) {
            int lane = F.lane; asm volatile("" : "+v"(lane));
            const int tA = (EIDS[ti * 128 + lane] >> 9) & 31, tB = (EIDS[ti * 128 + 64 + lane] >> 9) & 31; int mycnt = 0;
#pragma unroll
            for (int k = 0; k < NET; ++k) { const int c = __popcll(__ballot(tA == k)) + __popcll(__ballot(tB == k)); mycnt = (lane == k) ? c : mycnt; }
            if (lane < NET) OFFS[ti * NET + lane] = __hip_atomic_fetch_add((int*)(BC + lane), mycnt, __ATOMIC_RELAXED, __HIP_MEMORY_SCOPE_WORKGROUP);
        }
        __syncthreads();
        const int tt = blk >> 4;
        if (F.tid < NET) BC[NET + F.tid] = (int)__hip_atomic_fetch_add((unsigned*)(F.ctl + CW_CNT) + (tt * NET + F.tid) * 16, (unsigned)BC[F.tid], __ATOMIC_RELAXED, __HIP_MEMORY_SCOPE_AGENT);
        __syncthreads();
#pragma unroll 1
        for (int ti = 0; ti < 8; ++ti) { const int m = m0 + ti;
            int lane = F.lane; asm volatile("" : "+v"(lane));
            const unsigned long long lt_mask = (1ull << lane) - 1ull;
            const int eA = EIDS[ti * 128 + lane] & 16383, eB = EIDS[ti * 128 + 64 + lane] & 16383, tA = eA >> 9, tB = eB >> 9; int rankA = 0, rankB = 0;
#pragma unroll
            for (int k = 0; k < NET; ++k) { const unsigned long long mA = __ballot(tA == k), mB = __ballot(tB == k);
                rankA = (tA == k) ? __popcll(mA & lt_mask) : rankA; rankB = (tB == k) ? __popcll(mA) + __popcll(mB & lt_mask) : rankB; }
            const unsigned tl = (unsigned)(m & 1023) << 17;
            if (!(SKIP & 4)) { const int s = BC[NET + tA] + OFFS[ti * NET + tA] + rankA; if (s < REC_CAP) REC[(size_t)(tt * NET + tA) * REC_CAP + s] = tl | ((unsigned)(eA & 511) << 7) | (unsigned)lane; }
            if (!(SKIP & 4)) { const int s = BC[NET + tB] + OFFS[ti * NET + tB] + rankB; if (s < REC_CAP) REC[(size_t)(tt * NET + tB) * REC_CAP + s] = tl | ((unsigned)(eB & 511) << 7) | (unsigned)(lane + 64); }
        }
    }
}

constexpr int NSLOT = 12, UPITCH = 80;
template <int SKIP>
__device__ __forceinline__ void p11b_udot(Frame& F) {
    LAS unsigned char* XS = (LAS unsigned char*)F.lds;
    LAS unsigned char* US = XS + 1024 * UPITCH;
    LAS int* QB = (LAS int*)(F.lds + 124 * 1024);
    const int tid = F.tid;
    const unsigned char* XQ = F.ws + WS_XQ; const unsigned char* TU = F.ws + WS_TU; const unsigned* REC = (const unsigned*)(F.ws + WS_REC);
    const float* SXR = (const float*)(F.ws + WS_SXR); const float* GATEg = (const float*)(F.ws + WS_GATE); float* AVg = (float*)(F.ws + WS_AV);
    const float* SU = (const float*)(F.ws + WS_PSC); const float* SV = SU + 16384;
    for (;;) {
        __syncthreads();
        if (tid == 0) QB[0] = (int)__hip_atomic_fetch_add((unsigned*)(F.ctl + CW_Q), 1u, __ATOMIC_RELAXED, __HIP_MEMORY_SCOPE_AGENT);
        __syncthreads();
        const int b = QB[0];
        if (b >= NBUCK) break;
        const int tt = b >> 5, et = b & 31;
        int n = (int)__hip_atomic_load((unsigned*)(F.ctl + CW_CNT) + b * 16, __ATOMIC_RELAXED, __HIP_MEMORY_SCOPE_AGENT); n = n < REC_CAP ? n : REC_CAP;
        for (int g0 = 0; g0 < n; g0 += NSLOT * NTHR) {
            const int npass = (n - g0) < NSLOT * NTHR ? (n - g0) : NSLOT * NTHR;
            unsigned rec[NSLOT]; int acc[NSLOT];
#pragma unroll
            for (int j = 0; j < NSLOT; ++j) { const int idx = g0 + j * NTHR + tid; const unsigned r = idx < n ? REC[(size_t)b * REC_CAP + idx] : 0xffffffffu; acc[j] = 0;
                rec[j] = ((r >> 17) & 1023u) | (((r >> 7) & 511u) << 16); }
            v4u st[12];
#define P11B_SRC(step, i) (((i) % 6) < 4 ? XQ + ((size_t)(2 * (step) + (i) / 6) * SEQ + tt * 1024) * 32 + (size_t)(tid + 512 * ((i) % 6)) * 16 : TU + ((size_t)(2 * (step) + (i) / 6) * 16384 + et * ETSZ) * 32 + (size_t)(tid + 512 * (((i) % 6) - 4)) * 16)
#pragma unroll
            for (int i = 0; i < 12; ++i) st[i] = *(const GAS v4u*)P11B_SRC(0, i);
#pragma unroll 1
            for (int c = 0; c < 32; ++c) {
                __syncthreads();
#pragma unroll
                for (int i = 0; i < 12; ++i) { const int q = i % 6, hc = i / 6, p = (q < 4) ? tid + 512 * q : tid + 512 * (q - 4); *(LAS v4u*)((q < 4 ? XS : US) + (p >> 1) * UPITCH + hc * 32 + (p & 1) * 16) = st[i]; }
                __syncthreads();
                if (c + 1 < 32 && !(SKIP & 1)) {
#pragma unroll
                    for (int i = 0; i < 12; ++i) st[i] = *(const GAS v4u*)P11B_SRC(c + 1, i);
                }
#pragma unroll
                for (int j0 = 0; j0 < NSLOT; j0 += 2) {
                    if (j0 * NTHR < npass && !(SKIP & 2)) {
                        v4u xb[2][4], ub[2][4];
#pragma unroll
                        for (int q = 0; q < 2; ++q) { unsigned r = rec[j0 + q]; asm volatile("" : "+v"(r));
                            const unsigned xo = (r & 0xffffu) * UPITCH, uo = (r >> 16) * UPITCH;
#pragma unroll
                            for (int hh = 0; hh < 4; ++hh) { xb[q][hh] = *(const LAS v4u*)(XS + xo + 16 * hh); ub[q][hh] = *(const LAS v4u*)(US + uo + 16 * hh); } }
                        __builtin_amdgcn_sched_barrier(0);
#pragma unroll
                        for (int q = 0; q < 2; ++q) { int s = acc[j0 + q];
#pragma unroll
                            for (int hh = 0; hh < 4; ++hh) { const v4u u = ub[q][hh], x = xb[q][hh];
                                s = __builtin_amdgcn_sdot4((int)u.x, (int)x.x, s, false); s = __builtin_amdgcn_sdot4((int)u.y, (int)x.y, s, false); s = __builtin_amdgcn_sdot4((int)u.z, (int)x.z, s, false); s = __builtin_amdgcn_sdot4((int)u.w, (int)x.w, s, false); }
                            acc[j0 + q] = s; }
                        __builtin_amdgcn_sched_barrier(0);
                    }
                }
            }
#undef P11B_SRC
#pragma unroll
            for (int j = 0; j < NSLOT; ++j) { const int idx = g0 + j * NTHR + tid; const unsigned r = idx < n ? REC[(size_t)b * REC_CAP + idx] : 0xffffffffu;
                if (r != 0xffffffffu) { const int t = tt * 1024 + (int)((r >> 17) & 1023), e = et * ETSZ + (int)((r >> 7) & 511), j7 = (int)(r & 127);
                    const float hv = (float)acc[j] * SU[e] * SXR[2 * t]; AVg[(size_t)t * 128 + j7] = gelu_erf(hv) * GATEg[(size_t)t * 128 + j7] * SV[e]; } }
        }
    }
}

__device__ __forceinline__ void p11c_vsum(Frame& F) {
    const int gw = F.vcu * NWAVES + F.wave, NGW = F.G * NWAVES;
    LAS int* EID = (LAS int*)(F.lds + F.wave * 16384); LAS float* AV = (LAS float*)(EID + 128);
    const unsigned char* TV = F.ws + WS_TV; const int* EIDg = (const int*)(F.ws + WS_EID); const float* AVg = (const float*)(F.ws + WS_AV);
    for (int m = gw; m < SEQ; m += NGW) {
        int lane = F.lane; asm volatile("" : "+v"(lane));
        const int lo16 = lane * 16;
        EID[lane] = EIDg[(size_t)m * 128 + lane]; EID[lane + 64] = EIDg[(size_t)m * 128 + 64 + lane]; AV[lane] = AVg[(size_t)m * 128 + lane]; AV[lane + 64] = AVg[(size_t)m * 128 + 64 + lane];
        asm volatile("" ::: "memory");
        f32x2 y2[16];
#pragma unroll
        for (int e = 0; e < 16; ++e) y2[e] = (f32x2){0.f, 0.f};
        float av[2][4];
#if VFMT == 6
        v4u rv[2][4]; v2u rw[2][4];
#define P11C_LOAD(buf, g) do { _Pragma("unroll") for (int q = 0; q < 4; ++q) { const int e = __builtin_amdgcn_readfirstlane(EID[(g) + q]); av[buf][q] = AV[(g) + q]; const unsigned char* rp = TV + (size_t)e * TV_PITCH; \
            rv[buf][q] = *(const GAS v4u*)(rp + lo16); rw[buf][q] = *(const GAS v2u*)(rp + 1024 + lane * 8); } } while (0)
#define P11C_ACC(buf) do { _Pragma("unroll") for (int q = 0; q < 4; ++q) { const float a = av[buf][q]; const f32x2 a2 = {a, a}; \
            const v6u pk = {rv[buf][q].x, rv[buf][q].y, rv[buf][q].z, rv[buf][q].w, rw[buf][q].x, rw[buf][q].y}; const v32f f = __builtin_amdgcn_cvt_scalef32_pk32_f32_fp6(pk, 1.0f); \
            _Pragma("unroll") for (int k = 0; k < 16; ++k) y2[k] += a2 * (f32x2){f[2 * k], f[2 * k + 1]}; \
            __builtin_amdgcn_sched_barrier(0); } } while (0)
#else
        v4u rv[2][4][2];
#define P11C_LOAD(buf, g) do { _Pragma("unroll") for (int q = 0; q < 4; ++q) { const int e = __builtin_amdgcn_readfirstlane(EID[(g) + q]); av[buf][q] = AV[(g) + q]; const unsigned char* rp = TV + (size_t)e * DM + lo16; \
            rv[buf][q][0] = *(const GAS v4u*)(rp); rv[buf][q][1] = *(const GAS v4u*)(rp + 1024); } } while (0)
#define P11C_ACC(buf) do { _Pragma("unroll") for (int q = 0; q < 4; ++q) { const float a = av[buf][q]; const f32x2 a2 = {a, a}; \
            _Pragma("unroll") for (int j = 0; j < 2; ++j) { const v4u r = rv[buf][q][j]; const unsigned wv[4] = {r.x, r.y, r.z, r.w}; \
                _Pragma("unroll") for (int dd = 0; dd < 4; ++dd) { y2[8 * j + 2 * dd] += a2 * __builtin_amdgcn_cvt_pk_f32_fp8((int)wv[dd], false); y2[8 * j + 2 * dd + 1] += a2 * __builtin_amdgcn_cvt_pk_f32_fp8((int)wv[dd], true); } } \
            __builtin_amdgcn_sched_barrier(0); } } while (0)
#endif
        P11C_LOAD(0, 0);
#pragma unroll 1
        for (int g = 0; g < 128; g += 8) {
            P11C_LOAD(1, g + 4);
            P11C_ACC(0);
            if (g + 8 < 128) P11C_LOAD(0, g + 8);
            P11C_ACC(1);
        }
#undef P11C_LOAD
#undef P11C_ACC
        float y[32];
#pragma unroll
        for (int e = 0; e < 16; ++e) { if (VFMT == 6 && FP6_IL) { y[e] = y2[e].x; y[16 + e] = y2[e].y; } else { y[2 * e] = y2[e].x; y[2 * e + 1] = y2[e].y; } }
        const bf16* x1 = (const bf16*)(F.ws + WS_X1B) + (size_t)m * DM;
        float s2 = 0.f;
#pragma unroll
        for (int j = 0; j < 2; ++j)
#pragma unroll
            for (int q = 0; q < 4; ++q) { const v2u a2 = *(const GAS v2u*)(x1 + j * 1024 + lo16 + 4 * q); const f32x4 a = {bflo(a2.x), bfhi(a2.x), bflo(a2.y), bfhi(a2.y)};
                y[16 * j + 4 * q] += a.x; y[16 * j + 4 * q + 1] += a.y; y[16 * j + 4 * q + 2] += a.z; y[16 * j + 4 * q + 3] += a.w; }
#pragma unroll
        for (int e = 0; e < 32; ++e) s2 += y[e] * y[e];
        const float ro = 1.0f / sqrtf(wave_sum(s2) * (1.f / DM) + EPS);
        float* orow = F.out + (size_t)m * DM;
#pragma unroll
        for (int j = 0; j < 2; ++j)
#pragma unroll
            for (int q = 0; q < 4; ++q) { const f32x4 a = *(const GAS f32x4*)(F.in[I_FNW] + j * 1024 + lo16 + 4 * q);
                *(GAS f32x4*)(orow + j * 1024 + lo16 + 4 * q) = (f32x4){y[16 * j + 4 * q] * ro * a.x, y[16 * j + 4 * q + 1] * ro * a.y, y[16 * j + 4 * q + 2] * ro * a.z, y[16 * j + 4 * q + 3] * ro * a.w}; }
    }
}
#ifndef MK_N_LAUNCHES
#define MK_N_LAUNCHES 1
#endif
constexpr int N_PHASES = 14;
constexpr int N_LAUNCHES = MK_N_LAUNCHES;
static_assert(N_LAUNCHES == 1 || N_LAUNCHES == N_PHASES, "MK_N_LAUNCHES is 1 or N_PHASES");
#ifndef PG8_SP2
#define PG8_SP2 true
#endif
#ifndef PG8_ALIGN
#define PG8_ALIGN true
#endif
struct Args { const float* in[19]; float* out; unsigned char* ws; int ph_lo, ph_hi; };
__global__ void __launch_bounds__(NTHR, 2) fwd_kernel(Args args) {
    extern __shared__ __attribute__((aligned(16))) unsigned char lds[];
    Frame F;
    F.lds = (LAS unsigned char*)lds;
    F.MISC = (volatile LAS unsigned*)(F.lds + MISC_OFF);
    F.tid = threadIdx.x; F.lane = F.tid & 63; F.wave = __builtin_amdgcn_readfirstlane(F.tid >> 6);
    F.G = gridDim.x; { const int bx = blockIdx.x; F.vcu = (F.G % 8 == 0) ? (bx % 8) * (F.G / 8) + bx / 8 : bx; }
    F.ws = args.ws; F.out = args.out; F.ctl = (gu32*)(args.ws + WS_CTL);
#pragma unroll
    for (int i = 0; i < 19; ++i) F.in[i] = args.in[i];
    for (int u = F.tid; u < (LDS_BYTES - MISC_OFF) / 4; u += NTHR) ((LAS unsigned*)(F.lds + MISC_OFF))[u] = 0u;
    __syncthreads();
    XcdBarrier bar; bar.bar = (unsigned*)(F.ctl + CW_BAR); bar.x = 0; bar.st = nullptr;
    if (N_LAUNCHES == 1) bar = xcd_barrier_post((unsigned*)(F.ctl + CW_BAR), F.MISC + 8);
    const int lo = args.ph_lo, hi = args.ph_hi;
#ifdef ONLY_PHASE
#define IN(k) ((k) == ONLY_PHASE && lo <= (k) && (k) < hi)
#else
#define IN(k) (lo <= (k) && (k) < hi)
#endif
#define SEAM(k) do { if (IN(k) && IN((k) + 1)) xcd_barrier(bar); } while (0)
#ifndef REPEAT_MASK
#define REPEAT_MASK 0
#endif
#ifndef P11A_SKIP
#define P11A_SKIP 0
#endif
#define REPS(k) for (int rep_ = 0; rep_ < (((REPEAT_MASK) >> (k)) & 1) + 1; ++rep_)
#define RSEAM(k) do { if ((((REPEAT_MASK) >> (k)) & 1) && rep_ == 0) xcd_barrier(bar); } while (0)
    unsigned char* ws = args.ws;
    if (IN(0)) { REPS(0) { p0_prologue(F); RSEAM(0); } SEAM(0); }
    if (IN(1)) {
        pg8::Gemm g{(const bf16*)(ws + WS_XN), (const bf16*)(ws + WS_W1), SEQ, N1, DM}; pg8::StaticOrder S; S.init(SEQ, N1, F.G, (int)blockIdx.x);
        EpiG1 E{ws, F.in[I_LB], (const float*)(ws + WS_QX), (const float*)(ws + WS_QW) + QW_W1};
        if (QM_G1) g.A = (const bf16*)((const unsigned char*)F.out + DO_XN8);
        if ((REPEAT_MASK >> 1) & 1) { pg8::gemm_phase<EpiG1, pg8::StaticOrder, PG8_ALIGN, PG8_SP2, QM_G1>(F.lds, g, S, E); xcd_barrier(bar); }
        pg8::gemm_phase<EpiG1, pg8::StaticOrder, PG8_ALIGN, PG8_SP2, QM_G1>(F.lds, g, S, E);
        p1_ab(F);
        SEAM(1);
    }
#ifdef EXTRA_BARRIERS
    for (int eb = 0; eb < EXTRA_BARRIERS; ++eb) xcd_barrier(bar);
#endif
    if (IN(2)) { REPS(2) { hgrn_pass<false>(F); RSEAM(2); } SEAM(2); }
    if (IN(3)) { if ((REPEAT_MASK >> 3) & 1) { hgrn_pass<true, P11A_SKIP>(F); xcd_barrier(bar); } hgrn_pass<true>(F); SEAM(3); }
    if (IN(4)) { if ((REPEAT_MASK >> 4) & 1) { gdn_prep<P11A_SKIP>(F); xcd_barrier(bar); } gdn_prep<0>(F); SEAM(4); }
    if (IN(5)) { if ((REPEAT_MASK >> 5) & 1) { gdn_pass<false, P11A_SKIP>(F); xcd_barrier(bar); } gdn_pass<false>(F); SEAM(5); }
    if (IN(6)) { if ((REPEAT_MASK >> 6) & 1) { gdn_pass<true, P11A_SKIP>(F); xcd_barrier(bar); } gdn_pass<true>(F); SEAM(6); }
    if (IN(7)) { REPS(7) { p7_mix(F); RSEAM(7); } SEAM(7); }
    if (IN(8)) {
        pg8::StaticOrder S; S.init(SEQ, DM, F.G, (int)blockIdx.x);
        bf16* GT = (bf16*)(ws + WS_GT); unsigned char* GA8 = ws + WS_GT2; unsigned char* GB8 = ws + WS_GT2 + 32 * MiB;
        const bf16* XNg = QM_GATE ? (const bf16*)((const unsigned char*)F.out + DO_XN8) : (const bf16*)(ws + WS_XN);
        const bf16* WG2 = QM_GATE ? (const bf16*)(ws + WS_WG + (size_t)DM * DM) : (const bf16*)(ws + WS_WG) + (size_t)DM * DM;
        const float* QX = (const float*)(ws + WS_QX); const float* QW = (const float*)(ws + WS_QW);
#define P8_BODY \
        { pg8::Gemm g{XNg, (const bf16*)(ws + WS_WG), SEQ, DM, DM}; EpiGate E{GA8, QX, QW + QW_WG}; pg8::gemm_phase<EpiGate, pg8::StaticOrder, PG8_ALIGN, PG8_SP2, QM_GATE>(F.lds, g, S, E); } \
        __builtin_amdgcn_fence(__ATOMIC_ACQUIRE, "agent"); VM_WAIT(); __syncthreads(); \
        { pg8::Gemm g{(const bf16*)(ws + WS_YA), (const bf16*)(ws + WS_WPA), SEQ, DM, HW}; EpiMix<0> E{GT, GA8, nullptr, QX + SEQ, QW + QW_WPA}; pg8::gemm_phase<EpiMix<0>, pg8::StaticOrder, PG8_ALIGN, PG8_SP2, QM_MIX>(F.lds, g, S, E); } \
        { pg8::Gemm g{XNg, WG2, SEQ, DM, DM}; EpiGate E{GB8, QX, QW + QW_WG + DM}; pg8::gemm_phase<EpiGate, pg8::StaticOrder, PG8_ALIGN, PG8_SP2, QM_GATE>(F.lds, g, S, E); } \
        __builtin_amdgcn_fence(__ATOMIC_ACQUIRE, "agent"); VM_WAIT(); __syncthreads(); \
        { pg8::Gemm g{(const bf16*)(ws + WS_YB), (const bf16*)(ws + WS_WPB), SEQ, DM, HW}; EpiMix<1> E{GT, GB8, ws + WS_GT8, QX + 2 * SEQ, QW + QW_WPB}; pg8::gemm_phase<EpiMix<1>, pg8::StaticOrder, PG8_ALIGN, PG8_SP2, QM_MIX>(F.lds, g, S, E); }
        if ((REPEAT_MASK >> 8) & 1) { P8_BODY xcd_barrier(bar); }
        P8_BODY
#undef P8_BODY
        SEAM(8);
    }
    if (IN(9)) {
        pg8::Gemm g{(const bf16*)(ws + (QM_OUT ? WS_GT8 : WS_GT)), (const bf16*)(ws + WS_WOUT), SEQ, DM, DM}; pg8::StaticOrder S; S.init(SEQ, DM, F.G, (int)blockIdx.x);
        EpiX1 E{F.in[I_X], F.out, (bf16*)(ws + WS_X1B)};
        if ((REPEAT_MASK >> 9) & 1) { pg8::gemm_phase<EpiX1, pg8::StaticOrder, PG8_ALIGN, PG8_SP2, QM_OUT>(F.lds, g, S, E); xcd_barrier(bar); }
        pg8::gemm_phase<EpiX1, pg8::StaticOrder, PG8_ALIGN, PG8_SP2, QM_OUT>(F.lds, g, S, E);
        SEAM(9);
    }
    if (IN(10)) {
        pg8::Gemm g{(const bf16*)(ws + WS_X1B), (const bf16*)(ws + WS_WS), SEQ, DM, DM}; pg8::StaticOrder S; S.init(SEQ, DM, F.G, (int)blockIdx.x);
        EpiBf E{(bf16*)(ws + WS_SC)};
        if ((REPEAT_MASK >> 10) & 1) { pg8::gemm_phase<EpiBf, pg8::StaticOrder, PG8_ALIGN, PG8_SP2>(F.lds, g, S, E); xcd_barrier(bar); }
        pg8::gemm_phase<EpiBf, pg8::StaticOrder, PG8_ALIGN, PG8_SP2>(F.lds, g, S, E);
        SEAM(10);
    }
    if (IN(11)) {
        if ((REPEAT_MASK >> 11) & 1) { p11a_topk<P11A_SKIP>(F); xcd_barrier(bar); if (blockIdx.x == 0) for (int i = F.tid; i < NBUCK + 1; i += NTHR) __hip_atomic_store((unsigned*)(F.ctl + CW_CNT) + i * 16, 0u, __ATOMIC_RELAXED, __HIP_MEMORY_SCOPE_AGENT); xcd_barrier(bar); }
        p11a_topk<0>(F); SEAM(11); }
    if (IN(12)) { if ((REPEAT_MASK >> 12) & 1) { p11b_udot<P11A_SKIP>(F); xcd_barrier(bar); if (blockIdx.x == 0 && F.tid == 0) __hip_atomic_store((unsigned*)(F.ctl + CW_Q), 0u, __ATOMIC_RELAXED, __HIP_MEMORY_SCOPE_AGENT); xcd_barrier(bar); } p11b_udot<0>(F); SEAM(12); }
    if (IN(13)) { p11c_vsum(F); }
#undef IN
#undef SEAM
}


#ifdef PROBE
__global__ void digest_kernel(const unsigned* ws, float* out) {
    const size_t n = (size_t)SEQ * DM;
    for (size_t i = (size_t)blockIdx.x * blockDim.x + threadIdx.x; i < n; i += (size_t)gridDim.x * blockDim.x) {
        unsigned acc = (PROBE >= 9) ? __builtin_bit_cast(unsigned, out[i]) : 0u;
        const size_t offs[5] = {0, 128 * MiB / 4, 256 * MiB / 4, 384 * MiB / 4, 408 * MiB / 4};
#pragma unroll
        for (int r = 0; r < 5; ++r) acc = acc * 1664525u + ws[offs[r] + i];
        out[i] = (float)(acc >> 8) * (1.0f / 16777216.0f);
    }
}
#endif
extern "C" void kernel_launch(void* const* d_in, const int* in_sizes, int n_in, void* d_out, int out_size, void* d_ws, size_t ws_size, hipStream_t stream) {
    static int grid = 0;
    if (grid == 0) {
        if (n_in != 19 || in_sizes[0] != SEQ * DM || out_size != SEQ * DM || ws_size < WS_END) { fprintf(stderr, "kernel_launch: unexpected shapes (n_in %d, in0 %d, out %d, ws %zu; need ws >= %zu)\n", n_in, n_in > 0 ? in_sizes[0] : -1, out_size, ws_size, (size_t)WS_END); grid = -1; return; }
        int dev = 0, cus = 0, per_cu = 0;
        if (hipGetDevice(&dev) != hipSuccess || hipDeviceGetAttribute(&cus, hipDeviceAttributeMultiprocessorCount, dev) != hipSuccess) { grid = -1; return; }
        if (hipFuncSetAttribute((const void*)fwd_kernel, hipFuncAttributeMaxDynamicSharedMemorySize, LDS_BYTES) != hipSuccess) { fprintf(stderr, "kernel_launch: hipFuncSetAttribute failed\n"); grid = -1; return; }
        if (hipOccupancyMaxActiveBlocksPerMultiprocessor(&per_cu, (const void*)fwd_kernel, NTHR, LDS_BYTES) != hipSuccess || per_cu < 1) fprintf(stderr, "kernel_launch: occupancy query reports %d\n", per_cu);
        (void)hipGetLastError();
        grid = cus;
    }
    if (grid < 0) return;
    (void)hipMemsetAsync((char*)d_ws + WS_CTL, 0, CTL_ZERO_BYTES, stream);
    Args a{};
    for (int i = 0; i < 19; ++i) a.in[i] = (const float*)d_in[i];
    a.out = (float*)d_out; a.ws = (unsigned char*)d_ws;
    for (int li = 0; li < N_LAUNCHES; ++li) {
        a.ph_lo = (N_LAUNCHES == 1) ? 0 : li; a.ph_hi = (N_LAUNCHES == 1) ? N_PHASES : li + 1;
#ifdef PROBE
        if (li > PROBE) break;
#endif
        hipLaunchKernelGGL(fwd_kernel, dim3(grid), dim3(NTHR), LDS_BYTES, stream, a);
    }
#ifdef PROBE
    hipLaunchKernelGGL(digest_kernel, dim3(2048), dim3(256), 0, stream, (const unsigned*)d_ws, (float*)d_out);
#endif
}
```

```cpp
#include <hip/hip_runtime.h>
#include <cstdio>
#include <cstdint>
#define GAS __attribute__((address_space(1)))
#define LAS __attribute__((address_space(3)))
#define MK_N_LAUNCHES 1
namespace pg8 {
#define PG8_LAS __attribute__((address_space(3)))
typedef unsigned short bf16_t;
typedef short bf16x8 __attribute__((ext_vector_type(8)));
typedef float f32x4 __attribute__((ext_vector_type(4)));
typedef unsigned u32x4 __attribute__((ext_vector_type(4)));
constexpr int BM = 256, BK = 64, HALF = 128, HTB = HALF * BK * 2  , STAGE_BYTES = 8 * HTB, NXCD = 8, WGM = 8;

__host__ __device__ __forceinline__ int lds_byte(int r, int c) { const int st = (r >> 4) * 2 + (c >> 5), rr = r & 15, cc = c & 31, ob = rr * 64 + cc * 2; return st * 1024 + (ob ^ (((ob >> 9) & 1) << 5)); }
__host__ __device__ __forceinline__ void stage_rc(int b, int& R, int& C) { const int st = b / 1024, sb = b % 1024, swz = sb ^ (((sb >> 9) & 1) << 5); R = (st >> 1) * 16 + swz / 64; C = (st & 1) * 32 + (swz % 64) / 2; }
__host__ __device__ __forceinline__ int perm32(int rho) { const int n = rho >> 4, i = rho & 15; return 8 * (i >> 2) + 4 * n + (i & 3); }

struct Unit { int pm, pn; };
struct Gemm { const bf16_t* A; const bf16_t* Bt; int M, N, K; };

struct StaticOrder {
    int nM, nN, nwg, G, c;
    __host__ __device__ void init(int M, int N, int G_, int c_) { nM = M / BM; nN = N / BM; nwg = nM * nN; G = G_; c = c_; }
    __host__ __device__ bool next(int i, Unit& u) const {
        const long L = (long)i * G + c; if (L >= nwg) return false;
        int wgid = (int)L; { const int q = nwg / NXCD, r = nwg % NXCD, xcd = wgid % NXCD, off = wgid / NXCD; wgid = (xcd < r ? xcd * (q + 1) : r * (q + 1) + (xcd - r) * q) + off; }
        const int nig = WGM * nN, gid = wgid / nig, fm = gid * WGM, gsz = (nM - fm) < WGM ? (nM - fm) : WGM;
        u.pm = fm + ((wgid % nig) % gsz); u.pn = (wgid % nig) / gsz; return true;
    }
    __device__ __forceinline__ void a_ready(const Unit&) const {}
    __device__ __forceinline__ void done(const Unit&) const {}
};

__device__ __forceinline__ unsigned cvt_pk_bf16(float lo, float hi) { unsigned r; asm volatile("v_cvt_pk_bf16_f32 %0, %1, %2" : "=v"(r) : "v"(lo), "v"(hi)); return r; }
typedef float f32x2 __attribute__((ext_vector_type(2)));
__device__ __forceinline__ f32x2 gelu_pk(f32x2 v) {
    const f32x2 av = __builtin_elementwise_abs(v), d = av * 0.2316418882f + 1.0f;
    f32x2 t; t.x = __builtin_amdgcn_rcpf(d.x); t.y = __builtin_amdgcn_rcpf(d.y);
    f32x2 q = t * 0.5307027145f + (-0.7265760135f); q = q * t + 0.7107068705f; q = q * t + (-0.142248368f); q = q * t + 0.127414796f; q = q * t;
    const f32x2 s = (v * v) * (-0.72134752044f);
    f32x2 e; e.x = __builtin_amdgcn_exp2f(s.x); e.y = __builtin_amdgcn_exp2f(s.y);
    const f32x2 m = v * (q * e), r = v - m;
    f32x2 o; o.x = v.x < 0.f ? m.x : r.x; o.y = v.y < 0.f ? m.y : r.y; return o;
}

typedef int i32x4v __attribute__((ext_vector_type(4)));
typedef int i32x8v __attribute__((ext_vector_type(8)));
__device__ __forceinline__ i32x8v cat8(bf16x8 lo, bf16x8 hi) { return __builtin_shufflevector(__builtin_bit_cast(i32x4v, lo), __builtin_bit_cast(i32x4v, hi), 0, 1, 2, 3, 4, 5, 6, 7); }
template <class Epi, class Sched, bool ALIGN_EPI = false, bool SP2 = false, int QM = 0>
__device__ __forceinline__ void gemm_phase(PG8_LAS unsigned char* lds, const Gemm g, const Sched& S, const Epi& E) {
    const int tid = threadIdx.x, wid = __builtin_amdgcn_readfirstlane(tid >> 6), lane = tid & 63, wr = wid >> 2, wc = wid & 3, fr = lane & 15, fq = lane >> 4;
    constexpr bool F8 = QM == 1, I8 = QM == 2;
    const int K = g.K, KB = QM ? K : 2 * K  , nt = KB / (BK * 2);
    unsigned voffA[2], voffB[2];
#pragma unroll
    for (int i = 0; i < 2; ++i) { int R, C; stage_rc(tid * 16 + i * 8192, R, C); const int Rb = Epi::PERM ? ((R & ~31) + perm32(R & 31)) : R;
        voffA[i] = (unsigned)(R * KB + C * 2); voffB[i] = (unsigned)(Rb * KB + C * 2); }
    const size_t kstep = (size_t)(BK * 2);
    const size_t hstep = (size_t)HALF * KB;
    const size_t tstep = 2 * hstep;
    const unsigned ldsw = (unsigned)wid * 1024u;
    const int aoff = lds_byte(wr * 64 + fr, fq * 8), boff = lds_byte(wc * 32 + fr, fq * 8);
#define PG8_SA(b, h) (((b) * 2 + (h)) * HTB)
#define PG8_SB(b, h) ((4 + (b) * 2 + (h)) * HTB)
#define PG8_STAGE(bufoff, gbase, voff) do { _Pragma("unroll") for (int _i = 0; _i < 2; ++_i) \
        __builtin_amdgcn_global_load_lds((const unsigned*)((const char*)(gbase) + (voff)[_i]), (PG8_LAS unsigned*)(lds + (bufoff) + ldsw + _i * 8192), 16, 0, 0); } while (0)
#define PG8_LD16(off) (*(const PG8_LAS bf16x8*)(lds + (off)))
#define PG8_LDA(dst, b, h) do { _Pragma("unroll") for (int m = 0; m < 4; ++m) { if constexpr (F8) dst##8[m] = cat8(PG8_LD16(PG8_SA(b, h) + aoff + m * 2048), PG8_LD16(PG8_SA(b, h) + aoff + m * 2048 + 1024)); \
        else { _Pragma("unroll") for (int k = 0; k < 2; ++k) dst[m][k] = PG8_LD16(PG8_SA(b, h) + aoff + m * 2048 + k * 1024); } } } while (0)
#define PG8_LDB(dst, b, h) do { _Pragma("unroll") for (int n = 0; n < 2; ++n) { if constexpr (F8) dst##8[n] = cat8(PG8_LD16(PG8_SB(b, h) + boff + n * 2048), PG8_LD16(PG8_SB(b, h) + boff + n * 2048 + 1024)); \
        else { _Pragma("unroll") for (int k = 0; k < 2; ++k) dst[n][k] = PG8_LD16(PG8_SB(b, h) + boff + n * 2048 + k * 1024); } } } while (0)
#define PG8_MMA(ai, bj, At, Bt) do { __builtin_amdgcn_s_setprio(1); _Pragma("unroll") for (int m = 0; m < 4; ++m) _Pragma("unroll") for (int n = 0; n < 2; ++n) { \
        if constexpr (F8) asm volatile("v_mfma_f32_16x16x128_f8f6f4 %0, %1, %2, %0" : "+v"(acc[ai][bj][m][n]) : "v"(Bt##8[n]), "v"(At##8[m])); \
        else if constexpr (I8) { _Pragma("unroll") for (int k = 0; k < 2; ++k) acc[ai][bj][m][n] = __builtin_bit_cast(f32x4, __builtin_amdgcn_mfma_i32_16x16x64_i8(__builtin_bit_cast(i32x4v, Bt[n][k]), __builtin_bit_cast(i32x4v, At[m][k]), __builtin_bit_cast(i32x4v, acc[ai][bj][m][n]), 0, 0, 0)); } \
        else { _Pragma("unroll") for (int k = 0; k < 2; ++k) acc[ai][bj][m][n] = __builtin_amdgcn_mfma_f32_16x16x32_bf16(Bt[n][k], At[m][k], acc[ai][bj][m][n], 0, 0, 0); } } \
        __builtin_amdgcn_s_setprio(0); } while (0)
#define PG8_WAIT_V(n) asm volatile("s_waitcnt vmcnt(" #n ")" ::: "memory")
#define PG8_WAIT_L(n) asm volatile("s_waitcnt lgkmcnt(" #n ")" ::: "memory")
#define PG8_BAR __builtin_amdgcn_s_barrier()
#define PG8_SCHED __builtin_amdgcn_sched_barrier(0)
    Unit cur, nxt; int ui = 0;
    if (!S.next(0, cur)) return;
    f32x4 acc[2][2][4][2];
#pragma unroll
    for (int a = 0; a < 2; ++a)
#pragma unroll
        for (int b = 0; b < 2; ++b)
#pragma unroll
            for (int m = 0; m < 4; ++m)
#pragma unroll
                for (int n = 0; n < 2; ++n) acc[a][b][m][n] = (f32x4){0.f, 0.f, 0.f, 0.f};
    bf16x8 At[4][2], B0[2][2], B1[2][2]; i32x8v At8[4], B08[2], B18[2];
    const char* cA = (const char*)g.A + (size_t)cur.pm * tstep; const char* cB = (const char*)g.Bt + (size_t)cur.pn * tstep;
    S.a_ready(cur);
    if constexpr (SP2) {
        PG8_STAGE(PG8_SB(0, 0), cB, voffB); PG8_STAGE(PG8_SB(0, 1), cB + hstep, voffB); PG8_STAGE(PG8_SA(0, 0), cA, voffA); PG8_STAGE(PG8_SA(0, 1), cA + hstep, voffA);
        if (wr == 1) PG8_BAR;
        PG8_WAIT_V(2); PG8_BAR;
        PG8_STAGE(PG8_SB(1, 0), cB + kstep, voffB); PG8_STAGE(PG8_SA(1, 0), cA + kstep, voffA); PG8_STAGE(PG8_SB(1, 1), cB + hstep + kstep, voffB);
        PG8_WAIT_V(6); PG8_BAR;
    } else {
        PG8_STAGE(PG8_SB(0, 0), cB, voffB); PG8_STAGE(PG8_SA(0, 0), cA, voffA); PG8_STAGE(PG8_SB(0, 1), cB + hstep, voffB); PG8_STAGE(PG8_SA(0, 1), cA + hstep, voffA);
        if (wr == 1) PG8_BAR;
        PG8_WAIT_V(4); PG8_BAR;
        PG8_STAGE(PG8_SB(1, 0), cB + kstep, voffB); PG8_STAGE(PG8_SA(1, 0), cA + kstep, voffA); PG8_STAGE(PG8_SB(1, 1), cB + hstep + kstep, voffB);
        PG8_WAIT_V(6); PG8_BAR;
    }
    for (;;) {
        const bool has_next = S.next(ui + 1, nxt);
        const char* nA = has_next ? (const char*)g.A + (size_t)nxt.pm * tstep : cA; const char* nB = has_next ? (const char*)g.Bt + (size_t)nxt.pn * tstep : cB;
        for (int t = 0; t < nt; t += 2) {
            const bool last = (t == nt - 2);
            const char* a1 = cA + (size_t)(t + 1) * kstep;
            const char* a2 = last ? nA : cA + (size_t)(t + 2) * kstep; const char* b2 = last ? nB : cB + (size_t)(t + 2) * kstep;
            const char* a3 = a2 + kstep; const char* b3 = b2 + kstep;
            if (last && has_next) S.a_ready(nxt);
            if constexpr (SP2) {
            PG8_LDB(B0, 0, 0); PG8_LDB(B1, 0, 1); PG8_SCHED; PG8_LDA(At, 0, 0); PG8_STAGE(PG8_SA(1, 1), a1 + hstep, voffA);
            PG8_WAIT_V(8); PG8_WAIT_L(0); PG8_BAR; PG8_MMA(0, 0, At, B0); PG8_MMA(0, 1, At, B1); PG8_BAR; PG8_SCHED;
            PG8_LDA(At, 0, 1); PG8_STAGE(PG8_SB(0, 0), b2, voffB); PG8_STAGE(PG8_SB(0, 1), b2 + hstep, voffB); PG8_STAGE(PG8_SA(0, 0), a2, voffA);
            PG8_WAIT_V(8); PG8_WAIT_L(0); PG8_BAR; PG8_MMA(1, 0, At, B0); PG8_MMA(1, 1, At, B1); PG8_BAR; PG8_SCHED;
            PG8_LDB(B0, 1, 0); PG8_LDB(B1, 1, 1); PG8_SCHED; PG8_LDA(At, 1, 0); PG8_STAGE(PG8_SA(0, 1), a2 + hstep, voffA);
            PG8_WAIT_V(8); PG8_WAIT_L(0); PG8_BAR; PG8_MMA(0, 0, At, B0); PG8_MMA(0, 1, At, B1); PG8_BAR; PG8_SCHED;
            PG8_LDA(At, 1, 1); PG8_STAGE(PG8_SB(1, 0), b3, voffB); PG8_STAGE(PG8_SB(1, 1), b3 + hstep, voffB); PG8_STAGE(PG8_SA(1, 0), a3, voffA);
            PG8_WAIT_V(8); PG8_WAIT_L(0); PG8_BAR; PG8_MMA(1, 0, At, B0); PG8_MMA(1, 1, At, B1); PG8_BAR; PG8_SCHED;
            } else {
            PG8_LDB(B0, 0, 0); PG8_SCHED; PG8_LDA(At, 0, 0); PG8_STAGE(PG8_SA(1, 1), a1 + hstep, voffA);
            PG8_WAIT_L(8); PG8_BAR; PG8_WAIT_L(0); PG8_MMA(0, 0, At, B0); PG8_BAR; PG8_SCHED;
            PG8_LDB(B1, 0, 1); PG8_STAGE(PG8_SB(0, 0), b2, voffB);
            PG8_BAR; PG8_WAIT_L(0); PG8_MMA(0, 1, At, B1); PG8_BAR;
            PG8_LDA(At, 0, 1); PG8_STAGE(PG8_SA(0, 0), a2, voffA);
            PG8_BAR; PG8_WAIT_L(0); PG8_MMA(1, 0, At, B0); PG8_BAR; PG8_SCHED;
            PG8_STAGE(PG8_SB(0, 1), b2 + hstep, voffB);
            PG8_WAIT_V(6); PG8_BAR; PG8_MMA(1, 1, At, B1); PG8_BAR;
            PG8_LDB(B0, 1, 0); PG8_SCHED; PG8_LDA(At, 1, 0); PG8_STAGE(PG8_SA(0, 1), a2 + hstep, voffA);
            PG8_WAIT_L(8); PG8_BAR; PG8_WAIT_L(0); PG8_MMA(0, 0, At, B0); PG8_BAR; PG8_SCHED;
            PG8_LDB(B1, 1, 1); PG8_STAGE(PG8_SB(1, 0), b3, voffB);
            PG8_BAR; PG8_WAIT_L(0); PG8_MMA(0, 1, At, B1); PG8_BAR;
            PG8_LDA(At, 1, 1); PG8_STAGE(PG8_SA(1, 0), a3, voffA);
            PG8_BAR; PG8_WAIT_L(0); PG8_MMA(1, 0, At, B0); PG8_BAR; PG8_SCHED;
            PG8_STAGE(PG8_SB(1, 1), b3 + hstep, voffB);
            PG8_WAIT_V(6); PG8_BAR; PG8_MMA(1, 1, At, B1); PG8_BAR;
            }
        }
        if constexpr (ALIGN_EPI) { if (wr == 0) PG8_BAR; }
        if constexpr (F8) asm volatile("s_nop 15\n\ts_nop 15" ::: "memory");
        if constexpr (!Epi::AFTER_DRAIN) { E(acc, cur, wr, wc, fr, fq); S.done(cur); }
        if (!has_next) break;
#pragma unroll
        for (int a = 0; a < 2; ++a)
#pragma unroll
            for (int b = 0; b < 2; ++b)
#pragma unroll
                for (int m = 0; m < 4; ++m)
#pragma unroll
                    for (int n = 0; n < 2; ++n) acc[a][b][m][n] = (f32x4){0.f, 0.f, 0.f, 0.f};
        cur = nxt; cA = nA; cB = nB; ++ui;
        if constexpr (ALIGN_EPI) { if (wr == 1) PG8_BAR; }
    }
    PG8_WAIT_V(0);
    if constexpr (!ALIGN_EPI) { if (wr == 0) PG8_BAR; }
    PG8_BAR;
    if constexpr (Epi::AFTER_DRAIN) { E.fused(acc, cur, wr, wc, fr, fq, lds, wid, lane); S.done(cur); }
#undef PG8_SA
#undef PG8_SB
#undef PG8_STAGE
#undef PG8_LD16
#undef PG8_LDA
#undef PG8_LDB
#undef PG8_MMA
#undef PG8_WAIT_V
#undef PG8_WAIT_L
#undef PG8_BAR
#undef PG8_SCHED
}
}
typedef unsigned short bf16;
typedef unsigned v4u __attribute__((ext_vector_type(4)));
typedef unsigned v2u __attribute__((ext_vector_type(2)));
typedef float f32x4 __attribute__((ext_vector_type(4)));
typedef float f32x2 __attribute__((ext_vector_type(2)));
typedef short bf16x8 __attribute__((ext_vector_type(8)));
typedef GAS unsigned gu32;
#define RLX_AGENT __ATOMIC_RELAXED, __HIP_MEMORY_SCOPE_AGENT
#define LDS_WAIT() asm volatile("s_waitcnt lgkmcnt(0)" ::: "memory")
#define VM_WAIT() asm volatile("s_waitcnt vmcnt(0)" ::: "memory")
typedef __bf16 bf16x2_hw __attribute__((ext_vector_type(2)));
__device__ __forceinline__ unsigned pk2(float lo, float hi) { const f32x2 v = {lo, hi}; const bf16x2_hw b = __builtin_convertvector(v, bf16x2_hw); return __builtin_bit_cast(unsigned, b); }
__device__ __forceinline__ unsigned pk4f8(float a, float b, float c, float d) { int w = 0; w = __builtin_amdgcn_cvt_pk_fp8_f32(a, b, w, false); w = __builtin_amdgcn_cvt_pk_fp8_f32(c, d, w, true); return (unsigned)w; }
__device__ __forceinline__ float cvt_ub0(unsigned w) { float f; asm("v_cvt_f32_ubyte0 %0, %1" : "=v"(f) : "v"(w)); return f; }
__device__ __forceinline__ float cvt_ub1(unsigned w) { float f; asm("v_cvt_f32_ubyte1 %0, %1" : "=v"(f) : "v"(w)); return f; }
__device__ __forceinline__ float cvt_ub2(unsigned w) { float f; asm("v_cvt_f32_ubyte2 %0, %1" : "=v"(f) : "v"(w)); return f; }
__device__ __forceinline__ float cvt_ub3(unsigned w) { float f; asm("v_cvt_f32_ubyte3 %0, %1" : "=v"(f) : "v"(w)); return f; }
__device__ __forceinline__ unsigned f2bf(float f) { return pk2(f, 0.f) & 0xffffu; }
__device__ __forceinline__ float bflo(unsigned w) { return __builtin_bit_cast(float, w << 16); }
__device__ __forceinline__ float bfhi(unsigned w) { return __builtin_bit_cast(float, w & 0xffff0000u); }
__device__ __forceinline__ float bf1(bf16 b) { return __builtin_bit_cast(float, ((unsigned)b) << 16); }
__device__ __forceinline__ float fast_exp(float x) { return __builtin_amdgcn_exp2f(x * 1.4426950408889634f); }
__device__ __forceinline__ float fast_rcp(float x) { return __builtin_amdgcn_rcpf(x); }
__device__ __forceinline__ float sigmoidf_(float x) { return fast_rcp(1.0f + fast_exp(-x)); }
__device__ __forceinline__ float siluf_(float x) { return x * sigmoidf_(x); }
template <int CTRL> __device__ __forceinline__ float dppf(float v) { return __builtin_bit_cast(float, __builtin_amdgcn_mov_dpp(__builtin_bit_cast(int, v), CTRL, 0xF, 0xF, true)); }
template <int CTRL> __device__ __forceinline__ int dppi(int v) { return __builtin_amdgcn_mov_dpp(v, CTRL, 0xF, 0xF, true); }
__device__ __forceinline__ float rdl(float v, int l) { return __builtin_bit_cast(float, __builtin_amdgcn_readlane(__builtin_bit_cast(int, v), l)); }
__device__ __forceinline__ float wave_sum(float v) {
    v += dppf<0xB1>(v); v += dppf<0x4E>(v); v += dppf<0x141>(v); v += dppf<0x140>(v);
    return (rdl(v, 0) + rdl(v, 16)) + (rdl(v, 32) + rdl(v, 48));
}
__device__ __forceinline__ float wave_max(float v) {
    v = fmaxf(v, dppf<0xB1>(v)); v = fmaxf(v, dppf<0x4E>(v)); v = fmaxf(v, dppf<0x141>(v)); v = fmaxf(v, dppf<0x140>(v));
    return fmaxf(fmaxf(rdl(v, 0), rdl(v, 16)), fmaxf(rdl(v, 32), rdl(v, 48)));
}
__device__ __forceinline__ int wave_sum_i(int v) {
    v += dppi<0xB1>(v); v += dppi<0x4E>(v); v += dppi<0x141>(v); v += dppi<0x140>(v);
    return (__builtin_amdgcn_readlane(v, 0) + __builtin_amdgcn_readlane(v, 16)) + (__builtin_amdgcn_readlane(v, 32) + __builtin_amdgcn_readlane(v, 48));
}

constexpr int NWAVES = 8, NTHR = 512;
constexpr int SEQ = 16384, DM = 2048, NH = 8, HD = 128, HW = 1024;
constexpr int CK = 64, NCHUNK = SEQ / CK, NSEG = 16, CPS = NCHUNK / NSEG;
constexpr int INW = 13344;
constexpr int N1 = 9216;
constexpr float EPS = 1e-6f;
constexpr int PEER_K = 16;

constexpr size_t MiB = (size_t)1 << 20;
constexpr size_t WS_CTL = 0, CTL_ZERO_BYTES = 1 * MiB;
constexpr size_t WS_WG = 2 * MiB, WS_WPA = 18 * MiB, WS_WPB = 22 * MiB, WS_WOUT = 26 * MiB, WS_WS = 34 * MiB, WS_W1 = 42 * MiB;
constexpr size_t WS_XN = 80 * MiB;
constexpr size_t WS_H = 144 * MiB;
constexpr size_t WS_GAB = 432 * MiB;
constexpr size_t WS_HL = 434 * MiB;
constexpr size_t WS_HDS = 450 * MiB;
constexpr size_t WS_OHF = 452 * MiB, WS_OHB = 484 * MiB;
constexpr size_t WS_GSC = 516 * MiB;
constexpr size_t WS_UTF = 144 * MiB, WS_UTB = 176 * MiB, WS_WF = 208 * MiB, WS_WB = 240 * MiB;
constexpr size_t DO_AQKF = 0, DO_AQKB = 16 * MiB, DO_QN = 32 * MiB, DO_KNT = 64 * MiB;
constexpr size_t WS_GL = 42 * MiB, WS_GP = 58 * MiB;
constexpr size_t WS_OGF = 304 * MiB, WS_OGB = 336 * MiB;
constexpr size_t WS_YA = 42 * MiB, WS_YB = 368 * MiB;
constexpr size_t WS_TU = 144 * MiB, WS_TV = 176 * MiB;
constexpr size_t WS_PSC = 520 * MiB;
constexpr size_t WS_GT = 272 * MiB, WS_GT2 = 400 * MiB;
constexpr size_t WS_X1B = 400 * MiB;
constexpr size_t WS_SC = 272 * MiB;
constexpr size_t WS_END = 536 * MiB;
#ifndef QM_G1_
#define QM_G1_ 2
#endif
#ifndef QM_GATE_
#define QM_GATE_ 2
#endif
#ifndef QM_MIX_
#define QM_MIX_ 2
#endif
#ifndef QM_OUT_
#define QM_OUT_ 0
#endif
constexpr int QM_G1 = QM_G1_, QM_GATE = QM_GATE_, QM_MIX = QM_MIX_, QM_OUT = QM_OUT_;
constexpr int QM_XN = QM_G1 ? QM_G1 : QM_GATE;
static_assert(QM_G1 == 0 || QM_GATE == 0 || QM_G1 == QM_GATE, "xn has one 8-bit copy");
static_assert(QM_OUT != 2, "merged has no row scale");
constexpr float F8_WSCALE = 128.0f;
constexpr size_t WS_WAB = 78 * MiB;
constexpr size_t DO_XN8 = 96 * MiB;
constexpr size_t WS_GT8 = 336 * MiB;
constexpr size_t WS_QW = 521 * MiB;
constexpr int QW_W1 = 0, QW_WG = 9216, QW_WPA = 13312, QW_WPB = 15360, QW_WOUT = 17408, QW_WAB = 19456;
constexpr bool AB_I8 = QM_XN == 2;
constexpr bool XN_BF16 = QM_G1 == 0 || QM_GATE == 0 || !AB_I8;
constexpr size_t WS_QX = 522 * MiB;
#ifndef VFMT
#define VFMT 6
#endif
#ifndef FP6_IL
#define FP6_IL 1
#endif
constexpr int TV_PITCH = VFMT == 6 ? 1536 : 2048;
typedef float v16f __attribute__((ext_vector_type(16)));
typedef float v32f __attribute__((ext_vector_type(32)));
typedef unsigned v6u __attribute__((ext_vector_type(6)));
constexpr int CW_BAR = 4096;

constexpr int LDS_BYTES = 163840;
constexpr int MISC_OFF = 163840 - 256;
constexpr int LDS_USABLE = MISC_OFF;

__device__ __forceinline__ bf16x8 ldfrag(const LAS bf16* T, int pitch, int row, int k) { return *(const LAS bf16x8*)(T + row * pitch + k); }
__device__ __forceinline__ f32x4 mfma16(bf16x8 x, bf16x8 y, f32x4 c) { return __builtin_amdgcn_mfma_f32_16x16x32_bf16(x, y, c, 0, 0, 0); }
__device__ __forceinline__ v2u pack4(f32x4 v) { v2u r; r.x = pk2(v[0], v[1]); r.y = pk2(v[2], v[3]); return r; }
#define XB_TMO      128
#define XB_XCNT(j)  (256  + 64 * (j))
#define XB_XSUB(j)  (1280 + 64 * (j))
#define XB_XGEN(j)  (2304 + 64 * (j))
#define XB_TOP      3328
#define XB_TOPGEN   3392
#define XCD_BAR_WORDS 3456
#define XB_SPIN_CAP (1u << 18)

__device__ __forceinline__ unsigned xb_ld(unsigned* p)              { return __hip_atomic_load(p, __ATOMIC_RELAXED, __HIP_MEMORY_SCOPE_AGENT); }
__device__ __forceinline__ unsigned xb_add(unsigned* p, unsigned v) { return __hip_atomic_fetch_add(p, v, __ATOMIC_RELAXED, __HIP_MEMORY_SCOPE_AGENT); }
__device__ __forceinline__ unsigned xb_xcc_id() { return (unsigned)__builtin_amdgcn_s_getreg((3 << 11) | 20) & 0xFu; }
#define XB_SPIN(cond, bar) do { unsigned _sp = 0; while (cond) { __builtin_amdgcn_s_sleep(1); \
    if ((++_sp & 255u) == 0u) { if (xb_ld(&(bar)[XB_TMO])) break; if (_sp > XB_SPIN_CAP) { atomicAdd(&(bar)[XB_TMO], 1u); break; } } } } while (0)

struct XcdBarrier {
    unsigned* bar; unsigned x;
    volatile LAS unsigned* st;
};

__device__ __forceinline__ XcdBarrier xcd_barrier_post(unsigned* bar, volatile LAS unsigned* st) {
    XcdBarrier b; b.bar = bar; b.x = xb_xcc_id(); b.st = st;
    if (threadIdx.x == 0) (void)xb_add(&bar[XB_XCNT(b.x)], 1u);
    return b;
}
__device__ __forceinline__ void xcd_barrier_complete(unsigned* bar, unsigned x, unsigned& nloc, unsigned& nx) {
    const unsigned G = gridDim.x * gridDim.y * gridDim.z;
    unsigned sum, cnt, mine, sp = 0u;
    for (;;) {
        sum = 0u; cnt = 0u; mine = 0u;
#pragma unroll
        for (unsigned j = 0; j < 16; ++j) { const unsigned c = xb_ld(&bar[XB_XCNT(j)]); sum += c; cnt += (c > 0u) ? 1u : 0u; mine = (j == x) ? c : mine; }
        if (sum == G) break;
        __builtin_amdgcn_s_sleep(1);
        if ((++sp & 255u) == 0u) { if (xb_ld(&bar[XB_TMO])) break; if (sp > XB_SPIN_CAP) { atomicAdd(&bar[XB_TMO], 1u); break; } }
    }
    nloc = mine > 0u ? mine : 1u; nx = cnt > 0u ? cnt : 1u;
}

__device__ __forceinline__ void xcd_barrier(const XcdBarrier& b) {
    asm volatile("s_waitcnt vmcnt(0)" ::: "memory");
    __syncthreads();
    if (threadIdx.x == 0) {
        unsigned* bar = b.bar;
        __builtin_amdgcn_s_waitcnt(0);
        unsigned nloc = b.st[0], nx = b.st[1];
        if (nloc == 0u) { xcd_barrier_complete(bar, b.x, nloc, nx); b.st[0] = nloc; b.st[1] = nx; }
        const unsigned old = xb_add(&bar[XB_XSUB(b.x)], 1u);
        const unsigned gen = old / nloc;
        if (old + 1u == (gen + 1u) * nloc) {
            __builtin_amdgcn_fence(__ATOMIC_RELEASE, "agent");
            asm volatile("s_waitcnt vmcnt(0)" ::: "memory");
            const unsigned og = xb_add(&bar[XB_TOP], 1u);
            const unsigned tg = og / nx;
            if (og + 1u == (tg + 1u) * nx) xb_add(&bar[XB_TOPGEN], 1u);
            else XB_SPIN(xb_ld(&bar[XB_TOPGEN]) == tg, bar);
            __builtin_amdgcn_fence(__ATOMIC_ACQUIRE, "agent");
            xb_add(&bar[XB_XGEN(b.x)], 1u);
            asm volatile("s_waitcnt vmcnt(0)" ::: "memory");
        } else {
            XB_SPIN(xb_ld(&bar[XB_XGEN(b.x)]) == gen, bar);
            __builtin_amdgcn_fence(__ATOMIC_ACQUIRE, "agent");
            asm volatile("s_waitcnt vmcnt(0)" ::: "memory");
        }
    }
    __syncthreads();
}

struct Frame {
    LAS unsigned char* lds;
    volatile LAS unsigned* MISC;
    gu32* ctl;
    int tid, lane, wave, vcu, G;
    const float* in[19]; float* out; unsigned char* ws;
};
enum { I_X = 0, I_N1W, I_WIN, I_LB, I_HNW, I_CONVW, I_ALOG, I_DTB, I_GNW, I_WPA, I_WPB, I_WOUT, I_N2W, I_WQ, I_K1, I_K2, I_PU, I_PV, I_FNW };

template <bool F8>
__device__ __forceinline__ void p0_transpose_item(const float* W, int ldw, int c0, int K, int ncols, void* WTv, int row_off, LAS float* scr, int item, int lane) {
    const int nblk = ncols / 32, kb = item / nblk, nb = item % nblk, k0 = 64 * kb, n0 = 32 * nb;
#pragma unroll 8
    for (int i = 0; i < 32; ++i) { const int kk = 2 * i + (lane >> 5); scr[kk * 33 + (lane & 31)] = W[(size_t)(k0 + kk) * ldw + c0 + n0 + (lane & 31)]; }
    LDS_WAIT(); asm volatile("" ::: "memory");
    const int c = lane & 7;
#pragma unroll
    for (int j = 0; j < 4; ++j) { const int n = (lane >> 3) + 8 * j; const LAS float* s = scr + (8 * c) * 33 + n;
        if (F8) { v2u o; o.x = pk4f8(s[0 * 33] * F8_WSCALE, s[1 * 33] * F8_WSCALE, s[2 * 33] * F8_WSCALE, s[3 * 33] * F8_WSCALE); o.y = pk4f8(s[4 * 33] * F8_WSCALE, s[5 * 33] * F8_WSCALE, s[6 * 33] * F8_WSCALE, s[7 * 33] * F8_WSCALE);
            *(GAS v2u*)((unsigned char*)WTv + (size_t)(row_off + n0 + n) * K + k0 + 8 * c) = o; }
        else { v4u o; o.x = pk2(s[0 * 33], s[1 * 33]); o.y = pk2(s[2 * 33], s[3 * 33]); o.z = pk2(s[4 * 33], s[5 * 33]); o.w = pk2(s[6 * 33], s[7 * 33]);
            *(GAS v4u*)((bf16*)WTv + (size_t)(row_off + n0 + n) * K + k0 + 8 * c) = o; } }
    LDS_WAIT(); asm volatile("" ::: "memory");
}
__device__ __forceinline__ unsigned pk4i8(f32x4 v, float inv) {
    const int a = (int)rintf(v.x * inv), b = (int)rintf(v.y * inv), c = (int)rintf(v.z * inv), d = (int)rintf(v.w * inv);
    return (unsigned)(a & 255) | ((unsigned)(b & 255) << 8) | ((unsigned)(c & 255) << 16) | ((unsigned)d << 24);
}
__device__ __forceinline__ float amax4(f32x4 v) { const f32x4 a = __builtin_elementwise_abs(v); return fmaxf(fmaxf(a.x, a.y), fmaxf(a.z, a.w)); }
__device__ __forceinline__ void rms_row_to_bf16(int lane, const float* xrow, const float* w, bf16* orow, unsigned char* orow8, float* sx) {
    const GAS f32x4* xr = (const GAS f32x4*)xrow + lane; const GAS f32x4* wr = (const GAS f32x4*)w + lane;
    f32x4 v[8]; float s = 0.f;
#pragma unroll
    for (int j = 0; j < 8; ++j) { v[j] = xr[64 * j]; s += (v[j].x * v[j].x + v[j].y * v[j].y) + (v[j].z * v[j].z + v[j].w * v[j].w); }
    const float r = 1.0f / sqrtf(wave_sum(s) * (1.f / DM) + EPS);
    GAS v2u* o8 = (GAS v2u*)orow + lane; GAS unsigned* q8 = (GAS unsigned*)orow8 + lane; float am = 0.f;
#pragma unroll
    for (int j = 0; j < 8; ++j) { const f32x4 ww = wr[64 * j]; const f32x4 y = {v[j].x * r * ww.x, v[j].y * r * ww.y, v[j].z * r * ww.z, v[j].w * r * ww.w};
        if (XN_BF16) { v2u o; o.x = pk2(y.x, y.y); o.y = pk2(y.z, y.w); o8[64 * j] = o; }
        if (QM_XN == 1) q8[64 * j] = pk4f8(y.x, y.y, y.z, y.w);
        if (QM_XN == 2) { v[j] = y; am = fmaxf(am, amax4(y)); } }
    if (QM_XN == 2) { am = wave_max(am); const float inv = am > 0.f ? 127.0f / am : 0.f;
#pragma unroll
        for (int j = 0; j < 8; ++j) q8[64 * j] = pk4i8(v[j], inv);
        if (lane == 0) *sx = am > 0.f ? am * (1.0f / 127.0f) : 1.0f; }
}
template <int KT>
__device__ __forceinline__ void p0_quant_item(Frame& F, const float* W, int ldw, int c0, signed char* Wq, float* scl, int n0) {
    constexpr int KW = KT / 8, NB = KW / 64;
    const int col = F.lane & 31, kh = F.lane >> 5;
    const GAS float* src = (const GAS float*)W + (size_t)(F.wave * KW + 32 * kh) * ldw + c0 + n0 + col;
    float v[NB][32]; float mx = 0.f;
#pragma unroll
    for (int b = 0; b < NB; ++b)
#pragma unroll
        for (int i = 0; i < 32; ++i) v[b][i] = src[(size_t)(64 * b + i) * ldw];
#pragma unroll
    for (int b = 0; b < NB; ++b)
#pragma unroll
        for (int i = 0; i < 32; ++i) mx = fmaxf(mx, fabsf(v[b][i]));
    mx = fmaxf(mx, __shfl_xor(mx, 32));
    LAS float* part = (LAS float*)F.lds;
    if (kh == 0) part[F.wave * 32 + col] = mx;
    __syncthreads();
    float cm = part[col];
#pragma unroll
    for (int w = 1; w < 8; ++w) cm = fmaxf(cm, part[w * 32 + col]);
    const float inv = cm > 0.f ? 127.0f / cm : 0.f;
    if (F.wave == 0 && kh == 0) scl[n0 + col] = cm > 0.f ? cm * (1.0f / 127.0f) : 1.0f;
    GAS v4u* dst = (GAS v4u*)(Wq + (size_t)(n0 + col) * KT + F.wave * KW + 32 * kh);
#pragma unroll
    for (int b = 0; b < NB; ++b) { unsigned w[8];
#pragma unroll
        for (int q = 0; q < 8; ++q) w[q] = pk4i8((f32x4){v[b][4 * q], v[b][4 * q + 1], v[b][4 * q + 2], v[b][4 * q + 3]}, inv);
        dst[4 * b] = (v4u){w[0], w[1], w[2], w[3]}; dst[4 * b + 1] = (v4u){w[4], w[5], w[6], w[7]}; }
    __syncthreads();
}
__device__ __forceinline__ void p0_ws_item(Frame& F, int it) {
    const int h = it >> 6, half = (it >> 5) & 1, j0 = (it & 31) * 64, hc = h * 256 + half * 128;
    const float* Wq = F.in[I_WQ]; const float* Ks = half ? F.in[I_K2] : F.in[I_K1]; const float* n2 = F.in[I_N2W];
    LAS bf16* Xs = (LAS bf16*)F.lds; LAS bf16* Ys = Xs + 64 * 136;
    { const int row = F.tid >> 3, c0 = (F.tid & 7) * 16; const GAS f32x4* src = (const GAS f32x4*)(Wq + (size_t)(j0 + row) * DM + hc + c0);
      const f32x4 a = src[0], b = src[1], c = src[2], d = src[3];
      v4u o0, o1; o0.x = pk2(a.x, a.y); o0.y = pk2(a.z, a.w); o0.z = pk2(b.x, b.y); o0.w = pk2(b.z, b.w); o1.x = pk2(c.x, c.y); o1.y = pk2(c.z, c.w); o1.z = pk2(d.x, d.y); o1.w = pk2(d.z, d.w);
      *(LAS v4u*)(Xs + row * 136 + c0) = o0; *(LAS v4u*)(Xs + row * 136 + c0 + 8) = o1; }
    { const int row = F.tid >> 2, c0 = (F.tid & 3) * 32; const GAS f32x4* src = (const GAS f32x4*)(Ks + (size_t)row * 128 + c0);
#pragma unroll
      for (int q = 0; q < 4; ++q) { const f32x4 a = src[2 * q], b = src[2 * q + 1]; v4u o; o.x = pk2(a.x, a.y); o.y = pk2(a.z, a.w); o.z = pk2(b.x, b.y); o.w = pk2(b.z, b.w); *(LAS v4u*)(Ys + row * 136 + c0 + 8 * q) = o; } }
    __syncthreads();
    const int fr = F.lane & 15, fq = F.lane >> 4, w = F.wave;
    bf16* WSt = (bf16*)(F.ws + WS_WS);
#pragma unroll
    for (int jt = 0; jt < 4; ++jt) {
        f32x4 acc = {0.f, 0.f, 0.f, 0.f};
#pragma unroll
        for (int k0 = 0; k0 < 4; ++k0) acc = mfma16(ldfrag(Xs, 136, 16 * jt + fr, 32 * k0 + 8 * fq), ldfrag(Ys, 136, 16 * w + fr, 32 * k0 + 8 * fq), acc);
        const int jj = j0 + 16 * jt + 4 * fq; const f32x4 nw = *(const GAS f32x4*)(n2 + jj);
        *(GAS v2u*)(WSt + (size_t)(hc + 16 * w + fr) * DM + jj) = pack4(acc * nw);
    }
    __syncthreads();
}
__device__ __forceinline__ void p0_prologue(Frame& F) {
    LAS float* scr = (LAS float*)(F.lds + F.wave * 16384);
    const int gw = F.vcu * NWAVES + F.wave, NGW = F.G * NWAVES;
    constexpr int I_1 = QM_G1 == 2 ? 0 : (DM / 64) * (N1 / 32), I_AB = AB_I8 ? 0 : (DM / 64), I_G = QM_GATE == 2 ? 0 : (DM / 64) * (4096 / 32), I_PA = QM_MIX == 2 ? 0 : (HW / 64) * (DM / 32), I_O = QM_OUT == 2 ? 0 : (DM / 64) * (DM / 32);
    constexpr int NITEMS = I_1 + I_AB + I_G + 2 * I_PA + I_O;
    for (int it = gw; it < NITEMS; it += NGW) {
        int r = it;
        if (r < I_1) { p0_transpose_item<QM_G1 == 1>(F.in[I_WIN], INW, 0, DM, N1, F.ws + WS_W1, 0, scr, r, F.lane); continue; } r -= I_1;
        if (r < I_AB) { p0_transpose_item<false>(F.in[I_WIN], INW, N1, DM, 32, F.ws + WS_WAB, 0, scr, r, F.lane); continue; } r -= I_AB;
        if (r < I_G) { p0_transpose_item<QM_GATE == 1>(F.in[I_WIN], INW, 9248, DM, 4096, F.ws + WS_WG, 0, scr, r, F.lane); continue; } r -= I_G;
        if (r < I_PA) { p0_transpose_item<QM_MIX == 1>(F.in[I_WPA], DM, 0, HW, DM, F.ws + WS_WPA, 0, scr, r, F.lane); continue; } r -= I_PA;
        if (r < I_PA) { p0_transpose_item<QM_MIX == 1>(F.in[I_WPB], DM, 0, HW, DM, F.ws + WS_WPB, 0, scr, r, F.lane); continue; } r -= I_PA;
        p0_transpose_item<QM_OUT == 1>(F.in[I_WOUT], DM, 0, DM, DM, F.ws + WS_WOUT, 0, scr, r, F.lane);
    }
    bf16* XN = (bf16*)(F.ws + WS_XN); float* QX = (float*)(F.ws + WS_QX);
    for (int m = gw; m < SEQ; m += NGW) rms_row_to_bf16(F.lane, F.in[I_X] + (size_t)m * DM, F.in[I_N1W], XN + (size_t)m * DM, (unsigned char*)F.out + DO_XN8 + (size_t)m * DM, QX + m);
    __syncthreads();
    { constexpr int J_1 = (QM_G1 == 2 ? N1 / 32 : 0) + (AB_I8 ? 1 : 0), J_G = QM_GATE == 2 ? 4096 / 32 : 0, J_O = QM_OUT == 2 ? DM / 32 : 0, J_P = QM_MIX == 2 ? DM / 32 : 0;
      float* QW = (float*)(F.ws + WS_QW);
#pragma unroll 1
      for (int it = F.vcu; it < J_1 + J_G + J_O + 2 * J_P; it += F.G) {
          int r = it; const float* W = F.in[I_WIN]; int ldw = INW, c0 = 0, n0 = 0, qo = QW_W1; size_t wo = WS_W1; bool half = false;
          if (r < J_1) { n0 = 32 * r; if (AB_I8 && r == J_1 - 1) { c0 = N1; n0 = 0; qo = QW_WAB; wo = WS_WAB; } }
          else if ((r -= J_1) < J_G) { c0 = 9248; n0 = 32 * r; qo = QW_WG; wo = WS_WG; }
          else if ((r -= J_G) < J_O) { W = F.in[I_WOUT]; ldw = DM; n0 = 32 * r; qo = QW_WOUT; wo = WS_WOUT; }
          else if ((r -= J_O) < J_P) { W = F.in[I_WPA]; ldw = DM; n0 = 32 * r; qo = QW_WPA; wo = WS_WPA; half = true; }
          else { r -= J_P; W = F.in[I_WPB]; ldw = DM; n0 = 32 * r; qo = QW_WPB; wo = WS_WPB; half = true; }
          if (half) p0_quant_item<HW>(F, W, ldw, c0, (signed char*)(F.ws + wo), QW + qo, n0);
          else p0_quant_item<DM>(F, W, ldw, c0, (signed char*)(F.ws + wo), QW + qo, n0);
      } }
    __syncthreads();
    for (int it = blockIdx.x; it < 512; it += F.G) p0_ws_item(F, it);
}
typedef unsigned u32x4 __attribute__((ext_vector_type(4)));
__device__ __forceinline__ u32x4 pack8(f32x4 a, f32x4 b) { u32x4 w; w.x = pk2(a[0], a[1]); w.y = pk2(a[2], a[3]); w.z = pk2(b[0], b[1]); w.w = pk2(b[2], b[3]); return w; }
__device__ __forceinline__ void unpack8(u32x4 w, f32x4& a, f32x4& b) { a = (f32x4){bflo(w.x), bfhi(w.x), bflo(w.y), bfhi(w.y)}; b = (f32x4){bflo(w.z), bfhi(w.z), bflo(w.w), bfhi(w.w)}; }
__device__ __forceinline__ f32x4 silu4(f32x4 v) { return (f32x4){siluf_(v[0]), siluf_(v[1]), siluf_(v[2]), siluf_(v[3])}; }
__device__ __forceinline__ f32x4 sigm4(f32x4 v) { return (f32x4){sigmoidf_(v[0]), sigmoidf_(v[1]), sigmoidf_(v[2]), sigmoidf_(v[3])}; }

typedef int i32x4 __attribute__((ext_vector_type(4)));
template <int QM> __device__ __forceinline__ f32x4 deq(f32x4 a, float sr, f32x4 sc) {
    if (QM == 2) { const i32x4 q = __builtin_bit_cast(i32x4, a); return (f32x4){(float)q[0], (float)q[1], (float)q[2], (float)q[3]} * (sc * sr); }
    if (QM == 1) return a * (1.0f / F8_WSCALE);
    return a;
}
template <int QM, bool PERM> __device__ __forceinline__ void ld_colscale(f32x4 (&scv)[2][2], const float* sb, int cb) {
#pragma unroll
    for (int bj = 0; bj < 2; ++bj)
#pragma unroll
        for (int n = 0; n < 2; ++n) scv[bj][n] = (QM == 2) ? *(const f32x4*)(sb + cb + bj * 128 + (PERM ? 4 : 16) * n) : (f32x4){1.f, 1.f, 1.f, 1.f};
}
__device__ __forceinline__ unsigned pk4u8(f32x4 v) { const unsigned a = (unsigned)(v[0] * 255.f + 0.5f), b = (unsigned)(v[1] * 255.f + 0.5f), c = (unsigned)(v[2] * 255.f + 0.5f), d = (unsigned)(v[3] * 255.f + 0.5f); return a | (b << 8) | (c << 16) | (d << 24); }
__device__ __forceinline__ f32x4 un4u8(unsigned w) { return (f32x4){cvt_ub0(w), cvt_ub1(w), cvt_ub2(w), cvt_ub3(w)} * (1.0f / 255.f); }
struct EpiG1 {
    static constexpr bool PERM = true, AFTER_DRAIN = false;
    unsigned char* ws; const float* lbl;
    const float* sa; const float* sb;
    __device__ __forceinline__ void operator()(const f32x4 (&acc)[2][2][4][2], const pg8::Unit& u, int wr, int wc, int fr, int fq) const {
        const int pn = u.pn, row0 = u.pm * 256 + wr * 64 + fr;
        {
            const int grp = pn >> 2; const bool act = (grp == 0) | (grp == 4) | (grp == 8);
            bf16* base = (bf16*)(ws + WS_H + (size_t)grp * 32 * MiB); const int col0 = (pn & 3) * 256 + wc * 32 + 8 * fq;
            f32x4 scv[2][2]; ld_colscale<QM_G1, true>(scv, sb, pn * 256 + wc * 32 + 8 * fq);
            const bool fgate = (grp == 1) | (grp == 2); f32x4 lbv[2][2];
            if (fgate) { const float* l0 = lbl + (grp - 1) * 2048 + col0;
#pragma unroll
                for (int bj = 0; bj < 2; ++bj)
#pragma unroll
                    for (int n = 0; n < 2; ++n) { const f32x4 a0 = *(const f32x4*)(l0 + bj * 128 + 4 * n), a1 = *(const f32x4*)(l0 + 1024 + bj * 128 + 4 * n);
                        lbv[bj][n] = (f32x4){fast_rcp(1.0f + fast_exp(a1[0] - a0[0])), fast_rcp(1.0f + fast_exp(a1[1] - a0[1])), fast_rcp(1.0f + fast_exp(a1[2] - a0[2])), fast_rcp(1.0f + fast_exp(a1[3] - a0[3]))}; } }
#pragma unroll
            for (int ai = 0; ai < 2; ++ai)
#pragma unroll
                for (int m = 0; m < 4; ++m) { bf16* rowp = base + (size_t)(row0 + ai * 128 + m * 16) * HW + col0; const float sr = (QM_G1 == 2) ? sa[row0 + ai * 128 + m * 16] : 1.f;
#pragma unroll
                    for (int bj = 0; bj < 2; ++bj) { f32x4 v0 = deq<QM_G1>(acc[ai][bj][m][0], sr, scv[bj][0]), v1 = deq<QM_G1>(acc[ai][bj][m][1], sr, scv[bj][1]);
                        if (act) { v0 = silu4(v0); v1 = silu4(v1); }
                        if (fgate) { v0 = lbv[bj][0] + (1.0f - lbv[bj][0]) * sigm4(v0); v1 = lbv[bj][1] + (1.0f - lbv[bj][1]) * sigm4(v1); }
                        *(u32x4*)(rowp + bj * 128) = pack8(v0, v1); } }
        }
    }
};
struct EpiGate {
    static constexpr bool PERM = true, AFTER_DRAIN = false;
    unsigned char* O; const float* sa; const float* sb;
    __device__ __forceinline__ void operator()(const f32x4 (&acc)[2][2][4][2], const pg8::Unit& u, int wr, int wc, int fr, int fq) const {
        const int row0 = u.pm * 256 + wr * 64 + fr, col0 = u.pn * 256 + wc * 32 + 8 * fq;
        f32x4 scv[2][2]; ld_colscale<QM_GATE, true>(scv, sb, col0);
#pragma unroll
        for (int ai = 0; ai < 2; ++ai)
#pragma unroll
            for (int m = 0; m < 4; ++m) { unsigned char* rowp = O + (size_t)(row0 + ai * 128 + m * 16) * DM + col0; const float sr = (QM_GATE == 2) ? sa[row0 + ai * 128 + m * 16] : 1.f;
#pragma unroll
                for (int bj = 0; bj < 2; ++bj) { v2u w; w.x = pk4u8(sigm4(deq<QM_GATE>(acc[ai][bj][m][0], sr, scv[bj][0]))); w.y = pk4u8(sigm4(deq<QM_GATE>(acc[ai][bj][m][1], sr, scv[bj][1]))); *(v2u*)(rowp + bj * 128) = w; } }
    }
};
template <int MODE> struct EpiMix {
    static constexpr bool PERM = true, AFTER_DRAIN = false;
    bf16* O; const unsigned char* G; unsigned char* O8;
    const float* sa; const float* sb;
    __device__ __forceinline__ void operator()(const f32x4 (&acc)[2][2][4][2], const pg8::Unit& u, int wr, int wc, int fr, int fq) const {
        const int row0 = u.pm * 256 + wr * 64 + fr, col0 = u.pn * 256 + wc * 32 + 8 * fq;
        f32x4 scv[2][2]; ld_colscale<QM_MIX, true>(scv, sb, col0);
#pragma unroll
        for (int ai = 0; ai < 2; ++ai)
#pragma unroll
            for (int m = 0; m < 4; ++m) { const size_t off = (size_t)(row0 + ai * 128 + m * 16) * DM + col0; const float sr = (QM_MIX == 2) ? sa[row0 + ai * 128 + m * 16] : 1.f;
#pragma unroll
                for (int bj = 0; bj < 2; ++bj) { f32x4 o0, o1; const v2u gw = *(const v2u*)(G + off + bj * 128); const f32x4 g0 = un4u8(gw.x), g1 = un4u8(gw.y);
                    const f32x4 c0 = deq<QM_MIX>(acc[ai][bj][m][0], sr, scv[bj][0]), c1 = deq<QM_MIX>(acc[ai][bj][m][1], sr, scv[bj][1]);
                    if (MODE == 0) { o0 = g0 * c0; o1 = g1 * c1; }
                    else { unpack8(*(const u32x4*)(O + off + bj * 128), o0, o1); o0 = o0 + g0 * c0; o1 = o1 + g1 * c1; }
                    if (MODE == 1 && QM_OUT == 1) { v2u w; w.x = pk4f8(o0[0], o0[1], o0[2], o0[3]); w.y = pk4f8(o1[0], o1[1], o1[2], o1[3]); *(v2u*)(O8 + off + bj * 128) = w; }
                    else *(u32x4*)(O + off + bj * 128) = pack8(o0, o1); } }
    }
};
struct EpiX1 {
    static constexpr bool PERM = false, AFTER_DRAIN = false;
    const float* x; float* out; bf16* xb;
    __device__ __forceinline__ void operator()(const f32x4 (&acc)[2][2][4][2], const pg8::Unit& u, int wr, int wc, int fr, int fq) const {
        const int row0 = u.pm * 256 + wr * 64 + fr, col0 = u.pn * 256 + wc * 32 + 4 * fq;
#pragma unroll
        for (int ai = 0; ai < 2; ++ai)
#pragma unroll
            for (int m = 0; m < 4; ++m) { const size_t off = (size_t)(row0 + ai * 128 + m * 16) * DM + col0;
#pragma unroll
                for (int bj = 0; bj < 2; ++bj)
#pragma unroll
                    for (int n = 0; n < 2; ++n) { const size_t o = off + bj * 128 + n * 16; const f32x4 v = *(const f32x4*)(x + o) + deq<QM_OUT>(acc[ai][bj][m][n], 1.f, (f32x4){1.f, 1.f, 1.f, 1.f});
                        *(v2u*)(xb + o) = pack4(v); } }
    }
};
struct EpiBf {
    static constexpr bool PERM = true, AFTER_DRAIN = false;
    bf16* O;
    __device__ __forceinline__ void operator()(const f32x4 (&acc)[2][2][4][2], const pg8::Unit& u, int wr, int wc, int fr, int fq) const {
        const int row0 = u.pm * 256 + wr * 64 + fr, col0 = u.pn * 256 + wc * 32 + 8 * fq;
#pragma unroll
        for (int ai = 0; ai < 2; ++ai)
#pragma unroll
            for (int m = 0; m < 4; ++m) { bf16* rowp = O + (size_t)(row0 + ai * 128 + m * 16) * DM + col0;
#pragma unroll
                for (int bj = 0; bj < 2; ++bj) *(u32x4*)(rowp + bj * 128) = pack8(acc[ai][bj][m][0], acc[ai][bj][m][1]); }
    }
};
struct EpiF32 {
    static constexpr bool PERM = false, AFTER_DRAIN = false;
    float* C;
    __device__ __forceinline__ void operator()(const f32x4 (&acc)[2][2][4][2], const pg8::Unit& u, int wr, int wc, int fr, int fq) const {
        const int row0 = u.pm * 256 + wr * 64 + fr, col0 = u.pn * 256 + wc * 32 + 4 * fq;
#pragma unroll
        for (int ai = 0; ai < 2; ++ai)
#pragma unroll
            for (int m = 0; m < 4; ++m) { float* rowp = C + (size_t)(row0 + ai * 128 + m * 16) * DM + col0;
#pragma unroll
                for (int bj = 0; bj < 2; ++bj)
#pragma unroll
                    for (int n = 0; n < 2; ++n) *(f32x4*)(rowp + bj * 128 + n * 16) = acc[ai][bj][m][n]; }
    }
};

__device__ __forceinline__ void p1_ab(Frame& F) {
    float* Gab = (float*)(F.ws + WS_GAB);
    const int fr = F.lane & 15, fq = F.lane >> 4, rt = F.wave >> 1, ct = F.wave & 1;
    if (AB_I8) {
        const signed char* XQ = (const signed char*)F.out + DO_XN8; const signed char* Wab = (const signed char*)(F.ws + WS_WAB);
        const float* QX = (const float*)(F.ws + WS_QX); const f32x4 sw = *(const f32x4*)((const float*)(F.ws + WS_QW) + QW_WAB + ct * 16 + 4 * fq);
        for (int blk = F.vcu; blk < SEQ / 64; blk += F.G) {
            const int row = blk * 64 + rt * 16 + fr;
            const signed char* ap = XQ + (size_t)row * DM + 16 * fq; const signed char* bp = Wab + (size_t)(ct * 16 + fr) * DM + 16 * fq;
            i32x4 acc = {0, 0, 0, 0};
#pragma unroll 1
            for (int kb = 0; kb < DM; kb += 1024) { i32x4 af[16], bfr[16];
#pragma unroll
                for (int u = 0; u < 16; ++u) { af[u] = *(const GAS i32x4*)(ap + kb + 64 * u); bfr[u] = *(const GAS i32x4*)(bp + kb + 64 * u); }
                __builtin_amdgcn_sched_barrier(0);
#pragma unroll
                for (int u = 0; u < 16; ++u) acc = __builtin_amdgcn_mfma_i32_16x16x64_i8(bfr[u], af[u], acc, 0, 0, 0);
                __builtin_amdgcn_sched_barrier(0); }
            *(GAS f32x4*)(Gab + (size_t)row * 32 + ct * 16 + 4 * fq) = (f32x4){(float)acc[0], (float)acc[1], (float)acc[2], (float)acc[3]} * (sw * QX[row]);
        }
        return;
    }
    const bf16* XN = (const bf16*)(F.ws + WS_XN); const bf16* Wab = (const bf16*)(F.ws + WS_WAB);
    for (int blk = F.vcu; blk < SEQ / 64; blk += F.G) {
        const bf16* ap = XN + (size_t)(blk * 64 + rt * 16 + fr) * DM + 8 * fq; const bf16* bp = Wab + (size_t)(ct * 16 + fr) * DM + 8 * fq;
        f32x4 acc = {0.f, 0.f, 0.f, 0.f};
#pragma unroll 1
        for (int kb = 0; kb < DM; kb += 512) { bf16x8 af[16], bfr[16];
#pragma unroll
            for (int u = 0; u < 16; ++u) { af[u] = *(const GAS bf16x8*)(ap + kb + 32 * u); bfr[u] = *(const GAS bf16x8*)(bp + kb + 32 * u); }
            __builtin_amdgcn_sched_barrier(0);
#pragma unroll
            for (int u = 0; u < 16; ++u) acc = mfma16(bfr[u], af[u], acc);
            __builtin_amdgcn_sched_barrier(0); }
        *(GAS f32x4*)(Gab + (size_t)(blk * 64 + rt * 16 + fr) * 32 + ct * 16 + 4 * fq) = acc;
    }
}
template <bool PASS3, int SKIP = 0>
__device__ __forceinline__ void hgrn_pass(Frame& F) {
    LAS bf16*  ST  = (LAS bf16*)(F.lds + 0);
    LAS float* LF  = (LAS float*)(F.lds + 0);
    LAS bf16*  QT  = (LAS bf16*)(F.lds + 34816);
    LAS bf16*  KT  = (LAS bf16*)(F.lds + 52224);
    LAS bf16*  KHT = (LAS bf16*)(F.lds + 69632);
    LAS bf16*  VT  = (LAS bf16*)(F.lds + 88064);
    LAS bf16*  ATT = (LAS bf16*)(F.lds + 106496);
    LAS float* PT  = (LAS float*)(F.lds + 115712);
    LAS float* BL  = (LAS float*)(F.lds + 117760);
    LAS float* DKK = (LAS float*)(F.lds + 118272);
    LAS float* LBV = (LAS float*)(F.lds + 118784);
    LAS bf16*  VR  = (LAS bf16*)(F.lds + 119296);
    const int tid = F.tid, lane = F.lane, w = F.wave, fr = lane & 15, fq = lane >> 4;
    const int row = tid >> 3, c0 = (tid & 7) * 16;
    float* HL = (float*)(F.ws + WS_HL); float* HDS = (float*)(F.ws + WS_HDS);
    for (int it = blockIdx.x; it < 256; it += F.G) {
        const int hd = it >> 4, sg = it & 15, dir = hd >> 3, h = hd & 7;
        const bf16* Hq = (const bf16*)(F.ws + WS_H); const bf16* Hf = (const bf16*)(F.ws + WS_H + (size_t)(1 + dir) * 32 * MiB); const bf16* Hi = (const bf16*)(F.ws + WS_H + (size_t)3 * 32 * MiB);
        bf16* Oh = (bf16*)(F.ws + (dir ? WS_OHB : WS_OHF));
        __syncthreads();
        f32x4 Sacc[8];
#pragma unroll
        for (int kt = 0; kt < 8; ++kt) Sacc[kt] = (f32x4){0.f, 0.f, 0.f, 0.f};
        if (PASS3) {
            for (int p = 0; p < sg; ++p) { const int ip = hd * 16 + p; f32x4 dsv[8], lv[8];
#pragma unroll
                for (int kt = 0; kt < 8; ++kt) { dsv[kt] = *(const GAS f32x4*)(HDS + ip * 128 + 16 * kt + 4 * fq); lv[kt] = *(const GAS f32x4*)(HL + ((size_t)((ip * 8 + w) * 8 + kt) * 64 + lane) * 4); }
                __builtin_amdgcn_sched_barrier(0);
#pragma unroll
                for (int kt = 0; kt < 8; ++kt) Sacc[kt] = Sacc[kt] * dsv[kt] + lv[kt];
                __builtin_amdgcn_sched_barrier(0); }
        }
        float sumbl = 1.f;
        v4u rq[2], rf[2], rv[2];
        { const int oc = dir ? 255 - sg * 16 : sg * 16; const size_t off = (size_t)(64 * oc + row) * HW + h * 128 + c0;
          rq[0] = *(const GAS v4u*)(Hq + off); rq[1] = *(const GAS v4u*)(Hq + off + 8); rf[0] = *(const GAS v4u*)(Hf + off); rf[1] = *(const GAS v4u*)(Hf + off + 8); rv[0] = *(const GAS v4u*)(Hi + off); rv[1] = *(const GAS v4u*)(Hi + off + 8); }
        __syncthreads();
        for (int ci = 0; ci < ((SKIP & 4) ? 1 : CPS); ++ci) {
            const int sc = sg * 16 + ci, oc = dir ? 255 - sc : sc, tok0 = 64 * oc;
            float kk[16], qq[16];
            { const unsigned fw[8] = {rf[0].x, rf[0].y, rf[0].z, rf[0].w, rf[1].x, rf[1].y, rf[1].z, rf[1].w};
              const unsigned qw[8] = {rq[0].x, rq[0].y, rq[0].z, rq[0].w, rq[1].x, rq[1].y, rq[1].z, rq[1].w};
              float fgv[16];
#pragma unroll
              for (int e = 0; e < 16; ++e) { fgv[e] = (e & 1) ? bfhi(fw[e >> 1]) : bflo(fw[e >> 1]); qq[e] = (e & 1) ? bfhi(qw[e >> 1]) : bflo(qw[e >> 1]); kk[e] = 1.0f - fgv[e]; }
#pragma unroll
              for (int q4 = 0; q4 < 4; ++q4) *(LAS f32x4*)(LF + row * 132 + c0 + 4 * q4) = (f32x4){fgv[4 * q4], fgv[4 * q4 + 1], fgv[4 * q4 + 2], fgv[4 * q4 + 3]};
              *(LAS v4u*)(VR + row * 136 + c0) = rv[0]; *(LAS v4u*)(VR + row * 136 + c0 + 8) = rv[1]; }
            if (ci + 1 < CPS && !(SKIP & 2)) { const int oc2 = dir ? oc - 1 : oc + 1; const size_t off = (size_t)(64 * oc2 + row) * HW + h * 128 + c0;
              rq[0] = *(const GAS v4u*)(Hq + off); rq[1] = *(const GAS v4u*)(Hq + off + 8); rf[0] = *(const GAS v4u*)(Hf + off); rf[1] = *(const GAS v4u*)(Hf + off + 8); rv[0] = *(const GAS v4u*)(Hi + off); rv[1] = *(const GAS v4u*)(Hi + off + 8); }
            if (!(SKIP & 8)) __syncthreads();
            { const int c = tid & 127, part = tid >> 7, r0 = part * 16; float b[16], fv[16]; float run = 1.f;
#pragma unroll
              for (int i = 0; i < 16; ++i) fv[i] = LF[(r0 + i) * 132 + c];
              if (!dir) {
#pragma unroll
                  for (int i = 0; i < 16; ++i) { run *= fv[i]; b[i] = run; }
              } else {
#pragma unroll
                  for (int i = 15; i >= 0; --i) { run *= fv[i]; b[i] = run; }
              }
              PT[part * 128 + c] = run;
              unsigned short vcol[16];
#pragma unroll
              for (int i = 0; i < 16; ++i) vcol[i] = VR[(r0 + i) * 136 + c];
              if (!(SKIP & 8)) __syncthreads();
              const float p0 = PT[c], p1 = PT[128 + c], p2 = PT[256 + c], p3 = PT[384 + c];
              float offs;
              if (!dir) offs = (part > 0 ? p0 : 1.f) * (part > 1 ? p1 : 1.f) * (part > 2 ? p2 : 1.f);
              else      offs = (part < 3 ? p3 : 1.f) * (part < 2 ? p2 : 1.f) * (part < 1 ? p1 : 1.f);
              const float tot = (p0 * p1) * (p2 * p3);
              unsigned kh[8], vw[8];
#pragma unroll
              for (int i = 0; i < 8; ++i) { const float P0 = b[2 * i] * offs, P1 = b[2 * i + 1] * offs;
                  if (PASS3) { LF[(r0 + 2 * i) * 132 + c] = P0; LF[(r0 + 2 * i + 1) * 132 + c] = P1; }
                  kh[i] = pk2((1.0f - fv[2 * i]) * tot * fast_rcp(P0), (1.0f - fv[2 * i + 1]) * tot * fast_rcp(P1)); vw[i] = (unsigned)vcol[2 * i] | ((unsigned)vcol[2 * i + 1] << 16); }
              *(LAS v4u*)(KHT + c * 72 + r0) = (v4u){kh[0], kh[1], kh[2], kh[3]}; *(LAS v4u*)(KHT + c * 72 + r0 + 8) = (v4u){kh[4], kh[5], kh[6], kh[7]};
              *(LAS v4u*)(VT + c * 72 + r0) = (v4u){vw[0], vw[1], vw[2], vw[3]}; *(LAS v4u*)(VT + c * 72 + r0 + 8) = (v4u){vw[4], vw[5], vw[6], vw[7]};
              if (part == 0) { DKK[c] = tot; sumbl *= tot; }
            }
            if (!(SKIP & 8)) __syncthreads();
            if (PASS3 && !(SKIP & 1)) { float bb[16];
#pragma unroll
              for (int q4 = 0; q4 < 4; ++q4) { const f32x4 t4 = *(const LAS f32x4*)(LF + row * 132 + c0 + 4 * q4); bb[4 * q4] = t4[0]; bb[4 * q4 + 1] = t4[1]; bb[4 * q4 + 2] = t4[2]; bb[4 * q4 + 3] = t4[3]; }
              unsigned qo[8], ko[8];
#pragma unroll
              for (int e = 0; e < 8; ++e) { qo[e] = pk2(qq[2 * e] * bb[2 * e], qq[2 * e + 1] * bb[2 * e + 1]); ko[e] = pk2(kk[2 * e] * fast_rcp(bb[2 * e]), kk[2 * e + 1] * fast_rcp(bb[2 * e + 1])); }
              *(LAS v4u*)(QT + row * 136 + c0) = (v4u){qo[0], qo[1], qo[2], qo[3]}; *(LAS v4u*)(QT + row * 136 + c0 + 8) = (v4u){qo[4], qo[5], qo[6], qo[7]};
              *(LAS v4u*)(KT + row * 136 + c0) = (v4u){ko[0], ko[1], ko[2], ko[3]}; *(LAS v4u*)(KT + row * 136 + c0 + 8) = (v4u){ko[4], ko[5], ko[6], ko[7]};
            }
            if (PASS3) if (!(SKIP & 8)) __syncthreads();
            if (PASS3 && !(SKIP & 1)) {
                { bf16x8 kf[2][4], qf[2][4]; f32x4 acc[2];
#pragma unroll
                  for (int q2 = 0; q2 < 2; ++q2) { const int tl = 2 * w + q2, ti = tl >> 2, tj = tl & 3; acc[q2] = (f32x4){0.f, 0.f, 0.f, 0.f};
#pragma unroll
                      for (int k0 = 0; k0 < 4; ++k0) { kf[q2][k0] = ldfrag(KT, 136, 16 * ti + fr, 32 * k0 + 8 * fq); qf[q2][k0] = ldfrag(QT, 136, 16 * tj + fr, 32 * k0 + 8 * fq); } }
                  __builtin_amdgcn_sched_barrier(0);
#pragma unroll
                  for (int k0 = 0; k0 < 4; ++k0)
#pragma unroll
                      for (int q2 = 0; q2 < 2; ++q2) acc[q2] = mfma16(kf[q2][k0], qf[q2][k0], acc[q2]);
                  __builtin_amdgcn_sched_barrier(0);
#pragma unroll
                  for (int q2 = 0; q2 < 2; ++q2) { const int tl = 2 * w + q2, ti = tl >> 2, tj = tl & 3; const int t = 16 * tj + fr, s0 = 16 * ti + 4 * fq;
#pragma unroll
                      for (int r = 0; r < 4; ++r) { const bool keep = dir ? (s0 + r >= t) : (s0 + r <= t); acc[q2][r] = keep ? acc[q2][r] : 0.f; }
                      *(LAS v2u*)(ATT + t * 72 + s0) = pack4(acc[q2]); } }
#pragma unroll
                for (int kt = 0; kt < 8; ++kt) *(LAS v2u*)(ST + (16 * w + fr) * 136 + 16 * kt + 4 * fq) = pack4(Sacc[kt]);
                if (!(SKIP & 8)) __syncthreads();
            }
            bf16x8 xv[2];
#pragma unroll
            for (int s0 = 0; s0 < 2; ++s0) xv[s0] = ldfrag(VT, 72, 16 * w + fr, 32 * s0 + 8 * fq);
            if (PASS3 && !(SKIP & 1)) {
                bf16x8 xs[4];
#pragma unroll
                for (int k0 = 0; k0 < 4; ++k0) xs[k0] = ldfrag(ST, 136, 16 * w + fr, 32 * k0 + 8 * fq);
#pragma unroll
                for (int th = 0; th < 2; ++th) { bf16x8 qf[2][4], af[2][2]; f32x4 acc[2];
#pragma unroll
                    for (int tq = 0; tq < 2; ++tq) { const int tt = 2 * th + tq; acc[tq] = (f32x4){0.f, 0.f, 0.f, 0.f};
#pragma unroll
                        for (int k0 = 0; k0 < 4; ++k0) qf[tq][k0] = ldfrag(QT, 136, 16 * tt + fr, 32 * k0 + 8 * fq);
#pragma unroll
                        for (int s0 = 0; s0 < 2; ++s0) af[tq][s0] = ldfrag(ATT, 72, 16 * tt + fr, 32 * s0 + 8 * fq); }
                    __builtin_amdgcn_sched_barrier(0);
#pragma unroll
                    for (int k0 = 0; k0 < 4; ++k0)
#pragma unroll
                        for (int tq = 0; tq < 2; ++tq) acc[tq] = mfma16(xs[k0], qf[tq][k0], acc[tq]);
#pragma unroll
                    for (int s0 = 0; s0 < 2; ++s0)
#pragma unroll
                        for (int tq = 0; tq < 2; ++tq) acc[tq] = mfma16(xv[s0], af[tq][s0], acc[tq]);
                    __builtin_amdgcn_sched_barrier(0);
#pragma unroll
                    for (int tq = 0; tq < 2; ++tq) *(GAS v2u*)(Oh + (size_t)(tok0 + 16 * (2 * th + tq) + fr) * HW + h * 128 + 16 * w + 4 * fq) = pack4(acc[tq]); }
            }
#pragma unroll
            for (int kh = 0; kh < ((SKIP & 1) ? 0 : 2); ++kh) { bf16x8 kf[4][2];
#pragma unroll
                for (int kq = 0; kq < 4; ++kq) { const int kt = 4 * kh + kq; const f32x4 d4 = *(const LAS f32x4*)(DKK + 16 * kt + 4 * fq); Sacc[kt] = Sacc[kt] * d4;
#pragma unroll
                    for (int s0 = 0; s0 < 2; ++s0) kf[kq][s0] = ldfrag(KHT, 72, 16 * kt + fr, 32 * s0 + 8 * fq); }
                __builtin_amdgcn_sched_barrier(0);
#pragma unroll
                for (int s0 = 0; s0 < 2; ++s0)
#pragma unroll
                    for (int kq = 0; kq < 4; ++kq) Sacc[4 * kh + kq] = mfma16(kf[kq][s0], xv[s0], Sacc[4 * kh + kq]);
                __builtin_amdgcn_sched_barrier(0); }
            if (!(SKIP & 8)) __syncthreads();
        }
        if (!PASS3) {
#pragma unroll
            for (int kt = 0; kt < 8; ++kt) *(GAS f32x4*)(HL + ((size_t)((it * 8 + w) * 8 + kt) * 64 + lane) * 4) = Sacc[kt];
            if (tid < 128) HDS[it * 128 + tid] = sumbl;
        }
    }
}
template <int SKIP>
__device__ __forceinline__ void gdn_prep(Frame& F) {
    LAS bf16*  QN  = (LAS bf16*)(F.lds + 0);
    LAS bf16*  KN  = (LAS bf16*)(F.lds + 17408);
    LAS bf16*  VT  = (LAS bf16*)(F.lds + 34816);
    LAS bf16*  KNT = (LAS bf16*)(F.lds + 53248);
    LAS float* AD  = (LAS float*)(F.lds + 71680);
    LAS bf16*  AB  = (LAS bf16*)(F.lds + 79872);
    LAS float* RS  = (LAS float*)(F.lds + 150528);
    LAS bf16*  TB  = (LAS bf16*)(F.lds + 104448);
    LAS bf16*  VR  = (LAS bf16*)(F.lds + 104448);
    LAS float* CWL = (LAS float*)(F.lds + 142848);
    LAS float* DEC = (LAS float*)(F.lds + 141312);
    LAS float* BET = DEC + 128;
    LAS float* EXD = DEC + 256;
    const int tid = F.tid, lane = F.lane, w = F.wave, fr = lane & 15, fq = lane >> 4;
    const int row = tid >> 3, c0 = (tid & 7) * 16;
    const bf16* Gq = (const bf16*)(F.ws + WS_H + (size_t)5 * 32 * MiB); const bf16* Gk = (const bf16*)(F.ws + WS_H + (size_t)6 * 32 * MiB); const bf16* Gv = (const bf16*)(F.ws + WS_H + (size_t)7 * 32 * MiB);
    const float* Gab = (const float*)(F.ws + WS_GAB); const float* cw = F.in[I_CONVW];
    unsigned char* dob = (unsigned char*)F.out;
    bf16* QNg = (bf16*)(dob + DO_QN); bf16* KNTg = (bf16*)(dob + DO_KNT); float* GSC = (float*)(F.ws + WS_GSC);
    int hload = -1;
    for (int it = blockIdx.x; it < 2048; it += F.G) {
        const int h = it & 7, oc = it >> 3, tok0 = 64 * oc;
        __syncthreads();
        if (h != hload) { hload = h;
            for (int i = tid; i < 5 * 384; i += NTHR) { const int j = i / 384, r = i % 384; CWL[i] = cw[j * 3072 + (r >> 7) * 1024 + h * 128 + (r & 127)]; }
            __syncthreads(); }
        if (it + F.G < 2048 && tid < 408) { const int it2 = it + F.G, h2 = it2 & 7, oc2 = it2 >> 3; const int tz = tid / 136, rl = tid % 136, r = rl >> 1, half = rl & 1; const int tr = 64 * oc2 - 2 + r;
            if (tr >= 0 && tr < SEQ) { const bf16* src = (tz == 0 ? Gq : tz == 1 ? Gk : Gv) + (size_t)tr * HW + h2 * 128 + half * 64; unsigned tmp = *(const GAS unsigned*)src; asm volatile("" :: "v"(tmp)); } }
        if (tid < 128) { const int dir = tid >> 6, l = tid & 63, pos = dir ? 63 - l : l;
            const float a = Gab[(size_t)(tok0 + pos) * 32 + dir * 8 + h], b = Gab[(size_t)(tok0 + pos) * 32 + 16 + dir * 8 + h];
            const float x = a + F.in[I_DTB][dir * 8 + h]; const float sp = x > 20.f ? x : log1pf(__expf(x));
            float d = -__expf(F.in[I_ALOG][dir * 8 + h]) * sp;
#pragma unroll
            for (int o = 1; o < 64; o <<= 1) { const float t = __shfl_up(d, o); if (l >= o) d += t; }
            DEC[dir * 64 + pos] = d; BET[dir * 64 + pos] = sigmoidf_(b); EXD[dir * 64 + pos] = __expf(d); }
        if (!(SKIP & 64)) { float q[16], k[16], v[16];
#pragma unroll
          for (int e = 0; e < 16; ++e) { q[e] = 0.f; k[e] = 0.f; v[e] = 0.f; }
          const int ch = h * 128 + c0;
#pragma unroll
          for (int j = 0; j < ((SKIP & 1) ? 0 : 5); ++j) { const int tr = tok0 + row + j - 2;
              if (tr >= 0 && tr < SEQ) { const size_t off = (size_t)tr * HW + ch;
                  const v4u xq0 = *(const GAS v4u*)(Gq + off), xq1 = *(const GAS v4u*)(Gq + off + 8), xk0 = *(const GAS v4u*)(Gk + off), xk1 = *(const GAS v4u*)(Gk + off + 8), xv0 = *(const GAS v4u*)(Gv + off), xv1 = *(const GAS v4u*)(Gv + off + 8);
                  const unsigned wq[8] = {xq0.x, xq0.y, xq0.z, xq0.w, xq1.x, xq1.y, xq1.z, xq1.w}, wk[8] = {xk0.x, xk0.y, xk0.z, xk0.w, xk1.x, xk1.y, xk1.z, xk1.w}, wv[8] = {xv0.x, xv0.y, xv0.z, xv0.w, xv1.x, xv1.y, xv1.z, xv1.w};
                  const LAS float* cq = CWL + j * 384 + c0;
#pragma unroll
                  for (int e = 0; e < 16; ++e) { const float fq_ = (e & 1) ? bfhi(wq[e >> 1]) : bflo(wq[e >> 1]), fk_ = (e & 1) ? bfhi(wk[e >> 1]) : bflo(wk[e >> 1]), fv_ = (e & 1) ? bfhi(wv[e >> 1]) : bflo(wv[e >> 1]);
                      q[e] += cq[e] * fq_; k[e] += cq[128 + e] * fk_; v[e] += cq[256 + e] * fv_; } } }
          float sq = 0.f, sk = 0.f;
#pragma unroll
          for (int e = 0; e < 16; ++e) { q[e] = siluf_(q[e]); k[e] = siluf_(k[e]); v[e] = siluf_(v[e]); sq += q[e] * q[e]; sk += k[e] * k[e]; }
          sq += __shfl_xor(sq, 1); sq += __shfl_xor(sq, 2); sq += __shfl_xor(sq, 4); sk += __shfl_xor(sk, 1); sk += __shfl_xor(sk, 2); sk += __shfl_xor(sk, 4);
          const float rq = 0.08838834764831845f / sqrtf(sq + EPS), rk = 1.0f / sqrtf(sk + EPS);
          unsigned qo[8], ko[8];
#pragma unroll
          for (int e = 0; e < 8; ++e) { qo[e] = pk2(q[2 * e] * rq, q[2 * e + 1] * rq); ko[e] = pk2(k[2 * e] * rk, k[2 * e + 1] * rk); }
          const v4u q0 = {qo[0], qo[1], qo[2], qo[3]}, q1 = {qo[4], qo[5], qo[6], qo[7]}, k0_ = {ko[0], ko[1], ko[2], ko[3]}, k1_ = {ko[4], ko[5], ko[6], ko[7]};
          *(LAS v4u*)(QN + row * 136 + c0) = q0; *(LAS v4u*)(QN + row * 136 + c0 + 8) = q1; *(LAS v4u*)(KN + row * 136 + c0) = k0_; *(LAS v4u*)(KN + row * 136 + c0 + 8) = k1_;
          if (!(SKIP & 16)) { *(GAS v4u*)(QNg + (size_t)(tok0 + row) * HW + ch) = q0; *(GAS v4u*)(QNg + (size_t)(tok0 + row) * HW + ch + 8) = q1; }
          unsigned vo[8];
#pragma unroll
          for (int e = 0; e < 8; ++e) vo[e] = pk2(v[2 * e], v[2 * e + 1]);
          *(LAS v4u*)(VR + row * 136 + c0) = (v4u){vo[0], vo[1], vo[2], vo[3]}; *(LAS v4u*)(VR + row * 136 + c0 + 8) = (v4u){vo[4], vo[5], vo[6], vo[7]};
        }
        __syncthreads();
        { const int c = tid & 127, r0 = (tid >> 7) * 16; unsigned vw[8], kw[8];
#pragma unroll
          for (int i = 0; i < 8; ++i) { vw[i] = (unsigned)VR[(r0 + 2 * i) * 136 + c] | ((unsigned)VR[(r0 + 2 * i + 1) * 136 + c] << 16); kw[i] = (unsigned)KN[(r0 + 2 * i) * 136 + c] | ((unsigned)KN[(r0 + 2 * i + 1) * 136 + c] << 16); }
          *(LAS v4u*)(VT + c * 72 + r0) = (v4u){vw[0], vw[1], vw[2], vw[3]}; *(LAS v4u*)(VT + c * 72 + r0 + 8) = (v4u){vw[4], vw[5], vw[6], vw[7]};
          *(LAS v4u*)(KNT + c * 72 + r0) = (v4u){kw[0], kw[1], kw[2], kw[3]}; *(LAS v4u*)(KNT + c * 72 + r0 + 8) = (v4u){kw[4], kw[5], kw[6], kw[7]}; }
#pragma unroll
        for (int q2 = 0; q2 < ((SKIP & 8) ? 0 : 2); ++q2) { const int tl = 2 * w + q2, ti = tl >> 2, tj = tl & 3; f32x4 kkv = {0.f, 0.f, 0.f, 0.f}, qkv = {0.f, 0.f, 0.f, 0.f};
#pragma unroll
            for (int k0 = 0; k0 < 4; ++k0) { const bf16x8 xs = ldfrag(KN, 136, 16 * ti + fr, 32 * k0 + 8 * fq);
                kkv = mfma16(xs, ldfrag(KN, 136, 16 * tj + fr, 32 * k0 + 8 * fq), kkv); qkv = mfma16(xs, ldfrag(QN, 136, 16 * tj + fr, 32 * k0 + 8 * fq), qkv); }
            int fr2 = lane & 15, fq2 = lane >> 4; asm volatile("" : "+v"(fr2), "+v"(fq2));
            const int t = 16 * tj + fr2, s0 = 16 * ti + 4 * fq2;
#pragma unroll
            for (int dir = 0; dir < 2; ++dir) { const float dt = DEC[dir * 64 + t], bt = BET[dir * 64 + t]; f32x4 aq, av;
#pragma unroll
                for (int r = 0; r < 4; ++r) { const int s = s0 + r; const bool before = dir ? (s > t) : (s < t), beq = before || (s == t);
                    const float e = beq ? __expf(dt - DEC[dir * 64 + s]) : 0.f;
                    av[r] = before ? bt * kkv[r] * e : 0.f; aq[r] = qkv[r] * e;
                    if (ti == tj) AD[(dir * 4 + (dir ? 3 - ti : ti)) * 256 + (dir ? (15 - (s & 15)) * 16 + (15 - fr2) : (s & 15) * 16 + fr2)] = av[r]; }
                *(LAS v2u*)(AB + dir * 64 * 72 + (dir ? (63 - t) * 72 + 60 - s0 : t * 72 + s0)) = dir ? pack4((f32x4){av[3], av[2], av[1], av[0]}) : pack4(av);
                bf16* AQg = (bf16*)(dob + (dir ? DO_AQKB : DO_AQKF));
                if (!(SKIP & 16)) *(GAS v2u*)(AQg + ((size_t)(h * 256 + oc) * 64 + t) * 64 + s0) = pack4(aq); } }
        __syncthreads();
        if (SKIP & 32) {} else if (w < 2) { const int dir = w; int c = lane; asm volatile("" : "+v"(c));
            const LAS bf16* ABd = AB + dir * 64 * 72; LAS bf16* TT = TB + (dir * 2 + 1) * 64 * 72; LAS float* RSd = RS + dir * 1024; const LAS float* ADd = AD + dir * 1024;
#pragma unroll
            for (int q = 0; q < 9; ++q) *(LAS v4u*)(TT + (q * 64 + c) * 8) = (v4u){0u, 0u, 0u, 0u};
            int fr3 = c & 15, fq3 = c >> 4;
            float t[64];
#pragma unroll
            for (int bi = 0; bi < 4; ++bi) { float r[16];
#pragma unroll
                for (int ii = 0; ii < 16; ++ii) r[ii] = (16 * bi + ii == c) ? 1.f : 0.f;
                if (!(SKIP & 2)) {
                if (bi > 0) {
#pragma unroll
                    for (int ct = 0; ct < 4; ++ct) { f32x4 d = {0.f, 0.f, 0.f, 0.f};
#pragma unroll
                        for (int ks = 0; ks < (16 * bi + 31) / 32; ++ks) d = mfma16(ldfrag(ABd, 72, 16 * bi + fr3, 32 * ks + 8 * fq3), ldfrag(TT, 72, 16 * ct + fr3, 32 * ks + 8 * fq3), d);
                        *(LAS f32x4*)(RSd + (16 * ct + fr3) * 16 + 4 * fq3) = d; }
                    __builtin_amdgcn_sched_barrier(0);
                    f32x4 o4[4];
#pragma unroll
                    for (int q4 = 0; q4 < 4; ++q4) o4[q4] = *(const LAS f32x4*)(RSd + c * 16 + 4 * q4);
#pragma unroll
                    for (int q4 = 0; q4 < 4; ++q4) { r[4 * q4] -= o4[q4][0]; r[4 * q4 + 1] -= o4[q4][1]; r[4 * q4 + 2] -= o4[q4][2]; r[4 * q4 + 3] -= o4[q4][3]; }
                }
#pragma unroll
                for (int jg = 0; jg < 4; ++jg) { f32x4 av[4][4];
#pragma unroll
                    for (int jq = 0; jq < 4; ++jq)
#pragma unroll
                        for (int q4 = jg; q4 < 4; ++q4) av[jq][q4] = *(const LAS f32x4*)(ADd + bi * 256 + (4 * jg + jq) * 16 + 4 * q4);
                    __builtin_amdgcn_sched_barrier(0);
#pragma unroll
                    for (int jq = 0; jq < 4; ++jq) { const int jj = 4 * jg + jq; t[16 * bi + jj] = r[jj];
#pragma unroll
                        for (int q4 = jg; q4 < 4; ++q4)
#pragma unroll
                            for (int e = 0; e < 4; ++e) if (4 * q4 + e > jj) r[4 * q4 + e] -= av[jq][q4][e] * r[jj]; }
                    __builtin_amdgcn_sched_barrier(0); }
                if (bi < 3) { unsigned tw[8];
#pragma unroll
                    for (int e = 0; e < 8; ++e) tw[e] = pk2(t[16 * bi + 2 * e], t[16 * bi + 2 * e + 1]);
                    *(LAS v4u*)(TT + c * 72 + 16 * bi) = (v4u){tw[0], tw[1], tw[2], tw[3]}; *(LAS v4u*)(TT + c * 72 + 16 * bi + 8) = (v4u){tw[4], tw[5], tw[6], tw[7]}; }
                } else {
#pragma unroll
                for (int jj = 0; jj < 16; ++jj) t[16 * bi + jj] = r[jj]; }
            }
            const int tc = dir ? 63 - c : c; const float bc = BET[dir * 64 + tc], bd = bc * EXD[dir * 64 + tc];
            LAS bf16* T0 = TB + (dir * 2 + 0) * 64 * 72 + tc + (dir ? 63 * 72 : 0); const int tstep = dir ? -72 : 72;
#pragma unroll
            for (int i = 0; i < 64; ++i) { T0[i * tstep] = (bf16)f2bf(t[i] * bc); T0[64 * 72 + i * tstep] = (bf16)f2bf(t[i] * bd); }
        } else {
            for (int idx = tid - 128; idx < ((SKIP & 16) ? 0 : 1024); idx += 384) { const int r = idx >> 3, c8 = idx & 7; *(GAS v4u*)(KNTg + ((size_t)(h * 256 + oc) * 128 + r) * 64 + c8 * 8) = *(const LAS v4u*)(KNT + r * 72 + c8 * 8); }
            if (tid >= 128 && tid < 256) { const int dir = (tid - 128) >> 6, t = tid & 63; const float dl = dir ? DEC[64] : DEC[63];
                float* g = GSC + (size_t)((dir * 8 + h) * 256 + oc) * 192; g[t] = EXD[dir * 64 + t]; g[64 + t] = __expf(dl - DEC[dir * 64 + t]); if (t == 0) g[128] = __expf(dl); }
        }
        __syncthreads();
#pragma unroll 1
        for (int n = 0; n < ((SKIP & 4) ? 0 : 16); ++n) { const int qi = w * 16 + n, dir = qi >> 6, kind = (qi >> 5) & 1, idx = qi & 31; f32x4 acc = {0.f, 0.f, 0.f, 0.f};
            const LAS bf16* Tm = TB + (dir * 2 + kind) * 64 * 72; const size_t cb = (size_t)(h * 256 + oc) * 8192;
            if (kind == 0) { const int ti = idx >> 3, vj = idx & 7;
#pragma unroll
                for (int s0 = 0; s0 < 2; ++s0) acc = mfma16(ldfrag(Tm, 72, 16 * ti + fr, 32 * s0 + 8 * fq), ldfrag(VT, 72, 16 * vj + fr, 32 * s0 + 8 * fq), acc);
                bf16* U = (bf16*)(F.ws + (dir ? WS_UTB : WS_UTF)); if (!(SKIP & 16)) *(GAS v2u*)(U + cb + (16 * vj + fr) * 64 + 16 * ti + 4 * fq) = pack4(acc);
            } else { const int ki = idx >> 2, tj = idx & 3;
#pragma unroll
                for (int s0 = 0; s0 < 2; ++s0) acc = mfma16(ldfrag(KNT, 72, 16 * ki + fr, 32 * s0 + 8 * fq), ldfrag(Tm, 72, 16 * tj + fr, 32 * s0 + 8 * fq), acc);
                bf16* W = (bf16*)(F.ws + (dir ? WS_WB : WS_WF)); if (!(SKIP & 16)) *(GAS v2u*)(W + cb + (16 * tj + fr) * 128 + 16 * ki + 4 * fq) = pack4(acc); }
        }
    }
}
__device__ __forceinline__ void gdn_load_tiles(const unsigned char* ws, const unsigned char* dob, int tid, int dir, int hd, int h, int oc, bool pass3, v4u (&rw)[2], v4u (&rq)[2], v4u (&ru)[2], v4u (&rk)[2], v4u& ra, float& rs) {
    const size_t cb = (size_t)(h * 256 + oc);
    const int row = tid >> 3, c0 = (tid & 7) * 16, vrow = tid >> 2, t0 = (tid & 3) * 16;
    const bf16* W = (const bf16*)(ws + (dir ? WS_WB : WS_WF)) + cb * 8192 + row * 128 + c0; rw[0] = *(const GAS v4u*)W; rw[1] = *(const GAS v4u*)(W + 8);
    const bf16* U = (const bf16*)(ws + (dir ? WS_UTB : WS_UTF)) + cb * 8192 + vrow * 64 + t0; ru[0] = *(const GAS v4u*)U; ru[1] = *(const GAS v4u*)(U + 8);
    const bf16* Kt = (const bf16*)(dob + DO_KNT) + (size_t)(h * 256 + oc) * 8192 + vrow * 64 + t0; rk[0] = *(const GAS v4u*)Kt; rk[1] = *(const GAS v4u*)(Kt + 8);
    if (pass3) {
        const bf16* Q = (const bf16*)(dob + DO_QN) + (size_t)(64 * oc + row) * HW + h * 128 + c0; rq[0] = *(const GAS v4u*)Q; rq[1] = *(const GAS v4u*)(Q + 8);
        const bf16* A = (const bf16*)(dob + (dir ? DO_AQKB : DO_AQKF)) + cb * 4096 + row * 64 + (tid & 7) * 8; ra = *(const GAS v4u*)A;
    }
    rs = (tid < 192) ? ((const float*)(ws + WS_GSC))[(size_t)(hd * 256 + oc) * 192 + tid] : 0.f;
}
#define SCHED_FENCE() __builtin_amdgcn_sched_barrier(0)
template <bool PASS3, bool UREAL>
__device__ __forceinline__ void gdn_tile(f32x4 (&A)[8], const LAS bf16* WTL, const LAS bf16* QNL, const LAS bf16* UTL, const LAS bf16* KTL, const LAS bf16* AQL, const LAS float* SCL,
                                         LAS bf16* ST, LAS bf16* VN, LAS bf16* VNS, int w, int fr, int fq, float gl, bf16* Ogc) {
#pragma unroll
    for (int kt = 0; kt < 8; ++kt) *(LAS v2u*)(ST + fr * 136 + 16 * kt + 4 * fq) = pack4(A[kt]);
    asm volatile("" ::: "memory");
    bf16x8 xs[4];
#pragma unroll
    for (int k0 = 0; k0 < 4; ++k0) xs[k0] = ldfrag(ST, 136, fr, 32 * k0 + 8 * fq);
#pragma unroll
    for (int th = 0; th < 2; ++th) { bf16x8 wf[2][4]; f32x4 acc[2]; v2u uw[2]; f32x4 es[2];
#pragma unroll
      for (int tq = 0; tq < 2; ++tq) { const int tt = 2 * th + tq;
#pragma unroll
          for (int k0 = 0; k0 < 4; ++k0) wf[tq][k0] = ldfrag(WTL, 136, 16 * tt + fr, 32 * k0 + 8 * fq);
          if (UREAL) uw[tq] = *(const LAS v2u*)(UTL + (16 * w + fr) * 72 + 16 * tt + 4 * fq);
          es[tq] = *(const LAS f32x4*)(SCL + 64 + 16 * tt + 4 * fq); acc[tq] = (f32x4){0.f, 0.f, 0.f, 0.f}; }
      SCHED_FENCE();
#pragma unroll
      for (int k0 = 0; k0 < 4; ++k0)
#pragma unroll
          for (int tq = 0; tq < 2; ++tq) acc[tq] = mfma16(wf[tq][k0], xs[k0], acc[tq]);
      SCHED_FENCE();
#pragma unroll
      for (int tq = 0; tq < 2; ++tq) { const int tt = 2 * th + tq; f32x4 u4 = {0.f, 0.f, 0.f, 0.f};
          if (UREAL) u4 = (f32x4){bflo(uw[tq].x), bfhi(uw[tq].x), bflo(uw[tq].y), bfhi(uw[tq].y)};
          const f32x4 vn = u4 - acc[tq];
          if (PASS3) *(LAS v2u*)(VN + fr * 72 + 16 * tt + 4 * fq) = pack4(vn);
          *(LAS v2u*)(VNS + fr * 72 + 16 * tt + 4 * fq) = pack4(vn * es[tq]); }
      SCHED_FENCE(); }
    asm volatile("" ::: "memory");
    if (PASS3) { bf16x8 yv[2];
#pragma unroll
        for (int s0 = 0; s0 < 2; ++s0) yv[s0] = ldfrag(VN, 72, fr, 32 * s0 + 8 * fq);
#pragma unroll
        for (int th = 0; th < 2; ++th) { bf16x8 qf[2][4], af[2][2]; f32x4 acc[2]; float ed[2];
#pragma unroll
            for (int tq = 0; tq < 2; ++tq) { const int tt = 2 * th + tq;
#pragma unroll
                for (int k0 = 0; k0 < 4; ++k0) qf[tq][k0] = ldfrag(QNL, 136, 16 * tt + fr, 32 * k0 + 8 * fq);
#pragma unroll
                for (int s0 = 0; s0 < 2; ++s0) af[tq][s0] = ldfrag(AQL, 72, 16 * tt + fr, 32 * s0 + 8 * fq);
                ed[tq] = SCL[16 * tt + fr]; acc[tq] = (f32x4){0.f, 0.f, 0.f, 0.f}; }
            SCHED_FENCE();
#pragma unroll
            for (int k0 = 0; k0 < 4; ++k0)
#pragma unroll
                for (int tq = 0; tq < 2; ++tq) acc[tq] = mfma16(xs[k0], qf[tq][k0], acc[tq]);
#pragma unroll
            for (int tq = 0; tq < 2; ++tq) acc[tq] = acc[tq] * ed[tq];
#pragma unroll
            for (int s0 = 0; s0 < 2; ++s0)
#pragma unroll
                for (int tq = 0; tq < 2; ++tq) acc[tq] = mfma16(yv[s0], af[tq][s0], acc[tq]);
            SCHED_FENCE();
#pragma unroll
            for (int tq = 0; tq < 2; ++tq) *(GAS v2u*)(Ogc + (size_t)(16 * (2 * th + tq) + fr) * HW + 16 * w + 4 * fq) = pack4(acc[tq]);
            SCHED_FENCE(); } }
    { bf16x8 ys[2];
#pragma unroll
      for (int s0 = 0; s0 < 2; ++s0) ys[s0] = ldfrag(VNS, 72, fr, 32 * s0 + 8 * fq);
#pragma unroll
      for (int kh = 0; kh < 2; ++kh) { bf16x8 kf[4][2];
#pragma unroll
          for (int kq = 0; kq < 4; ++kq)
#pragma unroll
              for (int s0 = 0; s0 < 2; ++s0) kf[kq][s0] = ldfrag(KTL, 72, 16 * (4 * kh + kq) + fr, 32 * s0 + 8 * fq);
#pragma unroll
          for (int kq = 0; kq < 4; ++kq) A[4 * kh + kq] = A[4 * kh + kq] * gl;
          SCHED_FENCE();
#pragma unroll
          for (int s0 = 0; s0 < 2; ++s0)
#pragma unroll
              for (int kq = 0; kq < 4; ++kq) A[4 * kh + kq] = mfma16(kf[kq][s0], ys[s0], A[4 * kh + kq]);
          SCHED_FENCE(); } }
}
template <bool PASS3, int SKIP = 0>
__device__ __forceinline__ void gdn_pass(Frame& F) {
    LAS bf16*  WTL = (LAS bf16*)(F.lds + 0);
    LAS bf16*  QNL = (LAS bf16*)(F.lds + 17408);
    LAS bf16*  UTL = (LAS bf16*)(F.lds + 34816);
    LAS bf16*  KTL = (LAS bf16*)(F.lds + 53248);
    LAS bf16*  AQL = (LAS bf16*)(F.lds + 71680);
    LAS float* SCL = (LAS float*)(F.lds + 80896);
    LAS bf16*  PX  = (LAS bf16*)(F.lds + 0);
    const int tid = F.tid, lane = F.lane, w = F.wave, fr = lane & 15, fq = lane >> 4;
    LAS bf16* ST  = (LAS bf16*)(F.lds + 81920 + w * 8960);
    LAS bf16* VN  = ST + 16 * 136;
    LAS bf16* VNS = VN + 16 * 72;
    const int row = tid >> 3, c0 = (tid & 7) * 16, vrow = tid >> 2, t0 = (tid & 3) * 16;
    const unsigned char* dob = (const unsigned char*)F.out;
    float* GL = (float*)(F.ws + WS_GL); bf16* GP = (bf16*)(F.ws + WS_GP);
    for (int it = blockIdx.x; it < 256; it += F.G) {
        const int hd = it >> 4, sg = it & 15, dir = hd >> 3, h = hd & 7;
        bf16* Og = (bf16*)(F.ws + (dir ? WS_OGB : WS_OGF));
        f32x4 Sacc[8], Pacc[8];
        int dgi = 16 * w + fr - 4 * fq; asm volatile("" : "+v"(dgi));
#pragma unroll
        for (int kt = 0; kt < 8; ++kt) { Sacc[kt] = (f32x4){0.f, 0.f, 0.f, 0.f};
#pragma unroll
            for (int r = 0; r < 4; ++r) Pacc[kt][r] = (!PASS3 && (16 * kt + r == dgi)) ? 1.f : 0.f; }
        __syncthreads();
        if (PASS3) {
            for (int p = 0; p < sg; ++p) { const int ip = hd * 16 + p;
                { const bf16* src = GP + (size_t)ip * 16384 + vrow * 128 + (tid & 3) * 32;
#pragma unroll
                  for (int q = 0; q < 4; ++q) *(LAS v4u*)(PX + vrow * 136 + (tid & 3) * 32 + 8 * q) = *(const GAS v4u*)(src + 8 * q); }
#pragma unroll
                for (int kt = 0; kt < 8; ++kt) *(LAS v2u*)(ST + fr * 136 + 16 * kt + 4 * fq) = pack4(Sacc[kt]);
                __syncthreads();
                bf16x8 xs[4];
#pragma unroll
                for (int k0 = 0; k0 < 4; ++k0) xs[k0] = ldfrag(ST, 136, fr, 32 * k0 + 8 * fq);
#pragma unroll
                for (int kh = 0; kh < 2; ++kh) { bf16x8 pf[4][4]; f32x4 acc[4];
#pragma unroll
                    for (int kq = 0; kq < 4; ++kq) { const int kt = 4 * kh + kq; acc[kq] = *(const GAS f32x4*)(GL + ((size_t)((ip * 8 + w) * 8 + kt) * 64 + lane) * 4);
#pragma unroll
                        for (int k0 = 0; k0 < 4; ++k0) pf[kq][k0] = ldfrag(PX, 136, 16 * kt + fr, 32 * k0 + 8 * fq); }
                    SCHED_FENCE();
#pragma unroll
                    for (int k0 = 0; k0 < 4; ++k0)
#pragma unroll
                        for (int kq = 0; kq < 4; ++kq) acc[kq] = mfma16(pf[kq][k0], xs[k0], acc[kq]);
                    SCHED_FENCE();
#pragma unroll
                    for (int kq = 0; kq < 4; ++kq) Sacc[4 * kh + kq] = acc[kq]; }
                __syncthreads();
            }
        }
        v4u rw[2], rq[2], ru[2], rk[2], ra; float rs;
        gdn_load_tiles(F.ws, dob, tid, dir, hd, h, dir ? 255 - sg * 16 : sg * 16, PASS3, rw, rq, ru, rk, ra, rs);
        for (int ci = 0; ci < CPS; ++ci) {
            const int sc = sg * 16 + ci, oc = dir ? 255 - sc : sc, tok0 = 64 * oc;
            *(LAS v4u*)(WTL + row * 136 + c0) = rw[0]; *(LAS v4u*)(WTL + row * 136 + c0 + 8) = rw[1];
            *(LAS v4u*)(UTL + vrow * 72 + t0) = ru[0]; *(LAS v4u*)(UTL + vrow * 72 + t0 + 8) = ru[1];
            *(LAS v4u*)(KTL + vrow * 72 + t0) = rk[0]; *(LAS v4u*)(KTL + vrow * 72 + t0 + 8) = rk[1];
            if (PASS3) { *(LAS v4u*)(QNL + row * 136 + c0) = rq[0]; *(LAS v4u*)(QNL + row * 136 + c0 + 8) = rq[1]; *(LAS v4u*)(AQL + row * 72 + (tid & 7) * 8) = ra; }
            if (tid < 192) SCL[tid] = rs;
            __syncthreads();
            if (ci + 1 < CPS && !(SKIP & 1)) gdn_load_tiles(F.ws, dob, tid, dir, hd, h, dir ? oc - 1 : oc + 1, PASS3, rw, rq, ru, rk, ra, rs);
            const float gl = SCL[128];
            gdn_tile<PASS3, true>(Sacc, WTL, QNL, UTL, KTL, AQL, SCL, ST, VN, VNS, w, fr, fq, gl, Og + (size_t)tok0 * HW + h * 128);
            if (!PASS3) gdn_tile<PASS3, false>(Pacc, WTL, QNL, UTL, KTL, AQL, SCL, ST, VN, VNS, w, fr, fq, gl, Og);
            __syncthreads();
        }
        if (!PASS3) {
            int pofs = (4 * fq) * 128 + 16 * w + fr; asm volatile("" : "+v"(pofs));
            bf16* gp = GP + (size_t)it * 16384 + pofs;
#pragma unroll
            for (int kt = 0; kt < 8; ++kt) { *(GAS f32x4*)(GL + ((size_t)((it * 8 + w) * 8 + kt) * 64 + lane) * 4) = Sacc[kt];
#pragma unroll
                for (int r = 0; r < 4; ++r) gp[(16 * kt + r) * 128] = (bf16)f2bf(Pacc[kt][r]); }
        }
    }
}
__device__ __forceinline__ void p7_mix(Frame& F) {
    const int gw = F.vcu * NWAVES + F.wave, NGW = F.G * NWAVES, lane = F.lane;
    const int e0 = (lane & 7) * 16, col = (lane >> 3) * 128 + e0;
    for (int m = gw; m < SEQ; m += NGW) {
#pragma unroll
        for (int mx = 0; mx < 2; ++mx) {
            const bf16* of = (const bf16*)(F.ws + (mx ? WS_OGF : WS_OHF)); const bf16* ob = (const bf16*)(F.ws + (mx ? WS_OGB : WS_OHB));
            const bf16* gt = (const bf16*)(F.ws + WS_H + (size_t)(mx ? 8 : 4) * 32 * MiB); const float* nw = F.in[mx ? I_GNW : I_HNW];
            bf16* yo = (bf16*)(F.ws + (mx ? WS_YB : WS_YA));
            const size_t off = (size_t)m * HW + col;
            const v4u a0 = *(const GAS v4u*)(of + off), a1 = *(const GAS v4u*)(of + off + 8), b0 = *(const GAS v4u*)(ob + off), b1 = *(const GAS v4u*)(ob + off + 8), g0 = *(const GAS v4u*)(gt + off), g1 = *(const GAS v4u*)(gt + off + 8);
            const unsigned aw[8] = {a0.x, a0.y, a0.z, a0.w, a1.x, a1.y, a1.z, a1.w}, bw[8] = {b0.x, b0.y, b0.z, b0.w, b1.x, b1.y, b1.z, b1.w}, gw_[8] = {g0.x, g0.y, g0.z, g0.w, g1.x, g1.y, g1.z, g1.w};
            float o[16]; float ss = 0.f;
#pragma unroll
            for (int e = 0; e < 8; ++e) { o[2 * e] = bflo(aw[e]) + bflo(bw[e]); o[2 * e + 1] = bfhi(aw[e]) + bfhi(bw[e]); ss += o[2 * e] * o[2 * e] + o[2 * e + 1] * o[2 * e + 1]; }
            ss += __shfl_xor(ss, 1); ss += __shfl_xor(ss, 2); ss += __shfl_xor(ss, 4);
            const float r = 1.0f / sqrtf(ss * (1.f / 128.f) + EPS);
            if (QM_MIX == 2) { float yv[16]; float am = 0.f;
#pragma unroll
                for (int e = 0; e < 8; ++e) { yv[2 * e] = o[2 * e] * r * nw[e0 + 2 * e] * bflo(gw_[e]); yv[2 * e + 1] = o[2 * e + 1] * r * nw[e0 + 2 * e + 1] * bfhi(gw_[e]); am = fmaxf(am, fmaxf(fabsf(yv[2 * e]), fabsf(yv[2 * e + 1]))); }
                am = wave_max(am); const float inv = am > 0.f ? 127.0f / am : 0.f;
                *(GAS v4u*)((unsigned char*)yo + off) = (v4u){pk4i8((f32x4){yv[0], yv[1], yv[2], yv[3]}, inv), pk4i8((f32x4){yv[4], yv[5], yv[6], yv[7]}, inv), pk4i8((f32x4){yv[8], yv[9], yv[10], yv[11]}, inv), pk4i8((f32x4){yv[12], yv[13], yv[14], yv[15]}, inv)};
                if (lane == 0) ((float*)(F.ws + WS_QX))[(1 + mx) * SEQ + m] = am > 0.f ? am * (1.0f / 127.0f) : 1.0f; }
            else if (QM_MIX == 1) { unsigned yq[4];
#pragma unroll
                for (int e = 0; e < 4; ++e) yq[e] = pk4f8(o[4 * e] * r * nw[e0 + 4 * e] * bflo(gw_[2 * e]), o[4 * e + 1] * r * nw[e0 + 4 * e + 1] * bfhi(gw_[2 * e]), o[4 * e + 2] * r * nw[e0 + 4 * e + 2] * bflo(gw_[2 * e + 1]), o[4 * e + 3] * r * nw[e0 + 4 * e + 3] * bfhi(gw_[2 * e + 1]));
                *(GAS v4u*)((unsigned char*)yo + off) = (v4u){yq[0], yq[1], yq[2], yq[3]}; }
            else { unsigned yw[8];
#pragma unroll
            for (int e = 0; e < 8; ++e) yw[e] = pk2(o[2 * e] * r * nw[e0 + 2 * e] * bflo(gw_[e]), o[2 * e + 1] * r * nw[e0 + 2 * e + 1] * bfhi(gw_[e]));
            *(GAS v4u*)(yo + off) = (v4u){yw[0], yw[1], yw[2], yw[3]}; *(GAS v4u*)(yo + off + 8) = (v4u){yw[4], yw[5], yw[6], yw[7]}; }
        }
    }
    for (int tb = 0; tb < 2; ++tb) { const float* src = F.in[tb ? I_PV : I_PU]; unsigned char* dst = F.ws + (tb ? WS_TV : WS_TU); float* scl = (float*)(F.ws + WS_PSC) + tb * 16384;
        for (int r = gw; r < 16384; r += NGW) { const float* row = src + (size_t)r * DM; f32x4 v[8]; float mx = 0.f;
#pragma unroll
            for (int q = 0; q < 8; ++q) { v[q] = *(const GAS f32x4*)(row + (tb ? (q >> 2) * 1024 + lane * 16 + 4 * (q & 3) : lane * 32 + 4 * q)); const f32x4 a = __builtin_elementwise_abs(v[q]); mx = fmaxf(mx, fmaxf(fmaxf(a.x, a.y), fmaxf(a.z, a.w))); }
            mx = wave_max(mx);
            const float sc = mx > 0.f ? mx * (tb ? (VFMT == 6 ? 1.0f / 7.5f : 1.0f / 256.0f) : 1.0f / 127.0f) : 1.0f, inv = 1.0f / sc;
            if (tb && VFMT == 6) { v16f a16, b16;
#pragma unroll
                for (int q = 0; q < 4; ++q) { a16[4 * q] = v[q].x * inv; a16[4 * q + 1] = v[q].y * inv; a16[4 * q + 2] = v[q].z * inv; a16[4 * q + 3] = v[q].w * inv;
                    b16[4 * q] = v[4 + q].x * inv; b16[4 * q + 1] = v[4 + q].y * inv; b16[4 * q + 2] = v[4 + q].z * inv; b16[4 * q + 3] = v[4 + q].w * inv; }
                const v6u pk = __builtin_amdgcn_cvt_scalef32_2xpk16_fp6_f32(a16, b16, 1.0f);
                *(GAS v4u*)(dst + (size_t)r * TV_PITCH + lane * 16) = (v4u){pk[0], pk[1], pk[2], pk[3]}; *(GAS v2u*)(dst + (size_t)r * TV_PITCH + 1024 + lane * 8) = (v2u){pk[4], pk[5]};
                if (lane == 0) scl[r] = sc;
                continue; }
            unsigned w[8];
#pragma unroll
            for (int q = 0; q < 8; ++q) { const f32x4 x = v[q];
                if (tb) w[q] = pk4f8(x.x * inv, x.y * inv, x.z * inv, x.w * inv);
                else { const int a = (int)rintf(x.x * inv), b = (int)rintf(x.y * inv), c = (int)rintf(x.z * inv), d = (int)rintf(x.w * inv);
                    w[q] = (unsigned)(a & 255) | ((unsigned)(b & 255) << 8) | ((unsigned)(c & 255) << 16) | ((unsigned)(d & 255) << 24); } }
            if (tb) { *(GAS v4u*)(dst + (size_t)r * DM + lane * 16) = (v4u){w[0], w[1], w[2], w[3]}; *(GAS v4u*)(dst + (size_t)r * DM + 1024 + lane * 16) = (v4u){w[4], w[5], w[6], w[7]}; }
            else { GAS v4u* o = (GAS v4u*)(dst + ((size_t)lane * 16384 + r) * 32); o[0] = (v4u){w[0], w[1], w[2], w[3]}; o[1] = (v4u){w[4], w[5], w[6], w[7]}; }
            if (lane == 0) scl[r] = sc; } }
}
constexpr size_t WS_XQ = 80 * MiB;
constexpr size_t WS_SXR = 112 * MiB;
constexpr size_t WS_EID = 113 * MiB, WS_GATE = 121 * MiB, WS_AV = 129 * MiB;
constexpr size_t WS_REC = 208 * MiB;
constexpr int NET = 32, ETSZ = 512, NBUCK = 16 * NET, REC_CAP = 16384, CW_CNT = 8192, CW_Q = 8192 + 16 * NBUCK;
__device__ __forceinline__ unsigned fkey(float f) { const unsigned u = __builtin_bit_cast(unsigned, f); return (u & 0x80000000u) ? ~u : (u | 0x80000000u); }
__device__ __forceinline__ float gelu_erf(float x) { return 0.5f * x * (1.0f + erff(x * 0.70710678118654752f)); }

__device__ __forceinline__ float key_val(unsigned k, unsigned mask) { unsigned u = k & ~mask; u = (u & 0x80000000u) ? (u & 0x7fffffffu) : ~u; return __builtin_bit_cast(float, u); }
#define SN_CE(x, y) do { const unsigned sn_h = (x) > (y) ? (x) : (y); (y) = (x) > (y) ? (y) : (x); (x) = sn_h; } while (0)
#define SN_SORT16(k) do { SN_CE(k[0], k[1]); SN_CE(k[2], k[3]); SN_CE(k[0], k[2]); SN_CE(k[1], k[3]); SN_CE(k[1], k[2]); SN_CE(k[4], k[5]); SN_CE(k[6], k[7]); SN_CE(k[4], k[6]); SN_CE(k[5], k[7]); SN_CE(k[5], k[6]); SN_CE(k[0], k[4]); SN_CE(k[2], k[6]); SN_CE(k[2], k[4]); SN_CE(k[1], k[5]); SN_CE(k[3], k[7]); SN_CE(k[3], k[5]); SN_CE(k[1], k[2]); SN_CE(k[3], k[4]); SN_CE(k[5], k[6]); SN_CE(k[8], k[9]); SN_CE(k[10], k[11]); SN_CE(k[8], k[10]); SN_CE(k[9], k[11]); SN_CE(k[9], k[10]); SN_CE(k[12], k[13]); SN_CE(k[14], k[15]); SN_CE(k[12], k[14]); SN_CE(k[13], k[15]); SN_CE(k[13], k[14]); SN_CE(k[8], k[12]); SN_CE(k[10], k[14]); SN_CE(k[10], k[12]); SN_CE(k[9], k[13]); SN_CE(k[11], k[15]); SN_CE(k[11], k[13]); SN_CE(k[9], k[10]); SN_CE(k[11], k[12]); SN_CE(k[13], k[14]); SN_CE(k[0], k[8]); SN_CE(k[4], k[12]); SN_CE(k[4], k[8]); SN_CE(k[2], k[10]); SN_CE(k[6], k[14]); SN_CE(k[6], k[10]); SN_CE(k[2], k[4]); SN_CE(k[6], k[8]); SN_CE(k[10], k[12]); SN_CE(k[1], k[9]); SN_CE(k[5], k[13]); SN_CE(k[5], k[9]); SN_CE(k[3], k[11]); SN_CE(k[7], k[15]); SN_CE(k[7], k[11]); SN_CE(k[3], k[5]); SN_CE(k[7], k[9]); SN_CE(k[11], k[13]); SN_CE(k[1], k[2]); SN_CE(k[3], k[4]); SN_CE(k[5], k[6]); SN_CE(k[7], k[8]); SN_CE(k[9], k[10]); SN_CE(k[11], k[12]); SN_CE(k[13], k[14]); } while (0)
#define SN_MERGE16(t, k) do { t[0] = t[0] > k[15] ? t[0] : k[15]; t[1] = t[1] > k[14] ? t[1] : k[14]; t[2] = t[2] > k[13] ? t[2] : k[13]; t[3] = t[3] > k[12] ? t[3] : k[12]; t[4] = t[4] > k[11] ? t[4] : k[11]; t[5] = t[5] > k[10] ? t[5] : k[10]; t[6] = t[6] > k[9] ? t[6] : k[9]; t[7] = t[7] > k[8] ? t[7] : k[8]; t[8] = t[8] > k[7] ? t[8] : k[7]; t[9] = t[9] > k[6] ? t[9] : k[6]; t[10] = t[10] > k[5] ? t[10] : k[5]; t[11] = t[11] > k[4] ? t[11] : k[4]; t[12] = t[12] > k[3] ? t[12] : k[3]; t[13] = t[13] > k[2] ? t[13] : k[2]; t[14] = t[14] > k[1] ? t[14] : k[1]; t[15] = t[15] > k[0] ? t[15] : k[0]; SN_CE(t[0], t[8]); SN_CE(t[1], t[9]); SN_CE(t[2], t[10]); SN_CE(t[3], t[11]); SN_CE(t[4], t[12]); SN_CE(t[5], t[13]); SN_CE(t[6], t[14]); SN_CE(t[7], t[15]); SN_CE(t[0], t[4]); SN_CE(t[1], t[5]); SN_CE(t[2], t[6]); SN_CE(t[3], t[7]); SN_CE(t[8], t[12]); SN_CE(t[9], t[13]); SN_CE(t[10], t[14]); SN_CE(t[11], t[15]); SN_CE(t[0], t[2]); SN_CE(t[1], t[3]); SN_CE(t[4], t[6]); SN_CE(t[5], t[7]); SN_CE(t[8], t[10]); SN_CE(t[9], t[11]); SN_CE(t[12], t[14]); SN_CE(t[13], t[15]); SN_CE(t[0], t[1]); SN_CE(t[2], t[3]); SN_CE(t[4], t[5]); SN_CE(t[6], t[7]); SN_CE(t[8], t[9]); SN_CE(t[10], t[11]); SN_CE(t[12], t[13]); SN_CE(t[14], t[15]); } while (0)
#define SN_CAND(i, j) ((fkey(f1[i] + f2[j]) & ~255u) | (unsigned)((i) * 16 + (j)))
#define SN_STAGE2(c, k) do { k[0] = SN_CAND(0, 0); k[1] = SN_CAND(0, 1); k[2] = SN_CAND(0, 2); k[3] = SN_CAND(0, 3); k[4] = SN_CAND(0, 4); k[5] = SN_CAND(0, 5); k[6] = SN_CAND(0, 6); k[7] = SN_CAND(0, 7); k[8] = SN_CAND(0, 8); k[9] = SN_CAND(0, 9); k[10] = SN_CAND(0, 10); k[11] = SN_CAND(0, 11); k[12] = SN_CAND(0, 12); k[13] = SN_CAND(0, 13); k[14] = SN_CAND(0, 14); k[15] = SN_CAND(0, 15); SN_SORT16(k); c[0] = k[0]; c[1] = k[1]; c[2] = k[2]; c[3] = k[3]; c[4] = k[4]; c[5] = k[5]; c[6] = k[6]; c[7] = k[7]; c[8] = k[8]; c[9] = k[9]; c[10] = k[10]; c[11] = k[11]; c[12] = k[12]; c[13] = k[13]; c[14] = k[14]; c[15] = k[15]; k[0] = SN_CAND(1, 0); k[1] = SN_CAND(1, 1); k[2] = SN_CAND(1, 2); k[3] = SN_CAND(1, 3); k[4] = SN_CAND(1, 4); k[5] = SN_CAND(1, 5); k[6] = SN_CAND(1, 6); k[7] = SN_CAND(1, 7); k[8] = SN_CAND(2, 0); k[9] = SN_CAND(2, 1); k[10] = SN_CAND(2, 2); k[11] = SN_CAND(2, 3); k[12] = SN_CAND(2, 4); k[13] = SN_CAND(3, 0); k[14] = SN_CAND(3, 1); k[15] = SN_CAND(3, 2); SN_SORT16(k); SN_MERGE16(c, k); k[0] = SN_CAND(3, 3); k[1] = SN_CAND(4, 0); k[2] = SN_CAND(4, 1); k[3] = SN_CAND(4, 2); k[4] = SN_CAND(5, 0); k[5] = SN_CAND(5, 1); k[6] = SN_CAND(6, 0); k[7] = SN_CAND(6, 1); k[8] = SN_CAND(7, 0); k[9] = SN_CAND(7, 1); k[10] = SN_CAND(8, 0); k[11] = SN_CAND(9, 0); k[12] = SN_CAND(10, 0); k[13] = SN_CAND(11, 0); k[14] = SN_CAND(12, 0); k[15] = SN_CAND(13, 0); SN_SORT16(k); SN_MERGE16(c, k); { unsigned x = SN_CAND(14, 0); _Pragma("unroll") for (int r = 0; r < 16; ++r) { const unsigned hi = c[r] > x ? c[r] : x; x = c[r] > x ? x : c[r]; c[r] = hi; } } { unsigned x = SN_CAND(15, 0); _Pragma("unroll") for (int r = 0; r < 16; ++r) { const unsigned hi = c[r] > x ? c[r] : x; x = c[r] > x ? x : c[r]; c[r] = hi; } } } while (0)
template <int SKIP>
__device__ __forceinline__ void p11a_topk(Frame& F) {
    LAS float* SCR = (LAS float*)(F.lds + F.wave * 16384);
    LAS unsigned* SL = (LAS unsigned*)SCR;
    LAS int* EIDS = (LAS int*)(SCR + 1024);
    LAS int* OFFS = (LAS int*)(SCR + 2048);
    LAS float* RTS = SCR + 2304;
    LAS int* BC = (LAS int*)(F.lds + 8 * 16384);
    const bf16* SC = (const bf16*)(F.ws + WS_SC);
    unsigned char* XQ = F.ws + WS_XQ; float* SXR = (float*)(F.ws + WS_SXR); int* EIDg = (int*)(F.ws + WS_EID); float* GATEg = (float*)(F.ws + WS_GATE); unsigned* REC = (unsigned*)(F.ws + WS_REC);
    for (int blk = F.vcu; blk < SEQ / 64; blk += F.G) {
        __syncthreads();
        if (F.tid < NET) BC[F.tid] = 0;
        __syncthreads();
        const int m0 = blk * 64 + F.wave * 8;
#pragma unroll 2
        for (int ti = 0; ti < 8; ++ti) { const int m = m0 + ti;
            int lane = F.lane; asm volatile("" : "+v"(lane));
            float xh[32]; float ss = 0.f;
            const bf16* x1 = (const bf16*)(F.ws + WS_X1B) + (size_t)m * DM + lane * 32; const float* n2 = F.in[I_N2W] + lane * 32;
            f32x4 nwv[8];
#pragma unroll
            for (int q = 0; q < 8; ++q) { const v2u a = *(const GAS v2u*)(x1 + 4 * q); nwv[q] = *(const GAS f32x4*)(n2 + 4 * q); xh[4 * q] = bflo(a.x); xh[4 * q + 1] = bfhi(a.x); xh[4 * q + 2] = bflo(a.y); xh[4 * q + 3] = bfhi(a.y); }
#pragma unroll
            for (int e = 0; e < 32; ++e) ss += xh[e] * xh[e];
            const float rt = 1.0f / sqrtf(wave_sum(ss) * (1.f / DM) + EPS);
            float amx = 0.f;
#pragma unroll
            for (int q = 0; q < 8; ++q) { const f32x4 a = nwv[q]; xh[4 * q] *= rt * a.x; xh[4 * q + 1] *= rt * a.y; xh[4 * q + 2] *= rt * a.z; xh[4 * q + 3] *= rt * a.w; }
#pragma unroll
            for (int e = 0; e < 32; ++e) amx = fmaxf(amx, fabsf(xh[e]));
            amx = wave_max(amx);
            const float sx = amx > 0.f ? amx * (1.0f / 127.0f) : 1.0f, isx = 1.0f / sx;
            unsigned xq[8];
#pragma unroll
            for (int d = 0; d < 8; ++d) { const int a = (int)rintf(xh[4 * d] * isx), b = (int)rintf(xh[4 * d + 1] * isx), c = (int)rintf(xh[4 * d + 2] * isx), e = (int)rintf(xh[4 * d + 3] * isx);
                xq[d] = (unsigned)(a & 255) | ((unsigned)(b & 255) << 8) | ((unsigned)(c & 255) << 16) | ((unsigned)(e & 255) << 24); }
            if (!(SKIP & 2)) { GAS v4u* o = (GAS v4u*)(XQ + ((size_t)lane * SEQ + m) * 32); o[0] = (v4u){xq[0], xq[1], xq[2], xq[3]}; o[1] = (v4u){xq[4], xq[5], xq[6], xq[7]}; }
            if (lane == 0) { SXR[2 * m] = sx; SXR[2 * m + 1] = rt; RTS[ti] = rt; }
        }
#pragma unroll 1
        for (int grp = 0; grp < 2; ++grp) {
            int lane = F.lane; asm volatile("" : "+v"(lane));
            if (!(SKIP & 1)) {
                { const bf16* src = SC + (size_t)(m0 + grp * 4 + (lane >> 4)) * DM + (lane & 15) * 128;
                  unsigned v[16];
#pragma unroll
                  for (int i = 0; i < 16; ++i) v[i] = 0u;
#pragma unroll 1
                  for (int s8 = 0; s8 < 2; ++s8) { v4u a8[8];
#pragma unroll
                      for (int u = 0; u < 8; ++u) a8[u] = *(const GAS v4u*)(src + 64 * s8 + 8 * u);
#pragma unroll
                      for (int u2 = 0; u2 < 4; ++u2) { unsigned k[16];
#pragma unroll
                          for (int h = 0; h < 2; ++h) { const unsigned wv[4] = {a8[2 * u2 + h].x, a8[2 * u2 + h].y, a8[2 * u2 + h].z, a8[2 * u2 + h].w};
#pragma unroll
                              for (int e = 0; e < 8; ++e) { const float sv = (e & 1) ? bfhi(wv[e >> 1]) : bflo(wv[e >> 1]); k[8 * h + e] = (fkey(sv) & ~127u) | (unsigned)(64 * s8 + 16 * u2 + 8 * h + e); } }
                          SN_SORT16(k); SN_MERGE16(v, k); } }
#pragma unroll
                  for (int q = 0; q < 4; ++q) *(LAS v4u*)(SL + lane * 16 + 4 * q) = (v4u){v[4 * q], v[4 * q + 1], v[4 * q + 2], v[4 * q + 3]}; }
                asm volatile("" ::: "memory");
                if (lane < 32) { const int tk = lane >> 3, h = lane & 7, m = m0 + grp * 4 + tk;
                    const LAS unsigned* L1 = SL + (tk * 16 + 2 * h) * 16; const LAS unsigned* L2 = L1 + 16;
                    float f1[16], f2[16];
#pragma unroll
                    for (int q = 0; q < 4; ++q) { const v4u a = *(const LAS v4u*)(L1 + 4 * q), b = *(const LAS v4u*)(L2 + 4 * q);
                        f1[4 * q] = key_val(a.x, 127u); f1[4 * q + 1] = key_val(a.y, 127u); f1[4 * q + 2] = key_val(a.z, 127u); f1[4 * q + 3] = key_val(a.w, 127u);
                        f2[4 * q] = key_val(b.x, 127u); f2[4 * q + 1] = key_val(b.y, 127u); f2[4 * q + 2] = key_val(b.z, 127u); f2[4 * q + 3] = key_val(b.w, 127u); }
                    unsigned c[16]; { unsigned k[16]; SN_STAGE2(c, k); }
                    const float rt = RTS[grp * 4 + tk];
                    float sc[16]; int ee[16]; float mx = -3.0e38f;
#pragma unroll
                    for (int r = 0; r < 16; ++r) { const unsigned ij = c[r] & 255u; const unsigned k1 = L1[ij >> 4], k2 = L2[ij & 15u];
                        sc[r] = key_val(k1, 127u) + key_val(k2, 127u); ee[r] = (int)((k1 & 127u) * 128u + (k2 & 127u)); mx = fmaxf(mx, sc[r]); }
                    float sum = 0.f;
#pragma unroll
                    for (int r = 0; r < 16; ++r) { sc[r] = __expf(rt * (sc[r] - mx)); sum += sc[r]; }
                    const float inv = 1.0f / sum;
#pragma unroll
                    for (int q = 0; q < 4; ++q) { *(LAS v4u*)(EIDS + (grp * 4 + tk) * 128 + h * 16 + 4 * q) = (v4u){(unsigned)ee[4 * q], (unsigned)ee[4 * q + 1], (unsigned)ee[4 * q + 2], (unsigned)ee[4 * q + 3]};
                        if (!(SKIP & 4)) { *(GAS v4u*)(EIDg + (size_t)m * 128 + h * 16 + 4 * q) = (v4u){(unsigned)ee[4 * q], (unsigned)ee[4 * q + 1], (unsigned)ee[4 * q + 2], (unsigned)ee[4 * q + 3]};
                            *(GAS f32x4*)(GATEg + (size_t)m * 128 + h * 16 + 4 * q) = (f32x4){sc[4 * q] * inv, sc[4 * q + 1] * inv, sc[4 * q + 2] * inv, sc[4 * q + 3] * inv}; } }
                }
                asm volatile("" ::: "memory");
            }
        }
#pragma unroll 1
        for (int ti = 0; ti < 8; ++ti) {
            int lane = F.lane; asm volatile("" : "+v"(lane));
            const int tA = (EIDS[ti * 128 + lane] >> 9) & 31, tB = (EIDS[ti * 128 + 64 + lane] >> 9) & 31; int mycnt = 0;
#pragma unroll
            for (int k = 0; k < NET; ++k) { const int c = __popcll(__ballot(tA == k)) + __popcll(__ballot(tB == k)); mycnt = (lane == k) ? c : mycnt; }
            if (lane < NET) OFFS[ti * NET + lane] = __hip_atomic_fetch_add((int*)(BC + lane), mycnt, __ATOMIC_RELAXED, __HIP_MEMORY_SCOPE_WORKGROUP);
        }
        __syncthreads();
        const int tt = blk >> 4;
        if (F.tid < NET) BC[NET + F.tid] = (int)__hip_atomic_fetch_add((unsigned*)(F.ctl + CW_CNT) + (tt * NET + F.tid) * 16, (unsigned)BC[F.tid], __ATOMIC_RELAXED, __HIP_MEMORY_SCOPE_AGENT);
        __syncthreads();
#pragma unroll 1
        for (int ti = 0; ti < 8; ++ti) { const int m = m0 + ti;
            int lane = F.lane; asm volatile("" : "+v"(lane));
            const unsigned long long lt_mask = (1ull << lane) - 1ull;
            const int eA = EIDS[ti * 128 + lane] & 16383, eB = EIDS[ti * 128 + 64 + lane] & 16383, tA = eA >> 9, tB = eB >> 9; int rankA = 0, rankB = 0;
#pragma unroll
            for (int k = 0; k < NET; ++k) { const unsigned long long mA = __ballot(tA == k), mB = __ballot(tB == k);
                rankA = (tA == k) ? __popcll(mA & lt_mask) : rankA; rankB = (tB == k) ? __popcll(mA) + __popcll(mB & lt_mask) : rankB; }
            const unsigned tl = (unsigned)(m & 1023) << 17;
            if (!(SKIP & 4)) { const int s = BC[NET + tA] + OFFS[ti * NET + tA] + rankA; if (s < REC_CAP) REC[(size_t)(tt * NET + tA) * REC_CAP + s] = tl | ((unsigned)(eA & 511) << 7) | (unsigned)lane; }
            if (!(SKIP & 4)) { const int s = BC[NET + tB] + OFFS[ti * NET + tB] + rankB; if (s < REC_CAP) REC[(size_t)(tt * NET + tB) * REC_CAP + s] = tl | ((unsigned)(eB & 511) << 7) | (unsigned)(lane + 64); }
        }
    }
}

constexpr int NSLOT = 12, UPITCH = 80;
template <int SKIP>
__device__ __forceinline__ void p11b_udot(Frame& F) {
    LAS unsigned char* XS = (LAS unsigned char*)F.lds;
    LAS unsigned char* US = XS + 1024 * UPITCH;
    LAS int* QB = (LAS int*)(F.lds + 124 * 1024);
    const int tid = F.tid;
    const unsigned char* XQ = F.ws + WS_XQ; const unsigned char* TU = F.ws + WS_TU; const unsigned* REC = (const unsigned*)(F.ws + WS_REC);
    const float* SXR = (const float*)(F.ws + WS_SXR); const float* GATEg = (const float*)(F.ws + WS_GATE); float* AVg = (float*)(F.ws + WS_AV);
    const float* SU = (const float*)(F.ws + WS_PSC); const float* SV = SU + 16384;
    for (;;) {
        __syncthreads();
        if (tid == 0) QB[0] = (int)__hip_atomic_fetch_add((unsigned*)(F.ctl + CW_Q), 1u, __ATOMIC_RELAXED, __HIP_MEMORY_SCOPE_AGENT);
        __syncthreads();
        const int b = QB[0];
        if (b >= NBUCK) break;
        const int tt = b >> 5, et = b & 31;
        int n = (int)__hip_atomic_load((unsigned*)(F.ctl + CW_CNT) + b * 16, __ATOMIC_RELAXED, __HIP_MEMORY_SCOPE_AGENT); n = n < REC_CAP ? n : REC_CAP;
        for (int g0 = 0; g0 < n; g0 += NSLOT * NTHR) {
            const int npass = (n - g0) < NSLOT * NTHR ? (n - g0) : NSLOT * NTHR;
            unsigned rec[NSLOT]; int acc[NSLOT];
#pragma unroll
            for (int j = 0; j < NSLOT; ++j) { const int idx = g0 + j * NTHR + tid; const unsigned r = idx < n ? REC[(size_t)b * REC_CAP + idx] : 0xffffffffu; acc[j] = 0;
                rec[j] = ((r >> 17) & 1023u) | (((r >> 7) & 511u) << 16); }
            v4u st[12];
#define P11B_SRC(step, i) (((i) % 6) < 4 ? XQ + ((size_t)(2 * (step) + (i) / 6) * SEQ + tt * 1024) * 32 + (size_t)(tid + 512 * ((i) % 6)) * 16 : TU + ((size_t)(2 * (step) + (i) / 6) * 16384 + et * ETSZ) * 32 + (size_t)(tid + 512 * (((i) % 6) - 4)) * 16)
#pragma unroll
            for (int i = 0; i < 12; ++i) st[i] = *(const GAS v4u*)P11B_SRC(0, i);
#pragma unroll 1
            for (int c = 0; c < 32; ++c) {
                __syncthreads();
#pragma unroll
                for (int i = 0; i < 12; ++i) { const int q = i % 6, hc = i / 6, p = (q < 4) ? tid + 512 * q : tid + 512 * (q - 4); *(LAS v4u*)((q < 4 ? XS : US) + (p >> 1) * UPITCH + hc * 32 + (p & 1) * 16) = st[i]; }
                __syncthreads();
                if (c + 1 < 32 && !(SKIP & 1)) {
#pragma unroll
                    for (int i = 0; i < 12; ++i) st[i] = *(const GAS v4u*)P11B_SRC(c + 1, i);
                }
#pragma unroll
                for (int j0 = 0; j0 < NSLOT; j0 += 2) {
                    if (j0 * NTHR < npass && !(SKIP & 2)) {
                        v4u xb[2][4], ub[2][4];
#pragma unroll
                        for (int q = 0; q < 2; ++q) { unsigned r = rec[j0 + q]; asm volatile("" : "+v"(r));
                            const unsigned xo = (r & 0xffffu) * UPITCH, uo = (r >> 16) * UPITCH;
#pragma unroll
                            for (int hh = 0; hh < 4; ++hh) { xb[q][hh] = *(const LAS v4u*)(XS + xo + 16 * hh); ub[q][hh] = *(const LAS v4u*)(US + uo + 16 * hh); } }
                        __builtin_amdgcn_sched_barrier(0);
#pragma unroll
                        for (int q = 0; q < 2; ++q) { int s = acc[j0 + q];
#pragma unroll
                            for (int hh = 0; hh < 4; ++hh) { const v4u u = ub[q][hh], x = xb[q][hh];
                                s = __builtin_amdgcn_sdot4((int)u.x, (int)x.x, s, false); s = __builtin_amdgcn_sdot4((int)u.y, (int)x.y, s, false); s = __builtin_amdgcn_sdot4((int)u.z, (int)x.z, s, false); s = __builtin_amdgcn_sdot4((int)u.w, (int)x.w, s, false); }
                            acc[j0 + q] = s; }
                        __builtin_amdgcn_sched_barrier(0);
                    }
                }
            }
#undef P11B_SRC
#pragma unroll
            for (int j = 0; j < NSLOT; ++j) { const int idx = g0 + j * NTHR + tid; const unsigned r = idx < n ? REC[(size_t)b * REC_CAP + idx] : 0xffffffffu;
                if (r != 0xffffffffu) { const int t = tt * 1024 + (int)((r >> 17) & 1023), e = et * ETSZ + (int)((r >> 7) & 511), j7 = (int)(r & 127);
                    const float hv = (float)acc[j] * SU[e] * SXR[2 * t]; AVg[(size_t)t * 128 + j7] = gelu_erf(hv) * GATEg[(size_t)t * 128 + j7] * SV[e]; } }
        }
    }
}

__device__ __forceinline__ void p11c_vsum(Frame& F) {
    const int gw = F.vcu * NWAVES + F.wave, NGW = F.G * NWAVES;
    LAS int* EID = (LAS int*)(F.lds + F.wave * 16384); LAS float* AV = (LAS float*)(EID + 128);
    const unsigned char* TV = F.ws + WS_TV; const int* EIDg = (const int*)(F.ws + WS_EID); const float* AVg = (const float*)(F.ws + WS_AV);
    for (int m = gw; m < SEQ; m += NGW) {
        int lane = F.lane; asm volatile("" : "+v"(lane));
        const int lo16 = lane * 16;
        EID[lane] = EIDg[(size_t)m * 128 + lane]; EID[lane + 64] = EIDg[(size_t)m * 128 + 64 + lane]; AV[lane] = AVg[(size_t)m * 128 + lane]; AV[lane + 64] = AVg[(size_t)m * 128 + 64 + lane];
        asm volatile("" ::: "memory");
        f32x2 y2[16];
#pragma unroll
        for (int e = 0; e < 16; ++e) y2[e] = (f32x2){0.f, 0.f};
        float av[2][4];
#if VFMT == 6
        v4u rv[2][4]; v2u rw[2][4];
#define P11C_LOAD(buf, g) do { _Pragma("unroll") for (int q = 0; q < 4; ++q) { const int e = __builtin_amdgcn_readfirstlane(EID[(g) + q]); av[buf][q] = AV[(g) + q]; const unsigned char* rp = TV + (size_t)e * TV_PITCH; \
            rv[buf][q] = *(const GAS v4u*)(rp + lo16); rw[buf][q] = *(const GAS v2u*)(rp + 1024 + lane * 8); } } while (0)
#define P11C_ACC(buf) do { _Pragma("unroll") for (int q = 0; q < 4; ++q) { const float a = av[buf][q]; const f32x2 a2 = {a, a}; \
            const v6u pk = {rv[buf][q].x, rv[buf][q].y, rv[buf][q].z, rv[buf][q].w, rw[buf][q].x, rw[buf][q].y}; const v32f f = __builtin_amdgcn_cvt_scalef32_pk32_f32_fp6(pk, 1.0f); \
            _Pragma("unroll") for (int k = 0; k < 16; ++k) y2[k] += a2 * (f32x2){f[2 * k], f[2 * k + 1]}; \
            __builtin_amdgcn_sched_barrier(0); } } while (0)
#else
        v4u rv[2][4][2];
#define P11C_LOAD(buf, g) do { _Pragma("unroll") for (int q = 0; q < 4; ++q) { const int e = __builtin_amdgcn_readfirstlane(EID[(g) + q]); av[buf][q] = AV[(g) + q]; const unsigned char* rp = TV + (size_t)e * DM + lo16; \
            rv[buf][q][0] = *(const GAS v4u*)(rp); rv[buf][q][1] = *(const GAS v4u*)(rp + 1024); } } while (0)
#define P11C_ACC(buf) do { _Pragma("unroll") for (int q = 0; q < 4; ++q) { const float a = av[buf][q]; const f32x2 a2 = {a, a}; \
            _Pragma("unroll") for (int j = 0; j < 2; ++j) { const v4u r = rv[buf][q][j]; const unsigned wv[4] = {r.x, r.y, r.z, r.w}; \
                _Pragma("unroll") for (int dd = 0; dd < 4; ++dd) { y2[8 * j + 2 * dd] += a2 * __builtin_amdgcn_cvt_pk_f32_fp8((int)wv[dd], false); y2[8 * j + 2 * dd + 1] += a2 * __builtin_amdgcn_cvt_pk_f32_fp8((int)wv[dd], true); } } \
            __builtin_amdgcn_sched_barrier(0); } } while (0)
#endif
        P11C_LOAD(0, 0);
#pragma unroll 1
        for (int g = 0; g < 128; g += 8) {
            P11C_LOAD(1, g + 4);
            P11C_ACC(0);
            if (g + 8 < 128) P11C_LOAD(0, g + 8);
            P11C_ACC(1);
        }
#undef P11C_LOAD
#undef P11C_ACC
        float y[32];
#pragma unroll
        for (int e = 0; e < 16; ++e) { if (VFMT == 6 && FP6_IL) { y[e] = y2[e].x; y[16 + e] = y2[e].y; } else { y[2 * e] = y2[e].x; y[2 * e + 1] = y2[e].y; } }
        const bf16* x1 = (const bf16*)(F.ws + WS_X1B) + (size_t)m * DM;
        float s2 = 0.f;
#pragma unroll
        for (int j = 0; j < 2; ++j)
#pragma unroll
            for (int q = 0; q < 4; ++q) { const v2u a2 = *(const GAS v2u*)(x1 + j * 1024 + lo16 + 4 * q); const f32x4 a = {bflo(a2.x), bfhi(a2.x), bflo(a2.y), bfhi(a2.y)};
                y[16 * j + 4 * q] += a.x; y[16 * j + 4 * q + 1] += a.y; y[16 * j + 4 * q + 2] += a.z; y[16 * j + 4 * q + 3] += a.w; }
#pragma unroll
        for (int e = 0; e < 32; ++e) s2 += y[e] * y[e];
        const float ro = 1.0f / sqrtf(wave_sum(s2) * (1.f / DM) + EPS);
        float* orow = F.out + (size_t)m * DM;
#pragma unroll
        for (int j = 0; j < 2; ++j)
#pragma unroll
            for (int q = 0; q < 4; ++q) { const f32x4 a = *(const GAS f32x4*)(F.in[I_FNW] + j * 1024 + lo16 + 4 * q);
                *(GAS f32x4*)(orow + j * 1024 + lo16 + 4 * q) = (f32x4){y[16 * j + 4 * q] * ro * a.x, y[16 * j + 4 * q + 1] * ro * a.y, y[16 * j + 4 * q + 2] * ro * a.z, y[16 * j + 4 * q + 3] * ro * a.w}; }
    }
}
#ifndef MK_N_LAUNCHES
#define MK_N_LAUNCHES 1
#endif
constexpr int N_PHASES = 14;
constexpr int N_LAUNCHES = MK_N_LAUNCHES;
static_assert(N_LAUNCHES == 1 || N_LAUNCHES == N_PHASES, "MK_N_LAUNCHES is 1 or N_PHASES");
#ifndef PG8_SP2
#define PG8_SP2 true
#endif
#ifndef PG8_ALIGN
#define PG8_ALIGN true
#endif
struct Args { const float* in[19]; float* out; unsigned char* ws; int ph_lo, ph_hi; };
__global__ void __launch_bounds__(NTHR, 2) fwd_kernel(Args args) {
    extern __shared__ __attribute__((aligned(16))) unsigned char lds[];
    Frame F;
    F.lds = (LAS unsigned char*)lds;
    F.MISC = (volatile LAS unsigned*)(F.lds + MISC_OFF);
    F.tid = threadIdx.x; F.lane = F.tid & 63; F.wave = __builtin_amdgcn_readfirstlane(F.tid >> 6);
    F.G = gridDim.x; { const int bx = blockIdx.x; F.vcu = (F.G % 8 == 0) ? (bx % 8) * (F.G / 8) + bx / 8 : bx; }
    F.ws = args.ws; F.out = args.out; F.ctl = (gu32*)(args.ws + WS_CTL);
#pragma unroll
    for (int i = 0; i < 19; ++i) F.in[i] = args.in[i];
    for (int u = F.tid; u < (LDS_BYTES - MISC_OFF) / 4; u += NTHR) ((LAS unsigned*)(F.lds + MISC_OFF))[u] = 0u;
    __syncthreads();
    XcdBarrier bar; bar.bar = (unsigned*)(F.ctl + CW_BAR); bar.x = 0; bar.st = nullptr;
    if (N_LAUNCHES == 1) bar = xcd_barrier_post((unsigned*)(F.ctl + CW_BAR), F.MISC + 8);
    const int lo = args.ph_lo, hi = args.ph_hi;
#ifdef ONLY_PHASE
#define IN(k) ((k) == ONLY_PHASE && lo <= (k) && (k) < hi)
#else
#define IN(k) (lo <= (k) && (k) < hi)
#endif
#define SEAM(k) do { if (IN(k) && IN((k) + 1)) xcd_barrier(bar); } while (0)
#ifndef REPEAT_MASK
#define REPEAT_MASK 0
#endif
#ifndef P11A_SKIP
#define P11A_SKIP 0
#endif
#define REPS(k) for (int rep_ = 0; rep_ < (((REPEAT_MASK) >> (k)) & 1) + 1; ++rep_)
#define RSEAM(k) do { if ((((REPEAT_MASK) >> (k)) & 1) && rep_ == 0) xcd_barrier(bar); } while (0)
    unsigned char* ws = args.ws;
    if (IN(0)) { REPS(0) { p0_prologue(F); RSEAM(0); } SEAM(0); }
    if (IN(1)) {
        pg8::Gemm g{(const bf16*)(ws + WS_XN), (const bf16*)(ws + WS_W1), SEQ, N1, DM}; pg8::StaticOrder S; S.init(SEQ, N1, F.G, (int)blockIdx.x);
        EpiG1 E{ws, F.in[I_LB], (const float*)(ws + WS_QX), (const float*)(ws + WS_QW) + QW_W1};
        if (QM_G1) g.A = (const bf16*)((const unsigned char*)F.out + DO_XN8);
        if ((REPEAT_MASK >> 1) & 1) { pg8::gemm_phase<EpiG1, pg8::StaticOrder, PG8_ALIGN, PG8_SP2, QM_G1>(F.lds, g, S, E); xcd_barrier(bar); }
        pg8::gemm_phase<EpiG1, pg8::StaticOrder, PG8_ALIGN, PG8_SP2, QM_G1>(F.lds, g, S, E);
        p1_ab(F);
        SEAM(1);
    }
#ifdef EXTRA_BARRIERS
    for (int eb = 0; eb < EXTRA_BARRIERS; ++eb) xcd_barrier(bar);
#endif
    if (IN(2)) { REPS(2) { hgrn_pass<false>(F); RSEAM(2); } SEAM(2); }
    if (IN(3)) { if ((REPEAT_MASK >> 3) & 1) { hgrn_pass<true, P11A_SKIP>(F); xcd_barrier(bar); } hgrn_pass<true>(F); SEAM(3); }
    if (IN(4)) { if ((REPEAT_MASK >> 4) & 1) { gdn_prep<P11A_SKIP>(F); xcd_barrier(bar); } gdn_prep<0>(F); SEAM(4); }
    if (IN(5)) { if ((REPEAT_MASK >> 5) & 1) { gdn_pass<false, P11A_SKIP>(F); xcd_barrier(bar); } gdn_pass<false>(F); SEAM(5); }
    if (IN(6)) { if ((REPEAT_MASK >> 6) & 1) { gdn_pass<true, P11A_SKIP>(F); xcd_barrier(bar); } gdn_pass<true>(F); SEAM(6); }
    if (IN(7)) { REPS(7) { p7_mix(F); RSEAM(7); } SEAM(7); }
    if (IN(8)) {
        pg8::StaticOrder S; S.init(SEQ, DM, F.G, (int)blockIdx.x);
        bf16* GT = (bf16*)(ws + WS_GT); unsigned char* GA8 = ws + WS_GT2; unsigned char* GB8 = ws + WS_GT2 + 32 * MiB;
        const bf16* XNg = QM_GATE ? (const bf16*)((const unsigned char*)F.out + DO_XN8) : (const bf16*)(ws + WS_XN);
        const bf16* WG2 = QM_GATE ? (const bf16*)(ws + WS_WG + (size_t)DM * DM) : (const bf16*)(ws + WS_WG) + (size_t)DM * DM;
        const float* QX = (const float*)(ws + WS_QX); const float* QW = (const float*)(ws + WS_QW);
#define P8_BODY \
        { pg8::Gemm g{XNg, (const bf16*)(ws + WS_WG), SEQ, DM, DM}; EpiGate E{GA8, QX, QW + QW_WG}; pg8::gemm_phase<EpiGate, pg8::StaticOrder, PG8_ALIGN, PG8_SP2, QM_GATE>(F.lds, g, S, E); } \
        __builtin_amdgcn_fence(__ATOMIC_ACQUIRE, "agent"); VM_WAIT(); __syncthreads(); \
        { pg8::Gemm g{(const bf16*)(ws + WS_YA), (const bf16*)(ws + WS_WPA), SEQ, DM, HW}; EpiMix<0> E{GT, GA8, nullptr, QX + SEQ, QW + QW_WPA}; pg8::gemm_phase<EpiMix<0>, pg8::StaticOrder, PG8_ALIGN, PG8_SP2, QM_MIX>(F.lds, g, S, E); } \
        { pg8::Gemm g{XNg, WG2, SEQ, DM, DM}; EpiGate E{GB8, QX, QW + QW_WG + DM}; pg8::gemm_phase<EpiGate, pg8::StaticOrder, PG8_ALIGN, PG8_SP2, QM_GATE>(F.lds, g, S, E); } \
        __builtin_amdgcn_fence(__ATOMIC_ACQUIRE, "agent"); VM_WAIT(); __syncthreads(); \
        { pg8::Gemm g{(const bf16*)(ws + WS_YB), (const bf16*)(ws + WS_WPB), SEQ, DM, HW}; EpiMix<1> E{GT, GB8, ws + WS_GT8, QX + 2 * SEQ, QW + QW_WPB}; pg8::gemm_phase<EpiMix<1>, pg8::StaticOrder, PG8_ALIGN, PG8_SP2, QM_MIX>(F.lds, g, S, E); }
        if ((REPEAT_MASK >> 8) & 1) { P8_BODY xcd_barrier(bar); }
        P8_BODY
#undef P8_BODY
        SEAM(8);
    }
    if (IN(9)) {
        pg8::Gemm g{(const bf16*)(ws + (QM_OUT ? WS_GT8 : WS_GT)), (const bf16*)(ws + WS_WOUT), SEQ, DM, DM}; pg8::StaticOrder S; S.init(SEQ, DM, F.G, (int)blockIdx.x);
        EpiX1 E{F.in[I_X], F.out, (bf16*)(ws + WS_X1B)};
        if ((REPEAT_MASK >> 9) & 1) { pg8::gemm_phase<EpiX1, pg8::StaticOrder, PG8_ALIGN, PG8_SP2, QM_OUT>(F.lds, g, S, E); xcd_barrier(bar); }
        pg8::gemm_phase<EpiX1, pg8::StaticOrder, PG8_ALIGN, PG8_SP2, QM_OUT>(F.lds, g, S, E);
        SEAM(9);
    }
    if (IN(10)) {
        pg8::Gemm g{(const bf16*)(ws + WS_X1B), (const bf16*)(ws + WS_WS), SEQ, DM, DM}; pg8::StaticOrder S; S.init(SEQ, DM, F.G, (int)blockIdx.x);
        EpiBf E{(bf16*)(ws + WS_SC)};
        if ((REPEAT_MASK >> 10) & 1) { pg8::gemm_phase<EpiBf, pg8::StaticOrder, PG8_ALIGN, PG8_SP2>(F.lds, g, S, E); xcd_barrier(bar); }
        pg8::gemm_phase<EpiBf, pg8::StaticOrder, PG8_ALIGN, PG8_SP2>(F.lds, g, S, E);
        SEAM(10);
    }
    if (IN(11)) {
        if ((REPEAT_MASK >> 11) & 1) { p11a_topk<P11A_SKIP>(F); xcd_barrier(bar); if (blockIdx.x == 0) for (int i = F.tid; i < NBUCK + 1; i += NTHR) __hip_atomic_store((unsigned*)(F.ctl + CW_CNT) + i * 16, 0u, __ATOMIC_RELAXED, __HIP_MEMORY_SCOPE_AGENT); xcd_barrier(bar); }
        p11a_topk<0>(F); SEAM(11); }
    if (IN(12)) { if ((REPEAT_MASK >> 12) & 1) { p11b_udot<P11A_SKIP>(F); xcd_barrier(bar); if (blockIdx.x == 0 && F.tid == 0) __hip_atomic_store((unsigned*)(F.ctl + CW_Q), 0u, __ATOMIC_RELAXED, __HIP_MEMORY_SCOPE_AGENT); xcd_barrier(bar); } p11b_udot<0>(F); SEAM(12); }
    if (IN(13)) { p11c_vsum(F); }
#undef IN
#undef SEAM
}


#ifdef PROBE
__global__ void digest_kernel(const unsigned* ws, float* out) {
    const size_t n = (size_t)SEQ * DM;
    for (size_t i = (size_t)blockIdx.x * blockDim.x + threadIdx.x; i < n; i += (size_t)gridDim.x * blockDim.x) {
        unsigned acc = (PROBE >= 9) ? __builtin_bit_cast(unsigned, out[i]) : 0u;
        const size_t offs[5] = {0, 128 * MiB / 4, 256 * MiB / 4, 384 * MiB / 4, 408 * MiB / 4};
#pragma unroll
        for (int r = 0; r < 5; ++r) acc = acc * 1664525u + ws[offs[r] + i];
        out[i] = (float)(acc >> 8) * (1.0f / 16777216.0f);
    }
}
#endif
extern "C" void kernel_launch(void* const* d_in, const int* in_sizes, int n_in, void* d_out, int out_size, void* d_ws, size_t ws_size, hipStream_t stream) {
    static int grid = 0;
    if (grid == 0) {
        if (n_in != 19 || in_sizes[0] != SEQ * DM || out_size != SEQ * DM || ws_size < WS_END) { fprintf(stderr, "kernel_launch: unexpected shapes (n_in %d, in0 %d, out %d, ws %zu; need ws >= %zu)\n", n_in, n_in > 0 ? in_sizes[0] : -1, out_size, ws_size, (size_t)WS_END); grid = -1; return; }
        int dev = 0, cus = 0, per_cu = 0;
        if (hipGetDevice(&dev) != hipSuccess || hipDeviceGetAttribute(&cus, hipDeviceAttributeMultiprocessorCount, dev) != hipSuccess) { grid = -1; return; }
        if (hipFuncSetAttribute((const void*)fwd_kernel, hipFuncAttributeMaxDynamicSharedMemorySize, LDS_BYTES) != hipSuccess) { fprintf(stderr, "kernel_launch: hipFuncSetAttribute failed\n"); grid = -1; return; }
        if (hipOccupancyMaxActiveBlocksPerMultiprocessor(&per_cu, (const void*)fwd_kernel, NTHR, LDS_BYTES) != hipSuccess || per_cu < 1) fprintf(stderr, "kernel_launch: occupancy query reports %d\n", per_cu);
        (void)hipGetLastError();
        grid = cus;
    }
    if (grid < 0) return;
    (void)hipMemsetAsync((char*)d_ws + WS_CTL, 0, CTL_ZERO_BYTES, stream);
    Args a{};
    for (int i = 0; i < 19; ++i) a.in[i] = (const float*)d_in[i];
    a.out = (float*)d_out; a.ws = (unsigned char*)d_ws;
    for (int li = 0; li < N_LAUNCHES; ++li) {
        a.ph_lo = (N_LAUNCHES == 1) ? 0 : li; a.ph_hi = (N_LAUNCHES == 1) ? N_PHASES : li + 1;
#ifdef PROBE
        if (li > PROBE) break;
#endif
        hipLaunchKernelGGL(fwd_kernel, dim3(grid), dim3(NTHR), LDS_BYTES, stream, a);
    }
#ifdef PROBE
    hipLaunchKernelGGL(digest_kernel, dim3(2048), dim3(256), 0, stream, (const unsigned*)d_ws, (float*)d_out);
#endif
}
```

```cpp
#include <hip/hip_runtime.h>
#include <cstdio>
#include <cstdint>
#define GAS __attribute__((address_space(1)))
#define LAS __attribute__((address_space(3)))
#define MK_N_LAUNCHES 1
namespace pg8 {
#define PG8_LAS __attribute__((address_space(3)))
typedef unsigned short bf16_t;
typedef short bf16x8 __attribute__((ext_vector_type(8)));
typedef float f32x4 __attribute__((ext_vector_type(4)));
typedef unsigned u32x4 __attribute__((ext_vector_type(4)));
constexpr int BM = 256, BK = 64, HALF = 128, HTB = HALF * BK * 2  , STAGE_BYTES = 8 * HTB, NXCD = 8, WGM = 8;

__host__ __device__ __forceinline__ int lds_byte(int r, int c) { const int st = (r >> 4) * 2 + (c >> 5), rr = r & 15, cc = c & 31, ob = rr * 64 + cc * 2; return st * 1024 + (ob ^ (((ob >> 9) & 1) << 5)); }
__host__ __device__ __forceinline__ void stage_rc(int b, int& R, int& C) { const int st = b / 1024, sb = b % 1024, swz = sb ^ (((sb >> 9) & 1) << 5); R = (st >> 1) * 16 + swz / 64; C = (st & 1) * 32 + (swz % 64) / 2; }
__host__ __device__ __forceinline__ int perm32(int rho) { const int n = rho >> 4, i = rho & 15; return 8 * (i >> 2) + 4 * n + (i & 3); }

struct Unit { int pm, pn; };
struct Gemm { const bf16_t* A; const bf16_t* Bt; int M, N, K; };

struct StaticOrder {
    int nM, nN, nwg, G, c;
    __host__ __device__ void init(int M, int N, int G_, int c_) { nM = M / BM; nN = N / BM; nwg = nM * nN; G = G_; c = c_; }
    __host__ __device__ bool next(int i, Unit& u) const {
        const long L = (long)i * G + c; if (L >= nwg) return false;
        int wgid = (int)L; { const int q = nwg / NXCD, r = nwg % NXCD, xcd = wgid % NXCD, off = wgid / NXCD; wgid = (xcd < r ? xcd * (q + 1) : r * (q + 1) + (xcd - r) * q) + off; }
        const int nig = WGM * nN, gid = wgid / nig, fm = gid * WGM, gsz = (nM - fm) < WGM ? (nM - fm) : WGM;
        u.pm = fm + ((wgid % nig) % gsz); u.pn = (wgid % nig) / gsz; return true;
    }
    __device__ __forceinline__ void a_ready(const Unit&) const {}
    __device__ __forceinline__ void done(const Unit&) const {}
};

__device__ __forceinline__ unsigned cvt_pk_bf16(float lo, float hi) { unsigned r; asm volatile("v_cvt_pk_bf16_f32 %0, %1, %2" : "=v"(r) : "v"(lo), "v"(hi)); return r; }
typedef float f32x2 __attribute__((ext_vector_type(2)));
__device__ __forceinline__ f32x2 gelu_pk(f32x2 v) {
    const f32x2 av = __builtin_elementwise_abs(v), d = av * 0.2316418882f + 1.0f;
    f32x2 t; t.x = __builtin_amdgcn_rcpf(d.x); t.y = __builtin_amdgcn_rcpf(d.y);
    f32x2 q = t * 0.5307027145f + (-0.7265760135f); q = q * t + 0.7107068705f; q = q * t + (-0.142248368f); q = q * t + 0.127414796f; q = q * t;
    const f32x2 s = (v * v) * (-0.72134752044f);
    f32x2 e; e.x = __builtin_amdgcn_exp2f(s.x); e.y = __builtin_amdgcn_exp2f(s.y);
    const f32x2 m = v * (q * e), r = v - m;
    f32x2 o; o.x = v.x < 0.f ? m.x : r.x; o.y = v.y < 0.f ? m.y : r.y; return o;
}

typedef int i32x4v __attribute__((ext_vector_type(4)));
typedef int i32x8v __attribute__((ext_vector_type(8)));
__device__ __forceinline__ i32x8v cat8(bf16x8 lo, bf16x8 hi) { return __builtin_shufflevector(__builtin_bit_cast(i32x4v, lo), __builtin_bit_cast(i32x4v, hi), 0, 1, 2, 3, 4, 5, 6, 7); }
template <class Epi, class Sched, bool ALIGN_EPI = false, bool SP2 = false, int QM = 0>
__device__ __forceinline__ void gemm_phase(PG8_LAS unsigned char* lds, const Gemm g, const Sched& S, const Epi& E) {
    const int tid = threadIdx.x, wid = __builtin_amdgcn_readfirstlane(tid >> 6), lane = tid & 63, wr = wid >> 2, wc = wid & 3, fr = lane & 15, fq = lane >> 4;
    constexpr bool F8 = QM == 1, I8 = QM == 2;
    const int K = g.K, KB = QM ? K : 2 * K  , nt = KB / (BK * 2);
    unsigned voffA[2], voffB[2];
#pragma unroll
    for (int i = 0; i < 2; ++i) { int R, C; stage_rc(tid * 16 + i * 8192, R, C); const int Rb = Epi::PERM ? ((R & ~31) + perm32(R & 31)) : R;
        voffA[i] = (unsigned)(R * KB + C * 2); voffB[i] = (unsigned)(Rb * KB + C * 2); }
    const size_t kstep = (size_t)(BK * 2);
    const size_t hstep = (size_t)HALF * KB;
    const size_t tstep = 2 * hstep;
    const unsigned ldsw = (unsigned)wid * 1024u;
    const int aoff = lds_byte(wr * 64 + fr, fq * 8), boff = lds_byte(wc * 32 + fr, fq * 8);
#define PG8_SA(b, h) (((b) * 2 + (h)) * HTB)
#define PG8_SB(b, h) ((4 + (b) * 2 + (h)) * HTB)
#define PG8_STAGE(bufoff, gbase, voff) do { _Pragma("unroll") for (int _i = 0; _i < 2; ++_i) \
        __builtin_amdgcn_global_load_lds((const unsigned*)((const char*)(gbase) + (voff)[_i]), (PG8_LAS unsigned*)(lds + (bufoff) + ldsw + _i * 8192), 16, 0, 0); } while (0)
#define PG8_LD16(off) (*(const PG8_LAS bf16x8*)(lds + (off)))
#define PG8_LDA(dst, b, h) do { _Pragma("unroll") for (int m = 0; m < 4; ++m) { if constexpr (F8) dst##8[m] = cat8(PG8_LD16(PG8_SA(b, h) + aoff + m * 2048), PG8_LD16(PG8_SA(b, h) + aoff + m * 2048 + 1024)); \
        else { _Pragma("unroll") for (int k = 0; k < 2; ++k) dst[m][k] = PG8_LD16(PG8_SA(b, h) + aoff + m * 2048 + k * 1024); } } } while (0)
#define PG8_LDB(dst, b, h) do { _Pragma("unroll") for (int n = 0; n < 2; ++n) { if constexpr (F8) dst##8[n] = cat8(PG8_LD16(PG8_SB(b, h) + boff + n * 2048), PG8_LD16(PG8_SB(b, h) + boff + n * 2048 + 1024)); \
        else { _Pragma("unroll") for (int k = 0; k < 2; ++k) dst[n][k] = PG8_LD16(PG8_SB(b, h) + boff + n * 2048 + k * 1024); } } } while (0)
#define PG8_MMA(ai, bj, At, Bt) do { __builtin_amdgcn_s_setprio(1); _Pragma("unroll") for (int m = 0; m < 4; ++m) _Pragma("unroll") for (int n = 0; n < 2; ++n) { \
        if constexpr (F8) asm volatile("v_mfma_f32_16x16x128_f8f6f4 %0, %1, %2, %0" : "+v"(acc[ai][bj][m][n]) : "v"(Bt##8[n]), "v"(At##8[m])); \
        else if constexpr (I8) { _Pragma("unroll") for (int k = 0; k < 2; ++k) acc[ai][bj][m][n] = __builtin_bit_cast(f32x4, __builtin_amdgcn_mfma_i32_16x16x64_i8(__builtin_bit_cast(i32x4v, Bt[n][k]), __builtin_bit_cast(i32x4v, At[m][k]), __builtin_bit_cast(i32x4v, acc[ai][bj][m][n]), 0, 0, 0)); } \
        else { _Pragma("unroll") for (int k = 0; k < 2; ++k) acc[ai][bj][m][n] = __builtin_amdgcn_mfma_f32_16x16x32_bf16(Bt[n][k], At[m][k], acc[ai][bj][m][n], 0, 0, 0); } } \
        __builtin_amdgcn_s_setprio(0); } while (0)
#define PG8_WAIT_V(n) asm volatile("s_waitcnt vmcnt(" #n ")" ::: "memory")
#define PG8_WAIT_L(n) asm volatile("s_waitcnt lgkmcnt(" #n ")" ::: "memory")
#define PG8_BAR __builtin_amdgcn_s_barrier()
#define PG8_SCHED __builtin_amdgcn_sched_barrier(0)
    Unit cur, nxt; int ui = 0;
    if (!S.next(0, cur)) return;
    f32x4 acc[2][2][4][2];
#pragma unroll
    for (int a = 0; a < 2; ++a)
#pragma unroll
        for (int b = 0; b < 2; ++b)
#pragma unroll
            for (int m = 0; m < 4; ++m)
#pragma unroll
                for (int n = 0; n < 2; ++n) acc[a][b][m][n] = (f32x4){0.f, 0.f, 0.f, 0.f};
    bf16x8 At[4][2], B0[2][2], B1[2][2]; i32x8v At8[4], B08[2], B18[2];
    const char* cA = (const char*)g.A + (size_t)cur.pm * tstep; const char* cB = (const char*)g.Bt + (size_t)cur.pn * tstep;
    S.a_ready(cur);
    if constexpr (SP2) {
        PG8_STAGE(PG8_SB(0, 0), cB, voffB); PG8_STAGE(PG8_SB(0, 1), cB + hstep, voffB); PG8_STAGE(PG8_SA(0, 0), cA, voffA); PG8_STAGE(PG8_SA(0, 1), cA + hstep, voffA);
        if (wr == 1) PG8_BAR;
        PG8_WAIT_V(2); PG8_BAR;
        PG8_STAGE(PG8_SB(1, 0), cB + kstep, voffB); PG8_STAGE(PG8_SA(1, 0), cA + kstep, voffA); PG8_STAGE(PG8_SB(1, 1), cB + hstep + kstep, voffB);
        PG8_WAIT_V(6); PG8_BAR;
    } else {
        PG8_STAGE(PG8_SB(0, 0), cB, voffB); PG8_STAGE(PG8_SA(0, 0), cA, voffA); PG8_STAGE(PG8_SB(0, 1), cB + hstep, voffB); PG8_STAGE(PG8_SA(0, 1), cA + hstep, voffA);
        if (wr == 1) PG8_BAR;
        PG8_WAIT_V(4); PG8_BAR;
        PG8_STAGE(PG8_SB(1, 0), cB + kstep, voffB); PG8_STAGE(PG8_SA(1, 0), cA + kstep, voffA); PG8_STAGE(PG8_SB(1, 1), cB + hstep + kstep, voffB);
        PG8_WAIT_V(6); PG8_BAR;
    }
    for (;;) {
        const bool has_next = S.next(ui + 1, nxt);
        const char* nA = has_next ? (const char*)g.A + (size_t)nxt.pm * tstep : cA; const char* nB = has_next ? (const char*)g.Bt + (size_t)nxt.pn * tstep : cB;
        for (int t = 0; t < nt; t += 2) {
            const bool last = (t == nt - 2);
            const char* a1 = cA + (size_t)(t + 1) * kstep;
            const char* a2 = last ? nA : cA + (size_t)(t + 2) * kstep; const char* b2 = last ? nB : cB + (size_t)(t + 2) * kstep;
            const char* a3 = a2 + kstep; const char* b3 = b2 + kstep;
            if (last && has_next) S.a_ready(nxt);
            if constexpr (SP2) {
            PG8_LDB(B0, 0, 0); PG8_LDB(B1, 0, 1); PG8_SCHED; PG8_LDA(At, 0, 0); PG8_STAGE(PG8_SA(1, 1), a1 + hstep, voffA);
            PG8_WAIT_V(8); PG8_WAIT_L(0); PG8_BAR; PG8_MMA(0, 0, At, B0); PG8_MMA(0, 1, At, B1); PG8_BAR; PG8_SCHED;
            PG8_LDA(At, 0, 1); PG8_STAGE(PG8_SB(0, 0), b2, voffB); PG8_STAGE(PG8_SB(0, 1), b2 + hstep, voffB); PG8_STAGE(PG8_SA(0, 0), a2, voffA);
            PG8_WAIT_V(8); PG8_WAIT_L(0); PG8_BAR; PG8_MMA(1, 0, At, B0); PG8_MMA(1, 1, At, B1); PG8_BAR; PG8_SCHED;
            PG8_LDB(B0, 1, 0); PG8_LDB(B1, 1, 1); PG8_SCHED; PG8_LDA(At, 1, 0); PG8_STAGE(PG8_SA(0, 1), a2 + hstep, voffA);
            PG8_WAIT_V(8); PG8_WAIT_L(0); PG8_BAR; PG8_MMA(0, 0, At, B0); PG8_MMA(0, 1, At, B1); PG8_BAR; PG8_SCHED;
            PG8_LDA(At, 1, 1); PG8_STAGE(PG8_SB(1, 0), b3, voffB); PG8_STAGE(PG8_SB(1, 1), b3 + hstep, voffB); PG8_STAGE(PG8_SA(1, 0), a3, voffA);
            PG8_WAIT_V(8); PG8_WAIT_L(0); PG8_BAR; PG8_MMA(1, 0, At, B0); PG8_MMA(1, 1, At, B1); PG8_BAR; PG8_SCHED;
            } else {
            PG8_LDB(B0, 0, 0); PG8_SCHED; PG8_LDA(At, 0, 0); PG8_STAGE(PG8_SA(1, 1), a1 + hstep, voffA);
            PG8_WAIT_L(8); PG8_BAR; PG8_WAIT_L(0); PG8_MMA(0, 0, At, B0); PG8_BAR; PG8_SCHED;
            PG8_LDB(B1, 0, 1); PG8_STAGE(PG8_SB(0, 0), b2, voffB);
            PG8_BAR; PG8_WAIT_L(0); PG8_MMA(0, 1, At, B1); PG8_BAR;
            PG8_LDA(At, 0, 1); PG8_STAGE(PG8_SA(0, 0), a2, voffA);
            PG8_BAR; PG8_WAIT_L(0); PG8_MMA(1, 0, At, B0); PG8_BAR; PG8_SCHED;
            PG8_STAGE(PG8_SB(0, 1), b2 + hstep, voffB);
            PG8_WAIT_V(6); PG8_BAR; PG8_MMA(1, 1, At, B1); PG8_BAR;
            PG8_LDB(B0, 1, 0); PG8_SCHED; PG8_LDA(At, 1, 0); PG8_STAGE(PG8_SA(0, 1), a2 + hstep, voffA);
            PG8_WAIT_L(8); PG8_BAR; PG8_WAIT_L(0); PG8_MMA(0, 0, At, B0); PG8_BAR; PG8_SCHED;
            PG8_LDB(B1, 1, 1); PG8_STAGE(PG8_SB(1, 0), b3, voffB);
            PG8_BAR; PG8_WAIT_L(0); PG8_MMA(0, 1, At, B1); PG8_BAR;
            PG8_LDA(At, 1, 1); PG8_STAGE(PG8_SA(1, 0), a3, voffA);
            PG8_BAR; PG8_WAIT_L(0); PG8_MMA(1, 0, At, B0); PG8_BAR; PG8_SCHED;
            PG8_STAGE(PG8_SB(1, 1), b3 + hstep, voffB);
            PG8_WAIT_V(6); PG8_BAR; PG8_MMA(1, 1, At, B1); PG8_BAR;
            }
        }
        if constexpr (ALIGN_EPI) { if (wr == 0) PG8_BAR; }
        if constexpr (F8) asm volatile("s_nop 15\n\ts_nop 15" ::: "memory");
        if constexpr (!Epi::AFTER_DRAIN) { E(acc, cur, wr, wc, fr, fq); S.done(cur); }
        if (!has_next) break;
#pragma unroll
        for (int a = 0; a < 2; ++a)
#pragma unroll
            for (int b = 0; b < 2; ++b)
#pragma unroll
                for (int m = 0; m < 4; ++m)
#pragma unroll
                    for (int n = 0; n < 2; ++n) acc[a][b][m][n] = (f32x4){0.f, 0.f, 0.f, 0.f};
        cur = nxt; cA = nA; cB = nB; ++ui;
        if constexpr (ALIGN_EPI) { if (wr == 1) PG8_BAR; }
    }
    PG8_WAIT_V(0);
    if constexpr (!ALIGN_EPI) { if (wr == 0) PG8_BAR; }
    PG8_BAR;
    if constexpr (Epi::AFTER_DRAIN) { E.fused(acc, cur, wr, wc, fr, fq, lds, wid, lane); S.done(cur); }
#undef PG8_SA
#undef PG8_SB
#undef PG8_STAGE
#undef PG8_LD16
#undef PG8_LDA
#undef PG8_LDB
#undef PG8_MMA
#undef PG8_WAIT_V
#undef PG8_WAIT_L
#undef PG8_BAR
#undef PG8_SCHED
}
}
typedef unsigned short bf16;
typedef unsigned v4u __attribute__((ext_vector_type(4)));
typedef unsigned v2u __attribute__((ext_vector_type(2)));
typedef float f32x4 __attribute__((ext_vector_type(4)));
typedef float f32x2 __attribute__((ext_vector_type(2)));
typedef short bf16x8 __attribute__((ext_vector_type(8)));
typedef GAS unsigned gu32;
#define RLX_AGENT __ATOMIC_RELAXED, __HIP_MEMORY_SCOPE_AGENT
#define LDS_WAIT() asm volatile("s_waitcnt lgkmcnt(0)" ::: "memory")
#define VM_WAIT() asm volatile("s_waitcnt vmcnt(0)" ::: "memory")
typedef __bf16 bf16x2_hw __attribute__((ext_vector_type(2)));
__device__ __forceinline__ unsigned pk2(float lo, float hi) { const f32x2 v = {lo, hi}; const bf16x2_hw b = __builtin_convertvector(v, bf16x2_hw); return __builtin_bit_cast(unsigned, b); }
__device__ __forceinline__ unsigned pk4f8(float a, float b, float c, float d) { int w = 0; w = __builtin_amdgcn_cvt_pk_fp8_f32(a, b, w, false); w = __builtin_amdgcn_cvt_pk_fp8_f32(c, d, w, true); return (unsigned)w; }
__device__ __forceinline__ float cvt_ub0(unsigned w) { float f; asm("v_cvt_f32_ubyte0 %0, %1" : "=v"(f) : "v"(w)); return f; }
__device__ __forceinline__ float cvt_ub1(unsigned w) { float f; asm("v_cvt_f32_ubyte1 %0, %1" : "=v"(f) : "v"(w)); return f; }
__device__ __forceinline__ float cvt_ub2(unsigned w) { float f; asm("v_cvt_f32_ubyte2 %0, %1" : "=v"(f) : "v"(w)); return f; }
__device__ __forceinline__ float cvt_ub3(unsigned w) { float f; asm("v_cvt_f32_ubyte3 %0, %1" : "=v"(f) : "v"(w)); return f; }
__device__ __forceinline__ unsigned f2bf(float f) { return pk2(f, 0.f) & 0xffffu; }
__device__ __forceinline__ float bflo(unsigned w) { return __builtin_bit_cast(float, w << 16); }
__device__ __forceinline__ float bfhi(unsigned w) { return __builtin_bit_cast(float, w & 0xffff0000u); }
__device__ __forceinline__ float bf1(bf16 b) { return __builtin_bit_cast(float, ((unsigned)b) << 16); }
__device__ __forceinline__ float fast_exp(float x) { return __builtin_amdgcn_exp2f(x * 1.4426950408889634f); }
__device__ __forceinline__ float fast_rcp(float x) { return __builtin_amdgcn_rcpf(x); }
__device__ __forceinline__ float sigmoidf_(float x) { return fast_rcp(1.0f + fast_exp(-x)); }
__device__ __forceinline__ float siluf_(float x) { return x * sigmoidf_(x); }
template <int CTRL> __device__ __forceinline__ float dppf(float v) { return __builtin_bit_cast(float, __builtin_amdgcn_mov_dpp(__builtin_bit_cast(int, v), CTRL, 0xF, 0xF, true)); }
template <int CTRL> __device__ __forceinline__ int dppi(int v) { return __builtin_amdgcn_mov_dpp(v, CTRL, 0xF, 0xF, true); }
__device__ __forceinline__ float rdl(float v, int l) { return __builtin_bit_cast(float, __builtin_amdgcn_readlane(__builtin_bit_cast(int, v), l)); }
__device__ __forceinline__ float wave_sum(float v) {
    v += dppf<0xB1>(v); v += dppf<0x4E>(v); v += dppf<0x141>(v); v += dppf<0x140>(v);
    return (rdl(v, 0) + rdl(v, 16)) + (rdl(v, 32) + rdl(v, 48));
}
__device__ __forceinline__ float wave_max(float v) {
    v = fmaxf(v, dppf<0xB1>(v)); v = fmaxf(v, dppf<0x4E>(v)); v = fmaxf(v, dppf<0x141>(v)); v = fmaxf(v, dppf<0x140>(v));
    return fmaxf(fmaxf(rdl(v, 0), rdl(v, 16)), fmaxf(rdl(v, 32), rdl(v, 48)));
}
__device__ __forceinline__ int wave_sum_i(int v) {
    v += dppi<0xB1>(v); v += dppi<0x4E>(v); v += dppi<0x141>(v); v += dppi<0x140>(v);
    return (__builtin_amdgcn_readlane(v, 0) + __builtin_amdgcn_readlane(v, 16)) + (__builtin_amdgcn_readlane(v, 32) + __builtin_amdgcn_readlane(v, 48));
}

constexpr int NWAVES = 8, NTHR = 512;
constexpr int SEQ = 16384, DM = 2048, NH = 8, HD = 128, HW = 1024;
constexpr int CK = 64, NCHUNK = SEQ / CK, NSEG = 16, CPS = NCHUNK / NSEG;
constexpr int INW = 13344;
constexpr int N1 = 9216;
constexpr float EPS = 1e-6f;
constexpr int PEER_K = 16;

constexpr size_t MiB = (size_t)1 << 20;
constexpr size_t WS_CTL = 0, CTL_ZERO_BYTES = 1 * MiB;
constexpr size_t WS_WG = 2 * MiB, WS_WPA = 18 * MiB, WS_WPB = 22 * MiB, WS_WOUT = 26 * MiB, WS_WS = 34 * MiB, WS_W1 = 42 * MiB;
constexpr size_t WS_XN = 80 * MiB;
constexpr size_t WS_H = 144 * MiB;
constexpr size_t WS_GAB = 432 * MiB;
constexpr size_t WS_HL = 434 * MiB;
constexpr size_t WS_HDS = 450 * MiB;
constexpr size_t WS_OHF = 452 * MiB, WS_OHB = 484 * MiB;
constexpr size_t WS_GSC = 516 * MiB;
constexpr size_t WS_UTF = 144 * MiB, WS_UTB = 176 * MiB, WS_WF = 208 * MiB, WS_WB = 240 * MiB;
constexpr size_t DO_AQKF = 0, DO_AQKB = 16 * MiB, DO_QN = 32 * MiB, DO_KNT = 64 * MiB;
constexpr size_t WS_GL = 42 * MiB, WS_GP = 58 * MiB;
constexpr size_t WS_OGF = 304 * MiB, WS_OGB = 336 * MiB;
constexpr size_t WS_YA = 42 * MiB, WS_YB = 368 * MiB;
constexpr size_t WS_TU = 144 * MiB, WS_TV = 176 * MiB;
constexpr size_t WS_PSC = 520 * MiB;
constexpr size_t WS_GT = 272 * MiB, WS_GT2 = 400 * MiB;
constexpr size_t WS_X1B = 400 * MiB;
constexpr size_t WS_SC = 272 * MiB;
constexpr size_t WS_END = 536 * MiB;
#ifndef QM_G1_
#define QM_G1_ 2
#endif
#ifndef QM_GATE_
#define QM_GATE_ 2
#endif
#ifndef QM_MIX_
#define QM_MIX_ 2
#endif
#ifndef QM_OUT_
#define QM_OUT_ 0
#endif
constexpr int QM_G1 = QM_G1_, QM_GATE = QM_GATE_, QM_MIX = QM_MIX_, QM_OUT = QM_OUT_;
constexpr int QM_XN = QM_G1 ? QM_G1 : QM_GATE;
static_assert(QM_G1 == 0 || QM_GATE == 0 || QM_G1 == QM_GATE, "xn has one 8-bit copy");
static_assert(QM_OUT != 2, "merged has no row scale");
constexpr float F8_WSCALE = 128.0f;
constexpr size_t WS_WAB = 78 * MiB;
constexpr size_t DO_XN8 = 96 * MiB;
constexpr size_t WS_GT8 = 336 * MiB;
constexpr size_t WS_QW = 521 * MiB;
constexpr int QW_W1 = 0, QW_WG = 9216, QW_WPA = 13312, QW_WPB = 15360, QW_WOUT = 17408, QW_WAB = 19456;
constexpr bool AB_I8 = QM_XN == 2;
constexpr bool XN_BF16 = QM_G1 == 0 || QM_GATE == 0 || !AB_I8;
constexpr size_t WS_QX = 522 * MiB;
#ifndef VFMT
#define VFMT 4
#endif
#ifndef FP6_IL
#define FP6_IL 1
#endif
constexpr int TV_PITCH = (VFMT == 6 || VFMT == 64) ? 1536 : VFMT == 4 ? 1024 : 2048;
#ifndef VMIX_C
#define VMIX_C 1.0f
#endif
constexpr size_t WS_TV4 = 240 * MiB;
typedef float v16f __attribute__((ext_vector_type(16)));
typedef float v32f __attribute__((ext_vector_type(32)));
typedef unsigned v6u __attribute__((ext_vector_type(6)));
constexpr int CW_BAR = 4096;

constexpr int LDS_BYTES = 163840;
constexpr int MISC_OFF = 163840 - 256;
constexpr int LDS_USABLE = MISC_OFF;

__device__ __forceinline__ bf16x8 ldfrag(const LAS bf16* T, int pitch, int row, int k) { return *(const LAS bf16x8*)(T + row * pitch + k); }
__device__ __forceinline__ f32x4 mfma16(bf16x8 x, bf16x8 y, f32x4 c) { return __builtin_amdgcn_mfma_f32_16x16x32_bf16(x, y, c, 0, 0, 0); }
__device__ __forceinline__ v2u pack4(f32x4 v) { v2u r; r.x = pk2(v[0], v[1]); r.y = pk2(v[2], v[3]); return r; }
#define XB_TMO      128
#define XB_XCNT(j)  (256  + 64 * (j))
#define XB_XSUB(j)  (1280 + 64 * (j))
#define XB_XGEN(j)  (2304 + 64 * (j))
#define XB_TOP      3328
#define XB_TOPGEN   3392
#define XCD_BAR_WORDS 3456
#define XB_SPIN_CAP (1u << 18)

__device__ __forceinline__ unsigned xb_ld(unsigned* p)              { return __hip_atomic_load(p, __ATOMIC_RELAXED, __HIP_MEMORY_SCOPE_AGENT); }
__device__ __forceinline__ unsigned xb_add(unsigned* p, unsigned v) { return __hip_atomic_fetch_add(p, v, __ATOMIC_RELAXED, __HIP_MEMORY_SCOPE_AGENT); }
__device__ __forceinline__ unsigned xb_xcc_id() { return (unsigned)__builtin_amdgcn_s_getreg((3 << 11) | 20) & 0xFu; }
#define XB_SPIN(cond, bar) do { unsigned _sp = 0; while (cond) { __builtin_amdgcn_s_sleep(1); \
    if ((++_sp & 255u) == 0u) { if (xb_ld(&(bar)[XB_TMO])) break; if (_sp > XB_SPIN_CAP) { atomicAdd(&(bar)[XB_TMO], 1u); break; } } } } while (0)

struct XcdBarrier {
    unsigned* bar; unsigned x;
    volatile LAS unsigned* st;
};

__device__ __forceinline__ XcdBarrier xcd_barrier_post(unsigned* bar, volatile LAS unsigned* st) {
    XcdBarrier b; b.bar = bar; b.x = xb_xcc_id(); b.st = st;
    if (threadIdx.x == 0) (void)xb_add(&bar[XB_XCNT(b.x)], 1u);
    return b;
}
__device__ __forceinline__ void xcd_barrier_complete(unsigned* bar, unsigned x, unsigned& nloc, unsigned& nx) {
    const unsigned G = gridDim.x * gridDim.y * gridDim.z;
    unsigned sum, cnt, mine, sp = 0u;
    for (;;) {
        sum = 0u; cnt = 0u; mine = 0u;
#pragma unroll
        for (unsigned j = 0; j < 16; ++j) { const unsigned c = xb_ld(&bar[XB_XCNT(j)]); sum += c; cnt += (c > 0u) ? 1u : 0u; mine = (j == x) ? c : mine; }
        if (sum == G) break;
        __builtin_amdgcn_s_sleep(1);
        if ((++sp & 255u) == 0u) { if (xb_ld(&bar[XB_TMO])) break; if (sp > XB_SPIN_CAP) { atomicAdd(&bar[XB_TMO], 1u); break; } }
    }
    nloc = mine > 0u ? mine : 1u; nx = cnt > 0u ? cnt : 1u;
}

__device__ __forceinline__ void xcd_barrier(const XcdBarrier& b) {
    asm volatile("s_waitcnt vmcnt(0)" ::: "memory");
    __syncthreads();
    if (threadIdx.x == 0) {
        unsigned* bar = b.bar;
        __builtin_amdgcn_s_waitcnt(0);
        unsigned nloc = b.st[0], nx = b.st[1];
        if (nloc == 0u) { xcd_barrier_complete(bar, b.x, nloc, nx); b.st[0] = nloc; b.st[1] = nx; }
        const unsigned old = xb_add(&bar[XB_XSUB(b.x)], 1u);
        const unsigned gen = old / nloc;
        if (old + 1u == (gen + 1u) * nloc) {
            __builtin_amdgcn_fence(__ATOMIC_RELEASE, "agent");
            asm volatile("s_waitcnt vmcnt(0)" ::: "memory");
            const unsigned og = xb_add(&bar[XB_TOP], 1u);
            const unsigned tg = og / nx;
            if (og + 1u == (tg + 1u) * nx) xb_add(&bar[XB_TOPGEN], 1u);
            else XB_SPIN(xb_ld(&bar[XB_TOPGEN]) == tg, bar);
            __builtin_amdgcn_fence(__ATOMIC_ACQUIRE, "agent");
            xb_add(&bar[XB_XGEN(b.x)], 1u);
            asm volatile("s_waitcnt vmcnt(0)" ::: "memory");
        } else {
            XB_SPIN(xb_ld(&bar[XB_XGEN(b.x)]) == gen, bar);
            __builtin_amdgcn_fence(__ATOMIC_ACQUIRE, "agent");
            asm volatile("s_waitcnt vmcnt(0)" ::: "memory");
        }
    }
    __syncthreads();
}

struct Frame {
    LAS unsigned char* lds;
    volatile LAS unsigned* MISC;
    gu32* ctl;
    int tid, lane, wave, vcu, G;
    const float* in[19]; float* out; unsigned char* ws;
};
enum { I_X = 0, I_N1W, I_WIN, I_LB, I_HNW, I_CONVW, I_ALOG, I_DTB, I_GNW, I_WPA, I_WPB, I_WOUT, I_N2W, I_WQ, I_K1, I_K2, I_PU, I_PV, I_FNW };

template <bool F8>
__device__ __forceinline__ void p0_transpose_item(const float* W, int ldw, int c0, int K, int ncols, void* WTv, int row_off, LAS float* scr, int item, int lane) {
    const int nblk = ncols / 32, kb = item / nblk, nb = item % nblk, k0 = 64 * kb, n0 = 32 * nb;
#pragma unroll 8
    for (int i = 0; i < 32; ++i) { const int kk = 2 * i + (lane >> 5); scr[kk * 33 + (lane & 31)] = W[(size_t)(k0 + kk) * ldw + c0 + n0 + (lane & 31)]; }
    LDS_WAIT(); asm volatile("" ::: "memory");
    const int c = lane & 7;
#pragma unroll
    for (int j = 0; j < 4; ++j) { const int n = (lane >> 3) + 8 * j; const LAS float* s = scr + (8 * c) * 33 + n;
        if (F8) { v2u o; o.x = pk4f8(s[0 * 33] * F8_WSCALE, s[1 * 33] * F8_WSCALE, s[2 * 33] * F8_WSCALE, s[3 * 33] * F8_WSCALE); o.y = pk4f8(s[4 * 33] * F8_WSCALE, s[5 * 33] * F8_WSCALE, s[6 * 33] * F8_WSCALE, s[7 * 33] * F8_WSCALE);
            *(GAS v2u*)((unsigned char*)WTv + (size_t)(row_off + n0 + n) * K + k0 + 8 * c) = o; }
        else { v4u o; o.x = pk2(s[0 * 33], s[1 * 33]); o.y = pk2(s[2 * 33], s[3 * 33]); o.z = pk2(s[4 * 33], s[5 * 33]); o.w = pk2(s[6 * 33], s[7 * 33]);
            *(GAS v4u*)((bf16*)WTv + (size_t)(row_off + n0 + n) * K + k0 + 8 * c) = o; } }
    LDS_WAIT(); asm volatile("" ::: "memory");
}
__device__ __forceinline__ unsigned pk4i8(f32x4 v, float inv) {
    const int a = (int)rintf(v.x * inv), b = (int)rintf(v.y * inv), c = (int)rintf(v.z * inv), d = (int)rintf(v.w * inv);
    return (unsigned)(a & 255) | ((unsigned)(b & 255) << 8) | ((unsigned)(c & 255) << 16) | ((unsigned)d << 24);
}
__device__ __forceinline__ float amax4(f32x4 v) { const f32x4 a = __builtin_elementwise_abs(v); return fmaxf(fmaxf(a.x, a.y), fmaxf(a.z, a.w)); }
__device__ __forceinline__ void rms_row_to_bf16(int lane, const float* xrow, const float* w, bf16* orow, unsigned char* orow8, float* sx) {
    const GAS f32x4* xr = (const GAS f32x4*)xrow + lane; const GAS f32x4* wr = (const GAS f32x4*)w + lane;
    f32x4 v[8]; float s = 0.f;
#pragma unroll
    for (int j = 0; j < 8; ++j) { v[j] = xr[64 * j]; s += (v[j].x * v[j].x + v[j].y * v[j].y) + (v[j].z * v[j].z + v[j].w * v[j].w); }
    const float r = 1.0f / sqrtf(wave_sum(s) * (1.f / DM) + EPS);
    GAS v2u* o8 = (GAS v2u*)orow + lane; GAS unsigned* q8 = (GAS unsigned*)orow8 + lane; float am = 0.f;
#pragma unroll
    for (int j = 0; j < 8; ++j) { const f32x4 ww = wr[64 * j]; const f32x4 y = {v[j].x * r * ww.x, v[j].y * r * ww.y, v[j].z * r * ww.z, v[j].w * r * ww.w};
        if (XN_BF16) { v2u o; o.x = pk2(y.x, y.y); o.y = pk2(y.z, y.w); o8[64 * j] = o; }
        if (QM_XN == 1) q8[64 * j] = pk4f8(y.x, y.y, y.z, y.w);
        if (QM_XN == 2) { v[j] = y; am = fmaxf(am, amax4(y)); } }
    if (QM_XN == 2) { am = wave_max(am); const float inv = am > 0.f ? 127.0f / am : 0.f;
#pragma unroll
        for (int j = 0; j < 8; ++j) q8[64 * j] = pk4i8(v[j], inv);
        if (lane == 0) *sx = am > 0.f ? am * (1.0f / 127.0f) : 1.0f; }
}
template <int KT>
__device__ __forceinline__ void p0_quant_item(Frame& F, const float* W, int ldw, int c0, signed char* Wq, float* scl, int n0) {
    constexpr int KW = KT / 8, NB = KW / 64;
    const int col = F.lane & 31, kh = F.lane >> 5;
    const GAS float* src = (const GAS float*)W + (size_t)(F.wave * KW + 32 * kh) * ldw + c0 + n0 + col;
    float v[NB][32]; float mx = 0.f;
#pragma unroll
    for (int b = 0; b < NB; ++b)
#pragma unroll
        for (int i = 0; i < 32; ++i) v[b][i] = src[(size_t)(64 * b + i) * ldw];
#pragma unroll
    for (int b = 0; b < NB; ++b)
#pragma unroll
        for (int i = 0; i < 32; ++i) mx = fmaxf(mx, fabsf(v[b][i]));
    mx = fmaxf(mx, __shfl_xor(mx, 32));
    LAS float* part = (LAS float*)F.lds;
    if (kh == 0) part[F.wave * 32 + col] = mx;
    __syncthreads();
    float cm = part[col];
#pragma unroll
    for (int w = 1; w < 8; ++w) cm = fmaxf(cm, part[w * 32 + col]);
    const float inv = cm > 0.f ? 127.0f / cm : 0.f;
    if (F.wave == 0 && kh == 0) scl[n0 + col] = cm > 0.f ? cm * (1.0f / 127.0f) : 1.0f;
    GAS v4u* dst = (GAS v4u*)(Wq + (size_t)(n0 + col) * KT + F.wave * KW + 32 * kh);
#pragma unroll
    for (int b = 0; b < NB; ++b) { unsigned w[8];
#pragma unroll
        for (int q = 0; q < 8; ++q) w[q] = pk4i8((f32x4){v[b][4 * q], v[b][4 * q + 1], v[b][4 * q + 2], v[b][4 * q + 3]}, inv);
        dst[4 * b] = (v4u){w[0], w[1], w[2], w[3]}; dst[4 * b + 1] = (v4u){w[4], w[5], w[6], w[7]}; }
    __syncthreads();
}
__device__ __forceinline__ void p0_ws_item(Frame& F, int it) {
    const int h = it >> 6, half = (it >> 5) & 1, j0 = (it & 31) * 64, hc = h * 256 + half * 128;
    const float* Wq = F.in[I_WQ]; const float* Ks = half ? F.in[I_K2] : F.in[I_K1]; const float* n2 = F.in[I_N2W];
    LAS bf16* Xs = (LAS bf16*)F.lds; LAS bf16* Ys = Xs + 64 * 136;
    { const int row = F.tid >> 3, c0 = (F.tid & 7) * 16; const GAS f32x4* src = (const GAS f32x4*)(Wq + (size_t)(j0 + row) * DM + hc + c0);
      const f32x4 a = src[0], b = src[1], c = src[2], d = src[3];
      v4u o0, o1; o0.x = pk2(a.x, a.y); o0.y = pk2(a.z, a.w); o0.z = pk2(b.x, b.y); o0.w = pk2(b.z, b.w); o1.x = pk2(c.x, c.y); o1.y = pk2(c.z, c.w); o1.z = pk2(d.x, d.y); o1.w = pk2(d.z, d.w);
      *(LAS v4u*)(Xs + row * 136 + c0) = o0; *(LAS v4u*)(Xs + row * 136 + c0 + 8) = o1; }
    { const int row = F.tid >> 2, c0 = (F.tid & 3) * 32; const GAS f32x4* src = (const GAS f32x4*)(Ks + (size_t)row * 128 + c0);
#pragma unroll
      for (int q = 0; q < 4; ++q) { const f32x4 a = src[2 * q], b = src[2 * q + 1]; v4u o; o.x = pk2(a.x, a.y); o.y = pk2(a.z, a.w); o.z = pk2(b.x, b.y); o.w = pk2(b.z, b.w); *(LAS v4u*)(Ys + row * 136 + c0 + 8 * q) = o; } }
    __syncthreads();
    const int fr = F.lane & 15, fq = F.lane >> 4, w = F.wave;
    bf16* WSt = (bf16*)(F.ws + WS_WS);
#pragma unroll
    for (int jt = 0; jt < 4; ++jt) {
        f32x4 acc = {0.f, 0.f, 0.f, 0.f};
#pragma unroll
        for (int k0 = 0; k0 < 4; ++k0) acc = mfma16(ldfrag(Xs, 136, 16 * jt + fr, 32 * k0 + 8 * fq), ldfrag(Ys, 136, 16 * w + fr, 32 * k0 + 8 * fq), acc);
        const int jj = j0 + 16 * jt + 4 * fq; const f32x4 nw = *(const GAS f32x4*)(n2 + jj);
        *(GAS v2u*)(WSt + (size_t)(hc + 16 * w + fr) * DM + jj) = pack4(acc * nw);
    }
    __syncthreads();
}
__device__ __forceinline__ void p0_prologue(Frame& F) {
    LAS float* scr = (LAS float*)(F.lds + F.wave * 16384);
    const int gw = F.vcu * NWAVES + F.wave, NGW = F.G * NWAVES;
    constexpr int I_1 = QM_G1 == 2 ? 0 : (DM / 64) * (N1 / 32), I_AB = AB_I8 ? 0 : (DM / 64), I_G = QM_GATE == 2 ? 0 : (DM / 64) * (4096 / 32), I_PA = QM_MIX == 2 ? 0 : (HW / 64) * (DM / 32), I_O = QM_OUT == 2 ? 0 : (DM / 64) * (DM / 32);
    constexpr int NITEMS = I_1 + I_AB + I_G + 2 * I_PA + I_O;
    for (int it = gw; it < NITEMS; it += NGW) {
        int r = it;
        if (r < I_1) { p0_transpose_item<QM_G1 == 1>(F.in[I_WIN], INW, 0, DM, N1, F.ws + WS_W1, 0, scr, r, F.lane); continue; } r -= I_1;
        if (r < I_AB) { p0_transpose_item<false>(F.in[I_WIN], INW, N1, DM, 32, F.ws + WS_WAB, 0, scr, r, F.lane); continue; } r -= I_AB;
        if (r < I_G) { p0_transpose_item<QM_GATE == 1>(F.in[I_WIN], INW, 9248, DM, 4096, F.ws + WS_WG, 0, scr, r, F.lane); continue; } r -= I_G;
        if (r < I_PA) { p0_transpose_item<QM_MIX == 1>(F.in[I_WPA], DM, 0, HW, DM, F.ws + WS_WPA, 0, scr, r, F.lane); continue; } r -= I_PA;
        if (r < I_PA) { p0_transpose_item<QM_MIX == 1>(F.in[I_WPB], DM, 0, HW, DM, F.ws + WS_WPB, 0, scr, r, F.lane); continue; } r -= I_PA;
        p0_transpose_item<QM_OUT == 1>(F.in[I_WOUT], DM, 0, DM, DM, F.ws + WS_WOUT, 0, scr, r, F.lane);
    }
    bf16* XN = (bf16*)(F.ws + WS_XN); float* QX = (float*)(F.ws + WS_QX);
    for (int m = gw; m < SEQ; m += NGW) rms_row_to_bf16(F.lane, F.in[I_X] + (size_t)m * DM, F.in[I_N1W], XN + (size_t)m * DM, (unsigned char*)F.out + DO_XN8 + (size_t)m * DM, QX + m);
    __syncthreads();
    { constexpr int J_1 = (QM_G1 == 2 ? N1 / 32 : 0) + (AB_I8 ? 1 : 0), J_G = QM_GATE == 2 ? 4096 / 32 : 0, J_O = QM_OUT == 2 ? DM / 32 : 0, J_P = QM_MIX == 2 ? DM / 32 : 0;
      float* QW = (float*)(F.ws + WS_QW);
#pragma unroll 1
      for (int it = F.vcu; it < J_1 + J_G + J_O + 2 * J_P; it += F.G) {
          int r = it; const float* W = F.in[I_WIN]; int ldw = INW, c0 = 0, n0 = 0, qo = QW_W1; size_t wo = WS_W1; bool half = false;
          if (r < J_1) { n0 = 32 * r; if (AB_I8 && r == J_1 - 1) { c0 = N1; n0 = 0; qo = QW_WAB; wo = WS_WAB; } }
          else if ((r -= J_1) < J_G) { c0 = 9248; n0 = 32 * r; qo = QW_WG; wo = WS_WG; }
          else if ((r -= J_G) < J_O) { W = F.in[I_WOUT]; ldw = DM; n0 = 32 * r; qo = QW_WOUT; wo = WS_WOUT; }
          else if ((r -= J_O) < J_P) { W = F.in[I_WPA]; ldw = DM; n0 = 32 * r; qo = QW_WPA; wo = WS_WPA; half = true; }
          else { r -= J_P; W = F.in[I_WPB]; ldw = DM; n0 = 32 * r; qo = QW_WPB; wo = WS_WPB; half = true; }
          if (half) p0_quant_item<HW>(F, W, ldw, c0, (signed char*)(F.ws + wo), QW + qo, n0);
          else p0_quant_item<DM>(F, W, ldw, c0, (signed char*)(F.ws + wo), QW + qo, n0);
      } }
    __syncthreads();
    for (int it = blockIdx.x; it < 512; it += F.G) p0_ws_item(F, it);
}
typedef unsigned u32x4 __attribute__((ext_vector_type(4)));
__device__ __forceinline__ u32x4 pack8(f32x4 a, f32x4 b) { u32x4 w; w.x = pk2(a[0], a[1]); w.y = pk2(a[2], a[3]); w.z = pk2(b[0], b[1]); w.w = pk2(b[2], b[3]); return w; }
__device__ __forceinline__ void unpack8(u32x4 w, f32x4& a, f32x4& b) { a = (f32x4){bflo(w.x), bfhi(w.x), bflo(w.y), bfhi(w.y)}; b = (f32x4){bflo(w.z), bfhi(w.z), bflo(w.w), bfhi(w.w)}; }
__device__ __forceinline__ f32x4 silu4(f32x4 v) { return (f32x4){siluf_(v[0]), siluf_(v[1]), siluf_(v[2]), siluf_(v[3])}; }
__device__ __forceinline__ f32x4 sigm4(f32x4 v) { return (f32x4){sigmoidf_(v[0]), sigmoidf_(v[1]), sigmoidf_(v[2]), sigmoidf_(v[3])}; }

typedef int i32x4 __attribute__((ext_vector_type(4)));
template <int QM> __device__ __forceinline__ f32x4 deq(f32x4 a, float sr, f32x4 sc) {
    if (QM == 2) { const i32x4 q = __builtin_bit_cast(i32x4, a); return (f32x4){(float)q[0], (float)q[1], (float)q[2], (float)q[3]} * (sc * sr); }
    if (QM == 1) return a * (1.0f / F8_WSCALE);
    return a;
}
template <int QM, bool PERM> __device__ __forceinline__ void ld_colscale(f32x4 (&scv)[2][2], const float* sb, int cb) {
#pragma unroll
    for (int bj = 0; bj < 2; ++bj)
#pragma unroll
        for (int n = 0; n < 2; ++n) scv[bj][n] = (QM == 2) ? *(const f32x4*)(sb + cb + bj * 128 + (PERM ? 4 : 16) * n) : (f32x4){1.f, 1.f, 1.f, 1.f};
}
__device__ __forceinline__ unsigned pk4u8(f32x4 v) { const unsigned a = (unsigned)(v[0] * 255.f + 0.5f), b = (unsigned)(v[1] * 255.f + 0.5f), c = (unsigned)(v[2] * 255.f + 0.5f), d = (unsigned)(v[3] * 255.f + 0.5f); return a | (b << 8) | (c << 16) | (d << 24); }
__device__ __forceinline__ f32x4 un4u8(unsigned w) { return (f32x4){cvt_ub0(w), cvt_ub1(w), cvt_ub2(w), cvt_ub3(w)} * (1.0f / 255.f); }
struct EpiG1 {
    static constexpr bool PERM = true, AFTER_DRAIN = false;
    unsigned char* ws; const float* lbl;
    const float* sa; const float* sb;
    __device__ __forceinline__ void operator()(const f32x4 (&acc)[2][2][4][2], const pg8::Unit& u, int wr, int wc, int fr, int fq) const {
        const int pn = u.pn, row0 = u.pm * 256 + wr * 64 + fr;
        {
            const int grp = pn >> 2; const bool act = (grp == 0) | (grp == 4) | (grp == 8);
            bf16* base = (bf16*)(ws + WS_H + (size_t)grp * 32 * MiB); const int col0 = (pn & 3) * 256 + wc * 32 + 8 * fq;
            f32x4 scv[2][2]; ld_colscale<QM_G1, true>(scv, sb, pn * 256 + wc * 32 + 8 * fq);
            const bool fgate = (grp == 1) | (grp == 2); f32x4 lbv[2][2];
            if (fgate) { const float* l0 = lbl + (grp - 1) * 2048 + col0;
#pragma unroll
                for (int bj = 0; bj < 2; ++bj)
#pragma unroll
                    for (int n = 0; n < 2; ++n) { const f32x4 a0 = *(const f32x4*)(l0 + bj * 128 + 4 * n), a1 = *(const f32x4*)(l0 + 1024 + bj * 128 + 4 * n);
                        lbv[bj][n] = (f32x4){fast_rcp(1.0f + fast_exp(a1[0] - a0[0])), fast_rcp(1.0f + fast_exp(a1[1] - a0[1])), fast_rcp(1.0f + fast_exp(a1[2] - a0[2])), fast_rcp(1.0f + fast_exp(a1[3] - a0[3]))}; } }
#pragma unroll
            for (int ai = 0; ai < 2; ++ai)
#pragma unroll
                for (int m = 0; m < 4; ++m) { bf16* rowp = base + (size_t)(row0 + ai * 128 + m * 16) * HW + col0; const float sr = (QM_G1 == 2) ? sa[row0 + ai * 128 + m * 16] : 1.f;
#pragma unroll
                    for (int bj = 0; bj < 2; ++bj) { f32x4 v0 = deq<QM_G1>(acc[ai][bj][m][0], sr, scv[bj][0]), v1 = deq<QM_G1>(acc[ai][bj][m][1], sr, scv[bj][1]);
                        if (act) { v0 = silu4(v0); v1 = silu4(v1); }
                        if (fgate) { v0 = lbv[bj][0] + (1.0f - lbv[bj][0]) * sigm4(v0); v1 = lbv[bj][1] + (1.0f - lbv[bj][1]) * sigm4(v1); }
                        *(u32x4*)(rowp + bj * 128) = pack8(v0, v1); } }
        }
    }
};
struct EpiGate {
    static constexpr bool PERM = true, AFTER_DRAIN = false;
    unsigned char* O; const float* sa; const float* sb;
    __device__ __forceinline__ void operator()(const f32x4 (&acc)[2][2][4][2], const pg8::Unit& u, int wr, int wc, int fr, int fq) const {
        const int row0 = u.pm * 256 + wr * 64 + fr, col0 = u.pn * 256 + wc * 32 + 8 * fq;
        f32x4 scv[2][2]; ld_colscale<QM_GATE, true>(scv, sb, col0);
#pragma unroll
        for (int ai = 0; ai < 2; ++ai)
#pragma unroll
            for (int m = 0; m < 4; ++m) { unsigned char* rowp = O + (size_t)(row0 + ai * 128 + m * 16) * DM + col0; const float sr = (QM_GATE == 2) ? sa[row0 + ai * 128 + m * 16] : 1.f;
#pragma unroll
                for (int bj = 0; bj < 2; ++bj) { v2u w; w.x = pk4u8(sigm4(deq<QM_GATE>(acc[ai][bj][m][0], sr, scv[bj][0]))); w.y = pk4u8(sigm4(deq<QM_GATE>(acc[ai][bj][m][1], sr, scv[bj][1]))); *(v2u*)(rowp + bj * 128) = w; } }
    }
};
template <int MODE> struct EpiMix {
    static constexpr bool PERM = true, AFTER_DRAIN = false;
    bf16* O; const unsigned char* G; unsigned char* O8;
    const float* sa; const float* sb;
    __device__ __forceinline__ void operator()(const f32x4 (&acc)[2][2][4][2], const pg8::Unit& u, int wr, int wc, int fr, int fq) const {
        const int row0 = u.pm * 256 + wr * 64 + fr, col0 = u.pn * 256 + wc * 32 + 8 * fq;
        f32x4 scv[2][2]; ld_colscale<QM_MIX, true>(scv, sb, col0);
#pragma unroll
        for (int ai = 0; ai < 2; ++ai)
#pragma unroll
            for (int m = 0; m < 4; ++m) { const size_t off = (size_t)(row0 + ai * 128 + m * 16) * DM + col0; const float sr = (QM_MIX == 2) ? sa[row0 + ai * 128 + m * 16] : 1.f;
#pragma unroll
                for (int bj = 0; bj < 2; ++bj) { f32x4 o0, o1; const v2u gw = *(const v2u*)(G + off + bj * 128); const f32x4 g0 = un4u8(gw.x), g1 = un4u8(gw.y);
                    const f32x4 c0 = deq<QM_MIX>(acc[ai][bj][m][0], sr, scv[bj][0]), c1 = deq<QM_MIX>(acc[ai][bj][m][1], sr, scv[bj][1]);
                    if (MODE == 0) { o0 = g0 * c0; o1 = g1 * c1; }
                    else { unpack8(*(const u32x4*)(O + off + bj * 128), o0, o1); o0 = o0 + g0 * c0; o1 = o1 + g1 * c1; }
                    if (MODE == 1 && QM_OUT == 1) { v2u w; w.x = pk4f8(o0[0], o0[1], o0[2], o0[3]); w.y = pk4f8(o1[0], o1[1], o1[2], o1[3]); *(v2u*)(O8 + off + bj * 128) = w; }
                    else *(u32x4*)(O + off + bj * 128) = pack8(o0, o1); } }
    }
};
struct EpiX1 {
    static constexpr bool PERM = false, AFTER_DRAIN = false;
    const float* x; float* out; bf16* xb;
    __device__ __forceinline__ void operator()(const f32x4 (&acc)[2][2][4][2], const pg8::Unit& u, int wr, int wc, int fr, int fq) const {
        const int row0 = u.pm * 256 + wr * 64 + fr, col0 = u.pn * 256 + wc * 32 + 4 * fq;
#pragma unroll
        for (int ai = 0; ai < 2; ++ai)
#pragma unroll
            for (int m = 0; m < 4; ++m) { const size_t off = (size_t)(row0 + ai * 128 + m * 16) * DM + col0;
#pragma unroll
                for (int bj = 0; bj < 2; ++bj)
#pragma unroll
                    for (int n = 0; n < 2; ++n) { const size_t o = off + bj * 128 + n * 16; const f32x4 v = *(const f32x4*)(x + o) + deq<QM_OUT>(acc[ai][bj][m][n], 1.f, (f32x4){1.f, 1.f, 1.f, 1.f});
                        *(v2u*)(xb + o) = pack4(v); } }
    }
};
struct EpiBf {
    static constexpr bool PERM = true, AFTER_DRAIN = false;
    bf16* O;
    __device__ __forceinline__ void operator()(const f32x4 (&acc)[2][2][4][2], const pg8::Unit& u, int wr, int wc, int fr, int fq) const {
        const int row0 = u.pm * 256 + wr * 64 + fr, col0 = u.pn * 256 + wc * 32 + 8 * fq;
#pragma unroll
        for (int ai = 0; ai < 2; ++ai)
#pragma unroll
            for (int m = 0; m < 4; ++m) { bf16* rowp = O + (size_t)(row0 + ai * 128 + m * 16) * DM + col0;
#pragma unroll
                for (int bj = 0; bj < 2; ++bj) *(u32x4*)(rowp + bj * 128) = pack8(acc[ai][bj][m][0], acc[ai][bj][m][1]); }
    }
};
struct EpiF32 {
    static constexpr bool PERM = false, AFTER_DRAIN = false;
    float* C;
    __device__ __forceinline__ void operator()(const f32x4 (&acc)[2][2][4][2], const pg8::Unit& u, int wr, int wc, int fr, int fq) const {
        const int row0 = u.pm * 256 + wr * 64 + fr, col0 = u.pn * 256 + wc * 32 + 4 * fq;
#pragma unroll
        for (int ai = 0; ai < 2; ++ai)
#pragma unroll
            for (int m = 0; m < 4; ++m) { float* rowp = C + (size_t)(row0 + ai * 128 + m * 16) * DM + col0;
#pragma unroll
                for (int bj = 0; bj < 2; ++bj)
#pragma unroll
                    for (int n = 0; n < 2; ++n) *(f32x4*)(rowp + bj * 128 + n * 16) = acc[ai][bj][m][n]; }
    }
};

__device__ __forceinline__ void p1_ab(Frame& F) {
    float* Gab = (float*)(F.ws + WS_GAB);
    const int fr = F.lane & 15, fq = F.lane >> 4, rt = F.wave >> 1, ct = F.wave & 1;
    if (AB_I8) {
        const signed char* XQ = (const signed char*)F.out + DO_XN8; const signed char* Wab = (const signed char*)(F.ws + WS_WAB);
        const float* QX = (const float*)(F.ws + WS_QX); const f32x4 sw = *(const f32x4*)((const float*)(F.ws + WS_QW) + QW_WAB + ct * 16 + 4 * fq);
        for (int blk = F.vcu; blk < SEQ / 64; blk += F.G) {
            const int row = blk * 64 + rt * 16 + fr;
            const signed char* ap = XQ + (size_t)row * DM + 16 * fq; const signed char* bp = Wab + (size_t)(ct * 16 + fr) * DM + 16 * fq;
            i32x4 acc = {0, 0, 0, 0};
#pragma unroll 1
            for (int kb = 0; kb < DM; kb += 1024) { i32x4 af[16], bfr[16];
#pragma unroll
                for (int u = 0; u < 16; ++u) { af[u] = *(const GAS i32x4*)(ap + kb + 64 * u); bfr[u] = *(const GAS i32x4*)(bp + kb + 64 * u); }
                __builtin_amdgcn_sched_barrier(0);
#pragma unroll
                for (int u = 0; u < 16; ++u) acc = __builtin_amdgcn_mfma_i32_16x16x64_i8(bfr[u], af[u], acc, 0, 0, 0);
                __builtin_amdgcn_sched_barrier(0); }
            *(GAS f32x4*)(Gab + (size_t)row * 32 + ct * 16 + 4 * fq) = (f32x4){(float)acc[0], (float)acc[1], (float)acc[2], (float)acc[3]} * (sw * QX[row]);
        }
        return;
    }
    const bf16* XN = (const bf16*)(F.ws + WS_XN); const bf16* Wab = (const bf16*)(F.ws + WS_WAB);
    for (int blk = F.vcu; blk < SEQ / 64; blk += F.G) {
        const bf16* ap = XN + (size_t)(blk * 64 + rt * 16 + fr) * DM + 8 * fq; const bf16* bp = Wab + (size_t)(ct * 16 + fr) * DM + 8 * fq;
        f32x4 acc = {0.f, 0.f, 0.f, 0.f};
#pragma unroll 1
        for (int kb = 0; kb < DM; kb += 512) { bf16x8 af[16], bfr[16];
#pragma unroll
            for (int u = 0; u < 16; ++u) { af[u] = *(const GAS bf16x8*)(ap + kb + 32 * u); bfr[u] = *(const GAS bf16x8*)(bp + kb + 32 * u); }
            __builtin_amdgcn_sched_barrier(0);
#pragma unroll
            for (int u = 0; u < 16; ++u) acc = mfma16(bfr[u], af[u], acc);
            __builtin_amdgcn_sched_barrier(0); }
        *(GAS f32x4*)(Gab + (size_t)(blk * 64 + rt * 16 + fr) * 32 + ct * 16 + 4 * fq) = acc;
    }
}
template <bool PASS3, int SKIP = 0>
__device__ __forceinline__ void hgrn_pass(Frame& F) {
    LAS bf16*  ST  = (LAS bf16*)(F.lds + 0);
    LAS float* LF  = (LAS float*)(F.lds + 0);
    LAS bf16*  QT  = (LAS bf16*)(F.lds + 34816);
    LAS bf16*  KT  = (LAS bf16*)(F.lds + 52224);
    LAS bf16*  KHT = (LAS bf16*)(F.lds + 69632);
    LAS bf16*  VT  = (LAS bf16*)(F.lds + 88064);
    LAS bf16*  ATT = (LAS bf16*)(F.lds + 106496);
    LAS float* PT  = (LAS float*)(F.lds + 115712);
    LAS float* BL  = (LAS float*)(F.lds + 117760);
    LAS float* DKK = (LAS float*)(F.lds + 118272);
    LAS float* LBV = (LAS float*)(F.lds + 118784);
    LAS bf16*  VR  = (LAS bf16*)(F.lds + 119296);
    const int tid = F.tid, lane = F.lane, w = F.wave, fr = lane & 15, fq = lane >> 4;
    const int row = tid >> 3, c0 = (tid & 7) * 16;
    float* HL = (float*)(F.ws + WS_HL); float* HDS = (float*)(F.ws + WS_HDS);
    for (int it = blockIdx.x; it < 256; it += F.G) {
        const int hd = it >> 4, sg = it & 15, dir = hd >> 3, h = hd & 7;
        const bf16* Hq = (const bf16*)(F.ws + WS_H); const bf16* Hf = (const bf16*)(F.ws + WS_H + (size_t)(1 + dir) * 32 * MiB); const bf16* Hi = (const bf16*)(F.ws + WS_H + (size_t)3 * 32 * MiB);
        bf16* Oh = (bf16*)(F.ws + (dir ? WS_OHB : WS_OHF));
        __syncthreads();
        f32x4 Sacc[8];
#pragma unroll
        for (int kt = 0; kt < 8; ++kt) Sacc[kt] = (f32x4){0.f, 0.f, 0.f, 0.f};
        if (PASS3) {
            for (int p = 0; p < sg; ++p) { const int ip = hd * 16 + p; f32x4 dsv[8], lv[8];
#pragma unroll
                for (int kt = 0; kt < 8; ++kt) { dsv[kt] = *(const GAS f32x4*)(HDS + ip * 128 + 16 * kt + 4 * fq); lv[kt] = *(const GAS f32x4*)(HL + ((size_t)((ip * 8 + w) * 8 + kt) * 64 + lane) * 4); }
                __builtin_amdgcn_sched_barrier(0);
#pragma unroll
                for (int kt = 0; kt < 8; ++kt) Sacc[kt] = Sacc[kt] * dsv[kt] + lv[kt];
                __builtin_amdgcn_sched_barrier(0); }
        }
        float sumbl = 1.f;
        v4u rq[2], rf[2], rv[2];
        { const int oc = dir ? 255 - sg * 16 : sg * 16; const size_t off = (size_t)(64 * oc + row) * HW + h * 128 + c0;
          rq[0] = *(const GAS v4u*)(Hq + off); rq[1] = *(const GAS v4u*)(Hq + off + 8); rf[0] = *(const GAS v4u*)(Hf + off); rf[1] = *(const GAS v4u*)(Hf + off + 8); rv[0] = *(const GAS v4u*)(Hi + off); rv[1] = *(const GAS v4u*)(Hi + off + 8); }
        __syncthreads();
        for (int ci = 0; ci < ((SKIP & 4) ? 1 : CPS); ++ci) {
            const int sc = sg * 16 + ci, oc = dir ? 255 - sc : sc, tok0 = 64 * oc;
            float kk[16], qq[16];
            { const unsigned fw[8] = {rf[0].x, rf[0].y, rf[0].z, rf[0].w, rf[1].x, rf[1].y, rf[1].z, rf[1].w};
              const unsigned qw[8] = {rq[0].x, rq[0].y, rq[0].z, rq[0].w, rq[1].x, rq[1].y, rq[1].z, rq[1].w};
              float fgv[16];
#pragma unroll
              for (int e = 0; e < 16; ++e) { fgv[e] = (e & 1) ? bfhi(fw[e >> 1]) : bflo(fw[e >> 1]); qq[e] = (e & 1) ? bfhi(qw[e >> 1]) : bflo(qw[e >> 1]); kk[e] = 1.0f - fgv[e]; }
#pragma unroll
              for (int q4 = 0; q4 < 4; ++q4) *(LAS f32x4*)(LF + row * 132 + c0 + 4 * q4) = (f32x4){fgv[4 * q4], fgv[4 * q4 + 1], fgv[4 * q4 + 2], fgv[4 * q4 + 3]};
              *(LAS v4u*)(VR + row * 136 + c0) = rv[0]; *(LAS v4u*)(VR + row * 136 + c0 + 8) = rv[1]; }
            if (ci + 1 < CPS && !(SKIP & 2)) { const int oc2 = dir ? oc - 1 : oc + 1; const size_t off = (size_t)(64 * oc2 + row) * HW + h * 128 + c0;
              rq[0] = *(const GAS v4u*)(Hq + off); rq[1] = *(const GAS v4u*)(Hq + off + 8); rf[0] = *(const GAS v4u*)(Hf + off); rf[1] = *(const GAS v4u*)(Hf + off + 8); rv[0] = *(const GAS v4u*)(Hi + off); rv[1] = *(const GAS v4u*)(Hi + off + 8); }
            if (!(SKIP & 8)) __syncthreads();
            { const int c = tid & 127, part = tid >> 7, r0 = part * 16; float b[16], fv[16]; float run = 1.f;
#pragma unroll
              for (int i = 0; i < 16; ++i) fv[i] = LF[(r0 + i) * 132 + c];
              if (!dir) {
#pragma unroll
                  for (int i = 0; i < 16; ++i) { run *= fv[i]; b[i] = run; }
              } else {
#pragma unroll
                  for (int i = 15; i >= 0; --i) { run *= fv[i]; b[i] = run; }
              }
              PT[part * 128 + c] = run;
              unsigned short vcol[16];
#pragma unroll
              for (int i = 0; i < 16; ++i) vcol[i] = VR[(r0 + i) * 136 + c];
              if (!(SKIP & 8)) __syncthreads();
              const float p0 = PT[c], p1 = PT[128 + c], p2 = PT[256 + c], p3 = PT[384 + c];
              float offs;
              if (!dir) offs = (part > 0 ? p0 : 1.f) * (part > 1 ? p1 : 1.f) * (part > 2 ? p2 : 1.f);
              else      offs = (part < 3 ? p3 : 1.f) * (part < 2 ? p2 : 1.f) * (part < 1 ? p1 : 1.f);
              const float tot = (p0 * p1) * (p2 * p3);
              unsigned kh[8], vw[8];
#pragma unroll
              for (int i = 0; i < 8; ++i) { const float P0 = b[2 * i] * offs, P1 = b[2 * i + 1] * offs;
                  if (PASS3) { LF[(r0 + 2 * i) * 132 + c] = P0; LF[(r0 + 2 * i + 1) * 132 + c] = P1; }
                  kh[i] = pk2((1.0f - fv[2 * i]) * tot * fast_rcp(P0), (1.0f - fv[2 * i + 1]) * tot * fast_rcp(P1)); vw[i] = (unsigned)vcol[2 * i] | ((unsigned)vcol[2 * i + 1] << 16); }
              *(LAS v4u*)(KHT + c * 72 + r0) = (v4u){kh[0], kh[1], kh[2], kh[3]}; *(LAS v4u*)(KHT + c * 72 + r0 + 8) = (v4u){kh[4], kh[5], kh[6], kh[7]};
              *(LAS v4u*)(VT + c * 72 + r0) = (v4u){vw[0], vw[1], vw[2], vw[3]}; *(LAS v4u*)(VT + c * 72 + r0 + 8) = (v4u){vw[4], vw[5], vw[6], vw[7]};
              if (part == 0) { DKK[c] = tot; sumbl *= tot; }
            }
            if (!(SKIP & 8)) __syncthreads();
            if (PASS3 && !(SKIP & 1)) { float bb[16];
#pragma unroll
              for (int q4 = 0; q4 < 4; ++q4) { const f32x4 t4 = *(const LAS f32x4*)(LF + row * 132 + c0 + 4 * q4); bb[4 * q4] = t4[0]; bb[4 * q4 + 1] = t4[1]; bb[4 * q4 + 2] = t4[2]; bb[4 * q4 + 3] = t4[3]; }
              unsigned qo[8], ko[8];
#pragma unroll
              for (int e = 0; e < 8; ++e) { qo[e] = pk2(qq[2 * e] * bb[2 * e], qq[2 * e + 1] * bb[2 * e + 1]); ko[e] = pk2(kk[2 * e] * fast_rcp(bb[2 * e]), kk[2 * e + 1] * fast_rcp(bb[2 * e + 1])); }
              *(LAS v4u*)(QT + row * 136 + c0) = (v4u){qo[0], qo[1], qo[2], qo[3]}; *(LAS v4u*)(QT + row * 136 + c0 + 8) = (v4u){qo[4], qo[5], qo[6], qo[7]};
              *(LAS v4u*)(KT + row * 136 + c0) = (v4u){ko[0], ko[1], ko[2], ko[3]}; *(LAS v4u*)(KT + row * 136 + c0 + 8) = (v4u){ko[4], ko[5], ko[6], ko[7]};
            }
            if (PASS3) if (!(SKIP & 8)) __syncthreads();
            if (PASS3 && !(SKIP & 1)) {
                { bf16x8 kf[2][4], qf[2][4]; f32x4 acc[2];
#pragma unroll
                  for (int q2 = 0; q2 < 2; ++q2) { const int tl = 2 * w + q2, ti = tl >> 2, tj = tl & 3; acc[q2] = (f32x4){0.f, 0.f, 0.f, 0.f};
#pragma unroll
                      for (int k0 = 0; k0 < 4; ++k0) { kf[q2][k0] = ldfrag(KT, 136, 16 * ti + fr, 32 * k0 + 8 * fq); qf[q2][k0] = ldfrag(QT, 136, 16 * tj + fr, 32 * k0 + 8 * fq); } }
                  __builtin_amdgcn_sched_barrier(0);
#pragma unroll
                  for (int k0 = 0; k0 < 4; ++k0)
#pragma unroll
                      for (int q2 = 0; q2 < 2; ++q2) acc[q2] = mfma16(kf[q2][k0], qf[q2][k0], acc[q2]);
                  __builtin_amdgcn_sched_barrier(0);
#pragma unroll
                  for (int q2 = 0; q2 < 2; ++q2) { const int tl = 2 * w + q2, ti = tl >> 2, tj = tl & 3; const int t = 16 * tj + fr, s0 = 16 * ti + 4 * fq;
#pragma unroll
                      for (int r = 0; r < 4; ++r) { const bool keep = dir ? (s0 + r >= t) : (s0 + r <= t); acc[q2][r] = keep ? acc[q2][r] : 0.f; }
                      *(LAS v2u*)(ATT + t * 72 + s0) = pack4(acc[q2]); } }
#pragma unroll
                for (int kt = 0; kt < 8; ++kt) *(LAS v2u*)(ST + (16 * w + fr) * 136 + 16 * kt + 4 * fq) = pack4(Sacc[kt]);
                if (!(SKIP & 8)) __syncthreads();
            }
            bf16x8 xv[2];
#pragma unroll
            for (int s0 = 0; s0 < 2; ++s0) xv[s0] = ldfrag(VT, 72, 16 * w + fr, 32 * s0 + 8 * fq);
            if (PASS3 && !(SKIP & 1)) {
                bf16x8 xs[4];
#pragma unroll
                for (int k0 = 0; k0 < 4; ++k0) xs[k0] = ldfrag(ST, 136, 16 * w + fr, 32 * k0 + 8 * fq);
#pragma unroll
                for (int th = 0; th < 2; ++th) { bf16x8 qf[2][4], af[2][2]; f32x4 acc[2];
#pragma unroll
                    for (int tq = 0; tq < 2; ++tq) { const int tt = 2 * th + tq; acc[tq] = (f32x4){0.f, 0.f, 0.f, 0.f};
#pragma unroll
                        for (int k0 = 0; k0 < 4; ++k0) qf[tq][k0] = ldfrag(QT, 136, 16 * tt + fr, 32 * k0 + 8 * fq);
#pragma unroll
                        for (int s0 = 0; s0 < 2; ++s0) af[tq][s0] = ldfrag(ATT, 72, 16 * tt + fr, 32 * s0 + 8 * fq); }
                    __builtin_amdgcn_sched_barrier(0);
#pragma unroll
                    for (int k0 = 0; k0 < 4; ++k0)
#pragma unroll
                        for (int tq = 0; tq < 2; ++tq) acc[tq] = mfma16(xs[k0], qf[tq][k0], acc[tq]);
#pragma unroll
                    for (int s0 = 0; s0 < 2; ++s0)
#pragma unroll
                        for (int tq = 0; tq < 2; ++tq) acc[tq] = mfma16(xv[s0], af[tq][s0], acc[tq]);
                    __builtin_amdgcn_sched_barrier(0);
#pragma unroll
                    for (int tq = 0; tq < 2; ++tq) *(GAS v2u*)(Oh + (size_t)(tok0 + 16 * (2 * th + tq) + fr) * HW + h * 128 + 16 * w + 4 * fq) = pack4(acc[tq]); }
            }
#pragma unroll
            for (int kh = 0; kh < ((SKIP & 1) ? 0 : 2); ++kh) { bf16x8 kf[4][2];
#pragma unroll
                for (int kq = 0; kq < 4; ++kq) { const int kt = 4 * kh + kq; const f32x4 d4 = *(const LAS f32x4*)(DKK + 16 * kt + 4 * fq); Sacc[kt] = Sacc[kt] * d4;
#pragma unroll
                    for (int s0 = 0; s0 < 2; ++s0) kf[kq][s0] = ldfrag(KHT, 72, 16 * kt + fr, 32 * s0 + 8 * fq); }
                __builtin_amdgcn_sched_barrier(0);
#pragma unroll
                for (int s0 = 0; s0 < 2; ++s0)
#pragma unroll
                    for (int kq = 0; kq < 4; ++kq) Sacc[4 * kh + kq] = mfma16(kf[kq][s0], xv[s0], Sacc[4 * kh + kq]);
                __builtin_amdgcn_sched_barrier(0); }
            if (!(SKIP & 8)) __syncthreads();
        }
        if (!PASS3) {
#pragma unroll
            for (int kt = 0; kt < 8; ++kt) *(GAS f32x4*)(HL + ((size_t)((it * 8 + w) * 8 + kt) * 64 + lane) * 4) = Sacc[kt];
            if (tid < 128) HDS[it * 128 + tid] = sumbl;
        }
    }
}
template <int SKIP>
__device__ __forceinline__ void gdn_prep(Frame& F) {
    LAS bf16*  QN  = (LAS bf16*)(F.lds + 0);
    LAS bf16*  KN  = (LAS bf16*)(F.lds + 17408);
    LAS bf16*  VT  = (LAS bf16*)(F.lds + 34816);
    LAS bf16*  KNT = (LAS bf16*)(F.lds + 53248);
    LAS float* AD  = (LAS float*)(F.lds + 71680);
    LAS bf16*  AB  = (LAS bf16*)(F.lds + 79872);
    LAS float* RS  = (LAS float*)(F.lds + 150528);
    LAS bf16*  TB  = (LAS bf16*)(F.lds + 104448);
    LAS bf16*  VR  = (LAS bf16*)(F.lds + 104448);
    LAS float* CWL = (LAS float*)(F.lds + 142848);
    LAS float* DEC = (LAS float*)(F.lds + 141312);
    LAS float* BET = DEC + 128;
    LAS float* EXD = DEC + 256;
    const int tid = F.tid, lane = F.lane, w = F.wave, fr = lane & 15, fq = lane >> 4;
    const int row = tid >> 3, c0 = (tid & 7) * 16;
    const bf16* Gq = (const bf16*)(F.ws + WS_H + (size_t)5 * 32 * MiB); const bf16* Gk = (const bf16*)(F.ws + WS_H + (size_t)6 * 32 * MiB); const bf16* Gv = (const bf16*)(F.ws + WS_H + (size_t)7 * 32 * MiB);
    const float* Gab = (const float*)(F.ws + WS_GAB); const float* cw = F.in[I_CONVW];
    unsigned char* dob = (unsigned char*)F.out;
    bf16* QNg = (bf16*)(dob + DO_QN); bf16* KNTg = (bf16*)(dob + DO_KNT); float* GSC = (float*)(F.ws + WS_GSC);
    int hload = -1;
    for (int it = blockIdx.x; it < 2048; it += F.G) {
        const int h = it & 7, oc = it >> 3, tok0 = 64 * oc;
        __syncthreads();
        if (h != hload) { hload = h;
            for (int i = tid; i < 5 * 384; i += NTHR) { const int j = i / 384, r = i % 384; CWL[i] = cw[j * 3072 + (r >> 7) * 1024 + h * 128 + (r & 127)]; }
            __syncthreads(); }
        if (it + F.G < 2048 && tid < 408) { const int it2 = it + F.G, h2 = it2 & 7, oc2 = it2 >> 3; const int tz = tid / 136, rl = tid % 136, r = rl >> 1, half = rl & 1; const int tr = 64 * oc2 - 2 + r;
            if (tr >= 0 && tr < SEQ) { const bf16* src = (tz == 0 ? Gq : tz == 1 ? Gk : Gv) + (size_t)tr * HW + h2 * 128 + half * 64; unsigned tmp = *(const GAS unsigned*)src; asm volatile("" :: "v"(tmp)); } }
        if (tid < 128) { const int dir = tid >> 6, l = tid & 63, pos = dir ? 63 - l : l;
            const float a = Gab[(size_t)(tok0 + pos) * 32 + dir * 8 + h], b = Gab[(size_t)(tok0 + pos) * 32 + 16 + dir * 8 + h];
            const float x = a + F.in[I_DTB][dir * 8 + h]; const float sp = x > 20.f ? x : log1pf(__expf(x));
            float d = -__expf(F.in[I_ALOG][dir * 8 + h]) * sp;
#pragma unroll
            for (int o = 1; o < 64; o <<= 1) { const float t = __shfl_up(d, o); if (l >= o) d += t; }
            DEC[dir * 64 + pos] = d; BET[dir * 64 + pos] = sigmoidf_(b); EXD[dir * 64 + pos] = __expf(d); }
        if (!(SKIP & 64)) { float q[16], k[16], v[16];
#pragma unroll
          for (int e = 0; e < 16; ++e) { q[e] = 0.f; k[e] = 0.f; v[e] = 0.f; }
          const int ch = h * 128 + c0;
#pragma unroll
          for (int j = 0; j < ((SKIP & 1) ? 0 : 5); ++j) { const int tr = tok0 + row + j - 2;
              if (tr >= 0 && tr < SEQ) { const size_t off = (size_t)tr * HW + ch;
                  const v4u xq0 = *(const GAS v4u*)(Gq + off), xq1 = *(const GAS v4u*)(Gq + off + 8), xk0 = *(const GAS v4u*)(Gk + off), xk1 = *(const GAS v4u*)(Gk + off + 8), xv0 = *(const GAS v4u*)(Gv + off), xv1 = *(const GAS v4u*)(Gv + off + 8);
                  const unsigned wq[8] = {xq0.x, xq0.y, xq0.z, xq0.w, xq1.x, xq1.y, xq1.z, xq1.w}, wk[8] = {xk0.x, xk0.y, xk0.z, xk0.w, xk1.x, xk1.y, xk1.z, xk1.w}, wv[8] = {xv0.x, xv0.y, xv0.z, xv0.w, xv1.x, xv1.y, xv1.z, xv1.w};
                  const LAS float* cq = CWL + j * 384 + c0;
#pragma unroll
                  for (int e = 0; e < 16; ++e) { const float fq_ = (e & 1) ? bfhi(wq[e >> 1]) : bflo(wq[e >> 1]), fk_ = (e & 1) ? bfhi(wk[e >> 1]) : bflo(wk[e >> 1]), fv_ = (e & 1) ? bfhi(wv[e >> 1]) : bflo(wv[e >> 1]);
                      q[e] += cq[e] * fq_; k[e] += cq[128 + e] * fk_; v[e] += cq[256 + e] * fv_; } } }
          float sq = 0.f, sk = 0.f;
#pragma unroll
          for (int e = 0; e < 16; ++e) { q[e] = siluf_(q[e]); k[e] = siluf_(k[e]); v[e] = siluf_(v[e]); sq += q[e] * q[e]; sk += k[e] * k[e]; }
          sq += __shfl_xor(sq, 1); sq += __shfl_xor(sq, 2); sq += __shfl_xor(sq, 4); sk += __shfl_xor(sk, 1); sk += __shfl_xor(sk, 2); sk += __shfl_xor(sk, 4);
          const float rq = 0.08838834764831845f / sqrtf(sq + EPS), rk = 1.0f / sqrtf(sk + EPS);
          unsigned qo[8], ko[8];
#pragma unroll
          for (int e = 0; e < 8; ++e) { qo[e] = pk2(q[2 * e] * rq, q[2 * e + 1] * rq); ko[e] = pk2(k[2 * e] * rk, k[2 * e + 1] * rk); }
          const v4u q0 = {qo[0], qo[1], qo[2], qo[3]}, q1 = {qo[4], qo[5], qo[6], qo[7]}, k0_ = {ko[0], ko[1], ko[2], ko[3]}, k1_ = {ko[4], ko[5], ko[6], ko[7]};
          *(LAS v4u*)(QN + row * 136 + c0) = q0; *(LAS v4u*)(QN + row * 136 + c0 + 8) = q1; *(LAS v4u*)(KN + row * 136 + c0) = k0_; *(LAS v4u*)(KN + row * 136 + c0 + 8) = k1_;
          if (!(SKIP & 16)) { *(GAS v4u*)(QNg + (size_t)(tok0 + row) * HW + ch) = q0; *(GAS v4u*)(QNg + (size_t)(tok0 + row) * HW + ch + 8) = q1; }
          unsigned vo[8];
#pragma unroll
          for (int e = 0; e < 8; ++e) vo[e] = pk2(v[2 * e], v[2 * e + 1]);
          *(LAS v4u*)(VR + row * 136 + c0) = (v4u){vo[0], vo[1], vo[2], vo[3]}; *(LAS v4u*)(VR + row * 136 + c0 + 8) = (v4u){vo[4], vo[5], vo[6], vo[7]};
        }
        __syncthreads();
        { const int c = tid & 127, r0 = (tid >> 7) * 16; unsigned vw[8], kw[8];
#pragma unroll
          for (int i = 0; i < 8; ++i) { vw[i] = (unsigned)VR[(r0 + 2 * i) * 136 + c] | ((unsigned)VR[(r0 + 2 * i + 1) * 136 + c] << 16); kw[i] = (unsigned)KN[(r0 + 2 * i) * 136 + c] | ((unsigned)KN[(r0 + 2 * i + 1) * 136 + c] << 16); }
          *(LAS v4u*)(VT + c * 72 + r0) = (v4u){vw[0], vw[1], vw[2], vw[3]}; *(LAS v4u*)(VT + c * 72 + r0 + 8) = (v4u){vw[4], vw[5], vw[6], vw[7]};
          *(LAS v4u*)(KNT + c * 72 + r0) = (v4u){kw[0], kw[1], kw[2], kw[3]}; *(LAS v4u*)(KNT + c * 72 + r0 + 8) = (v4u){kw[4], kw[5], kw[6], kw[7]}; }
#pragma unroll
        for (int q2 = 0; q2 < ((SKIP & 8) ? 0 : 2); ++q2) { const int tl = 2 * w + q2, ti = tl >> 2, tj = tl & 3; f32x4 kkv = {0.f, 0.f, 0.f, 0.f}, qkv = {0.f, 0.f, 0.f, 0.f};
#pragma unroll
            for (int k0 = 0; k0 < 4; ++k0) { const bf16x8 xs = ldfrag(KN, 136, 16 * ti + fr, 32 * k0 + 8 * fq);
                kkv = mfma16(xs, ldfrag(KN, 136, 16 * tj + fr, 32 * k0 + 8 * fq), kkv); qkv = mfma16(xs, ldfrag(QN, 136, 16 * tj + fr, 32 * k0 + 8 * fq), qkv); }
            int fr2 = lane & 15, fq2 = lane >> 4; asm volatile("" : "+v"(fr2), "+v"(fq2));
            const int t = 16 * tj + fr2, s0 = 16 * ti + 4 * fq2;
#pragma unroll
            for (int dir = 0; dir < 2; ++dir) { const float dt = DEC[dir * 64 + t], bt = BET[dir * 64 + t]; f32x4 aq, av;
#pragma unroll
                for (int r = 0; r < 4; ++r) { const int s = s0 + r; const bool before = dir ? (s > t) : (s < t), beq = before || (s == t);
                    const float e = beq ? __expf(dt - DEC[dir * 64 + s]) : 0.f;
                    av[r] = before ? bt * kkv[r] * e : 0.f; aq[r] = qkv[r] * e;
                    if (ti == tj) AD[(dir * 4 + (dir ? 3 - ti : ti)) * 256 + (dir ? (15 - (s & 15)) * 16 + (15 - fr2) : (s & 15) * 16 + fr2)] = av[r]; }
                *(LAS v2u*)(AB + dir * 64 * 72 + (dir ? (63 - t) * 72 + 60 - s0 : t * 72 + s0)) = dir ? pack4((f32x4){av[3], av[2], av[1], av[0]}) : pack4(av);
                bf16* AQg = (bf16*)(dob + (dir ? DO_AQKB : DO_AQKF));
                if (!(SKIP & 16)) *(GAS v2u*)(AQg + ((size_t)(h * 256 + oc) * 64 + t) * 64 + s0) = pack4(aq); } }
        __syncthreads();
        if (SKIP & 32) {} else if (w < 2) { const int dir = w; int c = lane; asm volatile("" : "+v"(c));
            const LAS bf16* ABd = AB + dir * 64 * 72; LAS bf16* TT = TB + (dir * 2 + 1) * 64 * 72; LAS float* RSd = RS + dir * 1024; const LAS float* ADd = AD + dir * 1024;
#pragma unroll
            for (int q = 0; q < 9; ++q) *(LAS v4u*)(TT + (q * 64 + c) * 8) = (v4u){0u, 0u, 0u, 0u};
            int fr3 = c & 15, fq3 = c >> 4;
            float t[64];
#pragma unroll
            for (int bi = 0; bi < 4; ++bi) { float r[16];
#pragma unroll
                for (int ii = 0; ii < 16; ++ii) r[ii] = (16 * bi + ii == c) ? 1.f : 0.f;
                if (!(SKIP & 2)) {
                if (bi > 0) {
#pragma unroll
                    for (int ct = 0; ct < 4; ++ct) { f32x4 d = {0.f, 0.f, 0.f, 0.f};
#pragma unroll
                        for (int ks = 0; ks < (16 * bi + 31) / 32; ++ks) d = mfma16(ldfrag(ABd, 72, 16 * bi + fr3, 32 * ks + 8 * fq3), ldfrag(TT, 72, 16 * ct + fr3, 32 * ks + 8 * fq3), d);
                        *(LAS f32x4*)(RSd + (16 * ct + fr3) * 16 + 4 * fq3) = d; }
                    __builtin_amdgcn_sched_barrier(0);
                    f32x4 o4[4];
#pragma unroll
                    for (int q4 = 0; q4 < 4; ++q4) o4[q4] = *(const LAS f32x4*)(RSd + c * 16 + 4 * q4);
#pragma unroll
                    for (int q4 = 0; q4 < 4; ++q4) { r[4 * q4] -= o4[q4][0]; r[4 * q4 + 1] -= o4[q4][1]; r[4 * q4 + 2] -= o4[q4][2]; r[4 * q4 + 3] -= o4[q4][3]; }
                }
#pragma unroll
                for (int jg = 0; jg < 4; ++jg) { f32x4 av[4][4];
#pragma unroll
                    for (int jq = 0; jq < 4; ++jq)
#pragma unroll
                        for (int q4 = jg; q4 < 4; ++q4) av[jq][q4] = *(const LAS f32x4*)(ADd + bi * 256 + (4 * jg + jq) * 16 + 4 * q4);
                    __builtin_amdgcn_sched_barrier(0);
#pragma unroll
                    for (int jq = 0; jq < 4; ++jq) { const int jj = 4 * jg + jq; t[16 * bi + jj] = r[jj];
#pragma unroll
                        for (int q4 = jg; q4 < 4; ++q4)
#pragma unroll
                            for (int e = 0; e < 4; ++e) if (4 * q4 + e > jj) r[4 * q4 + e] -= av[jq][q4][e] * r[jj]; }
                    __builtin_amdgcn_sched_barrier(0); }
                if (bi < 3) { unsigned tw[8];
#pragma unroll
                    for (int e = 0; e < 8; ++e) tw[e] = pk2(t[16 * bi + 2 * e], t[16 * bi + 2 * e + 1]);
                    *(LAS v4u*)(TT + c * 72 + 16 * bi) = (v4u){tw[0], tw[1], tw[2], tw[3]}; *(LAS v4u*)(TT + c * 72 + 16 * bi + 8) = (v4u){tw[4], tw[5], tw[6], tw[7]}; }
                } else {
#pragma unroll
                for (int jj = 0; jj < 16; ++jj) t[16 * bi + jj] = r[jj]; }
            }
            const int tc = dir ? 63 - c : c; const float bc = BET[dir * 64 + tc], bd = bc * EXD[dir * 64 + tc];
            LAS bf16* T0 = TB + (dir * 2 + 0) * 64 * 72 + tc + (dir ? 63 * 72 : 0); const int tstep = dir ? -72 : 72;
#pragma unroll
            for (int i = 0; i < 64; ++i) { T0[i * tstep] = (bf16)f2bf(t[i] * bc); T0[64 * 72 + i * tstep] = (bf16)f2bf(t[i] * bd); }
        } else {
            for (int idx = tid - 128; idx < ((SKIP & 16) ? 0 : 1024); idx += 384) { const int r = idx >> 3, c8 = idx & 7; *(GAS v4u*)(KNTg + ((size_t)(h * 256 + oc) * 128 + r) * 64 + c8 * 8) = *(const LAS v4u*)(KNT + r * 72 + c8 * 8); }
            if (tid >= 128 && tid < 256) { const int dir = (tid - 128) >> 6, t = tid & 63; const float dl = dir ? DEC[64] : DEC[63];
                float* g = GSC + (size_t)((dir * 8 + h) * 256 + oc) * 192; g[t] = EXD[dir * 64 + t]; g[64 + t] = __expf(dl - DEC[dir * 64 + t]); if (t == 0) g[128] = __expf(dl); }
        }
        __syncthreads();
#pragma unroll 1
        for (int n = 0; n < ((SKIP & 4) ? 0 : 16); ++n) { const int qi = w * 16 + n, dir = qi >> 6, kind = (qi >> 5) & 1, idx = qi & 31; f32x4 acc = {0.f, 0.f, 0.f, 0.f};
            const LAS bf16* Tm = TB + (dir * 2 + kind) * 64 * 72; const size_t cb = (size_t)(h * 256 + oc) * 8192;
            if (kind == 0) { const int ti = idx >> 3, vj = idx & 7;
#pragma unroll
                for (int s0 = 0; s0 < 2; ++s0) acc = mfma16(ldfrag(Tm, 72, 16 * ti + fr, 32 * s0 + 8 * fq), ldfrag(VT, 72, 16 * vj + fr, 32 * s0 + 8 * fq), acc);
                bf16* U = (bf16*)(F.ws + (dir ? WS_UTB : WS_UTF)); if (!(SKIP & 16)) *(GAS v2u*)(U + cb + (16 * vj + fr) * 64 + 16 * ti + 4 * fq) = pack4(acc);
            } else { const int ki = idx >> 2, tj = idx & 3;
#pragma unroll
                for (int s0 = 0; s0 < 2; ++s0) acc = mfma16(ldfrag(KNT, 72, 16 * ki + fr, 32 * s0 + 8 * fq), ldfrag(Tm, 72, 16 * tj + fr, 32 * s0 + 8 * fq), acc);
                bf16* W = (bf16*)(F.ws + (dir ? WS_WB : WS_WF)); if (!(SKIP & 16)) *(GAS v2u*)(W + cb + (16 * tj + fr) * 128 + 16 * ki + 4 * fq) = pack4(acc); }
        }
    }
}
__device__ __forceinline__ void gdn_load_tiles(const unsigned char* ws, const unsigned char* dob, int tid, int dir, int hd, int h, int oc, bool pass3, v4u (&rw)[2], v4u (&rq)[2], v4u (&ru)[2], v4u (&rk)[2], v4u& ra, float& rs) {
    const size_t cb = (size_t)(h * 256 + oc);
    const int row = tid >> 3, c0 = (tid & 7) * 16, vrow = tid >> 2, t0 = (tid & 3) * 16;
    const bf16* W = (const bf16*)(ws + (dir ? WS_WB : WS_WF)) + cb * 8192 + row * 128 + c0; rw[0] = *(const GAS v4u*)W; rw[1] = *(const GAS v4u*)(W + 8);
    const bf16* U = (const bf16*)(ws + (dir ? WS_UTB : WS_UTF)) + cb * 8192 + vrow * 64 + t0; ru[0] = *(const GAS v4u*)U; ru[1] = *(const GAS v4u*)(U + 8);
    const bf16* Kt = (const bf16*)(dob + DO_KNT) + (size_t)(h * 256 + oc) * 8192 + vrow * 64 + t0; rk[0] = *(const GAS v4u*)Kt; rk[1] = *(const GAS v4u*)(Kt + 8);
    if (pass3) {
        const bf16* Q = (const bf16*)(dob + DO_QN) + (size_t)(64 * oc + row) * HW + h * 128 + c0; rq[0] = *(const GAS v4u*)Q; rq[1] = *(const GAS v4u*)(Q + 8);
        const bf16* A = (const bf16*)(dob + (dir ? DO_AQKB : DO_AQKF)) + cb * 4096 + row * 64 + (tid & 7) * 8; ra = *(const GAS v4u*)A;
    }
    rs = (tid < 192) ? ((const float*)(ws + WS_GSC))[(size_t)(hd * 256 + oc) * 192 + tid] : 0.f;
}
#define SCHED_FENCE() __builtin_amdgcn_sched_barrier(0)
template <bool PASS3, bool UREAL>
__device__ __forceinline__ void gdn_tile(f32x4 (&A)[8], const LAS bf16* WTL, const LAS bf16* QNL, const LAS bf16* UTL, const LAS bf16* KTL, const LAS bf16* AQL, const LAS float* SCL,
                                         LAS bf16* ST, LAS bf16* VN, LAS bf16* VNS, int w, int fr, int fq, float gl, bf16* Ogc) {
#pragma unroll
    for (int kt = 0; kt < 8; ++kt) *(LAS v2u*)(ST + fr * 136 + 16 * kt + 4 * fq) = pack4(A[kt]);
    asm volatile("" ::: "memory");
    bf16x8 xs[4];
#pragma unroll
    for (int k0 = 0; k0 < 4; ++k0) xs[k0] = ldfrag(ST, 136, fr, 32 * k0 + 8 * fq);
#pragma unroll
    for (int th = 0; th < 2; ++th) { bf16x8 wf[2][4]; f32x4 acc[2]; v2u uw[2]; f32x4 es[2];
#pragma unroll
      for (int tq = 0; tq < 2; ++tq) { const int tt = 2 * th + tq;
#pragma unroll
          for (int k0 = 0; k0 < 4; ++k0) wf[tq][k0] = ldfrag(WTL, 136, 16 * tt + fr, 32 * k0 + 8 * fq);
          if (UREAL) uw[tq] = *(const LAS v2u*)(UTL + (16 * w + fr) * 72 + 16 * tt + 4 * fq);
          es[tq] = *(const LAS f32x4*)(SCL + 64 + 16 * tt + 4 * fq); acc[tq] = (f32x4){0.f, 0.f, 0.f, 0.f}; }
      SCHED_FENCE();
#pragma unroll
      for (int k0 = 0; k0 < 4; ++k0)
#pragma unroll
          for (int tq = 0; tq < 2; ++tq) acc[tq] = mfma16(wf[tq][k0], xs[k0], acc[tq]);
      SCHED_FENCE();
#pragma unroll
      for (int tq = 0; tq < 2; ++tq) { const int tt = 2 * th + tq; f32x4 u4 = {0.f, 0.f, 0.f, 0.f};
          if (UREAL) u4 = (f32x4){bflo(uw[tq].x), bfhi(uw[tq].x), bflo(uw[tq].y), bfhi(uw[tq].y)};
          const f32x4 vn = u4 - acc[tq];
          if (PASS3) *(LAS v2u*)(VN + fr * 72 + 16 * tt + 4 * fq) = pack4(vn);
          *(LAS v2u*)(VNS + fr * 72 + 16 * tt + 4 * fq) = pack4(vn * es[tq]); }
      SCHED_FENCE(); }
    asm volatile("" ::: "memory");
    if (PASS3) { bf16x8 yv[2];
#pragma unroll
        for (int s0 = 0; s0 < 2; ++s0) yv[s0] = ldfrag(VN, 72, fr, 32 * s0 + 8 * fq);
#pragma unroll
        for (int th = 0; th < 2; ++th) { bf16x8 qf[2][4], af[2][2]; f32x4 acc[2]; float ed[2];
#pragma unroll
            for (int tq = 0; tq < 2; ++tq) { const int tt = 2 * th + tq;
#pragma unroll
                for (int k0 = 0; k0 < 4; ++k0) qf[tq][k0] = ldfrag(QNL, 136, 16 * tt + fr, 32 * k0 + 8 * fq);
#pragma unroll
                for (int s0 = 0; s0 < 2; ++s0) af[tq][s0] = ldfrag(AQL, 72, 16 * tt + fr, 32 * s0 + 8 * fq);
                ed[tq] = SCL[16 * tt + fr]; acc[tq] = (f32x4){0.f, 0.f, 0.f, 0.f}; }
            SCHED_FENCE();
#pragma unroll
            for (int k0 = 0; k0 < 4; ++k0)
#pragma unroll
                for (int tq = 0; tq < 2; ++tq) acc[tq] = mfma16(xs[k0], qf[tq][k0], acc[tq]);
#pragma unroll
            for (int tq = 0; tq < 2; ++tq) acc[tq] = acc[tq] * ed[tq];
#pragma unroll
            for (int s0 = 0; s0 < 2; ++s0)
#pragma unroll
                for (int tq = 0; tq < 2; ++tq) acc[tq] = mfma16(yv[s0], af[tq][s0], acc[tq]);
            SCHED_FENCE();
#pragma unroll
            for (int tq = 0; tq < 2; ++tq) *(GAS v2u*)(Ogc + (size_t)(16 * (2 * th + tq) + fr) * HW + 16 * w + 4 * fq) = pack4(acc[tq]);
            SCHED_FENCE(); } }
    { bf16x8 ys[2];
#pragma unroll
      for (int s0 = 0; s0 < 2; ++s0) ys[s0] = ldfrag(VNS, 72, fr, 32 * s0 + 8 * fq);
#pragma unroll
      for (int kh = 0; kh < 2; ++kh) { bf16x8 kf[4][2];
#pragma unroll
          for (int kq = 0; kq < 4; ++kq)
#pragma unroll
              for (int s0 = 0; s0 < 2; ++s0) kf[kq][s0] = ldfrag(KTL, 72, 16 * (4 * kh + kq) + fr, 32 * s0 + 8 * fq);
#pragma unroll
          for (int kq = 0; kq < 4; ++kq) A[4 * kh + kq] = A[4 * kh + kq] * gl;
          SCHED_FENCE();
#pragma unroll
          for (int s0 = 0; s0 < 2; ++s0)
#pragma unroll
              for (int kq = 0; kq < 4; ++kq) A[4 * kh + kq] = mfma16(kf[kq][s0], ys[s0], A[4 * kh + kq]);
          SCHED_FENCE(); } }
}
template <bool PASS3, int SKIP = 0>
__device__ __forceinline__ void gdn_pass(Frame& F) {
    LAS bf16*  WTL = (LAS bf16*)(F.lds + 0);
    LAS bf16*  QNL = (LAS bf16*)(F.lds + 17408);
    LAS bf16*  UTL = (LAS bf16*)(F.lds + 34816);
    LAS bf16*  KTL = (LAS bf16*)(F.lds + 53248);
    LAS bf16*  AQL = (LAS bf16*)(F.lds + 71680);
    LAS float* SCL = (LAS float*)(F.lds + 80896);
    LAS bf16*  PX  = (LAS bf16*)(F.lds + 0);
    const int tid = F.tid, lane = F.lane, w = F.wave, fr = lane & 15, fq = lane >> 4;
    LAS bf16* ST  = (LAS bf16*)(F.lds + 81920 + w * 8960);
    LAS bf16* VN  = ST + 16 * 136;
    LAS bf16* VNS = VN + 16 * 72;
    const int row = tid >> 3, c0 = (tid & 7) * 16, vrow = tid >> 2, t0 = (tid & 3) * 16;
    const unsigned char* dob = (const unsigned char*)F.out;
    float* GL = (float*)(F.ws + WS_GL); bf16* GP = (bf16*)(F.ws + WS_GP);
    for (int it = blockIdx.x; it < 256; it += F.G) {
        const int hd = it >> 4, sg = it & 15, dir = hd >> 3, h = hd & 7;
        bf16* Og = (bf16*)(F.ws + (dir ? WS_OGB : WS_OGF));
        f32x4 Sacc[8], Pacc[8];
        int dgi = 16 * w + fr - 4 * fq; asm volatile("" : "+v"(dgi));
#pragma unroll
        for (int kt = 0; kt < 8; ++kt) { Sacc[kt] = (f32x4){0.f, 0.f, 0.f, 0.f};
#pragma unroll
            for (int r = 0; r < 4; ++r) Pacc[kt][r] = (!PASS3 && (16 * kt + r == dgi)) ? 1.f : 0.f; }
        __syncthreads();
        if (PASS3) {
            for (int p = 0; p < sg; ++p) { const int ip = hd * 16 + p;
                { const bf16* src = GP + (size_t)ip * 16384 + vrow * 128 + (tid & 3) * 32;
#pragma unroll
                  for (int q = 0; q < 4; ++q) *(LAS v4u*)(PX + vrow * 136 + (tid & 3) * 32 + 8 * q) = *(const GAS v4u*)(src + 8 * q); }
#pragma unroll
                for (int kt = 0; kt < 8; ++kt) *(LAS v2u*)(ST + fr * 136 + 16 * kt + 4 * fq) = pack4(Sacc[kt]);
                __syncthreads();
                bf16x8 xs[4];
#pragma unroll
                for (int k0 = 0; k0 < 4; ++k0) xs[k0] = ldfrag(ST, 136, fr, 32 * k0 + 8 * fq);
#pragma unroll
                for (int kh = 0; kh < 2; ++kh) { bf16x8 pf[4][4]; f32x4 acc[4];
#pragma unroll
                    for (int kq = 0; kq < 4; ++kq) { const int kt = 4 * kh + kq; acc[kq] = *(const GAS f32x4*)(GL + ((size_t)((ip * 8 + w) * 8 + kt) * 64 + lane) * 4);
#pragma unroll
                        for (int k0 = 0; k0 < 4; ++k0) pf[kq][k0] = ldfrag(PX, 136, 16 * kt + fr, 32 * k0 + 8 * fq); }
                    SCHED_FENCE();
#pragma unroll
                    for (int k0 = 0; k0 < 4; ++k0)
#pragma unroll
                        for (int kq = 0; kq < 4; ++kq) acc[kq] = mfma16(pf[kq][k0], xs[k0], acc[kq]);
                    SCHED_FENCE();
#pragma unroll
                    for (int kq = 0; kq < 4; ++kq) Sacc[4 * kh + kq] = acc[kq]; }
                __syncthreads();
            }
        }
        v4u rw[2], rq[2], ru[2], rk[2], ra; float rs;
        gdn_load_tiles(F.ws, dob, tid, dir, hd, h, dir ? 255 - sg * 16 : sg * 16, PASS3, rw, rq, ru, rk, ra, rs);
        for (int ci = 0; ci < CPS; ++ci) {
            const int sc = sg * 16 + ci, oc = dir ? 255 - sc : sc, tok0 = 64 * oc;
            *(LAS v4u*)(WTL + row * 136 + c0) = rw[0]; *(LAS v4u*)(WTL + row * 136 + c0 + 8) = rw[1];
            *(LAS v4u*)(UTL + vrow * 72 + t0) = ru[0]; *(LAS v4u*)(UTL + vrow * 72 + t0 + 8) = ru[1];
            *(LAS v4u*)(KTL + vrow * 72 + t0) = rk[0]; *(LAS v4u*)(KTL + vrow * 72 + t0 + 8) = rk[1];
            if (PASS3) { *(LAS v4u*)(QNL + row * 136 + c0) = rq[0]; *(LAS v4u*)(QNL + row * 136 + c0 + 8) = rq[1]; *(LAS v4u*)(AQL + row * 72 + (tid & 7) * 8) = ra; }
            if (tid < 192) SCL[tid] = rs;
            __syncthreads();
            if (ci + 1 < CPS && !(SKIP & 1)) gdn_load_tiles(F.ws, dob, tid, dir, hd, h, dir ? oc - 1 : oc + 1, PASS3, rw, rq, ru, rk, ra, rs);
            const float gl = SCL[128];
            gdn_tile<PASS3, true>(Sacc, WTL, QNL, UTL, KTL, AQL, SCL, ST, VN, VNS, w, fr, fq, gl, Og + (size_t)tok0 * HW + h * 128);
            if (!PASS3) gdn_tile<PASS3, false>(Pacc, WTL, QNL, UTL, KTL, AQL, SCL, ST, VN, VNS, w, fr, fq, gl, Og);
            __syncthreads();
        }
        if (!PASS3) {
            int pofs = (4 * fq) * 128 + 16 * w + fr; asm volatile("" : "+v"(pofs));
            bf16* gp = GP + (size_t)it * 16384 + pofs;
#pragma unroll
            for (int kt = 0; kt < 8; ++kt) { *(GAS f32x4*)(GL + ((size_t)((it * 8 + w) * 8 + kt) * 64 + lane) * 4) = Sacc[kt];
#pragma unroll
                for (int r = 0; r < 4; ++r) gp[(16 * kt + r) * 128] = (bf16)f2bf(Pacc[kt][r]); }
        }
    }
}
__device__ __forceinline__ void p7_mix(Frame& F) {
    const int gw = F.vcu * NWAVES + F.wave, NGW = F.G * NWAVES, lane = F.lane;
    const int e0 = (lane & 7) * 16, col = (lane >> 3) * 128 + e0;
    for (int m = gw; m < SEQ; m += NGW) {
#pragma unroll
        for (int mx = 0; mx < 2; ++mx) {
            const bf16* of = (const bf16*)(F.ws + (mx ? WS_OGF : WS_OHF)); const bf16* ob = (const bf16*)(F.ws + (mx ? WS_OGB : WS_OHB));
            const bf16* gt = (const bf16*)(F.ws + WS_H + (size_t)(mx ? 8 : 4) * 32 * MiB); const float* nw = F.in[mx ? I_GNW : I_HNW];
            bf16* yo = (bf16*)(F.ws + (mx ? WS_YB : WS_YA));
            const size_t off = (size_t)m * HW + col;
            const v4u a0 = *(const GAS v4u*)(of + off), a1 = *(const GAS v4u*)(of + off + 8), b0 = *(const GAS v4u*)(ob + off), b1 = *(const GAS v4u*)(ob + off + 8), g0 = *(const GAS v4u*)(gt + off), g1 = *(const GAS v4u*)(gt + off + 8);
            const unsigned aw[8] = {a0.x, a0.y, a0.z, a0.w, a1.x, a1.y, a1.z, a1.w}, bw[8] = {b0.x, b0.y, b0.z, b0.w, b1.x, b1.y, b1.z, b1.w}, gw_[8] = {g0.x, g0.y, g0.z, g0.w, g1.x, g1.y, g1.z, g1.w};
            float gf[16];
#pragma unroll
            for (int e = 0; e < 8; ++e) { gf[2 * e] = bflo(gw_[e]); gf[2 * e + 1] = bfhi(gw_[e]); }
            float o[16]; float ss = 0.f;
#pragma unroll
            for (int e = 0; e < 8; ++e) { o[2 * e] = bflo(aw[e]) + bflo(bw[e]); o[2 * e + 1] = bfhi(aw[e]) + bfhi(bw[e]); ss += o[2 * e] * o[2 * e] + o[2 * e + 1] * o[2 * e + 1]; }
            ss += __shfl_xor(ss, 1); ss += __shfl_xor(ss, 2); ss += __shfl_xor(ss, 4);
            const float r = 1.0f / sqrtf(ss * (1.f / 128.f) + EPS);
            if (QM_MIX == 2) { float yv[16]; float am = 0.f;
#pragma unroll
                for (int e = 0; e < 8; ++e) { yv[2 * e] = o[2 * e] * r * nw[e0 + 2 * e] * gf[2 * e]; yv[2 * e + 1] = o[2 * e + 1] * r * nw[e0 + 2 * e + 1] * gf[2 * e + 1]; am = fmaxf(am, fmaxf(fabsf(yv[2 * e]), fabsf(yv[2 * e + 1]))); }
                am = wave_max(am); const float inv = am > 0.f ? 127.0f / am : 0.f;
                *(GAS v4u*)((unsigned char*)yo + off) = (v4u){pk4i8((f32x4){yv[0], yv[1], yv[2], yv[3]}, inv), pk4i8((f32x4){yv[4], yv[5], yv[6], yv[7]}, inv), pk4i8((f32x4){yv[8], yv[9], yv[10], yv[11]}, inv), pk4i8((f32x4){yv[12], yv[13], yv[14], yv[15]}, inv)};
                if (lane == 0) ((float*)(F.ws + WS_QX))[(1 + mx) * SEQ + m] = am > 0.f ? am * (1.0f / 127.0f) : 1.0f; }
            else if (QM_MIX == 1) { unsigned yq[4];
#pragma unroll
                for (int e = 0; e < 4; ++e) yq[e] = pk4f8(o[4 * e] * r * nw[e0 + 4 * e] * gf[4 * e], o[4 * e + 1] * r * nw[e0 + 4 * e + 1] * gf[4 * e + 1], o[4 * e + 2] * r * nw[e0 + 4 * e + 2] * gf[4 * e + 2], o[4 * e + 3] * r * nw[e0 + 4 * e + 3] * gf[4 * e + 3]);
                *(GAS v4u*)((unsigned char*)yo + off) = (v4u){yq[0], yq[1], yq[2], yq[3]}; }
            else { unsigned yw[8];
#pragma unroll
            for (int e = 0; e < 8; ++e) yw[e] = pk2(o[2 * e] * r * nw[e0 + 2 * e] * gf[2 * e], o[2 * e + 1] * r * nw[e0 + 2 * e + 1] * gf[2 * e + 1]);
            *(GAS v4u*)(yo + off) = (v4u){yw[0], yw[1], yw[2], yw[3]}; *(GAS v4u*)(yo + off + 8) = (v4u){yw[4], yw[5], yw[6], yw[7]}; }
        }
    }
    for (int tb = 0; tb < 2; ++tb) { const float* src = F.in[tb ? I_PV : I_PU]; unsigned char* dst = F.ws + (tb ? WS_TV : WS_TU); float* scl = (float*)(F.ws + WS_PSC) + tb * 16384;
        for (int r = gw; r < 16384; r += NGW) { const float* row = src + (size_t)r * DM; f32x4 v[8]; float mx = 0.f;
#pragma unroll
            for (int q = 0; q < 8; ++q) { v[q] = *(const GAS f32x4*)(row + (tb ? (q >> 2) * 1024 + lane * 16 + 4 * (q & 3) : lane * 32 + 4 * q)); const f32x4 a = __builtin_elementwise_abs(v[q]); mx = fmaxf(mx, fmaxf(fmaxf(a.x, a.y), fmaxf(a.z, a.w))); }
            mx = wave_max(mx);
            const float sc = mx > 0.f ? mx * (tb ? ((VFMT == 6 || VFMT == 64) ? 1.0f / 7.5f : VFMT == 4 ? 1.0f / 6.0f : 1.0f / 256.0f) : 1.0f / 127.0f) : 1.0f, inv = 1.0f / sc;
            if (tb && VFMT == 4) { unsigned w4[4];
#pragma unroll
                for (int d = 0; d < 4; ++d) { unsigned ww = 0u;
                    ww = __builtin_amdgcn_cvt_scalef32_pk_fp4_f32(ww, v[2 * d].x * inv, v[2 * d].y * inv, 1.0f, 0); ww = __builtin_amdgcn_cvt_scalef32_pk_fp4_f32(ww, v[2 * d].z * inv, v[2 * d].w * inv, 1.0f, 1);
                    ww = __builtin_amdgcn_cvt_scalef32_pk_fp4_f32(ww, v[2 * d + 1].x * inv, v[2 * d + 1].y * inv, 1.0f, 2); ww = __builtin_amdgcn_cvt_scalef32_pk_fp4_f32(ww, v[2 * d + 1].z * inv, v[2 * d + 1].w * inv, 1.0f, 3); w4[d] = ww; }
                *(GAS v4u*)(dst + (size_t)r * TV_PITCH + lane * 16) = (v4u){w4[0], w4[1], w4[2], w4[3]};
                if (lane == 0) scl[r] = sc;
                continue; }
            if (tb && VFMT == 64) { unsigned w4[4]; const float inv4 = inv * (6.0f / 7.5f);
#pragma unroll
                for (int d = 0; d < 4; ++d) { unsigned ww = 0u;
                    ww = __builtin_amdgcn_cvt_scalef32_pk_fp4_f32(ww, v[d].x * inv4, v[4 + d].x * inv4, 1.0f, 0); ww = __builtin_amdgcn_cvt_scalef32_pk_fp4_f32(ww, v[d].y * inv4, v[4 + d].y * inv4, 1.0f, 1);
                    ww = __builtin_amdgcn_cvt_scalef32_pk_fp4_f32(ww, v[d].z * inv4, v[4 + d].z * inv4, 1.0f, 2); ww = __builtin_amdgcn_cvt_scalef32_pk_fp4_f32(ww, v[d].w * inv4, v[4 + d].w * inv4, 1.0f, 3); w4[d] = ww; }
                *(GAS v4u*)(F.ws + WS_TV4 + (size_t)r * 1024 + lane * 16) = (v4u){w4[0], w4[1], w4[2], w4[3]}; }
            if (tb && (VFMT == 6 || VFMT == 64)) { v16f a16, b16;
#pragma unroll
                for (int q = 0; q < 4; ++q) { a16[4 * q] = v[q].x * inv; a16[4 * q + 1] = v[q].y * inv; a16[4 * q + 2] = v[q].z * inv; a16[4 * q + 3] = v[q].w * inv;
                    b16[4 * q] = v[4 + q].x * inv; b16[4 * q + 1] = v[4 + q].y * inv; b16[4 * q + 2] = v[4 + q].z * inv; b16[4 * q + 3] = v[4 + q].w * inv; }
                const v6u pk = __builtin_amdgcn_cvt_scalef32_2xpk16_fp6_f32(a16, b16, 1.0f);
                *(GAS v4u*)(dst + (size_t)r * TV_PITCH + lane * 16) = (v4u){pk[0], pk[1], pk[2], pk[3]}; *(GAS v2u*)(dst + (size_t)r * TV_PITCH + 1024 + lane * 8) = (v2u){pk[4], pk[5]};
                if (lane == 0) scl[r] = sc;
                continue; }
            unsigned w[8];
#pragma unroll
            for (int q = 0; q < 8; ++q) { const f32x4 x = v[q];
                if (tb) w[q] = pk4f8(x.x * inv, x.y * inv, x.z * inv, x.w * inv);
                else { const int a = (int)rintf(x.x * inv), b = (int)rintf(x.y * inv), c = (int)rintf(x.z * inv), d = (int)rintf(x.w * inv);
                    w[q] = (unsigned)(a & 255) | ((unsigned)(b & 255) << 8) | ((unsigned)(c & 255) << 16) | ((unsigned)(d & 255) << 24); } }
            if (tb) { *(GAS v4u*)(dst + (size_t)r * DM + lane * 16) = (v4u){w[0], w[1], w[2], w[3]}; *(GAS v4u*)(dst + (size_t)r * DM + 1024 + lane * 16) = (v4u){w[4], w[5], w[6], w[7]}; }
            else { GAS v4u* o = (GAS v4u*)(dst + ((size_t)lane * 16384 + r) * 32); o[0] = (v4u){w[0], w[1], w[2], w[3]}; o[1] = (v4u){w[4], w[5], w[6], w[7]}; }
            if (lane == 0) scl[r] = sc; } }
}
constexpr size_t WS_XQ = 80 * MiB;
constexpr size_t WS_SXR = 112 * MiB;
constexpr size_t WS_EID = 113 * MiB, WS_GATE = 121 * MiB, WS_AV = 129 * MiB;
constexpr size_t WS_REC = 208 * MiB;
constexpr int NET = 32, ETSZ = 512, NBUCK = 16 * NET, REC_CAP = 16384, CW_CNT = 8192, CW_Q = 8192 + 16 * NBUCK;
__device__ __forceinline__ unsigned fkey(float f) { const unsigned u = __builtin_bit_cast(unsigned, f); return (u & 0x80000000u) ? ~u : (u | 0x80000000u); }
__device__ __forceinline__ float gelu_erf(float x) { return 0.5f * x * (1.0f + erff(x * 0.70710678118654752f)); }

__device__ __forceinline__ float key_val(unsigned k, unsigned mask) { unsigned u = k & ~mask; u = (u & 0x80000000u) ? (u & 0x7fffffffu) : ~u; return __builtin_bit_cast(float, u); }
#define SN_CE(x, y) do { const unsigned sn_h = (x) > (y) ? (x) : (y); (y) = (x) > (y) ? (y) : (x); (x) = sn_h; } while (0)
#define SN_SORT16(k) do { SN_CE(k[0], k[1]); SN_CE(k[2], k[3]); SN_CE(k[0], k[2]); SN_CE(k[1], k[3]); SN_CE(k[1], k[2]); SN_CE(k[4], k[5]); SN_CE(k[6], k[7]); SN_CE(k[4], k[6]); SN_CE(k[5], k[7]); SN_CE(k[5], k[6]); SN_CE(k[0], k[4]); SN_CE(k[2], k[6]); SN_CE(k[2], k[4]); SN_CE(k[1], k[5]); SN_CE(k[3], k[7]); SN_CE(k[3], k[5]); SN_CE(k[1], k[2]); SN_CE(k[3], k[4]); SN_CE(k[5], k[6]); SN_CE(k[8], k[9]); SN_CE(k[10], k[11]); SN_CE(k[8], k[10]); SN_CE(k[9], k[11]); SN_CE(k[9], k[10]); SN_CE(k[12], k[13]); SN_CE(k[14], k[15]); SN_CE(k[12], k[14]); SN_CE(k[13], k[15]); SN_CE(k[13], k[14]); SN_CE(k[8], k[12]); SN_CE(k[10], k[14]); SN_CE(k[10], k[12]); SN_CE(k[9], k[13]); SN_CE(k[11], k[15]); SN_CE(k[11], k[13]); SN_CE(k[9], k[10]); SN_CE(k[11], k[12]); SN_CE(k[13], k[14]); SN_CE(k[0], k[8]); SN_CE(k[4], k[12]); SN_CE(k[4], k[8]); SN_CE(k[2], k[10]); SN_CE(k[6], k[14]); SN_CE(k[6], k[10]); SN_CE(k[2], k[4]); SN_CE(k[6], k[8]); SN_CE(k[10], k[12]); SN_CE(k[1], k[9]); SN_CE(k[5], k[13]); SN_CE(k[5], k[9]); SN_CE(k[3], k[11]); SN_CE(k[7], k[15]); SN_CE(k[7], k[11]); SN_CE(k[3], k[5]); SN_CE(k[7], k[9]); SN_CE(k[11], k[13]); SN_CE(k[1], k[2]); SN_CE(k[3], k[4]); SN_CE(k[5], k[6]); SN_CE(k[7], k[8]); SN_CE(k[9], k[10]); SN_CE(k[11], k[12]); SN_CE(k[13], k[14]); } while (0)
#define SN_MERGE16(t, k) do { t[0] = t[0] > k[15] ? t[0] : k[15]; t[1] = t[1] > k[14] ? t[1] : k[14]; t[2] = t[2] > k[13] ? t[2] : k[13]; t[3] = t[3] > k[12] ? t[3] : k[12]; t[4] = t[4] > k[11] ? t[4] : k[11]; t[5] = t[5] > k[10] ? t[5] : k[10]; t[6] = t[6] > k[9] ? t[6] : k[9]; t[7] = t[7] > k[8] ? t[7] : k[8]; t[8] = t[8] > k[7] ? t[8] : k[7]; t[9] = t[9] > k[6] ? t[9] : k[6]; t[10] = t[10] > k[5] ? t[10] : k[5]; t[11] = t[11] > k[4] ? t[11] : k[4]; t[12] = t[12] > k[3] ? t[12] : k[3]; t[13] = t[13] > k[2] ? t[13] : k[2]; t[14] = t[14] > k[1] ? t[14] : k[1]; t[15] = t[15] > k[0] ? t[15] : k[0]; SN_CE(t[0], t[8]); SN_CE(t[1], t[9]); SN_CE(t[2], t[10]); SN_CE(t[3], t[11]); SN_CE(t[4], t[12]); SN_CE(t[5], t[13]); SN_CE(t[6], t[14]); SN_CE(t[7], t[15]); SN_CE(t[0], t[4]); SN_CE(t[1], t[5]); SN_CE(t[2], t[6]); SN_CE(t[3], t[7]); SN_CE(t[8], t[12]); SN_CE(t[9], t[13]); SN_CE(t[10], t[14]); SN_CE(t[11], t[15]); SN_CE(t[0], t[2]); SN_CE(t[1], t[3]); SN_CE(t[4], t[6]); SN_CE(t[5], t[7]); SN_CE(t[8], t[10]); SN_CE(t[9], t[11]); SN_CE(t[12], t[14]); SN_CE(t[13], t[15]); SN_CE(t[0], t[1]); SN_CE(t[2], t[3]); SN_CE(t[4], t[5]); SN_CE(t[6], t[7]); SN_CE(t[8], t[9]); SN_CE(t[10], t[11]); SN_CE(t[12], t[13]); SN_CE(t[14], t[15]); } while (0)
#define SN_CAND(i, j) ((fkey(f1[i] + f2[j]) & ~255u) | (unsigned)((i) * 16 + (j)))
#define SN_STAGE2(c, k) do { k[0] = SN_CAND(0, 0); k[1] = SN_CAND(0, 1); k[2] = SN_CAND(0, 2); k[3] = SN_CAND(0, 3); k[4] = SN_CAND(0, 4); k[5] = SN_CAND(0, 5); k[6] = SN_CAND(0, 6); k[7] = SN_CAND(0, 7); k[8] = SN_CAND(0, 8); k[9] = SN_CAND(0, 9); k[10] = SN_CAND(0, 10); k[11] = SN_CAND(0, 11); k[12] = SN_CAND(0, 12); k[13] = SN_CAND(0, 13); k[14] = SN_CAND(0, 14); k[15] = SN_CAND(0, 15); SN_SORT16(k); c[0] = k[0]; c[1] = k[1]; c[2] = k[2]; c[3] = k[3]; c[4] = k[4]; c[5] = k[5]; c[6] = k[6]; c[7] = k[7]; c[8] = k[8]; c[9] = k[9]; c[10] = k[10]; c[11] = k[11]; c[12] = k[12]; c[13] = k[13]; c[14] = k[14]; c[15] = k[15]; k[0] = SN_CAND(1, 0); k[1] = SN_CAND(1, 1); k[2] = SN_CAND(1, 2); k[3] = SN_CAND(1, 3); k[4] = SN_CAND(1, 4); k[5] = SN_CAND(1, 5); k[6] = SN_CAND(1, 6); k[7] = SN_CAND(1, 7); k[8] = SN_CAND(2, 0); k[9] = SN_CAND(2, 1); k[10] = SN_CAND(2, 2); k[11] = SN_CAND(2, 3); k[12] = SN_CAND(2, 4); k[13] = SN_CAND(3, 0); k[14] = SN_CAND(3, 1); k[15] = SN_CAND(3, 2); SN_SORT16(k); SN_MERGE16(c, k); k[0] = SN_CAND(3, 3); k[1] = SN_CAND(4, 0); k[2] = SN_CAND(4, 1); k[3] = SN_CAND(4, 2); k[4] = SN_CAND(5, 0); k[5] = SN_CAND(5, 1); k[6] = SN_CAND(6, 0); k[7] = SN_CAND(6, 1); k[8] = SN_CAND(7, 0); k[9] = SN_CAND(7, 1); k[10] = SN_CAND(8, 0); k[11] = SN_CAND(9, 0); k[12] = SN_CAND(10, 0); k[13] = SN_CAND(11, 0); k[14] = SN_CAND(12, 0); k[15] = SN_CAND(13, 0); SN_SORT16(k); SN_MERGE16(c, k); { unsigned x = SN_CAND(14, 0); _Pragma("unroll") for (int r = 0; r < 16; ++r) { const unsigned hi = c[r] > x ? c[r] : x; x = c[r] > x ? x : c[r]; c[r] = hi; } } { unsigned x = SN_CAND(15, 0); _Pragma("unroll") for (int r = 0; r < 16; ++r) { const unsigned hi = c[r] > x ? c[r] : x; x = c[r] > x ? x : c[r]; c[r] = hi; } } } while (0)
template <int SKIP>
__device__ __forceinline__ void p11a_topk(Frame& F) {
    LAS float* SCR = (LAS float*)(F.lds + F.wave * 16384);
    LAS unsigned* SL = (LAS unsigned*)SCR;
    LAS int* EIDS = (LAS int*)(SCR + 1024);
    LAS int* OFFS = (LAS int*)(SCR + 2048);
    LAS float* RTS = SCR + 2304;
    LAS int* BC = (LAS int*)(F.lds + 8 * 16384);
    const bf16* SC = (const bf16*)(F.ws + WS_SC);
    unsigned char* XQ = F.ws + WS_XQ; float* SXR = (float*)(F.ws + WS_SXR); int* EIDg = (int*)(F.ws + WS_EID); float* GATEg = (float*)(F.ws + WS_GATE); unsigned* REC = (unsigned*)(F.ws + WS_REC);
    for (int blk = F.vcu; blk < SEQ / 64; blk += F.G) {
        __syncthreads();
        if (F.tid < NET) BC[F.tid] = 0;
        __syncthreads();
        const int m0 = blk * 64 + F.wave * 8;
#pragma unroll 2
        for (int ti = 0; ti < 8; ++ti) { const int m = m0 + ti;
            int lane = F.lane; asm volatile("" : "+v"(lane));
            float xh[32]; float ss = 0.f;
            const bf16* x1 = (const bf16*)(F.ws + WS_X1B) + (size_t)m * DM + lane * 32; const float* n2 = F.in[I_N2W] + lane * 32;
            f32x4 nwv[8];
#pragma unroll
            for (int q = 0; q < 8; ++q) { const v2u a = *(const GAS v2u*)(x1 + 4 * q); nwv[q] = *(const GAS f32x4*)(n2 + 4 * q); xh[4 * q] = bflo(a.x); xh[4 * q + 1] = bfhi(a.x); xh[4 * q + 2] = bflo(a.y); xh[4 * q + 3] = bfhi(a.y); }
#pragma unroll
            for (int e = 0; e < 32; ++e) ss += xh[e] * xh[e];
            const float rt = 1.0f / sqrtf(wave_sum(ss) * (1.f / DM) + EPS);
            float amx = 0.f;
#pragma unroll
            for (int q = 0; q < 8; ++q) { const f32x4 a = nwv[q]; xh[4 * q] *= rt * a.x; xh[4 * q + 1] *= rt * a.y; xh[4 * q + 2] *= rt * a.z; xh[4 * q + 3] *= rt * a.w; }
#pragma unroll
            for (int e = 0; e < 32; ++e) amx = fmaxf(amx, fabsf(xh[e]));
            amx = wave_max(amx);
            const float sx = amx > 0.f ? amx * (1.0f / 127.0f) : 1.0f, isx = 1.0f / sx;
            unsigned xq[8];
#pragma unroll
            for (int d = 0; d < 8; ++d) { const int a = (int)rintf(xh[4 * d] * isx), b = (int)rintf(xh[4 * d + 1] * isx), c = (int)rintf(xh[4 * d + 2] * isx), e = (int)rintf(xh[4 * d + 3] * isx);
                xq[d] = (unsigned)(a & 255) | ((unsigned)(b & 255) << 8) | ((unsigned)(c & 255) << 16) | ((unsigned)(e & 255) << 24); }
            if (!(SKIP & 2)) { GAS v4u* o = (GAS v4u*)(XQ + ((size_t)lane * SEQ + m) * 32); o[0] = (v4u){xq[0], xq[1], xq[2], xq[3]}; o[1] = (v4u){xq[4], xq[5], xq[6], xq[7]}; }
            if (lane == 0) { SXR[2 * m] = sx; SXR[2 * m + 1] = rt; RTS[ti] = rt; }
        }
#pragma unroll 1
        for (int grp = 0; grp < 2; ++grp) {
            int lane = F.lane; asm volatile("" : "+v"(lane));
            if (!(SKIP & 1)) {
                { const bf16* src = SC + (size_t)(m0 + grp * 4 + (lane >> 4)) * DM + (lane & 15) * 128;
                  unsigned v[16];
#pragma unroll
                  for (int i = 0; i < 16; ++i) v[i] = 0u;
#pragma unroll 1
                  for (int s8 = 0; s8 < 2; ++s8) { v4u a8[8];
#pragma unroll
                      for (int u = 0; u < 8; ++u) a8[u] = *(const GAS v4u*)(src + 64 * s8 + 8 * u);
#pragma unroll
                      for (int u2 = 0; u2 < 4; ++u2) { unsigned k[16];
#pragma unroll
                          for (int h = 0; h < 2; ++h) { const unsigned wv[4] = {a8[2 * u2 + h].x, a8[2 * u2 + h].y, a8[2 * u2 + h].z, a8[2 * u2 + h].w};
#pragma unroll
                              for (int e = 0; e < 8; ++e) { const float sv = (e & 1) ? bfhi(wv[e >> 1]) : bflo(wv[e >> 1]); k[8 * h + e] = (fkey(sv) & ~127u) | (unsigned)(64 * s8 + 16 * u2 + 8 * h + e); } }
                          SN_SORT16(k); SN_MERGE16(v, k); } }
#pragma unroll
                  for (int q = 0; q < 4; ++q) *(LAS v4u*)(SL + lane * 16 + 4 * q) = (v4u){v[4 * q], v[4 * q + 1], v[4 * q + 2], v[4 * q + 3]}; }
                asm volatile("" ::: "memory");
                if (lane < 32) { const int tk = lane >> 3, h = lane & 7, m = m0 + grp * 4 + tk;
                    const LAS unsigned* L1 = SL + (tk * 16 + 2 * h) * 16; const LAS unsigned* L2 = L1 + 16;
                    float f1[16], f2[16];
#pragma unroll
                    for (int q = 0; q < 4; ++q) { const v4u a = *(const LAS v4u*)(L1 + 4 * q), b = *(const LAS v4u*)(L2 + 4 * q);
                        f1[4 * q] = key_val(a.x, 127u); f1[4 * q + 1] = key_val(a.y, 127u); f1[4 * q + 2] = key_val(a.z, 127u); f1[4 * q + 3] = key_val(a.w, 127u);
                        f2[4 * q] = key_val(b.x, 127u); f2[4 * q + 1] = key_val(b.y, 127u); f2[4 * q + 2] = key_val(b.z, 127u); f2[4 * q + 3] = key_val(b.w, 127u); }
                    unsigned c[16]; { unsigned k[16]; SN_STAGE2(c, k); }
                    const float rt = RTS[grp * 4 + tk];
                    float sc[16]; int ee[16]; float mx = -3.0e38f;
#pragma unroll
                    for (int r = 0; r < 16; ++r) { const unsigned ij = c[r] & 255u; const unsigned k1 = L1[ij >> 4], k2 = L2[ij & 15u];
                        sc[r] = key_val(k1, 127u) + key_val(k2, 127u); ee[r] = (int)((k1 & 127u) * 128u + (k2 & 127u)); mx = fmaxf(mx, sc[r]); }
                    float sum = 0.f;
#pragma unroll
                    for (int r = 0; r < 16; ++r) { sc[r] = __expf(rt * (sc[r] - mx)); sum += sc[r]; }
                    const float inv = 1.0f / sum;
#pragma unroll
                    for (int q = 0; q < 4; ++q) { *(LAS v4u*)(EIDS + (grp * 4 + tk) * 128 + h * 16 + 4 * q) = (v4u){(unsigned)ee[4 * q], (unsigned)ee[4 * q + 1], (unsigned)ee[4 * q + 2], (unsigned)ee[4 * q + 3]};
                        if (!(SKIP & 4)) { *(GAS v4u*)(EIDg + (size_t)m * 128 + h * 16 + 4 * q) = (v4u){(unsigned)ee[4 * q], (unsigned)ee[4 * q + 1], (unsigned)ee[4 * q + 2], (unsigned)ee[4 * q + 3]};
                            *(GAS f32x4*)(GATEg + (size_t)m * 128 + h * 16 + 4 * q) = (f32x4){sc[4 * q] * inv, sc[4 * q + 1] * inv, sc[4 * q + 2] * inv, sc[4 * q + 3] * inv}; } }
                }
                asm volatile("" ::: "memory");
            }
        }
#pragma unroll 1
        for (int ti = 0; ti < 8; ++ti) {
            int lane = F.lane; asm volatile("" : "+v"(lane));
            const int tA = (EIDS[ti * 128 + lane] >> 9) & 31, tB = (EIDS[ti * 128 + 64 + lane] >> 9) & 31; int mycnt = 0;
#pragma unroll
            for (int k = 0; k < NET; ++k) { const int c = __popcll(__ballot(tA == k)) + __popcll(__ballot(tB == k)); mycnt = (lane == k) ? c : mycnt; }
            if (lane < NET) OFFS[ti * NET + lane] = __hip_atomic_fetch_add((int*)(BC + lane), mycnt, __ATOMIC_RELAXED, __HIP_MEMORY_SCOPE_WORKGROUP);
        }
        __syncthreads();
        const int tt = blk >> 4;
        if (F.tid < NET) BC[NET + F.tid] = (int)__hip_atomic_fetch_add((unsigned*)(F.ctl + CW_CNT) + (tt * NET + F.tid) * 16, (unsigned)BC[F.tid], __ATOMIC_RELAXED, __HIP_MEMORY_SCOPE_AGENT);
        __syncthreads();
#pragma unroll 1
        for (int ti = 0; ti < 8; ++ti) { const int m = m0 + ti;
            int lane = F.lane; asm volatile("" : "+v"(lane));
            const unsigned long long lt_mask = (1ull << lane) - 1ull;
            const int eA = EIDS[ti * 128 + lane] & 16383, eB = EIDS[ti * 128 + 64 + lane] & 16383, tA = eA >> 9, tB = eB >> 9; int rankA = 0, rankB = 0;
#pragma unroll
            for (int k = 0; k < NET; ++k) { const unsigned long long mA = __ballot(tA == k), mB = __ballot(tB == k);
                rankA = (tA == k) ? __popcll(mA & lt_mask) : rankA; rankB = (tB == k) ? __popcll(mA) + __popcll(mB & lt_mask) : rankB; }
            const unsigned tl = (unsigned)(m & 1023) << 17;
            if (!(SKIP & 4)) { const int s = BC[NET + tA] + OFFS[ti * NET + tA] + rankA; if (s < REC_CAP) REC[(size_t)(tt * NET + tA) * REC_CAP + s] = tl | ((unsigned)(eA & 511) << 7) | (unsigned)lane; }
            if (!(SKIP & 4)) { const int s = BC[NET + tB] + OFFS[ti * NET + tB] + rankB; if (s < REC_CAP) REC[(size_t)(tt * NET + tB) * REC_CAP + s] = tl | ((unsigned)(eB & 511) << 7) | (unsigned)(lane + 64); }
        }
    }
}

constexpr int NSLOT = 12, UPITCH = 80;
template <int SKIP>
__device__ __forceinline__ void p11b_udot(Frame& F) {
    LAS unsigned char* XS = (LAS unsigned char*)F.lds;
    LAS unsigned char* US = XS + 1024 * UPITCH;
    LAS int* QB = (LAS int*)(F.lds + 124 * 1024);
    const int tid = F.tid;
    const unsigned char* XQ = F.ws + WS_XQ; const unsigned char* TU = F.ws + WS_TU; const unsigned* REC = (const unsigned*)(F.ws + WS_REC);
    const float* SXR = (const float*)(F.ws + WS_SXR); const float* GATEg = (const float*)(F.ws + WS_GATE); float* AVg = (float*)(F.ws + WS_AV);
    const float* SU = (const float*)(F.ws + WS_PSC); const float* SV = SU + 16384;
    for (;;) {
        __syncthreads();
        if (tid == 0) QB[0] = (int)__hip_atomic_fetch_add((unsigned*)(F.ctl + CW_Q), 1u, __ATOMIC_RELAXED, __HIP_MEMORY_SCOPE_AGENT);
        __syncthreads();
        const int b = QB[0];
        if (b >= NBUCK) break;
        const int tt = b >> 5, et = b & 31;
        int n = (int)__hip_atomic_load((unsigned*)(F.ctl + CW_CNT) + b * 16, __ATOMIC_RELAXED, __HIP_MEMORY_SCOPE_AGENT); n = n < REC_CAP ? n : REC_CAP;
        for (int g0 = 0; g0 < n; g0 += NSLOT * NTHR) {
            const int npass = (n - g0) < NSLOT * NTHR ? (n - g0) : NSLOT * NTHR;
            unsigned rec[NSLOT]; int acc[NSLOT];
#pragma unroll
            for (int j = 0; j < NSLOT; ++j) { const int idx = g0 + j * NTHR + tid; const unsigned r = idx < n ? REC[(size_t)b * REC_CAP + idx] : 0xffffffffu; acc[j] = 0;
                rec[j] = ((r >> 17) & 1023u) | (((r >> 7) & 511u) << 16); }
            v4u st[12];
#define P11B_SRC(step, i) (((i) % 6) < 4 ? XQ + ((size_t)(2 * (step) + (i) / 6) * SEQ + tt * 1024) * 32 + (size_t)(tid + 512 * ((i) % 6)) * 16 : TU + ((size_t)(2 * (step) + (i) / 6) * 16384 + et * ETSZ) * 32 + (size_t)(tid + 512 * (((i) % 6) - 4)) * 16)
#pragma unroll
            for (int i = 0; i < 12; ++i) st[i] = *(const GAS v4u*)P11B_SRC(0, i);
#pragma unroll 1
            for (int c = 0; c < 32; ++c) {
                __syncthreads();
#pragma unroll
                for (int i = 0; i < 12; ++i) { const int q = i % 6, hc = i / 6, p = (q < 4) ? tid + 512 * q : tid + 512 * (q - 4); *(LAS v4u*)((q < 4 ? XS : US) + (p >> 1) * UPITCH + hc * 32 + (p & 1) * 16) = st[i]; }
                __syncthreads();
                if (c + 1 < 32 && !(SKIP & 1)) {
#pragma unroll
                    for (int i = 0; i < 12; ++i) st[i] = *(const GAS v4u*)P11B_SRC(c + 1, i);
                }
#pragma unroll
                for (int j0 = 0; j0 < NSLOT; j0 += 2) {
                    if (j0 * NTHR < npass && !(SKIP & 2)) {
                        v4u xb[2][4], ub[2][4];
#pragma unroll
                        for (int q = 0; q < 2; ++q) { unsigned r = rec[j0 + q]; asm volatile("" : "+v"(r));
                            const unsigned xo = (r & 0xffffu) * UPITCH, uo = (r >> 16) * UPITCH;
#pragma unroll
                            for (int hh = 0; hh < 4; ++hh) { xb[q][hh] = *(const LAS v4u*)(XS + xo + 16 * hh); ub[q][hh] = *(const LAS v4u*)(US + uo + 16 * hh); } }
                        __builtin_amdgcn_sched_barrier(0);
#pragma unroll
                        for (int q = 0; q < 2; ++q) { int s = acc[j0 + q];
#pragma unroll
                            for (int hh = 0; hh < 4; ++hh) { const v4u u = ub[q][hh], x = xb[q][hh];
                                s = __builtin_amdgcn_sdot4((int)u.x, (int)x.x, s, false); s = __builtin_amdgcn_sdot4((int)u.y, (int)x.y, s, false); s = __builtin_amdgcn_sdot4((int)u.z, (int)x.z, s, false); s = __builtin_amdgcn_sdot4((int)u.w, (int)x.w, s, false); }
                            acc[j0 + q] = s; }
                        __builtin_amdgcn_sched_barrier(0);
                    }
                }
            }
#undef P11B_SRC
#pragma unroll
            for (int j = 0; j < NSLOT; ++j) { const int idx = g0 + j * NTHR + tid; const unsigned r = idx < n ? REC[(size_t)b * REC_CAP + idx] : 0xffffffffu;
                if (r != 0xffffffffu) { const int t = tt * 1024 + (int)((r >> 17) & 1023), e = et * ETSZ + (int)((r >> 7) & 511), j7 = (int)(r & 127);
                    const float hv = (float)acc[j] * SU[e] * SXR[2 * t]; AVg[(size_t)t * 128 + j7] = gelu_erf(hv) * GATEg[(size_t)t * 128 + j7] * SV[e]; } }
        }
    }
}

__device__ __forceinline__ void p11c_vsum(Frame& F) {
    const int gw = F.vcu * NWAVES + F.wave, NGW = F.G * NWAVES;
    LAS int* EID = (LAS int*)(F.lds + F.wave * 16384); LAS float* AV = (LAS float*)(EID + 128);
    const unsigned char* TV = F.ws + WS_TV; const int* EIDg = (const int*)(F.ws + WS_EID); const float* AVg = (const float*)(F.ws + WS_AV);
    for (int m = gw; m < SEQ; m += NGW) {
        int lane = F.lane; asm volatile("" : "+v"(lane));
        const int lo16 = lane * 16;
        EID[lane] = EIDg[(size_t)m * 128 + lane]; EID[lane + 64] = EIDg[(size_t)m * 128 + 64 + lane]; AV[lane] = AVg[(size_t)m * 128 + lane]; AV[lane + 64] = AVg[(size_t)m * 128 + 64 + lane];
        asm volatile("" ::: "memory");
        f32x2 y2[16];
#pragma unroll
        for (int e = 0; e < 16; ++e) y2[e] = (f32x2){0.f, 0.f};
        float av[2][4];
#if VFMT == 64
        v4u rv[2][4]; v2u rw[2][4]; bool bg[2][4];
        float thr2; { const float a0 = AV[lane], a1 = AV[lane + 64]; thr2 = wave_sum(a0 * a0 + a1 * a1) * (VMIX_C / 128.0f); }
        const unsigned char* TV4 = F.ws + WS_TV4;
#define P11C_LOAD(buf, g) do { _Pragma("unroll") for (int q = 0; q < 4; ++q) { const int e = __builtin_amdgcn_readfirstlane(EID[(g) + q]); const float a = AV[(g) + q]; av[buf][q] = a; \
            const bool big = __builtin_amdgcn_readfirstlane((int)(a * a > thr2)) != 0; bg[buf][q] = big; \
            const unsigned char* p0 = big ? TV + (size_t)e * TV_PITCH : TV4 + (size_t)e * 1024; const unsigned char* p1 = big ? TV + (size_t)e * TV_PITCH + 1024 : TV;     \
            rv[buf][q] = *(const GAS v4u*)(p0 + lo16); rw[buf][q] = *(const GAS v2u*)(p1 + lane * 8); } } while (0)
#define P11C_ACC(buf) do { _Pragma("unroll") for (int q = 0; q < 4; ++q) { const float a = av[buf][q]; \
            if (bg[buf][q]) { const f32x2 a2 = {a, a}; const v6u pk = {rv[buf][q].x, rv[buf][q].y, rv[buf][q].z, rv[buf][q].w, rw[buf][q].x, rw[buf][q].y}; const v32f f = __builtin_amdgcn_cvt_scalef32_pk32_f32_fp6(pk, 1.0f); \
                _Pragma("unroll") for (int k = 0; k < 16; ++k) y2[k] += a2 * (f32x2){f[2 * k], f[2 * k + 1]}; } \
            else { const f32x2 a2 = {a * 1.25f, a * 1.25f}; const unsigned wv[4] = {rv[buf][q].x, rv[buf][q].y, rv[buf][q].z, rv[buf][q].w}; \
                _Pragma("unroll") for (int dd = 0; dd < 4; ++dd) { y2[4 * dd] += a2 * __builtin_amdgcn_cvt_scalef32_pk_f32_fp4(wv[dd], 1.0f, 0); y2[4 * dd + 1] += a2 * __builtin_amdgcn_cvt_scalef32_pk_f32_fp4(wv[dd], 1.0f, 1); \
                    y2[4 * dd + 2] += a2 * __builtin_amdgcn_cvt_scalef32_pk_f32_fp4(wv[dd], 1.0f, 2); y2[4 * dd + 3] += a2 * __builtin_amdgcn_cvt_scalef32_pk_f32_fp4(wv[dd], 1.0f, 3); } } \
            __builtin_amdgcn_sched_barrier(0); } } while (0)
#elif VFMT == 6
        v4u rv[2][4]; v2u rw[2][4];
#define P11C_LOAD(buf, g) do { _Pragma("unroll") for (int q = 0; q < 4; ++q) { const int e = __builtin_amdgcn_readfirstlane(EID[(g) + q]); av[buf][q] = AV[(g) + q]; const unsigned char* rp = TV + (size_t)e * TV_PITCH; \
            rv[buf][q] = *(const GAS v4u*)(rp + lo16); rw[buf][q] = *(const GAS v2u*)(rp + 1024 + lane * 8); } } while (0)
#define P11C_ACC(buf) do { _Pragma("unroll") for (int q = 0; q < 4; ++q) { const float a = av[buf][q]; const f32x2 a2 = {a, a}; \
            const v6u pk = {rv[buf][q].x, rv[buf][q].y, rv[buf][q].z, rv[buf][q].w, rw[buf][q].x, rw[buf][q].y}; const v32f f = __builtin_amdgcn_cvt_scalef32_pk32_f32_fp6(pk, 1.0f); \
            _Pragma("unroll") for (int k = 0; k < 16; ++k) y2[k] += a2 * (f32x2){f[2 * k], f[2 * k + 1]}; \
            __builtin_amdgcn_sched_barrier(0); } } while (0)
#elif VFMT == 4
        v4u rv[2][4];
#define P11C_LOAD(buf, g) do { _Pragma("unroll") for (int q = 0; q < 4; ++q) { const int e = __builtin_amdgcn_readfirstlane(EID[(g) + q]); av[buf][q] = AV[(g) + q]; rv[buf][q] = *(const GAS v4u*)(TV + (size_t)e * TV_PITCH + lo16); } } while (0)
#define P11C_ACC(buf) do { _Pragma("unroll") for (int q = 0; q < 4; ++q) { const float a = av[buf][q]; const f32x2 a2 = {a, a}; const unsigned wv[4] = {rv[buf][q].x, rv[buf][q].y, rv[buf][q].z, rv[buf][q].w}; \
            _Pragma("unroll") for (int dd = 0; dd < 4; ++dd) { y2[4 * dd] += a2 * __builtin_amdgcn_cvt_scalef32_pk_f32_fp4(wv[dd], 1.0f, 0); y2[4 * dd + 1] += a2 * __builtin_amdgcn_cvt_scalef32_pk_f32_fp4(wv[dd], 1.0f, 1); \
                y2[4 * dd + 2] += a2 * __builtin_amdgcn_cvt_scalef32_pk_f32_fp4(wv[dd], 1.0f, 2); y2[4 * dd + 3] += a2 * __builtin_amdgcn_cvt_scalef32_pk_f32_fp4(wv[dd], 1.0f, 3); } \
            __builtin_amdgcn_sched_barrier(0); } } while (0)
#else
        v4u rv[2][4][2];
#define P11C_LOAD(buf, g) do { _Pragma("unroll") for (int q = 0; q < 4; ++q) { const int e = __builtin_amdgcn_readfirstlane(EID[(g) + q]); av[buf][q] = AV[(g) + q]; const unsigned char* rp = TV + (size_t)e * DM + lo16; \
            rv[buf][q][0] = *(const GAS v4u*)(rp); rv[buf][q][1] = *(const GAS v4u*)(rp + 1024); } } while (0)
#define P11C_ACC(buf) do { _Pragma("unroll") for (int q = 0; q < 4; ++q) { const float a = av[buf][q]; const f32x2 a2 = {a, a}; \
            _Pragma("unroll") for (int j = 0; j < 2; ++j) { const v4u r = rv[buf][q][j]; const unsigned wv[4] = {r.x, r.y, r.z, r.w}; \
                _Pragma("unroll") for (int dd = 0; dd < 4; ++dd) { y2[8 * j + 2 * dd] += a2 * __builtin_amdgcn_cvt_pk_f32_fp8((int)wv[dd], false); y2[8 * j + 2 * dd + 1] += a2 * __builtin_amdgcn_cvt_pk_f32_fp8((int)wv[dd], true); } } \
            __builtin_amdgcn_sched_barrier(0); } } while (0)
#endif
        P11C_LOAD(0, 0);
#pragma unroll 1
        for (int g = 0; g < 128; g += 8) {
            P11C_LOAD(1, g + 4);
            P11C_ACC(0);
            if (g + 8 < 128) P11C_LOAD(0, g + 8);
            P11C_ACC(1);
        }
#undef P11C_LOAD
#undef P11C_ACC
        float y[32];
#pragma unroll
        for (int e = 0; e < 16; ++e) { if ((VFMT == 6 || VFMT == 64) && FP6_IL) { y[e] = y2[e].x; y[16 + e] = y2[e].y; } else { y[2 * e] = y2[e].x; y[2 * e + 1] = y2[e].y; } }
        const bf16* x1 = (const bf16*)(F.ws + WS_X1B) + (size_t)m * DM;
        float s2 = 0.f;
#pragma unroll
        for (int j = 0; j < 2; ++j)
#pragma unroll
            for (int q = 0; q < 4; ++q) { const v2u a2 = *(const GAS v2u*)(x1 + j * 1024 + lo16 + 4 * q); const f32x4 a = {bflo(a2.x), bfhi(a2.x), bflo(a2.y), bfhi(a2.y)};
                y[16 * j + 4 * q] += a.x; y[16 * j + 4 * q + 1] += a.y; y[16 * j + 4 * q + 2] += a.z; y[16 * j + 4 * q + 3] += a.w; }
#pragma unroll
        for (int e = 0; e < 32; ++e) s2 += y[e] * y[e];
        const float ro = 1.0f / sqrtf(wave_sum(s2) * (1.f / DM) + EPS);
        float* orow = F.out + (size_t)m * DM;
#pragma unroll
        for (int j = 0; j < 2; ++j)
#pragma unroll
            for (int q = 0; q < 4; ++q) { const f32x4 a = *(const GAS f32x4*)(F.in[I_FNW] + j * 1024 + lo16 + 4 * q);
                *(GAS f32x4*)(orow + j * 1024 + lo16 + 4 * q) = (f32x4){y[16 * j + 4 * q] * ro * a.x, y[16 * j + 4 * q + 1] * ro * a.y, y[16 * j + 4 * q + 2] * ro * a.z, y[16 * j + 4 * q + 3] * ro * a.w}; }
    }
}
#ifndef MK_N_LAUNCHES
#define MK_N_LAUNCHES 1
#endif
constexpr int N_PHASES = 14;
constexpr int N_LAUNCHES = MK_N_LAUNCHES;
static_assert(N_LAUNCHES == 1 || N_LAUNCHES == N_PHASES, "MK_N_LAUNCHES is 1 or N_PHASES");
#ifndef PG8_SP2
#define PG8_SP2 true
#endif
#ifndef PG8_ALIGN
#define PG8_ALIGN true
#endif
struct Args { const float* in[19]; float* out; unsigned char* ws; int ph_lo, ph_hi; };
__global__ void __launch_bounds__(NTHR, 2) fwd_kernel(Args args) {
    extern __shared__ __attribute__((aligned(16))) unsigned char lds[];
    Frame F;
    F.lds = (LAS unsigned char*)lds;
    F.MISC = (volatile LAS unsigned*)(F.lds + MISC_OFF);
    F.tid = threadIdx.x; F.lane = F.tid & 63; F.wave = __builtin_amdgcn_readfirstlane(F.tid >> 6);
    F.G = gridDim.x; { const int bx = blockIdx.x; F.vcu = (F.G % 8 == 0) ? (bx % 8) * (F.G / 8) + bx / 8 : bx; }
    F.ws = args.ws; F.out = args.out; F.ctl = (gu32*)(args.ws + WS_CTL);
#pragma unroll
    for (int i = 0; i < 19; ++i) F.in[i] = args.in[i];
    for (int u = F.tid; u < (LDS_BYTES - MISC_OFF) / 4; u += NTHR) ((LAS unsigned*)(F.lds + MISC_OFF))[u] = 0u;
    __syncthreads();
    XcdBarrier bar; bar.bar = (unsigned*)(F.ctl + CW_BAR); bar.x = 0; bar.st = nullptr;
    if (N_LAUNCHES == 1) bar = xcd_barrier_post((unsigned*)(F.ctl + CW_BAR), F.MISC + 8);
    const int lo = args.ph_lo, hi = args.ph_hi;
#ifdef ONLY_PHASE
#define IN(k) ((k) == ONLY_PHASE && lo <= (k) && (k) < hi)
#else
#define IN(k) (lo <= (k) && (k) < hi)
#endif
#define SEAM(k) do { if (IN(k) && IN((k) + 1)) xcd_barrier(bar); } while (0)
#ifndef REPEAT_MASK
#define REPEAT_MASK 0
#endif
#ifndef P11A_SKIP
#define P11A_SKIP 0
#endif
#define REPS(k) for (int rep_ = 0; rep_ < (((REPEAT_MASK) >> (k)) & 1) + 1; ++rep_)
#define RSEAM(k) do { if ((((REPEAT_MASK) >> (k)) & 1) && rep_ == 0) xcd_barrier(bar); } while (0)
    unsigned char* ws = args.ws;
    if (IN(0)) { REPS(0) { p0_prologue(F); RSEAM(0); } SEAM(0); }
    if (IN(1)) {
        pg8::Gemm g{(const bf16*)(ws + WS_XN), (const bf16*)(ws + WS_W1), SEQ, N1, DM}; pg8::StaticOrder S; S.init(SEQ, N1, F.G, (int)blockIdx.x);
        EpiG1 E{ws, F.in[I_LB], (const float*)(ws + WS_QX), (const float*)(ws + WS_QW) + QW_W1};
        if (QM_G1) g.A = (const bf16*)((const unsigned char*)F.out + DO_XN8);
        if ((REPEAT_MASK >> 1) & 1) { pg8::gemm_phase<EpiG1, pg8::StaticOrder, PG8_ALIGN, PG8_SP2, QM_G1>(F.lds, g, S, E); xcd_barrier(bar); }
        pg8::gemm_phase<EpiG1, pg8::StaticOrder, PG8_ALIGN, PG8_SP2, QM_G1>(F.lds, g, S, E);
        p1_ab(F);
        SEAM(1);
    }
#ifdef EXTRA_BARRIERS
    for (int eb = 0; eb < EXTRA_BARRIERS; ++eb) xcd_barrier(bar);
#endif
    if (IN(2)) { REPS(2) { hgrn_pass<false>(F); RSEAM(2); } SEAM(2); }
    if (IN(3)) { if ((REPEAT_MASK >> 3) & 1) { hgrn_pass<true, P11A_SKIP>(F); xcd_barrier(bar); } hgrn_pass<true>(F); SEAM(3); }
    if (IN(4)) { if ((REPEAT_MASK >> 4) & 1) { gdn_prep<P11A_SKIP>(F); xcd_barrier(bar); } gdn_prep<0>(F); SEAM(4); }
    if (IN(5)) { if ((REPEAT_MASK >> 5) & 1) { gdn_pass<false, P11A_SKIP>(F); xcd_barrier(bar); } gdn_pass<false>(F); SEAM(5); }
    if (IN(6)) { if ((REPEAT_MASK >> 6) & 1) { gdn_pass<true, P11A_SKIP>(F); xcd_barrier(bar); } gdn_pass<true>(F); SEAM(6); }
    if (IN(7)) { REPS(7) { p7_mix(F); RSEAM(7); } SEAM(7); }
    if (IN(8)) {
        pg8::StaticOrder S; S.init(SEQ, DM, F.G, (int)blockIdx.x);
        bf16* GT = (bf16*)(ws + WS_GT); unsigned char* GA8 = ws + WS_GT2; unsigned char* GB8 = ws + WS_GT2 + 32 * MiB;
        const bf16* XNg = QM_GATE ? (const bf16*)((const unsigned char*)F.out + DO_XN8) : (const bf16*)(ws + WS_XN);
        const bf16* WG2 = QM_GATE ? (const bf16*)(ws + WS_WG + (size_t)DM * DM) : (const bf16*)(ws + WS_WG) + (size_t)DM * DM;
        const float* QX = (const float*)(ws + WS_QX); const float* QW = (const float*)(ws + WS_QW);
#define P8_BODY \
        { pg8::Gemm g{XNg, (const bf16*)(ws + WS_WG), SEQ, DM, DM}; EpiGate E{GA8, QX, QW + QW_WG}; pg8::gemm_phase<EpiGate, pg8::StaticOrder, PG8_ALIGN, PG8_SP2, QM_GATE>(F.lds, g, S, E); } \
        __builtin_amdgcn_fence(__ATOMIC_ACQUIRE, "agent"); VM_WAIT(); __syncthreads(); \
        { pg8::Gemm g{(const bf16*)(ws + WS_YA), (const bf16*)(ws + WS_WPA), SEQ, DM, HW}; EpiMix<0> E{GT, GA8, nullptr, QX + SEQ, QW + QW_WPA}; pg8::gemm_phase<EpiMix<0>, pg8::StaticOrder, PG8_ALIGN, PG8_SP2, QM_MIX>(F.lds, g, S, E); } \
        { pg8::Gemm g{XNg, WG2, SEQ, DM, DM}; EpiGate E{GB8, QX, QW + QW_WG + DM}; pg8::gemm_phase<EpiGate, pg8::StaticOrder, PG8_ALIGN, PG8_SP2, QM_GATE>(F.lds, g, S, E); } \
        __builtin_amdgcn_fence(__ATOMIC_ACQUIRE, "agent"); VM_WAIT(); __syncthreads(); \
        { pg8::Gemm g{(const bf16*)(ws + WS_YB), (const bf16*)(ws + WS_WPB), SEQ, DM, HW}; EpiMix<1> E{GT, GB8, ws + WS_GT8, QX + 2 * SEQ, QW + QW_WPB}; pg8::gemm_phase<EpiMix<1>, pg8::StaticOrder, PG8_ALIGN, PG8_SP2, QM_MIX>(F.lds, g, S, E); }
        if ((REPEAT_MASK >> 8) & 1) { P8_BODY xcd_barrier(bar); }
        P8_BODY
#undef P8_BODY
        SEAM(8);
    }
    if (IN(9)) {
        pg8::Gemm g{(const bf16*)(ws + (QM_OUT ? WS_GT8 : WS_GT)), (const bf16*)(ws + WS_WOUT), SEQ, DM, DM}; pg8::StaticOrder S; S.init(SEQ, DM, F.G, (int)blockIdx.x);
        EpiX1 E{F.in[I_X], F.out, (bf16*)(ws + WS_X1B)};
        if ((REPEAT_MASK >> 9) & 1) { pg8::gemm_phase<EpiX1, pg8::StaticOrder, PG8_ALIGN, PG8_SP2, QM_OUT>(F.lds, g, S, E); xcd_barrier(bar); }
        pg8::gemm_phase<EpiX1, pg8::StaticOrder, PG8_ALIGN, PG8_SP2, QM_OUT>(F.lds, g, S, E);
        SEAM(9);
    }
    if (IN(10)) {
        pg8::Gemm g{(const bf16*)(ws + WS_X1B), (const bf16*)(ws + WS_WS), SEQ, DM, DM}; pg8::StaticOrder S; S.init(SEQ, DM, F.G, (int)blockIdx.x);
        EpiBf E{(bf16*)(ws + WS_SC)};
        if ((REPEAT_MASK >> 10) & 1) { pg8::gemm_phase<EpiBf, pg8::StaticOrder, PG8_ALIGN, PG8_SP2>(F.lds, g, S, E); xcd_barrier(bar); }
        pg8::gemm_phase<EpiBf, pg8::StaticOrder, PG8_ALIGN, PG8_SP2>(F.lds, g, S, E);
        SEAM(10);
    }
    if (IN(11)) {
        if ((REPEAT_MASK >> 11) & 1) { p11a_topk<P11A_SKIP>(F); xcd_barrier(bar); if (blockIdx.x == 0) for (int i = F.tid; i < NBUCK + 1; i += NTHR) __hip_atomic_store((unsigned*)(F.ctl + CW_CNT) + i * 16, 0u, __ATOMIC_RELAXED, __HIP_MEMORY_SCOPE_AGENT); xcd_barrier(bar); }
        p11a_topk<0>(F); SEAM(11); }
    if (IN(12)) { if ((REPEAT_MASK >> 12) & 1) { p11b_udot<P11A_SKIP>(F); xcd_barrier(bar); if (blockIdx.x == 0 && F.tid == 0) __hip_atomic_store((unsigned*)(F.ctl + CW_Q), 0u, __ATOMIC_RELAXED, __HIP_MEMORY_SCOPE_AGENT); xcd_barrier(bar); } p11b_udot<0>(F); SEAM(12); }
    if (IN(13)) { p11c_vsum(F); }
#undef IN
#undef SEAM
}


#ifdef PROBE
__global__ void digest_kernel(const unsigned* ws, float* out) {
    const size_t n = (size_t)SEQ * DM;
    for (size_t i = (size_t)blockIdx.x * blockDim.x + threadIdx.x; i < n; i += (size_t)gridDim.x * blockDim.x) {
        unsigned acc = (PROBE >= 9) ? __builtin_bit_cast(unsigned, out[i]) : 0u;
        const size_t offs[5] = {0, 128 * MiB / 4, 256 * MiB / 4, 384 * MiB / 4, 408 * MiB / 4};
#pragma unroll
        for (int r = 0; r < 5; ++r) acc = acc * 1664525u + ws[offs[r] + i];
        out[i] = (float)(acc >> 8) * (1.0f / 16777216.0f);
    }
}
#endif
extern "C" void kernel_launch(void* const* d_in, const int* in_sizes, int n_in, void* d_out, int out_size, void* d_ws, size_t ws_size, hipStream_t stream) {
    static int grid = 0;
    if (grid == 0) {
        if (n_in != 19 || in_sizes[0] != SEQ * DM || out_size != SEQ * DM || ws_size < WS_END) { fprintf(stderr, "kernel_launch: unexpected shapes (n_in %d, in0 %d, out %d, ws %zu; need ws >= %zu)\n", n_in, n_in > 0 ? in_sizes[0] : -1, out_size, ws_size, (size_t)WS_END); grid = -1; return; }
        int dev = 0, cus = 0, per_cu = 0;
        if (hipGetDevice(&dev) != hipSuccess || hipDeviceGetAttribute(&cus, hipDeviceAttributeMultiprocessorCount, dev) != hipSuccess) { grid = -1; return; }
        if (hipFuncSetAttribute((const void*)fwd_kernel, hipFuncAttributeMaxDynamicSharedMemorySize, LDS_BYTES) != hipSuccess) { fprintf(stderr, "kernel_launch: hipFuncSetAttribute failed\n"); grid = -1; return; }
        if (hipOccupancyMaxActiveBlocksPerMultiprocessor(&per_cu, (const void*)fwd_kernel, NTHR, LDS_BYTES) != hipSuccess || per_cu < 1) fprintf(stderr, "kernel_launch: occupancy query reports %d\n", per_cu);
        (void)hipGetLastError();
        grid = cus;
    }
    if (grid < 0) return;
    (void)hipMemsetAsync((char*)d_ws + WS_CTL, 0, CTL_ZERO_BYTES, stream);
    Args a{};
    for (int i = 0; i < 19; ++i) a.in[i] = (const float*)d_in[i];
    a.out = (float*)d_out; a.ws = (unsigned char*)d_ws;
    for (int li = 0; li < N_LAUNCHES; ++li) {
        a.ph_lo = (N_LAUNCHES == 1) ? 0 : li; a.ph_hi = (N_LAUNCHES == 1) ? N_PHASES : li + 1;
#ifdef PROBE
        if (li > PROBE) break;
#endif
        hipLaunchKernelGGL(fwd_kernel, dim3(grid), dim3(NTHR), LDS_BYTES, stream, a);
    }
#ifdef PROBE
    hipLaunchKernelGGL(digest_kernel, dim3(2048), dim3(256), 0, stream, (const unsigned*)d_ws, (float*)d_out);
#endif
}
```

```cpp
#include <hip/hip_runtime.h>
#include <cstdio>
#include <cstdint>
#define GAS __attribute__((address_space(1)))
#define LAS __attribute__((address_space(3)))
#define MK_N_LAUNCHES 1
namespace pg8 {
#define PG8_LAS __attribute__((address_space(3)))
typedef unsigned short bf16_t;
typedef short bf16x8 __attribute__((ext_vector_type(8)));
typedef float f32x4 __attribute__((ext_vector_type(4)));
typedef unsigned u32x4 __attribute__((ext_vector_type(4)));
constexpr int BM = 256, BK = 64, HALF = 128, HTB = HALF * BK * 2  , STAGE_BYTES = 8 * HTB, NXCD = 8, WGM = 8;

__host__ __device__ __forceinline__ int lds_byte(int r, int c) { const int st = (r >> 4) * 2 + (c >> 5), rr = r & 15, cc = c & 31, ob = rr * 64 + cc * 2; return st * 1024 + (ob ^ (((ob >> 9) & 1) << 5)); }
__host__ __device__ __forceinline__ void stage_rc(int b, int& R, int& C) { const int st = b / 1024, sb = b % 1024, swz = sb ^ (((sb >> 9) & 1) << 5); R = (st >> 1) * 16 + swz / 64; C = (st & 1) * 32 + (swz % 64) / 2; }
__host__ __device__ __forceinline__ int perm32(int rho) { const int n = rho >> 4, i = rho & 15; return 8 * (i >> 2) + 4 * n + (i & 3); }

struct Unit { int pm, pn; };
struct Gemm { const bf16_t* A; const bf16_t* Bt; int M, N, K; };

struct StaticOrder {
    int nM, nN, nwg, G, c;
    __host__ __device__ void init(int M, int N, int G_, int c_) { nM = M / BM; nN = N / BM; nwg = nM * nN; G = G_; c = c_; }
    __host__ __device__ bool next(int i, Unit& u) const {
        const long L = (long)i * G + c; if (L >= nwg) return false;
        int wgid = (int)L; { const int q = nwg / NXCD, r = nwg % NXCD, xcd = wgid % NXCD, off = wgid / NXCD; wgid = (xcd < r ? xcd * (q + 1) : r * (q + 1) + (xcd - r) * q) + off; }
        const int nig = WGM * nN, gid = wgid / nig, fm = gid * WGM, gsz = (nM - fm) < WGM ? (nM - fm) : WGM;
        u.pm = fm + ((wgid % nig) % gsz); u.pn = (wgid % nig) / gsz; return true;
    }
    __device__ __forceinline__ void a_ready(const Unit&) const {}
    __device__ __forceinline__ void done(const Unit&) const {}
};

__device__ __forceinline__ unsigned cvt_pk_bf16(float lo, float hi) { unsigned r; asm volatile("v_cvt_pk_bf16_f32 %0, %1, %2" : "=v"(r) : "v"(lo), "v"(hi)); return r; }
typedef float f32x2 __attribute__((ext_vector_type(2)));
__device__ __forceinline__ f32x2 gelu_pk(f32x2 v) {
    const f32x2 av = __builtin_elementwise_abs(v), d = av * 0.2316418882f + 1.0f;
    f32x2 t; t.x = __builtin_amdgcn_rcpf(d.x); t.y = __builtin_amdgcn_rcpf(d.y);
    f32x2 q = t * 0.5307027145f + (-0.7265760135f); q = q * t + 0.7107068705f; q = q * t + (-0.142248368f); q = q * t + 0.127414796f; q = q * t;
    const f32x2 s = (v * v) * (-0.72134752044f);
    f32x2 e; e.x = __builtin_amdgcn_exp2f(s.x); e.y = __builtin_amdgcn_exp2f(s.y);
    const f32x2 m = v * (q * e), r = v - m;
    f32x2 o; o.x = v.x < 0.f ? m.x : r.x; o.y = v.y < 0.f ? m.y : r.y; return o;
}

typedef int i32x4v __attribute__((ext_vector_type(4)));
typedef int i32x8v __attribute__((ext_vector_type(8)));
__device__ __forceinline__ i32x8v cat8(bf16x8 lo, bf16x8 hi) { return __builtin_shufflevector(__builtin_bit_cast(i32x4v, lo), __builtin_bit_cast(i32x4v, hi), 0, 1, 2, 3, 4, 5, 6, 7); }
template <class Epi, class Sched, bool ALIGN_EPI = false, bool SP2 = false, int QM = 0>
__device__ __forceinline__ void gemm_phase(PG8_LAS unsigned char* lds, const Gemm g, const Sched& S, const Epi& E) {
    const int tid = threadIdx.x, wid = __builtin_amdgcn_readfirstlane(tid >> 6), lane = tid & 63, wr = wid >> 2, wc = wid & 3, fr = lane & 15, fq = lane >> 4;
    constexpr bool F8 = QM == 1, I8 = QM == 2;
    const int K = g.K, KB = QM ? K : 2 * K  , nt = KB / (BK * 2);
    unsigned voffA[2], voffB[2];
#pragma unroll
    for (int i = 0; i < 2; ++i) { int R, C; stage_rc(tid * 16 + i * 8192, R, C); const int Rb = Epi::PERM ? ((R & ~31) + perm32(R & 31)) : R;
        voffA[i] = (unsigned)(R * KB + C * 2); voffB[i] = (unsigned)(Rb * KB + C * 2); }
    const size_t kstep = (size_t)(BK * 2);
    const size_t hstep = (size_t)HALF * KB;
    const size_t tstep = 2 * hstep;
    const unsigned ldsw = (unsigned)wid * 1024u;
    const int aoff = lds_byte(wr * 64 + fr, fq * 8), boff = lds_byte(wc * 32 + fr, fq * 8);
#define PG8_SA(b, h) (((b) * 2 + (h)) * HTB)
#define PG8_SB(b, h) ((4 + (b) * 2 + (h)) * HTB)
#define PG8_STAGE(bufoff, gbase, voff) do { _Pragma("unroll") for (int _i = 0; _i < 2; ++_i) \
        __builtin_amdgcn_global_load_lds((const unsigned*)((const char*)(gbase) + (voff)[_i]), (PG8_LAS unsigned*)(lds + (bufoff) + ldsw + _i * 8192), 16, 0, 0); } while (0)
#define PG8_LD16(off) (*(const PG8_LAS bf16x8*)(lds + (off)))
#define PG8_LDA(dst, b, h) do { _Pragma("unroll") for (int m = 0; m < 4; ++m) { if constexpr (F8) dst##8[m] = cat8(PG8_LD16(PG8_SA(b, h) + aoff + m * 2048), PG8_LD16(PG8_SA(b, h) + aoff + m * 2048 + 1024)); \
        else { _Pragma("unroll") for (int k = 0; k < 2; ++k) dst[m][k] = PG8_LD16(PG8_SA(b, h) + aoff + m * 2048 + k * 1024); } } } while (0)
#define PG8_LDB(dst, b, h) do { _Pragma("unroll") for (int n = 0; n < 2; ++n) { if constexpr (F8) dst##8[n] = cat8(PG8_LD16(PG8_SB(b, h) + boff + n * 2048), PG8_LD16(PG8_SB(b, h) + boff + n * 2048 + 1024)); \
        else { _Pragma("unroll") for (int k = 0; k < 2; ++k) dst[n][k] = PG8_LD16(PG8_SB(b, h) + boff + n * 2048 + k * 1024); } } } while (0)
#define PG8_MMA(ai, bj, At, Bt) do { __builtin_amdgcn_s_setprio(1); _Pragma("unroll") for (int m = 0; m < 4; ++m) _Pragma("unroll") for (int n = 0; n < 2; ++n) { \
        if constexpr (F8) asm volatile("v_mfma_f32_16x16x128_f8f6f4 %0, %1, %2, %0" : "+v"(acc[ai][bj][m][n]) : "v"(Bt##8[n]), "v"(At##8[m])); \
        else if constexpr (I8) { _Pragma("unroll") for (int k = 0; k < 2; ++k) acc[ai][bj][m][n] = __builtin_bit_cast(f32x4, __builtin_amdgcn_mfma_i32_16x16x64_i8(__builtin_bit_cast(i32x4v, Bt[n][k]), __builtin_bit_cast(i32x4v, At[m][k]), __builtin_bit_cast(i32x4v, acc[ai][bj][m][n]), 0, 0, 0)); } \
        else { _Pragma("unroll") for (int k = 0; k < 2; ++k) acc[ai][bj][m][n] = __builtin_amdgcn_mfma_f32_16x16x32_bf16(Bt[n][k], At[m][k], acc[ai][bj][m][n], 0, 0, 0); } } \
        __builtin_amdgcn_s_setprio(0); } while (0)
#define PG8_WAIT_V(n) asm volatile("s_waitcnt vmcnt(" #n ")" ::: "memory")
#define PG8_WAIT_L(n) asm volatile("s_waitcnt lgkmcnt(" #n ")" ::: "memory")
#define PG8_BAR __builtin_amdgcn_s_barrier()
#define PG8_SCHED __builtin_amdgcn_sched_barrier(0)
    Unit cur, nxt; int ui = 0;
    if (!S.next(0, cur)) return;
    f32x4 acc[2][2][4][2];
#pragma unroll
    for (int a = 0; a < 2; ++a)
#pragma unroll
        for (int b = 0; b < 2; ++b)
#pragma unroll
            for (int m = 0; m < 4; ++m)
#pragma unroll
                for (int n = 0; n < 2; ++n) acc[a][b][m][n] = (f32x4){0.f, 0.f, 0.f, 0.f};
    bf16x8 At[4][2], B0[2][2], B1[2][2]; i32x8v At8[4], B08[2], B18[2];
    const char* cA = (const char*)g.A + (size_t)cur.pm * tstep; const char* cB = (const char*)g.Bt + (size_t)cur.pn * tstep;
    S.a_ready(cur);
    if constexpr (SP2) {
        PG8_STAGE(PG8_SB(0, 0), cB, voffB); PG8_STAGE(PG8_SB(0, 1), cB + hstep, voffB); PG8_STAGE(PG8_SA(0, 0), cA, voffA); PG8_STAGE(PG8_SA(0, 1), cA + hstep, voffA);
        if (wr == 1) PG8_BAR;
        PG8_WAIT_V(2); PG8_BAR;
        PG8_STAGE(PG8_SB(1, 0), cB + kstep, voffB); PG8_STAGE(PG8_SA(1, 0), cA + kstep, voffA); PG8_STAGE(PG8_SB(1, 1), cB + hstep + kstep, voffB);
        PG8_WAIT_V(6); PG8_BAR;
    } else {
        PG8_STAGE(PG8_SB(0, 0), cB, voffB); PG8_STAGE(PG8_SA(0, 0), cA, voffA); PG8_STAGE(PG8_SB(0, 1), cB + hstep, voffB); PG8_STAGE(PG8_SA(0, 1), cA + hstep, voffA);
        if (wr == 1) PG8_BAR;
        PG8_WAIT_V(4); PG8_BAR;
        PG8_STAGE(PG8_SB(1, 0), cB + kstep, voffB); PG8_STAGE(PG8_SA(1, 0), cA + kstep, voffA); PG8_STAGE(PG8_SB(1, 1), cB + hstep + kstep, voffB);
        PG8_WAIT_V(6); PG8_BAR;
    }
    for (;;) {
        const bool has_next = S.next(ui + 1, nxt);
        const char* nA = has_next ? (const char*)g.A + (size_t)nxt.pm * tstep : cA; const char* nB = has_next ? (const char*)g.Bt + (size_t)nxt.pn * tstep : cB;
        for (int t = 0; t < nt; t += 2) {
            const bool last = (t == nt - 2);
            const char* a1 = cA + (size_t)(t + 1) * kstep;
            const char* a2 = last ? nA : cA + (size_t)(t + 2) * kstep; const char* b2 = last ? nB : cB + (size_t)(t + 2) * kstep;
            const char* a3 = a2 + kstep; const char* b3 = b2 + kstep;
            if (last && has_next) S.a_ready(nxt);
            if constexpr (SP2) {
            PG8_LDB(B0, 0, 0); PG8_LDB(B1, 0, 1); PG8_SCHED; PG8_LDA(At, 0, 0); PG8_STAGE(PG8_SA(1, 1), a1 + hstep, voffA);
            PG8_WAIT_V(8); PG8_WAIT_L(0); PG8_BAR; PG8_MMA(0, 0, At, B0); PG8_MMA(0, 1, At, B1); PG8_BAR; PG8_SCHED;
            PG8_LDA(At, 0, 1); PG8_STAGE(PG8_SB(0, 0), b2, voffB); PG8_STAGE(PG8_SB(0, 1), b2 + hstep, voffB); PG8_STAGE(PG8_SA(0, 0), a2, voffA);
            PG8_WAIT_V(8); PG8_WAIT_L(0); PG8_BAR; PG8_MMA(1, 0, At, B0); PG8_MMA(1, 1, At, B1); PG8_BAR; PG8_SCHED;
            PG8_LDB(B0, 1, 0); PG8_LDB(B1, 1, 1); PG8_SCHED; PG8_LDA(At, 1, 0); PG8_STAGE(PG8_SA(0, 1), a2 + hstep, voffA);
            PG8_WAIT_V(8); PG8_WAIT_L(0); PG8_BAR; PG8_MMA(0, 0, At, B0); PG8_MMA(0, 1, At, B1); PG8_BAR; PG8_SCHED;
            PG8_LDA(At, 1, 1); PG8_STAGE(PG8_SB(1, 0), b3, voffB); PG8_STAGE(PG8_SB(1, 1), b3 + hstep, voffB); PG8_STAGE(PG8_SA(1, 0), a3, voffA);
            PG8_WAIT_V(8); PG8_WAIT_L(0); PG8_BAR; PG8_MMA(1, 0, At, B0); PG8_MMA(1, 1, At, B1); PG8_BAR; PG8_SCHED;
            } else {
            PG8_LDB(B0, 0, 0); PG8_SCHED; PG8_LDA(At, 0, 0); PG8_STAGE(PG8_SA(1, 1), a1 + hstep, voffA);
            PG8_WAIT_L(8); PG8_BAR; PG8_WAIT_L(0); PG8_MMA(0, 0, At, B0); PG8_BAR; PG8_SCHED;
            PG8_LDB(B1, 0, 1); PG8_STAGE(PG8_SB(0, 0), b2, voffB);
            PG8_BAR; PG8_WAIT_L(0); PG8_MMA(0, 1, At, B1); PG8_BAR;
            PG8_LDA(At, 0, 1); PG8_STAGE(PG8_SA(0, 0), a2, voffA);
            PG8_BAR; PG8_WAIT_L(0); PG8_MMA(1, 0, At, B0); PG8_BAR; PG8_SCHED;
            PG8_STAGE(PG8_SB(0, 1), b2 + hstep, voffB);
            PG8_WAIT_V(6); PG8_BAR; PG8_MMA(1, 1, At, B1); PG8_BAR;
            PG8_LDB(B0, 1, 0); PG8_SCHED; PG8_LDA(At, 1, 0); PG8_STAGE(PG8_SA(0, 1), a2 + hstep, voffA);
            PG8_WAIT_L(8); PG8_BAR; PG8_WAIT_L(0); PG8_MMA(0, 0, At, B0); PG8_BAR; PG8_SCHED;
            PG8_LDB(B1, 1, 1); PG8_STAGE(PG8_SB(1, 0), b3, voffB);
            PG8_BAR; PG8_WAIT_L(0); PG8_MMA(0, 1, At, B1); PG8_BAR;
            PG8_LDA(At, 1, 1); PG8_STAGE(PG8_SA(1, 0), a3, voffA);
            PG8_BAR; PG8_WAIT_L(0); PG8_MMA(1, 0, At, B0); PG8_BAR; PG8_SCHED;
            PG8_STAGE(PG8_SB(1, 1), b3 + hstep, voffB);
            PG8_WAIT_V(6); PG8_BAR; PG8_MMA(1, 1, At, B1); PG8_BAR;
            }
        }
        if constexpr (ALIGN_EPI) { if (wr == 0) PG8_BAR; }
        if constexpr (F8) asm volatile("s_nop 15\n\ts_nop 15" ::: "memory");
        if constexpr (!Epi::AFTER_DRAIN) { E(acc, cur, wr, wc, fr, fq); S.done(cur); }
        if (!has_next) break;
#pragma unroll
        for (int a = 0; a < 2; ++a)
#pragma unroll
            for (int b = 0; b < 2; ++b)
#pragma unroll
                for (int m = 0; m < 4; ++m)
#pragma unroll
                    for (int n = 0; n < 2; ++n) acc[a][b][m][n] = (f32x4){0.f, 0.f, 0.f, 0.f};
        cur = nxt; cA = nA; cB = nB; ++ui;
        if constexpr (ALIGN_EPI) { if (wr == 1) PG8_BAR; }
    }
    PG8_WAIT_V(0);
    if constexpr (!ALIGN_EPI) { if (wr == 0) PG8_BAR; }
    PG8_BAR;
    if constexpr (Epi::AFTER_DRAIN) { E.fused(acc, cur, wr, wc, fr, fq, lds, wid, lane); S.done(cur); }
#undef PG8_SA
#undef PG8_SB
#undef PG8_STAGE
#undef PG8_LD16
#undef PG8_LDA
#undef PG8_LDB
#undef PG8_MMA
#undef PG8_WAIT_V
#undef PG8_WAIT_L
#undef PG8_BAR
#undef PG8_SCHED
}
}
typedef unsigned short bf16;
typedef unsigned v4u __attribute__((ext_vector_type(4)));
typedef unsigned v2u __attribute__((ext_vector_type(2)));
typedef float f32x4 __attribute__((ext_vector_type(4)));
typedef float f32x2 __attribute__((ext_vector_type(2)));
typedef short bf16x8 __attribute__((ext_vector_type(8)));
typedef GAS unsigned gu32;
#define RLX_AGENT __ATOMIC_RELAXED, __HIP_MEMORY_SCOPE_AGENT
#define LDS_WAIT() asm volatile("s_waitcnt lgkmcnt(0)" ::: "memory")
#define VM_WAIT() asm volatile("s_waitcnt vmcnt(0)" ::: "memory")
typedef __bf16 bf16x2_hw __attribute__((ext_vector_type(2)));
__device__ __forceinline__ unsigned pk2(float lo, float hi) { const f32x2 v = {lo, hi}; const bf16x2_hw b = __builtin_convertvector(v, bf16x2_hw); return __builtin_bit_cast(unsigned, b); }
__device__ __forceinline__ unsigned pk4f8(float a, float b, float c, float d) { int w = 0; w = __builtin_amdgcn_cvt_pk_fp8_f32(a, b, w, false); w = __builtin_amdgcn_cvt_pk_fp8_f32(c, d, w, true); return (unsigned)w; }
__device__ __forceinline__ float cvt_ub0(unsigned w) { float f; asm("v_cvt_f32_ubyte0 %0, %1" : "=v"(f) : "v"(w)); return f; }
__device__ __forceinline__ float cvt_ub1(unsigned w) { float f; asm("v_cvt_f32_ubyte1 %0, %1" : "=v"(f) : "v"(w)); return f; }
__device__ __forceinline__ float cvt_ub2(unsigned w) { float f; asm("v_cvt_f32_ubyte2 %0, %1" : "=v"(f) : "v"(w)); return f; }
__device__ __forceinline__ float cvt_ub3(unsigned w) { float f; asm("v_cvt_f32_ubyte3 %0, %1" : "=v"(f) : "v"(w)); return f; }
__device__ __forceinline__ unsigned f2bf(float f) { return pk2(f, 0.f) & 0xffffu; }
__device__ __forceinline__ float bflo(unsigned w) { return __builtin_bit_cast(float, w << 16); }
__device__ __forceinline__ float bfhi(unsigned w) { return __builtin_bit_cast(float, w & 0xffff0000u); }
__device__ __forceinline__ float bf1(bf16 b) { return __builtin_bit_cast(float, ((unsigned)b) << 16); }
__device__ __forceinline__ float fast_exp(float x) { return __builtin_amdgcn_exp2f(x * 1.4426950408889634f); }
__device__ __forceinline__ float fast_rcp(float x) { return __builtin_amdgcn_rcpf(x); }
__device__ __forceinline__ float sigmoidf_(float x) { return fast_rcp(1.0f + fast_exp(-x)); }
__device__ __forceinline__ float siluf_(float x) { return x * sigmoidf_(x); }
template <int CTRL> __device__ __forceinline__ float dppf(float v) { return __builtin_bit_cast(float, __builtin_amdgcn_mov_dpp(__builtin_bit_cast(int, v), CTRL, 0xF, 0xF, true)); }
template <int CTRL> __device__ __forceinline__ int dppi(int v) { return __builtin_amdgcn_mov_dpp(v, CTRL, 0xF, 0xF, true); }
__device__ __forceinline__ float rdl(float v, int l) { return __builtin_bit_cast(float, __builtin_amdgcn_readlane(__builtin_bit_cast(int, v), l)); }
__device__ __forceinline__ float wave_sum(float v) {
    v += dppf<0xB1>(v); v += dppf<0x4E>(v); v += dppf<0x141>(v); v += dppf<0x140>(v);
    return (rdl(v, 0) + rdl(v, 16)) + (rdl(v, 32) + rdl(v, 48));
}
__device__ __forceinline__ float wave_max(float v) {
    v = fmaxf(v, dppf<0xB1>(v)); v = fmaxf(v, dppf<0x4E>(v)); v = fmaxf(v, dppf<0x141>(v)); v = fmaxf(v, dppf<0x140>(v));
    return fmaxf(fmaxf(rdl(v, 0), rdl(v, 16)), fmaxf(rdl(v, 32), rdl(v, 48)));
}
__device__ __forceinline__ int wave_sum_i(int v) {
    v += dppi<0xB1>(v); v += dppi<0x4E>(v); v += dppi<0x141>(v); v += dppi<0x140>(v);
    return (__builtin_amdgcn_readlane(v, 0) + __builtin_amdgcn_readlane(v, 16)) + (__builtin_amdgcn_readlane(v, 32) + __builtin_amdgcn_readlane(v, 48));
}

constexpr int NWAVES = 8, NTHR = 512;
constexpr int SEQ = 16384, DM = 2048, NH = 8, HD = 128, HW = 1024;
constexpr int CK = 64, NCHUNK = SEQ / CK, NSEG = 16, CPS = NCHUNK / NSEG;
constexpr int INW = 13344;
constexpr int N1 = 9216;
constexpr float EPS = 1e-6f;
constexpr int PEER_K = 16;

constexpr size_t MiB = (size_t)1 << 20;
constexpr size_t WS_CTL = 0, CTL_ZERO_BYTES = 1 * MiB;
constexpr size_t WS_WG = 2 * MiB, WS_WPA = 18 * MiB, WS_WPB = 22 * MiB, WS_WOUT = 26 * MiB, WS_WS = 34 * MiB, WS_W1 = 42 * MiB;
constexpr size_t WS_XN = 80 * MiB;
constexpr size_t WS_H = 144 * MiB;
constexpr size_t WS_GAB = 432 * MiB;
constexpr size_t WS_HL = 434 * MiB;
constexpr size_t WS_HDS = 450 * MiB;
constexpr size_t WS_OHF = 452 * MiB, WS_OHB = 484 * MiB;
constexpr size_t WS_GSC = 516 * MiB;
constexpr size_t WS_UTF = 144 * MiB, WS_UTB = 176 * MiB, WS_WF = 208 * MiB, WS_WB = 240 * MiB;
constexpr size_t DO_AQKF = 0, DO_AQKB = 16 * MiB, DO_QN = 32 * MiB, DO_KNT = 64 * MiB;
constexpr size_t WS_GL = 42 * MiB, WS_GP = 58 * MiB;
constexpr size_t WS_OGF = 304 * MiB, WS_OGB = 336 * MiB;
constexpr size_t WS_YA = 42 * MiB, WS_YB = 368 * MiB;
constexpr size_t WS_TU = 144 * MiB, WS_TV = 176 * MiB;
constexpr size_t WS_PSC = 520 * MiB;
constexpr size_t WS_GT = 272 * MiB, WS_GT2 = 400 * MiB;
constexpr size_t WS_X1B = 400 * MiB;
constexpr size_t WS_SC = 272 * MiB;
constexpr size_t WS_END = 536 * MiB;
#ifndef QM_G1_
#define QM_G1_ 2
#endif
#ifndef QM_GATE_
#define QM_GATE_ 2
#endif
#ifndef QM_MIX_
#define QM_MIX_ 2
#endif
#ifndef QM_OUT_
#define QM_OUT_ 0
#endif
constexpr int QM_G1 = QM_G1_, QM_GATE = QM_GATE_, QM_MIX = QM_MIX_, QM_OUT = QM_OUT_;
constexpr int QM_XN = QM_G1 ? QM_G1 : QM_GATE;
static_assert(QM_G1 == 0 || QM_GATE == 0 || QM_G1 == QM_GATE, "xn has one 8-bit copy");
static_assert(QM_OUT != 2, "merged has no row scale");
constexpr float F8_WSCALE = 128.0f;
constexpr size_t WS_WAB = 78 * MiB;
constexpr size_t DO_XN8 = 96 * MiB;
constexpr size_t WS_GT8 = 336 * MiB;
constexpr size_t WS_QW = 521 * MiB;
constexpr int QW_W1 = 0, QW_WG = 9216, QW_WPA = 13312, QW_WPB = 15360, QW_WOUT = 17408, QW_WAB = 19456;
constexpr bool AB_I8 = QM_XN == 2;
constexpr bool XN_BF16 = QM_G1 == 0 || QM_GATE == 0 || !AB_I8;
constexpr size_t WS_QX = 522 * MiB;
#ifndef VFMT
#define VFMT 4
#endif
#ifndef FP6_IL
#define FP6_IL 1
#endif
constexpr int TV_PITCH = (VFMT == 6 || VFMT == 64) ? 1536 : VFMT == 4 ? 1024 : 2048;
#ifndef VMIX_C
#define VMIX_C 1.0f
#endif
constexpr size_t WS_TV4 = 240 * MiB;
#ifndef P11B_DIRECT
#define P11B_DIRECT 1
#endif
#ifndef UFMT
#define UFMT 4
#endif
#ifndef U4_SWAP
#define U4_SWAP 0
#endif
constexpr int TU_PITCH = UFMT == 4 ? 1024 : 1536;
typedef float v16f __attribute__((ext_vector_type(16)));
typedef float v32f __attribute__((ext_vector_type(32)));
typedef unsigned v6u __attribute__((ext_vector_type(6)));
constexpr int CW_BAR = 4096;

constexpr int LDS_BYTES = 163840;
constexpr int MISC_OFF = 163840 - 256;
constexpr int LDS_USABLE = MISC_OFF;

__device__ __forceinline__ bf16x8 ldfrag(const LAS bf16* T, int pitch, int row, int k) { return *(const LAS bf16x8*)(T + row * pitch + k); }
__device__ __forceinline__ f32x4 mfma16(bf16x8 x, bf16x8 y, f32x4 c) { return __builtin_amdgcn_mfma_f32_16x16x32_bf16(x, y, c, 0, 0, 0); }
__device__ __forceinline__ v2u pack4(f32x4 v) { v2u r; r.x = pk2(v[0], v[1]); r.y = pk2(v[2], v[3]); return r; }
#define XB_TMO      128
#define XB_XCNT(j)  (256  + 64 * (j))
#define XB_XSUB(j)  (1280 + 64 * (j))
#define XB_XGEN(j)  (2304 + 64 * (j))
#define XB_TOP      3328
#define XB_TOPGEN   3392
#define XCD_BAR_WORDS 3456
#define XB_SPIN_CAP (1u << 18)

__device__ __forceinline__ unsigned xb_ld(unsigned* p)              { return __hip_atomic_load(p, __ATOMIC_RELAXED, __HIP_MEMORY_SCOPE_AGENT); }
__device__ __forceinline__ unsigned xb_add(unsigned* p, unsigned v) { return __hip_atomic_fetch_add(p, v, __ATOMIC_RELAXED, __HIP_MEMORY_SCOPE_AGENT); }
__device__ __forceinline__ unsigned xb_xcc_id() { return (unsigned)__builtin_amdgcn_s_getreg((3 << 11) | 20) & 0xFu; }
#define XB_SPIN(cond, bar) do { unsigned _sp = 0; while (cond) { __builtin_amdgcn_s_sleep(1); \
    if ((++_sp & 255u) == 0u) { if (xb_ld(&(bar)[XB_TMO])) break; if (_sp > XB_SPIN_CAP) { atomicAdd(&(bar)[XB_TMO], 1u); break; } } } } while (0)

struct XcdBarrier {
    unsigned* bar; unsigned x;
    volatile LAS unsigned* st;
};

__device__ __forceinline__ XcdBarrier xcd_barrier_post(unsigned* bar, volatile LAS unsigned* st) {
    XcdBarrier b; b.bar = bar; b.x = xb_xcc_id(); b.st = st;
    if (threadIdx.x == 0) (void)xb_add(&bar[XB_XCNT(b.x)], 1u);
    return b;
}
__device__ __forceinline__ void xcd_barrier_complete(unsigned* bar, unsigned x, unsigned& nloc, unsigned& nx) {
    const unsigned G = gridDim.x * gridDim.y * gridDim.z;
    unsigned sum, cnt, mine, sp = 0u;
    for (;;) {
        sum = 0u; cnt = 0u; mine = 0u;
#pragma unroll
        for (unsigned j = 0; j < 16; ++j) { const unsigned c = xb_ld(&bar[XB_XCNT(j)]); sum += c; cnt += (c > 0u) ? 1u : 0u; mine = (j == x) ? c : mine; }
        if (sum == G) break;
        __builtin_amdgcn_s_sleep(1);
        if ((++sp & 255u) == 0u) { if (xb_ld(&bar[XB_TMO])) break; if (sp > XB_SPIN_CAP) { atomicAdd(&bar[XB_TMO], 1u); break; } }
    }
    nloc = mine > 0u ? mine : 1u; nx = cnt > 0u ? cnt : 1u;
}

__device__ __forceinline__ void xcd_barrier(const XcdBarrier& b) {
    asm volatile("s_waitcnt vmcnt(0)" ::: "memory");
    __syncthreads();
    if (threadIdx.x == 0) {
        unsigned* bar = b.bar;
        __builtin_amdgcn_s_waitcnt(0);
        unsigned nloc = b.st[0], nx = b.st[1];
        if (nloc == 0u) { xcd_barrier_complete(bar, b.x, nloc, nx); b.st[0] = nloc; b.st[1] = nx; }
        const unsigned old = xb_add(&bar[XB_XSUB(b.x)], 1u);
        const unsigned gen = old / nloc;
        if (old + 1u == (gen + 1u) * nloc) {
            __builtin_amdgcn_fence(__ATOMIC_RELEASE, "agent");
            asm volatile("s_waitcnt vmcnt(0)" ::: "memory");
            const unsigned og = xb_add(&bar[XB_TOP], 1u);
            const unsigned tg = og / nx;
            if (og + 1u == (tg + 1u) * nx) xb_add(&bar[XB_TOPGEN], 1u);
            else XB_SPIN(xb_ld(&bar[XB_TOPGEN]) == tg, bar);
            __builtin_amdgcn_fence(__ATOMIC_ACQUIRE, "agent");
            xb_add(&bar[XB_XGEN(b.x)], 1u);
            asm volatile("s_waitcnt vmcnt(0)" ::: "memory");
        } else {
            XB_SPIN(xb_ld(&bar[XB_XGEN(b.x)]) == gen, bar);
            __builtin_amdgcn_fence(__ATOMIC_ACQUIRE, "agent");
            asm volatile("s_waitcnt vmcnt(0)" ::: "memory");
        }
    }
    __syncthreads();
}

struct Frame {
    LAS unsigned char* lds;
    volatile LAS unsigned* MISC;
    gu32* ctl;
    int tid, lane, wave, vcu, G;
    const float* in[19]; float* out; unsigned char* ws;
};
enum { I_X = 0, I_N1W, I_WIN, I_LB, I_HNW, I_CONVW, I_ALOG, I_DTB, I_GNW, I_WPA, I_WPB, I_WOUT, I_N2W, I_WQ, I_K1, I_K2, I_PU, I_PV, I_FNW };

template <bool F8>
__device__ __forceinline__ void p0_transpose_item(const float* W, int ldw, int c0, int K, int ncols, void* WTv, int row_off, LAS float* scr, int item, int lane) {
    const int nblk = ncols / 32, kb = item / nblk, nb = item % nblk, k0 = 64 * kb, n0 = 32 * nb;
#pragma unroll 8
    for (int i = 0; i < 32; ++i) { const int kk = 2 * i + (lane >> 5); scr[kk * 33 + (lane & 31)] = W[(size_t)(k0 + kk) * ldw + c0 + n0 + (lane & 31)]; }
    LDS_WAIT(); asm volatile("" ::: "memory");
    const int c = lane & 7;
#pragma unroll
    for (int j = 0; j < 4; ++j) { const int n = (lane >> 3) + 8 * j; const LAS float* s = scr + (8 * c) * 33 + n;
        if (F8) { v2u o; o.x = pk4f8(s[0 * 33] * F8_WSCALE, s[1 * 33] * F8_WSCALE, s[2 * 33] * F8_WSCALE, s[3 * 33] * F8_WSCALE); o.y = pk4f8(s[4 * 33] * F8_WSCALE, s[5 * 33] * F8_WSCALE, s[6 * 33] * F8_WSCALE, s[7 * 33] * F8_WSCALE);
            *(GAS v2u*)((unsigned char*)WTv + (size_t)(row_off + n0 + n) * K + k0 + 8 * c) = o; }
        else { v4u o; o.x = pk2(s[0 * 33], s[1 * 33]); o.y = pk2(s[2 * 33], s[3 * 33]); o.z = pk2(s[4 * 33], s[5 * 33]); o.w = pk2(s[6 * 33], s[7 * 33]);
            *(GAS v4u*)((bf16*)WTv + (size_t)(row_off + n0 + n) * K + k0 + 8 * c) = o; } }
    LDS_WAIT(); asm volatile("" ::: "memory");
}
__device__ __forceinline__ unsigned pk4i8(f32x4 v, float inv) {
    const int a = (int)rintf(v.x * inv), b = (int)rintf(v.y * inv), c = (int)rintf(v.z * inv), d = (int)rintf(v.w * inv);
    return (unsigned)(a & 255) | ((unsigned)(b & 255) << 8) | ((unsigned)(c & 255) << 16) | ((unsigned)d << 24);
}
__device__ __forceinline__ float amax4(f32x4 v) { const f32x4 a = __builtin_elementwise_abs(v); return fmaxf(fmaxf(a.x, a.y), fmaxf(a.z, a.w)); }
__device__ __forceinline__ void rms_row_to_bf16(int lane, const float* xrow, const float* w, bf16* orow, unsigned char* orow8, float* sx) {
    const GAS f32x4* xr = (const GAS f32x4*)xrow + lane; const GAS f32x4* wr = (const GAS f32x4*)w + lane;
    f32x4 v[8]; float s = 0.f;
#pragma unroll
    for (int j = 0; j < 8; ++j) { v[j] = xr[64 * j]; s += (v[j].x * v[j].x + v[j].y * v[j].y) + (v[j].z * v[j].z + v[j].w * v[j].w); }
    const float r = 1.0f / sqrtf(wave_sum(s) * (1.f / DM) + EPS);
    GAS v2u* o8 = (GAS v2u*)orow + lane; GAS unsigned* q8 = (GAS unsigned*)orow8 + lane; float am = 0.f;
#pragma unroll
    for (int j = 0; j < 8; ++j) { const f32x4 ww = wr[64 * j]; const f32x4 y = {v[j].x * r * ww.x, v[j].y * r * ww.y, v[j].z * r * ww.z, v[j].w * r * ww.w};
        if (XN_BF16) { v2u o; o.x = pk2(y.x, y.y); o.y = pk2(y.z, y.w); o8[64 * j] = o; }
        if (QM_XN == 1) q8[64 * j] = pk4f8(y.x, y.y, y.z, y.w);
        if (QM_XN == 2) { v[j] = y; am = fmaxf(am, amax4(y)); } }
    if (QM_XN == 2) { am = wave_max(am); const float inv = am > 0.f ? 127.0f / am : 0.f;
#pragma unroll
        for (int j = 0; j < 8; ++j) q8[64 * j] = pk4i8(v[j], inv);
        if (lane == 0) *sx = am > 0.f ? am * (1.0f / 127.0f) : 1.0f; }
}
template <int KT>
__device__ __forceinline__ void p0_quant_item(Frame& F, const float* W, int ldw, int c0, signed char* Wq, float* scl, int n0) {
    constexpr int KW = KT / 8, NB = KW / 64;
    const int col = F.lane & 31, kh = F.lane >> 5;
    const GAS float* src = (const GAS float*)W + (size_t)(F.wave * KW + 32 * kh) * ldw + c0 + n0 + col;
    float v[NB][32]; float mx = 0.f;
#pragma unroll
    for (int b = 0; b < NB; ++b)
#pragma unroll
        for (int i = 0; i < 32; ++i) v[b][i] = src[(size_t)(64 * b + i) * ldw];
#pragma unroll
    for (int b = 0; b < NB; ++b)
#pragma unroll
        for (int i = 0; i < 32; ++i) mx = fmaxf(mx, fabsf(v[b][i]));
    mx = fmaxf(mx, __shfl_xor(mx, 32));
    LAS float* part = (LAS float*)F.lds;
    if (kh == 0) part[F.wave * 32 + col] = mx;
    __syncthreads();
    float cm = part[col];
#pragma unroll
    for (int w = 1; w < 8; ++w) cm = fmaxf(cm, part[w * 32 + col]);
    const float inv = cm > 0.f ? 127.0f / cm : 0.f;
    if (F.wave == 0 && kh == 0) scl[n0 + col] = cm > 0.f ? cm * (1.0f / 127.0f) : 1.0f;
    GAS v4u* dst = (GAS v4u*)(Wq + (size_t)(n0 + col) * KT + F.wave * KW + 32 * kh);
#pragma unroll
    for (int b = 0; b < NB; ++b) { unsigned w[8];
#pragma unroll
        for (int q = 0; q < 8; ++q) w[q] = pk4i8((f32x4){v[b][4 * q], v[b][4 * q + 1], v[b][4 * q + 2], v[b][4 * q + 3]}, inv);
        dst[4 * b] = (v4u){w[0], w[1], w[2], w[3]}; dst[4 * b + 1] = (v4u){w[4], w[5], w[6], w[7]}; }
    __syncthreads();
}
__device__ __forceinline__ void p0_ws_item(Frame& F, int it) {
    const int h = it >> 6, half = (it >> 5) & 1, j0 = (it & 31) * 64, hc = h * 256 + half * 128;
    const float* Wq = F.in[I_WQ]; const float* Ks = half ? F.in[I_K2] : F.in[I_K1]; const float* n2 = F.in[I_N2W];
    LAS bf16* Xs = (LAS bf16*)F.lds; LAS bf16* Ys = Xs + 64 * 136;
    { const int row = F.tid >> 3, c0 = (F.tid & 7) * 16; const GAS f32x4* src = (const GAS f32x4*)(Wq + (size_t)(j0 + row) * DM + hc + c0);
      const f32x4 a = src[0], b = src[1], c = src[2], d = src[3];
      v4u o0, o1; o0.x = pk2(a.x, a.y); o0.y = pk2(a.z, a.w); o0.z = pk2(b.x, b.y); o0.w = pk2(b.z, b.w); o1.x = pk2(c.x, c.y); o1.y = pk2(c.z, c.w); o1.z = pk2(d.x, d.y); o1.w = pk2(d.z, d.w);
      *(LAS v4u*)(Xs + row * 136 + c0) = o0; *(LAS v4u*)(Xs + row * 136 + c0 + 8) = o1; }
    { const int row = F.tid >> 2, c0 = (F.tid & 3) * 32; const GAS f32x4* src = (const GAS f32x4*)(Ks + (size_t)row * 128 + c0);
#pragma unroll
      for (int q = 0; q < 4; ++q) { const f32x4 a = src[2 * q], b = src[2 * q + 1]; v4u o; o.x = pk2(a.x, a.y); o.y = pk2(a.z, a.w); o.z = pk2(b.x, b.y); o.w = pk2(b.z, b.w); *(LAS v4u*)(Ys + row * 136 + c0 + 8 * q) = o; } }
    __syncthreads();
    const int fr = F.lane & 15, fq = F.lane >> 4, w = F.wave;
    bf16* WSt = (bf16*)(F.ws + WS_WS);
#pragma unroll
    for (int jt = 0; jt < 4; ++jt) {
        f32x4 acc = {0.f, 0.f, 0.f, 0.f};
#pragma unroll
        for (int k0 = 0; k0 < 4; ++k0) acc = mfma16(ldfrag(Xs, 136, 16 * jt + fr, 32 * k0 + 8 * fq), ldfrag(Ys, 136, 16 * w + fr, 32 * k0 + 8 * fq), acc);
        const int jj = j0 + 16 * jt + 4 * fq; const f32x4 nw = *(const GAS f32x4*)(n2 + jj);
        *(GAS v2u*)(WSt + (size_t)(hc + 16 * w + fr) * DM + jj) = pack4(acc * nw);
    }
    __syncthreads();
}
__device__ __forceinline__ void p0_prologue(Frame& F) {
    LAS float* scr = (LAS float*)(F.lds + F.wave * 16384);
    const int gw = F.vcu * NWAVES + F.wave, NGW = F.G * NWAVES;
    constexpr int I_1 = QM_G1 == 2 ? 0 : (DM / 64) * (N1 / 32), I_AB = AB_I8 ? 0 : (DM / 64), I_G = QM_GATE == 2 ? 0 : (DM / 64) * (4096 / 32), I_PA = QM_MIX == 2 ? 0 : (HW / 64) * (DM / 32), I_O = QM_OUT == 2 ? 0 : (DM / 64) * (DM / 32);
    constexpr int NITEMS = I_1 + I_AB + I_G + 2 * I_PA + I_O;
    for (int it = gw; it < NITEMS; it += NGW) {
        int r = it;
        if (r < I_1) { p0_transpose_item<QM_G1 == 1>(F.in[I_WIN], INW, 0, DM, N1, F.ws + WS_W1, 0, scr, r, F.lane); continue; } r -= I_1;
        if (r < I_AB) { p0_transpose_item<false>(F.in[I_WIN], INW, N1, DM, 32, F.ws + WS_WAB, 0, scr, r, F.lane); continue; } r -= I_AB;
        if (r < I_G) { p0_transpose_item<QM_GATE == 1>(F.in[I_WIN], INW, 9248, DM, 4096, F.ws + WS_WG, 0, scr, r, F.lane); continue; } r -= I_G;
        if (r < I_PA) { p0_transpose_item<QM_MIX == 1>(F.in[I_WPA], DM, 0, HW, DM, F.ws + WS_WPA, 0, scr, r, F.lane); continue; } r -= I_PA;
        if (r < I_PA) { p0_transpose_item<QM_MIX == 1>(F.in[I_WPB], DM, 0, HW, DM, F.ws + WS_WPB, 0, scr, r, F.lane); continue; } r -= I_PA;
        p0_transpose_item<QM_OUT == 1>(F.in[I_WOUT], DM, 0, DM, DM, F.ws + WS_WOUT, 0, scr, r, F.lane);
    }
    bf16* XN = (bf16*)(F.ws + WS_XN); float* QX = (float*)(F.ws + WS_QX);
    for (int m = gw; m < SEQ; m += NGW) rms_row_to_bf16(F.lane, F.in[I_X] + (size_t)m * DM, F.in[I_N1W], XN + (size_t)m * DM, (unsigned char*)F.out + DO_XN8 + (size_t)m * DM, QX + m);
    __syncthreads();
    { constexpr int J_1 = (QM_G1 == 2 ? N1 / 32 : 0) + (AB_I8 ? 1 : 0), J_G = QM_GATE == 2 ? 4096 / 32 : 0, J_O = QM_OUT == 2 ? DM / 32 : 0, J_P = QM_MIX == 2 ? DM / 32 : 0;
      float* QW = (float*)(F.ws + WS_QW);
#pragma unroll 1
      for (int it = F.vcu; it < J_1 + J_G + J_O + 2 * J_P; it += F.G) {
          int r = it; const float* W = F.in[I_WIN]; int ldw = INW, c0 = 0, n0 = 0, qo = QW_W1; size_t wo = WS_W1; bool half = false;
          if (r < J_1) { n0 = 32 * r; if (AB_I8 && r == J_1 - 1) { c0 = N1; n0 = 0; qo = QW_WAB; wo = WS_WAB; } }
          else if ((r -= J_1) < J_G) { c0 = 9248; n0 = 32 * r; qo = QW_WG; wo = WS_WG; }
          else if ((r -= J_G) < J_O) { W = F.in[I_WOUT]; ldw = DM; n0 = 32 * r; qo = QW_WOUT; wo = WS_WOUT; }
          else if ((r -= J_O) < J_P) { W = F.in[I_WPA]; ldw = DM; n0 = 32 * r; qo = QW_WPA; wo = WS_WPA; half = true; }
          else { r -= J_P; W = F.in[I_WPB]; ldw = DM; n0 = 32 * r; qo = QW_WPB; wo = WS_WPB; half = true; }
          if (half) p0_quant_item<HW>(F, W, ldw, c0, (signed char*)(F.ws + wo), QW + qo, n0);
          else p0_quant_item<DM>(F, W, ldw, c0, (signed char*)(F.ws + wo), QW + qo, n0);
      } }
    __syncthreads();
    for (int it = blockIdx.x; it < 512; it += F.G) p0_ws_item(F, it);
}
typedef unsigned u32x4 __attribute__((ext_vector_type(4)));
__device__ __forceinline__ u32x4 pack8(f32x4 a, f32x4 b) { u32x4 w; w.x = pk2(a[0], a[1]); w.y = pk2(a[2], a[3]); w.z = pk2(b[0], b[1]); w.w = pk2(b[2], b[3]); return w; }
__device__ __forceinline__ void unpack8(u32x4 w, f32x4& a, f32x4& b) { a = (f32x4){bflo(w.x), bfhi(w.x), bflo(w.y), bfhi(w.y)}; b = (f32x4){bflo(w.z), bfhi(w.z), bflo(w.w), bfhi(w.w)}; }
__device__ __forceinline__ f32x4 silu4(f32x4 v) { return (f32x4){siluf_(v[0]), siluf_(v[1]), siluf_(v[2]), siluf_(v[3])}; }
__device__ __forceinline__ f32x4 sigm4(f32x4 v) { return (f32x4){sigmoidf_(v[0]), sigmoidf_(v[1]), sigmoidf_(v[2]), sigmoidf_(v[3])}; }

typedef int i32x4 __attribute__((ext_vector_type(4)));
template <int QM> __device__ __forceinline__ f32x4 deq(f32x4 a, float sr, f32x4 sc) {
    if (QM == 2) { const i32x4 q = __builtin_bit_cast(i32x4, a); return (f32x4){(float)q[0], (float)q[1], (float)q[2], (float)q[3]} * (sc * sr); }
    if (QM == 1) return a * (1.0f / F8_WSCALE);
    return a;
}
template <int QM, bool PERM> __device__ __forceinline__ void ld_colscale(f32x4 (&scv)[2][2], const float* sb, int cb) {
#pragma unroll
    for (int bj = 0; bj < 2; ++bj)
#pragma unroll
        for (int n = 0; n < 2; ++n) scv[bj][n] = (QM == 2) ? *(const f32x4*)(sb + cb + bj * 128 + (PERM ? 4 : 16) * n) : (f32x4){1.f, 1.f, 1.f, 1.f};
}
__device__ __forceinline__ unsigned pk4u8(f32x4 v) { const unsigned a = (unsigned)(v[0] * 255.f + 0.5f), b = (unsigned)(v[1] * 255.f + 0.5f), c = (unsigned)(v[2] * 255.f + 0.5f), d = (unsigned)(v[3] * 255.f + 0.5f); return a | (b << 8) | (c << 16) | (d << 24); }
__device__ __forceinline__ f32x4 un4u8(unsigned w) { return (f32x4){cvt_ub0(w), cvt_ub1(w), cvt_ub2(w), cvt_ub3(w)} * (1.0f / 255.f); }
struct EpiG1 {
    static constexpr bool PERM = true, AFTER_DRAIN = false;
    unsigned char* ws; const float* lbl;
    const float* sa; const float* sb;
    __device__ __forceinline__ void operator()(const f32x4 (&acc)[2][2][4][2], const pg8::Unit& u, int wr, int wc, int fr, int fq) const {
        const int pn = u.pn, row0 = u.pm * 256 + wr * 64 + fr;
        {
            const int grp = pn >> 2; const bool act = (grp == 0) | (grp == 4) | (grp == 8);
            bf16* base = (bf16*)(ws + WS_H + (size_t)grp * 32 * MiB); const int col0 = (pn & 3) * 256 + wc * 32 + 8 * fq;
            f32x4 scv[2][2]; ld_colscale<QM_G1, true>(scv, sb, pn * 256 + wc * 32 + 8 * fq);
            const bool fgate = (grp == 1) | (grp == 2); f32x4 lbv[2][2];
            if (fgate) { const float* l0 = lbl + (grp - 1) * 2048 + col0;
#pragma unroll
                for (int bj = 0; bj < 2; ++bj)
#pragma unroll
                    for (int n = 0; n < 2; ++n) { const f32x4 a0 = *(const f32x4*)(l0 + bj * 128 + 4 * n), a1 = *(const f32x4*)(l0 + 1024 + bj * 128 + 4 * n);
                        lbv[bj][n] = (f32x4){fast_rcp(1.0f + fast_exp(a1[0] - a0[0])), fast_rcp(1.0f + fast_exp(a1[1] - a0[1])), fast_rcp(1.0f + fast_exp(a1[2] - a0[2])), fast_rcp(1.0f + fast_exp(a1[3] - a0[3]))}; } }
#pragma unroll
            for (int ai = 0; ai < 2; ++ai)
#pragma unroll
                for (int m = 0; m < 4; ++m) { bf16* rowp = base + (size_t)(row0 + ai * 128 + m * 16) * HW + col0; const float sr = (QM_G1 == 2) ? sa[row0 + ai * 128 + m * 16] : 1.f;
#pragma unroll
                    for (int bj = 0; bj < 2; ++bj) { f32x4 v0 = deq<QM_G1>(acc[ai][bj][m][0], sr, scv[bj][0]), v1 = deq<QM_G1>(acc[ai][bj][m][1], sr, scv[bj][1]);
                        if (act) { v0 = silu4(v0); v1 = silu4(v1); }
                        if (fgate) { v0 = lbv[bj][0] + (1.0f - lbv[bj][0]) * sigm4(v0); v1 = lbv[bj][1] + (1.0f - lbv[bj][1]) * sigm4(v1); }
                        *(u32x4*)(rowp + bj * 128) = pack8(v0, v1); } }
        }
    }
};
struct EpiGate {
    static constexpr bool PERM = true, AFTER_DRAIN = false;
    unsigned char* O; const float* sa; const float* sb;
    __device__ __forceinline__ void operator()(const f32x4 (&acc)[2][2][4][2], const pg8::Unit& u, int wr, int wc, int fr, int fq) const {
        const int row0 = u.pm * 256 + wr * 64 + fr, col0 = u.pn * 256 + wc * 32 + 8 * fq;
        f32x4 scv[2][2]; ld_colscale<QM_GATE, true>(scv, sb, col0);
#pragma unroll
        for (int ai = 0; ai < 2; ++ai)
#pragma unroll
            for (int m = 0; m < 4; ++m) { unsigned char* rowp = O + (size_t)(row0 + ai * 128 + m * 16) * DM + col0; const float sr = (QM_GATE == 2) ? sa[row0 + ai * 128 + m * 16] : 1.f;
#pragma unroll
                for (int bj = 0; bj < 2; ++bj) { v2u w; w.x = pk4u8(sigm4(deq<QM_GATE>(acc[ai][bj][m][0], sr, scv[bj][0]))); w.y = pk4u8(sigm4(deq<QM_GATE>(acc[ai][bj][m][1], sr, scv[bj][1]))); *(v2u*)(rowp + bj * 128) = w; } }
    }
};
template <int MODE> struct EpiMix {
    static constexpr bool PERM = true, AFTER_DRAIN = false;
    bf16* O; const unsigned char* G; unsigned char* O8;
    const float* sa; const float* sb;
    __device__ __forceinline__ void operator()(const f32x4 (&acc)[2][2][4][2], const pg8::Unit& u, int wr, int wc, int fr, int fq) const {
        const int row0 = u.pm * 256 + wr * 64 + fr, col0 = u.pn * 256 + wc * 32 + 8 * fq;
        f32x4 scv[2][2]; ld_colscale<QM_MIX, true>(scv, sb, col0);
#pragma unroll
        for (int ai = 0; ai < 2; ++ai)
#pragma unroll
            for (int m = 0; m < 4; ++m) { const size_t off = (size_t)(row0 + ai * 128 + m * 16) * DM + col0; const float sr = (QM_MIX == 2) ? sa[row0 + ai * 128 + m * 16] : 1.f;
#pragma unroll
                for (int bj = 0; bj < 2; ++bj) { f32x4 o0, o1; const v2u gw = *(const v2u*)(G + off + bj * 128); const f32x4 g0 = un4u8(gw.x), g1 = un4u8(gw.y);
                    const f32x4 c0 = deq<QM_MIX>(acc[ai][bj][m][0], sr, scv[bj][0]), c1 = deq<QM_MIX>(acc[ai][bj][m][1], sr, scv[bj][1]);
                    if (MODE == 0) { o0 = g0 * c0; o1 = g1 * c1; }
                    else { unpack8(*(const u32x4*)(O + off + bj * 128), o0, o1); o0 = o0 + g0 * c0; o1 = o1 + g1 * c1; }
                    if (MODE == 1 && QM_OUT == 1) { v2u w; w.x = pk4f8(o0[0], o0[1], o0[2], o0[3]); w.y = pk4f8(o1[0], o1[1], o1[2], o1[3]); *(v2u*)(O8 + off + bj * 128) = w; }
                    else *(u32x4*)(O + off + bj * 128) = pack8(o0, o1); } }
    }
};
struct EpiX1 {
    static constexpr bool PERM = false, AFTER_DRAIN = false;
    const float* x; float* out; bf16* xb;
    __device__ __forceinline__ void operator()(const f32x4 (&acc)[2][2][4][2], const pg8::Unit& u, int wr, int wc, int fr, int fq) const {
        const int row0 = u.pm * 256 + wr * 64 + fr, col0 = u.pn * 256 + wc * 32 + 4 * fq;
#pragma unroll
        for (int ai = 0; ai < 2; ++ai)
#pragma unroll
            for (int m = 0; m < 4; ++m) { const size_t off = (size_t)(row0 + ai * 128 + m * 16) * DM + col0;
#pragma unroll
                for (int bj = 0; bj < 2; ++bj)
#pragma unroll
                    for (int n = 0; n < 2; ++n) { const size_t o = off + bj * 128 + n * 16; const f32x4 v = *(const f32x4*)(x + o) + deq<QM_OUT>(acc[ai][bj][m][n], 1.f, (f32x4){1.f, 1.f, 1.f, 1.f});
                        *(v2u*)(xb + o) = pack4(v); } }
    }
};
struct EpiBf {
    static constexpr bool PERM = true, AFTER_DRAIN = false;
    bf16* O;
    __device__ __forceinline__ void operator()(const f32x4 (&acc)[2][2][4][2], const pg8::Unit& u, int wr, int wc, int fr, int fq) const {
        const int row0 = u.pm * 256 + wr * 64 + fr, col0 = u.pn * 256 + wc * 32 + 8 * fq;
#pragma unroll
        for (int ai = 0; ai < 2; ++ai)
#pragma unroll
            for (int m = 0; m < 4; ++m) { bf16* rowp = O + (size_t)(row0 + ai * 128 + m * 16) * DM + col0;
#pragma unroll
                for (int bj = 0; bj < 2; ++bj) *(u32x4*)(rowp + bj * 128) = pack8(acc[ai][bj][m][0], acc[ai][bj][m][1]); }
    }
};
struct EpiF32 {
    static constexpr bool PERM = false, AFTER_DRAIN = false;
    float* C;
    __device__ __forceinline__ void operator()(const f32x4 (&acc)[2][2][4][2], const pg8::Unit& u, int wr, int wc, int fr, int fq) const {
        const int row0 = u.pm * 256 + wr * 64 + fr, col0 = u.pn * 256 + wc * 32 + 4 * fq;
#pragma unroll
        for (int ai = 0; ai < 2; ++ai)
#pragma unroll
            for (int m = 0; m < 4; ++m) { float* rowp = C + (size_t)(row0 + ai * 128 + m * 16) * DM + col0;
#pragma unroll
                for (int bj = 0; bj < 2; ++bj)
#pragma unroll
                    for (int n = 0; n < 2; ++n) *(f32x4*)(rowp + bj * 128 + n * 16) = acc[ai][bj][m][n]; }
    }
};

__device__ __forceinline__ void p1_ab(Frame& F) {
    float* Gab = (float*)(F.ws + WS_GAB);
    const int fr = F.lane & 15, fq = F.lane >> 4, rt = F.wave >> 1, ct = F.wave & 1;
    if (AB_I8) {
        const signed char* XQ = (const signed char*)F.out + DO_XN8; const signed char* Wab = (const signed char*)(F.ws + WS_WAB);
        const float* QX = (const float*)(F.ws + WS_QX); const f32x4 sw = *(const f32x4*)((const float*)(F.ws + WS_QW) + QW_WAB + ct * 16 + 4 * fq);
        for (int blk = F.vcu; blk < SEQ / 64; blk += F.G) {
            const int row = blk * 64 + rt * 16 + fr;
            const signed char* ap = XQ + (size_t)row * DM + 16 * fq; const signed char* bp = Wab + (size_t)(ct * 16 + fr) * DM + 16 * fq;
            i32x4 acc = {0, 0, 0, 0};
#pragma unroll 1
            for (int kb = 0; kb < DM; kb += 1024) { i32x4 af[16], bfr[16];
#pragma unroll
                for (int u = 0; u < 16; ++u) { af[u] = *(const GAS i32x4*)(ap + kb + 64 * u); bfr[u] = *(const GAS i32x4*)(bp + kb + 64 * u); }
                __builtin_amdgcn_sched_barrier(0);
#pragma unroll
                for (int u = 0; u < 16; ++u) acc = __builtin_amdgcn_mfma_i32_16x16x64_i8(bfr[u], af[u], acc, 0, 0, 0);
                __builtin_amdgcn_sched_barrier(0); }
            *(GAS f32x4*)(Gab + (size_t)row * 32 + ct * 16 + 4 * fq) = (f32x4){(float)acc[0], (float)acc[1], (float)acc[2], (float)acc[3]} * (sw * QX[row]);
        }
        return;
    }
    const bf16* XN = (const bf16*)(F.ws + WS_XN); const bf16* Wab = (const bf16*)(F.ws + WS_WAB);
    for (int blk = F.vcu; blk < SEQ / 64; blk += F.G) {
        const bf16* ap = XN + (size_t)(blk * 64 + rt * 16 + fr) * DM + 8 * fq; const bf16* bp = Wab + (size_t)(ct * 16 + fr) * DM + 8 * fq;
        f32x4 acc = {0.f, 0.f, 0.f, 0.f};
#pragma unroll 1
        for (int kb = 0; kb < DM; kb += 512) { bf16x8 af[16], bfr[16];
#pragma unroll
            for (int u = 0; u < 16; ++u) { af[u] = *(const GAS bf16x8*)(ap + kb + 32 * u); bfr[u] = *(const GAS bf16x8*)(bp + kb + 32 * u); }
            __builtin_amdgcn_sched_barrier(0);
#pragma unroll
            for (int u = 0; u < 16; ++u) acc = mfma16(bfr[u], af[u], acc);
            __builtin_amdgcn_sched_barrier(0); }
        *(GAS f32x4*)(Gab + (size_t)(blk * 64 + rt * 16 + fr) * 32 + ct * 16 + 4 * fq) = acc;
    }
}
template <bool PASS3, int SKIP = 0>
__device__ __forceinline__ void hgrn_pass(Frame& F) {
    LAS bf16*  ST  = (LAS bf16*)(F.lds + 0);
    LAS float* LF  = (LAS float*)(F.lds + 0);
    LAS bf16*  QT  = (LAS bf16*)(F.lds + 34816);
    LAS bf16*  KT  = (LAS bf16*)(F.lds + 52224);
    LAS bf16*  KHT = (LAS bf16*)(F.lds + 69632);
    LAS bf16*  VT  = (LAS bf16*)(F.lds + 88064);
    LAS bf16*  ATT = (LAS bf16*)(F.lds + 106496);
    LAS float* PT  = (LAS float*)(F.lds + 115712);
    LAS float* BL  = (LAS float*)(F.lds + 117760);
    LAS float* DKK = (LAS float*)(F.lds + 118272);
    LAS float* LBV = (LAS float*)(F.lds + 118784);
    LAS bf16*  VR  = (LAS bf16*)(F.lds + 119296);
    const int tid = F.tid, lane = F.lane, w = F.wave, fr = lane & 15, fq = lane >> 4;
    const int row = tid >> 3, c0 = (tid & 7) * 16;
    float* HL = (float*)(F.ws + WS_HL); float* HDS = (float*)(F.ws + WS_HDS);
    for (int it = blockIdx.x; it < 256; it += F.G) {
        const int hd = it >> 4, sg = it & 15, dir = hd >> 3, h = hd & 7;
        const bf16* Hq = (const bf16*)(F.ws + WS_H); const bf16* Hf = (const bf16*)(F.ws + WS_H + (size_t)(1 + dir) * 32 * MiB); const bf16* Hi = (const bf16*)(F.ws + WS_H + (size_t)3 * 32 * MiB);
        bf16* Oh = (bf16*)(F.ws + (dir ? WS_OHB : WS_OHF));
        __syncthreads();
        f32x4 Sacc[8];
#pragma unroll
        for (int kt = 0; kt < 8; ++kt) Sacc[kt] = (f32x4){0.f, 0.f, 0.f, 0.f};
        if (PASS3) {
            for (int p = 0; p < sg; ++p) { const int ip = hd * 16 + p; f32x4 dsv[8], lv[8];
#pragma unroll
                for (int kt = 0; kt < 8; ++kt) { dsv[kt] = *(const GAS f32x4*)(HDS + ip * 128 + 16 * kt + 4 * fq); lv[kt] = *(const GAS f32x4*)(HL + ((size_t)((ip * 8 + w) * 8 + kt) * 64 + lane) * 4); }
                __builtin_amdgcn_sched_barrier(0);
#pragma unroll
                for (int kt = 0; kt < 8; ++kt) Sacc[kt] = Sacc[kt] * dsv[kt] + lv[kt];
                __builtin_amdgcn_sched_barrier(0); }
        }
        float sumbl = 1.f;
        v4u rq[2], rf[2], rv[2];
        { const int oc = dir ? 255 - sg * 16 : sg * 16; const size_t off = (size_t)(64 * oc + row) * HW + h * 128 + c0;
          rq[0] = *(const GAS v4u*)(Hq + off); rq[1] = *(const GAS v4u*)(Hq + off + 8); rf[0] = *(const GAS v4u*)(Hf + off); rf[1] = *(const GAS v4u*)(Hf + off + 8); rv[0] = *(const GAS v4u*)(Hi + off); rv[1] = *(const GAS v4u*)(Hi + off + 8); }
        __syncthreads();
        for (int ci = 0; ci < ((SKIP & 4) ? 1 : CPS); ++ci) {
            const int sc = sg * 16 + ci, oc = dir ? 255 - sc : sc, tok0 = 64 * oc;
            float kk[16], qq[16];
            { const unsigned fw[8] = {rf[0].x, rf[0].y, rf[0].z, rf[0].w, rf[1].x, rf[1].y, rf[1].z, rf[1].w};
              const unsigned qw[8] = {rq[0].x, rq[0].y, rq[0].z, rq[0].w, rq[1].x, rq[1].y, rq[1].z, rq[1].w};
              float fgv[16];
#pragma unroll
              for (int e = 0; e < 16; ++e) { fgv[e] = (e & 1) ? bfhi(fw[e >> 1]) : bflo(fw[e >> 1]); qq[e] = (e & 1) ? bfhi(qw[e >> 1]) : bflo(qw[e >> 1]); kk[e] = 1.0f - fgv[e]; }
#pragma unroll
              for (int q4 = 0; q4 < 4; ++q4) *(LAS f32x4*)(LF + row * 132 + c0 + 4 * q4) = (f32x4){fgv[4 * q4], fgv[4 * q4 + 1], fgv[4 * q4 + 2], fgv[4 * q4 + 3]};
              *(LAS v4u*)(VR + row * 136 + c0) = rv[0]; *(LAS v4u*)(VR + row * 136 + c0 + 8) = rv[1]; }
            if (ci + 1 < CPS && !(SKIP & 2)) { const int oc2 = dir ? oc - 1 : oc + 1; const size_t off = (size_t)(64 * oc2 + row) * HW + h * 128 + c0;
              rq[0] = *(const GAS v4u*)(Hq + off); rq[1] = *(const GAS v4u*)(Hq + off + 8); rf[0] = *(const GAS v4u*)(Hf + off); rf[1] = *(const GAS v4u*)(Hf + off + 8); rv[0] = *(const GAS v4u*)(Hi + off); rv[1] = *(const GAS v4u*)(Hi + off + 8); }
            if (!(SKIP & 8)) __syncthreads();
            { const int c = tid & 127, part = tid >> 7, r0 = part * 16; float b[16], fv[16]; float run = 1.f;
#pragma unroll
              for (int i = 0; i < 16; ++i) fv[i] = LF[(r0 + i) * 132 + c];
              if (!dir) {
#pragma unroll
                  for (int i = 0; i < 16; ++i) { run *= fv[i]; b[i] = run; }
              } else {
#pragma unroll
                  for (int i = 15; i >= 0; --i) { run *= fv[i]; b[i] = run; }
              }
              PT[part * 128 + c] = run;
              unsigned short vcol[16];
#pragma unroll
              for (int i = 0; i < 16; ++i) vcol[i] = VR[(r0 + i) * 136 + c];
              if (!(SKIP & 8)) __syncthreads();
              const float p0 = PT[c], p1 = PT[128 + c], p2 = PT[256 + c], p3 = PT[384 + c];
              float offs;
              if (!dir) offs = (part > 0 ? p0 : 1.f) * (part > 1 ? p1 : 1.f) * (part > 2 ? p2 : 1.f);
              else      offs = (part < 3 ? p3 : 1.f) * (part < 2 ? p2 : 1.f) * (part < 1 ? p1 : 1.f);
              const float tot = (p0 * p1) * (p2 * p3);
              unsigned kh[8], vw[8];
#pragma unroll
              for (int i = 0; i < 8; ++i) { const float P0 = b[2 * i] * offs, P1 = b[2 * i + 1] * offs;
                  if (PASS3) { LF[(r0 + 2 * i) * 132 + c] = P0; LF[(r0 + 2 * i + 1) * 132 + c] = P1; }
                  kh[i] = pk2((1.0f - fv[2 * i]) * tot * fast_rcp(P0), (1.0f - fv[2 * i + 1]) * tot * fast_rcp(P1)); vw[i] = (unsigned)vcol[2 * i] | ((unsigned)vcol[2 * i + 1] << 16); }
              *(LAS v4u*)(KHT + c * 72 + r0) = (v4u){kh[0], kh[1], kh[2], kh[3]}; *(LAS v4u*)(KHT + c * 72 + r0 + 8) = (v4u){kh[4], kh[5], kh[6], kh[7]};
              *(LAS v4u*)(VT + c * 72 + r0) = (v4u){vw[0], vw[1], vw[2], vw[3]}; *(LAS v4u*)(VT + c * 72 + r0 + 8) = (v4u){vw[4], vw[5], vw[6], vw[7]};
              if (part == 0) { DKK[c] = tot; sumbl *= tot; }
            }
            if (!(SKIP & 8)) __syncthreads();
            if (PASS3 && !(SKIP & 1)) { float bb[16];
#pragma unroll
              for (int q4 = 0; q4 < 4; ++q4) { const f32x4 t4 = *(const LAS f32x4*)(LF + row * 132 + c0 + 4 * q4); bb[4 * q4] = t4[0]; bb[4 * q4 + 1] = t4[1]; bb[4 * q4 + 2] = t4[2]; bb[4 * q4 + 3] = t4[3]; }
              unsigned qo[8], ko[8];
#pragma unroll
              for (int e = 0; e < 8; ++e) { qo[e] = pk2(qq[2 * e] * bb[2 * e], qq[2 * e + 1] * bb[2 * e + 1]); ko[e] = pk2(kk[2 * e] * fast_rcp(bb[2 * e]), kk[2 * e + 1] * fast_rcp(bb[2 * e + 1])); }
              *(LAS v4u*)(QT + row * 136 + c0) = (v4u){qo[0], qo[1], qo[2], qo[3]}; *(LAS v4u*)(QT + row * 136 + c0 + 8) = (v4u){qo[4], qo[5], qo[6], qo[7]};
              *(LAS v4u*)(KT + row * 136 + c0) = (v4u){ko[0], ko[1], ko[2], ko[3]}; *(LAS v4u*)(KT + row * 136 + c0 + 8) = (v4u){ko[4], ko[5], ko[6], ko[7]};
            }
            if (PASS3) if (!(SKIP & 8)) __syncthreads();
            if (PASS3 && !(SKIP & 1)) {
                { bf16x8 kf[2][4], qf[2][4]; f32x4 acc[2];
#pragma unroll
                  for (int q2 = 0; q2 < 2; ++q2) { const int tl = 2 * w + q2, ti = tl >> 2, tj = tl & 3; acc[q2] = (f32x4){0.f, 0.f, 0.f, 0.f};
#pragma unroll
                      for (int k0 = 0; k0 < 4; ++k0) { kf[q2][k0] = ldfrag(KT, 136, 16 * ti + fr, 32 * k0 + 8 * fq); qf[q2][k0] = ldfrag(QT, 136, 16 * tj + fr, 32 * k0 + 8 * fq); } }
                  __builtin_amdgcn_sched_barrier(0);
#pragma unroll
                  for (int k0 = 0; k0 < 4; ++k0)
#pragma unroll
                      for (int q2 = 0; q2 < 2; ++q2) acc[q2] = mfma16(kf[q2][k0], qf[q2][k0], acc[q2]);
                  __builtin_amdgcn_sched_barrier(0);
#pragma unroll
                  for (int q2 = 0; q2 < 2; ++q2) { const int tl = 2 * w + q2, ti = tl >> 2, tj = tl & 3; const int t = 16 * tj + fr, s0 = 16 * ti + 4 * fq;
#pragma unroll
                      for (int r = 0; r < 4; ++r) { const bool keep = dir ? (s0 + r >= t) : (s0 + r <= t); acc[q2][r] = keep ? acc[q2][r] : 0.f; }
                      *(LAS v2u*)(ATT + t * 72 + s0) = pack4(acc[q2]); } }
#pragma unroll
                for (int kt = 0; kt < 8; ++kt) *(LAS v2u*)(ST + (16 * w + fr) * 136 + 16 * kt + 4 * fq) = pack4(Sacc[kt]);
                if (!(SKIP & 8)) __syncthreads();
            }
            bf16x8 xv[2];
#pragma unroll
            for (int s0 = 0; s0 < 2; ++s0) xv[s0] = ldfrag(VT, 72, 16 * w + fr, 32 * s0 + 8 * fq);
            if (PASS3 && !(SKIP & 1)) {
                bf16x8 xs[4];
#pragma unroll
                for (int k0 = 0; k0 < 4; ++k0) xs[k0] = ldfrag(ST, 136, 16 * w + fr, 32 * k0 + 8 * fq);
#pragma unroll
                for (int th = 0; th < 2; ++th) { bf16x8 qf[2][4], af[2][2]; f32x4 acc[2];
#pragma unroll
                    for (int tq = 0; tq < 2; ++tq) { const int tt = 2 * th + tq; acc[tq] = (f32x4){0.f, 0.f, 0.f, 0.f};
#pragma unroll
                        for (int k0 = 0; k0 < 4; ++k0) qf[tq][k0] = ldfrag(QT, 136, 16 * tt + fr, 32 * k0 + 8 * fq);
#pragma unroll
                        for (int s0 = 0; s0 < 2; ++s0) af[tq][s0] = ldfrag(ATT, 72, 16 * tt + fr, 32 * s0 + 8 * fq); }
                    __builtin_amdgcn_sched_barrier(0);
#pragma unroll
                    for (int k0 = 0; k0 < 4; ++k0)
#pragma unroll
                        for (int tq = 0; tq < 2; ++tq) acc[tq] = mfma16(xs[k0], qf[tq][k0], acc[tq]);
#pragma unroll
                    for (int s0 = 0; s0 < 2; ++s0)
#pragma unroll
                        for (int tq = 0; tq < 2; ++tq) acc[tq] = mfma16(xv[s0], af[tq][s0], acc[tq]);
                    __builtin_amdgcn_sched_barrier(0);
#pragma unroll
                    for (int tq = 0; tq < 2; ++tq) *(GAS v2u*)(Oh + (size_t)(tok0 + 16 * (2 * th + tq) + fr) * HW + h * 128 + 16 * w + 4 * fq) = pack4(acc[tq]); }
            }
#pragma unroll
            for (int kh = 0; kh < ((SKIP & 1) ? 0 : 2); ++kh) { bf16x8 kf[4][2];
#pragma unroll
                for (int kq = 0; kq < 4; ++kq) { const int kt = 4 * kh + kq; const f32x4 d4 = *(const LAS f32x4*)(DKK + 16 * kt + 4 * fq); Sacc[kt] = Sacc[kt] * d4;
#pragma unroll
                    for (int s0 = 0; s0 < 2; ++s0) kf[kq][s0] = ldfrag(KHT, 72, 16 * kt + fr, 32 * s0 + 8 * fq); }
                __builtin_amdgcn_sched_barrier(0);
#pragma unroll
                for (int s0 = 0; s0 < 2; ++s0)
#pragma unroll
                    for (int kq = 0; kq < 4; ++kq) Sacc[4 * kh + kq] = mfma16(kf[kq][s0], xv[s0], Sacc[4 * kh + kq]);
                __builtin_amdgcn_sched_barrier(0); }
            if (!(SKIP & 8)) __syncthreads();
        }
        if (!PASS3) {
#pragma unroll
            for (int kt = 0; kt < 8; ++kt) *(GAS f32x4*)(HL + ((size_t)((it * 8 + w) * 8 + kt) * 64 + lane) * 4) = Sacc[kt];
            if (tid < 128) HDS[it * 128 + tid] = sumbl;
        }
    }
}
template <int SKIP>
__device__ __forceinline__ void gdn_prep(Frame& F) {
    LAS bf16*  QN  = (LAS bf16*)(F.lds + 0);
    LAS bf16*  KN  = (LAS bf16*)(F.lds + 17408);
    LAS bf16*  VT  = (LAS bf16*)(F.lds + 34816);
    LAS bf16*  KNT = (LAS bf16*)(F.lds + 53248);
    LAS float* AD  = (LAS float*)(F.lds + 71680);
    LAS bf16*  AB  = (LAS bf16*)(F.lds + 79872);
    LAS float* RS  = (LAS float*)(F.lds + 150528);
    LAS bf16*  TB  = (LAS bf16*)(F.lds + 104448);
    LAS bf16*  VR  = (LAS bf16*)(F.lds + 104448);
    LAS float* CWL = (LAS float*)(F.lds + 142848);
    LAS float* DEC = (LAS float*)(F.lds + 141312);
    LAS float* BET = DEC + 128;
    LAS float* EXD = DEC + 256;
    const int tid = F.tid, lane = F.lane, w = F.wave, fr = lane & 15, fq = lane >> 4;
    const int row = tid >> 3, c0 = (tid & 7) * 16;
    const bf16* Gq = (const bf16*)(F.ws + WS_H + (size_t)5 * 32 * MiB); const bf16* Gk = (const bf16*)(F.ws + WS_H + (size_t)6 * 32 * MiB); const bf16* Gv = (const bf16*)(F.ws + WS_H + (size_t)7 * 32 * MiB);
    const float* Gab = (const float*)(F.ws + WS_GAB); const float* cw = F.in[I_CONVW];
    unsigned char* dob = (unsigned char*)F.out;
    bf16* QNg = (bf16*)(dob + DO_QN); bf16* KNTg = (bf16*)(dob + DO_KNT); float* GSC = (float*)(F.ws + WS_GSC);
    int hload = -1;
    for (int it = blockIdx.x; it < 2048; it += F.G) {
        const int h = it & 7, oc = it >> 3, tok0 = 64 * oc;
        __syncthreads();
        if (h != hload) { hload = h;
            for (int i = tid; i < 5 * 384; i += NTHR) { const int j = i / 384, r = i % 384; CWL[i] = cw[j * 3072 + (r >> 7) * 1024 + h * 128 + (r & 127)]; }
            __syncthreads(); }
        if (it + F.G < 2048 && tid < 408) { const int it2 = it + F.G, h2 = it2 & 7, oc2 = it2 >> 3; const int tz = tid / 136, rl = tid % 136, r = rl >> 1, half = rl & 1; const int tr = 64 * oc2 - 2 + r;
            if (tr >= 0 && tr < SEQ) { const bf16* src = (tz == 0 ? Gq : tz == 1 ? Gk : Gv) + (size_t)tr * HW + h2 * 128 + half * 64; unsigned tmp = *(const GAS unsigned*)src; asm volatile("" :: "v"(tmp)); } }
        if (tid < 128) { const int dir = tid >> 6, l = tid & 63, pos = dir ? 63 - l : l;
            const float a = Gab[(size_t)(tok0 + pos) * 32 + dir * 8 + h], b = Gab[(size_t)(tok0 + pos) * 32 + 16 + dir * 8 + h];
            const float x = a + F.in[I_DTB][dir * 8 + h]; const float sp = x > 20.f ? x : log1pf(__expf(x));
            float d = -__expf(F.in[I_ALOG][dir * 8 + h]) * sp;
#pragma unroll
            for (int o = 1; o < 64; o <<= 1) { const float t = __shfl_up(d, o); if (l >= o) d += t; }
            DEC[dir * 64 + pos] = d; BET[dir * 64 + pos] = sigmoidf_(b); EXD[dir * 64 + pos] = __expf(d); }
        if (!(SKIP & 64)) { float q[16], k[16], v[16];
#pragma unroll
          for (int e = 0; e < 16; ++e) { q[e] = 0.f; k[e] = 0.f; v[e] = 0.f; }
          const int ch = h * 128 + c0;
#pragma unroll
          for (int j = 0; j < ((SKIP & 1) ? 0 : 5); ++j) { const int tr = tok0 + row + j - 2;
              if (tr >= 0 && tr < SEQ) { const size_t off = (size_t)tr * HW + ch;
                  const v4u xq0 = *(const GAS v4u*)(Gq + off), xq1 = *(const GAS v4u*)(Gq + off + 8), xk0 = *(const GAS v4u*)(Gk + off), xk1 = *(const GAS v4u*)(Gk + off + 8), xv0 = *(const GAS v4u*)(Gv + off), xv1 = *(const GAS v4u*)(Gv + off + 8);
                  const unsigned wq[8] = {xq0.x, xq0.y, xq0.z, xq0.w, xq1.x, xq1.y, xq1.z, xq1.w}, wk[8] = {xk0.x, xk0.y, xk0.z, xk0.w, xk1.x, xk1.y, xk1.z, xk1.w}, wv[8] = {xv0.x, xv0.y, xv0.z, xv0.w, xv1.x, xv1.y, xv1.z, xv1.w};
                  const LAS float* cq = CWL + j * 384 + c0;
#pragma unroll
                  for (int e = 0; e < 16; ++e) { const float fq_ = (e & 1) ? bfhi(wq[e >> 1]) : bflo(wq[e >> 1]), fk_ = (e & 1) ? bfhi(wk[e >> 1]) : bflo(wk[e >> 1]), fv_ = (e & 1) ? bfhi(wv[e >> 1]) : bflo(wv[e >> 1]);
                      q[e] += cq[e] * fq_; k[e] += cq[128 + e] * fk_; v[e] += cq[256 + e] * fv_; } } }
          float sq = 0.f, sk = 0.f;
#pragma unroll
          for (int e = 0; e < 16; ++e) { q[e] = siluf_(q[e]); k[e] = siluf_(k[e]); v[e] = siluf_(v[e]); sq += q[e] * q[e]; sk += k[e] * k[e]; }
          sq += __shfl_xor(sq, 1); sq += __shfl_xor(sq, 2); sq += __shfl_xor(sq, 4); sk += __shfl_xor(sk, 1); sk += __shfl_xor(sk, 2); sk += __shfl_xor(sk, 4);
          const float rq = 0.08838834764831845f / sqrtf(sq + EPS), rk = 1.0f / sqrtf(sk + EPS);
          unsigned qo[8], ko[8];
#pragma unroll
          for (int e = 0; e < 8; ++e) { qo[e] = pk2(q[2 * e] * rq, q[2 * e + 1] * rq); ko[e] = pk2(k[2 * e] * rk, k[2 * e + 1] * rk); }
          const v4u q0 = {qo[0], qo[1], qo[2], qo[3]}, q1 = {qo[4], qo[5], qo[6], qo[7]}, k0_ = {ko[0], ko[1], ko[2], ko[3]}, k1_ = {ko[4], ko[5], ko[6], ko[7]};
          *(LAS v4u*)(QN + row * 136 + c0) = q0; *(LAS v4u*)(QN + row * 136 + c0 + 8) = q1; *(LAS v4u*)(KN + row * 136 + c0) = k0_; *(LAS v4u*)(KN + row * 136 + c0 + 8) = k1_;
          if (!(SKIP & 16)) { *(GAS v4u*)(QNg + (size_t)(tok0 + row) * HW + ch) = q0; *(GAS v4u*)(QNg + (size_t)(tok0 + row) * HW + ch + 8) = q1; }
          unsigned vo[8];
#pragma unroll
          for (int e = 0; e < 8; ++e) vo[e] = pk2(v[2 * e], v[2 * e + 1]);
          *(LAS v4u*)(VR + row * 136 + c0) = (v4u){vo[0], vo[1], vo[2], vo[3]}; *(LAS v4u*)(VR + row * 136 + c0 + 8) = (v4u){vo[4], vo[5], vo[6], vo[7]};
        }
        __syncthreads();
        { const int c = tid & 127, r0 = (tid >> 7) * 16; unsigned vw[8], kw[8];
#pragma unroll
          for (int i = 0; i < 8; ++i) { vw[i] = (unsigned)VR[(r0 + 2 * i) * 136 + c] | ((unsigned)VR[(r0 + 2 * i + 1) * 136 + c] << 16); kw[i] = (unsigned)KN[(r0 + 2 * i) * 136 + c] | ((unsigned)KN[(r0 + 2 * i + 1) * 136 + c] << 16); }
          *(LAS v4u*)(VT + c * 72 + r0) = (v4u){vw[0], vw[1], vw[2], vw[3]}; *(LAS v4u*)(VT + c * 72 + r0 + 8) = (v4u){vw[4], vw[5], vw[6], vw[7]};
          *(LAS v4u*)(KNT + c * 72 + r0) = (v4u){kw[0], kw[1], kw[2], kw[3]}; *(LAS v4u*)(KNT + c * 72 + r0 + 8) = (v4u){kw[4], kw[5], kw[6], kw[7]}; }
#pragma unroll
        for (int q2 = 0; q2 < ((SKIP & 8) ? 0 : 2); ++q2) { const int tl = 2 * w + q2, ti = tl >> 2, tj = tl & 3; f32x4 kkv = {0.f, 0.f, 0.f, 0.f}, qkv = {0.f, 0.f, 0.f, 0.f};
#pragma unroll
            for (int k0 = 0; k0 < 4; ++k0) { const bf16x8 xs = ldfrag(KN, 136, 16 * ti + fr, 32 * k0 + 8 * fq);
                kkv = mfma16(xs, ldfrag(KN, 136, 16 * tj + fr, 32 * k0 + 8 * fq), kkv); qkv = mfma16(xs, ldfrag(QN, 136, 16 * tj + fr, 32 * k0 + 8 * fq), qkv); }
            int fr2 = lane & 15, fq2 = lane >> 4; asm volatile("" : "+v"(fr2), "+v"(fq2));
            const int t = 16 * tj + fr2, s0 = 16 * ti + 4 * fq2;
#pragma unroll
            for (int dir = 0; dir < 2; ++dir) { const float dt = DEC[dir * 64 + t], bt = BET[dir * 64 + t]; f32x4 aq, av;
#pragma unroll
                for (int r = 0; r < 4; ++r) { const int s = s0 + r; const bool before = dir ? (s > t) : (s < t), beq = before || (s == t);
                    const float e = beq ? __expf(dt - DEC[dir * 64 + s]) : 0.f;
                    av[r] = before ? bt * kkv[r] * e : 0.f; aq[r] = qkv[r] * e;
                    if (ti == tj) AD[(dir * 4 + (dir ? 3 - ti : ti)) * 256 + (dir ? (15 - (s & 15)) * 16 + (15 - fr2) : (s & 15) * 16 + fr2)] = av[r]; }
                *(LAS v2u*)(AB + dir * 64 * 72 + (dir ? (63 - t) * 72 + 60 - s0 : t * 72 + s0)) = dir ? pack4((f32x4){av[3], av[2], av[1], av[0]}) : pack4(av);
                bf16* AQg = (bf16*)(dob + (dir ? DO_AQKB : DO_AQKF));
                if (!(SKIP & 16)) *(GAS v2u*)(AQg + ((size_t)(h * 256 + oc) * 64 + t) * 64 + s0) = pack4(aq); } }
        __syncthreads();
        if (SKIP & 32) {} else if (w < 2) { const int dir = w; int c = lane; asm volatile("" : "+v"(c));
            const LAS bf16* ABd = AB + dir * 64 * 72; LAS bf16* TT = TB + (dir * 2 + 1) * 64 * 72; LAS float* RSd = RS + dir * 1024; const LAS float* ADd = AD + dir * 1024;
#pragma unroll
            for (int q = 0; q < 9; ++q) *(LAS v4u*)(TT + (q * 64 + c) * 8) = (v4u){0u, 0u, 0u, 0u};
            int fr3 = c & 15, fq3 = c >> 4;
            float t[64];
#pragma unroll
            for (int bi = 0; bi < 4; ++bi) { float r[16];
#pragma unroll
                for (int ii = 0; ii < 16; ++ii) r[ii] = (16 * bi + ii == c) ? 1.f : 0.f;
                if (!(SKIP & 2)) {
                if (bi > 0) {
#pragma unroll
                    for (int ct = 0; ct < 4; ++ct) { f32x4 d = {0.f, 0.f, 0.f, 0.f};
#pragma unroll
                        for (int ks = 0; ks < (16 * bi + 31) / 32; ++ks) d = mfma16(ldfrag(ABd, 72, 16 * bi + fr3, 32 * ks + 8 * fq3), ldfrag(TT, 72, 16 * ct + fr3, 32 * ks + 8 * fq3), d);
                        *(LAS f32x4*)(RSd + (16 * ct + fr3) * 16 + 4 * fq3) = d; }
                    __builtin_amdgcn_sched_barrier(0);
                    f32x4 o4[4];
#pragma unroll
                    for (int q4 = 0; q4 < 4; ++q4) o4[q4] = *(const LAS f32x4*)(RSd + c * 16 + 4 * q4);
#pragma unroll
                    for (int q4 = 0; q4 < 4; ++q4) { r[4 * q4] -= o4[q4][0]; r[4 * q4 + 1] -= o4[q4][1]; r[4 * q4 + 2] -= o4[q4][2]; r[4 * q4 + 3] -= o4[q4][3]; }
                }
#pragma unroll
                for (int jg = 0; jg < 4; ++jg) { f32x4 av[4][4];
#pragma unroll
                    for (int jq = 0; jq < 4; ++jq)
#pragma unroll
                        for (int q4 = jg; q4 < 4; ++q4) av[jq][q4] = *(const LAS f32x4*)(ADd + bi * 256 + (4 * jg + jq) * 16 + 4 * q4);
                    __builtin_amdgcn_sched_barrier(0);
#pragma unroll
                    for (int jq = 0; jq < 4; ++jq) { const int jj = 4 * jg + jq; t[16 * bi + jj] = r[jj];
#pragma unroll
                        for (int q4 = jg; q4 < 4; ++q4)
#pragma unroll
                            for (int e = 0; e < 4; ++e) if (4 * q4 + e > jj) r[4 * q4 + e] -= av[jq][q4][e] * r[jj]; }
                    __builtin_amdgcn_sched_barrier(0); }
                if (bi < 3) { unsigned tw[8];
#pragma unroll
                    for (int e = 0; e < 8; ++e) tw[e] = pk2(t[16 * bi + 2 * e], t[16 * bi + 2 * e + 1]);
                    *(LAS v4u*)(TT + c * 72 + 16 * bi) = (v4u){tw[0], tw[1], tw[2], tw[3]}; *(LAS v4u*)(TT + c * 72 + 16 * bi + 8) = (v4u){tw[4], tw[5], tw[6], tw[7]}; }
                } else {
#pragma unroll
                for (int jj = 0; jj < 16; ++jj) t[16 * bi + jj] = r[jj]; }
            }
            const int tc = dir ? 63 - c : c; const float bc = BET[dir * 64 + tc], bd = bc * EXD[dir * 64 + tc];
            LAS bf16* T0 = TB + (dir * 2 + 0) * 64 * 72 + tc + (dir ? 63 * 72 : 0); const int tstep = dir ? -72 : 72;
#pragma unroll
            for (int i = 0; i < 64; ++i) { T0[i * tstep] = (bf16)f2bf(t[i] * bc); T0[64 * 72 + i * tstep] = (bf16)f2bf(t[i] * bd); }
        } else {
            for (int idx = tid - 128; idx < ((SKIP & 16) ? 0 : 1024); idx += 384) { const int r = idx >> 3, c8 = idx & 7; *(GAS v4u*)(KNTg + ((size_t)(h * 256 + oc) * 128 + r) * 64 + c8 * 8) = *(const LAS v4u*)(KNT + r * 72 + c8 * 8); }
            if (tid >= 128 && tid < 256) { const int dir = (tid - 128) >> 6, t = tid & 63; const float dl = dir ? DEC[64] : DEC[63];
                float* g = GSC + (size_t)((dir * 8 + h) * 256 + oc) * 192; g[t] = EXD[dir * 64 + t]; g[64 + t] = __expf(dl - DEC[dir * 64 + t]); if (t == 0) g[128] = __expf(dl); }
        }
        __syncthreads();
#pragma unroll 1
        for (int n = 0; n < ((SKIP & 4) ? 0 : 16); ++n) { const int qi = w * 16 + n, dir = qi >> 6, kind = (qi >> 5) & 1, idx = qi & 31; f32x4 acc = {0.f, 0.f, 0.f, 0.f};
            const LAS bf16* Tm = TB + (dir * 2 + kind) * 64 * 72; const size_t cb = (size_t)(h * 256 + oc) * 8192;
            if (kind == 0) { const int ti = idx >> 3, vj = idx & 7;
#pragma unroll
                for (int s0 = 0; s0 < 2; ++s0) acc = mfma16(ldfrag(Tm, 72, 16 * ti + fr, 32 * s0 + 8 * fq), ldfrag(VT, 72, 16 * vj + fr, 32 * s0 + 8 * fq), acc);
                bf16* U = (bf16*)(F.ws + (dir ? WS_UTB : WS_UTF)); if (!(SKIP & 16)) *(GAS v2u*)(U + cb + (16 * vj + fr) * 64 + 16 * ti + 4 * fq) = pack4(acc);
            } else { const int ki = idx >> 2, tj = idx & 3;
#pragma unroll
                for (int s0 = 0; s0 < 2; ++s0) acc = mfma16(ldfrag(KNT, 72, 16 * ki + fr, 32 * s0 + 8 * fq), ldfrag(Tm, 72, 16 * tj + fr, 32 * s0 + 8 * fq), acc);
                bf16* W = (bf16*)(F.ws + (dir ? WS_WB : WS_WF)); if (!(SKIP & 16)) *(GAS v2u*)(W + cb + (16 * tj + fr) * 128 + 16 * ki + 4 * fq) = pack4(acc); }
        }
    }
}
__device__ __forceinline__ void gdn_load_tiles(const unsigned char* ws, const unsigned char* dob, int tid, int dir, int hd, int h, int oc, bool pass3, v4u (&rw)[2], v4u (&rq)[2], v4u (&ru)[2], v4u (&rk)[2], v4u& ra, float& rs) {
    const size_t cb = (size_t)(h * 256 + oc);
    const int row = tid >> 3, c0 = (tid & 7) * 16, vrow = tid >> 2, t0 = (tid & 3) * 16;
    const bf16* W = (const bf16*)(ws + (dir ? WS_WB : WS_WF)) + cb * 8192 + row * 128 + c0; rw[0] = *(const GAS v4u*)W; rw[1] = *(const GAS v4u*)(W + 8);
    const bf16* U = (const bf16*)(ws + (dir ? WS_UTB : WS_UTF)) + cb * 8192 + vrow * 64 + t0; ru[0] = *(const GAS v4u*)U; ru[1] = *(const GAS v4u*)(U + 8);
    const bf16* Kt = (const bf16*)(dob + DO_KNT) + (size_t)(h * 256 + oc) * 8192 + vrow * 64 + t0; rk[0] = *(const GAS v4u*)Kt; rk[1] = *(const GAS v4u*)(Kt + 8);
    if (pass3) {
        const bf16* Q = (const bf16*)(dob + DO_QN) + (size_t)(64 * oc + row) * HW + h * 128 + c0; rq[0] = *(const GAS v4u*)Q; rq[1] = *(const GAS v4u*)(Q + 8);
        const bf16* A = (const bf16*)(dob + (dir ? DO_AQKB : DO_AQKF)) + cb * 4096 + row * 64 + (tid & 7) * 8; ra = *(const GAS v4u*)A;
    }
    rs = (tid < 192) ? ((const float*)(ws + WS_GSC))[(size_t)(hd * 256 + oc) * 192 + tid] : 0.f;
}
#define SCHED_FENCE() __builtin_amdgcn_sched_barrier(0)
template <bool PASS3, bool UREAL>
__device__ __forceinline__ void gdn_tile(f32x4 (&A)[8], const LAS bf16* WTL, const LAS bf16* QNL, const LAS bf16* UTL, const LAS bf16* KTL, const LAS bf16* AQL, const LAS float* SCL,
                                         LAS bf16* ST, LAS bf16* VN, LAS bf16* VNS, int w, int fr, int fq, float gl, bf16* Ogc) {
#pragma unroll
    for (int kt = 0; kt < 8; ++kt) *(LAS v2u*)(ST + fr * 136 + 16 * kt + 4 * fq) = pack4(A[kt]);
    asm volatile("" ::: "memory");
    bf16x8 xs[4];
#pragma unroll
    for (int k0 = 0; k0 < 4; ++k0) xs[k0] = ldfrag(ST, 136, fr, 32 * k0 + 8 * fq);
#pragma unroll
    for (int th = 0; th < 2; ++th) { bf16x8 wf[2][4]; f32x4 acc[2]; v2u uw[2]; f32x4 es[2];
#pragma unroll
      for (int tq = 0; tq < 2; ++tq) { const int tt = 2 * th + tq;
#pragma unroll
          for (int k0 = 0; k0 < 4; ++k0) wf[tq][k0] = ldfrag(WTL, 136, 16 * tt + fr, 32 * k0 + 8 * fq);
          if (UREAL) uw[tq] = *(const LAS v2u*)(UTL + (16 * w + fr) * 72 + 16 * tt + 4 * fq);
          es[tq] = *(const LAS f32x4*)(SCL + 64 + 16 * tt + 4 * fq); acc[tq] = (f32x4){0.f, 0.f, 0.f, 0.f}; }
      SCHED_FENCE();
#pragma unroll
      for (int k0 = 0; k0 < 4; ++k0)
#pragma unroll
          for (int tq = 0; tq < 2; ++tq) acc[tq] = mfma16(wf[tq][k0], xs[k0], acc[tq]);
      SCHED_FENCE();
#pragma unroll
      for (int tq = 0; tq < 2; ++tq) { const int tt = 2 * th + tq; f32x4 u4 = {0.f, 0.f, 0.f, 0.f};
          if (UREAL) u4 = (f32x4){bflo(uw[tq].x), bfhi(uw[tq].x), bflo(uw[tq].y), bfhi(uw[tq].y)};
          const f32x4 vn = u4 - acc[tq];
          if (PASS3) *(LAS v2u*)(VN + fr * 72 + 16 * tt + 4 * fq) = pack4(vn);
          *(LAS v2u*)(VNS + fr * 72 + 16 * tt + 4 * fq) = pack4(vn * es[tq]); }
      SCHED_FENCE(); }
    asm volatile("" ::: "memory");
    if (PASS3) { bf16x8 yv[2];
#pragma unroll
        for (int s0 = 0; s0 < 2; ++s0) yv[s0] = ldfrag(VN, 72, fr, 32 * s0 + 8 * fq);
#pragma unroll
        for (int th = 0; th < 2; ++th) { bf16x8 qf[2][4], af[2][2]; f32x4 acc[2]; float ed[2];
#pragma unroll
            for (int tq = 0; tq < 2; ++tq) { const int tt = 2 * th + tq;
#pragma unroll
                for (int k0 = 0; k0 < 4; ++k0) qf[tq][k0] = ldfrag(QNL, 136, 16 * tt + fr, 32 * k0 + 8 * fq);
#pragma unroll
                for (int s0 = 0; s0 < 2; ++s0) af[tq][s0] = ldfrag(AQL, 72, 16 * tt + fr, 32 * s0 + 8 * fq);
                ed[tq] = SCL[16 * tt + fr]; acc[tq] = (f32x4){0.f, 0.f, 0.f, 0.f}; }
            SCHED_FENCE();
#pragma unroll
            for (int k0 = 0; k0 < 4; ++k0)
#pragma unroll
                for (int tq = 0; tq < 2; ++tq) acc[tq] = mfma16(xs[k0], qf[tq][k0], acc[tq]);
#pragma unroll
            for (int tq = 0; tq < 2; ++tq) acc[tq] = acc[tq] * ed[tq];
#pragma unroll
            for (int s0 = 0; s0 < 2; ++s0)
#pragma unroll
                for (int tq = 0; tq < 2; ++tq) acc[tq] = mfma16(yv[s0], af[tq][s0], acc[tq]);
            SCHED_FENCE();
#pragma unroll
            for (int tq = 0; tq < 2; ++tq) *(GAS v2u*)(Ogc + (size_t)(16 * (2 * th + tq) + fr) * HW + 16 * w + 4 * fq) = pack4(acc[tq]);
            SCHED_FENCE(); } }
    { bf16x8 ys[2];
#pragma unroll
      for (int s0 = 0; s0 < 2; ++s0) ys[s0] = ldfrag(VNS, 72, fr, 32 * s0 + 8 * fq);
#pragma unroll
      for (int kh = 0; kh < 2; ++kh) { bf16x8 kf[4][2];
#pragma unroll
          for (int kq = 0; kq < 4; ++kq)
#pragma unroll
              for (int s0 = 0; s0 < 2; ++s0) kf[kq][s0] = ldfrag(KTL, 72, 16 * (4 * kh + kq) + fr, 32 * s0 + 8 * fq);
#pragma unroll
          for (int kq = 0; kq < 4; ++kq) A[4 * kh + kq] = A[4 * kh + kq] * gl;
          SCHED_FENCE();
#pragma unroll
          for (int s0 = 0; s0 < 2; ++s0)
#pragma unroll
              for (int kq = 0; kq < 4; ++kq) A[4 * kh + kq] = mfma16(kf[kq][s0], ys[s0], A[4 * kh + kq]);
          SCHED_FENCE(); } }
}
template <bool PASS3, int SKIP = 0>
__device__ __forceinline__ void gdn_pass(Frame& F) {
    LAS bf16*  WTL = (LAS bf16*)(F.lds + 0);
    LAS bf16*  QNL = (LAS bf16*)(F.lds + 17408);
    LAS bf16*  UTL = (LAS bf16*)(F.lds + 34816);
    LAS bf16*  KTL = (LAS bf16*)(F.lds + 53248);
    LAS bf16*  AQL = (LAS bf16*)(F.lds + 71680);
    LAS float* SCL = (LAS float*)(F.lds + 80896);
    LAS bf16*  PX  = (LAS bf16*)(F.lds + 0);
    const int tid = F.tid, lane = F.lane, w = F.wave, fr = lane & 15, fq = lane >> 4;
    LAS bf16* ST  = (LAS bf16*)(F.lds + 81920 + w * 8960);
    LAS bf16* VN  = ST + 16 * 136;
    LAS bf16* VNS = VN + 16 * 72;
    const int row = tid >> 3, c0 = (tid & 7) * 16, vrow = tid >> 2, t0 = (tid & 3) * 16;
    const unsigned char* dob = (const unsigned char*)F.out;
    float* GL = (float*)(F.ws + WS_GL); bf16* GP = (bf16*)(F.ws + WS_GP);
    for (int it = blockIdx.x; it < 256; it += F.G) {
        const int hd = it >> 4, sg = it & 15, dir = hd >> 3, h = hd & 7;
        bf16* Og = (bf16*)(F.ws + (dir ? WS_OGB : WS_OGF));
        f32x4 Sacc[8], Pacc[8];
        int dgi = 16 * w + fr - 4 * fq; asm volatile("" : "+v"(dgi));
#pragma unroll
        for (int kt = 0; kt < 8; ++kt) { Sacc[kt] = (f32x4){0.f, 0.f, 0.f, 0.f};
#pragma unroll
            for (int r = 0; r < 4; ++r) Pacc[kt][r] = (!PASS3 && (16 * kt + r == dgi)) ? 1.f : 0.f; }
        __syncthreads();
        if (PASS3) {
            for (int p = 0; p < sg; ++p) { const int ip = hd * 16 + p;
                { const bf16* src = GP + (size_t)ip * 16384 + vrow * 128 + (tid & 3) * 32;
#pragma unroll
                  for (int q = 0; q < 4; ++q) *(LAS v4u*)(PX + vrow * 136 + (tid & 3) * 32 + 8 * q) = *(const GAS v4u*)(src + 8 * q); }
#pragma unroll
                for (int kt = 0; kt < 8; ++kt) *(LAS v2u*)(ST + fr * 136 + 16 * kt + 4 * fq) = pack4(Sacc[kt]);
                __syncthreads();
                bf16x8 xs[4];
#pragma unroll
                for (int k0 = 0; k0 < 4; ++k0) xs[k0] = ldfrag(ST, 136, fr, 32 * k0 + 8 * fq);
#pragma unroll
                for (int kh = 0; kh < 2; ++kh) { bf16x8 pf[4][4]; f32x4 acc[4];
#pragma unroll
                    for (int kq = 0; kq < 4; ++kq) { const int kt = 4 * kh + kq; acc[kq] = *(const GAS f32x4*)(GL + ((size_t)((ip * 8 + w) * 8 + kt) * 64 + lane) * 4);
#pragma unroll
                        for (int k0 = 0; k0 < 4; ++k0) pf[kq][k0] = ldfrag(PX, 136, 16 * kt + fr, 32 * k0 + 8 * fq); }
                    SCHED_FENCE();
#pragma unroll
                    for (int k0 = 0; k0 < 4; ++k0)
#pragma unroll
                        for (int kq = 0; kq < 4; ++kq) acc[kq] = mfma16(pf[kq][k0], xs[k0], acc[kq]);
                    SCHED_FENCE();
#pragma unroll
                    for (int kq = 0; kq < 4; ++kq) Sacc[4 * kh + kq] = acc[kq]; }
                __syncthreads();
            }
        }
        v4u rw[2], rq[2], ru[2], rk[2], ra; float rs;
        gdn_load_tiles(F.ws, dob, tid, dir, hd, h, dir ? 255 - sg * 16 : sg * 16, PASS3, rw, rq, ru, rk, ra, rs);
        for (int ci = 0; ci < CPS; ++ci) {
            const int sc = sg * 16 + ci, oc = dir ? 255 - sc : sc, tok0 = 64 * oc;
            *(LAS v4u*)(WTL + row * 136 + c0) = rw[0]; *(LAS v4u*)(WTL + row * 136 + c0 + 8) = rw[1];
            *(LAS v4u*)(UTL + vrow * 72 + t0) = ru[0]; *(LAS v4u*)(UTL + vrow * 72 + t0 + 8) = ru[1];
            *(LAS v4u*)(KTL + vrow * 72 + t0) = rk[0]; *(LAS v4u*)(KTL + vrow * 72 + t0 + 8) = rk[1];
            if (PASS3) { *(LAS v4u*)(QNL + row * 136 + c0) = rq[0]; *(LAS v4u*)(QNL + row * 136 + c0 + 8) = rq[1]; *(LAS v4u*)(AQL + row * 72 + (tid & 7) * 8) = ra; }
            if (tid < 192) SCL[tid] = rs;
            __syncthreads();
            if (ci + 1 < CPS && !(SKIP & 1)) gdn_load_tiles(F.ws, dob, tid, dir, hd, h, dir ? oc - 1 : oc + 1, PASS3, rw, rq, ru, rk, ra, rs);
            const float gl = SCL[128];
            gdn_tile<PASS3, true>(Sacc, WTL, QNL, UTL, KTL, AQL, SCL, ST, VN, VNS, w, fr, fq, gl, Og + (size_t)tok0 * HW + h * 128);
            if (!PASS3) gdn_tile<PASS3, false>(Pacc, WTL, QNL, UTL, KTL, AQL, SCL, ST, VN, VNS, w, fr, fq, gl, Og);
            __syncthreads();
        }
        if (!PASS3) {
            int pofs = (4 * fq) * 128 + 16 * w + fr; asm volatile("" : "+v"(pofs));
            bf16* gp = GP + (size_t)it * 16384 + pofs;
#pragma unroll
            for (int kt = 0; kt < 8; ++kt) { *(GAS f32x4*)(GL + ((size_t)((it * 8 + w) * 8 + kt) * 64 + lane) * 4) = Sacc[kt];
#pragma unroll
                for (int r = 0; r < 4; ++r) gp[(16 * kt + r) * 128] = (bf16)f2bf(Pacc[kt][r]); }
        }
    }
}
__device__ __forceinline__ void p7_mix(Frame& F) {
    const int gw = F.vcu * NWAVES + F.wave, NGW = F.G * NWAVES, lane = F.lane;
    const int e0 = (lane & 7) * 16, col = (lane >> 3) * 128 + e0;
    for (int m = gw; m < SEQ; m += NGW) {
#pragma unroll
        for (int mx = 0; mx < 2; ++mx) {
            const bf16* of = (const bf16*)(F.ws + (mx ? WS_OGF : WS_OHF)); const bf16* ob = (const bf16*)(F.ws + (mx ? WS_OGB : WS_OHB));
            const bf16* gt = (const bf16*)(F.ws + WS_H + (size_t)(mx ? 8 : 4) * 32 * MiB); const float* nw = F.in[mx ? I_GNW : I_HNW];
            bf16* yo = (bf16*)(F.ws + (mx ? WS_YB : WS_YA));
            const size_t off = (size_t)m * HW + col;
            const v4u a0 = *(const GAS v4u*)(of + off), a1 = *(const GAS v4u*)(of + off + 8), b0 = *(const GAS v4u*)(ob + off), b1 = *(const GAS v4u*)(ob + off + 8), g0 = *(const GAS v4u*)(gt + off), g1 = *(const GAS v4u*)(gt + off + 8);
            const unsigned aw[8] = {a0.x, a0.y, a0.z, a0.w, a1.x, a1.y, a1.z, a1.w}, bw[8] = {b0.x, b0.y, b0.z, b0.w, b1.x, b1.y, b1.z, b1.w}, gw_[8] = {g0.x, g0.y, g0.z, g0.w, g1.x, g1.y, g1.z, g1.w};
            float gf[16];
#pragma unroll
            for (int e = 0; e < 8; ++e) { gf[2 * e] = bflo(gw_[e]); gf[2 * e + 1] = bfhi(gw_[e]); }
            float o[16]; float ss = 0.f;
#pragma unroll
            for (int e = 0; e < 8; ++e) { o[2 * e] = bflo(aw[e]) + bflo(bw[e]); o[2 * e + 1] = bfhi(aw[e]) + bfhi(bw[e]); ss += o[2 * e] * o[2 * e] + o[2 * e + 1] * o[2 * e + 1]; }
            ss += __shfl_xor(ss, 1); ss += __shfl_xor(ss, 2); ss += __shfl_xor(ss, 4);
            const float r = 1.0f / sqrtf(ss * (1.f / 128.f) + EPS);
            if (QM_MIX == 2) { float yv[16]; float am = 0.f;
#pragma unroll
                for (int e = 0; e < 8; ++e) { yv[2 * e] = o[2 * e] * r * nw[e0 + 2 * e] * gf[2 * e]; yv[2 * e + 1] = o[2 * e + 1] * r * nw[e0 + 2 * e + 1] * gf[2 * e + 1]; am = fmaxf(am, fmaxf(fabsf(yv[2 * e]), fabsf(yv[2 * e + 1]))); }
                am = wave_max(am); const float inv = am > 0.f ? 127.0f / am : 0.f;
                *(GAS v4u*)((unsigned char*)yo + off) = (v4u){pk4i8((f32x4){yv[0], yv[1], yv[2], yv[3]}, inv), pk4i8((f32x4){yv[4], yv[5], yv[6], yv[7]}, inv), pk4i8((f32x4){yv[8], yv[9], yv[10], yv[11]}, inv), pk4i8((f32x4){yv[12], yv[13], yv[14], yv[15]}, inv)};
                if (lane == 0) ((float*)(F.ws + WS_QX))[(1 + mx) * SEQ + m] = am > 0.f ? am * (1.0f / 127.0f) : 1.0f; }
            else if (QM_MIX == 1) { unsigned yq[4];
#pragma unroll
                for (int e = 0; e < 4; ++e) yq[e] = pk4f8(o[4 * e] * r * nw[e0 + 4 * e] * gf[4 * e], o[4 * e + 1] * r * nw[e0 + 4 * e + 1] * gf[4 * e + 1], o[4 * e + 2] * r * nw[e0 + 4 * e + 2] * gf[4 * e + 2], o[4 * e + 3] * r * nw[e0 + 4 * e + 3] * gf[4 * e + 3]);
                *(GAS v4u*)((unsigned char*)yo + off) = (v4u){yq[0], yq[1], yq[2], yq[3]}; }
            else { unsigned yw[8];
#pragma unroll
            for (int e = 0; e < 8; ++e) yw[e] = pk2(o[2 * e] * r * nw[e0 + 2 * e] * gf[2 * e], o[2 * e + 1] * r * nw[e0 + 2 * e + 1] * gf[2 * e + 1]);
            *(GAS v4u*)(yo + off) = (v4u){yw[0], yw[1], yw[2], yw[3]}; *(GAS v4u*)(yo + off + 8) = (v4u){yw[4], yw[5], yw[6], yw[7]}; }
        }
    }
    for (int tb = 0; tb < 2; ++tb) { const float* src = F.in[tb ? I_PV : I_PU]; unsigned char* dst = F.ws + (tb ? WS_TV : WS_TU); float* scl = (float*)(F.ws + WS_PSC) + tb * 16384;
        for (int r = gw; r < 16384; r += NGW) { const float* row = src + (size_t)r * DM; f32x4 v[8]; float mx = 0.f;
#pragma unroll
            for (int q = 0; q < 8; ++q) { v[q] = *(const GAS f32x4*)(row + (tb ? (q >> 2) * 1024 + lane * 16 + 4 * (q & 3) : lane * 32 + 4 * q)); const f32x4 a = __builtin_elementwise_abs(v[q]); mx = fmaxf(mx, fmaxf(fmaxf(a.x, a.y), fmaxf(a.z, a.w))); }
            mx = wave_max(mx);
            const float sc = mx > 0.f ? mx * (tb ? ((VFMT == 6 || VFMT == 64) ? 1.0f / 7.5f : VFMT == 4 ? 1.0f / 6.0f : 1.0f / 256.0f) : 1.0f / 127.0f) : 1.0f, inv = 1.0f / sc;
            if (tb && VFMT == 4) { unsigned w4[4];
#pragma unroll
                for (int d = 0; d < 4; ++d) { unsigned ww = 0u;
                    ww = __builtin_amdgcn_cvt_scalef32_pk_fp4_f32(ww, v[2 * d].x * inv, v[2 * d].y * inv, 1.0f, 0); ww = __builtin_amdgcn_cvt_scalef32_pk_fp4_f32(ww, v[2 * d].z * inv, v[2 * d].w * inv, 1.0f, 1);
                    ww = __builtin_amdgcn_cvt_scalef32_pk_fp4_f32(ww, v[2 * d + 1].x * inv, v[2 * d + 1].y * inv, 1.0f, 2); ww = __builtin_amdgcn_cvt_scalef32_pk_fp4_f32(ww, v[2 * d + 1].z * inv, v[2 * d + 1].w * inv, 1.0f, 3); w4[d] = ww; }
                *(GAS v4u*)(dst + (size_t)r * TV_PITCH + lane * 16) = (v4u){w4[0], w4[1], w4[2], w4[3]};
                if (lane == 0) scl[r] = sc;
                continue; }
            if (!tb && P11B_DIRECT && UFMT == 4) { const float sc4 = mx > 0.f ? mx * (1.0f / 6.0f) : 1.0f, inv4 = 1.0f / sc4; unsigned w4[4];
#pragma unroll
                for (int d = 0; d < 4; ++d) { unsigned ww = 0u; const f32x4 lo = v[d], hi = v[4 + d];
                    if (U4_SWAP) { ww = __builtin_amdgcn_cvt_scalef32_pk_fp4_f32(ww, hi.x * inv4, lo.x * inv4, 1.0f, 0); ww = __builtin_amdgcn_cvt_scalef32_pk_fp4_f32(ww, hi.y * inv4, lo.y * inv4, 1.0f, 1); ww = __builtin_amdgcn_cvt_scalef32_pk_fp4_f32(ww, hi.z * inv4, lo.z * inv4, 1.0f, 2); ww = __builtin_amdgcn_cvt_scalef32_pk_fp4_f32(ww, hi.w * inv4, lo.w * inv4, 1.0f, 3); }
                    else { ww = __builtin_amdgcn_cvt_scalef32_pk_fp4_f32(ww, lo.x * inv4, hi.x * inv4, 1.0f, 0); ww = __builtin_amdgcn_cvt_scalef32_pk_fp4_f32(ww, lo.y * inv4, hi.y * inv4, 1.0f, 1); ww = __builtin_amdgcn_cvt_scalef32_pk_fp4_f32(ww, lo.z * inv4, hi.z * inv4, 1.0f, 2); ww = __builtin_amdgcn_cvt_scalef32_pk_fp4_f32(ww, lo.w * inv4, hi.w * inv4, 1.0f, 3); }
                    w4[d] = ww; }
                *(GAS v4u*)(dst + (size_t)r * 1024 + lane * 16) = (v4u){w4[0], w4[1], w4[2], w4[3]};
                if (lane == 0) scl[r] = sc4;
                continue; }
            if (!tb && P11B_DIRECT) { const float sc6 = mx > 0.f ? mx * (1.0f / 7.5f) : 1.0f, inv6 = 1.0f / sc6; v16f a16, b16;
#pragma unroll
                for (int q = 0; q < 4; ++q) { a16[4 * q] = v[q].x * inv6; a16[4 * q + 1] = v[q].y * inv6; a16[4 * q + 2] = v[q].z * inv6; a16[4 * q + 3] = v[q].w * inv6;
                    b16[4 * q] = v[4 + q].x * inv6; b16[4 * q + 1] = v[4 + q].y * inv6; b16[4 * q + 2] = v[4 + q].z * inv6; b16[4 * q + 3] = v[4 + q].w * inv6; }
                const v6u pk = __builtin_amdgcn_cvt_scalef32_2xpk16_fp6_f32(a16, b16, 1.0f);
                *(GAS v4u*)(dst + (size_t)r * 1536 + lane * 16) = (v4u){pk[0], pk[1], pk[2], pk[3]}; *(GAS v2u*)(dst + (size_t)r * 1536 + 1024 + lane * 8) = (v2u){pk[4], pk[5]};
                if (lane == 0) scl[r] = sc6;
                continue; }
            if (tb && VFMT == 64) { unsigned w4[4]; const float inv4 = inv * (6.0f / 7.5f);
#pragma unroll
                for (int d = 0; d < 4; ++d) { unsigned ww = 0u;
                    ww = __builtin_amdgcn_cvt_scalef32_pk_fp4_f32(ww, v[d].x * inv4, v[4 + d].x * inv4, 1.0f, 0); ww = __builtin_amdgcn_cvt_scalef32_pk_fp4_f32(ww, v[d].y * inv4, v[4 + d].y * inv4, 1.0f, 1);
                    ww = __builtin_amdgcn_cvt_scalef32_pk_fp4_f32(ww, v[d].z * inv4, v[4 + d].z * inv4, 1.0f, 2); ww = __builtin_amdgcn_cvt_scalef32_pk_fp4_f32(ww, v[d].w * inv4, v[4 + d].w * inv4, 1.0f, 3); w4[d] = ww; }
                *(GAS v4u*)(F.ws + WS_TV4 + (size_t)r * 1024 + lane * 16) = (v4u){w4[0], w4[1], w4[2], w4[3]}; }
            if (tb && (VFMT == 6 || VFMT == 64)) { v16f a16, b16;
#pragma unroll
                for (int q = 0; q < 4; ++q) { a16[4 * q] = v[q].x * inv; a16[4 * q + 1] = v[q].y * inv; a16[4 * q + 2] = v[q].z * inv; a16[4 * q + 3] = v[q].w * inv;
                    b16[4 * q] = v[4 + q].x * inv; b16[4 * q + 1] = v[4 + q].y * inv; b16[4 * q + 2] = v[4 + q].z * inv; b16[4 * q + 3] = v[4 + q].w * inv; }
                const v6u pk = __builtin_amdgcn_cvt_scalef32_2xpk16_fp6_f32(a16, b16, 1.0f);
                *(GAS v4u*)(dst + (size_t)r * TV_PITCH + lane * 16) = (v4u){pk[0], pk[1], pk[2], pk[3]}; *(GAS v2u*)(dst + (size_t)r * TV_PITCH + 1024 + lane * 8) = (v2u){pk[4], pk[5]};
                if (lane == 0) scl[r] = sc;
                continue; }
            unsigned w[8];
#pragma unroll
            for (int q = 0; q < 8; ++q) { const f32x4 x = v[q];
                if (tb) w[q] = pk4f8(x.x * inv, x.y * inv, x.z * inv, x.w * inv);
                else { const int a = (int)rintf(x.x * inv), b = (int)rintf(x.y * inv), c = (int)rintf(x.z * inv), d = (int)rintf(x.w * inv);
                    w[q] = (unsigned)(a & 255) | ((unsigned)(b & 255) << 8) | ((unsigned)(c & 255) << 16) | ((unsigned)(d & 255) << 24); } }
            if (tb) { *(GAS v4u*)(dst + (size_t)r * DM + lane * 16) = (v4u){w[0], w[1], w[2], w[3]}; *(GAS v4u*)(dst + (size_t)r * DM + 1024 + lane * 16) = (v4u){w[4], w[5], w[6], w[7]}; }
            else { GAS v4u* o = (GAS v4u*)(dst + ((size_t)lane * 16384 + r) * 32); o[0] = (v4u){w[0], w[1], w[2], w[3]}; o[1] = (v4u){w[4], w[5], w[6], w[7]}; }
            if (lane == 0) scl[r] = sc; } }
}
constexpr size_t WS_XQ = 80 * MiB;
constexpr size_t WS_SXR = 112 * MiB;
constexpr size_t WS_EID = 113 * MiB, WS_GATE = 121 * MiB, WS_AV = 129 * MiB;
constexpr size_t WS_REC = 208 * MiB;
constexpr int NET = 32, ETSZ = 512, NBUCK = 16 * NET, REC_CAP = 16384, CW_CNT = 8192, CW_Q = 8192 + 16 * NBUCK;
__device__ __forceinline__ unsigned fkey(float f) { const unsigned u = __builtin_bit_cast(unsigned, f); return (u & 0x80000000u) ? ~u : (u | 0x80000000u); }
__device__ __forceinline__ float gelu_erf(float x) { return 0.5f * x * (1.0f + erff(x * 0.70710678118654752f)); }

__device__ __forceinline__ float key_val(unsigned k, unsigned mask) { unsigned u = k & ~mask; u = (u & 0x80000000u) ? (u & 0x7fffffffu) : ~u; return __builtin_bit_cast(float, u); }
#define SN_CE(x, y) do { const unsigned sn_h = (x) > (y) ? (x) : (y); (y) = (x) > (y) ? (y) : (x); (x) = sn_h; } while (0)
#define SN_SORT16(k) do { SN_CE(k[0], k[1]); SN_CE(k[2], k[3]); SN_CE(k[0], k[2]); SN_CE(k[1], k[3]); SN_CE(k[1], k[2]); SN_CE(k[4], k[5]); SN_CE(k[6], k[7]); SN_CE(k[4], k[6]); SN_CE(k[5], k[7]); SN_CE(k[5], k[6]); SN_CE(k[0], k[4]); SN_CE(k[2], k[6]); SN_CE(k[2], k[4]); SN_CE(k[1], k[5]); SN_CE(k[3], k[7]); SN_CE(k[3], k[5]); SN_CE(k[1], k[2]); SN_CE(k[3], k[4]); SN_CE(k[5], k[6]); SN_CE(k[8], k[9]); SN_CE(k[10], k[11]); SN_CE(k[8], k[10]); SN_CE(k[9], k[11]); SN_CE(k[9], k[10]); SN_CE(k[12], k[13]); SN_CE(k[14], k[15]); SN_CE(k[12], k[14]); SN_CE(k[13], k[15]); SN_CE(k[13], k[14]); SN_CE(k[8], k[12]); SN_CE(k[10], k[14]); SN_CE(k[10], k[12]); SN_CE(k[9], k[13]); SN_CE(k[11], k[15]); SN_CE(k[11], k[13]); SN_CE(k[9], k[10]); SN_CE(k[11], k[12]); SN_CE(k[13], k[14]); SN_CE(k[0], k[8]); SN_CE(k[4], k[12]); SN_CE(k[4], k[8]); SN_CE(k[2], k[10]); SN_CE(k[6], k[14]); SN_CE(k[6], k[10]); SN_CE(k[2], k[4]); SN_CE(k[6], k[8]); SN_CE(k[10], k[12]); SN_CE(k[1], k[9]); SN_CE(k[5], k[13]); SN_CE(k[5], k[9]); SN_CE(k[3], k[11]); SN_CE(k[7], k[15]); SN_CE(k[7], k[11]); SN_CE(k[3], k[5]); SN_CE(k[7], k[9]); SN_CE(k[11], k[13]); SN_CE(k[1], k[2]); SN_CE(k[3], k[4]); SN_CE(k[5], k[6]); SN_CE(k[7], k[8]); SN_CE(k[9], k[10]); SN_CE(k[11], k[12]); SN_CE(k[13], k[14]); } while (0)
#define SN_MERGE16(t, k) do { t[0] = t[0] > k[15] ? t[0] : k[15]; t[1] = t[1] > k[14] ? t[1] : k[14]; t[2] = t[2] > k[13] ? t[2] : k[13]; t[3] = t[3] > k[12] ? t[3] : k[12]; t[4] = t[4] > k[11] ? t[4] : k[11]; t[5] = t[5] > k[10] ? t[5] : k[10]; t[6] = t[6] > k[9] ? t[6] : k[9]; t[7] = t[7] > k[8] ? t[7] : k[8]; t[8] = t[8] > k[7] ? t[8] : k[7]; t[9] = t[9] > k[6] ? t[9] : k[6]; t[10] = t[10] > k[5] ? t[10] : k[5]; t[11] = t[11] > k[4] ? t[11] : k[4]; t[12] = t[12] > k[3] ? t[12] : k[3]; t[13] = t[13] > k[2] ? t[13] : k[2]; t[14] = t[14] > k[1] ? t[14] : k[1]; t[15] = t[15] > k[0] ? t[15] : k[0]; SN_CE(t[0], t[8]); SN_CE(t[1], t[9]); SN_CE(t[2], t[10]); SN_CE(t[3], t[11]); SN_CE(t[4], t[12]); SN_CE(t[5], t[13]); SN_CE(t[6], t[14]); SN_CE(t[7], t[15]); SN_CE(t[0], t[4]); SN_CE(t[1], t[5]); SN_CE(t[2], t[6]); SN_CE(t[3], t[7]); SN_CE(t[8], t[12]); SN_CE(t[9], t[13]); SN_CE(t[10], t[14]); SN_CE(t[11], t[15]); SN_CE(t[0], t[2]); SN_CE(t[1], t[3]); SN_CE(t[4], t[6]); SN_CE(t[5], t[7]); SN_CE(t[8], t[10]); SN_CE(t[9], t[11]); SN_CE(t[12], t[14]); SN_CE(t[13], t[15]); SN_CE(t[0], t[1]); SN_CE(t[2], t[3]); SN_CE(t[4], t[5]); SN_CE(t[6], t[7]); SN_CE(t[8], t[9]); SN_CE(t[10], t[11]); SN_CE(t[12], t[13]); SN_CE(t[14], t[15]); } while (0)
#define SN_CAND(i, j) ((fkey(f1[i] + f2[j]) & ~255u) | (unsigned)((i) * 16 + (j)))
#define SN_STAGE2(c, k) do { k[0] = SN_CAND(0, 0); k[1] = SN_CAND(0, 1); k[2] = SN_CAND(0, 2); k[3] = SN_CAND(0, 3); k[4] = SN_CAND(0, 4); k[5] = SN_CAND(0, 5); k[6] = SN_CAND(0, 6); k[7] = SN_CAND(0, 7); k[8] = SN_CAND(0, 8); k[9] = SN_CAND(0, 9); k[10] = SN_CAND(0, 10); k[11] = SN_CAND(0, 11); k[12] = SN_CAND(0, 12); k[13] = SN_CAND(0, 13); k[14] = SN_CAND(0, 14); k[15] = SN_CAND(0, 15); SN_SORT16(k); c[0] = k[0]; c[1] = k[1]; c[2] = k[2]; c[3] = k[3]; c[4] = k[4]; c[5] = k[5]; c[6] = k[6]; c[7] = k[7]; c[8] = k[8]; c[9] = k[9]; c[10] = k[10]; c[11] = k[11]; c[12] = k[12]; c[13] = k[13]; c[14] = k[14]; c[15] = k[15]; k[0] = SN_CAND(1, 0); k[1] = SN_CAND(1, 1); k[2] = SN_CAND(1, 2); k[3] = SN_CAND(1, 3); k[4] = SN_CAND(1, 4); k[5] = SN_CAND(1, 5); k[6] = SN_CAND(1, 6); k[7] = SN_CAND(1, 7); k[8] = SN_CAND(2, 0); k[9] = SN_CAND(2, 1); k[10] = SN_CAND(2, 2); k[11] = SN_CAND(2, 3); k[12] = SN_CAND(2, 4); k[13] = SN_CAND(3, 0); k[14] = SN_CAND(3, 1); k[15] = SN_CAND(3, 2); SN_SORT16(k); SN_MERGE16(c, k); k[0] = SN_CAND(3, 3); k[1] = SN_CAND(4, 0); k[2] = SN_CAND(4, 1); k[3] = SN_CAND(4, 2); k[4] = SN_CAND(5, 0); k[5] = SN_CAND(5, 1); k[6] = SN_CAND(6, 0); k[7] = SN_CAND(6, 1); k[8] = SN_CAND(7, 0); k[9] = SN_CAND(7, 1); k[10] = SN_CAND(8, 0); k[11] = SN_CAND(9, 0); k[12] = SN_CAND(10, 0); k[13] = SN_CAND(11, 0); k[14] = SN_CAND(12, 0); k[15] = SN_CAND(13, 0); SN_SORT16(k); SN_MERGE16(c, k); { unsigned x = SN_CAND(14, 0); _Pragma("unroll") for (int r = 0; r < 16; ++r) { const unsigned hi = c[r] > x ? c[r] : x; x = c[r] > x ? x : c[r]; c[r] = hi; } } { unsigned x = SN_CAND(15, 0); _Pragma("unroll") for (int r = 0; r < 16; ++r) { const unsigned hi = c[r] > x ? c[r] : x; x = c[r] > x ? x : c[r]; c[r] = hi; } } } while (0)
template <int SKIP>
__device__ __forceinline__ void p11a_topk(Frame& F) {
    LAS float* SCR = (LAS float*)(F.lds + F.wave * 16384);
    LAS unsigned* SL = (LAS unsigned*)SCR;
    LAS int* EIDS = (LAS int*)(SCR + 1024);
    LAS int* OFFS = (LAS int*)(SCR + 2048);
    LAS float* RTS = SCR + 2304;
    LAS int* BC = (LAS int*)(F.lds + 8 * 16384);
    const bf16* SC = (const bf16*)(F.ws + WS_SC);
    unsigned char* XQ = F.ws + WS_XQ; float* SXR = (float*)(F.ws + WS_SXR); int* EIDg = (int*)(F.ws + WS_EID); float* GATEg = (float*)(F.ws + WS_GATE); unsigned* REC = (unsigned*)(F.ws + WS_REC);
    for (int blk = F.vcu; blk < SEQ / 64; blk += F.G) {
        __syncthreads();
        if (F.tid < NET) BC[F.tid] = 0;
        __syncthreads();
        const int m0 = blk * 64 + F.wave * 8;
#pragma unroll 2
        for (int ti = 0; ti < 8; ++ti) { const int m = m0 + ti;
            int lane = F.lane; asm volatile("" : "+v"(lane));
            float xh[32]; float ss = 0.f;
            const bf16* x1 = (const bf16*)(F.ws + WS_X1B) + (size_t)m * DM + lane * 32; const float* n2 = F.in[I_N2W] + lane * 32;
            f32x4 nwv[8];
#pragma unroll
            for (int q = 0; q < 8; ++q) { const v2u a = *(const GAS v2u*)(x1 + 4 * q); nwv[q] = *(const GAS f32x4*)(n2 + 4 * q); xh[4 * q] = bflo(a.x); xh[4 * q + 1] = bfhi(a.x); xh[4 * q + 2] = bflo(a.y); xh[4 * q + 3] = bfhi(a.y); }
#pragma unroll
            for (int e = 0; e < 32; ++e) ss += xh[e] * xh[e];
            const float rt = 1.0f / sqrtf(wave_sum(ss) * (1.f / DM) + EPS);
            float amx = 0.f;
#pragma unroll
            for (int q = 0; q < 8; ++q) { const f32x4 a = nwv[q]; xh[4 * q] *= rt * a.x; xh[4 * q + 1] *= rt * a.y; xh[4 * q + 2] *= rt * a.z; xh[4 * q + 3] *= rt * a.w; }
#pragma unroll
            for (int e = 0; e < 32; ++e) amx = fmaxf(amx, fabsf(xh[e]));
            amx = wave_max(amx);
            const float sx = amx > 0.f ? amx * (1.0f / 127.0f) : 1.0f, isx = 1.0f / sx;
            unsigned xq[8];
#pragma unroll
            for (int d = 0; d < 8; ++d) { const int a = (int)rintf(xh[4 * d] * isx), b = (int)rintf(xh[4 * d + 1] * isx), c = (int)rintf(xh[4 * d + 2] * isx), e = (int)rintf(xh[4 * d + 3] * isx);
                xq[d] = (unsigned)(a & 255) | ((unsigned)(b & 255) << 8) | ((unsigned)(c & 255) << 16) | ((unsigned)(e & 255) << 24); }
            if (P11B_DIRECT) { const float s6 = amx > 0.f ? amx * (1.0f / 7.5f) : 1.0f, i6 = 1.0f / s6; v16f a16, b16;
#pragma unroll
                for (int e = 0; e < 16; ++e) { a16[e] = xh[e] * i6; b16[e] = xh[16 + e] * i6; }
                const v6u pk = __builtin_amdgcn_cvt_scalef32_2xpk16_fp6_f32(a16, b16, 1.0f);
                *(GAS v4u*)(XQ + (size_t)m * 1536 + lane * 16) = (v4u){pk[0], pk[1], pk[2], pk[3]}; *(GAS v2u*)(XQ + (size_t)m * 1536 + 1024 + lane * 8) = (v2u){pk[4], pk[5]};
                if (lane == 0) { SXR[2 * m] = s6; SXR[2 * m + 1] = rt; RTS[ti] = rt; } }
            else {
            if (!(SKIP & 2)) { GAS v4u* o = (GAS v4u*)(XQ + ((size_t)lane * SEQ + m) * 32); o[0] = (v4u){xq[0], xq[1], xq[2], xq[3]}; o[1] = (v4u){xq[4], xq[5], xq[6], xq[7]}; }
            if (lane == 0) { SXR[2 * m] = sx; SXR[2 * m + 1] = rt; RTS[ti] = rt; } }
        }
#pragma unroll 1
        for (int grp = 0; grp < 2; ++grp) {
            int lane = F.lane; asm volatile("" : "+v"(lane));
            if (!(SKIP & 1)) {
                { const bf16* src = SC + (size_t)(m0 + grp * 4 + (lane >> 4)) * DM + (lane & 15) * 128;
                  unsigned v[16];
#pragma unroll
                  for (int i = 0; i < 16; ++i) v[i] = 0u;
#pragma unroll 1
                  for (int s8 = 0; s8 < 2; ++s8) { v4u a8[8];
#pragma unroll
                      for (int u = 0; u < 8; ++u) a8[u] = *(const GAS v4u*)(src + 64 * s8 + 8 * u);
#pragma unroll
                      for (int u2 = 0; u2 < 4; ++u2) { unsigned k[16];
#pragma unroll
                          for (int h = 0; h < 2; ++h) { const unsigned wv[4] = {a8[2 * u2 + h].x, a8[2 * u2 + h].y, a8[2 * u2 + h].z, a8[2 * u2 + h].w};
#pragma unroll
                              for (int e = 0; e < 8; ++e) { const float sv = (e & 1) ? bfhi(wv[e >> 1]) : bflo(wv[e >> 1]); k[8 * h + e] = (fkey(sv) & ~127u) | (unsigned)(64 * s8 + 16 * u2 + 8 * h + e); } }
                          SN_SORT16(k); SN_MERGE16(v, k); } }
#pragma unroll
                  for (int q = 0; q < 4; ++q) *(LAS v4u*)(SL + lane * 16 + 4 * q) = (v4u){v[4 * q], v[4 * q + 1], v[4 * q + 2], v[4 * q + 3]}; }
                asm volatile("" ::: "memory");
                if (lane < 32) { const int tk = lane >> 3, h = lane & 7, m = m0 + grp * 4 + tk;
                    const LAS unsigned* L1 = SL + (tk * 16 + 2 * h) * 16; const LAS unsigned* L2 = L1 + 16;
                    float f1[16], f2[16];
#pragma unroll
                    for (int q = 0; q < 4; ++q) { const v4u a = *(const LAS v4u*)(L1 + 4 * q), b = *(const LAS v4u*)(L2 + 4 * q);
                        f1[4 * q] = key_val(a.x, 127u); f1[4 * q + 1] = key_val(a.y, 127u); f1[4 * q + 2] = key_val(a.z, 127u); f1[4 * q + 3] = key_val(a.w, 127u);
                        f2[4 * q] = key_val(b.x, 127u); f2[4 * q + 1] = key_val(b.y, 127u); f2[4 * q + 2] = key_val(b.z, 127u); f2[4 * q + 3] = key_val(b.w, 127u); }
                    unsigned c[16]; { unsigned k[16]; SN_STAGE2(c, k); }
                    const float rt = RTS[grp * 4 + tk];
                    float sc[16]; int ee[16]; float mx = -3.0e38f;
#pragma unroll
                    for (int r = 0; r < 16; ++r) { const unsigned ij = c[r] & 255u; const unsigned k1 = L1[ij >> 4], k2 = L2[ij & 15u];
                        sc[r] = key_val(k1, 127u) + key_val(k2, 127u); ee[r] = (int)((k1 & 127u) * 128u + (k2 & 127u)); mx = fmaxf(mx, sc[r]); }
                    float sum = 0.f;
#pragma unroll
                    for (int r = 0; r < 16; ++r) { sc[r] = __expf(rt * (sc[r] - mx)); sum += sc[r]; }
                    const float inv = 1.0f / sum;
#pragma unroll
                    for (int q = 0; q < 4; ++q) { *(LAS v4u*)(EIDS + (grp * 4 + tk) * 128 + h * 16 + 4 * q) = (v4u){(unsigned)ee[4 * q], (unsigned)ee[4 * q + 1], (unsigned)ee[4 * q + 2], (unsigned)ee[4 * q + 3]};
                        if (!(SKIP & 4)) { *(GAS v4u*)(EIDg + (size_t)m * 128 + h * 16 + 4 * q) = (v4u){(unsigned)ee[4 * q], (unsigned)ee[4 * q + 1], (unsigned)ee[4 * q + 2], (unsigned)ee[4 * q + 3]};
                            *(GAS f32x4*)(GATEg + (size_t)m * 128 + h * 16 + 4 * q) = (f32x4){sc[4 * q] * inv, sc[4 * q + 1] * inv, sc[4 * q + 2] * inv, sc[4 * q + 3] * inv}; } }
                }
                asm volatile("" ::: "memory");
            }
        }
        if (P11B_DIRECT) continue;
#pragma unroll 1
        for (int ti = 0; ti < 8; ++ti) {
            int lane = F.lane; asm volatile("" : "+v"(lane));
            const int tA = (EIDS[ti * 128 + lane] >> 9) & 31, tB = (EIDS[ti * 128 + 64 + lane] >> 9) & 31; int mycnt = 0;
#pragma unroll
            for (int k = 0; k < NET; ++k) { const int c = __popcll(__ballot(tA == k)) + __popcll(__ballot(tB == k)); mycnt = (lane == k) ? c : mycnt; }
            if (lane < NET) OFFS[ti * NET + lane] = __hip_atomic_fetch_add((int*)(BC + lane), mycnt, __ATOMIC_RELAXED, __HIP_MEMORY_SCOPE_WORKGROUP);
        }
        __syncthreads();
        const int tt = blk >> 4;
        if (F.tid < NET) BC[NET + F.tid] = (int)__hip_atomic_fetch_add((unsigned*)(F.ctl + CW_CNT) + (tt * NET + F.tid) * 16, (unsigned)BC[F.tid], __ATOMIC_RELAXED, __HIP_MEMORY_SCOPE_AGENT);
        __syncthreads();
#pragma unroll 1
        for (int ti = 0; ti < 8; ++ti) { const int m = m0 + ti;
            int lane = F.lane; asm volatile("" : "+v"(lane));
            const unsigned long long lt_mask = (1ull << lane) - 1ull;
            const int eA = EIDS[ti * 128 + lane] & 16383, eB = EIDS[ti * 128 + 64 + lane] & 16383, tA = eA >> 9, tB = eB >> 9; int rankA = 0, rankB = 0;
#pragma unroll
            for (int k = 0; k < NET; ++k) { const unsigned long long mA = __ballot(tA == k), mB = __ballot(tB == k);
                rankA = (tA == k) ? __popcll(mA & lt_mask) : rankA; rankB = (tB == k) ? __popcll(mA) + __popcll(mB & lt_mask) : rankB; }
            const unsigned tl = (unsigned)(m & 1023) << 17;
            if (!(SKIP & 4)) { const int s = BC[NET + tA] + OFFS[ti * NET + tA] + rankA; if (s < REC_CAP) REC[(size_t)(tt * NET + tA) * REC_CAP + s] = tl | ((unsigned)(eA & 511) << 7) | (unsigned)lane; }
            if (!(SKIP & 4)) { const int s = BC[NET + tB] + OFFS[ti * NET + tB] + rankB; if (s < REC_CAP) REC[(size_t)(tt * NET + tB) * REC_CAP + s] = tl | ((unsigned)(eB & 511) << 7) | (unsigned)(lane + 64); }
        }
    }
}

typedef int v8i_t __attribute__((ext_vector_type(8)));
__device__ __forceinline__ void p11b_direct(Frame& F) {
    const int gw = F.vcu * NWAVES + F.wave, NGW = F.G * NWAVES;
    LAS int* EIDL = (LAS int*)(F.lds + F.wave * 16384);
    const unsigned char* XQ6 = F.ws + WS_XQ; const unsigned char* TU6 = F.ws + WS_TU; const int* EIDg = (const int*)(F.ws + WS_EID);
    const float* SXR = (const float*)(F.ws + WS_SXR); const float* GATEg = (const float*)(F.ws + WS_GATE); float* AVg = (float*)(F.ws + WS_AV);
    const float* SU = (const float*)(F.ws + WS_PSC); const float* SV = SU + 16384;
    for (int m = gw; m < SEQ; m += NGW) {
        int lane = F.lane; asm volatile("" : "+v"(lane));
        const int lo16 = lane * 16, lo8 = 1024 + lane * 8;
        const int e0 = EIDg[(size_t)m * 128 + lane] & 16383, e1 = EIDg[(size_t)m * 128 + 64 + lane] & 16383;
        EIDL[lane] = e0; EIDL[lane + 64] = e1;
        v8i_t xb; { const unsigned char* xp = XQ6 + (size_t)m * 1536; const v4u a = *(const GAS v4u*)(xp + lo16); const v2u b = *(const GAS v2u*)(xp + lo8); xb = (v8i_t){(int)a.x, (int)a.y, (int)a.z, (int)a.w, (int)b.x, (int)b.y, 0, 0}; }
        asm volatile("" ::: "memory");
        const bool dg = ((lane & 15) >> 2) == (lane >> 4); const int rsel = lane & 3;
        float h0 = 0.f, h1 = 0.f;
        v4u ua[2][4]; v2u ub[2][4];
#define P11D_LOAD(buf, g) do { _Pragma("unroll") for (int q = 0; q < 4; ++q) { const int e = __builtin_amdgcn_readfirstlane(EIDL[(g) + q]); const unsigned char* up = TU6 + (size_t)e * TU_PITCH; \
            ua[buf][q] = *(const GAS v4u*)(up + lo16); if (UFMT != 4) ub[buf][q] = *(const GAS v2u*)(up + lo8); } } while (0)
#define P11D_MMA(buf, g, hh) do { _Pragma("unroll") for (int q = 0; q < 4; ++q) { const v8i_t av8 = {(int)ua[buf][q].x, (int)ua[buf][q].y, (int)ua[buf][q].z, (int)ua[buf][q].w, UFMT != 4 ? (int)ub[buf][q].x : 0, UFMT != 4 ? (int)ub[buf][q].y : 0, 0, 0}; \
            const f32x4 d = __builtin_amdgcn_mfma_scale_f32_16x16x128_f8f6f4(av8, xb, (f32x4){0.f, 0.f, 0.f, 0.f}, UFMT == 4 ? 4 : 2, 2, 0, 0, 0, 0); \
            const float dv = rsel == 0 ? d[0] : rsel == 1 ? d[1] : rsel == 2 ? d[2] : d[3]; const float hs = wave_sum(dg ? dv : 0.f); hh = (lane == (((g) + q) & 63)) ? hs : hh; } \
            __builtin_amdgcn_sched_barrier(0); } while (0)
        P11D_LOAD(0, 0);
#pragma unroll 1
        for (int g = 0; g < 64; g += 8) { P11D_LOAD(1, g + 4); P11D_MMA(0, g, h0); P11D_LOAD(0, g + 8); P11D_MMA(1, g + 4, h0); }
#pragma unroll 1
        for (int g = 64; g < 128; g += 8) { P11D_LOAD(1, g + 4); P11D_MMA(0, g, h1); if (g + 8 < 128) P11D_LOAD(0, g + 8); P11D_MMA(1, g + 4, h1); }
#undef P11D_LOAD
#undef P11D_MMA
        const float sxm = SXR[2 * m];
        { const size_t j0 = (size_t)m * 128 + lane, j1 = j0 + 64;
          AVg[j0] = gelu_erf(h0 * SU[e0] * sxm) * GATEg[j0] * SV[e0]; AVg[j1] = gelu_erf(h1 * SU[e1] * sxm) * GATEg[j1] * SV[e1]; }
        asm volatile("" ::: "memory");
    }
}

constexpr int NSLOT = 12, UPITCH = 80;
template <int SKIP>
__device__ __forceinline__ void p11b_udot(Frame& F) {
    LAS unsigned char* XS = (LAS unsigned char*)F.lds;
    LAS unsigned char* US = XS + 1024 * UPITCH;
    LAS int* QB = (LAS int*)(F.lds + 124 * 1024);
    const int tid = F.tid;
    const unsigned char* XQ = F.ws + WS_XQ; const unsigned char* TU = F.ws + WS_TU; const unsigned* REC = (const unsigned*)(F.ws + WS_REC);
    const float* SXR = (const float*)(F.ws + WS_SXR); const float* GATEg = (const float*)(F.ws + WS_GATE); float* AVg = (float*)(F.ws + WS_AV);
    const float* SU = (const float*)(F.ws + WS_PSC); const float* SV = SU + 16384;
    for (;;) {
        __syncthreads();
        if (tid == 0) QB[0] = (int)__hip_atomic_fetch_add((unsigned*)(F.ctl + CW_Q), 1u, __ATOMIC_RELAXED, __HIP_MEMORY_SCOPE_AGENT);
        __syncthreads();
        const int b = QB[0];
        if (b >= NBUCK) break;
        const int tt = b >> 5, et = b & 31;
        int n = (int)__hip_atomic_load((unsigned*)(F.ctl + CW_CNT) + b * 16, __ATOMIC_RELAXED, __HIP_MEMORY_SCOPE_AGENT); n = n < REC_CAP ? n : REC_CAP;
        for (int g0 = 0; g0 < n; g0 += NSLOT * NTHR) {
            const int npass = (n - g0) < NSLOT * NTHR ? (n - g0) : NSLOT * NTHR;
            unsigned rec[NSLOT]; int acc[NSLOT];
#pragma unroll
            for (int j = 0; j < NSLOT; ++j) { const int idx = g0 + j * NTHR + tid; const unsigned r = idx < n ? REC[(size_t)b * REC_CAP + idx] : 0xffffffffu; acc[j] = 0;
                rec[j] = ((r >> 17) & 1023u) | (((r >> 7) & 511u) << 16); }
            v4u st[12];
#define P11B_SRC(step, i) (((i) % 6) < 4 ? XQ + ((size_t)(2 * (step) + (i) / 6) * SEQ + tt * 1024) * 32 + (size_t)(tid + 512 * ((i) % 6)) * 16 : TU + ((size_t)(2 * (step) + (i) / 6) * 16384 + et * ETSZ) * 32 + (size_t)(tid + 512 * (((i) % 6) - 4)) * 16)
#pragma unroll
            for (int i = 0; i < 12; ++i) st[i] = *(const GAS v4u*)P11B_SRC(0, i);
#pragma unroll 1
            for (int c = 0; c < 32; ++c) {
                __syncthreads();
#pragma unroll
                for (int i = 0; i < 12; ++i) { const int q = i % 6, hc = i / 6, p = (q < 4) ? tid + 512 * q : tid + 512 * (q - 4); *(LAS v4u*)((q < 4 ? XS : US) + (p >> 1) * UPITCH + hc * 32 + (p & 1) * 16) = st[i]; }
                __syncthreads();
                if (c + 1 < 32 && !(SKIP & 1)) {
#pragma unroll
                    for (int i = 0; i < 12; ++i) st[i] = *(const GAS v4u*)P11B_SRC(c + 1, i);
                }
#pragma unroll
                for (int j0 = 0; j0 < NSLOT; j0 += 2) {
                    if (j0 * NTHR < npass && !(SKIP & 2)) {
                        v4u xb[2][4], ub[2][4];
#pragma unroll
                        for (int q = 0; q < 2; ++q) { unsigned r = rec[j0 + q]; asm volatile("" : "+v"(r));
                            const unsigned xo = (r & 0xffffu) * UPITCH, uo = (r >> 16) * UPITCH;
#pragma unroll
                            for (int hh = 0; hh < 4; ++hh) { xb[q][hh] = *(const LAS v4u*)(XS + xo + 16 * hh); ub[q][hh] = *(const LAS v4u*)(US + uo + 16 * hh); } }
                        __builtin_amdgcn_sched_barrier(0);
#pragma unroll
                        for (int q = 0; q < 2; ++q) { int s = acc[j0 + q];
#pragma unroll
                            for (int hh = 0; hh < 4; ++hh) { const v4u u = ub[q][hh], x = xb[q][hh];
                                s = __builtin_amdgcn_sdot4((int)u.x, (int)x.x, s, false); s = __builtin_amdgcn_sdot4((int)u.y, (int)x.y, s, false); s = __builtin_amdgcn_sdot4((int)u.z, (int)x.z, s, false); s = __builtin_amdgcn_sdot4((int)u.w, (int)x.w, s, false); }
                            acc[j0 + q] = s; }
                        __builtin_amdgcn_sched_barrier(0);
                    }
                }
            }
#undef P11B_SRC
#pragma unroll
            for (int j = 0; j < NSLOT; ++j) { const int idx = g0 + j * NTHR + tid; const unsigned r = idx < n ? REC[(size_t)b * REC_CAP + idx] : 0xffffffffu;
                if (r != 0xffffffffu) { const int t = tt * 1024 + (int)((r >> 17) & 1023), e = et * ETSZ + (int)((r >> 7) & 511), j7 = (int)(r & 127);
                    const float hv = (float)acc[j] * SU[e] * SXR[2 * t]; AVg[(size_t)t * 128 + j7] = gelu_erf(hv) * GATEg[(size_t)t * 128 + j7] * SV[e]; } }
        }
    }
}

__device__ __forceinline__ void p11c_vsum(Frame& F) {
    const int gw = F.vcu * NWAVES + F.wave, NGW = F.G * NWAVES;
    LAS int* EID = (LAS int*)(F.lds + F.wave * 16384); LAS float* AV = (LAS float*)(EID + 128);
    const unsigned char* TV = F.ws + WS_TV; const int* EIDg = (const int*)(F.ws + WS_EID); const float* AVg = (const float*)(F.ws + WS_AV);
    for (int m = gw; m < SEQ; m += NGW) {
        int lane = F.lane; asm volatile("" : "+v"(lane));
        const int lo16 = lane * 16;
        EID[lane] = EIDg[(size_t)m * 128 + lane]; EID[lane + 64] = EIDg[(size_t)m * 128 + 64 + lane]; AV[lane] = AVg[(size_t)m * 128 + lane]; AV[lane + 64] = AVg[(size_t)m * 128 + 64 + lane];
        asm volatile("" ::: "memory");
        f32x2 y2[16];
#pragma unroll
        for (int e = 0; e < 16; ++e) y2[e] = (f32x2){0.f, 0.f};
        float av[2][4];
#if VFMT == 64
        v4u rv[2][4]; v2u rw[2][4]; bool bg[2][4];
        float thr2; { const float a0 = AV[lane], a1 = AV[lane + 64]; thr2 = wave_sum(a0 * a0 + a1 * a1) * (VMIX_C / 128.0f); }
        const unsigned char* TV4 = F.ws + WS_TV4;
#define P11C_LOAD(buf, g) do { _Pragma("unroll") for (int q = 0; q < 4; ++q) { const int e = __builtin_amdgcn_readfirstlane(EID[(g) + q]); const float a = AV[(g) + q]; av[buf][q] = a; \
            const bool big = __builtin_amdgcn_readfirstlane((int)(a * a > thr2)) != 0; bg[buf][q] = big; \
            const unsigned char* p0 = big ? TV + (size_t)e * TV_PITCH : TV4 + (size_t)e * 1024; const unsigned char* p1 = big ? TV + (size_t)e * TV_PITCH + 1024 : TV;     \
            rv[buf][q] = *(const GAS v4u*)(p0 + lo16); rw[buf][q] = *(const GAS v2u*)(p1 + lane * 8); } } while (0)
#define P11C_ACC(buf) do { _Pragma("unroll") for (int q = 0; q < 4; ++q) { const float a = av[buf][q]; \
            if (bg[buf][q]) { const f32x2 a2 = {a, a}; const v6u pk = {rv[buf][q].x, rv[buf][q].y, rv[buf][q].z, rv[buf][q].w, rw[buf][q].x, rw[buf][q].y}; const v32f f = __builtin_amdgcn_cvt_scalef32_pk32_f32_fp6(pk, 1.0f); \
                _Pragma("unroll") for (int k = 0; k < 16; ++k) y2[k] += a2 * (f32x2){f[2 * k], f[2 * k + 1]}; } \
            else { const f32x2 a2 = {a * 1.25f, a * 1.25f}; const unsigned wv[4] = {rv[buf][q].x, rv[buf][q].y, rv[buf][q].z, rv[buf][q].w}; \
                _Pragma("unroll") for (int dd = 0; dd < 4; ++dd) { y2[4 * dd] += a2 * __builtin_amdgcn_cvt_scalef32_pk_f32_fp4(wv[dd], 1.0f, 0); y2[4 * dd + 1] += a2 * __builtin_amdgcn_cvt_scalef32_pk_f32_fp4(wv[dd], 1.0f, 1); \
                    y2[4 * dd + 2] += a2 * __builtin_amdgcn_cvt_scalef32_pk_f32_fp4(wv[dd], 1.0f, 2); y2[4 * dd + 3] += a2 * __builtin_amdgcn_cvt_scalef32_pk_f32_fp4(wv[dd], 1.0f, 3); } } \
            __builtin_amdgcn_sched_barrier(0); } } while (0)
#elif VFMT == 6
        v4u rv[2][4]; v2u rw[2][4];
#define P11C_LOAD(buf, g) do { _Pragma("unroll") for (int q = 0; q < 4; ++q) { const int e = __builtin_amdgcn_readfirstlane(EID[(g) + q]); av[buf][q] = AV[(g) + q]; const unsigned char* rp = TV + (size_t)e * TV_PITCH; \
            rv[buf][q] = *(const GAS v4u*)(rp + lo16); rw[buf][q] = *(const GAS v2u*)(rp + 1024 + lane * 8); } } while (0)
#define P11C_ACC(buf) do { _Pragma("unroll") for (int q = 0; q < 4; ++q) { const float a = av[buf][q]; const f32x2 a2 = {a, a}; \
            const v6u pk = {rv[buf][q].x, rv[buf][q].y, rv[buf][q].z, rv[buf][q].w, rw[buf][q].x, rw[buf][q].y}; const v32f f = __builtin_amdgcn_cvt_scalef32_pk32_f32_fp6(pk, 1.0f); \
            _Pragma("unroll") for (int k = 0; k < 16; ++k) y2[k] += a2 * (f32x2){f[2 * k], f[2 * k + 1]}; \
            __builtin_amdgcn_sched_barrier(0); } } while (0)
#elif VFMT == 4
        v4u rv[2][4];
#define P11C_LOAD(buf, g) do { _Pragma("unroll") for (int q = 0; q < 4; ++q) { const int e = __builtin_amdgcn_readfirstlane(EID[(g) + q]); av[buf][q] = AV[(g) + q]; rv[buf][q] = *(const GAS v4u*)(TV + (size_t)e * TV_PITCH + lo16); } } while (0)
#define P11C_ACC(buf) do { _Pragma("unroll") for (int q = 0; q < 4; ++q) { const float a = av[buf][q]; const f32x2 a2 = {a, a}; const unsigned wv[4] = {rv[buf][q].x, rv[buf][q].y, rv[buf][q].z, rv[buf][q].w}; \
            _Pragma("unroll") for (int dd = 0; dd < 4; ++dd) { y2[4 * dd] += a2 * __builtin_amdgcn_cvt_scalef32_pk_f32_fp4(wv[dd], 1.0f, 0); y2[4 * dd + 1] += a2 * __builtin_amdgcn_cvt_scalef32_pk_f32_fp4(wv[dd], 1.0f, 1); \
                y2[4 * dd + 2] += a2 * __builtin_amdgcn_cvt_scalef32_pk_f32_fp4(wv[dd], 1.0f, 2); y2[4 * dd + 3] += a2 * __builtin_amdgcn_cvt_scalef32_pk_f32_fp4(wv[dd], 1.0f, 3); } \
            __builtin_amdgcn_sched_barrier(0); } } while (0)
#else
        v4u rv[2][4][2];
#define P11C_LOAD(buf, g) do { _Pragma("unroll") for (int q = 0; q < 4; ++q) { const int e = __builtin_amdgcn_readfirstlane(EID[(g) + q]); av[buf][q] = AV[(g) + q]; const unsigned char* rp = TV + (size_t)e * DM + lo16; \
            rv[buf][q][0] = *(const GAS v4u*)(rp); rv[buf][q][1] = *(const GAS v4u*)(rp + 1024); } } while (0)
#define P11C_ACC(buf) do { _Pragma("unroll") for (int q = 0; q < 4; ++q) { const float a = av[buf][q]; const f32x2 a2 = {a, a}; \
            _Pragma("unroll") for (int j = 0; j < 2; ++j) { const v4u r = rv[buf][q][j]; const unsigned wv[4] = {r.x, r.y, r.z, r.w}; \
                _Pragma("unroll") for (int dd = 0; dd < 4; ++dd) { y2[8 * j + 2 * dd] += a2 * __builtin_amdgcn_cvt_pk_f32_fp8((int)wv[dd], false); y2[8 * j + 2 * dd + 1] += a2 * __builtin_amdgcn_cvt_pk_f32_fp8((int)wv[dd], true); } } \
            __builtin_amdgcn_sched_barrier(0); } } while (0)
#endif
        P11C_LOAD(0, 0);
#pragma unroll 1
        for (int g = 0; g < 128; g += 8) {
            P11C_LOAD(1, g + 4);
            P11C_ACC(0);
            if (g + 8 < 128) P11C_LOAD(0, g + 8);
            P11C_ACC(1);
        }
#undef P11C_LOAD
#undef P11C_ACC
        float y[32];
#pragma unroll
        for (int e = 0; e < 16; ++e) { if ((VFMT == 6 || VFMT == 64) && FP6_IL) { y[e] = y2[e].x; y[16 + e] = y2[e].y; } else { y[2 * e] = y2[e].x; y[2 * e + 1] = y2[e].y; } }
        const bf16* x1 = (const bf16*)(F.ws + WS_X1B) + (size_t)m * DM;
        float s2 = 0.f;
#pragma unroll
        for (int j = 0; j < 2; ++j)
#pragma unroll
            for (int q = 0; q < 4; ++q) { const v2u a2 = *(const GAS v2u*)(x1 + j * 1024 + lo16 + 4 * q); const f32x4 a = {bflo(a2.x), bfhi(a2.x), bflo(a2.y), bfhi(a2.y)};
                y[16 * j + 4 * q] += a.x; y[16 * j + 4 * q + 1] += a.y; y[16 * j + 4 * q + 2] += a.z; y[16 * j + 4 * q + 3] += a.w; }
#pragma unroll
        for (int e = 0; e < 32; ++e) s2 += y[e] * y[e];
        const float ro = 1.0f / sqrtf(wave_sum(s2) * (1.f / DM) + EPS);
        float* orow = F.out + (size_t)m * DM;
#pragma unroll
        for (int j = 0; j < 2; ++j)
#pragma unroll
            for (int q = 0; q < 4; ++q) { const f32x4 a = *(const GAS f32x4*)(F.in[I_FNW] + j * 1024 + lo16 + 4 * q);
                *(GAS f32x4*)(orow + j * 1024 + lo16 + 4 * q) = (f32x4){y[16 * j + 4 * q] * ro * a.x, y[16 * j + 4 * q + 1] * ro * a.y, y[16 * j + 4 * q + 2] * ro * a.z, y[16 * j + 4 * q + 3] * ro * a.w}; }
    }
}
#ifndef MK_N_LAUNCHES
#define MK_N_LAUNCHES 1
#endif
constexpr int N_PHASES = 14;
constexpr int N_LAUNCHES = MK_N_LAUNCHES;
static_assert(N_LAUNCHES == 1 || N_LAUNCHES == N_PHASES, "MK_N_LAUNCHES is 1 or N_PHASES");
#ifndef PG8_SP2
#define PG8_SP2 true
#endif
#ifndef PG8_ALIGN
#define PG8_ALIGN true
#endif
struct Args { const float* in[19]; float* out; unsigned char* ws; int ph_lo, ph_hi; };
__global__ void __launch_bounds__(NTHR, 2) fwd_kernel(Args args) {
    extern __shared__ __attribute__((aligned(16))) unsigned char lds[];
    Frame F;
    F.lds = (LAS unsigned char*)lds;
    F.MISC = (volatile LAS unsigned*)(F.lds + MISC_OFF);
    F.tid = threadIdx.x; F.lane = F.tid & 63; F.wave = __builtin_amdgcn_readfirstlane(F.tid >> 6);
    F.G = gridDim.x; { const int bx = blockIdx.x; F.vcu = (F.G % 8 == 0) ? (bx % 8) * (F.G / 8) + bx / 8 : bx; }
    F.ws = args.ws; F.out = args.out; F.ctl = (gu32*)(args.ws + WS_CTL);
#pragma unroll
    for (int i = 0; i < 19; ++i) F.in[i] = args.in[i];
    for (int u = F.tid; u < (LDS_BYTES - MISC_OFF) / 4; u += NTHR) ((LAS unsigned*)(F.lds + MISC_OFF))[u] = 0u;
    __syncthreads();
    XcdBarrier bar; bar.bar = (unsigned*)(F.ctl + CW_BAR); bar.x = 0; bar.st = nullptr;
    if (N_LAUNCHES == 1) bar = xcd_barrier_post((unsigned*)(F.ctl + CW_BAR), F.MISC + 8);
    const int lo = args.ph_lo, hi = args.ph_hi;
#ifdef ONLY_PHASE
#define IN(k) ((k) == ONLY_PHASE && lo <= (k) && (k) < hi)
#else
#define IN(k) (lo <= (k) && (k) < hi)
#endif
#define SEAM(k) do { if (IN(k) && IN((k) + 1)) xcd_barrier(bar); } while (0)
#ifndef REPEAT_MASK
#define REPEAT_MASK 0
#endif
#ifndef P11A_SKIP
#define P11A_SKIP 0
#endif
#define REPS(k) for (int rep_ = 0; rep_ < (((REPEAT_MASK) >> (k)) & 1) + 1; ++rep_)
#define RSEAM(k) do { if ((((REPEAT_MASK) >> (k)) & 1) && rep_ == 0) xcd_barrier(bar); } while (0)
    unsigned char* ws = args.ws;
    if (IN(0)) { REPS(0) { p0_prologue(F); RSEAM(0); } SEAM(0); }
    if (IN(1)) {
        pg8::Gemm g{(const bf16*)(ws + WS_XN), (const bf16*)(ws + WS_W1), SEQ, N1, DM}; pg8::StaticOrder S; S.init(SEQ, N1, F.G, (int)blockIdx.x);
        EpiG1 E{ws, F.in[I_LB], (const float*)(ws + WS_QX), (const float*)(ws + WS_QW) + QW_W1};
        if (QM_G1) g.A = (const bf16*)((const unsigned char*)F.out + DO_XN8);
        if ((REPEAT_MASK >> 1) & 1) { pg8::gemm_phase<EpiG1, pg8::StaticOrder, PG8_ALIGN, PG8_SP2, QM_G1>(F.lds, g, S, E); xcd_barrier(bar); }
        pg8::gemm_phase<EpiG1, pg8::StaticOrder, PG8_ALIGN, PG8_SP2, QM_G1>(F.lds, g, S, E);
        p1_ab(F);
        SEAM(1);
    }
#ifdef EXTRA_BARRIERS
    for (int eb = 0; eb < EXTRA_BARRIERS; ++eb) xcd_barrier(bar);
#endif
    if (IN(2)) { REPS(2) { hgrn_pass<false>(F); RSEAM(2); } SEAM(2); }
    if (IN(3)) { if ((REPEAT_MASK >> 3) & 1) { hgrn_pass<true, P11A_SKIP>(F); xcd_barrier(bar); } hgrn_pass<true>(F); SEAM(3); }
    if (IN(4)) { if ((REPEAT_MASK >> 4) & 1) { gdn_prep<P11A_SKIP>(F); xcd_barrier(bar); } gdn_prep<0>(F); SEAM(4); }
    if (IN(5)) { if ((REPEAT_MASK >> 5) & 1) { gdn_pass<false, P11A_SKIP>(F); xcd_barrier(bar); } gdn_pass<false>(F); SEAM(5); }
    if (IN(6)) { if ((REPEAT_MASK >> 6) & 1) { gdn_pass<true, P11A_SKIP>(F); xcd_barrier(bar); } gdn_pass<true>(F); SEAM(6); }
    if (IN(7)) { REPS(7) { p7_mix(F); RSEAM(7); } SEAM(7); }
    if (IN(8)) {
        pg8::StaticOrder S; S.init(SEQ, DM, F.G, (int)blockIdx.x);
        bf16* GT = (bf16*)(ws + WS_GT); unsigned char* GA8 = ws + WS_GT2; unsigned char* GB8 = ws + WS_GT2 + 32 * MiB;
        const bf16* XNg = QM_GATE ? (const bf16*)((const unsigned char*)F.out + DO_XN8) : (const bf16*)(ws + WS_XN);
        const bf16* WG2 = QM_GATE ? (const bf16*)(ws + WS_WG + (size_t)DM * DM) : (const bf16*)(ws + WS_WG) + (size_t)DM * DM;
        const float* QX = (const float*)(ws + WS_QX); const float* QW = (const float*)(ws + WS_QW);
#define P8_BODY \
        { pg8::Gemm g{XNg, (const bf16*)(ws + WS_WG), SEQ, DM, DM}; EpiGate E{GA8, QX, QW + QW_WG}; pg8::gemm_phase<EpiGate, pg8::StaticOrder, PG8_ALIGN, PG8_SP2, QM_GATE>(F.lds, g, S, E); } \
        __builtin_amdgcn_fence(__ATOMIC_ACQUIRE, "agent"); VM_WAIT(); __syncthreads(); \
        { pg8::Gemm g{(const bf16*)(ws + WS_YA), (const bf16*)(ws + WS_WPA), SEQ, DM, HW}; EpiMix<0> E{GT, GA8, nullptr, QX + SEQ, QW + QW_WPA}; pg8::gemm_phase<EpiMix<0>, pg8::StaticOrder, PG8_ALIGN, PG8_SP2, QM_MIX>(F.lds, g, S, E); } \
        { pg8::Gemm g{XNg, WG2, SEQ, DM, DM}; EpiGate E{GB8, QX, QW + QW_WG + DM}; pg8::gemm_phase<EpiGate, pg8::StaticOrder, PG8_ALIGN, PG8_SP2, QM_GATE>(F.lds, g, S, E); } \
        __builtin_amdgcn_fence(__ATOMIC_ACQUIRE, "agent"); VM_WAIT(); __syncthreads(); \
        { pg8::Gemm g{(const bf16*)(ws + WS_YB), (const bf16*)(ws + WS_WPB), SEQ, DM, HW}; EpiMix<1> E{GT, GB8, ws + WS_GT8, QX + 2 * SEQ, QW + QW_WPB}; pg8::gemm_phase<EpiMix<1>, pg8::StaticOrder, PG8_ALIGN, PG8_SP2, QM_MIX>(F.lds, g, S, E); }
        if ((REPEAT_MASK >> 8) & 1) { P8_BODY xcd_barrier(bar); }
        P8_BODY
#undef P8_BODY
        SEAM(8);
    }
    if (IN(9)) {
        pg8::Gemm g{(const bf16*)(ws + (QM_OUT ? WS_GT8 : WS_GT)), (const bf16*)(ws + WS_WOUT), SEQ, DM, DM}; pg8::StaticOrder S; S.init(SEQ, DM, F.G, (int)blockIdx.x);
        EpiX1 E{F.in[I_X], F.out, (bf16*)(ws + WS_X1B)};
        if ((REPEAT_MASK >> 9) & 1) { pg8::gemm_phase<EpiX1, pg8::StaticOrder, PG8_ALIGN, PG8_SP2, QM_OUT>(F.lds, g, S, E); xcd_barrier(bar); }
        pg8::gemm_phase<EpiX1, pg8::StaticOrder, PG8_ALIGN, PG8_SP2, QM_OUT>(F.lds, g, S, E);
        SEAM(9);
    }
    if (IN(10)) {
        pg8::Gemm g{(const bf16*)(ws + WS_X1B), (const bf16*)(ws + WS_WS), SEQ, DM, DM}; pg8::StaticOrder S; S.init(SEQ, DM, F.G, (int)blockIdx.x);
        EpiBf E{(bf16*)(ws + WS_SC)};
        if ((REPEAT_MASK >> 10) & 1) { pg8::gemm_phase<EpiBf, pg8::StaticOrder, PG8_ALIGN, PG8_SP2>(F.lds, g, S, E); xcd_barrier(bar); }
        pg8::gemm_phase<EpiBf, pg8::StaticOrder, PG8_ALIGN, PG8_SP2>(F.lds, g, S, E);
        SEAM(10);
    }
    if (IN(11)) {
        if ((REPEAT_MASK >> 11) & 1) { p11a_topk<P11A_SKIP>(F); xcd_barrier(bar); if (blockIdx.x == 0) for (int i = F.tid; i < NBUCK + 1; i += NTHR) __hip_atomic_store((unsigned*)(F.ctl + CW_CNT) + i * 16, 0u, __ATOMIC_RELAXED, __HIP_MEMORY_SCOPE_AGENT); xcd_barrier(bar); }
        p11a_topk<0>(F); SEAM(11); }
    if (IN(12)) { if ((REPEAT_MASK >> 12) & 1) { p11b_udot<P11A_SKIP>(F); xcd_barrier(bar); if (blockIdx.x == 0 && F.tid == 0) __hip_atomic_store((unsigned*)(F.ctl + CW_Q), 0u, __ATOMIC_RELAXED, __HIP_MEMORY_SCOPE_AGENT); xcd_barrier(bar); } if (P11B_DIRECT) p11b_direct(F); else p11b_udot<0>(F); SEAM(12); }
    if (IN(13)) { p11c_vsum(F); }
#undef IN
#undef SEAM
}


#ifdef PROBE
__global__ void digest_kernel(const unsigned* ws, float* out) {
    const size_t n = (size_t)SEQ * DM;
    for (size_t i = (size_t)blockIdx.x * blockDim.x + threadIdx.x; i < n; i += (size_t)gridDim.x * blockDim.x) {
        unsigned acc = (PROBE >= 9) ? __builtin_bit_cast(unsigned, out[i]) : 0u;
        const size_t offs[5] = {0, 128 * MiB / 4, 256 * MiB / 4, 384 * MiB / 4, 408 * MiB / 4};
#pragma unroll
        for (int r = 0; r < 5; ++r) acc = acc * 1664525u + ws[offs[r] + i];
        out[i] = (float)(acc >> 8) * (1.0f / 16777216.0f);
    }
}
#endif
extern "C" void kernel_launch(void* const* d_in, const int* in_sizes, int n_in, void* d_out, int out_size, void* d_ws, size_t ws_size, hipStream_t stream) {
    static int grid = 0;
    if (grid == 0) {
        if (n_in != 19 || in_sizes[0] != SEQ * DM || out_size != SEQ * DM || ws_size < WS_END) { fprintf(stderr, "kernel_launch: unexpected shapes (n_in %d, in0 %d, out %d, ws %zu; need ws >= %zu)\n", n_in, n_in > 0 ? in_sizes[0] : -1, out_size, ws_size, (size_t)WS_END); grid = -1; return; }
        int dev = 0, cus = 0, per_cu = 0;
        if (hipGetDevice(&dev) != hipSuccess || hipDeviceGetAttribute(&cus, hipDeviceAttributeMultiprocessorCount, dev) != hipSuccess) { grid = -1; return; }
        if (hipFuncSetAttribute((const void*)fwd_kernel, hipFuncAttributeMaxDynamicSharedMemorySize, LDS_BYTES) != hipSuccess) { fprintf(stderr, "kernel_launch: hipFuncSetAttribute failed\n"); grid = -1; return; }
        if (hipOccupancyMaxActiveBlocksPerMultiprocessor(&per_cu, (const void*)fwd_kernel, NTHR, LDS_BYTES) != hipSuccess || per_cu < 1) fprintf(stderr, "kernel_launch: occupancy query reports %d\n", per_cu);
        (void)hipGetLastError();
        grid = cus;
    }
    if (grid < 0) return;
    (void)hipMemsetAsync((char*)d_ws + WS_CTL, 0, CTL_ZERO_BYTES, stream);
    Args a{};
    for (int i = 0; i < 19; ++i) a.in[i] = (const float*)d_in[i];
    a.out = (float*)d_out; a.ws = (unsigned char*)d_ws;
    for (int li = 0; li < N_LAUNCHES; ++li) {
        a.ph_lo = (N_LAUNCHES == 1) ? 0 : li; a.ph_hi = (N_LAUNCHES == 1) ? N_PHASES : li + 1;
#ifdef PROBE
        if (li > PROBE) break;
#endif
        hipLaunchKernelGGL(fwd_kernel, dim3(grid), dim3(NTHR), LDS_BYTES, stream, a);
    }
#ifdef PROBE
    hipLaunchKernelGGL(digest_kernel, dim3(2048), dim3(256), 0, stream, (const unsigned*)d_ws, (float*)d_out);
#endif
}
```

```cpp
#include <hip/hip_runtime.h>
#include <cstdio>
#include <cstdint>
#define GAS __attribute__((address_space(1)))
#define LAS __attribute__((address_space(3)))
#define MK_N_LAUNCHES 1
namespace pg8 {
#define PG8_LAS __attribute__((address_space(3)))
typedef unsigned short bf16_t;
typedef short bf16x8 __attribute__((ext_vector_type(8)));
typedef float f32x4 __attribute__((ext_vector_type(4)));
typedef unsigned u32x4 __attribute__((ext_vector_type(4)));
constexpr int BM = 256, BK = 64, HALF = 128, HTB = HALF * BK * 2  , STAGE_BYTES = 8 * HTB, NXCD = 8, WGM = 8;

__host__ __device__ __forceinline__ int lds_byte(int r, int c) { const int st = (r >> 4) * 2 + (c >> 5), rr = r & 15, cc = c & 31, ob = rr * 64 + cc * 2; return st * 1024 + (ob ^ (((ob >> 9) & 1) << 5)); }
__host__ __device__ __forceinline__ void stage_rc(int b, int& R, int& C) { const int st = b / 1024, sb = b % 1024, swz = sb ^ (((sb >> 9) & 1) << 5); R = (st >> 1) * 16 + swz / 64; C = (st & 1) * 32 + (swz % 64) / 2; }
__host__ __device__ __forceinline__ int perm32(int rho) { const int n = rho >> 4, i = rho & 15; return 8 * (i >> 2) + 4 * n + (i & 3); }

struct Unit { int pm, pn; };
struct Gemm { const bf16_t* A; const bf16_t* Bt; int M, N, K; };

struct StaticOrder {
    int nM, nN, nwg, G, c;
    __host__ __device__ void init(int M, int N, int G_, int c_) { nM = M / BM; nN = N / BM; nwg = nM * nN; G = G_; c = c_; }
    __host__ __device__ bool next(int i, Unit& u) const {
        const long L = (long)i * G + c; if (L >= nwg) return false;
        int wgid = (int)L; { const int q = nwg / NXCD, r = nwg % NXCD, xcd = wgid % NXCD, off = wgid / NXCD; wgid = (xcd < r ? xcd * (q + 1) : r * (q + 1) + (xcd - r) * q) + off; }
        const int nig = WGM * nN, gid = wgid / nig, fm = gid * WGM, gsz = (nM - fm) < WGM ? (nM - fm) : WGM;
        u.pm = fm + ((wgid % nig) % gsz); u.pn = (wgid % nig) / gsz; return true;
    }
    __device__ __forceinline__ void a_ready(const Unit&) const {}
    __device__ __forceinline__ void done(const Unit&) const {}
};

__device__ __forceinline__ unsigned cvt_pk_bf16(float lo, float hi) { unsigned r; asm volatile("v_cvt_pk_bf16_f32 %0, %1, %2" : "=v"(r) : "v"(lo), "v"(hi)); return r; }
typedef float f32x2 __attribute__((ext_vector_type(2)));
__device__ __forceinline__ f32x2 gelu_pk(f32x2 v) {
    const f32x2 av = __builtin_elementwise_abs(v), d = av * 0.2316418882f + 1.0f;
    f32x2 t; t.x = __builtin_amdgcn_rcpf(d.x); t.y = __builtin_amdgcn_rcpf(d.y);
    f32x2 q = t * 0.5307027145f + (-0.7265760135f); q = q * t + 0.7107068705f; q = q * t + (-0.142248368f); q = q * t + 0.127414796f; q = q * t;
    const f32x2 s = (v * v) * (-0.72134752044f);
    f32x2 e; e.x = __builtin_amdgcn_exp2f(s.x); e.y = __builtin_amdgcn_exp2f(s.y);
    const f32x2 m = v * (q * e), r = v - m;
    f32x2 o; o.x = v.x < 0.f ? m.x : r.x; o.y = v.y < 0.f ? m.y : r.y; return o;
}

typedef int i32x4v __attribute__((ext_vector_type(4)));
typedef int i32x8v __attribute__((ext_vector_type(8)));
__device__ __forceinline__ i32x8v cat8(bf16x8 lo, bf16x8 hi) { return __builtin_shufflevector(__builtin_bit_cast(i32x4v, lo), __builtin_bit_cast(i32x4v, hi), 0, 1, 2, 3, 4, 5, 6, 7); }
template <class Epi, class Sched, bool ALIGN_EPI = false, bool SP2 = false, int QM = 0>
__device__ __forceinline__ void gemm_phase(PG8_LAS unsigned char* lds, const Gemm g, const Sched& S, const Epi& E) {
    const int tid = threadIdx.x, wid = __builtin_amdgcn_readfirstlane(tid >> 6), lane = tid & 63, wr = wid >> 2, wc = wid & 3, fr = lane & 15, fq = lane >> 4;
    constexpr bool F8 = QM == 1, I8 = QM == 2;
    const int K = g.K, KB = QM ? K : 2 * K  , nt = KB / (BK * 2);
    unsigned voffA[2], voffB[2];
#pragma unroll
    for (int i = 0; i < 2; ++i) { int R, C; stage_rc(tid * 16 + i * 8192, R, C); const int Rb = Epi::PERM ? ((R & ~31) + perm32(R & 31)) : R;
        voffA[i] = (unsigned)(R * KB + C * 2); voffB[i] = (unsigned)(Rb * KB + C * 2); }
    const size_t kstep = (size_t)(BK * 2);
    const size_t hstep = (size_t)HALF * KB;
    const size_t tstep = 2 * hstep;
    const unsigned ldsw = (unsigned)wid * 1024u;
    const int aoff = lds_byte(wr * 64 + fr, fq * 8), boff = lds_byte(wc * 32 + fr, fq * 8);
#define PG8_SA(b, h) (((b) * 2 + (h)) * HTB)
#define PG8_SB(b, h) ((4 + (b) * 2 + (h)) * HTB)
#define PG8_STAGE(bufoff, gbase, voff) do { _Pragma("unroll") for (int _i = 0; _i < 2; ++_i) \
        __builtin_amdgcn_global_load_lds((const unsigned*)((const char*)(gbase) + (voff)[_i]), (PG8_LAS unsigned*)(lds + (bufoff) + ldsw + _i * 8192), 16, 0, 0); } while (0)
#define PG8_LD16(off) (*(const PG8_LAS bf16x8*)(lds + (off)))
#define PG8_LDA(dst, b, h) do { _Pragma("unroll") for (int m = 0; m < 4; ++m) { if constexpr (F8) dst##8[m] = cat8(PG8_LD16(PG8_SA(b, h) + aoff + m * 2048), PG8_LD16(PG8_SA(b, h) + aoff + m * 2048 + 1024)); \
        else { _Pragma("unroll") for (int k = 0; k < 2; ++k) dst[m][k] = PG8_LD16(PG8_SA(b, h) + aoff + m * 2048 + k * 1024); } } } while (0)
#define PG8_LDB(dst, b, h) do { _Pragma("unroll") for (int n = 0; n < 2; ++n) { if constexpr (F8) dst##8[n] = cat8(PG8_LD16(PG8_SB(b, h) + boff + n * 2048), PG8_LD16(PG8_SB(b, h) + boff + n * 2048 + 1024)); \
        else { _Pragma("unroll") for (int k = 0; k < 2; ++k) dst[n][k] = PG8_LD16(PG8_SB(b, h) + boff + n * 2048 + k * 1024); } } } while (0)
#define PG8_MMA(ai, bj, At, Bt) do { __builtin_amdgcn_s_setprio(1); _Pragma("unroll") for (int m = 0; m < 4; ++m) _Pragma("unroll") for (int n = 0; n < 2; ++n) { \
        if constexpr (F8) asm volatile("v_mfma_f32_16x16x128_f8f6f4 %0, %1, %2, %0" : "+v"(acc[ai][bj][m][n]) : "v"(Bt##8[n]), "v"(At##8[m])); \
        else if constexpr (I8) { _Pragma("unroll") for (int k = 0; k < 2; ++k) acc[ai][bj][m][n] = __builtin_bit_cast(f32x4, __builtin_amdgcn_mfma_i32_16x16x64_i8(__builtin_bit_cast(i32x4v, Bt[n][k]), __builtin_bit_cast(i32x4v, At[m][k]), __builtin_bit_cast(i32x4v, acc[ai][bj][m][n]), 0, 0, 0)); } \
        else { _Pragma("unroll") for (int k = 0; k < 2; ++k) acc[ai][bj][m][n] = __builtin_amdgcn_mfma_f32_16x16x32_bf16(Bt[n][k], At[m][k], acc[ai][bj][m][n], 0, 0, 0); } } \
        __builtin_amdgcn_s_setprio(0); } while (0)
#define PG8_WAIT_V(n) asm volatile("s_waitcnt vmcnt(" #n ")" ::: "memory")
#define PG8_WAIT_L(n) asm volatile("s_waitcnt lgkmcnt(" #n ")" ::: "memory")
#define PG8_BAR __builtin_amdgcn_s_barrier()
#define PG8_SCHED __builtin_amdgcn_sched_barrier(0)
    Unit cur, nxt; int ui = 0;
    if (!S.next(0, cur)) return;
    f32x4 acc[2][2][4][2];
#pragma unroll
    for (int a = 0; a < 2; ++a)
#pragma unroll
        for (int b = 0; b < 2; ++b)
#pragma unroll
            for (int m = 0; m < 4; ++m)
#pragma unroll
                for (int n = 0; n < 2; ++n) acc[a][b][m][n] = (f32x4){0.f, 0.f, 0.f, 0.f};
    bf16x8 At[4][2], B0[2][2], B1[2][2]; i32x8v At8[4], B08[2], B18[2];
    const char* cA = (const char*)g.A + (size_t)cur.pm * tstep; const char* cB = (const char*)g.Bt + (size_t)cur.pn * tstep;
    S.a_ready(cur);
    if constexpr (SP2) {
        PG8_STAGE(PG8_SB(0, 0), cB, voffB); PG8_STAGE(PG8_SB(0, 1), cB + hstep, voffB); PG8_STAGE(PG8_SA(0, 0), cA, voffA); PG8_STAGE(PG8_SA(0, 1), cA + hstep, voffA);
        if (wr == 1) PG8_BAR;
        PG8_WAIT_V(2); PG8_BAR;
        PG8_STAGE(PG8_SB(1, 0), cB + kstep, voffB); PG8_STAGE(PG8_SA(1, 0), cA + kstep, voffA); PG8_STAGE(PG8_SB(1, 1), cB + hstep + kstep, voffB);
        PG8_WAIT_V(6); PG8_BAR;
    } else {
        PG8_STAGE(PG8_SB(0, 0), cB, voffB); PG8_STAGE(PG8_SA(0, 0), cA, voffA); PG8_STAGE(PG8_SB(0, 1), cB + hstep, voffB); PG8_STAGE(PG8_SA(0, 1), cA + hstep, voffA);
        if (wr == 1) PG8_BAR;
        PG8_WAIT_V(4); PG8_BAR;
        PG8_STAGE(PG8_SB(1, 0), cB + kstep, voffB); PG8_STAGE(PG8_SA(1, 0), cA + kstep, voffA); PG8_STAGE(PG8_SB(1, 1), cB + hstep + kstep, voffB);
        PG8_WAIT_V(6); PG8_BAR;
    }
    for (;;) {
        const bool has_next = S.next(ui + 1, nxt);
        const char* nA = has_next ? (const char*)g.A + (size_t)nxt.pm * tstep : cA; const char* nB = has_next ? (const char*)g.Bt + (size_t)nxt.pn * tstep : cB;
        for (int t = 0; t < nt; t += 2) {
            const bool last = (t == nt - 2);
            const char* a1 = cA + (size_t)(t + 1) * kstep;
            const char* a2 = last ? nA : cA + (size_t)(t + 2) * kstep; const char* b2 = last ? nB : cB + (size_t)(t + 2) * kstep;
            const char* a3 = a2 + kstep; const char* b3 = b2 + kstep;
            if (last && has_next) S.a_ready(nxt);
            if constexpr (SP2) {
            PG8_LDB(B0, 0, 0); PG8_LDB(B1, 0, 1); PG8_SCHED; PG8_LDA(At, 0, 0); PG8_STAGE(PG8_SA(1, 1), a1 + hstep, voffA);
            PG8_WAIT_V(8); PG8_WAIT_L(0); PG8_BAR; PG8_MMA(0, 0, At, B0); PG8_MMA(0, 1, At, B1); PG8_BAR; PG8_SCHED;
            PG8_LDA(At, 0, 1); PG8_STAGE(PG8_SB(0, 0), b2, voffB); PG8_STAGE(PG8_SB(0, 1), b2 + hstep, voffB); PG8_STAGE(PG8_SA(0, 0), a2, voffA);
            PG8_WAIT_V(8); PG8_WAIT_L(0); PG8_BAR; PG8_MMA(1, 0, At, B0); PG8_MMA(1, 1, At, B1); PG8_BAR; PG8_SCHED;
            PG8_LDB(B0, 1, 0); PG8_LDB(B1, 1, 1); PG8_SCHED; PG8_LDA(At, 1, 0); PG8_STAGE(PG8_SA(0, 1), a2 + hstep, voffA);
            PG8_WAIT_V(8); PG8_WAIT_L(0); PG8_BAR; PG8_MMA(0, 0, At, B0); PG8_MMA(0, 1, At, B1); PG8_BAR; PG8_SCHED;
            PG8_LDA(At, 1, 1); PG8_STAGE(PG8_SB(1, 0), b3, voffB); PG8_STAGE(PG8_SB(1, 1), b3 + hstep, voffB); PG8_STAGE(PG8_SA(1, 0), a3, voffA);
            PG8_WAIT_V(8); PG8_WAIT_L(0); PG8_BAR; PG8_MMA(1, 0, At, B0); PG8_MMA(1, 1, At, B1); PG8_BAR; PG8_SCHED;
            } else {
            PG8_LDB(B0, 0, 0); PG8_SCHED; PG8_LDA(At, 0, 0); PG8_STAGE(PG8_SA(1, 1), a1 + hstep, voffA);
            PG8_WAIT_L(8); PG8_BAR; PG8_WAIT_L(0); PG8_MMA(0, 0, At, B0); PG8_BAR; PG8_SCHED;
            PG8_LDB(B1, 0, 1); PG8_STAGE(PG8_SB(0, 0), b2, voffB);
            PG8_BAR; PG8_WAIT_L(0); PG8_MMA(0, 1, At, B1); PG8_BAR;
            PG8_LDA(At, 0, 1); PG8_STAGE(PG8_SA(0, 0), a2, voffA);
            PG8_BAR; PG8_WAIT_L(0); PG8_MMA(1, 0, At, B0); PG8_BAR; PG8_SCHED;
            PG8_STAGE(PG8_SB(0, 1), b2 + hstep, voffB);
            PG8_WAIT_V(6); PG8_BAR; PG8_MMA(1, 1, At, B1); PG8_BAR;
            PG8_LDB(B0, 1, 0); PG8_SCHED; PG8_LDA(At, 1, 0); PG8_STAGE(PG8_SA(0, 1), a2 + hstep, voffA);
            PG8_WAIT_L(8); PG8_BAR; PG8_WAIT_L(0); PG8_MMA(0, 0, At, B0); PG8_BAR; PG8_SCHED;
            PG8_LDB(B1, 1, 1); PG8_STAGE(PG8_SB(1, 0), b3, voffB);
            PG8_BAR; PG8_WAIT_L(0); PG8_MMA(0, 1, At, B1); PG8_BAR;
            PG8_LDA(At, 1, 1); PG8_STAGE(PG8_SA(1, 0), a3, voffA);
            PG8_BAR; PG8_WAIT_L(0); PG8_MMA(1, 0, At, B0); PG8_BAR; PG8_SCHED;
            PG8_STAGE(PG8_SB(1, 1), b3 + hstep, voffB);
            PG8_WAIT_V(6); PG8_BAR; PG8_MMA(1, 1, At, B1); PG8_BAR;
            }
        }
        if constexpr (ALIGN_EPI) { if (wr == 0) PG8_BAR; }
        if constexpr (F8) asm volatile("s_nop 15\n\ts_nop 15" ::: "memory");
        if constexpr (!Epi::AFTER_DRAIN) { E(acc, cur, wr, wc, fr, fq); S.done(cur); }
        if (!has_next) break;
#pragma unroll
        for (int a = 0; a < 2; ++a)
#pragma unroll
            for (int b = 0; b < 2; ++b)
#pragma unroll
                for (int m = 0; m < 4; ++m)
#pragma unroll
                    for (int n = 0; n < 2; ++n) acc[a][b][m][n] = (f32x4){0.f, 0.f, 0.f, 0.f};
        cur = nxt; cA = nA; cB = nB; ++ui;
        if constexpr (ALIGN_EPI) { if (wr == 1) PG8_BAR; }
    }
    PG8_WAIT_V(0);
    if constexpr (!ALIGN_EPI) { if (wr == 0) PG8_BAR; }
    PG8_BAR;
    if constexpr (Epi::AFTER_DRAIN) { E.fused(acc, cur, wr, wc, fr, fq, lds, wid, lane); S.done(cur); }
#undef PG8_SA
#undef PG8_SB
#undef PG8_STAGE
#undef PG8_LD16
#undef PG8_LDA
#undef PG8_LDB
#undef PG8_MMA
#undef PG8_WAIT_V
#undef PG8_WAIT_L
#undef PG8_BAR
#undef PG8_SCHED
}
}
typedef unsigned short bf16;
typedef unsigned v4u __attribute__((ext_vector_type(4)));
typedef unsigned v2u __attribute__((ext_vector_type(2)));
typedef float f32x4 __attribute__((ext_vector_type(4)));
typedef float f32x2 __attribute__((ext_vector_type(2)));
typedef short bf16x8 __attribute__((ext_vector_type(8)));
typedef GAS unsigned gu32;
#define RLX_AGENT __ATOMIC_RELAXED, __HIP_MEMORY_SCOPE_AGENT
#define LDS_WAIT() asm volatile("s_waitcnt lgkmcnt(0)" ::: "memory")
#define VM_WAIT() asm volatile("s_waitcnt vmcnt(0)" ::: "memory")
typedef __bf16 bf16x2_hw __attribute__((ext_vector_type(2)));
__device__ __forceinline__ unsigned pk2(float lo, float hi) { const f32x2 v = {lo, hi}; const bf16x2_hw b = __builtin_convertvector(v, bf16x2_hw); return __builtin_bit_cast(unsigned, b); }
__device__ __forceinline__ unsigned pk4f8(float a, float b, float c, float d) { int w = 0; w = __builtin_amdgcn_cvt_pk_fp8_f32(a, b, w, false); w = __builtin_amdgcn_cvt_pk_fp8_f32(c, d, w, true); return (unsigned)w; }
__device__ __forceinline__ float cvt_ub0(unsigned w) { float f; asm("v_cvt_f32_ubyte0 %0, %1" : "=v"(f) : "v"(w)); return f; }
__device__ __forceinline__ float cvt_ub1(unsigned w) { float f; asm("v_cvt_f32_ubyte1 %0, %1" : "=v"(f) : "v"(w)); return f; }
__device__ __forceinline__ float cvt_ub2(unsigned w) { float f; asm("v_cvt_f32_ubyte2 %0, %1" : "=v"(f) : "v"(w)); return f; }
__device__ __forceinline__ float cvt_ub3(unsigned w) { float f; asm("v_cvt_f32_ubyte3 %0, %1" : "=v"(f) : "v"(w)); return f; }
__device__ __forceinline__ unsigned f2bf(float f) { return pk2(f, 0.f) & 0xffffu; }
__device__ __forceinline__ float bflo(unsigned w) { return __builtin_bit_cast(float, w << 16); }
__device__ __forceinline__ float bfhi(unsigned w) { return __builtin_bit_cast(float, w & 0xffff0000u); }
__device__ __forceinline__ float bf1(bf16 b) { return __builtin_bit_cast(float, ((unsigned)b) << 16); }
__device__ __forceinline__ float fast_exp(float x) { return __builtin_amdgcn_exp2f(x * 1.4426950408889634f); }
__device__ __forceinline__ float fast_rcp(float x) { return __builtin_amdgcn_rcpf(x); }
__device__ __forceinline__ float sigmoidf_(float x) { return fast_rcp(1.0f + fast_exp(-x)); }
__device__ __forceinline__ float siluf_(float x) { return x * sigmoidf_(x); }
template <int CTRL> __device__ __forceinline__ float dppf(float v) { return __builtin_bit_cast(float, __builtin_amdgcn_mov_dpp(__builtin_bit_cast(int, v), CTRL, 0xF, 0xF, true)); }
template <int CTRL> __device__ __forceinline__ int dppi(int v) { return __builtin_amdgcn_mov_dpp(v, CTRL, 0xF, 0xF, true); }
__device__ __forceinline__ float rdl(float v, int l) { return __builtin_bit_cast(float, __builtin_amdgcn_readlane(__builtin_bit_cast(int, v), l)); }
__device__ __forceinline__ float wave_sum(float v) {
    v += dppf<0xB1>(v); v += dppf<0x4E>(v); v += dppf<0x141>(v); v += dppf<0x140>(v);
    return (rdl(v, 0) + rdl(v, 16)) + (rdl(v, 32) + rdl(v, 48));
}
__device__ __forceinline__ float wave_max(float v) {
    v = fmaxf(v, dppf<0xB1>(v)); v = fmaxf(v, dppf<0x4E>(v)); v = fmaxf(v, dppf<0x141>(v)); v = fmaxf(v, dppf<0x140>(v));
    return fmaxf(fmaxf(rdl(v, 0), rdl(v, 16)), fmaxf(rdl(v, 32), rdl(v, 48)));
}
__device__ __forceinline__ int wave_sum_i(int v) {
    v += dppi<0xB1>(v); v += dppi<0x4E>(v); v += dppi<0x141>(v); v += dppi<0x140>(v);
    return (__builtin_amdgcn_readlane(v, 0) + __builtin_amdgcn_readlane(v, 16)) + (__builtin_amdgcn_readlane(v, 32) + __builtin_amdgcn_readlane(v, 48));
}

constexpr int NWAVES = 8, NTHR = 512;
constexpr int SEQ = 16384, DM = 2048, NH = 8, HD = 128, HW = 1024;
constexpr int CK = 64, NCHUNK = SEQ / CK, NSEG = 16, CPS = NCHUNK / NSEG;
constexpr int INW = 13344;
constexpr int N1 = 9216;
constexpr float EPS = 1e-6f;
constexpr int PEER_K = 16;

constexpr size_t MiB = (size_t)1 << 20;
constexpr size_t WS_CTL = 0, CTL_ZERO_BYTES = 1 * MiB;
#ifndef P11C_A2
#define P11C_A2 0
#endif
#ifndef P11C_NTK
#define P11C_NTK 2
#endif
#ifndef B8_SPLIT
#define B8_SPLIT 1
#endif
#ifndef P11C_MFMA
#define P11C_MFMA 2
#endif
#ifndef PEER_LOCAL
#define PEER_LOCAL 1
#endif
#ifndef P11A_S2MERGE
#define P11A_S2MERGE 1
#endif
#ifndef S1_BATCH2
#define S1_BATCH2 1
#endif
#ifndef S1_STAGED
#define S1_STAGED 0
#endif
#ifndef S4_STAGED
#define S4_STAGED 1
#endif
#ifndef S3_MFMA
#define S3_MFMA 1
#endif
#ifndef GATE_IN_G1
#define GATE_IN_G1 0
#endif
constexpr size_t WS_GA8 = 80 * MiB, WS_GB8 = 112 * MiB;
constexpr size_t WS_WG = GATE_IN_G1 ? 60 * MiB : 2 * MiB, WS_WPA = 18 * MiB, WS_WPB = 22 * MiB, WS_WOUT = 26 * MiB, WS_WS = 34 * MiB, WS_W1 = 42 * MiB;
constexpr size_t WS_XN = 80 * MiB;
constexpr size_t WS_H = 144 * MiB;
constexpr size_t WS_GAB = 432 * MiB;
constexpr size_t WS_HL = 434 * MiB;
constexpr size_t WS_HDS = 450 * MiB;
constexpr size_t WS_OHF = 452 * MiB, WS_OHB = 484 * MiB;
constexpr size_t WS_GSC = 516 * MiB;
constexpr size_t WS_UTF = 144 * MiB, WS_UTB = 176 * MiB, WS_WF = 208 * MiB, WS_WB = 240 * MiB;
constexpr size_t DO_AQKF = 0, DO_AQKB = 16 * MiB, DO_QN = 32 * MiB, DO_KNT = 64 * MiB;
constexpr size_t WS_GL = 42 * MiB, WS_GP = 58 * MiB;
constexpr size_t WS_OGF = 304 * MiB, WS_OGB = 336 * MiB;
constexpr size_t WS_YA = 42 * MiB, WS_YB = 368 * MiB;
#ifndef X_FROM_Q
#define X_FROM_Q 0
#endif
#ifndef FG_U8
#define FG_U8 1
#endif
#ifndef TBL_BESIDE
#define TBL_BESIDE 0
#endif
constexpr size_t WS_TU = TBL_BESIDE ? 80 * MiB : 144 * MiB, WS_TV = TBL_BESIDE ? 96 * MiB : 176 * MiB;
constexpr size_t WS_PSC = 520 * MiB;
constexpr size_t WS_GT = 272 * MiB, WS_GT2 = 400 * MiB;
constexpr size_t WS_X1B = 400 * MiB;
constexpr size_t WS_SC = 272 * MiB;
constexpr size_t WS_END = 536 * MiB;
#ifndef QM_G1_
#define QM_G1_ 2
#endif
#ifndef QM_GATE_
#define QM_GATE_ 2
#endif
#ifndef QM_MIX_
#define QM_MIX_ 2
#endif
#ifndef QM_OUT_
#define QM_OUT_ 2
#endif
constexpr int QM_G1 = QM_G1_, QM_GATE = QM_GATE_, QM_MIX = QM_MIX_, QM_OUT = QM_OUT_;
constexpr int QM_XN = QM_G1 ? QM_G1 : QM_GATE;
static_assert(QM_G1 == 0 || QM_GATE == 0 || QM_G1 == QM_GATE, "xn has one 8-bit copy");
constexpr float F8_WSCALE = 128.0f;
constexpr size_t WS_WAB = 78 * MiB;
constexpr size_t DO_XN8 = 96 * MiB;
constexpr size_t WS_GT8 = 336 * MiB;
constexpr size_t WS_QW = 521 * MiB;
constexpr int QW_W1 = 0, QW_WG = 9216, QW_WPA = 13312, QW_WPB = 15360, QW_WOUT = 17408, QW_WAB = 19456;
constexpr bool AB_I8 = QM_XN == 2;
constexpr bool XN_BF16 = QM_G1 == 0 || QM_GATE == 0 || !AB_I8;
constexpr size_t WS_QX = 522 * MiB;
#ifndef VFMT
#define VFMT 4
#endif
#ifndef FP6_IL
#define FP6_IL 1
#endif
#ifndef V16
#define V16 1
#endif
typedef _Float16 h2_t __attribute__((ext_vector_type(2)));
constexpr int TV_PITCH = (VFMT == 6 || VFMT == 64) ? 1536 : VFMT == 4 ? 1024 : 2048;
#ifndef VMIX_C
#define VMIX_C 1.0f
#endif
constexpr size_t WS_TV4 = 240 * MiB;
#ifndef MIX_HAD
#define MIX_HAD 1
#endif
#ifndef P11B_DIRECT
#define P11B_DIRECT 1
#endif
#ifndef P11_FUSED
#define P11_FUSED 0
#endif
#ifndef QM_SC_
#define QM_SC_ 0
#endif
constexpr int QM_SC = QM_SC_;
constexpr size_t WS_X18 = 464 * MiB;
#ifndef P11B_SLICED
#define P11B_SLICED 1
#endif
#ifndef P11C_SLICED
#define P11C_SLICED 0
#endif
#ifndef NSL_LOG
#define NSL_LOG 3
#endif
#define NSLICES (1 << NSL_LOG)
#ifndef P11B_SORT
#define P11B_SORT 1
#endif
#ifndef UFMT
#define UFMT 4
#endif
#ifndef U4_SWAP
#define U4_SWAP 0
#endif
constexpr int TU_PITCH = UFMT == 4 ? 1024 : 1536;
typedef float v16f __attribute__((ext_vector_type(16)));
typedef float v32f __attribute__((ext_vector_type(32)));
typedef unsigned v6u __attribute__((ext_vector_type(6)));
constexpr int CW_ROWMAX = 65536;
constexpr int CW_BAR = 4096;

constexpr int LDS_BYTES = 163840;
constexpr int MISC_OFF = 163840 - 256;
constexpr int LDS_USABLE = MISC_OFF;

__device__ __forceinline__ bf16x8 ldfrag(const LAS bf16* T, int pitch, int row, int k) { return *(const LAS bf16x8*)(T + row * pitch + k); }
__device__ __forceinline__ f32x4 mfma16(bf16x8 x, bf16x8 y, f32x4 c) { return __builtin_amdgcn_mfma_f32_16x16x32_bf16(x, y, c, 0, 0, 0); }
__device__ __forceinline__ v2u pack4(f32x4 v) { v2u r; r.x = pk2(v[0], v[1]); r.y = pk2(v[2], v[3]); return r; }
#define XB_TMO      128
#define XB_XCNT(j)  (256  + 64 * (j))
#define XB_XSUB(j)  (1280 + 64 * (j))
#define XB_XGEN(j)  (2304 + 64 * (j))
#define XB_TOP      3328
#define XB_TOPGEN   3392
#define XCD_BAR_WORDS 3456
#define XB_SPIN_CAP (1u << 18)

__device__ __forceinline__ unsigned xb_ld(unsigned* p)              { return __hip_atomic_load(p, __ATOMIC_RELAXED, __HIP_MEMORY_SCOPE_AGENT); }
__device__ __forceinline__ unsigned xb_add(unsigned* p, unsigned v) { return __hip_atomic_fetch_add(p, v, __ATOMIC_RELAXED, __HIP_MEMORY_SCOPE_AGENT); }
__device__ __forceinline__ unsigned xb_xcc_id() { return (unsigned)__builtin_amdgcn_s_getreg((3 << 11) | 20) & 0xFu; }
#define XB_SPIN(cond, bar) do { unsigned _sp = 0; while (cond) { __builtin_amdgcn_s_sleep(1); \
    if ((++_sp & 255u) == 0u) { if (xb_ld(&(bar)[XB_TMO])) break; if (_sp > XB_SPIN_CAP) { atomicAdd(&(bar)[XB_TMO], 1u); break; } } } } while (0)

struct XcdBarrier {
    unsigned* bar; unsigned x;
    volatile LAS unsigned* st;
};

__device__ __forceinline__ XcdBarrier xcd_barrier_post(unsigned* bar, volatile LAS unsigned* st) {
    XcdBarrier b; b.bar = bar; b.x = xb_xcc_id(); b.st = st;
    if (threadIdx.x == 0) (void)xb_add(&bar[XB_XCNT(b.x)], 1u);
    return b;
}
__device__ __forceinline__ void xcd_barrier_complete(unsigned* bar, unsigned x, unsigned& nloc, unsigned& nx) {
    const unsigned G = gridDim.x * gridDim.y * gridDim.z;
    unsigned sum, cnt, mine, sp = 0u;
    for (;;) {
        sum = 0u; cnt = 0u; mine = 0u;
#pragma unroll
        for (unsigned j = 0; j < 16; ++j) { const unsigned c = xb_ld(&bar[XB_XCNT(j)]); sum += c; cnt += (c > 0u) ? 1u : 0u; mine = (j == x) ? c : mine; }
        if (sum == G) break;
        __builtin_amdgcn_s_sleep(1);
        if ((++sp & 255u) == 0u) { if (xb_ld(&bar[XB_TMO])) break; if (sp > XB_SPIN_CAP) { atomicAdd(&bar[XB_TMO], 1u); break; } }
    }
    nloc = mine > 0u ? mine : 1u; nx = cnt > 0u ? cnt : 1u;
}

__device__ __forceinline__ void xcd_barrier(const XcdBarrier& b) {
    asm volatile("s_waitcnt vmcnt(0)" ::: "memory");
    __syncthreads();
    if (threadIdx.x == 0) {
        unsigned* bar = b.bar;
        __builtin_amdgcn_s_waitcnt(0);
        unsigned nloc = b.st[0], nx = b.st[1];
        if (nloc == 0u) { xcd_barrier_complete(bar, b.x, nloc, nx); b.st[0] = nloc; b.st[1] = nx; }
        const unsigned old = xb_add(&bar[XB_XSUB(b.x)], 1u);
        const unsigned gen = old / nloc;
        if (old + 1u == (gen + 1u) * nloc) {
            __builtin_amdgcn_fence(__ATOMIC_RELEASE, "agent");
            asm volatile("s_waitcnt vmcnt(0)" ::: "memory");
            const unsigned og = xb_add(&bar[XB_TOP], 1u);
            const unsigned tg = og / nx;
            if (og + 1u == (tg + 1u) * nx) xb_add(&bar[XB_TOPGEN], 1u);
            else XB_SPIN(xb_ld(&bar[XB_TOPGEN]) == tg, bar);
            __builtin_amdgcn_fence(__ATOMIC_ACQUIRE, "agent");
            xb_add(&bar[XB_XGEN(b.x)], 1u);
            asm volatile("s_waitcnt vmcnt(0)" ::: "memory");
        } else {
            XB_SPIN(xb_ld(&bar[XB_XGEN(b.x)]) == gen, bar);
            __builtin_amdgcn_fence(__ATOMIC_ACQUIRE, "agent");
            asm volatile("s_waitcnt vmcnt(0)" ::: "memory");
        }
    }
    __syncthreads();
}

struct Frame {
    LAS unsigned char* lds;
    volatile LAS unsigned* MISC;
    gu32* ctl;
    int tid, lane, wave, vcu, G;
    const float* in[19]; float* out; unsigned char* ws;
};
enum { I_X = 0, I_N1W, I_WIN, I_LB, I_HNW, I_CONVW, I_ALOG, I_DTB, I_GNW, I_WPA, I_WPB, I_WOUT, I_N2W, I_WQ, I_K1, I_K2, I_PU, I_PV, I_FNW };

template <bool F8>
__device__ __forceinline__ void p0_transpose_item(const float* W, int ldw, int c0, int K, int ncols, void* WTv, int row_off, LAS float* scr, int item, int lane) {
    const int nblk = ncols / 32, kb = item / nblk, nb = item % nblk, k0 = 64 * kb, n0 = 32 * nb;
#pragma unroll 8
    for (int i = 0; i < 32; ++i) { const int kk = 2 * i + (lane >> 5); scr[kk * 33 + (lane & 31)] = W[(size_t)(k0 + kk) * ldw + c0 + n0 + (lane & 31)]; }
    LDS_WAIT(); asm volatile("" ::: "memory");
    const int c = lane & 7;
#pragma unroll
    for (int j = 0; j < 4; ++j) { const int n = (lane >> 3) + 8 * j; const LAS float* s = scr + (8 * c) * 33 + n;
        if (F8) { v2u o; o.x = pk4f8(s[0 * 33] * F8_WSCALE, s[1 * 33] * F8_WSCALE, s[2 * 33] * F8_WSCALE, s[3 * 33] * F8_WSCALE); o.y = pk4f8(s[4 * 33] * F8_WSCALE, s[5 * 33] * F8_WSCALE, s[6 * 33] * F8_WSCALE, s[7 * 33] * F8_WSCALE);
            *(GAS v2u*)((unsigned char*)WTv + (size_t)(row_off + n0 + n) * K + k0 + 8 * c) = o; }
        else { v4u o; o.x = pk2(s[0 * 33], s[1 * 33]); o.y = pk2(s[2 * 33], s[3 * 33]); o.z = pk2(s[4 * 33], s[5 * 33]); o.w = pk2(s[6 * 33], s[7 * 33]);
            *(GAS v4u*)((bf16*)WTv + (size_t)(row_off + n0 + n) * K + k0 + 8 * c) = o; } }
    LDS_WAIT(); asm volatile("" ::: "memory");
}
__device__ __forceinline__ unsigned pk4i8(f32x4 v, float inv) {
    const int a = (int)rintf(v.x * inv), b = (int)rintf(v.y * inv), c = (int)rintf(v.z * inv), d = (int)rintf(v.w * inv);
    return (unsigned)(a & 255) | ((unsigned)(b & 255) << 8) | ((unsigned)(c & 255) << 16) | ((unsigned)d << 24);
}
__device__ __forceinline__ float amax4(f32x4 v) { const f32x4 a = __builtin_elementwise_abs(v); return fmaxf(fmaxf(a.x, a.y), fmaxf(a.z, a.w)); }
__device__ __forceinline__ void rms_row_load(int lane, const float* xrow, f32x4 (&v)[8]) {
    const GAS f32x4* xr = (const GAS f32x4*)xrow + lane;
#pragma unroll
    for (int j = 0; j < 8; ++j) v[j] = xr[64 * j];
}
__device__ __forceinline__ void rms_row_to_bf16(int lane, f32x4 (&v)[8], const float* w, bf16* orow, unsigned char* orow8, float* sx) {
    const GAS f32x4* wr = (const GAS f32x4*)w + lane;
    float s = 0.f;
#pragma unroll
    for (int j = 0; j < 8; ++j) s += (v[j].x * v[j].x + v[j].y * v[j].y) + (v[j].z * v[j].z + v[j].w * v[j].w);
    const float r = 1.0f / sqrtf(wave_sum(s) * (1.f / DM) + EPS);
    GAS v2u* o8 = (GAS v2u*)orow + lane; GAS unsigned* q8 = (GAS unsigned*)orow8 + lane; float am = 0.f;
#pragma unroll
    for (int j = 0; j < 8; ++j) { const f32x4 ww = wr[64 * j]; const f32x4 y = {v[j].x * r * ww.x, v[j].y * r * ww.y, v[j].z * r * ww.z, v[j].w * r * ww.w};
        if (XN_BF16) { v2u o; o.x = pk2(y.x, y.y); o.y = pk2(y.z, y.w); o8[64 * j] = o; }
        if (QM_XN == 1) q8[64 * j] = pk4f8(y.x, y.y, y.z, y.w);
        if (QM_XN == 2) { v[j] = y; am = fmaxf(am, amax4(y)); } }
    if (QM_XN == 2) { am = wave_max(am); const float inv = am > 0.f ? 127.0f / am : 0.f;
#pragma unroll
        for (int j = 0; j < 8; ++j) q8[64 * j] = pk4i8(v[j], inv);
        if (lane == 0) { const float sxv = am > 0.f ? am * (1.0f / 127.0f) : 1.0f; *sx = sxv; sx[3 * SEQ] = sxv / r; } }
}
template <int KT>
__device__ __forceinline__ void p0_quant_item(Frame& F, const float* W, int ldw, int c0, signed char* Wq, float* scl, int n0) {
    constexpr int KW = KT / 8, NB = KW / 64;
    const int col = F.lane & 31, kh = F.lane >> 5;
    const GAS float* src = (const GAS float*)W + (size_t)(F.wave * KW + 32 * kh) * ldw + c0 + n0 + col;
    float v[NB][32]; float mx = 0.f;
#pragma unroll
    for (int b = 0; b < NB; ++b)
#pragma unroll
        for (int i = 0; i < 32; ++i) v[b][i] = src[(size_t)(64 * b + i) * ldw];
    if (MIX_HAD && KT == HW) {
#pragma unroll
        for (int st = 1; st < 32; st <<= 1)
#pragma unroll
            for (int b = 0; b < NB; ++b)
#pragma unroll
                for (int i = 0; i < 32; ++i) if (!(i & st)) { const float p = v[b][i], q = v[b][i + st]; v[b][i] = p + q; v[b][i + st] = p - q; }
#pragma unroll
        for (int b = 0; b < NB; ++b)
#pragma unroll
            for (int i = 0; i < 32; ++i) { const float o = __shfl_xor(v[b][i], 32); v[b][i] = kh ? o - v[b][i] : v[b][i] + o; }
#pragma unroll
        for (int i = 0; i < 32; ++i) { const float p = v[0][i], q = v[NB - 1][i]; v[0][i] = (p + q) * (1.0f / 128.0f); v[NB - 1][i] = (p - q) * (1.0f / 128.0f); }
    }
#pragma unroll
    for (int b = 0; b < NB; ++b)
#pragma unroll
        for (int i = 0; i < 32; ++i) mx = fmaxf(mx, fabsf(v[b][i]));
    mx = fmaxf(mx, __shfl_xor(mx, 32));
    LAS float* part = (LAS float*)F.lds;
    if (kh == 0) part[F.wave * 32 + col] = mx;
    __syncthreads();
    float cm = part[col];
#pragma unroll
    for (int w = 1; w < 8; ++w) cm = fmaxf(cm, part[w * 32 + col]);
    const float inv = cm > 0.f ? 127.0f / cm : 0.f;
    if (F.wave == 0 && kh == 0) scl[n0 + col] = cm > 0.f ? cm * (1.0f / 127.0f) : 1.0f;
    GAS v4u* dst = (GAS v4u*)(Wq + (size_t)(n0 + col) * KT + F.wave * KW + 32 * kh);
#pragma unroll
    for (int b = 0; b < NB; ++b) { unsigned w[8];
#pragma unroll
        for (int q = 0; q < 8; ++q) w[q] = pk4i8((f32x4){v[b][4 * q], v[b][4 * q + 1], v[b][4 * q + 2], v[b][4 * q + 3]}, inv);
        dst[4 * b] = (v4u){w[0], w[1], w[2], w[3]}; dst[4 * b + 1] = (v4u){w[4], w[5], w[6], w[7]}; }
    __syncthreads();
}
__device__ __forceinline__ void p0_ws_item(Frame& F, int it) {
    const int h = it >> 6, half = (it >> 5) & 1, j0 = (it & 31) * 64, hc = h * 256 + half * 128;
    const float* Wq = F.in[I_WQ]; const float* Ks = half ? F.in[I_K2] : F.in[I_K1]; const float* n2 = F.in[I_N2W];
    LAS bf16* Xs = (LAS bf16*)F.lds; LAS bf16* Ys = Xs + 64 * 136;
    { const int row = F.tid >> 3, c0 = (F.tid & 7) * 16; const GAS f32x4* src = (const GAS f32x4*)(Wq + (size_t)(j0 + row) * DM + hc + c0);
      const f32x4 a = src[0], b = src[1], c = src[2], d = src[3];
      v4u o0, o1; o0.x = pk2(a.x, a.y); o0.y = pk2(a.z, a.w); o0.z = pk2(b.x, b.y); o0.w = pk2(b.z, b.w); o1.x = pk2(c.x, c.y); o1.y = pk2(c.z, c.w); o1.z = pk2(d.x, d.y); o1.w = pk2(d.z, d.w);
      *(LAS v4u*)(Xs + row * 136 + c0) = o0; *(LAS v4u*)(Xs + row * 136 + c0 + 8) = o1; }
    { const int row = F.tid >> 2, c0 = (F.tid & 3) * 32; const GAS f32x4* src = (const GAS f32x4*)(Ks + (size_t)row * 128 + c0);
#pragma unroll
      for (int q = 0; q < 4; ++q) { const f32x4 a = src[2 * q], b = src[2 * q + 1]; v4u o; o.x = pk2(a.x, a.y); o.y = pk2(a.z, a.w); o.z = pk2(b.x, b.y); o.w = pk2(b.z, b.w); *(LAS v4u*)(Ys + row * 136 + c0 + 8 * q) = o; } }
    __syncthreads();
    const int fr = F.lane & 15, fq = F.lane >> 4, w = F.wave;
    bf16* WSt = (bf16*)(F.ws + WS_WS);
#pragma unroll
    for (int jt = 0; jt < 4; ++jt) {
        f32x4 acc = {0.f, 0.f, 0.f, 0.f};
#pragma unroll
        for (int k0 = 0; k0 < 4; ++k0) acc = mfma16(ldfrag(Xs, 136, 16 * jt + fr, 32 * k0 + 8 * fq), ldfrag(Ys, 136, 16 * w + fr, 32 * k0 + 8 * fq), acc);
        const int jj = j0 + 16 * jt + 4 * fq; const f32x4 nw = *(const GAS f32x4*)(n2 + jj);
        if (QM_SC == 1) { const f32x4 q = acc * nw * F8_WSCALE; *(GAS unsigned*)((unsigned char*)WSt + (size_t)(hc + 16 * w + fr) * DM + jj) = pk4f8(q[0], q[1], q[2], q[3]); }
        else *(GAS v2u*)(WSt + (size_t)(hc + 16 * w + fr) * DM + jj) = pack4(acc * nw);
    }
    __syncthreads();
}
__device__ __forceinline__ void p0_prologue(Frame& F) {
    LAS float* scr = (LAS float*)(F.lds + F.wave * 16384);
    const int gw = F.vcu * NWAVES + F.wave, NGW = F.G * NWAVES;
    constexpr int I_1 = QM_G1 == 2 ? 0 : (DM / 64) * (N1 / 32), I_AB = AB_I8 ? 0 : (DM / 64), I_G = QM_GATE == 2 ? 0 : (DM / 64) * (4096 / 32), I_PA = QM_MIX == 2 ? 0 : (HW / 64) * (DM / 32), I_O = QM_OUT == 2 ? 0 : (DM / 64) * (DM / 32);
    constexpr int NITEMS = I_1 + I_AB + I_G + 2 * I_PA + I_O;
    for (int it = gw; it < NITEMS; it += NGW) {
        int r = it;
        if (r < I_1) { p0_transpose_item<QM_G1 == 1>(F.in[I_WIN], INW, 0, DM, N1, F.ws + WS_W1, 0, scr, r, F.lane); continue; } r -= I_1;
        if (r < I_AB) { p0_transpose_item<false>(F.in[I_WIN], INW, N1, DM, 32, F.ws + WS_WAB, 0, scr, r, F.lane); continue; } r -= I_AB;
        if (r < I_G) { p0_transpose_item<QM_GATE == 1>(F.in[I_WIN], INW, 9248, DM, 4096, F.ws + WS_WG, 0, scr, r, F.lane); continue; } r -= I_G;
        if (r < I_PA) { p0_transpose_item<QM_MIX == 1>(F.in[I_WPA], DM, 0, HW, DM, F.ws + WS_WPA, 0, scr, r, F.lane); continue; } r -= I_PA;
        if (r < I_PA) { p0_transpose_item<QM_MIX == 1>(F.in[I_WPB], DM, 0, HW, DM, F.ws + WS_WPB, 0, scr, r, F.lane); continue; } r -= I_PA;
        p0_transpose_item<QM_OUT == 1>(F.in[I_WOUT], DM, 0, DM, DM, F.ws + WS_WOUT, 0, scr, r, F.lane);
    }
    bf16* XN = (bf16*)(F.ws + WS_XN); float* QX = (float*)(F.ws + WS_QX);
    { f32x4 va[8], vb[8]; int m = gw; int tl = F.lane; asm volatile("" : "+v"(tl));
#define P0_ROW(V, m_) do { __builtin_amdgcn_sched_barrier(0); rms_row_to_bf16(tl, V, F.in[I_N1W], XN + (size_t)(m_) * DM, (unsigned char*)F.out + DO_XN8 + (size_t)(m_) * DM, QX + (m_)); __builtin_amdgcn_sched_barrier(0); } while (0)
      if (m < SEQ) rms_row_load(tl, F.in[I_X] + (size_t)m * DM, va);
      while (m < SEQ) {
          if (m + NGW < SEQ) rms_row_load(tl, F.in[I_X] + (size_t)(m + NGW) * DM, vb);
          P0_ROW(va, m); m += NGW; if (m >= SEQ) break;
          if (m + NGW < SEQ) rms_row_load(tl, F.in[I_X] + (size_t)(m + NGW) * DM, va);
          P0_ROW(vb, m); m += NGW; }
#undef P0_ROW
    }
    __syncthreads();
    { constexpr int J_1 = (QM_G1 == 2 ? N1 / 32 : 0) + (AB_I8 ? 1 : 0), J_G = QM_GATE == 2 ? 4096 / 32 : 0, J_O = QM_OUT == 2 ? DM / 32 : 0, J_P = QM_MIX == 2 ? DM / 32 : 0;
      float* QW = (float*)(F.ws + WS_QW);
#pragma unroll 1
      for (int it = F.vcu; it < J_1 + J_G + J_O + 2 * J_P; it += F.G) {
          int r = it; const float* W = F.in[I_WIN]; int ldw = INW, c0 = 0, n0 = 0, qo = QW_W1; size_t wo = WS_W1; bool half = false;
          if (r < J_1) { n0 = 32 * r; if (AB_I8 && r == J_1 - 1) { c0 = N1; n0 = 0; qo = QW_WAB; wo = WS_WAB; } }
          else if ((r -= J_1) < J_G) { c0 = 9248; n0 = 32 * r; qo = QW_WG; wo = WS_WG; }
          else if ((r -= J_G) < J_O) { W = F.in[I_WOUT]; ldw = DM; n0 = 32 * r; qo = QW_WOUT; wo = WS_WOUT; }
          else if ((r -= J_O) < J_P) { W = F.in[I_WPA]; ldw = DM; n0 = 32 * r; qo = QW_WPA; wo = WS_WPA; half = true; }
          else { r -= J_P; W = F.in[I_WPB]; ldw = DM; n0 = 32 * r; qo = QW_WPB; wo = WS_WPB; half = true; }
          if (half) p0_quant_item<HW>(F, W, ldw, c0, (signed char*)(F.ws + wo), QW + qo, n0);
          else p0_quant_item<DM>(F, W, ldw, c0, (signed char*)(F.ws + wo), QW + qo, n0);
      } }
    __syncthreads();
    for (int it = blockIdx.x; it < 512; it += F.G) p0_ws_item(F, it);
}
typedef unsigned u32x4 __attribute__((ext_vector_type(4)));
__device__ __forceinline__ u32x4 pack8(f32x4 a, f32x4 b) { u32x4 w; w.x = pk2(a[0], a[1]); w.y = pk2(a[2], a[3]); w.z = pk2(b[0], b[1]); w.w = pk2(b[2], b[3]); return w; }
__device__ __forceinline__ void unpack8(u32x4 w, f32x4& a, f32x4& b) { a = (f32x4){bflo(w.x), bfhi(w.x), bflo(w.y), bfhi(w.y)}; b = (f32x4){bflo(w.z), bfhi(w.z), bflo(w.w), bfhi(w.w)}; }
__device__ __forceinline__ f32x4 silu4(f32x4 v) { return (f32x4){siluf_(v[0]), siluf_(v[1]), siluf_(v[2]), siluf_(v[3])}; }
__device__ __forceinline__ f32x4 sigm4(f32x4 v) { return (f32x4){sigmoidf_(v[0]), sigmoidf_(v[1]), sigmoidf_(v[2]), sigmoidf_(v[3])}; }

typedef int i32x4 __attribute__((ext_vector_type(4)));
template <int QM> __device__ __forceinline__ f32x4 deq(f32x4 a, float sr, f32x4 sc) {
    if (QM == 2) { const i32x4 q = __builtin_bit_cast(i32x4, a); return (f32x4){(float)q[0], (float)q[1], (float)q[2], (float)q[3]} * (sc * sr); }
    if (QM == 1) return a * (1.0f / F8_WSCALE);
    return a;
}
template <int QM, bool PERM> __device__ __forceinline__ void ld_colscale(f32x4 (&scv)[2][2], const float* sb, int cb) {
#pragma unroll
    for (int bj = 0; bj < 2; ++bj)
#pragma unroll
        for (int n = 0; n < 2; ++n) scv[bj][n] = (QM == 2) ? *(const f32x4*)(sb + cb + bj * 128 + (PERM ? 4 : 16) * n) : (f32x4){1.f, 1.f, 1.f, 1.f};
}
__device__ __forceinline__ unsigned pk4u8(f32x4 v) { const unsigned a = (unsigned)(v[0] * 255.f + 0.5f), b = (unsigned)(v[1] * 255.f + 0.5f), c = (unsigned)(v[2] * 255.f + 0.5f), d = (unsigned)(v[3] * 255.f + 0.5f); return a | (b << 8) | (c << 16) | (d << 24); }
__device__ __forceinline__ f32x4 un4u8(unsigned w) { return (f32x4){cvt_ub0(w), cvt_ub1(w), cvt_ub2(w), cvt_ub3(w)} * (1.0f / 255.f); }
struct EpiG1 {
    static constexpr bool PERM = true, AFTER_DRAIN = false;
    unsigned char* ws; const float* lbl;
    const float* sa; const float* sb;
    __device__ __forceinline__ void operator()(const f32x4 (&acc)[2][2][4][2], const pg8::Unit& u, int wr, int wc, int fr, int fq) const {
        const int pn = u.pn, row0 = u.pm * 256 + wr * 64 + fr;
        {
            const int grp = pn >> 2; const bool act = (grp == 0) | (grp == 4) | (grp == 8);
            bf16* base = (bf16*)(ws + WS_H + (size_t)grp * 32 * MiB); const int col0 = (pn & 3) * 256 + wc * 32 + 8 * fq;
            f32x4 scv[2][2]; ld_colscale<QM_G1, true>(scv, sb, pn * 256 + wc * 32 + 8 * fq);
            const bool fgate = (grp == 1) | (grp == 2); f32x4 lbv[2][2];
            if (fgate) { const float* l0 = lbl + (grp - 1) * 2048 + col0;
#pragma unroll
                for (int bj = 0; bj < 2; ++bj)
#pragma unroll
                    for (int n = 0; n < 2; ++n) { const f32x4 a0 = *(const f32x4*)(l0 + bj * 128 + 4 * n), a1 = *(const f32x4*)(l0 + 1024 + bj * 128 + 4 * n);
                        lbv[bj][n] = (f32x4){fast_rcp(1.0f + fast_exp(a1[0] - a0[0])), fast_rcp(1.0f + fast_exp(a1[1] - a0[1])), fast_rcp(1.0f + fast_exp(a1[2] - a0[2])), fast_rcp(1.0f + fast_exp(a1[3] - a0[3]))}; } }
#pragma unroll
            for (int ai = 0; ai < 2; ++ai) { float srv[4];
#pragma unroll
                for (int m = 0; m < 4; ++m) srv[m] = (QM_G1 == 2) ? sa[row0 + ai * 128 + m * 16] : 1.f;
#pragma unroll
                for (int m = 0; m < 4; ++m) { bf16* rowp = base + (size_t)(row0 + ai * 128 + m * 16) * HW + col0; const float sr = srv[m];
#pragma unroll
                    for (int bj = 0; bj < 2; ++bj) { f32x4 v0 = deq<QM_G1>(acc[ai][bj][m][0], sr, scv[bj][0]), v1 = deq<QM_G1>(acc[ai][bj][m][1], sr, scv[bj][1]);
                        if (act) { v0 = silu4(v0); v1 = silu4(v1); }
                        if (fgate) { v0 = lbv[bj][0] + (1.0f - lbv[bj][0]) * sigm4(v0); v1 = lbv[bj][1] + (1.0f - lbv[bj][1]) * sigm4(v1); }
                        if (FG_U8 && fgate) { v2u w8; w8.x = pk4u8(v0); w8.y = pk4u8(v1); *(v2u*)((unsigned char*)base + (size_t)(row0 + ai * 128 + m * 16) * HW + col0 + bj * 128) = w8; }
                        else *(u32x4*)(rowp + bj * 128) = pack8(v0, v1); } } }
        }
    }
};
struct EpiGate {
    static constexpr bool PERM = true, AFTER_DRAIN = false;
    unsigned char* O; const float* sa; const float* sb;
    __device__ __forceinline__ void operator()(const f32x4 (&acc)[2][2][4][2], const pg8::Unit& u, int wr, int wc, int fr, int fq) const {
        const int row0 = u.pm * 256 + wr * 64 + fr, col0 = u.pn * 256 + wc * 32 + 8 * fq;
        f32x4 scv[2][2]; ld_colscale<QM_GATE, true>(scv, sb, col0);
#pragma unroll
        for (int ai = 0; ai < 2; ++ai) { float srv[4];
#pragma unroll
            for (int m = 0; m < 4; ++m) srv[m] = (QM_GATE == 2) ? sa[row0 + ai * 128 + m * 16] : 1.f;
#pragma unroll
            for (int m = 0; m < 4; ++m) { unsigned char* rowp = O + (size_t)(row0 + ai * 128 + m * 16) * DM + col0; const float sr = srv[m];
#pragma unroll
                for (int bj = 0; bj < 2; ++bj) { v2u w; w.x = pk4u8(sigm4(deq<QM_GATE>(acc[ai][bj][m][0], sr, scv[bj][0]))); w.y = pk4u8(sigm4(deq<QM_GATE>(acc[ai][bj][m][1], sr, scv[bj][1]))); *(v2u*)(rowp + bj * 128) = w; } } }
    }
};
struct EpiG1G {
    static constexpr bool PERM = true, AFTER_DRAIN = false;
    EpiG1 a; unsigned char* ga; unsigned char* gb;
    __device__ __forceinline__ void operator()(const f32x4 (&acc)[2][2][4][2], const pg8::Unit& u, int wr, int wc, int fr, int fq) const {
        if (u.pn < 36) { a(acc, u, wr, wc, fr, fq); return; }
        const int row0 = u.pm * 256 + wr * 64 + fr, gcol = (u.pn - 36) * 256 + wc * 32 + 8 * fq; unsigned char* O = gcol < 2048 ? ga : gb; const int col0 = gcol & 2047;
        f32x4 scv[2][2]; ld_colscale<2, true>(scv, a.sb, u.pn * 256 + wc * 32 + 8 * fq);
#pragma unroll
        for (int ai = 0; ai < 2; ++ai)
#pragma unroll
            for (int m = 0; m < 4; ++m) { unsigned char* rowp = O + (size_t)(row0 + ai * 128 + m * 16) * DM + col0; const float sr = a.sa[row0 + ai * 128 + m * 16];
#pragma unroll
                for (int bj = 0; bj < 2; ++bj) { v2u w; w.x = pk4u8(sigm4(deq<2>(acc[ai][bj][m][0], sr, scv[bj][0]))); w.y = pk4u8(sigm4(deq<2>(acc[ai][bj][m][1], sr, scv[bj][1]))); *(v2u*)(rowp + bj * 128) = w; } }
    }
};
template <int MODE> struct EpiMix {
    static constexpr bool PERM = true, AFTER_DRAIN = false;
    bf16* O; const unsigned char* G; unsigned char* O8;
    const float* sa; const float* sb; unsigned* rowmax;
    __device__ __forceinline__ void operator()(const f32x4 (&acc)[2][2][4][2], const pg8::Unit& u, int wr, int wc, int fr, int fq) const {
        const int row0 = u.pm * 256 + wr * 64 + fr, col0 = u.pn * 256 + wc * 32 + 8 * fq;
        f32x4 scv[2][2]; ld_colscale<QM_MIX, true>(scv, sb, col0);
        v2u gn_[2]; u32x4 on_[2]; float srn_;
#define EPMX_LOAD(r_) do { const int rr_ = (r_); const size_t off_ = (size_t)(row0 + (rr_ >> 2) * 128 + (rr_ & 3) * 16) * DM + col0; srn_ = (QM_MIX == 2) ? sa[row0 + (rr_ >> 2) * 128 + (rr_ & 3) * 16] : 1.f; \
            _Pragma("unroll") for (int bj = 0; bj < 2; ++bj) { gn_[bj] = *(const v2u*)(G + off_ + bj * 128); if (MODE == 1) on_[bj] = *(const u32x4*)(O + off_ + bj * 128); } } while (0)
        EPMX_LOAD(0);
#pragma unroll
        for (int r = 0; r < 8; ++r) { const int ai = r >> 2, m = r & 3; const size_t off = (size_t)(row0 + ai * 128 + m * 16) * DM + col0; const float sr = srn_; float rmx = 0.f;
            v2u gc[2]; u32x4 oc[2];
#pragma unroll
            for (int bj = 0; bj < 2; ++bj) { gc[bj] = gn_[bj]; if (MODE == 1) oc[bj] = on_[bj]; }
            if (r + 1 < 8) EPMX_LOAD(r + 1);
#pragma unroll
                for (int bj = 0; bj < 2; ++bj) { f32x4 o0, o1; const v2u gw = gc[bj]; const f32x4 g0 = un4u8(gw.x), g1 = un4u8(gw.y);
                    const f32x4 c0 = deq<QM_MIX>(acc[ai][bj][m][0], sr, scv[bj][0]), c1 = deq<QM_MIX>(acc[ai][bj][m][1], sr, scv[bj][1]);
                    if (MODE == 0) { o0 = g0 * c0; o1 = g1 * c1; }
                    else { unpack8(oc[bj], o0, o1); o0 = o0 + g0 * c0; o1 = o1 + g1 * c1; }
                    if (MODE == 1 && QM_OUT == 1) { v2u w; w.x = pk4f8(o0[0], o0[1], o0[2], o0[3]); w.y = pk4f8(o1[0], o1[1], o1[2], o1[3]); *(v2u*)(O8 + off + bj * 128) = w; }
                    else { const u32x4 pw = pack8(o0, o1); *(u32x4*)(O + off + bj * 128) = pw;
                        if (MODE == 1 && QM_OUT == 2) { f32x4 r0, r1; unpack8(pw, r0, r1); const f32x4 a0 = __builtin_elementwise_abs(r0), a1 = __builtin_elementwise_abs(r1);
                            rmx = fmaxf(rmx, fmaxf(fmaxf(fmaxf(a0[0], a0[1]), fmaxf(a0[2], a0[3])), fmaxf(fmaxf(a1[0], a1[1]), fmaxf(a1[2], a1[3])))); } } }
                if (MODE == 1 && QM_OUT == 2) { rmx = fmaxf(rmx, __shfl_xor(rmx, 16)); rmx = fmaxf(rmx, __shfl_xor(rmx, 32));
                    if (fq == 0) __hip_atomic_fetch_max(rowmax + row0 + ai * 128 + m * 16, __builtin_bit_cast(unsigned, rmx), __ATOMIC_RELAXED, __HIP_MEMORY_SCOPE_AGENT); } }
#undef EPMX_LOAD
    }
};
struct EpiX1 {
    static constexpr bool PERM = false, AFTER_DRAIN = false;
    const float* x; float* out; bf16* xb; unsigned char* x8;
    const unsigned char* xq; const float* xs; const float* n1w;
    const float* sa; const float* sb;
    __device__ __forceinline__ void operator()(const f32x4 (&acc)[2][2][4][2], const pg8::Unit& u, int wr, int wc, int fr, int fq) const {
        const int row0 = u.pm * 256 + wr * 64 + fr, col0 = u.pn * 256 + wc * 32 + 4 * fq;
        f32x4 scw[2][2]; ld_colscale<QM_OUT, false>(scw, sb, col0);
        f32x4 rwv[2][2];
        if (X_FROM_Q) {
#pragma unroll
            for (int bj = 0; bj < 2; ++bj)
#pragma unroll
                for (int n = 0; n < 2; ++n) { const f32x4 wv = *(const f32x4*)(n1w + col0 + bj * 128 + n * 16); rwv[bj][n] = (f32x4){fast_rcp(wv[0]), fast_rcp(wv[1]), fast_rcp(wv[2]), fast_rcp(wv[3])}; } }
#if X_FROM_Q
#pragma unroll
        for (int ai = 0; ai < 2; ++ai)
#pragma unroll
            for (int m = 0; m < 4; ++m) { const size_t off = (size_t)(row0 + ai * 128 + m * 16) * DM + col0; const float xsr = xs[row0 + ai * 128 + m * 16]; const float srw = (QM_OUT == 2) ? sa[row0 + ai * 128 + m * 16] : 1.f;
#pragma unroll
                for (int bj = 0; bj < 2; ++bj)
#pragma unroll
                    for (int n = 0; n < 2; ++n) { const size_t o = off + bj * 128 + n * 16; f32x4 xv;
                        { const unsigned qb = *(const unsigned*)(xq + o) ^ 0x80808080u; const f32x4 sc = rwv[bj][n] * xsr;
                            xv = ((f32x4){cvt_ub0(qb), cvt_ub1(qb), cvt_ub2(qb), cvt_ub3(qb)} - 128.0f) * sc; }
                        const f32x4 v = xv + deq<QM_OUT>(acc[ai][bj][m][n], srw, scw[bj][n]);
                        *(v2u*)(xb + o) = pack4(v); if (QM_SC == 1) *(unsigned*)(x8 + o) = pk4f8(v[0], v[1], v[2], v[3]); } }
#else
        f32x4 xn_[2][2]; float srn_;
#define EPX1_LOAD(r_) do { const int rr_ = (r_); const size_t off_ = (size_t)(row0 + (rr_ >> 2) * 128 + (rr_ & 3) * 16) * DM + col0; srn_ = (QM_OUT == 2) ? sa[row0 + (rr_ >> 2) * 128 + (rr_ & 3) * 16] : 1.f; \
            _Pragma("unroll") for (int bj = 0; bj < 2; ++bj) _Pragma("unroll") for (int n = 0; n < 2; ++n) xn_[bj][n] = *(const f32x4*)(x + off_ + bj * 128 + n * 16); } while (0)
        EPX1_LOAD(0);
#pragma unroll
        for (int r = 0; r < 8; ++r) { const int ai = r >> 2, m = r & 3; const size_t off = (size_t)(row0 + ai * 128 + m * 16) * DM + col0;
            f32x4 xc[2][2]; const float srw = srn_;
#pragma unroll
            for (int bj = 0; bj < 2; ++bj)
#pragma unroll
                for (int n = 0; n < 2; ++n) xc[bj][n] = xn_[bj][n];
            if (r + 1 < 8) EPX1_LOAD(r + 1);
#pragma unroll
            for (int bj = 0; bj < 2; ++bj)
#pragma unroll
                for (int n = 0; n < 2; ++n) { const size_t o = off + bj * 128 + n * 16;
                    const f32x4 v = xc[bj][n] + deq<QM_OUT>(acc[ai][bj][m][n], srw, scw[bj][n]);
                    *(v2u*)(xb + o) = pack4(v); if (QM_SC == 1) *(unsigned*)(x8 + o) = pk4f8(v[0], v[1], v[2], v[3]); } }
#undef EPX1_LOAD
#endif
    }
};
struct EpiBf {
    static constexpr bool PERM = true, AFTER_DRAIN = false;
    bf16* O;
    __device__ __forceinline__ void operator()(const f32x4 (&acc)[2][2][4][2], const pg8::Unit& u, int wr, int wc, int fr, int fq) const {
        const int row0 = u.pm * 256 + wr * 64 + fr, col0 = u.pn * 256 + wc * 32 + 8 * fq;
#pragma unroll
        for (int ai = 0; ai < 2; ++ai)
#pragma unroll
            for (int m = 0; m < 4; ++m) { bf16* rowp = O + (size_t)(row0 + ai * 128 + m * 16) * DM + col0;
#pragma unroll
                for (int bj = 0; bj < 2; ++bj) *(u32x4*)(rowp + bj * 128) = pack8(deq<QM_SC>(acc[ai][bj][m][0], 1.f, (f32x4){1.f, 1.f, 1.f, 1.f}), deq<QM_SC>(acc[ai][bj][m][1], 1.f, (f32x4){1.f, 1.f, 1.f, 1.f})); }
    }
};
struct EpiF32 {
    static constexpr bool PERM = false, AFTER_DRAIN = false;
    float* C;
    __device__ __forceinline__ void operator()(const f32x4 (&acc)[2][2][4][2], const pg8::Unit& u, int wr, int wc, int fr, int fq) const {
        const int row0 = u.pm * 256 + wr * 64 + fr, col0 = u.pn * 256 + wc * 32 + 4 * fq;
#pragma unroll
        for (int ai = 0; ai < 2; ++ai)
#pragma unroll
            for (int m = 0; m < 4; ++m) { float* rowp = C + (size_t)(row0 + ai * 128 + m * 16) * DM + col0;
#pragma unroll
                for (int bj = 0; bj < 2; ++bj)
#pragma unroll
                    for (int n = 0; n < 2; ++n) *(f32x4*)(rowp + bj * 128 + n * 16) = acc[ai][bj][m][n]; }
    }
};

__device__ __forceinline__ void p1_ab(Frame& F) {
    float* Gab = (float*)(F.ws + WS_GAB);
    const int fr = F.lane & 15, fq = F.lane >> 4, rt = F.wave >> 1, ct = F.wave & 1;
    if (AB_I8) {
        const signed char* XQ = (const signed char*)F.out + DO_XN8; const signed char* Wab = (const signed char*)(F.ws + WS_WAB);
        const float* QX = (const float*)(F.ws + WS_QX); const f32x4 sw = *(const f32x4*)((const float*)(F.ws + WS_QW) + QW_WAB + ct * 16 + 4 * fq);
        for (int blk = F.vcu; blk < SEQ / 64; blk += F.G) {
            const int row = blk * 64 + rt * 16 + fr;
            const signed char* ap = XQ + (size_t)row * DM + 16 * fq; const signed char* bp = Wab + (size_t)(ct * 16 + fr) * DM + 16 * fq;
            i32x4 acc = {0, 0, 0, 0};
#pragma unroll 1
            for (int kb = 0; kb < DM; kb += 1024) { i32x4 af[16], bfr[16];
#pragma unroll
                for (int u = 0; u < 16; ++u) { af[u] = *(const GAS i32x4*)(ap + kb + 64 * u); bfr[u] = *(const GAS i32x4*)(bp + kb + 64 * u); }
                __builtin_amdgcn_sched_barrier(0);
#pragma unroll
                for (int u = 0; u < 16; ++u) acc = __builtin_amdgcn_mfma_i32_16x16x64_i8(bfr[u], af[u], acc, 0, 0, 0);
                __builtin_amdgcn_sched_barrier(0); }
            *(GAS f32x4*)(Gab + (size_t)row * 32 + ct * 16 + 4 * fq) = (f32x4){(float)acc[0], (float)acc[1], (float)acc[2], (float)acc[3]} * (sw * QX[row]);
        }
        return;
    }
    const bf16* XN = (const bf16*)(F.ws + WS_XN); const bf16* Wab = (const bf16*)(F.ws + WS_WAB);
    for (int blk = F.vcu; blk < SEQ / 64; blk += F.G) {
        const bf16* ap = XN + (size_t)(blk * 64 + rt * 16 + fr) * DM + 8 * fq; const bf16* bp = Wab + (size_t)(ct * 16 + fr) * DM + 8 * fq;
        f32x4 acc = {0.f, 0.f, 0.f, 0.f};
#pragma unroll 1
        for (int kb = 0; kb < DM; kb += 512) { bf16x8 af[16], bfr[16];
#pragma unroll
            for (int u = 0; u < 16; ++u) { af[u] = *(const GAS bf16x8*)(ap + kb + 32 * u); bfr[u] = *(const GAS bf16x8*)(bp + kb + 32 * u); }
            __builtin_amdgcn_sched_barrier(0);
#pragma unroll
            for (int u = 0; u < 16; ++u) acc = mfma16(bfr[u], af[u], acc);
            __builtin_amdgcn_sched_barrier(0); }
        *(GAS f32x4*)(Gab + (size_t)(blk * 64 + rt * 16 + fr) * 32 + ct * 16 + 4 * fq) = acc;
    }
}
__device__ __forceinline__ void tbl_issue(Frame& F, int r, int lane, f32x4 (&v)[8]) {
    const bool tb = r >= 16384; const float* row = (tb ? F.in[I_PV] : F.in[I_PU]) + (size_t)(r & 16383) * DM;
#pragma unroll
    for (int q = 0; q < 8; ++q) v[q] = *(const GAS f32x4*)(row + ((tb && !P11C_MFMA) ? (q >> 2) * 1024 + lane * 16 + 4 * (q & 3) : lane * 32 + 4 * q));
}
__device__ __forceinline__ void tbl_finish(Frame& F, int r, int lane, const f32x4 (&v)[8]) {
    const bool tb = r >= 16384; const int e = r & 16383; float mx = 0.f;
#pragma unroll
    for (int q = 0; q < 8; ++q) { const f32x4 a = __builtin_elementwise_abs(v[q]); mx = fmaxf(mx, fmaxf(fmaxf(a.x, a.y), fmaxf(a.z, a.w))); }
    mx = wave_max(mx);
    const float sc = mx > 0.f ? mx * (1.0f / 6.0f) : 1.0f, inv = 1.0f / sc; unsigned w4[4];
    if (tb) {
#pragma unroll
        for (int d = 0; d < 4; ++d) { unsigned ww = 0u;
            ww = __builtin_amdgcn_cvt_scalef32_pk_fp4_f32(ww, v[2 * d].x * inv, v[2 * d].y * inv, 1.0f, 0); ww = __builtin_amdgcn_cvt_scalef32_pk_fp4_f32(ww, v[2 * d].z * inv, v[2 * d].w * inv, 1.0f, 1);
            ww = __builtin_amdgcn_cvt_scalef32_pk_fp4_f32(ww, v[2 * d + 1].x * inv, v[2 * d + 1].y * inv, 1.0f, 2); ww = __builtin_amdgcn_cvt_scalef32_pk_fp4_f32(ww, v[2 * d + 1].z * inv, v[2 * d + 1].w * inv, 1.0f, 3); w4[d] = ww; }
    } else {
#pragma unroll
        for (int d = 0; d < 4; ++d) { unsigned ww = 0u; const f32x4 lo = v[d], hi = v[4 + d];
            ww = __builtin_amdgcn_cvt_scalef32_pk_fp4_f32(ww, lo.x * inv, hi.x * inv, 1.0f, 0); ww = __builtin_amdgcn_cvt_scalef32_pk_fp4_f32(ww, lo.y * inv, hi.y * inv, 1.0f, 1);
            ww = __builtin_amdgcn_cvt_scalef32_pk_fp4_f32(ww, lo.z * inv, hi.z * inv, 1.0f, 2); ww = __builtin_amdgcn_cvt_scalef32_pk_fp4_f32(ww, lo.w * inv, hi.w * inv, 1.0f, 3); w4[d] = ww; }
    }
    *(GAS v4u*)(F.ws + (tb ? WS_TV : WS_TU) + (size_t)e * 1024 + lane * 16) = (v4u){w4[0], w4[1], w4[2], w4[3]};
    if (lane == 0) ((float*)(F.ws + WS_PSC))[r] = sc;
}
template <bool PASS3, int SKIP = 0>
__device__ __forceinline__ void hgrn_pass(Frame& F) {
    LAS bf16*  ST  = (LAS bf16*)(F.lds + 0);
    LAS float* LF  = (LAS float*)(F.lds + 0);
    LAS bf16*  QT  = (LAS bf16*)(F.lds + 34816);
    LAS bf16*  KT  = (LAS bf16*)(F.lds + 52224);
    LAS bf16*  KHT = (LAS bf16*)(F.lds + 69632);
    LAS bf16*  VT  = (LAS bf16*)(F.lds + 88064);
    LAS bf16*  ATT = (LAS bf16*)(F.lds + 106496);
    LAS float* PT  = (LAS float*)(F.lds + 115712);
    LAS float* BL  = (LAS float*)(F.lds + 117760);
    LAS float* DKK = (LAS float*)(F.lds + 118272);
    LAS float* LBV = (LAS float*)(F.lds + 118784);
    LAS bf16*  VR  = (LAS bf16*)(F.lds + 119296);
    const int tid = F.tid, lane = F.lane, w = F.wave, fr = lane & 15, fq = lane >> 4;
    const int row = tid >> 3, c0 = (tid & 7) * 16;
    float* HL = (float*)(F.ws + WS_HL); float* HDS = (float*)(F.ws + WS_HDS);
    constexpr bool TBL = PASS3 && TBL_BESIDE && UFMT == 4 && VFMT == 4 && P11B_DIRECT;
    const int tgw = F.vcu * NWAVES + F.wave, TNGW = F.G * NWAVES; int trow = tgw + (PASS3 ? 16384 : 0); const int tend = PASS3 ? 32768 : 16384;
    for (int it = blockIdx.x; it < 256; it += F.G) {
        const int hd = it >> 4, sg = it & 15, dir = hd >> 3, h = hd & 7;
        const bf16* Hq = (const bf16*)(F.ws + WS_H); const bf16* Hf = (const bf16*)(F.ws + WS_H + (size_t)(1 + dir) * 32 * MiB); const bf16* Hi = (const bf16*)(F.ws + WS_H + (size_t)3 * 32 * MiB);
        bf16* Oh = (bf16*)(F.ws + (dir ? WS_OHB : WS_OHF));
        __syncthreads();
        f32x4 Sacc[8];
#pragma unroll
        for (int kt = 0; kt < 8; ++kt) Sacc[kt] = (f32x4){0.f, 0.f, 0.f, 0.f};
        if (PASS3) {
            for (int p = 0; p < sg; ++p) { const int ip = hd * 16 + p; f32x4 dsv[8], lv[8];
#pragma unroll
                for (int kt = 0; kt < 8; ++kt) { dsv[kt] = *(const GAS f32x4*)(HDS + ip * 128 + 16 * kt + 4 * fq); lv[kt] = *(const GAS f32x4*)(HL + ((size_t)((ip * 8 + w) * 8 + kt) * 64 + lane) * 4); }
                __builtin_amdgcn_sched_barrier(0);
#pragma unroll
                for (int kt = 0; kt < 8; ++kt) Sacc[kt] = Sacc[kt] * dsv[kt] + lv[kt];
                __builtin_amdgcn_sched_barrier(0); }
        }
        float sumbl = 1.f;
        v4u rq[2], rf[2], rv[2];
        { const int oc = dir ? 255 - sg * 16 : sg * 16; const size_t off = (size_t)(64 * oc + row) * HW + h * 128 + c0;
          rq[0] = *(const GAS v4u*)(Hq + off); rq[1] = *(const GAS v4u*)(Hq + off + 8); if (FG_U8) rf[0] = *(const GAS v4u*)((const unsigned char*)Hf + off); else { rf[0] = *(const GAS v4u*)(Hf + off); rf[1] = *(const GAS v4u*)(Hf + off + 8); } rv[0] = *(const GAS v4u*)(Hi + off); rv[1] = *(const GAS v4u*)(Hi + off + 8); }
        __syncthreads();
        for (int ci = 0; ci < ((SKIP & 4) ? 1 : CPS); ++ci) {
            const int sc = sg * 16 + ci, oc = dir ? 255 - sc : sc, tok0 = 64 * oc;
            float kk[16], qq[16];
            { const unsigned fw[8] = {rf[0].x, rf[0].y, rf[0].z, rf[0].w, rf[1].x, rf[1].y, rf[1].z, rf[1].w};
              const unsigned qw[8] = {rq[0].x, rq[0].y, rq[0].z, rq[0].w, rq[1].x, rq[1].y, rq[1].z, rq[1].w};
              float fgv[16];
#pragma unroll
              for (int e = 0; e < 16; ++e) { if (FG_U8) { const unsigned wq_ = fw[e >> 2]; fgv[e] = ((e & 3) == 0 ? cvt_ub0(wq_) : (e & 3) == 1 ? cvt_ub1(wq_) : (e & 3) == 2 ? cvt_ub2(wq_) : cvt_ub3(wq_)) * (1.0f / 255.f); } else fgv[e] = (e & 1) ? bfhi(fw[e >> 1]) : bflo(fw[e >> 1]); qq[e] = (e & 1) ? bfhi(qw[e >> 1]) : bflo(qw[e >> 1]); kk[e] = 1.0f - fgv[e]; }
#pragma unroll
              for (int q4 = 0; q4 < 4; ++q4) *(LAS f32x4*)(LF + row * 132 + c0 + 4 * q4) = (f32x4){fgv[4 * q4], fgv[4 * q4 + 1], fgv[4 * q4 + 2], fgv[4 * q4 + 3]};
              *(LAS v4u*)(VR + row * 136 + c0) = rv[0]; *(LAS v4u*)(VR + row * 136 + c0 + 8) = rv[1]; }
            if (ci + 1 < CPS && !(SKIP & 2)) { const int oc2 = dir ? oc - 1 : oc + 1; const size_t off = (size_t)(64 * oc2 + row) * HW + h * 128 + c0;
              rq[0] = *(const GAS v4u*)(Hq + off); rq[1] = *(const GAS v4u*)(Hq + off + 8); if (FG_U8) rf[0] = *(const GAS v4u*)((const unsigned char*)Hf + off); else { rf[0] = *(const GAS v4u*)(Hf + off); rf[1] = *(const GAS v4u*)(Hf + off + 8); } rv[0] = *(const GAS v4u*)(Hi + off); rv[1] = *(const GAS v4u*)(Hi + off + 8); }
            f32x4 tv[8]; const bool tdo = TBL && trow < tend && !(ci & 1);
            if (tdo) { int tl = lane; asm volatile("" : "+v"(tl)); tbl_issue(F, trow, tl, tv); }
            if (!(SKIP & 8)) __syncthreads();
            { const int c = tid & 127, part = tid >> 7, r0 = part * 16; float b[16], fv[16]; float run = 1.f;
#pragma unroll
              for (int i = 0; i < 16; ++i) fv[i] = LF[(r0 + i) * 132 + c];
              if (!dir) {
#pragma unroll
                  for (int i = 0; i < 16; ++i) { run *= fv[i]; b[i] = run; }
              } else {
#pragma unroll
                  for (int i = 15; i >= 0; --i) { run *= fv[i]; b[i] = run; }
              }
              PT[part * 128 + c] = run;
              unsigned short vcol[16];
#pragma unroll
              for (int i = 0; i < 16; ++i) vcol[i] = VR[(r0 + i) * 136 + c];
              if (!(SKIP & 8)) __syncthreads();
              const float p0 = PT[c], p1 = PT[128 + c], p2 = PT[256 + c], p3 = PT[384 + c];
              float offs;
              if (!dir) offs = (part > 0 ? p0 : 1.f) * (part > 1 ? p1 : 1.f) * (part > 2 ? p2 : 1.f);
              else      offs = (part < 3 ? p3 : 1.f) * (part < 2 ? p2 : 1.f) * (part < 1 ? p1 : 1.f);
              const float tot = (p0 * p1) * (p2 * p3);
              unsigned kh[8], vw[8];
#pragma unroll
              for (int i = 0; i < 8; ++i) { const float P0 = b[2 * i] * offs, P1 = b[2 * i + 1] * offs;
                  if (PASS3) { LF[(r0 + 2 * i) * 132 + c] = P0; LF[(r0 + 2 * i + 1) * 132 + c] = P1; }
                  kh[i] = pk2((1.0f - fv[2 * i]) * tot * fast_rcp(P0), (1.0f - fv[2 * i + 1]) * tot * fast_rcp(P1)); vw[i] = (unsigned)vcol[2 * i] | ((unsigned)vcol[2 * i + 1] << 16); }
              *(LAS v4u*)(KHT + c * 72 + r0) = (v4u){kh[0], kh[1], kh[2], kh[3]}; *(LAS v4u*)(KHT + c * 72 + r0 + 8) = (v4u){kh[4], kh[5], kh[6], kh[7]};
              *(LAS v4u*)(VT + c * 72 + r0) = (v4u){vw[0], vw[1], vw[2], vw[3]}; *(LAS v4u*)(VT + c * 72 + r0 + 8) = (v4u){vw[4], vw[5], vw[6], vw[7]};
              if (part == 0) { DKK[c] = tot; sumbl *= tot; }
            }
            if (!(SKIP & 8)) __syncthreads();
            if (PASS3 && !(SKIP & 1)) { float bb[16];
#pragma unroll
              for (int q4 = 0; q4 < 4; ++q4) { const f32x4 t4 = *(const LAS f32x4*)(LF + row * 132 + c0 + 4 * q4); bb[4 * q4] = t4[0]; bb[4 * q4 + 1] = t4[1]; bb[4 * q4 + 2] = t4[2]; bb[4 * q4 + 3] = t4[3]; }
              unsigned qo[8], ko[8];
#pragma unroll
              for (int e = 0; e < 8; ++e) { qo[e] = pk2(qq[2 * e] * bb[2 * e], qq[2 * e + 1] * bb[2 * e + 1]); ko[e] = pk2(kk[2 * e] * fast_rcp(bb[2 * e]), kk[2 * e + 1] * fast_rcp(bb[2 * e + 1])); }
              *(LAS v4u*)(QT + row * 136 + c0) = (v4u){qo[0], qo[1], qo[2], qo[3]}; *(LAS v4u*)(QT + row * 136 + c0 + 8) = (v4u){qo[4], qo[5], qo[6], qo[7]};
              *(LAS v4u*)(KT + row * 136 + c0) = (v4u){ko[0], ko[1], ko[2], ko[3]}; *(LAS v4u*)(KT + row * 136 + c0 + 8) = (v4u){ko[4], ko[5], ko[6], ko[7]};
            }
            if (PASS3) if (!(SKIP & 8)) __syncthreads();
            if (PASS3 && !(SKIP & 1)) {
                { bf16x8 kf[2][4], qf[2][4]; f32x4 acc[2];
#pragma unroll
                  for (int q2 = 0; q2 < 2; ++q2) { const int tl = 2 * w + q2, ti = tl >> 2, tj = tl & 3; acc[q2] = (f32x4){0.f, 0.f, 0.f, 0.f};
#pragma unroll
                      for (int k0 = 0; k0 < 4; ++k0) { kf[q2][k0] = ldfrag(KT, 136, 16 * ti + fr, 32 * k0 + 8 * fq); qf[q2][k0] = ldfrag(QT, 136, 16 * tj + fr, 32 * k0 + 8 * fq); } }
                  __builtin_amdgcn_sched_barrier(0);
#pragma unroll
                  for (int k0 = 0; k0 < 4; ++k0)
#pragma unroll
                      for (int q2 = 0; q2 < 2; ++q2) acc[q2] = mfma16(kf[q2][k0], qf[q2][k0], acc[q2]);
                  __builtin_amdgcn_sched_barrier(0);
#pragma unroll
                  for (int q2 = 0; q2 < 2; ++q2) { const int tl = 2 * w + q2, ti = tl >> 2, tj = tl & 3; const int t = 16 * tj + fr, s0 = 16 * ti + 4 * fq;
#pragma unroll
                      for (int r = 0; r < 4; ++r) { const bool keep = dir ? (s0 + r >= t) : (s0 + r <= t); acc[q2][r] = keep ? acc[q2][r] : 0.f; }
                      *(LAS v2u*)(ATT + t * 72 + s0) = pack4(acc[q2]); } }
#pragma unroll
                for (int kt = 0; kt < 8; ++kt) *(LAS v2u*)(ST + (16 * w + fr) * 136 + 16 * kt + 4 * fq) = pack4(Sacc[kt]);
                if (!(SKIP & 8)) __syncthreads();
            }
            bf16x8 xv[2];
#pragma unroll
            for (int s0 = 0; s0 < 2; ++s0) xv[s0] = ldfrag(VT, 72, 16 * w + fr, 32 * s0 + 8 * fq);
            if (PASS3 && tdo) { int tl = lane; asm volatile("" : "+v"(tl)); tbl_finish(F, trow, tl, tv); trow += TNGW; }
            if (PASS3 && !(SKIP & 1)) {
                bf16x8 xs[4];
#pragma unroll
                for (int k0 = 0; k0 < 4; ++k0) xs[k0] = ldfrag(ST, 136, 16 * w + fr, 32 * k0 + 8 * fq);
#pragma unroll
                for (int th = 0; th < 2; ++th) { bf16x8 qf[2][4], af[2][2]; f32x4 acc[2];
#pragma unroll
                    for (int tq = 0; tq < 2; ++tq) { const int tt = 2 * th + tq; acc[tq] = (f32x4){0.f, 0.f, 0.f, 0.f};
#pragma unroll
                        for (int k0 = 0; k0 < 4; ++k0) qf[tq][k0] = ldfrag(QT, 136, 16 * tt + fr, 32 * k0 + 8 * fq);
#pragma unroll
                        for (int s0 = 0; s0 < 2; ++s0) af[tq][s0] = ldfrag(ATT, 72, 16 * tt + fr, 32 * s0 + 8 * fq); }
                    __builtin_amdgcn_sched_barrier(0);
#pragma unroll
                    for (int k0 = 0; k0 < 4; ++k0)
#pragma unroll
                        for (int tq = 0; tq < 2; ++tq) acc[tq] = mfma16(xs[k0], qf[tq][k0], acc[tq]);
#pragma unroll
                    for (int s0 = 0; s0 < 2; ++s0)
#pragma unroll
                        for (int tq = 0; tq < 2; ++tq) acc[tq] = mfma16(xv[s0], af[tq][s0], acc[tq]);
                    __builtin_amdgcn_sched_barrier(0);
#pragma unroll
                    for (int tq = 0; tq < 2; ++tq) *(GAS v2u*)(Oh + (size_t)(tok0 + 16 * (2 * th + tq) + fr) * HW + h * 128 + 16 * w + 4 * fq) = pack4(acc[tq]); }
            }
#pragma unroll
            for (int kh = 0; kh < ((SKIP & 1) ? 0 : 2); ++kh) { bf16x8 kf[4][2];
#pragma unroll
                for (int kq = 0; kq < 4; ++kq) { const int kt = 4 * kh + kq; const f32x4 d4 = *(const LAS f32x4*)(DKK + 16 * kt + 4 * fq); Sacc[kt] = Sacc[kt] * d4;
#pragma unroll
                    for (int s0 = 0; s0 < 2; ++s0) kf[kq][s0] = ldfrag(KHT, 72, 16 * kt + fr, 32 * s0 + 8 * fq); }
                __builtin_amdgcn_sched_barrier(0);
#pragma unroll
                for (int s0 = 0; s0 < 2; ++s0)
#pragma unroll
                    for (int kq = 0; kq < 4; ++kq) Sacc[4 * kh + kq] = mfma16(kf[kq][s0], xv[s0], Sacc[4 * kh + kq]);
                __builtin_amdgcn_sched_barrier(0); }
            if (!PASS3 && tdo) { int tl = lane; asm volatile("" : "+v"(tl)); tbl_finish(F, trow, tl, tv); trow += TNGW; }
            if (!(SKIP & 8)) __syncthreads();
        }
        if (!PASS3) {
#pragma unroll
            for (int kt = 0; kt < 8; ++kt) *(GAS f32x4*)(HL + ((size_t)((it * 8 + w) * 8 + kt) * 64 + lane) * 4) = Sacc[kt];
            if (tid < 128) HDS[it * 128 + tid] = sumbl;
        }
    }
    if (TBL) { int tl = lane; asm volatile("" : "+v"(tl));
        for (; trow < tend; trow += TNGW) { f32x4 tv[8]; tbl_issue(F, trow, tl, tv); tbl_finish(F, trow, tl, tv); } }
}
template <int SKIP>
__device__ __forceinline__ void gdn_prep(Frame& F) {
    LAS bf16*  QN  = (LAS bf16*)(F.lds + 0);
    LAS bf16*  KN  = (LAS bf16*)(F.lds + 17408);
    LAS bf16*  VT  = (LAS bf16*)(F.lds + 34816);
    LAS bf16*  KNT = (LAS bf16*)(F.lds + 53248);
    LAS float* AD  = (LAS float*)(F.lds + 71680);
    LAS bf16*  AB  = (LAS bf16*)(F.lds + 79872);
    LAS float* RS  = (LAS float*)(F.lds + 150528);
    LAS bf16*  TB  = (LAS bf16*)(F.lds + 104448);
    LAS bf16*  VR  = (LAS bf16*)(F.lds + 104448);
    LAS float* CWL = (LAS float*)(F.lds + 142848);
    LAS float* DEC = (LAS float*)(F.lds + 141312);
    LAS float* BET = DEC + 128;
    LAS float* EXD = DEC + 256;
    const int tid = F.tid, lane = F.lane, w = F.wave, fr = lane & 15, fq = lane >> 4;
    const int row = tid >> 3, c0 = (tid & 7) * 16;
    const bf16* Gq = (const bf16*)(F.ws + WS_H + (size_t)5 * 32 * MiB); const bf16* Gk = (const bf16*)(F.ws + WS_H + (size_t)6 * 32 * MiB); const bf16* Gv = (const bf16*)(F.ws + WS_H + (size_t)7 * 32 * MiB);
    const float* Gab = (const float*)(F.ws + WS_GAB); const float* cw = F.in[I_CONVW];
    unsigned char* dob = (unsigned char*)F.out;
    bf16* QNg = (bf16*)(dob + DO_QN); bf16* KNTg = (bf16*)(dob + DO_KNT); float* GSC = (float*)(F.ws + WS_GSC);
    int hload = -1;
    for (int it = blockIdx.x; it < 2048; it += F.G) {
        const int h = it & 7, oc = it >> 3, tok0 = 64 * oc;
        __syncthreads();
        if (h != hload) { hload = h;
            for (int i = tid; i < 5 * 384; i += NTHR) { const int j = i / 384, r = i % 384; CWL[i] = cw[j * 3072 + (r >> 7) * 1024 + h * 128 + (r & 127)]; }
            __syncthreads(); }
        if (it + F.G < 2048 && tid < 408) { const int it2 = it + F.G, h2 = it2 & 7, oc2 = it2 >> 3; const int tz = tid / 136, rl = tid % 136, r = rl >> 1, half = rl & 1; const int tr = 64 * oc2 - 2 + r;
            if (tr >= 0 && tr < SEQ) { const bf16* src = (tz == 0 ? Gq : tz == 1 ? Gk : Gv) + (size_t)tr * HW + h2 * 128 + half * 64; unsigned tmp = *(const GAS unsigned*)src; asm volatile("" :: "v"(tmp)); } }
#if S1_STAGED
        LAS bf16* RAW = (LAS bf16*)F.lds;
        if (!(SKIP & 1)) { v4u rp[7];
#pragma unroll
            for (int i = 0; i < 7; ++i) { const int p = tid + NTHR * i; const int tz = p / 1088, rem = p - tz * 1088, r = rem >> 4, c16 = rem & 15, tr = tok0 - 2 + r;
                rp[i] = (v4u){0u, 0u, 0u, 0u};
                if (p < 3264 && tr >= 0 && tr < SEQ) rp[i] = *(const GAS v4u*)((tz == 0 ? Gq : tz == 1 ? Gk : Gv) + (size_t)tr * HW + h * 128 + c16 * 8); }
#pragma unroll
            for (int i = 0; i < 7; ++i) { const int p = tid + NTHR * i; const int tz = p / 1088, rem = p - tz * 1088, r = rem >> 4, c16 = rem & 15;
                if (p < 3264) *(LAS v4u*)(RAW + (tz * 68 + r) * 136 + c16 * 8) = rp[i]; } }
#endif
        if (tid < 128) { const int dir = tid >> 6, l = tid & 63, pos = dir ? 63 - l : l;
            const float a = Gab[(size_t)(tok0 + pos) * 32 + dir * 8 + h], b = Gab[(size_t)(tok0 + pos) * 32 + 16 + dir * 8 + h];
            const float x = a + F.in[I_DTB][dir * 8 + h]; const float sp = x > 20.f ? x : log1pf(__expf(x));
            float d = -__expf(F.in[I_ALOG][dir * 8 + h]) * sp;
#pragma unroll
            for (int o = 1; o < 64; o <<= 1) { const float t = __shfl_up(d, o); if (l >= o) d += t; }
            DEC[dir * 64 + pos] = d; BET[dir * 64 + pos] = sigmoidf_(b); EXD[dir * 64 + pos] = __expf(d); }
        if (!(SKIP & 64)) { float q[16], k[16], v[16];
#pragma unroll
          for (int e = 0; e < 16; ++e) { q[e] = 0.f; k[e] = 0.f; v[e] = 0.f; }
          const int ch = h * 128 + c0;
#if S1_STAGED
          __syncthreads();
#pragma unroll
          for (int j = 0; j < ((SKIP & 1) ? 0 : 5); ++j) { const LAS bf16* rq_ = RAW + (row + j) * 136 + c0;
              const v4u xq0 = *(const LAS v4u*)(rq_), xq1 = *(const LAS v4u*)(rq_ + 8), xk0 = *(const LAS v4u*)(rq_ + 68 * 136), xk1 = *(const LAS v4u*)(rq_ + 68 * 136 + 8), xv0 = *(const LAS v4u*)(rq_ + 2 * 68 * 136), xv1 = *(const LAS v4u*)(rq_ + 2 * 68 * 136 + 8);
              const unsigned wq[8] = {xq0.x, xq0.y, xq0.z, xq0.w, xq1.x, xq1.y, xq1.z, xq1.w}, wk[8] = {xk0.x, xk0.y, xk0.z, xk0.w, xk1.x, xk1.y, xk1.z, xk1.w}, wv[8] = {xv0.x, xv0.y, xv0.z, xv0.w, xv1.x, xv1.y, xv1.z, xv1.w};
              const LAS float* cq = CWL + j * 384 + c0;
#pragma unroll
              for (int e = 0; e < 16; ++e) { const float fq_ = (e & 1) ? bfhi(wq[e >> 1]) : bflo(wq[e >> 1]), fk_ = (e & 1) ? bfhi(wk[e >> 1]) : bflo(wk[e >> 1]), fv_ = (e & 1) ? bfhi(wv[e >> 1]) : bflo(wv[e >> 1]);
                  q[e] += cq[e] * fq_; k[e] += cq[128 + e] * fk_; v[e] += cq[256 + e] * fv_; } }
          __syncthreads();
#elif S1_BATCH2
#define GP_LD(buf, j) do { const int tr_ = tok0 + row + (j) - 2; const bool ok_ = tr_ >= 0 && tr_ < SEQ; const size_t off_ = (size_t)(ok_ ? tr_ : 0) * HW + ch; \
              tq[buf][0] = *(const GAS v4u*)(Gq + off_); tq[buf][1] = *(const GAS v4u*)(Gq + off_ + 8); tk[buf][0] = *(const GAS v4u*)(Gk + off_); tk[buf][1] = *(const GAS v4u*)(Gk + off_ + 8); \
              tvv[buf][0] = *(const GAS v4u*)(Gv + off_); tvv[buf][1] = *(const GAS v4u*)(Gv + off_ + 8); tok_[buf] = ok_; } while (0)
#define GP_FMA(buf, j) do { if (tok_[buf]) { const v4u xq0 = tq[buf][0], xq1 = tq[buf][1], xk0 = tk[buf][0], xk1 = tk[buf][1], xv0 = tvv[buf][0], xv1 = tvv[buf][1]; \
              const unsigned wq[8] = {xq0.x, xq0.y, xq0.z, xq0.w, xq1.x, xq1.y, xq1.z, xq1.w}, wk[8] = {xk0.x, xk0.y, xk0.z, xk0.w, xk1.x, xk1.y, xk1.z, xk1.w}, wv[8] = {xv0.x, xv0.y, xv0.z, xv0.w, xv1.x, xv1.y, xv1.z, xv1.w}; \
              const LAS float* cq = CWL + (j) * 384 + c0; \
              _Pragma("unroll") for (int e = 0; e < 16; ++e) { const float fq_ = (e & 1) ? bfhi(wq[e >> 1]) : bflo(wq[e >> 1]), fk_ = (e & 1) ? bfhi(wk[e >> 1]) : bflo(wk[e >> 1]), fv_ = (e & 1) ? bfhi(wv[e >> 1]) : bflo(wv[e >> 1]); \
                  q[e] += cq[e] * fq_; k[e] += cq[128 + e] * fk_; v[e] += cq[256 + e] * fv_; } } } while (0)
          if (!(SKIP & 1)) { v4u tq[2][2], tk[2][2], tvv[2][2]; bool tok_[2];
              GP_LD(0, 0); GP_LD(1, 1); __builtin_amdgcn_sched_barrier(0); GP_FMA(0, 0); GP_FMA(1, 1); __builtin_amdgcn_sched_barrier(0);
              GP_LD(0, 2); GP_LD(1, 3); __builtin_amdgcn_sched_barrier(0); GP_FMA(0, 2); GP_FMA(1, 3); __builtin_amdgcn_sched_barrier(0);
              GP_LD(0, 4); __builtin_amdgcn_sched_barrier(0); GP_FMA(0, 4); }
#undef GP_LD
#undef GP_FMA
#else
#pragma unroll
          for (int j = 0; j < ((SKIP & 1) ? 0 : 5); ++j) { const int tr = tok0 + row + j - 2;
              if (tr >= 0 && tr < SEQ) { const size_t off = (size_t)tr * HW + ch;
                  const v4u xq0 = *(const GAS v4u*)(Gq + off), xq1 = *(const GAS v4u*)(Gq + off + 8), xk0 = *(const GAS v4u*)(Gk + off), xk1 = *(const GAS v4u*)(Gk + off + 8), xv0 = *(const GAS v4u*)(Gv + off), xv1 = *(const GAS v4u*)(Gv + off + 8);
                  const unsigned wq[8] = {xq0.x, xq0.y, xq0.z, xq0.w, xq1.x, xq1.y, xq1.z, xq1.w}, wk[8] = {xk0.x, xk0.y, xk0.z, xk0.w, xk1.x, xk1.y, xk1.z, xk1.w}, wv[8] = {xv0.x, xv0.y, xv0.z, xv0.w, xv1.x, xv1.y, xv1.z, xv1.w};
                  const LAS float* cq = CWL + j * 384 + c0;
#pragma unroll
                  for (int e = 0; e < 16; ++e) { const float fq_ = (e & 1) ? bfhi(wq[e >> 1]) : bflo(wq[e >> 1]), fk_ = (e & 1) ? bfhi(wk[e >> 1]) : bflo(wk[e >> 1]), fv_ = (e & 1) ? bfhi(wv[e >> 1]) : bflo(wv[e >> 1]);
                      q[e] += cq[e] * fq_; k[e] += cq[128 + e] * fk_; v[e] += cq[256 + e] * fv_; } } }
#endif
          float sq = 0.f, sk = 0.f;
#pragma unroll
          for (int e = 0; e < 16; ++e) { q[e] = siluf_(q[e]); k[e] = siluf_(k[e]); v[e] = siluf_(v[e]); sq += q[e] * q[e]; sk += k[e] * k[e]; }
          sq += __shfl_xor(sq, 1); sq += __shfl_xor(sq, 2); sq += __shfl_xor(sq, 4); sk += __shfl_xor(sk, 1); sk += __shfl_xor(sk, 2); sk += __shfl_xor(sk, 4);
          const float rq = 0.08838834764831845f / sqrtf(sq + EPS), rk = 1.0f / sqrtf(sk + EPS);
          unsigned qo[8], ko[8];
#pragma unroll
          for (int e = 0; e < 8; ++e) { qo[e] = pk2(q[2 * e] * rq, q[2 * e + 1] * rq); ko[e] = pk2(k[2 * e] * rk, k[2 * e + 1] * rk); }
          const v4u q0 = {qo[0], qo[1], qo[2], qo[3]}, q1 = {qo[4], qo[5], qo[6], qo[7]}, k0_ = {ko[0], ko[1], ko[2], ko[3]}, k1_ = {ko[4], ko[5], ko[6], ko[7]};
          *(LAS v4u*)(QN + row * 136 + c0) = q0; *(LAS v4u*)(QN + row * 136 + c0 + 8) = q1; *(LAS v4u*)(KN + row * 136 + c0) = k0_; *(LAS v4u*)(KN + row * 136 + c0 + 8) = k1_;
          if (!(SKIP & 16)) { *(GAS v4u*)(QNg + (size_t)(tok0 + row) * HW + ch) = q0; *(GAS v4u*)(QNg + (size_t)(tok0 + row) * HW + ch + 8) = q1; }
          unsigned vo[8];
#pragma unroll
          for (int e = 0; e < 8; ++e) vo[e] = pk2(v[2 * e], v[2 * e + 1]);
          *(LAS v4u*)(VR + row * 136 + c0) = (v4u){vo[0], vo[1], vo[2], vo[3]}; *(LAS v4u*)(VR + row * 136 + c0 + 8) = (v4u){vo[4], vo[5], vo[6], vo[7]};
        }
        __syncthreads();
        { const int c = tid & 127, r0 = (tid >> 7) * 16; unsigned vw[8], kw[8];
#pragma unroll
          for (int i = 0; i < 8; ++i) { vw[i] = (unsigned)VR[(r0 + 2 * i) * 136 + c] | ((unsigned)VR[(r0 + 2 * i + 1) * 136 + c] << 16); kw[i] = (unsigned)KN[(r0 + 2 * i) * 136 + c] | ((unsigned)KN[(r0 + 2 * i + 1) * 136 + c] << 16); }
          *(LAS v4u*)(VT + c * 72 + r0) = (v4u){vw[0], vw[1], vw[2], vw[3]}; *(LAS v4u*)(VT + c * 72 + r0 + 8) = (v4u){vw[4], vw[5], vw[6], vw[7]};
          *(LAS v4u*)(KNT + c * 72 + r0) = (v4u){kw[0], kw[1], kw[2], kw[3]}; *(LAS v4u*)(KNT + c * 72 + r0 + 8) = (v4u){kw[4], kw[5], kw[6], kw[7]}; }
#pragma unroll
        for (int q2 = 0; q2 < ((SKIP & 8) ? 0 : 2); ++q2) { const int tl = 2 * w + q2, ti = tl >> 2, tj = tl & 3; f32x4 kkv = {0.f, 0.f, 0.f, 0.f}, qkv = {0.f, 0.f, 0.f, 0.f};
#pragma unroll
            for (int k0 = 0; k0 < 4; ++k0) { const bf16x8 xs = ldfrag(KN, 136, 16 * ti + fr, 32 * k0 + 8 * fq);
                kkv = mfma16(xs, ldfrag(KN, 136, 16 * tj + fr, 32 * k0 + 8 * fq), kkv); qkv = mfma16(xs, ldfrag(QN, 136, 16 * tj + fr, 32 * k0 + 8 * fq), qkv); }
            int fr2 = lane & 15, fq2 = lane >> 4; asm volatile("" : "+v"(fr2), "+v"(fq2));
            const int t = 16 * tj + fr2, s0 = 16 * ti + 4 * fq2;
#pragma unroll
            for (int dir = 0; dir < 2; ++dir) { const float dt = DEC[dir * 64 + t], bt = BET[dir * 64 + t]; f32x4 aq, av;
#pragma unroll
                for (int r = 0; r < 4; ++r) { const int s = s0 + r; const bool before = dir ? (s > t) : (s < t), beq = before || (s == t);
                    const float e = beq ? __expf(dt - DEC[dir * 64 + s]) : 0.f;
                    av[r] = before ? bt * kkv[r] * e : 0.f; aq[r] = qkv[r] * e;
                    if (ti == tj) AD[(dir * 4 + (dir ? 3 - ti : ti)) * 256 + (dir ? (15 - (s & 15)) * 16 + (15 - fr2) : (s & 15) * 16 + fr2)] = av[r]; }
                *(LAS v2u*)(AB + dir * 64 * 72 + (dir ? (63 - t) * 72 + 60 - s0 : t * 72 + s0)) = dir ? pack4((f32x4){av[3], av[2], av[1], av[0]}) : pack4(av);
                bf16* AQg = (bf16*)(dob + (dir ? DO_AQKB : DO_AQKF));
                if (!(SKIP & 16)) *(GAS v2u*)(AQg + ((size_t)(h * 256 + oc) * 64 + t) * 64 + s0) = pack4(aq); } }
        __syncthreads();
#if S3_MFMA
        if (!(SKIP & 32)) {
            for (int idx = tid; idx < ((SKIP & 16) ? 0 : 1024); idx += NTHR) { const int r = idx >> 3, c8 = idx & 7; *(GAS v4u*)(KNTg + ((size_t)(h * 256 + oc) * 128 + r) * 64 + c8 * 8) = *(const LAS v4u*)(KNT + r * 72 + c8 * 8); }
            if (tid < 128) { const int dir = tid >> 6, t = tid & 63; const float dl = dir ? DEC[64] : DEC[63];
                float* g = GSC + (size_t)((dir * 8 + h) * 256 + oc) * 192; g[t] = EXD[dir * 64 + t]; g[64 + t] = __expf(dl - DEC[dir * 64 + t]); if (t == 0) g[128] = __expf(dl); }
            LAS bf16* DI = (LAS bf16*)(F.lds + 98304);
            LAS bf16* TTn = (LAS bf16*)(F.lds + 150528);
            int l3 = lane; asm volatile("" : "+v"(l3));
            const int f3 = l3 & 15, q3 = l3 >> 4, d3 = w >> 2, b3 = w & 3;
            { const LAS float* ADb = AD + (d3 * 4 + b3) * 256; float r[16], t[16];
#pragma unroll
              for (int ii = 0; ii < 16; ++ii) r[ii] = (ii == f3) ? 1.f : 0.f;
#pragma unroll
              for (int jg = 0; jg < 4; ++jg) { f32x4 av[4][4];
#pragma unroll
                  for (int jq = 0; jq < 4; ++jq)
#pragma unroll
                      for (int q4 = jg; q4 < 4; ++q4) av[jq][q4] = *(const LAS f32x4*)(ADb + (4 * jg + jq) * 16 + 4 * q4);
                  __builtin_amdgcn_sched_barrier(0);
#pragma unroll
                  for (int jq = 0; jq < 4; ++jq) { const int jj = 4 * jg + jq; t[jj] = r[jj];
#pragma unroll
                      for (int q4 = jg; q4 < 4; ++q4)
#pragma unroll
                          for (int e = 0; e < 4; ++e) if (4 * q4 + e > jj) r[4 * q4 + e] -= av[jq][q4][e] * r[jj]; }
                  __builtin_amdgcn_sched_barrier(0); }
              if (q3 == 0) {
#pragma unroll
                  for (int i = 0; i < 16; ++i) DI[((d3 * 4 + b3) * 16 + i) * 24 + f3] = (bf16)f2bf(t[i]); } }
            for (int i = tid; i < 2 * 64 * 48 / 8; i += NTHR) *(LAS v4u*)(TTn + i * 8) = (v4u){0u, 0u, 0u, 0u};
            __syncthreads();
            { const LAS bf16* ABd = AB + d3 * 64 * 72; LAS bf16* TTd = TTn + d3 * 64 * 48; const int ct = b3, cg = 16 * ct + f3, tc = d3 ? 63 - cg : cg;
              const float bc = BET[d3 * 64 + tc], bd = bc * EXD[d3 * 64 + tc];
              LAS bf16* TB0 = TB + (d3 * 2 + 0) * 64 * 72 + tc; LAS bf16* TB1 = TB0 + 64 * 72;
#pragma unroll
              for (int bi = 0; bi < 4; ++bi) { f32x4 d1 = {0.f, 0.f, 0.f, 0.f};
                  if (bi > 0) {
#pragma unroll
                      for (int ks = 0; ks < (16 * bi + 31) / 32; ++ks) { bf16x8 yf = *(const LAS bf16x8*)(TTd + cg * 48 + ((32 * ks + 8 * q3) < 48 ? 32 * ks + 8 * q3 : 0));
                          if (32 * ks + 8 * q3 >= 48) yf = (bf16x8){0, 0, 0, 0, 0, 0, 0, 0};
                          d1 = mfma16(ldfrag(ABd, 72, 16 * bi + f3, 32 * ks + 8 * q3), yf, d1); } }
                  f32x4 rr;
#pragma unroll
                  for (int e = 0; e < 4; ++e) rr[e] = ((bi == ct && 4 * q3 + e == f3) ? 1.f : 0.f) - d1[e];
                  const v2u rp = pack4(rr); const v2u xp = *(const LAS v2u*)(DI + ((d3 * 4 + bi) * 16 + f3) * 24 + 4 * q3);
                  typedef short s4_t __attribute__((ext_vector_type(4)));
                  const f32x4 tt = __builtin_amdgcn_mfma_f32_16x16x16bf16_1k(__builtin_bit_cast(s4_t, xp), __builtin_bit_cast(s4_t, rp), (f32x4){0.f, 0.f, 0.f, 0.f}, 0, 0, 0);
                  if (bi < 3) *(LAS v2u*)(TTd + cg * 48 + 16 * bi + 4 * q3) = pack4(tt);
#pragma unroll
                  for (int e = 0; e < 4; ++e) { const int i = 16 * bi + 4 * q3 + e, ro = (d3 ? 63 - i : i) * 72; TB0[ro] = (bf16)f2bf(tt[e] * bc); TB1[ro] = (bf16)f2bf(tt[e] * bd); }
                  if (bi < 3) __syncthreads(); } }
        }
#else
        if (SKIP & 32) {} else if (w < 2) { const int dir = w; int c = lane; asm volatile("" : "+v"(c));
            const LAS bf16* ABd = AB + dir * 64 * 72; LAS bf16* TT = TB + (dir * 2 + 1) * 64 * 72; LAS float* RSd = RS + dir * 1024; const LAS float* ADd = AD + dir * 1024;
#pragma unroll
            for (int q = 0; q < 9; ++q) *(LAS v4u*)(TT + (q * 64 + c) * 8) = (v4u){0u, 0u, 0u, 0u};
            int fr3 = c & 15, fq3 = c >> 4;
            float t[64];
#pragma unroll
            for (int bi = 0; bi < 4; ++bi) { float r[16];
#pragma unroll
                for (int ii = 0; ii < 16; ++ii) r[ii] = (16 * bi + ii == c) ? 1.f : 0.f;
                if (!(SKIP & 2)) {
                if (bi > 0) {
#pragma unroll
                    for (int ct = 0; ct < 4; ++ct) { f32x4 d = {0.f, 0.f, 0.f, 0.f};
#pragma unroll
                        for (int ks = 0; ks < (16 * bi + 31) / 32; ++ks) d = mfma16(ldfrag(ABd, 72, 16 * bi + fr3, 32 * ks + 8 * fq3), ldfrag(TT, 72, 16 * ct + fr3, 32 * ks + 8 * fq3), d);
                        *(LAS f32x4*)(RSd + (16 * ct + fr3) * 16 + 4 * fq3) = d; }
                    __builtin_amdgcn_sched_barrier(0);
                    f32x4 o4[4];
#pragma unroll
                    for (int q4 = 0; q4 < 4; ++q4) o4[q4] = *(const LAS f32x4*)(RSd + c * 16 + 4 * q4);
#pragma unroll
                    for (int q4 = 0; q4 < 4; ++q4) { r[4 * q4] -= o4[q4][0]; r[4 * q4 + 1] -= o4[q4][1]; r[4 * q4 + 2] -= o4[q4][2]; r[4 * q4 + 3] -= o4[q4][3]; }
                }
#pragma unroll
                for (int jg = 0; jg < 4; ++jg) { f32x4 av[4][4];
#pragma unroll
                    for (int jq = 0; jq < 4; ++jq)
#pragma unroll
                        for (int q4 = jg; q4 < 4; ++q4) av[jq][q4] = *(const LAS f32x4*)(ADd + bi * 256 + (4 * jg + jq) * 16 + 4 * q4);
                    __builtin_amdgcn_sched_barrier(0);
#pragma unroll
                    for (int jq = 0; jq < 4; ++jq) { const int jj = 4 * jg + jq; t[16 * bi + jj] = r[jj];
#pragma unroll
                        for (int q4 = jg; q4 < 4; ++q4)
#pragma unroll
                            for (int e = 0; e < 4; ++e) if (4 * q4 + e > jj) r[4 * q4 + e] -= av[jq][q4][e] * r[jj]; }
                    __builtin_amdgcn_sched_barrier(0); }
                if (bi < 3) { unsigned tw[8];
#pragma unroll
                    for (int e = 0; e < 8; ++e) tw[e] = pk2(t[16 * bi + 2 * e], t[16 * bi + 2 * e + 1]);
                    *(LAS v4u*)(TT + c * 72 + 16 * bi) = (v4u){tw[0], tw[1], tw[2], tw[3]}; *(LAS v4u*)(TT + c * 72 + 16 * bi + 8) = (v4u){tw[4], tw[5], tw[6], tw[7]}; }
                } else {
#pragma unroll
                for (int jj = 0; jj < 16; ++jj) t[16 * bi + jj] = r[jj]; }
            }
            const int tc = dir ? 63 - c : c; const float bc = BET[dir * 64 + tc], bd = bc * EXD[dir * 64 + tc];
            LAS bf16* T0 = TB + (dir * 2 + 0) * 64 * 72 + tc + (dir ? 63 * 72 : 0); const int tstep = dir ? -72 : 72;
#pragma unroll
            for (int i = 0; i < 64; ++i) { T0[i * tstep] = (bf16)f2bf(t[i] * bc); T0[64 * 72 + i * tstep] = (bf16)f2bf(t[i] * bd); }
        } else {
            for (int idx = tid - 128; idx < ((SKIP & 16) ? 0 : 1024); idx += 384) { const int r = idx >> 3, c8 = idx & 7; *(GAS v4u*)(KNTg + ((size_t)(h * 256 + oc) * 128 + r) * 64 + c8 * 8) = *(const LAS v4u*)(KNT + r * 72 + c8 * 8); }
            if (tid >= 128 && tid < 256) { const int dir = (tid - 128) >> 6, t = tid & 63; const float dl = dir ? DEC[64] : DEC[63];
                float* g = GSC + (size_t)((dir * 8 + h) * 256 + oc) * 192; g[t] = EXD[dir * 64 + t]; g[64 + t] = __expf(dl - DEC[dir * 64 + t]); if (t == 0) g[128] = __expf(dl); }
        }
#endif
        __syncthreads();
#if S4_STAGED
        if (!(SKIP & 4)) { int l4 = lane; asm volatile("" : "+v"(l4)); const int f4 = l4 & 15, q4_ = l4 >> 4;
            const int dir = w >> 2, kind = (w >> 1) & 1, hf = w & 1;
            const LAS bf16* Tm = TB + (dir * 2 + kind) * 64 * 72; const size_t cb = (size_t)(h * 256 + oc) * 8192;
            LAS bf16* SG = (LAS bf16*)(F.lds + w * 2304);
            bf16* U = (bf16*)(F.ws + (dir ? WS_UTB : WS_UTF)); bf16* W = (bf16*)(F.ws + (dir ? WS_WB : WS_WF));
#pragma unroll 1
            for (int g = 0; g < 4; ++g) { bf16x8 yf[2], xf[4][2]; f32x4 acc[4];
                const LAS bf16* Yb = kind == 0 ? VT : Tm; const LAS bf16* Xb = kind == 0 ? Tm : KNT;
                const int yrow = kind == 0 ? 16 * (4 * hf + g) : 16 * g, xrow0 = kind == 0 ? 0 : 64 * hf;
#pragma unroll
                for (int s0 = 0; s0 < 2; ++s0) { yf[s0] = ldfrag(Yb, 72, yrow + f4, 32 * s0 + 8 * q4_);
#pragma unroll
                    for (int tl = 0; tl < 4; ++tl) xf[tl][s0] = ldfrag(Xb, 72, xrow0 + 16 * tl + f4, 32 * s0 + 8 * q4_); }
                __builtin_amdgcn_sched_barrier(0);
#pragma unroll
                for (int tl = 0; tl < 4; ++tl) { acc[tl] = (f32x4){0.f, 0.f, 0.f, 0.f};
#pragma unroll
                    for (int s0 = 0; s0 < 2; ++s0) acc[tl] = mfma16(xf[tl][s0], yf[s0], acc[tl]); }
                __builtin_amdgcn_sched_barrier(0);
#pragma unroll
                for (int tl = 0; tl < 4; ++tl) *(LAS v2u*)(SG + f4 * 72 + 16 * tl + 4 * q4_) = pack4(acc[tl]);
                __builtin_amdgcn_sched_barrier(0);
                const int rr = l4 >> 2, cc = (l4 & 3) * 16;
                const v4u o0 = *(const LAS v4u*)(SG + rr * 72 + cc), o1 = *(const LAS v4u*)(SG + rr * 72 + cc + 8);
                if (!(SKIP & 16)) { bf16* dst = kind == 0 ? U + cb + (size_t)(yrow + rr) * 64 + cc : W + cb + (size_t)(yrow + rr) * 128 + 64 * hf + cc;
                    *(GAS v4u*)dst = o0; *(GAS v4u*)(dst + 8) = o1; }
                __builtin_amdgcn_sched_barrier(0); }
        }
#else
#pragma unroll 1
        for (int n = 0; n < ((SKIP & 4) ? 0 : 16); ++n) { const int qi = w * 16 + n, dir = qi >> 6, kind = (qi >> 5) & 1, idx = qi & 31; f32x4 acc = {0.f, 0.f, 0.f, 0.f};
            const LAS bf16* Tm = TB + (dir * 2 + kind) * 64 * 72; const size_t cb = (size_t)(h * 256 + oc) * 8192;
            if (kind == 0) { const int ti = idx >> 3, vj = idx & 7;
#pragma unroll
                for (int s0 = 0; s0 < 2; ++s0) acc = mfma16(ldfrag(Tm, 72, 16 * ti + fr, 32 * s0 + 8 * fq), ldfrag(VT, 72, 16 * vj + fr, 32 * s0 + 8 * fq), acc);
                bf16* U = (bf16*)(F.ws + (dir ? WS_UTB : WS_UTF)); if (!(SKIP & 16)) *(GAS v2u*)(U + cb + (16 * vj + fr) * 64 + 16 * ti + 4 * fq) = pack4(acc);
            } else { const int ki = idx >> 2, tj = idx & 3;
#pragma unroll
                for (int s0 = 0; s0 < 2; ++s0) acc = mfma16(ldfrag(KNT, 72, 16 * ki + fr, 32 * s0 + 8 * fq), ldfrag(Tm, 72, 16 * tj + fr, 32 * s0 + 8 * fq), acc);
                bf16* W = (bf16*)(F.ws + (dir ? WS_WB : WS_WF)); if (!(SKIP & 16)) *(GAS v2u*)(W + cb + (16 * tj + fr) * 128 + 16 * ki + 4 * fq) = pack4(acc); }
        }
#endif
    }
}
__device__ __forceinline__ void gdn_load_tiles(const unsigned char* ws, const unsigned char* dob, int tid, int dir, int hd, int h, int oc, bool pass3, v4u (&rw)[2], v4u (&rq)[2], v4u (&ru)[2], v4u (&rk)[2], v4u& ra, float& rs) {
    const size_t cb = (size_t)(h * 256 + oc);
    const int row = tid >> 3, c0 = (tid & 7) * 16, vrow = tid >> 2, t0 = (tid & 3) * 16;
    const bf16* W = (const bf16*)(ws + (dir ? WS_WB : WS_WF)) + cb * 8192 + row * 128 + c0; rw[0] = *(const GAS v4u*)W; rw[1] = *(const GAS v4u*)(W + 8);
    const bf16* U = (const bf16*)(ws + (dir ? WS_UTB : WS_UTF)) + cb * 8192 + vrow * 64 + t0; ru[0] = *(const GAS v4u*)U; ru[1] = *(const GAS v4u*)(U + 8);
    const bf16* Kt = (const bf16*)(dob + DO_KNT) + (size_t)(h * 256 + oc) * 8192 + vrow * 64 + t0; rk[0] = *(const GAS v4u*)Kt; rk[1] = *(const GAS v4u*)(Kt + 8);
    if (pass3) {
        const bf16* Q = (const bf16*)(dob + DO_QN) + (size_t)(64 * oc + row) * HW + h * 128 + c0; rq[0] = *(const GAS v4u*)Q; rq[1] = *(const GAS v4u*)(Q + 8);
        const bf16* A = (const bf16*)(dob + (dir ? DO_AQKB : DO_AQKF)) + cb * 4096 + row * 64 + (tid & 7) * 8; ra = *(const GAS v4u*)A;
    }
    rs = (tid < 192) ? ((const float*)(ws + WS_GSC))[(size_t)(hd * 256 + oc) * 192 + tid] : 0.f;
}
#define SCHED_FENCE() __builtin_amdgcn_sched_barrier(0)
template <bool PASS3, bool UREAL>
__device__ __forceinline__ void gdn_tile(f32x4 (&A)[8], const LAS bf16* WTL, const LAS bf16* QNL, const LAS bf16* UTL, const LAS bf16* KTL, const LAS bf16* AQL, const LAS float* SCL,
                                         LAS bf16* ST, LAS bf16* VN, LAS bf16* VNS, int w, int fr, int fq, float gl, bf16* Ogc) {
#pragma unroll
    for (int kt = 0; kt < 8; ++kt) *(LAS v2u*)(ST + fr * 136 + 16 * kt + 4 * fq) = pack4(A[kt]);
    asm volatile("" ::: "memory");
    bf16x8 xs[4];
#pragma unroll
    for (int k0 = 0; k0 < 4; ++k0) xs[k0] = ldfrag(ST, 136, fr, 32 * k0 + 8 * fq);
#pragma unroll
    for (int th = 0; th < 2; ++th) { bf16x8 wf[2][4]; f32x4 acc[2]; v2u uw[2]; f32x4 es[2];
#pragma unroll
      for (int tq = 0; tq < 2; ++tq) { const int tt = 2 * th + tq;
#pragma unroll
          for (int k0 = 0; k0 < 4; ++k0) wf[tq][k0] = ldfrag(WTL, 136, 16 * tt + fr, 32 * k0 + 8 * fq);
          if (UREAL) uw[tq] = *(const LAS v2u*)(UTL + (16 * w + fr) * 72 + 16 * tt + 4 * fq);
          es[tq] = *(const LAS f32x4*)(SCL + 64 + 16 * tt + 4 * fq); acc[tq] = (f32x4){0.f, 0.f, 0.f, 0.f}; }
      SCHED_FENCE();
#pragma unroll
      for (int k0 = 0; k0 < 4; ++k0)
#pragma unroll
          for (int tq = 0; tq < 2; ++tq) acc[tq] = mfma16(wf[tq][k0], xs[k0], acc[tq]);
      SCHED_FENCE();
#pragma unroll
      for (int tq = 0; tq < 2; ++tq) { const int tt = 2 * th + tq; f32x4 u4 = {0.f, 0.f, 0.f, 0.f};
          if (UREAL) u4 = (f32x4){bflo(uw[tq].x), bfhi(uw[tq].x), bflo(uw[tq].y), bfhi(uw[tq].y)};
          const f32x4 vn = u4 - acc[tq];
          if (PASS3) *(LAS v2u*)(VN + fr * 72 + 16 * tt + 4 * fq) = pack4(vn);
          *(LAS v2u*)(VNS + fr * 72 + 16 * tt + 4 * fq) = pack4(vn * es[tq]); }
      SCHED_FENCE(); }
    asm volatile("" ::: "memory");
    if (PASS3) { bf16x8 yv[2];
#pragma unroll
        for (int s0 = 0; s0 < 2; ++s0) yv[s0] = ldfrag(VN, 72, fr, 32 * s0 + 8 * fq);
#pragma unroll
        for (int th = 0; th < 2; ++th) { bf16x8 qf[2][4], af[2][2]; f32x4 acc[2]; float ed[2];
#pragma unroll
            for (int tq = 0; tq < 2; ++tq) { const int tt = 2 * th + tq;
#pragma unroll
                for (int k0 = 0; k0 < 4; ++k0) qf[tq][k0] = ldfrag(QNL, 136, 16 * tt + fr, 32 * k0 + 8 * fq);
#pragma unroll
                for (int s0 = 0; s0 < 2; ++s0) af[tq][s0] = ldfrag(AQL, 72, 16 * tt + fr, 32 * s0 + 8 * fq);
                ed[tq] = SCL[16 * tt + fr]; acc[tq] = (f32x4){0.f, 0.f, 0.f, 0.f}; }
            SCHED_FENCE();
#pragma unroll
            for (int k0 = 0; k0 < 4; ++k0)
#pragma unroll
                for (int tq = 0; tq < 2; ++tq) acc[tq] = mfma16(xs[k0], qf[tq][k0], acc[tq]);
#pragma unroll
            for (int tq = 0; tq < 2; ++tq) acc[tq] = acc[tq] * ed[tq];
#pragma unroll
            for (int s0 = 0; s0 < 2; ++s0)
#pragma unroll
                for (int tq = 0; tq < 2; ++tq) acc[tq] = mfma16(yv[s0], af[tq][s0], acc[tq]);
            SCHED_FENCE();
#pragma unroll
            for (int tq = 0; tq < 2; ++tq) *(GAS v2u*)(Ogc + (size_t)(16 * (2 * th + tq) + fr) * HW + 16 * w + 4 * fq) = pack4(acc[tq]);
            SCHED_FENCE(); } }
    { bf16x8 ys[2];
#pragma unroll
      for (int s0 = 0; s0 < 2; ++s0) ys[s0] = ldfrag(VNS, 72, fr, 32 * s0 + 8 * fq);
#pragma unroll
      for (int kh = 0; kh < 2; ++kh) { bf16x8 kf[4][2];
#pragma unroll
          for (int kq = 0; kq < 4; ++kq)
#pragma unroll
              for (int s0 = 0; s0 < 2; ++s0) kf[kq][s0] = ldfrag(KTL, 72, 16 * (4 * kh + kq) + fr, 32 * s0 + 8 * fq);
#pragma unroll
          for (int kq = 0; kq < 4; ++kq) A[4 * kh + kq] = A[4 * kh + kq] * gl;
          SCHED_FENCE();
#pragma unroll
          for (int s0 = 0; s0 < 2; ++s0)
#pragma unroll
              for (int kq = 0; kq < 4; ++kq) A[4 * kh + kq] = mfma16(kf[kq][s0], ys[s0], A[4 * kh + kq]);
          SCHED_FENCE(); } }
}
template <bool PASS3, int SKIP = 0>
__device__ __forceinline__ void gdn_pass(Frame& F) {
    LAS bf16*  WTL = (LAS bf16*)(F.lds + 0);
    LAS bf16*  QNL = (LAS bf16*)(F.lds + 17408);
    LAS bf16*  UTL = (LAS bf16*)(F.lds + 34816);
    LAS bf16*  KTL = (LAS bf16*)(F.lds + 53248);
    LAS bf16*  AQL = (LAS bf16*)(F.lds + 71680);
    LAS float* SCL = (LAS float*)(F.lds + 80896);
    LAS bf16*  PX  = (LAS bf16*)(F.lds + 0);
    const int tid = F.tid, lane = F.lane, w = F.wave, fr = lane & 15, fq = lane >> 4;
    LAS bf16* ST  = (LAS bf16*)(F.lds + 81920 + w * 8960);
    LAS bf16* VN  = ST + 16 * 136;
    LAS bf16* VNS = VN + 16 * 72;
    const int row = tid >> 3, c0 = (tid & 7) * 16, vrow = tid >> 2, t0 = (tid & 3) * 16;
    const unsigned char* dob = (const unsigned char*)F.out;
    float* GL = (float*)(F.ws + WS_GL); bf16* GP = (bf16*)(F.ws + WS_GP);
    constexpr bool TBLG = PASS3 && TBL_BESIDE && UFMT == 4 && VFMT == 4 && P11B_DIRECT;
    const int TNGW = F.G * NWAVES; int trow = F.vcu * NWAVES + F.wave;
    for (int it = blockIdx.x; it < 256; it += F.G) {
        const int hd = it >> 4, sg = it & 15, dir = hd >> 3, h = hd & 7;
        bf16* Og = (bf16*)(F.ws + (dir ? WS_OGB : WS_OGF));
        f32x4 Sacc[8], Pacc[8];
        int dgi = 16 * w + fr - 4 * fq; asm volatile("" : "+v"(dgi));
#pragma unroll
        for (int kt = 0; kt < 8; ++kt) { Sacc[kt] = (f32x4){0.f, 0.f, 0.f, 0.f};
#pragma unroll
            for (int r = 0; r < 4; ++r) Pacc[kt][r] = (!PASS3 && (16 * kt + r == dgi)) ? 1.f : 0.f; }
        __syncthreads();
        if (PASS3) {
            v4u nP[4];
#define GDN_PRE(ip_) do { const bf16* src_ = GP + (size_t)(ip_) * 16384 + vrow * 128 + (tid & 3) * 32; \
                _Pragma("unroll") for (int q = 0; q < 4; ++q) nP[q] = *(const GAS v4u*)(src_ + 8 * q); } while (0)
            if (sg > 0) GDN_PRE(hd * 16);
            for (int p = 0; p < sg; ++p) { const int ip = hd * 16 + p;
#pragma unroll
                for (int q = 0; q < 4; ++q) *(LAS v4u*)(PX + vrow * 136 + (tid & 3) * 32 + 8 * q) = nP[q];
#pragma unroll
                for (int kt = 0; kt < 8; ++kt) *(LAS v2u*)(ST + fr * 136 + 16 * kt + 4 * fq) = pack4(Sacc[kt]);
                SCHED_FENCE();
#pragma unroll
                for (int kt = 0; kt < 8; ++kt) Sacc[kt] = *(const GAS f32x4*)(GL + ((size_t)((ip * 8 + w) * 8 + kt) * 64 + lane) * 4);
                if (p + 1 < sg) GDN_PRE(ip + 1);
                SCHED_FENCE();
                __syncthreads();
                bf16x8 xs[4];
#pragma unroll
                for (int k0 = 0; k0 < 4; ++k0) xs[k0] = ldfrag(ST, 136, fr, 32 * k0 + 8 * fq);
                SCHED_FENCE();
#pragma unroll
                for (int kh = 0; kh < 4; ++kh) { bf16x8 pf[2][4]; f32x4 acc[2];
#pragma unroll
                    for (int kq = 0; kq < 2; ++kq) { const int kt = 2 * kh + kq; acc[kq] = Sacc[kt];
#pragma unroll
                        for (int k0 = 0; k0 < 4; ++k0) pf[kq][k0] = ldfrag(PX, 136, 16 * kt + fr, 32 * k0 + 8 * fq); }
                    SCHED_FENCE();
#pragma unroll
                    for (int k0 = 0; k0 < 4; ++k0)
#pragma unroll
                        for (int kq = 0; kq < 2; ++kq) acc[kq] = mfma16(pf[kq][k0], xs[k0], acc[kq]);
                    SCHED_FENCE();
#pragma unroll
                    for (int kq = 0; kq < 2; ++kq) Sacc[2 * kh + kq] = acc[kq]; }
                __syncthreads();
            }
#undef GDN_PRE
        }
        v4u rw[2], rq[2], ru[2], rk[2], ra; float rs;
        gdn_load_tiles(F.ws, dob, tid, dir, hd, h, dir ? 255 - sg * 16 : sg * 16, PASS3, rw, rq, ru, rk, ra, rs);
        for (int ci = 0; ci < CPS; ++ci) {
            f32x4 tv[8]; const bool tdo = TBLG && trow < 16384 && !(ci & 1);
            const int sc = sg * 16 + ci, oc = dir ? 255 - sc : sc, tok0 = 64 * oc;
            *(LAS v4u*)(WTL + row * 136 + c0) = rw[0]; *(LAS v4u*)(WTL + row * 136 + c0 + 8) = rw[1];
            *(LAS v4u*)(UTL + vrow * 72 + t0) = ru[0]; *(LAS v4u*)(UTL + vrow * 72 + t0 + 8) = ru[1];
            *(LAS v4u*)(KTL + vrow * 72 + t0) = rk[0]; *(LAS v4u*)(KTL + vrow * 72 + t0 + 8) = rk[1];
            if (PASS3) { *(LAS v4u*)(QNL + row * 136 + c0) = rq[0]; *(LAS v4u*)(QNL + row * 136 + c0 + 8) = rq[1]; *(LAS v4u*)(AQL + row * 72 + (tid & 7) * 8) = ra; }
            if (tid < 192) SCL[tid] = rs;
            __syncthreads();
            if (ci + 1 < CPS && !(SKIP & 1)) gdn_load_tiles(F.ws, dob, tid, dir, hd, h, dir ? oc - 1 : oc + 1, PASS3, rw, rq, ru, rk, ra, rs);
            if (tdo) { int tl = F.lane; asm volatile("" : "+v"(tl)); tbl_issue(F, trow, tl, tv); }
            const float gl = SCL[128];
            gdn_tile<PASS3, true>(Sacc, WTL, QNL, UTL, KTL, AQL, SCL, ST, VN, VNS, w, fr, fq, gl, Og + (size_t)tok0 * HW + h * 128);
            if (!PASS3) gdn_tile<PASS3, false>(Pacc, WTL, QNL, UTL, KTL, AQL, SCL, ST, VN, VNS, w, fr, fq, gl, Og);
            if (tdo) { int tl = F.lane; asm volatile("" : "+v"(tl)); tbl_finish(F, trow, tl, tv); trow += TNGW; }
            __syncthreads();
        }
        if (!PASS3) {
            int pofs = (4 * fq) * 128 + 16 * w + fr; asm volatile("" : "+v"(pofs));
            bf16* gp = GP + (size_t)it * 16384 + pofs;
#pragma unroll
            for (int kt = 0; kt < 8; ++kt) { *(GAS f32x4*)(GL + ((size_t)((it * 8 + w) * 8 + kt) * 64 + lane) * 4) = Sacc[kt];
#pragma unroll
                for (int r = 0; r < 4; ++r) gp[(16 * kt + r) * 128] = (bf16)f2bf(Pacc[kt][r]); }
        }
    }
    if (TBLG) { int tl = F.lane; asm volatile("" : "+v"(tl));
        for (; trow < 16384; trow += TNGW) { f32x4 tv[8]; tbl_issue(F, trow, tl, tv); tbl_finish(F, trow, tl, tv); } }
}
__device__ __forceinline__ void p7_row(Frame& F, int m, int mx, int lane, int e0, int col, v4u a0, v4u a1, v4u b0, v4u b1, v4u g0, v4u g1) {
            const float* nw = F.in[mx ? I_GNW : I_HNW]; bf16* yo = (bf16*)(F.ws + (mx ? WS_YB : WS_YA)); const size_t off = (size_t)m * HW + col;
            const unsigned aw[8] = {a0.x, a0.y, a0.z, a0.w, a1.x, a1.y, a1.z, a1.w}, bw[8] = {b0.x, b0.y, b0.z, b0.w, b1.x, b1.y, b1.z, b1.w}, gw_[8] = {g0.x, g0.y, g0.z, g0.w, g1.x, g1.y, g1.z, g1.w};
            float gf[16];
#pragma unroll
            for (int e = 0; e < 8; ++e) { gf[2 * e] = bflo(gw_[e]); gf[2 * e + 1] = bfhi(gw_[e]); }
            float o[16]; float ss = 0.f;
#pragma unroll
            for (int e = 0; e < 8; ++e) { o[2 * e] = bflo(aw[e]) + bflo(bw[e]); o[2 * e + 1] = bfhi(aw[e]) + bfhi(bw[e]); ss += o[2 * e] * o[2 * e] + o[2 * e + 1] * o[2 * e + 1]; }
            ss += __shfl_xor(ss, 1); ss += __shfl_xor(ss, 2); ss += __shfl_xor(ss, 4);
            const float r = 1.0f / sqrtf(ss * (1.f / 128.f) + EPS);
            if (QM_MIX == 2) { float yv[16]; float am = 0.f;
#pragma unroll
                for (int e = 0; e < 8; ++e) { yv[2 * e] = o[2 * e] * r * nw[e0 + 2 * e] * gf[2 * e]; yv[2 * e + 1] = o[2 * e + 1] * r * nw[e0 + 2 * e + 1] * gf[2 * e + 1]; am = fmaxf(am, fmaxf(fabsf(yv[2 * e]), fabsf(yv[2 * e + 1]))); }
                if (MIX_HAD) {
#pragma unroll
                    for (int st = 1; st < 16; st <<= 1)
#pragma unroll
                        for (int e = 0; e < 16; ++e) if (!(e & st)) { const float p = yv[e], q = yv[e + st]; yv[e] = p + q; yv[e + st] = p - q; }
#pragma unroll
                    for (int lb = 1; lb < 8; lb <<= 1)
#pragma unroll
                        for (int e = 0; e < 16; ++e) { const float o = __shfl_xor(yv[e], lb); yv[e] = (lane & lb) ? o - yv[e] : yv[e] + o; }
                    am = 0.f;
#pragma unroll
                    for (int e = 0; e < 16; ++e) am = fmaxf(am, fabsf(yv[e])); }
                am = wave_max(am); const float inv = am > 0.f ? 127.0f / am : 0.f;
                *(GAS v4u*)((unsigned char*)yo + off) = (v4u){pk4i8((f32x4){yv[0], yv[1], yv[2], yv[3]}, inv), pk4i8((f32x4){yv[4], yv[5], yv[6], yv[7]}, inv), pk4i8((f32x4){yv[8], yv[9], yv[10], yv[11]}, inv), pk4i8((f32x4){yv[12], yv[13], yv[14], yv[15]}, inv)};
                if (lane == 0) ((float*)(F.ws + WS_QX))[(1 + mx) * SEQ + m] = am > 0.f ? am * (1.0f / 127.0f) : 1.0f; }
            else if (QM_MIX == 1) { unsigned yq[4];
#pragma unroll
                for (int e = 0; e < 4; ++e) yq[e] = pk4f8(o[4 * e] * r * nw[e0 + 4 * e] * gf[4 * e], o[4 * e + 1] * r * nw[e0 + 4 * e + 1] * gf[4 * e + 1], o[4 * e + 2] * r * nw[e0 + 4 * e + 2] * gf[4 * e + 2], o[4 * e + 3] * r * nw[e0 + 4 * e + 3] * gf[4 * e + 3]);
                *(GAS v4u*)((unsigned char*)yo + off) = (v4u){yq[0], yq[1], yq[2], yq[3]}; }
            else { unsigned yw[8];
#pragma unroll
            for (int e = 0; e < 8; ++e) yw[e] = pk2(o[2 * e] * r * nw[e0 + 2 * e] * gf[2 * e], o[2 * e + 1] * r * nw[e0 + 2 * e + 1] * gf[2 * e + 1]);
            *(GAS v4u*)(yo + off) = (v4u){yw[0], yw[1], yw[2], yw[3]}; *(GAS v4u*)(yo + off + 8) = (v4u){yw[4], yw[5], yw[6], yw[7]}; }
}
__device__ __forceinline__ void p7_mix(Frame& F) {
    const int gw = F.vcu * NWAVES + F.wave, NGW = F.G * NWAVES, lane = F.lane;
    const int e0 = (lane & 7) * 16, col = (lane >> 3) * 128 + e0;
    v4u ra[2][6], rb[2][6];
#define P7_LOAD(R, m_) do { _Pragma("unroll") for (int mx = 0; mx < 2; ++mx) { const bf16* of = (const bf16*)(F.ws + (mx ? WS_OGF : WS_OHF)); const bf16* ob = (const bf16*)(F.ws + (mx ? WS_OGB : WS_OHB)); \
        const bf16* gt = (const bf16*)(F.ws + WS_H + (size_t)(mx ? 8 : 4) * 32 * MiB); const size_t off = (size_t)(m_) * HW + col; \
        R[mx][0] = *(const GAS v4u*)(of + off); R[mx][1] = *(const GAS v4u*)(of + off + 8); R[mx][2] = *(const GAS v4u*)(ob + off); R[mx][3] = *(const GAS v4u*)(ob + off + 8); R[mx][4] = *(const GAS v4u*)(gt + off); R[mx][5] = *(const GAS v4u*)(gt + off + 8); } } while (0)
#define P7_BODY(R, m_) do { __builtin_amdgcn_sched_barrier(0); p7_row(F, m_, 0, lane, e0, col, R[0][0], R[0][1], R[0][2], R[0][3], R[0][4], R[0][5]); p7_row(F, m_, 1, lane, e0, col, R[1][0], R[1][1], R[1][2], R[1][3], R[1][4], R[1][5]); __builtin_amdgcn_sched_barrier(0); } while (0)
    { int m = gw; if (m < SEQ) P7_LOAD(ra, m);
      while (m < SEQ) { if (m + NGW < SEQ) P7_LOAD(rb, m + NGW); P7_BODY(ra, m); m += NGW; if (m >= SEQ) break; if (m + NGW < SEQ) P7_LOAD(ra, m + NGW); P7_BODY(rb, m); m += NGW; } }
#undef P7_LOAD
#undef P7_BODY
    if (TBL_BESIDE && UFMT == 4 && VFMT == 4 && P11B_DIRECT) return;
    if (UFMT == 4 && VFMT == 4 && P11B_DIRECT) {
        f32x4 ta[8], tbv[8]; int r = gw; int tl = lane; asm volatile("" : "+v"(tl));
        if (r < 32768) tbl_issue(F, r, tl, ta);
        while (r < 32768) {
            if (r + NGW < 32768) tbl_issue(F, r + NGW, tl, tbv);
            __builtin_amdgcn_sched_barrier(0); tbl_finish(F, r, tl, ta); __builtin_amdgcn_sched_barrier(0); r += NGW; if (r >= 32768) break;
            if (r + NGW < 32768) tbl_issue(F, r + NGW, tl, ta);
            __builtin_amdgcn_sched_barrier(0); tbl_finish(F, r, tl, tbv); __builtin_amdgcn_sched_barrier(0); r += NGW; }
        return; }
    for (int tb = 0; tb < 2; ++tb) { const float* src = F.in[tb ? I_PV : I_PU]; unsigned char* dst = F.ws + (tb ? WS_TV : WS_TU); float* scl = (float*)(F.ws + WS_PSC) + tb * 16384;
        for (int r = gw; r < 16384; r += NGW) { const float* row = src + (size_t)r * DM; f32x4 v[8]; float mx = 0.f;
#pragma unroll
            for (int q = 0; q < 8; ++q) { v[q] = *(const GAS f32x4*)(row + (tb ? (q >> 2) * 1024 + lane * 16 + 4 * (q & 3) : lane * 32 + 4 * q)); const f32x4 a = __builtin_elementwise_abs(v[q]); mx = fmaxf(mx, fmaxf(fmaxf(a.x, a.y), fmaxf(a.z, a.w))); }
            mx = wave_max(mx);
            const float sc = mx > 0.f ? mx * (tb ? ((VFMT == 6 || VFMT == 64) ? 1.0f / 7.5f : VFMT == 4 ? 1.0f / 6.0f : 1.0f / 256.0f) : 1.0f / 127.0f) : 1.0f, inv = 1.0f / sc;
            if (tb && VFMT == 4) { unsigned w4[4];
#pragma unroll
                for (int d = 0; d < 4; ++d) { unsigned ww = 0u;
                    ww = __builtin_amdgcn_cvt_scalef32_pk_fp4_f32(ww, v[2 * d].x * inv, v[2 * d].y * inv, 1.0f, 0); ww = __builtin_amdgcn_cvt_scalef32_pk_fp4_f32(ww, v[2 * d].z * inv, v[2 * d].w * inv, 1.0f, 1);
                    ww = __builtin_amdgcn_cvt_scalef32_pk_fp4_f32(ww, v[2 * d + 1].x * inv, v[2 * d + 1].y * inv, 1.0f, 2); ww = __builtin_amdgcn_cvt_scalef32_pk_fp4_f32(ww, v[2 * d + 1].z * inv, v[2 * d + 1].w * inv, 1.0f, 3); w4[d] = ww; }
                *(GAS v4u*)(dst + (size_t)r * TV_PITCH + lane * 16) = (v4u){w4[0], w4[1], w4[2], w4[3]};
                if (lane == 0) scl[r] = sc;
                continue; }
            if (!tb && P11B_DIRECT && UFMT == 4) { const float sc4 = mx > 0.f ? mx * (1.0f / 6.0f) : 1.0f, inv4 = 1.0f / sc4; unsigned w4[4];
#pragma unroll
                for (int d = 0; d < 4; ++d) { unsigned ww = 0u; const f32x4 lo = v[d], hi = v[4 + d];
                    if (U4_SWAP) { ww = __builtin_amdgcn_cvt_scalef32_pk_fp4_f32(ww, hi.x * inv4, lo.x * inv4, 1.0f, 0); ww = __builtin_amdgcn_cvt_scalef32_pk_fp4_f32(ww, hi.y * inv4, lo.y * inv4, 1.0f, 1); ww = __builtin_amdgcn_cvt_scalef32_pk_fp4_f32(ww, hi.z * inv4, lo.z * inv4, 1.0f, 2); ww = __builtin_amdgcn_cvt_scalef32_pk_fp4_f32(ww, hi.w * inv4, lo.w * inv4, 1.0f, 3); }
                    else { ww = __builtin_amdgcn_cvt_scalef32_pk_fp4_f32(ww, lo.x * inv4, hi.x * inv4, 1.0f, 0); ww = __builtin_amdgcn_cvt_scalef32_pk_fp4_f32(ww, lo.y * inv4, hi.y * inv4, 1.0f, 1); ww = __builtin_amdgcn_cvt_scalef32_pk_fp4_f32(ww, lo.z * inv4, hi.z * inv4, 1.0f, 2); ww = __builtin_amdgcn_cvt_scalef32_pk_fp4_f32(ww, lo.w * inv4, hi.w * inv4, 1.0f, 3); }
                    w4[d] = ww; }
                *(GAS v4u*)(dst + (size_t)r * 1024 + lane * 16) = (v4u){w4[0], w4[1], w4[2], w4[3]};
                if (lane == 0) scl[r] = sc4;
                continue; }
            if (!tb && P11B_DIRECT) { const float sc6 = mx > 0.f ? mx * (1.0f / 7.5f) : 1.0f, inv6 = 1.0f / sc6; v16f a16, b16;
#pragma unroll
                for (int q = 0; q < 4; ++q) { a16[4 * q] = v[q].x * inv6; a16[4 * q + 1] = v[q].y * inv6; a16[4 * q + 2] = v[q].z * inv6; a16[4 * q + 3] = v[q].w * inv6;
                    b16[4 * q] = v[4 + q].x * inv6; b16[4 * q + 1] = v[4 + q].y * inv6; b16[4 * q + 2] = v[4 + q].z * inv6; b16[4 * q + 3] = v[4 + q].w * inv6; }
                const v6u pk = __builtin_amdgcn_cvt_scalef32_2xpk16_fp6_f32(a16, b16, 1.0f);
                *(GAS v4u*)(dst + (size_t)r * 1536 + lane * 16) = (v4u){pk[0], pk[1], pk[2], pk[3]}; *(GAS v2u*)(dst + (size_t)r * 1536 + 1024 + lane * 8) = (v2u){pk[4], pk[5]};
                if (lane == 0) scl[r] = sc6;
                continue; }
            if (tb && VFMT == 64) { unsigned w4[4]; const float inv4 = inv * (6.0f / 7.5f);
#pragma unroll
                for (int d = 0; d < 4; ++d) { unsigned ww = 0u;
                    ww = __builtin_amdgcn_cvt_scalef32_pk_fp4_f32(ww, v[d].x * inv4, v[4 + d].x * inv4, 1.0f, 0); ww = __builtin_amdgcn_cvt_scalef32_pk_fp4_f32(ww, v[d].y * inv4, v[4 + d].y * inv4, 1.0f, 1);
                    ww = __builtin_amdgcn_cvt_scalef32_pk_fp4_f32(ww, v[d].z * inv4, v[4 + d].z * inv4, 1.0f, 2); ww = __builtin_amdgcn_cvt_scalef32_pk_fp4_f32(ww, v[d].w * inv4, v[4 + d].w * inv4, 1.0f, 3); w4[d] = ww; }
                *(GAS v4u*)(F.ws + WS_TV4 + (size_t)r * 1024 + lane * 16) = (v4u){w4[0], w4[1], w4[2], w4[3]}; }
            if (tb && (VFMT == 6 || VFMT == 64)) { v16f a16, b16;
#pragma unroll
                for (int q = 0; q < 4; ++q) { a16[4 * q] = v[q].x * inv; a16[4 * q + 1] = v[q].y * inv; a16[4 * q + 2] = v[q].z * inv; a16[4 * q + 3] = v[q].w * inv;
                    b16[4 * q] = v[4 + q].x * inv; b16[4 * q + 1] = v[4 + q].y * inv; b16[4 * q + 2] = v[4 + q].z * inv; b16[4 * q + 3] = v[4 + q].w * inv; }
                const v6u pk = __builtin_amdgcn_cvt_scalef32_2xpk16_fp6_f32(a16, b16, 1.0f);
                *(GAS v4u*)(dst + (size_t)r * TV_PITCH + lane * 16) = (v4u){pk[0], pk[1], pk[2], pk[3]}; *(GAS v2u*)(dst + (size_t)r * TV_PITCH + 1024 + lane * 8) = (v2u){pk[4], pk[5]};
                if (lane == 0) scl[r] = sc;
                continue; }
            unsigned w[8];
#pragma unroll
            for (int q = 0; q < 8; ++q) { const f32x4 x = v[q];
                if (tb) w[q] = pk4f8(x.x * inv, x.y * inv, x.z * inv, x.w * inv);
                else { const int a = (int)rintf(x.x * inv), b = (int)rintf(x.y * inv), c = (int)rintf(x.z * inv), d = (int)rintf(x.w * inv);
                    w[q] = (unsigned)(a & 255) | ((unsigned)(b & 255) << 8) | ((unsigned)(c & 255) << 16) | ((unsigned)(d & 255) << 24); } }
            if (tb) { *(GAS v4u*)(dst + (size_t)r * DM + lane * 16) = (v4u){w[0], w[1], w[2], w[3]}; *(GAS v4u*)(dst + (size_t)r * DM + 1024 + lane * 16) = (v4u){w[4], w[5], w[6], w[7]}; }
            else { GAS v4u* o = (GAS v4u*)(dst + ((size_t)lane * 16384 + r) * 32); o[0] = (v4u){w[0], w[1], w[2], w[3]}; o[1] = (v4u){w[4], w[5], w[6], w[7]}; }
            if (lane == 0) scl[r] = sc; } }
}

__device__ __forceinline__ void p8b_quant(Frame& F) {
    const int gw = F.vcu * NWAVES + F.wave, NGW = F.G * NWAVES; int lane = F.lane; asm volatile("" : "+v"(lane));
    const bf16* GT = (const bf16*)(F.ws + WS_GT); unsigned char* GQ = F.ws + WS_GT8; float* QM = (float*)(F.ws + WS_QX) + 4 * SEQ; const unsigned* rowmax = (const unsigned*)(F.ctl + CW_ROWMAX);
    for (int m = gw; m < SEQ; m += NGW) { const bf16* row = GT + (size_t)m * DM + lane * 32;
        const v4u a = *(const GAS v4u*)(row), b = *(const GAS v4u*)(row + 8), c = *(const GAS v4u*)(row + 16), d = *(const GAS v4u*)(row + 24);
        const float am = __builtin_bit_cast(float, __hip_atomic_load(rowmax + m, __ATOMIC_RELAXED, __HIP_MEMORY_SCOPE_AGENT)); const float inv = am > 0.f ? 127.0f / am : 0.f;
        const unsigned wv[16] = {a.x, a.y, a.z, a.w, b.x, b.y, b.z, b.w, c.x, c.y, c.z, c.w, d.x, d.y, d.z, d.w}; unsigned o[8];
#pragma unroll
        for (int q = 0; q < 8; ++q) o[q] = pk4i8((f32x4){bflo(wv[2 * q]), bfhi(wv[2 * q]), bflo(wv[2 * q + 1]), bfhi(wv[2 * q + 1])}, inv);
        *(GAS v4u*)(GQ + (size_t)m * DM + lane * 32) = (v4u){o[0], o[1], o[2], o[3]}; *(GAS v4u*)(GQ + (size_t)m * DM + lane * 32 + 16) = (v4u){o[4], o[5], o[6], o[7]};
        if (lane == 0) QM[m] = am > 0.f ? am * (1.0f / 127.0f) : 1.0f; }
}
constexpr size_t WS_XQ = 240 * MiB;
constexpr size_t WS_SXR = 112 * MiB;
constexpr size_t WS_EID = 113 * MiB, WS_GATE = 121 * MiB, WS_AV = 129 * MiB;
constexpr size_t WS_REC = 208 * MiB;
constexpr int NET = 32, ETSZ = 512, NBUCK = 16 * NET, REC_CAP = 16384, CW_CNT = 8192, CW_Q = 8192 + 16 * NBUCK;
__device__ __forceinline__ unsigned fkey(float f) { const unsigned u = __builtin_bit_cast(unsigned, f); return (u & 0x80000000u) ? ~u : (u | 0x80000000u); }
__device__ __forceinline__ float gelu_erf(float x) { return 0.5f * x * (1.0f + erff(x * 0.70710678118654752f)); }

__device__ __forceinline__ float key_val(unsigned k, unsigned mask) { unsigned u = k & ~mask; u = (u & 0x80000000u) ? (u & 0x7fffffffu) : ~u; return __builtin_bit_cast(float, u); }
#define SN_CE(x, y) do { const unsigned sn_h = (x) > (y) ? (x) : (y); (y) = (x) > (y) ? (y) : (x); (x) = sn_h; } while (0)
#define SN_SORT16(k) do { SN_CE(k[0], k[1]); SN_CE(k[2], k[3]); SN_CE(k[0], k[2]); SN_CE(k[1], k[3]); SN_CE(k[1], k[2]); SN_CE(k[4], k[5]); SN_CE(k[6], k[7]); SN_CE(k[4], k[6]); SN_CE(k[5], k[7]); SN_CE(k[5], k[6]); SN_CE(k[0], k[4]); SN_CE(k[2], k[6]); SN_CE(k[2], k[4]); SN_CE(k[1], k[5]); SN_CE(k[3], k[7]); SN_CE(k[3], k[5]); SN_CE(k[1], k[2]); SN_CE(k[3], k[4]); SN_CE(k[5], k[6]); SN_CE(k[8], k[9]); SN_CE(k[10], k[11]); SN_CE(k[8], k[10]); SN_CE(k[9], k[11]); SN_CE(k[9], k[10]); SN_CE(k[12], k[13]); SN_CE(k[14], k[15]); SN_CE(k[12], k[14]); SN_CE(k[13], k[15]); SN_CE(k[13], k[14]); SN_CE(k[8], k[12]); SN_CE(k[10], k[14]); SN_CE(k[10], k[12]); SN_CE(k[9], k[13]); SN_CE(k[11], k[15]); SN_CE(k[11], k[13]); SN_CE(k[9], k[10]); SN_CE(k[11], k[12]); SN_CE(k[13], k[14]); SN_CE(k[0], k[8]); SN_CE(k[4], k[12]); SN_CE(k[4], k[8]); SN_CE(k[2], k[10]); SN_CE(k[6], k[14]); SN_CE(k[6], k[10]); SN_CE(k[2], k[4]); SN_CE(k[6], k[8]); SN_CE(k[10], k[12]); SN_CE(k[1], k[9]); SN_CE(k[5], k[13]); SN_CE(k[5], k[9]); SN_CE(k[3], k[11]); SN_CE(k[7], k[15]); SN_CE(k[7], k[11]); SN_CE(k[3], k[5]); SN_CE(k[7], k[9]); SN_CE(k[11], k[13]); SN_CE(k[1], k[2]); SN_CE(k[3], k[4]); SN_CE(k[5], k[6]); SN_CE(k[7], k[8]); SN_CE(k[9], k[10]); SN_CE(k[11], k[12]); SN_CE(k[13], k[14]); } while (0)
#define SN_MERGE16(t, k) do { t[0] = t[0] > k[15] ? t[0] : k[15]; t[1] = t[1] > k[14] ? t[1] : k[14]; t[2] = t[2] > k[13] ? t[2] : k[13]; t[3] = t[3] > k[12] ? t[3] : k[12]; t[4] = t[4] > k[11] ? t[4] : k[11]; t[5] = t[5] > k[10] ? t[5] : k[10]; t[6] = t[6] > k[9] ? t[6] : k[9]; t[7] = t[7] > k[8] ? t[7] : k[8]; t[8] = t[8] > k[7] ? t[8] : k[7]; t[9] = t[9] > k[6] ? t[9] : k[6]; t[10] = t[10] > k[5] ? t[10] : k[5]; t[11] = t[11] > k[4] ? t[11] : k[4]; t[12] = t[12] > k[3] ? t[12] : k[3]; t[13] = t[13] > k[2] ? t[13] : k[2]; t[14] = t[14] > k[1] ? t[14] : k[1]; t[15] = t[15] > k[0] ? t[15] : k[0]; SN_CE(t[0], t[8]); SN_CE(t[1], t[9]); SN_CE(t[2], t[10]); SN_CE(t[3], t[11]); SN_CE(t[4], t[12]); SN_CE(t[5], t[13]); SN_CE(t[6], t[14]); SN_CE(t[7], t[15]); SN_CE(t[0], t[4]); SN_CE(t[1], t[5]); SN_CE(t[2], t[6]); SN_CE(t[3], t[7]); SN_CE(t[8], t[12]); SN_CE(t[9], t[13]); SN_CE(t[10], t[14]); SN_CE(t[11], t[15]); SN_CE(t[0], t[2]); SN_CE(t[1], t[3]); SN_CE(t[4], t[6]); SN_CE(t[5], t[7]); SN_CE(t[8], t[10]); SN_CE(t[9], t[11]); SN_CE(t[12], t[14]); SN_CE(t[13], t[15]); SN_CE(t[0], t[1]); SN_CE(t[2], t[3]); SN_CE(t[4], t[5]); SN_CE(t[6], t[7]); SN_CE(t[8], t[9]); SN_CE(t[10], t[11]); SN_CE(t[12], t[13]); SN_CE(t[14], t[15]); } while (0)
#define SN_CAND(i, j) ((fkey(f1[i] + f2[j]) & ~255u) | (unsigned)((i) * 16 + (j)))
#define SN_STAGE2(c, k) do { k[0] = SN_CAND(0, 0); k[1] = SN_CAND(0, 1); k[2] = SN_CAND(0, 2); k[3] = SN_CAND(0, 3); k[4] = SN_CAND(0, 4); k[5] = SN_CAND(0, 5); k[6] = SN_CAND(0, 6); k[7] = SN_CAND(0, 7); k[8] = SN_CAND(0, 8); k[9] = SN_CAND(0, 9); k[10] = SN_CAND(0, 10); k[11] = SN_CAND(0, 11); k[12] = SN_CAND(0, 12); k[13] = SN_CAND(0, 13); k[14] = SN_CAND(0, 14); k[15] = SN_CAND(0, 15); SN_SORT16(k); c[0] = k[0]; c[1] = k[1]; c[2] = k[2]; c[3] = k[3]; c[4] = k[4]; c[5] = k[5]; c[6] = k[6]; c[7] = k[7]; c[8] = k[8]; c[9] = k[9]; c[10] = k[10]; c[11] = k[11]; c[12] = k[12]; c[13] = k[13]; c[14] = k[14]; c[15] = k[15]; k[0] = SN_CAND(1, 0); k[1] = SN_CAND(1, 1); k[2] = SN_CAND(1, 2); k[3] = SN_CAND(1, 3); k[4] = SN_CAND(1, 4); k[5] = SN_CAND(1, 5); k[6] = SN_CAND(1, 6); k[7] = SN_CAND(1, 7); k[8] = SN_CAND(2, 0); k[9] = SN_CAND(2, 1); k[10] = SN_CAND(2, 2); k[11] = SN_CAND(2, 3); k[12] = SN_CAND(2, 4); k[13] = SN_CAND(3, 0); k[14] = SN_CAND(3, 1); k[15] = SN_CAND(3, 2); SN_SORT16(k); SN_MERGE16(c, k); k[0] = SN_CAND(3, 3); k[1] = SN_CAND(4, 0); k[2] = SN_CAND(4, 1); k[3] = SN_CAND(4, 2); k[4] = SN_CAND(5, 0); k[5] = SN_CAND(5, 1); k[6] = SN_CAND(6, 0); k[7] = SN_CAND(6, 1); k[8] = SN_CAND(7, 0); k[9] = SN_CAND(7, 1); k[10] = SN_CAND(8, 0); k[11] = SN_CAND(9, 0); k[12] = SN_CAND(10, 0); k[13] = SN_CAND(11, 0); k[14] = SN_CAND(12, 0); k[15] = SN_CAND(13, 0); SN_SORT16(k); SN_MERGE16(c, k); { unsigned x = SN_CAND(14, 0); _Pragma("unroll") for (int r = 0; r < 16; ++r) { const unsigned hi = c[r] > x ? c[r] : x; x = c[r] > x ? x : c[r]; c[r] = hi; } } { unsigned x = SN_CAND(15, 0); _Pragma("unroll") for (int r = 0; r < 16; ++r) { const unsigned hi = c[r] > x ? c[r] : x; x = c[r] > x ? x : c[r]; c[r] = hi; } } } while (0)
template <int SKIP>
__device__ __forceinline__ void p11a_topk(Frame& F) {
    LAS float* SCR = (LAS float*)(F.lds + F.wave * 16384);
    LAS unsigned* SL = (LAS unsigned*)SCR;
    LAS int* EIDS = (LAS int*)(SCR + 1024);
    LAS int* OFFS = (LAS int*)(SCR + 2048);
    LAS float* RTS = SCR + 2304;
    LAS unsigned* SL2 = (LAS unsigned*)(SCR + 2560);
    LAS int* BC = (LAS int*)(F.lds + 8 * 16384);
    const bf16* SC = (const bf16*)(F.ws + WS_SC);
    unsigned char* XQ = F.ws + WS_XQ; float* SXR = (float*)(F.ws + WS_SXR); int* EIDg = (int*)(F.ws + WS_EID); float* GATEg = (float*)(F.ws + WS_GATE); unsigned* REC = (unsigned*)(F.ws + WS_REC);
    for (int blk = F.vcu; blk < SEQ / 64; blk += F.G) {
        __syncthreads();
        if (F.tid < NET) BC[F.tid] = 0;
        __syncthreads();
        const int m0 = blk * 64 + F.wave * 8;
        v2u xa[8];
        { int l0 = F.lane; asm volatile("" : "+v"(l0)); const bf16* x10 = (const bf16*)(F.ws + WS_X1B) + (size_t)m0 * DM + l0 * 32;
#pragma unroll
          for (int q = 0; q < 8; ++q) xa[q] = *(const GAS v2u*)(x10 + 4 * q); }
#pragma unroll 2
        for (int ti = 0; ti < 8; ++ti) { const int m = m0 + ti;
            int lane = F.lane; asm volatile("" : "+v"(lane));
            float xh[32]; float ss = 0.f;
            const bf16* x1 = (const bf16*)(F.ws + WS_X1B) + (size_t)m * DM + lane * 32; const float* n2 = F.in[I_N2W] + lane * 32;
            f32x4 nwv[8];
#pragma unroll
            for (int q = 0; q < 8; ++q) { const v2u a = xa[q]; nwv[q] = *(const GAS f32x4*)(n2 + 4 * q); xh[4 * q] = bflo(a.x); xh[4 * q + 1] = bfhi(a.x); xh[4 * q + 2] = bflo(a.y); xh[4 * q + 3] = bfhi(a.y); }
            if (ti + 1 < 8) {
#pragma unroll
                for (int q = 0; q < 8; ++q) xa[q] = *(const GAS v2u*)(x1 + DM + 4 * q); }
#pragma unroll
            for (int e = 0; e < 32; ++e) ss += xh[e] * xh[e];
            const float rt = 1.0f / sqrtf(wave_sum(ss) * (1.f / DM) + EPS);
            float amx = 0.f;
#pragma unroll
            for (int q = 0; q < 8; ++q) { const f32x4 a = nwv[q]; xh[4 * q] *= rt * a.x; xh[4 * q + 1] *= rt * a.y; xh[4 * q + 2] *= rt * a.z; xh[4 * q + 3] *= rt * a.w; }
#pragma unroll
            for (int e = 0; e < 32; ++e) amx = fmaxf(amx, fabsf(xh[e]));
            amx = wave_max(amx);
            const float sx = amx > 0.f ? amx * (1.0f / 127.0f) : 1.0f, isx = 1.0f / sx;
            unsigned xq[8];
#pragma unroll
            for (int d = 0; d < 8; ++d) { const int a = (int)rintf(xh[4 * d] * isx), b = (int)rintf(xh[4 * d + 1] * isx), c = (int)rintf(xh[4 * d + 2] * isx), e = (int)rintf(xh[4 * d + 3] * isx);
                xq[d] = (unsigned)(a & 255) | ((unsigned)(b & 255) << 8) | ((unsigned)(c & 255) << 16) | ((unsigned)(e & 255) << 24); }
            if (P11B_DIRECT) { const float s6 = amx > 0.f ? amx * (1.0f / 7.5f) : 1.0f, i6 = 1.0f / s6; v16f a16, b16;
#pragma unroll
                for (int e = 0; e < 16; ++e) { a16[e] = xh[e] * i6; b16[e] = xh[16 + e] * i6; }
                const v6u pk = __builtin_amdgcn_cvt_scalef32_2xpk16_fp6_f32(a16, b16, 1.0f);
                *(GAS v4u*)(XQ + (size_t)m * 1536 + lane * 16) = (v4u){pk[0], pk[1], pk[2], pk[3]}; *(GAS v2u*)(XQ + (size_t)m * 1536 + 1024 + lane * 8) = (v2u){pk[4], pk[5]};
                if (lane == 0) { SXR[2 * m] = s6; SXR[2 * m + 1] = rt; RTS[ti] = rt; } }
            else {
            if (!(SKIP & 2)) { GAS v4u* o = (GAS v4u*)(XQ + ((size_t)lane * SEQ + m) * 32); o[0] = (v4u){xq[0], xq[1], xq[2], xq[3]}; o[1] = (v4u){xq[4], xq[5], xq[6], xq[7]}; }
            if (lane == 0) { SXR[2 * m] = sx; SXR[2 * m + 1] = rt; RTS[ti] = rt; } }
        }
#pragma unroll 1
        for (int grp = 0; grp < 2; ++grp) {
            int lane = F.lane; asm volatile("" : "+v"(lane));
            if (!(SKIP & 1)) {
                { const bf16* src = SC + (size_t)(m0 + grp * 4 + (lane >> 4)) * DM + (lane & 15) * 128;
                  unsigned v[16];
#pragma unroll
                  for (int i = 0; i < 16; ++i) v[i] = 0u;
#pragma unroll 1
                  for (int s8 = 0; s8 < 2; ++s8) { v4u a8[8];
#pragma unroll
                      for (int u = 0; u < 8; ++u) a8[u] = *(const GAS v4u*)(src + 64 * s8 + 8 * u);
#pragma unroll
                      for (int u2 = 0; u2 < 4; ++u2) { unsigned k[16];
#pragma unroll
                          for (int h = 0; h < 2; ++h) { const unsigned wv[4] = {a8[2 * u2 + h].x, a8[2 * u2 + h].y, a8[2 * u2 + h].z, a8[2 * u2 + h].w};
#pragma unroll
                              for (int e = 0; e < 8; ++e) { const float sv = (e & 1) ? bfhi(wv[e >> 1]) : bflo(wv[e >> 1]); k[8 * h + e] = (fkey(sv) & ~127u) | (unsigned)(64 * s8 + 16 * u2 + 8 * h + e); } }
                          SN_SORT16(k); SN_MERGE16(v, k); } }
#pragma unroll
                  for (int q = 0; q < 4; ++q) *(LAS v4u*)(((P11A_S2MERGE && grp) ? SL2 : SL) + lane * 16 + 4 * q) = (v4u){v[4 * q], v[4 * q + 1], v[4 * q + 2], v[4 * q + 3]}; }
                asm volatile("" ::: "memory");
                if (!P11A_S2MERGE && lane < 32) { const int tk = lane >> 3, h = lane & 7, m = m0 + grp * 4 + tk;
                    const LAS unsigned* L1 = SL + (tk * 16 + 2 * h) * 16; const LAS unsigned* L2 = L1 + 16;
                    float f1[16], f2[16];
#pragma unroll
                    for (int q = 0; q < 4; ++q) { const v4u a = *(const LAS v4u*)(L1 + 4 * q), b = *(const LAS v4u*)(L2 + 4 * q);
                        f1[4 * q] = key_val(a.x, 127u); f1[4 * q + 1] = key_val(a.y, 127u); f1[4 * q + 2] = key_val(a.z, 127u); f1[4 * q + 3] = key_val(a.w, 127u);
                        f2[4 * q] = key_val(b.x, 127u); f2[4 * q + 1] = key_val(b.y, 127u); f2[4 * q + 2] = key_val(b.z, 127u); f2[4 * q + 3] = key_val(b.w, 127u); }
                    unsigned c[16]; { unsigned k[16]; SN_STAGE2(c, k); }
                    const float rt = RTS[grp * 4 + tk];
                    float sc[16]; int ee[16]; float mx = -3.0e38f;
#pragma unroll
                    for (int r = 0; r < 16; ++r) { const unsigned ij = c[r] & 255u; const unsigned k1 = L1[ij >> 4], k2 = L2[ij & 15u];
                        sc[r] = key_val(k1, 127u) + key_val(k2, 127u); ee[r] = (int)((k1 & 127u) * 128u + (k2 & 127u)); mx = fmaxf(mx, sc[r]); }
                    float sum = 0.f;
#pragma unroll
                    for (int r = 0; r < 16; ++r) { sc[r] = __expf(rt * (sc[r] - mx)); sum += sc[r]; }
                    const float inv = 1.0f / sum;
#pragma unroll
                    for (int q = 0; q < 4; ++q) { *(LAS v4u*)(EIDS + (grp * 4 + tk) * 128 + h * 16 + 4 * q) = (v4u){(unsigned)ee[4 * q], (unsigned)ee[4 * q + 1], (unsigned)ee[4 * q + 2], (unsigned)ee[4 * q + 3]};
                        if (!(SKIP & 4)) { *(GAS v4u*)(EIDg + (size_t)m * 128 + h * 16 + 4 * q) = (v4u){(unsigned)ee[4 * q], (unsigned)ee[4 * q + 1], (unsigned)ee[4 * q + 2], (unsigned)ee[4 * q + 3]};
                            *(GAS f32x4*)(GATEg + (size_t)m * 128 + h * 16 + 4 * q) = (f32x4){sc[4 * q] * inv, sc[4 * q + 1] * inv, sc[4 * q + 2] * inv, sc[4 * q + 3] * inv}; } }
                }
                asm volatile("" ::: "memory");
            }
        }
        if (P11A_S2MERGE && !(SKIP & 1)) { int lane = F.lane; asm volatile("" : "+v"(lane));
                { const int grp = lane >> 5, tk = (lane >> 3) & 3, h = lane & 7, m = m0 + grp * 4 + tk; const LAS unsigned* SLg = grp ? SL2 : SL;
                    const LAS unsigned* L1 = SLg + (tk * 16 + 2 * h) * 16; const LAS unsigned* L2 = L1 + 16;
                    float f1[16], f2[16];
#pragma unroll
                    for (int q = 0; q < 4; ++q) { const v4u a = *(const LAS v4u*)(L1 + 4 * q), b = *(const LAS v4u*)(L2 + 4 * q);
                        f1[4 * q] = key_val(a.x, 127u); f1[4 * q + 1] = key_val(a.y, 127u); f1[4 * q + 2] = key_val(a.z, 127u); f1[4 * q + 3] = key_val(a.w, 127u);
                        f2[4 * q] = key_val(b.x, 127u); f2[4 * q + 1] = key_val(b.y, 127u); f2[4 * q + 2] = key_val(b.z, 127u); f2[4 * q + 3] = key_val(b.w, 127u); }
                    unsigned c[16]; { unsigned k[16]; SN_STAGE2(c, k); }
                    const float rt = RTS[grp * 4 + tk];
                    float sc[16]; int ee[16]; float mx = -3.0e38f;
#pragma unroll
                    for (int r = 0; r < 16; ++r) { const unsigned ij = c[r] & 255u; const unsigned k1 = L1[ij >> 4], k2 = L2[ij & 15u];
                        sc[r] = key_val(k1, 127u) + key_val(k2, 127u); ee[r] = (int)((k1 & 127u) * 128u + (k2 & 127u)); mx = fmaxf(mx, sc[r]); }
                    float sum = 0.f;
#pragma unroll
                    for (int r = 0; r < 16; ++r) { sc[r] = __expf(rt * (sc[r] - mx)); sum += sc[r]; }
                    const float inv = 1.0f / sum;
#pragma unroll
                    for (int q = 0; q < 4; ++q) { *(LAS v4u*)(EIDS + (grp * 4 + tk) * 128 + h * 16 + 4 * q) = (v4u){(unsigned)ee[4 * q], (unsigned)ee[4 * q + 1], (unsigned)ee[4 * q + 2], (unsigned)ee[4 * q + 3]};
                        if (!(SKIP & 4)) { *(GAS v4u*)(EIDg + (size_t)m * 128 + h * 16 + 4 * q) = (v4u){(unsigned)ee[4 * q], (unsigned)ee[4 * q + 1], (unsigned)ee[4 * q + 2], (unsigned)ee[4 * q + 3]};
                            *(GAS f32x4*)(GATEg + (size_t)m * 128 + h * 16 + 4 * q) = (f32x4){sc[4 * q] * inv, sc[4 * q + 1] * inv, sc[4 * q + 2] * inv, sc[4 * q + 3] * inv}; } }
                }
                asm volatile("" ::: "memory");
        }
        if (P11B_DIRECT) continue;
#pragma unroll 1
        for (int ti = 0; ti < 8; ++ti) {
            int lane = F.lane; asm volatile("" : "+v"(lane));
            const int tA = (EIDS[ti * 128 + lane] >> 9) & 31, tB = (EIDS[ti * 128 + 64 + lane] >> 9) & 31; int mycnt = 0;
#pragma unroll
            for (int k = 0; k < NET; ++k) { const int c = __popcll(__ballot(tA == k)) + __popcll(__ballot(tB == k)); mycnt = (lane == k) ? c : mycnt; }
            if (lane < NET) OFFS[ti * NET + lane] = __hip_atomic_fetch_add((int*)(BC + lane), mycnt, __ATOMIC_RELAXED, __HIP_MEMORY_SCOPE_WORKGROUP);
        }
        __syncthreads();
        const int tt = blk >> 4;
        if (F.tid < NET) BC[NET + F.tid] = (int)__hip_atomic_fetch_add((unsigned*)(F.ctl + CW_CNT) + (tt * NET + F.tid) * 16, (unsigned)BC[F.tid], __ATOMIC_RELAXED, __HIP_MEMORY_SCOPE_AGENT);
        __syncthreads();
#pragma unroll 1
        for (int ti = 0; ti < 8; ++ti) { const int m = m0 + ti;
            int lane = F.lane; asm volatile("" : "+v"(lane));
            const unsigned long long lt_mask = (1ull << lane) - 1ull;
            const int eA = EIDS[ti * 128 + lane] & 16383, eB = EIDS[ti * 128 + 64 + lane] & 16383, tA = eA >> 9, tB = eB >> 9; int rankA = 0, rankB = 0;
#pragma unroll
            for (int k = 0; k < NET; ++k) { const unsigned long long mA = __ballot(tA == k), mB = __ballot(tB == k);
                rankA = (tA == k) ? __popcll(mA & lt_mask) : rankA; rankB = (tB == k) ? __popcll(mA) + __popcll(mB & lt_mask) : rankB; }
            const unsigned tl = (unsigned)(m & 1023) << 17;
            if (!(SKIP & 4)) { const int s = BC[NET + tA] + OFFS[ti * NET + tA] + rankA; if (s < REC_CAP) REC[(size_t)(tt * NET + tA) * REC_CAP + s] = tl | ((unsigned)(eA & 511) << 7) | (unsigned)lane; }
            if (!(SKIP & 4)) { const int s = BC[NET + tB] + OFFS[ti * NET + tB] + rankB; if (s < REC_CAP) REC[(size_t)(tt * NET + tB) * REC_CAP + s] = tl | ((unsigned)(eB & 511) << 7) | (unsigned)(lane + 64); }
        }
    }
}

typedef int v8i_t __attribute__((ext_vector_type(8)));
template <bool TOG>
__device__ __forceinline__ void p11_udot_token(Frame& F, int m, int lane, LAS int* EIDL, LAS float* AVL) {
    const unsigned char* XQ6 = F.ws + WS_XQ; const unsigned char* TU6 = F.ws + WS_TU; const int* EIDg = (const int*)(F.ws + WS_EID);
    const float* SXR = (const float*)(F.ws + WS_SXR); const float* GATEg = (const float*)(F.ws + WS_GATE); float* AVg = (float*)(F.ws + WS_AV);
    const float* SU = (const float*)(F.ws + WS_PSC); const float* SV = SU + 16384;
    {
        const int lo16 = lane * 16, lo8 = 1024 + lane * 8;
        const int e0 = EIDg[(size_t)m * 128 + lane] & 16383, e1 = EIDg[(size_t)m * 128 + 64 + lane] & 16383;
        EIDL[lane] = e0; EIDL[lane + 64] = e1;
        v8i_t xb; { const unsigned char* xp = XQ6 + (size_t)m * 1536; const v4u a = *(const GAS v4u*)(xp + lo16); const v2u b = *(const GAS v2u*)(xp + lo8); xb = (v8i_t){(int)a.x, (int)a.y, (int)a.z, (int)a.w, (int)b.x, (int)b.y, 0, 0}; }
        asm volatile("" ::: "memory");
        const bool dg = ((lane & 15) >> 2) == (lane >> 4); const int rsel = lane & 3;
        LAS float* HP = (LAS float*)(EIDL + 256);
        constexpr int NB = 8;
        v4u ua[2][NB]; v2u ub[2][NB];
#define P11D_LOAD(buf, g) do { _Pragma("unroll") for (int q = 0; q < NB; ++q) { const int e = __builtin_amdgcn_readfirstlane(EIDL[(g) + q]); const unsigned char* up = TU6 + (size_t)e * TU_PITCH; \
            ua[buf][q] = *(const GAS v4u*)(up + lo16); if (UFMT != 4) ub[buf][q] = *(const GAS v2u*)(up + lo8); } } while (0)
#define P11D_MMA(buf, g) do { _Pragma("unroll") for (int q = 0; q < NB; ++q) { const v8i_t av8 = {(int)ua[buf][q].x, (int)ua[buf][q].y, (int)ua[buf][q].z, (int)ua[buf][q].w, UFMT != 4 ? (int)ub[buf][q].x : 0, UFMT != 4 ? (int)ub[buf][q].y : 0, 0, 0}; \
            const f32x4 d = __builtin_amdgcn_mfma_scale_f32_16x16x128_f8f6f4(av8, xb, (f32x4){0.f, 0.f, 0.f, 0.f}, UFMT == 4 ? 4 : 2, 2, 0, 0, 0, 0); \
            float dv = rsel == 0 ? d[0] : rsel == 1 ? d[1] : rsel == 2 ? d[2] : d[3]; dv += dppf<0xB1>(dv); dv += dppf<0x4E>(dv);        \
            HP[dg ? ((g) + q) * 4 + (lane >> 4) : 512] = dv; } \
            __builtin_amdgcn_sched_barrier(0); } while (0)
        P11D_LOAD(0, 0);
#pragma unroll 1
        for (int g = 0; g < 64; g += 2 * NB) { P11D_LOAD(1, g + NB); P11D_MMA(0, g); P11D_LOAD(0, g + 2 * NB); P11D_MMA(1, g + NB); }
#pragma unroll 1
        for (int g = 64; g < 128; g += 2 * NB) { P11D_LOAD(1, g + NB); P11D_MMA(0, g); if (g + 2 * NB < 128) P11D_LOAD(0, g + 2 * NB); P11D_MMA(1, g + NB); }
#undef P11D_LOAD
#undef P11D_MMA
        asm volatile("" ::: "memory");
        const f32x4 p0 = *(const LAS f32x4*)(HP + lane * 4), p1 = *(const LAS f32x4*)(HP + 256 + lane * 4);
        const float h0 = (p0[0] + p0[1]) + (p0[2] + p0[3]), h1 = (p1[0] + p1[1]) + (p1[2] + p1[3]);
        const float sxm = SXR[2 * m];
        { const size_t j0 = (size_t)m * 128 + lane, j1 = j0 + 64;
          const float a0 = gelu_erf(h0 * SU[e0] * sxm) * GATEg[j0] * SV[e0], a1 = gelu_erf(h1 * SU[e1] * sxm) * GATEg[j1] * SV[e1];
          AVL[lane] = a0; AVL[lane + 64] = a1; if (TOG) { AVg[j0] = a0; AVg[j1] = a1; } }
        asm volatile("" ::: "memory");
    }
}
template <int SKIP>
__device__ __forceinline__ void p11b_direct_sliced(Frame& F) {
    constexpr int WL = 20224, NSL = NSLICES, SLSH = 14 - NSL_LOG;
    const int gw = F.vcu * NWAVES + F.wave, NGW = F.G * NWAVES;
    LAS unsigned* LR = (LAS unsigned*)(F.lds + F.wave * WL);
    LAS unsigned char* XS = (LAS unsigned char*)(LR + 1024);
    LAS float* HPb = (LAS float*)(XS + 8 * 1536);
    LAS int* CNT = (LAS int*)(HPb + 512);
    const unsigned char* XQ6 = F.ws + WS_XQ; const unsigned char* TU6 = F.ws + WS_TU; const int* EIDg = (const int*)(F.ws + WS_EID);
    const float* SXR = (const float*)(F.ws + WS_SXR); const float* GATEg = (const float*)(F.ws + WS_GATE); float* AVg = (float*)(F.ws + WS_AV);
    const float* SU = (const float*)(F.ws + WS_PSC); const float* SV = SU + 16384;
    int lane = F.lane; asm volatile("" : "+v"(lane));
    const int lo16 = lane * 16, lo8 = 1024 + lane * 8;
    const bool dg = ((lane & 15) >> 2) == (lane >> 4); const int rsel = lane & 3;
    const float sm0 = (dg && rsel == 0) ? 1.f : 0.f, sm1 = (dg && rsel == 1) ? 1.f : 0.f, sm2 = (dg && rsel == 2) ? 1.f : 0.f, sm3 = (dg && rsel == 3) ? 1.f : 0.f;
    const int hpo = dg ? (lane >> 4) : 256;
    const int ntok = PEER_LOCAL ? 8 * ((SEQ / 64 - F.vcu + F.G - 1) / F.G) : (gw < SEQ ? (SEQ - gw + NGW - 1) / NGW : 0);
    for (int k0 = 0; k0 < ntok; k0 += 8) {
        const int nk = ntok - k0 < 8 ? ntok - k0 : 8, np = nk * 128;
        const int tb0 = PEER_LOCAL ? (F.vcu + (k0 >> 3) * F.G) * 64 + F.wave * 8 : gw + k0 * NGW, tst = PEER_LOCAL ? 1 : NGW;
        if (lane < NSL) CNT[lane] = 0;
        unsigned rec[16]; int pos[16];
#pragma unroll
        for (int k = 0; k < 8; ++k) if (k < nk) { const int m = tb0 + k * tst; const size_t mb = (size_t)m * 128;
            const unsigned char* xp = XQ6 + (size_t)m * 1536; *(LAS v4u*)(XS + k * 1536 + lo16) = *(const GAS v4u*)(xp + lo16); *(LAS v2u*)(XS + k * 1536 + lo8) = *(const GAS v2u*)(xp + lo8);
#pragma unroll
            for (int hh = 0; hh < 2; ++hh) { const unsigned e = (unsigned)EIDg[mb + 64 * hh + lane] & 16383u; rec[2 * k + hh] = (e << 10) | (unsigned)(k << 7) | (unsigned)(64 * hh + lane);
                if (P11B_SORT) pos[2 * k + hh] = __hip_atomic_fetch_add(CNT + (e >> SLSH), 1, __ATOMIC_RELAXED, __HIP_MEMORY_SCOPE_WORKGROUP); else { pos[2 * k + hh] = 0; LR[k * 128 + 64 * hh + lane] = rec[2 * k + hh]; } } }
        asm volatile("" ::: "memory");
        if (P11B_SORT) { int base[NSL]; int run = 0;
#pragma unroll
          for (int sl = 0; sl < NSL; ++sl) { base[sl] = run; run += CNT[sl]; }
#pragma unroll
          for (int k = 0; k < 8; ++k) if (k < nk)
#pragma unroll
              for (int hh = 0; hh < 2; ++hh) { const unsigned sl = rec[2 * k + hh] >> (10 + SLSH); int bs = base[0];
#pragma unroll
                  for (int t = 1; t < NSL; ++t) bs = sl == (unsigned)t ? base[t] : bs;
                  LR[bs + pos[2 * k + hh]] = rec[2 * k + hh]; } }
        asm volatile("" ::: "memory");
        v4u ua[2][8]; unsigned rc[2][8];
#define P11S_LOAD(buf, g) do { const v4u r03 = *(const LAS v4u*)(LR + (g)), r47 = *(const LAS v4u*)(LR + (g) + 4); const unsigned rr[8] = {r03.x, r03.y, r03.z, r03.w, r47.x, r47.y, r47.z, r47.w}; \
            _Pragma("unroll") for (int q = 0; q < 8; ++q) { const unsigned r = (unsigned)__builtin_amdgcn_readfirstlane((int)rr[q]); rc[buf][q] = r; \
                ua[buf][q] = *(const GAS v4u*)(TU6 + (unsigned)(((r >> 10) << 10) + (unsigned)lo16)); } } while (0)
#define P11S_MMA(buf, g) do { f32x4 dq[8]; v4u xa[8]; v2u xc[8]; \
            _Pragma("unroll") for (int q = 0; q < 8; ++q) { const int kx = (int)((rc[buf][q] >> 7) & 7u); xa[q] = *(const LAS v4u*)(XS + kx * 1536 + lo16); xc[q] = *(const LAS v2u*)(XS + kx * 1536 + lo8); } \
            __builtin_amdgcn_sched_barrier(0); \
            _Pragma("unroll") for (int q = 0; q < 8; ++q) { const v8i_t xb = {(int)xa[q].x, (int)xa[q].y, (int)xa[q].z, (int)xa[q].w, (int)xc[q].x, (int)xc[q].y, 0, 0}; \
                const v8i_t av8 = {(int)ua[buf][q].x, (int)ua[buf][q].y, (int)ua[buf][q].z, (int)ua[buf][q].w, 0, 0, 0, 0}; \
                dq[q] = __builtin_amdgcn_mfma_scale_f32_16x16x128_f8f6f4(av8, xb, (f32x4){0.f, 0.f, 0.f, 0.f}, 4, 2, 0, 0, 0, 0); } \
            __builtin_amdgcn_sched_barrier(0); \
            _Pragma("unroll") for (int q = 0; q < 8; ++q) { float dv = (dq[q][0] * sm0 + dq[q][1] * sm1) + (dq[q][2] * sm2 + dq[q][3] * sm3);        \
                dv += dppf<0xB1>(dv); dv += dppf<0x4E>(dv); HPb[hpo + (((g) & 63) + q) * 4] = dv; } \
            __builtin_amdgcn_sched_barrier(0); } while (0)
        P11S_LOAD(0, 0);
#pragma unroll 1
        for (int g64 = 0; g64 < np; g64 += 64) {
            const unsigned fr_ = LR[g64 + lane]; const unsigned fe = fr_ >> 10; const int fm = tb0 + (int)((fr_ >> 7) & 7u) * tst;
            const float fsu = SU[fe], fsv = SV[fe], fgt = GATEg[(size_t)fm * 128 + (fr_ & 127u)], fsx = SXR[2 * fm];
#pragma unroll 1
            for (int g = g64; g < g64 + 64; g += 16) { P11S_LOAD(1, g + 8); P11S_MMA(0, g); if (g + 16 < np) P11S_LOAD(0, g + 16); P11S_MMA(1, g + 8); }
            asm volatile("" ::: "memory");
            { const f32x4 p = *(const LAS f32x4*)(HPb + lane * 4); AVg[(size_t)fm * 128 + (fr_ & 127u)] = gelu_erf(((p[0] + p[1]) + (p[2] + p[3])) * fsu * fsx) * fgt * fsv; }
            asm volatile("" ::: "memory");
        }
#undef P11S_LOAD
#undef P11S_MMA
        asm volatile("" ::: "memory");
    }
}
__device__ __forceinline__ void p11b_direct(Frame& F) {
    const int gw = F.vcu * NWAVES + F.wave, NGW = F.G * NWAVES;
    LAS int* EIDL = (LAS int*)(F.lds + F.wave * 16384);
    for (int m = gw; m < SEQ; m += NGW) { int lane = F.lane; asm volatile("" : "+v"(lane)); p11_udot_token<true>(F, m, lane, EIDL, (LAS float*)(EIDL + 128)); }
}

constexpr int NSLOT = 12, UPITCH = 80;
template <int SKIP>
__device__ __forceinline__ void p11b_udot(Frame& F) {
    LAS unsigned char* XS = (LAS unsigned char*)F.lds;
    LAS unsigned char* US = XS + 1024 * UPITCH;
    LAS int* QB = (LAS int*)(F.lds + 124 * 1024);
    const int tid = F.tid;
    const unsigned char* XQ = F.ws + WS_XQ; const unsigned char* TU = F.ws + WS_TU; const unsigned* REC = (const unsigned*)(F.ws + WS_REC);
    const float* SXR = (const float*)(F.ws + WS_SXR); const float* GATEg = (const float*)(F.ws + WS_GATE); float* AVg = (float*)(F.ws + WS_AV);
    const float* SU = (const float*)(F.ws + WS_PSC); const float* SV = SU + 16384;
    for (;;) {
        __syncthreads();
        if (tid == 0) QB[0] = (int)__hip_atomic_fetch_add((unsigned*)(F.ctl + CW_Q), 1u, __ATOMIC_RELAXED, __HIP_MEMORY_SCOPE_AGENT);
        __syncthreads();
        const int b = QB[0];
        if (b >= NBUCK) break;
        const int tt = b >> 5, et = b & 31;
        int n = (int)__hip_atomic_load((unsigned*)(F.ctl + CW_CNT) + b * 16, __ATOMIC_RELAXED, __HIP_MEMORY_SCOPE_AGENT); n = n < REC_CAP ? n : REC_CAP;
        for (int g0 = 0; g0 < n; g0 += NSLOT * NTHR) {
            const int npass = (n - g0) < NSLOT * NTHR ? (n - g0) : NSLOT * NTHR;
            unsigned rec[NSLOT]; int acc[NSLOT];
#pragma unroll
            for (int j = 0; j < NSLOT; ++j) { const int idx = g0 + j * NTHR + tid; const unsigned r = idx < n ? REC[(size_t)b * REC_CAP + idx] : 0xffffffffu; acc[j] = 0;
                rec[j] = ((r >> 17) & 1023u) | (((r >> 7) & 511u) << 16); }
            v4u st[12];
#define P11B_SRC(step, i) (((i) % 6) < 4 ? XQ + ((size_t)(2 * (step) + (i) / 6) * SEQ + tt * 1024) * 32 + (size_t)(tid + 512 * ((i) % 6)) * 16 : TU + ((size_t)(2 * (step) + (i) / 6) * 16384 + et * ETSZ) * 32 + (size_t)(tid + 512 * (((i) % 6) - 4)) * 16)
#pragma unroll
            for (int i = 0; i < 12; ++i) st[i] = *(const GAS v4u*)P11B_SRC(0, i);
#pragma unroll 1
            for (int c = 0; c < 32; ++c) {
                __syncthreads();
#pragma unroll
                for (int i = 0; i < 12; ++i) { const int q = i % 6, hc = i / 6, p = (q < 4) ? tid + 512 * q : tid + 512 * (q - 4); *(LAS v4u*)((q < 4 ? XS : US) + (p >> 1) * UPITCH + hc * 32 + (p & 1) * 16) = st[i]; }
                __syncthreads();
                if (c + 1 < 32 && !(SKIP & 1)) {
#pragma unroll
                    for (int i = 0; i < 12; ++i) st[i] = *(const GAS v4u*)P11B_SRC(c + 1, i);
                }
#pragma unroll
                for (int j0 = 0; j0 < NSLOT; j0 += 2) {
                    if (j0 * NTHR < npass && !(SKIP & 2)) {
                        v4u xb[2][4], ub[2][4];
#pragma unroll
                        for (int q = 0; q < 2; ++q) { unsigned r = rec[j0 + q]; asm volatile("" : "+v"(r));
                            const unsigned xo = (r & 0xffffu) * UPITCH, uo = (r >> 16) * UPITCH;
#pragma unroll
                            for (int hh = 0; hh < 4; ++hh) { xb[q][hh] = *(const LAS v4u*)(XS + xo + 16 * hh); ub[q][hh] = *(const LAS v4u*)(US + uo + 16 * hh); } }
                        __builtin_amdgcn_sched_barrier(0);
#pragma unroll
                        for (int q = 0; q < 2; ++q) { int s = acc[j0 + q];
#pragma unroll
                            for (int hh = 0; hh < 4; ++hh) { const v4u u = ub[q][hh], x = xb[q][hh];
                                s = __builtin_amdgcn_sdot4((int)u.x, (int)x.x, s, false); s = __builtin_amdgcn_sdot4((int)u.y, (int)x.y, s, false); s = __builtin_amdgcn_sdot4((int)u.z, (int)x.z, s, false); s = __builtin_amdgcn_sdot4((int)u.w, (int)x.w, s, false); }
                            acc[j0 + q] = s; }
                        __builtin_amdgcn_sched_barrier(0);
                    }
                }
            }
#undef P11B_SRC
#pragma unroll
            for (int j = 0; j < NSLOT; ++j) { const int idx = g0 + j * NTHR + tid; const unsigned r = idx < n ? REC[(size_t)b * REC_CAP + idx] : 0xffffffffu;
                if (r != 0xffffffffu) { const int t = tt * 1024 + (int)((r >> 17) & 1023), e = et * ETSZ + (int)((r >> 7) & 511), j7 = (int)(r & 127);
                    const float hv = (float)acc[j] * SU[e] * SXR[2 * t]; AVg[(size_t)t * 128 + j7] = gelu_erf(hv) * GATEg[(size_t)t * 128 + j7] * SV[e]; } }
        }
    }
}

#if VFMT == 4 && P11C_MFMA
__device__ __forceinline__ void p11c_mfma(Frame& F) {
    const int gw = F.vcu * NWAVES + F.wave, NGW = F.G * NWAVES;
    LAS int* EID = (LAS int*)(F.lds + F.wave * 16384); LAS float* AV = (LAS float*)(EID + 128); LAS float* YL = (LAS float*)(EID + 256);
    const unsigned char* TV = F.ws + WS_TV; const int* EIDg = (const int*)(F.ws + WS_EID); const float* AVg = (const float*)(F.ws + WS_AV);
    const int nmy = PEER_LOCAL ? 8 * ((SEQ / 64 - F.vcu + F.G - 1) / F.G) : (gw < SEQ ? (SEQ - gw + NGW - 1) / NGW : 0);
    for (int ti = 0; ti < nmy; ++ti) { const int m = PEER_LOCAL ? (F.vcu + (ti >> 3) * F.G) * 64 + F.wave * 8 + (ti & 7) : gw + ti * NGW;
        int lane = F.lane; asm volatile("" : "+v"(lane));
        const int i16 = lane & 15, kg = lane >> 4, lo16 = lane * 16;
        EID[lane] = EIDg[(size_t)m * 128 + lane]; EID[lane + 64] = EIDg[(size_t)m * 128 + 64 + lane]; AV[lane] = AVg[(size_t)m * 128 + lane]; AV[lane + 64] = AVg[(size_t)m * 128 + 64 + lane];
        asm volatile("" ::: "memory");
        f32x4 acc[4][2];
#pragma unroll
        for (int Q = 0; Q < 4; ++Q) { acc[Q][0] = (f32x4){0.f, 0.f, 0.f, 0.f}; acc[Q][1] = (f32x4){0.f, 0.f, 0.f, 0.f}; }
        v4u ua[2][2][4]; float aw[2][2];
        const int wsh = 8 * (i16 & 3), wd = i16 >> 2;
#define P11M_LOAD(buf, g) do { _Pragma("unroll") for (int gg = 0; gg < 2; ++gg) { const int e = EID[4 * ((g) + gg) + kg] & 16383; aw[buf][gg] = AV[4 * ((g) + gg) + kg]; const unsigned char* rp = TV + (size_t)e * 1024 + 16 * i16; \
            _Pragma("unroll") for (int Q = 0; Q < 4; ++Q) ua[buf][gg][Q] = *(const GAS v4u*)(rp + 256 * Q); } } while (0)
#if B8_SPLIT
#define P11M_ACC(buf) do { _Pragma("unroll") for (int gg = 0; gg < 2; ++gg) { \
            const float alo = AV[4 * ((gcur_##buf) + gg) + (kg >> 1)], ahi = AV[4 * ((gcur_##buf) + gg) + 2 + (kg >> 1)]; \
            const unsigned l8 = ((unsigned)__builtin_amdgcn_cvt_pk_fp8_f32(alo, alo, 0, false) & 0xffu) << wsh, h8 = ((unsigned)__builtin_amdgcn_cvt_pk_fp8_f32(ahi, ahi, 0, false) & 0xffu) << wsh; \
            const int l0 = wd == 0 ? (int)l8 : 0, l1 = wd == 1 ? (int)l8 : 0, l2 = wd == 2 ? (int)l8 : 0, l3 = wd == 3 ? (int)l8 : 0, h0 = wd == 0 ? (int)h8 : 0, h1 = wd == 1 ? (int)h8 : 0, h2 = wd == 2 ? (int)h8 : 0, h3 = wd == 3 ? (int)h8 : 0; \
            const bool c0 = (kg & 1) == 0; \
            const v8i_t b0 = {c0 ? l0 : 0, c0 ? l1 : 0, c0 ? l2 : 0, c0 ? l3 : 0, c0 ? h0 : 0, c0 ? h1 : 0, c0 ? h2 : 0, c0 ? h3 : 0}, b1 = {c0 ? 0 : l0, c0 ? 0 : l1, c0 ? 0 : l2, c0 ? 0 : l3, c0 ? 0 : h0, c0 ? 0 : h1, c0 ? 0 : h2, c0 ? 0 : h3}; \
            _Pragma("unroll") for (int Q = 0; Q < 4; ++Q) { const v8i_t av8 = {(int)ua[buf][gg][Q].x, (int)ua[buf][gg][Q].y, (int)ua[buf][gg][Q].z, (int)ua[buf][gg][Q].w, 0, 0, 0, 0}; \
                acc[Q][0] = __builtin_amdgcn_mfma_scale_f32_16x16x128_f8f6f4(av8, b0, acc[Q][0], 4, 0, 0, 0, 0, 0); acc[Q][1] = __builtin_amdgcn_mfma_scale_f32_16x16x128_f8f6f4(av8, b1, acc[Q][1], 4, 0, 0, 0, 0, 0); } } \
            __builtin_amdgcn_sched_barrier(0); } while (0)
#else
#define P11M_ACC(buf) do { _Pragma("unroll") for (int gg = 0; gg < 2; ++gg) { const unsigned a8 = (unsigned)__builtin_amdgcn_cvt_pk_fp8_f32(aw[buf][gg], aw[buf][gg], 0, false) & 0xffu; const unsigned wv = a8 << wsh; \
            const int w0 = wd == 0 ? (int)wv : 0, w1 = wd == 1 ? (int)wv : 0, w2 = wd == 2 ? (int)wv : 0, w3 = wd == 3 ? (int)wv : 0; \
            const v8i_t b0 = {w0, w1, w2, w3, 0, 0, 0, 0}, b1 = {0, 0, 0, 0, w0, w1, w2, w3}; \
            _Pragma("unroll") for (int Q = 0; Q < 4; ++Q) { const v8i_t av8 = {(int)ua[buf][gg][Q].x, (int)ua[buf][gg][Q].y, (int)ua[buf][gg][Q].z, (int)ua[buf][gg][Q].w, 0, 0, 0, 0}; \
                acc[Q][0] = __builtin_amdgcn_mfma_scale_f32_16x16x128_f8f6f4(av8, b0, acc[Q][0], 4, 0, 0, 0, 0, 0); acc[Q][1] = __builtin_amdgcn_mfma_scale_f32_16x16x128_f8f6f4(av8, b1, acc[Q][1], 4, 0, 0, 0, 0, 0); } } \
            __builtin_amdgcn_sched_barrier(0); } while (0)
#endif
        int gcur_0 = 0, gcur_1 = 2; P11M_LOAD(0, 0);
#pragma unroll 1
        for (int g = 0; g < 32; g += 4) { gcur_1 = g + 2; P11M_LOAD(1, g + 2); P11M_ACC(0); gcur_0 = g + 4; if (g + 4 < 32) P11M_LOAD(0, g + 4); P11M_ACC(1); }
        (void)gcur_0; (void)gcur_1;
#undef P11M_LOAD
#undef P11M_ACC
#pragma unroll
        for (int Q = 0; Q < 4; ++Q)
#pragma unroll
            for (int c = 0; c < 2; ++c)
#pragma unroll
                for (int r = 0; r < 4; ++r) YL[512 * Q + 32 * (4 * kg + r) + 16 * c + i16] = acc[Q][c][r];
        asm volatile("" ::: "memory");
        float y[32];
#pragma unroll
        for (int j = 0; j < 2; ++j)
#pragma unroll
            for (int q = 0; q < 4; ++q) { const f32x4 t = *(const LAS f32x4*)(YL + 1024 * j + lo16 + 4 * q); y[16 * j + 4 * q] = t[0]; y[16 * j + 4 * q + 1] = t[1]; y[16 * j + 4 * q + 2] = t[2]; y[16 * j + 4 * q + 3] = t[3]; }
        const bf16* x1 = (const bf16*)(F.ws + WS_X1B) + (size_t)m * DM; float s2 = 0.f;
#pragma unroll
        for (int j = 0; j < 2; ++j)
#pragma unroll
            for (int q = 0; q < 4; ++q) { const v2u a2 = *(const GAS v2u*)(x1 + j * 1024 + lo16 + 4 * q); y[16 * j + 4 * q] += bflo(a2.x); y[16 * j + 4 * q + 1] += bfhi(a2.x); y[16 * j + 4 * q + 2] += bflo(a2.y); y[16 * j + 4 * q + 3] += bfhi(a2.y); }
#pragma unroll
        for (int e = 0; e < 32; ++e) s2 += y[e] * y[e];
        const float ro = 1.0f / sqrtf(wave_sum(s2) * (1.f / DM) + EPS);
        float* orow = F.out + (size_t)m * DM;
#pragma unroll
        for (int j = 0; j < 2; ++j)
#pragma unroll
            for (int q = 0; q < 4; ++q) { const f32x4 a = *(const GAS f32x4*)(F.in[I_FNW] + j * 1024 + lo16 + 4 * q);
                *(GAS f32x4*)(orow + j * 1024 + lo16 + 4 * q) = (f32x4){y[16 * j + 4 * q] * ro * a.x, y[16 * j + 4 * q + 1] * ro * a.y, y[16 * j + 4 * q + 2] * ro * a.z, y[16 * j + 4 * q + 3] * ro * a.w}; }
        asm volatile("" ::: "memory");
    }
}
#endif
#if VFMT == 4 && P11C_MFMA == 2
__device__ __forceinline__ void p11c_mfma_sliced(Frame& F) {
    constexpr int WL = 20224, NTK = P11C_NTK, NBIN = 8 * NTK, GB = NTK == 4 ? 1 : 2;
    const int gw = F.vcu * NWAVES + F.wave, NGW = F.G * NWAVES;
    LAS unsigned* LR = (LAS unsigned*)(F.lds + F.wave * WL);
    LAS float* AVL = (LAS float*)(LR + 640);
    LAS int* CNT = (LAS int*)(AVL + 512);
    LAS float* YL = (LAS float*)(CNT + 64);
    const unsigned char* TV = F.ws + WS_TV; const int* EIDg = (const int*)(F.ws + WS_EID); const float* AVg = (const float*)(F.ws + WS_AV);
    int lane = F.lane; asm volatile("" : "+v"(lane));
    const int i16 = lane & 15, kg = lane >> 4, lo16 = lane * 16, wsh = 8 * (i16 & 3), wd = i16 >> 2; const bool c0 = (kg & 1) == 0;
    const int nmy = PEER_LOCAL ? 8 * ((SEQ / 64 - F.vcu + F.G - 1) / F.G) : (gw < SEQ ? (SEQ - gw + NGW - 1) / NGW : 0);
    unsigned pe[2 * NTK]; float pa[2 * NTK];
#define P11T_TOK(t_) (PEER_LOCAL ? (F.vcu + ((t_) >> 3) * F.G) * 64 + F.wave * 8 + ((t_) & 7) : gw + (t_) * NGW)
#define P11T_PRE(t0_) do { _Pragma("unroll") for (int k = 0; k < NTK; ++k) { const size_t mb_ = (size_t)P11T_TOK((t0_) + k) * 128; _Pragma("unroll") for (int hh = 0; hh < 2; ++hh) { pe[2 * k + hh] = (unsigned)EIDg[mb_ + 64 * hh + lane]; pa[2 * k + hh] = AVg[mb_ + 64 * hh + lane]; } } } while (0)
    if (nmy > 0) P11T_PRE(0);
    for (int t0 = 0; t0 < nmy; t0 += NTK) {
#define P11T_TOK_UNUSED(t_) (PEER_LOCAL ? (F.vcu + ((t_) >> 3) * F.G) * 64 + F.wave * 8 + ((t_) & 7) : gw + (t_) * NGW)
        if (lane < NBIN) CNT[lane] = 0;
        unsigned rec[2 * NTK]; int pos[2 * NTK];
#pragma unroll
        for (int k = 0; k < NTK; ++k) { const size_t mb = (size_t)P11T_TOK(t0 + k) * 128; int c0cnt[8]; const unsigned long long ltm = (1ull << lane) - 1ull;
#pragma unroll
            for (int hh = 0; hh < 2; ++hh) { const int j = 64 * hh + lane; const unsigned e = pe[2 * k + hh] & 16383u; AVL[k * 128 + j] = pa[2 * k + hh];
                rec[2 * k + hh] = (e << 10) | (unsigned)(k << 7) | (unsigned)j;
                const int sl = (int)(e >> 11); int rk = 0;
#pragma unroll
                for (int s8 = 0; s8 < 8; ++s8) { const unsigned long long mk = __ballot(sl == s8); const int before = hh ? c0cnt[s8] : 0;
                    if (sl == s8) rk = before + __popcll(mk & ltm); if (hh == 0) c0cnt[s8] = __popcll(mk); else if (lane == 0) CNT[s8 * NTK + k] = c0cnt[s8] + __popcll(mk); }
                pos[2 * k + hh] = rk; } }
        asm volatile("" ::: "memory");
        int run = 0, mybase = 0, mycnt = 0;
#pragma unroll 1
        for (int b = 0; b < NBIN; ++b) { const int c = CNT[b]; if (lane == b) { mybase = run; mycnt = c; } run += (c + 3) & ~3; }
        const int ng = __builtin_amdgcn_readfirstlane(run) >> 2;
        if (lane < NBIN) { CNT[32 + lane] = mybase;
            for (int t = mycnt; t < ((mycnt + 3) & ~3); ++t) LR[mybase + t] = 0x80000000u | ((unsigned)(lane / NTK) << 21) | ((unsigned)(lane % NTK) << 7); }
        asm volatile("" ::: "memory");
#pragma unroll
        for (int q = 0; q < 2 * NTK; ++q) { const int bin = (int)(rec[q] >> 21) * NTK + (int)((rec[q] >> 7) & 3u); LR[CNT[32 + bin] + pos[q]] = rec[q]; }
        asm volatile("" ::: "memory");
        if (t0 + NTK < nmy) P11T_PRE(t0 + NTK);
        f32x4 acc[NTK][4][2];
#pragma unroll
        for (int k = 0; k < NTK; ++k)
#pragma unroll
            for (int Q = 0; Q < 4; ++Q) { acc[k][Q][0] = (f32x4){0.f, 0.f, 0.f, 0.f}; acc[k][Q][1] = (f32x4){0.f, 0.f, 0.f, 0.f}; }
        v4u ua[2][GB][4]; float alo[2][GB], ahi[2][GB]; int kq[2][GB];
#define P11T_W(r_) (((r_) >> 31) ? 0.f : AVL[(((r_) >> 7) & 3u) * 128 + ((r_) & 127u)])
#define P11T_LOAD(buf, g) do { _Pragma("unroll") for (int gg = 0; gg < GB; ++gg) if ((g) + gg < ng) { const int gi = 4 * ((g) + gg); const unsigned r = LR[gi + kg], rl = LR[gi + (kg >> 1)], rh = LR[gi + 2 + (kg >> 1)]; \
            kq[buf][gg] = __builtin_amdgcn_readfirstlane((int)((r >> 7) & 3u)); alo[buf][gg] = P11T_W(rl); ahi[buf][gg] = P11T_W(rh); const unsigned char* rp = TV + (size_t)((r >> 10) & 16383u) * 1024 + 16 * i16; \
            _Pragma("unroll") for (int Q = 0; Q < 4; ++Q) ua[buf][gg][Q] = *(const GAS v4u*)(rp + 256 * Q); } } while (0)
#define P11T_MM(K) do { _Pragma("unroll") for (int Q = 0; Q < 4; ++Q) { const v8i_t av8 = {(int)ua_[Q].x, (int)ua_[Q].y, (int)ua_[Q].z, (int)ua_[Q].w, 0, 0, 0, 0}; \
            acc[K][Q][0] = __builtin_amdgcn_mfma_scale_f32_16x16x128_f8f6f4(av8, b0, acc[K][Q][0], 4, 0, 0, 0, 0, 0); acc[K][Q][1] = __builtin_amdgcn_mfma_scale_f32_16x16x128_f8f6f4(av8, b1, acc[K][Q][1], 4, 0, 0, 0, 0, 0); \
            if (P11C_A2) { acc[K][Q][0] = __builtin_amdgcn_mfma_scale_f32_16x16x128_f8f6f4(av8, b0r, acc[K][Q][0], 4, 0, 0, 0, 0, 0); acc[K][Q][1] = __builtin_amdgcn_mfma_scale_f32_16x16x128_f8f6f4(av8, b1r, acc[K][Q][1], 4, 0, 0, 0, 0, 0); } } } while (0)
#define P11T_ACC(buf, g) do { _Pragma("unroll") for (int gg = 0; gg < GB; ++gg) if ((g) + gg < ng) { \
            const unsigned l8 = ((unsigned)__builtin_amdgcn_cvt_pk_fp8_f32(alo[buf][gg], alo[buf][gg], 0, false) & 0xffu) << wsh, h8 = ((unsigned)__builtin_amdgcn_cvt_pk_fp8_f32(ahi[buf][gg], ahi[buf][gg], 0, false) & 0xffu) << wsh; \
            const int l0 = wd == 0 ? (int)l8 : 0, l1 = wd == 1 ? (int)l8 : 0, l2 = wd == 2 ? (int)l8 : 0, l3 = wd == 3 ? (int)l8 : 0, h0 = wd == 0 ? (int)h8 : 0, h1 = wd == 1 ? (int)h8 : 0, h2 = wd == 2 ? (int)h8 : 0, h3 = wd == 3 ? (int)h8 : 0; \
            const v8i_t b0 = {c0 ? l0 : 0, c0 ? l1 : 0, c0 ? l2 : 0, c0 ? l3 : 0, c0 ? h0 : 0, c0 ? h1 : 0, c0 ? h2 : 0, c0 ? h3 : 0}, b1 = {c0 ? 0 : l0, c0 ? 0 : l1, c0 ? 0 : l2, c0 ? 0 : l3, c0 ? 0 : h0, c0 ? 0 : h1, c0 ? 0 : h2, c0 ? 0 : h3}; \
              \
            const int lq = __builtin_amdgcn_cvt_pk_fp8_f32(alo[buf][gg], alo[buf][gg], 0, false), hq = __builtin_amdgcn_cvt_pk_fp8_f32(ahi[buf][gg], ahi[buf][gg], 0, false); \
            const float rl_ = alo[buf][gg] - __builtin_amdgcn_cvt_f32_fp8(lq, 0), rh_ = ahi[buf][gg] - __builtin_amdgcn_cvt_f32_fp8(hq, 0); \
            const unsigned l8r = ((unsigned)__builtin_amdgcn_cvt_pk_fp8_f32(rl_, rl_, 0, false) & 0xffu) << wsh, h8r = ((unsigned)__builtin_amdgcn_cvt_pk_fp8_f32(rh_, rh_, 0, false) & 0xffu) << wsh; \
            const int m0 = wd == 0 ? (int)l8r : 0, m1 = wd == 1 ? (int)l8r : 0, m2 = wd == 2 ? (int)l8r : 0, m3 = wd == 3 ? (int)l8r : 0, n0 = wd == 0 ? (int)h8r : 0, n1 = wd == 1 ? (int)h8r : 0, n2 = wd == 2 ? (int)h8r : 0, n3 = wd == 3 ? (int)h8r : 0; \
            const v8i_t b0r = {c0 ? m0 : 0, c0 ? m1 : 0, c0 ? m2 : 0, c0 ? m3 : 0, c0 ? n0 : 0, c0 ? n1 : 0, c0 ? n2 : 0, c0 ? n3 : 0}, b1r = {c0 ? 0 : m0, c0 ? 0 : m1, c0 ? 0 : m2, c0 ? 0 : m3, c0 ? 0 : n0, c0 ? 0 : n1, c0 ? 0 : n2, c0 ? 0 : n3}; \
            const v4u (&ua_)[4] = ua[buf][gg]; \
            if (NTK == 2) { if (kq[buf][gg] == 0) P11T_MM(0); else P11T_MM(1); } else { switch (kq[buf][gg]) { case 0: P11T_MM(0); break; case 1: P11T_MM(1); break; case 2: P11T_MM(NTK > 2 ? 2 : 0); break; default: P11T_MM(NTK > 2 ? 3 : 0); break; } } } \
            __builtin_amdgcn_sched_barrier(0); } while (0)
        P11T_LOAD(0, 0);
#pragma unroll 1
        for (int g = 0; g < ng; g += 2 * GB) { P11T_LOAD(1, g + GB); P11T_ACC(0, g); P11T_LOAD(0, g + 2 * GB); P11T_ACC(1, g + GB); }
#undef P11T_LOAD
#undef P11T_ACC
#undef P11T_MM
#undef P11T_W
#pragma unroll
        for (int k = 0; k < NTK; ++k) { const int m = P11T_TOK(t0 + k);
#pragma unroll
            for (int Q = 0; Q < 4; ++Q)
#pragma unroll
                for (int c = 0; c < 2; ++c)
#pragma unroll
                    for (int r = 0; r < 4; ++r) YL[512 * Q + 32 * (4 * kg + r) + 16 * c + i16] = acc[k][Q][c][r];
            asm volatile("" ::: "memory");
            float y[32];
#pragma unroll
            for (int j = 0; j < 2; ++j)
#pragma unroll
                for (int q = 0; q < 4; ++q) { const f32x4 t = *(const LAS f32x4*)(YL + 1024 * j + lo16 + 4 * q); y[16 * j + 4 * q] = t[0]; y[16 * j + 4 * q + 1] = t[1]; y[16 * j + 4 * q + 2] = t[2]; y[16 * j + 4 * q + 3] = t[3]; }
            asm volatile("" ::: "memory");
            const bf16* x1 = (const bf16*)(F.ws + WS_X1B) + (size_t)m * DM; float s2 = 0.f;
#pragma unroll
            for (int j = 0; j < 2; ++j)
#pragma unroll
                for (int q = 0; q < 4; ++q) { const v2u a2 = *(const GAS v2u*)(x1 + j * 1024 + lo16 + 4 * q); y[16 * j + 4 * q] += bflo(a2.x); y[16 * j + 4 * q + 1] += bfhi(a2.x); y[16 * j + 4 * q + 2] += bflo(a2.y); y[16 * j + 4 * q + 3] += bfhi(a2.y); }
#pragma unroll
            for (int e = 0; e < 32; ++e) s2 += y[e] * y[e];
            const float ro = 1.0f / sqrtf(wave_sum(s2) * (1.f / DM) + EPS);
            float* orow = F.out + (size_t)m * DM;
#pragma unroll
            for (int j = 0; j < 2; ++j)
#pragma unroll
                for (int q = 0; q < 4; ++q) { const f32x4 a = *(const GAS f32x4*)(F.in[I_FNW] + j * 1024 + lo16 + 4 * q);
                    *(GAS f32x4*)(orow + j * 1024 + lo16 + 4 * q) = (f32x4){y[16 * j + 4 * q] * ro * a.x, y[16 * j + 4 * q + 1] * ro * a.y, y[16 * j + 4 * q + 2] * ro * a.z, y[16 * j + 4 * q + 3] * ro * a.w}; } }
#undef P11T_TOK_UNUSED
        asm volatile("" ::: "memory");
    }
}
#undef P11T_TOK
#undef P11T_PRE
#endif
#if VFMT == 4 && V16
__device__ __forceinline__ void p11c_sliced(Frame& F) {
    constexpr int WL = 20224, NT = 4;
    const int gw = F.vcu * NWAVES + F.wave, NGW = F.G * NWAVES;
    LAS unsigned* LR = (LAS unsigned*)(F.lds + F.wave * WL);
    LAS int* CNT = (LAS int*)(LR + 1024);
    const unsigned char* TV = F.ws + WS_TV; const int* EIDg = (const int*)(F.ws + WS_EID); const float* AVg = (const float*)(F.ws + WS_AV);
    int lane = F.lane; asm volatile("" : "+v"(lane));
    const int lo16 = lane * 16;
    const int ntok = gw < SEQ ? (SEQ - gw + NGW - 1) / NGW : 0;
    for (int k0 = 0; k0 < ntok; k0 += NT) {
        const int nk = ntok - k0 < NT ? ntok - k0 : NT, np = nk * 128;
        if (lane < 8) CNT[lane] = 0;
        { unsigned rec[2 * NT]; int pos[2 * NT];
#pragma unroll
          for (int k = 0; k < NT; ++k) if (k < nk) { const size_t mb = (size_t)(gw + (k0 + k) * NGW) * 128;
#pragma unroll
              for (int hh = 0; hh < 2; ++hh) { const unsigned e = (unsigned)EIDg[mb + 64 * hh + lane] & 16383u; rec[2 * k + hh] = (e << 10) | (unsigned)(k << 7) | (unsigned)(64 * hh + lane);
                  pos[2 * k + hh] = __hip_atomic_fetch_add(CNT + (e >> 11), 1, __ATOMIC_RELAXED, __HIP_MEMORY_SCOPE_WORKGROUP); } }
          asm volatile("" ::: "memory");
          int base[8]; int run = 0;
#pragma unroll
          for (int sl = 0; sl < 8; ++sl) { base[sl] = run; run += CNT[sl]; }
#pragma unroll
          for (int k = 0; k < NT; ++k) if (k < nk)
#pragma unroll
              for (int hh = 0; hh < 2; ++hh) { const unsigned sl = rec[2 * k + hh] >> 21; int bs = base[0];
#pragma unroll
                  for (int t = 1; t < 8; ++t) bs = sl == (unsigned)t ? base[t] : bs;
                  LR[bs + pos[2 * k + hh]] = rec[2 * k + hh]; } }
        asm volatile("" ::: "memory");
        h2_t yh[NT][16];
#pragma unroll
        for (int k = 0; k < NT; ++k)
#pragma unroll
            for (int e = 0; e < 16; ++e) yh[k][e] = (h2_t){(_Float16)0.f, (_Float16)0.f};
        v4u rv[2][4]; unsigned rc[2][4]; float av[2][4];
#define P11V_LOAD(buf, g) do { const v4u r03 = *(const LAS v4u*)(LR + (g)); const unsigned rr[4] = {r03.x, r03.y, r03.z, r03.w}; \
            _Pragma("unroll") for (int q = 0; q < 4; ++q) { const unsigned r = (unsigned)__builtin_amdgcn_readfirstlane((int)rr[q]); rc[buf][q] = r; \
                rv[buf][q] = *(const GAS v4u*)(TV + (unsigned)(((r >> 10) << 10) + (unsigned)lo16)); \
                av[buf][q] = AVg[(size_t)(gw + (k0 + (int)((r >> 7) & 7u)) * NGW) * 128 + (r & 127u)]; } } while (0)
#define P11V_BODY(K) do { _Pragma("unroll") for (int dd = 0; dd < 4; ++dd) { yh[K][4 * dd] += a2 * __builtin_amdgcn_cvt_scalef32_pk_f16_fp4(wv[dd], 1.0f, 0); yh[K][4 * dd + 1] += a2 * __builtin_amdgcn_cvt_scalef32_pk_f16_fp4(wv[dd], 1.0f, 1); \
            yh[K][4 * dd + 2] += a2 * __builtin_amdgcn_cvt_scalef32_pk_f16_fp4(wv[dd], 1.0f, 2); yh[K][4 * dd + 3] += a2 * __builtin_amdgcn_cvt_scalef32_pk_f16_fp4(wv[dd], 1.0f, 3); } } while (0)
#define P11V_ACC(buf) do { _Pragma("unroll") for (int q = 0; q < 4; ++q) { const _Float16 ah = (_Float16)av[buf][q]; const h2_t a2 = {ah, ah}; const unsigned wv[4] = {rv[buf][q].x, rv[buf][q].y, rv[buf][q].z, rv[buf][q].w}; \
            switch ((rc[buf][q] >> 7) & 3u) { case 0: P11V_BODY(0); break; case 1: P11V_BODY(1); break; case 2: P11V_BODY(2); break; default: P11V_BODY(3); break; } \
            __builtin_amdgcn_sched_barrier(0); } } while (0)
        P11V_LOAD(0, 0);
#pragma unroll 1
        for (int g = 0; g < np; g += 8) { P11V_LOAD(1, g + 4); P11V_ACC(0); if (g + 8 < np) P11V_LOAD(0, g + 8); P11V_ACC(1); }
#undef P11V_LOAD
#undef P11V_BODY
#undef P11V_ACC
#pragma unroll
        for (int k = 0; k < NT; ++k) if (k < nk) { const int m = gw + (k0 + k) * NGW; float y[32];
#pragma unroll
            for (int e = 0; e < 16; ++e) { y[2 * e] = (float)yh[k][e].x; y[2 * e + 1] = (float)yh[k][e].y; }
            const bf16* x1 = (const bf16*)(F.ws + WS_X1B) + (size_t)m * DM; float s2 = 0.f;
#pragma unroll
            for (int j = 0; j < 2; ++j)
#pragma unroll
                for (int q = 0; q < 4; ++q) { const v2u a2 = *(const GAS v2u*)(x1 + j * 1024 + lo16 + 4 * q); y[16 * j + 4 * q] += bflo(a2.x); y[16 * j + 4 * q + 1] += bfhi(a2.x); y[16 * j + 4 * q + 2] += bflo(a2.y); y[16 * j + 4 * q + 3] += bfhi(a2.y); }
#pragma unroll
            for (int e = 0; e < 32; ++e) s2 += y[e] * y[e];
            const float ro = 1.0f / sqrtf(wave_sum(s2) * (1.f / DM) + EPS);
            float* orow = F.out + (size_t)m * DM;
#pragma unroll
            for (int j = 0; j < 2; ++j)
#pragma unroll
                for (int q = 0; q < 4; ++q) { const f32x4 a = *(const GAS f32x4*)(F.in[I_FNW] + j * 1024 + lo16 + 4 * q);
                    *(GAS f32x4*)(orow + j * 1024 + lo16 + 4 * q) = (f32x4){y[16 * j + 4 * q] * ro * a.x, y[16 * j + 4 * q + 1] * ro * a.y, y[16 * j + 4 * q + 2] * ro * a.z, y[16 * j + 4 * q + 3] * ro * a.w}; } }
        asm volatile("" ::: "memory");
    }
}
#endif
template <int SKIP>
__device__ __forceinline__ void p11c_vsum(Frame& F) {
    const int gw = F.vcu * NWAVES + F.wave, NGW = F.G * NWAVES;
    LAS int* EID = (LAS int*)(F.lds + F.wave * 16384); LAS float* AV = (LAS float*)(EID + 128);
    const unsigned char* TV = F.ws + WS_TV; const int* EIDg = (const int*)(F.ws + WS_EID); const float* AVg = (const float*)(F.ws + WS_AV);
    const int nmy = PEER_LOCAL ? 8 * ((SEQ / 64 - F.vcu + F.G - 1) / F.G) : (gw < SEQ ? (SEQ - gw + NGW - 1) / NGW : 0);
    for (int ti = 0; ti < nmy; ++ti) { const int m = PEER_LOCAL ? (F.vcu + (ti >> 3) * F.G) * 64 + F.wave * 8 + (ti & 7) : gw + ti * NGW;
        int lane = F.lane; asm volatile("" : "+v"(lane));
        const int lo16 = lane * 16;
        if (P11B_DIRECT && P11_FUSED) p11_udot_token<false>(F, m, lane, EID, AV);
        else { EID[lane] = EIDg[(size_t)m * 128 + lane]; EID[lane + 64] = EIDg[(size_t)m * 128 + 64 + lane]; AV[lane] = AVg[(size_t)m * 128 + lane]; AV[lane + 64] = AVg[(size_t)m * 128 + 64 + lane]; }
        asm volatile("" ::: "memory");
        f32x2 y2[16];
#pragma unroll
        for (int e = 0; e < 16; ++e) y2[e] = (f32x2){0.f, 0.f};
        constexpr int NR = VFMT == 4 ? 8 : 4;
        float av[2][NR];
#if VFMT == 64
        v4u rv[2][4]; v2u rw[2][4]; bool bg[2][4];
        float thr2; { const float a0 = AV[lane], a1 = AV[lane + 64]; thr2 = wave_sum(a0 * a0 + a1 * a1) * (VMIX_C / 128.0f); }
        const unsigned char* TV4 = F.ws + WS_TV4;
#define P11C_LOAD(buf, g) do { _Pragma("unroll") for (int q = 0; q < 4; ++q) { const int e = __builtin_amdgcn_readfirstlane(EID[(g) + q]); const float a = AV[(g) + q]; av[buf][q] = a; \
            const bool big = __builtin_amdgcn_readfirstlane((int)(a * a > thr2)) != 0; bg[buf][q] = big; \
            const unsigned char* p0 = big ? TV + (size_t)e * TV_PITCH : TV4 + (size_t)e * 1024; const unsigned char* p1 = big ? TV + (size_t)e * TV_PITCH + 1024 : TV;     \
            rv[buf][q] = *(const GAS v4u*)(p0 + lo16); rw[buf][q] = *(const GAS v2u*)(p1 + lane * 8); } } while (0)
#define P11C_ACC(buf) do { _Pragma("unroll") for (int q = 0; q < 4; ++q) { const float a = av[buf][q]; \
            if (bg[buf][q]) { const f32x2 a2 = {a, a}; const v6u pk = {rv[buf][q].x, rv[buf][q].y, rv[buf][q].z, rv[buf][q].w, rw[buf][q].x, rw[buf][q].y}; const v32f f = __builtin_amdgcn_cvt_scalef32_pk32_f32_fp6(pk, 1.0f); \
                _Pragma("unroll") for (int k = 0; k < 16; ++k) y2[k] += a2 * (f32x2){f[2 * k], f[2 * k + 1]}; } \
            else { const f32x2 a2 = {a * 1.25f, a * 1.25f}; const unsigned wv[4] = {rv[buf][q].x, rv[buf][q].y, rv[buf][q].z, rv[buf][q].w}; \
                _Pragma("unroll") for (int dd = 0; dd < 4; ++dd) { y2[4 * dd] += a2 * __builtin_amdgcn_cvt_scalef32_pk_f32_fp4(wv[dd], 1.0f, 0); y2[4 * dd + 1] += a2 * __builtin_amdgcn_cvt_scalef32_pk_f32_fp4(wv[dd], 1.0f, 1); \
                    y2[4 * dd + 2] += a2 * __builtin_amdgcn_cvt_scalef32_pk_f32_fp4(wv[dd], 1.0f, 2); y2[4 * dd + 3] += a2 * __builtin_amdgcn_cvt_scalef32_pk_f32_fp4(wv[dd], 1.0f, 3); } } \
            __builtin_amdgcn_sched_barrier(0); } } while (0)
#elif VFMT == 6
        v4u rv[2][4]; v2u rw[2][4];
#define P11C_LOAD(buf, g) do { _Pragma("unroll") for (int q = 0; q < 4; ++q) { const int e = __builtin_amdgcn_readfirstlane(EID[(g) + q]); av[buf][q] = AV[(g) + q]; const unsigned char* rp = TV + (size_t)e * TV_PITCH; \
            rv[buf][q] = *(const GAS v4u*)(rp + lo16); rw[buf][q] = *(const GAS v2u*)(rp + 1024 + lane * 8); } } while (0)
#define P11C_ACC(buf) do { _Pragma("unroll") for (int q = 0; q < 4; ++q) { const float a = av[buf][q]; const f32x2 a2 = {a, a}; \
            const v6u pk = {rv[buf][q].x, rv[buf][q].y, rv[buf][q].z, rv[buf][q].w, rw[buf][q].x, rw[buf][q].y}; const v32f f = __builtin_amdgcn_cvt_scalef32_pk32_f32_fp6(pk, 1.0f); \
            _Pragma("unroll") for (int k = 0; k < 16; ++k) y2[k] += a2 * (f32x2){f[2 * k], f[2 * k + 1]}; \
            __builtin_amdgcn_sched_barrier(0); } } while (0)
#elif VFMT == 4
        v4u rv[2][NR];
#define P11C_LOAD(buf, g) do { _Pragma("unroll") for (int q = 0; q < NR; ++q) { const int e = __builtin_amdgcn_readfirstlane(EID[(g) + q]) & ((SKIP & 1) ? 2047 : 16383); av[buf][q] = AV[(g) + q]; rv[buf][q] = *(const GAS v4u*)(TV + (size_t)e * TV_PITCH + lo16); } } while (0)
#if V16
        h2_t yh[16];
#pragma unroll
        for (int e = 0; e < 16; ++e) yh[e] = (h2_t){(_Float16)0.f, (_Float16)0.f};
#define P11C_ACC(buf) do { _Pragma("unroll") for (int q = 0; q < NR; ++q) { const _Float16 ah = (_Float16)av[buf][q]; const h2_t a2 = {ah, ah}; const unsigned wv[4] = {rv[buf][q].x, rv[buf][q].y, rv[buf][q].z, rv[buf][q].w}; \
            _Pragma("unroll") for (int dd = 0; dd < 4; ++dd) { if (SKIP & 2) { yh[4 * dd] += a2 * __builtin_bit_cast(h2_t, wv[dd] & 0x03ff03ffu); yh[4 * dd + 1] += a2 * __builtin_bit_cast(h2_t, (wv[dd] >> 1) & 0x03ff03ffu); yh[4 * dd + 2] += a2 * __builtin_bit_cast(h2_t, (wv[dd] >> 2) & 0x03ff03ffu); yh[4 * dd + 3] += a2 * __builtin_bit_cast(h2_t, (wv[dd] >> 3) & 0x03ff03ffu); } else { \
                yh[4 * dd] += a2 * __builtin_amdgcn_cvt_scalef32_pk_f16_fp4(wv[dd], 1.0f, 0); yh[4 * dd + 1] += a2 * __builtin_amdgcn_cvt_scalef32_pk_f16_fp4(wv[dd], 1.0f, 1); \
                yh[4 * dd + 2] += a2 * __builtin_amdgcn_cvt_scalef32_pk_f16_fp4(wv[dd], 1.0f, 2); yh[4 * dd + 3] += a2 * __builtin_amdgcn_cvt_scalef32_pk_f16_fp4(wv[dd], 1.0f, 3); } } \
            __builtin_amdgcn_sched_barrier(0); } } while (0)
#else
#define P11C_ACC(buf) do { _Pragma("unroll") for (int q = 0; q < NR; ++q) { const float a = av[buf][q]; const f32x2 a2 = {a, a}; const unsigned wv[4] = {rv[buf][q].x, rv[buf][q].y, rv[buf][q].z, rv[buf][q].w}; \
            _Pragma("unroll") for (int dd = 0; dd < 4; ++dd) { y2[4 * dd] += a2 * __builtin_amdgcn_cvt_scalef32_pk_f32_fp4(wv[dd], 1.0f, 0); y2[4 * dd + 1] += a2 * __builtin_amdgcn_cvt_scalef32_pk_f32_fp4(wv[dd], 1.0f, 1); \
                y2[4 * dd + 2] += a2 * __builtin_amdgcn_cvt_scalef32_pk_f32_fp4(wv[dd], 1.0f, 2); y2[4 * dd + 3] += a2 * __builtin_amdgcn_cvt_scalef32_pk_f32_fp4(wv[dd], 1.0f, 3); } \
            __builtin_amdgcn_sched_barrier(0); } } while (0)
#endif
#else
        v4u rv[2][4][2];
#define P11C_LOAD(buf, g) do { _Pragma("unroll") for (int q = 0; q < 4; ++q) { const int e = __builtin_amdgcn_readfirstlane(EID[(g) + q]); av[buf][q] = AV[(g) + q]; const unsigned char* rp = TV + (size_t)e * DM + lo16; \
            rv[buf][q][0] = *(const GAS v4u*)(rp); rv[buf][q][1] = *(const GAS v4u*)(rp + 1024); } } while (0)
#define P11C_ACC(buf) do { _Pragma("unroll") for (int q = 0; q < 4; ++q) { const float a = av[buf][q]; const f32x2 a2 = {a, a}; \
            _Pragma("unroll") for (int j = 0; j < 2; ++j) { const v4u r = rv[buf][q][j]; const unsigned wv[4] = {r.x, r.y, r.z, r.w}; \
                _Pragma("unroll") for (int dd = 0; dd < 4; ++dd) { y2[8 * j + 2 * dd] += a2 * __builtin_amdgcn_cvt_pk_f32_fp8((int)wv[dd], false); y2[8 * j + 2 * dd + 1] += a2 * __builtin_amdgcn_cvt_pk_f32_fp8((int)wv[dd], true); } } \
            __builtin_amdgcn_sched_barrier(0); } } while (0)
#endif
        P11C_LOAD(0, 0);
#pragma unroll 1
        for (int g = 0; g < 128; g += 2 * NR) {
            P11C_LOAD(1, g + NR);
            P11C_ACC(0);
            if (g + 2 * NR < 128) P11C_LOAD(0, g + 2 * NR);
            P11C_ACC(1);
        }
#undef P11C_LOAD
#undef P11C_ACC
        float y[32];
#if VFMT == 4 && V16
#pragma unroll
        for (int e = 0; e < 16; ++e) y2[e] = (f32x2){(float)yh[e].x, (float)yh[e].y};
#endif
#pragma unroll
        for (int e = 0; e < 16; ++e) { if ((VFMT == 6 || VFMT == 64) && FP6_IL) { y[e] = y2[e].x; y[16 + e] = y2[e].y; } else { y[2 * e] = y2[e].x; y[2 * e + 1] = y2[e].y; } }
        const bf16* x1 = (const bf16*)(F.ws + WS_X1B) + (size_t)m * DM;
        float s2 = 0.f;
#pragma unroll
        for (int j = 0; j < 2; ++j)
#pragma unroll
            for (int q = 0; q < 4; ++q) { const v2u a2 = *(const GAS v2u*)(x1 + j * 1024 + lo16 + 4 * q); const f32x4 a = {bflo(a2.x), bfhi(a2.x), bflo(a2.y), bfhi(a2.y)};
                y[16 * j + 4 * q] += a.x; y[16 * j + 4 * q + 1] += a.y; y[16 * j + 4 * q + 2] += a.z; y[16 * j + 4 * q + 3] += a.w; }
#pragma unroll
        for (int e = 0; e < 32; ++e) s2 += y[e] * y[e];
        const float ro = 1.0f / sqrtf(wave_sum(s2) * (1.f / DM) + EPS);
        float* orow = F.out + (size_t)m * DM;
#pragma unroll
        for (int j = 0; j < 2; ++j)
#pragma unroll
            for (int q = 0; q < 4; ++q) { const f32x4 a = *(const GAS f32x4*)(F.in[I_FNW] + j * 1024 + lo16 + 4 * q);
                *(GAS f32x4*)(orow + j * 1024 + lo16 + 4 * q) = (f32x4){y[16 * j + 4 * q] * ro * a.x, y[16 * j + 4 * q + 1] * ro * a.y, y[16 * j + 4 * q + 2] * ro * a.z, y[16 * j + 4 * q + 3] * ro * a.w}; }
    }
}
#ifndef MK_N_LAUNCHES
#define MK_N_LAUNCHES 1
#endif
constexpr int N_PHASES = 14;
constexpr int N_LAUNCHES = MK_N_LAUNCHES;
static_assert(N_LAUNCHES == 1 || N_LAUNCHES == N_PHASES, "MK_N_LAUNCHES is 1 or N_PHASES");
#ifndef PG8_SP2
#define PG8_SP2 true
#endif
#ifndef PG8_ALIGN
#define PG8_ALIGN true
#endif
struct Args { const float* in[19]; float* out; unsigned char* ws; int ph_lo, ph_hi; };
__global__ void __launch_bounds__(NTHR, 2) fwd_kernel(Args args) {
    extern __shared__ __attribute__((aligned(16))) unsigned char lds[];
    Frame F;
    F.lds = (LAS unsigned char*)lds;
    F.MISC = (volatile LAS unsigned*)(F.lds + MISC_OFF);
    F.tid = threadIdx.x; F.lane = F.tid & 63; F.wave = __builtin_amdgcn_readfirstlane(F.tid >> 6);
    F.G = gridDim.x; { const int bx = blockIdx.x; F.vcu = (F.G % 8 == 0) ? (bx % 8) * (F.G / 8) + bx / 8 : bx; }
    F.ws = args.ws; F.out = args.out; F.ctl = (gu32*)(args.ws + WS_CTL);
#pragma unroll
    for (int i = 0; i < 19; ++i) F.in[i] = args.in[i];
    for (int u = F.tid; u < (LDS_BYTES - MISC_OFF) / 4; u += NTHR) ((LAS unsigned*)(F.lds + MISC_OFF))[u] = 0u;
    __syncthreads();
    XcdBarrier bar; bar.bar = (unsigned*)(F.ctl + CW_BAR); bar.x = 0; bar.st = nullptr;
    if (N_LAUNCHES == 1) bar = xcd_barrier_post((unsigned*)(F.ctl + CW_BAR), F.MISC + 8);
    const int lo = args.ph_lo, hi = args.ph_hi;
#ifdef ONLY_PHASE
#define IN(k) ((k) == ONLY_PHASE && lo <= (k) && (k) < hi)
#else
#define IN(k) (lo <= (k) && (k) < hi)
#endif
#define SEAM(k) do { if (IN(k) && IN((k) + 1)) xcd_barrier(bar); } while (0)
#ifndef REPEAT_MASK
#define REPEAT_MASK 0
#endif
#ifndef P11A_SKIP
#define P11A_SKIP 0
#endif
#define REPS(k) for (int rep_ = 0; rep_ < (((REPEAT_MASK) >> (k)) & 1) + 1; ++rep_)
#define RSEAM(k) do { if ((((REPEAT_MASK) >> (k)) & 1) && rep_ == 0) xcd_barrier(bar); } while (0)
    unsigned char* ws = args.ws;
    if (IN(0)) { REPS(0) { p0_prologue(F); RSEAM(0); } SEAM(0); }
    if (IN(1)) {
        constexpr bool GG = GATE_IN_G1 && QM_G1 == 2 && QM_GATE == 2; constexpr int NG1 = GG ? N1 + 4096 : N1;
        pg8::Gemm g{(const bf16*)(ws + WS_XN), (const bf16*)(ws + WS_W1), SEQ, NG1, DM}; pg8::StaticOrder S; S.init(SEQ, NG1, F.G, (int)blockIdx.x);
        EpiG1 E{ws, F.in[I_LB], (const float*)(ws + WS_QX), (const float*)(ws + WS_QW) + QW_W1};
        if (QM_G1) g.A = (const bf16*)((const unsigned char*)F.out + DO_XN8);
        if (GG) { EpiG1G EG{E, ws + WS_GA8, ws + WS_GB8};
            if ((REPEAT_MASK >> 1) & 1) { pg8::gemm_phase<EpiG1G, pg8::StaticOrder, PG8_ALIGN, PG8_SP2, 2>(F.lds, g, S, EG); xcd_barrier(bar); }
            pg8::gemm_phase<EpiG1G, pg8::StaticOrder, PG8_ALIGN, PG8_SP2, 2>(F.lds, g, S, EG); }
        else {
        if ((REPEAT_MASK >> 1) & 1) { pg8::gemm_phase<EpiG1, pg8::StaticOrder, PG8_ALIGN, PG8_SP2, QM_G1>(F.lds, g, S, E); xcd_barrier(bar); }
        pg8::gemm_phase<EpiG1, pg8::StaticOrder, PG8_ALIGN, PG8_SP2, QM_G1>(F.lds, g, S, E); }
        p1_ab(F);
        SEAM(1);
    }
#ifdef EXTRA_BARRIERS
    for (int eb = 0; eb < EXTRA_BARRIERS; ++eb) xcd_barrier(bar);
#endif
    if (IN(2)) { REPS(2) { hgrn_pass<false>(F); RSEAM(2); } SEAM(2); }
    if (IN(3)) { if ((REPEAT_MASK >> 3) & 1) { hgrn_pass<true, P11A_SKIP>(F); xcd_barrier(bar); } hgrn_pass<true>(F); SEAM(3); }
    if (IN(4)) { if ((REPEAT_MASK >> 4) & 1) { gdn_prep<P11A_SKIP>(F); xcd_barrier(bar); } gdn_prep<0>(F); SEAM(4); }
    if (IN(5)) { if ((REPEAT_MASK >> 5) & 1) { gdn_pass<false, P11A_SKIP>(F); xcd_barrier(bar); } gdn_pass<false>(F); SEAM(5); }
    if (IN(6)) { if ((REPEAT_MASK >> 6) & 1) { gdn_pass<true, P11A_SKIP>(F); xcd_barrier(bar); } gdn_pass<true>(F); SEAM(6); }
    if (IN(7)) { REPS(7) { p7_mix(F); RSEAM(7); } SEAM(7); }
    if (IN(8)) {
        pg8::StaticOrder S; S.init(SEQ, DM, F.G, (int)blockIdx.x);
        bf16* GT = (bf16*)(ws + WS_GT); unsigned char* GA8 = ws + WS_GT2; unsigned char* GB8 = ws + WS_GT2 + 32 * MiB;
        const bf16* XNg = QM_GATE ? (const bf16*)((const unsigned char*)F.out + DO_XN8) : (const bf16*)(ws + WS_XN);
        const bf16* WG2 = QM_GATE ? (const bf16*)(ws + WS_WG + (size_t)DM * DM) : (const bf16*)(ws + WS_WG) + (size_t)DM * DM;
        const float* QX = (const float*)(ws + WS_QX); const float* QW = (const float*)(ws + WS_QW);
#if GATE_IN_G1
#define P8_BODY \
        { pg8::Gemm g{(const bf16*)(ws + WS_YA), (const bf16*)(ws + WS_WPA), SEQ, DM, HW}; EpiMix<0> E{GT, ws + WS_GA8, nullptr, QX + SEQ, QW + QW_WPA, nullptr}; pg8::gemm_phase<EpiMix<0>, pg8::StaticOrder, PG8_ALIGN, PG8_SP2, QM_MIX>(F.lds, g, S, E); } \
        VM_WAIT(); __syncthreads();        \
        { pg8::Gemm g{(const bf16*)(ws + WS_YB), (const bf16*)(ws + WS_WPB), SEQ, DM, HW}; EpiMix<1> E{GT, ws + WS_GB8, ws + WS_GT8, QX + 2 * SEQ, QW + QW_WPB, (unsigned*)(F.ctl + CW_ROWMAX)}; pg8::gemm_phase<EpiMix<1>, pg8::StaticOrder, PG8_ALIGN, PG8_SP2, QM_MIX>(F.lds, g, S, E); }
#else
#define P8_BODY \
        { pg8::Gemm g{XNg, (const bf16*)(ws + WS_WG), SEQ, DM, DM}; EpiGate E{GA8, QX, QW + QW_WG}; pg8::gemm_phase<EpiGate, pg8::StaticOrder, PG8_ALIGN, PG8_SP2, QM_GATE>(F.lds, g, S, E); } \
        VM_WAIT(); __syncthreads();        \
        { pg8::Gemm g{(const bf16*)(ws + WS_YA), (const bf16*)(ws + WS_WPA), SEQ, DM, HW}; EpiMix<0> E{GT, GA8, nullptr, QX + SEQ, QW + QW_WPA, nullptr}; pg8::gemm_phase<EpiMix<0>, pg8::StaticOrder, PG8_ALIGN, PG8_SP2, QM_MIX>(F.lds, g, S, E); } \
        { pg8::Gemm g{XNg, WG2, SEQ, DM, DM}; EpiGate E{GB8, QX, QW + QW_WG + DM}; pg8::gemm_phase<EpiGate, pg8::StaticOrder, PG8_ALIGN, PG8_SP2, QM_GATE>(F.lds, g, S, E); } \
        VM_WAIT(); __syncthreads();        \
        { pg8::Gemm g{(const bf16*)(ws + WS_YB), (const bf16*)(ws + WS_WPB), SEQ, DM, HW}; EpiMix<1> E{GT, GB8, ws + WS_GT8, QX + 2 * SEQ, QW + QW_WPB, (unsigned*)(F.ctl + CW_ROWMAX)}; pg8::gemm_phase<EpiMix<1>, pg8::StaticOrder, PG8_ALIGN, PG8_SP2, QM_MIX>(F.lds, g, S, E); }
#endif
        if ((REPEAT_MASK >> 8) & 1) { P8_BODY xcd_barrier(bar); }
        P8_BODY
#undef P8_BODY
        SEAM(8);
    }
    if (IN(9)) {
        if (QM_OUT == 2) { p8b_quant(F); xcd_barrier(bar); }
        pg8::Gemm g{(const bf16*)(ws + (QM_OUT ? WS_GT8 : WS_GT)), (const bf16*)(ws + WS_WOUT), SEQ, DM, DM}; pg8::StaticOrder S; S.init(SEQ, DM, F.G, (int)blockIdx.x);
        EpiX1 E{F.in[I_X], F.out, (bf16*)(ws + WS_X1B), ws + WS_X18, (const unsigned char*)F.out + DO_XN8, (const float*)(ws + WS_QX) + 3 * SEQ, F.in[I_N1W], (const float*)(ws + WS_QX) + 4 * SEQ, (const float*)(ws + WS_QW) + QW_WOUT};
        if ((REPEAT_MASK >> 9) & 1) { pg8::gemm_phase<EpiX1, pg8::StaticOrder, PG8_ALIGN, PG8_SP2, QM_OUT>(F.lds, g, S, E); xcd_barrier(bar); }
        pg8::gemm_phase<EpiX1, pg8::StaticOrder, PG8_ALIGN, PG8_SP2, QM_OUT>(F.lds, g, S, E);
        SEAM(9);
    }
    if (IN(10)) {
        pg8::Gemm g{(const bf16*)(ws + (QM_SC == 1 ? WS_X18 : WS_X1B)), (const bf16*)(ws + WS_WS), SEQ, DM, DM}; pg8::StaticOrder S; S.init(SEQ, DM, F.G, (int)blockIdx.x);
        EpiBf E{(bf16*)(ws + WS_SC)};
        if ((REPEAT_MASK >> 10) & 1) { pg8::gemm_phase<EpiBf, pg8::StaticOrder, PG8_ALIGN, PG8_SP2, QM_SC>(F.lds, g, S, E); xcd_barrier(bar); }
        pg8::gemm_phase<EpiBf, pg8::StaticOrder, PG8_ALIGN, PG8_SP2, QM_SC>(F.lds, g, S, E);
        SEAM(10);
    }
    if (IN(11)) {
        if ((REPEAT_MASK >> 11) & 1) { p11a_topk<P11A_SKIP>(F); xcd_barrier(bar); if (blockIdx.x == 0) for (int i = F.tid; i < NBUCK + 1; i += NTHR) __hip_atomic_store((unsigned*)(F.ctl + CW_CNT) + i * 16, 0u, __ATOMIC_RELAXED, __HIP_MEMORY_SCOPE_AGENT); xcd_barrier(bar); }
        p11a_topk<0>(F);
        if (PEER_LOCAL && P11B_DIRECT && P11B_SLICED && UFMT == 4) { VM_WAIT(); __syncthreads(); } else SEAM(11); }
    if (IN(12)) { if ((REPEAT_MASK >> 12) & 1) { if (P11B_DIRECT) { if (P11B_SLICED && UFMT == 4) p11b_direct_sliced<P11A_SKIP>(F); else p11b_direct(F); } else p11b_udot<P11A_SKIP>(F); xcd_barrier(bar); if (blockIdx.x == 0 && F.tid == 0) __hip_atomic_store((unsigned*)(F.ctl + CW_Q), 0u, __ATOMIC_RELAXED, __HIP_MEMORY_SCOPE_AGENT); xcd_barrier(bar); } if (P11B_DIRECT && P11_FUSED) {} else { if (P11B_DIRECT) { if (P11B_SLICED && UFMT == 4) p11b_direct_sliced<0>(F); else p11b_direct(F); } else p11b_udot<0>(F);
            if (PEER_LOCAL && P11B_DIRECT && P11B_SLICED && UFMT == 4) { VM_WAIT(); __syncthreads(); } else SEAM(12); } }
    if (IN(13)) { if ((REPEAT_MASK >> 13) & 1) { p11c_vsum<P11A_SKIP>(F); xcd_barrier(bar); }
#if P11C_MFMA == 2 && VFMT == 4
        p11c_mfma_sliced(F); }
#elif P11C_MFMA && VFMT == 4
        p11c_mfma(F); }
#else
        if (P11C_SLICED && VFMT == 4 && V16) p11c_sliced(F); else p11c_vsum<0>(F); }
#endif

#undef IN
#undef SEAM
}


#ifdef PROBE
__global__ void digest_kernel(const unsigned* ws, float* out) {
    const size_t n = (size_t)SEQ * DM;
    for (size_t i = (size_t)blockIdx.x * blockDim.x + threadIdx.x; i < n; i += (size_t)gridDim.x * blockDim.x) {
        unsigned acc = (PROBE >= 9) ? __builtin_bit_cast(unsigned, out[i]) : 0u;
        const size_t offs[5] = {0, 128 * MiB / 4, 256 * MiB / 4, 384 * MiB / 4, 408 * MiB / 4};
#pragma unroll
        for (int r = 0; r < 5; ++r) acc = acc * 1664525u + ws[offs[r] + i];
        out[i] = (float)(acc >> 8) * (1.0f / 16777216.0f);
    }
}
#endif
extern "C" void kernel_launch(void* const* d_in, const int* in_sizes, int n_in, void* d_out, int out_size, void* d_ws, size_t ws_size, hipStream_t stream) {
    static int grid = 0;
    if (grid == 0) {
        if (n_in != 19 || in_sizes[0] != SEQ * DM || out_size != SEQ * DM || ws_size < WS_END) { fprintf(stderr, "kernel_launch: unexpected shapes (n_in %d, in0 %d, out %d, ws %zu; need ws >= %zu)\n", n_in, n_in > 0 ? in_sizes[0] : -1, out_size, ws_size, (size_t)WS_END); grid = -1; return; }
        int dev = 0, cus = 0, per_cu = 0;
        if (hipGetDevice(&dev) != hipSuccess || hipDeviceGetAttribute(&cus, hipDeviceAttributeMultiprocessorCount, dev) != hipSuccess) { grid = -1; return; }
        if (hipFuncSetAttribute((const void*)fwd_kernel, hipFuncAttributeMaxDynamicSharedMemorySize, LDS_BYTES) != hipSuccess) { fprintf(stderr, "kernel_launch: hipFuncSetAttribute failed\n"); grid = -1; return; }
        if (hipOccupancyMaxActiveBlocksPerMultiprocessor(&per_cu, (const void*)fwd_kernel, NTHR, LDS_BYTES) != hipSuccess || per_cu < 1) fprintf(stderr, "kernel_launch: occupancy query reports %d\n", per_cu);
        (void)hipGetLastError();
        grid = cus;
    }
    if (grid < 0) return;
    (void)hipMemsetAsync((char*)d_ws + WS_CTL, 0, CTL_ZERO_BYTES, stream);
    Args a{};
    for (int i = 0; i < 19; ++i) a.in[i] = (const float*)d_in[i];
    a.out = (float*)d_out; a.ws = (unsigned char*)d_ws;
    for (int li = 0; li < N_LAUNCHES; ++li) {
        a.ph_lo = (N_LAUNCHES == 1) ? 0 : li; a.ph_hi = (N_LAUNCHES == 1) ? N_PHASES : li + 1;
#ifdef PROBE
        if (li > PROBE) break;
#endif
        hipLaunchKernelGGL(fwd_kernel, dim3(grid), dim3(NTHR), LDS_BYTES, stream, a);
    }
#ifdef PROBE
    hipLaunchKernelGGL(digest_kernel, dim3(2048), dim3(256), 0, stream, (const unsigned*)d_ws, (float*)d_out);
#endif
}
```
